# Optimizing an MI355X kernel written in HIP

```python
import math
import jax, jax.numpy as jnp
from jax import lax
import numpy as np

D_MODEL = 1024
BATCH = 2
SEQ = 8192
DEPTH = 1

GRID_W = 64
SSM_HEADS = 16
SSM_HEAD_DIM = 64
SSM_INNER = SSM_HEADS * SSM_HEAD_DIM
SSM_GROUPS = 2
SSM_STATE = 128
SSM_CONV = 5
SSM_CHUNK = 128
CONV_CH = SSM_INNER + 2 * SSM_GROUPS * SSM_STATE
ATTN_HEADS = 8
ATTN_KV_HEADS = 2
ATTN_HEAD_DIM = 128
ATTN_Q_WIDTH = ATTN_HEADS * ATTN_HEAD_DIM
ATTN_KV_WIDTH = ATTN_KV_HEADS * ATTN_HEAD_DIM
ATTN_Q_BLOCK = 128
ROPE_THETA = 10000.0
ROPE_AXIS_DIM = ATTN_HEAD_DIM // 2
N_BRANCHES = 2
Z_END = SSM_INNER
XBC_END = Z_END + CONV_CH
DTF_END = XBC_END + SSM_HEADS
DTB_END = DTF_END + SSM_HEADS
Q_END = DTB_END + ATTN_Q_WIDTH
K_END = Q_END + ATTN_KV_WIDTH
V_END = K_END + ATTN_KV_WIDTH
IN_COLS = V_END + N_BRANCHES * D_MODEL
SPLITS = [Z_END, XBC_END, DTF_END, DTB_END, Q_END, K_END, V_END]
N_EXPERTS = 32
TOP_K = 4
D_EXPERT = D_MODEL
SWIGLU_LIMIT = 7.0
SWIGLU_ALPHA = 1.702
MOE_BLOCK = 128
NORM_EPS = 1e-6

kernel_name = "hybrid_ssd_axial_gqa_moe_encoder"


def rmsnorm(x, g):
    xf = x.astype(jnp.float32)
    y = xf * lax.rsqrt(jnp.mean(xf * xf, axis=-1, keepdims=True) + NORM_EPS)
    return y.astype(x.dtype) * g


def depthwise_conv(u, w, b):
    pad = (SSM_CONV - 1) // 2
    y = lax.conv_general_dilated(u, w[:, None, :], window_strides=(1,),
                                 padding=[(pad, SSM_CONV - 1 - pad)],
                                 dimension_numbers=('NWC', 'WIO', 'NWC'),
                                 feature_group_count=u.shape[-1])
    return y + b


def ssd_scan(x, dt, A, Bm, Cm):
    b, l, h, p = x.shape
    g, n = Bm.shape[-2:]
    hg = h // g
    c = l // SSM_CHUNK
    L = SSM_CHUNK
    xr = (x * dt[..., None].astype(x.dtype)).reshape(b, c, L, g, hg, p)
    a = (dt * A.astype(jnp.float32)).reshape(b, c, L, g, hg)
    a_cs = jnp.cumsum(a, axis=2)
    Br = Bm.reshape(b, c, L, g, n)
    Cr = Cm.reshape(b, c, L, g, n)
    seg = a_cs[:, :, :, None] - a_cs[:, :, None, :]
    mask = jnp.tril(jnp.ones((L, L), dtype=bool))[:, :, None, None]
    lmat = jnp.exp(jnp.where(mask, seg, -jnp.inf))
    cb = jnp.einsum('bclgn,bcsgn->bclsg', Cr, Br)
    y_diag = jnp.einsum('bclsgh,bcsghp->bclghp', cb[..., None] * lmat, xr)
    decay_to_end = jnp.exp(a_cs[:, :, -1:] - a_cs)
    states = jnp.einsum('bclgn,bclghp->bcghpn', Br, xr * decay_to_end[..., None])
    chunk_decay = jnp.exp(a_cs[:, :, -1])

    def step(carry, inp):
        st, dec = inp
        return carry * dec[..., None, None] + st, carry

    init = jnp.zeros((b, g, hg, p, n), states.dtype)
    _, prev = lax.scan(step, init, (jnp.moveaxis(states, 1, 0), jnp.moveaxis(chunk_decay, 1, 0)))
    prev = jnp.moveaxis(prev, 0, 1)
    y_off = jnp.einsum('bclgn,bcghpn->bclghp', Cr, prev) * jnp.exp(a_cs)[..., None]
    return (y_diag + y_off).reshape(b, l, h, p).astype(x.dtype)


def rope_axis(part, ang):
    m = ang.shape[-1]
    cos = jnp.cos(ang)[None, :, None, :].astype(part.dtype)
    sin = jnp.sin(ang)[None, :, None, :].astype(part.dtype)
    p1, p2 = part[..., :m], part[..., m:]
    return jnp.concatenate([p1 * cos - p2 * sin, p2 * cos + p1 * sin], axis=-1)


def axial_rope(t, row, col):
    inv_freq = ROPE_THETA ** (-jnp.arange(0, ROPE_AXIS_DIM, 2, dtype=jnp.float32) / ROPE_AXIS_DIM)
    ang_r = row.astype(jnp.float32)[:, None] * inv_freq
    ang_c = col.astype(jnp.float32)[:, None] * inv_freq
    return jnp.concatenate([rope_axis(t[..., :ROPE_AXIS_DIM], ang_r),
                            rope_axis(t[..., ROPE_AXIS_DIM:], ang_c)], axis=-1)


def blocked_attention(q, k, v):
    b, s, hq, d = q.shape
    hkv = k.shape[2]
    grp = hq // hkv
    nb = s // ATTN_Q_BLOCK
    qb = q.reshape(b, nb, ATTN_Q_BLOCK, hkv, grp, d).transpose(1, 0, 2, 3, 4, 5)
    scale = d ** -0.5

    def one_block(qblk):
        sc = jnp.einsum('bqkgd,bskd->bkgqs', qblk, k).astype(jnp.float32) * scale
        pr = jax.nn.softmax(sc, axis=-1).astype(v.dtype)
        return jnp.einsum('bkgqs,bskd->bqkgd', pr, v)

    o = lax.map(one_block, qb)
    return o.transpose(1, 0, 2, 3, 4, 5).reshape(b, s, hq * d)


def token_mixer(h, w_in, conv_w, conv_b, dt_bias_f, dt_bias_b, a_log_f, a_log_b, d_skip,
                g_ssm, q_norm_g, k_norm_g, w_br_ssm, w_br_attn, w_out):
    b, s, _ = h.shape
    proj = h @ w_in
    z, xbc, dt_f, dt_b, q, k, v, gates = jnp.split(proj, SPLITS, axis=-1)

    xbc = jax.nn.silu(depthwise_conv(xbc, conv_w, conv_b))
    xs, Bm, Cm = jnp.split(xbc, [SSM_INNER, SSM_INNER + SSM_GROUPS * SSM_STATE], axis=-1)
    xs = xs.reshape(b, s, SSM_HEADS, SSM_HEAD_DIM)
    Bm = Bm.reshape(b, s, SSM_GROUPS, SSM_STATE)
    Cm = Cm.reshape(b, s, SSM_GROUPS, SSM_STATE)
    dtf = jax.nn.softplus((dt_f + dt_bias_f).astype(jnp.float32))
    dtb = jax.nn.softplus((dt_b + dt_bias_b).astype(jnp.float32))
    flip = lambda t: jnp.flip(t, axis=1)
    y_f = ssd_scan(xs, dtf, -jnp.exp(a_log_f.astype(jnp.float32)), Bm, Cm)
    y_b = flip(ssd_scan(flip(xs), flip(dtb), -jnp.exp(a_log_b.astype(jnp.float32)), flip(Bm), flip(Cm)))
    y = (y_f + y_b + xs * d_skip[:, None]).reshape(b, s, SSM_INNER)
    y = rmsnorm(y * jax.nn.silu(z), g_ssm)
    br_ssm = y @ w_br_ssm

    q = rmsnorm(q.reshape(b, s, ATTN_HEADS, ATTN_HEAD_DIM), q_norm_g)
    k = rmsnorm(k.reshape(b, s, ATTN_KV_HEADS, ATTN_HEAD_DIM), k_norm_g)
    v = v.reshape(b, s, ATTN_KV_HEADS, ATTN_HEAD_DIM)
    rows = s // GRID_W
    row = jnp.repeat(jnp.arange(rows, dtype=jnp.int32), GRID_W)
    col = jnp.tile(jnp.arange(GRID_W, dtype=jnp.int32), rows)
    q = axial_rope(q, row, col)
    k = axial_rope(k, row, col)
    br_attn = blocked_attention(q, k, v) @ w_br_attn

    g_s, g_a = jnp.split(jax.nn.sigmoid(gates), N_BRANCHES, axis=-1)
    return (g_s * br_ssm + g_a * br_attn) @ w_out


def moe_ffn(h, w_router, b_router, w_mlp1, b_mlp1, w_mlp2, b_mlp2):
    b, s, d = h.shape
    n = b * s
    hf = h.reshape(n, d)
    logits = (hf @ w_router + b_router).astype(jnp.float32)
    top_val, top_idx = lax.top_k(logits, TOP_K)
    top_w = jax.nn.softmax(top_val, axis=-1).astype(h.dtype)
    n_assign = n * TOP_K
    flat_e = top_idx.reshape(-1).astype(jnp.int32)
    flat_tok = jnp.arange(n_assign, dtype=jnp.int32) // TOP_K
    flat_w = top_w.reshape(-1)
    order = jnp.argsort(flat_e)
    sorted_e = flat_e[order]
    counts = jnp.bincount(flat_e, length=N_EXPERTS).astype(jnp.int32)
    padded = (counts + MOE_BLOCK - 1) // MOE_BLOCK * MOE_BLOCK
    start = jnp.cumsum(counts) - counts
    pad_end = jnp.cumsum(padded)
    pad_start = pad_end - padded
    dest = pad_start[sorted_e] + jnp.arange(n_assign, dtype=jnp.int32) - start[sorted_e]
    n_blocks = -(-n_assign // MOE_BLOCK) + N_EXPERTS
    n_rows = n_blocks * MOE_BLOCK
    row_tok = jnp.zeros((n_rows,), jnp.int32).at[dest].set(flat_tok[order])
    row_w = jnp.zeros((n_rows,), h.dtype).at[dest].set(flat_w[order])
    block_e = jnp.minimum(jnp.searchsorted(pad_end, jnp.arange(n_blocks, dtype=jnp.int32) * MOE_BLOCK,
                                           side='right'), N_EXPERTS - 1)
    xb = hf[row_tok].reshape(n_blocks, MOE_BLOCK, d)

    def expert_block(args):
        xblk, e = args
        hm = xblk @ w_mlp1[e] + b_mlp1[e]
        gate, up = hm[:, :D_EXPERT], hm[:, D_EXPERT:]
        gate = jnp.minimum(gate, SWIGLU_LIMIT)
        up = jnp.clip(up, -SWIGLU_LIMIT, SWIGLU_LIMIT)
        act = gate * jax.nn.sigmoid(SWIGLU_ALPHA * gate) * (up + 1)
        return act @ w_mlp2[e] + b_mlp2[e]

    yb = lax.map(expert_block, (xb, block_e)).reshape(n_rows, d)
    y = jax.ops.segment_sum(yb * row_w[:, None], row_tok, num_segments=n)
    return y.reshape(b, s, d)


def setup_inputs(seed: int = 0) -> dict:
    key = jax.random.key(seed)
    ks = jax.random.split(key, 26)
    nrm = lambda k, shape, sc: jax.random.normal(k, shape, jnp.float32) * sc
    lo, hi = math.log(0.001), math.log(0.1)
    dt_f = jnp.exp(jax.random.uniform(ks[5], (DEPTH, SSM_HEADS)) * (hi - lo) + lo)
    dt_b = jnp.exp(jax.random.uniform(ks[6], (DEPTH, SSM_HEADS)) * (hi - lo) + lo)
    return {
        "x": nrm(ks[0], (BATCH, SEQ, D_MODEL), 1.0),
        "g_mix": 1.0 + nrm(ks[1], (DEPTH, D_MODEL), 0.02),
        "w_in": nrm(ks[2], (DEPTH, D_MODEL, IN_COLS), D_MODEL ** -0.5),
        "conv_w": nrm(ks[3], (DEPTH, SSM_CONV, CONV_CH), SSM_CONV ** -0.5),
        "conv_b": nrm(ks[4], (DEPTH, CONV_CH), 0.02),
        "dt_bias_f": dt_f + jnp.log(-jnp.expm1(-dt_f)),
        "dt_bias_b": dt_b + jnp.log(-jnp.expm1(-dt_b)),
        "a_log_f": jnp.log(jax.random.uniform(ks[7], (DEPTH, SSM_HEADS), minval=1.0, maxval=16.0)),
        "a_log_b": jnp.log(jax.random.uniform(ks[8], (DEPTH, SSM_HEADS), minval=1.0, maxval=16.0)),
        "d_skip": 1.0 + nrm(ks[9], (DEPTH, SSM_HEADS), 0.02),
        "g_ssm": 1.0 + nrm(ks[10], (DEPTH, SSM_INNER), 0.02),
        "q_norm_g": 1.0 + nrm(ks[11], (DEPTH, ATTN_HEAD_DIM), 0.02),
        "k_norm_g": 1.0 + nrm(ks[12], (DEPTH, ATTN_HEAD_DIM), 0.02),
        "w_br_ssm": nrm(ks[13], (DEPTH, SSM_INNER, D_MODEL), SSM_INNER ** -0.5),
        "w_br_attn": nrm(ks[14], (DEPTH, ATTN_Q_WIDTH, D_MODEL), ATTN_Q_WIDTH ** -0.5),
        "w_out": nrm(ks[15], (DEPTH, D_MODEL, D_MODEL), D_MODEL ** -0.5),
        "g_ffn": 1.0 + nrm(ks[16], (DEPTH, D_MODEL), 0.02),
        "w_router": nrm(ks[17], (DEPTH, D_MODEL, N_EXPERTS), D_MODEL ** -0.5),
        "b_router": nrm(ks[18], (DEPTH, N_EXPERTS), 0.01),
        "w_mlp1": nrm(ks[19], (DEPTH, N_EXPERTS, D_MODEL, 2 * D_EXPERT), D_MODEL ** -0.5),
        "b_mlp1": nrm(ks[20], (DEPTH, N_EXPERTS, 2 * D_EXPERT), 0.02),
        "w_mlp2": nrm(ks[21], (DEPTH, N_EXPERTS, D_EXPERT, D_MODEL), D_EXPERT ** -0.5),
        "b_mlp2": nrm(ks[22], (DEPTH, N_EXPERTS, D_MODEL), 0.02),
        "g_final": 1.0 + nrm(ks[23], (D_MODEL,), 0.02),
    }


def reference(x, g_mix, w_in, conv_w, conv_b, dt_bias_f, dt_bias_b, a_log_f, a_log_b, d_skip,
              g_ssm, q_norm_g, k_norm_g, w_br_ssm, w_br_attn, w_out, g_ffn, w_router, b_router,
              w_mlp1, b_mlp1, w_mlp2, b_mlp2, g_final):
    for l in range(DEPTH):
        x = x + token_mixer(rmsnorm(x, g_mix[l]), w_in[l], conv_w[l], conv_b[l],
                            dt_bias_f[l], dt_bias_b[l], a_log_f[l], a_log_b[l], d_skip[l],
                            g_ssm[l], q_norm_g[l], k_norm_g[l], w_br_ssm[l], w_br_attn[l], w_out[l])
        x = x + moe_ffn(rmsnorm(x, g_ffn[l]), w_router[l], b_router[l],
                        w_mlp1[l], b_mlp1[l], w_mlp2[l], b_mlp2[l])
    return rmsnorm(x, g_final)
```

```cpp
#include <hip/hip_runtime.h>
#include <cstdio>
#include <cstdint>

#define LAS __attribute__((address_space(3)))
typedef unsigned short bf16_t;
typedef unsigned u32x4 __attribute__((ext_vector_type(4)));
typedef unsigned u32x2 __attribute__((ext_vector_type(2)));
typedef float f32x4 __attribute__((ext_vector_type(4)));

constexpr int NB = 2, S = 8192, D = 1024, M = NB * S;
constexpr int NPROJ = 6400;
constexpr int PZ = 0, PXBC = 1024, PQ = 2560, PK = 3584, PV = 3840, PG = 4096, PDT = 6144;
constexpr int ROWS_MAX = 65536 + 32 * 256;
constexpr float EPS = 1e-6f;

constexpr size_t al256(size_t x) { return (x + 255) / 256 * 256; }
constexpr size_t WS_CTL = 0;
constexpr size_t WS_ROPE = 4096;
constexpr size_t WS_WRT = WS_ROPE + 32768;
constexpr size_t WS_WINT = WS_WRT + 131072;
constexpr size_t WS_WST = WS_WINT + (size_t)NPROJ * 1024 * 2;
constexpr size_t WS_WAT = WS_WST + 2097152;
constexpr size_t WS_WOT = WS_WAT + 2097152;
constexpr size_t WS_W1T = WS_WOT + 2097152;
constexpr size_t WS_W2T = WS_W1T + (size_t)32 * 2048 * 1024 * 2;
constexpr size_t WS_X1 = WS_W2T + (size_t)32 * 1024 * 1024 * 2;
constexpr size_t WS_H2 = WS_X1 + (size_t)M * 1024 * 4;
constexpr size_t WS_TOKES = WS_H2 + (size_t)M * 1024 * 2;
constexpr size_t WS_TOKW = WS_TOKES + (size_t)M * 16;
constexpr size_t WS_LIST = WS_TOKW + (size_t)M * 16;
constexpr size_t WS_R = WS_LIST + (size_t)32 * 16384 * 4;
constexpr size_t WS_H = WS_R;
constexpr size_t WS_P = WS_H + (size_t)M * 1024 * 2;
constexpr size_t WS_XT = WS_P + (size_t)M * NPROJ * 2;
constexpr size_t WS_BMR = WS_XT + (size_t)M * 1024 * 2;
constexpr size_t WS_BMT = WS_BMR + (size_t)M * 256 * 2;
constexpr size_t WS_CMR = WS_BMT + (size_t)M * 256 * 2;
constexpr size_t WS_DT = WS_CMR + (size_t)M * 256 * 2;
constexpr size_t WS_ACS = WS_DT + (size_t)2 * M * 16 * 4;
constexpr size_t WS_CDEC = WS_ACS + (size_t)2 * M * 16 * 4;
constexpr size_t WS_ST = WS_CDEC + 16384;
constexpr size_t WS_PREV = WS_ST + (size_t)2 * 2 * 64 * 16 * 8192 * 4;
constexpr size_t WS_YZ = WS_PREV + (size_t)2 * 2 * 64 * 16 * 8192 * 2;
constexpr size_t WS_RSTD = WS_YZ + (size_t)M * 1024 * 2;
constexpr size_t WS_QN = WS_RSTD + (size_t)M * 4;
constexpr size_t WS_KN = WS_QN + (size_t)M * 1024 * 2;
constexpr size_t WS_VB = WS_KN + (size_t)M * 256 * 2;
constexpr size_t WS_AO = WS_VB + (size_t)M * 256 * 2;
constexpr size_t WS_T1 = WS_AO + (size_t)M * 1024 * 2;
constexpr size_t WS_MG = WS_T1 + (size_t)M * 1024 * 2;
constexpr size_t WS_END = WS_MG + (size_t)M * 1024 * 2;
constexpr size_t WS_XB = WS_R;
constexpr size_t WS_ACT = WS_XB + (size_t)ROWS_MAX * 1024 * 2;
constexpr size_t WS_YB = WS_XB;
static_assert(WS_ACT + (size_t)ROWS_MAX * 1024 * 2 <= WS_END, "moe overlay");
static_assert(WS_END <= (size_t)1073741824, "workspace");

constexpr int LDS_BYTES = 147456;
constexpr int LDS_CTL = 135168;

struct Params {
    const float* in[24];
    float* out;
    unsigned char* ws;
    int ph_lo, ph_hi;
};

__device__ __forceinline__ float bf2f(bf16_t v) { return __uint_as_float((unsigned)v << 16); }
__device__ __forceinline__ float bflo(unsigned w) { return __uint_as_float(w << 16); }
__device__ __forceinline__ float bfhi(unsigned w) { return __uint_as_float(w & 0xffff0000u); }
__device__ __forceinline__ unsigned f2bf(float f) { unsigned u = __float_as_uint(f); return (u + 0x7fffu + ((u >> 16) & 1u)) >> 16; }
__device__ __forceinline__ unsigned pk2(float lo, float hi) { return f2bf(lo) | (f2bf(hi) << 16); }
__device__ __forceinline__ float wave_sum(float v) {
#pragma unroll
    for (int o = 1; o < 64; o <<= 1) v += __shfl_xor(v, o);
    return v;
}
__device__ __forceinline__ float wave_max(float v) {
#pragma unroll
    for (int o = 1; o < 64; o <<= 1) v = fmaxf(v, __shfl_xor(v, o));
    return v;
}
__device__ __forceinline__ int wave_min_i(int v) {
#pragma unroll
    for (int o = 1; o < 64; o <<= 1) { int t = __shfl_xor(v, o); v = t < v ? t : v; }
    return v;
}
__device__ __forceinline__ float sigmoidf_(float x) { return 1.f / (1.f + __expf(-x)); }
#define LDS_WAIT() asm volatile("s_waitcnt lgkmcnt(0)" ::: "memory")

struct Ctx { int tid, lane, wave, bid, G; LAS unsigned char* lds; };

__device__ __forceinline__ void transpose_item(const float* W, int K, int N, bf16_t* WT, int k0, int n0, int orow0, const float* kscale, LAS float* scr, int lane) {
#pragma unroll 8
    for (int i = 0; i < 32; ++i) {
        const int kk = 2 * i + (lane >> 5);
        float v = W[(size_t)(k0 + kk) * N + n0 + (lane & 31)];
        if (kscale) v *= kscale[k0 + kk];
        scr[kk * 33 + (lane & 31)] = v;
    }
    LDS_WAIT();
    const int c = lane & 7;
#pragma unroll
    for (int j = 0; j < 4; ++j) {
        const int n = (lane >> 3) + 8 * j;
        const LAS float* s = scr + (8 * c) * 33 + n;
        u32x4 o;
        o.x = pk2(s[0 * 33], s[1 * 33]); o.y = pk2(s[2 * 33], s[3 * 33]); o.z = pk2(s[4 * 33], s[5 * 33]); o.w = pk2(s[6 * 33], s[7 * 33]);
        *(u32x4*)(WT + (size_t)(orow0 + n) * K + k0 + 8 * c) = o;
    }
    LDS_WAIT();
}

__device__ __forceinline__ void phase_prep(const Params& p, const Ctx& c) {
    unsigned char* ws = p.ws;
    LAS float* scr = (LAS float*)(c.lds + c.wave * 16384);
    const int gw = c.bid * 8 + c.wave, NGW = c.G * 8;
    constexpr int I_IN = 16 * 193, I_SQ = 512, I_W1 = 32 * 1024, I_W2 = 32 * 512;
    constexpr int NITEMS = I_IN + 3 * I_SQ + I_W1 + I_W2;
    for (int it = gw; it < NITEMS; it += NGW) {
        int r = it;
        if (r < I_IN) {
            const int kb = r / 193, nb = r % 193, n0 = nb * 32;
            const int orow = n0 < 2560 ? n0 : (n0 < 2592 ? PDT + (n0 - 2560) : n0 - 32);
            transpose_item(p.in[2], 1024, 6176, (bf16_t*)(ws + WS_WINT), kb * 64, n0, orow, nullptr, scr, c.lane); continue;
        }
        r -= I_IN;
        if (r < I_SQ) { transpose_item(p.in[13], 1024, 1024, (bf16_t*)(ws + WS_WST), (r / 32) * 64, (r % 32) * 32, (r % 32) * 32, p.in[10], scr, c.lane); continue; }
        r -= I_SQ;
        if (r < I_SQ) { transpose_item(p.in[14], 1024, 1024, (bf16_t*)(ws + WS_WAT), (r / 32) * 64, (r % 32) * 32, (r % 32) * 32, nullptr, scr, c.lane); continue; }
        r -= I_SQ;
        if (r < I_SQ) { transpose_item(p.in[15], 1024, 1024, (bf16_t*)(ws + WS_WOT), (r / 32) * 64, (r % 32) * 32, (r % 32) * 32, nullptr, scr, c.lane); continue; }
        r -= I_SQ;
        if (r < I_W1) {
            const int e = r / 1024, rr = r % 1024, kb = rr / 64, nb = rr % 64, n0 = nb * 32;
            const int half = n0 / 1024, q = n0 % 1024, nt = q / 128, j = q % 128;
            transpose_item(p.in[19] + (size_t)e * 1024 * 2048, 1024, 2048, (bf16_t*)(ws + WS_W1T) + (size_t)e * 2048 * 1024, kb * 64, n0, nt * 256 + half * 128 + j, nullptr, scr, c.lane); continue;
        }
        r -= I_W1;
        {
            const int e = r / 512, rr = r % 512, kb = rr / 32, nb = rr % 32;
            transpose_item(p.in[21] + (size_t)e * 1024 * 1024, 1024, 1024, (bf16_t*)(ws + WS_W2T) + (size_t)e * 1024 * 1024, kb * 64, nb * 32, nb * 32, nullptr, scr, c.lane);
        }
    }
    for (int r = 6176 + gw; r < NPROJ; r += NGW) {
        u32x4* o = (u32x4*)((bf16_t*)(ws + WS_WINT) + (size_t)r * 1024);
        o[c.lane] = (u32x4){0u, 0u, 0u, 0u}; o[c.lane + 64] = (u32x4){0u, 0u, 0u, 0u};
    }
    {
        const float* x = p.in[0]; const float* g = p.in[1]; bf16_t* H = (bf16_t*)(ws + WS_H);
        f32x4 gv[4];
#pragma unroll
        for (int j = 0; j < 4; ++j) gv[j] = ((const f32x4*)g)[c.lane + 64 * j];
        for (int m = gw; m < M; m += NGW) {
            const f32x4* xr = (const f32x4*)(x + (size_t)m * D) + c.lane;
            f32x4 v[4]; float s = 0.f;
#pragma unroll
            for (int j = 0; j < 4; ++j) { v[j] = xr[64 * j]; s += (v[j].x * v[j].x + v[j].y * v[j].y) + (v[j].z * v[j].z + v[j].w * v[j].w); }
            const float rstd = rsqrtf(wave_sum(s) * (1.f / D) + EPS);
            u32x2* o = (u32x2*)(H + (size_t)m * D) + c.lane;
#pragma unroll
            for (int j = 0; j < 4; ++j) { u32x2 w; w.x = pk2(v[j].x * rstd * gv[j].x, v[j].y * rstd * gv[j].y); w.y = pk2(v[j].z * rstd * gv[j].z, v[j].w * rstd * gv[j].w); o[64 * j] = w; }
        }
    }
    {
        float* rc = (float*)(ws + WS_ROPE); float* rs = rc + 4096;
        for (int idx = c.bid * 512 + c.tid; idx < 4096; idx += c.G * 512) {
            const int pos = idx >> 5, i = idx & 31;
            const float inv = exp2f(-(float)i * (13.287712379549449f / 32.f));
            float rev = (float)pos * inv * 0.15915494309189535f; rev -= floorf(rev);
            rc[idx] = __builtin_amdgcn_cosf(rev); rs[idx] = __builtin_amdgcn_sinf(rev);
        }
        float* wrt = (float*)(ws + WS_WRT); const float* wr = p.in[17];
        for (int idx = c.bid * 512 + c.tid; idx < 32768; idx += c.G * 512) { const int k = idx >> 5, e = idx & 31; wrt[e * 1024 + k] = wr[idx]; }
        if (c.bid == 0 && c.tid < 64) ((int*)(ws + WS_CTL))[c.tid] = 0;
    }
}

template <bool DUAL, class ARow, class Epi>
__device__ __forceinline__ void ngemm_tile(const ARow& arow, const bf16_t* Bt, const bf16_t* Bt2, int K, int m0, const Epi& epi, LAS float* lds, int tid) {
    LAS float* As = lds;
    LAS float* Bs = lds + 32 * 132;
    LAS float* Bs2 = Bs + 32 * 68;
    float acc[4][4], acc2[4][4];
#pragma unroll
    for (int i = 0; i < 4; ++i)
#pragma unroll
        for (int j = 0; j < 4; ++j) { acc[i][j] = 0.f; acc2[i][j] = 0.f; }
    const int tm = tid & 31, tn = tid >> 5;
    const int sr = tid >> 2, kq = (tid & 3) * 8;
    const bf16_t* ap = arow(m0 + sr) + kq;
    const bf16_t* bp = Bt + (size_t)(sr & 63) * K + kq;
    const bf16_t* bp2 = DUAL ? Bt2 + (size_t)(sr & 63) * K + kq : nullptr;
    for (int k0 = 0; k0 < K; k0 += 32) {
        {
            const u32x4 v = *(const u32x4*)(ap + k0);
            As[(kq + 0) * 132 + sr] = bflo(v.x); As[(kq + 1) * 132 + sr] = bfhi(v.x); As[(kq + 2) * 132 + sr] = bflo(v.y); As[(kq + 3) * 132 + sr] = bfhi(v.y);
            As[(kq + 4) * 132 + sr] = bflo(v.z); As[(kq + 5) * 132 + sr] = bfhi(v.z); As[(kq + 6) * 132 + sr] = bflo(v.w); As[(kq + 7) * 132 + sr] = bfhi(v.w);
        }
        if (tid < 256) {
            const u32x4 v = *(const u32x4*)(bp + k0);
            Bs[(kq + 0) * 68 + sr] = bflo(v.x); Bs[(kq + 1) * 68 + sr] = bfhi(v.x); Bs[(kq + 2) * 68 + sr] = bflo(v.y); Bs[(kq + 3) * 68 + sr] = bfhi(v.y);
            Bs[(kq + 4) * 68 + sr] = bflo(v.z); Bs[(kq + 5) * 68 + sr] = bfhi(v.z); Bs[(kq + 6) * 68 + sr] = bflo(v.w); Bs[(kq + 7) * 68 + sr] = bfhi(v.w);
        } else if (DUAL) {
            const int r2 = sr & 63;
            const u32x4 v = *(const u32x4*)(bp2 + k0);
            Bs2[(kq + 0) * 68 + r2] = bflo(v.x); Bs2[(kq + 1) * 68 + r2] = bfhi(v.x); Bs2[(kq + 2) * 68 + r2] = bflo(v.y); Bs2[(kq + 3) * 68 + r2] = bfhi(v.y);
            Bs2[(kq + 4) * 68 + r2] = bflo(v.z); Bs2[(kq + 5) * 68 + r2] = bfhi(v.z); Bs2[(kq + 6) * 68 + r2] = bflo(v.w); Bs2[(kq + 7) * 68 + r2] = bfhi(v.w);
        }
        __syncthreads();
#pragma unroll 8
        for (int k = 0; k < 32; ++k) {
            const f32x4 a = *(const LAS f32x4*)&As[k * 132 + tm * 4];
            const f32x4 b = *(const LAS f32x4*)&Bs[k * 68 + tn * 4];
#pragma unroll
            for (int i = 0; i < 4; ++i)
#pragma unroll
                for (int j = 0; j < 4; ++j) acc[i][j] = fmaf(a[i], b[j], acc[i][j]);
            if (DUAL) {
                const f32x4 b2 = *(const LAS f32x4*)&Bs2[k * 68 + tn * 4];
#pragma unroll
                for (int i = 0; i < 4; ++i)
#pragma unroll
                    for (int j = 0; j < 4; ++j) acc2[i][j] = fmaf(a[i], b2[j], acc2[i][j]);
            }
        }
        __syncthreads();
    }
#pragma unroll
    for (int i = 0; i < 4; ++i)
#pragma unroll
        for (int j = 0; j < 4; ++j) epi(m0 + tm * 4 + i, tn * 4 + j, acc[i][j], acc2[i][j]);
}
struct ARowPlain { const bf16_t* A; int lda; __device__ __forceinline__ const bf16_t* operator()(int m) const { return A + (size_t)m * lda; } };

struct EpiP { bf16_t* P; int n0; __device__ __forceinline__ void operator()(int r, int cl, float a, float) const { P[(size_t)r * NPROJ + n0 + cl] = (bf16_t)f2bf(a); } };
__device__ __forceinline__ void phase_gemm1_naive(const Params& p, const Ctx& c) {
    const bf16_t* H = (const bf16_t*)(p.ws + WS_H); const bf16_t* W = (const bf16_t*)(p.ws + WS_WINT); bf16_t* P = (bf16_t*)(p.ws + WS_P);
    constexpr int NT_N = NPROJ / 64, NT_M = M / 128;
    for (int it = c.bid; it < NT_M * NT_N; it += c.G) {
        const int mt = it / NT_N, nt = it % NT_N;
        ngemm_tile<false>(ARowPlain{H, 1024}, W + (size_t)nt * 64 * 1024, nullptr, 1024, mt * 128, EpiP{P, nt * 64}, (LAS float*)c.lds, c.tid);
    }
}

__device__ __forceinline__ void phase_conv(const Params& p, const Ctx& c) {
    unsigned char* ws = p.ws;
    const bf16_t* P = (const bf16_t*)(ws + WS_P);
    const int tid = c.tid;
    LAS bf16_t* raw = (LAS bf16_t*)c.lds;
    LAS bf16_t* outb = (LAS bf16_t*)(c.lds + 132 * 256 * 2);
    for (int it = c.bid; it < 2 * 64 * 6; it += c.G) {
        const int part = it % 6, bc = it / 6, b = bc / 64, ch_ = bc % 64, t0 = ch_ * 128;
        __syncthreads();
        for (int idx = tid; idx < 132 * 32; idx += 512) {
            const int r = idx >> 5, c8 = idx & 31, tok = t0 - 2 + r;
            u32x4 v = (u32x4){0u, 0u, 0u, 0u};
            if (tok >= 0 && tok < S) v = *(const u32x4*)(P + (size_t)(b * S + tok) * NPROJ + PXBC + part * 256 + c8 * 8);
            *(LAS u32x4*)(raw + r * 256 + c8 * 8) = v;
        }
        __syncthreads();
        {
            const int ch = tid & 255, l0 = tid >> 8, cg_ = part * 256 + ch;
            const float* cw = p.in[3]; const float cb = p.in[4][cg_];
            const float w0 = cw[0 * 1536 + cg_], w1 = cw[1 * 1536 + cg_], w2 = cw[2 * 1536 + cg_], w3 = cw[3 * 1536 + cg_], w4 = cw[4 * 1536 + cg_];
            for (int i = 0; i < 64; ++i) {
                const int l = l0 + 2 * i;
                float a = cb;
                a = fmaf(w0, bf2f(raw[(l + 0) * 256 + ch]), a); a = fmaf(w1, bf2f(raw[(l + 1) * 256 + ch]), a); a = fmaf(w2, bf2f(raw[(l + 2) * 256 + ch]), a);
                a = fmaf(w3, bf2f(raw[(l + 3) * 256 + ch]), a); a = fmaf(w4, bf2f(raw[(l + 4) * 256 + ch]), a);
                outb[l * 256 + ch] = (bf16_t)f2bf(a * sigmoidf_(a));
            }
        }
        __syncthreads();
        if (part < 4 || part == 4) {
            bf16_t* dst = part < 4 ? (bf16_t*)(ws + WS_XT) + ((size_t)(b * 64 + ch_) * 16 + part * 4) * 64 * 128
                                   : (bf16_t*)(ws + WS_BMT) + (size_t)(b * 64 + ch_) * 2 * 128 * 128;
            for (int idx = tid; idx < 256 * 16; idx += 512) {
                const int lc = idx >> 8, ch = idx & 255;
                u32x4 o;
                o.x = (unsigned)outb[(lc * 8 + 0) * 256 + ch] | ((unsigned)outb[(lc * 8 + 1) * 256 + ch] << 16);
                o.y = (unsigned)outb[(lc * 8 + 2) * 256 + ch] | ((unsigned)outb[(lc * 8 + 3) * 256 + ch] << 16);
                o.z = (unsigned)outb[(lc * 8 + 4) * 256 + ch] | ((unsigned)outb[(lc * 8 + 5) * 256 + ch] << 16);
                o.w = (unsigned)outb[(lc * 8 + 6) * 256 + ch] | ((unsigned)outb[(lc * 8 + 7) * 256 + ch] << 16);
                *(u32x4*)(dst + (size_t)ch * 128 + lc * 8) = o;
            }
        }
        if (part >= 4) {
            bf16_t* dst = (bf16_t*)(ws + (part == 4 ? WS_BMR : WS_CMR)) + (size_t)(b * S + t0) * 256;
            for (int idx = tid; idx < 128 * 32; idx += 512) {
                const int l = idx >> 5, c8 = idx & 31;
                *(u32x4*)(dst + (size_t)l * 256 + c8 * 8) = *(const LAS u32x4*)(outb + l * 256 + c8 * 8);
            }
        }
    }
    {
        LAS float* as_ = (LAS float*)c.lds;
        float* DT = (float*)(ws + WS_DT); float* ACS = (float*)(ws + WS_ACS); float* CDEC = (float*)(ws + WS_CDEC);
        for (int it = c.bid; it < 128; it += c.G) {
            const int b = it / 64, ch_ = it % 64, t0 = ch_ * 128;
            __syncthreads();
            for (int idx = tid; idx < 4096; idx += 512) {
                const int l = idx >> 5, q = idx & 31, dir = q >> 4, h = q & 15;
                const size_t tok = (size_t)b * S + t0 + l;
                const float x = bf2f(P[tok * NPROJ + PDT + q]) + (dir ? p.in[6][h] : p.in[5][h]);
                const float dt = fmaxf(x, 0.f) + log1pf(expf(-fabsf(x)));
                const float a = -dt * expf(dir ? p.in[8][h] : p.in[7][h]);
                DT[((size_t)dir * M + tok) * 16 + h] = dt;
                as_[q * 128 + l] = a;
            }
            __syncthreads();
            if (tid < 32) {
                const int q = tid, dir = q >> 4, h = q & 15; float run = 0.f;
                if (dir == 0) { for (int l = 0; l < 128; ++l) { run += as_[q * 128 + l]; ACS[((size_t)b * S + t0 + l) * 16 + h] = run; } }
                else { for (int l = 127; l >= 0; --l) { run += as_[q * 128 + l]; ACS[((size_t)M + (size_t)b * S + t0 + l) * 16 + h] = run; } }
                CDEC[((dir * 2 + b) * 64 + ch_) * 16 + h] = expf(run);
            }
        }
        __syncthreads();
    }
    {
        const int gw = c.bid * 8 + c.wave, NGW = c.G * 8, lane = c.lane;
        const float* rc = (const float*)(ws + WS_ROPE); const float* rs = rc + 4096;
        const int axis = lane >> 5, i = lane & 31, e1 = axis * 64 + i, e2 = e1 + 32;
        const float gq1 = p.in[11][e1], gq2 = p.in[11][e2], gk1 = p.in[12][e1], gk2 = p.in[12][e2];
        bf16_t* QN = (bf16_t*)(ws + WS_QN); bf16_t* KN = (bf16_t*)(ws + WS_KN);
        for (int it = gw; it < M * 10; it += NGW) {
            const int tok = it / 10, hh = it % 10;
            const bf16_t* src = P + (size_t)tok * NPROJ + (hh < 8 ? PQ + hh * 128 : PK + (hh - 8) * 128);
            bf16_t* dst = hh < 8 ? QN + (size_t)tok * 1024 + hh * 128 : KN + (size_t)tok * 256 + (hh - 8) * 128;
            const float v1 = bf2f(src[e1]), v2 = bf2f(src[e2]);
            const float rstd = rsqrtf(wave_sum(v1 * v1 + v2 * v2) * (1.f / 128.f) + EPS);
            const float y1 = v1 * rstd * (hh < 8 ? gq1 : gk1), y2 = v2 * rstd * (hh < 8 ? gq2 : gk2);
            const int s = tok & (S - 1), pos = axis ? (s & 63) : (s >> 6);
            const float cs = rc[pos * 32 + i], sn = rs[pos * 32 + i];
            dst[e1] = (bf16_t)f2bf(y1 * cs - y2 * sn); dst[e2] = (bf16_t)f2bf(y2 * cs + y1 * sn);
        }
        bf16_t* VB = (bf16_t*)(ws + WS_VB);
        for (int idx = c.bid * 512 + c.tid; idx < M * 32; idx += c.G * 512) {
            const int tok = idx >> 5, c8 = idx & 31;
            *(u32x4*)(VB + (size_t)tok * 256 + c8 * 8) = *(const u32x4*)(P + (size_t)tok * NPROJ + PV + c8 * 8);
        }
    }
}

__device__ __forceinline__ void phase_ssd_naive(const Params& p, const Ctx& c) {
    unsigned char* ws = p.ws;
    const bf16_t* P = (const bf16_t*)(ws + WS_P); const bf16_t* XT = (const bf16_t*)(ws + WS_XT);
    const bf16_t* BMR = (const bf16_t*)(ws + WS_BMR); const bf16_t* CMR = (const bf16_t*)(ws + WS_CMR);
    const float* DT = (const float*)(ws + WS_DT); float* YACC = (float*)(ws + WS_ST); bf16_t* YZ = (bf16_t*)(ws + WS_YZ);
    const int pp = c.tid >> 3, nq = c.tid & 7;
    for (int item = c.bid; item < 32; item += c.G) {
        const int b = item >> 4, h = item & 15, g = h >> 3;
        const float dsk = p.in[9][h];
        for (int dir = 0; dir < 2; ++dir) {
            const float A = -expf(dir ? p.in[8][h] : p.in[7][h]);
            float st[16];
#pragma unroll
            for (int i = 0; i < 16; ++i) st[i] = 0.f;
            int t = dir ? S - 1 : 0;
            size_t tok = (size_t)b * S + t;
            u32x4 nb0 = *(const u32x4*)(BMR + tok * 256 + g * 128 + nq * 16), nb1 = *(const u32x4*)(BMR + tok * 256 + g * 128 + nq * 16 + 8);
            u32x4 nc0 = *(const u32x4*)(CMR + tok * 256 + g * 128 + nq * 16), nc1 = *(const u32x4*)(CMR + tok * 256 + g * 128 + nq * 16 + 8);
            float nx = bf2f(XT[((((size_t)b * 64 + (t >> 7)) * 16 + h) * 64 + pp) * 128 + (t & 127)]);
            float ndt = DT[((size_t)dir * M + tok) * 16 + h];
            for (int step = 0; step < S; ++step) {
                const u32x4 b0 = nb0, b1 = nb1, c0 = nc0, c1 = nc1; const float x = nx, dt = ndt; const size_t tokc = tok;
                if (step + 1 < S) {
                    t = dir ? S - 2 - step : step + 1; tok = (size_t)b * S + t;
                    nb0 = *(const u32x4*)(BMR + tok * 256 + g * 128 + nq * 16); nb1 = *(const u32x4*)(BMR + tok * 256 + g * 128 + nq * 16 + 8);
                    nc0 = *(const u32x4*)(CMR + tok * 256 + g * 128 + nq * 16); nc1 = *(const u32x4*)(CMR + tok * 256 + g * 128 + nq * 16 + 8);
                    nx = bf2f(XT[((((size_t)b * 64 + (t >> 7)) * 16 + h) * 64 + pp) * 128 + (t & 127)]);
                    ndt = DT[((size_t)dir * M + tok) * 16 + h];
                }
                const float dec = __expf(dt * A), xdt = x * dt;
                float part = 0.f;
#define SSD_STEP(i, BW, CW, LOHI) { st[i] = fmaf(st[i], dec, LOHI(BW) * xdt); part = fmaf(LOHI(CW), st[i], part); }
                SSD_STEP(0, b0.x, c0.x, bflo) SSD_STEP(1, b0.x, c0.x, bfhi) SSD_STEP(2, b0.y, c0.y, bflo) SSD_STEP(3, b0.y, c0.y, bfhi)
                SSD_STEP(4, b0.z, c0.z, bflo) SSD_STEP(5, b0.z, c0.z, bfhi) SSD_STEP(6, b0.w, c0.w, bflo) SSD_STEP(7, b0.w, c0.w, bfhi)
                SSD_STEP(8, b1.x, c1.x, bflo) SSD_STEP(9, b1.x, c1.x, bfhi) SSD_STEP(10, b1.y, c1.y, bflo) SSD_STEP(11, b1.y, c1.y, bfhi)
                SSD_STEP(12, b1.z, c1.z, bflo) SSD_STEP(13, b1.z, c1.z, bfhi) SSD_STEP(14, b1.w, c1.w, bflo) SSD_STEP(15, b1.w, c1.w, bfhi)
#undef SSD_STEP
                part += __shfl_xor(part, 1); part += __shfl_xor(part, 2); part += __shfl_xor(part, 4);
                if (nq == 0) {
                    const size_t o = tokc * 1024 + h * 64 + pp;
                    if (dir == 0) YACC[o] = part + x * dsk;
                    else { const float y = YACC[o] + part; const float z = bf2f(P[tokc * NPROJ + PZ + h * 64 + pp]); YZ[o] = (bf16_t)f2bf(y * z * sigmoidf_(z)); }
                }
            }
        }
    }
}

__device__ __forceinline__ void phase_rstd(const Params& p, const Ctx& c) {
    const bf16_t* YZ = (const bf16_t*)(p.ws + WS_YZ); float* RSTD = (float*)(p.ws + WS_RSTD);
    const int gw = c.bid * 8 + c.wave, NGW = c.G * 8;
    for (int m = gw; m < M; m += NGW) {
        const u32x4* r = (const u32x4*)(YZ + (size_t)m * 1024) + c.lane;
        float s = 0.f;
#pragma unroll
        for (int j = 0; j < 2; ++j) { const u32x4 v = r[64 * j];
            s += bflo(v.x) * bflo(v.x) + bfhi(v.x) * bfhi(v.x) + bflo(v.y) * bflo(v.y) + bfhi(v.y) * bfhi(v.y) + bflo(v.z) * bflo(v.z) + bfhi(v.z) * bfhi(v.z) + bflo(v.w) * bflo(v.w) + bfhi(v.w) * bfhi(v.w); }
        s = wave_sum(s);
        if (c.lane == 0) RSTD[m] = rsqrtf(s * (1.f / 1024.f) + EPS);
    }
}

__device__ __forceinline__ void phase_attn_naive(const Params& p, const Ctx& c) {
    unsigned char* ws = p.ws;
    const bf16_t* QN = (const bf16_t*)(ws + WS_QN); const bf16_t* KN = (const bf16_t*)(ws + WS_KN); const bf16_t* VB = (const bf16_t*)(ws + WS_VB);
    bf16_t* AO = (bf16_t*)(ws + WS_AO);
    LAS bf16_t* Ks = (LAS bf16_t*)c.lds; LAS bf16_t* Vs = Ks + 64 * 128;
    const int tid = c.tid, row = tid >> 2, dq = tid & 3;
    constexpr float C = 0.088388347648318440f * 1.4426950408889634f;
    for (int item = c.bid; item < 1024; item += c.G) {
        const int b = item >> 9, h = (item >> 6) & 7, qb = item & 63, kvh = h >> 2;
        const size_t tokq = (size_t)b * S + qb * 128 + row;
        float q[32], o[32];
#pragma unroll
        for (int i = 0; i < 4; ++i) { const u32x4 v = *(const u32x4*)(QN + tokq * 1024 + h * 128 + dq * 32 + i * 8);
            q[i * 8 + 0] = bflo(v.x) * C; q[i * 8 + 1] = bfhi(v.x) * C; q[i * 8 + 2] = bflo(v.y) * C; q[i * 8 + 3] = bfhi(v.y) * C;
            q[i * 8 + 4] = bflo(v.z) * C; q[i * 8 + 5] = bfhi(v.z) * C; q[i * 8 + 6] = bflo(v.w) * C; q[i * 8 + 7] = bfhi(v.w) * C; }
#pragma unroll
        for (int i = 0; i < 32; ++i) o[i] = 0.f;
        float mrun = -1e30f, lrun = 0.f;
        for (int kt = 0; kt < S / 64; ++kt) {
            __syncthreads();
            {
                const int key = tid >> 3, ch = tid & 7;
                const size_t tk = ((size_t)b * S + kt * 64 + key) * 256 + kvh * 128 + ch * 16;
                *(LAS u32x4*)(Ks + key * 128 + ch * 16) = *(const u32x4*)(KN + tk); *(LAS u32x4*)(Ks + key * 128 + ch * 16 + 8) = *(const u32x4*)(KN + tk + 8);
                *(LAS u32x4*)(Vs + key * 128 + ch * 16) = *(const u32x4*)(VB + tk); *(LAS u32x4*)(Vs + key * 128 + ch * 16 + 8) = *(const u32x4*)(VB + tk + 8);
            }
            __syncthreads();
            for (int j = 0; j < 64; ++j) {
                float s = 0.f;
#pragma unroll
                for (int i = 0; i < 4; ++i) { const u32x4 v = *(const LAS u32x4*)(Ks + j * 128 + dq * 32 + i * 8);
                    s = fmaf(q[i * 8 + 0], bflo(v.x), s); s = fmaf(q[i * 8 + 1], bfhi(v.x), s); s = fmaf(q[i * 8 + 2], bflo(v.y), s); s = fmaf(q[i * 8 + 3], bfhi(v.y), s);
                    s = fmaf(q[i * 8 + 4], bflo(v.z), s); s = fmaf(q[i * 8 + 5], bfhi(v.z), s); s = fmaf(q[i * 8 + 6], bflo(v.w), s); s = fmaf(q[i * 8 + 7], bfhi(v.w), s); }
                s += __shfl_xor(s, 1); s += __shfl_xor(s, 2);
                const float mn = fmaxf(mrun, s), al = __builtin_amdgcn_exp2f(mrun - mn), pe = __builtin_amdgcn_exp2f(s - mn);
                mrun = mn; lrun = lrun * al + pe;
#pragma unroll
                for (int i = 0; i < 4; ++i) { const u32x4 v = *(const LAS u32x4*)(Vs + j * 128 + dq * 32 + i * 8);
                    o[i * 8 + 0] = fmaf(pe, bflo(v.x), o[i * 8 + 0] * al); o[i * 8 + 1] = fmaf(pe, bfhi(v.x), o[i * 8 + 1] * al);
                    o[i * 8 + 2] = fmaf(pe, bflo(v.y), o[i * 8 + 2] * al); o[i * 8 + 3] = fmaf(pe, bfhi(v.y), o[i * 8 + 3] * al);
                    o[i * 8 + 4] = fmaf(pe, bflo(v.z), o[i * 8 + 4] * al); o[i * 8 + 5] = fmaf(pe, bfhi(v.z), o[i * 8 + 5] * al);
                    o[i * 8 + 6] = fmaf(pe, bflo(v.w), o[i * 8 + 6] * al); o[i * 8 + 7] = fmaf(pe, bfhi(v.w), o[i * 8 + 7] * al); }
            }
        }
        const float rl = 1.f / lrun;
#pragma unroll
        for (int i = 0; i < 4; ++i) { u32x4 w;
            w.x = pk2(o[i * 8 + 0] * rl, o[i * 8 + 1] * rl); w.y = pk2(o[i * 8 + 2] * rl, o[i * 8 + 3] * rl); w.z = pk2(o[i * 8 + 4] * rl, o[i * 8 + 5] * rl); w.w = pk2(o[i * 8 + 6] * rl, o[i * 8 + 7] * rl);
            *(u32x4*)(AO + tokq * 1024 + h * 128 + dq * 32 + i * 8) = w; }
    }
}

struct EpiT1 { bf16_t* T1; const bf16_t* P; const float* RSTD; int n0;
    __device__ __forceinline__ void operator()(int r, int cl, float a, float) const { const int col = n0 + cl;
        T1[(size_t)r * 1024 + col] = (bf16_t)f2bf(a * RSTD[r] * sigmoidf_(bf2f(P[(size_t)r * NPROJ + PG + col]))); } };
struct EpiT2 { bf16_t* MG; const bf16_t* T1; const bf16_t* P; int n0;
    __device__ __forceinline__ void operator()(int r, int cl, float a, float) const { const int col = n0 + cl;
        MG[(size_t)r * 1024 + col] = (bf16_t)f2bf(bf2f(T1[(size_t)r * 1024 + col]) + a * sigmoidf_(bf2f(P[(size_t)r * NPROJ + PG + 1024 + col]))); } };
struct EpiT3 { float* X1; const float* x; int n0;
    __device__ __forceinline__ void operator()(int r, int cl, float a, float) const { const size_t o = (size_t)r * 1024 + n0 + cl; X1[o] = x[o] + a; } };
template <int WHICH> __device__ __forceinline__ void phase_tail_naive(const Params& p, const Ctx& c) {
    unsigned char* ws = p.ws;
    for (int it = c.bid; it < (M / 128) * 16; it += c.G) {
        const int mt = it >> 4, nt = it & 15;
        if (WHICH == 0) ngemm_tile<false>(ARowPlain{(const bf16_t*)(ws + WS_YZ), 1024}, (const bf16_t*)(ws + WS_WST) + (size_t)nt * 64 * 1024, nullptr, 1024, mt * 128,
                                          EpiT1{(bf16_t*)(ws + WS_T1), (const bf16_t*)(ws + WS_P), (const float*)(ws + WS_RSTD), nt * 64}, (LAS float*)c.lds, c.tid);
        if (WHICH == 1) ngemm_tile<false>(ARowPlain{(const bf16_t*)(ws + WS_AO), 1024}, (const bf16_t*)(ws + WS_WAT) + (size_t)nt * 64 * 1024, nullptr, 1024, mt * 128,
                                          EpiT2{(bf16_t*)(ws + WS_MG), (const bf16_t*)(ws + WS_T1), (const bf16_t*)(ws + WS_P), nt * 64}, (LAS float*)c.lds, c.tid);
        if (WHICH == 2) ngemm_tile<false>(ARowPlain{(const bf16_t*)(ws + WS_MG), 1024}, (const bf16_t*)(ws + WS_WOT) + (size_t)nt * 64 * 1024, nullptr, 1024, mt * 128,
                                          EpiT3{(float*)(ws + WS_X1), p.in[0], nt * 64}, (LAS float*)c.lds, c.tid);
    }
}

__device__ __forceinline__ void phase_router(const Params& p, const Ctx& c) {
    unsigned char* ws = p.ws;
    LAS float* wT = (LAS float*)c.lds;
    LAS int* tokE = (LAS int*)(c.lds + LDS_CTL + 512);
    LAS float* tokW = (LAS float*)(c.lds + LDS_CTL + 512 + 1024);
    LAS int* lcnt = (LAS int*)(c.lds + LDS_CTL + 512 + 2048);
    LAS int* lbase = lcnt + 32;
    LAS int* lrank = lbase + 32;
    const float* X1 = (const float*)(ws + WS_X1); bf16_t* H2 = (bf16_t*)(ws + WS_H2);
    int* CNT = (int*)(ws + WS_CTL); int* TOKES = (int*)(ws + WS_TOKES); float* TOKW = (float*)(ws + WS_TOKW); int* LIST = (int*)(ws + WS_LIST);
    const int tid = c.tid, lane = c.lane;
    __syncthreads();
    { const f32x4* src = (const f32x4*)(ws + WS_WRT); for (int idx = tid; idx < 8192; idx += 512) ((LAS f32x4*)wT)[idx] = src[idx]; }
    __syncthreads();
    f32x4 gv[4];
#pragma unroll
    for (int j = 0; j < 4; ++j) gv[j] = ((const f32x4*)p.in[16])[lane + 64 * j];
    const float bias_e = p.in[18][lane & 31];
    for (int blk = c.bid; blk < M / 64; blk += c.G) {
        if (tid < 32) lcnt[tid] = 0;
        for (int pr = 0; pr < 4; ++pr) {
            const int tl = c.wave * 8 + pr * 2;
            const size_t tokA = (size_t)blk * 64 + tl;
            f32x4 hA[4], hB[4];
            {
                const f32x4* xa = (const f32x4*)(X1 + tokA * 1024) + lane; const f32x4* xb = xa + 256;
                float sa = 0.f, sb = 0.f;
#pragma unroll
                for (int j = 0; j < 4; ++j) { hA[j] = xa[64 * j]; hB[j] = xb[64 * j];
                    sa += (hA[j].x * hA[j].x + hA[j].y * hA[j].y) + (hA[j].z * hA[j].z + hA[j].w * hA[j].w);
                    sb += (hB[j].x * hB[j].x + hB[j].y * hB[j].y) + (hB[j].z * hB[j].z + hB[j].w * hB[j].w); }
                const float ra = rsqrtf(wave_sum(sa) * (1.f / 1024.f) + EPS), rb = rsqrtf(wave_sum(sb) * (1.f / 1024.f) + EPS);
                u32x2* oa = (u32x2*)(H2 + tokA * 1024) + lane; u32x2* ob = oa + 256;
#pragma unroll
                for (int j = 0; j < 4; ++j) { hA[j] = hA[j] * ra * gv[j]; hB[j] = hB[j] * rb * gv[j];
                    u32x2 w; w.x = pk2(hA[j].x, hA[j].y); w.y = pk2(hA[j].z, hA[j].w); oa[64 * j] = w;
                    w.x = pk2(hB[j].x, hB[j].y); w.y = pk2(hB[j].z, hB[j].w); ob[64 * j] = w; }
            }
            float la = -INFINITY, lb = -INFINITY;
#pragma unroll 1
            for (int e = 0; e < 32; ++e) {
                float a = 0.f, b = 0.f;
#pragma unroll
                for (int j = 0; j < 4; ++j) { const f32x4 w = *(const LAS f32x4*)&wT[e * 1024 + 256 * j + 4 * lane];
                    a = fmaf(hA[j].x, w.x, a); a = fmaf(hA[j].y, w.y, a); a = fmaf(hA[j].z, w.z, a); a = fmaf(hA[j].w, w.w, a);
                    b = fmaf(hB[j].x, w.x, b); b = fmaf(hB[j].y, w.y, b); b = fmaf(hB[j].z, w.z, b); b = fmaf(hB[j].w, w.w, b); }
                a = wave_sum(a); b = wave_sum(b);
                if (lane == e) { la = a + bias_e; lb = b + bias_e; }
            }
            const int my_e = lane < 32 ? lane : 64;
#pragma unroll
            for (int t2 = 0; t2 < 2; ++t2) {
                float val = t2 ? lb : la;
                int se[4]; float sv[4];
#pragma unroll
                for (int k = 0; k < 4; ++k) {
                    const float mx = wave_max(val);
                    const int sel = wave_min_i(val == mx ? my_e : 64);
                    se[k] = sel; sv[k] = mx;
                    if (my_e == sel) val = -INFINITY;
                }
                const float e1 = __expf(sv[1] - sv[0]), e2 = __expf(sv[2] - sv[0]), e3 = __expf(sv[3] - sv[0]);
                const float inv = 1.f / (1.f + e1 + e2 + e3);
                if (lane == 0) {
                    const int t = tl + t2;
                    tokE[t * 4 + 0] = se[0]; tokE[t * 4 + 1] = se[1]; tokE[t * 4 + 2] = se[2]; tokE[t * 4 + 3] = se[3];
                    tokW[t * 4 + 0] = inv; tokW[t * 4 + 1] = e1 * inv; tokW[t * 4 + 2] = e2 * inv; tokW[t * 4 + 3] = e3 * inv;
                }
            }
        }
        __syncthreads();
        if (tid < 256) lrank[tid] = atomicAdd((int*)&lcnt[tokE[tid]], 1);
        __syncthreads();
        if (tid < 32) lbase[tid] = lcnt[tid] ? atomicAdd(&CNT[tid], lcnt[tid]) : 0;
        __syncthreads();
        if (tid < 256) {
            const int e = tokE[tid], slot = lbase[e] + lrank[tid], tok = blk * 64 + (tid >> 2);
            LIST[e * 16384 + slot] = tok; TOKES[tok * 4 + (tid & 3)] = (e << 16) | slot; TOKW[tok * 4 + (tid & 3)] = tokW[tid];
        }
        __syncthreads();
    }
}

__device__ __forceinline__ void load_offs(const Params& p, const Ctx& c, LAS int*& offs, LAS int*& cnt) {
    offs = (LAS int*)(c.lds + LDS_CTL); cnt = offs + 40;
    __syncthreads();
    if (c.tid == 0) {
        const int* CNT = (const int*)(p.ws + WS_CTL); int run = 0;
        for (int e = 0; e < 32; ++e) { const int n = __hip_atomic_load(CNT + e, __ATOMIC_RELAXED, __HIP_MEMORY_SCOPE_AGENT); cnt[e] = n; offs[e] = run; run += (n + 255) & ~255; }
        offs[32] = run;
    }
    __syncthreads();
}
__device__ __forceinline__ int find_expert(const LAS int* offs, int row) { int e = 0; while (e < 31 && row >= offs[e + 1]) ++e; return e; }

__device__ __forceinline__ void phase_gather(const Params& p, const Ctx& c) {
    LAS int* offs; LAS int* cnt; load_offs(p, c, offs, cnt);
    const bf16_t* H2 = (const bf16_t*)(p.ws + WS_H2); bf16_t* XB = (bf16_t*)(p.ws + WS_XB); const int* LIST = (const int*)(p.ws + WS_LIST);
    const int gw = c.bid * 8 + c.wave, NGW = c.G * 8, total = offs[32];
    for (int row = gw; row < total; row += NGW) {
        const int e = find_expert(offs, row), slot = row - offs[e];
        u32x4 v0 = (u32x4){0u, 0u, 0u, 0u}, v1 = v0;
        if (slot < cnt[e]) { const int tok = LIST[e * 16384 + slot]; const u32x4* s = (const u32x4*)(H2 + (size_t)tok * 1024); v0 = s[c.lane]; v1 = s[c.lane + 64]; }
        u32x4* d = (u32x4*)(XB + (size_t)row * 1024); d[c.lane] = v0; d[c.lane + 64] = v1;
    }
}

struct EpiAct { bf16_t* ACT; const float* b1; int j0;
    __device__ __forceinline__ void operator()(int r, int cl, float g, float u) const { const int j = j0 + cl;
        g = fminf(g + b1[j], 7.f); u = fminf(fmaxf(u + b1[1024 + j], -7.f), 7.f);
        ACT[(size_t)r * 1024 + j] = (bf16_t)f2bf(g * sigmoidf_(1.702f * g) * (u + 1.f)); } };
struct EpiY { bf16_t* YB; const float* b2; int n0;
    __device__ __forceinline__ void operator()(int r, int cl, float a, float) const { const int col = n0 + cl; YB[(size_t)r * 1024 + col] = (bf16_t)f2bf(a + b2[col]); } };
template <int WHICH> __device__ __forceinline__ void phase_moe_naive(const Params& p, const Ctx& c) {
    LAS int* offs; LAS int* cnt; load_offs(p, c, offs, cnt);
    unsigned char* ws = p.ws;
    const int nrt = offs[32] / 128;
    for (int it = c.bid; it < nrt * 16; it += c.G) {
        const int rt = it >> 4, ct = it & 15, row0 = rt * 128, e = find_expert(offs, row0);
        if (WHICH == 0) {
            const int j0 = ct * 64, nt = j0 >> 7, jj = j0 & 127;
            const bf16_t* Wg = (const bf16_t*)(ws + WS_W1T) + ((size_t)e * 2048 + nt * 256 + jj) * 1024;
            ngemm_tile<true>(ARowPlain{(const bf16_t*)(ws + WS_XB), 1024}, Wg, Wg + (size_t)128 * 1024, 1024, row0,
                             EpiAct{(bf16_t*)(ws + WS_ACT), p.in[20] + (size_t)e * 2048, j0}, (LAS float*)c.lds, c.tid);
        } else {
            const bf16_t* W = (const bf16_t*)(ws + WS_W2T) + ((size_t)e * 1024 + ct * 64) * 1024;
            ngemm_tile<false>(ARowPlain{(const bf16_t*)(ws + WS_ACT), 1024}, W, nullptr, 1024, row0,
                              EpiY{(bf16_t*)(ws + WS_YB), p.in[22] + (size_t)e * 1024, ct * 64}, (LAS float*)c.lds, c.tid);
        }
    }
}

__device__ __forceinline__ void phase_combine(const Params& p, const Ctx& c) {
    LAS int* offs; LAS int* cnt; load_offs(p, c, offs, cnt);
    unsigned char* ws = p.ws;
    const float* X1 = (const float*)(ws + WS_X1); const bf16_t* YB = (const bf16_t*)(ws + WS_YB);
    const int* TOKES = (const int*)(ws + WS_TOKES); const float* TOKW = (const float*)(ws + WS_TOKW);
    const int gw = c.bid * 8 + c.wave, NGW = c.G * 8, lane = c.lane;
    f32x4 gv[4];
#pragma unroll
    for (int j = 0; j < 4; ++j) gv[j] = ((const f32x4*)p.in[23])[lane + 64 * j];
    for (int m = gw; m < M; m += NGW) {
        f32x4 v[4];
        const f32x4* xr = (const f32x4*)(X1 + (size_t)m * 1024) + lane;
#pragma unroll
        for (int j = 0; j < 4; ++j) v[j] = xr[64 * j];
#pragma unroll
        for (int k = 0; k < 4; ++k) {
            const int es = TOKES[m * 4 + k]; const float w = TOKW[m * 4 + k];
            const int row = offs[es >> 16] + (es & 0xffff);
            const u32x2* yr = (const u32x2*)(YB + (size_t)row * 1024) + lane;
#pragma unroll
            for (int j = 0; j < 4; ++j) { const u32x2 y = yr[64 * j];
                v[j].x = fmaf(w, bflo(y.x), v[j].x); v[j].y = fmaf(w, bfhi(y.x), v[j].y); v[j].z = fmaf(w, bflo(y.y), v[j].z); v[j].w = fmaf(w, bfhi(y.y), v[j].w); }
        }
        float s = 0.f;
#pragma unroll
        for (int j = 0; j < 4; ++j) s += (v[j].x * v[j].x + v[j].y * v[j].y) + (v[j].z * v[j].z + v[j].w * v[j].w);
        const float rstd = rsqrtf(wave_sum(s) * (1.f / 1024.f) + EPS);
        f32x4* o = (f32x4*)(p.out + (size_t)m * 1024) + lane;
#pragma unroll
        for (int j = 0; j < 4; ++j) o[64 * j] = v[j] * rstd * gv[j];
    }
}

constexpr int NPHASE = 14;
__global__ void __launch_bounds__(512) mega(Params p) {
    extern __shared__ __attribute__((aligned(16))) unsigned char lds_raw[];
    Ctx c; c.tid = threadIdx.x; c.lane = c.tid & 63; c.wave = __builtin_amdgcn_readfirstlane(c.tid >> 6); c.bid = blockIdx.x; c.G = gridDim.x;
    c.lds = (LAS unsigned char*)lds_raw;
#define RUN(k, call) if (p.ph_lo <= (k) && (k) < p.ph_hi) { call; }
    RUN(0, phase_prep(p, c))
    RUN(1, phase_gemm1_naive(p, c))
    RUN(2, phase_conv(p, c))
    RUN(3, phase_ssd_naive(p, c))
    RUN(4, phase_rstd(p, c))
    RUN(5, phase_attn_naive(p, c))
    RUN(6, phase_tail_naive<0>(p, c))
    RUN(7, phase_tail_naive<1>(p, c))
    RUN(8, phase_tail_naive<2>(p, c))
    RUN(9, phase_router(p, c))
    RUN(10, phase_gather(p, c))
    RUN(11, phase_moe_naive<0>(p, c))
    RUN(12, phase_moe_naive<1>(p, c))
    RUN(13, phase_combine(p, c))
#undef RUN
}

extern "C" void kernel_launch(void* const* d_in, const int* in_sizes, int n_in, void* d_out, int out_size, void* d_ws, size_t ws_size, hipStream_t stream) {
    static int ok = 0;
    if (ok == 0) {
        if (n_in != 24 || out_size != M * D || ws_size < WS_END) { fprintf(stderr, "kernel_launch: unexpected shapes: n_in %d out %d ws %zu (need %zu)\n", n_in, out_size, ws_size, (size_t)WS_END); ok = -1; return; }
        if (hipFuncSetAttribute((const void*)mega, hipFuncAttributeMaxDynamicSharedMemorySize, LDS_BYTES) != hipSuccess) { fprintf(stderr, "kernel_launch: hipFuncSetAttribute failed\n"); ok = -1; return; }
        ok = 1;
    }
    if (ok < 0) return;
    Params p{};
    for (int i = 0; i < 24; ++i) p.in[i] = (const float*)d_in[i];
    p.out = (float*)d_out; p.ws = (unsigned char*)d_ws;
    for (int ph = 0; ph < NPHASE; ++ph) {
        p.ph_lo = ph; p.ph_hi = ph + 1;
        hipLaunchKernelGGL(mega, dim3(256), dim3(512), LDS_BYTES, stream, p);
    }
}
```

```cpp
#include <hip/hip_runtime.h>
#include <hip/hip_cooperative_groups.h>
#include <cstdio>
#include <cstdint>

namespace cg = cooperative_groups;
#define LAS __attribute__((address_space(3)))
typedef unsigned short bf16_t;
typedef unsigned u32x4 __attribute__((ext_vector_type(4)));
typedef unsigned u32x2 __attribute__((ext_vector_type(2)));
typedef float f32x4 __attribute__((ext_vector_type(4)));

constexpr int NB = 2, S = 8192, D = 1024, M = NB * S;
constexpr int NPROJ = 6400;
constexpr int PZ = 0, PXBC = 1024, PQ = 2560, PK = 3584, PV = 3840, PG = 4096, PDT = 6144;
constexpr int ROWS_MAX = 65536 + 32 * 256;
constexpr float EPS = 1e-6f;

constexpr size_t al256(size_t x) { return (x + 255) / 256 * 256; }
constexpr size_t WS_CTL = 0;
constexpr size_t WS_ROPE = 4096;
constexpr size_t WS_WRT = WS_ROPE + 32768;
constexpr size_t WS_WINT = WS_WRT + 131072;
constexpr size_t WS_WST = WS_WINT + (size_t)NPROJ * 1024 * 2;
constexpr size_t WS_WAT = WS_WST + 2097152;
constexpr size_t WS_WOT = WS_WAT + 2097152;
constexpr size_t WS_W1T = WS_WOT + 2097152;
constexpr size_t WS_W2T = WS_W1T + (size_t)32 * 2048 * 1024 * 2;
constexpr size_t WS_X1 = WS_W2T + (size_t)32 * 1024 * 1024 * 2;
constexpr size_t WS_H2 = WS_X1 + (size_t)M * 1024 * 4;
constexpr size_t WS_TOKES = WS_H2 + (size_t)M * 1024 * 2;
constexpr size_t WS_TOKW = WS_TOKES + (size_t)M * 16;
constexpr size_t WS_LIST = WS_TOKW + (size_t)M * 16;
constexpr size_t WS_R = WS_LIST + (size_t)32 * 16384 * 4;
constexpr size_t WS_H = WS_R;
constexpr size_t WS_P = WS_H + (size_t)M * 1024 * 2;
constexpr size_t WS_XT = WS_P + (size_t)M * NPROJ * 2;
constexpr size_t WS_BMR = WS_XT + (size_t)M * 1024 * 2;
constexpr size_t WS_BMT = WS_BMR + (size_t)M * 256 * 2;
constexpr size_t WS_CMR = WS_BMT + (size_t)M * 256 * 2;
constexpr size_t WS_DT = WS_CMR + (size_t)M * 256 * 2;
constexpr size_t WS_ACS = WS_DT + (size_t)2 * M * 16 * 4;
constexpr size_t WS_CDEC = WS_ACS + (size_t)2 * M * 16 * 4;
constexpr size_t WS_ST = WS_CDEC + 16384;
constexpr size_t WS_PREV = WS_ST + (size_t)2 * 2 * 64 * 16 * 8192 * 4;
constexpr size_t WS_YZ = WS_PREV + (size_t)2 * 2 * 64 * 16 * 8192 * 2;
constexpr size_t WS_RSTD = WS_YZ + (size_t)M * 1024 * 2;
constexpr size_t WS_QN = WS_RSTD + (size_t)M * 4;
constexpr size_t WS_KN = WS_QN + (size_t)M * 1024 * 2;
constexpr size_t WS_VB = WS_KN + (size_t)M * 256 * 2;
constexpr size_t WS_AO = WS_VB + (size_t)M * 256 * 2;
constexpr size_t WS_T1 = WS_AO + (size_t)M * 1024 * 2;
constexpr size_t WS_MG = WS_T1 + (size_t)M * 1024 * 2;
constexpr size_t WS_END = WS_MG + (size_t)M * 1024 * 2;
constexpr size_t WS_XB = WS_R;
constexpr size_t WS_ACT = WS_XB + (size_t)ROWS_MAX * 1024 * 2;
constexpr size_t WS_YB = WS_XB;
static_assert(WS_ACT + (size_t)ROWS_MAX * 1024 * 2 <= WS_END, "moe overlay");
static_assert(WS_END <= (size_t)1073741824, "workspace");

constexpr int LDS_BYTES = 147456;
constexpr int LDS_CTL = 135168;

struct Params {
    const float* in[24];
    float* out;
    unsigned char* ws;
    int ph_lo, ph_hi;
};

__device__ __forceinline__ float bf2f(bf16_t v) { return __uint_as_float((unsigned)v << 16); }
__device__ __forceinline__ float bflo(unsigned w) { return __uint_as_float(w << 16); }
__device__ __forceinline__ float bfhi(unsigned w) { return __uint_as_float(w & 0xffff0000u); }
__device__ __forceinline__ unsigned f2bf(float f) { unsigned u = __float_as_uint(f); return (u + 0x7fffu + ((u >> 16) & 1u)) >> 16; }
__device__ __forceinline__ unsigned pk2(float lo, float hi) { return f2bf(lo) | (f2bf(hi) << 16); }
__device__ __forceinline__ float wave_sum(float v) {
#pragma unroll
    for (int o = 1; o < 64; o <<= 1) v += __shfl_xor(v, o);
    return v;
}
__device__ __forceinline__ float wave_max(float v) {
#pragma unroll
    for (int o = 1; o < 64; o <<= 1) v = fmaxf(v, __shfl_xor(v, o));
    return v;
}
__device__ __forceinline__ int wave_min_i(int v) {
#pragma unroll
    for (int o = 1; o < 64; o <<= 1) { int t = __shfl_xor(v, o); v = t < v ? t : v; }
    return v;
}
__device__ __forceinline__ float sigmoidf_(float x) { return 1.f / (1.f + __expf(-x)); }
#define LDS_WAIT() asm volatile("s_waitcnt lgkmcnt(0)" ::: "memory")

struct Ctx { int tid, lane, wave, bid, G; LAS unsigned char* lds; };

__device__ __forceinline__ void transpose_item(const float* W, int K, int N, bf16_t* WT, int k0, int n0, int orow0, const float* kscale, LAS float* scr, int lane) {
#pragma unroll 8
    for (int i = 0; i < 32; ++i) {
        const int kk = 2 * i + (lane >> 5);
        float v = W[(size_t)(k0 + kk) * N + n0 + (lane & 31)];
        if (kscale) v *= kscale[k0 + kk];
        scr[kk * 33 + (lane & 31)] = v;
    }
    LDS_WAIT();
    const int c = lane & 7;
#pragma unroll
    for (int j = 0; j < 4; ++j) {
        const int n = (lane >> 3) + 8 * j;
        const LAS float* s = scr + (8 * c) * 33 + n;
        u32x4 o;
        o.x = pk2(s[0 * 33], s[1 * 33]); o.y = pk2(s[2 * 33], s[3 * 33]); o.z = pk2(s[4 * 33], s[5 * 33]); o.w = pk2(s[6 * 33], s[7 * 33]);
        *(u32x4*)(WT + (size_t)(orow0 + n) * K + k0 + 8 * c) = o;
    }
    LDS_WAIT();
}

__device__ __forceinline__ void phase_prep(const Params& p, const Ctx& c) {
    unsigned char* ws = p.ws;
    LAS float* scr = (LAS float*)(c.lds + c.wave * 16384);
    const int gw = c.bid * 8 + c.wave, NGW = c.G * 8;
    constexpr int I_IN = 16 * 193, I_SQ = 512, I_W1 = 32 * 1024, I_W2 = 32 * 512;
    constexpr int NITEMS = I_IN + 3 * I_SQ + I_W1 + I_W2;
    for (int it = gw; it < NITEMS; it += NGW) {
        int r = it;
        if (r < I_IN) {
            const int kb = r / 193, nb = r % 193, n0 = nb * 32;
            const int orow = n0 < 2560 ? n0 : (n0 < 2592 ? PDT + (n0 - 2560) : n0 - 32);
            transpose_item(p.in[2], 1024, 6176, (bf16_t*)(ws + WS_WINT), kb * 64, n0, orow, nullptr, scr, c.lane); continue;
        }
        r -= I_IN;
        if (r < I_SQ) { transpose_item(p.in[13], 1024, 1024, (bf16_t*)(ws + WS_WST), (r / 32) * 64, (r % 32) * 32, (r % 32) * 32, p.in[10], scr, c.lane); continue; }
        r -= I_SQ;
        if (r < I_SQ) { transpose_item(p.in[14], 1024, 1024, (bf16_t*)(ws + WS_WAT), (r / 32) * 64, (r % 32) * 32, (r % 32) * 32, nullptr, scr, c.lane); continue; }
        r -= I_SQ;
        if (r < I_SQ) { transpose_item(p.in[15], 1024, 1024, (bf16_t*)(ws + WS_WOT), (r / 32) * 64, (r % 32) * 32, (r % 32) * 32, nullptr, scr, c.lane); continue; }
        r -= I_SQ;
        if (r < I_W1) {
            const int e = r / 1024, rr = r % 1024, kb = rr / 64, nb = rr % 64, n0 = nb * 32;
            const int half = n0 / 1024, q = n0 % 1024, nt = q / 128, j = q % 128;
            transpose_item(p.in[19] + (size_t)e * 1024 * 2048, 1024, 2048, (bf16_t*)(ws + WS_W1T) + (size_t)e * 2048 * 1024, kb * 64, n0, nt * 256 + half * 128 + j, nullptr, scr, c.lane); continue;
        }
        r -= I_W1;
        {
            const int e = r / 512, rr = r % 512, kb = rr / 32, nb = rr % 32;
            transpose_item(p.in[21] + (size_t)e * 1024 * 1024, 1024, 1024, (bf16_t*)(ws + WS_W2T) + (size_t)e * 1024 * 1024, kb * 64, nb * 32, nb * 32, nullptr, scr, c.lane);
        }
    }
    for (int r = 6176 + gw; r < NPROJ; r += NGW) {
        u32x4* o = (u32x4*)((bf16_t*)(ws + WS_WINT) + (size_t)r * 1024);
        o[c.lane] = (u32x4){0u, 0u, 0u, 0u}; o[c.lane + 64] = (u32x4){0u, 0u, 0u, 0u};
    }
    {
        const float* x = p.in[0]; const float* g = p.in[1]; bf16_t* H = (bf16_t*)(ws + WS_H);
        f32x4 gv[4];
#pragma unroll
        for (int j = 0; j < 4; ++j) gv[j] = ((const f32x4*)g)[c.lane + 64 * j];
        for (int m = gw; m < M; m += NGW) {
            const f32x4* xr = (const f32x4*)(x + (size_t)m * D) + c.lane;
            f32x4 v[4]; float s = 0.f;
#pragma unroll
            for (int j = 0; j < 4; ++j) { v[j] = xr[64 * j]; s += (v[j].x * v[j].x + v[j].y * v[j].y) + (v[j].z * v[j].z + v[j].w * v[j].w); }
            const float rstd = rsqrtf(wave_sum(s) * (1.f / D) + EPS);
            u32x2* o = (u32x2*)(H + (size_t)m * D) + c.lane;
#pragma unroll
            for (int j = 0; j < 4; ++j) { u32x2 w; w.x = pk2(v[j].x * rstd * gv[j].x, v[j].y * rstd * gv[j].y); w.y = pk2(v[j].z * rstd * gv[j].z, v[j].w * rstd * gv[j].w); o[64 * j] = w; }
        }
    }
    {
        float* rc = (float*)(ws + WS_ROPE); float* rs = rc + 4096;
        for (int idx = c.bid * 512 + c.tid; idx < 4096; idx += c.G * 512) {
            const int pos = idx >> 5, i = idx & 31;
            const float inv = exp2f(-(float)i * (13.287712379549449f / 32.f));
            float rev = (float)pos * inv * 0.15915494309189535f; rev -= floorf(rev);
            rc[idx] = __builtin_amdgcn_cosf(rev); rs[idx] = __builtin_amdgcn_sinf(rev);
        }
        float* wrt = (float*)(ws + WS_WRT); const float* wr = p.in[17];
        for (int idx = c.bid * 512 + c.tid; idx < 32768; idx += c.G * 512) { const int k = idx >> 5, e = idx & 31; wrt[e * 1024 + k] = wr[idx]; }
        if (c.bid == 0 && c.tid < 64) ((int*)(ws + WS_CTL))[c.tid] = 0;
    }
}

template <bool DUAL, class ARow, class Epi>
__device__ __forceinline__ void ngemm_tile(const ARow& arow, const bf16_t* Bt, const bf16_t* Bt2, int K, int m0, const Epi& epi, LAS float* lds, int tid) {
    LAS float* As = lds;
    LAS float* Bs = lds + 32 * 132;
    LAS float* Bs2 = Bs + 32 * 68;
    float acc[4][4], acc2[4][4];
#pragma unroll
    for (int i = 0; i < 4; ++i)
#pragma unroll
        for (int j = 0; j < 4; ++j) { acc[i][j] = 0.f; acc2[i][j] = 0.f; }
    const int tm = tid & 31, tn = tid >> 5;
    const int sr = tid >> 2, kq = (tid & 3) * 8;
    const bf16_t* ap = arow(m0 + sr) + kq;
    const bf16_t* bp = Bt + (size_t)(sr & 63) * K + kq;
    const bf16_t* bp2 = DUAL ? Bt2 + (size_t)(sr & 63) * K + kq : nullptr;
    for (int k0 = 0; k0 < K; k0 += 32) {
        {
            const u32x4 v = *(const u32x4*)(ap + k0);
            As[(kq + 0) * 132 + sr] = bflo(v.x); As[(kq + 1) * 132 + sr] = bfhi(v.x); As[(kq + 2) * 132 + sr] = bflo(v.y); As[(kq + 3) * 132 + sr] = bfhi(v.y);
            As[(kq + 4) * 132 + sr] = bflo(v.z); As[(kq + 5) * 132 + sr] = bfhi(v.z); As[(kq + 6) * 132 + sr] = bflo(v.w); As[(kq + 7) * 132 + sr] = bfhi(v.w);
        }
        if (tid < 256) {
            const u32x4 v = *(const u32x4*)(bp + k0);
            Bs[(kq + 0) * 68 + sr] = bflo(v.x); Bs[(kq + 1) * 68 + sr] = bfhi(v.x); Bs[(kq + 2) * 68 + sr] = bflo(v.y); Bs[(kq + 3) * 68 + sr] = bfhi(v.y);
            Bs[(kq + 4) * 68 + sr] = bflo(v.z); Bs[(kq + 5) * 68 + sr] = bfhi(v.z); Bs[(kq + 6) * 68 + sr] = bflo(v.w); Bs[(kq + 7) * 68 + sr] = bfhi(v.w);
        } else if (DUAL) {
            const int r2 = sr & 63;
            const u32x4 v = *(const u32x4*)(bp2 + k0);
            Bs2[(kq + 0) * 68 + r2] = bflo(v.x); Bs2[(kq + 1) * 68 + r2] = bfhi(v.x); Bs2[(kq + 2) * 68 + r2] = bflo(v.y); Bs2[(kq + 3) * 68 + r2] = bfhi(v.y);
            Bs2[(kq + 4) * 68 + r2] = bflo(v.z); Bs2[(kq + 5) * 68 + r2] = bfhi(v.z); Bs2[(kq + 6) * 68 + r2] = bflo(v.w); Bs2[(kq + 7) * 68 + r2] = bfhi(v.w);
        }
        __syncthreads();
#pragma unroll 8
        for (int k = 0; k < 32; ++k) {
            const f32x4 a = *(const LAS f32x4*)&As[k * 132 + tm * 4];
            const f32x4 b = *(const LAS f32x4*)&Bs[k * 68 + tn * 4];
#pragma unroll
            for (int i = 0; i < 4; ++i)
#pragma unroll
                for (int j = 0; j < 4; ++j) acc[i][j] = fmaf(a[i], b[j], acc[i][j]);
            if (DUAL) {
                const f32x4 b2 = *(const LAS f32x4*)&Bs2[k * 68 + tn * 4];
#pragma unroll
                for (int i = 0; i < 4; ++i)
#pragma unroll
                    for (int j = 0; j < 4; ++j) acc2[i][j] = fmaf(a[i], b2[j], acc2[i][j]);
            }
        }
        __syncthreads();
    }
#pragma unroll
    for (int i = 0; i < 4; ++i)
#pragma unroll
        for (int j = 0; j < 4; ++j) epi(m0 + tm * 4 + i, tn * 4 + j, acc[i][j], acc2[i][j]);
}
struct ARowPlain { const bf16_t* A; int lda; __device__ __forceinline__ const bf16_t* operator()(int m) const { return A + (size_t)m * lda; } };

struct EpiP { bf16_t* P; int n0; __device__ __forceinline__ void operator()(int r, int cl, float a, float) const { P[(size_t)r * NPROJ + n0 + cl] = (bf16_t)f2bf(a); } };
__device__ __forceinline__ void phase_gemm1_naive(const Params& p, const Ctx& c) {
    const bf16_t* H = (const bf16_t*)(p.ws + WS_H); const bf16_t* W = (const bf16_t*)(p.ws + WS_WINT); bf16_t* P = (bf16_t*)(p.ws + WS_P);
    constexpr int NT_N = NPROJ / 64, NT_M = M / 128;
    for (int it = c.bid; it < NT_M * NT_N; it += c.G) {
        const int mt = it / NT_N, nt = it % NT_N;
        ngemm_tile<false>(ARowPlain{H, 1024}, W + (size_t)nt * 64 * 1024, nullptr, 1024, mt * 128, EpiP{P, nt * 64}, (LAS float*)c.lds, c.tid);
    }
}

__device__ __forceinline__ void phase_conv(const Params& p, const Ctx& c) {
    unsigned char* ws = p.ws;
    const bf16_t* P = (const bf16_t*)(ws + WS_P);
    const int tid = c.tid;
    LAS bf16_t* raw = (LAS bf16_t*)c.lds;
    LAS bf16_t* outb = (LAS bf16_t*)(c.lds + 132 * 256 * 2);
    for (int it = c.bid; it < 2 * 64 * 6; it += c.G) {
        const int part = it % 6, bc = it / 6, b = bc / 64, ch_ = bc % 64, t0 = ch_ * 128;
        __syncthreads();
        for (int idx = tid; idx < 132 * 32; idx += 512) {
            const int r = idx >> 5, c8 = idx & 31, tok = t0 - 2 + r;
            u32x4 v = (u32x4){0u, 0u, 0u, 0u};
            if (tok >= 0 && tok < S) v = *(const u32x4*)(P + (size_t)(b * S + tok) * NPROJ + PXBC + part * 256 + c8 * 8);
            *(LAS u32x4*)(raw + r * 256 + c8 * 8) = v;
        }
        __syncthreads();
        {
            const int ch = tid & 255, l0 = tid >> 8, cg_ = part * 256 + ch;
            const float* cw = p.in[3]; const float cb = p.in[4][cg_];
            const float w0 = cw[0 * 1536 + cg_], w1 = cw[1 * 1536 + cg_], w2 = cw[2 * 1536 + cg_], w3 = cw[3 * 1536 + cg_], w4 = cw[4 * 1536 + cg_];
            for (int i = 0; i < 64; ++i) {
                const int l = l0 + 2 * i;
                float a = cb;
                a = fmaf(w0, bf2f(raw[(l + 0) * 256 + ch]), a); a = fmaf(w1, bf2f(raw[(l + 1) * 256 + ch]), a); a = fmaf(w2, bf2f(raw[(l + 2) * 256 + ch]), a);
                a = fmaf(w3, bf2f(raw[(l + 3) * 256 + ch]), a); a = fmaf(w4, bf2f(raw[(l + 4) * 256 + ch]), a);
                outb[l * 256 + ch] = (bf16_t)f2bf(a * sigmoidf_(a));
            }
        }
        __syncthreads();
        if (part < 4 || part == 4) {
            bf16_t* dst = part < 4 ? (bf16_t*)(ws + WS_XT) + ((size_t)(b * 64 + ch_) * 16 + part * 4) * 64 * 128
                                   : (bf16_t*)(ws + WS_BMT) + (size_t)(b * 64 + ch_) * 2 * 128 * 128;
            for (int idx = tid; idx < 256 * 16; idx += 512) {
                const int lc = idx >> 8, ch = idx & 255;
                u32x4 o;
                o.x = (unsigned)outb[(lc * 8 + 0) * 256 + ch] | ((unsigned)outb[(lc * 8 + 1) * 256 + ch] << 16);
                o.y = (unsigned)outb[(lc * 8 + 2) * 256 + ch] | ((unsigned)outb[(lc * 8 + 3) * 256 + ch] << 16);
                o.z = (unsigned)outb[(lc * 8 + 4) * 256 + ch] | ((unsigned)outb[(lc * 8 + 5) * 256 + ch] << 16);
                o.w = (unsigned)outb[(lc * 8 + 6) * 256 + ch] | ((unsigned)outb[(lc * 8 + 7) * 256 + ch] << 16);
                *(u32x4*)(dst + (size_t)ch * 128 + lc * 8) = o;
            }
        }
        if (part >= 4) {
            bf16_t* dst = (bf16_t*)(ws + (part == 4 ? WS_BMR : WS_CMR)) + (size_t)(b * S + t0) * 256;
            for (int idx = tid; idx < 128 * 32; idx += 512) {
                const int l = idx >> 5, c8 = idx & 31;
                *(u32x4*)(dst + (size_t)l * 256 + c8 * 8) = *(const LAS u32x4*)(outb + l * 256 + c8 * 8);
            }
        }
    }
    {
        LAS float* as_ = (LAS float*)c.lds;
        float* DT = (float*)(ws + WS_DT); float* ACS = (float*)(ws + WS_ACS); float* CDEC = (float*)(ws + WS_CDEC);
        for (int it = c.bid; it < 128; it += c.G) {
            const int b = it / 64, ch_ = it % 64, t0 = ch_ * 128;
            __syncthreads();
            for (int idx = tid; idx < 4096; idx += 512) {
                const int l = idx >> 5, q = idx & 31, dir = q >> 4, h = q & 15;
                const size_t tok = (size_t)b * S + t0 + l;
                const float x = bf2f(P[tok * NPROJ + PDT + q]) + (dir ? p.in[6][h] : p.in[5][h]);
                const float dt = fmaxf(x, 0.f) + log1pf(expf(-fabsf(x)));
                const float a = -dt * expf(dir ? p.in[8][h] : p.in[7][h]);
                DT[((size_t)dir * M + tok) * 16 + h] = dt;
                as_[q * 128 + l] = a;
            }
            __syncthreads();
            if (tid < 32) {
                const int q = tid, dir = q >> 4, h = q & 15; float run = 0.f;
                if (dir == 0) { for (int l = 0; l < 128; ++l) { run += as_[q * 128 + l]; ACS[((size_t)b * S + t0 + l) * 16 + h] = run; } }
                else { for (int l = 127; l >= 0; --l) { run += as_[q * 128 + l]; ACS[((size_t)M + (size_t)b * S + t0 + l) * 16 + h] = run; } }
                CDEC[((dir * 2 + b) * 64 + ch_) * 16 + h] = expf(run);
            }
        }
        __syncthreads();
    }
    {
        const int gw = c.bid * 8 + c.wave, NGW = c.G * 8, lane = c.lane;
        const float* rc = (const float*)(ws + WS_ROPE); const float* rs = rc + 4096;
        const int axis = lane >> 5, i = lane & 31, e1 = axis * 64 + i, e2 = e1 + 32;
        const float gq1 = p.in[11][e1], gq2 = p.in[11][e2], gk1 = p.in[12][e1], gk2 = p.in[12][e2];
        bf16_t* QN = (bf16_t*)(ws + WS_QN); bf16_t* KN = (bf16_t*)(ws + WS_KN);
        for (int it = gw; it < M * 10; it += NGW) {
            const int tok = it / 10, hh = it % 10;
            const bf16_t* src = P + (size_t)tok * NPROJ + (hh < 8 ? PQ + hh * 128 : PK + (hh - 8) * 128);
            bf16_t* dst = hh < 8 ? QN + (size_t)tok * 1024 + hh * 128 : KN + (size_t)tok * 256 + (hh - 8) * 128;
            const float v1 = bf2f(src[e1]), v2 = bf2f(src[e2]);
            const float rstd = rsqrtf(wave_sum(v1 * v1 + v2 * v2) * (1.f / 128.f) + EPS);
            const float y1 = v1 * rstd * (hh < 8 ? gq1 : gk1), y2 = v2 * rstd * (hh < 8 ? gq2 : gk2);
            const int s = tok & (S - 1), pos = axis ? (s & 63) : (s >> 6);
            const float cs = rc[pos * 32 + i], sn = rs[pos * 32 + i];
            dst[e1] = (bf16_t)f2bf(y1 * cs - y2 * sn); dst[e2] = (bf16_t)f2bf(y2 * cs + y1 * sn);
        }
        bf16_t* VB = (bf16_t*)(ws + WS_VB);
        for (int idx = c.bid * 512 + c.tid; idx < M * 32; idx += c.G * 512) {
            const int tok = idx >> 5, c8 = idx & 31;
            *(u32x4*)(VB + (size_t)tok * 256 + c8 * 8) = *(const u32x4*)(P + (size_t)tok * NPROJ + PV + c8 * 8);
        }
    }
}

__device__ __forceinline__ void phase_ssd_naive(const Params& p, const Ctx& c) {
    unsigned char* ws = p.ws;
    const bf16_t* P = (const bf16_t*)(ws + WS_P); const bf16_t* XT = (const bf16_t*)(ws + WS_XT);
    const bf16_t* BMR = (const bf16_t*)(ws + WS_BMR); const bf16_t* CMR = (const bf16_t*)(ws + WS_CMR);
    const float* DT = (const float*)(ws + WS_DT); float* YACC = (float*)(ws + WS_ST); bf16_t* YZ = (bf16_t*)(ws + WS_YZ);
    const int pp = c.tid >> 3, nq = c.tid & 7;
    for (int item = c.bid; item < 32; item += c.G) {
        const int b = item >> 4, h = item & 15, g = h >> 3;
        const float dsk = p.in[9][h];
        for (int dir = 0; dir < 2; ++dir) {
            const float A = -expf(dir ? p.in[8][h] : p.in[7][h]);
            float st[16];
#pragma unroll
            for (int i = 0; i < 16; ++i) st[i] = 0.f;
            int t = dir ? S - 1 : 0;
            size_t tok = (size_t)b * S + t;
            u32x4 nb0 = *(const u32x4*)(BMR + tok * 256 + g * 128 + nq * 16), nb1 = *(const u32x4*)(BMR + tok * 256 + g * 128 + nq * 16 + 8);
            u32x4 nc0 = *(const u32x4*)(CMR + tok * 256 + g * 128 + nq * 16), nc1 = *(const u32x4*)(CMR + tok * 256 + g * 128 + nq * 16 + 8);
            float nx = bf2f(XT[((((size_t)b * 64 + (t >> 7)) * 16 + h) * 64 + pp) * 128 + (t & 127)]);
            float ndt = DT[((size_t)dir * M + tok) * 16 + h];
            for (int step = 0; step < S; ++step) {
                const u32x4 b0 = nb0, b1 = nb1, c0 = nc0, c1 = nc1; const float x = nx, dt = ndt; const size_t tokc = tok;
                if (step + 1 < S) {
                    t = dir ? S - 2 - step : step + 1; tok = (size_t)b * S + t;
                    nb0 = *(const u32x4*)(BMR + tok * 256 + g * 128 + nq * 16); nb1 = *(const u32x4*)(BMR + tok * 256 + g * 128 + nq * 16 + 8);
                    nc0 = *(const u32x4*)(CMR + tok * 256 + g * 128 + nq * 16); nc1 = *(const u32x4*)(CMR + tok * 256 + g * 128 + nq * 16 + 8);
                    nx = bf2f(XT[((((size_t)b * 64 + (t >> 7)) * 16 + h) * 64 + pp) * 128 + (t & 127)]);
                    ndt = DT[((size_t)dir * M + tok) * 16 + h];
                }
                const float dec = __expf(dt * A), xdt = x * dt;
                float part = 0.f;
#define SSD_STEP(i, BW, CW, LOHI) { st[i] = fmaf(st[i], dec, LOHI(BW) * xdt); part = fmaf(LOHI(CW), st[i], part); }
                SSD_STEP(0, b0.x, c0.x, bflo) SSD_STEP(1, b0.x, c0.x, bfhi) SSD_STEP(2, b0.y, c0.y, bflo) SSD_STEP(3, b0.y, c0.y, bfhi)
                SSD_STEP(4, b0.z, c0.z, bflo) SSD_STEP(5, b0.z, c0.z, bfhi) SSD_STEP(6, b0.w, c0.w, bflo) SSD_STEP(7, b0.w, c0.w, bfhi)
                SSD_STEP(8, b1.x, c1.x, bflo) SSD_STEP(9, b1.x, c1.x, bfhi) SSD_STEP(10, b1.y, c1.y, bflo) SSD_STEP(11, b1.y, c1.y, bfhi)
                SSD_STEP(12, b1.z, c1.z, bflo) SSD_STEP(13, b1.z, c1.z, bfhi) SSD_STEP(14, b1.w, c1.w, bflo) SSD_STEP(15, b1.w, c1.w, bfhi)
#undef SSD_STEP
                part += __shfl_xor(part, 1); part += __shfl_xor(part, 2); part += __shfl_xor(part, 4);
                if (nq == 0) {
                    const size_t o = tokc * 1024 + h * 64 + pp;
                    if (dir == 0) YACC[o] = part + x * dsk;
                    else { const float y = YACC[o] + part; const float z = bf2f(P[tokc * NPROJ + PZ + h * 64 + pp]); YZ[o] = (bf16_t)f2bf(y * z * sigmoidf_(z)); }
                }
            }
        }
    }
}

__device__ __forceinline__ void phase_rstd(const Params& p, const Ctx& c) {
    const bf16_t* YZ = (const bf16_t*)(p.ws + WS_YZ); float* RSTD = (float*)(p.ws + WS_RSTD);
    const int gw = c.bid * 8 + c.wave, NGW = c.G * 8;
    for (int m = gw; m < M; m += NGW) {
        const u32x4* r = (const u32x4*)(YZ + (size_t)m * 1024) + c.lane;
        float s = 0.f;
#pragma unroll
        for (int j = 0; j < 2; ++j) { const u32x4 v = r[64 * j];
            s += bflo(v.x) * bflo(v.x) + bfhi(v.x) * bfhi(v.x) + bflo(v.y) * bflo(v.y) + bfhi(v.y) * bfhi(v.y) + bflo(v.z) * bflo(v.z) + bfhi(v.z) * bfhi(v.z) + bflo(v.w) * bflo(v.w) + bfhi(v.w) * bfhi(v.w); }
        s = wave_sum(s);
        if (c.lane == 0) RSTD[m] = rsqrtf(s * (1.f / 1024.f) + EPS);
    }
}

__device__ __forceinline__ void phase_attn_naive(const Params& p, const Ctx& c) {
    unsigned char* ws = p.ws;
    const bf16_t* QN = (const bf16_t*)(ws + WS_QN); const bf16_t* KN = (const bf16_t*)(ws + WS_KN); const bf16_t* VB = (const bf16_t*)(ws + WS_VB);
    bf16_t* AO = (bf16_t*)(ws + WS_AO);
    LAS bf16_t* Ks = (LAS bf16_t*)c.lds; LAS bf16_t* Vs = Ks + 64 * 128;
    const int tid = c.tid, row = tid >> 2, dq = tid & 3;
    constexpr float C = 0.088388347648318440f * 1.4426950408889634f;
    for (int item = c.bid; item < 1024; item += c.G) {
        const int b = item >> 9, h = (item >> 6) & 7, qb = item & 63, kvh = h >> 2;
        const size_t tokq = (size_t)b * S + qb * 128 + row;
        float q[32], o[32];
#pragma unroll
        for (int i = 0; i < 4; ++i) { const u32x4 v = *(const u32x4*)(QN + tokq * 1024 + h * 128 + dq * 32 + i * 8);
            q[i * 8 + 0] = bflo(v.x) * C; q[i * 8 + 1] = bfhi(v.x) * C; q[i * 8 + 2] = bflo(v.y) * C; q[i * 8 + 3] = bfhi(v.y) * C;
            q[i * 8 + 4] = bflo(v.z) * C; q[i * 8 + 5] = bfhi(v.z) * C; q[i * 8 + 6] = bflo(v.w) * C; q[i * 8 + 7] = bfhi(v.w) * C; }
#pragma unroll
        for (int i = 0; i < 32; ++i) o[i] = 0.f;
        float mrun = -1e30f, lrun = 0.f;
        for (int kt = 0; kt < S / 64; ++kt) {
            __syncthreads();
            {
                const int key = tid >> 3, ch = tid & 7;
                const size_t tk = ((size_t)b * S + kt * 64 + key) * 256 + kvh * 128 + ch * 16;
                *(LAS u32x4*)(Ks + key * 128 + ch * 16) = *(const u32x4*)(KN + tk); *(LAS u32x4*)(Ks + key * 128 + ch * 16 + 8) = *(const u32x4*)(KN + tk + 8);
                *(LAS u32x4*)(Vs + key * 128 + ch * 16) = *(const u32x4*)(VB + tk); *(LAS u32x4*)(Vs + key * 128 + ch * 16 + 8) = *(const u32x4*)(VB + tk + 8);
            }
            __syncthreads();
            for (int j = 0; j < 64; ++j) {
                float s = 0.f;
#pragma unroll
                for (int i = 0; i < 4; ++i) { const u32x4 v = *(const LAS u32x4*)(Ks + j * 128 + dq * 32 + i * 8);
                    s = fmaf(q[i * 8 + 0], bflo(v.x), s); s = fmaf(q[i * 8 + 1], bfhi(v.x), s); s = fmaf(q[i * 8 + 2], bflo(v.y), s); s = fmaf(q[i * 8 + 3], bfhi(v.y), s);
                    s = fmaf(q[i * 8 + 4], bflo(v.z), s); s = fmaf(q[i * 8 + 5], bfhi(v.z), s); s = fmaf(q[i * 8 + 6], bflo(v.w), s); s = fmaf(q[i * 8 + 7], bfhi(v.w), s); }
                s += __shfl_xor(s, 1); s += __shfl_xor(s, 2);
                const float mn = fmaxf(mrun, s), al = __builtin_amdgcn_exp2f(mrun - mn), pe = __builtin_amdgcn_exp2f(s - mn);
                mrun = mn; lrun = lrun * al + pe;
#pragma unroll
                for (int i = 0; i < 4; ++i) { const u32x4 v = *(const LAS u32x4*)(Vs + j * 128 + dq * 32 + i * 8);
                    o[i * 8 + 0] = fmaf(pe, bflo(v.x), o[i * 8 + 0] * al); o[i * 8 + 1] = fmaf(pe, bfhi(v.x), o[i * 8 + 1] * al);
                    o[i * 8 + 2] = fmaf(pe, bflo(v.y), o[i * 8 + 2] * al); o[i * 8 + 3] = fmaf(pe, bfhi(v.y), o[i * 8 + 3] * al);
                    o[i * 8 + 4] = fmaf(pe, bflo(v.z), o[i * 8 + 4] * al); o[i * 8 + 5] = fmaf(pe, bfhi(v.z), o[i * 8 + 5] * al);
                    o[i * 8 + 6] = fmaf(pe, bflo(v.w), o[i * 8 + 6] * al); o[i * 8 + 7] = fmaf(pe, bfhi(v.w), o[i * 8 + 7] * al); }
            }
        }
        const float rl = 1.f / lrun;
#pragma unroll
        for (int i = 0; i < 4; ++i) { u32x4 w;
            w.x = pk2(o[i * 8 + 0] * rl, o[i * 8 + 1] * rl); w.y = pk2(o[i * 8 + 2] * rl, o[i * 8 + 3] * rl); w.z = pk2(o[i * 8 + 4] * rl, o[i * 8 + 5] * rl); w.w = pk2(o[i * 8 + 6] * rl, o[i * 8 + 7] * rl);
            *(u32x4*)(AO + tokq * 1024 + h * 128 + dq * 32 + i * 8) = w; }
    }
}

struct EpiT1 { bf16_t* T1; const bf16_t* P; const float* RSTD; int n0;
    __device__ __forceinline__ void operator()(int r, int cl, float a, float) const { const int col = n0 + cl;
        T1[(size_t)r * 1024 + col] = (bf16_t)f2bf(a * RSTD[r] * sigmoidf_(bf2f(P[(size_t)r * NPROJ + PG + col]))); } };
struct EpiT2 { bf16_t* MG; const bf16_t* T1; const bf16_t* P; int n0;
    __device__ __forceinline__ void operator()(int r, int cl, float a, float) const { const int col = n0 + cl;
        MG[(size_t)r * 1024 + col] = (bf16_t)f2bf(bf2f(T1[(size_t)r * 1024 + col]) + a * sigmoidf_(bf2f(P[(size_t)r * NPROJ + PG + 1024 + col]))); } };
struct EpiT3 { float* X1; const float* x; int n0;
    __device__ __forceinline__ void operator()(int r, int cl, float a, float) const { const size_t o = (size_t)r * 1024 + n0 + cl; X1[o] = x[o] + a; } };
template <int WHICH> __device__ __forceinline__ void phase_tail_naive(const Params& p, const Ctx& c) {
    unsigned char* ws = p.ws;
    for (int it = c.bid; it < (M / 128) * 16; it += c.G) {
        const int mt = it >> 4, nt = it & 15;
        if (WHICH == 0) ngemm_tile<false>(ARowPlain{(const bf16_t*)(ws + WS_YZ), 1024}, (const bf16_t*)(ws + WS_WST) + (size_t)nt * 64 * 1024, nullptr, 1024, mt * 128,
                                          EpiT1{(bf16_t*)(ws + WS_T1), (const bf16_t*)(ws + WS_P), (const float*)(ws + WS_RSTD), nt * 64}, (LAS float*)c.lds, c.tid);
        if (WHICH == 1) ngemm_tile<false>(ARowPlain{(const bf16_t*)(ws + WS_AO), 1024}, (const bf16_t*)(ws + WS_WAT) + (size_t)nt * 64 * 1024, nullptr, 1024, mt * 128,
                                          EpiT2{(bf16_t*)(ws + WS_MG), (const bf16_t*)(ws + WS_T1), (const bf16_t*)(ws + WS_P), nt * 64}, (LAS float*)c.lds, c.tid);
        if (WHICH == 2) ngemm_tile<false>(ARowPlain{(const bf16_t*)(ws + WS_MG), 1024}, (const bf16_t*)(ws + WS_WOT) + (size_t)nt * 64 * 1024, nullptr, 1024, mt * 128,
                                          EpiT3{(float*)(ws + WS_X1), p.in[0], nt * 64}, (LAS float*)c.lds, c.tid);
    }
}

__device__ __forceinline__ void phase_router(const Params& p, const Ctx& c) {
    unsigned char* ws = p.ws;
    LAS float* wT = (LAS float*)c.lds;
    LAS int* tokE = (LAS int*)(c.lds + LDS_CTL + 512);
    LAS float* tokW = (LAS float*)(c.lds + LDS_CTL + 512 + 1024);
    LAS int* lcnt = (LAS int*)(c.lds + LDS_CTL + 512 + 2048);
    LAS int* lbase = lcnt + 32;
    LAS int* lrank = lbase + 32;
    const float* X1 = (const float*)(ws + WS_X1); bf16_t* H2 = (bf16_t*)(ws + WS_H2);
    int* CNT = (int*)(ws + WS_CTL); int* TOKES = (int*)(ws + WS_TOKES); float* TOKW = (float*)(ws + WS_TOKW); int* LIST = (int*)(ws + WS_LIST);
    const int tid = c.tid, lane = c.lane;
    __syncthreads();
    { const f32x4* src = (const f32x4*)(ws + WS_WRT); for (int idx = tid; idx < 8192; idx += 512) ((LAS f32x4*)wT)[idx] = src[idx]; }
    __syncthreads();
    f32x4 gv[4];
#pragma unroll
    for (int j = 0; j < 4; ++j) gv[j] = ((const f32x4*)p.in[16])[lane + 64 * j];
    const float bias_e = p.in[18][lane & 31];
    for (int blk = c.bid; blk < M / 64; blk += c.G) {
        if (tid < 32) lcnt[tid] = 0;
        for (int pr = 0; pr < 4; ++pr) {
            const int tl = c.wave * 8 + pr * 2;
            const size_t tokA = (size_t)blk * 64 + tl;
            f32x4 hA[4], hB[4];
            {
                const f32x4* xa = (const f32x4*)(X1 + tokA * 1024) + lane; const f32x4* xb = xa + 256;
                float sa = 0.f, sb = 0.f;
#pragma unroll
                for (int j = 0; j < 4; ++j) { hA[j] = xa[64 * j]; hB[j] = xb[64 * j];
                    sa += (hA[j].x * hA[j].x + hA[j].y * hA[j].y) + (hA[j].z * hA[j].z + hA[j].w * hA[j].w);
                    sb += (hB[j].x * hB[j].x + hB[j].y * hB[j].y) + (hB[j].z * hB[j].z + hB[j].w * hB[j].w); }
                const float ra = rsqrtf(wave_sum(sa) * (1.f / 1024.f) + EPS), rb = rsqrtf(wave_sum(sb) * (1.f / 1024.f) + EPS);
                u32x2* oa = (u32x2*)(H2 + tokA * 1024) + lane; u32x2* ob = oa + 256;
#pragma unroll
                for (int j = 0; j < 4; ++j) { hA[j] = hA[j] * ra * gv[j]; hB[j] = hB[j] * rb * gv[j];
                    u32x2 w; w.x = pk2(hA[j].x, hA[j].y); w.y = pk2(hA[j].z, hA[j].w); oa[64 * j] = w;
                    w.x = pk2(hB[j].x, hB[j].y); w.y = pk2(hB[j].z, hB[j].w); ob[64 * j] = w; }
            }
            float la = -INFINITY, lb = -INFINITY;
#pragma unroll 1
            for (int e = 0; e < 32; ++e) {
                float a = 0.f, b = 0.f;
#pragma unroll
                for (int j = 0; j < 4; ++j) { const f32x4 w = *(const LAS f32x4*)&wT[e * 1024 + 256 * j + 4 * lane];
                    a = fmaf(hA[j].x, w.x, a); a = fmaf(hA[j].y, w.y, a); a = fmaf(hA[j].z, w.z, a); a = fmaf(hA[j].w, w.w, a);
                    b = fmaf(hB[j].x, w.x, b); b = fmaf(hB[j].y, w.y, b); b = fmaf(hB[j].z, w.z, b); b = fmaf(hB[j].w, w.w, b); }
                a = wave_sum(a); b = wave_sum(b);
                if (lane == e) { la = a + bias_e; lb = b + bias_e; }
            }
            const int my_e = lane < 32 ? lane : 64;
#pragma unroll
            for (int t2 = 0; t2 < 2; ++t2) {
                float val = t2 ? lb : la;
                int se[4]; float sv[4];
#pragma unroll
                for (int k = 0; k < 4; ++k) {
                    const float mx = wave_max(val);
                    const int sel = wave_min_i(val == mx ? my_e : 64);
                    se[k] = sel; sv[k] = mx;
                    if (my_e == sel) val = -INFINITY;
                }
                const float e1 = __expf(sv[1] - sv[0]), e2 = __expf(sv[2] - sv[0]), e3 = __expf(sv[3] - sv[0]);
                const float inv = 1.f / (1.f + e1 + e2 + e3);
                if (lane == 0) {
                    const int t = tl + t2;
                    tokE[t * 4 + 0] = se[0]; tokE[t * 4 + 1] = se[1]; tokE[t * 4 + 2] = se[2]; tokE[t * 4 + 3] = se[3];
                    tokW[t * 4 + 0] = inv; tokW[t * 4 + 1] = e1 * inv; tokW[t * 4 + 2] = e2 * inv; tokW[t * 4 + 3] = e3 * inv;
                }
            }
        }
        __syncthreads();
        if (tid < 256) lrank[tid] = atomicAdd((int*)&lcnt[tokE[tid]], 1);
        __syncthreads();
        if (tid < 32) lbase[tid] = lcnt[tid] ? atomicAdd(&CNT[tid], lcnt[tid]) : 0;
        __syncthreads();
        if (tid < 256) {
            const int e = tokE[tid], slot = lbase[e] + lrank[tid], tok = blk * 64 + (tid >> 2);
            LIST[e * 16384 + slot] = tok; TOKES[tok * 4 + (tid & 3)] = (e << 16) | slot; TOKW[tok * 4 + (tid & 3)] = tokW[tid];
        }
        __syncthreads();
    }
}

__device__ __forceinline__ void load_offs(const Params& p, const Ctx& c, LAS int*& offs, LAS int*& cnt) {
    offs = (LAS int*)(c.lds + LDS_CTL); cnt = offs + 40;
    __syncthreads();
    if (c.tid == 0) {
        const int* CNT = (const int*)(p.ws + WS_CTL); int run = 0;
        for (int e = 0; e < 32; ++e) { const int n = __hip_atomic_load(CNT + e, __ATOMIC_RELAXED, __HIP_MEMORY_SCOPE_AGENT); cnt[e] = n; offs[e] = run; run += (n + 255) & ~255; }
        offs[32] = run;
    }
    __syncthreads();
}
__device__ __forceinline__ int find_expert(const LAS int* offs, int row) { int e = 0; while (e < 31 && row >= offs[e + 1]) ++e; return e; }

__device__ __forceinline__ void phase_gather(const Params& p, const Ctx& c) {
    LAS int* offs; LAS int* cnt; load_offs(p, c, offs, cnt);
    const bf16_t* H2 = (const bf16_t*)(p.ws + WS_H2); bf16_t* XB = (bf16_t*)(p.ws + WS_XB); const int* LIST = (const int*)(p.ws + WS_LIST);
    const int gw = c.bid * 8 + c.wave, NGW = c.G * 8, total = offs[32];
    for (int row = gw; row < total; row += NGW) {
        const int e = find_expert(offs, row), slot = row - offs[e];
        u32x4 v0 = (u32x4){0u, 0u, 0u, 0u}, v1 = v0;
        if (slot < cnt[e]) { const int tok = LIST[e * 16384 + slot]; const u32x4* s = (const u32x4*)(H2 + (size_t)tok * 1024); v0 = s[c.lane]; v1 = s[c.lane + 64]; }
        u32x4* d = (u32x4*)(XB + (size_t)row * 1024); d[c.lane] = v0; d[c.lane + 64] = v1;
    }
}

struct EpiAct { bf16_t* ACT; const float* b1; int j0;
    __device__ __forceinline__ void operator()(int r, int cl, float g, float u) const { const int j = j0 + cl;
        g = fminf(g + b1[j], 7.f); u = fminf(fmaxf(u + b1[1024 + j], -7.f), 7.f);
        ACT[(size_t)r * 1024 + j] = (bf16_t)f2bf(g * sigmoidf_(1.702f * g) * (u + 1.f)); } };
struct EpiY { bf16_t* YB; const float* b2; int n0;
    __device__ __forceinline__ void operator()(int r, int cl, float a, float) const { const int col = n0 + cl; YB[(size_t)r * 1024 + col] = (bf16_t)f2bf(a + b2[col]); } };
template <int WHICH> __device__ __forceinline__ void phase_moe_naive(const Params& p, const Ctx& c) {
    LAS int* offs; LAS int* cnt; load_offs(p, c, offs, cnt);
    unsigned char* ws = p.ws;
    const int nrt = offs[32] / 128;
    for (int it = c.bid; it < nrt * 16; it += c.G) {
        const int rt = it >> 4, ct = it & 15, row0 = rt * 128, e = find_expert(offs, row0);
        if (WHICH == 0) {
            const int j0 = ct * 64, nt = j0 >> 7, jj = j0 & 127;
            const bf16_t* Wg = (const bf16_t*)(ws + WS_W1T) + ((size_t)e * 2048 + nt * 256 + jj) * 1024;
            ngemm_tile<true>(ARowPlain{(const bf16_t*)(ws + WS_XB), 1024}, Wg, Wg + (size_t)128 * 1024, 1024, row0,
                             EpiAct{(bf16_t*)(ws + WS_ACT), p.in[20] + (size_t)e * 2048, j0}, (LAS float*)c.lds, c.tid);
        } else {
            const bf16_t* W = (const bf16_t*)(ws + WS_W2T) + ((size_t)e * 1024 + ct * 64) * 1024;
            ngemm_tile<false>(ARowPlain{(const bf16_t*)(ws + WS_ACT), 1024}, W, nullptr, 1024, row0,
                              EpiY{(bf16_t*)(ws + WS_YB), p.in[22] + (size_t)e * 1024, ct * 64}, (LAS float*)c.lds, c.tid);
        }
    }
}

__device__ __forceinline__ void phase_combine(const Params& p, const Ctx& c) {
    LAS int* offs; LAS int* cnt; load_offs(p, c, offs, cnt);
    unsigned char* ws = p.ws;
    const float* X1 = (const float*)(ws + WS_X1); const bf16_t* YB = (const bf16_t*)(ws + WS_YB);
    const int* TOKES = (const int*)(ws + WS_TOKES); const float* TOKW = (const float*)(ws + WS_TOKW);
    const int gw = c.bid * 8 + c.wave, NGW = c.G * 8, lane = c.lane;
    f32x4 gv[4];
#pragma unroll
    for (int j = 0; j < 4; ++j) gv[j] = ((const f32x4*)p.in[23])[lane + 64 * j];
    for (int m = gw; m < M; m += NGW) {
        f32x4 v[4];
        const f32x4* xr = (const f32x4*)(X1 + (size_t)m * 1024) + lane;
#pragma unroll
        for (int j = 0; j < 4; ++j) v[j] = xr[64 * j];
#pragma unroll
        for (int k = 0; k < 4; ++k) {
            const int es = TOKES[m * 4 + k]; const float w = TOKW[m * 4 + k];
            const int row = offs[es >> 16] + (es & 0xffff);
            const u32x2* yr = (const u32x2*)(YB + (size_t)row * 1024) + lane;
#pragma unroll
            for (int j = 0; j < 4; ++j) { const u32x2 y = yr[64 * j];
                v[j].x = fmaf(w, bflo(y.x), v[j].x); v[j].y = fmaf(w, bfhi(y.x), v[j].y); v[j].z = fmaf(w, bflo(y.y), v[j].z); v[j].w = fmaf(w, bfhi(y.y), v[j].w); }
        }
        float s = 0.f;
#pragma unroll
        for (int j = 0; j < 4; ++j) s += (v[j].x * v[j].x + v[j].y * v[j].y) + (v[j].z * v[j].z + v[j].w * v[j].w);
        const float rstd = rsqrtf(wave_sum(s) * (1.f / 1024.f) + EPS);
        f32x4* o = (f32x4*)(p.out + (size_t)m * 1024) + lane;
#pragma unroll
        for (int j = 0; j < 4; ++j) o[64 * j] = v[j] * rstd * gv[j];
    }
}

constexpr int NPHASE = 14;
__global__ void __launch_bounds__(512) mega(Params p) {
    extern __shared__ __attribute__((aligned(16))) unsigned char lds_raw[];
    Ctx c; c.tid = threadIdx.x; c.lane = c.tid & 63; c.wave = __builtin_amdgcn_readfirstlane(c.tid >> 6); c.bid = blockIdx.x; c.G = gridDim.x;
    c.lds = (LAS unsigned char*)lds_raw;
    cg::grid_group grid = cg::this_grid();
#define RUN(k, call) if (p.ph_lo <= (k) && (k) < p.ph_hi) { call; if ((k) + 1 < p.ph_hi) grid.sync(); }
    RUN(0, phase_prep(p, c))
    RUN(1, phase_gemm1_naive(p, c))
    RUN(2, phase_conv(p, c))
    RUN(3, phase_ssd_naive(p, c))
    RUN(4, phase_rstd(p, c))
    RUN(5, phase_attn_naive(p, c))
    RUN(6, phase_tail_naive<0>(p, c))
    RUN(7, phase_tail_naive<1>(p, c))
    RUN(8, phase_tail_naive<2>(p, c))
    RUN(9, phase_router(p, c))
    RUN(10, phase_gather(p, c))
    RUN(11, phase_moe_naive<0>(p, c))
    RUN(12, phase_moe_naive<1>(p, c))
    RUN(13, phase_combine(p, c))
#undef RUN
}

extern "C" void kernel_launch(void* const* d_in, const int* in_sizes, int n_in, void* d_out, int out_size, void* d_ws, size_t ws_size, hipStream_t stream) {
    static int ok = 0; static int grid_blocks = 0;
    if (ok == 0) {
        if (n_in != 24 || out_size != M * D || ws_size < WS_END) { fprintf(stderr, "kernel_launch: unexpected shapes: n_in %d out %d ws %zu (need %zu)\n", n_in, out_size, ws_size, (size_t)WS_END); ok = -1; return; }
        if (hipFuncSetAttribute((const void*)mega, hipFuncAttributeMaxDynamicSharedMemorySize, LDS_BYTES) != hipSuccess) { fprintf(stderr, "kernel_launch: hipFuncSetAttribute failed\n"); ok = -1; return; }
        int dev = 0, cus = 0, per_cu = 0;
        hipGetDevice(&dev);
        hipDeviceGetAttribute(&cus, hipDeviceAttributeMultiprocessorCount, dev);
        hipOccupancyMaxActiveBlocksPerMultiprocessor(&per_cu, (const void*)mega, 512, LDS_BYTES);
        if (per_cu < 1 || cus < 1) { fprintf(stderr, "kernel_launch: occupancy query gave %d blocks/CU on %d CUs\n", per_cu, cus); ok = -1; return; }
        grid_blocks = cus;
        ok = 1;
    }
    if (ok < 0) return;
    Params p{};
    for (int i = 0; i < 24; ++i) p.in[i] = (const float*)d_in[i];
    p.out = (float*)d_out; p.ws = (unsigned char*)d_ws;
    p.ph_lo = 0; p.ph_hi = NPHASE;
    void* args[] = {&p};
    hipError_t e = hipLaunchCooperativeKernel((const void*)mega, dim3(grid_blocks), dim3(512), args, LDS_BYTES, stream);
    if (e != hipSuccess) fprintf(stderr, "kernel_launch: cooperative launch failed: %s (grid %d)\n", hipGetErrorString(e), grid_blocks);
}
```

```cpp
#include <hip/hip_runtime.h>
#include <hip/hip_cooperative_groups.h>
#include <cstdio>
#include <cstdint>

namespace cg = cooperative_groups;
#define LAS __attribute__((address_space(3)))
typedef unsigned short bf16_t;
typedef unsigned u32x4 __attribute__((ext_vector_type(4)));
typedef unsigned u32x2 __attribute__((ext_vector_type(2)));
typedef float f32x4 __attribute__((ext_vector_type(4)));

constexpr int NB = 2, S = 8192, D = 1024, M = NB * S;
constexpr int NPROJ = 6400;
constexpr int PZ = 0, PXBC = 1024, PQ = 2560, PK = 3584, PV = 3840, PG = 4096, PDT = 6144;
constexpr int ROWS_MAX = 65536 + 32 * 256;
constexpr float EPS = 1e-6f;

constexpr size_t al256(size_t x) { return (x + 255) / 256 * 256; }
constexpr size_t WS_CTL = 0;
constexpr size_t WS_ROPE = 4096;
constexpr size_t WS_WRT = WS_ROPE + 32768;
constexpr size_t WS_WINT = WS_WRT + 131072;
constexpr size_t WS_WST = WS_WINT + (size_t)NPROJ * 1024 * 2;
constexpr size_t WS_WAT = WS_WST + 2097152;
constexpr size_t WS_WOT = WS_WAT + 2097152;
constexpr size_t WS_W1T = WS_WOT + 2097152;
constexpr size_t WS_W2T = WS_W1T + (size_t)32 * 2048 * 1024 * 2;
constexpr size_t WS_X1 = WS_W2T + (size_t)32 * 1024 * 1024 * 2;
constexpr size_t WS_H2 = WS_X1 + (size_t)M * 1024 * 4;
constexpr size_t WS_TOKES = WS_H2 + (size_t)M * 1024 * 2;
constexpr size_t WS_TOKW = WS_TOKES + (size_t)M * 16;
constexpr size_t WS_LIST = WS_TOKW + (size_t)M * 16;
constexpr size_t WS_R = WS_LIST + (size_t)32 * 16384 * 4;
constexpr size_t WS_H = WS_R;
constexpr size_t WS_P = WS_H + (size_t)M * 1024 * 2;
constexpr size_t WS_XT = WS_P + (size_t)M * NPROJ * 2;
constexpr size_t WS_BMR = WS_XT + (size_t)M * 1024 * 2;
constexpr size_t WS_BMT = WS_BMR + (size_t)M * 256 * 2;
constexpr size_t WS_CMR = WS_BMT + (size_t)M * 256 * 2;
constexpr size_t WS_DT = WS_CMR + (size_t)M * 256 * 2;
constexpr size_t WS_ACS = WS_DT + (size_t)2 * M * 16 * 4;
constexpr size_t WS_CDEC = WS_ACS + (size_t)2 * M * 16 * 4;
constexpr size_t WS_ST = WS_CDEC + 16384;
constexpr size_t WS_PREV = WS_ST + (size_t)2 * 2 * 64 * 16 * 8192 * 4;
constexpr size_t WS_YZ = WS_PREV + (size_t)2 * 2 * 64 * 16 * 8192 * 2;
constexpr size_t WS_RSTD = WS_YZ + (size_t)M * 1024 * 2;
constexpr size_t WS_QN = WS_RSTD + (size_t)M * 4;
constexpr size_t WS_KN = WS_QN + (size_t)M * 1024 * 2;
constexpr size_t WS_VB = WS_KN + (size_t)M * 256 * 2;
constexpr size_t WS_AO = WS_VB + (size_t)M * 256 * 2;
constexpr size_t WS_T1 = WS_AO + (size_t)M * 1024 * 2;
constexpr size_t WS_MG = WS_T1 + (size_t)M * 1024 * 2;
constexpr size_t WS_END = WS_MG + (size_t)M * 1024 * 2;
constexpr size_t WS_XB = WS_R;
constexpr size_t WS_ACT = WS_XB + (size_t)ROWS_MAX * 1024 * 2;
constexpr size_t WS_YB = WS_XB;
static_assert(WS_ACT + (size_t)ROWS_MAX * 1024 * 2 <= WS_END, "moe overlay");
static_assert(WS_END <= (size_t)1073741824, "workspace");

constexpr int LDS_BYTES = 147456;
constexpr int LDS_CTL = 135168;

struct Params {
    const float* in[24];
    float* out;
    unsigned char* ws;
    int ph_lo, ph_hi;
};

__device__ __forceinline__ float bf2f(bf16_t v) { return __uint_as_float((unsigned)v << 16); }
__device__ __forceinline__ float bflo(unsigned w) { return __uint_as_float(w << 16); }
__device__ __forceinline__ float bfhi(unsigned w) { return __uint_as_float(w & 0xffff0000u); }
__device__ __forceinline__ unsigned f2bf(float f) { unsigned u = __float_as_uint(f); return (u + 0x7fffu + ((u >> 16) & 1u)) >> 16; }
__device__ __forceinline__ unsigned pk2(float lo, float hi) { return f2bf(lo) | (f2bf(hi) << 16); }
__device__ __forceinline__ float wave_sum(float v) {
#pragma unroll
    for (int o = 1; o < 64; o <<= 1) v += __shfl_xor(v, o);
    return v;
}
__device__ __forceinline__ float wave_max(float v) {
#pragma unroll
    for (int o = 1; o < 64; o <<= 1) v = fmaxf(v, __shfl_xor(v, o));
    return v;
}
__device__ __forceinline__ int wave_min_i(int v) {
#pragma unroll
    for (int o = 1; o < 64; o <<= 1) { int t = __shfl_xor(v, o); v = t < v ? t : v; }
    return v;
}
__device__ __forceinline__ float sigmoidf_(float x) { return 1.f / (1.f + __expf(-x)); }
#define LDS_WAIT() asm volatile("s_waitcnt lgkmcnt(0)" ::: "memory")

struct Ctx { int tid, lane, wave, bid, G; LAS unsigned char* lds; };

__device__ __forceinline__ void transpose_item(const float* W, int K, int N, bf16_t* WT, int k0, int n0, int orow0, const float* kscale, LAS float* scr, int lane) {
#pragma unroll 8
    for (int i = 0; i < 32; ++i) {
        const int kk = 2 * i + (lane >> 5);
        float v = W[(size_t)(k0 + kk) * N + n0 + (lane & 31)];
        if (kscale) v *= kscale[k0 + kk];
        scr[kk * 33 + (lane & 31)] = v;
    }
    LDS_WAIT();
    const int c = lane & 7;
#pragma unroll
    for (int j = 0; j < 4; ++j) {
        const int n = (lane >> 3) + 8 * j;
        const LAS float* s = scr + (8 * c) * 33 + n;
        u32x4 o;
        o.x = pk2(s[0 * 33], s[1 * 33]); o.y = pk2(s[2 * 33], s[3 * 33]); o.z = pk2(s[4 * 33], s[5 * 33]); o.w = pk2(s[6 * 33], s[7 * 33]);
        *(u32x4*)(WT + (size_t)(orow0 + n) * K + k0 + 8 * c) = o;
    }
    LDS_WAIT();
}

__device__ __forceinline__ void phase_prep(const Params& p, const Ctx& c) {
    unsigned char* ws = p.ws;
    LAS float* scr = (LAS float*)(c.lds + c.wave * 16384);
    const int gw = c.bid * 8 + c.wave, NGW = c.G * 8;
    constexpr int I_IN = 16 * 193, I_SQ = 512, I_W1 = 32 * 1024, I_W2 = 32 * 512;
    constexpr int NITEMS = I_IN + 3 * I_SQ + I_W1 + I_W2;
    for (int it = gw; it < NITEMS; it += NGW) {
        int r = it;
        if (r < I_IN) {
            const int kb = r / 193, nb = r % 193, n0 = nb * 32;
            const int orow = n0 < 2560 ? n0 : (n0 < 2592 ? PDT + (n0 - 2560) : n0 - 32);
            transpose_item(p.in[2], 1024, 6176, (bf16_t*)(ws + WS_WINT), kb * 64, n0, orow, nullptr, scr, c.lane); continue;
        }
        r -= I_IN;
        if (r < I_SQ) { transpose_item(p.in[13], 1024, 1024, (bf16_t*)(ws + WS_WST), (r / 32) * 64, (r % 32) * 32, (r % 32) * 32, p.in[10], scr, c.lane); continue; }
        r -= I_SQ;
        if (r < I_SQ) { transpose_item(p.in[14], 1024, 1024, (bf16_t*)(ws + WS_WAT), (r / 32) * 64, (r % 32) * 32, (r % 32) * 32, nullptr, scr, c.lane); continue; }
        r -= I_SQ;
        if (r < I_SQ) { transpose_item(p.in[15], 1024, 1024, (bf16_t*)(ws + WS_WOT), (r / 32) * 64, (r % 32) * 32, (r % 32) * 32, nullptr, scr, c.lane); continue; }
        r -= I_SQ;
        if (r < I_W1) {
            const int e = r / 1024, rr = r % 1024, kb = rr / 64, nb = rr % 64, n0 = nb * 32;
            const int half = n0 / 1024, q = n0 % 1024, nt = q / 128, j = q % 128;
            transpose_item(p.in[19] + (size_t)e * 1024 * 2048, 1024, 2048, (bf16_t*)(ws + WS_W1T) + (size_t)e * 2048 * 1024, kb * 64, n0, nt * 256 + half * 128 + j, nullptr, scr, c.lane); continue;
        }
        r -= I_W1;
        {
            const int e = r / 512, rr = r % 512, kb = rr / 32, nb = rr % 32;
            transpose_item(p.in[21] + (size_t)e * 1024 * 1024, 1024, 1024, (bf16_t*)(ws + WS_W2T) + (size_t)e * 1024 * 1024, kb * 64, nb * 32, nb * 32, nullptr, scr, c.lane);
        }
    }
    for (int r = 6176 + gw; r < NPROJ; r += NGW) {
        u32x4* o = (u32x4*)((bf16_t*)(ws + WS_WINT) + (size_t)r * 1024);
        o[c.lane] = (u32x4){0u, 0u, 0u, 0u}; o[c.lane + 64] = (u32x4){0u, 0u, 0u, 0u};
    }
    {
        const float* x = p.in[0]; const float* g = p.in[1]; bf16_t* H = (bf16_t*)(ws + WS_H);
        f32x4 gv[4];
#pragma unroll
        for (int j = 0; j < 4; ++j) gv[j] = ((const f32x4*)g)[c.lane + 64 * j];
        for (int m = gw; m < M; m += NGW) {
            const f32x4* xr = (const f32x4*)(x + (size_t)m * D) + c.lane;
            f32x4 v[4]; float s = 0.f;
#pragma unroll
            for (int j = 0; j < 4; ++j) { v[j] = xr[64 * j]; s += (v[j].x * v[j].x + v[j].y * v[j].y) + (v[j].z * v[j].z + v[j].w * v[j].w); }
            const float rstd = rsqrtf(wave_sum(s) * (1.f / D) + EPS);
            u32x2* o = (u32x2*)(H + (size_t)m * D) + c.lane;
#pragma unroll
            for (int j = 0; j < 4; ++j) { u32x2 w; w.x = pk2(v[j].x * rstd * gv[j].x, v[j].y * rstd * gv[j].y); w.y = pk2(v[j].z * rstd * gv[j].z, v[j].w * rstd * gv[j].w); o[64 * j] = w; }
        }
    }
    {
        float* rc = (float*)(ws + WS_ROPE); float* rs = rc + 4096;
        for (int idx = c.bid * 512 + c.tid; idx < 4096; idx += c.G * 512) {
            const int pos = idx >> 5, i = idx & 31;
            const float inv = exp2f(-(float)i * (13.287712379549449f / 32.f));
            float rev = (float)pos * inv * 0.15915494309189535f; rev -= floorf(rev);
            rc[idx] = __builtin_amdgcn_cosf(rev); rs[idx] = __builtin_amdgcn_sinf(rev);
        }
        float* wrt = (float*)(ws + WS_WRT); const float* wr = p.in[17];
        for (int idx = c.bid * 512 + c.tid; idx < 32768; idx += c.G * 512) { const int k = idx >> 5, e = idx & 31; wrt[e * 1024 + k] = wr[idx]; }
        if (c.bid == 0 && c.tid < 64) ((int*)(ws + WS_CTL))[c.tid] = 0;
    }
}

template <bool DUAL, class ARow, class Epi>
__device__ __forceinline__ void ngemm_tile(const ARow& arow, const bf16_t* Bt, const bf16_t* Bt2, int K, int m0, const Epi& epi, LAS float* lds, int tid) {
    LAS float* As = lds;
    LAS float* Bs = lds + 32 * 132;
    LAS float* Bs2 = Bs + 32 * 68;
    float acc[4][4], acc2[4][4];
#pragma unroll
    for (int i = 0; i < 4; ++i)
#pragma unroll
        for (int j = 0; j < 4; ++j) { acc[i][j] = 0.f; acc2[i][j] = 0.f; }
    const int tm = tid & 31, tn = tid >> 5;
    const int sr = tid >> 2, kq = (tid & 3) * 8;
    const bf16_t* ap = arow(m0 + sr) + kq;
    const bf16_t* bp = Bt + (size_t)(sr & 63) * K + kq;
    const bf16_t* bp2 = DUAL ? Bt2 + (size_t)(sr & 63) * K + kq : nullptr;
    for (int k0 = 0; k0 < K; k0 += 32) {
        {
            const u32x4 v = *(const u32x4*)(ap + k0);
            As[(kq + 0) * 132 + sr] = bflo(v.x); As[(kq + 1) * 132 + sr] = bfhi(v.x); As[(kq + 2) * 132 + sr] = bflo(v.y); As[(kq + 3) * 132 + sr] = bfhi(v.y);
            As[(kq + 4) * 132 + sr] = bflo(v.z); As[(kq + 5) * 132 + sr] = bfhi(v.z); As[(kq + 6) * 132 + sr] = bflo(v.w); As[(kq + 7) * 132 + sr] = bfhi(v.w);
        }
        if (tid < 256) {
            const u32x4 v = *(const u32x4*)(bp + k0);
            Bs[(kq + 0) * 68 + sr] = bflo(v.x); Bs[(kq + 1) * 68 + sr] = bfhi(v.x); Bs[(kq + 2) * 68 + sr] = bflo(v.y); Bs[(kq + 3) * 68 + sr] = bfhi(v.y);
            Bs[(kq + 4) * 68 + sr] = bflo(v.z); Bs[(kq + 5) * 68 + sr] = bfhi(v.z); Bs[(kq + 6) * 68 + sr] = bflo(v.w); Bs[(kq + 7) * 68 + sr] = bfhi(v.w);
        } else if (DUAL) {
            const int r2 = sr & 63;
            const u32x4 v = *(const u32x4*)(bp2 + k0);
            Bs2[(kq + 0) * 68 + r2] = bflo(v.x); Bs2[(kq + 1) * 68 + r2] = bfhi(v.x); Bs2[(kq + 2) * 68 + r2] = bflo(v.y); Bs2[(kq + 3) * 68 + r2] = bfhi(v.y);
            Bs2[(kq + 4) * 68 + r2] = bflo(v.z); Bs2[(kq + 5) * 68 + r2] = bfhi(v.z); Bs2[(kq + 6) * 68 + r2] = bflo(v.w); Bs2[(kq + 7) * 68 + r2] = bfhi(v.w);
        }
        __syncthreads();
#pragma unroll 8
        for (int k = 0; k < 32; ++k) {
            const f32x4 a = *(const LAS f32x4*)&As[k * 132 + tm * 4];
            const f32x4 b = *(const LAS f32x4*)&Bs[k * 68 + tn * 4];
#pragma unroll
            for (int i = 0; i < 4; ++i)
#pragma unroll
                for (int j = 0; j < 4; ++j) acc[i][j] = fmaf(a[i], b[j], acc[i][j]);
            if (DUAL) {
                const f32x4 b2 = *(const LAS f32x4*)&Bs2[k * 68 + tn * 4];
#pragma unroll
                for (int i = 0; i < 4; ++i)
#pragma unroll
                    for (int j = 0; j < 4; ++j) acc2[i][j] = fmaf(a[i], b2[j], acc2[i][j]);
            }
        }
        __syncthreads();
    }
#pragma unroll
    for (int i = 0; i < 4; ++i)
#pragma unroll
        for (int j = 0; j < 4; ++j) epi(m0 + tm * 4 + i, tn * 4 + j, acc[i][j], acc2[i][j]);
}
struct ARowPlain { const bf16_t* A; int lda; __device__ __forceinline__ const bf16_t* operator()(int m) const { return A + (size_t)m * lda; } };

namespace pg8 {
#define PG8_LAS __attribute__((address_space(3)))
typedef unsigned short bf16_t;
typedef short bf16x8 __attribute__((ext_vector_type(8)));
typedef float f32x4 __attribute__((ext_vector_type(4)));
typedef unsigned u32x4 __attribute__((ext_vector_type(4)));
constexpr int BM = 256, BK = 64, HALF = 128, HTB = HALF * BK * 2  , STAGE_BYTES = 8 * HTB, NXCD = 8, WGM = 8;

__host__ __device__ __forceinline__ int lds_byte(int r, int c) { const int st = (r >> 4) * 2 + (c >> 5), rr = r & 15, cc = c & 31, ob = rr * 64 + cc * 2; return st * 1024 + (ob ^ (((ob >> 9) & 1) << 5)); }
__host__ __device__ __forceinline__ void stage_rc(int b, int& R, int& C) { const int st = b / 1024, sb = b % 1024, swz = sb ^ (((sb >> 9) & 1) << 5); R = (st >> 1) * 16 + swz / 64; C = (st & 1) * 32 + (swz % 64) / 2; }
__host__ __device__ __forceinline__ int perm32(int rho) { const int n = rho >> 4, i = rho & 15; return 8 * (i >> 2) + 4 * n + (i & 3); }

struct Unit { int pm, pn; };
struct Gemm { const bf16_t* A; const bf16_t* Bt; int M, N, K; };

struct StaticOrder {
    int nM, nN, nwg, G, c;
    __host__ __device__ void init(int M, int N, int G_, int c_) { nM = M / BM; nN = N / BM; nwg = nM * nN; G = G_; c = c_; }
    __host__ __device__ bool next(int i, Unit& u) const {
        const long L = (long)i * G + c; if (L >= nwg) return false;
        int wgid = (int)L; { const int q = nwg / NXCD, r = nwg % NXCD, xcd = wgid % NXCD, off = wgid / NXCD; wgid = (xcd < r ? xcd * (q + 1) : r * (q + 1) + (xcd - r) * q) + off; }
        const int nig = WGM * nN, gid = wgid / nig, fm = gid * WGM, gsz = (nM - fm) < WGM ? (nM - fm) : WGM;
        u.pm = fm + ((wgid % nig) % gsz); u.pn = (wgid % nig) / gsz; return true;
    }
    __device__ __forceinline__ void a_ready(const Unit&) const {}
    __device__ __forceinline__ void done(const Unit&) const {}
};


__device__ __forceinline__ unsigned cvt_pk_bf16(float lo, float hi) { unsigned r; asm volatile("v_cvt_pk_bf16_f32 %0, %1, %2" : "=v"(r) : "v"(lo), "v"(hi)); return r; }
__device__ __forceinline__ float sig_(float x) { return __builtin_amdgcn_rcpf(1.f + __builtin_amdgcn_exp2f(-1.4426950408889634f * x)); }
__device__ __forceinline__ u32x4 pack8(const f32x4& v0, const f32x4& v1) { u32x4 w; w.x = cvt_pk_bf16(v0[0], v0[1]); w.y = cvt_pk_bf16(v0[2], v0[3]); w.z = cvt_pk_bf16(v1[0], v1[1]); w.w = cvt_pk_bf16(v1[2], v1[3]); return w; }
__device__ __forceinline__ void unpack8(const u32x4& w, f32x4& v0, f32x4& v1) {
    v0[0] = __uint_as_float(w.x << 16); v0[1] = __uint_as_float(w.x & 0xffff0000u); v0[2] = __uint_as_float(w.y << 16); v0[3] = __uint_as_float(w.y & 0xffff0000u);
    v1[0] = __uint_as_float(w.z << 16); v1[1] = __uint_as_float(w.z & 0xffff0000u); v1[2] = __uint_as_float(w.w << 16); v1[3] = __uint_as_float(w.w & 0xffff0000u); }
struct EpiStore {
    static constexpr bool PERM = true, AFTER_DRAIN = false;
    bf16_t* O; int ldc;
    __device__ __forceinline__ void operator()(const f32x4 (&acc)[2][2][4][2], const Unit& u, int wr, int wc, int fr, int fq) const {
        const int row0 = u.pm * BM + wr * 64 + fr, col0 = u.pn * BM + wc * 32 + 8 * fq;
#pragma unroll
        for (int ai = 0; ai < 2; ++ai)
#pragma unroll
            for (int m = 0; m < 4; ++m) { bf16_t* rowp = O + (size_t)(row0 + ai * HALF + m * 16) * ldc + col0;
#pragma unroll
                for (int bj = 0; bj < 2; ++bj) *(u32x4*)(rowp + bj * HALF) = pack8(acc[ai][bj][m][0], acc[ai][bj][m][1]); }
    }
};
struct EpiT1 {
    static constexpr bool PERM = true, AFTER_DRAIN = false;
    bf16_t* T1; const bf16_t* G; int ldg; const float* RSTD;
    __device__ __forceinline__ void operator()(const f32x4 (&acc)[2][2][4][2], const Unit& u, int wr, int wc, int fr, int fq) const {
        const int row0 = u.pm * BM + wr * 64 + fr, col0 = u.pn * BM + wc * 32 + 8 * fq;
#pragma unroll
        for (int ai = 0; ai < 2; ++ai)
#pragma unroll
            for (int m = 0; m < 4; ++m) { const int row = row0 + ai * HALF + m * 16; const float rs = RSTD[row];
#pragma unroll
                for (int bj = 0; bj < 2; ++bj) { const int col = col0 + bj * HALF;
                    f32x4 g0, g1; unpack8(*(const u32x4*)(G + (size_t)row * ldg + col), g0, g1);
                    f32x4 v0 = acc[ai][bj][m][0] * rs, v1 = acc[ai][bj][m][1] * rs;
#pragma unroll
                    for (int i = 0; i < 4; ++i) { v0[i] *= sig_(g0[i]); v1[i] *= sig_(g1[i]); }
                    *(u32x4*)(T1 + (size_t)row * 1024 + col) = pack8(v0, v1); } }
    }
};
struct EpiT2 {
    static constexpr bool PERM = true, AFTER_DRAIN = false;
    bf16_t* MG; const bf16_t* T1; const bf16_t* G; int ldg;
    __device__ __forceinline__ void operator()(const f32x4 (&acc)[2][2][4][2], const Unit& u, int wr, int wc, int fr, int fq) const {
        const int row0 = u.pm * BM + wr * 64 + fr, col0 = u.pn * BM + wc * 32 + 8 * fq;
#pragma unroll
        for (int ai = 0; ai < 2; ++ai)
#pragma unroll
            for (int m = 0; m < 4; ++m) { const int row = row0 + ai * HALF + m * 16;
#pragma unroll
                for (int bj = 0; bj < 2; ++bj) { const int col = col0 + bj * HALF;
                    f32x4 g0, g1, t0, t1; unpack8(*(const u32x4*)(G + (size_t)row * ldg + col), g0, g1); unpack8(*(const u32x4*)(T1 + (size_t)row * 1024 + col), t0, t1);
                    f32x4 v0 = acc[ai][bj][m][0], v1 = acc[ai][bj][m][1];
#pragma unroll
                    for (int i = 0; i < 4; ++i) { v0[i] = fmaf(v0[i], sig_(g0[i]), t0[i]); v1[i] = fmaf(v1[i], sig_(g1[i]), t1[i]); }
                    *(u32x4*)(MG + (size_t)row * 1024 + col) = pack8(v0, v1); } }
    }
};
struct EpiT3 {
    static constexpr bool PERM = true, AFTER_DRAIN = false;
    float* X1; const float* x;
    __device__ __forceinline__ void operator()(const f32x4 (&acc)[2][2][4][2], const Unit& u, int wr, int wc, int fr, int fq) const {
        const int row0 = u.pm * BM + wr * 64 + fr, col0 = u.pn * BM + wc * 32 + 8 * fq;
#pragma unroll
        for (int ai = 0; ai < 2; ++ai)
#pragma unroll
            for (int m = 0; m < 4; ++m) { const size_t ro = (size_t)(row0 + ai * HALF + m * 16) * 1024 + col0;
#pragma unroll
                for (int bj = 0; bj < 2; ++bj) { const size_t o = ro + bj * HALF;
                    *(f32x4*)(X1 + o) = *(const f32x4*)(x + o) + acc[ai][bj][m][0]; *(f32x4*)(X1 + o + 4) = *(const f32x4*)(x + o + 4) + acc[ai][bj][m][1]; } }
    }
};
struct EpiAct {
    static constexpr bool PERM = true, AFTER_DRAIN = false;
    bf16_t* ACT; const float* b1;
    __device__ __forceinline__ void operator()(const f32x4 (&acc)[2][2][4][2], const Unit& u, int wr, int wc, int fr, int fq) const {
        const int e = u.pn >> 3, nt = u.pn & 7;
        const int row0 = u.pm * BM + wr * 64 + fr, col0 = nt * 128 + wc * 32 + 8 * fq;
        const float* bg = b1 + (size_t)e * 2048 + col0;
        const f32x4 bg0 = *(const f32x4*)bg, bg1 = *(const f32x4*)(bg + 4), bu0 = *(const f32x4*)(bg + 1024), bu1 = *(const f32x4*)(bg + 1028);
#pragma unroll
        for (int ai = 0; ai < 2; ++ai)
#pragma unroll
            for (int m = 0; m < 4; ++m) { const int row = row0 + ai * HALF + m * 16;
                f32x4 g0 = acc[ai][0][m][0] + bg0, g1 = acc[ai][0][m][1] + bg1, u0 = acc[ai][1][m][0] + bu0, u1 = acc[ai][1][m][1] + bu1;
#pragma unroll
                for (int i = 0; i < 4; ++i) {
                    const float ga = fminf(g0[i], 7.f), gb = fminf(g1[i], 7.f), ua = fminf(fmaxf(u0[i], -7.f), 7.f), ub = fminf(fmaxf(u1[i], -7.f), 7.f);
                    g0[i] = ga * sig_(1.702f * ga) * (ua + 1.f); g1[i] = gb * sig_(1.702f * gb) * (ub + 1.f); }
                *(u32x4*)(ACT + (size_t)row * 1024 + col0) = pack8(g0, g1); }
    }
};
struct EpiY {
    static constexpr bool PERM = true, AFTER_DRAIN = false;
    bf16_t* YB; const float* b2;
    __device__ __forceinline__ void operator()(const f32x4 (&acc)[2][2][4][2], const Unit& u, int wr, int wc, int fr, int fq) const {
        const int e = u.pn >> 2, nt = u.pn & 3;
        const int row0 = u.pm * BM + wr * 64 + fr, col0 = nt * BM + wc * 32 + 8 * fq;
        f32x4 bv[2][2];
#pragma unroll
        for (int bj = 0; bj < 2; ++bj) { bv[bj][0] = *(const f32x4*)(b2 + (size_t)e * 1024 + col0 + bj * HALF); bv[bj][1] = *(const f32x4*)(b2 + (size_t)e * 1024 + col0 + bj * HALF + 4); }
#pragma unroll
        for (int ai = 0; ai < 2; ++ai)
#pragma unroll
            for (int m = 0; m < 4; ++m) { bf16_t* rowp = YB + (size_t)(row0 + ai * HALF + m * 16) * 1024 + col0;
#pragma unroll
                for (int bj = 0; bj < 2; ++bj) *(u32x4*)(rowp + bj * HALF) = pack8(acc[ai][bj][m][0] + bv[bj][0], acc[ai][bj][m][1] + bv[bj][1]); }
    }
};
struct MoeOrder {
    const PG8_LAS int* offs; int nN, G, c, ntile;
    __device__ __forceinline__ bool next(int i, Unit& u) const {
        const long L = (long)i * G + c; if (L >= (long)ntile * nN) return false;
        const int t = (int)(L / nN), pnl = (int)(L % nN); int e = 0; while (e < 31 && t * 256 >= offs[e + 1]) ++e;
        u.pm = t; u.pn = e * nN + pnl; return true;
    }
    __device__ __forceinline__ void a_ready(const Unit&) const {}
    __device__ __forceinline__ void done(const Unit&) const {}
};
template <class Epi, class Sched, bool ALIGN_EPI = false, bool SP2 = false>
__device__ __forceinline__ void gemm_phase(PG8_LAS unsigned char* lds, const Gemm g, const Sched& S, const Epi& E) {
    const int tid = threadIdx.x, wid = __builtin_amdgcn_readfirstlane(tid >> 6), lane = tid & 63, wr = wid >> 2, wc = wid & 3, fr = lane & 15, fq = lane >> 4;
    const int K = g.K, nt = K / BK;
    unsigned voffA[2], voffB[2];
#pragma unroll
    for (int i = 0; i < 2; ++i) { int R, C; stage_rc(tid * 16 + i * 8192, R, C); const int Rb = Epi::PERM ? ((R & ~31) + perm32(R & 31)) : R;
        voffA[i] = (unsigned)(R * K + C) * 2u; voffB[i] = (unsigned)(Rb * K + C) * 2u; }
    const size_t kstep = (size_t)(BK * 2);
    const size_t hstep = (size_t)HALF * K * 2;
    const size_t tstep = 2 * hstep;
    const unsigned ldsw = (unsigned)wid * 1024u;
    const int aoff = lds_byte(wr * 64 + fr, fq * 8), boff = lds_byte(wc * 32 + fr, fq * 8);
#define PG8_SA(b, h) (((b) * 2 + (h)) * HTB)
#define PG8_SB(b, h) ((4 + (b) * 2 + (h)) * HTB)
#define PG8_STAGE(bufoff, gbase, voff) do { _Pragma("unroll") for (int _i = 0; _i < 2; ++_i) \
        __builtin_amdgcn_global_load_lds((const unsigned*)((const char*)(gbase) + (voff)[_i]), (PG8_LAS unsigned*)(lds + (bufoff) + ldsw + _i * 8192), 16, 0, 0); } while (0)
#define PG8_LDA(dst, b, h) do { _Pragma("unroll") for (int m = 0; m < 4; ++m) _Pragma("unroll") for (int k = 0; k < 2; ++k) dst[m][k] = *(const PG8_LAS bf16x8*)(lds + PG8_SA(b, h) + aoff + m * 2048 + k * 1024); } while (0)
#define PG8_LDB(dst, b, h) do { _Pragma("unroll") for (int n = 0; n < 2; ++n) _Pragma("unroll") for (int k = 0; k < 2; ++k) dst[n][k] = *(const PG8_LAS bf16x8*)(lds + PG8_SB(b, h) + boff + n * 2048 + k * 1024); } while (0)
#define PG8_MMA(ai, bj, At, Bt) do { __builtin_amdgcn_s_setprio(1); _Pragma("unroll") for (int m = 0; m < 4; ++m) _Pragma("unroll") for (int n = 0; n < 2; ++n) _Pragma("unroll") for (int k = 0; k < 2; ++k) \
        acc[ai][bj][m][n] = __builtin_amdgcn_mfma_f32_16x16x32_bf16(Bt[n][k], At[m][k], acc[ai][bj][m][n], 0, 0, 0); __builtin_amdgcn_s_setprio(0); } while (0)
#define PG8_WAIT_V(n) asm volatile("s_waitcnt vmcnt(" #n ")" ::: "memory")
#define PG8_WAIT_L(n) asm volatile("s_waitcnt lgkmcnt(" #n ")" ::: "memory")
#define PG8_BAR __builtin_amdgcn_s_barrier()
#define PG8_SCHED __builtin_amdgcn_sched_barrier(0)
    Unit cur, nxt; int ui = 0;
    if (!S.next(0, cur)) return;
    f32x4 acc[2][2][4][2];
#pragma unroll
    for (int a = 0; a < 2; ++a)
#pragma unroll
        for (int b = 0; b < 2; ++b)
#pragma unroll
            for (int m = 0; m < 4; ++m)
#pragma unroll
                for (int n = 0; n < 2; ++n) acc[a][b][m][n] = (f32x4){0.f, 0.f, 0.f, 0.f};
    bf16x8 At[4][2], B0[2][2], B1[2][2];
    const char* cA = (const char*)g.A + (size_t)cur.pm * tstep; const char* cB = (const char*)g.Bt + (size_t)cur.pn * tstep;
    S.a_ready(cur);
    if constexpr (SP2) {
        PG8_STAGE(PG8_SB(0, 0), cB, voffB); PG8_STAGE(PG8_SB(0, 1), cB + hstep, voffB); PG8_STAGE(PG8_SA(0, 0), cA, voffA); PG8_STAGE(PG8_SA(0, 1), cA + hstep, voffA);
        if (wr == 1) PG8_BAR;
        PG8_WAIT_V(2); PG8_BAR;
        PG8_STAGE(PG8_SB(1, 0), cB + kstep, voffB); PG8_STAGE(PG8_SA(1, 0), cA + kstep, voffA); PG8_STAGE(PG8_SB(1, 1), cB + hstep + kstep, voffB);
        PG8_WAIT_V(6); PG8_BAR;
    } else {
        PG8_STAGE(PG8_SB(0, 0), cB, voffB); PG8_STAGE(PG8_SA(0, 0), cA, voffA); PG8_STAGE(PG8_SB(0, 1), cB + hstep, voffB); PG8_STAGE(PG8_SA(0, 1), cA + hstep, voffA);
        if (wr == 1) PG8_BAR;
        PG8_WAIT_V(4); PG8_BAR;
        PG8_STAGE(PG8_SB(1, 0), cB + kstep, voffB); PG8_STAGE(PG8_SA(1, 0), cA + kstep, voffA); PG8_STAGE(PG8_SB(1, 1), cB + hstep + kstep, voffB);
        PG8_WAIT_V(6); PG8_BAR;
    }
    for (;;) {
        const bool has_next = S.next(ui + 1, nxt);
        const char* nA = has_next ? (const char*)g.A + (size_t)nxt.pm * tstep : cA; const char* nB = has_next ? (const char*)g.Bt + (size_t)nxt.pn * tstep : cB;
        for (int t = 0; t < nt; t += 2) {
            const bool last = (t == nt - 2);
            const char* a1 = cA + (size_t)(t + 1) * kstep;
            const char* a2 = last ? nA : cA + (size_t)(t + 2) * kstep; const char* b2 = last ? nB : cB + (size_t)(t + 2) * kstep;
            const char* a3 = a2 + kstep; const char* b3 = b2 + kstep;
            if (last && has_next) S.a_ready(nxt);
            if constexpr (SP2) {
            PG8_LDB(B0, 0, 0); PG8_LDB(B1, 0, 1); PG8_SCHED; PG8_LDA(At, 0, 0); PG8_STAGE(PG8_SA(1, 1), a1 + hstep, voffA);
            PG8_WAIT_V(8); PG8_WAIT_L(0); PG8_BAR; PG8_MMA(0, 0, At, B0); PG8_MMA(0, 1, At, B1); PG8_BAR; PG8_SCHED;
            PG8_LDA(At, 0, 1); PG8_STAGE(PG8_SB(0, 0), b2, voffB); PG8_STAGE(PG8_SB(0, 1), b2 + hstep, voffB); PG8_STAGE(PG8_SA(0, 0), a2, voffA);
            PG8_WAIT_V(8); PG8_WAIT_L(0); PG8_BAR; PG8_MMA(1, 0, At, B0); PG8_MMA(1, 1, At, B1); PG8_BAR; PG8_SCHED;
            PG8_LDB(B0, 1, 0); PG8_LDB(B1, 1, 1); PG8_SCHED; PG8_LDA(At, 1, 0); PG8_STAGE(PG8_SA(0, 1), a2 + hstep, voffA);
            PG8_WAIT_V(8); PG8_WAIT_L(0); PG8_BAR; PG8_MMA(0, 0, At, B0); PG8_MMA(0, 1, At, B1); PG8_BAR; PG8_SCHED;
            PG8_LDA(At, 1, 1); PG8_STAGE(PG8_SB(1, 0), b3, voffB); PG8_STAGE(PG8_SB(1, 1), b3 + hstep, voffB); PG8_STAGE(PG8_SA(1, 0), a3, voffA);
            PG8_WAIT_V(8); PG8_WAIT_L(0); PG8_BAR; PG8_MMA(1, 0, At, B0); PG8_MMA(1, 1, At, B1); PG8_BAR; PG8_SCHED;
            } else {
            PG8_LDB(B0, 0, 0); PG8_SCHED; PG8_LDA(At, 0, 0); PG8_STAGE(PG8_SA(1, 1), a1 + hstep, voffA);
            PG8_WAIT_L(8); PG8_BAR; PG8_WAIT_L(0); PG8_MMA(0, 0, At, B0); PG8_BAR; PG8_SCHED;
            PG8_LDB(B1, 0, 1); PG8_STAGE(PG8_SB(0, 0), b2, voffB);
            PG8_BAR; PG8_WAIT_L(0); PG8_MMA(0, 1, At, B1); PG8_BAR;
            PG8_LDA(At, 0, 1); PG8_STAGE(PG8_SA(0, 0), a2, voffA);
            PG8_BAR; PG8_WAIT_L(0); PG8_MMA(1, 0, At, B0); PG8_BAR; PG8_SCHED;
            PG8_STAGE(PG8_SB(0, 1), b2 + hstep, voffB);
            PG8_WAIT_V(6); PG8_BAR; PG8_MMA(1, 1, At, B1); PG8_BAR;
            PG8_LDB(B0, 1, 0); PG8_SCHED; PG8_LDA(At, 1, 0); PG8_STAGE(PG8_SA(0, 1), a2 + hstep, voffA);
            PG8_WAIT_L(8); PG8_BAR; PG8_WAIT_L(0); PG8_MMA(0, 0, At, B0); PG8_BAR; PG8_SCHED;
            PG8_LDB(B1, 1, 1); PG8_STAGE(PG8_SB(1, 0), b3, voffB);
            PG8_BAR; PG8_WAIT_L(0); PG8_MMA(0, 1, At, B1); PG8_BAR;
            PG8_LDA(At, 1, 1); PG8_STAGE(PG8_SA(1, 0), a3, voffA);
            PG8_BAR; PG8_WAIT_L(0); PG8_MMA(1, 0, At, B0); PG8_BAR; PG8_SCHED;
            PG8_STAGE(PG8_SB(1, 1), b3 + hstep, voffB);
            PG8_WAIT_V(6); PG8_BAR; PG8_MMA(1, 1, At, B1); PG8_BAR;
            }
        }
        if constexpr (ALIGN_EPI) { if (wr == 0) PG8_BAR; }
        if constexpr (!Epi::AFTER_DRAIN) { E(acc, cur, wr, wc, fr, fq); S.done(cur); }
        if (!has_next) break;
#pragma unroll
        for (int a = 0; a < 2; ++a)
#pragma unroll
            for (int b = 0; b < 2; ++b)
#pragma unroll
                for (int m = 0; m < 4; ++m)
#pragma unroll
                    for (int n = 0; n < 2; ++n) acc[a][b][m][n] = (f32x4){0.f, 0.f, 0.f, 0.f};
        cur = nxt; cA = nA; cB = nB; ++ui;
        if constexpr (ALIGN_EPI) { if (wr == 1) PG8_BAR; }
    }
    PG8_WAIT_V(0);
    if constexpr (!ALIGN_EPI) { if (wr == 0) PG8_BAR; }
    PG8_BAR;
    if constexpr (Epi::AFTER_DRAIN) { E.fused(acc, cur, wr, wc, fr, fq, lds, wid, lane); S.done(cur); }
#undef PG8_SA
#undef PG8_SB
#undef PG8_STAGE
#undef PG8_LDA
#undef PG8_LDB
#undef PG8_MMA
#undef PG8_WAIT_V
#undef PG8_WAIT_L
#undef PG8_BAR
#undef PG8_SCHED
}
}

struct EpiP { bf16_t* P; int n0; __device__ __forceinline__ void operator()(int r, int cl, float a, float) const { P[(size_t)r * NPROJ + n0 + cl] = (bf16_t)f2bf(a); } };
__device__ __forceinline__ void phase_gemm1_naive(const Params& p, const Ctx& c) {
    const bf16_t* H = (const bf16_t*)(p.ws + WS_H); const bf16_t* W = (const bf16_t*)(p.ws + WS_WINT); bf16_t* P = (bf16_t*)(p.ws + WS_P);
    constexpr int NT_N = NPROJ / 64, NT_M = M / 128;
    for (int it = c.bid; it < NT_M * NT_N; it += c.G) {
        const int mt = it / NT_N, nt = it % NT_N;
        ngemm_tile<false>(ARowPlain{H, 1024}, W + (size_t)nt * 64 * 1024, nullptr, 1024, mt * 128, EpiP{P, nt * 64}, (LAS float*)c.lds, c.tid);
    }
}

__device__ __forceinline__ void phase_conv(const Params& p, const Ctx& c) {
    unsigned char* ws = p.ws;
    const bf16_t* P = (const bf16_t*)(ws + WS_P);
    const int tid = c.tid;
    LAS bf16_t* raw = (LAS bf16_t*)c.lds;
    LAS bf16_t* outb = (LAS bf16_t*)(c.lds + 132 * 256 * 2);
    for (int it = c.bid; it < 2 * 64 * 6; it += c.G) {
        const int part = it % 6, bc = it / 6, b = bc / 64, ch_ = bc % 64, t0 = ch_ * 128;
        __syncthreads();
        for (int idx = tid; idx < 132 * 32; idx += 512) {
            const int r = idx >> 5, c8 = idx & 31, tok = t0 - 2 + r;
            u32x4 v = (u32x4){0u, 0u, 0u, 0u};
            if (tok >= 0 && tok < S) v = *(const u32x4*)(P + (size_t)(b * S + tok) * NPROJ + PXBC + part * 256 + c8 * 8);
            *(LAS u32x4*)(raw + r * 256 + c8 * 8) = v;
        }
        __syncthreads();
        {
            const int ch = tid & 255, l0 = tid >> 8, cg_ = part * 256 + ch;
            const float* cw = p.in[3]; const float cb = p.in[4][cg_];
            const float w0 = cw[0 * 1536 + cg_], w1 = cw[1 * 1536 + cg_], w2 = cw[2 * 1536 + cg_], w3 = cw[3 * 1536 + cg_], w4 = cw[4 * 1536 + cg_];
            for (int i = 0; i < 64; ++i) {
                const int l = l0 + 2 * i;
                float a = cb;
                a = fmaf(w0, bf2f(raw[(l + 0) * 256 + ch]), a); a = fmaf(w1, bf2f(raw[(l + 1) * 256 + ch]), a); a = fmaf(w2, bf2f(raw[(l + 2) * 256 + ch]), a);
                a = fmaf(w3, bf2f(raw[(l + 3) * 256 + ch]), a); a = fmaf(w4, bf2f(raw[(l + 4) * 256 + ch]), a);
                outb[l * 256 + ch] = (bf16_t)f2bf(a * sigmoidf_(a));
            }
        }
        __syncthreads();
        if (part < 4 || part == 4) {
            bf16_t* dst = part < 4 ? (bf16_t*)(ws + WS_XT) + ((size_t)(b * 64 + ch_) * 16 + part * 4) * 64 * 128
                                   : (bf16_t*)(ws + WS_BMT) + (size_t)(b * 64 + ch_) * 2 * 128 * 128;
            for (int idx = tid; idx < 256 * 16; idx += 512) {
                const int lc = idx >> 8, ch = idx & 255;
                u32x4 o;
                o.x = (unsigned)outb[(lc * 8 + 0) * 256 + ch] | ((unsigned)outb[(lc * 8 + 1) * 256 + ch] << 16);
                o.y = (unsigned)outb[(lc * 8 + 2) * 256 + ch] | ((unsigned)outb[(lc * 8 + 3) * 256 + ch] << 16);
                o.z = (unsigned)outb[(lc * 8 + 4) * 256 + ch] | ((unsigned)outb[(lc * 8 + 5) * 256 + ch] << 16);
                o.w = (unsigned)outb[(lc * 8 + 6) * 256 + ch] | ((unsigned)outb[(lc * 8 + 7) * 256 + ch] << 16);
                *(u32x4*)(dst + (size_t)ch * 128 + lc * 8) = o;
            }
        }
        if (part >= 4) {
            bf16_t* dst = (bf16_t*)(ws + (part == 4 ? WS_BMR : WS_CMR)) + (size_t)(b * S + t0) * 256;
            for (int idx = tid; idx < 128 * 32; idx += 512) {
                const int l = idx >> 5, c8 = idx & 31;
                *(u32x4*)(dst + (size_t)l * 256 + c8 * 8) = *(const LAS u32x4*)(outb + l * 256 + c8 * 8);
            }
        }
    }
    {
        LAS float* as_ = (LAS float*)c.lds;
        float* DT = (float*)(ws + WS_DT); float* ACS = (float*)(ws + WS_ACS); float* CDEC = (float*)(ws + WS_CDEC);
        for (int it = c.bid; it < 128; it += c.G) {
            const int b = it / 64, ch_ = it % 64, t0 = ch_ * 128;
            __syncthreads();
            for (int idx = tid; idx < 4096; idx += 512) {
                const int l = idx >> 5, q = idx & 31, dir = q >> 4, h = q & 15;
                const size_t tok = (size_t)b * S + t0 + l;
                const float x = bf2f(P[tok * NPROJ + PDT + q]) + (dir ? p.in[6][h] : p.in[5][h]);
                const float dt = fmaxf(x, 0.f) + log1pf(expf(-fabsf(x)));
                const float a = -dt * expf(dir ? p.in[8][h] : p.in[7][h]);
                DT[((size_t)dir * M + tok) * 16 + h] = dt;
                as_[q * 128 + l] = a;
            }
            __syncthreads();
            if (tid < 32) {
                const int q = tid, dir = q >> 4, h = q & 15; float run = 0.f;
                if (dir == 0) { for (int l = 0; l < 128; ++l) { run += as_[q * 128 + l]; ACS[((size_t)b * S + t0 + l) * 16 + h] = run; } }
                else { for (int l = 127; l >= 0; --l) { run += as_[q * 128 + l]; ACS[((size_t)M + (size_t)b * S + t0 + l) * 16 + h] = run; } }
                CDEC[((dir * 2 + b) * 64 + ch_) * 16 + h] = expf(run);
            }
        }
        __syncthreads();
    }
    {
        const int gw = c.bid * 8 + c.wave, NGW = c.G * 8, lane = c.lane;
        const float* rc = (const float*)(ws + WS_ROPE); const float* rs = rc + 4096;
        const int axis = lane >> 5, i = lane & 31, e1 = axis * 64 + i, e2 = e1 + 32;
        const float gq1 = p.in[11][e1], gq2 = p.in[11][e2], gk1 = p.in[12][e1], gk2 = p.in[12][e2];
        bf16_t* QN = (bf16_t*)(ws + WS_QN); bf16_t* KN = (bf16_t*)(ws + WS_KN);
        for (int it = gw; it < M * 10; it += NGW) {
            const int tok = it / 10, hh = it % 10;
            const bf16_t* src = P + (size_t)tok * NPROJ + (hh < 8 ? PQ + hh * 128 : PK + (hh - 8) * 128);
            bf16_t* dst = hh < 8 ? QN + (size_t)tok * 1024 + hh * 128 : KN + (size_t)tok * 256 + (hh - 8) * 128;
            const float v1 = bf2f(src[e1]), v2 = bf2f(src[e2]);
            const float rstd = rsqrtf(wave_sum(v1 * v1 + v2 * v2) * (1.f / 128.f) + EPS);
            const float y1 = v1 * rstd * (hh < 8 ? gq1 : gk1), y2 = v2 * rstd * (hh < 8 ? gq2 : gk2);
            const int s = tok & (S - 1), pos = axis ? (s & 63) : (s >> 6);
            const float cs = rc[pos * 32 + i], sn = rs[pos * 32 + i];
            dst[e1] = (bf16_t)f2bf(y1 * cs - y2 * sn); dst[e2] = (bf16_t)f2bf(y2 * cs + y1 * sn);
        }
        bf16_t* VB = (bf16_t*)(ws + WS_VB);
        for (int idx = c.bid * 512 + c.tid; idx < M * 32; idx += c.G * 512) {
            const int tok = idx >> 5, c8 = idx & 31;
            *(u32x4*)(VB + (size_t)tok * 256 + c8 * 8) = *(const u32x4*)(P + (size_t)tok * NPROJ + PV + c8 * 8);
        }
    }
}

__device__ __forceinline__ void phase_ssd_naive(const Params& p, const Ctx& c) {
    unsigned char* ws = p.ws;
    const bf16_t* P = (const bf16_t*)(ws + WS_P); const bf16_t* XT = (const bf16_t*)(ws + WS_XT);
    const bf16_t* BMR = (const bf16_t*)(ws + WS_BMR); const bf16_t* CMR = (const bf16_t*)(ws + WS_CMR);
    const float* DT = (const float*)(ws + WS_DT); float* YACC = (float*)(ws + WS_ST); bf16_t* YZ = (bf16_t*)(ws + WS_YZ);
    const int pp = c.tid >> 3, nq = c.tid & 7;
    for (int item = c.bid; item < 32; item += c.G) {
        const int b = item >> 4, h = item & 15, g = h >> 3;
        const float dsk = p.in[9][h];
        for (int dir = 0; dir < 2; ++dir) {
            const float A = -expf(dir ? p.in[8][h] : p.in[7][h]);
            float st[16];
#pragma unroll
            for (int i = 0; i < 16; ++i) st[i] = 0.f;
            int t = dir ? S - 1 : 0;
            size_t tok = (size_t)b * S + t;
            u32x4 nb0 = *(const u32x4*)(BMR + tok * 256 + g * 128 + nq * 16), nb1 = *(const u32x4*)(BMR + tok * 256 + g * 128 + nq * 16 + 8);
            u32x4 nc0 = *(const u32x4*)(CMR + tok * 256 + g * 128 + nq * 16), nc1 = *(const u32x4*)(CMR + tok * 256 + g * 128 + nq * 16 + 8);
            float nx = bf2f(XT[((((size_t)b * 64 + (t >> 7)) * 16 + h) * 64 + pp) * 128 + (t & 127)]);
            float ndt = DT[((size_t)dir * M + tok) * 16 + h];
            for (int step = 0; step < S; ++step) {
                const u32x4 b0 = nb0, b1 = nb1, c0 = nc0, c1 = nc1; const float x = nx, dt = ndt; const size_t tokc = tok;
                if (step + 1 < S) {
                    t = dir ? S - 2 - step : step + 1; tok = (size_t)b * S + t;
                    nb0 = *(const u32x4*)(BMR + tok * 256 + g * 128 + nq * 16); nb1 = *(const u32x4*)(BMR + tok * 256 + g * 128 + nq * 16 + 8);
                    nc0 = *(const u32x4*)(CMR + tok * 256 + g * 128 + nq * 16); nc1 = *(const u32x4*)(CMR + tok * 256 + g * 128 + nq * 16 + 8);
                    nx = bf2f(XT[((((size_t)b * 64 + (t >> 7)) * 16 + h) * 64 + pp) * 128 + (t & 127)]);
                    ndt = DT[((size_t)dir * M + tok) * 16 + h];
                }
                const float dec = __expf(dt * A), xdt = x * dt;
                float part = 0.f;
#define SSD_STEP(i, BW, CW, LOHI) { st[i] = fmaf(st[i], dec, LOHI(BW) * xdt); part = fmaf(LOHI(CW), st[i], part); }
                SSD_STEP(0, b0.x, c0.x, bflo) SSD_STEP(1, b0.x, c0.x, bfhi) SSD_STEP(2, b0.y, c0.y, bflo) SSD_STEP(3, b0.y, c0.y, bfhi)
                SSD_STEP(4, b0.z, c0.z, bflo) SSD_STEP(5, b0.z, c0.z, bfhi) SSD_STEP(6, b0.w, c0.w, bflo) SSD_STEP(7, b0.w, c0.w, bfhi)
                SSD_STEP(8, b1.x, c1.x, bflo) SSD_STEP(9, b1.x, c1.x, bfhi) SSD_STEP(10, b1.y, c1.y, bflo) SSD_STEP(11, b1.y, c1.y, bfhi)
                SSD_STEP(12, b1.z, c1.z, bflo) SSD_STEP(13, b1.z, c1.z, bfhi) SSD_STEP(14, b1.w, c1.w, bflo) SSD_STEP(15, b1.w, c1.w, bfhi)
#undef SSD_STEP
                part += __shfl_xor(part, 1); part += __shfl_xor(part, 2); part += __shfl_xor(part, 4);
                if (nq == 0) {
                    const size_t o = tokc * 1024 + h * 64 + pp;
                    if (dir == 0) YACC[o] = part + x * dsk;
                    else { const float y = YACC[o] + part; const float z = bf2f(P[tokc * NPROJ + PZ + h * 64 + pp]); YZ[o] = (bf16_t)f2bf(y * z * sigmoidf_(z)); }
                }
            }
        }
    }
}


typedef short bf16x8 __attribute__((ext_vector_type(8)));
typedef float f32x16 __attribute__((ext_vector_type(16)));
constexpr int TS = 136;
__device__ __forceinline__ bf16x8 ldfrag(const LAS bf16_t* tile, int row, int k0) { return *(const LAS bf16x8*)(tile + row * TS + k0); }
__device__ __forceinline__ void load_tile128(LAS bf16_t* dst, const bf16_t* src, int rows, int ld, int tid) {
    for (int idx = tid; idx < rows * 16; idx += 512) { const int r = idx >> 4, c16 = idx & 15;
        *(LAS u32x4*)(dst + r * TS + c16 * 8) = *(const u32x4*)(src + (size_t)r * ld + c16 * 8); }
}
__device__ __forceinline__ void phase_ssd_states(const Params& p, const Ctx& c) {
    unsigned char* ws = p.ws;
    const bf16_t* XT = (const bf16_t*)(ws + WS_XT); const bf16_t* BMT = (const bf16_t*)(ws + WS_BMT);
    const float* DT = (const float*)(ws + WS_DT); const float* ACS = (const float*)(ws + WS_ACS); float* ST = (float*)(ws + WS_ST);
    LAS bf16_t* BTs = (LAS bf16_t*)c.lds; LAS bf16_t* XTf = BTs + 128 * TS; LAS bf16_t* XTb = XTf + 64 * TS; LAS float* wd = (LAS float*)(XTb + 64 * TS);
    const int tid = c.tid, lane = c.lane, r = lane & 31, hh = lane >> 5;
    for (int unit = c.bid; unit < 256; unit += c.G) {
        const int b = unit >> 7, ch = (unit >> 1) & 63, g = unit & 1;
        __syncthreads();
        load_tile128(BTs, BMT + ((size_t)(b * 64 + ch) * 2 + g) * 128 * 128, 128, 128, tid);
        for (int h8 = 0; h8 < 8; ++h8) {
            const int h = g * 8 + h8;
            __syncthreads();
            if (tid < 256) { const int d = tid >> 7, l = tid & 127; const size_t t0 = (size_t)d * M + (size_t)b * S + ch * 128;
                const float acs = ACS[(t0 + l) * 16 + h], dt = DT[(t0 + l) * 16 + h], aend = ACS[(t0 + (d ? 0 : 127)) * 16 + h];
                wd[d * 128 + l] = dt * __expf(aend - acs); }
            __syncthreads();
            { const bf16_t* xt = XT + ((size_t)(b * 64 + ch) * 16 + h) * 64 * 128;
#pragma unroll
              for (int i = 0; i < 2; ++i) { const int idx = tid + 512 * i, pr = idx >> 4, c16 = idx & 15, l0 = c16 * 8;
                const u32x4 v = *(const u32x4*)(xt + pr * 128 + l0);
                float x[8] = {bflo(v.x), bfhi(v.x), bflo(v.y), bfhi(v.y), bflo(v.z), bfhi(v.z), bflo(v.w), bfhi(v.w)};
                u32x4 of, ob;
                of.x = pk2(x[0] * wd[l0 + 0], x[1] * wd[l0 + 1]); of.y = pk2(x[2] * wd[l0 + 2], x[3] * wd[l0 + 3]); of.z = pk2(x[4] * wd[l0 + 4], x[5] * wd[l0 + 5]); of.w = pk2(x[6] * wd[l0 + 6], x[7] * wd[l0 + 7]);
                ob.x = pk2(x[0] * wd[128 + l0 + 0], x[1] * wd[128 + l0 + 1]); ob.y = pk2(x[2] * wd[128 + l0 + 2], x[3] * wd[128 + l0 + 3]);
                ob.z = pk2(x[4] * wd[128 + l0 + 4], x[5] * wd[128 + l0 + 5]); ob.w = pk2(x[6] * wd[128 + l0 + 6], x[7] * wd[128 + l0 + 7]);
                *(LAS u32x4*)(XTf + pr * TS + l0) = of; *(LAS u32x4*)(XTb + pr * TS + l0) = ob; } }
            __syncthreads();
            { const int d = c.wave >> 2, nb = c.wave & 3; const LAS bf16_t* XTd = d ? XTb : XTf;
              float* st = ST + ((((size_t)(d * 2 + b) * 64 + ch) * 16 + h) * 64) * 128;
#pragma unroll
              for (int pb = 0; pb < 2; ++pb) { f32x16 acc = {};
#pragma unroll
                for (int ks = 0; ks < 8; ++ks) acc = __builtin_amdgcn_mfma_f32_32x32x16_bf16(ldfrag(XTd, pb * 32 + r, ks * 16 + 8 * hh), ldfrag(BTs, nb * 32 + r, ks * 16 + 8 * hh), acc, 0, 0, 0);
#pragma unroll
                for (int i = 0; i < 16; ++i) { const int pp = pb * 32 + (i & 3) + 8 * (i >> 2) + 4 * hh; st[(size_t)pp * 128 + nb * 32 + r] = acc[i]; } } }
        }
    }
}
__device__ __forceinline__ void phase_ssd_scan(const Params& p, const Ctx& c) {
    unsigned char* ws = p.ws;
    const float* ST = (const float*)(ws + WS_ST); const float* CDEC = (const float*)(ws + WS_CDEC); bf16_t* PREV = (bf16_t*)(ws + WS_PREV);
    for (int idx = c.bid * 512 + c.tid; idx < 131072; idx += c.G * 512) {
        const int n4 = idx & 31, pp = (idx >> 5) & 63, h = (idx >> 11) & 15, b = (idx >> 15) & 1, d = idx >> 16;
        f32x4 run = {0.f, 0.f, 0.f, 0.f};
#pragma unroll 8
        for (int step = 0; step < 64; ++step) {
            const int ch = d ? 63 - step : step;
            const size_t o = ((((size_t)(d * 2 + b) * 64 + ch) * 16 + h) * 64 + pp) * 128 + n4 * 4;
            u32x2 w; w.x = pk2(run.x, run.y); w.y = pk2(run.z, run.w); *(u32x2*)(PREV + o) = w;
            const f32x4 st = *(const f32x4*)(ST + o); const float dec = CDEC[((d * 2 + b) * 64 + ch) * 16 + h];
            run = run * dec + st;
        }
    }
}
__device__ __forceinline__ void phase_ssd_out(const Params& p, const Ctx& c) {
    unsigned char* ws = p.ws;
    const bf16_t* P = (const bf16_t*)(ws + WS_P); const bf16_t* XT = (const bf16_t*)(ws + WS_XT);
    const bf16_t* BMR = (const bf16_t*)(ws + WS_BMR); const bf16_t* CMR = (const bf16_t*)(ws + WS_CMR); const bf16_t* PREV = (const bf16_t*)(ws + WS_PREV);
    const float* DT = (const float*)(ws + WS_DT); const float* ACS = (const float*)(ws + WS_ACS); bf16_t* YZ = (bf16_t*)(ws + WS_YZ);
    LAS bf16_t* Cs = (LAS bf16_t*)c.lds; LAS bf16_t* Ms = Cs + 128 * TS; LAS bf16_t* XTs = Ms + 128 * TS; LAS bf16_t* PF = XTs + 64 * TS; LAS bf16_t* PB = PF + 64 * TS;
    LAS float* vec = (LAS float*)(PB + 64 * TS);
    const int tid = c.tid, lane = c.lane, r = lane & 31, hh = lane >> 5, wave = c.wave;
    for (int unit = c.bid; unit < 256; unit += c.G) {
        const int b = unit >> 7, ch = (unit >> 1) & 63, g = unit & 1;
        const size_t tok0 = (size_t)b * S + ch * 128;
        __syncthreads();
        load_tile128(Cs, CMR + tok0 * 256 + g * 128, 128, 256, tid);
        load_tile128(Ms, BMR + tok0 * 256 + g * 128, 128, 256, tid);
        __syncthreads();
        const int lb = wave & 3, sb0 = 2 * (wave >> 2);
        f32x16 G0 = {}, G1 = {};
#pragma unroll
        for (int ks = 0; ks < 8; ++ks) { const bf16x8 a = ldfrag(Cs, lb * 32 + r, ks * 16 + 8 * hh);
            G0 = __builtin_amdgcn_mfma_f32_32x32x16_bf16(a, ldfrag(Ms, sb0 * 32 + r, ks * 16 + 8 * hh), G0, 0, 0, 0);
            G1 = __builtin_amdgcn_mfma_f32_32x32x16_bf16(a, ldfrag(Ms, (sb0 + 1) * 32 + r, ks * 16 + 8 * hh), G1, 0, 0, 0); }
        for (int h8 = 0; h8 < 8; ++h8) {
            const int h = g * 8 + h8;
            const float dsk = p.in[9][h];
            __syncthreads();
            { const int v = tid >> 7, l = tid & 127; const size_t o = ((size_t)(v & 1) * M + tok0 + l) * 16 + h; vec[tid] = (v < 2) ? ACS[o] : DT[o]; }
            load_tile128(XTs, XT + ((size_t)(b * 64 + ch) * 16 + h) * 64 * 128, 64, 128, tid);
            load_tile128(PF, PREV + ((((size_t)(0 * 2 + b) * 64 + ch) * 16 + h) * 64) * 128, 64, 128, tid);
            load_tile128(PB, PREV + ((((size_t)(1 * 2 + b) * 64 + ch) * 16 + h) * 64) * 128, 64, 128, tid);
            __syncthreads();
#pragma unroll
            for (int t2 = 0; t2 < 2; ++t2) { const f32x16& Gt = t2 ? G1 : G0; const int s = (sb0 + t2) * 32 + r;
                const float afs = vec[s], abs_ = vec[128 + s], dfs = vec[256 + s], dbs = vec[384 + s];
#pragma unroll
                for (int i = 0; i < 16; ++i) { const int l = lb * 32 + (i & 3) + 8 * (i >> 2) + 4 * hh;
                    const float tf = (s <= l) ? __expf(vec[l] - afs) * dfs : 0.f, tb = (s >= l) ? __expf(vec[128 + l] - abs_) * dbs : 0.f;
                    const float m = Gt[i] * (tf + tb) + (s == l ? dsk : 0.f);
                    Ms[l * TS + s] = (bf16_t)f2bf(m); } }
            __syncthreads();
            { const int pb = wave >> 2;
              f32x16 Yd = {}, Yf = {}, Yb = {};
#pragma unroll
              for (int ks = 0; ks < 8; ++ks) { const int k0 = ks * 16 + 8 * hh;
                  Yd = __builtin_amdgcn_mfma_f32_32x32x16_bf16(ldfrag(Ms, lb * 32 + r, k0), ldfrag(XTs, pb * 32 + r, k0), Yd, 0, 0, 0);
                  const bf16x8 a = ldfrag(Cs, lb * 32 + r, k0);
                  Yf = __builtin_amdgcn_mfma_f32_32x32x16_bf16(a, ldfrag(PF, pb * 32 + r, k0), Yf, 0, 0, 0);
                  Yb = __builtin_amdgcn_mfma_f32_32x32x16_bf16(a, ldfrag(PB, pb * 32 + r, k0), Yb, 0, 0, 0); }
#pragma unroll
              for (int i = 0; i < 16; ++i) { const int l = lb * 32 + (i & 3) + 8 * (i >> 2) + 4 * hh; const int col = h * 64 + pb * 32 + r;
                  const float y = Yd[i] + __expf(vec[l]) * Yf[i] + __expf(vec[128 + l]) * Yb[i];
                  const float z = bf2f(P[(tok0 + l) * NPROJ + PZ + col]);
                  YZ[(tok0 + l) * 1024 + col] = (bf16_t)f2bf(y * z * sigmoidf_(z)); } }
        }
    }
}

__device__ __forceinline__ void phase_rstd(const Params& p, const Ctx& c) {
    const bf16_t* YZ = (const bf16_t*)(p.ws + WS_YZ); float* RSTD = (float*)(p.ws + WS_RSTD);
    const int gw = c.bid * 8 + c.wave, NGW = c.G * 8;
    for (int m = gw; m < M; m += NGW) {
        const u32x4* r = (const u32x4*)(YZ + (size_t)m * 1024) + c.lane;
        float s = 0.f;
#pragma unroll
        for (int j = 0; j < 2; ++j) { const u32x4 v = r[64 * j];
            s += bflo(v.x) * bflo(v.x) + bfhi(v.x) * bfhi(v.x) + bflo(v.y) * bflo(v.y) + bfhi(v.y) * bfhi(v.y) + bflo(v.z) * bflo(v.z) + bfhi(v.z) * bfhi(v.z) + bflo(v.w) * bflo(v.w) + bfhi(v.w) * bfhi(v.w); }
        s = wave_sum(s);
        if (c.lane == 0) RSTD[m] = rsqrtf(s * (1.f / 1024.f) + EPS);
    }
}

__device__ __forceinline__ void phase_attn_naive(const Params& p, const Ctx& c) {
    unsigned char* ws = p.ws;
    const bf16_t* QN = (const bf16_t*)(ws + WS_QN); const bf16_t* KN = (const bf16_t*)(ws + WS_KN); const bf16_t* VB = (const bf16_t*)(ws + WS_VB);
    bf16_t* AO = (bf16_t*)(ws + WS_AO);
    LAS bf16_t* Ks = (LAS bf16_t*)c.lds; LAS bf16_t* Vs = Ks + 64 * 128;
    const int tid = c.tid, row = tid >> 2, dq = tid & 3;
    constexpr float C = 0.088388347648318440f * 1.4426950408889634f;
    for (int item = c.bid; item < 1024; item += c.G) {
        const int b = item >> 9, h = (item >> 6) & 7, qb = item & 63, kvh = h >> 2;
        const size_t tokq = (size_t)b * S + qb * 128 + row;
        float q[32], o[32];
#pragma unroll
        for (int i = 0; i < 4; ++i) { const u32x4 v = *(const u32x4*)(QN + tokq * 1024 + h * 128 + dq * 32 + i * 8);
            q[i * 8 + 0] = bflo(v.x) * C; q[i * 8 + 1] = bfhi(v.x) * C; q[i * 8 + 2] = bflo(v.y) * C; q[i * 8 + 3] = bfhi(v.y) * C;
            q[i * 8 + 4] = bflo(v.z) * C; q[i * 8 + 5] = bfhi(v.z) * C; q[i * 8 + 6] = bflo(v.w) * C; q[i * 8 + 7] = bfhi(v.w) * C; }
#pragma unroll
        for (int i = 0; i < 32; ++i) o[i] = 0.f;
        float mrun = -1e30f, lrun = 0.f;
        for (int kt = 0; kt < S / 64; ++kt) {
            __syncthreads();
            {
                const int key = tid >> 3, ch = tid & 7;
                const size_t tk = ((size_t)b * S + kt * 64 + key) * 256 + kvh * 128 + ch * 16;
                *(LAS u32x4*)(Ks + key * 128 + ch * 16) = *(const u32x4*)(KN + tk); *(LAS u32x4*)(Ks + key * 128 + ch * 16 + 8) = *(const u32x4*)(KN + tk + 8);
                *(LAS u32x4*)(Vs + key * 128 + ch * 16) = *(const u32x4*)(VB + tk); *(LAS u32x4*)(Vs + key * 128 + ch * 16 + 8) = *(const u32x4*)(VB + tk + 8);
            }
            __syncthreads();
            for (int j = 0; j < 64; ++j) {
                float s = 0.f;
#pragma unroll
                for (int i = 0; i < 4; ++i) { const u32x4 v = *(const LAS u32x4*)(Ks + j * 128 + dq * 32 + i * 8);
                    s = fmaf(q[i * 8 + 0], bflo(v.x), s); s = fmaf(q[i * 8 + 1], bfhi(v.x), s); s = fmaf(q[i * 8 + 2], bflo(v.y), s); s = fmaf(q[i * 8 + 3], bfhi(v.y), s);
                    s = fmaf(q[i * 8 + 4], bflo(v.z), s); s = fmaf(q[i * 8 + 5], bfhi(v.z), s); s = fmaf(q[i * 8 + 6], bflo(v.w), s); s = fmaf(q[i * 8 + 7], bfhi(v.w), s); }
                s += __shfl_xor(s, 1); s += __shfl_xor(s, 2);
                const float mn = fmaxf(mrun, s), al = __builtin_amdgcn_exp2f(mrun - mn), pe = __builtin_amdgcn_exp2f(s - mn);
                mrun = mn; lrun = lrun * al + pe;
#pragma unroll
                for (int i = 0; i < 4; ++i) { const u32x4 v = *(const LAS u32x4*)(Vs + j * 128 + dq * 32 + i * 8);
                    o[i * 8 + 0] = fmaf(pe, bflo(v.x), o[i * 8 + 0] * al); o[i * 8 + 1] = fmaf(pe, bfhi(v.x), o[i * 8 + 1] * al);
                    o[i * 8 + 2] = fmaf(pe, bflo(v.y), o[i * 8 + 2] * al); o[i * 8 + 3] = fmaf(pe, bfhi(v.y), o[i * 8 + 3] * al);
                    o[i * 8 + 4] = fmaf(pe, bflo(v.z), o[i * 8 + 4] * al); o[i * 8 + 5] = fmaf(pe, bfhi(v.z), o[i * 8 + 5] * al);
                    o[i * 8 + 6] = fmaf(pe, bflo(v.w), o[i * 8 + 6] * al); o[i * 8 + 7] = fmaf(pe, bfhi(v.w), o[i * 8 + 7] * al); }
            }
        }
        const float rl = 1.f / lrun;
#pragma unroll
        for (int i = 0; i < 4; ++i) { u32x4 w;
            w.x = pk2(o[i * 8 + 0] * rl, o[i * 8 + 1] * rl); w.y = pk2(o[i * 8 + 2] * rl, o[i * 8 + 3] * rl); w.z = pk2(o[i * 8 + 4] * rl, o[i * 8 + 5] * rl); w.w = pk2(o[i * 8 + 6] * rl, o[i * 8 + 7] * rl);
            *(u32x4*)(AO + tokq * 1024 + h * 128 + dq * 32 + i * 8) = w; }
    }
}

namespace attn {
typedef unsigned short bf16;
constexpr int   D = 128, NW = 8, QBLK = 32, KVBLK = 64;
constexpr float SCALE = 0.088388347648318440f;
constexpr float THR = 8.f;
constexpr int SDEPTH = 2;
constexpr int LDQ = 1024, LDK = 256, LDO = 1024;
constexpr size_t SHM_V = KVBLK * D * 2, SHM_K = KVBLK * D * 2, SHM_ATTN = 2 * SHM_V + 2 * SHM_K + NW * 64 * 4;
using bf16x8 = __attribute__((ext_vector_type(8))) short;
using s16x4  = __attribute__((ext_vector_type(4))) short;
using f32x16 = __attribute__((ext_vector_type(16))) float;
using f32x8  = __attribute__((ext_vector_type(8))) float;
using u32x4  = __attribute__((ext_vector_type(4))) unsigned;
#define KSWZ(row, colB) ((row) * 256 + ((colB) ^ (((row) & 7) << 4)))
#define SBAR() __builtin_amdgcn_sched_barrier(0)
__device__ __forceinline__ int crow(int r, int hi) { return (r & 3) + 8 * (r >> 2) + 4 * hi; }
__device__ __forceinline__ unsigned cvtpk(float lo, float hi) {
  unsigned r; asm volatile("v_cvt_pk_bf16_f32 %0, %1, %2" : "=v"(r) : "v"(lo), "v"(hi)); return r;
}
template <typename TIn> struct Stage;
template <> struct Stage<bf16>  { using T = bf16x8;
  __device__ static __forceinline__ T ld8(const bf16* p) { return *reinterpret_cast<const bf16x8*>(p); }
  __device__ static __forceinline__ bf16x8 tobf(T x) { return x; } };
template <> struct Stage<float> { using T = f32x8;
  __device__ static __forceinline__ T ld8(const float* p) { return *reinterpret_cast<const f32x8*>(p); }
  __device__ static __forceinline__ bf16x8 tobf(T x) {
    u32x4 w = {cvtpk(x[0], x[1]), cvtpk(x[2], x[3]), cvtpk(x[4], x[5]), cvtpk(x[6], x[7])}; return *reinterpret_cast<bf16x8*>(&w); } };

__device__ __forceinline__ void partialSM(f32x16& p0, f32x16& p1, float& m_reg, float& mn, float& alpha) {
  constexpr float C = SCALE * 1.4426950408889634f;
  float pmax = p0[0]; for (int r = 1; r < 16; ++r) pmax = fmaxf(pmax, p0[r]); for (int r = 0; r < 16; ++r) pmax = fmaxf(pmax, p1[r]);
  { auto rr = __builtin_amdgcn_permlane32_swap(__float_as_uint(pmax), __float_as_uint(pmax), false, false);
    pmax = fmaxf(__uint_as_float(rr[0]), __uint_as_float(rr[1])); }
  if (__builtin_expect(__all(pmax - m_reg <= THR / SCALE), 1)) { mn = m_reg; alpha = 1.f; }
  else { mn = fmaxf(m_reg, pmax); alpha = __builtin_amdgcn_exp2f((m_reg - mn) * C); m_reg = mn; }
  float mnC = -mn * C;
  for (int r = 0; r < 16; ++r) p0[r] = fmaf(p0[r], C, mnC); for (int r = 0; r < 16; ++r) p1[r] = fmaf(p1[r], C, mnC);
  for (int r = 0; r < 16; ++r) p0[r] = __builtin_amdgcn_exp2f(p0[r]);
}
__device__ __forceinline__ void finishSM(f32x16& p0, f32x16& p1, float alpha, float& l_reg, bf16x8& pa0, bf16x8& pa1, bf16x8& pa2, bf16x8& pa3) {
  for (int r = 0; r < 16; ++r) p1[r] = __builtin_amdgcn_exp2f(p1[r]);
  float ps = 0; for (int r = 0; r < 16; ++r) ps += p0[r]; for (int r = 0; r < 16; ++r) ps += p1[r];
  { auto rr = __builtin_amdgcn_permlane32_swap(__float_as_uint(ps), __float_as_uint(ps), false, false);
    ps = __uint_as_float(rr[0]) + __uint_as_float(rr[1]); }
  l_reg = l_reg * alpha + ps;
#define PK4(P, BASE, OUT) do { unsigned a0 = cvtpk(P[BASE + 0], P[BASE + 1]), a1 = cvtpk(P[BASE + 2], P[BASE + 3]);   \
    unsigned b0 = cvtpk(P[BASE + 4], P[BASE + 5]), b1 = cvtpk(P[BASE + 6], P[BASE + 7]);                              \
    auto r0 = __builtin_amdgcn_permlane32_swap(a0, b0, false, false); auto r1 = __builtin_amdgcn_permlane32_swap(a1, b1, false, false); \
    u32x4 w = {r0[0], r1[0], r0[1], r1[1]}; OUT = *reinterpret_cast<bf16x8*>(&w); } while (0)
  PK4(p0, 0, pa0); PK4(p0, 8, pa1); PK4(p1, 0, pa2); PK4(p1, 8, pa3);
#undef PK4
}
__device__ __forceinline__ void qkt(f32x16& p0, f32x16& p1, const bf16* Ks, const bf16x8* qr, int r32, int hi) {
  p0 = f32x16{}; p1 = f32x16{};
  for (int d0 = 0; d0 < 8; ++d0) { int cb = (d0 * 16 + hi * 8) * 2;
    bf16x8 b0 = *reinterpret_cast<const bf16x8*>((const char*)Ks + KSWZ(r32, cb));
    bf16x8 b1 = *reinterpret_cast<const bf16x8*>((const char*)Ks + KSWZ(32 + r32, cb));
    p0 = __builtin_amdgcn_mfma_f32_32x32x16_bf16(b0, qr[d0], p0, 0, 0, 0);
    p1 = __builtin_amdgcn_mfma_f32_32x32x16_bf16(b1, qr[d0], p1, 0, 0, 0); }
}
__device__ __forceinline__ int v_st(int k, int c) { const int kk = (k & ~0xC) | ((k & 4) << 1) | ((k & 8) >> 1); return ((kk >> 3) * 4 + (c >> 5)) * 512 + ((kk & 7) * 32 + (c & 31)) * 2; }
__device__ __forceinline__ int v_rd_base(int lane) { return ((lane & 3) << 3) | (((lane >> 2) & 3) << 6) | (((lane >> 4) & 1) << 5) | (((lane >> 5) & 1) << 8); }
constexpr int v_rd_off(int d0, int ks, int half) { return d0 * 512 + ks * 4096 + half * 2048; }
template <int OFF> __device__ __forceinline__ s16x4 tr_read(int vb) {
  s16x4 r; asm volatile("ds_read_b64_tr_b16 %0, %1 offset:%2" : "=&v"(r) : "v"(vb), "i"(OFF) : "memory"); return r;
}
template <int D0> __device__ __forceinline__ void pv_one(f32x16& od, int vb, bf16x8 pa0, bf16x8 pa1, bf16x8 pa2, bf16x8 pa3) {
  const s16x4 l0 = tr_read<v_rd_off(D0, 0, 0)>(vb), h0 = tr_read<v_rd_off(D0, 0, 1)>(vb), l1 = tr_read<v_rd_off(D0, 1, 0)>(vb), h1 = tr_read<v_rd_off(D0, 1, 1)>(vb);
  const s16x4 l2 = tr_read<v_rd_off(D0, 2, 0)>(vb), h2 = tr_read<v_rd_off(D0, 2, 1)>(vb), l3 = tr_read<v_rd_off(D0, 3, 0)>(vb), h3 = tr_read<v_rd_off(D0, 3, 1)>(vb);
  asm volatile("s_waitcnt lgkmcnt(0)" ::: "memory"); SBAR();
#define PK(L, H) (bf16x8){L[0], L[1], L[2], L[3], H[0], H[1], H[2], H[3]}
  od = __builtin_amdgcn_mfma_f32_32x32x16_bf16(pa0, PK(l0, h0), od, 0, 0, 0);
  od = __builtin_amdgcn_mfma_f32_32x32x16_bf16(pa1, PK(l1, h1), od, 0, 0, 0);
  od = __builtin_amdgcn_mfma_f32_32x32x16_bf16(pa2, PK(l2, h2), od, 0, 0, 0);
  od = __builtin_amdgcn_mfma_f32_32x32x16_bf16(pa3, PK(l3, h3), od, 0, 0, 0);
#undef PK
}
__device__ __forceinline__ void pv_d0(f32x16* o, int vb, bf16x8 pa0, bf16x8 pa1, bf16x8 pa2, bf16x8 pa3) {
  pv_one<0>(o[0], vb, pa0, pa1, pa2, pa3); pv_one<1>(o[1], vb, pa0, pa1, pa2, pa3); pv_one<2>(o[2], vb, pa0, pa1, pa2, pa3); pv_one<3>(o[3], vb, pa0, pa1, pa2, pa3);
}

template <typename TQ>
__device__ __forceinline__ void attn_dense_body(const TQ* __restrict__ Qb, const bf16* __restrict__ Kh, const bf16* __restrict__ Vh,
                                                bf16* __restrict__ Ob, int seq, char* lds) {
  using St = Stage<bf16>; using SQ = Stage<TQ>;
  const int tid = threadIdx.x, wid = tid >> 6, lane = tid & 63, r32 = lane & 31, hi = lane >> 5;
  bf16* V_lds = (bf16*)lds; bf16* K_lds = (bf16*)(lds + 2 * SHM_V);
  float* ws = (float*)(lds + 2 * SHM_V + 2 * SHM_K) + wid * 64; float* li_l = ws; float* al_l = ws + 32;
  float m_reg = -1e30f, l_reg = 0; f32x16 o[4] = {}; bf16x8 qr[8];
  const TQ* Qw = Qb + (long)(wid * QBLK + r32) * LDQ + hi * 8;
#pragma unroll
  for (int d0 = 0; d0 < 8; ++d0) qr[d0] = SQ::tobf(SQ::ld8(Qw + d0 * 16));
  const int sr = tid >> 4, sc = (tid & 15) * 8, vst0 = v_st(sr, sc), vst1 = v_st(32 + sr, sc);
  const int vb0 = (int)(uintptr_t)V_lds + v_rd_base(lane);
  struct { typename St::T vs0, vs1, ks0, ks1; } sr_[SDEPTH];
#define SLOAD(i, k0) do { sr_[i].vs0 = St::ld8(&Vh[(long)((k0) + sr) * LDK + sc]); sr_[i].vs1 = St::ld8(&Vh[(long)((k0) + 32 + sr) * LDK + sc]); \
    sr_[i].ks0 = St::ld8(&Kh[(long)((k0) + sr) * LDK + sc]); sr_[i].ks1 = St::ld8(&Kh[(long)((k0) + 32 + sr) * LDK + sc]); } while (0)
#define SWRITE(b, i) do { *(bf16x8*)((char*)V_lds + (b) * SHM_V + vst0) = St::tobf(sr_[i].vs0);          \
    *(bf16x8*)((char*)V_lds + (b) * SHM_V + vst1) = St::tobf(sr_[i].vs1); int kc = sc * 2;               \
    *(bf16x8*)((char*)K_lds + (b) * SHM_K + KSWZ(sr, kc)) = St::tobf(sr_[i].ks0);                       \
    *(bf16x8*)((char*)K_lds + (b) * SHM_K + KSWZ(32 + sr, kc)) = St::tobf(sr_[i].ks1); } while (0)
#define SWAIT() do { if constexpr (SDEPTH == 2) asm volatile("s_waitcnt vmcnt(4)" ::: "memory"); else asm volatile("s_waitcnt vmcnt(0)" ::: "memory"); } while (0)
#define RESC(a) do { if (__any((a) < 1.f)) { if (hi == 0) al_l[r32] = (a); asm volatile("s_waitcnt lgkmcnt(0)" ::: "memory"); \
    for (int d = 0; d < 4; ++d) for (int r = 0; r < 16; ++r) o[d][r] *= al_l[crow(r, hi)]; } } while (0)
  f32x16 pA0, pA1, pB0, pB1; float mnA, mnB, alA, alB; bf16x8 pa0, pa1, pa2, pa3; const int NT = seq / KVBLK;
  constexpr int SE = 0, SO = SDEPTH - 1;
  SLOAD(SE, 0); asm volatile("s_waitcnt vmcnt(0)" ::: "memory"); SWRITE(0, SE); __syncthreads();
  qkt(pA0, pA1, K_lds, qr, r32, hi); partialSM(pA0, pA1, m_reg, mnA, alA);
  SLOAD(SO, KVBLK); if constexpr (SDEPTH == 2) { if (2 < NT) SLOAD(SE, 2 * KVBLK); }
  SWAIT(); SWRITE(1, SO); __syncthreads();
  for (int j = 1; j + 1 < NT; j += 2) {
    SBAR(); qkt(pB0, pB1, (bf16*)((char*)K_lds + SHM_K), qr, r32, hi);
    finishSM(pA0, pA1, alA, l_reg, pa0, pa1, pa2, pa3); SBAR();
    SLOAD(SO, (j + SDEPTH) * KVBLK); SBAR();
    pv_d0(o, vb0, pa0, pa1, pa2, pa3); partialSM(pB0, pB1, m_reg, mnB, alB);
    __syncthreads(); SWAIT(); SWRITE(0, SE);
    RESC(alB); __syncthreads();
    SBAR(); qkt(pA0, pA1, K_lds, qr, r32, hi);
    finishSM(pB0, pB1, alB, l_reg, pa0, pa1, pa2, pa3); SBAR();
    if (SDEPTH == 1 || j + 3 < NT) SLOAD(SE, (j + 1 + SDEPTH) * KVBLK); SBAR();
    pv_d0(o, vb0 + (int)SHM_V, pa0, pa1, pa2, pa3); partialSM(pA0, pA1, m_reg, mnA, alA);
    __syncthreads(); SWAIT(); SWRITE(1, SO);
    RESC(alA); __syncthreads();
  }
  SBAR(); qkt(pB0, pB1, (bf16*)((char*)K_lds + SHM_K), qr, r32, hi);
  finishSM(pA0, pA1, alA, l_reg, pa0, pa1, pa2, pa3); SBAR();
  pv_d0(o, vb0, pa0, pa1, pa2, pa3); partialSM(pB0, pB1, m_reg, mnB, alB);
  __syncthreads(); RESC(alB);
  finishSM(pB0, pB1, alB, l_reg, pa0, pa1, pa2, pa3); SBAR();
  pv_d0(o, vb0 + (int)SHM_V, pa0, pa1, pa2, pa3);
  if (hi == 0) li_l[r32] = l_reg; asm volatile("s_waitcnt lgkmcnt(0)" ::: "memory");
  float rli[16];
#pragma unroll
  for (int r = 0; r < 16; ++r) rli[r] = __builtin_amdgcn_rcpf(li_l[crow(r, hi)]);
  bf16* Ow = Ob + (long)(wid * QBLK) * LDO;
#pragma unroll
  for (int r = 0; r < 16; ++r) { int orow = crow(r, hi);
    for (int d0 = 0; d0 < 4; ++d0) Ow[(long)orow * LDO + d0 * 32 + r32] = (bf16)f2bf(o[d0][r] * rli[r]); }
#undef SLOAD
#undef SWRITE
#undef SWAIT
#undef RESC
}
}

__device__ __forceinline__ void phase_attn(const Params& p, const Ctx& c, char* lds_generic) {
    unsigned char* ws = p.ws;
    const bf16_t* QN = (const bf16_t*)(ws + WS_QN); const bf16_t* KN = (const bf16_t*)(ws + WS_KN); const bf16_t* VB = (const bf16_t*)(ws + WS_VB); bf16_t* AO = (bf16_t*)(ws + WS_AO);
    for (int item = c.bid; item < 512; item += c.G) {
        const int b = item >> 8, h = (item >> 5) & 7, qb = item & 31, kvh = h >> 2;
        const size_t q0 = ((size_t)b * S + qb * 256) * 1024 + h * 128, k0 = (size_t)b * S * 256 + kvh * 128;
        attn::attn_dense_body<attn::bf16>(QN + q0, KN + k0, VB + k0, AO + q0, S, lds_generic);
        __syncthreads();
    }
}

struct EpiT1 { bf16_t* T1; const bf16_t* P; const float* RSTD; int n0;
    __device__ __forceinline__ void operator()(int r, int cl, float a, float) const { const int col = n0 + cl;
        T1[(size_t)r * 1024 + col] = (bf16_t)f2bf(a * RSTD[r] * sigmoidf_(bf2f(P[(size_t)r * NPROJ + PG + col]))); } };
struct EpiT2 { bf16_t* MG; const bf16_t* T1; const bf16_t* P; int n0;
    __device__ __forceinline__ void operator()(int r, int cl, float a, float) const { const int col = n0 + cl;
        MG[(size_t)r * 1024 + col] = (bf16_t)f2bf(bf2f(T1[(size_t)r * 1024 + col]) + a * sigmoidf_(bf2f(P[(size_t)r * NPROJ + PG + 1024 + col]))); } };
struct EpiT3 { float* X1; const float* x; int n0;
    __device__ __forceinline__ void operator()(int r, int cl, float a, float) const { const size_t o = (size_t)r * 1024 + n0 + cl; X1[o] = x[o] + a; } };
template <int WHICH> __device__ __forceinline__ void phase_tail_naive(const Params& p, const Ctx& c) {
    unsigned char* ws = p.ws;
    for (int it = c.bid; it < (M / 128) * 16; it += c.G) {
        const int mt = it >> 4, nt = it & 15;
        if (WHICH == 0) ngemm_tile<false>(ARowPlain{(const bf16_t*)(ws + WS_YZ), 1024}, (const bf16_t*)(ws + WS_WST) + (size_t)nt * 64 * 1024, nullptr, 1024, mt * 128,
                                          EpiT1{(bf16_t*)(ws + WS_T1), (const bf16_t*)(ws + WS_P), (const float*)(ws + WS_RSTD), nt * 64}, (LAS float*)c.lds, c.tid);
        if (WHICH == 1) ngemm_tile<false>(ARowPlain{(const bf16_t*)(ws + WS_AO), 1024}, (const bf16_t*)(ws + WS_WAT) + (size_t)nt * 64 * 1024, nullptr, 1024, mt * 128,
                                          EpiT2{(bf16_t*)(ws + WS_MG), (const bf16_t*)(ws + WS_T1), (const bf16_t*)(ws + WS_P), nt * 64}, (LAS float*)c.lds, c.tid);
        if (WHICH == 2) ngemm_tile<false>(ARowPlain{(const bf16_t*)(ws + WS_MG), 1024}, (const bf16_t*)(ws + WS_WOT) + (size_t)nt * 64 * 1024, nullptr, 1024, mt * 128,
                                          EpiT3{(float*)(ws + WS_X1), p.in[0], nt * 64}, (LAS float*)c.lds, c.tid);
    }
}

__device__ __forceinline__ void phase_router(const Params& p, const Ctx& c) {
    unsigned char* ws = p.ws;
    LAS float* wT = (LAS float*)c.lds;
    LAS int* tokE = (LAS int*)(c.lds + LDS_CTL + 512);
    LAS float* tokW = (LAS float*)(c.lds + LDS_CTL + 512 + 1024);
    LAS int* lcnt = (LAS int*)(c.lds + LDS_CTL + 512 + 2048);
    LAS int* lbase = lcnt + 32;
    LAS int* lrank = lbase + 32;
    const float* X1 = (const float*)(ws + WS_X1); bf16_t* H2 = (bf16_t*)(ws + WS_H2);
    int* CNT = (int*)(ws + WS_CTL); int* TOKES = (int*)(ws + WS_TOKES); float* TOKW = (float*)(ws + WS_TOKW); int* LIST = (int*)(ws + WS_LIST);
    const int tid = c.tid, lane = c.lane;
    __syncthreads();
    { const f32x4* src = (const f32x4*)(ws + WS_WRT); for (int idx = tid; idx < 8192; idx += 512) ((LAS f32x4*)wT)[idx] = src[idx]; }
    __syncthreads();
    f32x4 gv[4];
#pragma unroll
    for (int j = 0; j < 4; ++j) gv[j] = ((const f32x4*)p.in[16])[lane + 64 * j];
    const float bias_e = p.in[18][lane & 31];
    for (int blk = c.bid; blk < M / 64; blk += c.G) {
        if (tid < 32) lcnt[tid] = 0;
        for (int pr = 0; pr < 4; ++pr) {
            const int tl = c.wave * 8 + pr * 2;
            const size_t tokA = (size_t)blk * 64 + tl;
            f32x4 hA[4], hB[4];
            {
                const f32x4* xa = (const f32x4*)(X1 + tokA * 1024) + lane; const f32x4* xb = xa + 256;
                float sa = 0.f, sb = 0.f;
#pragma unroll
                for (int j = 0; j < 4; ++j) { hA[j] = xa[64 * j]; hB[j] = xb[64 * j];
                    sa += (hA[j].x * hA[j].x + hA[j].y * hA[j].y) + (hA[j].z * hA[j].z + hA[j].w * hA[j].w);
                    sb += (hB[j].x * hB[j].x + hB[j].y * hB[j].y) + (hB[j].z * hB[j].z + hB[j].w * hB[j].w); }
                const float ra = rsqrtf(wave_sum(sa) * (1.f / 1024.f) + EPS), rb = rsqrtf(wave_sum(sb) * (1.f / 1024.f) + EPS);
                u32x2* oa = (u32x2*)(H2 + tokA * 1024) + lane; u32x2* ob = oa + 256;
#pragma unroll
                for (int j = 0; j < 4; ++j) { hA[j] = hA[j] * ra * gv[j]; hB[j] = hB[j] * rb * gv[j];
                    u32x2 w; w.x = pk2(hA[j].x, hA[j].y); w.y = pk2(hA[j].z, hA[j].w); oa[64 * j] = w;
                    w.x = pk2(hB[j].x, hB[j].y); w.y = pk2(hB[j].z, hB[j].w); ob[64 * j] = w; }
            }
            float la = -INFINITY, lb = -INFINITY;
#pragma unroll 1
            for (int e = 0; e < 32; ++e) {
                float a = 0.f, b = 0.f;
#pragma unroll
                for (int j = 0; j < 4; ++j) { const f32x4 w = *(const LAS f32x4*)&wT[e * 1024 + 256 * j + 4 * lane];
                    a = fmaf(hA[j].x, w.x, a); a = fmaf(hA[j].y, w.y, a); a = fmaf(hA[j].z, w.z, a); a = fmaf(hA[j].w, w.w, a);
                    b = fmaf(hB[j].x, w.x, b); b = fmaf(hB[j].y, w.y, b); b = fmaf(hB[j].z, w.z, b); b = fmaf(hB[j].w, w.w, b); }
                a = wave_sum(a); b = wave_sum(b);
                if (lane == e) { la = a + bias_e; lb = b + bias_e; }
            }
            const int my_e = lane < 32 ? lane : 64;
#pragma unroll
            for (int t2 = 0; t2 < 2; ++t2) {
                float val = t2 ? lb : la;
                int se[4]; float sv[4];
#pragma unroll
                for (int k = 0; k < 4; ++k) {
                    const float mx = wave_max(val);
                    const int sel = wave_min_i(val == mx ? my_e : 64);
                    se[k] = sel; sv[k] = mx;
                    if (my_e == sel) val = -INFINITY;
                }
                const float e1 = __expf(sv[1] - sv[0]), e2 = __expf(sv[2] - sv[0]), e3 = __expf(sv[3] - sv[0]);
                const float inv = 1.f / (1.f + e1 + e2 + e3);
                if (lane == 0) {
                    const int t = tl + t2;
                    tokE[t * 4 + 0] = se[0]; tokE[t * 4 + 1] = se[1]; tokE[t * 4 + 2] = se[2]; tokE[t * 4 + 3] = se[3];
                    tokW[t * 4 + 0] = inv; tokW[t * 4 + 1] = e1 * inv; tokW[t * 4 + 2] = e2 * inv; tokW[t * 4 + 3] = e3 * inv;
                }
            }
        }
        __syncthreads();
        if (tid < 256) lrank[tid] = atomicAdd((int*)&lcnt[tokE[tid]], 1);
        __syncthreads();
        if (tid < 32) lbase[tid] = lcnt[tid] ? atomicAdd(&CNT[tid], lcnt[tid]) : 0;
        __syncthreads();
        if (tid < 256) {
            const int e = tokE[tid], slot = lbase[e] + lrank[tid], tok = blk * 64 + (tid >> 2);
            LIST[e * 16384 + slot] = tok; TOKES[tok * 4 + (tid & 3)] = (e << 16) | slot; TOKW[tok * 4 + (tid & 3)] = tokW[tid];
        }
        __syncthreads();
    }
}

__device__ __forceinline__ void load_offs(const Params& p, const Ctx& c, LAS int*& offs, LAS int*& cnt) {
    offs = (LAS int*)(c.lds + LDS_CTL); cnt = offs + 40;
    __syncthreads();
    if (c.tid == 0) {
        const int* CNT = (const int*)(p.ws + WS_CTL); int run = 0;
        for (int e = 0; e < 32; ++e) { const int n = __hip_atomic_load(CNT + e, __ATOMIC_RELAXED, __HIP_MEMORY_SCOPE_AGENT); cnt[e] = n; offs[e] = run; run += (n + 255) & ~255; }
        offs[32] = run;
    }
    __syncthreads();
}
__device__ __forceinline__ int find_expert(const LAS int* offs, int row) { int e = 0; while (e < 31 && row >= offs[e + 1]) ++e; return e; }

__device__ __forceinline__ void phase_gather(const Params& p, const Ctx& c) {
    LAS int* offs; LAS int* cnt; load_offs(p, c, offs, cnt);
    const bf16_t* H2 = (const bf16_t*)(p.ws + WS_H2); bf16_t* XB = (bf16_t*)(p.ws + WS_XB); const int* LIST = (const int*)(p.ws + WS_LIST);
    const int gw = c.bid * 8 + c.wave, NGW = c.G * 8, total = offs[32];
    for (int row = gw; row < total; row += NGW) {
        const int e = find_expert(offs, row), slot = row - offs[e];
        u32x4 v0 = (u32x4){0u, 0u, 0u, 0u}, v1 = v0;
        if (slot < cnt[e]) { const int tok = LIST[e * 16384 + slot]; const u32x4* s = (const u32x4*)(H2 + (size_t)tok * 1024); v0 = s[c.lane]; v1 = s[c.lane + 64]; }
        u32x4* d = (u32x4*)(XB + (size_t)row * 1024); d[c.lane] = v0; d[c.lane + 64] = v1;
    }
}

struct EpiAct { bf16_t* ACT; const float* b1; int j0;
    __device__ __forceinline__ void operator()(int r, int cl, float g, float u) const { const int j = j0 + cl;
        g = fminf(g + b1[j], 7.f); u = fminf(fmaxf(u + b1[1024 + j], -7.f), 7.f);
        ACT[(size_t)r * 1024 + j] = (bf16_t)f2bf(g * sigmoidf_(1.702f * g) * (u + 1.f)); } };
struct EpiY { bf16_t* YB; const float* b2; int n0;
    __device__ __forceinline__ void operator()(int r, int cl, float a, float) const { const int col = n0 + cl; YB[(size_t)r * 1024 + col] = (bf16_t)f2bf(a + b2[col]); } };
template <int WHICH> __device__ __forceinline__ void phase_moe_naive(const Params& p, const Ctx& c) {
    LAS int* offs; LAS int* cnt; load_offs(p, c, offs, cnt);
    unsigned char* ws = p.ws;
    const int nrt = offs[32] / 128;
    for (int it = c.bid; it < nrt * 16; it += c.G) {
        const int rt = it >> 4, ct = it & 15, row0 = rt * 128, e = find_expert(offs, row0);
        if (WHICH == 0) {
            const int j0 = ct * 64, nt = j0 >> 7, jj = j0 & 127;
            const bf16_t* Wg = (const bf16_t*)(ws + WS_W1T) + ((size_t)e * 2048 + nt * 256 + jj) * 1024;
            ngemm_tile<true>(ARowPlain{(const bf16_t*)(ws + WS_XB), 1024}, Wg, Wg + (size_t)128 * 1024, 1024, row0,
                             EpiAct{(bf16_t*)(ws + WS_ACT), p.in[20] + (size_t)e * 2048, j0}, (LAS float*)c.lds, c.tid);
        } else {
            const bf16_t* W = (const bf16_t*)(ws + WS_W2T) + ((size_t)e * 1024 + ct * 64) * 1024;
            ngemm_tile<false>(ARowPlain{(const bf16_t*)(ws + WS_ACT), 1024}, W, nullptr, 1024, row0,
                              EpiY{(bf16_t*)(ws + WS_YB), p.in[22] + (size_t)e * 1024, ct * 64}, (LAS float*)c.lds, c.tid);
        }
    }
}


__device__ __forceinline__ void phase_gemm1(const Params& p, const Ctx& c) {
    pg8::Gemm g{(const bf16_t*)(p.ws + WS_H), (const bf16_t*)(p.ws + WS_WINT), M, NPROJ, 1024};
    pg8::StaticOrder S; S.init(M, NPROJ, c.G, c.bid);
    pg8::EpiStore E{(bf16_t*)(p.ws + WS_P), NPROJ};
    pg8::gemm_phase<pg8::EpiStore, pg8::StaticOrder, true, true>(c.lds, g, S, E);
}
template <int WHICH> __device__ __forceinline__ void phase_tail(const Params& p, const Ctx& c) {
    unsigned char* ws = p.ws;
    pg8::StaticOrder S; S.init(M, 1024, c.G, c.bid);
    if (WHICH == 0) { pg8::Gemm g{(const bf16_t*)(ws + WS_YZ), (const bf16_t*)(ws + WS_WST), M, 1024, 1024};
        pg8::EpiT1 E{(bf16_t*)(ws + WS_T1), (const bf16_t*)(ws + WS_P) + PG, NPROJ, (const float*)(ws + WS_RSTD)};
        pg8::gemm_phase<pg8::EpiT1, pg8::StaticOrder, true, true>(c.lds, g, S, E); }
    if (WHICH == 1) { pg8::Gemm g{(const bf16_t*)(ws + WS_AO), (const bf16_t*)(ws + WS_WAT), M, 1024, 1024};
        pg8::EpiT2 E{(bf16_t*)(ws + WS_MG), (const bf16_t*)(ws + WS_T1), (const bf16_t*)(ws + WS_P) + PG + 1024, NPROJ};
        pg8::gemm_phase<pg8::EpiT2, pg8::StaticOrder, true, true>(c.lds, g, S, E); }
    if (WHICH == 2) { pg8::Gemm g{(const bf16_t*)(ws + WS_MG), (const bf16_t*)(ws + WS_WOT), M, 1024, 1024};
        pg8::EpiT3 E{(float*)(ws + WS_X1), p.in[0]};
        pg8::gemm_phase<pg8::EpiT3, pg8::StaticOrder, true, true>(c.lds, g, S, E); }
}
template <int WHICH> __device__ __forceinline__ void phase_moe(const Params& p, const Ctx& c) {
    LAS int* offs; LAS int* cnt; load_offs(p, c, offs, cnt);
    unsigned char* ws = p.ws;
    if (WHICH == 0) { pg8::Gemm g{(const bf16_t*)(ws + WS_XB), (const bf16_t*)(ws + WS_W1T), ROWS_MAX, 32 * 2048, 1024};
        pg8::MoeOrder S{offs, 8, c.G, c.bid, offs[32] / 256};
        pg8::EpiAct E{(bf16_t*)(ws + WS_ACT), p.in[20]};
        pg8::gemm_phase<pg8::EpiAct, pg8::MoeOrder, true, true>(c.lds, g, S, E); }
    else { pg8::Gemm g{(const bf16_t*)(ws + WS_ACT), (const bf16_t*)(ws + WS_W2T), ROWS_MAX, 32 * 1024, 1024};
        pg8::MoeOrder S{offs, 4, c.G, c.bid, offs[32] / 256};
        pg8::EpiY E{(bf16_t*)(ws + WS_YB), p.in[22]};
        pg8::gemm_phase<pg8::EpiY, pg8::MoeOrder, true, true>(c.lds, g, S, E); }
}

__device__ __forceinline__ void phase_combine(const Params& p, const Ctx& c) {
    LAS int* offs; LAS int* cnt; load_offs(p, c, offs, cnt);
    unsigned char* ws = p.ws;
    const float* X1 = (const float*)(ws + WS_X1); const bf16_t* YB = (const bf16_t*)(ws + WS_YB);
    const int* TOKES = (const int*)(ws + WS_TOKES); const float* TOKW = (const float*)(ws + WS_TOKW);
    const int gw = c.bid * 8 + c.wave, NGW = c.G * 8, lane = c.lane;
    f32x4 gv[4];
#pragma unroll
    for (int j = 0; j < 4; ++j) gv[j] = ((const f32x4*)p.in[23])[lane + 64 * j];
    for (int m = gw; m < M; m += NGW) {
        f32x4 v[4];
        const f32x4* xr = (const f32x4*)(X1 + (size_t)m * 1024) + lane;
#pragma unroll
        for (int j = 0; j < 4; ++j) v[j] = xr[64 * j];
#pragma unroll
        for (int k = 0; k < 4; ++k) {
            const int es = TOKES[m * 4 + k]; const float w = TOKW[m * 4 + k];
            const int row = offs[es >> 16] + (es & 0xffff);
            const u32x2* yr = (const u32x2*)(YB + (size_t)row * 1024) + lane;
#pragma unroll
            for (int j = 0; j < 4; ++j) { const u32x2 y = yr[64 * j];
                v[j].x = fmaf(w, bflo(y.x), v[j].x); v[j].y = fmaf(w, bfhi(y.x), v[j].y); v[j].z = fmaf(w, bflo(y.y), v[j].z); v[j].w = fmaf(w, bfhi(y.y), v[j].w); }
        }
        float s = 0.f;
#pragma unroll
        for (int j = 0; j < 4; ++j) s += (v[j].x * v[j].x + v[j].y * v[j].y) + (v[j].z * v[j].z + v[j].w * v[j].w);
        const float rstd = rsqrtf(wave_sum(s) * (1.f / 1024.f) + EPS);
        f32x4* o = (f32x4*)(p.out + (size_t)m * 1024) + lane;
#pragma unroll
        for (int j = 0; j < 4; ++j) o[64 * j] = v[j] * rstd * gv[j];
    }
}

constexpr int NPHASE = 15;
__global__ void __launch_bounds__(512) mega(Params p) {
    extern __shared__ __attribute__((aligned(16))) unsigned char lds_raw[];
    Ctx c; c.tid = threadIdx.x; c.lane = c.tid & 63; c.wave = __builtin_amdgcn_readfirstlane(c.tid >> 6); c.bid = blockIdx.x; c.G = gridDim.x;
    c.lds = (LAS unsigned char*)lds_raw;
    cg::grid_group grid = cg::this_grid();
#define RUN(k, call) if (p.ph_lo <= (k) && (k) < p.ph_hi) { call; if ((k) + 1 < p.ph_hi) grid.sync(); }
    RUN(0, phase_prep(p, c))
    RUN(1, phase_gemm1(p, c))
    RUN(2, phase_conv(p, c))
    RUN(3, phase_ssd_states(p, c))
    RUN(4, phase_ssd_scan(p, c))
    RUN(5, phase_ssd_out(p, c))
    RUN(6, phase_rstd(p, c); phase_attn(p, c, (char*)lds_raw))
    RUN(7, phase_tail<0>(p, c))
    RUN(8, phase_tail<1>(p, c))
    RUN(9, phase_tail<2>(p, c))
    RUN(10, phase_router(p, c))
    RUN(11, phase_gather(p, c))
    RUN(12, phase_moe<0>(p, c))
    RUN(13, phase_moe<1>(p, c))
    RUN(14, phase_combine(p, c))
#undef RUN
}

extern "C" void kernel_launch(void* const* d_in, const int* in_sizes, int n_in, void* d_out, int out_size, void* d_ws, size_t ws_size, hipStream_t stream) {
    static int ok = 0; static int grid_blocks = 0;
    if (ok == 0) {
        if (n_in != 24 || out_size != M * D || ws_size < WS_END) { fprintf(stderr, "kernel_launch: unexpected shapes: n_in %d out %d ws %zu (need %zu)\n", n_in, out_size, ws_size, (size_t)WS_END); ok = -1; return; }
        if (hipFuncSetAttribute((const void*)mega, hipFuncAttributeMaxDynamicSharedMemorySize, LDS_BYTES) != hipSuccess) { fprintf(stderr, "kernel_launch: hipFuncSetAttribute failed\n"); ok = -1; return; }
        int dev = 0, cus = 0, per_cu = 0;
        hipGetDevice(&dev);
        hipDeviceGetAttribute(&cus, hipDeviceAttributeMultiprocessorCount, dev);
        hipOccupancyMaxActiveBlocksPerMultiprocessor(&per_cu, (const void*)mega, 512, LDS_BYTES);
        if (per_cu < 1 || cus < 1) { fprintf(stderr, "kernel_launch: occupancy query gave %d blocks/CU on %d CUs\n", per_cu, cus); ok = -1; return; }
        grid_blocks = cus;
        ok = 1;
    }
    if (ok < 0) return;
    Params p{};
    for (int i = 0; i < 24; ++i) p.in[i] = (const float*)d_in[i];
    p.out = (float*)d_out; p.ws = (unsigned char*)d_ws;
    p.ph_lo = 0; p.ph_hi = NPHASE;
    void* args[] = {&p};
    hipError_t e = hipLaunchCooperativeKernel((const void*)mega, dim3(grid_blocks), dim3(512), args, LDS_BYTES, stream);
    if (e != hipSuccess) fprintf(stderr, "kernel_launch: cooperative launch failed: %s (grid %d)\n", hipGetErrorString(e), grid_blocks);
}
```

```cpp
#include <hip/hip_runtime.h>
#include <hip/hip_cooperative_groups.h>
#include <cstdio>
#include <cstdint>

namespace cg = cooperative_groups;
#define LAS __attribute__((address_space(3)))
typedef unsigned short bf16_t;
typedef unsigned u32x4 __attribute__((ext_vector_type(4)));
typedef unsigned u32x2 __attribute__((ext_vector_type(2)));
typedef float f32x4 __attribute__((ext_vector_type(4)));

constexpr int NB = 2, S = 8192, D = 1024, M = NB * S;
constexpr int NPROJ = 6400;
constexpr int PZ = 0, PXBC = 1024, PQ = 2560, PK = 3584, PV = 3840, PG = 4096, PDT = 6144;
constexpr int ROWS_MAX = 65536 + 32 * 256;
constexpr float EPS = 1e-6f;

constexpr size_t al256(size_t x) { return (x + 255) / 256 * 256; }
constexpr size_t WS_CTL = 0;
constexpr size_t WS_ROPE = 4096;
constexpr size_t WS_WRT = WS_ROPE + 32768;
constexpr size_t WS_WINT = WS_WRT + 131072;
constexpr size_t WS_WST = WS_WINT + (size_t)NPROJ * 1024 * 2;
constexpr size_t WS_WAT = WS_WST + 2097152;
constexpr size_t WS_WOT = WS_WAT + 2097152;
constexpr size_t WS_W1T = WS_WOT + 2097152;
constexpr size_t WS_W2T = WS_W1T + (size_t)32 * 2048 * 1024 * 2;
constexpr size_t WS_X1 = WS_W2T + (size_t)32 * 1024 * 1024 * 2;
constexpr size_t WS_H2 = WS_X1 + (size_t)M * 1024 * 4;
constexpr size_t WS_TOKES = WS_H2 + (size_t)M * 1024 * 2;
constexpr size_t WS_TOKW = WS_TOKES + (size_t)M * 16;
constexpr size_t WS_LIST = WS_TOKW + (size_t)M * 16;
constexpr size_t WS_R = WS_LIST + (size_t)32 * 16384 * 4;
constexpr size_t WS_H = WS_R;
constexpr size_t WS_P = WS_H + (size_t)M * 1024 * 2;
constexpr size_t WS_XT = WS_P + (size_t)M * NPROJ * 2;
constexpr size_t WS_BMR = WS_XT + (size_t)M * 1024 * 2;
constexpr size_t WS_BMT = WS_BMR + (size_t)M * 256 * 2;
constexpr size_t WS_CMR = WS_BMT + (size_t)M * 256 * 2;
constexpr size_t WS_DT = WS_CMR + (size_t)M * 256 * 2;
constexpr size_t WS_ACS = WS_DT + (size_t)2 * M * 16 * 4;
constexpr size_t WS_CDEC = WS_ACS + (size_t)2 * M * 16 * 4;
constexpr size_t WS_ST = WS_CDEC + 16384;
constexpr size_t WS_PREV = WS_ST + (size_t)2 * 2 * 64 * 16 * 8192 * 4;
constexpr size_t WS_YZ = WS_PREV + (size_t)2 * 2 * 64 * 16 * 8192 * 2;
constexpr size_t WS_RSTD = WS_YZ + (size_t)M * 1024 * 2;
constexpr size_t WS_QN = WS_RSTD + (size_t)M * 4;
constexpr size_t WS_KN = WS_QN + (size_t)M * 1024 * 2;
constexpr size_t WS_VB = WS_KN + (size_t)M * 256 * 2;
constexpr size_t WS_AO = WS_VB + (size_t)M * 256 * 2;
constexpr size_t WS_T1 = WS_AO + (size_t)M * 1024 * 2;
constexpr size_t WS_MG = WS_T1 + (size_t)M * 1024 * 2;
constexpr size_t WS_END = WS_MG + (size_t)M * 1024 * 2;
constexpr size_t WS_XB = WS_R;
constexpr size_t WS_ACT = WS_XB + (size_t)ROWS_MAX * 1024 * 2;
constexpr size_t WS_YB = WS_XB;
static_assert(WS_ACT + (size_t)ROWS_MAX * 1024 * 2 <= WS_END, "moe overlay");
static_assert(WS_END <= (size_t)1073741824, "workspace");

constexpr int LDS_BYTES = 147456;
constexpr int LDS_CTL = 143360;

struct Params {
    const float* in[24];
    float* out;
    unsigned char* ws;
    int ph_lo, ph_hi;
};

__device__ __forceinline__ float bf2f(bf16_t v) { return __uint_as_float((unsigned)v << 16); }
__device__ __forceinline__ float bflo(unsigned w) { return __uint_as_float(w << 16); }
__device__ __forceinline__ float bfhi(unsigned w) { return __uint_as_float(w & 0xffff0000u); }
__device__ __forceinline__ unsigned f2bf(float f) { unsigned u = __float_as_uint(f); return (u + 0x7fffu + ((u >> 16) & 1u)) >> 16; }
__device__ __forceinline__ unsigned pk2(float lo, float hi) { return f2bf(lo) | (f2bf(hi) << 16); }
__device__ __forceinline__ float wave_sum(float v) {
#pragma unroll
    for (int o = 1; o < 64; o <<= 1) v += __shfl_xor(v, o);
    return v;
}
__device__ __forceinline__ float wave_max(float v) {
#pragma unroll
    for (int o = 1; o < 64; o <<= 1) v = fmaxf(v, __shfl_xor(v, o));
    return v;
}
__device__ __forceinline__ int wave_min_i(int v) {
#pragma unroll
    for (int o = 1; o < 64; o <<= 1) { int t = __shfl_xor(v, o); v = t < v ? t : v; }
    return v;
}
__device__ __forceinline__ float sigmoidf_(float x) { return 1.f / (1.f + __expf(-x)); }
#define LDS_WAIT() asm volatile("s_waitcnt lgkmcnt(0)" ::: "memory")

struct Ctx { int tid, lane, wave, bid, G; LAS unsigned char* lds; };

__device__ __forceinline__ void transpose_item(const float* W, int K, int N, bf16_t* WT, int k0, int n0, int orow0, const float* kscale, LAS float* scr, int lane) {
#pragma unroll 8
    for (int i = 0; i < 32; ++i) {
        const int kk = 2 * i + (lane >> 5);
        float v = W[(size_t)(k0 + kk) * N + n0 + (lane & 31)];
        if (kscale) v *= kscale[k0 + kk];
        scr[kk * 33 + (lane & 31)] = v;
    }
    LDS_WAIT();
    const int c = lane & 7;
#pragma unroll
    for (int j = 0; j < 4; ++j) {
        const int n = (lane >> 3) + 8 * j;
        const LAS float* s = scr + (8 * c) * 33 + n;
        u32x4 o;
        o.x = pk2(s[0 * 33], s[1 * 33]); o.y = pk2(s[2 * 33], s[3 * 33]); o.z = pk2(s[4 * 33], s[5 * 33]); o.w = pk2(s[6 * 33], s[7 * 33]);
        *(u32x4*)(WT + (size_t)(orow0 + n) * K + k0 + 8 * c) = o;
    }
    LDS_WAIT();
}

__device__ __forceinline__ void phase_prep(const Params& p, const Ctx& c) {
    unsigned char* ws = p.ws;
    LAS float* scr = (LAS float*)(c.lds + c.wave * 16384);
    const int gw = c.bid * 8 + c.wave, NGW = c.G * 8;
    constexpr int I_IN = 16 * 193, I_SQ = 512, I_W1 = 32 * 1024, I_W2 = 32 * 512;
    constexpr int NITEMS = I_IN + 3 * I_SQ + I_W1 + I_W2;
    for (int it = gw; it < NITEMS; it += NGW) {
        int r = it;
        if (r < I_IN) {
            const int kb = r / 193, nb = r % 193, n0 = nb * 32;
            const int orow = n0 < 2560 ? n0 : (n0 < 2592 ? PDT + (n0 - 2560) : n0 - 32);
            transpose_item(p.in[2], 1024, 6176, (bf16_t*)(ws + WS_WINT), kb * 64, n0, orow, nullptr, scr, c.lane); continue;
        }
        r -= I_IN;
        if (r < I_SQ) { transpose_item(p.in[13], 1024, 1024, (bf16_t*)(ws + WS_WST), (r / 32) * 64, (r % 32) * 32, (r % 32) * 32, p.in[10], scr, c.lane); continue; }
        r -= I_SQ;
        if (r < I_SQ) { transpose_item(p.in[14], 1024, 1024, (bf16_t*)(ws + WS_WAT), (r / 32) * 64, (r % 32) * 32, (r % 32) * 32, nullptr, scr, c.lane); continue; }
        r -= I_SQ;
        if (r < I_SQ) { transpose_item(p.in[15], 1024, 1024, (bf16_t*)(ws + WS_WOT), (r / 32) * 64, (r % 32) * 32, (r % 32) * 32, nullptr, scr, c.lane); continue; }
        r -= I_SQ;
        if (r < I_W1) {
            const int e = r / 1024, rr = r % 1024, kb = rr / 64, nb = rr % 64, n0 = nb * 32;
            const int half = n0 / 1024, q = n0 % 1024, nt = q / 128, j = q % 128;
            transpose_item(p.in[19] + (size_t)e * 1024 * 2048, 1024, 2048, (bf16_t*)(ws + WS_W1T) + (size_t)e * 2048 * 1024, kb * 64, n0, nt * 256 + half * 128 + j, nullptr, scr, c.lane); continue;
        }
        r -= I_W1;
        {
            const int e = r / 512, rr = r % 512, kb = rr / 32, nb = rr % 32;
            transpose_item(p.in[21] + (size_t)e * 1024 * 1024, 1024, 1024, (bf16_t*)(ws + WS_W2T) + (size_t)e * 1024 * 1024, kb * 64, nb * 32, nb * 32, nullptr, scr, c.lane);
        }
    }
    for (int r = 6176 + gw; r < NPROJ; r += NGW) {
        u32x4* o = (u32x4*)((bf16_t*)(ws + WS_WINT) + (size_t)r * 1024);
        o[c.lane] = (u32x4){0u, 0u, 0u, 0u}; o[c.lane + 64] = (u32x4){0u, 0u, 0u, 0u};
    }
    {
        const float* x = p.in[0]; const float* g = p.in[1]; bf16_t* H = (bf16_t*)(ws + WS_H);
        f32x4 gv[4];
#pragma unroll
        for (int j = 0; j < 4; ++j) gv[j] = ((const f32x4*)g)[c.lane + 64 * j];
        for (int m = gw; m < M; m += NGW) {
            const f32x4* xr = (const f32x4*)(x + (size_t)m * D) + c.lane;
            f32x4 v[4]; float s = 0.f;
#pragma unroll
            for (int j = 0; j < 4; ++j) { v[j] = xr[64 * j]; s += (v[j].x * v[j].x + v[j].y * v[j].y) + (v[j].z * v[j].z + v[j].w * v[j].w); }
            const float rstd = rsqrtf(wave_sum(s) * (1.f / D) + EPS);
            u32x2* o = (u32x2*)(H + (size_t)m * D) + c.lane;
#pragma unroll
            for (int j = 0; j < 4; ++j) { u32x2 w; w.x = pk2(v[j].x * rstd * gv[j].x, v[j].y * rstd * gv[j].y); w.y = pk2(v[j].z * rstd * gv[j].z, v[j].w * rstd * gv[j].w); o[64 * j] = w; }
        }
    }
    {
        float* rc = (float*)(ws + WS_ROPE); float* rs = rc + 4096;
        for (int idx = c.bid * 512 + c.tid; idx < 4096; idx += c.G * 512) {
            const int pos = idx >> 5, i = idx & 31;
            const float inv = exp2f(-(float)i * (13.287712379549449f / 32.f));
            float rev = (float)pos * inv * 0.15915494309189535f; rev -= floorf(rev);
            rc[idx] = __builtin_amdgcn_cosf(rev); rs[idx] = __builtin_amdgcn_sinf(rev);
        }
        float* wrt = (float*)(ws + WS_WRT); const float* wr = p.in[17];
        for (int idx = c.bid * 512 + c.tid; idx < 32768; idx += c.G * 512) { const int k = idx >> 5, e = idx & 31; wrt[e * 1024 + k] = wr[idx]; }
        if (c.bid == 0 && c.tid < 64) ((int*)(ws + WS_CTL))[c.tid] = 0;
    }
}

template <bool DUAL, class ARow, class Epi>
__device__ __forceinline__ void ngemm_tile(const ARow& arow, const bf16_t* Bt, const bf16_t* Bt2, int K, int m0, const Epi& epi, LAS float* lds, int tid) {
    LAS float* As = lds;
    LAS float* Bs = lds + 32 * 132;
    LAS float* Bs2 = Bs + 32 * 68;
    float acc[4][4], acc2[4][4];
#pragma unroll
    for (int i = 0; i < 4; ++i)
#pragma unroll
        for (int j = 0; j < 4; ++j) { acc[i][j] = 0.f; acc2[i][j] = 0.f; }
    const int tm = tid & 31, tn = tid >> 5;
    const int sr = tid >> 2, kq = (tid & 3) * 8;
    const bf16_t* ap = arow(m0 + sr) + kq;
    const bf16_t* bp = Bt + (size_t)(sr & 63) * K + kq;
    const bf16_t* bp2 = DUAL ? Bt2 + (size_t)(sr & 63) * K + kq : nullptr;
    for (int k0 = 0; k0 < K; k0 += 32) {
        {
            const u32x4 v = *(const u32x4*)(ap + k0);
            As[(kq + 0) * 132 + sr] = bflo(v.x); As[(kq + 1) * 132 + sr] = bfhi(v.x); As[(kq + 2) * 132 + sr] = bflo(v.y); As[(kq + 3) * 132 + sr] = bfhi(v.y);
            As[(kq + 4) * 132 + sr] = bflo(v.z); As[(kq + 5) * 132 + sr] = bfhi(v.z); As[(kq + 6) * 132 + sr] = bflo(v.w); As[(kq + 7) * 132 + sr] = bfhi(v.w);
        }
        if (tid < 256) {
            const u32x4 v = *(const u32x4*)(bp + k0);
            Bs[(kq + 0) * 68 + sr] = bflo(v.x); Bs[(kq + 1) * 68 + sr] = bfhi(v.x); Bs[(kq + 2) * 68 + sr] = bflo(v.y); Bs[(kq + 3) * 68 + sr] = bfhi(v.y);
            Bs[(kq + 4) * 68 + sr] = bflo(v.z); Bs[(kq + 5) * 68 + sr] = bfhi(v.z); Bs[(kq + 6) * 68 + sr] = bflo(v.w); Bs[(kq + 7) * 68 + sr] = bfhi(v.w);
        } else if (DUAL) {
            const int r2 = sr & 63;
            const u32x4 v = *(const u32x4*)(bp2 + k0);
            Bs2[(kq + 0) * 68 + r2] = bflo(v.x); Bs2[(kq + 1) * 68 + r2] = bfhi(v.x); Bs2[(kq + 2) * 68 + r2] = bflo(v.y); Bs2[(kq + 3) * 68 + r2] = bfhi(v.y);
            Bs2[(kq + 4) * 68 + r2] = bflo(v.z); Bs2[(kq + 5) * 68 + r2] = bfhi(v.z); Bs2[(kq + 6) * 68 + r2] = bflo(v.w); Bs2[(kq + 7) * 68 + r2] = bfhi(v.w);
        }
        __syncthreads();
#pragma unroll 8
        for (int k = 0; k < 32; ++k) {
            const f32x4 a = *(const LAS f32x4*)&As[k * 132 + tm * 4];
            const f32x4 b = *(const LAS f32x4*)&Bs[k * 68 + tn * 4];
#pragma unroll
            for (int i = 0; i < 4; ++i)
#pragma unroll
                for (int j = 0; j < 4; ++j) acc[i][j] = fmaf(a[i], b[j], acc[i][j]);
            if (DUAL) {
                const f32x4 b2 = *(const LAS f32x4*)&Bs2[k * 68 + tn * 4];
#pragma unroll
                for (int i = 0; i < 4; ++i)
#pragma unroll
                    for (int j = 0; j < 4; ++j) acc2[i][j] = fmaf(a[i], b2[j], acc2[i][j]);
            }
        }
        __syncthreads();
    }
#pragma unroll
    for (int i = 0; i < 4; ++i)
#pragma unroll
        for (int j = 0; j < 4; ++j) epi(m0 + tm * 4 + i, tn * 4 + j, acc[i][j], acc2[i][j]);
}
struct ARowPlain { const bf16_t* A; int lda; __device__ __forceinline__ const bf16_t* operator()(int m) const { return A + (size_t)m * lda; } };

namespace pg8 {
#define PG8_LAS __attribute__((address_space(3)))
typedef unsigned short bf16_t;
typedef short bf16x8 __attribute__((ext_vector_type(8)));
typedef float f32x4 __attribute__((ext_vector_type(4)));
typedef unsigned u32x4 __attribute__((ext_vector_type(4)));
constexpr int BM = 256, BK = 64, HALF = 128, HTB = HALF * BK * 2  , STAGE_BYTES = 8 * HTB, NXCD = 8, WGM = 8;

__host__ __device__ __forceinline__ int lds_byte(int r, int c) { const int st = (r >> 4) * 2 + (c >> 5), rr = r & 15, cc = c & 31, ob = rr * 64 + cc * 2; return st * 1024 + (ob ^ (((ob >> 9) & 1) << 5)); }
__host__ __device__ __forceinline__ void stage_rc(int b, int& R, int& C) { const int st = b / 1024, sb = b % 1024, swz = sb ^ (((sb >> 9) & 1) << 5); R = (st >> 1) * 16 + swz / 64; C = (st & 1) * 32 + (swz % 64) / 2; }
__host__ __device__ __forceinline__ int perm32(int rho) { const int n = rho >> 4, i = rho & 15; return 8 * (i >> 2) + 4 * n + (i & 3); }

struct Unit { int pm, pn; };
struct Gemm { const bf16_t* A; const bf16_t* Bt; int M, N, K; };

struct StaticOrder {
    int nM, nN, nwg, G, c;
    __host__ __device__ void init(int M, int N, int G_, int c_) { nM = M / BM; nN = N / BM; nwg = nM * nN; G = G_; c = c_; }
    __host__ __device__ bool next(int i, Unit& u) const {
        const long L = (long)i * G + c; if (L >= nwg) return false;
        int wgid = (int)L; { const int q = nwg / NXCD, r = nwg % NXCD, xcd = wgid % NXCD, off = wgid / NXCD; wgid = (xcd < r ? xcd * (q + 1) : r * (q + 1) + (xcd - r) * q) + off; }
        const int nig = WGM * nN, gid = wgid / nig, fm = gid * WGM, gsz = (nM - fm) < WGM ? (nM - fm) : WGM;
        u.pm = fm + ((wgid % nig) % gsz); u.pn = (wgid % nig) / gsz; return true;
    }
    __device__ __forceinline__ void a_ready(const Unit&) const {}
    __device__ __forceinline__ void done(const Unit&) const {}
};


__device__ __forceinline__ unsigned cvt_pk_bf16(float lo, float hi) { unsigned r; asm volatile("v_cvt_pk_bf16_f32 %0, %1, %2" : "=v"(r) : "v"(lo), "v"(hi)); return r; }
__device__ __forceinline__ float sig_(float x) { return __builtin_amdgcn_rcpf(1.f + __builtin_amdgcn_exp2f(-1.4426950408889634f * x)); }
__device__ __forceinline__ u32x4 pack8(const f32x4& v0, const f32x4& v1) { u32x4 w; w.x = cvt_pk_bf16(v0[0], v0[1]); w.y = cvt_pk_bf16(v0[2], v0[3]); w.z = cvt_pk_bf16(v1[0], v1[1]); w.w = cvt_pk_bf16(v1[2], v1[3]); return w; }
__device__ __forceinline__ void unpack8(const u32x4& w, f32x4& v0, f32x4& v1) {
    v0[0] = __uint_as_float(w.x << 16); v0[1] = __uint_as_float(w.x & 0xffff0000u); v0[2] = __uint_as_float(w.y << 16); v0[3] = __uint_as_float(w.y & 0xffff0000u);
    v1[0] = __uint_as_float(w.z << 16); v1[1] = __uint_as_float(w.z & 0xffff0000u); v1[2] = __uint_as_float(w.w << 16); v1[3] = __uint_as_float(w.w & 0xffff0000u); }
struct EpiStore {
    static constexpr bool PERM = true, AFTER_DRAIN = false;
    bf16_t* O; int ldc;
    __device__ __forceinline__ void operator()(const f32x4 (&acc)[2][2][4][2], const Unit& u, int wr, int wc, int fr, int fq) const {
        const int row0 = u.pm * BM + wr * 64 + fr, col0 = u.pn * BM + wc * 32 + 8 * fq;
#pragma unroll
        for (int ai = 0; ai < 2; ++ai)
#pragma unroll
            for (int m = 0; m < 4; ++m) { bf16_t* rowp = O + (size_t)(row0 + ai * HALF + m * 16) * ldc + col0;
#pragma unroll
                for (int bj = 0; bj < 2; ++bj) *(u32x4*)(rowp + bj * HALF) = pack8(acc[ai][bj][m][0], acc[ai][bj][m][1]); }
    }
};
struct EpiT1 {
    static constexpr bool PERM = true, AFTER_DRAIN = false;
    bf16_t* T1; const bf16_t* G; int ldg; const float* RSTD;
    __device__ __forceinline__ void operator()(const f32x4 (&acc)[2][2][4][2], const Unit& u, int wr, int wc, int fr, int fq) const {
        const int row0 = u.pm * BM + wr * 64 + fr, col0 = u.pn * BM + wc * 32 + 8 * fq;
#pragma unroll
        for (int ai = 0; ai < 2; ++ai)
#pragma unroll
            for (int m = 0; m < 4; ++m) { const int row = row0 + ai * HALF + m * 16; const float rs = RSTD[row];
#pragma unroll
                for (int bj = 0; bj < 2; ++bj) { const int col = col0 + bj * HALF;
                    f32x4 g0, g1; unpack8(*(const u32x4*)(G + (size_t)row * ldg + col), g0, g1);
                    f32x4 v0 = acc[ai][bj][m][0] * rs, v1 = acc[ai][bj][m][1] * rs;
#pragma unroll
                    for (int i = 0; i < 4; ++i) { v0[i] *= sig_(g0[i]); v1[i] *= sig_(g1[i]); }
                    *(u32x4*)(T1 + (size_t)row * 1024 + col) = pack8(v0, v1); } }
    }
};
struct EpiT2 {
    static constexpr bool PERM = true, AFTER_DRAIN = false;
    bf16_t* MG; const bf16_t* T1; const bf16_t* G; int ldg;
    __device__ __forceinline__ void operator()(const f32x4 (&acc)[2][2][4][2], const Unit& u, int wr, int wc, int fr, int fq) const {
        const int row0 = u.pm * BM + wr * 64 + fr, col0 = u.pn * BM + wc * 32 + 8 * fq;
#pragma unroll
        for (int ai = 0; ai < 2; ++ai)
#pragma unroll
            for (int m = 0; m < 4; ++m) { const int row = row0 + ai * HALF + m * 16;
#pragma unroll
                for (int bj = 0; bj < 2; ++bj) { const int col = col0 + bj * HALF;
                    f32x4 g0, g1, t0, t1; unpack8(*(const u32x4*)(G + (size_t)row * ldg + col), g0, g1); unpack8(*(const u32x4*)(T1 + (size_t)row * 1024 + col), t0, t1);
                    f32x4 v0 = acc[ai][bj][m][0], v1 = acc[ai][bj][m][1];
#pragma unroll
                    for (int i = 0; i < 4; ++i) { v0[i] = fmaf(v0[i], sig_(g0[i]), t0[i]); v1[i] = fmaf(v1[i], sig_(g1[i]), t1[i]); }
                    *(u32x4*)(MG + (size_t)row * 1024 + col) = pack8(v0, v1); } }
    }
};
struct EpiT3 {
    static constexpr bool PERM = true, AFTER_DRAIN = false;
    float* X1; const float* x;
    __device__ __forceinline__ void operator()(const f32x4 (&acc)[2][2][4][2], const Unit& u, int wr, int wc, int fr, int fq) const {
        const int row0 = u.pm * BM + wr * 64 + fr, col0 = u.pn * BM + wc * 32 + 8 * fq;
#pragma unroll
        for (int ai = 0; ai < 2; ++ai)
#pragma unroll
            for (int m = 0; m < 4; ++m) { const size_t ro = (size_t)(row0 + ai * HALF + m * 16) * 1024 + col0;
#pragma unroll
                for (int bj = 0; bj < 2; ++bj) { const size_t o = ro + bj * HALF;
                    *(f32x4*)(X1 + o) = *(const f32x4*)(x + o) + acc[ai][bj][m][0]; *(f32x4*)(X1 + o + 4) = *(const f32x4*)(x + o + 4) + acc[ai][bj][m][1]; } }
    }
};
struct EpiAct {
    static constexpr bool PERM = true, AFTER_DRAIN = false;
    bf16_t* ACT; const float* b1;
    __device__ __forceinline__ void operator()(const f32x4 (&acc)[2][2][4][2], const Unit& u, int wr, int wc, int fr, int fq) const {
        const int e = u.pn >> 3, nt = u.pn & 7;
        const int row0 = u.pm * BM + wr * 64 + fr, col0 = nt * 128 + wc * 32 + 8 * fq;
        const float* bg = b1 + (size_t)e * 2048 + col0;
        const f32x4 bg0 = *(const f32x4*)bg, bg1 = *(const f32x4*)(bg + 4), bu0 = *(const f32x4*)(bg + 1024), bu1 = *(const f32x4*)(bg + 1028);
#pragma unroll
        for (int ai = 0; ai < 2; ++ai)
#pragma unroll
            for (int m = 0; m < 4; ++m) { const int row = row0 + ai * HALF + m * 16;
                f32x4 g0 = acc[ai][0][m][0] + bg0, g1 = acc[ai][0][m][1] + bg1, u0 = acc[ai][1][m][0] + bu0, u1 = acc[ai][1][m][1] + bu1;
#pragma unroll
                for (int i = 0; i < 4; ++i) {
                    const float ga = fminf(g0[i], 7.f), gb = fminf(g1[i], 7.f), ua = fminf(fmaxf(u0[i], -7.f), 7.f), ub = fminf(fmaxf(u1[i], -7.f), 7.f);
                    g0[i] = ga * sig_(1.702f * ga) * (ua + 1.f); g1[i] = gb * sig_(1.702f * gb) * (ub + 1.f); }
                *(u32x4*)(ACT + (size_t)row * 1024 + col0) = pack8(g0, g1); }
    }
};
struct EpiY {
    static constexpr bool PERM = true, AFTER_DRAIN = false;
    bf16_t* YB; const float* b2;
    __device__ __forceinline__ void operator()(const f32x4 (&acc)[2][2][4][2], const Unit& u, int wr, int wc, int fr, int fq) const {
        const int e = u.pn >> 2, nt = u.pn & 3;
        const int row0 = u.pm * BM + wr * 64 + fr, col0 = nt * BM + wc * 32 + 8 * fq;
        f32x4 bv[2][2];
#pragma unroll
        for (int bj = 0; bj < 2; ++bj) { bv[bj][0] = *(const f32x4*)(b2 + (size_t)e * 1024 + col0 + bj * HALF); bv[bj][1] = *(const f32x4*)(b2 + (size_t)e * 1024 + col0 + bj * HALF + 4); }
#pragma unroll
        for (int ai = 0; ai < 2; ++ai)
#pragma unroll
            for (int m = 0; m < 4; ++m) { bf16_t* rowp = YB + (size_t)(row0 + ai * HALF + m * 16) * 1024 + col0;
#pragma unroll
                for (int bj = 0; bj < 2; ++bj) *(u32x4*)(rowp + bj * HALF) = pack8(acc[ai][bj][m][0] + bv[bj][0], acc[ai][bj][m][1] + bv[bj][1]); }
    }
};
struct MoeOrder {
    const PG8_LAS int* offs; int nN, G, c, ntile;
    __device__ __forceinline__ bool next(int i, Unit& u) const {
        const long L = (long)i * G + c; if (L >= (long)ntile * nN) return false;
        const int t = (int)(L / nN), pnl = (int)(L % nN); int e = 0; while (e < 31 && t * 256 >= offs[e + 1]) ++e;
        u.pm = t; u.pn = e * nN + pnl; return true;
    }
    __device__ __forceinline__ void a_ready(const Unit&) const {}
    __device__ __forceinline__ void done(const Unit&) const {}
};
template <class Epi, class Sched, bool ALIGN_EPI = false, bool SP2 = false>
__device__ __forceinline__ void gemm_phase(PG8_LAS unsigned char* lds, const Gemm g, const Sched& S, const Epi& E) {
    const int tid = threadIdx.x, wid = __builtin_amdgcn_readfirstlane(tid >> 6), lane = tid & 63, wr = wid >> 2, wc = wid & 3, fr = lane & 15, fq = lane >> 4;
    const int K = g.K, nt = K / BK;
    unsigned voffA[2], voffB[2];
#pragma unroll
    for (int i = 0; i < 2; ++i) { int R, C; stage_rc(tid * 16 + i * 8192, R, C); const int Rb = Epi::PERM ? ((R & ~31) + perm32(R & 31)) : R;
        voffA[i] = (unsigned)(R * K + C) * 2u; voffB[i] = (unsigned)(Rb * K + C) * 2u; }
    const size_t kstep = (size_t)(BK * 2);
    const size_t hstep = (size_t)HALF * K * 2;
    const size_t tstep = 2 * hstep;
    const unsigned ldsw = (unsigned)wid * 1024u;
    const int aoff = lds_byte(wr * 64 + fr, fq * 8), boff = lds_byte(wc * 32 + fr, fq * 8);
#define PG8_SA(b, h) (((b) * 2 + (h)) * HTB)
#define PG8_SB(b, h) ((4 + (b) * 2 + (h)) * HTB)
#define PG8_STAGE(bufoff, gbase, voff) do { _Pragma("unroll") for (int _i = 0; _i < 2; ++_i) \
        __builtin_amdgcn_global_load_lds((const unsigned*)((const char*)(gbase) + (voff)[_i]), (PG8_LAS unsigned*)(lds + (bufoff) + ldsw + _i * 8192), 16, 0, 0); } while (0)
#define PG8_LDA(dst, b, h) do { _Pragma("unroll") for (int m = 0; m < 4; ++m) _Pragma("unroll") for (int k = 0; k < 2; ++k) dst[m][k] = *(const PG8_LAS bf16x8*)(lds + PG8_SA(b, h) + aoff + m * 2048 + k * 1024); } while (0)
#define PG8_LDB(dst, b, h) do { _Pragma("unroll") for (int n = 0; n < 2; ++n) _Pragma("unroll") for (int k = 0; k < 2; ++k) dst[n][k] = *(const PG8_LAS bf16x8*)(lds + PG8_SB(b, h) + boff + n * 2048 + k * 1024); } while (0)
#define PG8_MMA(ai, bj, At, Bt) do { __builtin_amdgcn_s_setprio(1); _Pragma("unroll") for (int m = 0; m < 4; ++m) _Pragma("unroll") for (int n = 0; n < 2; ++n) _Pragma("unroll") for (int k = 0; k < 2; ++k) \
        acc[ai][bj][m][n] = __builtin_amdgcn_mfma_f32_16x16x32_bf16(Bt[n][k], At[m][k], acc[ai][bj][m][n], 0, 0, 0); __builtin_amdgcn_s_setprio(0); } while (0)
#define PG8_WAIT_V(n) asm volatile("s_waitcnt vmcnt(" #n ")" ::: "memory")
#define PG8_WAIT_L(n) asm volatile("s_waitcnt lgkmcnt(" #n ")" ::: "memory")
#define PG8_BAR __builtin_amdgcn_s_barrier()
#define PG8_SCHED __builtin_amdgcn_sched_barrier(0)
    Unit cur, nxt; int ui = 0;
    if (!S.next(0, cur)) return;
    f32x4 acc[2][2][4][2];
#pragma unroll
    for (int a = 0; a < 2; ++a)
#pragma unroll
        for (int b = 0; b < 2; ++b)
#pragma unroll
            for (int m = 0; m < 4; ++m)
#pragma unroll
                for (int n = 0; n < 2; ++n) acc[a][b][m][n] = (f32x4){0.f, 0.f, 0.f, 0.f};
    bf16x8 At[4][2], B0[2][2], B1[2][2];
    const char* cA = (const char*)g.A + (size_t)cur.pm * tstep; const char* cB = (const char*)g.Bt + (size_t)cur.pn * tstep;
    S.a_ready(cur);
    if constexpr (SP2) {
        PG8_STAGE(PG8_SB(0, 0), cB, voffB); PG8_STAGE(PG8_SB(0, 1), cB + hstep, voffB); PG8_STAGE(PG8_SA(0, 0), cA, voffA); PG8_STAGE(PG8_SA(0, 1), cA + hstep, voffA);
        if (wr == 1) PG8_BAR;
        PG8_WAIT_V(2); PG8_BAR;
        PG8_STAGE(PG8_SB(1, 0), cB + kstep, voffB); PG8_STAGE(PG8_SA(1, 0), cA + kstep, voffA); PG8_STAGE(PG8_SB(1, 1), cB + hstep + kstep, voffB);
        PG8_WAIT_V(6); PG8_BAR;
    } else {
        PG8_STAGE(PG8_SB(0, 0), cB, voffB); PG8_STAGE(PG8_SA(0, 0), cA, voffA); PG8_STAGE(PG8_SB(0, 1), cB + hstep, voffB); PG8_STAGE(PG8_SA(0, 1), cA + hstep, voffA);
        if (wr == 1) PG8_BAR;
        PG8_WAIT_V(4); PG8_BAR;
        PG8_STAGE(PG8_SB(1, 0), cB + kstep, voffB); PG8_STAGE(PG8_SA(1, 0), cA + kstep, voffA); PG8_STAGE(PG8_SB(1, 1), cB + hstep + kstep, voffB);
        PG8_WAIT_V(6); PG8_BAR;
    }
    for (;;) {
        const bool has_next = S.next(ui + 1, nxt);
        const char* nA = has_next ? (const char*)g.A + (size_t)nxt.pm * tstep : cA; const char* nB = has_next ? (const char*)g.Bt + (size_t)nxt.pn * tstep : cB;
        for (int t = 0; t < nt; t += 2) {
            const bool last = (t == nt - 2);
            const char* a1 = cA + (size_t)(t + 1) * kstep;
            const char* a2 = last ? nA : cA + (size_t)(t + 2) * kstep; const char* b2 = last ? nB : cB + (size_t)(t + 2) * kstep;
            const char* a3 = a2 + kstep; const char* b3 = b2 + kstep;
            if (last && has_next) S.a_ready(nxt);
            if constexpr (SP2) {
            PG8_LDB(B0, 0, 0); PG8_LDB(B1, 0, 1); PG8_SCHED; PG8_LDA(At, 0, 0); PG8_STAGE(PG8_SA(1, 1), a1 + hstep, voffA);
            PG8_WAIT_V(8); PG8_WAIT_L(0); PG8_BAR; PG8_MMA(0, 0, At, B0); PG8_MMA(0, 1, At, B1); PG8_BAR; PG8_SCHED;
            PG8_LDA(At, 0, 1); PG8_STAGE(PG8_SB(0, 0), b2, voffB); PG8_STAGE(PG8_SB(0, 1), b2 + hstep, voffB); PG8_STAGE(PG8_SA(0, 0), a2, voffA);
            PG8_WAIT_V(8); PG8_WAIT_L(0); PG8_BAR; PG8_MMA(1, 0, At, B0); PG8_MMA(1, 1, At, B1); PG8_BAR; PG8_SCHED;
            PG8_LDB(B0, 1, 0); PG8_LDB(B1, 1, 1); PG8_SCHED; PG8_LDA(At, 1, 0); PG8_STAGE(PG8_SA(0, 1), a2 + hstep, voffA);
            PG8_WAIT_V(8); PG8_WAIT_L(0); PG8_BAR; PG8_MMA(0, 0, At, B0); PG8_MMA(0, 1, At, B1); PG8_BAR; PG8_SCHED;
            PG8_LDA(At, 1, 1); PG8_STAGE(PG8_SB(1, 0), b3, voffB); PG8_STAGE(PG8_SB(1, 1), b3 + hstep, voffB); PG8_STAGE(PG8_SA(1, 0), a3, voffA);
            PG8_WAIT_V(8); PG8_WAIT_L(0); PG8_BAR; PG8_MMA(1, 0, At, B0); PG8_MMA(1, 1, At, B1); PG8_BAR; PG8_SCHED;
            } else {
            PG8_LDB(B0, 0, 0); PG8_SCHED; PG8_LDA(At, 0, 0); PG8_STAGE(PG8_SA(1, 1), a1 + hstep, voffA);
            PG8_WAIT_L(8); PG8_BAR; PG8_WAIT_L(0); PG8_MMA(0, 0, At, B0); PG8_BAR; PG8_SCHED;
            PG8_LDB(B1, 0, 1); PG8_STAGE(PG8_SB(0, 0), b2, voffB);
            PG8_BAR; PG8_WAIT_L(0); PG8_MMA(0, 1, At, B1); PG8_BAR;
            PG8_LDA(At, 0, 1); PG8_STAGE(PG8_SA(0, 0), a2, voffA);
            PG8_BAR; PG8_WAIT_L(0); PG8_MMA(1, 0, At, B0); PG8_BAR; PG8_SCHED;
            PG8_STAGE(PG8_SB(0, 1), b2 + hstep, voffB);
            PG8_WAIT_V(6); PG8_BAR; PG8_MMA(1, 1, At, B1); PG8_BAR;
            PG8_LDB(B0, 1, 0); PG8_SCHED; PG8_LDA(At, 1, 0); PG8_STAGE(PG8_SA(0, 1), a2 + hstep, voffA);
            PG8_WAIT_L(8); PG8_BAR; PG8_WAIT_L(0); PG8_MMA(0, 0, At, B0); PG8_BAR; PG8_SCHED;
            PG8_LDB(B1, 1, 1); PG8_STAGE(PG8_SB(1, 0), b3, voffB);
            PG8_BAR; PG8_WAIT_L(0); PG8_MMA(0, 1, At, B1); PG8_BAR;
            PG8_LDA(At, 1, 1); PG8_STAGE(PG8_SA(1, 0), a3, voffA);
            PG8_BAR; PG8_WAIT_L(0); PG8_MMA(1, 0, At, B0); PG8_BAR; PG8_SCHED;
            PG8_STAGE(PG8_SB(1, 1), b3 + hstep, voffB);
            PG8_WAIT_V(6); PG8_BAR; PG8_MMA(1, 1, At, B1); PG8_BAR;
            }
        }
        if constexpr (ALIGN_EPI) { if (wr == 0) PG8_BAR; }
        if constexpr (!Epi::AFTER_DRAIN) { E(acc, cur, wr, wc, fr, fq); S.done(cur); }
        if (!has_next) break;
#pragma unroll
        for (int a = 0; a < 2; ++a)
#pragma unroll
            for (int b = 0; b < 2; ++b)
#pragma unroll
                for (int m = 0; m < 4; ++m)
#pragma unroll
                    for (int n = 0; n < 2; ++n) acc[a][b][m][n] = (f32x4){0.f, 0.f, 0.f, 0.f};
        cur = nxt; cA = nA; cB = nB; ++ui;
        if constexpr (ALIGN_EPI) { if (wr == 1) PG8_BAR; }
    }
    PG8_WAIT_V(0);
    if constexpr (!ALIGN_EPI) { if (wr == 0) PG8_BAR; }
    PG8_BAR;
    if constexpr (Epi::AFTER_DRAIN) { E.fused(acc, cur, wr, wc, fr, fq, lds, wid, lane); S.done(cur); }
#undef PG8_SA
#undef PG8_SB
#undef PG8_STAGE
#undef PG8_LDA
#undef PG8_LDB
#undef PG8_MMA
#undef PG8_WAIT_V
#undef PG8_WAIT_L
#undef PG8_BAR
#undef PG8_SCHED
}
}

struct EpiP { bf16_t* P; int n0; __device__ __forceinline__ void operator()(int r, int cl, float a, float) const { P[(size_t)r * NPROJ + n0 + cl] = (bf16_t)f2bf(a); } };
__device__ __forceinline__ void phase_gemm1_naive(const Params& p, const Ctx& c) {
    const bf16_t* H = (const bf16_t*)(p.ws + WS_H); const bf16_t* W = (const bf16_t*)(p.ws + WS_WINT); bf16_t* P = (bf16_t*)(p.ws + WS_P);
    constexpr int NT_N = NPROJ / 64, NT_M = M / 128;
    for (int it = c.bid; it < NT_M * NT_N; it += c.G) {
        const int mt = it / NT_N, nt = it % NT_N;
        ngemm_tile<false>(ARowPlain{H, 1024}, W + (size_t)nt * 64 * 1024, nullptr, 1024, mt * 128, EpiP{P, nt * 64}, (LAS float*)c.lds, c.tid);
    }
}

__device__ __forceinline__ void phase_conv(const Params& p, const Ctx& c) {
    unsigned char* ws = p.ws;
    const bf16_t* P = (const bf16_t*)(ws + WS_P);
    const int tid = c.tid;
    LAS bf16_t* raw = (LAS bf16_t*)c.lds;
    LAS bf16_t* outb = (LAS bf16_t*)(c.lds + 132 * 256 * 2);
    for (int it = c.bid; it < 2 * 64 * 6; it += c.G) {
        const int part = it % 6, bc = it / 6, b = bc / 64, ch_ = bc % 64, t0 = ch_ * 128;
        __syncthreads();
        {
            u32x4 rv[9];
#pragma unroll
            for (int i = 0; i < 9; ++i) { const int idx = tid + 512 * i, r = idx >> 5, c8 = idx & 31, tok = t0 - 2 + r;
                rv[i] = (u32x4){0u, 0u, 0u, 0u};
                if (idx < 132 * 32 && tok >= 0 && tok < S) rv[i] = *(const u32x4*)(P + (size_t)(b * S + tok) * NPROJ + PXBC + part * 256 + c8 * 8); }
#pragma unroll
            for (int i = 0; i < 9; ++i) { const int idx = tid + 512 * i, r = idx >> 5, c8 = idx & 31;
                if (idx < 132 * 32) *(LAS u32x4*)(raw + r * 256 + c8 * 8) = rv[i]; }
        }
        __syncthreads();
        {
            const int ch = tid & 255, l0 = tid >> 8, cg_ = part * 256 + ch;
            const float* cw = p.in[3]; const float cb = p.in[4][cg_];
            const float w0 = cw[0 * 1536 + cg_], w1 = cw[1 * 1536 + cg_], w2 = cw[2 * 1536 + cg_], w3 = cw[3 * 1536 + cg_], w4 = cw[4 * 1536 + cg_];
            for (int i = 0; i < 64; ++i) {
                const int l = l0 + 2 * i;
                float a = cb;
                a = fmaf(w0, bf2f(raw[(l + 0) * 256 + ch]), a); a = fmaf(w1, bf2f(raw[(l + 1) * 256 + ch]), a); a = fmaf(w2, bf2f(raw[(l + 2) * 256 + ch]), a);
                a = fmaf(w3, bf2f(raw[(l + 3) * 256 + ch]), a); a = fmaf(w4, bf2f(raw[(l + 4) * 256 + ch]), a);
                outb[l * 256 + ch] = (bf16_t)f2bf(a * sigmoidf_(a));
            }
        }
        __syncthreads();
        if (part < 4 || part == 4) {
            bf16_t* dst = part < 4 ? (bf16_t*)(ws + WS_XT) + ((size_t)(b * 64 + ch_) * 16 + part * 4) * 64 * 128
                                   : (bf16_t*)(ws + WS_BMT) + (size_t)(b * 64 + ch_) * 2 * 128 * 128;
            for (int idx = tid; idx < 256 * 16; idx += 512) {
                const int lc = idx >> 8, ch = idx & 255;
                u32x4 o;
                o.x = (unsigned)outb[(lc * 8 + 0) * 256 + ch] | ((unsigned)outb[(lc * 8 + 1) * 256 + ch] << 16);
                o.y = (unsigned)outb[(lc * 8 + 2) * 256 + ch] | ((unsigned)outb[(lc * 8 + 3) * 256 + ch] << 16);
                o.z = (unsigned)outb[(lc * 8 + 4) * 256 + ch] | ((unsigned)outb[(lc * 8 + 5) * 256 + ch] << 16);
                o.w = (unsigned)outb[(lc * 8 + 6) * 256 + ch] | ((unsigned)outb[(lc * 8 + 7) * 256 + ch] << 16);
                *(u32x4*)(dst + (size_t)ch * 128 + lc * 8) = o;
            }
        }
        if (part >= 4) {
            bf16_t* dst = (bf16_t*)(ws + (part == 4 ? WS_BMR : WS_CMR)) + (size_t)(b * S + t0) * 256;
            for (int idx = tid; idx < 128 * 32; idx += 512) {
                const int l = idx >> 5, c8 = idx & 31;
                *(u32x4*)(dst + (size_t)l * 256 + c8 * 8) = *(const LAS u32x4*)(outb + l * 256 + c8 * 8);
            }
        }
    }
    {
        float* DT = (float*)(ws + WS_DT); float* ACS = (float*)(ws + WS_ACS); float* CDEC = (float*)(ws + WS_CDEC);
        const int lane = c.lane;
        for (int it = c.bid; it < 128; it += c.G) {
            const int b = it / 64, ch_ = it % 64, t0 = ch_ * 128;
#pragma unroll
            for (int qi = 0; qi < 4; ++qi) {
                const int q = c.wave * 4 + qi, dir = q >> 4, h = q & 15;
                const float bias = dir ? p.in[6][h] : p.in[5][h], nA = -expf(dir ? p.in[8][h] : p.in[7][h]);
                const int l0 = dir ? 127 - lane : lane, l1 = dir ? 63 - lane : lane + 64;
                const size_t tok0 = (size_t)b * S + t0 + l0, tok1 = (size_t)b * S + t0 + l1;
                const float x0 = bf2f(P[tok0 * NPROJ + PDT + q]) + bias, x1 = bf2f(P[tok1 * NPROJ + PDT + q]) + bias;
                const float d0 = fmaxf(x0, 0.f) + log1pf(expf(-fabsf(x0))), d1 = fmaxf(x1, 0.f) + log1pf(expf(-fabsf(x1)));
                float a0 = d0 * nA, a1 = d1 * nA;
#pragma unroll
                for (int o = 1; o < 64; o <<= 1) { const float t0_ = __shfl_up(a0, o), t1_ = __shfl_up(a1, o); if (lane >= o) { a0 += t0_; a1 += t1_; } }
                const float tot0 = __shfl(a0, 63); a1 += tot0;
                DT[((size_t)dir * M + tok0) * 16 + h] = d0; DT[((size_t)dir * M + tok1) * 16 + h] = d1;
                ACS[((size_t)dir * M + tok0) * 16 + h] = a0; ACS[((size_t)dir * M + tok1) * 16 + h] = a1;
                if (lane == 63) CDEC[((dir * 2 + b) * 64 + ch_) * 16 + h] = expf(a1);
            }
        }
    }
    {
        const int gw = c.bid * 8 + c.wave, NGW = c.G * 8, lane = c.lane;
        const float* rc = (const float*)(ws + WS_ROPE); const float* rs = rc + 4096;
        const int sub = lane >> 4, j = lane & 15, axis = j >> 3, i0 = 8 * (j & 3); const bool second = (j & 4) != 0;
        const f32x4 gq0 = *(const f32x4*)(p.in[11] + 8 * j), gq1 = *(const f32x4*)(p.in[11] + 8 * j + 4), gk0 = *(const f32x4*)(p.in[12] + 8 * j), gk1 = *(const f32x4*)(p.in[12] + 8 * j + 4);
        bf16_t* QN = (bf16_t*)(ws + WS_QN); bf16_t* KN = (bf16_t*)(ws + WS_KN);
#pragma unroll 4
        for (int base = gw; base < M * 10 / 4; base += NGW) {
            const int it = base * 4 + sub, tok = it / 10, hh = it % 10;
            const bf16_t* src = P + (size_t)tok * NPROJ + (hh < 8 ? PQ + hh * 128 : PK + (hh - 8) * 128) + 8 * j;
            bf16_t* dst = (hh < 8 ? QN + (size_t)tok * 1024 + hh * 128 : KN + (size_t)tok * 256 + (hh - 8) * 128) + 8 * j;
            const u32x4 v = *(const u32x4*)src;
            float y[8] = {bflo(v.x), bfhi(v.x), bflo(v.y), bfhi(v.y), bflo(v.z), bfhi(v.z), bflo(v.w), bfhi(v.w)};
            float ss = 0.f;
#pragma unroll
            for (int i = 0; i < 8; ++i) ss = fmaf(y[i], y[i], ss);
            ss += __shfl_xor(ss, 1); ss += __shfl_xor(ss, 2); ss += __shfl_xor(ss, 4); ss += __shfl_xor(ss, 8);
            const float rstd = rsqrtf(ss * (1.f / 128.f) + EPS);
            const f32x4 g0 = hh < 8 ? gq0 : gk0, g1 = hh < 8 ? gq1 : gk1;
#pragma unroll
            for (int i = 0; i < 4; ++i) { y[i] *= rstd * g0[i]; y[4 + i] *= rstd * g1[i]; }
            const int s = tok & (S - 1), pos = axis ? (s & 63) : (s >> 6);
            const f32x4 c0 = *(const f32x4*)(rc + pos * 32 + i0), c1 = *(const f32x4*)(rc + pos * 32 + i0 + 4), s0 = *(const f32x4*)(rs + pos * 32 + i0), s1 = *(const f32x4*)(rs + pos * 32 + i0 + 4);
            float o[8];
#pragma unroll
            for (int i = 0; i < 8; ++i) { const float other = __shfl_xor(y[i], 4); const float cs = i < 4 ? c0[i] : c1[i - 4], sn = i < 4 ? s0[i] : s1[i - 4];
                o[i] = second ? fmaf(other, sn, y[i] * cs) : fmaf(-other, sn, y[i] * cs); }
            u32x4 w; w.x = pk2(o[0], o[1]); w.y = pk2(o[2], o[3]); w.z = pk2(o[4], o[5]); w.w = pk2(o[6], o[7]);
            *(u32x4*)dst = w;
        }
        bf16_t* VB = (bf16_t*)(ws + WS_VB);
        for (int idx0 = c.bid * 512 + c.tid; idx0 < M * 32; idx0 += c.G * 512 * 4) {
            u32x4 v[4];
#pragma unroll
            for (int i = 0; i < 4; ++i) { const int idx = idx0 + i * c.G * 512; if (idx < M * 32) v[i] = *(const u32x4*)(P + (size_t)(idx >> 5) * NPROJ + PV + (idx & 31) * 8); }
#pragma unroll
            for (int i = 0; i < 4; ++i) { const int idx = idx0 + i * c.G * 512; if (idx < M * 32) *(u32x4*)(VB + (size_t)(idx >> 5) * 256 + (idx & 31) * 8) = v[i]; }
        }
    }
}

__device__ __forceinline__ void phase_ssd_naive(const Params& p, const Ctx& c) {
    unsigned char* ws = p.ws;
    const bf16_t* P = (const bf16_t*)(ws + WS_P); const bf16_t* XT = (const bf16_t*)(ws + WS_XT);
    const bf16_t* BMR = (const bf16_t*)(ws + WS_BMR); const bf16_t* CMR = (const bf16_t*)(ws + WS_CMR);
    const float* DT = (const float*)(ws + WS_DT); float* YACC = (float*)(ws + WS_ST); bf16_t* YZ = (bf16_t*)(ws + WS_YZ);
    const int pp = c.tid >> 3, nq = c.tid & 7;
    for (int item = c.bid; item < 32; item += c.G) {
        const int b = item >> 4, h = item & 15, g = h >> 3;
        const float dsk = p.in[9][h];
        for (int dir = 0; dir < 2; ++dir) {
            const float A = -expf(dir ? p.in[8][h] : p.in[7][h]);
            float st[16];
#pragma unroll
            for (int i = 0; i < 16; ++i) st[i] = 0.f;
            int t = dir ? S - 1 : 0;
            size_t tok = (size_t)b * S + t;
            u32x4 nb0 = *(const u32x4*)(BMR + tok * 256 + g * 128 + nq * 16), nb1 = *(const u32x4*)(BMR + tok * 256 + g * 128 + nq * 16 + 8);
            u32x4 nc0 = *(const u32x4*)(CMR + tok * 256 + g * 128 + nq * 16), nc1 = *(const u32x4*)(CMR + tok * 256 + g * 128 + nq * 16 + 8);
            float nx = bf2f(XT[((((size_t)b * 64 + (t >> 7)) * 16 + h) * 64 + pp) * 128 + (t & 127)]);
            float ndt = DT[((size_t)dir * M + tok) * 16 + h];
            for (int step = 0; step < S; ++step) {
                const u32x4 b0 = nb0, b1 = nb1, c0 = nc0, c1 = nc1; const float x = nx, dt = ndt; const size_t tokc = tok;
                if (step + 1 < S) {
                    t = dir ? S - 2 - step : step + 1; tok = (size_t)b * S + t;
                    nb0 = *(const u32x4*)(BMR + tok * 256 + g * 128 + nq * 16); nb1 = *(const u32x4*)(BMR + tok * 256 + g * 128 + nq * 16 + 8);
                    nc0 = *(const u32x4*)(CMR + tok * 256 + g * 128 + nq * 16); nc1 = *(const u32x4*)(CMR + tok * 256 + g * 128 + nq * 16 + 8);
                    nx = bf2f(XT[((((size_t)b * 64 + (t >> 7)) * 16 + h) * 64 + pp) * 128 + (t & 127)]);
                    ndt = DT[((size_t)dir * M + tok) * 16 + h];
                }
                const float dec = __expf(dt * A), xdt = x * dt;
                float part = 0.f;
#define SSD_STEP(i, BW, CW, LOHI) { st[i] = fmaf(st[i], dec, LOHI(BW) * xdt); part = fmaf(LOHI(CW), st[i], part); }
                SSD_STEP(0, b0.x, c0.x, bflo) SSD_STEP(1, b0.x, c0.x, bfhi) SSD_STEP(2, b0.y, c0.y, bflo) SSD_STEP(3, b0.y, c0.y, bfhi)
                SSD_STEP(4, b0.z, c0.z, bflo) SSD_STEP(5, b0.z, c0.z, bfhi) SSD_STEP(6, b0.w, c0.w, bflo) SSD_STEP(7, b0.w, c0.w, bfhi)
                SSD_STEP(8, b1.x, c1.x, bflo) SSD_STEP(9, b1.x, c1.x, bfhi) SSD_STEP(10, b1.y, c1.y, bflo) SSD_STEP(11, b1.y, c1.y, bfhi)
                SSD_STEP(12, b1.z, c1.z, bflo) SSD_STEP(13, b1.z, c1.z, bfhi) SSD_STEP(14, b1.w, c1.w, bflo) SSD_STEP(15, b1.w, c1.w, bfhi)
#undef SSD_STEP
                part += __shfl_xor(part, 1); part += __shfl_xor(part, 2); part += __shfl_xor(part, 4);
                if (nq == 0) {
                    const size_t o = tokc * 1024 + h * 64 + pp;
                    if (dir == 0) YACC[o] = part + x * dsk;
                    else { const float y = YACC[o] + part; const float z = bf2f(P[tokc * NPROJ + PZ + h * 64 + pp]); YZ[o] = (bf16_t)f2bf(y * z * sigmoidf_(z)); }
                }
            }
        }
    }
}


typedef short bf16x8 __attribute__((ext_vector_type(8)));
typedef float f32x16 __attribute__((ext_vector_type(16)));
constexpr int TS = 136;
__device__ __forceinline__ bf16x8 ldfrag(const LAS bf16_t* tile, int row, int k0) { return *(const LAS bf16x8*)(tile + row * TS + k0); }
template <int ROWS> __device__ __forceinline__ void load_tile128(LAS bf16_t* dst, const bf16_t* src, int ld, int tid) {
    constexpr int N = ROWS * 16 / 512;
    u32x4 v[N];
#pragma unroll
    for (int i = 0; i < N; ++i) { const int idx = tid + 512 * i; v[i] = *(const u32x4*)(src + (size_t)(idx >> 4) * ld + (idx & 15) * 8); }
#pragma unroll
    for (int i = 0; i < N; ++i) { const int idx = tid + 512 * i; *(LAS u32x4*)(dst + (idx >> 4) * TS + (idx & 15) * 8) = v[i]; }
}
__device__ __forceinline__ void phase_ssd_states(const Params& p, const Ctx& c) {
    unsigned char* ws = p.ws;
    const bf16_t* XT = (const bf16_t*)(ws + WS_XT); const bf16_t* BMT = (const bf16_t*)(ws + WS_BMT);
    const float* DT = (const float*)(ws + WS_DT); const float* ACS = (const float*)(ws + WS_ACS); bf16_t* ST = (bf16_t*)(ws + WS_PREV);
    LAS bf16_t* BTs = (LAS bf16_t*)c.lds; LAS bf16_t* XTf = BTs + 128 * TS; LAS bf16_t* XTb = XTf + 64 * TS; LAS float* wd = (LAS float*)(XTb + 64 * TS);
    const int tid = c.tid, lane = c.lane, r = lane & 31, hh = lane >> 5;
    for (int unit = c.bid; unit < 256; unit += c.G) {
        const int b = unit >> 7, ch = (unit >> 1) & 63, g = unit & 1;
        __syncthreads();
        load_tile128<128>(BTs, BMT + ((size_t)(b * 64 + ch) * 2 + g) * 128 * 128, 128, tid);
        u32x4 xv0, xv1; float pacs = 0.f, pdt = 0.f, paend = 0.f;
        const int wd_d = (tid >> 7) & 1, wd_l = tid & 127; const size_t wd_t0 = (size_t)wd_d * M + (size_t)b * S + ch * 128;
#define S1_PREFETCH(H) do { const bf16_t* xt_ = XT + ((size_t)(b * 64 + ch) * 16 + (H)) * 64 * 128; \
            xv0 = *(const u32x4*)(xt_ + (tid >> 4) * 128 + (tid & 15) * 8); xv1 = *(const u32x4*)(xt_ + ((tid + 512) >> 4) * 128 + (tid & 15) * 8); \
            if (tid < 256) { pacs = ACS[(wd_t0 + wd_l) * 16 + (H)]; pdt = DT[(wd_t0 + wd_l) * 16 + (H)]; paend = ACS[(wd_t0 + (wd_d ? 0 : 127)) * 16 + (H)]; } } while (0)
        S1_PREFETCH(g * 8);
#pragma unroll 1
        for (int h8 = 0; h8 < 8; ++h8) {
            const int h = g * 8 + h8;
            __syncthreads();
            if (tid < 256) wd[wd_d * 128 + wd_l] = pdt * __expf(paend - pacs);
            __syncthreads();
            {
                const u32x4 vv[2] = {xv0, xv1};
#pragma unroll
                for (int i = 0; i < 2; ++i) { const int idx = tid + 512 * i, pr = idx >> 4, l0 = (idx & 15) * 8; const u32x4 v = vv[i];
                    const float x[8] = {bflo(v.x), bfhi(v.x), bflo(v.y), bfhi(v.y), bflo(v.z), bfhi(v.z), bflo(v.w), bfhi(v.w)};
                    const f32x4 wf0 = *(const LAS f32x4*)(wd + l0), wf1 = *(const LAS f32x4*)(wd + l0 + 4), wb0 = *(const LAS f32x4*)(wd + 128 + l0), wb1 = *(const LAS f32x4*)(wd + 128 + l0 + 4);
                    u32x4 of, ob;
                    of.x = pk2(x[0] * wf0[0], x[1] * wf0[1]); of.y = pk2(x[2] * wf0[2], x[3] * wf0[3]); of.z = pk2(x[4] * wf1[0], x[5] * wf1[1]); of.w = pk2(x[6] * wf1[2], x[7] * wf1[3]);
                    ob.x = pk2(x[0] * wb0[0], x[1] * wb0[1]); ob.y = pk2(x[2] * wb0[2], x[3] * wb0[3]); ob.z = pk2(x[4] * wb1[0], x[5] * wb1[1]); ob.w = pk2(x[6] * wb1[2], x[7] * wb1[3]);
                    *(LAS u32x4*)(XTf + pr * TS + l0) = of; *(LAS u32x4*)(XTb + pr * TS + l0) = ob; }
            }
            if (h8 < 7) S1_PREFETCH(h + 1);
            __syncthreads();
            { const int d = c.wave >> 2, nb = c.wave & 3; const LAS bf16_t* XTd = d ? XTb : XTf;
              bf16_t* st = ST + ((((size_t)(d * 2 + b) * 64 + ch) * 16 + h) * 64) * 128;
#pragma unroll
              for (int pb = 0; pb < 2; ++pb) { f32x16 acc = {};
#pragma unroll
                for (int ks = 0; ks < 8; ++ks) acc = __builtin_amdgcn_mfma_f32_32x32x16_bf16(ldfrag(XTd, pb * 32 + r, ks * 16 + 8 * hh), ldfrag(BTs, nb * 32 + r, ks * 16 + 8 * hh), acc, 0, 0, 0);
#pragma unroll
                for (int i = 0; i < 16; ++i) { const int pp = pb * 32 + (i & 3) + 8 * (i >> 2) + 4 * hh; st[(size_t)pp * 128 + nb * 32 + r] = (bf16_t)f2bf(acc[i]); } } }
        }
#undef S1_PREFETCH
    }
}
__device__ __forceinline__ void phase_ssd_scan(const Params& p, const Ctx& c) {
    unsigned char* ws = p.ws;
    const float* CDEC = (const float*)(ws + WS_CDEC); bf16_t* PREV = (bf16_t*)(ws + WS_PREV);
    for (int idx = c.bid * 512 + c.tid; idx < 131072; idx += c.G * 512) {
        const int n4 = idx & 31, pp = (idx >> 5) & 63, h = (idx >> 11) & 15, b = (idx >> 15) & 1, d = idx >> 16;
        f32x4 run = {0.f, 0.f, 0.f, 0.f};
#pragma unroll 16
        for (int step = 0; step < 64; ++step) {
            const int ch = d ? 63 - step : step;
            const size_t o = ((((size_t)(d * 2 + b) * 64 + ch) * 16 + h) * 64 + pp) * 128 + n4 * 4;
            const u32x2 sv = *(const u32x2*)(PREV + o); const float dec = CDEC[((d * 2 + b) * 64 + ch) * 16 + h];
            u32x2 w; w.x = pk2(run.x, run.y); w.y = pk2(run.z, run.w); *(u32x2*)(PREV + o) = w;
            run.x = fmaf(run.x, dec, bflo(sv.x)); run.y = fmaf(run.y, dec, bfhi(sv.x)); run.z = fmaf(run.z, dec, bflo(sv.y)); run.w = fmaf(run.w, dec, bfhi(sv.y));
        }
    }
}
__device__ __forceinline__ void phase_ssd_out(const Params& p, const Ctx& c) {
    unsigned char* ws = p.ws;
    const bf16_t* P = (const bf16_t*)(ws + WS_P); const bf16_t* XT = (const bf16_t*)(ws + WS_XT);
    const bf16_t* BMR = (const bf16_t*)(ws + WS_BMR); const bf16_t* CMR = (const bf16_t*)(ws + WS_CMR); const bf16_t* PREV = (const bf16_t*)(ws + WS_PREV);
    const float* DT = (const float*)(ws + WS_DT); const float* ACS = (const float*)(ws + WS_ACS); bf16_t* YZ = (bf16_t*)(ws + WS_YZ);
    LAS bf16_t* Cs = (LAS bf16_t*)c.lds; LAS bf16_t* Ms = Cs + 128 * TS; LAS bf16_t* XTs = Ms + 128 * TS; LAS bf16_t* PF = XTs + 64 * TS; LAS bf16_t* PB = PF + 64 * TS;
    LAS float* vec = (LAS float*)(PB + 64 * TS);
    constexpr int ZS = 72; LAS bf16_t* Zs = (LAS bf16_t*)(vec + 512); LAS float* dskl = (LAS float*)(Zs + 128 * ZS);
    const int tid = c.tid, lane = c.lane, r = lane & 31, hh = lane >> 5, wave = c.wave;
    for (int unit = c.bid; unit < 256; unit += c.G) {
        const int b = unit >> 7, ch = (unit >> 1) & 63, g = unit & 1;
        const size_t tok0 = (size_t)b * S + ch * 128;
        __syncthreads();
        load_tile128<128>(Cs, CMR + tok0 * 256 + g * 128, 256, tid);
        load_tile128<128>(Ms, BMR + tok0 * 256 + g * 128, 256, tid);
        u32x4 px0, px1, pf0, pf1, pb0, pb1, pz0, pz1; float pvec;
        const int t_r0 = tid >> 4, t_r1 = (tid + 512) >> 4, t_c = (tid & 15) * 8;
#define S3_PREFETCH(H) do { const bf16_t* xt_ = XT + ((size_t)(b * 64 + ch) * 16 + (H)) * 64 * 128; \
            const bf16_t* f_ = PREV + ((((size_t)(0 * 2 + b) * 64 + ch) * 16 + (H)) * 64) * 128; const bf16_t* b_ = PREV + ((((size_t)(1 * 2 + b) * 64 + ch) * 16 + (H)) * 64) * 128; \
            px0 = *(const u32x4*)(xt_ + t_r0 * 128 + t_c); px1 = *(const u32x4*)(xt_ + t_r1 * 128 + t_c); pf0 = *(const u32x4*)(f_ + t_r0 * 128 + t_c); pf1 = *(const u32x4*)(f_ + t_r1 * 128 + t_c); \
            pb0 = *(const u32x4*)(b_ + t_r0 * 128 + t_c); pb1 = *(const u32x4*)(b_ + t_r1 * 128 + t_c); \
            pz0 = *(const u32x4*)(P + (tok0 + (tid >> 3)) * NPROJ + PZ + (H) * 64 + (tid & 7) * 8); pz1 = *(const u32x4*)(P + (tok0 + 64 + (tid >> 3)) * NPROJ + PZ + (H) * 64 + (tid & 7) * 8); \
            { const int v_ = tid >> 7, l_ = tid & 127; const size_t o_ = ((size_t)(v_ & 1) * M + tok0 + l_) * 16 + (H); pvec = (v_ < 2) ? ACS[o_] : DT[o_]; } } while (0)
        S3_PREFETCH(g * 8);
        if (tid < 8) dskl[tid] = p.in[9][g * 8 + tid];
        __syncthreads();
        const int lb = wave & 3, sb0 = 2 * (wave >> 2);
        f32x16 G0 = {}, G1 = {};
#pragma unroll
        for (int ks = 0; ks < 8; ++ks) { const bf16x8 a = ldfrag(Cs, lb * 32 + r, ks * 16 + 8 * hh);
            G0 = __builtin_amdgcn_mfma_f32_32x32x16_bf16(a, ldfrag(Ms, sb0 * 32 + r, ks * 16 + 8 * hh), G0, 0, 0, 0);
            G1 = __builtin_amdgcn_mfma_f32_32x32x16_bf16(a, ldfrag(Ms, (sb0 + 1) * 32 + r, ks * 16 + 8 * hh), G1, 0, 0, 0); }
#pragma unroll 1
        for (int h8 = 0; h8 < 8; ++h8) {
            const int h = g * 8 + h8;
            __syncthreads();
            vec[tid] = pvec;
            *(LAS u32x4*)(XTs + t_r0 * TS + t_c) = px0; *(LAS u32x4*)(XTs + t_r1 * TS + t_c) = px1;
            *(LAS u32x4*)(PF + t_r0 * TS + t_c) = pf0; *(LAS u32x4*)(PF + t_r1 * TS + t_c) = pf1;
            *(LAS u32x4*)(PB + t_r0 * TS + t_c) = pb0; *(LAS u32x4*)(PB + t_r1 * TS + t_c) = pb1;
            *(LAS u32x4*)(Zs + (tid >> 3) * ZS + (tid & 7) * 8) = pz0; *(LAS u32x4*)(Zs + (64 + (tid >> 3)) * ZS + (tid & 7) * 8) = pz1;
            if (h8 < 7) S3_PREFETCH(h + 1);
            const int pbY = wave >> 2;
            __syncthreads();
#pragma unroll
            for (int t2 = 0; t2 < 2; ++t2) { const f32x16& Gt = t2 ? G1 : G0; const int sb = sb0 + t2, s = sb * 32 + r;
                const float afs = vec[s], abs_ = vec[128 + s], dfs = vec[256 + s], dbs = vec[384 + s];
                if (sb < lb) {
#pragma unroll
                    for (int i = 0; i < 16; ++i) { const int l = lb * 32 + (i & 3) + 8 * (i >> 2) + 4 * hh;
                        Ms[l * TS + s] = (bf16_t)f2bf(Gt[i] * __expf(vec[l] - afs) * dfs); }
                } else if (sb > lb) {
#pragma unroll
                    for (int i = 0; i < 16; ++i) { const int l = lb * 32 + (i & 3) + 8 * (i >> 2) + 4 * hh;
                        Ms[l * TS + s] = (bf16_t)f2bf(Gt[i] * __expf(vec[128 + l] - abs_) * dbs); }
                } else {
                    const float dsk = dskl[h8];
#pragma unroll
                    for (int i = 0; i < 16; ++i) { const int l = lb * 32 + (i & 3) + 8 * (i >> 2) + 4 * hh;
                        const float ef = __expf(fminf(vec[l] - afs, 0.f)) * dfs, eb = __expf(fminf(vec[128 + l] - abs_, 0.f)) * dbs;
                        const float tf = (s <= l) ? ef : 0.f, tb = (s >= l) ? eb : 0.f;
                        Ms[l * TS + s] = (bf16_t)f2bf(Gt[i] * (tf + tb) + (s == l ? dsk : 0.f)); }
                } }
            __syncthreads();
            { f32x16 Yd = {}, Yf = {}, Yb = {};
#pragma unroll
              for (int ks = 0; ks < 8; ++ks) { const int k0 = ks * 16 + 8 * hh;
                  Yd = __builtin_amdgcn_mfma_f32_32x32x16_bf16(ldfrag(Ms, lb * 32 + r, k0), ldfrag(XTs, pbY * 32 + r, k0), Yd, 0, 0, 0);
                  const bf16x8 a = ldfrag(Cs, lb * 32 + r, k0);
                  Yf = __builtin_amdgcn_mfma_f32_32x32x16_bf16(a, ldfrag(PF, pbY * 32 + r, k0), Yf, 0, 0, 0);
                  Yb = __builtin_amdgcn_mfma_f32_32x32x16_bf16(a, ldfrag(PB, pbY * 32 + r, k0), Yb, 0, 0, 0);
                  if (ks & 1) __builtin_amdgcn_sched_barrier(0); }
#pragma unroll
              for (int i = 0; i < 16; ++i) { const int l = lb * 32 + (i & 3) + 8 * (i >> 2) + 4 * hh;
                  const float y = Yd[i] + __expf(vec[l]) * Yf[i] + __expf(vec[128 + l]) * Yb[i];
                  const float z = bf2f(Zs[l * ZS + pbY * 32 + r]);
                  Zs[l * ZS + pbY * 32 + r] = (bf16_t)f2bf(y * z * sigmoidf_(z)); } }
            __syncthreads();
            *(u32x4*)(YZ + (tok0 + (tid >> 3)) * 1024 + h * 64 + (tid & 7) * 8) = *(const LAS u32x4*)(Zs + (tid >> 3) * ZS + (tid & 7) * 8);
            *(u32x4*)(YZ + (tok0 + 64 + (tid >> 3)) * 1024 + h * 64 + (tid & 7) * 8) = *(const LAS u32x4*)(Zs + (64 + (tid >> 3)) * ZS + (tid & 7) * 8);
        }
#undef S3_PREFETCH
    }
}

__device__ __forceinline__ void phase_rstd(const Params& p, const Ctx& c) {
    const bf16_t* YZ = (const bf16_t*)(p.ws + WS_YZ); float* RSTD = (float*)(p.ws + WS_RSTD);
    const int gw = c.bid * 8 + c.wave, NGW = c.G * 8;
    for (int m0 = gw * 4; m0 < M; m0 += NGW * 4) {
        u32x4 v[4][2];
#pragma unroll
        for (int q = 0; q < 4; ++q) { const u32x4* r = (const u32x4*)(YZ + (size_t)(m0 + q) * 1024) + c.lane; v[q][0] = r[0]; v[q][1] = r[64]; }
#pragma unroll
        for (int q = 0; q < 4; ++q) { float s = 0.f;
#pragma unroll
            for (int j = 0; j < 2; ++j) { const u32x4 w = v[q][j];
                s += bflo(w.x) * bflo(w.x) + bfhi(w.x) * bfhi(w.x) + bflo(w.y) * bflo(w.y) + bfhi(w.y) * bfhi(w.y) + bflo(w.z) * bflo(w.z) + bfhi(w.z) * bfhi(w.z) + bflo(w.w) * bflo(w.w) + bfhi(w.w) * bfhi(w.w); }
            s = wave_sum(s);
            if (c.lane == 0) RSTD[m0 + q] = rsqrtf(s * (1.f / 1024.f) + EPS); }
    }
}

__device__ __forceinline__ void phase_attn_naive(const Params& p, const Ctx& c) {
    unsigned char* ws = p.ws;
    const bf16_t* QN = (const bf16_t*)(ws + WS_QN); const bf16_t* KN = (const bf16_t*)(ws + WS_KN); const bf16_t* VB = (const bf16_t*)(ws + WS_VB);
    bf16_t* AO = (bf16_t*)(ws + WS_AO);
    LAS bf16_t* Ks = (LAS bf16_t*)c.lds; LAS bf16_t* Vs = Ks + 64 * 128;
    const int tid = c.tid, row = tid >> 2, dq = tid & 3;
    constexpr float C = 0.088388347648318440f * 1.4426950408889634f;
    for (int item = c.bid; item < 1024; item += c.G) {
        const int b = item >> 9, h = (item >> 6) & 7, qb = item & 63, kvh = h >> 2;
        const size_t tokq = (size_t)b * S + qb * 128 + row;
        float q[32], o[32];
#pragma unroll
        for (int i = 0; i < 4; ++i) { const u32x4 v = *(const u32x4*)(QN + tokq * 1024 + h * 128 + dq * 32 + i * 8);
            q[i * 8 + 0] = bflo(v.x) * C; q[i * 8 + 1] = bfhi(v.x) * C; q[i * 8 + 2] = bflo(v.y) * C; q[i * 8 + 3] = bfhi(v.y) * C;
            q[i * 8 + 4] = bflo(v.z) * C; q[i * 8 + 5] = bfhi(v.z) * C; q[i * 8 + 6] = bflo(v.w) * C; q[i * 8 + 7] = bfhi(v.w) * C; }
#pragma unroll
        for (int i = 0; i < 32; ++i) o[i] = 0.f;
        float mrun = -1e30f, lrun = 0.f;
        for (int kt = 0; kt < S / 64; ++kt) {
            __syncthreads();
            {
                const int key = tid >> 3, ch = tid & 7;
                const size_t tk = ((size_t)b * S + kt * 64 + key) * 256 + kvh * 128 + ch * 16;
                *(LAS u32x4*)(Ks + key * 128 + ch * 16) = *(const u32x4*)(KN + tk); *(LAS u32x4*)(Ks + key * 128 + ch * 16 + 8) = *(const u32x4*)(KN + tk + 8);
                *(LAS u32x4*)(Vs + key * 128 + ch * 16) = *(const u32x4*)(VB + tk); *(LAS u32x4*)(Vs + key * 128 + ch * 16 + 8) = *(const u32x4*)(VB + tk + 8);
            }
            __syncthreads();
            for (int j = 0; j < 64; ++j) {
                float s = 0.f;
#pragma unroll
                for (int i = 0; i < 4; ++i) { const u32x4 v = *(const LAS u32x4*)(Ks + j * 128 + dq * 32 + i * 8);
                    s = fmaf(q[i * 8 + 0], bflo(v.x), s); s = fmaf(q[i * 8 + 1], bfhi(v.x), s); s = fmaf(q[i * 8 + 2], bflo(v.y), s); s = fmaf(q[i * 8 + 3], bfhi(v.y), s);
                    s = fmaf(q[i * 8 + 4], bflo(v.z), s); s = fmaf(q[i * 8 + 5], bfhi(v.z), s); s = fmaf(q[i * 8 + 6], bflo(v.w), s); s = fmaf(q[i * 8 + 7], bfhi(v.w), s); }
                s += __shfl_xor(s, 1); s += __shfl_xor(s, 2);
                const float mn = fmaxf(mrun, s), al = __builtin_amdgcn_exp2f(mrun - mn), pe = __builtin_amdgcn_exp2f(s - mn);
                mrun = mn; lrun = lrun * al + pe;
#pragma unroll
                for (int i = 0; i < 4; ++i) { const u32x4 v = *(const LAS u32x4*)(Vs + j * 128 + dq * 32 + i * 8);
                    o[i * 8 + 0] = fmaf(pe, bflo(v.x), o[i * 8 + 0] * al); o[i * 8 + 1] = fmaf(pe, bfhi(v.x), o[i * 8 + 1] * al);
                    o[i * 8 + 2] = fmaf(pe, bflo(v.y), o[i * 8 + 2] * al); o[i * 8 + 3] = fmaf(pe, bfhi(v.y), o[i * 8 + 3] * al);
                    o[i * 8 + 4] = fmaf(pe, bflo(v.z), o[i * 8 + 4] * al); o[i * 8 + 5] = fmaf(pe, bfhi(v.z), o[i * 8 + 5] * al);
                    o[i * 8 + 6] = fmaf(pe, bflo(v.w), o[i * 8 + 6] * al); o[i * 8 + 7] = fmaf(pe, bfhi(v.w), o[i * 8 + 7] * al); }
            }
        }
        const float rl = 1.f / lrun;
#pragma unroll
        for (int i = 0; i < 4; ++i) { u32x4 w;
            w.x = pk2(o[i * 8 + 0] * rl, o[i * 8 + 1] * rl); w.y = pk2(o[i * 8 + 2] * rl, o[i * 8 + 3] * rl); w.z = pk2(o[i * 8 + 4] * rl, o[i * 8 + 5] * rl); w.w = pk2(o[i * 8 + 6] * rl, o[i * 8 + 7] * rl);
            *(u32x4*)(AO + tokq * 1024 + h * 128 + dq * 32 + i * 8) = w; }
    }
}

namespace attn {
typedef unsigned short bf16;
constexpr int   D = 128, NW = 8, QBLK = 32, KVBLK = 64;
constexpr float SCALE = 0.088388347648318440f;
constexpr float THR = 8.f;
constexpr int SDEPTH = 2;
constexpr int LDQ = 1024, LDK = 256, LDO = 1024;
constexpr size_t SHM_V = KVBLK * D * 2, SHM_K = KVBLK * D * 2, SHM_ATTN = 2 * SHM_V + 2 * SHM_K + NW * 64 * 4;
using bf16x8 = __attribute__((ext_vector_type(8))) short;
using s16x4  = __attribute__((ext_vector_type(4))) short;
using f32x16 = __attribute__((ext_vector_type(16))) float;
using f32x8  = __attribute__((ext_vector_type(8))) float;
using u32x4  = __attribute__((ext_vector_type(4))) unsigned;
#define KSWZ(row, colB) ((row) * 256 + ((colB) ^ (((row) & 7) << 4)))
#define SBAR() __builtin_amdgcn_sched_barrier(0)
__device__ __forceinline__ int crow(int r, int hi) { return (r & 3) + 8 * (r >> 2) + 4 * hi; }
__device__ __forceinline__ unsigned cvtpk(float lo, float hi) {
  unsigned r; asm volatile("v_cvt_pk_bf16_f32 %0, %1, %2" : "=v"(r) : "v"(lo), "v"(hi)); return r;
}
template <typename TIn> struct Stage;
template <> struct Stage<bf16>  { using T = bf16x8;
  __device__ static __forceinline__ T ld8(const bf16* p) { return *reinterpret_cast<const bf16x8*>(p); }
  __device__ static __forceinline__ bf16x8 tobf(T x) { return x; } };
template <> struct Stage<float> { using T = f32x8;
  __device__ static __forceinline__ T ld8(const float* p) { return *reinterpret_cast<const f32x8*>(p); }
  __device__ static __forceinline__ bf16x8 tobf(T x) {
    u32x4 w = {cvtpk(x[0], x[1]), cvtpk(x[2], x[3]), cvtpk(x[4], x[5]), cvtpk(x[6], x[7])}; return *reinterpret_cast<bf16x8*>(&w); } };

__device__ __forceinline__ void partialSM(f32x16& p0, f32x16& p1, float& m_reg, float& mn, float& alpha) {
  constexpr float C = SCALE * 1.4426950408889634f;
  float pmax = p0[0]; for (int r = 1; r < 16; ++r) pmax = fmaxf(pmax, p0[r]); for (int r = 0; r < 16; ++r) pmax = fmaxf(pmax, p1[r]);
  { auto rr = __builtin_amdgcn_permlane32_swap(__float_as_uint(pmax), __float_as_uint(pmax), false, false);
    pmax = fmaxf(__uint_as_float(rr[0]), __uint_as_float(rr[1])); }
  if (__builtin_expect(__all(pmax - m_reg <= THR / SCALE), 1)) { mn = m_reg; alpha = 1.f; }
  else { mn = fmaxf(m_reg, pmax); alpha = __builtin_amdgcn_exp2f((m_reg - mn) * C); m_reg = mn; }
  float mnC = -mn * C;
  for (int r = 0; r < 16; ++r) p0[r] = fmaf(p0[r], C, mnC); for (int r = 0; r < 16; ++r) p1[r] = fmaf(p1[r], C, mnC);
  for (int r = 0; r < 16; ++r) p0[r] = __builtin_amdgcn_exp2f(p0[r]);
}
__device__ __forceinline__ void finishSM(f32x16& p0, f32x16& p1, float alpha, float& l_reg, bf16x8& pa0, bf16x8& pa1, bf16x8& pa2, bf16x8& pa3) {
  for (int r = 0; r < 16; ++r) p1[r] = __builtin_amdgcn_exp2f(p1[r]);
  float ps = 0; for (int r = 0; r < 16; ++r) ps += p0[r]; for (int r = 0; r < 16; ++r) ps += p1[r];
  { auto rr = __builtin_amdgcn_permlane32_swap(__float_as_uint(ps), __float_as_uint(ps), false, false);
    ps = __uint_as_float(rr[0]) + __uint_as_float(rr[1]); }
  l_reg = l_reg * alpha + ps;
#define PK4(P, BASE, OUT) do { unsigned a0 = cvtpk(P[BASE + 0], P[BASE + 1]), a1 = cvtpk(P[BASE + 2], P[BASE + 3]);   \
    unsigned b0 = cvtpk(P[BASE + 4], P[BASE + 5]), b1 = cvtpk(P[BASE + 6], P[BASE + 7]);                              \
    auto r0 = __builtin_amdgcn_permlane32_swap(a0, b0, false, false); auto r1 = __builtin_amdgcn_permlane32_swap(a1, b1, false, false); \
    u32x4 w = {r0[0], r1[0], r0[1], r1[1]}; OUT = *reinterpret_cast<bf16x8*>(&w); } while (0)
  PK4(p0, 0, pa0); PK4(p0, 8, pa1); PK4(p1, 0, pa2); PK4(p1, 8, pa3);
#undef PK4
}
__device__ __forceinline__ void qkt(f32x16& p0, f32x16& p1, const bf16* Ks, const bf16x8* qr, int r32, int hi) {
  p0 = f32x16{}; p1 = f32x16{};
  for (int d0 = 0; d0 < 8; ++d0) { int cb = (d0 * 16 + hi * 8) * 2;
    bf16x8 b0 = *reinterpret_cast<const bf16x8*>((const char*)Ks + KSWZ(r32, cb));
    bf16x8 b1 = *reinterpret_cast<const bf16x8*>((const char*)Ks + KSWZ(32 + r32, cb));
    p0 = __builtin_amdgcn_mfma_f32_32x32x16_bf16(b0, qr[d0], p0, 0, 0, 0);
    p1 = __builtin_amdgcn_mfma_f32_32x32x16_bf16(b1, qr[d0], p1, 0, 0, 0); }
}
__device__ __forceinline__ int v_st(int k, int c) { const int kk = (k & ~0xC) | ((k & 4) << 1) | ((k & 8) >> 1); return ((kk >> 3) * 4 + (c >> 5)) * 512 + ((kk & 7) * 32 + (c & 31)) * 2; }
__device__ __forceinline__ int v_rd_base(int lane) { return ((lane & 3) << 3) | (((lane >> 2) & 3) << 6) | (((lane >> 4) & 1) << 5) | (((lane >> 5) & 1) << 8); }
constexpr int v_rd_off(int d0, int ks, int half) { return d0 * 512 + ks * 4096 + half * 2048; }
template <int OFF> __device__ __forceinline__ s16x4 tr_read(int vb) {
  s16x4 r; asm volatile("ds_read_b64_tr_b16 %0, %1 offset:%2" : "=&v"(r) : "v"(vb), "i"(OFF) : "memory"); return r;
}
template <int D0> __device__ __forceinline__ void pv_one(f32x16& od, int vb, bf16x8 pa0, bf16x8 pa1, bf16x8 pa2, bf16x8 pa3) {
  const s16x4 l0 = tr_read<v_rd_off(D0, 0, 0)>(vb), h0 = tr_read<v_rd_off(D0, 0, 1)>(vb), l1 = tr_read<v_rd_off(D0, 1, 0)>(vb), h1 = tr_read<v_rd_off(D0, 1, 1)>(vb);
  const s16x4 l2 = tr_read<v_rd_off(D0, 2, 0)>(vb), h2 = tr_read<v_rd_off(D0, 2, 1)>(vb), l3 = tr_read<v_rd_off(D0, 3, 0)>(vb), h3 = tr_read<v_rd_off(D0, 3, 1)>(vb);
  asm volatile("s_waitcnt lgkmcnt(0)" ::: "memory"); SBAR();
#define PK(L, H) (bf16x8){L[0], L[1], L[2], L[3], H[0], H[1], H[2], H[3]}
  od = __builtin_amdgcn_mfma_f32_32x32x16_bf16(pa0, PK(l0, h0), od, 0, 0, 0);
  od = __builtin_amdgcn_mfma_f32_32x32x16_bf16(pa1, PK(l1, h1), od, 0, 0, 0);
  od = __builtin_amdgcn_mfma_f32_32x32x16_bf16(pa2, PK(l2, h2), od, 0, 0, 0);
  od = __builtin_amdgcn_mfma_f32_32x32x16_bf16(pa3, PK(l3, h3), od, 0, 0, 0);
#undef PK
}
__device__ __forceinline__ void pv_d0(f32x16* o, int vb, bf16x8 pa0, bf16x8 pa1, bf16x8 pa2, bf16x8 pa3) {
  pv_one<0>(o[0], vb, pa0, pa1, pa2, pa3); pv_one<1>(o[1], vb, pa0, pa1, pa2, pa3); pv_one<2>(o[2], vb, pa0, pa1, pa2, pa3); pv_one<3>(o[3], vb, pa0, pa1, pa2, pa3);
}

template <typename TQ>
__device__ __forceinline__ void attn_dense_body(const TQ* __restrict__ Qb, const bf16* __restrict__ Kh, const bf16* __restrict__ Vh,
                                                bf16* __restrict__ Ob, int seq, char* lds) {
  using St = Stage<bf16>; using SQ = Stage<TQ>;
  const int tid = threadIdx.x, wid = tid >> 6, lane = tid & 63, r32 = lane & 31, hi = lane >> 5;
  bf16* V_lds = (bf16*)lds; bf16* K_lds = (bf16*)(lds + 2 * SHM_V);
  float* ws = (float*)(lds + 2 * SHM_V + 2 * SHM_K) + wid * 64; float* li_l = ws; float* al_l = ws + 32;
  float m_reg = -1e30f, l_reg = 0; f32x16 o[4] = {}; bf16x8 qr[8];
  const TQ* Qw = Qb + (long)(wid * QBLK + r32) * LDQ + hi * 8;
#pragma unroll
  for (int d0 = 0; d0 < 8; ++d0) qr[d0] = SQ::tobf(SQ::ld8(Qw + d0 * 16));
  const int sr = tid >> 4, sc = (tid & 15) * 8, vst0 = v_st(sr, sc), vst1 = v_st(32 + sr, sc);
  const int vb0 = (int)(uintptr_t)V_lds + v_rd_base(lane);
  struct { typename St::T vs0, vs1, ks0, ks1; } sr_[SDEPTH];
#define SLOAD(i, k0) do { sr_[i].vs0 = St::ld8(&Vh[(long)((k0) + sr) * LDK + sc]); sr_[i].vs1 = St::ld8(&Vh[(long)((k0) + 32 + sr) * LDK + sc]); \
    sr_[i].ks0 = St::ld8(&Kh[(long)((k0) + sr) * LDK + sc]); sr_[i].ks1 = St::ld8(&Kh[(long)((k0) + 32 + sr) * LDK + sc]); } while (0)
#define SWRITE(b, i) do { *(bf16x8*)((char*)V_lds + (b) * SHM_V + vst0) = St::tobf(sr_[i].vs0);          \
    *(bf16x8*)((char*)V_lds + (b) * SHM_V + vst1) = St::tobf(sr_[i].vs1); int kc = sc * 2;               \
    *(bf16x8*)((char*)K_lds + (b) * SHM_K + KSWZ(sr, kc)) = St::tobf(sr_[i].ks0);                       \
    *(bf16x8*)((char*)K_lds + (b) * SHM_K + KSWZ(32 + sr, kc)) = St::tobf(sr_[i].ks1); } while (0)
#define SWAIT() do { if constexpr (SDEPTH == 2) asm volatile("s_waitcnt vmcnt(4)" ::: "memory"); else asm volatile("s_waitcnt vmcnt(0)" ::: "memory"); } while (0)
#define RESC(a) do { if (__any((a) < 1.f)) { if (hi == 0) al_l[r32] = (a); asm volatile("s_waitcnt lgkmcnt(0)" ::: "memory"); \
    for (int d = 0; d < 4; ++d) for (int r = 0; r < 16; ++r) o[d][r] *= al_l[crow(r, hi)]; } } while (0)
  f32x16 pA0, pA1, pB0, pB1; float mnA, mnB, alA, alB; bf16x8 pa0, pa1, pa2, pa3; const int NT = seq / KVBLK;
  constexpr int SE = 0, SO = SDEPTH - 1;
  SLOAD(SE, 0); asm volatile("s_waitcnt vmcnt(0)" ::: "memory"); SWRITE(0, SE); __syncthreads();
  qkt(pA0, pA1, K_lds, qr, r32, hi); partialSM(pA0, pA1, m_reg, mnA, alA);
  SLOAD(SO, KVBLK); if constexpr (SDEPTH == 2) { if (2 < NT) SLOAD(SE, 2 * KVBLK); }
  SWAIT(); SWRITE(1, SO); __syncthreads();
  for (int j = 1; j + 1 < NT; j += 2) {
    SBAR(); qkt(pB0, pB1, (bf16*)((char*)K_lds + SHM_K), qr, r32, hi);
    finishSM(pA0, pA1, alA, l_reg, pa0, pa1, pa2, pa3); SBAR();
    SLOAD(SO, (j + SDEPTH) * KVBLK); SBAR();
    pv_d0(o, vb0, pa0, pa1, pa2, pa3); partialSM(pB0, pB1, m_reg, mnB, alB);
    __syncthreads(); SWAIT(); SWRITE(0, SE);
    RESC(alB); __syncthreads();
    SBAR(); qkt(pA0, pA1, K_lds, qr, r32, hi);
    finishSM(pB0, pB1, alB, l_reg, pa0, pa1, pa2, pa3); SBAR();
    if (SDEPTH == 1 || j + 3 < NT) SLOAD(SE, (j + 1 + SDEPTH) * KVBLK); SBAR();
    pv_d0(o, vb0 + (int)SHM_V, pa0, pa1, pa2, pa3); partialSM(pA0, pA1, m_reg, mnA, alA);
    __syncthreads(); SWAIT(); SWRITE(1, SO);
    RESC(alA); __syncthreads();
  }
  SBAR(); qkt(pB0, pB1, (bf16*)((char*)K_lds + SHM_K), qr, r32, hi);
  finishSM(pA0, pA1, alA, l_reg, pa0, pa1, pa2, pa3); SBAR();
  pv_d0(o, vb0, pa0, pa1, pa2, pa3); partialSM(pB0, pB1, m_reg, mnB, alB);
  __syncthreads(); RESC(alB);
  finishSM(pB0, pB1, alB, l_reg, pa0, pa1, pa2, pa3); SBAR();
  pv_d0(o, vb0 + (int)SHM_V, pa0, pa1, pa2, pa3);
  if (hi == 0) li_l[r32] = l_reg; asm volatile("s_waitcnt lgkmcnt(0)" ::: "memory");
  float rli[16];
#pragma unroll
  for (int r = 0; r < 16; ++r) rli[r] = __builtin_amdgcn_rcpf(li_l[crow(r, hi)]);
  bf16* Ow = Ob + (long)(wid * QBLK) * LDO;
#pragma unroll
  for (int r = 0; r < 16; ++r) { int orow = crow(r, hi);
    for (int d0 = 0; d0 < 4; ++d0) Ow[(long)orow * LDO + d0 * 32 + r32] = (bf16)f2bf(o[d0][r] * rli[r]); }
#undef SLOAD
#undef SWRITE
#undef SWAIT
#undef RESC
}
}

__device__ __forceinline__ void phase_attn(const Params& p, const Ctx& c, char* lds_generic) {
    unsigned char* ws = p.ws;
    const bf16_t* QN = (const bf16_t*)(ws + WS_QN); const bf16_t* KN = (const bf16_t*)(ws + WS_KN); const bf16_t* VB = (const bf16_t*)(ws + WS_VB); bf16_t* AO = (bf16_t*)(ws + WS_AO);
    for (int item = c.bid; item < 512; item += c.G) {
        const int b = item >> 8, h = (item >> 5) & 7, qb = item & 31, kvh = h >> 2;
        const size_t q0 = ((size_t)b * S + qb * 256) * 1024 + h * 128, k0 = (size_t)b * S * 256 + kvh * 128;
        attn::attn_dense_body<attn::bf16>(QN + q0, KN + k0, VB + k0, AO + q0, S, lds_generic);
        __syncthreads();
    }
}

struct EpiT1 { bf16_t* T1; const bf16_t* P; const float* RSTD; int n0;
    __device__ __forceinline__ void operator()(int r, int cl, float a, float) const { const int col = n0 + cl;
        T1[(size_t)r * 1024 + col] = (bf16_t)f2bf(a * RSTD[r] * sigmoidf_(bf2f(P[(size_t)r * NPROJ + PG + col]))); } };
struct EpiT2 { bf16_t* MG; const bf16_t* T1; const bf16_t* P; int n0;
    __device__ __forceinline__ void operator()(int r, int cl, float a, float) const { const int col = n0 + cl;
        MG[(size_t)r * 1024 + col] = (bf16_t)f2bf(bf2f(T1[(size_t)r * 1024 + col]) + a * sigmoidf_(bf2f(P[(size_t)r * NPROJ + PG + 1024 + col]))); } };
struct EpiT3 { float* X1; const float* x; int n0;
    __device__ __forceinline__ void operator()(int r, int cl, float a, float) const { const size_t o = (size_t)r * 1024 + n0 + cl; X1[o] = x[o] + a; } };
template <int WHICH> __device__ __forceinline__ void phase_tail_naive(const Params& p, const Ctx& c) {
    unsigned char* ws = p.ws;
    for (int it = c.bid; it < (M / 128) * 16; it += c.G) {
        const int mt = it >> 4, nt = it & 15;
        if (WHICH == 0) ngemm_tile<false>(ARowPlain{(const bf16_t*)(ws + WS_YZ), 1024}, (const bf16_t*)(ws + WS_WST) + (size_t)nt * 64 * 1024, nullptr, 1024, mt * 128,
                                          EpiT1{(bf16_t*)(ws + WS_T1), (const bf16_t*)(ws + WS_P), (const float*)(ws + WS_RSTD), nt * 64}, (LAS float*)c.lds, c.tid);
        if (WHICH == 1) ngemm_tile<false>(ARowPlain{(const bf16_t*)(ws + WS_AO), 1024}, (const bf16_t*)(ws + WS_WAT) + (size_t)nt * 64 * 1024, nullptr, 1024, mt * 128,
                                          EpiT2{(bf16_t*)(ws + WS_MG), (const bf16_t*)(ws + WS_T1), (const bf16_t*)(ws + WS_P), nt * 64}, (LAS float*)c.lds, c.tid);
        if (WHICH == 2) ngemm_tile<false>(ARowPlain{(const bf16_t*)(ws + WS_MG), 1024}, (const bf16_t*)(ws + WS_WOT) + (size_t)nt * 64 * 1024, nullptr, 1024, mt * 128,
                                          EpiT3{(float*)(ws + WS_X1), p.in[0], nt * 64}, (LAS float*)c.lds, c.tid);
    }
}

__device__ __forceinline__ void phase_router(const Params& p, const Ctx& c) {
    unsigned char* ws = p.ws;
    LAS float* wT = (LAS float*)c.lds;
    LAS int* tokE = (LAS int*)(c.lds + LDS_CTL + 512);
    LAS float* tokW = (LAS float*)(c.lds + LDS_CTL + 512 + 1024);
    LAS int* lcnt = (LAS int*)(c.lds + LDS_CTL + 512 + 2048);
    LAS int* lbase = lcnt + 32;
    LAS int* lrank = lbase + 32;
    const float* X1 = (const float*)(ws + WS_X1); bf16_t* H2 = (bf16_t*)(ws + WS_H2);
    int* CNT = (int*)(ws + WS_CTL); int* TOKES = (int*)(ws + WS_TOKES); float* TOKW = (float*)(ws + WS_TOKW); int* LIST = (int*)(ws + WS_LIST);
    const int tid = c.tid, lane = c.lane;
    __syncthreads();
    { const f32x4* src = (const f32x4*)(ws + WS_WRT); for (int idx = tid; idx < 8192; idx += 512) ((LAS f32x4*)wT)[idx] = src[idx]; }
    __syncthreads();
    f32x4 gv[4];
#pragma unroll
    for (int j = 0; j < 4; ++j) gv[j] = ((const f32x4*)p.in[16])[lane + 64 * j];
    const float bias_e = p.in[18][(lane >> 1) & 31];
    for (int blk = c.bid; blk < M / 64; blk += c.G) {
        if (tid < 32) lcnt[tid] = 0;
        for (int pr = 0; pr < 4; ++pr) {
            const int tl = c.wave * 8 + pr * 2;
            const size_t tokA = (size_t)blk * 64 + tl;
            f32x4 hA[4], hB[4];
            {
                const f32x4* xa = (const f32x4*)(X1 + tokA * 1024) + lane; const f32x4* xb = xa + 256;
                float sa = 0.f, sb = 0.f;
#pragma unroll
                for (int j = 0; j < 4; ++j) { hA[j] = xa[64 * j]; hB[j] = xb[64 * j];
                    sa += (hA[j].x * hA[j].x + hA[j].y * hA[j].y) + (hA[j].z * hA[j].z + hA[j].w * hA[j].w);
                    sb += (hB[j].x * hB[j].x + hB[j].y * hB[j].y) + (hB[j].z * hB[j].z + hB[j].w * hB[j].w); }
                const float ra = rsqrtf(wave_sum(sa) * (1.f / 1024.f) + EPS), rb = rsqrtf(wave_sum(sb) * (1.f / 1024.f) + EPS);
                u32x2* oa = (u32x2*)(H2 + tokA * 1024) + lane; u32x2* ob = oa + 256;
#pragma unroll
                for (int j = 0; j < 4; ++j) { hA[j] = hA[j] * ra * gv[j]; hB[j] = hB[j] * rb * gv[j];
                    u32x2 w; w.x = pk2(hA[j].x, hA[j].y); w.y = pk2(hA[j].z, hA[j].w); oa[64 * j] = w;
                    w.x = pk2(hB[j].x, hB[j].y); w.y = pk2(hB[j].z, hB[j].w); ob[64 * j] = w; }
            }
            float accA[32], accB[32];
#pragma unroll
            for (int e = 0; e < 32; ++e) {
                float a = 0.f, b = 0.f;
#pragma unroll
                for (int j = 0; j < 4; ++j) { const f32x4 w = *(const LAS f32x4*)&wT[e * 1024 + 256 * j + 4 * lane];
                    a = fmaf(hA[j].x, w.x, a); a = fmaf(hA[j].y, w.y, a); a = fmaf(hA[j].z, w.z, a); a = fmaf(hA[j].w, w.w, a);
                    b = fmaf(hB[j].x, w.x, b); b = fmaf(hB[j].y, w.y, b); b = fmaf(hB[j].z, w.z, b); b = fmaf(hB[j].w, w.w, b); }
                accA[e] = a; accB[e] = b;
                if (e & 1) __builtin_amdgcn_sched_barrier(0);
            }
#define RSTEP(N, BIT) _Pragma("unroll") for (int i = 0; i < N; ++i) { const bool up = (lane & BIT) != 0; \
                const float ka = up ? accA[N + i] : accA[i], sa_ = up ? accA[i] : accA[N + i]; accA[i] = ka + __shfl_xor(sa_, BIT); \
                const float kb = up ? accB[N + i] : accB[i], sb_ = up ? accB[i] : accB[N + i]; accB[i] = kb + __shfl_xor(sb_, BIT); }
            RSTEP(16, 32) RSTEP(8, 16) RSTEP(4, 8) RSTEP(2, 4) RSTEP(1, 2)
#undef RSTEP
            const float la = accA[0] + __shfl_xor(accA[0], 1) + bias_e, lb = accB[0] + __shfl_xor(accB[0], 1) + bias_e;
            const int my_e = (lane >> 1) & 31;
#pragma unroll
            for (int t2 = 0; t2 < 2; ++t2) {
                float val = t2 ? lb : la;
                int se[4]; float sv[4];
#pragma unroll
                for (int k = 0; k < 4; ++k) {
                    const float mx = wave_max(val);
                    const int sel = wave_min_i(val == mx ? my_e : 64);
                    se[k] = sel; sv[k] = mx;
                    if (my_e == sel) val = -INFINITY;
                }
                const float e1 = __expf(sv[1] - sv[0]), e2 = __expf(sv[2] - sv[0]), e3 = __expf(sv[3] - sv[0]);
                const float inv = 1.f / (1.f + e1 + e2 + e3);
                if (lane == 0) {
                    const int t = tl + t2;
                    tokE[t * 4 + 0] = se[0]; tokE[t * 4 + 1] = se[1]; tokE[t * 4 + 2] = se[2]; tokE[t * 4 + 3] = se[3];
                    tokW[t * 4 + 0] = inv; tokW[t * 4 + 1] = e1 * inv; tokW[t * 4 + 2] = e2 * inv; tokW[t * 4 + 3] = e3 * inv;
                }
            }
        }
        __syncthreads();
        if (tid < 256) lrank[tid] = atomicAdd((int*)&lcnt[tokE[tid]], 1);
        __syncthreads();
        if (tid < 32) lbase[tid] = lcnt[tid] ? atomicAdd(&CNT[tid], lcnt[tid]) : 0;
        __syncthreads();
        if (tid < 256) {
            const int e = tokE[tid], slot = lbase[e] + lrank[tid], tok = blk * 64 + (tid >> 2);
            LIST[e * 16384 + slot] = tok; TOKES[tok * 4 + (tid & 3)] = (e << 16) | slot; TOKW[tok * 4 + (tid & 3)] = tokW[tid];
        }
        __syncthreads();
    }
}

__device__ __forceinline__ void load_offs(const Params& p, const Ctx& c, LAS int*& offs, LAS int*& cnt) {
    offs = (LAS int*)(c.lds + LDS_CTL); cnt = offs + 40;
    __syncthreads();
    if (c.tid == 0) {
        const int* CNT = (const int*)(p.ws + WS_CTL); int run = 0;
        for (int e = 0; e < 32; ++e) { const int n = __hip_atomic_load(CNT + e, __ATOMIC_RELAXED, __HIP_MEMORY_SCOPE_AGENT); cnt[e] = n; offs[e] = run; run += (n + 255) & ~255; }
        offs[32] = run;
    }
    __syncthreads();
}
__device__ __forceinline__ int find_expert(const LAS int* offs, int row) { int e = 0; while (e < 31 && row >= offs[e + 1]) ++e; return e; }

__device__ __forceinline__ void phase_gather(const Params& p, const Ctx& c) {
    LAS int* offs; LAS int* cnt; load_offs(p, c, offs, cnt);
    const bf16_t* H2 = (const bf16_t*)(p.ws + WS_H2); bf16_t* XB = (bf16_t*)(p.ws + WS_XB); const int* LIST = (const int*)(p.ws + WS_LIST);
    const int gw = c.bid * 8 + c.wave, NGW = c.G * 8, total = offs[32];
    for (int row0 = gw * 4; row0 < total; row0 += NGW * 4) {
        const int e = find_expert(offs, row0), slot0 = row0 - offs[e], n = cnt[e];
        int tok[4];
#pragma unroll
        for (int q = 0; q < 4; ++q) tok[q] = (slot0 + q < n) ? LIST[e * 16384 + slot0 + q] : -1;
        u32x4 v[4][2];
#pragma unroll
        for (int q = 0; q < 4; ++q) { v[q][0] = (u32x4){0u, 0u, 0u, 0u}; v[q][1] = v[q][0];
            if (tok[q] >= 0) { const u32x4* s = (const u32x4*)(H2 + (size_t)tok[q] * 1024); v[q][0] = s[c.lane]; v[q][1] = s[c.lane + 64]; } }
#pragma unroll
        for (int q = 0; q < 4; ++q) { u32x4* d = (u32x4*)(XB + (size_t)(row0 + q) * 1024); d[c.lane] = v[q][0]; d[c.lane + 64] = v[q][1]; }
    }
}

struct EpiAct { bf16_t* ACT; const float* b1; int j0;
    __device__ __forceinline__ void operator()(int r, int cl, float g, float u) const { const int j = j0 + cl;
        g = fminf(g + b1[j], 7.f); u = fminf(fmaxf(u + b1[1024 + j], -7.f), 7.f);
        ACT[(size_t)r * 1024 + j] = (bf16_t)f2bf(g * sigmoidf_(1.702f * g) * (u + 1.f)); } };
struct EpiY { bf16_t* YB; const float* b2; int n0;
    __device__ __forceinline__ void operator()(int r, int cl, float a, float) const { const int col = n0 + cl; YB[(size_t)r * 1024 + col] = (bf16_t)f2bf(a + b2[col]); } };
template <int WHICH> __device__ __forceinline__ void phase_moe_naive(const Params& p, const Ctx& c) {
    LAS int* offs; LAS int* cnt; load_offs(p, c, offs, cnt);
    unsigned char* ws = p.ws;
    const int nrt = offs[32] / 128;
    for (int it = c.bid; it < nrt * 16; it += c.G) {
        const int rt = it >> 4, ct = it & 15, row0 = rt * 128, e = find_expert(offs, row0);
        if (WHICH == 0) {
            const int j0 = ct * 64, nt = j0 >> 7, jj = j0 & 127;
            const bf16_t* Wg = (const bf16_t*)(ws + WS_W1T) + ((size_t)e * 2048 + nt * 256 + jj) * 1024;
            ngemm_tile<true>(ARowPlain{(const bf16_t*)(ws + WS_XB), 1024}, Wg, Wg + (size_t)128 * 1024, 1024, row0,
                             EpiAct{(bf16_t*)(ws + WS_ACT), p.in[20] + (size_t)e * 2048, j0}, (LAS float*)c.lds, c.tid);
        } else {
            const bf16_t* W = (const bf16_t*)(ws + WS_W2T) + ((size_t)e * 1024 + ct * 64) * 1024;
            ngemm_tile<false>(ARowPlain{(const bf16_t*)(ws + WS_ACT), 1024}, W, nullptr, 1024, row0,
                              EpiY{(bf16_t*)(ws + WS_YB), p.in[22] + (size_t)e * 1024, ct * 64}, (LAS float*)c.lds, c.tid);
        }
    }
}


__device__ __forceinline__ void phase_gemm1(const Params& p, const Ctx& c) {
    pg8::Gemm g{(const bf16_t*)(p.ws + WS_H), (const bf16_t*)(p.ws + WS_WINT), M, NPROJ, 1024};
    pg8::StaticOrder S; S.init(M, NPROJ, c.G, c.bid);
    pg8::EpiStore E{(bf16_t*)(p.ws + WS_P), NPROJ};
    pg8::gemm_phase<pg8::EpiStore, pg8::StaticOrder, true, true>(c.lds, g, S, E);
}
template <int WHICH> __device__ __forceinline__ void phase_tail(const Params& p, const Ctx& c) {
    unsigned char* ws = p.ws;
    pg8::StaticOrder S; S.init(M, 1024, c.G, c.bid);
    if (WHICH == 0) { pg8::Gemm g{(const bf16_t*)(ws + WS_YZ), (const bf16_t*)(ws + WS_WST), M, 1024, 1024};
        pg8::EpiT1 E{(bf16_t*)(ws + WS_T1), (const bf16_t*)(ws + WS_P) + PG, NPROJ, (const float*)(ws + WS_RSTD)};
        pg8::gemm_phase<pg8::EpiT1, pg8::StaticOrder, true, true>(c.lds, g, S, E); }
    if (WHICH == 1) { pg8::Gemm g{(const bf16_t*)(ws + WS_AO), (const bf16_t*)(ws + WS_WAT), M, 1024, 1024};
        pg8::EpiT2 E{(bf16_t*)(ws + WS_MG), (const bf16_t*)(ws + WS_T1), (const bf16_t*)(ws + WS_P) + PG + 1024, NPROJ};
        pg8::gemm_phase<pg8::EpiT2, pg8::StaticOrder, true, true>(c.lds, g, S, E); }
    if (WHICH == 2) { pg8::Gemm g{(const bf16_t*)(ws + WS_MG), (const bf16_t*)(ws + WS_WOT), M, 1024, 1024};
        pg8::EpiT3 E{(float*)(ws + WS_X1), p.in[0]};
        pg8::gemm_phase<pg8::EpiT3, pg8::StaticOrder, true, true>(c.lds, g, S, E); }
}
template <int WHICH> __device__ __forceinline__ void phase_moe(const Params& p, const Ctx& c) {
    LAS int* offs; LAS int* cnt; load_offs(p, c, offs, cnt);
    unsigned char* ws = p.ws;
    if (WHICH == 0) { pg8::Gemm g{(const bf16_t*)(ws + WS_XB), (const bf16_t*)(ws + WS_W1T), ROWS_MAX, 32 * 2048, 1024};
        pg8::MoeOrder S{offs, 8, c.G, c.bid, offs[32] / 256};
        pg8::EpiAct E{(bf16_t*)(ws + WS_ACT), p.in[20]};
        pg8::gemm_phase<pg8::EpiAct, pg8::MoeOrder, true, true>(c.lds, g, S, E); }
    else { pg8::Gemm g{(const bf16_t*)(ws + WS_ACT), (const bf16_t*)(ws + WS_W2T), ROWS_MAX, 32 * 1024, 1024};
        pg8::MoeOrder S{offs, 4, c.G, c.bid, offs[32] / 256};
        pg8::EpiY E{(bf16_t*)(ws + WS_YB), p.in[22]};
        pg8::gemm_phase<pg8::EpiY, pg8::MoeOrder, true, true>(c.lds, g, S, E); }
}

__device__ __forceinline__ void phase_combine(const Params& p, const Ctx& c) {
    LAS int* offs; LAS int* cnt; load_offs(p, c, offs, cnt);
    unsigned char* ws = p.ws;
    const float* X1 = (const float*)(ws + WS_X1); const bf16_t* YB = (const bf16_t*)(ws + WS_YB);
    const int* TOKES = (const int*)(ws + WS_TOKES); const float* TOKW = (const float*)(ws + WS_TOKW);
    const int gw = c.bid * 8 + c.wave, NGW = c.G * 8, lane = c.lane;
    f32x4 gv[4];
#pragma unroll
    for (int j = 0; j < 4; ++j) gv[j] = ((const f32x4*)p.in[23])[lane + 64 * j];
    for (int m0 = gw * 2; m0 < M; m0 += NGW * 2) {
        int es[2][4]; float wq[2][4];
#pragma unroll
        for (int t = 0; t < 2; ++t)
#pragma unroll
            for (int k = 0; k < 4; ++k) { es[t][k] = TOKES[(m0 + t) * 4 + k]; wq[t][k] = TOKW[(m0 + t) * 4 + k]; }
        f32x4 v[2][4]; u32x2 y[2][4][4];
#pragma unroll
        for (int t = 0; t < 2; ++t) { const f32x4* xr = (const f32x4*)(X1 + (size_t)(m0 + t) * 1024) + lane;
#pragma unroll
            for (int j = 0; j < 4; ++j) v[t][j] = xr[64 * j];
#pragma unroll
            for (int k = 0; k < 4; ++k) { const int row = offs[es[t][k] >> 16] + (es[t][k] & 0xffff); const u32x2* yr = (const u32x2*)(YB + (size_t)row * 1024) + lane;
#pragma unroll
                for (int j = 0; j < 4; ++j) y[t][k][j] = yr[64 * j]; } }
#pragma unroll
        for (int t = 0; t < 2; ++t) {
#pragma unroll
            for (int k = 0; k < 4; ++k) { const float w = wq[t][k];
#pragma unroll
                for (int j = 0; j < 4; ++j) { const u32x2 yy = y[t][k][j];
                    v[t][j].x = fmaf(w, bflo(yy.x), v[t][j].x); v[t][j].y = fmaf(w, bfhi(yy.x), v[t][j].y); v[t][j].z = fmaf(w, bflo(yy.y), v[t][j].z); v[t][j].w = fmaf(w, bfhi(yy.y), v[t][j].w); } }
            float s = 0.f;
#pragma unroll
            for (int j = 0; j < 4; ++j) s += (v[t][j].x * v[t][j].x + v[t][j].y * v[t][j].y) + (v[t][j].z * v[t][j].z + v[t][j].w * v[t][j].w);
            const float rstd = rsqrtf(wave_sum(s) * (1.f / 1024.f) + EPS);
            f32x4* o = (f32x4*)(p.out + (size_t)(m0 + t) * 1024) + lane;
#pragma unroll
            for (int j = 0; j < 4; ++j) o[64 * j] = v[t][j] * rstd * gv[j];
        }
    }
}

constexpr int NPHASE = 15;
__global__ void __launch_bounds__(512) mega(Params p) {
    extern __shared__ __attribute__((aligned(16))) unsigned char lds_raw[];
    Ctx c; c.tid = threadIdx.x; c.lane = c.tid & 63; c.wave = __builtin_amdgcn_readfirstlane(c.tid >> 6); c.bid = blockIdx.x; c.G = gridDim.x;
    c.lds = (LAS unsigned char*)lds_raw;
    cg::grid_group grid = cg::this_grid();
#define RUN(k, call) if (p.ph_lo <= (k) && (k) < p.ph_hi) { call; if ((k) + 1 < p.ph_hi) grid.sync(); }
    RUN(0, phase_prep(p, c))
    RUN(1, phase_gemm1(p, c))
    RUN(2, phase_conv(p, c))
    RUN(3, phase_ssd_states(p, c))
    RUN(4, phase_ssd_scan(p, c))
    RUN(5, phase_ssd_out(p, c))
    RUN(6, phase_rstd(p, c); phase_attn(p, c, (char*)lds_raw))
    RUN(7, phase_tail<0>(p, c))
    RUN(8, phase_tail<1>(p, c))
    RUN(9, phase_tail<2>(p, c))
    RUN(10, phase_router(p, c))
    RUN(11, phase_gather(p, c))
    RUN(12, phase_moe<0>(p, c))
    RUN(13, phase_moe<1>(p, c))
    RUN(14, phase_combine(p, c))
#undef RUN
}

extern "C" void kernel_launch(void* const* d_in, const int* in_sizes, int n_in, void* d_out, int out_size, void* d_ws, size_t ws_size, hipStream_t stream) {
    static int ok = 0; static int grid_blocks = 0;
    if (ok == 0) {
        if (n_in != 24 || out_size != M * D || ws_size < WS_END) { fprintf(stderr, "kernel_launch: unexpected shapes: n_in %d out %d ws %zu (need %zu)\n", n_in, out_size, ws_size, (size_t)WS_END); ok = -1; return; }
        if (hipFuncSetAttribute((const void*)mega, hipFuncAttributeMaxDynamicSharedMemorySize, LDS_BYTES) != hipSuccess) { fprintf(stderr, "kernel_launch: hipFuncSetAttribute failed\n"); ok = -1; return; }
        int dev = 0, cus = 0, per_cu = 0;
        hipGetDevice(&dev);
        hipDeviceGetAttribute(&cus, hipDeviceAttributeMultiprocessorCount, dev);
        hipOccupancyMaxActiveBlocksPerMultiprocessor(&per_cu, (const void*)mega, 512, LDS_BYTES);
        if (per_cu < 1 || cus < 1) { fprintf(stderr, "kernel_launch: occupancy query gave %d blocks/CU on %d CUs\n", per_cu, cus); ok = -1; return; }
        grid_blocks = cus;
        ok = 1;
    }
    if (ok < 0) return;
    Params p{};
    for (int i = 0; i < 24; ++i) p.in[i] = (const float*)d_in[i];
    p.out = (float*)d_out; p.ws = (unsigned char*)d_ws;
    p.ph_lo = 0; p.ph_hi = NPHASE;
    void* args[] = {&p};
    hipError_t e = hipLaunchCooperativeKernel((const void*)mega, dim3(grid_blocks), dim3(512), args, LDS_BYTES, stream);
    if (e != hipSuccess) fprintf(stderr, "kernel_launch: cooperative launch failed: %s (grid %d)\n", hipGetErrorString(e), grid_blocks);
}
```

```cpp
#include <hip/hip_runtime.h>
#include <hip/hip_cooperative_groups.h>
#include <cstdio>
#include <cstdint>

namespace cg = cooperative_groups;
#define LAS __attribute__((address_space(3)))
typedef unsigned short bf16_t;
typedef unsigned u32x4 __attribute__((ext_vector_type(4)));
typedef unsigned u32x2 __attribute__((ext_vector_type(2)));
typedef float f32x4 __attribute__((ext_vector_type(4)));

constexpr int NB = 2, S = 8192, D = 1024, M = NB * S;
constexpr int NPROJ = 6400;
constexpr int PZ = 0, PXBC = 1024, PQ = 2560, PK = 3584, PV = 3840, PG = 4096, PDT = 6144;
constexpr int ROWS_MAX = 65536 + 32 * 256;
constexpr float EPS = 1e-6f;

constexpr size_t al256(size_t x) { return (x + 255) / 256 * 256; }
constexpr size_t WS_CTL = 0;
constexpr size_t WS_ROPE = 4096;
constexpr size_t WS_WRT = WS_ROPE + 32768;
constexpr size_t WS_WINT = WS_WRT + 131072;
constexpr size_t WS_WST = WS_WINT + (size_t)NPROJ * 1024 * 2;
constexpr size_t WS_WAT = WS_WST + 2097152;
constexpr size_t WS_WOT = WS_WAT + 2097152;
constexpr size_t WS_W1T = WS_WOT + 2097152;
constexpr size_t WS_W2T = WS_W1T + (size_t)32 * 2048 * 1024 * 2;
constexpr size_t WS_X1 = WS_W2T + (size_t)32 * 1024 * 1024 * 2;
constexpr size_t WS_H2 = WS_X1 + (size_t)M * 1024 * 4;
constexpr size_t WS_TOKES = WS_H2 + (size_t)M * 1024 * 2;
constexpr size_t WS_TOKW = WS_TOKES + (size_t)M * 16;
constexpr size_t WS_LIST = WS_TOKW + (size_t)M * 16;
constexpr size_t WS_R = WS_LIST + (size_t)32 * 16384 * 4;
constexpr size_t WS_H = WS_R;
constexpr size_t WS_P = WS_H + (size_t)M * 1024 * 2;
constexpr size_t WS_XT = WS_P + (size_t)M * NPROJ * 2;
constexpr size_t WS_BMR = WS_XT + (size_t)M * 1024 * 2;
constexpr size_t WS_BMT = WS_BMR + (size_t)M * 256 * 2;
constexpr size_t WS_CMR = WS_BMT + (size_t)M * 256 * 2;
constexpr size_t WS_DT = WS_CMR + (size_t)M * 256 * 2;
constexpr size_t WS_ACS = WS_DT + (size_t)2 * M * 16 * 4;
constexpr size_t WS_CDEC = WS_ACS + (size_t)2 * M * 16 * 4;
constexpr size_t WS_ST = WS_CDEC + 16384;
constexpr size_t WS_PREV = WS_ST + (size_t)2 * 2 * 64 * 16 * 8192 * 4;
constexpr size_t WS_YZ = WS_PREV + (size_t)2 * 2 * 64 * 16 * 8192 * 2;
constexpr size_t WS_AO = WS_YZ + (size_t)M * 1024 * 2;
constexpr size_t WS_RSTD = WS_AO + (size_t)M * 1024 * 2;
constexpr size_t WS_QN = WS_RSTD + (size_t)M * 4;
constexpr size_t WS_KN = WS_QN + (size_t)M * 1024 * 2;
constexpr size_t WS_VB = WS_KN + (size_t)M * 256 * 2;
constexpr size_t WS_T1 = WS_VB + (size_t)M * 256 * 2;
constexpr size_t WS_MG = WS_T1 + (size_t)M * 1024 * 2;
constexpr size_t WS_END = WS_MG + (size_t)M * 1024 * 2;
constexpr size_t WS_XB = WS_R;
constexpr size_t WS_ACT = WS_XB + (size_t)ROWS_MAX * 1024 * 2;
constexpr size_t WS_YB = WS_XB;
static_assert(WS_ACT + (size_t)ROWS_MAX * 1024 * 2 <= WS_END, "moe overlay");
static_assert(WS_END <= (size_t)1073741824, "workspace");
static_assert(WS_WAT == WS_WST + 2097152 && WS_AO == WS_YZ + (size_t)M * 2048, "concatenated operands of the merged branch GEMMs");

constexpr int LDS_BYTES = 147456;
constexpr int LDS_CTL = 143360;

struct Params {
    const float* in[24];
    float* out;
    unsigned char* ws;
    int ph_lo, ph_hi;
};

__device__ __forceinline__ float bf2f(bf16_t v) { return __uint_as_float((unsigned)v << 16); }
__device__ __forceinline__ float bflo(unsigned w) { return __uint_as_float(w << 16); }
__device__ __forceinline__ float bfhi(unsigned w) { return __uint_as_float(w & 0xffff0000u); }
__device__ __forceinline__ unsigned f2bf(float f) { unsigned u = __float_as_uint(f); return (u + 0x7fffu + ((u >> 16) & 1u)) >> 16; }
__device__ __forceinline__ unsigned pk2(float lo, float hi) { return f2bf(lo) | (f2bf(hi) << 16); }
__device__ __forceinline__ float wave_sum(float v) {
#pragma unroll
    for (int o = 1; o < 64; o <<= 1) v += __shfl_xor(v, o);
    return v;
}
__device__ __forceinline__ float wave_max(float v) {
#pragma unroll
    for (int o = 1; o < 64; o <<= 1) v = fmaxf(v, __shfl_xor(v, o));
    return v;
}
__device__ __forceinline__ int wave_min_i(int v) {
#pragma unroll
    for (int o = 1; o < 64; o <<= 1) { int t = __shfl_xor(v, o); v = t < v ? t : v; }
    return v;
}
__device__ __forceinline__ float sigmoidf_(float x) { return 1.f / (1.f + __expf(-x)); }
__device__ __forceinline__ unsigned pack4_fp8(float a, float b, float c, float d) { unsigned w = __builtin_amdgcn_cvt_pk_fp8_f32(a, b, 0u, false); return __builtin_amdgcn_cvt_pk_fp8_f32(c, d, w, true); }
#define LDS_WAIT() asm volatile("s_waitcnt lgkmcnt(0)" ::: "memory")

struct Ctx { int tid, lane, wave, bid, G; LAS unsigned char* lds; };

struct TItem { const float* W; bf16_t* WT; const float* kscale; int N, k0, n0, orow0; };
__device__ __forceinline__ void transpose_load(const TItem& t, f32x4 (&v)[8], int lane) {
    const int nq = lane & 7, kg = lane >> 3;
    const float* s = t.W + (size_t)(t.k0 + 8 * kg) * t.N + t.n0 + 4 * nq;
#pragma unroll
    for (int i = 0; i < 8; ++i) v[i] = *(const f32x4*)(s + (size_t)i * t.N);
}
__device__ __forceinline__ void transpose_store(const TItem& t, f32x4 (&v)[8], int lane) {
    const int nq = lane & 7, kg = lane >> 3;
    if (t.kscale) {
#pragma unroll
        for (int i = 0; i < 8; ++i) v[i] = v[i] * t.kscale[t.k0 + 8 * kg + i];
    }
    bf16_t* d = t.WT + (size_t)(t.orow0 + 4 * nq) * 1024 + t.k0 + 8 * kg;
#pragma unroll
    for (int j = 0; j < 4; ++j) { u32x4 o; o.x = pk2(v[0][j], v[1][j]); o.y = pk2(v[2][j], v[3][j]); o.z = pk2(v[4][j], v[5][j]); o.w = pk2(v[6][j], v[7][j]);
        *(u32x4*)(d + (size_t)j * 1024) = o; }
}
constexpr int PREP_I_IN = 16 * 193, PREP_I_SQ = 512, PREP_NITEMS = PREP_I_IN + 3 * PREP_I_SQ;
constexpr int PREP8_I_W1 = 32 * 8 * 64, PREP8_I_W2 = 32 * 8 * 32, PREP8_NITEMS = PREP8_I_W1 + PREP8_I_W2;
__device__ __forceinline__ TItem prep_item(const Params& p, int r) {
    unsigned char* ws = p.ws; TItem t; t.kscale = nullptr;
    if (r < PREP_I_IN) { const int kb = r / 193, nb = r % 193, n0 = nb * 32;
        t.W = p.in[2]; t.WT = (bf16_t*)(ws + WS_WINT); t.N = 6176; t.k0 = kb * 64; t.n0 = n0; t.orow0 = n0 < 2560 ? n0 : (n0 < 2592 ? PDT + (n0 - 2560) : n0 - 32); return t; }
    r -= PREP_I_IN;
    { const int which = r / PREP_I_SQ, q = r % PREP_I_SQ;
        t.W = which == 0 ? p.in[13] : (which == 1 ? p.in[14] : p.in[15]); t.WT = (bf16_t*)(ws + (which == 0 ? WS_WST : (which == 1 ? WS_WAT : WS_WOT)));
        t.kscale = which == 0 ? p.in[10] : nullptr; t.N = 1024; t.k0 = (q / 32) * 64; t.n0 = (q % 32) * 32; t.orow0 = t.n0; return t; }
}
__device__ __forceinline__ void prep_item8(const Params& p, int r, int lane) {
    unsigned char* ws = p.ws; const float* W; unsigned char* WT; int N, k0, n0, orow0;
    if (r < PREP8_I_W1) { const int e = r / 512, rr = r % 512, kb = rr / 64, nb = rr % 64; n0 = nb * 32; const int half = n0 / 1024, q = n0 % 1024;
        W = p.in[19] + (size_t)e * 1024 * 2048; WT = ws + WS_W1T + (size_t)e * 2048 * 1024; N = 2048; k0 = kb * 128; orow0 = (q / 128) * 256 + half * 128 + (q % 128); }
    else { r -= PREP8_I_W1; const int e = r / 256, rr = r % 256, kb = rr / 32, nb = rr % 32; n0 = nb * 32;
        W = p.in[21] + (size_t)e * 1024 * 1024; WT = ws + WS_W2T + (size_t)e * 1024 * 1024; N = 1024; k0 = kb * 128; orow0 = n0; }
    const int nq = lane & 7, kg = lane >> 3;
    const float* s = W + (size_t)(k0 + 16 * kg) * N + n0 + 4 * nq;
    f32x4 v[16];
#pragma unroll
    for (int i = 0; i < 16; ++i) v[i] = *(const f32x4*)(s + (size_t)i * N);
    unsigned char* d = WT + (size_t)(orow0 + 4 * nq) * 1024 + k0 + 16 * kg;
#pragma unroll
    for (int j = 0; j < 4; ++j) { u32x4 o;
        o.x = pack4_fp8(64.f * v[0][j], 64.f * v[1][j], 64.f * v[2][j], 64.f * v[3][j]); o.y = pack4_fp8(64.f * v[4][j], 64.f * v[5][j], 64.f * v[6][j], 64.f * v[7][j]);
        o.z = pack4_fp8(64.f * v[8][j], 64.f * v[9][j], 64.f * v[10][j], 64.f * v[11][j]); o.w = pack4_fp8(64.f * v[12][j], 64.f * v[13][j], 64.f * v[14][j], 64.f * v[15][j]);
        *(u32x4*)(d + (size_t)j * 1024) = o; }
}

__device__ __forceinline__ void phase_prep(const Params& p, const Ctx& c) {
    unsigned char* ws = p.ws;
    const int gw = c.bid * 8 + c.wave, NGW = c.G * 8;
    for (int it = gw; it < PREP_NITEMS; it += 2 * NGW) {
        const TItem ta = prep_item(p, it); f32x4 va[8], vb[8];
        transpose_load(ta, va, c.lane);
        const bool two = it + NGW < PREP_NITEMS;
        const TItem tb = prep_item(p, two ? it + NGW : it);
        if (two) transpose_load(tb, vb, c.lane);
        transpose_store(ta, va, c.lane);
        if (two) transpose_store(tb, vb, c.lane);
    }
    for (int it = gw; it < PREP8_NITEMS; it += NGW) prep_item8(p, it, c.lane);
    for (int r = 6176 + gw; r < NPROJ; r += NGW) {
        u32x4* o = (u32x4*)((bf16_t*)(ws + WS_WINT) + (size_t)r * 1024);
        o[c.lane] = (u32x4){0u, 0u, 0u, 0u}; o[c.lane + 64] = (u32x4){0u, 0u, 0u, 0u};
    }
    {
        const float* x = p.in[0]; const float* g = p.in[1]; bf16_t* H = (bf16_t*)(ws + WS_H);
        f32x4 gv[4];
#pragma unroll
        for (int j = 0; j < 4; ++j) gv[j] = ((const f32x4*)g)[c.lane + 64 * j];
        for (int m = gw; m < M; m += NGW) {
            const f32x4* xr = (const f32x4*)(x + (size_t)m * D) + c.lane;
            f32x4 v[4]; float s = 0.f;
#pragma unroll
            for (int j = 0; j < 4; ++j) { v[j] = xr[64 * j]; s += (v[j].x * v[j].x + v[j].y * v[j].y) + (v[j].z * v[j].z + v[j].w * v[j].w); }
            const float rstd = rsqrtf(wave_sum(s) * (1.f / D) + EPS);
            u32x2* o = (u32x2*)(H + (size_t)m * D) + c.lane;
#pragma unroll
            for (int j = 0; j < 4; ++j) { u32x2 w; w.x = pk2(v[j].x * rstd * gv[j].x, v[j].y * rstd * gv[j].y); w.y = pk2(v[j].z * rstd * gv[j].z, v[j].w * rstd * gv[j].w); o[64 * j] = w; }
        }
    }
    {
        float* rc = (float*)(ws + WS_ROPE); float* rs = rc + 4096;
        for (int idx = c.bid * 512 + c.tid; idx < 4096; idx += c.G * 512) {
            const int pos = idx >> 5, i = idx & 31;
            const float inv = exp2f(-(float)i * (13.287712379549449f / 32.f));
            float rev = (float)pos * inv * 0.15915494309189535f; rev -= floorf(rev);
            rc[idx] = __builtin_amdgcn_cosf(rev); rs[idx] = __builtin_amdgcn_sinf(rev);
        }
        float* wrt = (float*)(ws + WS_WRT); const float* wr = p.in[17];
        for (int idx = c.bid * 512 + c.tid; idx < 32768; idx += c.G * 512) { const int k = idx >> 5, e = idx & 31; wrt[e * 1024 + k] = wr[idx]; }
        if (c.bid == 0 && c.tid < 64) ((int*)(ws + WS_CTL))[c.tid] = 0;
    }
}

template <bool DUAL, class ARow, class Epi>
__device__ __forceinline__ void ngemm_tile(const ARow& arow, const bf16_t* Bt, const bf16_t* Bt2, int K, int m0, const Epi& epi, LAS float* lds, int tid) {
    LAS float* As = lds;
    LAS float* Bs = lds + 32 * 132;
    LAS float* Bs2 = Bs + 32 * 68;
    float acc[4][4], acc2[4][4];
#pragma unroll
    for (int i = 0; i < 4; ++i)
#pragma unroll
        for (int j = 0; j < 4; ++j) { acc[i][j] = 0.f; acc2[i][j] = 0.f; }
    const int tm = tid & 31, tn = tid >> 5;
    const int sr = tid >> 2, kq = (tid & 3) * 8;
    const bf16_t* ap = arow(m0 + sr) + kq;
    const bf16_t* bp = Bt + (size_t)(sr & 63) * K + kq;
    const bf16_t* bp2 = DUAL ? Bt2 + (size_t)(sr & 63) * K + kq : nullptr;
    for (int k0 = 0; k0 < K; k0 += 32) {
        {
            const u32x4 v = *(const u32x4*)(ap + k0);
            As[(kq + 0) * 132 + sr] = bflo(v.x); As[(kq + 1) * 132 + sr] = bfhi(v.x); As[(kq + 2) * 132 + sr] = bflo(v.y); As[(kq + 3) * 132 + sr] = bfhi(v.y);
            As[(kq + 4) * 132 + sr] = bflo(v.z); As[(kq + 5) * 132 + sr] = bfhi(v.z); As[(kq + 6) * 132 + sr] = bflo(v.w); As[(kq + 7) * 132 + sr] = bfhi(v.w);
        }
        if (tid < 256) {
            const u32x4 v = *(const u32x4*)(bp + k0);
            Bs[(kq + 0) * 68 + sr] = bflo(v.x); Bs[(kq + 1) * 68 + sr] = bfhi(v.x); Bs[(kq + 2) * 68 + sr] = bflo(v.y); Bs[(kq + 3) * 68 + sr] = bfhi(v.y);
            Bs[(kq + 4) * 68 + sr] = bflo(v.z); Bs[(kq + 5) * 68 + sr] = bfhi(v.z); Bs[(kq + 6) * 68 + sr] = bflo(v.w); Bs[(kq + 7) * 68 + sr] = bfhi(v.w);
        } else if (DUAL) {
            const int r2 = sr & 63;
            const u32x4 v = *(const u32x4*)(bp2 + k0);
            Bs2[(kq + 0) * 68 + r2] = bflo(v.x); Bs2[(kq + 1) * 68 + r2] = bfhi(v.x); Bs2[(kq + 2) * 68 + r2] = bflo(v.y); Bs2[(kq + 3) * 68 + r2] = bfhi(v.y);
            Bs2[(kq + 4) * 68 + r2] = bflo(v.z); Bs2[(kq + 5) * 68 + r2] = bfhi(v.z); Bs2[(kq + 6) * 68 + r2] = bflo(v.w); Bs2[(kq + 7) * 68 + r2] = bfhi(v.w);
        }
        __syncthreads();
#pragma unroll 8
        for (int k = 0; k < 32; ++k) {
            const f32x4 a = *(const LAS f32x4*)&As[k * 132 + tm * 4];
            const f32x4 b = *(const LAS f32x4*)&Bs[k * 68 + tn * 4];
#pragma unroll
            for (int i = 0; i < 4; ++i)
#pragma unroll
                for (int j = 0; j < 4; ++j) acc[i][j] = fmaf(a[i], b[j], acc[i][j]);
            if (DUAL) {
                const f32x4 b2 = *(const LAS f32x4*)&Bs2[k * 68 + tn * 4];
#pragma unroll
                for (int i = 0; i < 4; ++i)
#pragma unroll
                    for (int j = 0; j < 4; ++j) acc2[i][j] = fmaf(a[i], b2[j], acc2[i][j]);
            }
        }
        __syncthreads();
    }
#pragma unroll
    for (int i = 0; i < 4; ++i)
#pragma unroll
        for (int j = 0; j < 4; ++j) epi(m0 + tm * 4 + i, tn * 4 + j, acc[i][j], acc2[i][j]);
}
struct ARowPlain { const bf16_t* A; int lda; __device__ __forceinline__ const bf16_t* operator()(int m) const { return A + (size_t)m * lda; } };

namespace pg8 {
#define PG8_LAS __attribute__((address_space(3)))
typedef unsigned short bf16_t;
typedef short bf16x8 __attribute__((ext_vector_type(8)));
typedef float f32x4 __attribute__((ext_vector_type(4)));
typedef unsigned u32x4 __attribute__((ext_vector_type(4)));
constexpr int BM = 256, BK = 64, HALF = 128, HTB = HALF * BK * 2  , STAGE_BYTES = 8 * HTB, NXCD = 8, WGM = 8;

__host__ __device__ __forceinline__ int lds_byte(int r, int c) { const int st = (r >> 4) * 2 + (c >> 5), rr = r & 15, cc = c & 31, ob = rr * 64 + cc * 2; return st * 1024 + (ob ^ (((ob >> 9) & 1) << 5)); }
__host__ __device__ __forceinline__ void stage_rc(int b, int& R, int& C) { const int st = b / 1024, sb = b % 1024, swz = sb ^ (((sb >> 9) & 1) << 5); R = (st >> 1) * 16 + swz / 64; C = (st & 1) * 32 + (swz % 64) / 2; }
__host__ __device__ __forceinline__ int perm32(int rho) { const int n = rho >> 4, i = rho & 15; return 8 * (i >> 2) + 4 * n + (i & 3); }

struct Unit { int pm, pn; };
struct Gemm { const bf16_t* A; const bf16_t* Bt; int M, N, K; };

struct StaticOrder {
    int nM, nN, nwg, G, c;
    __host__ __device__ void init(int M, int N, int G_, int c_) { nM = M / BM; nN = N / BM; nwg = nM * nN; G = G_; c = c_; }
    __host__ __device__ bool next(int i, Unit& u) const {
        const long L = (long)i * G + c; if (L >= nwg) return false;
        int wgid = (int)L; { const int q = nwg / NXCD, r = nwg % NXCD, xcd = wgid % NXCD, off = wgid / NXCD; wgid = (xcd < r ? xcd * (q + 1) : r * (q + 1) + (xcd - r) * q) + off; }
        const int nig = WGM * nN, gid = wgid / nig, fm = gid * WGM, gsz = (nM - fm) < WGM ? (nM - fm) : WGM;
        u.pm = fm + ((wgid % nig) % gsz); u.pn = (wgid % nig) / gsz; return true;
    }
    __device__ __forceinline__ void a_ready(const Unit&) const {}
    __device__ __forceinline__ void done(const Unit&) const {}
};


__device__ __forceinline__ unsigned cvt_pk_bf16(float lo, float hi) { unsigned r; asm volatile("v_cvt_pk_bf16_f32 %0, %1, %2" : "=v"(r) : "v"(lo), "v"(hi)); return r; }
__device__ __forceinline__ float sig_(float x) { return __builtin_amdgcn_rcpf(1.f + __builtin_amdgcn_exp2f(-1.4426950408889634f * x)); }
__device__ __forceinline__ u32x4 pack8(const f32x4& v0, const f32x4& v1) { u32x4 w; w.x = cvt_pk_bf16(v0[0], v0[1]); w.y = cvt_pk_bf16(v0[2], v0[3]); w.z = cvt_pk_bf16(v1[0], v1[1]); w.w = cvt_pk_bf16(v1[2], v1[3]); return w; }
__device__ __forceinline__ void unpack8(const u32x4& w, f32x4& v0, f32x4& v1) {
    v0[0] = __uint_as_float(w.x << 16); v0[1] = __uint_as_float(w.x & 0xffff0000u); v0[2] = __uint_as_float(w.y << 16); v0[3] = __uint_as_float(w.y & 0xffff0000u);
    v1[0] = __uint_as_float(w.z << 16); v1[1] = __uint_as_float(w.z & 0xffff0000u); v1[2] = __uint_as_float(w.w << 16); v1[3] = __uint_as_float(w.w & 0xffff0000u); }
struct EpiStore {
    static constexpr bool PERM = true, AFTER_DRAIN = false;
    bf16_t* O; int ldc;
    __device__ __forceinline__ void operator()(const f32x4 (&acc)[2][2][4][2], const Unit& u, int wr, int wc, int fr, int fq) const {
        const int row0 = u.pm * BM + wr * 64 + fr, col0 = u.pn * BM + wc * 32 + 8 * fq;
#pragma unroll
        for (int ai = 0; ai < 2; ++ai)
#pragma unroll
            for (int m = 0; m < 4; ++m) { bf16_t* rowp = O + (size_t)(row0 + ai * HALF + m * 16) * ldc + col0;
#pragma unroll
                for (int bj = 0; bj < 2; ++bj) *(u32x4*)(rowp + bj * HALF) = pack8(acc[ai][bj][m][0], acc[ai][bj][m][1]); }
    }
};
struct EpiT1 {
    static constexpr bool PERM = true, AFTER_DRAIN = false;
    bf16_t* T1; const bf16_t* G; int ldg; const float* RSTD;
    __device__ __forceinline__ void operator()(const f32x4 (&acc)[2][2][4][2], const Unit& u, int wr, int wc, int fr, int fq) const {
        const int row0 = u.pm * BM + wr * 64 + fr, col0 = u.pn * BM + wc * 32 + 8 * fq;
#pragma unroll
        for (int ai = 0; ai < 2; ++ai)
#pragma unroll
            for (int m = 0; m < 4; ++m) { const int row = row0 + ai * HALF + m * 16; const float rs = RSTD[row];
#pragma unroll
                for (int bj = 0; bj < 2; ++bj) { const int col = col0 + bj * HALF;
                    f32x4 g0, g1; unpack8(*(const u32x4*)(G + (size_t)row * ldg + col), g0, g1);
                    f32x4 v0 = acc[ai][bj][m][0] * rs, v1 = acc[ai][bj][m][1] * rs;
#pragma unroll
                    for (int i = 0; i < 4; ++i) { v0[i] *= sig_(g0[i]); v1[i] *= sig_(g1[i]); }
                    *(u32x4*)(T1 + (size_t)row * 1024 + col) = pack8(v0, v1); } }
    }
};
struct EpiT2 {
    static constexpr bool PERM = true, AFTER_DRAIN = false;
    bf16_t* MG; const bf16_t* T1; const bf16_t* G; int ldg;
    __device__ __forceinline__ void operator()(const f32x4 (&acc)[2][2][4][2], const Unit& u, int wr, int wc, int fr, int fq) const {
        const int row0 = u.pm * BM + wr * 64 + fr, col0 = u.pn * BM + wc * 32 + 8 * fq;
#pragma unroll
        for (int ai = 0; ai < 2; ++ai)
#pragma unroll
            for (int m = 0; m < 4; ++m) { const int row = row0 + ai * HALF + m * 16;
#pragma unroll
                for (int bj = 0; bj < 2; ++bj) { const int col = col0 + bj * HALF;
                    f32x4 g0, g1, t0, t1; unpack8(*(const u32x4*)(G + (size_t)row * ldg + col), g0, g1); unpack8(*(const u32x4*)(T1 + (size_t)row * 1024 + col), t0, t1);
                    f32x4 v0 = acc[ai][bj][m][0], v1 = acc[ai][bj][m][1];
#pragma unroll
                    for (int i = 0; i < 4; ++i) { v0[i] = fmaf(v0[i], sig_(g0[i]), t0[i]); v1[i] = fmaf(v1[i], sig_(g1[i]), t1[i]); }
                    *(u32x4*)(MG + (size_t)row * 1024 + col) = pack8(v0, v1); } }
    }
};
struct EpiT3 {
    static constexpr bool PERM = true, AFTER_DRAIN = false;
    float* X1; const float* x;
    __device__ __forceinline__ void operator()(const f32x4 (&acc)[2][2][4][2], const Unit& u, int wr, int wc, int fr, int fq) const {
        const int row0 = u.pm * BM + wr * 64 + fr, col0 = u.pn * BM + wc * 32 + 8 * fq;
#pragma unroll
        for (int ai = 0; ai < 2; ++ai)
#pragma unroll
            for (int m = 0; m < 4; ++m) { const size_t ro = (size_t)(row0 + ai * HALF + m * 16) * 1024 + col0;
#pragma unroll
                for (int bj = 0; bj < 2; ++bj) { const size_t o = ro + bj * HALF;
                    *(f32x4*)(X1 + o) = *(const f32x4*)(x + o) + acc[ai][bj][m][0]; *(f32x4*)(X1 + o + 4) = *(const f32x4*)(x + o + 4) + acc[ai][bj][m][1]; } }
    }
};
struct EpiAct {
    static constexpr bool PERM = true, AFTER_DRAIN = false;
    bf16_t* ACT; const float* b1;
    __device__ __forceinline__ void operator()(const f32x4 (&acc)[2][2][4][2], const Unit& u, int wr, int wc, int fr, int fq) const {
        const int e = u.pn >> 3, nt = u.pn & 7;
        const int row0 = u.pm * BM + wr * 64 + fr, col0 = nt * 128 + wc * 32 + 8 * fq;
        const float* bg = b1 + (size_t)e * 2048 + col0;
        const f32x4 bg0 = *(const f32x4*)bg, bg1 = *(const f32x4*)(bg + 4), bu0 = *(const f32x4*)(bg + 1024), bu1 = *(const f32x4*)(bg + 1028);
#pragma unroll
        for (int ai = 0; ai < 2; ++ai)
#pragma unroll
            for (int m = 0; m < 4; ++m) { const int row = row0 + ai * HALF + m * 16;
                f32x4 g0 = acc[ai][0][m][0] + bg0, g1 = acc[ai][0][m][1] + bg1, u0 = acc[ai][1][m][0] + bu0, u1 = acc[ai][1][m][1] + bu1;
#pragma unroll
                for (int i = 0; i < 4; ++i) {
                    const float ga = fminf(g0[i], 7.f), gb = fminf(g1[i], 7.f), ua = fminf(fmaxf(u0[i], -7.f), 7.f), ub = fminf(fmaxf(u1[i], -7.f), 7.f);
                    g0[i] = ga * sig_(1.702f * ga) * (ua + 1.f); g1[i] = gb * sig_(1.702f * gb) * (ub + 1.f); }
                *(u32x4*)(ACT + (size_t)row * 1024 + col0) = pack8(g0, g1); }
    }
};
struct EpiY {
    static constexpr bool PERM = true, AFTER_DRAIN = false;
    bf16_t* YB; const float* b2;
    __device__ __forceinline__ void operator()(const f32x4 (&acc)[2][2][4][2], const Unit& u, int wr, int wc, int fr, int fq) const {
        const int e = u.pn >> 2, nt = u.pn & 3;
        const int row0 = u.pm * BM + wr * 64 + fr, col0 = nt * BM + wc * 32 + 8 * fq;
        f32x4 bv[2][2];
#pragma unroll
        for (int bj = 0; bj < 2; ++bj) { bv[bj][0] = *(const f32x4*)(b2 + (size_t)e * 1024 + col0 + bj * HALF); bv[bj][1] = *(const f32x4*)(b2 + (size_t)e * 1024 + col0 + bj * HALF + 4); }
#pragma unroll
        for (int ai = 0; ai < 2; ++ai)
#pragma unroll
            for (int m = 0; m < 4; ++m) { bf16_t* rowp = YB + (size_t)(row0 + ai * HALF + m * 16) * 1024 + col0;
#pragma unroll
                for (int bj = 0; bj < 2; ++bj) *(u32x4*)(rowp + bj * HALF) = pack8(acc[ai][bj][m][0] + bv[bj][0], acc[ai][bj][m][1] + bv[bj][1]); }
    }
};

struct EpiAct8 {
    static constexpr bool PERM = true, AFTER_DRAIN = false;
    unsigned char* ACT; const float* b1;
    __device__ __forceinline__ void operator()(const f32x4 (&acc)[2][2][4][2], const Unit& u, int wr, int wc, int fr, int fq) const {
        const int e = u.pn >> 3, nt = u.pn & 7;
        const int row0 = u.pm * BM + wr * 64 + fr, col0 = nt * 128 + wc * 32 + 8 * fq;
        const float* bg = b1 + (size_t)e * 2048 + col0;
        const f32x4 bg0 = *(const f32x4*)bg, bg1 = *(const f32x4*)(bg + 4), bu0 = *(const f32x4*)(bg + 1024), bu1 = *(const f32x4*)(bg + 1028);
        constexpr float SC = 1.f / 512.f;
#pragma unroll
        for (int ai = 0; ai < 2; ++ai)
#pragma unroll
            for (int m = 0; m < 4; ++m) { const int row = row0 + ai * HALF + m * 16;
                f32x4 g0 = acc[ai][0][m][0] * SC + bg0, g1 = acc[ai][0][m][1] * SC + bg1, u0 = acc[ai][1][m][0] * SC + bu0, u1 = acc[ai][1][m][1] * SC + bu1;
#pragma unroll
                for (int i = 0; i < 4; ++i) {
                    const float ga = fminf(g0[i], 7.f), gb = fminf(g1[i], 7.f), ua = fminf(fmaxf(u0[i], -7.f), 7.f), ub = fminf(fmaxf(u1[i], -7.f), 7.f);
                    g0[i] = 4.f * ga * sig_(1.702f * ga) * (ua + 1.f); g1[i] = 4.f * gb * sig_(1.702f * gb) * (ub + 1.f); }
                u32x2 w; w.x = pack4_fp8(g0[0], g0[1], g0[2], g0[3]); w.y = pack4_fp8(g1[0], g1[1], g1[2], g1[3]);
                *(u32x2*)(ACT + (size_t)row * 1024 + col0) = w; }
    }
};
struct EpiY8 {
    static constexpr bool PERM = true, AFTER_DRAIN = false;
    bf16_t* YB; const float* b2;
    __device__ __forceinline__ void operator()(const f32x4 (&acc)[2][2][4][2], const Unit& u, int wr, int wc, int fr, int fq) const {
        const int e = u.pn >> 2, nt = u.pn & 3;
        const int row0 = u.pm * BM + wr * 64 + fr, col0 = nt * BM + wc * 32 + 8 * fq;
        constexpr float SC = 1.f / 256.f;
        f32x4 bv[2][2];
#pragma unroll
        for (int bj = 0; bj < 2; ++bj) { bv[bj][0] = *(const f32x4*)(b2 + (size_t)e * 1024 + col0 + bj * HALF); bv[bj][1] = *(const f32x4*)(b2 + (size_t)e * 1024 + col0 + bj * HALF + 4); }
#pragma unroll
        for (int ai = 0; ai < 2; ++ai)
#pragma unroll
            for (int m = 0; m < 4; ++m) { bf16_t* rowp = YB + (size_t)(row0 + ai * HALF + m * 16) * 1024 + col0;
#pragma unroll
                for (int bj = 0; bj < 2; ++bj) *(u32x4*)(rowp + bj * HALF) = pack8(acc[ai][bj][m][0] * SC + bv[bj][0], acc[ai][bj][m][1] * SC + bv[bj][1]); }
    }
};
struct MoeOrder {
    const PG8_LAS int* offs; int nN, G, c, ntile;
    __device__ __forceinline__ bool next(int i, Unit& u) const {
        const long L = (long)i * G + c; if (L >= (long)ntile * nN) return false;
        const int t = (int)(L / nN), pnl = (int)(L % nN); int e = 0; while (e < 31 && t * 256 >= offs[e + 1]) ++e;
        u.pm = t; u.pn = e * nN + pnl; return true;
    }
    __device__ __forceinline__ void a_ready(const Unit&) const {}
    __device__ __forceinline__ void done(const Unit&) const {}
};
template <class Epi, class Sched, bool ALIGN_EPI = false, bool SP2 = false>
__device__ __forceinline__ void gemm_phase(PG8_LAS unsigned char* lds, const Gemm g, const Sched& S, const Epi& E) {
    const int tid = threadIdx.x, wid = __builtin_amdgcn_readfirstlane(tid >> 6), lane = tid & 63, wr = wid >> 2, wc = wid & 3, fr = lane & 15, fq = lane >> 4;
    const int K = g.K, nt = K / BK;
    unsigned voffA[2], voffB[2];
#pragma unroll
    for (int i = 0; i < 2; ++i) { int R, C; stage_rc(tid * 16 + i * 8192, R, C); const int Rb = Epi::PERM ? ((R & ~31) + perm32(R & 31)) : R;
        voffA[i] = (unsigned)(R * K + C) * 2u; voffB[i] = (unsigned)(Rb * K + C) * 2u; }
    const size_t kstep = (size_t)(BK * 2);
    const size_t hstep = (size_t)HALF * K * 2;
    const size_t tstep = 2 * hstep;
    const unsigned ldsw = (unsigned)wid * 1024u;
    const int aoff = lds_byte(wr * 64 + fr, fq * 8), boff = lds_byte(wc * 32 + fr, fq * 8);
#define PG8_SA(b, h) (((b) * 2 + (h)) * HTB)
#define PG8_SB(b, h) ((4 + (b) * 2 + (h)) * HTB)
#define PG8_STAGE(bufoff, gbase, voff) do { _Pragma("unroll") for (int _i = 0; _i < 2; ++_i) \
        __builtin_amdgcn_global_load_lds((const unsigned*)((const char*)(gbase) + (voff)[_i]), (PG8_LAS unsigned*)(lds + (bufoff) + ldsw + _i * 8192), 16, 0, 0); } while (0)
#define PG8_LDA(dst, b, h) do { _Pragma("unroll") for (int m = 0; m < 4; ++m) _Pragma("unroll") for (int k = 0; k < 2; ++k) dst[m][k] = *(const PG8_LAS bf16x8*)(lds + PG8_SA(b, h) + aoff + m * 2048 + k * 1024); } while (0)
#define PG8_LDB(dst, b, h) do { _Pragma("unroll") for (int n = 0; n < 2; ++n) _Pragma("unroll") for (int k = 0; k < 2; ++k) dst[n][k] = *(const PG8_LAS bf16x8*)(lds + PG8_SB(b, h) + boff + n * 2048 + k * 1024); } while (0)
#define PG8_MMA(ai, bj, At, Bt) do { __builtin_amdgcn_s_setprio(1); _Pragma("unroll") for (int m = 0; m < 4; ++m) _Pragma("unroll") for (int n = 0; n < 2; ++n) _Pragma("unroll") for (int k = 0; k < 2; ++k) \
        acc[ai][bj][m][n] = __builtin_amdgcn_mfma_f32_16x16x32_bf16(Bt[n][k], At[m][k], acc[ai][bj][m][n], 0, 0, 0); __builtin_amdgcn_s_setprio(0); } while (0)
#define PG8_WAIT_V(n) asm volatile("s_waitcnt vmcnt(" #n ")" ::: "memory")
#define PG8_WAIT_L(n) asm volatile("s_waitcnt lgkmcnt(" #n ")" ::: "memory")
#define PG8_BAR __builtin_amdgcn_s_barrier()
#define PG8_SCHED __builtin_amdgcn_sched_barrier(0)
    Unit cur, nxt; int ui = 0;
    if (!S.next(0, cur)) return;
    f32x4 acc[2][2][4][2];
#pragma unroll
    for (int a = 0; a < 2; ++a)
#pragma unroll
        for (int b = 0; b < 2; ++b)
#pragma unroll
            for (int m = 0; m < 4; ++m)
#pragma unroll
                for (int n = 0; n < 2; ++n) acc[a][b][m][n] = (f32x4){0.f, 0.f, 0.f, 0.f};
    bf16x8 At[4][2], B0[2][2], B1[2][2];
    const char* cA = (const char*)g.A + (size_t)cur.pm * tstep; const char* cB = (const char*)g.Bt + (size_t)cur.pn * tstep;
    S.a_ready(cur);
    if constexpr (SP2) {
        PG8_STAGE(PG8_SB(0, 0), cB, voffB); PG8_STAGE(PG8_SB(0, 1), cB + hstep, voffB); PG8_STAGE(PG8_SA(0, 0), cA, voffA); PG8_STAGE(PG8_SA(0, 1), cA + hstep, voffA);
        if (wr == 1) PG8_BAR;
        PG8_WAIT_V(2); PG8_BAR;
        PG8_STAGE(PG8_SB(1, 0), cB + kstep, voffB); PG8_STAGE(PG8_SA(1, 0), cA + kstep, voffA); PG8_STAGE(PG8_SB(1, 1), cB + hstep + kstep, voffB);
        PG8_WAIT_V(6); PG8_BAR;
    } else {
        PG8_STAGE(PG8_SB(0, 0), cB, voffB); PG8_STAGE(PG8_SA(0, 0), cA, voffA); PG8_STAGE(PG8_SB(0, 1), cB + hstep, voffB); PG8_STAGE(PG8_SA(0, 1), cA + hstep, voffA);
        if (wr == 1) PG8_BAR;
        PG8_WAIT_V(4); PG8_BAR;
        PG8_STAGE(PG8_SB(1, 0), cB + kstep, voffB); PG8_STAGE(PG8_SA(1, 0), cA + kstep, voffA); PG8_STAGE(PG8_SB(1, 1), cB + hstep + kstep, voffB);
        PG8_WAIT_V(6); PG8_BAR;
    }
    for (;;) {
        const bool has_next = S.next(ui + 1, nxt);
        const char* nA = has_next ? (const char*)g.A + (size_t)nxt.pm * tstep : cA; const char* nB = has_next ? (const char*)g.Bt + (size_t)nxt.pn * tstep : cB;
        for (int t = 0; t < nt; t += 2) {
            const bool last = (t == nt - 2);
            const char* a1 = cA + (size_t)(t + 1) * kstep;
            const char* a2 = last ? nA : cA + (size_t)(t + 2) * kstep; const char* b2 = last ? nB : cB + (size_t)(t + 2) * kstep;
            const char* a3 = a2 + kstep; const char* b3 = b2 + kstep;
            if (last && has_next) S.a_ready(nxt);
            if constexpr (SP2) {
            PG8_LDB(B0, 0, 0); PG8_LDB(B1, 0, 1); PG8_SCHED; PG8_LDA(At, 0, 0); PG8_STAGE(PG8_SA(1, 1), a1 + hstep, voffA);
            PG8_WAIT_V(8); PG8_WAIT_L(0); PG8_BAR; PG8_MMA(0, 0, At, B0); PG8_MMA(0, 1, At, B1); PG8_BAR; PG8_SCHED;
            PG8_LDA(At, 0, 1); PG8_STAGE(PG8_SB(0, 0), b2, voffB); PG8_STAGE(PG8_SB(0, 1), b2 + hstep, voffB); PG8_STAGE(PG8_SA(0, 0), a2, voffA);
            PG8_WAIT_V(8); PG8_WAIT_L(0); PG8_BAR; PG8_MMA(1, 0, At, B0); PG8_MMA(1, 1, At, B1); PG8_BAR; PG8_SCHED;
            PG8_LDB(B0, 1, 0); PG8_LDB(B1, 1, 1); PG8_SCHED; PG8_LDA(At, 1, 0); PG8_STAGE(PG8_SA(0, 1), a2 + hstep, voffA);
            PG8_WAIT_V(8); PG8_WAIT_L(0); PG8_BAR; PG8_MMA(0, 0, At, B0); PG8_MMA(0, 1, At, B1); PG8_BAR; PG8_SCHED;
            PG8_LDA(At, 1, 1); PG8_STAGE(PG8_SB(1, 0), b3, voffB); PG8_STAGE(PG8_SB(1, 1), b3 + hstep, voffB); PG8_STAGE(PG8_SA(1, 0), a3, voffA);
            PG8_WAIT_V(8); PG8_WAIT_L(0); PG8_BAR; PG8_MMA(1, 0, At, B0); PG8_MMA(1, 1, At, B1); PG8_BAR; PG8_SCHED;
            } else {
            PG8_LDB(B0, 0, 0); PG8_SCHED; PG8_LDA(At, 0, 0); PG8_STAGE(PG8_SA(1, 1), a1 + hstep, voffA);
            PG8_WAIT_L(8); PG8_BAR; PG8_WAIT_L(0); PG8_MMA(0, 0, At, B0); PG8_BAR; PG8_SCHED;
            PG8_LDB(B1, 0, 1); PG8_STAGE(PG8_SB(0, 0), b2, voffB);
            PG8_BAR; PG8_WAIT_L(0); PG8_MMA(0, 1, At, B1); PG8_BAR;
            PG8_LDA(At, 0, 1); PG8_STAGE(PG8_SA(0, 0), a2, voffA);
            PG8_BAR; PG8_WAIT_L(0); PG8_MMA(1, 0, At, B0); PG8_BAR; PG8_SCHED;
            PG8_STAGE(PG8_SB(0, 1), b2 + hstep, voffB);
            PG8_WAIT_V(6); PG8_BAR; PG8_MMA(1, 1, At, B1); PG8_BAR;
            PG8_LDB(B0, 1, 0); PG8_SCHED; PG8_LDA(At, 1, 0); PG8_STAGE(PG8_SA(0, 1), a2 + hstep, voffA);
            PG8_WAIT_L(8); PG8_BAR; PG8_WAIT_L(0); PG8_MMA(0, 0, At, B0); PG8_BAR; PG8_SCHED;
            PG8_LDB(B1, 1, 1); PG8_STAGE(PG8_SB(1, 0), b3, voffB);
            PG8_BAR; PG8_WAIT_L(0); PG8_MMA(0, 1, At, B1); PG8_BAR;
            PG8_LDA(At, 1, 1); PG8_STAGE(PG8_SA(1, 0), a3, voffA);
            PG8_BAR; PG8_WAIT_L(0); PG8_MMA(1, 0, At, B0); PG8_BAR; PG8_SCHED;
            PG8_STAGE(PG8_SB(1, 1), b3 + hstep, voffB);
            PG8_WAIT_V(6); PG8_BAR; PG8_MMA(1, 1, At, B1); PG8_BAR;
            }
        }
        if constexpr (ALIGN_EPI) { if (wr == 0) PG8_BAR; }
        if constexpr (!Epi::AFTER_DRAIN) { E(acc, cur, wr, wc, fr, fq); S.done(cur); }
        if (!has_next) break;
#pragma unroll
        for (int a = 0; a < 2; ++a)
#pragma unroll
            for (int b = 0; b < 2; ++b)
#pragma unroll
                for (int m = 0; m < 4; ++m)
#pragma unroll
                    for (int n = 0; n < 2; ++n) acc[a][b][m][n] = (f32x4){0.f, 0.f, 0.f, 0.f};
        cur = nxt; cA = nA; cB = nB; ++ui;
        if constexpr (ALIGN_EPI) { if (wr == 1) PG8_BAR; }
    }
    PG8_WAIT_V(0);
    if constexpr (!ALIGN_EPI) { if (wr == 0) PG8_BAR; }
    PG8_BAR;
    if constexpr (Epi::AFTER_DRAIN) { E.fused(acc, cur, wr, wc, fr, fq, lds, wid, lane); S.done(cur); }
#undef PG8_SA
#undef PG8_SB
#undef PG8_STAGE
#undef PG8_LDA
#undef PG8_LDB
#undef PG8_MMA
#undef PG8_WAIT_V
#undef PG8_WAIT_L
#undef PG8_BAR
#undef PG8_SCHED
}

struct MoeGatherOrder {
    const PG8_LAS int* offs; const PG8_LAS int* cnt; const int* LIST; int nN, G, c, ntile;
    __device__ __forceinline__ bool next(int i, Unit& u) const {
        const long L = (long)i * G + c; if (L >= (long)ntile * nN) return false;
        const int t = (int)(L / nN), pnl = (int)(L % nN); int e = 0; while (e < 31 && t * 256 >= offs[e + 1]) ++e;
        u.pm = t; u.pn = e * nN + pnl; return true;
    }
    __device__ __forceinline__ int arow(const Unit& u, int r) const { const int e = u.pn / nN, slot = u.pm * 256 + r - offs[e]; return slot < cnt[e] ? LIST[e * 16384 + slot] : 0; }
    __device__ __forceinline__ void a_ready(const Unit&) const {}
    __device__ __forceinline__ void done(const Unit&) const {}
};
struct TailOrder {
    StaticOrder so;
    __device__ __forceinline__ bool next(int i, Unit& u) const { Unit b; if (!so.next(i >> 1, b)) return false; u.pm = b.pm + 64 * (i & 1); u.pn = b.pn + 4 * (i & 1); return true; }
    __device__ __forceinline__ void a_ready(const Unit&) const {}
    __device__ __forceinline__ void done(const Unit&) const {}
};
struct EpiT12 {
    static constexpr bool PERM = true, AFTER_DRAIN = false;
    bf16_t* T1; bf16_t* MG; const bf16_t* G; int ldg; const float* RSTD;
    __device__ __forceinline__ void operator()(const f32x4 (&acc)[2][2][4][2], const Unit& u, int wr, int wc, int fr, int fq) const {
        const bool second = u.pm >= 64;
        const int row0 = (u.pm & 63) * BM + wr * 64 + fr, col0 = (u.pn & 3) * BM + wc * 32 + 8 * fq;
        const bf16_t* Gp = G + (second ? 1024 : 0);
#pragma unroll
        for (int ai = 0; ai < 2; ++ai) {
            u32x4 gv[4][2], tv[4][2]; float rs[4];
#pragma unroll
            for (int m = 0; m < 4; ++m) { const int row = row0 + ai * HALF + m * 16; rs[m] = second ? 1.f : RSTD[row];
#pragma unroll
                for (int bj = 0; bj < 2; ++bj) { gv[m][bj] = *(const u32x4*)(Gp + (size_t)row * ldg + col0 + bj * HALF);
                    tv[m][bj] = second ? *(const u32x4*)(T1 + (size_t)row * 1024 + col0 + bj * HALF) : (u32x4){0u, 0u, 0u, 0u}; } }
#pragma unroll
            for (int m = 0; m < 4; ++m) { const int row = row0 + ai * HALF + m * 16;
#pragma unroll
                for (int bj = 0; bj < 2; ++bj) { f32x4 g0, g1, t0, t1; unpack8(gv[m][bj], g0, g1); unpack8(tv[m][bj], t0, t1);
                    f32x4 v0 = acc[ai][bj][m][0] * rs[m], v1 = acc[ai][bj][m][1] * rs[m];
#pragma unroll
                    for (int i = 0; i < 4; ++i) { v0[i] = fmaf(v0[i], sig_(g0[i]), t0[i]); v1[i] = fmaf(v1[i], sig_(g1[i]), t1[i]); }
                    *(u32x4*)((second ? MG : T1) + (size_t)row * 1024 + col0 + bj * HALF) = pack8(v0, v1); } }
        }
    }
};
struct EpiT3b {
    static constexpr bool PERM = true, AFTER_DRAIN = false;
    float* X1; const float* x;
    __device__ __forceinline__ void operator()(const f32x4 (&acc)[2][2][4][2], const Unit& u, int wr, int wc, int fr, int fq) const {
        const int row0 = u.pm * BM + wr * 64 + fr, col0 = u.pn * BM + wc * 32 + 8 * fq;
#pragma unroll
        for (int ai = 0; ai < 2; ++ai) {
            f32x4 xv[4][2][2];
#pragma unroll
            for (int m = 0; m < 4; ++m)
#pragma unroll
                for (int bj = 0; bj < 2; ++bj) { const size_t o = (size_t)(row0 + ai * HALF + m * 16) * 1024 + col0 + bj * HALF; xv[m][bj][0] = *(const f32x4*)(x + o); xv[m][bj][1] = *(const f32x4*)(x + o + 4); }
#pragma unroll
            for (int m = 0; m < 4; ++m)
#pragma unroll
                for (int bj = 0; bj < 2; ++bj) { const size_t o = (size_t)(row0 + ai * HALF + m * 16) * 1024 + col0 + bj * HALF;
                    *(f32x4*)(X1 + o) = xv[m][bj][0] + acc[ai][bj][m][0]; *(f32x4*)(X1 + o + 4) = xv[m][bj][1] + acc[ai][bj][m][1]; }
        }
    }
};
template <class Epi, class Sched>
__device__ __forceinline__ void gemm_phase_gather(PG8_LAS unsigned char* lds, const Gemm g, const Sched& S, const Epi& E) {
    constexpr bool ALIGN_EPI = true, SP2 = true;
    const int tid = threadIdx.x, wid = __builtin_amdgcn_readfirstlane(tid >> 6), lane = tid & 63, wr = wid >> 2, wc = wid & 3, fr = lane & 15, fq = lane >> 4;
    const int K = g.K, nt = K / BK;
    unsigned voffA[2], voffB[2];
#pragma unroll
    for (int i = 0; i < 2; ++i) { int R, C; stage_rc(tid * 16 + i * 8192, R, C); const int Rb = Epi::PERM ? ((R & ~31) + perm32(R & 31)) : R;
        voffA[i] = (unsigned)(R * K + C) * 2u; voffB[i] = (unsigned)(Rb * K + C) * 2u; }
    const size_t kstep = (size_t)(BK * 2);
    const size_t hstep = (size_t)HALF * K * 2;
    const size_t tstep = 2 * hstep;
    const unsigned ldsw = (unsigned)wid * 1024u;
    const int aoff = lds_byte(wr * 64 + fr, fq * 8), boff = lds_byte(wc * 32 + fr, fq * 8);
#define PG8_SA(b, h) (((b) * 2 + (h)) * HTB)
#define PG8_SB(b, h) ((4 + (b) * 2 + (h)) * HTB)
#define PG8_STAGE(bufoff, gbase, voff) do { _Pragma("unroll") for (int _i = 0; _i < 2; ++_i) \
        __builtin_amdgcn_global_load_lds((const unsigned*)((const char*)(gbase) + (voff)[_i]), (PG8_LAS unsigned*)(lds + (bufoff) + ldsw + _i * 8192), 16, 0, 0); } while (0)
#define PG8_LDA(dst, b, h) do { _Pragma("unroll") for (int m = 0; m < 4; ++m) _Pragma("unroll") for (int k = 0; k < 2; ++k) dst[m][k] = *(const PG8_LAS bf16x8*)(lds + PG8_SA(b, h) + aoff + m * 2048 + k * 1024); } while (0)
#define PG8_LDB(dst, b, h) do { _Pragma("unroll") for (int n = 0; n < 2; ++n) _Pragma("unroll") for (int k = 0; k < 2; ++k) dst[n][k] = *(const PG8_LAS bf16x8*)(lds + PG8_SB(b, h) + boff + n * 2048 + k * 1024); } while (0)
#define PG8_MMA(ai, bj, At, Bt) do { __builtin_amdgcn_s_setprio(1); _Pragma("unroll") for (int m = 0; m < 4; ++m) _Pragma("unroll") for (int n = 0; n < 2; ++n) _Pragma("unroll") for (int k = 0; k < 2; ++k) \
        acc[ai][bj][m][n] = __builtin_amdgcn_mfma_f32_16x16x32_bf16(Bt[n][k], At[m][k], acc[ai][bj][m][n], 0, 0, 0); __builtin_amdgcn_s_setprio(0); } while (0)
#define PG8_WAIT_V(n) asm volatile("s_waitcnt vmcnt(" #n ")" ::: "memory")
#define PG8_WAIT_L(n) asm volatile("s_waitcnt lgkmcnt(" #n ")" ::: "memory")
#define PG8_BAR __builtin_amdgcn_s_barrier()
#define PG8_SCHED __builtin_amdgcn_sched_barrier(0)
    Unit cur, nxt; int ui = 0;
    if (!S.next(0, cur)) return;
    int rA[2]; unsigned cAo[2];
#pragma unroll
    for (int i = 0; i < 2; ++i) { int R, C; stage_rc(tid * 16 + i * 8192, R, C); rA[i] = R; cAo[i] = (unsigned)C * 2u; }
    unsigned cO[2][2], o2[2][2]; int nR[2][2];
#define PG8_ROWS(dst, u) do { _Pragma("unroll") for (int h_ = 0; h_ < 2; ++h_) _Pragma("unroll") for (int i_ = 0; i_ < 2; ++i_) \
        dst[h_][i_] = (unsigned)S.arow(u, h_ * HALF + rA[i_]) * (unsigned)(K * 2) + cAo[i_]; } while (0)
    PG8_ROWS(cO, cur);
    f32x4 acc[2][2][4][2];
#pragma unroll
    for (int a = 0; a < 2; ++a)
#pragma unroll
        for (int b = 0; b < 2; ++b)
#pragma unroll
            for (int m = 0; m < 4; ++m)
#pragma unroll
                for (int n = 0; n < 2; ++n) acc[a][b][m][n] = (f32x4){0.f, 0.f, 0.f, 0.f};
    bf16x8 At[4][2], B0[2][2], B1[2][2];
    const char* const Ab = (const char*)g.A; const char* cB = (const char*)g.Bt + (size_t)cur.pn * tstep;
    S.a_ready(cur);
    if constexpr (SP2) {
        PG8_STAGE(PG8_SB(0, 0), cB, voffB); PG8_STAGE(PG8_SB(0, 1), cB + hstep, voffB); PG8_STAGE(PG8_SA(0, 0), Ab, cO[0]); PG8_STAGE(PG8_SA(0, 1), Ab, cO[1]);
        if (wr == 1) PG8_BAR;
        PG8_WAIT_V(2); PG8_BAR;
        PG8_STAGE(PG8_SB(1, 0), cB + kstep, voffB); PG8_STAGE(PG8_SA(1, 0), Ab + kstep, cO[0]); PG8_STAGE(PG8_SB(1, 1), cB + hstep + kstep, voffB);
        PG8_WAIT_V(6); PG8_BAR;
    }
    for (;;) {
        const bool has_next = S.next(ui + 1, nxt);
        const char* nB = has_next ? (const char*)g.Bt + (size_t)nxt.pn * tstep : cB;
#pragma unroll
        for (int h_ = 0; h_ < 2; ++h_)
#pragma unroll
            for (int i_ = 0; i_ < 2; ++i_) nR[h_][i_] = has_next ? S.arow(nxt, h_ * HALF + rA[i_]) : 0;
        for (int t = 0; t < nt; t += 2) {
            const bool last = (t == nt - 2);
            const char* a1 = Ab + (size_t)(t + 1) * kstep;
            const char* a2 = last ? Ab : Ab + (size_t)(t + 2) * kstep; const char* b2 = last ? nB : cB + (size_t)(t + 2) * kstep;
#pragma unroll
            for (int h_ = 0; h_ < 2; ++h_)
#pragma unroll
                for (int i_ = 0; i_ < 2; ++i_) o2[h_][i_] = cO[h_][i_];
            if (last && has_next) {
#pragma unroll
                for (int h_ = 0; h_ < 2; ++h_)
#pragma unroll
                    for (int i_ = 0; i_ < 2; ++i_) { int v_ = nR[h_][i_]; asm volatile("" : "+v"(v_)); o2[h_][i_] = (unsigned)v_ * (unsigned)(K * 2) + cAo[i_]; } }
            const char* a3 = a2 + kstep; const char* b3 = b2 + kstep;
            if (last && has_next) S.a_ready(nxt);
            if constexpr (SP2) {
            PG8_LDB(B0, 0, 0); PG8_LDB(B1, 0, 1); PG8_SCHED; PG8_LDA(At, 0, 0); PG8_STAGE(PG8_SA(1, 1), a1, cO[1]);
            PG8_WAIT_V(8); PG8_WAIT_L(0); PG8_BAR; PG8_MMA(0, 0, At, B0); PG8_MMA(0, 1, At, B1); PG8_BAR; PG8_SCHED;
            PG8_LDA(At, 0, 1); PG8_STAGE(PG8_SB(0, 0), b2, voffB); PG8_STAGE(PG8_SB(0, 1), b2 + hstep, voffB); PG8_STAGE(PG8_SA(0, 0), a2, o2[0]);
            PG8_WAIT_V(8); PG8_WAIT_L(0); PG8_BAR; PG8_MMA(1, 0, At, B0); PG8_MMA(1, 1, At, B1); PG8_BAR; PG8_SCHED;
            PG8_LDB(B0, 1, 0); PG8_LDB(B1, 1, 1); PG8_SCHED; PG8_LDA(At, 1, 0); PG8_STAGE(PG8_SA(0, 1), a2, o2[1]);
            PG8_WAIT_V(8); PG8_WAIT_L(0); PG8_BAR; PG8_MMA(0, 0, At, B0); PG8_MMA(0, 1, At, B1); PG8_BAR; PG8_SCHED;
            PG8_LDA(At, 1, 1); PG8_STAGE(PG8_SB(1, 0), b3, voffB); PG8_STAGE(PG8_SB(1, 1), b3 + hstep, voffB); PG8_STAGE(PG8_SA(1, 0), a3, o2[0]);
            PG8_WAIT_V(8); PG8_WAIT_L(0); PG8_BAR; PG8_MMA(1, 0, At, B0); PG8_MMA(1, 1, At, B1); PG8_BAR; PG8_SCHED;
            }
        }
        if constexpr (ALIGN_EPI) { if (wr == 0) PG8_BAR; }
        if constexpr (!Epi::AFTER_DRAIN) { E(acc, cur, wr, wc, fr, fq); S.done(cur); }
        if (!has_next) break;
#pragma unroll
        for (int a = 0; a < 2; ++a)
#pragma unroll
            for (int b = 0; b < 2; ++b)
#pragma unroll
                for (int m = 0; m < 4; ++m)
#pragma unroll
                    for (int n = 0; n < 2; ++n) acc[a][b][m][n] = (f32x4){0.f, 0.f, 0.f, 0.f};
        cur = nxt; cB = nB; ++ui;
#pragma unroll
        for (int h_ = 0; h_ < 2; ++h_)
#pragma unroll
            for (int i_ = 0; i_ < 2; ++i_) cO[h_][i_] = o2[h_][i_];
        if constexpr (ALIGN_EPI) { if (wr == 1) PG8_BAR; }
    }
    PG8_WAIT_V(0);
    if constexpr (!ALIGN_EPI) { if (wr == 0) PG8_BAR; }
    PG8_BAR;
    if constexpr (Epi::AFTER_DRAIN) { E.fused(acc, cur, wr, wc, fr, fq, lds, wid, lane); S.done(cur); }
#undef PG8_ROWS
#undef PG8_SA
#undef PG8_SB
#undef PG8_STAGE
#undef PG8_LDA
#undef PG8_LDB
#undef PG8_MMA
#undef PG8_WAIT_V
#undef PG8_WAIT_L
#undef PG8_BAR
#undef PG8_SCHED
}
typedef int v4i_t __attribute__((ext_vector_type(4)));
typedef int v8i_t __attribute__((ext_vector_type(8)));
template <class Epi, class Sched, bool ALIGN_EPI = false, bool SP2 = false>
__device__ __forceinline__ void gemm_phase_f8(PG8_LAS unsigned char* lds, const Gemm g, const Sched& S, const Epi& E) {
    const int tid = threadIdx.x, wid = __builtin_amdgcn_readfirstlane(tid >> 6), lane = tid & 63, wr = wid >> 2, wc = wid & 3, fr = lane & 15, fq = lane >> 4;
    const int K = g.K, nt = K / BK;
    unsigned voffA[2], voffB[2];
#pragma unroll
    for (int i = 0; i < 2; ++i) { int R, C; stage_rc(tid * 16 + i * 8192, R, C); const int Rb = Epi::PERM ? ((R & ~31) + perm32(R & 31)) : R;
        voffA[i] = (unsigned)(R * K + C) * 2u; voffB[i] = (unsigned)(Rb * K + C) * 2u; }
    const size_t kstep = (size_t)(BK * 2);
    const size_t hstep = (size_t)HALF * K * 2;
    const size_t tstep = 2 * hstep;
    const unsigned ldsw = (unsigned)wid * 1024u;
    const int aoff = lds_byte(wr * 64 + fr, fq * 8), boff = lds_byte(wc * 32 + fr, fq * 8);
#define PG8_SA(b, h) (((b) * 2 + (h)) * HTB)
#define PG8_SB(b, h) ((4 + (b) * 2 + (h)) * HTB)
#define PG8_STAGE(bufoff, gbase, voff) do { _Pragma("unroll") for (int _i = 0; _i < 2; ++_i) \
        __builtin_amdgcn_global_load_lds((const unsigned*)((const char*)(gbase) + (voff)[_i]), (PG8_LAS unsigned*)(lds + (bufoff) + ldsw + _i * 8192), 16, 0, 0); } while (0)
#define PG8_LDA(dst, b, h) do { _Pragma("unroll") for (int m = 0; m < 4; ++m) { const v4i_t lo_ = *(const PG8_LAS v4i_t*)(lds + PG8_SA(b, h) + aoff + m * 2048), hi_ = *(const PG8_LAS v4i_t*)(lds + PG8_SA(b, h) + aoff + m * 2048 + 1024); dst[m] = __builtin_shufflevector(lo_, hi_, 0, 1, 2, 3, 4, 5, 6, 7); } } while (0)
#define PG8_LDB(dst, b, h) do { _Pragma("unroll") for (int n = 0; n < 2; ++n) { const v4i_t lo_ = *(const PG8_LAS v4i_t*)(lds + PG8_SB(b, h) + boff + n * 2048), hi_ = *(const PG8_LAS v4i_t*)(lds + PG8_SB(b, h) + boff + n * 2048 + 1024); dst[n] = __builtin_shufflevector(lo_, hi_, 0, 1, 2, 3, 4, 5, 6, 7); } } while (0)
#define PG8_MMA(ai, bj, At, Bt) do { __builtin_amdgcn_s_setprio(1); _Pragma("unroll") for (int m = 0; m < 4; ++m) _Pragma("unroll") for (int n = 0; n < 2; ++n) \
        asm volatile("v_mfma_scale_f32_16x16x128_f8f6f4 %0, %1, %2, %0, %3, %3 op_sel_hi:[0,0,0]" : "+v"(acc[ai][bj][m][n]) : "v"(Bt[n]), "v"(At[m]), "v"(scl_)); __builtin_amdgcn_s_setprio(0); } while (0)
#define PG8_WAIT_V(n) asm volatile("s_waitcnt vmcnt(" #n ")" ::: "memory")
#define PG8_WAIT_L(n) asm volatile("s_waitcnt lgkmcnt(" #n ")" ::: "memory")
#define PG8_BAR __builtin_amdgcn_s_barrier()
#define PG8_SCHED __builtin_amdgcn_sched_barrier(0)
    Unit cur, nxt; int ui = 0;
    if (!S.next(0, cur)) return;
    f32x4 acc[2][2][4][2];
#pragma unroll
    for (int a = 0; a < 2; ++a)
#pragma unroll
        for (int b = 0; b < 2; ++b)
#pragma unroll
            for (int m = 0; m < 4; ++m)
#pragma unroll
                for (int n = 0; n < 2; ++n) acc[a][b][m][n] = (f32x4){0.f, 0.f, 0.f, 0.f};
    const int scl_ = 0x7f7f7f7f;
    v8i_t At[4], B0[2], B1[2];
    const char* cA = (const char*)g.A + (size_t)cur.pm * tstep; const char* cB = (const char*)g.Bt + (size_t)cur.pn * tstep;
    S.a_ready(cur);
    if constexpr (SP2) {
        PG8_STAGE(PG8_SB(0, 0), cB, voffB); PG8_STAGE(PG8_SB(0, 1), cB + hstep, voffB); PG8_STAGE(PG8_SA(0, 0), cA, voffA); PG8_STAGE(PG8_SA(0, 1), cA + hstep, voffA);
        if (wr == 1) PG8_BAR;
        PG8_WAIT_V(2); PG8_BAR;
        PG8_STAGE(PG8_SB(1, 0), cB + kstep, voffB); PG8_STAGE(PG8_SA(1, 0), cA + kstep, voffA); PG8_STAGE(PG8_SB(1, 1), cB + hstep + kstep, voffB);
        PG8_WAIT_V(6); PG8_BAR;
    } else {
        PG8_STAGE(PG8_SB(0, 0), cB, voffB); PG8_STAGE(PG8_SA(0, 0), cA, voffA); PG8_STAGE(PG8_SB(0, 1), cB + hstep, voffB); PG8_STAGE(PG8_SA(0, 1), cA + hstep, voffA);
        if (wr == 1) PG8_BAR;
        PG8_WAIT_V(4); PG8_BAR;
        PG8_STAGE(PG8_SB(1, 0), cB + kstep, voffB); PG8_STAGE(PG8_SA(1, 0), cA + kstep, voffA); PG8_STAGE(PG8_SB(1, 1), cB + hstep + kstep, voffB);
        PG8_WAIT_V(6); PG8_BAR;
    }
    for (;;) {
        const bool has_next = S.next(ui + 1, nxt);
        const char* nA = has_next ? (const char*)g.A + (size_t)nxt.pm * tstep : cA; const char* nB = has_next ? (const char*)g.Bt + (size_t)nxt.pn * tstep : cB;
        for (int t = 0; t < nt; t += 2) {
            const bool last = (t == nt - 2);
            const char* a1 = cA + (size_t)(t + 1) * kstep;
            const char* a2 = last ? nA : cA + (size_t)(t + 2) * kstep; const char* b2 = last ? nB : cB + (size_t)(t + 2) * kstep;
            const char* a3 = a2 + kstep; const char* b3 = b2 + kstep;
            if (last && has_next) S.a_ready(nxt);
            if constexpr (SP2) {
            PG8_LDB(B0, 0, 0); PG8_LDB(B1, 0, 1); PG8_SCHED; PG8_LDA(At, 0, 0); PG8_STAGE(PG8_SA(1, 1), a1 + hstep, voffA);
            PG8_WAIT_V(8); PG8_WAIT_L(0); PG8_BAR; PG8_MMA(0, 0, At, B0); PG8_MMA(0, 1, At, B1); PG8_BAR; PG8_SCHED;
            PG8_LDA(At, 0, 1); PG8_STAGE(PG8_SB(0, 0), b2, voffB); PG8_STAGE(PG8_SB(0, 1), b2 + hstep, voffB); PG8_STAGE(PG8_SA(0, 0), a2, voffA);
            PG8_WAIT_V(8); PG8_WAIT_L(0); PG8_BAR; PG8_MMA(1, 0, At, B0); PG8_MMA(1, 1, At, B1); PG8_BAR; PG8_SCHED;
            PG8_LDB(B0, 1, 0); PG8_LDB(B1, 1, 1); PG8_SCHED; PG8_LDA(At, 1, 0); PG8_STAGE(PG8_SA(0, 1), a2 + hstep, voffA);
            PG8_WAIT_V(8); PG8_WAIT_L(0); PG8_BAR; PG8_MMA(0, 0, At, B0); PG8_MMA(0, 1, At, B1); PG8_BAR; PG8_SCHED;
            PG8_LDA(At, 1, 1); PG8_STAGE(PG8_SB(1, 0), b3, voffB); PG8_STAGE(PG8_SB(1, 1), b3 + hstep, voffB); PG8_STAGE(PG8_SA(1, 0), a3, voffA);
            PG8_WAIT_V(8); PG8_WAIT_L(0); PG8_BAR; PG8_MMA(1, 0, At, B0); PG8_MMA(1, 1, At, B1); PG8_BAR; PG8_SCHED;
            } else {
            PG8_LDB(B0, 0, 0); PG8_SCHED; PG8_LDA(At, 0, 0); PG8_STAGE(PG8_SA(1, 1), a1 + hstep, voffA);
            PG8_WAIT_L(8); PG8_BAR; PG8_WAIT_L(0); PG8_MMA(0, 0, At, B0); PG8_BAR; PG8_SCHED;
            PG8_LDB(B1, 0, 1); PG8_STAGE(PG8_SB(0, 0), b2, voffB);
            PG8_BAR; PG8_WAIT_L(0); PG8_MMA(0, 1, At, B1); PG8_BAR;
            PG8_LDA(At, 0, 1); PG8_STAGE(PG8_SA(0, 0), a2, voffA);
            PG8_BAR; PG8_WAIT_L(0); PG8_MMA(1, 0, At, B0); PG8_BAR; PG8_SCHED;
            PG8_STAGE(PG8_SB(0, 1), b2 + hstep, voffB);
            PG8_WAIT_V(6); PG8_BAR; PG8_MMA(1, 1, At, B1); PG8_BAR;
            PG8_LDB(B0, 1, 0); PG8_SCHED; PG8_LDA(At, 1, 0); PG8_STAGE(PG8_SA(0, 1), a2 + hstep, voffA);
            PG8_WAIT_L(8); PG8_BAR; PG8_WAIT_L(0); PG8_MMA(0, 0, At, B0); PG8_BAR; PG8_SCHED;
            PG8_LDB(B1, 1, 1); PG8_STAGE(PG8_SB(1, 0), b3, voffB);
            PG8_BAR; PG8_WAIT_L(0); PG8_MMA(0, 1, At, B1); PG8_BAR;
            PG8_LDA(At, 1, 1); PG8_STAGE(PG8_SA(1, 0), a3, voffA);
            PG8_BAR; PG8_WAIT_L(0); PG8_MMA(1, 0, At, B0); PG8_BAR; PG8_SCHED;
            PG8_STAGE(PG8_SB(1, 1), b3 + hstep, voffB);
            PG8_WAIT_V(6); PG8_BAR; PG8_MMA(1, 1, At, B1); PG8_BAR;
            }
        }
        if constexpr (ALIGN_EPI) { if (wr == 0) PG8_BAR; }
        asm volatile("s_nop 15\n\ts_nop 15" ::: "memory");
        if constexpr (!Epi::AFTER_DRAIN) { E(acc, cur, wr, wc, fr, fq); S.done(cur); }
        if (!has_next) break;
#pragma unroll
        for (int a = 0; a < 2; ++a)
#pragma unroll
            for (int b = 0; b < 2; ++b)
#pragma unroll
                for (int m = 0; m < 4; ++m)
#pragma unroll
                    for (int n = 0; n < 2; ++n) acc[a][b][m][n] = (f32x4){0.f, 0.f, 0.f, 0.f};
        cur = nxt; cA = nA; cB = nB; ++ui;
        if constexpr (ALIGN_EPI) { if (wr == 1) PG8_BAR; }
    }
    PG8_WAIT_V(0);
    if constexpr (!ALIGN_EPI) { if (wr == 0) PG8_BAR; }
    PG8_BAR;
    if constexpr (Epi::AFTER_DRAIN) { E.fused(acc, cur, wr, wc, fr, fq, lds, wid, lane); S.done(cur); }
#undef PG8_SA
#undef PG8_SB
#undef PG8_STAGE
#undef PG8_LDA
#undef PG8_LDB
#undef PG8_MMA
#undef PG8_WAIT_V
#undef PG8_WAIT_L
#undef PG8_BAR
#undef PG8_SCHED
}

template <class Epi, class Sched>
__device__ __forceinline__ void gemm_phase_gather_f8(PG8_LAS unsigned char* lds, const Gemm g, const Sched& S, const Epi& E) {
    constexpr bool ALIGN_EPI = true, SP2 = true;
    const int tid = threadIdx.x, wid = __builtin_amdgcn_readfirstlane(tid >> 6), lane = tid & 63, wr = wid >> 2, wc = wid & 3, fr = lane & 15, fq = lane >> 4;
    const int K = g.K, nt = K / BK;
    unsigned voffA[2], voffB[2];
#pragma unroll
    for (int i = 0; i < 2; ++i) { int R, C; stage_rc(tid * 16 + i * 8192, R, C); const int Rb = Epi::PERM ? ((R & ~31) + perm32(R & 31)) : R;
        voffA[i] = (unsigned)(R * K + C) * 2u; voffB[i] = (unsigned)(Rb * K + C) * 2u; }
    const size_t kstep = (size_t)(BK * 2);
    const size_t hstep = (size_t)HALF * K * 2;
    const size_t tstep = 2 * hstep;
    const unsigned ldsw = (unsigned)wid * 1024u;
    const int aoff = lds_byte(wr * 64 + fr, fq * 8), boff = lds_byte(wc * 32 + fr, fq * 8);
#define PG8_SA(b, h) (((b) * 2 + (h)) * HTB)
#define PG8_SB(b, h) ((4 + (b) * 2 + (h)) * HTB)
#define PG8_STAGE(bufoff, gbase, voff) do { _Pragma("unroll") for (int _i = 0; _i < 2; ++_i) \
        __builtin_amdgcn_global_load_lds((const unsigned*)((const char*)(gbase) + (voff)[_i]), (PG8_LAS unsigned*)(lds + (bufoff) + ldsw + _i * 8192), 16, 0, 0); } while (0)
#define PG8_LDA(dst, b, h) do { _Pragma("unroll") for (int m = 0; m < 4; ++m) { const v4i_t lo_ = *(const PG8_LAS v4i_t*)(lds + PG8_SA(b, h) + aoff + m * 2048), hi_ = *(const PG8_LAS v4i_t*)(lds + PG8_SA(b, h) + aoff + m * 2048 + 1024); dst[m] = __builtin_shufflevector(lo_, hi_, 0, 1, 2, 3, 4, 5, 6, 7); } } while (0)
#define PG8_LDB(dst, b, h) do { _Pragma("unroll") for (int n = 0; n < 2; ++n) { const v4i_t lo_ = *(const PG8_LAS v4i_t*)(lds + PG8_SB(b, h) + boff + n * 2048), hi_ = *(const PG8_LAS v4i_t*)(lds + PG8_SB(b, h) + boff + n * 2048 + 1024); dst[n] = __builtin_shufflevector(lo_, hi_, 0, 1, 2, 3, 4, 5, 6, 7); } } while (0)
#define PG8_MMA(ai, bj, At, Bt) do { __builtin_amdgcn_s_setprio(1); _Pragma("unroll") for (int m = 0; m < 4; ++m) _Pragma("unroll") for (int n = 0; n < 2; ++n) \
        asm volatile("v_mfma_scale_f32_16x16x128_f8f6f4 %0, %1, %2, %0, %3, %3 op_sel_hi:[0,0,0]" : "+v"(acc[ai][bj][m][n]) : "v"(Bt[n]), "v"(At[m]), "v"(scl_)); __builtin_amdgcn_s_setprio(0); } while (0)
#define PG8_WAIT_V(n) asm volatile("s_waitcnt vmcnt(" #n ")" ::: "memory")
#define PG8_WAIT_L(n) asm volatile("s_waitcnt lgkmcnt(" #n ")" ::: "memory")
#define PG8_BAR __builtin_amdgcn_s_barrier()
#define PG8_SCHED __builtin_amdgcn_sched_barrier(0)
    Unit cur, nxt; int ui = 0;
    if (!S.next(0, cur)) return;
    int rA[2]; unsigned cAo[2];
#pragma unroll
    for (int i = 0; i < 2; ++i) { int R, C; stage_rc(tid * 16 + i * 8192, R, C); rA[i] = R; cAo[i] = (unsigned)C * 2u; }
    unsigned cO[2][2], o2[2][2]; int nR[2][2];
#define PG8_ROWS(dst, u) do { _Pragma("unroll") for (int h_ = 0; h_ < 2; ++h_) _Pragma("unroll") for (int i_ = 0; i_ < 2; ++i_) \
        dst[h_][i_] = (unsigned)S.arow(u, h_ * HALF + rA[i_]) * (unsigned)(K * 2) + cAo[i_]; } while (0)
    PG8_ROWS(cO, cur);
    f32x4 acc[2][2][4][2];
#pragma unroll
    for (int a = 0; a < 2; ++a)
#pragma unroll
        for (int b = 0; b < 2; ++b)
#pragma unroll
            for (int m = 0; m < 4; ++m)
#pragma unroll
                for (int n = 0; n < 2; ++n) acc[a][b][m][n] = (f32x4){0.f, 0.f, 0.f, 0.f};
    const int scl_ = 0x7f7f7f7f;
    v8i_t At[4], B0[2], B1[2];
    const char* const Ab = (const char*)g.A; const char* cB = (const char*)g.Bt + (size_t)cur.pn * tstep;
    S.a_ready(cur);
    if constexpr (SP2) {
        PG8_STAGE(PG8_SB(0, 0), cB, voffB); PG8_STAGE(PG8_SB(0, 1), cB + hstep, voffB); PG8_STAGE(PG8_SA(0, 0), Ab, cO[0]); PG8_STAGE(PG8_SA(0, 1), Ab, cO[1]);
        if (wr == 1) PG8_BAR;
        PG8_WAIT_V(2); PG8_BAR;
        PG8_STAGE(PG8_SB(1, 0), cB + kstep, voffB); PG8_STAGE(PG8_SA(1, 0), Ab + kstep, cO[0]); PG8_STAGE(PG8_SB(1, 1), cB + hstep + kstep, voffB);
        PG8_WAIT_V(6); PG8_BAR;
    }
    for (;;) {
        const bool has_next = S.next(ui + 1, nxt);
        const char* nB = has_next ? (const char*)g.Bt + (size_t)nxt.pn * tstep : cB;
#pragma unroll
        for (int h_ = 0; h_ < 2; ++h_)
#pragma unroll
            for (int i_ = 0; i_ < 2; ++i_) nR[h_][i_] = has_next ? S.arow(nxt, h_ * HALF + rA[i_]) : 0;
        for (int t = 0; t < nt; t += 2) {
            const bool last = (t == nt - 2);
            const char* a1 = Ab + (size_t)(t + 1) * kstep;
            const char* a2 = last ? Ab : Ab + (size_t)(t + 2) * kstep; const char* b2 = last ? nB : cB + (size_t)(t + 2) * kstep;
#pragma unroll
            for (int h_ = 0; h_ < 2; ++h_)
#pragma unroll
                for (int i_ = 0; i_ < 2; ++i_) o2[h_][i_] = cO[h_][i_];
            if (last && has_next) {
#pragma unroll
                for (int h_ = 0; h_ < 2; ++h_)
#pragma unroll
                    for (int i_ = 0; i_ < 2; ++i_) { int v_ = nR[h_][i_]; asm volatile("" : "+v"(v_)); o2[h_][i_] = (unsigned)v_ * (unsigned)(K * 2) + cAo[i_]; } }
            const char* a3 = a2 + kstep; const char* b3 = b2 + kstep;
            if (last && has_next) S.a_ready(nxt);
            if constexpr (SP2) {
            PG8_LDB(B0, 0, 0); PG8_LDB(B1, 0, 1); PG8_SCHED; PG8_LDA(At, 0, 0); PG8_STAGE(PG8_SA(1, 1), a1, cO[1]);
            PG8_WAIT_V(8); PG8_WAIT_L(0); PG8_BAR; PG8_MMA(0, 0, At, B0); PG8_MMA(0, 1, At, B1); PG8_BAR; PG8_SCHED;
            PG8_LDA(At, 0, 1); PG8_STAGE(PG8_SB(0, 0), b2, voffB); PG8_STAGE(PG8_SB(0, 1), b2 + hstep, voffB); PG8_STAGE(PG8_SA(0, 0), a2, o2[0]);
            PG8_WAIT_V(8); PG8_WAIT_L(0); PG8_BAR; PG8_MMA(1, 0, At, B0); PG8_MMA(1, 1, At, B1); PG8_BAR; PG8_SCHED;
            PG8_LDB(B0, 1, 0); PG8_LDB(B1, 1, 1); PG8_SCHED; PG8_LDA(At, 1, 0); PG8_STAGE(PG8_SA(0, 1), a2, o2[1]);
            PG8_WAIT_V(8); PG8_WAIT_L(0); PG8_BAR; PG8_MMA(0, 0, At, B0); PG8_MMA(0, 1, At, B1); PG8_BAR; PG8_SCHED;
            PG8_LDA(At, 1, 1); PG8_STAGE(PG8_SB(1, 0), b3, voffB); PG8_STAGE(PG8_SB(1, 1), b3 + hstep, voffB); PG8_STAGE(PG8_SA(1, 0), a3, o2[0]);
            PG8_WAIT_V(8); PG8_WAIT_L(0); PG8_BAR; PG8_MMA(1, 0, At, B0); PG8_MMA(1, 1, At, B1); PG8_BAR; PG8_SCHED;
            }
        }
        if constexpr (ALIGN_EPI) { if (wr == 0) PG8_BAR; }
        asm volatile("s_nop 15\n\ts_nop 15" ::: "memory");
        if constexpr (!Epi::AFTER_DRAIN) { E(acc, cur, wr, wc, fr, fq); S.done(cur); }
        if (!has_next) break;
#pragma unroll
        for (int a = 0; a < 2; ++a)
#pragma unroll
            for (int b = 0; b < 2; ++b)
#pragma unroll
                for (int m = 0; m < 4; ++m)
#pragma unroll
                    for (int n = 0; n < 2; ++n) acc[a][b][m][n] = (f32x4){0.f, 0.f, 0.f, 0.f};
        cur = nxt; cB = nB; ++ui;
#pragma unroll
        for (int h_ = 0; h_ < 2; ++h_)
#pragma unroll
            for (int i_ = 0; i_ < 2; ++i_) cO[h_][i_] = o2[h_][i_];
        if constexpr (ALIGN_EPI) { if (wr == 1) PG8_BAR; }
    }
    PG8_WAIT_V(0);
    if constexpr (!ALIGN_EPI) { if (wr == 0) PG8_BAR; }
    PG8_BAR;
    if constexpr (Epi::AFTER_DRAIN) { E.fused(acc, cur, wr, wc, fr, fq, lds, wid, lane); S.done(cur); }
#undef PG8_ROWS
#undef PG8_SA
#undef PG8_SB
#undef PG8_STAGE
#undef PG8_LDA
#undef PG8_LDB
#undef PG8_MMA
#undef PG8_WAIT_V
#undef PG8_WAIT_L
#undef PG8_BAR
#undef PG8_SCHED
}
}

struct EpiP { bf16_t* P; int n0; __device__ __forceinline__ void operator()(int r, int cl, float a, float) const { P[(size_t)r * NPROJ + n0 + cl] = (bf16_t)f2bf(a); } };
__device__ __forceinline__ void phase_gemm1_naive(const Params& p, const Ctx& c) {
    const bf16_t* H = (const bf16_t*)(p.ws + WS_H); const bf16_t* W = (const bf16_t*)(p.ws + WS_WINT); bf16_t* P = (bf16_t*)(p.ws + WS_P);
    constexpr int NT_N = NPROJ / 64, NT_M = M / 128;
    for (int it = c.bid; it < NT_M * NT_N; it += c.G) {
        const int mt = it / NT_N, nt = it % NT_N;
        ngemm_tile<false>(ARowPlain{H, 1024}, W + (size_t)nt * 64 * 1024, nullptr, 1024, mt * 128, EpiP{P, nt * 64}, (LAS float*)c.lds, c.tid);
    }
}

__device__ __forceinline__ void phase_conv(const Params& p, const Ctx& c) {
    unsigned char* ws = p.ws;
    const bf16_t* P = (const bf16_t*)(ws + WS_P);
    const int tid = c.tid;
    LAS bf16_t* raw = (LAS bf16_t*)c.lds;
    LAS bf16_t* outb = (LAS bf16_t*)(c.lds + 132 * 256 * 2);
    for (int it = c.bid; it < 2 * 64 * 6; it += c.G) {
        const int part = it % 6, bc = it / 6, b = bc / 64, ch_ = bc % 64, t0 = ch_ * 128;
        __syncthreads();
        {
            u32x4 rv[9];
#pragma unroll
            for (int i = 0; i < 9; ++i) { const int idx = tid + 512 * i, r = idx >> 5, c8 = idx & 31, tok = t0 - 2 + r;
                rv[i] = (u32x4){0u, 0u, 0u, 0u};
                if (idx < 132 * 32 && tok >= 0 && tok < S) rv[i] = *(const u32x4*)(P + (size_t)(b * S + tok) * NPROJ + PXBC + part * 256 + c8 * 8); }
#pragma unroll
            for (int i = 0; i < 9; ++i) { const int idx = tid + 512 * i, r = idx >> 5, c8 = idx & 31;
                if (idx < 132 * 32) *(LAS u32x4*)(raw + r * 256 + c8 * 8) = rv[i]; }
        }
        __syncthreads();
        {
            const int ch = tid & 255, l0 = tid >> 8, cg_ = part * 256 + ch;
            const float* cw = p.in[3]; const float cb = p.in[4][cg_];
            const float w0 = cw[0 * 1536 + cg_], w1 = cw[1 * 1536 + cg_], w2 = cw[2 * 1536 + cg_], w3 = cw[3 * 1536 + cg_], w4 = cw[4 * 1536 + cg_];
            for (int i = 0; i < 64; ++i) {
                const int l = l0 + 2 * i;
                float a = cb;
                a = fmaf(w0, bf2f(raw[(l + 0) * 256 + ch]), a); a = fmaf(w1, bf2f(raw[(l + 1) * 256 + ch]), a); a = fmaf(w2, bf2f(raw[(l + 2) * 256 + ch]), a);
                a = fmaf(w3, bf2f(raw[(l + 3) * 256 + ch]), a); a = fmaf(w4, bf2f(raw[(l + 4) * 256 + ch]), a);
                outb[l * 256 + ch] = (bf16_t)f2bf(a * sigmoidf_(a));
            }
        }
        __syncthreads();
        if (part < 4 || part == 4) {
            bf16_t* dst = part < 4 ? (bf16_t*)(ws + WS_XT) + ((size_t)(b * 64 + ch_) * 16 + part * 4) * 64 * 128
                                   : (bf16_t*)(ws + WS_BMT) + (size_t)(b * 64 + ch_) * 2 * 128 * 128;
            for (int idx = tid; idx < 256 * 16; idx += 512) {
                const int lc = idx >> 8, ch = idx & 255;
                u32x4 o;
                o.x = (unsigned)outb[(lc * 8 + 0) * 256 + ch] | ((unsigned)outb[(lc * 8 + 1) * 256 + ch] << 16);
                o.y = (unsigned)outb[(lc * 8 + 2) * 256 + ch] | ((unsigned)outb[(lc * 8 + 3) * 256 + ch] << 16);
                o.z = (unsigned)outb[(lc * 8 + 4) * 256 + ch] | ((unsigned)outb[(lc * 8 + 5) * 256 + ch] << 16);
                o.w = (unsigned)outb[(lc * 8 + 6) * 256 + ch] | ((unsigned)outb[(lc * 8 + 7) * 256 + ch] << 16);
                *(u32x4*)(dst + (size_t)ch * 128 + lc * 8) = o;
            }
        }
        if (part >= 4) {
            bf16_t* dst = (bf16_t*)(ws + (part == 4 ? WS_BMR : WS_CMR)) + (size_t)(b * S + t0) * 256;
            for (int idx = tid; idx < 128 * 32; idx += 512) {
                const int l = idx >> 5, c8 = idx & 31;
                *(u32x4*)(dst + (size_t)l * 256 + c8 * 8) = *(const LAS u32x4*)(outb + l * 256 + c8 * 8);
            }
        }
    }
    {
        float* DT = (float*)(ws + WS_DT); float* ACS = (float*)(ws + WS_ACS); float* CDEC = (float*)(ws + WS_CDEC);
        const int lane = c.lane;
        for (int it = c.bid; it < 128; it += c.G) {
            const int b = it / 64, ch_ = it % 64, t0 = ch_ * 128;
#pragma unroll
            for (int qi = 0; qi < 4; ++qi) {
                const int q = c.wave * 4 + qi, dir = q >> 4, h = q & 15;
                const float bias = dir ? p.in[6][h] : p.in[5][h], nA = -expf(dir ? p.in[8][h] : p.in[7][h]);
                const int l0 = dir ? 127 - lane : lane, l1 = dir ? 63 - lane : lane + 64;
                const size_t tok0 = (size_t)b * S + t0 + l0, tok1 = (size_t)b * S + t0 + l1;
                const float x0 = bf2f(P[tok0 * NPROJ + PDT + q]) + bias, x1 = bf2f(P[tok1 * NPROJ + PDT + q]) + bias;
                const float d0 = fmaxf(x0, 0.f) + log1pf(expf(-fabsf(x0))), d1 = fmaxf(x1, 0.f) + log1pf(expf(-fabsf(x1)));
                float a0 = d0 * nA, a1 = d1 * nA;
#pragma unroll
                for (int o = 1; o < 64; o <<= 1) { const float t0_ = __shfl_up(a0, o), t1_ = __shfl_up(a1, o); if (lane >= o) { a0 += t0_; a1 += t1_; } }
                const float tot0 = __shfl(a0, 63); a1 += tot0;
                DT[((size_t)dir * M + tok0) * 16 + h] = d0; DT[((size_t)dir * M + tok1) * 16 + h] = d1;
                ACS[((size_t)dir * M + tok0) * 16 + h] = a0; ACS[((size_t)dir * M + tok1) * 16 + h] = a1;
                if (lane == 63) CDEC[((dir * 2 + b) * 64 + ch_) * 16 + h] = expf(a1);
            }
        }
    }
    {
        const int gw = c.bid * 8 + c.wave, NGW = c.G * 8, lane = c.lane;
        const float* rc = (const float*)(ws + WS_ROPE); const float* rs = rc + 4096;
        const int sub = lane >> 4, j = lane & 15, axis = j >> 3, i0 = 8 * (j & 3); const bool second = (j & 4) != 0;
        const f32x4 gq0 = *(const f32x4*)(p.in[11] + 8 * j), gq1 = *(const f32x4*)(p.in[11] + 8 * j + 4), gk0 = *(const f32x4*)(p.in[12] + 8 * j), gk1 = *(const f32x4*)(p.in[12] + 8 * j + 4);
        bf16_t* QN = (bf16_t*)(ws + WS_QN); bf16_t* KN = (bf16_t*)(ws + WS_KN);
#pragma unroll 4
        for (int base = gw; base < M * 10 / 4; base += NGW) {
            const int it = base * 4 + sub, tok = it / 10, hh = it % 10;
            const bf16_t* src = P + (size_t)tok * NPROJ + (hh < 8 ? PQ + hh * 128 : PK + (hh - 8) * 128) + 8 * j;
            bf16_t* dst = (hh < 8 ? QN + (size_t)tok * 1024 + hh * 128 : KN + (size_t)tok * 256 + (hh - 8) * 128) + 8 * j;
            const u32x4 v = *(const u32x4*)src;
            float y[8] = {bflo(v.x), bfhi(v.x), bflo(v.y), bfhi(v.y), bflo(v.z), bfhi(v.z), bflo(v.w), bfhi(v.w)};
            float ss = 0.f;
#pragma unroll
            for (int i = 0; i < 8; ++i) ss = fmaf(y[i], y[i], ss);
            ss += __shfl_xor(ss, 1); ss += __shfl_xor(ss, 2); ss += __shfl_xor(ss, 4); ss += __shfl_xor(ss, 8);
            const float rstd = rsqrtf(ss * (1.f / 128.f) + EPS);
            const f32x4 g0 = hh < 8 ? gq0 : gk0, g1 = hh < 8 ? gq1 : gk1;
#pragma unroll
            for (int i = 0; i < 4; ++i) { y[i] *= rstd * g0[i]; y[4 + i] *= rstd * g1[i]; }
            const int s = tok & (S - 1), pos = axis ? (s & 63) : (s >> 6);
            const f32x4 c0 = *(const f32x4*)(rc + pos * 32 + i0), c1 = *(const f32x4*)(rc + pos * 32 + i0 + 4), s0 = *(const f32x4*)(rs + pos * 32 + i0), s1 = *(const f32x4*)(rs + pos * 32 + i0 + 4);
            float o[8];
#pragma unroll
            for (int i = 0; i < 8; ++i) { const float other = __shfl_xor(y[i], 4); const float cs = i < 4 ? c0[i] : c1[i - 4], sn = i < 4 ? s0[i] : s1[i - 4];
                o[i] = second ? fmaf(other, sn, y[i] * cs) : fmaf(-other, sn, y[i] * cs); }
            u32x4 w; w.x = pk2(o[0], o[1]); w.y = pk2(o[2], o[3]); w.z = pk2(o[4], o[5]); w.w = pk2(o[6], o[7]);
            *(u32x4*)dst = w;
        }
        bf16_t* VB = (bf16_t*)(ws + WS_VB);
        for (int idx0 = c.bid * 512 + c.tid; idx0 < M * 32; idx0 += c.G * 512 * 4) {
            u32x4 v[4];
#pragma unroll
            for (int i = 0; i < 4; ++i) { const int idx = idx0 + i * c.G * 512; if (idx < M * 32) v[i] = *(const u32x4*)(P + (size_t)(idx >> 5) * NPROJ + PV + (idx & 31) * 8); }
#pragma unroll
            for (int i = 0; i < 4; ++i) { const int idx = idx0 + i * c.G * 512; if (idx < M * 32) *(u32x4*)(VB + (size_t)(idx >> 5) * 256 + (idx & 31) * 8) = v[i]; }
        }
    }
}

__device__ __forceinline__ void phase_ssd_naive(const Params& p, const Ctx& c) {
    unsigned char* ws = p.ws;
    const bf16_t* P = (const bf16_t*)(ws + WS_P); const bf16_t* XT = (const bf16_t*)(ws + WS_XT);
    const bf16_t* BMR = (const bf16_t*)(ws + WS_BMR); const bf16_t* CMR = (const bf16_t*)(ws + WS_CMR);
    const float* DT = (const float*)(ws + WS_DT); float* YACC = (float*)(ws + WS_ST); bf16_t* YZ = (bf16_t*)(ws + WS_YZ);
    const int pp = c.tid >> 3, nq = c.tid & 7;
    for (int item = c.bid; item < 32; item += c.G) {
        const int b = item >> 4, h = item & 15, g = h >> 3;
        const float dsk = p.in[9][h];
        for (int dir = 0; dir < 2; ++dir) {
            const float A = -expf(dir ? p.in[8][h] : p.in[7][h]);
            float st[16];
#pragma unroll
            for (int i = 0; i < 16; ++i) st[i] = 0.f;
            int t = dir ? S - 1 : 0;
            size_t tok = (size_t)b * S + t;
            u32x4 nb0 = *(const u32x4*)(BMR + tok * 256 + g * 128 + nq * 16), nb1 = *(const u32x4*)(BMR + tok * 256 + g * 128 + nq * 16 + 8);
            u32x4 nc0 = *(const u32x4*)(CMR + tok * 256 + g * 128 + nq * 16), nc1 = *(const u32x4*)(CMR + tok * 256 + g * 128 + nq * 16 + 8);
            float nx = bf2f(XT[((((size_t)b * 64 + (t >> 7)) * 16 + h) * 64 + pp) * 128 + (t & 127)]);
            float ndt = DT[((size_t)dir * M + tok) * 16 + h];
            for (int step = 0; step < S; ++step) {
                const u32x4 b0 = nb0, b1 = nb1, c0 = nc0, c1 = nc1; const float x = nx, dt = ndt; const size_t tokc = tok;
                if (step + 1 < S) {
                    t = dir ? S - 2 - step : step + 1; tok = (size_t)b * S + t;
                    nb0 = *(const u32x4*)(BMR + tok * 256 + g * 128 + nq * 16); nb1 = *(const u32x4*)(BMR + tok * 256 + g * 128 + nq * 16 + 8);
                    nc0 = *(const u32x4*)(CMR + tok * 256 + g * 128 + nq * 16); nc1 = *(const u32x4*)(CMR + tok * 256 + g * 128 + nq * 16 + 8);
                    nx = bf2f(XT[((((size_t)b * 64 + (t >> 7)) * 16 + h) * 64 + pp) * 128 + (t & 127)]);
                    ndt = DT[((size_t)dir * M + tok) * 16 + h];
                }
                const float dec = __expf(dt * A), xdt = x * dt;
                float part = 0.f;
#define SSD_STEP(i, BW, CW, LOHI) { st[i] = fmaf(st[i], dec, LOHI(BW) * xdt); part = fmaf(LOHI(CW), st[i], part); }
                SSD_STEP(0, b0.x, c0.x, bflo) SSD_STEP(1, b0.x, c0.x, bfhi) SSD_STEP(2, b0.y, c0.y, bflo) SSD_STEP(3, b0.y, c0.y, bfhi)
                SSD_STEP(4, b0.z, c0.z, bflo) SSD_STEP(5, b0.z, c0.z, bfhi) SSD_STEP(6, b0.w, c0.w, bflo) SSD_STEP(7, b0.w, c0.w, bfhi)
                SSD_STEP(8, b1.x, c1.x, bflo) SSD_STEP(9, b1.x, c1.x, bfhi) SSD_STEP(10, b1.y, c1.y, bflo) SSD_STEP(11, b1.y, c1.y, bfhi)
                SSD_STEP(12, b1.z, c1.z, bflo) SSD_STEP(13, b1.z, c1.z, bfhi) SSD_STEP(14, b1.w, c1.w, bflo) SSD_STEP(15, b1.w, c1.w, bfhi)
#undef SSD_STEP
                part += __shfl_xor(part, 1); part += __shfl_xor(part, 2); part += __shfl_xor(part, 4);
                if (nq == 0) {
                    const size_t o = tokc * 1024 + h * 64 + pp;
                    if (dir == 0) YACC[o] = part + x * dsk;
                    else { const float y = YACC[o] + part; const float z = bf2f(P[tokc * NPROJ + PZ + h * 64 + pp]); YZ[o] = (bf16_t)f2bf(y * z * sigmoidf_(z)); }
                }
            }
        }
    }
}


typedef short bf16x8 __attribute__((ext_vector_type(8)));
typedef float f32x16 __attribute__((ext_vector_type(16)));
constexpr int TS = 136;
__device__ __forceinline__ bf16x8 ldfrag(const LAS bf16_t* tile, int row, int k0) { return *(const LAS bf16x8*)(tile + row * TS + k0); }
template <int ROWS> __device__ __forceinline__ void load_tile128(LAS bf16_t* dst, const bf16_t* src, int ld, int tid) {
    constexpr int N = ROWS * 16 / 512;
    u32x4 v[N];
#pragma unroll
    for (int i = 0; i < N; ++i) { const int idx = tid + 512 * i; v[i] = *(const u32x4*)(src + (size_t)(idx >> 4) * ld + (idx & 15) * 8); }
#pragma unroll
    for (int i = 0; i < N; ++i) { const int idx = tid + 512 * i; *(LAS u32x4*)(dst + (idx >> 4) * TS + (idx & 15) * 8) = v[i]; }
}
__device__ __forceinline__ void phase_ssd_states(const Params& p, const Ctx& c) {
    unsigned char* ws = p.ws;
    const bf16_t* XT = (const bf16_t*)(ws + WS_XT); const bf16_t* BMT = (const bf16_t*)(ws + WS_BMT);
    const float* DT = (const float*)(ws + WS_DT); const float* ACS = (const float*)(ws + WS_ACS); bf16_t* ST = (bf16_t*)(ws + WS_PREV);
    LAS bf16_t* BTs = (LAS bf16_t*)c.lds; LAS bf16_t* XTf = BTs + 128 * TS; LAS bf16_t* XTb = XTf + 64 * TS; LAS float* wd = (LAS float*)(XTb + 64 * TS);
    const int tid = c.tid, lane = c.lane, r = lane & 31, hh = lane >> 5;
    for (int unit = c.bid; unit < 256; unit += c.G) {
        const int b = unit >> 7, ch = (unit >> 1) & 63, g = unit & 1;
        __syncthreads();
        load_tile128<128>(BTs, BMT + ((size_t)(b * 64 + ch) * 2 + g) * 128 * 128, 128, tid);
        u32x4 xv0, xv1; float pacs = 0.f, pdt = 0.f, paend = 0.f;
        const int wd_d = (tid >> 7) & 1, wd_l = tid & 127; const size_t wd_t0 = (size_t)wd_d * M + (size_t)b * S + ch * 128;
#define S1_PREFETCH(H) do { const bf16_t* xt_ = XT + ((size_t)(b * 64 + ch) * 16 + (H)) * 64 * 128; \
            xv0 = *(const u32x4*)(xt_ + (tid >> 4) * 128 + (tid & 15) * 8); xv1 = *(const u32x4*)(xt_ + ((tid + 512) >> 4) * 128 + (tid & 15) * 8); \
            if (tid < 256) { pacs = ACS[(wd_t0 + wd_l) * 16 + (H)]; pdt = DT[(wd_t0 + wd_l) * 16 + (H)]; paend = ACS[(wd_t0 + (wd_d ? 0 : 127)) * 16 + (H)]; } } while (0)
        S1_PREFETCH(g * 8);
#pragma unroll 1
        for (int h8 = 0; h8 < 8; ++h8) {
            const int h = g * 8 + h8;
            __syncthreads();
            if (tid < 256) wd[wd_d * 128 + wd_l] = pdt * __expf(paend - pacs);
            __syncthreads();
            {
                const u32x4 vv[2] = {xv0, xv1};
#pragma unroll
                for (int i = 0; i < 2; ++i) { const int idx = tid + 512 * i, pr = idx >> 4, l0 = (idx & 15) * 8; const u32x4 v = vv[i];
                    const float x[8] = {bflo(v.x), bfhi(v.x), bflo(v.y), bfhi(v.y), bflo(v.z), bfhi(v.z), bflo(v.w), bfhi(v.w)};
                    const f32x4 wf0 = *(const LAS f32x4*)(wd + l0), wf1 = *(const LAS f32x4*)(wd + l0 + 4), wb0 = *(const LAS f32x4*)(wd + 128 + l0), wb1 = *(const LAS f32x4*)(wd + 128 + l0 + 4);
                    u32x4 of, ob;
                    of.x = pk2(x[0] * wf0[0], x[1] * wf0[1]); of.y = pk2(x[2] * wf0[2], x[3] * wf0[3]); of.z = pk2(x[4] * wf1[0], x[5] * wf1[1]); of.w = pk2(x[6] * wf1[2], x[7] * wf1[3]);
                    ob.x = pk2(x[0] * wb0[0], x[1] * wb0[1]); ob.y = pk2(x[2] * wb0[2], x[3] * wb0[3]); ob.z = pk2(x[4] * wb1[0], x[5] * wb1[1]); ob.w = pk2(x[6] * wb1[2], x[7] * wb1[3]);
                    *(LAS u32x4*)(XTf + pr * TS + l0) = of; *(LAS u32x4*)(XTb + pr * TS + l0) = ob; }
            }
            if (h8 < 7) S1_PREFETCH(h + 1);
            __syncthreads();
            { const int d = c.wave >> 2, nb = c.wave & 3; const LAS bf16_t* XTd = d ? XTb : XTf;
              bf16_t* st = ST + ((((size_t)(d * 2 + b) * 64 + ch) * 16 + h) * 64) * 128;
#pragma unroll
              for (int pb = 0; pb < 2; ++pb) { f32x16 acc = {};
#pragma unroll
                for (int ks = 0; ks < 8; ++ks) acc = __builtin_amdgcn_mfma_f32_32x32x16_bf16(ldfrag(XTd, pb * 32 + r, ks * 16 + 8 * hh), ldfrag(BTs, nb * 32 + r, ks * 16 + 8 * hh), acc, 0, 0, 0);
#pragma unroll
                for (int i = 0; i < 16; ++i) { const int pp = pb * 32 + (i & 3) + 8 * (i >> 2) + 4 * hh; st[(size_t)pp * 128 + nb * 32 + r] = (bf16_t)f2bf(acc[i]); } } }
        }
#undef S1_PREFETCH
    }
}
__device__ __forceinline__ void phase_ssd_scan(const Params& p, const Ctx& c) {
    unsigned char* ws = p.ws;
    const float* CDEC = (const float*)(ws + WS_CDEC); bf16_t* PREV = (bf16_t*)(ws + WS_PREV);
    for (int idx = c.bid * 512 + c.tid; idx < 131072; idx += c.G * 512) {
        const int n4 = idx & 31, pp = (idx >> 5) & 63, h = (idx >> 11) & 15, b = (idx >> 15) & 1, d = idx >> 16;
        f32x4 run = {0.f, 0.f, 0.f, 0.f};
        const size_t obase = ((size_t)(d * 2 + b) * 64 * 16 + h) * 64 * 128 + (size_t)pp * 128 + n4 * 4;
        const float* cd = CDEC + (d * 2 + b) * 64 * 16 + h;
#pragma unroll 1
        for (int s0 = 0; s0 < 64; s0 += 16) {
            u32x2 sv[16]; float dec[16];
#pragma unroll
            for (int i = 0; i < 16; ++i) { const int ch = d ? 63 - (s0 + i) : s0 + i; sv[i] = *(const u32x2*)(PREV + obase + (size_t)ch * (16 * 64 * 128)); dec[i] = cd[ch * 16]; }
#pragma unroll
            for (int i = 0; i < 16; ++i) { const int ch = d ? 63 - (s0 + i) : s0 + i;
                u32x2 w; w.x = pk2(run.x, run.y); w.y = pk2(run.z, run.w); *(u32x2*)(PREV + obase + (size_t)ch * (16 * 64 * 128)) = w;
                run.x = fmaf(run.x, dec[i], bflo(sv[i].x)); run.y = fmaf(run.y, dec[i], bfhi(sv[i].x)); run.z = fmaf(run.z, dec[i], bflo(sv[i].y)); run.w = fmaf(run.w, dec[i], bfhi(sv[i].y)); }
        }
    }
}
__device__ __forceinline__ void phase_ssd_out(const Params& p, const Ctx& c) {
    unsigned char* ws = p.ws;
    const bf16_t* P = (const bf16_t*)(ws + WS_P); const bf16_t* XT = (const bf16_t*)(ws + WS_XT);
    const bf16_t* BMR = (const bf16_t*)(ws + WS_BMR); const bf16_t* CMR = (const bf16_t*)(ws + WS_CMR); const bf16_t* PREV = (const bf16_t*)(ws + WS_PREV);
    const float* DT = (const float*)(ws + WS_DT); const float* ACS = (const float*)(ws + WS_ACS); bf16_t* YZ = (bf16_t*)(ws + WS_YZ);
    LAS bf16_t* Cs = (LAS bf16_t*)c.lds; LAS bf16_t* Ms = Cs + 128 * TS; LAS bf16_t* XTs = Ms + 128 * TS; LAS bf16_t* PF = XTs + 64 * TS; LAS bf16_t* PB = PF + 64 * TS;
    LAS float* vec = (LAS float*)(PB + 64 * TS);
    constexpr int ZS = 72; LAS bf16_t* Zs = (LAS bf16_t*)(vec + 512); LAS float* dskl = (LAS float*)(Zs + 128 * ZS);
    const int tid = c.tid, lane = c.lane, r = lane & 31, hh = lane >> 5, wave = c.wave;
    for (int unit = c.bid; unit < 256; unit += c.G) {
        const int b = unit >> 7, ch = (unit >> 1) & 63, g = unit & 1;
        const size_t tok0 = (size_t)b * S + ch * 128;
        __syncthreads();
        load_tile128<128>(Cs, CMR + tok0 * 256 + g * 128, 256, tid);
        load_tile128<128>(Ms, BMR + tok0 * 256 + g * 128, 256, tid);
        u32x4 px0, px1, pf0, pf1, pb0, pb1, pz0, pz1; float pvec;
        const int t_r0 = tid >> 4, t_r1 = (tid + 512) >> 4, t_c = (tid & 15) * 8;
#define S3_PREFETCH(H) do { const bf16_t* xt_ = XT + ((size_t)(b * 64 + ch) * 16 + (H)) * 64 * 128; \
            const bf16_t* f_ = PREV + ((((size_t)(0 * 2 + b) * 64 + ch) * 16 + (H)) * 64) * 128; const bf16_t* b_ = PREV + ((((size_t)(1 * 2 + b) * 64 + ch) * 16 + (H)) * 64) * 128; \
            px0 = *(const u32x4*)(xt_ + t_r0 * 128 + t_c); px1 = *(const u32x4*)(xt_ + t_r1 * 128 + t_c); pf0 = *(const u32x4*)(f_ + t_r0 * 128 + t_c); pf1 = *(const u32x4*)(f_ + t_r1 * 128 + t_c); \
            pb0 = *(const u32x4*)(b_ + t_r0 * 128 + t_c); pb1 = *(const u32x4*)(b_ + t_r1 * 128 + t_c); \
            pz0 = *(const u32x4*)(P + (tok0 + (tid >> 3)) * NPROJ + PZ + (H) * 64 + (tid & 7) * 8); pz1 = *(const u32x4*)(P + (tok0 + 64 + (tid >> 3)) * NPROJ + PZ + (H) * 64 + (tid & 7) * 8); \
            { const int v_ = tid >> 7, l_ = tid & 127; const size_t o_ = ((size_t)(v_ & 1) * M + tok0 + l_) * 16 + (H); pvec = (v_ < 2) ? ACS[o_] : DT[o_]; } } while (0)
        S3_PREFETCH(g * 8);
        if (tid < 8) dskl[tid] = p.in[9][g * 8 + tid];
        __syncthreads();
        const int lb = wave & 3, sb0 = 2 * (wave >> 2);
        f32x16 G0 = {}, G1 = {};
#pragma unroll
        for (int ks = 0; ks < 8; ++ks) { const bf16x8 a = ldfrag(Cs, lb * 32 + r, ks * 16 + 8 * hh);
            G0 = __builtin_amdgcn_mfma_f32_32x32x16_bf16(a, ldfrag(Ms, sb0 * 32 + r, ks * 16 + 8 * hh), G0, 0, 0, 0);
            G1 = __builtin_amdgcn_mfma_f32_32x32x16_bf16(a, ldfrag(Ms, (sb0 + 1) * 32 + r, ks * 16 + 8 * hh), G1, 0, 0, 0); }
#pragma unroll 1
        for (int h8 = 0; h8 < 8; ++h8) {
            const int h = g * 8 + h8;
            __syncthreads();
            vec[tid] = pvec;
            *(LAS u32x4*)(XTs + t_r0 * TS + t_c) = px0; *(LAS u32x4*)(XTs + t_r1 * TS + t_c) = px1;
            *(LAS u32x4*)(PF + t_r0 * TS + t_c) = pf0; *(LAS u32x4*)(PF + t_r1 * TS + t_c) = pf1;
            *(LAS u32x4*)(PB + t_r0 * TS + t_c) = pb0; *(LAS u32x4*)(PB + t_r1 * TS + t_c) = pb1;
            *(LAS u32x4*)(Zs + (tid >> 3) * ZS + (tid & 7) * 8) = pz0; *(LAS u32x4*)(Zs + (64 + (tid >> 3)) * ZS + (tid & 7) * 8) = pz1;
            if (h8 < 7) S3_PREFETCH(h + 1);
            const int pbY = wave >> 2;
            __syncthreads();
#pragma unroll
            for (int t2 = 0; t2 < 2; ++t2) { const f32x16& Gt = t2 ? G1 : G0; const int sb = sb0 + t2, s = sb * 32 + r;
                const float afs = vec[s], abs_ = vec[128 + s], dfs = vec[256 + s], dbs = vec[384 + s];
                if (sb < lb) {
#pragma unroll
                    for (int i = 0; i < 16; ++i) { const int l = lb * 32 + (i & 3) + 8 * (i >> 2) + 4 * hh;
                        Ms[l * TS + s] = (bf16_t)f2bf(Gt[i] * __expf(vec[l] - afs) * dfs); }
                } else if (sb > lb) {
#pragma unroll
                    for (int i = 0; i < 16; ++i) { const int l = lb * 32 + (i & 3) + 8 * (i >> 2) + 4 * hh;
                        Ms[l * TS + s] = (bf16_t)f2bf(Gt[i] * __expf(vec[128 + l] - abs_) * dbs); }
                } else {
                    const float dsk = dskl[h8];
#pragma unroll
                    for (int i = 0; i < 16; ++i) { const int l = lb * 32 + (i & 3) + 8 * (i >> 2) + 4 * hh;
                        const float ef = __expf(fminf(vec[l] - afs, 0.f)) * dfs, eb = __expf(fminf(vec[128 + l] - abs_, 0.f)) * dbs;
                        const float tf = (s <= l) ? ef : 0.f, tb = (s >= l) ? eb : 0.f;
                        Ms[l * TS + s] = (bf16_t)f2bf(Gt[i] * (tf + tb) + (s == l ? dsk : 0.f)); }
                } }
            __syncthreads();
            { f32x16 Yd = {}, Yf = {}, Yb = {};
#pragma unroll
              for (int ks = 0; ks < 8; ++ks) { const int k0 = ks * 16 + 8 * hh;
                  Yd = __builtin_amdgcn_mfma_f32_32x32x16_bf16(ldfrag(Ms, lb * 32 + r, k0), ldfrag(XTs, pbY * 32 + r, k0), Yd, 0, 0, 0);
                  const bf16x8 a = ldfrag(Cs, lb * 32 + r, k0);
                  Yf = __builtin_amdgcn_mfma_f32_32x32x16_bf16(a, ldfrag(PF, pbY * 32 + r, k0), Yf, 0, 0, 0);
                  Yb = __builtin_amdgcn_mfma_f32_32x32x16_bf16(a, ldfrag(PB, pbY * 32 + r, k0), Yb, 0, 0, 0);
                  if (ks & 1) __builtin_amdgcn_sched_barrier(0); }
#pragma unroll
              for (int i = 0; i < 16; ++i) { const int l = lb * 32 + (i & 3) + 8 * (i >> 2) + 4 * hh;
                  const float y = Yd[i] + __expf(vec[l]) * Yf[i] + __expf(vec[128 + l]) * Yb[i];
                  const float z = bf2f(Zs[l * ZS + pbY * 32 + r]);
                  Zs[l * ZS + pbY * 32 + r] = (bf16_t)f2bf(y * z * sigmoidf_(z)); } }
            __syncthreads();
            *(u32x4*)(YZ + (tok0 + (tid >> 3)) * 1024 + h * 64 + (tid & 7) * 8) = *(const LAS u32x4*)(Zs + (tid >> 3) * ZS + (tid & 7) * 8);
            *(u32x4*)(YZ + (tok0 + 64 + (tid >> 3)) * 1024 + h * 64 + (tid & 7) * 8) = *(const LAS u32x4*)(Zs + (64 + (tid >> 3)) * ZS + (tid & 7) * 8);
        }
#undef S3_PREFETCH
    }
}

__device__ __forceinline__ void phase_rstd(const Params& p, const Ctx& c) {
    const bf16_t* YZ = (const bf16_t*)(p.ws + WS_YZ); float* RSTD = (float*)(p.ws + WS_RSTD);
    const int gw = c.bid * 8 + c.wave, NGW = c.G * 8;
    for (int m0 = gw * 4; m0 < M; m0 += NGW * 4) {
        u32x4 v[4][2];
#pragma unroll
        for (int q = 0; q < 4; ++q) { const u32x4* r = (const u32x4*)(YZ + (size_t)(m0 + q) * 1024) + c.lane; v[q][0] = r[0]; v[q][1] = r[64]; }
#pragma unroll
        for (int q = 0; q < 4; ++q) { float s = 0.f;
#pragma unroll
            for (int j = 0; j < 2; ++j) { const u32x4 w = v[q][j];
                s += bflo(w.x) * bflo(w.x) + bfhi(w.x) * bfhi(w.x) + bflo(w.y) * bflo(w.y) + bfhi(w.y) * bfhi(w.y) + bflo(w.z) * bflo(w.z) + bfhi(w.z) * bfhi(w.z) + bflo(w.w) * bflo(w.w) + bfhi(w.w) * bfhi(w.w); }
            s = wave_sum(s);
            if (c.lane == 0) RSTD[m0 + q] = rsqrtf(s * (1.f / 1024.f) + EPS); }
    }
}

__device__ __forceinline__ void phase_attn_naive(const Params& p, const Ctx& c) {
    unsigned char* ws = p.ws;
    const bf16_t* QN = (const bf16_t*)(ws + WS_QN); const bf16_t* KN = (const bf16_t*)(ws + WS_KN); const bf16_t* VB = (const bf16_t*)(ws + WS_VB);
    bf16_t* AO = (bf16_t*)(ws + WS_AO);
    LAS bf16_t* Ks = (LAS bf16_t*)c.lds; LAS bf16_t* Vs = Ks + 64 * 128;
    const int tid = c.tid, row = tid >> 2, dq = tid & 3;
    constexpr float C = 0.088388347648318440f * 1.4426950408889634f;
    for (int item = c.bid; item < 1024; item += c.G) {
        const int b = item >> 9, h = (item >> 6) & 7, qb = item & 63, kvh = h >> 2;
        const size_t tokq = (size_t)b * S + qb * 128 + row;
        float q[32], o[32];
#pragma unroll
        for (int i = 0; i < 4; ++i) { const u32x4 v = *(const u32x4*)(QN + tokq * 1024 + h * 128 + dq * 32 + i * 8);
            q[i * 8 + 0] = bflo(v.x) * C; q[i * 8 + 1] = bfhi(v.x) * C; q[i * 8 + 2] = bflo(v.y) * C; q[i * 8 + 3] = bfhi(v.y) * C;
            q[i * 8 + 4] = bflo(v.z) * C; q[i * 8 + 5] = bfhi(v.z) * C; q[i * 8 + 6] = bflo(v.w) * C; q[i * 8 + 7] = bfhi(v.w) * C; }
#pragma unroll
        for (int i = 0; i < 32; ++i) o[i] = 0.f;
        float mrun = -1e30f, lrun = 0.f;
        for (int kt = 0; kt < S / 64; ++kt) {
            __syncthreads();
            {
                const int key = tid >> 3, ch = tid & 7;
                const size_t tk = ((size_t)b * S + kt * 64 + key) * 256 + kvh * 128 + ch * 16;
                *(LAS u32x4*)(Ks + key * 128 + ch * 16) = *(const u32x4*)(KN + tk); *(LAS u32x4*)(Ks + key * 128 + ch * 16 + 8) = *(const u32x4*)(KN + tk + 8);
                *(LAS u32x4*)(Vs + key * 128 + ch * 16) = *(const u32x4*)(VB + tk); *(LAS u32x4*)(Vs + key * 128 + ch * 16 + 8) = *(const u32x4*)(VB + tk + 8);
            }
            __syncthreads();
            for (int j = 0; j < 64; ++j) {
                float s = 0.f;
#pragma unroll
                for (int i = 0; i < 4; ++i) { const u32x4 v = *(const LAS u32x4*)(Ks + j * 128 + dq * 32 + i * 8);
                    s = fmaf(q[i * 8 + 0], bflo(v.x), s); s = fmaf(q[i * 8 + 1], bfhi(v.x), s); s = fmaf(q[i * 8 + 2], bflo(v.y), s); s = fmaf(q[i * 8 + 3], bfhi(v.y), s);
                    s = fmaf(q[i * 8 + 4], bflo(v.z), s); s = fmaf(q[i * 8 + 5], bfhi(v.z), s); s = fmaf(q[i * 8 + 6], bflo(v.w), s); s = fmaf(q[i * 8 + 7], bfhi(v.w), s); }
                s += __shfl_xor(s, 1); s += __shfl_xor(s, 2);
                const float mn = fmaxf(mrun, s), al = __builtin_amdgcn_exp2f(mrun - mn), pe = __builtin_amdgcn_exp2f(s - mn);
                mrun = mn; lrun = lrun * al + pe;
#pragma unroll
                for (int i = 0; i < 4; ++i) { const u32x4 v = *(const LAS u32x4*)(Vs + j * 128 + dq * 32 + i * 8);
                    o[i * 8 + 0] = fmaf(pe, bflo(v.x), o[i * 8 + 0] * al); o[i * 8 + 1] = fmaf(pe, bfhi(v.x), o[i * 8 + 1] * al);
                    o[i * 8 + 2] = fmaf(pe, bflo(v.y), o[i * 8 + 2] * al); o[i * 8 + 3] = fmaf(pe, bfhi(v.y), o[i * 8 + 3] * al);
                    o[i * 8 + 4] = fmaf(pe, bflo(v.z), o[i * 8 + 4] * al); o[i * 8 + 5] = fmaf(pe, bfhi(v.z), o[i * 8 + 5] * al);
                    o[i * 8 + 6] = fmaf(pe, bflo(v.w), o[i * 8 + 6] * al); o[i * 8 + 7] = fmaf(pe, bfhi(v.w), o[i * 8 + 7] * al); }
            }
        }
        const float rl = 1.f / lrun;
#pragma unroll
        for (int i = 0; i < 4; ++i) { u32x4 w;
            w.x = pk2(o[i * 8 + 0] * rl, o[i * 8 + 1] * rl); w.y = pk2(o[i * 8 + 2] * rl, o[i * 8 + 3] * rl); w.z = pk2(o[i * 8 + 4] * rl, o[i * 8 + 5] * rl); w.w = pk2(o[i * 8 + 6] * rl, o[i * 8 + 7] * rl);
            *(u32x4*)(AO + tokq * 1024 + h * 128 + dq * 32 + i * 8) = w; }
    }
}

namespace attn {
typedef unsigned short bf16;
constexpr int   D = 128, NW = 8, QBLK = 32, KVBLK = 64;
constexpr float SCALE = 0.088388347648318440f;
constexpr float THR = 8.f;
constexpr int SDEPTH = 2;
constexpr int LDQ = 1024, LDK = 256, LDO = 1024;
constexpr size_t SHM_V = KVBLK * D * 2, SHM_K = KVBLK * D * 2, SHM_ATTN = 2 * SHM_V + 2 * SHM_K + NW * 64 * 4;
using bf16x8 = __attribute__((ext_vector_type(8))) short;
using s16x4  = __attribute__((ext_vector_type(4))) short;
using f32x16 = __attribute__((ext_vector_type(16))) float;
using f32x8  = __attribute__((ext_vector_type(8))) float;
using u32x4  = __attribute__((ext_vector_type(4))) unsigned;
#define KSWZ(row, colB) ((row) * 256 + ((colB) ^ (((row) & 7) << 4)))
#define SBAR() __builtin_amdgcn_sched_barrier(0)
__device__ __forceinline__ int crow(int r, int hi) { return (r & 3) + 8 * (r >> 2) + 4 * hi; }
__device__ __forceinline__ unsigned cvtpk(float lo, float hi) {
  unsigned r; asm volatile("v_cvt_pk_bf16_f32 %0, %1, %2" : "=v"(r) : "v"(lo), "v"(hi)); return r;
}
template <typename TIn> struct Stage;
template <> struct Stage<bf16>  { using T = bf16x8;
  __device__ static __forceinline__ T ld8(const bf16* p) { return *reinterpret_cast<const bf16x8*>(p); }
  __device__ static __forceinline__ bf16x8 tobf(T x) { return x; } };
template <> struct Stage<float> { using T = f32x8;
  __device__ static __forceinline__ T ld8(const float* p) { return *reinterpret_cast<const f32x8*>(p); }
  __device__ static __forceinline__ bf16x8 tobf(T x) {
    u32x4 w = {cvtpk(x[0], x[1]), cvtpk(x[2], x[3]), cvtpk(x[4], x[5]), cvtpk(x[6], x[7])}; return *reinterpret_cast<bf16x8*>(&w); } };

__device__ __forceinline__ void partialSM(f32x16& p0, f32x16& p1, float& m_reg, float& mn, float& alpha) {
  constexpr float C = SCALE * 1.4426950408889634f;
  float pmax = p0[0]; for (int r = 1; r < 16; ++r) pmax = fmaxf(pmax, p0[r]); for (int r = 0; r < 16; ++r) pmax = fmaxf(pmax, p1[r]);
  { auto rr = __builtin_amdgcn_permlane32_swap(__float_as_uint(pmax), __float_as_uint(pmax), false, false);
    pmax = fmaxf(__uint_as_float(rr[0]), __uint_as_float(rr[1])); }
  if (__builtin_expect(__all(pmax - m_reg <= THR / SCALE), 1)) { mn = m_reg; alpha = 1.f; }
  else { mn = fmaxf(m_reg, pmax); alpha = __builtin_amdgcn_exp2f((m_reg - mn) * C); m_reg = mn; }
  float mnC = -mn * C;
  for (int r = 0; r < 16; ++r) p0[r] = fmaf(p0[r], C, mnC); for (int r = 0; r < 16; ++r) p1[r] = fmaf(p1[r], C, mnC);
  for (int r = 0; r < 16; ++r) p0[r] = __builtin_amdgcn_exp2f(p0[r]);
}
__device__ __forceinline__ void finishSM(f32x16& p0, f32x16& p1, float alpha, float& l_reg, bf16x8& pa0, bf16x8& pa1, bf16x8& pa2, bf16x8& pa3) {
  for (int r = 0; r < 16; ++r) p1[r] = __builtin_amdgcn_exp2f(p1[r]);
  float ps = 0; for (int r = 0; r < 16; ++r) ps += p0[r]; for (int r = 0; r < 16; ++r) ps += p1[r];
  { auto rr = __builtin_amdgcn_permlane32_swap(__float_as_uint(ps), __float_as_uint(ps), false, false);
    ps = __uint_as_float(rr[0]) + __uint_as_float(rr[1]); }
  l_reg = l_reg * alpha + ps;
#define PK4(P, BASE, OUT) do { unsigned a0 = cvtpk(P[BASE + 0], P[BASE + 1]), a1 = cvtpk(P[BASE + 2], P[BASE + 3]);   \
    unsigned b0 = cvtpk(P[BASE + 4], P[BASE + 5]), b1 = cvtpk(P[BASE + 6], P[BASE + 7]);                              \
    auto r0 = __builtin_amdgcn_permlane32_swap(a0, b0, false, false); auto r1 = __builtin_amdgcn_permlane32_swap(a1, b1, false, false); \
    u32x4 w = {r0[0], r1[0], r0[1], r1[1]}; OUT = *reinterpret_cast<bf16x8*>(&w); } while (0)
  PK4(p0, 0, pa0); PK4(p0, 8, pa1); PK4(p1, 0, pa2); PK4(p1, 8, pa3);
#undef PK4
}
__device__ __forceinline__ void qkt(f32x16& p0, f32x16& p1, const bf16* Ks, const bf16x8* qr, int r32, int hi) {
  p0 = f32x16{}; p1 = f32x16{};
  for (int d0 = 0; d0 < 8; ++d0) { int cb = (d0 * 16 + hi * 8) * 2;
    bf16x8 b0 = *reinterpret_cast<const bf16x8*>((const char*)Ks + KSWZ(r32, cb));
    bf16x8 b1 = *reinterpret_cast<const bf16x8*>((const char*)Ks + KSWZ(32 + r32, cb));
    p0 = __builtin_amdgcn_mfma_f32_32x32x16_bf16(b0, qr[d0], p0, 0, 0, 0);
    p1 = __builtin_amdgcn_mfma_f32_32x32x16_bf16(b1, qr[d0], p1, 0, 0, 0); }
}
__device__ __forceinline__ int v_st(int k, int c) { const int kk = (k & ~0xC) | ((k & 4) << 1) | ((k & 8) >> 1); return ((kk >> 3) * 4 + (c >> 5)) * 512 + ((kk & 7) * 32 + (c & 31)) * 2; }
__device__ __forceinline__ int v_rd_base(int lane) { return ((lane & 3) << 3) | (((lane >> 2) & 3) << 6) | (((lane >> 4) & 1) << 5) | (((lane >> 5) & 1) << 8); }
constexpr int v_rd_off(int d0, int ks, int half) { return d0 * 512 + ks * 4096 + half * 2048; }
template <int OFF> __device__ __forceinline__ s16x4 tr_read(int vb) {
  s16x4 r; asm volatile("ds_read_b64_tr_b16 %0, %1 offset:%2" : "=&v"(r) : "v"(vb), "i"(OFF) : "memory"); return r;
}
template <int D0> __device__ __forceinline__ void pv_one(f32x16& od, int vb, bf16x8 pa0, bf16x8 pa1, bf16x8 pa2, bf16x8 pa3) {
  const s16x4 l0 = tr_read<v_rd_off(D0, 0, 0)>(vb), h0 = tr_read<v_rd_off(D0, 0, 1)>(vb), l1 = tr_read<v_rd_off(D0, 1, 0)>(vb), h1 = tr_read<v_rd_off(D0, 1, 1)>(vb);
  const s16x4 l2 = tr_read<v_rd_off(D0, 2, 0)>(vb), h2 = tr_read<v_rd_off(D0, 2, 1)>(vb), l3 = tr_read<v_rd_off(D0, 3, 0)>(vb), h3 = tr_read<v_rd_off(D0, 3, 1)>(vb);
  asm volatile("s_waitcnt lgkmcnt(0)" ::: "memory"); SBAR();
#define PK(L, H) (bf16x8){L[0], L[1], L[2], L[3], H[0], H[1], H[2], H[3]}
  od = __builtin_amdgcn_mfma_f32_32x32x16_bf16(pa0, PK(l0, h0), od, 0, 0, 0);
  od = __builtin_amdgcn_mfma_f32_32x32x16_bf16(pa1, PK(l1, h1), od, 0, 0, 0);
  od = __builtin_amdgcn_mfma_f32_32x32x16_bf16(pa2, PK(l2, h2), od, 0, 0, 0);
  od = __builtin_amdgcn_mfma_f32_32x32x16_bf16(pa3, PK(l3, h3), od, 0, 0, 0);
#undef PK
}
__device__ __forceinline__ void pv_d0(f32x16* o, int vb, bf16x8 pa0, bf16x8 pa1, bf16x8 pa2, bf16x8 pa3) {
  pv_one<0>(o[0], vb, pa0, pa1, pa2, pa3); pv_one<1>(o[1], vb, pa0, pa1, pa2, pa3); pv_one<2>(o[2], vb, pa0, pa1, pa2, pa3); pv_one<3>(o[3], vb, pa0, pa1, pa2, pa3);
}

template <typename TQ>
__device__ __forceinline__ void attn_dense_body(const TQ* __restrict__ Qb, const bf16* __restrict__ Kh, const bf16* __restrict__ Vh,
                                                bf16* __restrict__ Ob, int seq, char* lds) {
  using St = Stage<bf16>; using SQ = Stage<TQ>;
  const int tid = threadIdx.x, wid = tid >> 6, lane = tid & 63, r32 = lane & 31, hi = lane >> 5;
  bf16* V_lds = (bf16*)lds; bf16* K_lds = (bf16*)(lds + 2 * SHM_V);
  float* ws = (float*)(lds + 2 * SHM_V + 2 * SHM_K) + wid * 64; float* li_l = ws; float* al_l = ws + 32;
  float m_reg = -1e30f, l_reg = 0; f32x16 o[4] = {}; bf16x8 qr[8];
  const TQ* Qw = Qb + (long)(wid * QBLK + r32) * LDQ + hi * 8;
#pragma unroll
  for (int d0 = 0; d0 < 8; ++d0) qr[d0] = SQ::tobf(SQ::ld8(Qw + d0 * 16));
  const int sr = tid >> 4, sc = (tid & 15) * 8, vst0 = v_st(sr, sc), vst1 = v_st(32 + sr, sc);
  const int vb0 = (int)(uintptr_t)V_lds + v_rd_base(lane);
  struct { typename St::T vs0, vs1, ks0, ks1; } sr_[SDEPTH];
#define SLOAD(i, k0) do { sr_[i].vs0 = St::ld8(&Vh[(long)((k0) + sr) * LDK + sc]); sr_[i].vs1 = St::ld8(&Vh[(long)((k0) + 32 + sr) * LDK + sc]); \
    sr_[i].ks0 = St::ld8(&Kh[(long)((k0) + sr) * LDK + sc]); sr_[i].ks1 = St::ld8(&Kh[(long)((k0) + 32 + sr) * LDK + sc]); } while (0)
#define SWRITE(b, i) do { *(bf16x8*)((char*)V_lds + (b) * SHM_V + vst0) = St::tobf(sr_[i].vs0);          \
    *(bf16x8*)((char*)V_lds + (b) * SHM_V + vst1) = St::tobf(sr_[i].vs1); int kc = sc * 2;               \
    *(bf16x8*)((char*)K_lds + (b) * SHM_K + KSWZ(sr, kc)) = St::tobf(sr_[i].ks0);                       \
    *(bf16x8*)((char*)K_lds + (b) * SHM_K + KSWZ(32 + sr, kc)) = St::tobf(sr_[i].ks1); } while (0)
#define SWAIT() do { if constexpr (SDEPTH == 2) asm volatile("s_waitcnt vmcnt(4)" ::: "memory"); else asm volatile("s_waitcnt vmcnt(0)" ::: "memory"); } while (0)
#define RESC(a) do { if (__any((a) < 1.f)) { if (hi == 0) al_l[r32] = (a); asm volatile("s_waitcnt lgkmcnt(0)" ::: "memory"); \
    for (int d = 0; d < 4; ++d) for (int r = 0; r < 16; ++r) o[d][r] *= al_l[crow(r, hi)]; } } while (0)
  f32x16 pA0, pA1, pB0, pB1; float mnA, mnB, alA, alB; bf16x8 pa0, pa1, pa2, pa3; const int NT = seq / KVBLK;
  constexpr int SE = 0, SO = SDEPTH - 1;
  SLOAD(SE, 0); asm volatile("s_waitcnt vmcnt(0)" ::: "memory"); SWRITE(0, SE); __syncthreads();
  qkt(pA0, pA1, K_lds, qr, r32, hi); partialSM(pA0, pA1, m_reg, mnA, alA);
  SLOAD(SO, KVBLK); if constexpr (SDEPTH == 2) { if (2 < NT) SLOAD(SE, 2 * KVBLK); }
  SWAIT(); SWRITE(1, SO); __syncthreads();
  for (int j = 1; j + 1 < NT; j += 2) {
    SBAR(); qkt(pB0, pB1, (bf16*)((char*)K_lds + SHM_K), qr, r32, hi);
    finishSM(pA0, pA1, alA, l_reg, pa0, pa1, pa2, pa3); SBAR();
    SLOAD(SO, (j + SDEPTH) * KVBLK); SBAR();
    pv_d0(o, vb0, pa0, pa1, pa2, pa3); partialSM(pB0, pB1, m_reg, mnB, alB);
    __syncthreads(); SWAIT(); SWRITE(0, SE);
    RESC(alB); __syncthreads();
    SBAR(); qkt(pA0, pA1, K_lds, qr, r32, hi);
    finishSM(pB0, pB1, alB, l_reg, pa0, pa1, pa2, pa3); SBAR();
    if (SDEPTH == 1 || j + 3 < NT) SLOAD(SE, (j + 1 + SDEPTH) * KVBLK); SBAR();
    pv_d0(o, vb0 + (int)SHM_V, pa0, pa1, pa2, pa3); partialSM(pA0, pA1, m_reg, mnA, alA);
    __syncthreads(); SWAIT(); SWRITE(1, SO);
    RESC(alA); __syncthreads();
  }
  SBAR(); qkt(pB0, pB1, (bf16*)((char*)K_lds + SHM_K), qr, r32, hi);
  finishSM(pA0, pA1, alA, l_reg, pa0, pa1, pa2, pa3); SBAR();
  pv_d0(o, vb0, pa0, pa1, pa2, pa3); partialSM(pB0, pB1, m_reg, mnB, alB);
  __syncthreads(); RESC(alB);
  finishSM(pB0, pB1, alB, l_reg, pa0, pa1, pa2, pa3); SBAR();
  pv_d0(o, vb0 + (int)SHM_V, pa0, pa1, pa2, pa3);
  if (hi == 0) li_l[r32] = l_reg; asm volatile("s_waitcnt lgkmcnt(0)" ::: "memory");
  float rli[16];
#pragma unroll
  for (int r = 0; r < 16; ++r) rli[r] = __builtin_amdgcn_rcpf(li_l[crow(r, hi)]);
  bf16* Ow = Ob + (long)(wid * QBLK) * LDO;
#pragma unroll
  for (int r = 0; r < 16; ++r) { int orow = crow(r, hi);
    for (int d0 = 0; d0 < 4; ++d0) Ow[(long)orow * LDO + d0 * 32 + r32] = (bf16)f2bf(o[d0][r] * rli[r]); }
#undef SLOAD
#undef SWRITE
#undef SWAIT
#undef RESC
}
}

__device__ __forceinline__ void phase_attn(const Params& p, const Ctx& c, char* lds_generic) {
    unsigned char* ws = p.ws;
    const bf16_t* QN = (const bf16_t*)(ws + WS_QN); const bf16_t* KN = (const bf16_t*)(ws + WS_KN); const bf16_t* VB = (const bf16_t*)(ws + WS_VB); bf16_t* AO = (bf16_t*)(ws + WS_AO);
    for (int item = c.bid; item < 512; item += c.G) {
        const int b = item >> 8, h = (item >> 5) & 7, qb = item & 31, kvh = h >> 2;
        const size_t q0 = ((size_t)b * S + qb * 256) * 1024 + h * 128, k0 = (size_t)b * S * 256 + kvh * 128;
        attn::attn_dense_body<attn::bf16>(QN + q0, KN + k0, VB + k0, AO + q0, S, lds_generic);
        __syncthreads();
    }
}

struct EpiT1 { bf16_t* T1; const bf16_t* P; const float* RSTD; int n0;
    __device__ __forceinline__ void operator()(int r, int cl, float a, float) const { const int col = n0 + cl;
        T1[(size_t)r * 1024 + col] = (bf16_t)f2bf(a * RSTD[r] * sigmoidf_(bf2f(P[(size_t)r * NPROJ + PG + col]))); } };
struct EpiT2 { bf16_t* MG; const bf16_t* T1; const bf16_t* P; int n0;
    __device__ __forceinline__ void operator()(int r, int cl, float a, float) const { const int col = n0 + cl;
        MG[(size_t)r * 1024 + col] = (bf16_t)f2bf(bf2f(T1[(size_t)r * 1024 + col]) + a * sigmoidf_(bf2f(P[(size_t)r * NPROJ + PG + 1024 + col]))); } };
struct EpiT3 { float* X1; const float* x; int n0;
    __device__ __forceinline__ void operator()(int r, int cl, float a, float) const { const size_t o = (size_t)r * 1024 + n0 + cl; X1[o] = x[o] + a; } };
template <int WHICH> __device__ __forceinline__ void phase_tail_naive(const Params& p, const Ctx& c) {
    unsigned char* ws = p.ws;
    for (int it = c.bid; it < (M / 128) * 16; it += c.G) {
        const int mt = it >> 4, nt = it & 15;
        if (WHICH == 0) ngemm_tile<false>(ARowPlain{(const bf16_t*)(ws + WS_YZ), 1024}, (const bf16_t*)(ws + WS_WST) + (size_t)nt * 64 * 1024, nullptr, 1024, mt * 128,
                                          EpiT1{(bf16_t*)(ws + WS_T1), (const bf16_t*)(ws + WS_P), (const float*)(ws + WS_RSTD), nt * 64}, (LAS float*)c.lds, c.tid);
        if (WHICH == 1) ngemm_tile<false>(ARowPlain{(const bf16_t*)(ws + WS_AO), 1024}, (const bf16_t*)(ws + WS_WAT) + (size_t)nt * 64 * 1024, nullptr, 1024, mt * 128,
                                          EpiT2{(bf16_t*)(ws + WS_MG), (const bf16_t*)(ws + WS_T1), (const bf16_t*)(ws + WS_P), nt * 64}, (LAS float*)c.lds, c.tid);
        if (WHICH == 2) ngemm_tile<false>(ARowPlain{(const bf16_t*)(ws + WS_MG), 1024}, (const bf16_t*)(ws + WS_WOT) + (size_t)nt * 64 * 1024, nullptr, 1024, mt * 128,
                                          EpiT3{(float*)(ws + WS_X1), p.in[0], nt * 64}, (LAS float*)c.lds, c.tid);
    }
}

__device__ __forceinline__ void phase_router(const Params& p, const Ctx& c) {
    unsigned char* ws = p.ws;
    LAS float* wT = (LAS float*)c.lds;
    LAS int* tokE = (LAS int*)(c.lds + LDS_CTL + 512);
    LAS float* tokW = (LAS float*)(c.lds + LDS_CTL + 512 + 1024);
    LAS int* lcnt = (LAS int*)(c.lds + LDS_CTL + 512 + 2048);
    LAS int* lbase = lcnt + 32;
    LAS int* lrank = lbase + 32;
    const float* X1 = (const float*)(ws + WS_X1); unsigned char* H2 = ws + WS_H2;
    int* CNT = (int*)(ws + WS_CTL); int* TOKES = (int*)(ws + WS_TOKES); float* TOKW = (float*)(ws + WS_TOKW); int* LIST = (int*)(ws + WS_LIST);
    const int tid = c.tid, lane = c.lane;
    __syncthreads();
    { const f32x4* src = (const f32x4*)(ws + WS_WRT); for (int idx = tid; idx < 8192; idx += 512) ((LAS f32x4*)wT)[idx] = src[idx]; }
    __syncthreads();
    f32x4 gv[4];
#pragma unroll
    for (int j = 0; j < 4; ++j) gv[j] = ((const f32x4*)p.in[16])[lane + 64 * j];
    const float bias_e = p.in[18][(lane >> 1) & 31];
    for (int blk = c.bid; blk < M / 64; blk += c.G) {
        if (tid < 32) lcnt[tid] = 0;
        for (int pr = 0; pr < 4; ++pr) {
            const int tl = c.wave * 8 + pr * 2;
            const size_t tokA = (size_t)blk * 64 + tl;
            f32x4 hA[4], hB[4];
            {
                const f32x4* xa = (const f32x4*)(X1 + tokA * 1024) + lane; const f32x4* xb = xa + 256;
                float sa = 0.f, sb = 0.f;
#pragma unroll
                for (int j = 0; j < 4; ++j) { hA[j] = xa[64 * j]; hB[j] = xb[64 * j];
                    sa += (hA[j].x * hA[j].x + hA[j].y * hA[j].y) + (hA[j].z * hA[j].z + hA[j].w * hA[j].w);
                    sb += (hB[j].x * hB[j].x + hB[j].y * hB[j].y) + (hB[j].z * hB[j].z + hB[j].w * hB[j].w); }
                const float ra = rsqrtf(wave_sum(sa) * (1.f / 1024.f) + EPS), rb = rsqrtf(wave_sum(sb) * (1.f / 1024.f) + EPS);
                unsigned* oa = (unsigned*)(H2 + tokA * 1024) + lane; unsigned* ob = oa + 256;
#pragma unroll
                for (int j = 0; j < 4; ++j) { hA[j] = hA[j] * ra * gv[j]; hB[j] = hB[j] * rb * gv[j];
                    oa[64 * j] = pack4_fp8(8.f * hA[j].x, 8.f * hA[j].y, 8.f * hA[j].z, 8.f * hA[j].w);
                    ob[64 * j] = pack4_fp8(8.f * hB[j].x, 8.f * hB[j].y, 8.f * hB[j].z, 8.f * hB[j].w); }
            }
            float accA[32], accB[32];
#pragma unroll
            for (int e = 0; e < 32; ++e) {
                float a = 0.f, b = 0.f;
#pragma unroll
                for (int j = 0; j < 4; ++j) { const f32x4 w = *(const LAS f32x4*)&wT[e * 1024 + 256 * j + 4 * lane];
                    a = fmaf(hA[j].x, w.x, a); a = fmaf(hA[j].y, w.y, a); a = fmaf(hA[j].z, w.z, a); a = fmaf(hA[j].w, w.w, a);
                    b = fmaf(hB[j].x, w.x, b); b = fmaf(hB[j].y, w.y, b); b = fmaf(hB[j].z, w.z, b); b = fmaf(hB[j].w, w.w, b); }
                accA[e] = a; accB[e] = b;
                if (e & 1) __builtin_amdgcn_sched_barrier(0);
            }
#define RSTEP(N, BIT) _Pragma("unroll") for (int i = 0; i < N; ++i) { const bool up = (lane & BIT) != 0; \
                const float ka = up ? accA[N + i] : accA[i], sa_ = up ? accA[i] : accA[N + i]; accA[i] = ka + __shfl_xor(sa_, BIT); \
                const float kb = up ? accB[N + i] : accB[i], sb_ = up ? accB[i] : accB[N + i]; accB[i] = kb + __shfl_xor(sb_, BIT); }
            RSTEP(16, 32) RSTEP(8, 16) RSTEP(4, 8) RSTEP(2, 4) RSTEP(1, 2)
#undef RSTEP
            const float la = accA[0] + __shfl_xor(accA[0], 1) + bias_e, lb = accB[0] + __shfl_xor(accB[0], 1) + bias_e;
            const int my_e = (lane >> 1) & 31;
#pragma unroll
            for (int t2 = 0; t2 < 2; ++t2) {
                float val = t2 ? lb : la;
                int se[4]; float sv[4];
#pragma unroll
                for (int k = 0; k < 4; ++k) {
                    const float mx = wave_max(val);
                    const int sel = wave_min_i(val == mx ? my_e : 64);
                    se[k] = sel; sv[k] = mx;
                    if (my_e == sel) val = -INFINITY;
                }
                const float e1 = __expf(sv[1] - sv[0]), e2 = __expf(sv[2] - sv[0]), e3 = __expf(sv[3] - sv[0]);
                const float inv = 1.f / (1.f + e1 + e2 + e3);
                if (lane == 0) {
                    const int t = tl + t2;
                    tokE[t * 4 + 0] = se[0]; tokE[t * 4 + 1] = se[1]; tokE[t * 4 + 2] = se[2]; tokE[t * 4 + 3] = se[3];
                    tokW[t * 4 + 0] = inv; tokW[t * 4 + 1] = e1 * inv; tokW[t * 4 + 2] = e2 * inv; tokW[t * 4 + 3] = e3 * inv;
                }
            }
        }
        __syncthreads();
        if (tid < 256) lrank[tid] = atomicAdd((int*)&lcnt[tokE[tid]], 1);
        __syncthreads();
        if (tid < 32) lbase[tid] = lcnt[tid] ? atomicAdd(&CNT[tid], lcnt[tid]) : 0;
        __syncthreads();
        if (tid < 256) {
            const int e = tokE[tid], slot = lbase[e] + lrank[tid], tok = blk * 64 + (tid >> 2);
            LIST[e * 16384 + slot] = tok; TOKES[tok * 4 + (tid & 3)] = (e << 16) | slot; TOKW[tok * 4 + (tid & 3)] = tokW[tid];
        }
        __syncthreads();
    }
}

__device__ __forceinline__ void load_offs(const Params& p, const Ctx& c, LAS int*& offs, LAS int*& cnt) {
    offs = (LAS int*)(c.lds + LDS_CTL); cnt = offs + 40;
    __syncthreads();
    if (c.tid == 0) {
        const int* CNT = (const int*)(p.ws + WS_CTL); int run = 0;
        for (int e = 0; e < 32; ++e) { const int n = __hip_atomic_load(CNT + e, __ATOMIC_RELAXED, __HIP_MEMORY_SCOPE_AGENT); cnt[e] = n; offs[e] = run; run += (n + 255) & ~255; }
        offs[32] = run;
    }
    __syncthreads();
}
__device__ __forceinline__ int find_expert(const LAS int* offs, int row) { int e = 0; while (e < 31 && row >= offs[e + 1]) ++e; return e; }

__device__ __forceinline__ void phase_gather(const Params& p, const Ctx& c) {
    LAS int* offs; LAS int* cnt; load_offs(p, c, offs, cnt);
    const bf16_t* H2 = (const bf16_t*)(p.ws + WS_H2); bf16_t* XB = (bf16_t*)(p.ws + WS_XB); const int* LIST = (const int*)(p.ws + WS_LIST);
    const int gw = c.bid * 8 + c.wave, NGW = c.G * 8, total = offs[32];
    for (int row0 = gw * 4; row0 < total; row0 += NGW * 4) {
        const int e = find_expert(offs, row0), slot0 = row0 - offs[e], n = cnt[e];
        int tok[4];
#pragma unroll
        for (int q = 0; q < 4; ++q) tok[q] = (slot0 + q < n) ? LIST[e * 16384 + slot0 + q] : -1;
        u32x4 v[4][2];
#pragma unroll
        for (int q = 0; q < 4; ++q) { v[q][0] = (u32x4){0u, 0u, 0u, 0u}; v[q][1] = v[q][0];
            if (tok[q] >= 0) { const u32x4* s = (const u32x4*)(H2 + (size_t)tok[q] * 1024); v[q][0] = s[c.lane]; v[q][1] = s[c.lane + 64]; } }
#pragma unroll
        for (int q = 0; q < 4; ++q) { u32x4* d = (u32x4*)(XB + (size_t)(row0 + q) * 1024); d[c.lane] = v[q][0]; d[c.lane + 64] = v[q][1]; }
    }
}

struct EpiAct { bf16_t* ACT; const float* b1; int j0;
    __device__ __forceinline__ void operator()(int r, int cl, float g, float u) const { const int j = j0 + cl;
        g = fminf(g + b1[j], 7.f); u = fminf(fmaxf(u + b1[1024 + j], -7.f), 7.f);
        ACT[(size_t)r * 1024 + j] = (bf16_t)f2bf(g * sigmoidf_(1.702f * g) * (u + 1.f)); } };
struct EpiY { bf16_t* YB; const float* b2; int n0;
    __device__ __forceinline__ void operator()(int r, int cl, float a, float) const { const int col = n0 + cl; YB[(size_t)r * 1024 + col] = (bf16_t)f2bf(a + b2[col]); } };
template <int WHICH> __device__ __forceinline__ void phase_moe_naive(const Params& p, const Ctx& c) {
    LAS int* offs; LAS int* cnt; load_offs(p, c, offs, cnt);
    unsigned char* ws = p.ws;
    const int nrt = offs[32] / 128;
    for (int it = c.bid; it < nrt * 16; it += c.G) {
        const int rt = it >> 4, ct = it & 15, row0 = rt * 128, e = find_expert(offs, row0);
        if (WHICH == 0) {
            const int j0 = ct * 64, nt = j0 >> 7, jj = j0 & 127;
            const bf16_t* Wg = (const bf16_t*)(ws + WS_W1T) + ((size_t)e * 2048 + nt * 256 + jj) * 1024;
            ngemm_tile<true>(ARowPlain{(const bf16_t*)(ws + WS_XB), 1024}, Wg, Wg + (size_t)128 * 1024, 1024, row0,
                             EpiAct{(bf16_t*)(ws + WS_ACT), p.in[20] + (size_t)e * 2048, j0}, (LAS float*)c.lds, c.tid);
        } else {
            const bf16_t* W = (const bf16_t*)(ws + WS_W2T) + ((size_t)e * 1024 + ct * 64) * 1024;
            ngemm_tile<false>(ARowPlain{(const bf16_t*)(ws + WS_ACT), 1024}, W, nullptr, 1024, row0,
                              EpiY{(bf16_t*)(ws + WS_YB), p.in[22] + (size_t)e * 1024, ct * 64}, (LAS float*)c.lds, c.tid);
        }
    }
}


__device__ __forceinline__ void phase_gemm1(const Params& p, const Ctx& c) {
    pg8::Gemm g{(const bf16_t*)(p.ws + WS_H), (const bf16_t*)(p.ws + WS_WINT), M, NPROJ, 1024};
    pg8::StaticOrder S; S.init(M, NPROJ, c.G, c.bid);
    pg8::EpiStore E{(bf16_t*)(p.ws + WS_P), NPROJ};
    pg8::gemm_phase<pg8::EpiStore, pg8::StaticOrder, true, true>(c.lds, g, S, E);
}
__device__ __forceinline__ void phase_tail12(const Params& p, const Ctx& c) {
    unsigned char* ws = p.ws;
    pg8::TailOrder S; S.so.init(M, 1024, c.G, c.bid);
    pg8::Gemm g{(const bf16_t*)(ws + WS_YZ), (const bf16_t*)(ws + WS_WST), 2 * M, 2048, 1024};
    pg8::EpiT12 E{(bf16_t*)(ws + WS_T1), (bf16_t*)(ws + WS_MG), (const bf16_t*)(ws + WS_P) + PG, NPROJ, (const float*)(ws + WS_RSTD)};
    pg8::gemm_phase<pg8::EpiT12, pg8::TailOrder, true, true>(c.lds, g, S, E);
}
__device__ __forceinline__ void phase_tail3(const Params& p, const Ctx& c) {
    unsigned char* ws = p.ws;
    pg8::StaticOrder S; S.init(M, 1024, c.G, c.bid);
    pg8::Gemm g{(const bf16_t*)(ws + WS_MG), (const bf16_t*)(ws + WS_WOT), M, 1024, 1024};
    pg8::EpiT3b E{(float*)(ws + WS_X1), p.in[0]};
    pg8::gemm_phase<pg8::EpiT3b, pg8::StaticOrder, true, true>(c.lds, g, S, E);
}
__device__ __forceinline__ void phase_moe1(const Params& p, const Ctx& c) {
    LAS int* offs; LAS int* cnt; load_offs(p, c, offs, cnt);
    unsigned char* ws = p.ws;
    pg8::Gemm g{(const bf16_t*)(ws + WS_H2), (const bf16_t*)(ws + WS_W1T), M, 32 * 2048, 512};
    pg8::MoeGatherOrder S{offs, cnt, (const int*)(ws + WS_LIST), 8, c.G, c.bid, offs[32] / 256};
    pg8::EpiAct8 E{(unsigned char*)(ws + WS_ACT), p.in[20]};
    pg8::gemm_phase_gather_f8<pg8::EpiAct8, pg8::MoeGatherOrder>(c.lds, g, S, E);
}
__device__ __forceinline__ void phase_moe2(const Params& p, const Ctx& c) {
    LAS int* offs; LAS int* cnt; load_offs(p, c, offs, cnt);
    unsigned char* ws = p.ws;
    pg8::Gemm g{(const bf16_t*)(ws + WS_ACT), (const bf16_t*)(ws + WS_W2T), ROWS_MAX, 32 * 1024, 512};
    pg8::MoeOrder S{offs, 4, c.G, c.bid, offs[32] / 256};
    pg8::EpiY8 E{(bf16_t*)(ws + WS_YB), p.in[22]};
    pg8::gemm_phase_f8<pg8::EpiY8, pg8::MoeOrder, true, true>(c.lds, g, S, E);
}

__device__ __forceinline__ void phase_combine(const Params& p, const Ctx& c) {
    LAS int* offs; LAS int* cnt; load_offs(p, c, offs, cnt);
    unsigned char* ws = p.ws;
    const float* X1 = (const float*)(ws + WS_X1); const bf16_t* YB = (const bf16_t*)(ws + WS_YB);
    const int* TOKES = (const int*)(ws + WS_TOKES); const float* TOKW = (const float*)(ws + WS_TOKW);
    const int gw = c.bid * 8 + c.wave, NGW = c.G * 8, lane = c.lane;
    f32x4 gv[4];
#pragma unroll
    for (int j = 0; j < 4; ++j) gv[j] = ((const f32x4*)p.in[23])[lane + 64 * j];
    for (int m0 = gw * 2; m0 < M; m0 += NGW * 2) {
        int es[2][4]; float wq[2][4];
#pragma unroll
        for (int t = 0; t < 2; ++t)
#pragma unroll
            for (int k = 0; k < 4; ++k) { es[t][k] = TOKES[(m0 + t) * 4 + k]; wq[t][k] = TOKW[(m0 + t) * 4 + k]; }
        f32x4 v[2][4]; u32x2 y[2][4][4];
#pragma unroll
        for (int t = 0; t < 2; ++t) { const f32x4* xr = (const f32x4*)(X1 + (size_t)(m0 + t) * 1024) + lane;
#pragma unroll
            for (int j = 0; j < 4; ++j) v[t][j] = xr[64 * j];
#pragma unroll
            for (int k = 0; k < 4; ++k) { const int row = offs[es[t][k] >> 16] + (es[t][k] & 0xffff); const u32x2* yr = (const u32x2*)(YB + (size_t)row * 1024) + lane;
#pragma unroll
                for (int j = 0; j < 4; ++j) y[t][k][j] = yr[64 * j]; } }
#pragma unroll
        for (int t = 0; t < 2; ++t) {
#pragma unroll
            for (int k = 0; k < 4; ++k) { const float w = wq[t][k];
#pragma unroll
                for (int j = 0; j < 4; ++j) { const u32x2 yy = y[t][k][j];
                    v[t][j].x = fmaf(w, bflo(yy.x), v[t][j].x); v[t][j].y = fmaf(w, bfhi(yy.x), v[t][j].y); v[t][j].z = fmaf(w, bflo(yy.y), v[t][j].z); v[t][j].w = fmaf(w, bfhi(yy.y), v[t][j].w); } }
            float s = 0.f;
#pragma unroll
            for (int j = 0; j < 4; ++j) s += (v[t][j].x * v[t][j].x + v[t][j].y * v[t][j].y) + (v[t][j].z * v[t][j].z + v[t][j].w * v[t][j].w);
            const float rstd = rsqrtf(wave_sum(s) * (1.f / 1024.f) + EPS);
            f32x4* o = (f32x4*)(p.out + (size_t)(m0 + t) * 1024) + lane;
#pragma unroll
            for (int j = 0; j < 4; ++j) o[64 * j] = v[t][j] * rstd * gv[j];
        }
    }
}

constexpr int NPHASE = 13;
__global__ void __launch_bounds__(512) mega(Params p) {
    extern __shared__ __attribute__((aligned(16))) unsigned char lds_raw[];
    Ctx c; c.tid = threadIdx.x; c.lane = c.tid & 63; c.wave = __builtin_amdgcn_readfirstlane(c.tid >> 6); c.bid = blockIdx.x; c.G = gridDim.x;
    c.lds = (LAS unsigned char*)lds_raw;
    cg::grid_group grid = cg::this_grid();
#define RUN(k, call) if (p.ph_lo <= (k) && (k) < p.ph_hi) { call; if ((k) + 1 < p.ph_hi) grid.sync(); }
    RUN(0, phase_prep(p, c))
    RUN(1, phase_gemm1(p, c))
    RUN(2, phase_conv(p, c))
    RUN(3, phase_ssd_states(p, c))
    RUN(4, phase_ssd_scan(p, c))
    RUN(5, phase_ssd_out(p, c))
    RUN(6, phase_rstd(p, c); phase_attn(p, c, (char*)lds_raw))
    RUN(7, phase_tail12(p, c))
    RUN(8, phase_tail3(p, c))
    RUN(9, phase_router(p, c))
    RUN(10, phase_moe1(p, c))
    RUN(11, phase_moe2(p, c))
    RUN(12, phase_combine(p, c))
#undef RUN
}

extern "C" void kernel_launch(void* const* d_in, const int* in_sizes, int n_in, void* d_out, int out_size, void* d_ws, size_t ws_size, hipStream_t stream) {
    static int ok = 0; static int grid_blocks = 0;
    if (ok == 0) {
        if (n_in != 24 || out_size != M * D || ws_size < WS_END) { fprintf(stderr, "kernel_launch: unexpected shapes: n_in %d out %d ws %zu (need %zu)\n", n_in, out_size, ws_size, (size_t)WS_END); ok = -1; return; }
        if (hipFuncSetAttribute((const void*)mega, hipFuncAttributeMaxDynamicSharedMemorySize, LDS_BYTES) != hipSuccess) { fprintf(stderr, "kernel_launch: hipFuncSetAttribute failed\n"); ok = -1; return; }
        int dev = 0, cus = 0, per_cu = 0;
        hipGetDevice(&dev);
        hipDeviceGetAttribute(&cus, hipDeviceAttributeMultiprocessorCount, dev);
        hipOccupancyMaxActiveBlocksPerMultiprocessor(&per_cu, (const void*)mega, 512, LDS_BYTES);
        if (per_cu < 1 || cus < 1) { fprintf(stderr, "kernel_launch: occupancy query gave %d blocks/CU on %d CUs\n", per_cu, cus); ok = -1; return; }
        grid_blocks = cus;
        ok = 1;
    }
    if (ok < 0) return;
    Params p{};
    for (int i = 0; i < 24; ++i) p.in[i] = (const float*)d_in[i];
    p.out = (float*)d_out; p.ws = (unsigned char*)d_ws;
    p.ph_lo = 0; p.ph_hi = NPHASE;
    void* args[] = {&p};
    hipError_t e = hipLaunchCooperativeKernel((const void*)mega, dim3(grid_blocks), dim3(512), args, LDS_BYTES, stream);
    if (e != hipSuccess) fprintf(stderr, "kernel_launch: cooperative launch failed: %s (grid %d)\n", hipGetErrorString(e), grid_blocks);
}
```

```cpp
#include <hip/hip_runtime.h>
#include <hip/hip_cooperative_groups.h>
#include <cstdio>
#include <cstdint>

namespace cg = cooperative_groups;
#define LAS __attribute__((address_space(3)))
typedef unsigned short bf16_t;
typedef unsigned u32x4 __attribute__((ext_vector_type(4)));
typedef unsigned u32x2 __attribute__((ext_vector_type(2)));
typedef float f32x4 __attribute__((ext_vector_type(4)));

constexpr int NB = 2, S = 8192, D = 1024, M = NB * S;
constexpr int NPROJ = 6400;
constexpr int PZ = 0, PXBC = 1024, PQ = 2560, PK = 3584, PV = 3840, PG = 4096, PDT = 6144;
constexpr int ROWS_MAX = 65536 + 32 * 256;
constexpr float EPS = 1e-6f;

constexpr size_t al256(size_t x) { return (x + 255) / 256 * 256; }
constexpr size_t WS_CTL = 0;
constexpr size_t WS_BAR = 4096;
constexpr size_t WS_ROPE = 4096 + 16384;
constexpr size_t WS_WRT = WS_ROPE + 32768;
constexpr size_t WS_WINT = WS_WRT + 131072;
constexpr size_t WS_WST = WS_WINT + (size_t)NPROJ * 1024 * 2;
constexpr size_t WS_WAT = WS_WST + 2097152;
constexpr size_t WS_WOT = WS_WAT + 2097152;
constexpr size_t WS_W1T = WS_WOT + 2097152;
constexpr size_t WS_W2T = WS_W1T + (size_t)32 * 2048 * 1024 * 2;
constexpr size_t WS_X1 = WS_W2T + (size_t)32 * 1024 * 1024 * 2;
constexpr size_t WS_H2 = WS_X1 + (size_t)M * 1024 * 4;
constexpr size_t WS_TOKES = WS_H2 + (size_t)M * 1024 * 2;
constexpr size_t WS_TOKW = WS_TOKES + (size_t)M * 16;
constexpr size_t WS_LIST = WS_TOKW + (size_t)M * 16;
constexpr size_t WS_R = WS_LIST + (size_t)32 * 16384 * 4;
constexpr size_t WS_H = WS_R;
constexpr size_t WS_P = WS_H + (size_t)M * 1024 * 2;
constexpr size_t WS_XT = WS_P + (size_t)M * NPROJ * 2;
constexpr size_t WS_BMR = WS_XT + (size_t)M * 1024 * 2;
constexpr size_t WS_BMT = WS_BMR + (size_t)M * 256 * 2;
constexpr size_t WS_CMR = WS_BMT + (size_t)M * 256 * 2;
constexpr size_t WS_DT = WS_CMR + (size_t)M * 256 * 2;
constexpr size_t WS_ACS = WS_DT + (size_t)2 * M * 16 * 4;
constexpr size_t WS_CDEC = WS_ACS + (size_t)2 * M * 16 * 4;
constexpr size_t WS_ST = WS_CDEC + 16384;
constexpr size_t WS_PREV = WS_ST + (size_t)2 * 2 * 64 * 16 * 8192 * 4;
constexpr size_t WS_YZ = WS_PREV + (size_t)2 * 2 * 64 * 16 * 8192 * 2;
constexpr size_t WS_AO = WS_YZ + (size_t)M * 1024 * 2;
constexpr size_t WS_RSTD = WS_AO + (size_t)M * 1024 * 2;
constexpr size_t WS_QN = WS_RSTD + (size_t)M * 4;
constexpr size_t WS_KN = WS_QN + (size_t)M * 1024 * 2;
constexpr size_t WS_VB = WS_KN + (size_t)M * 256 * 2;
constexpr size_t WS_T1 = WS_VB + (size_t)M * 256 * 2;
constexpr size_t WS_MG = WS_T1 + (size_t)M * 1024 * 2;
constexpr size_t WS_END = WS_MG + (size_t)M * 1024 * 2;
constexpr size_t WS_XB = WS_R;
constexpr size_t WS_ACT = WS_XB + (size_t)ROWS_MAX * 1024 * 2;
constexpr size_t WS_YB = WS_XB;
static_assert(WS_ACT + (size_t)ROWS_MAX * 1024 * 2 <= WS_END, "moe overlay");
static_assert(WS_END <= (size_t)1073741824, "workspace");
static_assert(WS_WAT == WS_WST + 2097152 && WS_AO == WS_YZ + (size_t)M * 2048, "concatenated operands of the merged branch GEMMs");

constexpr int LDS_BYTES = 147712;
constexpr int LDS_BARST = 147456;
constexpr int LDS_CTL = 143360;

struct Params {
    const float* in[24];
    float* out;
    unsigned char* ws;
    int ph_lo, ph_hi;
};

__device__ __forceinline__ float bf2f(bf16_t v) { return __uint_as_float((unsigned)v << 16); }
__device__ __forceinline__ float bflo(unsigned w) { return __uint_as_float(w << 16); }
__device__ __forceinline__ float bfhi(unsigned w) { return __uint_as_float(w & 0xffff0000u); }
__device__ __forceinline__ unsigned f2bf(float f) { unsigned u = __float_as_uint(f); return (u + 0x7fffu + ((u >> 16) & 1u)) >> 16; }
__device__ __forceinline__ unsigned pk2(float lo, float hi) { return f2bf(lo) | (f2bf(hi) << 16); }
__device__ __forceinline__ float wave_sum(float v) {
#pragma unroll
    for (int o = 1; o < 64; o <<= 1) v += __shfl_xor(v, o);
    return v;
}
__device__ __forceinline__ float wave_max(float v) {
#pragma unroll
    for (int o = 1; o < 64; o <<= 1) v = fmaxf(v, __shfl_xor(v, o));
    return v;
}
__device__ __forceinline__ int wave_min_i(int v) {
#pragma unroll
    for (int o = 1; o < 64; o <<= 1) { int t = __shfl_xor(v, o); v = t < v ? t : v; }
    return v;
}
__device__ __forceinline__ float sigmoidf_(float x) { return 1.f / (1.f + __expf(-x)); }
__device__ __forceinline__ unsigned pack4_fp8(float a, float b, float c, float d) { unsigned w = __builtin_amdgcn_cvt_pk_fp8_f32(a, b, 0u, false); return __builtin_amdgcn_cvt_pk_fp8_f32(c, d, w, true); }
#define LDS_WAIT() asm volatile("s_waitcnt lgkmcnt(0)" ::: "memory")

struct Ctx { int tid, lane, wave, bid, G; LAS unsigned char* lds; };

struct TItem { const float* W; bf16_t* WT; const float* kscale; int N, k0, n0, orow0; };
__device__ __forceinline__ void transpose_load(const TItem& t, f32x4 (&v)[8], int lane) {
    const int nq = lane & 7, kg = lane >> 3;
    const float* s = t.W + (size_t)(t.k0 + 8 * kg) * t.N + t.n0 + 4 * nq;
#pragma unroll
    for (int i = 0; i < 8; ++i) v[i] = *(const f32x4*)(s + (size_t)i * t.N);
}
__device__ __forceinline__ void transpose_store(const TItem& t, f32x4 (&v)[8], int lane) {
    const int nq = lane & 7, kg = lane >> 3;
    if (t.kscale) {
#pragma unroll
        for (int i = 0; i < 8; ++i) v[i] = v[i] * t.kscale[t.k0 + 8 * kg + i];
    }
    bf16_t* d = t.WT + (size_t)(t.orow0 + 4 * nq) * 1024 + t.k0 + 8 * kg;
#pragma unroll
    for (int j = 0; j < 4; ++j) { u32x4 o; o.x = pk2(v[0][j], v[1][j]); o.y = pk2(v[2][j], v[3][j]); o.z = pk2(v[4][j], v[5][j]); o.w = pk2(v[6][j], v[7][j]);
        *(u32x4*)(d + (size_t)j * 1024) = o; }
}
constexpr int PREP_I_IN = 16 * 193, PREP_I_SQ = 512, PREP_NITEMS = PREP_I_IN + 3 * PREP_I_SQ;
constexpr int PREP8_I_W1 = 32 * 8 * 64, PREP8_I_W2 = 32 * 8 * 32, PREP8_NITEMS = PREP8_I_W1 + PREP8_I_W2;
__device__ __forceinline__ TItem prep_item(const Params& p, int r) {
    unsigned char* ws = p.ws; TItem t; t.kscale = nullptr;
    if (r < PREP_I_IN) { const int kb = r / 193, nb = r % 193, n0 = nb * 32;
        t.W = p.in[2]; t.WT = (bf16_t*)(ws + WS_WINT); t.N = 6176; t.k0 = kb * 64; t.n0 = n0; t.orow0 = n0 < 2560 ? n0 : (n0 < 2592 ? PDT + (n0 - 2560) : n0 - 32); return t; }
    r -= PREP_I_IN;
    { const int which = r / PREP_I_SQ, q = r % PREP_I_SQ;
        t.W = which == 0 ? p.in[13] : (which == 1 ? p.in[14] : p.in[15]); t.WT = (bf16_t*)(ws + (which == 0 ? WS_WST : (which == 1 ? WS_WAT : WS_WOT)));
        t.kscale = which == 0 ? p.in[10] : nullptr; t.N = 1024; t.k0 = (q / 32) * 64; t.n0 = (q % 32) * 32; t.orow0 = t.n0; return t; }
}
__device__ __forceinline__ void prep_item8(const Params& p, int r, int lane) {
    unsigned char* ws = p.ws; const float* W; unsigned char* WT; int N, k0, n0, orow0;
    if (r < PREP8_I_W1) { const int e = r / 512, rr = r % 512, kb = rr / 64, nb = rr % 64; n0 = nb * 32; const int half = n0 / 1024, q = n0 % 1024;
        W = p.in[19] + (size_t)e * 1024 * 2048; WT = ws + WS_W1T + (size_t)e * 2048 * 1024; N = 2048; k0 = kb * 128; orow0 = (q / 128) * 256 + half * 128 + (q % 128); }
    else { r -= PREP8_I_W1; const int e = r / 256, rr = r % 256, kb = rr / 32, nb = rr % 32; n0 = nb * 32;
        W = p.in[21] + (size_t)e * 1024 * 1024; WT = ws + WS_W2T + (size_t)e * 1024 * 1024; N = 1024; k0 = kb * 128; orow0 = n0; }
    const int nq = lane & 7, kg = lane >> 3;
    const float* s = W + (size_t)(k0 + 16 * kg) * N + n0 + 4 * nq;
    f32x4 v[16];
#pragma unroll
    for (int i = 0; i < 16; ++i) v[i] = *(const f32x4*)(s + (size_t)i * N);
    unsigned char* d = WT + (size_t)(orow0 + 4 * nq) * 1024 + k0 + 16 * kg;
#pragma unroll
    for (int j = 0; j < 4; ++j) { u32x4 o;
        o.x = pack4_fp8(64.f * v[0][j], 64.f * v[1][j], 64.f * v[2][j], 64.f * v[3][j]); o.y = pack4_fp8(64.f * v[4][j], 64.f * v[5][j], 64.f * v[6][j], 64.f * v[7][j]);
        o.z = pack4_fp8(64.f * v[8][j], 64.f * v[9][j], 64.f * v[10][j], 64.f * v[11][j]); o.w = pack4_fp8(64.f * v[12][j], 64.f * v[13][j], 64.f * v[14][j], 64.f * v[15][j]);
        *(u32x4*)(d + (size_t)j * 1024) = o; }
}

__device__ __forceinline__ void phase_prep(const Params& p, const Ctx& c) {
    unsigned char* ws = p.ws;
    const int gw = c.bid * 8 + c.wave, NGW = c.G * 8;
    for (int it = gw; it < PREP_NITEMS; it += 2 * NGW) {
        const TItem ta = prep_item(p, it); f32x4 va[8], vb[8];
        transpose_load(ta, va, c.lane);
        const bool two = it + NGW < PREP_NITEMS;
        const TItem tb = prep_item(p, two ? it + NGW : it);
        if (two) transpose_load(tb, vb, c.lane);
        transpose_store(ta, va, c.lane);
        if (two) transpose_store(tb, vb, c.lane);
    }
    for (int it = gw; it < PREP8_NITEMS; it += NGW) prep_item8(p, it, c.lane);
    for (int r = 6176 + gw; r < NPROJ; r += NGW) {
        u32x4* o = (u32x4*)((bf16_t*)(ws + WS_WINT) + (size_t)r * 1024);
        o[c.lane] = (u32x4){0u, 0u, 0u, 0u}; o[c.lane + 64] = (u32x4){0u, 0u, 0u, 0u};
    }
    {
        const float* x = p.in[0]; const float* g = p.in[1]; bf16_t* H = (bf16_t*)(ws + WS_H);
        f32x4 gv[4];
#pragma unroll
        for (int j = 0; j < 4; ++j) gv[j] = ((const f32x4*)g)[c.lane + 64 * j];
        for (int m = gw; m < M; m += NGW) {
            const f32x4* xr = (const f32x4*)(x + (size_t)m * D) + c.lane;
            f32x4 v[4]; float s = 0.f;
#pragma unroll
            for (int j = 0; j < 4; ++j) { v[j] = xr[64 * j]; s += (v[j].x * v[j].x + v[j].y * v[j].y) + (v[j].z * v[j].z + v[j].w * v[j].w); }
            const float rstd = rsqrtf(wave_sum(s) * (1.f / D) + EPS);
            u32x2* o = (u32x2*)(H + (size_t)m * D) + c.lane;
#pragma unroll
            for (int j = 0; j < 4; ++j) { u32x2 w; w.x = pk2(v[j].x * rstd * gv[j].x, v[j].y * rstd * gv[j].y); w.y = pk2(v[j].z * rstd * gv[j].z, v[j].w * rstd * gv[j].w); o[64 * j] = w; }
        }
    }
    {
        float* rc = (float*)(ws + WS_ROPE); float* rs = rc + 4096;
        for (int idx = c.bid * 512 + c.tid; idx < 4096; idx += c.G * 512) {
            const int pos = idx >> 5, i = idx & 31;
            const float inv = exp2f(-(float)i * (13.287712379549449f / 32.f));
            float rev = (float)pos * inv * 0.15915494309189535f; rev -= floorf(rev);
            rc[idx] = __builtin_amdgcn_cosf(rev); rs[idx] = __builtin_amdgcn_sinf(rev);
        }
        float* wrt = (float*)(ws + WS_WRT); const float* wr = p.in[17];
        for (int idx = c.bid * 512 + c.tid; idx < 32768; idx += c.G * 512) { const int k = idx >> 5, e = idx & 31; wrt[e * 1024 + k] = wr[idx]; }
        if (c.bid == 0 && c.tid < 64) ((int*)(ws + WS_CTL))[c.tid] = 0;
        if (c.bid == 0) for (int i = c.tid; i < 3456; i += 512) ((unsigned*)(ws + WS_BAR))[i] = 0u;
    }
}

template <bool DUAL, class ARow, class Epi>
__device__ __forceinline__ void ngemm_tile(const ARow& arow, const bf16_t* Bt, const bf16_t* Bt2, int K, int m0, const Epi& epi, LAS float* lds, int tid) {
    LAS float* As = lds;
    LAS float* Bs = lds + 32 * 132;
    LAS float* Bs2 = Bs + 32 * 68;
    float acc[4][4], acc2[4][4];
#pragma unroll
    for (int i = 0; i < 4; ++i)
#pragma unroll
        for (int j = 0; j < 4; ++j) { acc[i][j] = 0.f; acc2[i][j] = 0.f; }
    const int tm = tid & 31, tn = tid >> 5;
    const int sr = tid >> 2, kq = (tid & 3) * 8;
    const bf16_t* ap = arow(m0 + sr) + kq;
    const bf16_t* bp = Bt + (size_t)(sr & 63) * K + kq;
    const bf16_t* bp2 = DUAL ? Bt2 + (size_t)(sr & 63) * K + kq : nullptr;
    for (int k0 = 0; k0 < K; k0 += 32) {
        {
            const u32x4 v = *(const u32x4*)(ap + k0);
            As[(kq + 0) * 132 + sr] = bflo(v.x); As[(kq + 1) * 132 + sr] = bfhi(v.x); As[(kq + 2) * 132 + sr] = bflo(v.y); As[(kq + 3) * 132 + sr] = bfhi(v.y);
            As[(kq + 4) * 132 + sr] = bflo(v.z); As[(kq + 5) * 132 + sr] = bfhi(v.z); As[(kq + 6) * 132 + sr] = bflo(v.w); As[(kq + 7) * 132 + sr] = bfhi(v.w);
        }
        if (tid < 256) {
            const u32x4 v = *(const u32x4*)(bp + k0);
            Bs[(kq + 0) * 68 + sr] = bflo(v.x); Bs[(kq + 1) * 68 + sr] = bfhi(v.x); Bs[(kq + 2) * 68 + sr] = bflo(v.y); Bs[(kq + 3) * 68 + sr] = bfhi(v.y);
            Bs[(kq + 4) * 68 + sr] = bflo(v.z); Bs[(kq + 5) * 68 + sr] = bfhi(v.z); Bs[(kq + 6) * 68 + sr] = bflo(v.w); Bs[(kq + 7) * 68 + sr] = bfhi(v.w);
        } else if (DUAL) {
            const int r2 = sr & 63;
            const u32x4 v = *(const u32x4*)(bp2 + k0);
            Bs2[(kq + 0) * 68 + r2] = bflo(v.x); Bs2[(kq + 1) * 68 + r2] = bfhi(v.x); Bs2[(kq + 2) * 68 + r2] = bflo(v.y); Bs2[(kq + 3) * 68 + r2] = bfhi(v.y);
            Bs2[(kq + 4) * 68 + r2] = bflo(v.z); Bs2[(kq + 5) * 68 + r2] = bfhi(v.z); Bs2[(kq + 6) * 68 + r2] = bflo(v.w); Bs2[(kq + 7) * 68 + r2] = bfhi(v.w);
        }
        __syncthreads();
#pragma unroll 8
        for (int k = 0; k < 32; ++k) {
            const f32x4 a = *(const LAS f32x4*)&As[k * 132 + tm * 4];
            const f32x4 b = *(const LAS f32x4*)&Bs[k * 68 + tn * 4];
#pragma unroll
            for (int i = 0; i < 4; ++i)
#pragma unroll
                for (int j = 0; j < 4; ++j) acc[i][j] = fmaf(a[i], b[j], acc[i][j]);
            if (DUAL) {
                const f32x4 b2 = *(const LAS f32x4*)&Bs2[k * 68 + tn * 4];
#pragma unroll
                for (int i = 0; i < 4; ++i)
#pragma unroll
                    for (int j = 0; j < 4; ++j) acc2[i][j] = fmaf(a[i], b2[j], acc2[i][j]);
            }
        }
        __syncthreads();
    }
#pragma unroll
    for (int i = 0; i < 4; ++i)
#pragma unroll
        for (int j = 0; j < 4; ++j) epi(m0 + tm * 4 + i, tn * 4 + j, acc[i][j], acc2[i][j]);
}
struct ARowPlain { const bf16_t* A; int lda; __device__ __forceinline__ const bf16_t* operator()(int m) const { return A + (size_t)m * lda; } };

namespace pg8 {
#define PG8_LAS __attribute__((address_space(3)))
typedef unsigned short bf16_t;
typedef short bf16x8 __attribute__((ext_vector_type(8)));
typedef float f32x4 __attribute__((ext_vector_type(4)));
typedef unsigned u32x4 __attribute__((ext_vector_type(4)));
constexpr int BM = 256, BK = 64, HALF = 128, HTB = HALF * BK * 2  , STAGE_BYTES = 8 * HTB, NXCD = 8, WGM = 8;

__host__ __device__ __forceinline__ int lds_byte(int r, int c) { const int st = (r >> 4) * 2 + (c >> 5), rr = r & 15, cc = c & 31, ob = rr * 64 + cc * 2; return st * 1024 + (ob ^ (((ob >> 9) & 1) << 5)); }
__host__ __device__ __forceinline__ void stage_rc(int b, int& R, int& C) { const int st = b / 1024, sb = b % 1024, swz = sb ^ (((sb >> 9) & 1) << 5); R = (st >> 1) * 16 + swz / 64; C = (st & 1) * 32 + (swz % 64) / 2; }
__host__ __device__ __forceinline__ int perm32(int rho) { const int n = rho >> 4, i = rho & 15; return 8 * (i >> 2) + 4 * n + (i & 3); }

struct Unit { int pm, pn; };
struct Gemm { const bf16_t* A; const bf16_t* Bt; int M, N, K; };

struct StaticOrder {
    int nM, nN, nwg, G, c;
    __host__ __device__ void init(int M, int N, int G_, int c_) { nM = M / BM; nN = N / BM; nwg = nM * nN; G = G_; c = c_; }
    __host__ __device__ bool next(int i, Unit& u) const {
        const long L = (long)i * G + c; if (L >= nwg) return false;
        int wgid = (int)L; { const int q = nwg / NXCD, r = nwg % NXCD, xcd = wgid % NXCD, off = wgid / NXCD; wgid = (xcd < r ? xcd * (q + 1) : r * (q + 1) + (xcd - r) * q) + off; }
        const int nig = WGM * nN, gid = wgid / nig, fm = gid * WGM, gsz = (nM - fm) < WGM ? (nM - fm) : WGM;
        u.pm = fm + ((wgid % nig) % gsz); u.pn = (wgid % nig) / gsz; return true;
    }
    __device__ __forceinline__ void a_ready(const Unit&) const {}
    __device__ __forceinline__ void done(const Unit&) const {}
};


__device__ __forceinline__ unsigned cvt_pk_bf16(float lo, float hi) { unsigned r; asm volatile("v_cvt_pk_bf16_f32 %0, %1, %2" : "=v"(r) : "v"(lo), "v"(hi)); return r; }
__device__ __forceinline__ float sig_(float x) { return __builtin_amdgcn_rcpf(1.f + __builtin_amdgcn_exp2f(-1.4426950408889634f * x)); }
__device__ __forceinline__ u32x4 pack8(const f32x4& v0, const f32x4& v1) { u32x4 w; w.x = cvt_pk_bf16(v0[0], v0[1]); w.y = cvt_pk_bf16(v0[2], v0[3]); w.z = cvt_pk_bf16(v1[0], v1[1]); w.w = cvt_pk_bf16(v1[2], v1[3]); return w; }
__device__ __forceinline__ void unpack8(const u32x4& w, f32x4& v0, f32x4& v1) {
    v0[0] = __uint_as_float(w.x << 16); v0[1] = __uint_as_float(w.x & 0xffff0000u); v0[2] = __uint_as_float(w.y << 16); v0[3] = __uint_as_float(w.y & 0xffff0000u);
    v1[0] = __uint_as_float(w.z << 16); v1[1] = __uint_as_float(w.z & 0xffff0000u); v1[2] = __uint_as_float(w.w << 16); v1[3] = __uint_as_float(w.w & 0xffff0000u); }
struct EpiStore {
    static constexpr bool PERM = true, AFTER_DRAIN = false;
    bf16_t* O; int ldc;
    __device__ __forceinline__ void operator()(const f32x4 (&acc)[2][2][4][2], const Unit& u, int wr, int wc, int fr, int fq) const {
        const int row0 = u.pm * BM + wr * 64 + fr, col0 = u.pn * BM + wc * 32 + 8 * fq;
#pragma unroll
        for (int ai = 0; ai < 2; ++ai)
#pragma unroll
            for (int m = 0; m < 4; ++m) { bf16_t* rowp = O + (size_t)(row0 + ai * HALF + m * 16) * ldc + col0;
#pragma unroll
                for (int bj = 0; bj < 2; ++bj) *(u32x4*)(rowp + bj * HALF) = pack8(acc[ai][bj][m][0], acc[ai][bj][m][1]); }
    }
};
struct EpiT1 {
    static constexpr bool PERM = true, AFTER_DRAIN = false;
    bf16_t* T1; const bf16_t* G; int ldg; const float* RSTD;
    __device__ __forceinline__ void operator()(const f32x4 (&acc)[2][2][4][2], const Unit& u, int wr, int wc, int fr, int fq) const {
        const int row0 = u.pm * BM + wr * 64 + fr, col0 = u.pn * BM + wc * 32 + 8 * fq;
#pragma unroll
        for (int ai = 0; ai < 2; ++ai)
#pragma unroll
            for (int m = 0; m < 4; ++m) { const int row = row0 + ai * HALF + m * 16; const float rs = RSTD[row];
#pragma unroll
                for (int bj = 0; bj < 2; ++bj) { const int col = col0 + bj * HALF;
                    f32x4 g0, g1; unpack8(*(const u32x4*)(G + (size_t)row * ldg + col), g0, g1);
                    f32x4 v0 = acc[ai][bj][m][0] * rs, v1 = acc[ai][bj][m][1] * rs;
#pragma unroll
                    for (int i = 0; i < 4; ++i) { v0[i] *= sig_(g0[i]); v1[i] *= sig_(g1[i]); }
                    *(u32x4*)(T1 + (size_t)row * 1024 + col) = pack8(v0, v1); } }
    }
};
struct EpiT2 {
    static constexpr bool PERM = true, AFTER_DRAIN = false;
    bf16_t* MG; const bf16_t* T1; const bf16_t* G; int ldg;
    __device__ __forceinline__ void operator()(const f32x4 (&acc)[2][2][4][2], const Unit& u, int wr, int wc, int fr, int fq) const {
        const int row0 = u.pm * BM + wr * 64 + fr, col0 = u.pn * BM + wc * 32 + 8 * fq;
#pragma unroll
        for (int ai = 0; ai < 2; ++ai)
#pragma unroll
            for (int m = 0; m < 4; ++m) { const int row = row0 + ai * HALF + m * 16;
#pragma unroll
                for (int bj = 0; bj < 2; ++bj) { const int col = col0 + bj * HALF;
                    f32x4 g0, g1, t0, t1; unpack8(*(const u32x4*)(G + (size_t)row * ldg + col), g0, g1); unpack8(*(const u32x4*)(T1 + (size_t)row * 1024 + col), t0, t1);
                    f32x4 v0 = acc[ai][bj][m][0], v1 = acc[ai][bj][m][1];
#pragma unroll
                    for (int i = 0; i < 4; ++i) { v0[i] = fmaf(v0[i], sig_(g0[i]), t0[i]); v1[i] = fmaf(v1[i], sig_(g1[i]), t1[i]); }
                    *(u32x4*)(MG + (size_t)row * 1024 + col) = pack8(v0, v1); } }
    }
};
struct EpiT3 {
    static constexpr bool PERM = true, AFTER_DRAIN = false;
    float* X1; const float* x;
    __device__ __forceinline__ void operator()(const f32x4 (&acc)[2][2][4][2], const Unit& u, int wr, int wc, int fr, int fq) const {
        const int row0 = u.pm * BM + wr * 64 + fr, col0 = u.pn * BM + wc * 32 + 8 * fq;
#pragma unroll
        for (int ai = 0; ai < 2; ++ai)
#pragma unroll
            for (int m = 0; m < 4; ++m) { const size_t ro = (size_t)(row0 + ai * HALF + m * 16) * 1024 + col0;
#pragma unroll
                for (int bj = 0; bj < 2; ++bj) { const size_t o = ro + bj * HALF;
                    *(f32x4*)(X1 + o) = *(const f32x4*)(x + o) + acc[ai][bj][m][0]; *(f32x4*)(X1 + o + 4) = *(const f32x4*)(x + o + 4) + acc[ai][bj][m][1]; } }
    }
};
struct EpiAct {
    static constexpr bool PERM = true, AFTER_DRAIN = false;
    bf16_t* ACT; const float* b1;
    __device__ __forceinline__ void operator()(const f32x4 (&acc)[2][2][4][2], const Unit& u, int wr, int wc, int fr, int fq) const {
        const int e = u.pn >> 3, nt = u.pn & 7;
        const int row0 = u.pm * BM + wr * 64 + fr, col0 = nt * 128 + wc * 32 + 8 * fq;
        const float* bg = b1 + (size_t)e * 2048 + col0;
        const f32x4 bg0 = *(const f32x4*)bg, bg1 = *(const f32x4*)(bg + 4), bu0 = *(const f32x4*)(bg + 1024), bu1 = *(const f32x4*)(bg + 1028);
#pragma unroll
        for (int ai = 0; ai < 2; ++ai)
#pragma unroll
            for (int m = 0; m < 4; ++m) { const int row = row0 + ai * HALF + m * 16;
                f32x4 g0 = acc[ai][0][m][0] + bg0, g1 = acc[ai][0][m][1] + bg1, u0 = acc[ai][1][m][0] + bu0, u1 = acc[ai][1][m][1] + bu1;
#pragma unroll
                for (int i = 0; i < 4; ++i) {
                    const float ga = fminf(g0[i], 7.f), gb = fminf(g1[i], 7.f), ua = fminf(fmaxf(u0[i], -7.f), 7.f), ub = fminf(fmaxf(u1[i], -7.f), 7.f);
                    g0[i] = ga * sig_(1.702f * ga) * (ua + 1.f); g1[i] = gb * sig_(1.702f * gb) * (ub + 1.f); }
                *(u32x4*)(ACT + (size_t)row * 1024 + col0) = pack8(g0, g1); }
    }
};
struct EpiY {
    static constexpr bool PERM = true, AFTER_DRAIN = false;
    bf16_t* YB; const float* b2;
    __device__ __forceinline__ void operator()(const f32x4 (&acc)[2][2][4][2], const Unit& u, int wr, int wc, int fr, int fq) const {
        const int e = u.pn >> 2, nt = u.pn & 3;
        const int row0 = u.pm * BM + wr * 64 + fr, col0 = nt * BM + wc * 32 + 8 * fq;
        f32x4 bv[2][2];
#pragma unroll
        for (int bj = 0; bj < 2; ++bj) { bv[bj][0] = *(const f32x4*)(b2 + (size_t)e * 1024 + col0 + bj * HALF); bv[bj][1] = *(const f32x4*)(b2 + (size_t)e * 1024 + col0 + bj * HALF + 4); }
#pragma unroll
        for (int ai = 0; ai < 2; ++ai)
#pragma unroll
            for (int m = 0; m < 4; ++m) { bf16_t* rowp = YB + (size_t)(row0 + ai * HALF + m * 16) * 1024 + col0;
#pragma unroll
                for (int bj = 0; bj < 2; ++bj) *(u32x4*)(rowp + bj * HALF) = pack8(acc[ai][bj][m][0] + bv[bj][0], acc[ai][bj][m][1] + bv[bj][1]); }
    }
};

struct EpiAct8 {
    static constexpr bool PERM = true, AFTER_DRAIN = false;
    unsigned char* ACT; const float* b1;
    __device__ __forceinline__ void operator()(const f32x4 (&acc)[2][2][4][2], const Unit& u, int wr, int wc, int fr, int fq) const {
        const int e = u.pn >> 3, nt = u.pn & 7;
        const int row0 = u.pm * BM + wr * 64 + fr, col0 = nt * 128 + wc * 32 + 8 * fq;
        const float* bg = b1 + (size_t)e * 2048 + col0;
        const f32x4 bg0 = *(const f32x4*)bg, bg1 = *(const f32x4*)(bg + 4), bu0 = *(const f32x4*)(bg + 1024), bu1 = *(const f32x4*)(bg + 1028);
        constexpr float SC = 1.f / 512.f;
#pragma unroll
        for (int ai = 0; ai < 2; ++ai)
#pragma unroll
            for (int m = 0; m < 4; ++m) { const int row = row0 + ai * HALF + m * 16;
                f32x4 g0 = acc[ai][0][m][0] * SC + bg0, g1 = acc[ai][0][m][1] * SC + bg1, u0 = acc[ai][1][m][0] * SC + bu0, u1 = acc[ai][1][m][1] * SC + bu1;
#pragma unroll
                for (int i = 0; i < 4; ++i) {
                    const float ga = fminf(g0[i], 7.f), gb = fminf(g1[i], 7.f), ua = fminf(fmaxf(u0[i], -7.f), 7.f), ub = fminf(fmaxf(u1[i], -7.f), 7.f);
                    g0[i] = 4.f * ga * sig_(1.702f * ga) * (ua + 1.f); g1[i] = 4.f * gb * sig_(1.702f * gb) * (ub + 1.f); }
                u32x2 w; w.x = pack4_fp8(g0[0], g0[1], g0[2], g0[3]); w.y = pack4_fp8(g1[0], g1[1], g1[2], g1[3]);
                *(u32x2*)(ACT + (size_t)row * 1024 + col0) = w; }
    }
};
struct EpiY8 {
    static constexpr bool PERM = true, AFTER_DRAIN = false;
    bf16_t* YB; const float* b2;
    __device__ __forceinline__ void operator()(const f32x4 (&acc)[2][2][4][2], const Unit& u, int wr, int wc, int fr, int fq) const {
        const int e = u.pn >> 2, nt = u.pn & 3;
        const int row0 = u.pm * BM + wr * 64 + fr, col0 = nt * BM + wc * 32 + 8 * fq;
        constexpr float SC = 1.f / 256.f;
        f32x4 bv[2][2];
#pragma unroll
        for (int bj = 0; bj < 2; ++bj) { bv[bj][0] = *(const f32x4*)(b2 + (size_t)e * 1024 + col0 + bj * HALF); bv[bj][1] = *(const f32x4*)(b2 + (size_t)e * 1024 + col0 + bj * HALF + 4); }
#pragma unroll
        for (int ai = 0; ai < 2; ++ai)
#pragma unroll
            for (int m = 0; m < 4; ++m) { bf16_t* rowp = YB + (size_t)(row0 + ai * HALF + m * 16) * 1024 + col0;
#pragma unroll
                for (int bj = 0; bj < 2; ++bj) *(u32x4*)(rowp + bj * HALF) = pack8(acc[ai][bj][m][0] * SC + bv[bj][0], acc[ai][bj][m][1] * SC + bv[bj][1]); }
    }
};
struct MoeOrder {
    const PG8_LAS int* offs; int nN, G, c, ntile;
    __device__ __forceinline__ bool next(int i, Unit& u) const {
        const long L = (long)i * G + c; if (L >= (long)ntile * nN) return false;
        const int t = (int)(L / nN), pnl = (int)(L % nN); int e = 0; while (e < 31 && t * 256 >= offs[e + 1]) ++e;
        u.pm = t; u.pn = e * nN + pnl; return true;
    }
    __device__ __forceinline__ void a_ready(const Unit&) const {}
    __device__ __forceinline__ void done(const Unit&) const {}
};
template <class Epi, class Sched, bool ALIGN_EPI = false, bool SP2 = false>
__device__ __forceinline__ void gemm_phase(PG8_LAS unsigned char* lds, const Gemm g, const Sched& S, const Epi& E) {
    const int tid = threadIdx.x, wid = __builtin_amdgcn_readfirstlane(tid >> 6), lane = tid & 63, wr = wid >> 2, wc = wid & 3, fr = lane & 15, fq = lane >> 4;
    const int K = g.K, nt = K / BK;
    unsigned voffA[2], voffB[2];
#pragma unroll
    for (int i = 0; i < 2; ++i) { int R, C; stage_rc(tid * 16 + i * 8192, R, C); const int Rb = Epi::PERM ? ((R & ~31) + perm32(R & 31)) : R;
        voffA[i] = (unsigned)(R * K + C) * 2u; voffB[i] = (unsigned)(Rb * K + C) * 2u; }
    const size_t kstep = (size_t)(BK * 2);
    const size_t hstep = (size_t)HALF * K * 2;
    const size_t tstep = 2 * hstep;
    const unsigned ldsw = (unsigned)wid * 1024u;
    const int aoff = lds_byte(wr * 64 + fr, fq * 8), boff = lds_byte(wc * 32 + fr, fq * 8);
#define PG8_SA(b, h) (((b) * 2 + (h)) * HTB)
#define PG8_SB(b, h) ((4 + (b) * 2 + (h)) * HTB)
#define PG8_STAGE(bufoff, gbase, voff) do { _Pragma("unroll") for (int _i = 0; _i < 2; ++_i) \
        __builtin_amdgcn_global_load_lds((const unsigned*)((const char*)(gbase) + (voff)[_i]), (PG8_LAS unsigned*)(lds + (bufoff) + ldsw + _i * 8192), 16, 0, 0); } while (0)
#define PG8_LDA(dst, b, h) do { _Pragma("unroll") for (int m = 0; m < 4; ++m) _Pragma("unroll") for (int k = 0; k < 2; ++k) dst[m][k] = *(const PG8_LAS bf16x8*)(lds + PG8_SA(b, h) + aoff + m * 2048 + k * 1024); } while (0)
#define PG8_LDB(dst, b, h) do { _Pragma("unroll") for (int n = 0; n < 2; ++n) _Pragma("unroll") for (int k = 0; k < 2; ++k) dst[n][k] = *(const PG8_LAS bf16x8*)(lds + PG8_SB(b, h) + boff + n * 2048 + k * 1024); } while (0)
#define PG8_MMA(ai, bj, At, Bt) do { __builtin_amdgcn_s_setprio(1); _Pragma("unroll") for (int m = 0; m < 4; ++m) _Pragma("unroll") for (int n = 0; n < 2; ++n) _Pragma("unroll") for (int k = 0; k < 2; ++k) \
        acc[ai][bj][m][n] = __builtin_amdgcn_mfma_f32_16x16x32_bf16(Bt[n][k], At[m][k], acc[ai][bj][m][n], 0, 0, 0); __builtin_amdgcn_s_setprio(0); } while (0)
#define PG8_WAIT_V(n) asm volatile("s_waitcnt vmcnt(" #n ")" ::: "memory")
#define PG8_WAIT_L(n) asm volatile("s_waitcnt lgkmcnt(" #n ")" ::: "memory")
#define PG8_BAR __builtin_amdgcn_s_barrier()
#define PG8_SCHED __builtin_amdgcn_sched_barrier(0)
    Unit cur, nxt; int ui = 0;
    if (!S.next(0, cur)) return;
    f32x4 acc[2][2][4][2];
#pragma unroll
    for (int a = 0; a < 2; ++a)
#pragma unroll
        for (int b = 0; b < 2; ++b)
#pragma unroll
            for (int m = 0; m < 4; ++m)
#pragma unroll
                for (int n = 0; n < 2; ++n) acc[a][b][m][n] = (f32x4){0.f, 0.f, 0.f, 0.f};
    bf16x8 At[4][2], B0[2][2], B1[2][2];
    const char* cA = (const char*)g.A + (size_t)cur.pm * tstep; const char* cB = (const char*)g.Bt + (size_t)cur.pn * tstep;
    S.a_ready(cur);
    if constexpr (SP2) {
        PG8_STAGE(PG8_SB(0, 0), cB, voffB); PG8_STAGE(PG8_SB(0, 1), cB + hstep, voffB); PG8_STAGE(PG8_SA(0, 0), cA, voffA); PG8_STAGE(PG8_SA(0, 1), cA + hstep, voffA);
        if (wr == 1) PG8_BAR;
        PG8_WAIT_V(2); PG8_BAR;
        PG8_STAGE(PG8_SB(1, 0), cB + kstep, voffB); PG8_STAGE(PG8_SA(1, 0), cA + kstep, voffA); PG8_STAGE(PG8_SB(1, 1), cB + hstep + kstep, voffB);
        PG8_WAIT_V(6); PG8_BAR;
    } else {
        PG8_STAGE(PG8_SB(0, 0), cB, voffB); PG8_STAGE(PG8_SA(0, 0), cA, voffA); PG8_STAGE(PG8_SB(0, 1), cB + hstep, voffB); PG8_STAGE(PG8_SA(0, 1), cA + hstep, voffA);
        if (wr == 1) PG8_BAR;
        PG8_WAIT_V(4); PG8_BAR;
        PG8_STAGE(PG8_SB(1, 0), cB + kstep, voffB); PG8_STAGE(PG8_SA(1, 0), cA + kstep, voffA); PG8_STAGE(PG8_SB(1, 1), cB + hstep + kstep, voffB);
        PG8_WAIT_V(6); PG8_BAR;
    }
    for (;;) {
        const bool has_next = S.next(ui + 1, nxt);
        const char* nA = has_next ? (const char*)g.A + (size_t)nxt.pm * tstep : cA; const char* nB = has_next ? (const char*)g.Bt + (size_t)nxt.pn * tstep : cB;
        for (int t = 0; t < nt; t += 2) {
            const bool last = (t == nt - 2);
            const char* a1 = cA + (size_t)(t + 1) * kstep;
            const char* a2 = last ? nA : cA + (size_t)(t + 2) * kstep; const char* b2 = last ? nB : cB + (size_t)(t + 2) * kstep;
            const char* a3 = a2 + kstep; const char* b3 = b2 + kstep;
            if (last && has_next) S.a_ready(nxt);
            if constexpr (SP2) {
            PG8_LDB(B0, 0, 0); PG8_LDB(B1, 0, 1); PG8_SCHED; PG8_LDA(At, 0, 0); PG8_STAGE(PG8_SA(1, 1), a1 + hstep, voffA);
            PG8_WAIT_V(8); PG8_WAIT_L(0); PG8_BAR; PG8_MMA(0, 0, At, B0); PG8_MMA(0, 1, At, B1); PG8_BAR; PG8_SCHED;
            PG8_LDA(At, 0, 1); PG8_STAGE(PG8_SB(0, 0), b2, voffB); PG8_STAGE(PG8_SB(0, 1), b2 + hstep, voffB); PG8_STAGE(PG8_SA(0, 0), a2, voffA);
            PG8_WAIT_V(8); PG8_WAIT_L(0); PG8_BAR; PG8_MMA(1, 0, At, B0); PG8_MMA(1, 1, At, B1); PG8_BAR; PG8_SCHED;
            PG8_LDB(B0, 1, 0); PG8_LDB(B1, 1, 1); PG8_SCHED; PG8_LDA(At, 1, 0); PG8_STAGE(PG8_SA(0, 1), a2 + hstep, voffA);
            PG8_WAIT_V(8); PG8_WAIT_L(0); PG8_BAR; PG8_MMA(0, 0, At, B0); PG8_MMA(0, 1, At, B1); PG8_BAR; PG8_SCHED;
            PG8_LDA(At, 1, 1); PG8_STAGE(PG8_SB(1, 0), b3, voffB); PG8_STAGE(PG8_SB(1, 1), b3 + hstep, voffB); PG8_STAGE(PG8_SA(1, 0), a3, voffA);
            PG8_WAIT_V(8); PG8_WAIT_L(0); PG8_BAR; PG8_MMA(1, 0, At, B0); PG8_MMA(1, 1, At, B1); PG8_BAR; PG8_SCHED;
            } else {
            PG8_LDB(B0, 0, 0); PG8_SCHED; PG8_LDA(At, 0, 0); PG8_STAGE(PG8_SA(1, 1), a1 + hstep, voffA);
            PG8_WAIT_L(8); PG8_BAR; PG8_WAIT_L(0); PG8_MMA(0, 0, At, B0); PG8_BAR; PG8_SCHED;
            PG8_LDB(B1, 0, 1); PG8_STAGE(PG8_SB(0, 0), b2, voffB);
            PG8_BAR; PG8_WAIT_L(0); PG8_MMA(0, 1, At, B1); PG8_BAR;
            PG8_LDA(At, 0, 1); PG8_STAGE(PG8_SA(0, 0), a2, voffA);
            PG8_BAR; PG8_WAIT_L(0); PG8_MMA(1, 0, At, B0); PG8_BAR; PG8_SCHED;
            PG8_STAGE(PG8_SB(0, 1), b2 + hstep, voffB);
            PG8_WAIT_V(6); PG8_BAR; PG8_MMA(1, 1, At, B1); PG8_BAR;
            PG8_LDB(B0, 1, 0); PG8_SCHED; PG8_LDA(At, 1, 0); PG8_STAGE(PG8_SA(0, 1), a2 + hstep, voffA);
            PG8_WAIT_L(8); PG8_BAR; PG8_WAIT_L(0); PG8_MMA(0, 0, At, B0); PG8_BAR; PG8_SCHED;
            PG8_LDB(B1, 1, 1); PG8_STAGE(PG8_SB(1, 0), b3, voffB);
            PG8_BAR; PG8_WAIT_L(0); PG8_MMA(0, 1, At, B1); PG8_BAR;
            PG8_LDA(At, 1, 1); PG8_STAGE(PG8_SA(1, 0), a3, voffA);
            PG8_BAR; PG8_WAIT_L(0); PG8_MMA(1, 0, At, B0); PG8_BAR; PG8_SCHED;
            PG8_STAGE(PG8_SB(1, 1), b3 + hstep, voffB);
            PG8_WAIT_V(6); PG8_BAR; PG8_MMA(1, 1, At, B1); PG8_BAR;
            }
        }
        if constexpr (ALIGN_EPI) { if (wr == 0) PG8_BAR; }
        if constexpr (!Epi::AFTER_DRAIN) { E(acc, cur, wr, wc, fr, fq); S.done(cur); }
        if (!has_next) break;
#pragma unroll
        for (int a = 0; a < 2; ++a)
#pragma unroll
            for (int b = 0; b < 2; ++b)
#pragma unroll
                for (int m = 0; m < 4; ++m)
#pragma unroll
                    for (int n = 0; n < 2; ++n) acc[a][b][m][n] = (f32x4){0.f, 0.f, 0.f, 0.f};
        cur = nxt; cA = nA; cB = nB; ++ui;
        if constexpr (ALIGN_EPI) { if (wr == 1) PG8_BAR; }
    }
    PG8_WAIT_V(0);
    if constexpr (!ALIGN_EPI) { if (wr == 0) PG8_BAR; }
    PG8_BAR;
    if constexpr (Epi::AFTER_DRAIN) { E.fused(acc, cur, wr, wc, fr, fq, lds, wid, lane); S.done(cur); }
#undef PG8_SA
#undef PG8_SB
#undef PG8_STAGE
#undef PG8_LDA
#undef PG8_LDB
#undef PG8_MMA
#undef PG8_WAIT_V
#undef PG8_WAIT_L
#undef PG8_BAR
#undef PG8_SCHED
}

struct MoeGatherOrder {
    const PG8_LAS int* offs; const PG8_LAS int* cnt; const int* LIST; int nN, G, c, ntile;
    __device__ __forceinline__ bool next(int i, Unit& u) const {
        const long L = (long)i * G + c; if (L >= (long)ntile * nN) return false;
        const int t = (int)(L / nN), pnl = (int)(L % nN); int e = 0; while (e < 31 && t * 256 >= offs[e + 1]) ++e;
        u.pm = t; u.pn = e * nN + pnl; return true;
    }
    __device__ __forceinline__ int arow(const Unit& u, int r) const { const int e = u.pn / nN, slot = u.pm * 256 + r - offs[e]; return slot < cnt[e] ? LIST[e * 16384 + slot] : 0; }
    __device__ __forceinline__ void a_ready(const Unit&) const {}
    __device__ __forceinline__ void done(const Unit&) const {}
};
struct TailOrder {
    StaticOrder so;
    __device__ __forceinline__ bool next(int i, Unit& u) const { Unit b; if (!so.next(i >> 1, b)) return false; u.pm = b.pm + 64 * (i & 1); u.pn = b.pn + 4 * (i & 1); return true; }
    __device__ __forceinline__ void a_ready(const Unit&) const {}
    __device__ __forceinline__ void done(const Unit&) const {}
};
struct EpiT12 {
    static constexpr bool PERM = true, AFTER_DRAIN = false;
    bf16_t* T1; bf16_t* MG; const bf16_t* G; int ldg; const float* RSTD;
    __device__ __forceinline__ void operator()(const f32x4 (&acc)[2][2][4][2], const Unit& u, int wr, int wc, int fr, int fq) const {
        const bool second = u.pm >= 64;
        const int row0 = (u.pm & 63) * BM + wr * 64 + fr, col0 = (u.pn & 3) * BM + wc * 32 + 8 * fq;
        const bf16_t* Gp = G + (second ? 1024 : 0);
#pragma unroll
        for (int ai = 0; ai < 2; ++ai) {
            u32x4 gv[4][2], tv[4][2]; float rs[4];
#pragma unroll
            for (int m = 0; m < 4; ++m) { const int row = row0 + ai * HALF + m * 16; rs[m] = second ? 1.f : RSTD[row];
#pragma unroll
                for (int bj = 0; bj < 2; ++bj) { gv[m][bj] = *(const u32x4*)(Gp + (size_t)row * ldg + col0 + bj * HALF);
                    tv[m][bj] = second ? *(const u32x4*)(T1 + (size_t)row * 1024 + col0 + bj * HALF) : (u32x4){0u, 0u, 0u, 0u}; } }
#pragma unroll
            for (int m = 0; m < 4; ++m) { const int row = row0 + ai * HALF + m * 16;
#pragma unroll
                for (int bj = 0; bj < 2; ++bj) { f32x4 g0, g1, t0, t1; unpack8(gv[m][bj], g0, g1); unpack8(tv[m][bj], t0, t1);
                    f32x4 v0 = acc[ai][bj][m][0] * rs[m], v1 = acc[ai][bj][m][1] * rs[m];
#pragma unroll
                    for (int i = 0; i < 4; ++i) { v0[i] = fmaf(v0[i], sig_(g0[i]), t0[i]); v1[i] = fmaf(v1[i], sig_(g1[i]), t1[i]); }
                    *(u32x4*)((second ? MG : T1) + (size_t)row * 1024 + col0 + bj * HALF) = pack8(v0, v1); } }
        }
    }
};
struct EpiT3b {
    static constexpr bool PERM = true, AFTER_DRAIN = false;
    float* X1; const float* x;
    __device__ __forceinline__ void operator()(const f32x4 (&acc)[2][2][4][2], const Unit& u, int wr, int wc, int fr, int fq) const {
        const int row0 = u.pm * BM + wr * 64 + fr, col0 = u.pn * BM + wc * 32 + 8 * fq;
#pragma unroll
        for (int ai = 0; ai < 2; ++ai) {
            f32x4 xv[4][2][2];
#pragma unroll
            for (int m = 0; m < 4; ++m)
#pragma unroll
                for (int bj = 0; bj < 2; ++bj) { const size_t o = (size_t)(row0 + ai * HALF + m * 16) * 1024 + col0 + bj * HALF; xv[m][bj][0] = *(const f32x4*)(x + o); xv[m][bj][1] = *(const f32x4*)(x + o + 4); }
#pragma unroll
            for (int m = 0; m < 4; ++m)
#pragma unroll
                for (int bj = 0; bj < 2; ++bj) { const size_t o = (size_t)(row0 + ai * HALF + m * 16) * 1024 + col0 + bj * HALF;
                    *(f32x4*)(X1 + o) = xv[m][bj][0] + acc[ai][bj][m][0]; *(f32x4*)(X1 + o + 4) = xv[m][bj][1] + acc[ai][bj][m][1]; }
        }
    }
};
template <class Epi, class Sched>
__device__ __forceinline__ void gemm_phase_gather(PG8_LAS unsigned char* lds, const Gemm g, const Sched& S, const Epi& E) {
    constexpr bool ALIGN_EPI = true, SP2 = true;
    const int tid = threadIdx.x, wid = __builtin_amdgcn_readfirstlane(tid >> 6), lane = tid & 63, wr = wid >> 2, wc = wid & 3, fr = lane & 15, fq = lane >> 4;
    const int K = g.K, nt = K / BK;
    unsigned voffA[2], voffB[2];
#pragma unroll
    for (int i = 0; i < 2; ++i) { int R, C; stage_rc(tid * 16 + i * 8192, R, C); const int Rb = Epi::PERM ? ((R & ~31) + perm32(R & 31)) : R;
        voffA[i] = (unsigned)(R * K + C) * 2u; voffB[i] = (unsigned)(Rb * K + C) * 2u; }
    const size_t kstep = (size_t)(BK * 2);
    const size_t hstep = (size_t)HALF * K * 2;
    const size_t tstep = 2 * hstep;
    const unsigned ldsw = (unsigned)wid * 1024u;
    const int aoff = lds_byte(wr * 64 + fr, fq * 8), boff = lds_byte(wc * 32 + fr, fq * 8);
#define PG8_SA(b, h) (((b) * 2 + (h)) * HTB)
#define PG8_SB(b, h) ((4 + (b) * 2 + (h)) * HTB)
#define PG8_STAGE(bufoff, gbase, voff) do { _Pragma("unroll") for (int _i = 0; _i < 2; ++_i) \
        __builtin_amdgcn_global_load_lds((const unsigned*)((const char*)(gbase) + (voff)[_i]), (PG8_LAS unsigned*)(lds + (bufoff) + ldsw + _i * 8192), 16, 0, 0); } while (0)
#define PG8_LDA(dst, b, h) do { _Pragma("unroll") for (int m = 0; m < 4; ++m) _Pragma("unroll") for (int k = 0; k < 2; ++k) dst[m][k] = *(const PG8_LAS bf16x8*)(lds + PG8_SA(b, h) + aoff + m * 2048 + k * 1024); } while (0)
#define PG8_LDB(dst, b, h) do { _Pragma("unroll") for (int n = 0; n < 2; ++n) _Pragma("unroll") for (int k = 0; k < 2; ++k) dst[n][k] = *(const PG8_LAS bf16x8*)(lds + PG8_SB(b, h) + boff + n * 2048 + k * 1024); } while (0)
#define PG8_MMA(ai, bj, At, Bt) do { __builtin_amdgcn_s_setprio(1); _Pragma("unroll") for (int m = 0; m < 4; ++m) _Pragma("unroll") for (int n = 0; n < 2; ++n) _Pragma("unroll") for (int k = 0; k < 2; ++k) \
        acc[ai][bj][m][n] = __builtin_amdgcn_mfma_f32_16x16x32_bf16(Bt[n][k], At[m][k], acc[ai][bj][m][n], 0, 0, 0); __builtin_amdgcn_s_setprio(0); } while (0)
#define PG8_WAIT_V(n) asm volatile("s_waitcnt vmcnt(" #n ")" ::: "memory")
#define PG8_WAIT_L(n) asm volatile("s_waitcnt lgkmcnt(" #n ")" ::: "memory")
#define PG8_BAR __builtin_amdgcn_s_barrier()
#define PG8_SCHED __builtin_amdgcn_sched_barrier(0)
    Unit cur, nxt; int ui = 0;
    if (!S.next(0, cur)) return;
    int rA[2]; unsigned cAo[2];
#pragma unroll
    for (int i = 0; i < 2; ++i) { int R, C; stage_rc(tid * 16 + i * 8192, R, C); rA[i] = R; cAo[i] = (unsigned)C * 2u; }
    unsigned cO[2][2], o2[2][2]; int nR[2][2];
#define PG8_ROWS(dst, u) do { _Pragma("unroll") for (int h_ = 0; h_ < 2; ++h_) _Pragma("unroll") for (int i_ = 0; i_ < 2; ++i_) \
        dst[h_][i_] = (unsigned)S.arow(u, h_ * HALF + rA[i_]) * (unsigned)(K * 2) + cAo[i_]; } while (0)
    PG8_ROWS(cO, cur);
    f32x4 acc[2][2][4][2];
#pragma unroll
    for (int a = 0; a < 2; ++a)
#pragma unroll
        for (int b = 0; b < 2; ++b)
#pragma unroll
            for (int m = 0; m < 4; ++m)
#pragma unroll
                for (int n = 0; n < 2; ++n) acc[a][b][m][n] = (f32x4){0.f, 0.f, 0.f, 0.f};
    bf16x8 At[4][2], B0[2][2], B1[2][2];
    const char* const Ab = (const char*)g.A; const char* cB = (const char*)g.Bt + (size_t)cur.pn * tstep;
    S.a_ready(cur);
    if constexpr (SP2) {
        PG8_STAGE(PG8_SB(0, 0), cB, voffB); PG8_STAGE(PG8_SB(0, 1), cB + hstep, voffB); PG8_STAGE(PG8_SA(0, 0), Ab, cO[0]); PG8_STAGE(PG8_SA(0, 1), Ab, cO[1]);
        if (wr == 1) PG8_BAR;
        PG8_WAIT_V(2); PG8_BAR;
        PG8_STAGE(PG8_SB(1, 0), cB + kstep, voffB); PG8_STAGE(PG8_SA(1, 0), Ab + kstep, cO[0]); PG8_STAGE(PG8_SB(1, 1), cB + hstep + kstep, voffB);
        PG8_WAIT_V(6); PG8_BAR;
    }
    for (;;) {
        const bool has_next = S.next(ui + 1, nxt);
        const char* nB = has_next ? (const char*)g.Bt + (size_t)nxt.pn * tstep : cB;
#pragma unroll
        for (int h_ = 0; h_ < 2; ++h_)
#pragma unroll
            for (int i_ = 0; i_ < 2; ++i_) nR[h_][i_] = has_next ? S.arow(nxt, h_ * HALF + rA[i_]) : 0;
        for (int t = 0; t < nt; t += 2) {
            const bool last = (t == nt - 2);
            const char* a1 = Ab + (size_t)(t + 1) * kstep;
            const char* a2 = last ? Ab : Ab + (size_t)(t + 2) * kstep; const char* b2 = last ? nB : cB + (size_t)(t + 2) * kstep;
#pragma unroll
            for (int h_ = 0; h_ < 2; ++h_)
#pragma unroll
                for (int i_ = 0; i_ < 2; ++i_) o2[h_][i_] = cO[h_][i_];
            if (last && has_next) {
#pragma unroll
                for (int h_ = 0; h_ < 2; ++h_)
#pragma unroll
                    for (int i_ = 0; i_ < 2; ++i_) { int v_ = nR[h_][i_]; asm volatile("" : "+v"(v_)); o2[h_][i_] = (unsigned)v_ * (unsigned)(K * 2) + cAo[i_]; } }
            const char* a3 = a2 + kstep; const char* b3 = b2 + kstep;
            if (last && has_next) S.a_ready(nxt);
            if constexpr (SP2) {
            PG8_LDB(B0, 0, 0); PG8_LDB(B1, 0, 1); PG8_SCHED; PG8_LDA(At, 0, 0); PG8_STAGE(PG8_SA(1, 1), a1, cO[1]);
            PG8_WAIT_V(8); PG8_WAIT_L(0); PG8_BAR; PG8_MMA(0, 0, At, B0); PG8_MMA(0, 1, At, B1); PG8_BAR; PG8_SCHED;
            PG8_LDA(At, 0, 1); PG8_STAGE(PG8_SB(0, 0), b2, voffB); PG8_STAGE(PG8_SB(0, 1), b2 + hstep, voffB); PG8_STAGE(PG8_SA(0, 0), a2, o2[0]);
            PG8_WAIT_V(8); PG8_WAIT_L(0); PG8_BAR; PG8_MMA(1, 0, At, B0); PG8_MMA(1, 1, At, B1); PG8_BAR; PG8_SCHED;
            PG8_LDB(B0, 1, 0); PG8_LDB(B1, 1, 1); PG8_SCHED; PG8_LDA(At, 1, 0); PG8_STAGE(PG8_SA(0, 1), a2, o2[1]);
            PG8_WAIT_V(8); PG8_WAIT_L(0); PG8_BAR; PG8_MMA(0, 0, At, B0); PG8_MMA(0, 1, At, B1); PG8_BAR; PG8_SCHED;
            PG8_LDA(At, 1, 1); PG8_STAGE(PG8_SB(1, 0), b3, voffB); PG8_STAGE(PG8_SB(1, 1), b3 + hstep, voffB); PG8_STAGE(PG8_SA(1, 0), a3, o2[0]);
            PG8_WAIT_V(8); PG8_WAIT_L(0); PG8_BAR; PG8_MMA(1, 0, At, B0); PG8_MMA(1, 1, At, B1); PG8_BAR; PG8_SCHED;
            }
        }
        if constexpr (ALIGN_EPI) { if (wr == 0) PG8_BAR; }
        if constexpr (!Epi::AFTER_DRAIN) { E(acc, cur, wr, wc, fr, fq); S.done(cur); }
        if (!has_next) break;
#pragma unroll
        for (int a = 0; a < 2; ++a)
#pragma unroll
            for (int b = 0; b < 2; ++b)
#pragma unroll
                for (int m = 0; m < 4; ++m)
#pragma unroll
                    for (int n = 0; n < 2; ++n) acc[a][b][m][n] = (f32x4){0.f, 0.f, 0.f, 0.f};
        cur = nxt; cB = nB; ++ui;
#pragma unroll
        for (int h_ = 0; h_ < 2; ++h_)
#pragma unroll
            for (int i_ = 0; i_ < 2; ++i_) cO[h_][i_] = o2[h_][i_];
        if constexpr (ALIGN_EPI) { if (wr == 1) PG8_BAR; }
    }
    PG8_WAIT_V(0);
    if constexpr (!ALIGN_EPI) { if (wr == 0) PG8_BAR; }
    PG8_BAR;
    if constexpr (Epi::AFTER_DRAIN) { E.fused(acc, cur, wr, wc, fr, fq, lds, wid, lane); S.done(cur); }
#undef PG8_ROWS
#undef PG8_SA
#undef PG8_SB
#undef PG8_STAGE
#undef PG8_LDA
#undef PG8_LDB
#undef PG8_MMA
#undef PG8_WAIT_V
#undef PG8_WAIT_L
#undef PG8_BAR
#undef PG8_SCHED
}
typedef int v4i_t __attribute__((ext_vector_type(4)));
typedef int v8i_t __attribute__((ext_vector_type(8)));
template <class Epi, class Sched, bool ALIGN_EPI = false, bool SP2 = false>
__device__ __forceinline__ void gemm_phase_f8(PG8_LAS unsigned char* lds, const Gemm g, const Sched& S, const Epi& E) {
    const int tid = threadIdx.x, wid = __builtin_amdgcn_readfirstlane(tid >> 6), lane = tid & 63, wr = wid >> 2, wc = wid & 3, fr = lane & 15, fq = lane >> 4;
    const int K = g.K, nt = K / BK;
    unsigned voffA[2], voffB[2];
#pragma unroll
    for (int i = 0; i < 2; ++i) { int R, C; stage_rc(tid * 16 + i * 8192, R, C); const int Rb = Epi::PERM ? ((R & ~31) + perm32(R & 31)) : R;
        voffA[i] = (unsigned)(R * K + C) * 2u; voffB[i] = (unsigned)(Rb * K + C) * 2u; }
    const size_t kstep = (size_t)(BK * 2);
    const size_t hstep = (size_t)HALF * K * 2;
    const size_t tstep = 2 * hstep;
    const unsigned ldsw = (unsigned)wid * 1024u;
    const int aoff = lds_byte(wr * 64 + fr, fq * 8), boff = lds_byte(wc * 32 + fr, fq * 8);
#define PG8_SA(b, h) (((b) * 2 + (h)) * HTB)
#define PG8_SB(b, h) ((4 + (b) * 2 + (h)) * HTB)
#define PG8_STAGE(bufoff, gbase, voff) do { _Pragma("unroll") for (int _i = 0; _i < 2; ++_i) \
        __builtin_amdgcn_global_load_lds((const unsigned*)((const char*)(gbase) + (voff)[_i]), (PG8_LAS unsigned*)(lds + (bufoff) + ldsw + _i * 8192), 16, 0, 0); } while (0)
#define PG8_LDA(dst, b, h) do { _Pragma("unroll") for (int m = 0; m < 4; ++m) { const v4i_t lo_ = *(const PG8_LAS v4i_t*)(lds + PG8_SA(b, h) + aoff + m * 2048), hi_ = *(const PG8_LAS v4i_t*)(lds + PG8_SA(b, h) + aoff + m * 2048 + 1024); dst[m] = __builtin_shufflevector(lo_, hi_, 0, 1, 2, 3, 4, 5, 6, 7); } } while (0)
#define PG8_LDB(dst, b, h) do { _Pragma("unroll") for (int n = 0; n < 2; ++n) { const v4i_t lo_ = *(const PG8_LAS v4i_t*)(lds + PG8_SB(b, h) + boff + n * 2048), hi_ = *(const PG8_LAS v4i_t*)(lds + PG8_SB(b, h) + boff + n * 2048 + 1024); dst[n] = __builtin_shufflevector(lo_, hi_, 0, 1, 2, 3, 4, 5, 6, 7); } } while (0)
#define PG8_MMA(ai, bj, At, Bt) do { __builtin_amdgcn_s_setprio(1); _Pragma("unroll") for (int m = 0; m < 4; ++m) _Pragma("unroll") for (int n = 0; n < 2; ++n) \
        asm volatile("v_mfma_scale_f32_16x16x128_f8f6f4 %0, %1, %2, %0, %3, %3 op_sel_hi:[0,0,0]" : "+v"(acc[ai][bj][m][n]) : "v"(Bt[n]), "v"(At[m]), "v"(scl_)); __builtin_amdgcn_s_setprio(0); } while (0)
#define PG8_WAIT_V(n) asm volatile("s_waitcnt vmcnt(" #n ")" ::: "memory")
#define PG8_WAIT_L(n) asm volatile("s_waitcnt lgkmcnt(" #n ")" ::: "memory")
#define PG8_BAR __builtin_amdgcn_s_barrier()
#define PG8_SCHED __builtin_amdgcn_sched_barrier(0)
    Unit cur, nxt; int ui = 0;
    if (!S.next(0, cur)) return;
    f32x4 acc[2][2][4][2];
#pragma unroll
    for (int a = 0; a < 2; ++a)
#pragma unroll
        for (int b = 0; b < 2; ++b)
#pragma unroll
            for (int m = 0; m < 4; ++m)
#pragma unroll
                for (int n = 0; n < 2; ++n) acc[a][b][m][n] = (f32x4){0.f, 0.f, 0.f, 0.f};
    const int scl_ = 0x7f7f7f7f;
    v8i_t At[4], B0[2], B1[2];
    const char* cA = (const char*)g.A + (size_t)cur.pm * tstep; const char* cB = (const char*)g.Bt + (size_t)cur.pn * tstep;
    S.a_ready(cur);
    if constexpr (SP2) {
        PG8_STAGE(PG8_SB(0, 0), cB, voffB); PG8_STAGE(PG8_SB(0, 1), cB + hstep, voffB); PG8_STAGE(PG8_SA(0, 0), cA, voffA); PG8_STAGE(PG8_SA(0, 1), cA + hstep, voffA);
        if (wr == 1) PG8_BAR;
        PG8_WAIT_V(2); PG8_BAR;
        PG8_STAGE(PG8_SB(1, 0), cB + kstep, voffB); PG8_STAGE(PG8_SA(1, 0), cA + kstep, voffA); PG8_STAGE(PG8_SB(1, 1), cB + hstep + kstep, voffB);
        PG8_WAIT_V(6); PG8_BAR;
    } else {
        PG8_STAGE(PG8_SB(0, 0), cB, voffB); PG8_STAGE(PG8_SA(0, 0), cA, voffA); PG8_STAGE(PG8_SB(0, 1), cB + hstep, voffB); PG8_STAGE(PG8_SA(0, 1), cA + hstep, voffA);
        if (wr == 1) PG8_BAR;
        PG8_WAIT_V(4); PG8_BAR;
        PG8_STAGE(PG8_SB(1, 0), cB + kstep, voffB); PG8_STAGE(PG8_SA(1, 0), cA + kstep, voffA); PG8_STAGE(PG8_SB(1, 1), cB + hstep + kstep, voffB);
        PG8_WAIT_V(6); PG8_BAR;
    }
    for (;;) {
        const bool has_next = S.next(ui + 1, nxt);
        const char* nA = has_next ? (const char*)g.A + (size_t)nxt.pm * tstep : cA; const char* nB = has_next ? (const char*)g.Bt + (size_t)nxt.pn * tstep : cB;
        for (int t = 0; t < nt; t += 2) {
            const bool last = (t == nt - 2);
            const char* a1 = cA + (size_t)(t + 1) * kstep;
            const char* a2 = last ? nA : cA + (size_t)(t + 2) * kstep; const char* b2 = last ? nB : cB + (size_t)(t + 2) * kstep;
            const char* a3 = a2 + kstep; const char* b3 = b2 + kstep;
            if (last && has_next) S.a_ready(nxt);
            if constexpr (SP2) {
            PG8_LDB(B0, 0, 0); PG8_LDB(B1, 0, 1); PG8_SCHED; PG8_LDA(At, 0, 0); PG8_STAGE(PG8_SA(1, 1), a1 + hstep, voffA);
            PG8_WAIT_V(8); PG8_WAIT_L(0); PG8_BAR; PG8_MMA(0, 0, At, B0); PG8_MMA(0, 1, At, B1); PG8_BAR; PG8_SCHED;
            PG8_LDA(At, 0, 1); PG8_STAGE(PG8_SB(0, 0), b2, voffB); PG8_STAGE(PG8_SB(0, 1), b2 + hstep, voffB); PG8_STAGE(PG8_SA(0, 0), a2, voffA);
            PG8_WAIT_V(8); PG8_WAIT_L(0); PG8_BAR; PG8_MMA(1, 0, At, B0); PG8_MMA(1, 1, At, B1); PG8_BAR; PG8_SCHED;
            PG8_LDB(B0, 1, 0); PG8_LDB(B1, 1, 1); PG8_SCHED; PG8_LDA(At, 1, 0); PG8_STAGE(PG8_SA(0, 1), a2 + hstep, voffA);
            PG8_WAIT_V(8); PG8_WAIT_L(0); PG8_BAR; PG8_MMA(0, 0, At, B0); PG8_MMA(0, 1, At, B1); PG8_BAR; PG8_SCHED;
            PG8_LDA(At, 1, 1); PG8_STAGE(PG8_SB(1, 0), b3, voffB); PG8_STAGE(PG8_SB(1, 1), b3 + hstep, voffB); PG8_STAGE(PG8_SA(1, 0), a3, voffA);
            PG8_WAIT_V(8); PG8_WAIT_L(0); PG8_BAR; PG8_MMA(1, 0, At, B0); PG8_MMA(1, 1, At, B1); PG8_BAR; PG8_SCHED;
            } else {
            PG8_LDB(B0, 0, 0); PG8_SCHED; PG8_LDA(At, 0, 0); PG8_STAGE(PG8_SA(1, 1), a1 + hstep, voffA);
            PG8_WAIT_L(8); PG8_BAR; PG8_WAIT_L(0); PG8_MMA(0, 0, At, B0); PG8_BAR; PG8_SCHED;
            PG8_LDB(B1, 0, 1); PG8_STAGE(PG8_SB(0, 0), b2, voffB);
            PG8_BAR; PG8_WAIT_L(0); PG8_MMA(0, 1, At, B1); PG8_BAR;
            PG8_LDA(At, 0, 1); PG8_STAGE(PG8_SA(0, 0), a2, voffA);
            PG8_BAR; PG8_WAIT_L(0); PG8_MMA(1, 0, At, B0); PG8_BAR; PG8_SCHED;
            PG8_STAGE(PG8_SB(0, 1), b2 + hstep, voffB);
            PG8_WAIT_V(6); PG8_BAR; PG8_MMA(1, 1, At, B1); PG8_BAR;
            PG8_LDB(B0, 1, 0); PG8_SCHED; PG8_LDA(At, 1, 0); PG8_STAGE(PG8_SA(0, 1), a2 + hstep, voffA);
            PG8_WAIT_L(8); PG8_BAR; PG8_WAIT_L(0); PG8_MMA(0, 0, At, B0); PG8_BAR; PG8_SCHED;
            PG8_LDB(B1, 1, 1); PG8_STAGE(PG8_SB(1, 0), b3, voffB);
            PG8_BAR; PG8_WAIT_L(0); PG8_MMA(0, 1, At, B1); PG8_BAR;
            PG8_LDA(At, 1, 1); PG8_STAGE(PG8_SA(1, 0), a3, voffA);
            PG8_BAR; PG8_WAIT_L(0); PG8_MMA(1, 0, At, B0); PG8_BAR; PG8_SCHED;
            PG8_STAGE(PG8_SB(1, 1), b3 + hstep, voffB);
            PG8_WAIT_V(6); PG8_BAR; PG8_MMA(1, 1, At, B1); PG8_BAR;
            }
        }
        if constexpr (ALIGN_EPI) { if (wr == 0) PG8_BAR; }
        asm volatile("s_nop 15\n\ts_nop 15" ::: "memory");
        if constexpr (!Epi::AFTER_DRAIN) { E(acc, cur, wr, wc, fr, fq); S.done(cur); }
        if (!has_next) break;
#pragma unroll
        for (int a = 0; a < 2; ++a)
#pragma unroll
            for (int b = 0; b < 2; ++b)
#pragma unroll
                for (int m = 0; m < 4; ++m)
#pragma unroll
                    for (int n = 0; n < 2; ++n) acc[a][b][m][n] = (f32x4){0.f, 0.f, 0.f, 0.f};
        cur = nxt; cA = nA; cB = nB; ++ui;
        if constexpr (ALIGN_EPI) { if (wr == 1) PG8_BAR; }
    }
    PG8_WAIT_V(0);
    if constexpr (!ALIGN_EPI) { if (wr == 0) PG8_BAR; }
    PG8_BAR;
    if constexpr (Epi::AFTER_DRAIN) { E.fused(acc, cur, wr, wc, fr, fq, lds, wid, lane); S.done(cur); }
#undef PG8_SA
#undef PG8_SB
#undef PG8_STAGE
#undef PG8_LDA
#undef PG8_LDB
#undef PG8_MMA
#undef PG8_WAIT_V
#undef PG8_WAIT_L
#undef PG8_BAR
#undef PG8_SCHED
}

template <class Epi, class Sched>
__device__ __forceinline__ void gemm_phase_gather_f8(PG8_LAS unsigned char* lds, const Gemm g, const Sched& S, const Epi& E) {
    constexpr bool ALIGN_EPI = true, SP2 = true;
    const int tid = threadIdx.x, wid = __builtin_amdgcn_readfirstlane(tid >> 6), lane = tid & 63, wr = wid >> 2, wc = wid & 3, fr = lane & 15, fq = lane >> 4;
    const int K = g.K, nt = K / BK;
    unsigned voffA[2], voffB[2];
#pragma unroll
    for (int i = 0; i < 2; ++i) { int R, C; stage_rc(tid * 16 + i * 8192, R, C); const int Rb = Epi::PERM ? ((R & ~31) + perm32(R & 31)) : R;
        voffA[i] = (unsigned)(R * K + C) * 2u; voffB[i] = (unsigned)(Rb * K + C) * 2u; }
    const size_t kstep = (size_t)(BK * 2);
    const size_t hstep = (size_t)HALF * K * 2;
    const size_t tstep = 2 * hstep;
    const unsigned ldsw = (unsigned)wid * 1024u;
    const int aoff = lds_byte(wr * 64 + fr, fq * 8), boff = lds_byte(wc * 32 + fr, fq * 8);
#define PG8_SA(b, h) (((b) * 2 + (h)) * HTB)
#define PG8_SB(b, h) ((4 + (b) * 2 + (h)) * HTB)
#define PG8_STAGE(bufoff, gbase, voff) do { _Pragma("unroll") for (int _i = 0; _i < 2; ++_i) \
        __builtin_amdgcn_global_load_lds((const unsigned*)((const char*)(gbase) + (voff)[_i]), (PG8_LAS unsigned*)(lds + (bufoff) + ldsw + _i * 8192), 16, 0, 0); } while (0)
#define PG8_LDA(dst, b, h) do { _Pragma("unroll") for (int m = 0; m < 4; ++m) { const v4i_t lo_ = *(const PG8_LAS v4i_t*)(lds + PG8_SA(b, h) + aoff + m * 2048), hi_ = *(const PG8_LAS v4i_t*)(lds + PG8_SA(b, h) + aoff + m * 2048 + 1024); dst[m] = __builtin_shufflevector(lo_, hi_, 0, 1, 2, 3, 4, 5, 6, 7); } } while (0)
#define PG8_LDB(dst, b, h) do { _Pragma("unroll") for (int n = 0; n < 2; ++n) { const v4i_t lo_ = *(const PG8_LAS v4i_t*)(lds + PG8_SB(b, h) + boff + n * 2048), hi_ = *(const PG8_LAS v4i_t*)(lds + PG8_SB(b, h) + boff + n * 2048 + 1024); dst[n] = __builtin_shufflevector(lo_, hi_, 0, 1, 2, 3, 4, 5, 6, 7); } } while (0)
#define PG8_MMA(ai, bj, At, Bt) do { __builtin_amdgcn_s_setprio(1); _Pragma("unroll") for (int m = 0; m < 4; ++m) _Pragma("unroll") for (int n = 0; n < 2; ++n) \
        asm volatile("v_mfma_scale_f32_16x16x128_f8f6f4 %0, %1, %2, %0, %3, %3 op_sel_hi:[0,0,0]" : "+v"(acc[ai][bj][m][n]) : "v"(Bt[n]), "v"(At[m]), "v"(scl_)); __builtin_amdgcn_s_setprio(0); } while (0)
#define PG8_WAIT_V(n) asm volatile("s_waitcnt vmcnt(" #n ")" ::: "memory")
#define PG8_WAIT_L(n) asm volatile("s_waitcnt lgkmcnt(" #n ")" ::: "memory")
#define PG8_BAR __builtin_amdgcn_s_barrier()
#define PG8_SCHED __builtin_amdgcn_sched_barrier(0)
    Unit cur, nxt; int ui = 0;
    if (!S.next(0, cur)) return;
    int rA[2]; unsigned cAo[2];
#pragma unroll
    for (int i = 0; i < 2; ++i) { int R, C; stage_rc(tid * 16 + i * 8192, R, C); rA[i] = R; cAo[i] = (unsigned)C * 2u; }
    unsigned cO[2][2], o2[2][2]; int nR[2][2];
#define PG8_ROWS(dst, u) do { _Pragma("unroll") for (int h_ = 0; h_ < 2; ++h_) _Pragma("unroll") for (int i_ = 0; i_ < 2; ++i_) \
        dst[h_][i_] = (unsigned)S.arow(u, h_ * HALF + rA[i_]) * (unsigned)(K * 2) + cAo[i_]; } while (0)
    PG8_ROWS(cO, cur);
    f32x4 acc[2][2][4][2];
#pragma unroll
    for (int a = 0; a < 2; ++a)
#pragma unroll
        for (int b = 0; b < 2; ++b)
#pragma unroll
            for (int m = 0; m < 4; ++m)
#pragma unroll
                for (int n = 0; n < 2; ++n) acc[a][b][m][n] = (f32x4){0.f, 0.f, 0.f, 0.f};
    const int scl_ = 0x7f7f7f7f;
    v8i_t At[4], B0[2], B1[2];
    const char* const Ab = (const char*)g.A; const char* cB = (const char*)g.Bt + (size_t)cur.pn * tstep;
    S.a_ready(cur);
    if constexpr (SP2) {
        PG8_STAGE(PG8_SB(0, 0), cB, voffB); PG8_STAGE(PG8_SB(0, 1), cB + hstep, voffB); PG8_STAGE(PG8_SA(0, 0), Ab, cO[0]); PG8_STAGE(PG8_SA(0, 1), Ab, cO[1]);
        if (wr == 1) PG8_BAR;
        PG8_WAIT_V(2); PG8_BAR;
        PG8_STAGE(PG8_SB(1, 0), cB + kstep, voffB); PG8_STAGE(PG8_SA(1, 0), Ab + kstep, cO[0]); PG8_STAGE(PG8_SB(1, 1), cB + hstep + kstep, voffB);
        PG8_WAIT_V(6); PG8_BAR;
    }
    for (;;) {
        const bool has_next = S.next(ui + 1, nxt);
        const char* nB = has_next ? (const char*)g.Bt + (size_t)nxt.pn * tstep : cB;
#pragma unroll
        for (int h_ = 0; h_ < 2; ++h_)
#pragma unroll
            for (int i_ = 0; i_ < 2; ++i_) nR[h_][i_] = has_next ? S.arow(nxt, h_ * HALF + rA[i_]) : 0;
        for (int t = 0; t < nt; t += 2) {
            const bool last = (t == nt - 2);
            const char* a1 = Ab + (size_t)(t + 1) * kstep;
            const char* a2 = last ? Ab : Ab + (size_t)(t + 2) * kstep; const char* b2 = last ? nB : cB + (size_t)(t + 2) * kstep;
#pragma unroll
            for (int h_ = 0; h_ < 2; ++h_)
#pragma unroll
                for (int i_ = 0; i_ < 2; ++i_) o2[h_][i_] = cO[h_][i_];
            if (last && has_next) {
#pragma unroll
                for (int h_ = 0; h_ < 2; ++h_)
#pragma unroll
                    for (int i_ = 0; i_ < 2; ++i_) { int v_ = nR[h_][i_]; asm volatile("" : "+v"(v_)); o2[h_][i_] = (unsigned)v_ * (unsigned)(K * 2) + cAo[i_]; } }
            const char* a3 = a2 + kstep; const char* b3 = b2 + kstep;
            if (last && has_next) S.a_ready(nxt);
            if constexpr (SP2) {
            PG8_LDB(B0, 0, 0); PG8_LDB(B1, 0, 1); PG8_SCHED; PG8_LDA(At, 0, 0); PG8_STAGE(PG8_SA(1, 1), a1, cO[1]);
            PG8_WAIT_V(8); PG8_WAIT_L(0); PG8_BAR; PG8_MMA(0, 0, At, B0); PG8_MMA(0, 1, At, B1); PG8_BAR; PG8_SCHED;
            PG8_LDA(At, 0, 1); PG8_STAGE(PG8_SB(0, 0), b2, voffB); PG8_STAGE(PG8_SB(0, 1), b2 + hstep, voffB); PG8_STAGE(PG8_SA(0, 0), a2, o2[0]);
            PG8_WAIT_V(8); PG8_WAIT_L(0); PG8_BAR; PG8_MMA(1, 0, At, B0); PG8_MMA(1, 1, At, B1); PG8_BAR; PG8_SCHED;
            PG8_LDB(B0, 1, 0); PG8_LDB(B1, 1, 1); PG8_SCHED; PG8_LDA(At, 1, 0); PG8_STAGE(PG8_SA(0, 1), a2, o2[1]);
            PG8_WAIT_V(8); PG8_WAIT_L(0); PG8_BAR; PG8_MMA(0, 0, At, B0); PG8_MMA(0, 1, At, B1); PG8_BAR; PG8_SCHED;
            PG8_LDA(At, 1, 1); PG8_STAGE(PG8_SB(1, 0), b3, voffB); PG8_STAGE(PG8_SB(1, 1), b3 + hstep, voffB); PG8_STAGE(PG8_SA(1, 0), a3, o2[0]);
            PG8_WAIT_V(8); PG8_WAIT_L(0); PG8_BAR; PG8_MMA(1, 0, At, B0); PG8_MMA(1, 1, At, B1); PG8_BAR; PG8_SCHED;
            }
        }
        if constexpr (ALIGN_EPI) { if (wr == 0) PG8_BAR; }
        asm volatile("s_nop 15\n\ts_nop 15" ::: "memory");
        if constexpr (!Epi::AFTER_DRAIN) { E(acc, cur, wr, wc, fr, fq); S.done(cur); }
        if (!has_next) break;
#pragma unroll
        for (int a = 0; a < 2; ++a)
#pragma unroll
            for (int b = 0; b < 2; ++b)
#pragma unroll
                for (int m = 0; m < 4; ++m)
#pragma unroll
                    for (int n = 0; n < 2; ++n) acc[a][b][m][n] = (f32x4){0.f, 0.f, 0.f, 0.f};
        cur = nxt; cB = nB; ++ui;
#pragma unroll
        for (int h_ = 0; h_ < 2; ++h_)
#pragma unroll
            for (int i_ = 0; i_ < 2; ++i_) cO[h_][i_] = o2[h_][i_];
        if constexpr (ALIGN_EPI) { if (wr == 1) PG8_BAR; }
    }
    PG8_WAIT_V(0);
    if constexpr (!ALIGN_EPI) { if (wr == 0) PG8_BAR; }
    PG8_BAR;
    if constexpr (Epi::AFTER_DRAIN) { E.fused(acc, cur, wr, wc, fr, fq, lds, wid, lane); S.done(cur); }
#undef PG8_ROWS
#undef PG8_SA
#undef PG8_SB
#undef PG8_STAGE
#undef PG8_LDA
#undef PG8_LDB
#undef PG8_MMA
#undef PG8_WAIT_V
#undef PG8_WAIT_L
#undef PG8_BAR
#undef PG8_SCHED
}
}

struct EpiP { bf16_t* P; int n0; __device__ __forceinline__ void operator()(int r, int cl, float a, float) const { P[(size_t)r * NPROJ + n0 + cl] = (bf16_t)f2bf(a); } };
__device__ __forceinline__ void phase_gemm1_naive(const Params& p, const Ctx& c) {
    const bf16_t* H = (const bf16_t*)(p.ws + WS_H); const bf16_t* W = (const bf16_t*)(p.ws + WS_WINT); bf16_t* P = (bf16_t*)(p.ws + WS_P);
    constexpr int NT_N = NPROJ / 64, NT_M = M / 128;
    for (int it = c.bid; it < NT_M * NT_N; it += c.G) {
        const int mt = it / NT_N, nt = it % NT_N;
        ngemm_tile<false>(ARowPlain{H, 1024}, W + (size_t)nt * 64 * 1024, nullptr, 1024, mt * 128, EpiP{P, nt * 64}, (LAS float*)c.lds, c.tid);
    }
}

__device__ __forceinline__ void phase_conv(const Params& p, const Ctx& c) {
    unsigned char* ws = p.ws;
    const bf16_t* P = (const bf16_t*)(ws + WS_P);
    const int tid = c.tid;
    LAS bf16_t* raw = (LAS bf16_t*)c.lds;
    LAS bf16_t* outb = (LAS bf16_t*)(c.lds + 132 * 256 * 2);
    for (int it = c.bid; it < 2 * 64 * 6; it += c.G) {
        const int part = it % 6, bc = it / 6, b = bc / 64, ch_ = bc % 64, t0 = ch_ * 128;
        __syncthreads();
        {
            u32x4 rv[9];
#pragma unroll
            for (int i = 0; i < 9; ++i) { const int idx = tid + 512 * i, r = idx >> 5, c8 = idx & 31, tok = t0 - 2 + r;
                rv[i] = (u32x4){0u, 0u, 0u, 0u};
                if (idx < 132 * 32 && tok >= 0 && tok < S) rv[i] = *(const u32x4*)(P + (size_t)(b * S + tok) * NPROJ + PXBC + part * 256 + c8 * 8); }
#pragma unroll
            for (int i = 0; i < 9; ++i) { const int idx = tid + 512 * i, r = idx >> 5, c8 = idx & 31;
                if (idx < 132 * 32) *(LAS u32x4*)(raw + r * 256 + c8 * 8) = rv[i]; }
        }
        __syncthreads();
        {
            const int ch = tid & 255, l0 = tid >> 8, cg_ = part * 256 + ch;
            const float* cw = p.in[3]; const float cb = p.in[4][cg_];
            const float w0 = cw[0 * 1536 + cg_], w1 = cw[1 * 1536 + cg_], w2 = cw[2 * 1536 + cg_], w3 = cw[3 * 1536 + cg_], w4 = cw[4 * 1536 + cg_];
            for (int i = 0; i < 64; ++i) {
                const int l = l0 + 2 * i;
                float a = cb;
                a = fmaf(w0, bf2f(raw[(l + 0) * 256 + ch]), a); a = fmaf(w1, bf2f(raw[(l + 1) * 256 + ch]), a); a = fmaf(w2, bf2f(raw[(l + 2) * 256 + ch]), a);
                a = fmaf(w3, bf2f(raw[(l + 3) * 256 + ch]), a); a = fmaf(w4, bf2f(raw[(l + 4) * 256 + ch]), a);
                outb[l * 256 + ch] = (bf16_t)f2bf(a * sigmoidf_(a));
            }
        }
        __syncthreads();
        if (part < 4 || part == 4) {
            bf16_t* dst = part < 4 ? (bf16_t*)(ws + WS_XT) + ((size_t)(b * 64 + ch_) * 16 + part * 4) * 64 * 128
                                   : (bf16_t*)(ws + WS_BMT) + (size_t)(b * 64 + ch_) * 2 * 128 * 128;
            for (int idx = tid; idx < 256 * 16; idx += 512) {
                const int lc = idx >> 8, ch = idx & 255;
                u32x4 o;
                o.x = (unsigned)outb[(lc * 8 + 0) * 256 + ch] | ((unsigned)outb[(lc * 8 + 1) * 256 + ch] << 16);
                o.y = (unsigned)outb[(lc * 8 + 2) * 256 + ch] | ((unsigned)outb[(lc * 8 + 3) * 256 + ch] << 16);
                o.z = (unsigned)outb[(lc * 8 + 4) * 256 + ch] | ((unsigned)outb[(lc * 8 + 5) * 256 + ch] << 16);
                o.w = (unsigned)outb[(lc * 8 + 6) * 256 + ch] | ((unsigned)outb[(lc * 8 + 7) * 256 + ch] << 16);
                *(u32x4*)(dst + (size_t)ch * 128 + lc * 8) = o;
            }
        }
        if (part >= 4) {
            bf16_t* dst = (bf16_t*)(ws + (part == 4 ? WS_BMR : WS_CMR)) + (size_t)(b * S + t0) * 256;
            for (int idx = tid; idx < 128 * 32; idx += 512) {
                const int l = idx >> 5, c8 = idx & 31;
                *(u32x4*)(dst + (size_t)l * 256 + c8 * 8) = *(const LAS u32x4*)(outb + l * 256 + c8 * 8);
            }
        }
    }
    {
        float* DT = (float*)(ws + WS_DT); float* ACS = (float*)(ws + WS_ACS); float* CDEC = (float*)(ws + WS_CDEC);
        const int lane = c.lane;
        for (int it = c.bid; it < 128; it += c.G) {
            const int b = it / 64, ch_ = it % 64, t0 = ch_ * 128;
#pragma unroll
            for (int qi = 0; qi < 4; ++qi) {
                const int q = c.wave * 4 + qi, dir = q >> 4, h = q & 15;
                const float bias = dir ? p.in[6][h] : p.in[5][h], nA = -expf(dir ? p.in[8][h] : p.in[7][h]);
                const int l0 = dir ? 127 - lane : lane, l1 = dir ? 63 - lane : lane + 64;
                const size_t tok0 = (size_t)b * S + t0 + l0, tok1 = (size_t)b * S + t0 + l1;
                const float x0 = bf2f(P[tok0 * NPROJ + PDT + q]) + bias, x1 = bf2f(P[tok1 * NPROJ + PDT + q]) + bias;
                const float d0 = fmaxf(x0, 0.f) + log1pf(expf(-fabsf(x0))), d1 = fmaxf(x1, 0.f) + log1pf(expf(-fabsf(x1)));
                float a0 = d0 * nA, a1 = d1 * nA;
#pragma unroll
                for (int o = 1; o < 64; o <<= 1) { const float t0_ = __shfl_up(a0, o), t1_ = __shfl_up(a1, o); if (lane >= o) { a0 += t0_; a1 += t1_; } }
                const float tot0 = __shfl(a0, 63); a1 += tot0;
                DT[((size_t)dir * M + tok0) * 16 + h] = d0; DT[((size_t)dir * M + tok1) * 16 + h] = d1;
                ACS[((size_t)dir * M + tok0) * 16 + h] = a0; ACS[((size_t)dir * M + tok1) * 16 + h] = a1;
                if (lane == 63) CDEC[((dir * 2 + b) * 64 + ch_) * 16 + h] = expf(a1);
            }
        }
    }
    {
        const int gw = c.bid * 8 + c.wave, NGW = c.G * 8, lane = c.lane;
        const float* rc = (const float*)(ws + WS_ROPE); const float* rs = rc + 4096;
        const int sub = lane >> 4, j = lane & 15, axis = j >> 3, i0 = 8 * (j & 3); const bool second = (j & 4) != 0;
        const f32x4 gq0 = *(const f32x4*)(p.in[11] + 8 * j), gq1 = *(const f32x4*)(p.in[11] + 8 * j + 4), gk0 = *(const f32x4*)(p.in[12] + 8 * j), gk1 = *(const f32x4*)(p.in[12] + 8 * j + 4);
        bf16_t* QN = (bf16_t*)(ws + WS_QN); bf16_t* KN = (bf16_t*)(ws + WS_KN);
#pragma unroll 4
        for (int base = gw; base < M * 10 / 4; base += NGW) {
            const int it = base * 4 + sub, tok = it / 10, hh = it % 10;
            const bf16_t* src = P + (size_t)tok * NPROJ + (hh < 8 ? PQ + hh * 128 : PK + (hh - 8) * 128) + 8 * j;
            bf16_t* dst = (hh < 8 ? QN + (size_t)tok * 1024 + hh * 128 : KN + (size_t)tok * 256 + (hh - 8) * 128) + 8 * j;
            const u32x4 v = *(const u32x4*)src;
            float y[8] = {bflo(v.x), bfhi(v.x), bflo(v.y), bfhi(v.y), bflo(v.z), bfhi(v.z), bflo(v.w), bfhi(v.w)};
            float ss = 0.f;
#pragma unroll
            for (int i = 0; i < 8; ++i) ss = fmaf(y[i], y[i], ss);
            ss += __shfl_xor(ss, 1); ss += __shfl_xor(ss, 2); ss += __shfl_xor(ss, 4); ss += __shfl_xor(ss, 8);
            const float rstd = rsqrtf(ss * (1.f / 128.f) + EPS);
            const f32x4 g0 = hh < 8 ? gq0 : gk0, g1 = hh < 8 ? gq1 : gk1;
#pragma unroll
            for (int i = 0; i < 4; ++i) { y[i] *= rstd * g0[i]; y[4 + i] *= rstd * g1[i]; }
            const int s = tok & (S - 1), pos = axis ? (s & 63) : (s >> 6);
            const f32x4 c0 = *(const f32x4*)(rc + pos * 32 + i0), c1 = *(const f32x4*)(rc + pos * 32 + i0 + 4), s0 = *(const f32x4*)(rs + pos * 32 + i0), s1 = *(const f32x4*)(rs + pos * 32 + i0 + 4);
            float o[8];
#pragma unroll
            for (int i = 0; i < 8; ++i) { const float other = __shfl_xor(y[i], 4); const float cs = i < 4 ? c0[i] : c1[i - 4], sn = i < 4 ? s0[i] : s1[i - 4];
                o[i] = second ? fmaf(other, sn, y[i] * cs) : fmaf(-other, sn, y[i] * cs); }
            u32x4 w; w.x = pk2(o[0], o[1]); w.y = pk2(o[2], o[3]); w.z = pk2(o[4], o[5]); w.w = pk2(o[6], o[7]);
            *(u32x4*)dst = w;
        }
        bf16_t* VB = (bf16_t*)(ws + WS_VB);
        for (int idx0 = c.bid * 512 + c.tid; idx0 < M * 32; idx0 += c.G * 512 * 4) {
            u32x4 v[4];
#pragma unroll
            for (int i = 0; i < 4; ++i) { const int idx = idx0 + i * c.G * 512; if (idx < M * 32) v[i] = *(const u32x4*)(P + (size_t)(idx >> 5) * NPROJ + PV + (idx & 31) * 8); }
#pragma unroll
            for (int i = 0; i < 4; ++i) { const int idx = idx0 + i * c.G * 512; if (idx < M * 32) *(u32x4*)(VB + (size_t)(idx >> 5) * 256 + (idx & 31) * 8) = v[i]; }
        }
    }
}

__device__ __forceinline__ void phase_ssd_naive(const Params& p, const Ctx& c) {
    unsigned char* ws = p.ws;
    const bf16_t* P = (const bf16_t*)(ws + WS_P); const bf16_t* XT = (const bf16_t*)(ws + WS_XT);
    const bf16_t* BMR = (const bf16_t*)(ws + WS_BMR); const bf16_t* CMR = (const bf16_t*)(ws + WS_CMR);
    const float* DT = (const float*)(ws + WS_DT); float* YACC = (float*)(ws + WS_ST); bf16_t* YZ = (bf16_t*)(ws + WS_YZ);
    const int pp = c.tid >> 3, nq = c.tid & 7;
    for (int item = c.bid; item < 32; item += c.G) {
        const int b = item >> 4, h = item & 15, g = h >> 3;
        const float dsk = p.in[9][h];
        for (int dir = 0; dir < 2; ++dir) {
            const float A = -expf(dir ? p.in[8][h] : p.in[7][h]);
            float st[16];
#pragma unroll
            for (int i = 0; i < 16; ++i) st[i] = 0.f;
            int t = dir ? S - 1 : 0;
            size_t tok = (size_t)b * S + t;
            u32x4 nb0 = *(const u32x4*)(BMR + tok * 256 + g * 128 + nq * 16), nb1 = *(const u32x4*)(BMR + tok * 256 + g * 128 + nq * 16 + 8);
            u32x4 nc0 = *(const u32x4*)(CMR + tok * 256 + g * 128 + nq * 16), nc1 = *(const u32x4*)(CMR + tok * 256 + g * 128 + nq * 16 + 8);
            float nx = bf2f(XT[((((size_t)b * 64 + (t >> 7)) * 16 + h) * 64 + pp) * 128 + (t & 127)]);
            float ndt = DT[((size_t)dir * M + tok) * 16 + h];
            for (int step = 0; step < S; ++step) {
                const u32x4 b0 = nb0, b1 = nb1, c0 = nc0, c1 = nc1; const float x = nx, dt = ndt; const size_t tokc = tok;
                if (step + 1 < S) {
                    t = dir ? S - 2 - step : step + 1; tok = (size_t)b * S + t;
                    nb0 = *(const u32x4*)(BMR + tok * 256 + g * 128 + nq * 16); nb1 = *(const u32x4*)(BMR + tok * 256 + g * 128 + nq * 16 + 8);
                    nc0 = *(const u32x4*)(CMR + tok * 256 + g * 128 + nq * 16); nc1 = *(const u32x4*)(CMR + tok * 256 + g * 128 + nq * 16 + 8);
                    nx = bf2f(XT[((((size_t)b * 64 + (t >> 7)) * 16 + h) * 64 + pp) * 128 + (t & 127)]);
                    ndt = DT[((size_t)dir * M + tok) * 16 + h];
                }
                const float dec = __expf(dt * A), xdt = x * dt;
                float part = 0.f;
#define SSD_STEP(i, BW, CW, LOHI) { st[i] = fmaf(st[i], dec, LOHI(BW) * xdt); part = fmaf(LOHI(CW), st[i], part); }
                SSD_STEP(0, b0.x, c0.x, bflo) SSD_STEP(1, b0.x, c0.x, bfhi) SSD_STEP(2, b0.y, c0.y, bflo) SSD_STEP(3, b0.y, c0.y, bfhi)
                SSD_STEP(4, b0.z, c0.z, bflo) SSD_STEP(5, b0.z, c0.z, bfhi) SSD_STEP(6, b0.w, c0.w, bflo) SSD_STEP(7, b0.w, c0.w, bfhi)
                SSD_STEP(8, b1.x, c1.x, bflo) SSD_STEP(9, b1.x, c1.x, bfhi) SSD_STEP(10, b1.y, c1.y, bflo) SSD_STEP(11, b1.y, c1.y, bfhi)
                SSD_STEP(12, b1.z, c1.z, bflo) SSD_STEP(13, b1.z, c1.z, bfhi) SSD_STEP(14, b1.w, c1.w, bflo) SSD_STEP(15, b1.w, c1.w, bfhi)
#undef SSD_STEP
                part += __shfl_xor(part, 1); part += __shfl_xor(part, 2); part += __shfl_xor(part, 4);
                if (nq == 0) {
                    const size_t o = tokc * 1024 + h * 64 + pp;
                    if (dir == 0) YACC[o] = part + x * dsk;
                    else { const float y = YACC[o] + part; const float z = bf2f(P[tokc * NPROJ + PZ + h * 64 + pp]); YZ[o] = (bf16_t)f2bf(y * z * sigmoidf_(z)); }
                }
            }
        }
    }
}


typedef short bf16x8 __attribute__((ext_vector_type(8)));
typedef float f32x16 __attribute__((ext_vector_type(16)));
constexpr int TS = 136;
__device__ __forceinline__ bf16x8 ldfrag(const LAS bf16_t* tile, int row, int k0) { return *(const LAS bf16x8*)(tile + row * TS + k0); }
template <int ROWS> __device__ __forceinline__ void load_tile128(LAS bf16_t* dst, const bf16_t* src, int ld, int tid) {
    constexpr int N = ROWS * 16 / 512;
    u32x4 v[N];
#pragma unroll
    for (int i = 0; i < N; ++i) { const int idx = tid + 512 * i; v[i] = *(const u32x4*)(src + (size_t)(idx >> 4) * ld + (idx & 15) * 8); }
#pragma unroll
    for (int i = 0; i < N; ++i) { const int idx = tid + 512 * i; *(LAS u32x4*)(dst + (idx >> 4) * TS + (idx & 15) * 8) = v[i]; }
}
__device__ __forceinline__ void phase_ssd_states(const Params& p, const Ctx& c) {
    unsigned char* ws = p.ws;
    const bf16_t* XT = (const bf16_t*)(ws + WS_XT); const bf16_t* BMT = (const bf16_t*)(ws + WS_BMT);
    const float* DT = (const float*)(ws + WS_DT); const float* ACS = (const float*)(ws + WS_ACS); bf16_t* ST = (bf16_t*)(ws + WS_PREV);
    LAS bf16_t* BTs = (LAS bf16_t*)c.lds; LAS bf16_t* XTf = BTs + 128 * TS; LAS bf16_t* XTb = XTf + 64 * TS; LAS float* wd = (LAS float*)(XTb + 64 * TS);
    const int tid = c.tid, lane = c.lane, r = lane & 31, hh = lane >> 5;
    for (int unit = c.bid; unit < 256; unit += c.G) {
        const int b = unit >> 7, ch = (unit >> 1) & 63, g = unit & 1;
        __syncthreads();
        load_tile128<128>(BTs, BMT + ((size_t)(b * 64 + ch) * 2 + g) * 128 * 128, 128, tid);
        u32x4 xv0, xv1; float pacs = 0.f, pdt = 0.f, paend = 0.f;
        const int wd_d = (tid >> 7) & 1, wd_l = tid & 127; const size_t wd_t0 = (size_t)wd_d * M + (size_t)b * S + ch * 128;
#define S1_PREFETCH(H) do { const bf16_t* xt_ = XT + ((size_t)(b * 64 + ch) * 16 + (H)) * 64 * 128; \
            xv0 = *(const u32x4*)(xt_ + (tid >> 4) * 128 + (tid & 15) * 8); xv1 = *(const u32x4*)(xt_ + ((tid + 512) >> 4) * 128 + (tid & 15) * 8); \
            if (tid < 256) { pacs = ACS[(wd_t0 + wd_l) * 16 + (H)]; pdt = DT[(wd_t0 + wd_l) * 16 + (H)]; paend = ACS[(wd_t0 + (wd_d ? 0 : 127)) * 16 + (H)]; } } while (0)
        S1_PREFETCH(g * 8);
#pragma unroll 1
        for (int h8 = 0; h8 < 8; ++h8) {
            const int h = g * 8 + h8;
            __syncthreads();
            if (tid < 256) wd[wd_d * 128 + wd_l] = pdt * __expf(paend - pacs);
            __syncthreads();
            {
                const u32x4 vv[2] = {xv0, xv1};
#pragma unroll
                for (int i = 0; i < 2; ++i) { const int idx = tid + 512 * i, pr = idx >> 4, l0 = (idx & 15) * 8; const u32x4 v = vv[i];
                    const float x[8] = {bflo(v.x), bfhi(v.x), bflo(v.y), bfhi(v.y), bflo(v.z), bfhi(v.z), bflo(v.w), bfhi(v.w)};
                    const f32x4 wf0 = *(const LAS f32x4*)(wd + l0), wf1 = *(const LAS f32x4*)(wd + l0 + 4), wb0 = *(const LAS f32x4*)(wd + 128 + l0), wb1 = *(const LAS f32x4*)(wd + 128 + l0 + 4);
                    u32x4 of, ob;
                    of.x = pk2(x[0] * wf0[0], x[1] * wf0[1]); of.y = pk2(x[2] * wf0[2], x[3] * wf0[3]); of.z = pk2(x[4] * wf1[0], x[5] * wf1[1]); of.w = pk2(x[6] * wf1[2], x[7] * wf1[3]);
                    ob.x = pk2(x[0] * wb0[0], x[1] * wb0[1]); ob.y = pk2(x[2] * wb0[2], x[3] * wb0[3]); ob.z = pk2(x[4] * wb1[0], x[5] * wb1[1]); ob.w = pk2(x[6] * wb1[2], x[7] * wb1[3]);
                    *(LAS u32x4*)(XTf + pr * TS + l0) = of; *(LAS u32x4*)(XTb + pr * TS + l0) = ob; }
            }
            if (h8 < 7) S1_PREFETCH(h + 1);
            __syncthreads();
            { const int d = c.wave >> 2, nb = c.wave & 3; const LAS bf16_t* XTd = d ? XTb : XTf;
              bf16_t* st = ST + ((((size_t)(d * 2 + b) * 64 + ch) * 16 + h) * 64) * 128;
#pragma unroll
              for (int pb = 0; pb < 2; ++pb) { f32x16 acc = {};
#pragma unroll
                for (int ks = 0; ks < 8; ++ks) acc = __builtin_amdgcn_mfma_f32_32x32x16_bf16(ldfrag(XTd, pb * 32 + r, ks * 16 + 8 * hh), ldfrag(BTs, nb * 32 + r, ks * 16 + 8 * hh), acc, 0, 0, 0);
#pragma unroll
                for (int i = 0; i < 16; ++i) { const int pp = pb * 32 + (i & 3) + 8 * (i >> 2) + 4 * hh; st[(size_t)pp * 128 + nb * 32 + r] = (bf16_t)f2bf(acc[i]); } } }
        }
#undef S1_PREFETCH
    }
}
__device__ __forceinline__ void phase_ssd_scan(const Params& p, const Ctx& c) {
    unsigned char* ws = p.ws;
    const float* CDEC = (const float*)(ws + WS_CDEC); bf16_t* PREV = (bf16_t*)(ws + WS_PREV);
    for (int idx = c.bid * 512 + c.tid; idx < 131072; idx += c.G * 512) {
        const int n4 = idx & 31, pp = (idx >> 5) & 63, h = (idx >> 11) & 15, b = (idx >> 15) & 1, d = idx >> 16;
        f32x4 run = {0.f, 0.f, 0.f, 0.f};
        const size_t obase = ((size_t)(d * 2 + b) * 64 * 16 + h) * 64 * 128 + (size_t)pp * 128 + n4 * 4;
        const float* cd = CDEC + (d * 2 + b) * 64 * 16 + h;
#pragma unroll 1
        for (int s0 = 0; s0 < 64; s0 += 16) {
            u32x2 sv[16]; float dec[16];
#pragma unroll
            for (int i = 0; i < 16; ++i) { const int ch = d ? 63 - (s0 + i) : s0 + i; sv[i] = *(const u32x2*)(PREV + obase + (size_t)ch * (16 * 64 * 128)); dec[i] = cd[ch * 16]; }
#pragma unroll
            for (int i = 0; i < 16; ++i) { const int ch = d ? 63 - (s0 + i) : s0 + i;
                u32x2 w; w.x = pk2(run.x, run.y); w.y = pk2(run.z, run.w); *(u32x2*)(PREV + obase + (size_t)ch * (16 * 64 * 128)) = w;
                run.x = fmaf(run.x, dec[i], bflo(sv[i].x)); run.y = fmaf(run.y, dec[i], bfhi(sv[i].x)); run.z = fmaf(run.z, dec[i], bflo(sv[i].y)); run.w = fmaf(run.w, dec[i], bfhi(sv[i].y)); }
        }
    }
}
__device__ __forceinline__ void phase_ssd_out(const Params& p, const Ctx& c) {
    unsigned char* ws = p.ws;
    const bf16_t* P = (const bf16_t*)(ws + WS_P); const bf16_t* XT = (const bf16_t*)(ws + WS_XT);
    const bf16_t* BMR = (const bf16_t*)(ws + WS_BMR); const bf16_t* CMR = (const bf16_t*)(ws + WS_CMR); const bf16_t* PREV = (const bf16_t*)(ws + WS_PREV);
    const float* DT = (const float*)(ws + WS_DT); const float* ACS = (const float*)(ws + WS_ACS); bf16_t* YZ = (bf16_t*)(ws + WS_YZ);
    LAS bf16_t* Cs = (LAS bf16_t*)c.lds; LAS bf16_t* Ms = Cs + 128 * TS; LAS bf16_t* XTs = Ms + 128 * TS; LAS bf16_t* PF = XTs + 64 * TS; LAS bf16_t* PB = PF + 64 * TS;
    LAS float* vec = (LAS float*)(PB + 64 * TS);
    constexpr int ZS = 72; LAS bf16_t* Zs = (LAS bf16_t*)(vec + 512); LAS float* dskl = (LAS float*)(Zs + 128 * ZS);
    const int tid = c.tid, lane = c.lane, r = lane & 31, hh = lane >> 5, wave = c.wave;
    for (int unit = c.bid; unit < 256; unit += c.G) {
        const int b = unit >> 7, ch = (unit >> 1) & 63, g = unit & 1;
        const size_t tok0 = (size_t)b * S + ch * 128;
        __syncthreads();
        load_tile128<128>(Cs, CMR + tok0 * 256 + g * 128, 256, tid);
        load_tile128<128>(Ms, BMR + tok0 * 256 + g * 128, 256, tid);
        u32x4 px0, px1, pf0, pf1, pb0, pb1, pz0, pz1; float pvec;
        const int t_r0 = tid >> 4, t_r1 = (tid + 512) >> 4, t_c = (tid & 15) * 8;
#define S3_PREFETCH(H) do { const bf16_t* xt_ = XT + ((size_t)(b * 64 + ch) * 16 + (H)) * 64 * 128; \
            const bf16_t* f_ = PREV + ((((size_t)(0 * 2 + b) * 64 + ch) * 16 + (H)) * 64) * 128; const bf16_t* b_ = PREV + ((((size_t)(1 * 2 + b) * 64 + ch) * 16 + (H)) * 64) * 128; \
            px0 = *(const u32x4*)(xt_ + t_r0 * 128 + t_c); px1 = *(const u32x4*)(xt_ + t_r1 * 128 + t_c); pf0 = *(const u32x4*)(f_ + t_r0 * 128 + t_c); pf1 = *(const u32x4*)(f_ + t_r1 * 128 + t_c); \
            pb0 = *(const u32x4*)(b_ + t_r0 * 128 + t_c); pb1 = *(const u32x4*)(b_ + t_r1 * 128 + t_c); \
            pz0 = *(const u32x4*)(P + (tok0 + (tid >> 3)) * NPROJ + PZ + (H) * 64 + (tid & 7) * 8); pz1 = *(const u32x4*)(P + (tok0 + 64 + (tid >> 3)) * NPROJ + PZ + (H) * 64 + (tid & 7) * 8); \
            { const int v_ = tid >> 7, l_ = tid & 127; const size_t o_ = ((size_t)(v_ & 1) * M + tok0 + l_) * 16 + (H); pvec = (v_ < 2) ? ACS[o_] : DT[o_]; } } while (0)
        S3_PREFETCH(g * 8);
        if (tid < 8) dskl[tid] = p.in[9][g * 8 + tid];
        __syncthreads();
        const int lb = wave & 3, sb0 = 2 * (wave >> 2);
        f32x16 G0 = {}, G1 = {};
#pragma unroll
        for (int ks = 0; ks < 8; ++ks) { const bf16x8 a = ldfrag(Cs, lb * 32 + r, ks * 16 + 8 * hh);
            G0 = __builtin_amdgcn_mfma_f32_32x32x16_bf16(a, ldfrag(Ms, sb0 * 32 + r, ks * 16 + 8 * hh), G0, 0, 0, 0);
            G1 = __builtin_amdgcn_mfma_f32_32x32x16_bf16(a, ldfrag(Ms, (sb0 + 1) * 32 + r, ks * 16 + 8 * hh), G1, 0, 0, 0); }
#pragma unroll 1
        for (int h8 = 0; h8 < 8; ++h8) {
            const int h = g * 8 + h8;
            __syncthreads();
            vec[tid] = pvec;
            *(LAS u32x4*)(XTs + t_r0 * TS + t_c) = px0; *(LAS u32x4*)(XTs + t_r1 * TS + t_c) = px1;
            *(LAS u32x4*)(PF + t_r0 * TS + t_c) = pf0; *(LAS u32x4*)(PF + t_r1 * TS + t_c) = pf1;
            *(LAS u32x4*)(PB + t_r0 * TS + t_c) = pb0; *(LAS u32x4*)(PB + t_r1 * TS + t_c) = pb1;
            *(LAS u32x4*)(Zs + (tid >> 3) * ZS + (tid & 7) * 8) = pz0; *(LAS u32x4*)(Zs + (64 + (tid >> 3)) * ZS + (tid & 7) * 8) = pz1;
            if (h8 < 7) S3_PREFETCH(h + 1);
            const int pbY = wave >> 2;
            __syncthreads();
#pragma unroll
            for (int t2 = 0; t2 < 2; ++t2) { const f32x16& Gt = t2 ? G1 : G0; const int sb = sb0 + t2, s = sb * 32 + r;
                const float afs = vec[s], abs_ = vec[128 + s], dfs = vec[256 + s], dbs = vec[384 + s];
                if (sb < lb) {
#pragma unroll
                    for (int i = 0; i < 16; ++i) { const int l = lb * 32 + (i & 3) + 8 * (i >> 2) + 4 * hh;
                        Ms[l * TS + s] = (bf16_t)f2bf(Gt[i] * __expf(vec[l] - afs) * dfs); }
                } else if (sb > lb) {
#pragma unroll
                    for (int i = 0; i < 16; ++i) { const int l = lb * 32 + (i & 3) + 8 * (i >> 2) + 4 * hh;
                        Ms[l * TS + s] = (bf16_t)f2bf(Gt[i] * __expf(vec[128 + l] - abs_) * dbs); }
                } else {
                    const float dsk = dskl[h8];
#pragma unroll
                    for (int i = 0; i < 16; ++i) { const int l = lb * 32 + (i & 3) + 8 * (i >> 2) + 4 * hh;
                        const float ef = __expf(fminf(vec[l] - afs, 0.f)) * dfs, eb = __expf(fminf(vec[128 + l] - abs_, 0.f)) * dbs;
                        const float tf = (s <= l) ? ef : 0.f, tb = (s >= l) ? eb : 0.f;
                        Ms[l * TS + s] = (bf16_t)f2bf(Gt[i] * (tf + tb) + (s == l ? dsk : 0.f)); }
                } }
            __syncthreads();
            { f32x16 Yd = {}, Yf = {}, Yb = {};
#pragma unroll
              for (int ks = 0; ks < 8; ++ks) { const int k0 = ks * 16 + 8 * hh;
                  Yd = __builtin_amdgcn_mfma_f32_32x32x16_bf16(ldfrag(Ms, lb * 32 + r, k0), ldfrag(XTs, pbY * 32 + r, k0), Yd, 0, 0, 0);
                  const bf16x8 a = ldfrag(Cs, lb * 32 + r, k0);
                  Yf = __builtin_amdgcn_mfma_f32_32x32x16_bf16(a, ldfrag(PF, pbY * 32 + r, k0), Yf, 0, 0, 0);
                  Yb = __builtin_amdgcn_mfma_f32_32x32x16_bf16(a, ldfrag(PB, pbY * 32 + r, k0), Yb, 0, 0, 0);
                  if (ks & 1) __builtin_amdgcn_sched_barrier(0); }
#pragma unroll
              for (int i = 0; i < 16; ++i) { const int l = lb * 32 + (i & 3) + 8 * (i >> 2) + 4 * hh;
                  const float y = Yd[i] + __expf(vec[l]) * Yf[i] + __expf(vec[128 + l]) * Yb[i];
                  const float z = bf2f(Zs[l * ZS + pbY * 32 + r]);
                  Zs[l * ZS + pbY * 32 + r] = (bf16_t)f2bf(y * z * sigmoidf_(z)); } }
            __syncthreads();
            *(u32x4*)(YZ + (tok0 + (tid >> 3)) * 1024 + h * 64 + (tid & 7) * 8) = *(const LAS u32x4*)(Zs + (tid >> 3) * ZS + (tid & 7) * 8);
            *(u32x4*)(YZ + (tok0 + 64 + (tid >> 3)) * 1024 + h * 64 + (tid & 7) * 8) = *(const LAS u32x4*)(Zs + (64 + (tid >> 3)) * ZS + (tid & 7) * 8);
        }
#undef S3_PREFETCH
    }
}

__device__ __forceinline__ void phase_rstd(const Params& p, const Ctx& c) {
    const bf16_t* YZ = (const bf16_t*)(p.ws + WS_YZ); float* RSTD = (float*)(p.ws + WS_RSTD);
    const int gw = c.bid * 8 + c.wave, NGW = c.G * 8;
    for (int m0 = gw * 4; m0 < M; m0 += NGW * 4) {
        u32x4 v[4][2];
#pragma unroll
        for (int q = 0; q < 4; ++q) { const u32x4* r = (const u32x4*)(YZ + (size_t)(m0 + q) * 1024) + c.lane; v[q][0] = r[0]; v[q][1] = r[64]; }
#pragma unroll
        for (int q = 0; q < 4; ++q) { float s = 0.f;
#pragma unroll
            for (int j = 0; j < 2; ++j) { const u32x4 w = v[q][j];
                s += bflo(w.x) * bflo(w.x) + bfhi(w.x) * bfhi(w.x) + bflo(w.y) * bflo(w.y) + bfhi(w.y) * bfhi(w.y) + bflo(w.z) * bflo(w.z) + bfhi(w.z) * bfhi(w.z) + bflo(w.w) * bflo(w.w) + bfhi(w.w) * bfhi(w.w); }
            s = wave_sum(s);
            if (c.lane == 0) RSTD[m0 + q] = rsqrtf(s * (1.f / 1024.f) + EPS); }
    }
}

__device__ __forceinline__ void phase_attn_naive(const Params& p, const Ctx& c) {
    unsigned char* ws = p.ws;
    const bf16_t* QN = (const bf16_t*)(ws + WS_QN); const bf16_t* KN = (const bf16_t*)(ws + WS_KN); const bf16_t* VB = (const bf16_t*)(ws + WS_VB);
    bf16_t* AO = (bf16_t*)(ws + WS_AO);
    LAS bf16_t* Ks = (LAS bf16_t*)c.lds; LAS bf16_t* Vs = Ks + 64 * 128;
    const int tid = c.tid, row = tid >> 2, dq = tid & 3;
    constexpr float C = 0.088388347648318440f * 1.4426950408889634f;
    for (int item = c.bid; item < 1024; item += c.G) {
        const int b = item >> 9, h = (item >> 6) & 7, qb = item & 63, kvh = h >> 2;
        const size_t tokq = (size_t)b * S + qb * 128 + row;
        float q[32], o[32];
#pragma unroll
        for (int i = 0; i < 4; ++i) { const u32x4 v = *(const u32x4*)(QN + tokq * 1024 + h * 128 + dq * 32 + i * 8);
            q[i * 8 + 0] = bflo(v.x) * C; q[i * 8 + 1] = bfhi(v.x) * C; q[i * 8 + 2] = bflo(v.y) * C; q[i * 8 + 3] = bfhi(v.y) * C;
            q[i * 8 + 4] = bflo(v.z) * C; q[i * 8 + 5] = bfhi(v.z) * C; q[i * 8 + 6] = bflo(v.w) * C; q[i * 8 + 7] = bfhi(v.w) * C; }
#pragma unroll
        for (int i = 0; i < 32; ++i) o[i] = 0.f;
        float mrun = -1e30f, lrun = 0.f;
        for (int kt = 0; kt < S / 64; ++kt) {
            __syncthreads();
            {
                const int key = tid >> 3, ch = tid & 7;
                const size_t tk = ((size_t)b * S + kt * 64 + key) * 256 + kvh * 128 + ch * 16;
                *(LAS u32x4*)(Ks + key * 128 + ch * 16) = *(const u32x4*)(KN + tk); *(LAS u32x4*)(Ks + key * 128 + ch * 16 + 8) = *(const u32x4*)(KN + tk + 8);
                *(LAS u32x4*)(Vs + key * 128 + ch * 16) = *(const u32x4*)(VB + tk); *(LAS u32x4*)(Vs + key * 128 + ch * 16 + 8) = *(const u32x4*)(VB + tk + 8);
            }
            __syncthreads();
            for (int j = 0; j < 64; ++j) {
                float s = 0.f;
#pragma unroll
                for (int i = 0; i < 4; ++i) { const u32x4 v = *(const LAS u32x4*)(Ks + j * 128 + dq * 32 + i * 8);
                    s = fmaf(q[i * 8 + 0], bflo(v.x), s); s = fmaf(q[i * 8 + 1], bfhi(v.x), s); s = fmaf(q[i * 8 + 2], bflo(v.y), s); s = fmaf(q[i * 8 + 3], bfhi(v.y), s);
                    s = fmaf(q[i * 8 + 4], bflo(v.z), s); s = fmaf(q[i * 8 + 5], bfhi(v.z), s); s = fmaf(q[i * 8 + 6], bflo(v.w), s); s = fmaf(q[i * 8 + 7], bfhi(v.w), s); }
                s += __shfl_xor(s, 1); s += __shfl_xor(s, 2);
                const float mn = fmaxf(mrun, s), al = __builtin_amdgcn_exp2f(mrun - mn), pe = __builtin_amdgcn_exp2f(s - mn);
                mrun = mn; lrun = lrun * al + pe;
#pragma unroll
                for (int i = 0; i < 4; ++i) { const u32x4 v = *(const LAS u32x4*)(Vs + j * 128 + dq * 32 + i * 8);
                    o[i * 8 + 0] = fmaf(pe, bflo(v.x), o[i * 8 + 0] * al); o[i * 8 + 1] = fmaf(pe, bfhi(v.x), o[i * 8 + 1] * al);
                    o[i * 8 + 2] = fmaf(pe, bflo(v.y), o[i * 8 + 2] * al); o[i * 8 + 3] = fmaf(pe, bfhi(v.y), o[i * 8 + 3] * al);
                    o[i * 8 + 4] = fmaf(pe, bflo(v.z), o[i * 8 + 4] * al); o[i * 8 + 5] = fmaf(pe, bfhi(v.z), o[i * 8 + 5] * al);
                    o[i * 8 + 6] = fmaf(pe, bflo(v.w), o[i * 8 + 6] * al); o[i * 8 + 7] = fmaf(pe, bfhi(v.w), o[i * 8 + 7] * al); }
            }
        }
        const float rl = 1.f / lrun;
#pragma unroll
        for (int i = 0; i < 4; ++i) { u32x4 w;
            w.x = pk2(o[i * 8 + 0] * rl, o[i * 8 + 1] * rl); w.y = pk2(o[i * 8 + 2] * rl, o[i * 8 + 3] * rl); w.z = pk2(o[i * 8 + 4] * rl, o[i * 8 + 5] * rl); w.w = pk2(o[i * 8 + 6] * rl, o[i * 8 + 7] * rl);
            *(u32x4*)(AO + tokq * 1024 + h * 128 + dq * 32 + i * 8) = w; }
    }
}

namespace attn {
typedef unsigned short bf16;
constexpr int   D = 128, NW = 8, QBLK = 32, KVBLK = 64;
constexpr float SCALE = 0.088388347648318440f;
constexpr float THR = 8.f;
constexpr int SDEPTH = 2;
constexpr int LDQ = 1024, LDK = 256, LDO = 1024;
constexpr size_t SHM_V = KVBLK * D * 2, SHM_K = KVBLK * D * 2, SHM_ATTN = 2 * SHM_V + 2 * SHM_K + NW * 64 * 4;
using bf16x8 = __attribute__((ext_vector_type(8))) short;
using s16x4  = __attribute__((ext_vector_type(4))) short;
using f32x16 = __attribute__((ext_vector_type(16))) float;
using f32x8  = __attribute__((ext_vector_type(8))) float;
using u32x4  = __attribute__((ext_vector_type(4))) unsigned;
#define KSWZ(row, colB) ((row) * 256 + ((colB) ^ (((row) & 7) << 4)))
#define SBAR() __builtin_amdgcn_sched_barrier(0)
__device__ __forceinline__ int crow(int r, int hi) { return (r & 3) + 8 * (r >> 2) + 4 * hi; }
__device__ __forceinline__ unsigned cvtpk(float lo, float hi) {
  unsigned r; asm volatile("v_cvt_pk_bf16_f32 %0, %1, %2" : "=v"(r) : "v"(lo), "v"(hi)); return r;
}
template <typename TIn> struct Stage;
template <> struct Stage<bf16>  { using T = bf16x8;
  __device__ static __forceinline__ T ld8(const bf16* p) { return *reinterpret_cast<const bf16x8*>(p); }
  __device__ static __forceinline__ bf16x8 tobf(T x) { return x; } };
template <> struct Stage<float> { using T = f32x8;
  __device__ static __forceinline__ T ld8(const float* p) { return *reinterpret_cast<const f32x8*>(p); }
  __device__ static __forceinline__ bf16x8 tobf(T x) {
    u32x4 w = {cvtpk(x[0], x[1]), cvtpk(x[2], x[3]), cvtpk(x[4], x[5]), cvtpk(x[6], x[7])}; return *reinterpret_cast<bf16x8*>(&w); } };

__device__ __forceinline__ void partialSM(f32x16& p0, f32x16& p1, float& m_reg, float& mn, float& alpha) {
  constexpr float C = SCALE * 1.4426950408889634f;
  float pmax = p0[0]; for (int r = 1; r < 16; ++r) pmax = fmaxf(pmax, p0[r]); for (int r = 0; r < 16; ++r) pmax = fmaxf(pmax, p1[r]);
  { auto rr = __builtin_amdgcn_permlane32_swap(__float_as_uint(pmax), __float_as_uint(pmax), false, false);
    pmax = fmaxf(__uint_as_float(rr[0]), __uint_as_float(rr[1])); }
  if (__builtin_expect(__all(pmax - m_reg <= THR / SCALE), 1)) { mn = m_reg; alpha = 1.f; }
  else { mn = fmaxf(m_reg, pmax); alpha = __builtin_amdgcn_exp2f((m_reg - mn) * C); m_reg = mn; }
  float mnC = -mn * C;
  for (int r = 0; r < 16; ++r) p0[r] = fmaf(p0[r], C, mnC); for (int r = 0; r < 16; ++r) p1[r] = fmaf(p1[r], C, mnC);
  for (int r = 0; r < 16; ++r) p0[r] = __builtin_amdgcn_exp2f(p0[r]);
}
__device__ __forceinline__ void finishSM(f32x16& p0, f32x16& p1, float alpha, float& l_reg, bf16x8& pa0, bf16x8& pa1, bf16x8& pa2, bf16x8& pa3) {
  for (int r = 0; r < 16; ++r) p1[r] = __builtin_amdgcn_exp2f(p1[r]);
  float ps = 0; for (int r = 0; r < 16; ++r) ps += p0[r]; for (int r = 0; r < 16; ++r) ps += p1[r];
  { auto rr = __builtin_amdgcn_permlane32_swap(__float_as_uint(ps), __float_as_uint(ps), false, false);
    ps = __uint_as_float(rr[0]) + __uint_as_float(rr[1]); }
  l_reg = l_reg * alpha + ps;
#define PK4(P, BASE, OUT) do { unsigned a0 = cvtpk(P[BASE + 0], P[BASE + 1]), a1 = cvtpk(P[BASE + 2], P[BASE + 3]);   \
    unsigned b0 = cvtpk(P[BASE + 4], P[BASE + 5]), b1 = cvtpk(P[BASE + 6], P[BASE + 7]);                              \
    auto r0 = __builtin_amdgcn_permlane32_swap(a0, b0, false, false); auto r1 = __builtin_amdgcn_permlane32_swap(a1, b1, false, false); \
    u32x4 w = {r0[0], r1[0], r0[1], r1[1]}; OUT = *reinterpret_cast<bf16x8*>(&w); } while (0)
  PK4(p0, 0, pa0); PK4(p0, 8, pa1); PK4(p1, 0, pa2); PK4(p1, 8, pa3);
#undef PK4
}
__device__ __forceinline__ void qkt(f32x16& p0, f32x16& p1, const bf16* Ks, const bf16x8* qr, int r32, int hi) {
  p0 = f32x16{}; p1 = f32x16{};
  for (int d0 = 0; d0 < 8; ++d0) { int cb = (d0 * 16 + hi * 8) * 2;
    bf16x8 b0 = *reinterpret_cast<const bf16x8*>((const char*)Ks + KSWZ(r32, cb));
    bf16x8 b1 = *reinterpret_cast<const bf16x8*>((const char*)Ks + KSWZ(32 + r32, cb));
    p0 = __builtin_amdgcn_mfma_f32_32x32x16_bf16(b0, qr[d0], p0, 0, 0, 0);
    p1 = __builtin_amdgcn_mfma_f32_32x32x16_bf16(b1, qr[d0], p1, 0, 0, 0); }
}
__device__ __forceinline__ int v_st(int k, int c) { const int kk = (k & ~0xC) | ((k & 4) << 1) | ((k & 8) >> 1); return ((kk >> 3) * 4 + (c >> 5)) * 512 + ((kk & 7) * 32 + (c & 31)) * 2; }
__device__ __forceinline__ int v_rd_base(int lane) { return ((lane & 3) << 3) | (((lane >> 2) & 3) << 6) | (((lane >> 4) & 1) << 5) | (((lane >> 5) & 1) << 8); }
constexpr int v_rd_off(int d0, int ks, int half) { return d0 * 512 + ks * 4096 + half * 2048; }
template <int OFF> __device__ __forceinline__ s16x4 tr_read(int vb) {
  s16x4 r; asm volatile("ds_read_b64_tr_b16 %0, %1 offset:%2" : "=&v"(r) : "v"(vb), "i"(OFF) : "memory"); return r;
}
template <int D0> __device__ __forceinline__ void pv_one(f32x16& od, int vb, bf16x8 pa0, bf16x8 pa1, bf16x8 pa2, bf16x8 pa3) {
  const s16x4 l0 = tr_read<v_rd_off(D0, 0, 0)>(vb), h0 = tr_read<v_rd_off(D0, 0, 1)>(vb), l1 = tr_read<v_rd_off(D0, 1, 0)>(vb), h1 = tr_read<v_rd_off(D0, 1, 1)>(vb);
  const s16x4 l2 = tr_read<v_rd_off(D0, 2, 0)>(vb), h2 = tr_read<v_rd_off(D0, 2, 1)>(vb), l3 = tr_read<v_rd_off(D0, 3, 0)>(vb), h3 = tr_read<v_rd_off(D0, 3, 1)>(vb);
  asm volatile("s_waitcnt lgkmcnt(0)" ::: "memory"); SBAR();
#define PK(L, H) (bf16x8){L[0], L[1], L[2], L[3], H[0], H[1], H[2], H[3]}
  od = __builtin_amdgcn_mfma_f32_32x32x16_bf16(pa0, PK(l0, h0), od, 0, 0, 0);
  od = __builtin_amdgcn_mfma_f32_32x32x16_bf16(pa1, PK(l1, h1), od, 0, 0, 0);
  od = __builtin_amdgcn_mfma_f32_32x32x16_bf16(pa2, PK(l2, h2), od, 0, 0, 0);
  od = __builtin_amdgcn_mfma_f32_32x32x16_bf16(pa3, PK(l3, h3), od, 0, 0, 0);
#undef PK
}
__device__ __forceinline__ void pv_d0(f32x16* o, int vb, bf16x8 pa0, bf16x8 pa1, bf16x8 pa2, bf16x8 pa3) {
  pv_one<0>(o[0], vb, pa0, pa1, pa2, pa3); pv_one<1>(o[1], vb, pa0, pa1, pa2, pa3); pv_one<2>(o[2], vb, pa0, pa1, pa2, pa3); pv_one<3>(o[3], vb, pa0, pa1, pa2, pa3);
}

template <typename TQ>
__device__ __forceinline__ void attn_dense_body(const TQ* __restrict__ Qb, const bf16* __restrict__ Kh, const bf16* __restrict__ Vh,
                                                bf16* __restrict__ Ob, int seq, char* lds) {
  using St = Stage<bf16>; using SQ = Stage<TQ>;
  const int tid = threadIdx.x, wid = tid >> 6, lane = tid & 63, r32 = lane & 31, hi = lane >> 5;
  bf16* V_lds = (bf16*)lds; bf16* K_lds = (bf16*)(lds + 2 * SHM_V);
  float* ws = (float*)(lds + 2 * SHM_V + 2 * SHM_K) + wid * 64; float* li_l = ws; float* al_l = ws + 32;
  float m_reg = -1e30f, l_reg = 0; f32x16 o[4] = {}; bf16x8 qr[8];
  const TQ* Qw = Qb + (long)(wid * QBLK + r32) * LDQ + hi * 8;
#pragma unroll
  for (int d0 = 0; d0 < 8; ++d0) qr[d0] = SQ::tobf(SQ::ld8(Qw + d0 * 16));
  const int sr = tid >> 4, sc = (tid & 15) * 8, vst0 = v_st(sr, sc), vst1 = v_st(32 + sr, sc);
  const int vb0 = (int)(uintptr_t)V_lds + v_rd_base(lane);
  struct { typename St::T vs0, vs1, ks0, ks1; } sr_[SDEPTH];
#define SLOAD(i, k0) do { sr_[i].vs0 = St::ld8(&Vh[(long)((k0) + sr) * LDK + sc]); sr_[i].vs1 = St::ld8(&Vh[(long)((k0) + 32 + sr) * LDK + sc]); \
    sr_[i].ks0 = St::ld8(&Kh[(long)((k0) + sr) * LDK + sc]); sr_[i].ks1 = St::ld8(&Kh[(long)((k0) + 32 + sr) * LDK + sc]); } while (0)
#define SWRITE(b, i) do { *(bf16x8*)((char*)V_lds + (b) * SHM_V + vst0) = St::tobf(sr_[i].vs0);          \
    *(bf16x8*)((char*)V_lds + (b) * SHM_V + vst1) = St::tobf(sr_[i].vs1); int kc = sc * 2;               \
    *(bf16x8*)((char*)K_lds + (b) * SHM_K + KSWZ(sr, kc)) = St::tobf(sr_[i].ks0);                       \
    *(bf16x8*)((char*)K_lds + (b) * SHM_K + KSWZ(32 + sr, kc)) = St::tobf(sr_[i].ks1); } while (0)
#define SWAIT() do { if constexpr (SDEPTH == 2) asm volatile("s_waitcnt vmcnt(4)" ::: "memory"); else asm volatile("s_waitcnt vmcnt(0)" ::: "memory"); } while (0)
#define RESC(a) do { if (__any((a) < 1.f)) { if (hi == 0) al_l[r32] = (a); asm volatile("s_waitcnt lgkmcnt(0)" ::: "memory"); \
    for (int d = 0; d < 4; ++d) for (int r = 0; r < 16; ++r) o[d][r] *= al_l[crow(r, hi)]; } } while (0)
  f32x16 pA0, pA1, pB0, pB1; float mnA, mnB, alA, alB; bf16x8 pa0, pa1, pa2, pa3; const int NT = seq / KVBLK;
  constexpr int SE = 0, SO = SDEPTH - 1;
  SLOAD(SE, 0); asm volatile("s_waitcnt vmcnt(0)" ::: "memory"); SWRITE(0, SE); __syncthreads();
  qkt(pA0, pA1, K_lds, qr, r32, hi); partialSM(pA0, pA1, m_reg, mnA, alA);
  SLOAD(SO, KVBLK); if constexpr (SDEPTH == 2) { if (2 < NT) SLOAD(SE, 2 * KVBLK); }
  SWAIT(); SWRITE(1, SO); __syncthreads();
  for (int j = 1; j + 1 < NT; j += 2) {
    SBAR(); qkt(pB0, pB1, (bf16*)((char*)K_lds + SHM_K), qr, r32, hi);
    finishSM(pA0, pA1, alA, l_reg, pa0, pa1, pa2, pa3); SBAR();
    SLOAD(SO, (j + SDEPTH) * KVBLK); SBAR();
    pv_d0(o, vb0, pa0, pa1, pa2, pa3); partialSM(pB0, pB1, m_reg, mnB, alB);
    __syncthreads(); SWAIT(); SWRITE(0, SE);
    RESC(alB); __syncthreads();
    SBAR(); qkt(pA0, pA1, K_lds, qr, r32, hi);
    finishSM(pB0, pB1, alB, l_reg, pa0, pa1, pa2, pa3); SBAR();
    if (SDEPTH == 1 || j + 3 < NT) SLOAD(SE, (j + 1 + SDEPTH) * KVBLK); SBAR();
    pv_d0(o, vb0 + (int)SHM_V, pa0, pa1, pa2, pa3); partialSM(pA0, pA1, m_reg, mnA, alA);
    __syncthreads(); SWAIT(); SWRITE(1, SO);
    RESC(alA); __syncthreads();
  }
  SBAR(); qkt(pB0, pB1, (bf16*)((char*)K_lds + SHM_K), qr, r32, hi);
  finishSM(pA0, pA1, alA, l_reg, pa0, pa1, pa2, pa3); SBAR();
  pv_d0(o, vb0, pa0, pa1, pa2, pa3); partialSM(pB0, pB1, m_reg, mnB, alB);
  __syncthreads(); RESC(alB);
  finishSM(pB0, pB1, alB, l_reg, pa0, pa1, pa2, pa3); SBAR();
  pv_d0(o, vb0 + (int)SHM_V, pa0, pa1, pa2, pa3);
  if (hi == 0) li_l[r32] = l_reg; asm volatile("s_waitcnt lgkmcnt(0)" ::: "memory");
  float rli[16];
#pragma unroll
  for (int r = 0; r < 16; ++r) rli[r] = __builtin_amdgcn_rcpf(li_l[crow(r, hi)]);
  bf16* Ow = Ob + (long)(wid * QBLK) * LDO;
#pragma unroll
  for (int r = 0; r < 16; ++r) { int orow = crow(r, hi);
    for (int d0 = 0; d0 < 4; ++d0) Ow[(long)orow * LDO + d0 * 32 + r32] = (bf16)f2bf(o[d0][r] * rli[r]); }
#undef SLOAD
#undef SWRITE
#undef SWAIT
#undef RESC
}
}

__device__ __forceinline__ void phase_attn(const Params& p, const Ctx& c, char* lds_generic) {
    unsigned char* ws = p.ws;
    const bf16_t* QN = (const bf16_t*)(ws + WS_QN); const bf16_t* KN = (const bf16_t*)(ws + WS_KN); const bf16_t* VB = (const bf16_t*)(ws + WS_VB); bf16_t* AO = (bf16_t*)(ws + WS_AO);
    for (int item = c.bid; item < 512; item += c.G) {
        const int b = item >> 8, h = (item >> 5) & 7, qb = item & 31, kvh = h >> 2;
        const size_t q0 = ((size_t)b * S + qb * 256) * 1024 + h * 128, k0 = (size_t)b * S * 256 + kvh * 128;
        attn::attn_dense_body<attn::bf16>(QN + q0, KN + k0, VB + k0, AO + q0, S, lds_generic);
        __syncthreads();
    }
}

struct EpiT1 { bf16_t* T1; const bf16_t* P; const float* RSTD; int n0;
    __device__ __forceinline__ void operator()(int r, int cl, float a, float) const { const int col = n0 + cl;
        T1[(size_t)r * 1024 + col] = (bf16_t)f2bf(a * RSTD[r] * sigmoidf_(bf2f(P[(size_t)r * NPROJ + PG + col]))); } };
struct EpiT2 { bf16_t* MG; const bf16_t* T1; const bf16_t* P; int n0;
    __device__ __forceinline__ void operator()(int r, int cl, float a, float) const { const int col = n0 + cl;
        MG[(size_t)r * 1024 + col] = (bf16_t)f2bf(bf2f(T1[(size_t)r * 1024 + col]) + a * sigmoidf_(bf2f(P[(size_t)r * NPROJ + PG + 1024 + col]))); } };
struct EpiT3 { float* X1; const float* x; int n0;
    __device__ __forceinline__ void operator()(int r, int cl, float a, float) const { const size_t o = (size_t)r * 1024 + n0 + cl; X1[o] = x[o] + a; } };
template <int WHICH> __device__ __forceinline__ void phase_tail_naive(const Params& p, const Ctx& c) {
    unsigned char* ws = p.ws;
    for (int it = c.bid; it < (M / 128) * 16; it += c.G) {
        const int mt = it >> 4, nt = it & 15;
        if (WHICH == 0) ngemm_tile<false>(ARowPlain{(const bf16_t*)(ws + WS_YZ), 1024}, (const bf16_t*)(ws + WS_WST) + (size_t)nt * 64 * 1024, nullptr, 1024, mt * 128,
                                          EpiT1{(bf16_t*)(ws + WS_T1), (const bf16_t*)(ws + WS_P), (const float*)(ws + WS_RSTD), nt * 64}, (LAS float*)c.lds, c.tid);
        if (WHICH == 1) ngemm_tile<false>(ARowPlain{(const bf16_t*)(ws + WS_AO), 1024}, (const bf16_t*)(ws + WS_WAT) + (size_t)nt * 64 * 1024, nullptr, 1024, mt * 128,
                                          EpiT2{(bf16_t*)(ws + WS_MG), (const bf16_t*)(ws + WS_T1), (const bf16_t*)(ws + WS_P), nt * 64}, (LAS float*)c.lds, c.tid);
        if (WHICH == 2) ngemm_tile<false>(ARowPlain{(const bf16_t*)(ws + WS_MG), 1024}, (const bf16_t*)(ws + WS_WOT) + (size_t)nt * 64 * 1024, nullptr, 1024, mt * 128,
                                          EpiT3{(float*)(ws + WS_X1), p.in[0], nt * 64}, (LAS float*)c.lds, c.tid);
    }
}

__device__ __forceinline__ void phase_router(const Params& p, const Ctx& c) {
    unsigned char* ws = p.ws;
    LAS float* wT = (LAS float*)c.lds;
    LAS int* tokE = (LAS int*)(c.lds + LDS_CTL + 512);
    LAS float* tokW = (LAS float*)(c.lds + LDS_CTL + 512 + 1024);
    LAS int* lcnt = (LAS int*)(c.lds + LDS_CTL + 512 + 2048);
    LAS int* lbase = lcnt + 32;
    LAS int* lrank = lbase + 32;
    const float* X1 = (const float*)(ws + WS_X1); unsigned char* H2 = ws + WS_H2;
    int* CNT = (int*)(ws + WS_CTL); int* TOKES = (int*)(ws + WS_TOKES); float* TOKW = (float*)(ws + WS_TOKW); int* LIST = (int*)(ws + WS_LIST);
    const int tid = c.tid, lane = c.lane;
    __syncthreads();
    { const f32x4* src = (const f32x4*)(ws + WS_WRT); for (int idx = tid; idx < 8192; idx += 512) ((LAS f32x4*)wT)[idx] = src[idx]; }
    __syncthreads();
    f32x4 gv[4];
#pragma unroll
    for (int j = 0; j < 4; ++j) gv[j] = ((const f32x4*)p.in[16])[lane + 64 * j];
    const float bias_e = p.in[18][(lane >> 1) & 31];
    for (int blk = c.bid; blk < M / 64; blk += c.G) {
        if (tid < 32) lcnt[tid] = 0;
        for (int pr = 0; pr < 4; ++pr) {
            const int tl = c.wave * 8 + pr * 2;
            const size_t tokA = (size_t)blk * 64 + tl;
            f32x4 hA[4], hB[4];
            {
                const f32x4* xa = (const f32x4*)(X1 + tokA * 1024) + lane; const f32x4* xb = xa + 256;
                float sa = 0.f, sb = 0.f;
#pragma unroll
                for (int j = 0; j < 4; ++j) { hA[j] = xa[64 * j]; hB[j] = xb[64 * j];
                    sa += (hA[j].x * hA[j].x + hA[j].y * hA[j].y) + (hA[j].z * hA[j].z + hA[j].w * hA[j].w);
                    sb += (hB[j].x * hB[j].x + hB[j].y * hB[j].y) + (hB[j].z * hB[j].z + hB[j].w * hB[j].w); }
                const float ra = rsqrtf(wave_sum(sa) * (1.f / 1024.f) + EPS), rb = rsqrtf(wave_sum(sb) * (1.f / 1024.f) + EPS);
                unsigned* oa = (unsigned*)(H2 + tokA * 1024) + lane; unsigned* ob = oa + 256;
#pragma unroll
                for (int j = 0; j < 4; ++j) { hA[j] = hA[j] * ra * gv[j]; hB[j] = hB[j] * rb * gv[j];
                    oa[64 * j] = pack4_fp8(8.f * hA[j].x, 8.f * hA[j].y, 8.f * hA[j].z, 8.f * hA[j].w);
                    ob[64 * j] = pack4_fp8(8.f * hB[j].x, 8.f * hB[j].y, 8.f * hB[j].z, 8.f * hB[j].w); }
            }
            float accA[32], accB[32];
#pragma unroll
            for (int e = 0; e < 32; ++e) {
                float a = 0.f, b = 0.f;
#pragma unroll
                for (int j = 0; j < 4; ++j) { const f32x4 w = *(const LAS f32x4*)&wT[e * 1024 + 256 * j + 4 * lane];
                    a = fmaf(hA[j].x, w.x, a); a = fmaf(hA[j].y, w.y, a); a = fmaf(hA[j].z, w.z, a); a = fmaf(hA[j].w, w.w, a);
                    b = fmaf(hB[j].x, w.x, b); b = fmaf(hB[j].y, w.y, b); b = fmaf(hB[j].z, w.z, b); b = fmaf(hB[j].w, w.w, b); }
                accA[e] = a; accB[e] = b;
                if (e & 1) __builtin_amdgcn_sched_barrier(0);
            }
#define RSTEP(N, BIT) _Pragma("unroll") for (int i = 0; i < N; ++i) { const bool up = (lane & BIT) != 0; \
                const float ka = up ? accA[N + i] : accA[i], sa_ = up ? accA[i] : accA[N + i]; accA[i] = ka + __shfl_xor(sa_, BIT); \
                const float kb = up ? accB[N + i] : accB[i], sb_ = up ? accB[i] : accB[N + i]; accB[i] = kb + __shfl_xor(sb_, BIT); }
            RSTEP(16, 32) RSTEP(8, 16) RSTEP(4, 8) RSTEP(2, 4) RSTEP(1, 2)
#undef RSTEP
            const float la = accA[0] + __shfl_xor(accA[0], 1) + bias_e, lb = accB[0] + __shfl_xor(accB[0], 1) + bias_e;
            const int my_e = (lane >> 1) & 31;
#pragma unroll
            for (int t2 = 0; t2 < 2; ++t2) {
                float val = t2 ? lb : la;
                int se[4]; float sv[4];
#pragma unroll
                for (int k = 0; k < 4; ++k) {
                    const float mx = wave_max(val);
                    const int sel = wave_min_i(val == mx ? my_e : 64);
                    se[k] = sel; sv[k] = mx;
                    if (my_e == sel) val = -INFINITY;
                }
                const float e1 = __expf(sv[1] - sv[0]), e2 = __expf(sv[2] - sv[0]), e3 = __expf(sv[3] - sv[0]);
                const float inv = 1.f / (1.f + e1 + e2 + e3);
                if (lane == 0) {
                    const int t = tl + t2;
                    tokE[t * 4 + 0] = se[0]; tokE[t * 4 + 1] = se[1]; tokE[t * 4 + 2] = se[2]; tokE[t * 4 + 3] = se[3];
                    tokW[t * 4 + 0] = inv; tokW[t * 4 + 1] = e1 * inv; tokW[t * 4 + 2] = e2 * inv; tokW[t * 4 + 3] = e3 * inv;
                }
            }
        }
        __syncthreads();
        if (tid < 256) lrank[tid] = atomicAdd((int*)&lcnt[tokE[tid]], 1);
        __syncthreads();
        if (tid < 32) lbase[tid] = lcnt[tid] ? atomicAdd(&CNT[tid], lcnt[tid]) : 0;
        __syncthreads();
        if (tid < 256) {
            const int e = tokE[tid], slot = lbase[e] + lrank[tid], tok = blk * 64 + (tid >> 2);
            LIST[e * 16384 + slot] = tok; TOKES[tok * 4 + (tid & 3)] = (e << 16) | slot; TOKW[tok * 4 + (tid & 3)] = tokW[tid];
        }
        __syncthreads();
    }
}

__device__ __forceinline__ void load_offs(const Params& p, const Ctx& c, LAS int*& offs, LAS int*& cnt) {
    offs = (LAS int*)(c.lds + LDS_CTL); cnt = offs + 40;
    __syncthreads();
    if (c.tid == 0) {
        const int* CNT = (const int*)(p.ws + WS_CTL); int run = 0;
        for (int e = 0; e < 32; ++e) { const int n = __hip_atomic_load(CNT + e, __ATOMIC_RELAXED, __HIP_MEMORY_SCOPE_AGENT); cnt[e] = n; offs[e] = run; run += (n + 255) & ~255; }
        offs[32] = run;
    }
    __syncthreads();
}
__device__ __forceinline__ int find_expert(const LAS int* offs, int row) { int e = 0; while (e < 31 && row >= offs[e + 1]) ++e; return e; }

__device__ __forceinline__ void phase_gather(const Params& p, const Ctx& c) {
    LAS int* offs; LAS int* cnt; load_offs(p, c, offs, cnt);
    const bf16_t* H2 = (const bf16_t*)(p.ws + WS_H2); bf16_t* XB = (bf16_t*)(p.ws + WS_XB); const int* LIST = (const int*)(p.ws + WS_LIST);
    const int gw = c.bid * 8 + c.wave, NGW = c.G * 8, total = offs[32];
    for (int row0 = gw * 4; row0 < total; row0 += NGW * 4) {
        const int e = find_expert(offs, row0), slot0 = row0 - offs[e], n = cnt[e];
        int tok[4];
#pragma unroll
        for (int q = 0; q < 4; ++q) tok[q] = (slot0 + q < n) ? LIST[e * 16384 + slot0 + q] : -1;
        u32x4 v[4][2];
#pragma unroll
        for (int q = 0; q < 4; ++q) { v[q][0] = (u32x4){0u, 0u, 0u, 0u}; v[q][1] = v[q][0];
            if (tok[q] >= 0) { const u32x4* s = (const u32x4*)(H2 + (size_t)tok[q] * 1024); v[q][0] = s[c.lane]; v[q][1] = s[c.lane + 64]; } }
#pragma unroll
        for (int q = 0; q < 4; ++q) { u32x4* d = (u32x4*)(XB + (size_t)(row0 + q) * 1024); d[c.lane] = v[q][0]; d[c.lane + 64] = v[q][1]; }
    }
}

struct EpiAct { bf16_t* ACT; const float* b1; int j0;
    __device__ __forceinline__ void operator()(int r, int cl, float g, float u) const { const int j = j0 + cl;
        g = fminf(g + b1[j], 7.f); u = fminf(fmaxf(u + b1[1024 + j], -7.f), 7.f);
        ACT[(size_t)r * 1024 + j] = (bf16_t)f2bf(g * sigmoidf_(1.702f * g) * (u + 1.f)); } };
struct EpiY { bf16_t* YB; const float* b2; int n0;
    __device__ __forceinline__ void operator()(int r, int cl, float a, float) const { const int col = n0 + cl; YB[(size_t)r * 1024 + col] = (bf16_t)f2bf(a + b2[col]); } };
template <int WHICH> __device__ __forceinline__ void phase_moe_naive(const Params& p, const Ctx& c) {
    LAS int* offs; LAS int* cnt; load_offs(p, c, offs, cnt);
    unsigned char* ws = p.ws;
    const int nrt = offs[32] / 128;
    for (int it = c.bid; it < nrt * 16; it += c.G) {
        const int rt = it >> 4, ct = it & 15, row0 = rt * 128, e = find_expert(offs, row0);
        if (WHICH == 0) {
            const int j0 = ct * 64, nt = j0 >> 7, jj = j0 & 127;
            const bf16_t* Wg = (const bf16_t*)(ws + WS_W1T) + ((size_t)e * 2048 + nt * 256 + jj) * 1024;
            ngemm_tile<true>(ARowPlain{(const bf16_t*)(ws + WS_XB), 1024}, Wg, Wg + (size_t)128 * 1024, 1024, row0,
                             EpiAct{(bf16_t*)(ws + WS_ACT), p.in[20] + (size_t)e * 2048, j0}, (LAS float*)c.lds, c.tid);
        } else {
            const bf16_t* W = (const bf16_t*)(ws + WS_W2T) + ((size_t)e * 1024 + ct * 64) * 1024;
            ngemm_tile<false>(ARowPlain{(const bf16_t*)(ws + WS_ACT), 1024}, W, nullptr, 1024, row0,
                              EpiY{(bf16_t*)(ws + WS_YB), p.in[22] + (size_t)e * 1024, ct * 64}, (LAS float*)c.lds, c.tid);
        }
    }
}


__device__ __forceinline__ void phase_gemm1(const Params& p, const Ctx& c) {
    pg8::Gemm g{(const bf16_t*)(p.ws + WS_H), (const bf16_t*)(p.ws + WS_WINT), M, NPROJ, 1024};
    pg8::StaticOrder S; S.init(M, NPROJ, c.G, c.bid);
    pg8::EpiStore E{(bf16_t*)(p.ws + WS_P), NPROJ};
    pg8::gemm_phase<pg8::EpiStore, pg8::StaticOrder, true, true>(c.lds, g, S, E);
}
__device__ __forceinline__ void phase_tail12(const Params& p, const Ctx& c) {
    unsigned char* ws = p.ws;
    pg8::TailOrder S; S.so.init(M, 1024, c.G, c.bid);
    pg8::Gemm g{(const bf16_t*)(ws + WS_YZ), (const bf16_t*)(ws + WS_WST), 2 * M, 2048, 1024};
    pg8::EpiT12 E{(bf16_t*)(ws + WS_T1), (bf16_t*)(ws + WS_MG), (const bf16_t*)(ws + WS_P) + PG, NPROJ, (const float*)(ws + WS_RSTD)};
    pg8::gemm_phase<pg8::EpiT12, pg8::TailOrder, true, true>(c.lds, g, S, E);
}
__device__ __forceinline__ void phase_tail3(const Params& p, const Ctx& c) {
    unsigned char* ws = p.ws;
    pg8::StaticOrder S; S.init(M, 1024, c.G, c.bid);
    pg8::Gemm g{(const bf16_t*)(ws + WS_MG), (const bf16_t*)(ws + WS_WOT), M, 1024, 1024};
    pg8::EpiT3b E{(float*)(ws + WS_X1), p.in[0]};
    pg8::gemm_phase<pg8::EpiT3b, pg8::StaticOrder, true, true>(c.lds, g, S, E);
}
__device__ __forceinline__ void phase_moe1(const Params& p, const Ctx& c) {
    LAS int* offs; LAS int* cnt; load_offs(p, c, offs, cnt);
    unsigned char* ws = p.ws;
    pg8::Gemm g{(const bf16_t*)(ws + WS_H2), (const bf16_t*)(ws + WS_W1T), M, 32 * 2048, 512};
    pg8::MoeGatherOrder S{offs, cnt, (const int*)(ws + WS_LIST), 8, c.G, c.bid, offs[32] / 256};
    pg8::EpiAct8 E{(unsigned char*)(ws + WS_ACT), p.in[20]};
    pg8::gemm_phase_gather_f8<pg8::EpiAct8, pg8::MoeGatherOrder>(c.lds, g, S, E);
}
__device__ __forceinline__ void phase_moe2(const Params& p, const Ctx& c) {
    LAS int* offs; LAS int* cnt; load_offs(p, c, offs, cnt);
    unsigned char* ws = p.ws;
    pg8::Gemm g{(const bf16_t*)(ws + WS_ACT), (const bf16_t*)(ws + WS_W2T), ROWS_MAX, 32 * 1024, 512};
    pg8::MoeOrder S{offs, 4, c.G, c.bid, offs[32] / 256};
    pg8::EpiY8 E{(bf16_t*)(ws + WS_YB), p.in[22]};
    pg8::gemm_phase_f8<pg8::EpiY8, pg8::MoeOrder, true, true>(c.lds, g, S, E);
}

__device__ __forceinline__ void phase_combine(const Params& p, const Ctx& c) {
    LAS int* offs; LAS int* cnt; load_offs(p, c, offs, cnt);
    unsigned char* ws = p.ws;
    const float* X1 = (const float*)(ws + WS_X1); const bf16_t* YB = (const bf16_t*)(ws + WS_YB);
    const int* TOKES = (const int*)(ws + WS_TOKES); const float* TOKW = (const float*)(ws + WS_TOKW);
    const int gw = c.bid * 8 + c.wave, NGW = c.G * 8, lane = c.lane;
    f32x4 gv[4];
#pragma unroll
    for (int j = 0; j < 4; ++j) gv[j] = ((const f32x4*)p.in[23])[lane + 64 * j];
    for (int m0 = gw * 2; m0 < M; m0 += NGW * 2) {
        int es[2][4]; float wq[2][4];
#pragma unroll
        for (int t = 0; t < 2; ++t)
#pragma unroll
            for (int k = 0; k < 4; ++k) { es[t][k] = TOKES[(m0 + t) * 4 + k]; wq[t][k] = TOKW[(m0 + t) * 4 + k]; }
        f32x4 v[2][4]; u32x2 y[2][4][4];
#pragma unroll
        for (int t = 0; t < 2; ++t) { const f32x4* xr = (const f32x4*)(X1 + (size_t)(m0 + t) * 1024) + lane;
#pragma unroll
            for (int j = 0; j < 4; ++j) v[t][j] = xr[64 * j];
#pragma unroll
            for (int k = 0; k < 4; ++k) { const int row = offs[es[t][k] >> 16] + (es[t][k] & 0xffff); const u32x2* yr = (const u32x2*)(YB + (size_t)row * 1024) + lane;
#pragma unroll
                for (int j = 0; j < 4; ++j) y[t][k][j] = yr[64 * j]; } }
#pragma unroll
        for (int t = 0; t < 2; ++t) {
#pragma unroll
            for (int k = 0; k < 4; ++k) { const float w = wq[t][k];
#pragma unroll
                for (int j = 0; j < 4; ++j) { const u32x2 yy = y[t][k][j];
                    v[t][j].x = fmaf(w, bflo(yy.x), v[t][j].x); v[t][j].y = fmaf(w, bfhi(yy.x), v[t][j].y); v[t][j].z = fmaf(w, bflo(yy.y), v[t][j].z); v[t][j].w = fmaf(w, bfhi(yy.y), v[t][j].w); } }
            float s = 0.f;
#pragma unroll
            for (int j = 0; j < 4; ++j) s += (v[t][j].x * v[t][j].x + v[t][j].y * v[t][j].y) + (v[t][j].z * v[t][j].z + v[t][j].w * v[t][j].w);
            const float rstd = rsqrtf(wave_sum(s) * (1.f / 1024.f) + EPS);
            f32x4* o = (f32x4*)(p.out + (size_t)(m0 + t) * 1024) + lane;
#pragma unroll
            for (int j = 0; j < 4; ++j) o[64 * j] = v[t][j] * rstd * gv[j];
        }
    }
}

#define XB_TMO      128
#define XB_XCNT(j)  (256  + 64 * (j))
#define XB_XSUB(j)  (1280 + 64 * (j))
#define XB_XGEN(j)  (2304 + 64 * (j))
#define XB_TOP      3328
#define XB_TOPGEN   3392
#define XCD_BAR_WORDS 3456
#define XB_SPIN_CAP (1u << 18)

__device__ __forceinline__ unsigned xb_ld(unsigned* p)              { return __hip_atomic_load(p, __ATOMIC_RELAXED, __HIP_MEMORY_SCOPE_AGENT); }
__device__ __forceinline__ unsigned xb_add(unsigned* p, unsigned v) { return __hip_atomic_fetch_add(p, v, __ATOMIC_RELAXED, __HIP_MEMORY_SCOPE_AGENT); }
__device__ __forceinline__ unsigned xb_xcc_id() { return (unsigned)__builtin_amdgcn_s_getreg((3 << 11) | 20) & 0xFu; }
#define XB_SPIN(cond, bar) do { unsigned _sp = 0; while (cond) { __builtin_amdgcn_s_sleep(1); \
    if ((++_sp & 255u) == 0u) { if (xb_ld(&(bar)[XB_TMO])) break; if (_sp > XB_SPIN_CAP) { atomicAdd(&(bar)[XB_TMO], 1u); break; } } } } while (0)

struct XcdBarrier {
    unsigned* bar; unsigned x;
    volatile LAS unsigned* st;
};

__device__ __forceinline__ XcdBarrier xcd_barrier_post(unsigned* bar, volatile LAS unsigned* st) {
    XcdBarrier b; b.bar = bar; b.x = xb_xcc_id(); b.st = st;
    if (threadIdx.x == 0) (void)xb_add(&bar[XB_XCNT(b.x)], 1u);
    return b;
}
__device__ __forceinline__ void xcd_barrier_complete(unsigned* bar, unsigned x, unsigned& nloc, unsigned& nx) {
    const unsigned G = gridDim.x * gridDim.y * gridDim.z;
    unsigned sum, cnt, mine, sp = 0u;
    for (;;) {
        sum = 0u; cnt = 0u; mine = 0u;
#pragma unroll
        for (unsigned j = 0; j < 16; ++j) { const unsigned c = xb_ld(&bar[XB_XCNT(j)]); sum += c; cnt += (c > 0u) ? 1u : 0u; mine = (j == x) ? c : mine; }
        if (sum == G) break;
        __builtin_amdgcn_s_sleep(1);
        if ((++sp & 255u) == 0u) { if (xb_ld(&bar[XB_TMO])) break; if (sp > XB_SPIN_CAP) { atomicAdd(&bar[XB_TMO], 1u); break; } }
    }
    nloc = mine > 0u ? mine : 1u; nx = cnt > 0u ? cnt : 1u;
}

__device__ __forceinline__ void xcd_barrier(const XcdBarrier& b) {
    asm volatile("s_waitcnt vmcnt(0)" ::: "memory");
    __syncthreads();
    if (threadIdx.x == 0) {
        unsigned* bar = b.bar;
        __builtin_amdgcn_s_waitcnt(0);
        unsigned nloc = b.st[0], nx = b.st[1];
        if (nloc == 0u) { xcd_barrier_complete(bar, b.x, nloc, nx); b.st[0] = nloc; b.st[1] = nx; }
        const unsigned old = xb_add(&bar[XB_XSUB(b.x)], 1u);
        const unsigned gen = old / nloc;
        if (old + 1u == (gen + 1u) * nloc) {
            __builtin_amdgcn_fence(__ATOMIC_RELEASE, "agent");
            asm volatile("s_waitcnt vmcnt(0)" ::: "memory");
            const unsigned og = xb_add(&bar[XB_TOP], 1u);
            const unsigned tg = og / nx;
            if (og + 1u == (tg + 1u) * nx) xb_add(&bar[XB_TOPGEN], 1u);
            else XB_SPIN(xb_ld(&bar[XB_TOPGEN]) == tg, bar);
            __builtin_amdgcn_fence(__ATOMIC_ACQUIRE, "agent");
            xb_add(&bar[XB_XGEN(b.x)], 1u);
            asm volatile("s_waitcnt vmcnt(0)" ::: "memory");
        } else {
            XB_SPIN(xb_ld(&bar[XB_XGEN(b.x)]) == gen, bar);
            __builtin_amdgcn_fence(__ATOMIC_ACQUIRE, "agent");
            asm volatile("s_waitcnt vmcnt(0)" ::: "memory");
        }
    }
    __syncthreads();
}

constexpr int NPHASE = 13;
__global__ void __launch_bounds__(512) mega(Params p) {
    extern __shared__ __attribute__((aligned(16))) unsigned char lds_raw[];
    Ctx c; c.tid = threadIdx.x; c.lane = c.tid & 63; c.wave = __builtin_amdgcn_readfirstlane(c.tid >> 6); c.bid = blockIdx.x; c.G = gridDim.x;
    c.lds = (LAS unsigned char*)lds_raw;
    cg::grid_group grid = cg::this_grid();
    if (c.tid < 2) ((volatile LAS unsigned*)(c.lds + LDS_BARST))[c.tid] = 0u;
    __syncthreads();
#define SEAM(k) do { if ((k) == 0) { grid.sync(); (void)xcd_barrier_post((unsigned*)(p.ws + WS_BAR), (volatile LAS unsigned*)(c.lds + LDS_BARST)); } \
        else { XcdBarrier b_; b_.bar = (unsigned*)(p.ws + WS_BAR); b_.x = xb_xcc_id(); b_.st = (volatile LAS unsigned*)(c.lds + LDS_BARST); xcd_barrier(b_); } } while (0)
#define RUN(k, call) if (p.ph_lo <= (k) && (k) < p.ph_hi) { call; if ((k) + 1 < p.ph_hi) SEAM(k); }
    RUN(0, phase_prep(p, c))
    RUN(1, phase_gemm1(p, c))
    RUN(2, phase_conv(p, c))
    RUN(3, phase_ssd_states(p, c))
    RUN(4, phase_ssd_scan(p, c))
    RUN(5, phase_ssd_out(p, c))
    RUN(6, phase_rstd(p, c); phase_attn(p, c, (char*)lds_raw))
    RUN(7, phase_tail12(p, c))
    RUN(8, phase_tail3(p, c))
    RUN(9, phase_router(p, c))
    RUN(10, phase_moe1(p, c))
    RUN(11, phase_moe2(p, c))
    RUN(12, phase_combine(p, c))
#undef RUN
}

extern "C" void kernel_launch(void* const* d_in, const int* in_sizes, int n_in, void* d_out, int out_size, void* d_ws, size_t ws_size, hipStream_t stream) {
    static int ok = 0; static int grid_blocks = 0;
    if (ok == 0) {
        if (n_in != 24 || out_size != M * D || ws_size < WS_END) { fprintf(stderr, "kernel_launch: unexpected shapes: n_in %d out %d ws %zu (need %zu)\n", n_in, out_size, ws_size, (size_t)WS_END); ok = -1; return; }
        if (hipFuncSetAttribute((const void*)mega, hipFuncAttributeMaxDynamicSharedMemorySize, LDS_BYTES) != hipSuccess) { fprintf(stderr, "kernel_launch: hipFuncSetAttribute failed\n"); ok = -1; return; }
        int dev = 0, cus = 0, per_cu = 0;
        hipGetDevice(&dev);
        hipDeviceGetAttribute(&cus, hipDeviceAttributeMultiprocessorCount, dev);
        hipOccupancyMaxActiveBlocksPerMultiprocessor(&per_cu, (const void*)mega, 512, LDS_BYTES);
        if (per_cu < 1 || cus < 1) { fprintf(stderr, "kernel_launch: occupancy query gave %d blocks/CU on %d CUs\n", per_cu, cus); ok = -1; return; }
        grid_blocks = cus;
        ok = 1;
    }
    if (ok < 0) return;
    Params p{};
    for (int i = 0; i < 24; ++i) p.in[i] = (const float*)d_in[i];
    p.out = (float*)d_out; p.ws = (unsigned char*)d_ws;
    p.ph_lo = 0; p.ph_hi = NPHASE;
    void* args[] = {&p};
    hipError_t e = hipLaunchCooperativeKernel((const void*)mega, dim3(grid_blocks), dim3(512), args, LDS_BYTES, stream);
    if (e != hipSuccess) fprintf(stderr, "kernel_launch: cooperative launch failed: %s (grid %d)\n", hipGetErrorString(e), grid_blocks);
}
```

```cpp
#include <hip/hip_runtime.h>
#include <hip/hip_cooperative_groups.h>
#include <cstdio>
#include <cstdint>

namespace cg = cooperative_groups;
#define LAS __attribute__((address_space(3)))
typedef unsigned short bf16_t;
typedef unsigned u32x4 __attribute__((ext_vector_type(4)));
typedef unsigned u32x2 __attribute__((ext_vector_type(2)));
typedef float f32x4 __attribute__((ext_vector_type(4)));

constexpr int NB = 2, S = 8192, D = 1024, M = NB * S;
constexpr int NPROJ = 6400;
constexpr int PZ = 0, PXBC = 1024, PQ = 2560, PK = 3584, PV = 3840, PG = 4096, PDT = 6144;
constexpr int ROWS_MAX = 65536 + 32 * 256;
constexpr float EPS = 1e-6f;

constexpr size_t al256(size_t x) { return (x + 255) / 256 * 256; }
constexpr size_t WS_CTL = 0;
constexpr size_t WS_BAR = 4096;
constexpr size_t WS_ROPE = 4096 + 16384;
constexpr size_t WS_WRT = WS_ROPE + 32768;
constexpr size_t WS_WINT = WS_WRT + 131072;
constexpr size_t WS_WST = WS_WINT + (size_t)NPROJ * 1024 * 2;
constexpr size_t WS_WAT = WS_WST + 2097152;
constexpr size_t WS_WOT = WS_WAT + 2097152;
constexpr size_t WS_W1T = WS_WOT + 2097152;
constexpr size_t WS_W2T = WS_W1T + (size_t)32 * 2048 * 1024 * 2;
constexpr size_t WS_X1 = WS_W2T + (size_t)32 * 1024 * 1024 * 2;
constexpr size_t WS_H2 = WS_X1 + (size_t)M * 1024 * 4;
constexpr size_t WS_TOKES = WS_H2 + (size_t)M * 1024 * 2;
constexpr size_t WS_TOKW = WS_TOKES + (size_t)M * 16;
constexpr size_t WS_LIST = WS_TOKW + (size_t)M * 16;
constexpr size_t WS_R = WS_LIST + (size_t)32 * 16384 * 4;
constexpr size_t WS_H = WS_R;
constexpr size_t WS_P = WS_H + (size_t)M * 1024 * 2;
constexpr size_t WS_XT = WS_P + (size_t)M * NPROJ * 2;
constexpr size_t WS_BMR = WS_XT + (size_t)M * 1024 * 2;
constexpr size_t WS_BMT = WS_BMR + (size_t)M * 256 * 2;
constexpr size_t WS_CMR = WS_BMT + (size_t)M * 256 * 2;
constexpr size_t WS_DT = WS_CMR + (size_t)M * 256 * 2;
constexpr size_t WS_ACS = WS_DT + (size_t)2 * M * 16 * 4;
constexpr size_t WS_CDEC = WS_ACS + (size_t)2 * M * 16 * 4;
constexpr size_t WS_ST = WS_CDEC + 16384;
constexpr size_t WS_PREV = WS_ST + (size_t)2 * 2 * 64 * 16 * 8192 * 4;
constexpr size_t WS_YZ = WS_PREV + (size_t)2 * 2 * 64 * 16 * 8192 * 2;
constexpr size_t WS_AO = WS_YZ + (size_t)M * 1024 * 2;
constexpr size_t WS_RSTD = WS_AO + (size_t)M * 1024 * 2;
constexpr size_t WS_QN = WS_RSTD + (size_t)M * 4;
constexpr size_t WS_KN = WS_QN + (size_t)M * 1024 * 2;
constexpr size_t WS_VB = WS_KN + (size_t)M * 256 * 2;
constexpr size_t WS_T1 = WS_VB + (size_t)M * 256 * 2;
constexpr size_t WS_MG = WS_T1 + (size_t)M * 1024 * 2;
constexpr size_t WS_END = WS_MG + (size_t)M * 1024 * 2;
constexpr size_t WS_XB = WS_R;
constexpr size_t WS_ACT = WS_XB + (size_t)ROWS_MAX * 1024 * 2;
constexpr size_t WS_YB = WS_XB;
static_assert(WS_ACT + (size_t)ROWS_MAX * 1024 * 2 <= WS_END, "moe overlay");
static_assert(WS_END <= (size_t)1073741824, "workspace");
static_assert(WS_WAT == WS_WST + 2097152 && WS_AO == WS_YZ + (size_t)M * 2048, "concatenated operands of the merged branch GEMMs");

constexpr int LDS_BYTES = 147712;
constexpr int LDS_BARST = 147456;
constexpr int LDS_CTL = 143360;

struct Params {
    const float* in[24];
    float* out;
    unsigned char* ws;
    int ph_lo, ph_hi;
};

__device__ __forceinline__ float bf2f(bf16_t v) { return __uint_as_float((unsigned)v << 16); }
__device__ __forceinline__ float bflo(unsigned w) { return __uint_as_float(w << 16); }
__device__ __forceinline__ float bfhi(unsigned w) { return __uint_as_float(w & 0xffff0000u); }
__device__ __forceinline__ unsigned f2bf(float f) { unsigned u = __float_as_uint(f); return (u + 0x7fffu + ((u >> 16) & 1u)) >> 16; }
__device__ __forceinline__ unsigned pk2(float lo, float hi) { return f2bf(lo) | (f2bf(hi) << 16); }
__device__ __forceinline__ float wave_sum(float v) {
#pragma unroll
    for (int o = 1; o < 64; o <<= 1) v += __shfl_xor(v, o);
    return v;
}
__device__ __forceinline__ float wave_max(float v) {
#pragma unroll
    for (int o = 1; o < 64; o <<= 1) v = fmaxf(v, __shfl_xor(v, o));
    return v;
}
__device__ __forceinline__ int wave_min_i(int v) {
#pragma unroll
    for (int o = 1; o < 64; o <<= 1) { int t = __shfl_xor(v, o); v = t < v ? t : v; }
    return v;
}
__device__ __forceinline__ float sigmoidf_(float x) { return 1.f / (1.f + __expf(-x)); }
__device__ __forceinline__ unsigned pack4_fp8(float a, float b, float c, float d) { unsigned w = __builtin_amdgcn_cvt_pk_fp8_f32(a, b, 0u, false); return __builtin_amdgcn_cvt_pk_fp8_f32(c, d, w, true); }
#define LDS_WAIT() asm volatile("s_waitcnt lgkmcnt(0)" ::: "memory")

struct Ctx { int tid, lane, wave, bid, G; LAS unsigned char* lds; };

struct TItem { const float* W; bf16_t* WT; const float* kscale; int N, k0, n0, orow0; };
__device__ __forceinline__ void transpose_load(const TItem& t, f32x4 (&v)[8], int lane) {
    const int nq = lane & 7, kg = lane >> 3;
    const float* s = t.W + (size_t)(t.k0 + 8 * kg) * t.N + t.n0 + 4 * nq;
#pragma unroll
    for (int i = 0; i < 8; ++i) v[i] = *(const f32x4*)(s + (size_t)i * t.N);
}
__device__ __forceinline__ void transpose_store(const TItem& t, f32x4 (&v)[8], int lane) {
    const int nq = lane & 7, kg = lane >> 3;
    if (t.kscale) {
#pragma unroll
        for (int i = 0; i < 8; ++i) v[i] = v[i] * t.kscale[t.k0 + 8 * kg + i];
    }
    bf16_t* d = t.WT + (size_t)(t.orow0 + 4 * nq) * 1024 + t.k0 + 8 * kg;
#pragma unroll
    for (int j = 0; j < 4; ++j) { u32x4 o; o.x = pk2(v[0][j], v[1][j]); o.y = pk2(v[2][j], v[3][j]); o.z = pk2(v[4][j], v[5][j]); o.w = pk2(v[6][j], v[7][j]);
        *(u32x4*)(d + (size_t)j * 1024) = o; }
}
constexpr int PREP_I_IN = 16 * 193, PREP_I_SQ = 512, PREP_NITEMS = PREP_I_IN + 3 * PREP_I_SQ;
__device__ __forceinline__ TItem prep_item(const Params& p, int r) {
    unsigned char* ws = p.ws; TItem t; t.kscale = nullptr;
    if (r < PREP_I_IN) { const int kb = r / 193, nb = r % 193, n0 = nb * 32;
        t.W = p.in[2]; t.WT = (bf16_t*)(ws + WS_WINT); t.N = 6176; t.k0 = kb * 64; t.n0 = n0; t.orow0 = n0 < 2560 ? n0 : (n0 < 2592 ? PDT + (n0 - 2560) : n0 - 32); return t; }
    r -= PREP_I_IN;
    { const int which = r / PREP_I_SQ, q = r % PREP_I_SQ;
        t.W = which == 0 ? p.in[13] : (which == 1 ? p.in[14] : p.in[15]); t.WT = (bf16_t*)(ws + (which == 0 ? WS_WST : (which == 1 ? WS_WAT : WS_WOT)));
        t.kscale = which == 0 ? p.in[10] : nullptr; t.N = 1024; t.k0 = (q / 32) * 64; t.n0 = (q % 32) * 32; t.orow0 = t.n0; return t; }
}
constexpr int PREP8_TILES = 32 * 64 + 32 * 32;
struct T8 { const float* W; unsigned char* WT; int N, k0, n0; bool w1; };
__device__ __forceinline__ T8 prep8_tile(const Params& p, int t) {
    T8 r;
    if (t < 2048) { const int e = t >> 6; r.W = p.in[19] + (size_t)e * 1024 * 2048; r.WT = p.ws + WS_W1T + (size_t)e * 2048 * 1024; r.N = 2048; r.k0 = ((t >> 3) & 7) * 128; r.n0 = (t & 7) * 256; r.w1 = true; }
    else { t -= 2048; const int e = t >> 5; r.W = p.in[21] + (size_t)e * 1024 * 1024; r.WT = p.ws + WS_W2T + (size_t)e * 1024 * 1024; r.N = 1024; r.k0 = ((t >> 2) & 7) * 128; r.n0 = (t & 3) * 256; r.w1 = false; }
    return r;
}
__device__ __forceinline__ void prep8_load(const T8& t, f32x4 (&v)[16], int wave, int lane) {
    const float* s = t.W + (size_t)(t.k0 + 16 * wave) * t.N + t.n0 + 4 * lane;
#pragma unroll
    for (int i = 0; i < 16; ++i) v[i] = *(const f32x4*)(s + (size_t)i * t.N);
}
__device__ __forceinline__ void phase_prep8(const Params& p, const Ctx& c) {
    f32x4 v[16];
    int t = c.bid;
    if (t < PREP8_TILES) { const T8 t0 = prep8_tile(p, t); prep8_load(t0, v, c.wave, c.lane); }
    for (int i = 0; t < PREP8_TILES; ++i, t += c.G) {
        const T8 cur = prep8_tile(p, t);
        LAS unsigned char* img = c.lds + (i & 1) * 32768;
#pragma unroll
        for (int j = 0; j < 4; ++j) { u32x4 o;
            o.x = pack4_fp8(64.f * v[0][j], 64.f * v[1][j], 64.f * v[2][j], 64.f * v[3][j]); o.y = pack4_fp8(64.f * v[4][j], 64.f * v[5][j], 64.f * v[6][j], 64.f * v[7][j]);
            o.z = pack4_fp8(64.f * v[8][j], 64.f * v[9][j], 64.f * v[10][j], 64.f * v[11][j]); o.w = pack4_fp8(64.f * v[12][j], 64.f * v[13][j], 64.f * v[14][j], 64.f * v[15][j]);
            *(LAS u32x4*)(img + (4 * c.lane + j) * 128 + 16 * c.wave) = o; }
        if (t + c.G < PREP8_TILES) { const T8 nx = prep8_tile(p, t + c.G); prep8_load(nx, v, c.wave, c.lane); }
        __syncthreads();
#pragma unroll
        for (int q = 0; q < 4; ++q) { const int idx = c.tid + 512 * q, nl = idx >> 3, cw = idx & 7, n = cur.n0 + nl;
            const int orow = cur.w1 ? (((n & 1023) >> 7) * 256 + (n >> 10) * 128 + (n & 127)) : n;
            *(u32x4*)(cur.WT + (size_t)orow * 1024 + cur.k0 + 16 * cw) = *(const LAS u32x4*)(img + nl * 128 + 16 * cw); }
    }
    __syncthreads();
}

__device__ __forceinline__ void phase_prep(const Params& p, const Ctx& c) {
    unsigned char* ws = p.ws;
    const int gw = c.bid * 8 + c.wave, NGW = c.G * 8;
    for (int it = gw; it < PREP_NITEMS; it += 2 * NGW) {
        const TItem ta = prep_item(p, it); f32x4 va[8], vb[8];
        transpose_load(ta, va, c.lane);
        const bool two = it + NGW < PREP_NITEMS;
        const TItem tb = prep_item(p, two ? it + NGW : it);
        if (two) transpose_load(tb, vb, c.lane);
        transpose_store(ta, va, c.lane);
        if (two) transpose_store(tb, vb, c.lane);
    }
    phase_prep8(p, c);
    for (int r = 6176 + gw; r < NPROJ; r += NGW) {
        u32x4* o = (u32x4*)((bf16_t*)(ws + WS_WINT) + (size_t)r * 1024);
        o[c.lane] = (u32x4){0u, 0u, 0u, 0u}; o[c.lane + 64] = (u32x4){0u, 0u, 0u, 0u};
    }
    {
        const float* x = p.in[0]; const float* g = p.in[1]; bf16_t* H = (bf16_t*)(ws + WS_H);
        f32x4 gv[4];
#pragma unroll
        for (int j = 0; j < 4; ++j) gv[j] = ((const f32x4*)g)[c.lane + 64 * j];
        for (int m = gw; m < M; m += NGW) {
            const f32x4* xr = (const f32x4*)(x + (size_t)m * D) + c.lane;
            f32x4 v[4]; float s = 0.f;
#pragma unroll
            for (int j = 0; j < 4; ++j) { v[j] = xr[64 * j]; s += (v[j].x * v[j].x + v[j].y * v[j].y) + (v[j].z * v[j].z + v[j].w * v[j].w); }
            const float rstd = rsqrtf(wave_sum(s) * (1.f / D) + EPS);
            u32x2* o = (u32x2*)(H + (size_t)m * D) + c.lane;
#pragma unroll
            for (int j = 0; j < 4; ++j) { u32x2 w; w.x = pk2(v[j].x * rstd * gv[j].x, v[j].y * rstd * gv[j].y); w.y = pk2(v[j].z * rstd * gv[j].z, v[j].w * rstd * gv[j].w); o[64 * j] = w; }
        }
    }
    {
        float* rc = (float*)(ws + WS_ROPE); float* rs = rc + 4096;
        for (int idx = c.bid * 512 + c.tid; idx < 4096; idx += c.G * 512) {
            const int pos = idx >> 5, i = idx & 31;
            const float inv = exp2f(-(float)i * (13.287712379549449f / 32.f));
            float rev = (float)pos * inv * 0.15915494309189535f; rev -= floorf(rev);
            rc[idx] = __builtin_amdgcn_cosf(rev); rs[idx] = __builtin_amdgcn_sinf(rev);
        }
        float* wrt = (float*)(ws + WS_WRT); const float* wr = p.in[17];
        for (int idx = c.bid * 512 + c.tid; idx < 32768; idx += c.G * 512) { const int k = idx >> 5, e = idx & 31; wrt[e * 1024 + k] = wr[idx]; }
        if (c.bid == 0 && c.tid < 64) ((int*)(ws + WS_CTL))[c.tid] = 0;
        if (c.bid == 0) for (int i = c.tid; i < 3456; i += 512) ((unsigned*)(ws + WS_BAR))[i] = 0u;
    }
}

template <bool DUAL, class ARow, class Epi>
__device__ __forceinline__ void ngemm_tile(const ARow& arow, const bf16_t* Bt, const bf16_t* Bt2, int K, int m0, const Epi& epi, LAS float* lds, int tid) {
    LAS float* As = lds;
    LAS float* Bs = lds + 32 * 132;
    LAS float* Bs2 = Bs + 32 * 68;
    float acc[4][4], acc2[4][4];
#pragma unroll
    for (int i = 0; i < 4; ++i)
#pragma unroll
        for (int j = 0; j < 4; ++j) { acc[i][j] = 0.f; acc2[i][j] = 0.f; }
    const int tm = tid & 31, tn = tid >> 5;
    const int sr = tid >> 2, kq = (tid & 3) * 8;
    const bf16_t* ap = arow(m0 + sr) + kq;
    const bf16_t* bp = Bt + (size_t)(sr & 63) * K + kq;
    const bf16_t* bp2 = DUAL ? Bt2 + (size_t)(sr & 63) * K + kq : nullptr;
    for (int k0 = 0; k0 < K; k0 += 32) {
        {
            const u32x4 v = *(const u32x4*)(ap + k0);
            As[(kq + 0) * 132 + sr] = bflo(v.x); As[(kq + 1) * 132 + sr] = bfhi(v.x); As[(kq + 2) * 132 + sr] = bflo(v.y); As[(kq + 3) * 132 + sr] = bfhi(v.y);
            As[(kq + 4) * 132 + sr] = bflo(v.z); As[(kq + 5) * 132 + sr] = bfhi(v.z); As[(kq + 6) * 132 + sr] = bflo(v.w); As[(kq + 7) * 132 + sr] = bfhi(v.w);
        }
        if (tid < 256) {
            const u32x4 v = *(const u32x4*)(bp + k0);
            Bs[(kq + 0) * 68 + sr] = bflo(v.x); Bs[(kq + 1) * 68 + sr] = bfhi(v.x); Bs[(kq + 2) * 68 + sr] = bflo(v.y); Bs[(kq + 3) * 68 + sr] = bfhi(v.y);
            Bs[(kq + 4) * 68 + sr] = bflo(v.z); Bs[(kq + 5) * 68 + sr] = bfhi(v.z); Bs[(kq + 6) * 68 + sr] = bflo(v.w); Bs[(kq + 7) * 68 + sr] = bfhi(v.w);
        } else if (DUAL) {
            const int r2 = sr & 63;
            const u32x4 v = *(const u32x4*)(bp2 + k0);
            Bs2[(kq + 0) * 68 + r2] = bflo(v.x); Bs2[(kq + 1) * 68 + r2] = bfhi(v.x); Bs2[(kq + 2) * 68 + r2] = bflo(v.y); Bs2[(kq + 3) * 68 + r2] = bfhi(v.y);
            Bs2[(kq + 4) * 68 + r2] = bflo(v.z); Bs2[(kq + 5) * 68 + r2] = bfhi(v.z); Bs2[(kq + 6) * 68 + r2] = bflo(v.w); Bs2[(kq + 7) * 68 + r2] = bfhi(v.w);
        }
        __syncthreads();
#pragma unroll 8
        for (int k = 0; k < 32; ++k) {
            const f32x4 a = *(const LAS f32x4*)&As[k * 132 + tm * 4];
            const f32x4 b = *(const LAS f32x4*)&Bs[k * 68 + tn * 4];
#pragma unroll
            for (int i = 0; i < 4; ++i)
#pragma unroll
                for (int j = 0; j < 4; ++j) acc[i][j] = fmaf(a[i], b[j], acc[i][j]);
            if (DUAL) {
                const f32x4 b2 = *(const LAS f32x4*)&Bs2[k * 68 + tn * 4];
#pragma unroll
                for (int i = 0; i < 4; ++i)
#pragma unroll
                    for (int j = 0; j < 4; ++j) acc2[i][j] = fmaf(a[i], b2[j], acc2[i][j]);
            }
        }
        __syncthreads();
    }
#pragma unroll
    for (int i = 0; i < 4; ++i)
#pragma unroll
        for (int j = 0; j < 4; ++j) epi(m0 + tm * 4 + i, tn * 4 + j, acc[i][j], acc2[i][j]);
}
struct ARowPlain { const bf16_t* A; int lda; __device__ __forceinline__ const bf16_t* operator()(int m) const { return A + (size_t)m * lda; } };

namespace pg8 {
#define PG8_LAS __attribute__((address_space(3)))
typedef unsigned short bf16_t;
typedef short bf16x8 __attribute__((ext_vector_type(8)));
typedef float f32x4 __attribute__((ext_vector_type(4)));
typedef unsigned u32x4 __attribute__((ext_vector_type(4)));
constexpr int BM = 256, BK = 64, HALF = 128, HTB = HALF * BK * 2  , STAGE_BYTES = 8 * HTB, NXCD = 8, WGM = 8;

__host__ __device__ __forceinline__ int lds_byte(int r, int c) { const int st = (r >> 4) * 2 + (c >> 5), rr = r & 15, cc = c & 31, ob = rr * 64 + cc * 2; return st * 1024 + (ob ^ (((ob >> 9) & 1) << 5)); }
__host__ __device__ __forceinline__ void stage_rc(int b, int& R, int& C) { const int st = b / 1024, sb = b % 1024, swz = sb ^ (((sb >> 9) & 1) << 5); R = (st >> 1) * 16 + swz / 64; C = (st & 1) * 32 + (swz % 64) / 2; }
__host__ __device__ __forceinline__ int perm32(int rho) { const int n = rho >> 4, i = rho & 15; return 8 * (i >> 2) + 4 * n + (i & 3); }

struct Unit { int pm, pn; };
struct Gemm { const bf16_t* A; const bf16_t* Bt; int M, N, K; };

struct StaticOrder {
    int nM, nN, nwg, G, c;
    __host__ __device__ void init(int M, int N, int G_, int c_) { nM = M / BM; nN = N / BM; nwg = nM * nN; G = G_; c = c_; }
    __host__ __device__ bool next(int i, Unit& u) const {
        const long L = (long)i * G + c; if (L >= nwg) return false;
        int wgid = (int)L; { const int q = nwg / NXCD, r = nwg % NXCD, xcd = wgid % NXCD, off = wgid / NXCD; wgid = (xcd < r ? xcd * (q + 1) : r * (q + 1) + (xcd - r) * q) + off; }
        const int nig = WGM * nN, gid = wgid / nig, fm = gid * WGM, gsz = (nM - fm) < WGM ? (nM - fm) : WGM;
        u.pm = fm + ((wgid % nig) % gsz); u.pn = (wgid % nig) / gsz; return true;
    }
    __device__ __forceinline__ void a_ready(const Unit&) const {}
    __device__ __forceinline__ void done(const Unit&) const {}
};


__device__ __forceinline__ unsigned cvt_pk_bf16(float lo, float hi) { unsigned r; asm volatile("v_cvt_pk_bf16_f32 %0, %1, %2" : "=v"(r) : "v"(lo), "v"(hi)); return r; }
__device__ __forceinline__ float sig_(float x) { return __builtin_amdgcn_rcpf(1.f + __builtin_amdgcn_exp2f(-1.4426950408889634f * x)); }
__device__ __forceinline__ u32x4 pack8(const f32x4& v0, const f32x4& v1) { u32x4 w; w.x = cvt_pk_bf16(v0[0], v0[1]); w.y = cvt_pk_bf16(v0[2], v0[3]); w.z = cvt_pk_bf16(v1[0], v1[1]); w.w = cvt_pk_bf16(v1[2], v1[3]); return w; }
__device__ __forceinline__ void unpack8(const u32x4& w, f32x4& v0, f32x4& v1) {
    v0[0] = __uint_as_float(w.x << 16); v0[1] = __uint_as_float(w.x & 0xffff0000u); v0[2] = __uint_as_float(w.y << 16); v0[3] = __uint_as_float(w.y & 0xffff0000u);
    v1[0] = __uint_as_float(w.z << 16); v1[1] = __uint_as_float(w.z & 0xffff0000u); v1[2] = __uint_as_float(w.w << 16); v1[3] = __uint_as_float(w.w & 0xffff0000u); }
struct EpiStore {
    static constexpr bool PERM = true, AFTER_DRAIN = false;
    bf16_t* O; int ldc;
    __device__ __forceinline__ void operator()(const f32x4 (&acc)[2][2][4][2], const Unit& u, int wr, int wc, int fr, int fq) const {
        const int row0 = u.pm * BM + wr * 64 + fr, col0 = u.pn * BM + wc * 32 + 8 * fq;
#pragma unroll
        for (int ai = 0; ai < 2; ++ai)
#pragma unroll
            for (int m = 0; m < 4; ++m) { bf16_t* rowp = O + (size_t)(row0 + ai * HALF + m * 16) * ldc + col0;
#pragma unroll
                for (int bj = 0; bj < 2; ++bj) *(u32x4*)(rowp + bj * HALF) = pack8(acc[ai][bj][m][0], acc[ai][bj][m][1]); }
    }
};
struct EpiT1 {
    static constexpr bool PERM = true, AFTER_DRAIN = false;
    bf16_t* T1; const bf16_t* G; int ldg; const float* RSTD;
    __device__ __forceinline__ void operator()(const f32x4 (&acc)[2][2][4][2], const Unit& u, int wr, int wc, int fr, int fq) const {
        const int row0 = u.pm * BM + wr * 64 + fr, col0 = u.pn * BM + wc * 32 + 8 * fq;
#pragma unroll
        for (int ai = 0; ai < 2; ++ai)
#pragma unroll
            for (int m = 0; m < 4; ++m) { const int row = row0 + ai * HALF + m * 16; const float rs = RSTD[row];
#pragma unroll
                for (int bj = 0; bj < 2; ++bj) { const int col = col0 + bj * HALF;
                    f32x4 g0, g1; unpack8(*(const u32x4*)(G + (size_t)row * ldg + col), g0, g1);
                    f32x4 v0 = acc[ai][bj][m][0] * rs, v1 = acc[ai][bj][m][1] * rs;
#pragma unroll
                    for (int i = 0; i < 4; ++i) { v0[i] *= sig_(g0[i]); v1[i] *= sig_(g1[i]); }
                    *(u32x4*)(T1 + (size_t)row * 1024 + col) = pack8(v0, v1); } }
    }
};
struct EpiT2 {
    static constexpr bool PERM = true, AFTER_DRAIN = false;
    bf16_t* MG; const bf16_t* T1; const bf16_t* G; int ldg;
    __device__ __forceinline__ void operator()(const f32x4 (&acc)[2][2][4][2], const Unit& u, int wr, int wc, int fr, int fq) const {
        const int row0 = u.pm * BM + wr * 64 + fr, col0 = u.pn * BM + wc * 32 + 8 * fq;
#pragma unroll
        for (int ai = 0; ai < 2; ++ai)
#pragma unroll
            for (int m = 0; m < 4; ++m) { const int row = row0 + ai * HALF + m * 16;
#pragma unroll
                for (int bj = 0; bj < 2; ++bj) { const int col = col0 + bj * HALF;
                    f32x4 g0, g1, t0, t1; unpack8(*(const u32x4*)(G + (size_t)row * ldg + col), g0, g1); unpack8(*(const u32x4*)(T1 + (size_t)row * 1024 + col), t0, t1);
                    f32x4 v0 = acc[ai][bj][m][0], v1 = acc[ai][bj][m][1];
#pragma unroll
                    for (int i = 0; i < 4; ++i) { v0[i] = fmaf(v0[i], sig_(g0[i]), t0[i]); v1[i] = fmaf(v1[i], sig_(g1[i]), t1[i]); }
                    *(u32x4*)(MG + (size_t)row * 1024 + col) = pack8(v0, v1); } }
    }
};
struct EpiT3 {
    static constexpr bool PERM = true, AFTER_DRAIN = false;
    float* X1; const float* x;
    __device__ __forceinline__ void operator()(const f32x4 (&acc)[2][2][4][2], const Unit& u, int wr, int wc, int fr, int fq) const {
        const int row0 = u.pm * BM + wr * 64 + fr, col0 = u.pn * BM + wc * 32 + 8 * fq;
#pragma unroll
        for (int ai = 0; ai < 2; ++ai)
#pragma unroll
            for (int m = 0; m < 4; ++m) { const size_t ro = (size_t)(row0 + ai * HALF + m * 16) * 1024 + col0;
#pragma unroll
                for (int bj = 0; bj < 2; ++bj) { const size_t o = ro + bj * HALF;
                    *(f32x4*)(X1 + o) = *(const f32x4*)(x + o) + acc[ai][bj][m][0]; *(f32x4*)(X1 + o + 4) = *(const f32x4*)(x + o + 4) + acc[ai][bj][m][1]; } }
    }
};
struct EpiAct {
    static constexpr bool PERM = true, AFTER_DRAIN = false;
    bf16_t* ACT; const float* b1;
    __device__ __forceinline__ void operator()(const f32x4 (&acc)[2][2][4][2], const Unit& u, int wr, int wc, int fr, int fq) const {
        const int e = u.pn >> 3, nt = u.pn & 7;
        const int row0 = u.pm * BM + wr * 64 + fr, col0 = nt * 128 + wc * 32 + 8 * fq;
        const float* bg = b1 + (size_t)e * 2048 + col0;
        const f32x4 bg0 = *(const f32x4*)bg, bg1 = *(const f32x4*)(bg + 4), bu0 = *(const f32x4*)(bg + 1024), bu1 = *(const f32x4*)(bg + 1028);
#pragma unroll
        for (int ai = 0; ai < 2; ++ai)
#pragma unroll
            for (int m = 0; m < 4; ++m) { const int row = row0 + ai * HALF + m * 16;
                f32x4 g0 = acc[ai][0][m][0] + bg0, g1 = acc[ai][0][m][1] + bg1, u0 = acc[ai][1][m][0] + bu0, u1 = acc[ai][1][m][1] + bu1;
#pragma unroll
                for (int i = 0; i < 4; ++i) {
                    const float ga = fminf(g0[i], 7.f), gb = fminf(g1[i], 7.f), ua = fminf(fmaxf(u0[i], -7.f), 7.f), ub = fminf(fmaxf(u1[i], -7.f), 7.f);
                    g0[i] = ga * sig_(1.702f * ga) * (ua + 1.f); g1[i] = gb * sig_(1.702f * gb) * (ub + 1.f); }
                *(u32x4*)(ACT + (size_t)row * 1024 + col0) = pack8(g0, g1); }
    }
};
struct EpiY {
    static constexpr bool PERM = true, AFTER_DRAIN = false;
    bf16_t* YB; const float* b2;
    __device__ __forceinline__ void operator()(const f32x4 (&acc)[2][2][4][2], const Unit& u, int wr, int wc, int fr, int fq) const {
        const int e = u.pn >> 2, nt = u.pn & 3;
        const int row0 = u.pm * BM + wr * 64 + fr, col0 = nt * BM + wc * 32 + 8 * fq;
        f32x4 bv[2][2];
#pragma unroll
        for (int bj = 0; bj < 2; ++bj) { bv[bj][0] = *(const f32x4*)(b2 + (size_t)e * 1024 + col0 + bj * HALF); bv[bj][1] = *(const f32x4*)(b2 + (size_t)e * 1024 + col0 + bj * HALF + 4); }
#pragma unroll
        for (int ai = 0; ai < 2; ++ai)
#pragma unroll
            for (int m = 0; m < 4; ++m) { bf16_t* rowp = YB + (size_t)(row0 + ai * HALF + m * 16) * 1024 + col0;
#pragma unroll
                for (int bj = 0; bj < 2; ++bj) *(u32x4*)(rowp + bj * HALF) = pack8(acc[ai][bj][m][0] + bv[bj][0], acc[ai][bj][m][1] + bv[bj][1]); }
    }
};

struct EpiAct8 {
    static constexpr bool PERM = true, AFTER_DRAIN = false;
    unsigned char* ACT; const float* b1;
    __device__ __forceinline__ void operator()(const f32x4 (&acc)[2][2][4][2], const Unit& u, int wr, int wc, int fr, int fq) const {
        const int e = u.pn >> 3, nt = u.pn & 7;
        const int row0 = u.pm * BM + wr * 64 + fr, col0 = nt * 128 + wc * 32 + 8 * fq;
        const float* bg = b1 + (size_t)e * 2048 + col0;
        const f32x4 bg0 = *(const f32x4*)bg, bg1 = *(const f32x4*)(bg + 4), bu0 = *(const f32x4*)(bg + 1024), bu1 = *(const f32x4*)(bg + 1028);
        constexpr float SC = 1.f / 512.f;
#pragma unroll
        for (int ai = 0; ai < 2; ++ai)
#pragma unroll
            for (int m = 0; m < 4; ++m) { const int row = row0 + ai * HALF + m * 16;
                f32x4 g0 = acc[ai][0][m][0] * SC + bg0, g1 = acc[ai][0][m][1] * SC + bg1, u0 = acc[ai][1][m][0] * SC + bu0, u1 = acc[ai][1][m][1] * SC + bu1;
#pragma unroll
                for (int i = 0; i < 4; ++i) {
                    const float ga = fminf(g0[i], 7.f), gb = fminf(g1[i], 7.f), ua = fminf(fmaxf(u0[i], -7.f), 7.f), ub = fminf(fmaxf(u1[i], -7.f), 7.f);
                    g0[i] = 4.f * ga * sig_(1.702f * ga) * (ua + 1.f); g1[i] = 4.f * gb * sig_(1.702f * gb) * (ub + 1.f); }
                u32x2 w; w.x = pack4_fp8(g0[0], g0[1], g0[2], g0[3]); w.y = pack4_fp8(g1[0], g1[1], g1[2], g1[3]);
                *(u32x2*)(ACT + (size_t)row * 1024 + col0) = w; }
    }
};
struct EpiY8 {
    static constexpr bool PERM = true, AFTER_DRAIN = false;
    bf16_t* YB; const float* b2;
    __device__ __forceinline__ void operator()(const f32x4 (&acc)[2][2][4][2], const Unit& u, int wr, int wc, int fr, int fq) const {
        const int e = u.pn >> 2, nt = u.pn & 3;
        const int row0 = u.pm * BM + wr * 64 + fr, col0 = nt * BM + wc * 32 + 8 * fq;
        constexpr float SC = 1.f / 256.f;
        f32x4 bv[2][2];
#pragma unroll
        for (int bj = 0; bj < 2; ++bj) { bv[bj][0] = *(const f32x4*)(b2 + (size_t)e * 1024 + col0 + bj * HALF); bv[bj][1] = *(const f32x4*)(b2 + (size_t)e * 1024 + col0 + bj * HALF + 4); }
#pragma unroll
        for (int ai = 0; ai < 2; ++ai)
#pragma unroll
            for (int m = 0; m < 4; ++m) { bf16_t* rowp = YB + (size_t)(row0 + ai * HALF + m * 16) * 1024 + col0;
#pragma unroll
                for (int bj = 0; bj < 2; ++bj) *(u32x4*)(rowp + bj * HALF) = pack8(acc[ai][bj][m][0] * SC + bv[bj][0], acc[ai][bj][m][1] * SC + bv[bj][1]); }
    }
};
struct MoeOrder {
    const PG8_LAS int* offs; int nN, G, c, ntile;
    __device__ __forceinline__ bool next(int i, Unit& u) const {
        const long L = (long)i * G + c; if (L >= (long)ntile * nN) return false;
        const int t = (int)(L / nN), pnl = (int)(L % nN); int e = 0; while (e < 31 && t * 256 >= offs[e + 1]) ++e;
        u.pm = t; u.pn = e * nN + pnl; return true;
    }
    __device__ __forceinline__ void a_ready(const Unit&) const {}
    __device__ __forceinline__ void done(const Unit&) const {}
};
template <class Epi, class Sched, bool ALIGN_EPI = false, bool SP2 = false>
__device__ __forceinline__ void gemm_phase(PG8_LAS unsigned char* lds, const Gemm g, const Sched& S, const Epi& E) {
    const int tid = threadIdx.x, wid = __builtin_amdgcn_readfirstlane(tid >> 6), lane = tid & 63, wr = wid >> 2, wc = wid & 3, fr = lane & 15, fq = lane >> 4;
    const int K = g.K, nt = K / BK;
    unsigned voffA[2], voffB[2];
#pragma unroll
    for (int i = 0; i < 2; ++i) { int R, C; stage_rc(tid * 16 + i * 8192, R, C); const int Rb = Epi::PERM ? ((R & ~31) + perm32(R & 31)) : R;
        voffA[i] = (unsigned)(R * K + C) * 2u; voffB[i] = (unsigned)(Rb * K + C) * 2u; }
    const size_t kstep = (size_t)(BK * 2);
    const size_t hstep = (size_t)HALF * K * 2;
    const size_t tstep = 2 * hstep;
    const unsigned ldsw = (unsigned)wid * 1024u;
    const int aoff = lds_byte(wr * 64 + fr, fq * 8), boff = lds_byte(wc * 32 + fr, fq * 8);
#define PG8_SA(b, h) (((b) * 2 + (h)) * HTB)
#define PG8_SB(b, h) ((4 + (b) * 2 + (h)) * HTB)
#define PG8_STAGE(bufoff, gbase, voff) do { _Pragma("unroll") for (int _i = 0; _i < 2; ++_i) \
        __builtin_amdgcn_global_load_lds((const unsigned*)((const char*)(gbase) + (voff)[_i]), (PG8_LAS unsigned*)(lds + (bufoff) + ldsw + _i * 8192), 16, 0, 0); } while (0)
#define PG8_LDA(dst, b, h) do { _Pragma("unroll") for (int m = 0; m < 4; ++m) _Pragma("unroll") for (int k = 0; k < 2; ++k) dst[m][k] = *(const PG8_LAS bf16x8*)(lds + PG8_SA(b, h) + aoff + m * 2048 + k * 1024); } while (0)
#define PG8_LDB(dst, b, h) do { _Pragma("unroll") for (int n = 0; n < 2; ++n) _Pragma("unroll") for (int k = 0; k < 2; ++k) dst[n][k] = *(const PG8_LAS bf16x8*)(lds + PG8_SB(b, h) + boff + n * 2048 + k * 1024); } while (0)
#define PG8_MMA(ai, bj, At, Bt) do { __builtin_amdgcn_s_setprio(1); _Pragma("unroll") for (int m = 0; m < 4; ++m) _Pragma("unroll") for (int n = 0; n < 2; ++n) _Pragma("unroll") for (int k = 0; k < 2; ++k) \
        acc[ai][bj][m][n] = __builtin_amdgcn_mfma_f32_16x16x32_bf16(Bt[n][k], At[m][k], acc[ai][bj][m][n], 0, 0, 0); __builtin_amdgcn_s_setprio(0); } while (0)
#define PG8_WAIT_V(n) asm volatile("s_waitcnt vmcnt(" #n ")" ::: "memory")
#define PG8_WAIT_L(n) asm volatile("s_waitcnt lgkmcnt(" #n ")" ::: "memory")
#define PG8_BAR __builtin_amdgcn_s_barrier()
#define PG8_SCHED __builtin_amdgcn_sched_barrier(0)
    Unit cur, nxt; int ui = 0;
    if (!S.next(0, cur)) return;
    f32x4 acc[2][2][4][2];
#pragma unroll
    for (int a = 0; a < 2; ++a)
#pragma unroll
        for (int b = 0; b < 2; ++b)
#pragma unroll
            for (int m = 0; m < 4; ++m)
#pragma unroll
                for (int n = 0; n < 2; ++n) acc[a][b][m][n] = (f32x4){0.f, 0.f, 0.f, 0.f};
    bf16x8 At[4][2], B0[2][2], B1[2][2];
    const char* cA = (const char*)g.A + (size_t)cur.pm * tstep; const char* cB = (const char*)g.Bt + (size_t)cur.pn * tstep;
    S.a_ready(cur);
    if constexpr (SP2) {
        PG8_STAGE(PG8_SB(0, 0), cB, voffB); PG8_STAGE(PG8_SB(0, 1), cB + hstep, voffB); PG8_STAGE(PG8_SA(0, 0), cA, voffA); PG8_STAGE(PG8_SA(0, 1), cA + hstep, voffA);
        if (wr == 1) PG8_BAR;
        PG8_WAIT_V(2); PG8_BAR;
        PG8_STAGE(PG8_SB(1, 0), cB + kstep, voffB); PG8_STAGE(PG8_SA(1, 0), cA + kstep, voffA); PG8_STAGE(PG8_SB(1, 1), cB + hstep + kstep, voffB);
        PG8_WAIT_V(6); PG8_BAR;
    } else {
        PG8_STAGE(PG8_SB(0, 0), cB, voffB); PG8_STAGE(PG8_SA(0, 0), cA, voffA); PG8_STAGE(PG8_SB(0, 1), cB + hstep, voffB); PG8_STAGE(PG8_SA(0, 1), cA + hstep, voffA);
        if (wr == 1) PG8_BAR;
        PG8_WAIT_V(4); PG8_BAR;
        PG8_STAGE(PG8_SB(1, 0), cB + kstep, voffB); PG8_STAGE(PG8_SA(1, 0), cA + kstep, voffA); PG8_STAGE(PG8_SB(1, 1), cB + hstep + kstep, voffB);
        PG8_WAIT_V(6); PG8_BAR;
    }
    for (;;) {
        const bool has_next = S.next(ui + 1, nxt);
        const char* nA = has_next ? (const char*)g.A + (size_t)nxt.pm * tstep : cA; const char* nB = has_next ? (const char*)g.Bt + (size_t)nxt.pn * tstep : cB;
        for (int t = 0; t < nt; t += 2) {
            const bool last = (t == nt - 2);
            const char* a1 = cA + (size_t)(t + 1) * kstep;
            const char* a2 = last ? nA : cA + (size_t)(t + 2) * kstep; const char* b2 = last ? nB : cB + (size_t)(t + 2) * kstep;
            const char* a3 = a2 + kstep; const char* b3 = b2 + kstep;
            if (last && has_next) S.a_ready(nxt);
            if constexpr (SP2) {
            PG8_LDB(B0, 0, 0); PG8_LDB(B1, 0, 1); PG8_SCHED; PG8_LDA(At, 0, 0); PG8_STAGE(PG8_SA(1, 1), a1 + hstep, voffA);
            PG8_WAIT_V(8); PG8_WAIT_L(0); PG8_BAR; PG8_MMA(0, 0, At, B0); PG8_MMA(0, 1, At, B1); PG8_BAR; PG8_SCHED;
            PG8_LDA(At, 0, 1); PG8_STAGE(PG8_SB(0, 0), b2, voffB); PG8_STAGE(PG8_SB(0, 1), b2 + hstep, voffB); PG8_STAGE(PG8_SA(0, 0), a2, voffA);
            PG8_WAIT_V(8); PG8_WAIT_L(0); PG8_BAR; PG8_MMA(1, 0, At, B0); PG8_MMA(1, 1, At, B1); PG8_BAR; PG8_SCHED;
            PG8_LDB(B0, 1, 0); PG8_LDB(B1, 1, 1); PG8_SCHED; PG8_LDA(At, 1, 0); PG8_STAGE(PG8_SA(0, 1), a2 + hstep, voffA);
            PG8_WAIT_V(8); PG8_WAIT_L(0); PG8_BAR; PG8_MMA(0, 0, At, B0); PG8_MMA(0, 1, At, B1); PG8_BAR; PG8_SCHED;
            PG8_LDA(At, 1, 1); PG8_STAGE(PG8_SB(1, 0), b3, voffB); PG8_STAGE(PG8_SB(1, 1), b3 + hstep, voffB); PG8_STAGE(PG8_SA(1, 0), a3, voffA);
            PG8_WAIT_V(8); PG8_WAIT_L(0); PG8_BAR; PG8_MMA(1, 0, At, B0); PG8_MMA(1, 1, At, B1); PG8_BAR; PG8_SCHED;
            } else {
            PG8_LDB(B0, 0, 0); PG8_SCHED; PG8_LDA(At, 0, 0); PG8_STAGE(PG8_SA(1, 1), a1 + hstep, voffA);
            PG8_WAIT_L(8); PG8_BAR; PG8_WAIT_L(0); PG8_MMA(0, 0, At, B0); PG8_BAR; PG8_SCHED;
            PG8_LDB(B1, 0, 1); PG8_STAGE(PG8_SB(0, 0), b2, voffB);
            PG8_BAR; PG8_WAIT_L(0); PG8_MMA(0, 1, At, B1); PG8_BAR;
            PG8_LDA(At, 0, 1); PG8_STAGE(PG8_SA(0, 0), a2, voffA);
            PG8_BAR; PG8_WAIT_L(0); PG8_MMA(1, 0, At, B0); PG8_BAR; PG8_SCHED;
            PG8_STAGE(PG8_SB(0, 1), b2 + hstep, voffB);
            PG8_WAIT_V(6); PG8_BAR; PG8_MMA(1, 1, At, B1); PG8_BAR;
            PG8_LDB(B0, 1, 0); PG8_SCHED; PG8_LDA(At, 1, 0); PG8_STAGE(PG8_SA(0, 1), a2 + hstep, voffA);
            PG8_WAIT_L(8); PG8_BAR; PG8_WAIT_L(0); PG8_MMA(0, 0, At, B0); PG8_BAR; PG8_SCHED;
            PG8_LDB(B1, 1, 1); PG8_STAGE(PG8_SB(1, 0), b3, voffB);
            PG8_BAR; PG8_WAIT_L(0); PG8_MMA(0, 1, At, B1); PG8_BAR;
            PG8_LDA(At, 1, 1); PG8_STAGE(PG8_SA(1, 0), a3, voffA);
            PG8_BAR; PG8_WAIT_L(0); PG8_MMA(1, 0, At, B0); PG8_BAR; PG8_SCHED;
            PG8_STAGE(PG8_SB(1, 1), b3 + hstep, voffB);
            PG8_WAIT_V(6); PG8_BAR; PG8_MMA(1, 1, At, B1); PG8_BAR;
            }
        }
        if constexpr (ALIGN_EPI) { if (wr == 0) PG8_BAR; }
        if constexpr (!Epi::AFTER_DRAIN) { E(acc, cur, wr, wc, fr, fq); S.done(cur); }
        if (!has_next) break;
#pragma unroll
        for (int a = 0; a < 2; ++a)
#pragma unroll
            for (int b = 0; b < 2; ++b)
#pragma unroll
                for (int m = 0; m < 4; ++m)
#pragma unroll
                    for (int n = 0; n < 2; ++n) acc[a][b][m][n] = (f32x4){0.f, 0.f, 0.f, 0.f};
        cur = nxt; cA = nA; cB = nB; ++ui;
        if constexpr (ALIGN_EPI) { if (wr == 1) PG8_BAR; }
    }
    PG8_WAIT_V(0);
    if constexpr (!ALIGN_EPI) { if (wr == 0) PG8_BAR; }
    PG8_BAR;
    if constexpr (Epi::AFTER_DRAIN) { E.fused(acc, cur, wr, wc, fr, fq, lds, wid, lane); S.done(cur); }
#undef PG8_SA
#undef PG8_SB
#undef PG8_STAGE
#undef PG8_LDA
#undef PG8_LDB
#undef PG8_MMA
#undef PG8_WAIT_V
#undef PG8_WAIT_L
#undef PG8_BAR
#undef PG8_SCHED
}

struct MoeGatherOrder {
    const PG8_LAS int* offs; const PG8_LAS int* cnt; const int* LIST; int nN, G, c, ntile;
    __device__ __forceinline__ bool next(int i, Unit& u) const {
        const long L = (long)i * G + c; if (L >= (long)ntile * nN) return false;
        const int t = (int)(L / nN), pnl = (int)(L % nN); int e = 0; while (e < 31 && t * 256 >= offs[e + 1]) ++e;
        u.pm = t; u.pn = e * nN + pnl; return true;
    }
    __device__ __forceinline__ int arow(const Unit& u, int r) const { const int e = u.pn / nN, slot = u.pm * 256 + r - offs[e]; return slot < cnt[e] ? LIST[e * 16384 + slot] : 0; }
    __device__ __forceinline__ void a_ready(const Unit&) const {}
    __device__ __forceinline__ void done(const Unit&) const {}
};
struct TailOrder {
    StaticOrder so;
    __device__ __forceinline__ bool next(int i, Unit& u) const { Unit b; if (!so.next(i >> 1, b)) return false; u.pm = b.pm + 64 * (i & 1); u.pn = b.pn + 4 * (i & 1); return true; }
    __device__ __forceinline__ void a_ready(const Unit&) const {}
    __device__ __forceinline__ void done(const Unit&) const {}
};
struct EpiT12 {
    static constexpr bool PERM = true, AFTER_DRAIN = false;
    bf16_t* T1; bf16_t* MG; const bf16_t* G; int ldg; const float* RSTD;
    __device__ __forceinline__ void operator()(const f32x4 (&acc)[2][2][4][2], const Unit& u, int wr, int wc, int fr, int fq) const {
        const bool second = u.pm >= 64;
        const int row0 = (u.pm & 63) * BM + wr * 64 + fr, col0 = (u.pn & 3) * BM + wc * 32 + 8 * fq;
        const bf16_t* Gp = G + (second ? 1024 : 0);
#pragma unroll
        for (int ai = 0; ai < 2; ++ai) {
            u32x4 gv[4][2], tv[4][2]; float rs[4];
#pragma unroll
            for (int m = 0; m < 4; ++m) { const int row = row0 + ai * HALF + m * 16; rs[m] = second ? 1.f : RSTD[row];
#pragma unroll
                for (int bj = 0; bj < 2; ++bj) { gv[m][bj] = *(const u32x4*)(Gp + (size_t)row * ldg + col0 + bj * HALF);
                    tv[m][bj] = second ? *(const u32x4*)(T1 + (size_t)row * 1024 + col0 + bj * HALF) : (u32x4){0u, 0u, 0u, 0u}; } }
#pragma unroll
            for (int m = 0; m < 4; ++m) { const int row = row0 + ai * HALF + m * 16;
#pragma unroll
                for (int bj = 0; bj < 2; ++bj) { f32x4 g0, g1, t0, t1; unpack8(gv[m][bj], g0, g1); unpack8(tv[m][bj], t0, t1);
                    f32x4 v0 = acc[ai][bj][m][0] * rs[m], v1 = acc[ai][bj][m][1] * rs[m];
#pragma unroll
                    for (int i = 0; i < 4; ++i) { v0[i] = fmaf(v0[i], sig_(g0[i]), t0[i]); v1[i] = fmaf(v1[i], sig_(g1[i]), t1[i]); }
                    *(u32x4*)((second ? MG : T1) + (size_t)row * 1024 + col0 + bj * HALF) = pack8(v0, v1); } }
        }
    }
};
struct EpiT3b {
    static constexpr bool PERM = true, AFTER_DRAIN = false;
    float* X1; const float* x;
    __device__ __forceinline__ void operator()(const f32x4 (&acc)[2][2][4][2], const Unit& u, int wr, int wc, int fr, int fq) const {
        const int row0 = u.pm * BM + wr * 64 + fr, col0 = u.pn * BM + wc * 32 + 8 * fq;
#pragma unroll
        for (int ai = 0; ai < 2; ++ai) {
            f32x4 xv[4][2][2];
#pragma unroll
            for (int m = 0; m < 4; ++m)
#pragma unroll
                for (int bj = 0; bj < 2; ++bj) { const size_t o = (size_t)(row0 + ai * HALF + m * 16) * 1024 + col0 + bj * HALF; xv[m][bj][0] = *(const f32x4*)(x + o); xv[m][bj][1] = *(const f32x4*)(x + o + 4); }
#pragma unroll
            for (int m = 0; m < 4; ++m)
#pragma unroll
                for (int bj = 0; bj < 2; ++bj) { const size_t o = (size_t)(row0 + ai * HALF + m * 16) * 1024 + col0 + bj * HALF;
                    *(f32x4*)(X1 + o) = xv[m][bj][0] + acc[ai][bj][m][0]; *(f32x4*)(X1 + o + 4) = xv[m][bj][1] + acc[ai][bj][m][1]; }
        }
    }
};
template <class Epi, class Sched>
__device__ __forceinline__ void gemm_phase_gather(PG8_LAS unsigned char* lds, const Gemm g, const Sched& S, const Epi& E) {
    constexpr bool ALIGN_EPI = true, SP2 = true;
    const int tid = threadIdx.x, wid = __builtin_amdgcn_readfirstlane(tid >> 6), lane = tid & 63, wr = wid >> 2, wc = wid & 3, fr = lane & 15, fq = lane >> 4;
    const int K = g.K, nt = K / BK;
    unsigned voffA[2], voffB[2];
#pragma unroll
    for (int i = 0; i < 2; ++i) { int R, C; stage_rc(tid * 16 + i * 8192, R, C); const int Rb = Epi::PERM ? ((R & ~31) + perm32(R & 31)) : R;
        voffA[i] = (unsigned)(R * K + C) * 2u; voffB[i] = (unsigned)(Rb * K + C) * 2u; }
    const size_t kstep = (size_t)(BK * 2);
    const size_t hstep = (size_t)HALF * K * 2;
    const size_t tstep = 2 * hstep;
    const unsigned ldsw = (unsigned)wid * 1024u;
    const int aoff = lds_byte(wr * 64 + fr, fq * 8), boff = lds_byte(wc * 32 + fr, fq * 8);
#define PG8_SA(b, h) (((b) * 2 + (h)) * HTB)
#define PG8_SB(b, h) ((4 + (b) * 2 + (h)) * HTB)
#define PG8_STAGE(bufoff, gbase, voff) do { _Pragma("unroll") for (int _i = 0; _i < 2; ++_i) \
        __builtin_amdgcn_global_load_lds((const unsigned*)((const char*)(gbase) + (voff)[_i]), (PG8_LAS unsigned*)(lds + (bufoff) + ldsw + _i * 8192), 16, 0, 0); } while (0)
#define PG8_LDA(dst, b, h) do { _Pragma("unroll") for (int m = 0; m < 4; ++m) _Pragma("unroll") for (int k = 0; k < 2; ++k) dst[m][k] = *(const PG8_LAS bf16x8*)(lds + PG8_SA(b, h) + aoff + m * 2048 + k * 1024); } while (0)
#define PG8_LDB(dst, b, h) do { _Pragma("unroll") for (int n = 0; n < 2; ++n) _Pragma("unroll") for (int k = 0; k < 2; ++k) dst[n][k] = *(const PG8_LAS bf16x8*)(lds + PG8_SB(b, h) + boff + n * 2048 + k * 1024); } while (0)
#define PG8_MMA(ai, bj, At, Bt) do { __builtin_amdgcn_s_setprio(1); _Pragma("unroll") for (int m = 0; m < 4; ++m) _Pragma("unroll") for (int n = 0; n < 2; ++n) _Pragma("unroll") for (int k = 0; k < 2; ++k) \
        acc[ai][bj][m][n] = __builtin_amdgcn_mfma_f32_16x16x32_bf16(Bt[n][k], At[m][k], acc[ai][bj][m][n], 0, 0, 0); __builtin_amdgcn_s_setprio(0); } while (0)
#define PG8_WAIT_V(n) asm volatile("s_waitcnt vmcnt(" #n ")" ::: "memory")
#define PG8_WAIT_L(n) asm volatile("s_waitcnt lgkmcnt(" #n ")" ::: "memory")
#define PG8_BAR __builtin_amdgcn_s_barrier()
#define PG8_SCHED __builtin_amdgcn_sched_barrier(0)
    Unit cur, nxt; int ui = 0;
    if (!S.next(0, cur)) return;
    int rA[2]; unsigned cAo[2];
#pragma unroll
    for (int i = 0; i < 2; ++i) { int R, C; stage_rc(tid * 16 + i * 8192, R, C); rA[i] = R; cAo[i] = (unsigned)C * 2u; }
    unsigned cO[2][2], o2[2][2]; int nR[2][2];
#define PG8_ROWS(dst, u) do { _Pragma("unroll") for (int h_ = 0; h_ < 2; ++h_) _Pragma("unroll") for (int i_ = 0; i_ < 2; ++i_) \
        dst[h_][i_] = (unsigned)S.arow(u, h_ * HALF + rA[i_]) * (unsigned)(K * 2) + cAo[i_]; } while (0)
    PG8_ROWS(cO, cur);
    f32x4 acc[2][2][4][2];
#pragma unroll
    for (int a = 0; a < 2; ++a)
#pragma unroll
        for (int b = 0; b < 2; ++b)
#pragma unroll
            for (int m = 0; m < 4; ++m)
#pragma unroll
                for (int n = 0; n < 2; ++n) acc[a][b][m][n] = (f32x4){0.f, 0.f, 0.f, 0.f};
    bf16x8 At[4][2], B0[2][2], B1[2][2];
    const char* const Ab = (const char*)g.A; const char* cB = (const char*)g.Bt + (size_t)cur.pn * tstep;
    S.a_ready(cur);
    if constexpr (SP2) {
        PG8_STAGE(PG8_SB(0, 0), cB, voffB); PG8_STAGE(PG8_SB(0, 1), cB + hstep, voffB); PG8_STAGE(PG8_SA(0, 0), Ab, cO[0]); PG8_STAGE(PG8_SA(0, 1), Ab, cO[1]);
        if (wr == 1) PG8_BAR;
        PG8_WAIT_V(2); PG8_BAR;
        PG8_STAGE(PG8_SB(1, 0), cB + kstep, voffB); PG8_STAGE(PG8_SA(1, 0), Ab + kstep, cO[0]); PG8_STAGE(PG8_SB(1, 1), cB + hstep + kstep, voffB);
        PG8_WAIT_V(6); PG8_BAR;
    }
    for (;;) {
        const bool has_next = S.next(ui + 1, nxt);
        const char* nB = has_next ? (const char*)g.Bt + (size_t)nxt.pn * tstep : cB;
#pragma unroll
        for (int h_ = 0; h_ < 2; ++h_)
#pragma unroll
            for (int i_ = 0; i_ < 2; ++i_) nR[h_][i_] = has_next ? S.arow(nxt, h_ * HALF + rA[i_]) : 0;
        for (int t = 0; t < nt; t += 2) {
            const bool last = (t == nt - 2);
            const char* a1 = Ab + (size_t)(t + 1) * kstep;
            const char* a2 = last ? Ab : Ab + (size_t)(t + 2) * kstep; const char* b2 = last ? nB : cB + (size_t)(t + 2) * kstep;
#pragma unroll
            for (int h_ = 0; h_ < 2; ++h_)
#pragma unroll
                for (int i_ = 0; i_ < 2; ++i_) o2[h_][i_] = cO[h_][i_];
            if (last && has_next) {
#pragma unroll
                for (int h_ = 0; h_ < 2; ++h_)
#pragma unroll
                    for (int i_ = 0; i_ < 2; ++i_) { int v_ = nR[h_][i_]; asm volatile("" : "+v"(v_)); o2[h_][i_] = (unsigned)v_ * (unsigned)(K * 2) + cAo[i_]; } }
            const char* a3 = a2 + kstep; const char* b3 = b2 + kstep;
            if (last && has_next) S.a_ready(nxt);
            if constexpr (SP2) {
            PG8_LDB(B0, 0, 0); PG8_LDB(B1, 0, 1); PG8_SCHED; PG8_LDA(At, 0, 0); PG8_STAGE(PG8_SA(1, 1), a1, cO[1]);
            PG8_WAIT_V(8); PG8_WAIT_L(0); PG8_BAR; PG8_MMA(0, 0, At, B0); PG8_MMA(0, 1, At, B1); PG8_BAR; PG8_SCHED;
            PG8_LDA(At, 0, 1); PG8_STAGE(PG8_SB(0, 0), b2, voffB); PG8_STAGE(PG8_SB(0, 1), b2 + hstep, voffB); PG8_STAGE(PG8_SA(0, 0), a2, o2[0]);
            PG8_WAIT_V(8); PG8_WAIT_L(0); PG8_BAR; PG8_MMA(1, 0, At, B0); PG8_MMA(1, 1, At, B1); PG8_BAR; PG8_SCHED;
            PG8_LDB(B0, 1, 0); PG8_LDB(B1, 1, 1); PG8_SCHED; PG8_LDA(At, 1, 0); PG8_STAGE(PG8_SA(0, 1), a2, o2[1]);
            PG8_WAIT_V(8); PG8_WAIT_L(0); PG8_BAR; PG8_MMA(0, 0, At, B0); PG8_MMA(0, 1, At, B1); PG8_BAR; PG8_SCHED;
            PG8_LDA(At, 1, 1); PG8_STAGE(PG8_SB(1, 0), b3, voffB); PG8_STAGE(PG8_SB(1, 1), b3 + hstep, voffB); PG8_STAGE(PG8_SA(1, 0), a3, o2[0]);
            PG8_WAIT_V(8); PG8_WAIT_L(0); PG8_BAR; PG8_MMA(1, 0, At, B0); PG8_MMA(1, 1, At, B1); PG8_BAR; PG8_SCHED;
            }
        }
        if constexpr (ALIGN_EPI) { if (wr == 0) PG8_BAR; }
        if constexpr (!Epi::AFTER_DRAIN) { E(acc, cur, wr, wc, fr, fq); S.done(cur); }
        if (!has_next) break;
#pragma unroll
        for (int a = 0; a < 2; ++a)
#pragma unroll
            for (int b = 0; b < 2; ++b)
#pragma unroll
                for (int m = 0; m < 4; ++m)
#pragma unroll
                    for (int n = 0; n < 2; ++n) acc[a][b][m][n] = (f32x4){0.f, 0.f, 0.f, 0.f};
        cur = nxt; cB = nB; ++ui;
#pragma unroll
        for (int h_ = 0; h_ < 2; ++h_)
#pragma unroll
            for (int i_ = 0; i_ < 2; ++i_) cO[h_][i_] = o2[h_][i_];
        if constexpr (ALIGN_EPI) { if (wr == 1) PG8_BAR; }
    }
    PG8_WAIT_V(0);
    if constexpr (!ALIGN_EPI) { if (wr == 0) PG8_BAR; }
    PG8_BAR;
    if constexpr (Epi::AFTER_DRAIN) { E.fused(acc, cur, wr, wc, fr, fq, lds, wid, lane); S.done(cur); }
#undef PG8_ROWS
#undef PG8_SA
#undef PG8_SB
#undef PG8_STAGE
#undef PG8_LDA
#undef PG8_LDB
#undef PG8_MMA
#undef PG8_WAIT_V
#undef PG8_WAIT_L
#undef PG8_BAR
#undef PG8_SCHED
}
typedef int v4i_t __attribute__((ext_vector_type(4)));
typedef int v8i_t __attribute__((ext_vector_type(8)));
template <class Epi, class Sched, bool ALIGN_EPI = false, bool SP2 = false>
__device__ __forceinline__ void gemm_phase_f8(PG8_LAS unsigned char* lds, const Gemm g, const Sched& S, const Epi& E) {
    const int tid = threadIdx.x, wid = __builtin_amdgcn_readfirstlane(tid >> 6), lane = tid & 63, wr = wid >> 2, wc = wid & 3, fr = lane & 15, fq = lane >> 4;
    const int K = g.K, nt = K / BK;
    unsigned voffA[2], voffB[2];
#pragma unroll
    for (int i = 0; i < 2; ++i) { int R, C; stage_rc(tid * 16 + i * 8192, R, C); const int Rb = Epi::PERM ? ((R & ~31) + perm32(R & 31)) : R;
        voffA[i] = (unsigned)(R * K + C) * 2u; voffB[i] = (unsigned)(Rb * K + C) * 2u; }
    const size_t kstep = (size_t)(BK * 2);
    const size_t hstep = (size_t)HALF * K * 2;
    const size_t tstep = 2 * hstep;
    const unsigned ldsw = (unsigned)wid * 1024u;
    const int aoff = lds_byte(wr * 64 + fr, fq * 8), boff = lds_byte(wc * 32 + fr, fq * 8);
#define PG8_SA(b, h) (((b) * 2 + (h)) * HTB)
#define PG8_SB(b, h) ((4 + (b) * 2 + (h)) * HTB)
#define PG8_STAGE(bufoff, gbase, voff) do { _Pragma("unroll") for (int _i = 0; _i < 2; ++_i) \
        __builtin_amdgcn_global_load_lds((const unsigned*)((const char*)(gbase) + (voff)[_i]), (PG8_LAS unsigned*)(lds + (bufoff) + ldsw + _i * 8192), 16, 0, 0); } while (0)
#define PG8_LDA(dst, b, h) do { _Pragma("unroll") for (int m = 0; m < 4; ++m) { const v4i_t lo_ = *(const PG8_LAS v4i_t*)(lds + PG8_SA(b, h) + aoff + m * 2048), hi_ = *(const PG8_LAS v4i_t*)(lds + PG8_SA(b, h) + aoff + m * 2048 + 1024); dst[m] = __builtin_shufflevector(lo_, hi_, 0, 1, 2, 3, 4, 5, 6, 7); } } while (0)
#define PG8_LDB(dst, b, h) do { _Pragma("unroll") for (int n = 0; n < 2; ++n) { const v4i_t lo_ = *(const PG8_LAS v4i_t*)(lds + PG8_SB(b, h) + boff + n * 2048), hi_ = *(const PG8_LAS v4i_t*)(lds + PG8_SB(b, h) + boff + n * 2048 + 1024); dst[n] = __builtin_shufflevector(lo_, hi_, 0, 1, 2, 3, 4, 5, 6, 7); } } while (0)
#define PG8_MMA(ai, bj, At, Bt) do { __builtin_amdgcn_s_setprio(1); _Pragma("unroll") for (int m = 0; m < 4; ++m) _Pragma("unroll") for (int n = 0; n < 2; ++n) \
        asm volatile("v_mfma_scale_f32_16x16x128_f8f6f4 %0, %1, %2, %0, %3, %3 op_sel_hi:[0,0,0]" : "+v"(acc[ai][bj][m][n]) : "v"(Bt[n]), "v"(At[m]), "v"(scl_)); __builtin_amdgcn_s_setprio(0); } while (0)
#define PG8_WAIT_V(n) asm volatile("s_waitcnt vmcnt(" #n ")" ::: "memory")
#define PG8_WAIT_L(n) asm volatile("s_waitcnt lgkmcnt(" #n ")" ::: "memory")
#define PG8_BAR __builtin_amdgcn_s_barrier()
#define PG8_SCHED __builtin_amdgcn_sched_barrier(0)
    Unit cur, nxt; int ui = 0;
    if (!S.next(0, cur)) return;
    f32x4 acc[2][2][4][2];
#pragma unroll
    for (int a = 0; a < 2; ++a)
#pragma unroll
        for (int b = 0; b < 2; ++b)
#pragma unroll
            for (int m = 0; m < 4; ++m)
#pragma unroll
                for (int n = 0; n < 2; ++n) acc[a][b][m][n] = (f32x4){0.f, 0.f, 0.f, 0.f};
    const int scl_ = 0x7f7f7f7f;
    v8i_t At[4], B0[2], B1[2];
    const char* cA = (const char*)g.A + (size_t)cur.pm * tstep; const char* cB = (const char*)g.Bt + (size_t)cur.pn * tstep;
    S.a_ready(cur);
    if constexpr (SP2) {
        PG8_STAGE(PG8_SB(0, 0), cB, voffB); PG8_STAGE(PG8_SB(0, 1), cB + hstep, voffB); PG8_STAGE(PG8_SA(0, 0), cA, voffA); PG8_STAGE(PG8_SA(0, 1), cA + hstep, voffA);
        if (wr == 1) PG8_BAR;
        PG8_WAIT_V(2); PG8_BAR;
        PG8_STAGE(PG8_SB(1, 0), cB + kstep, voffB); PG8_STAGE(PG8_SA(1, 0), cA + kstep, voffA); PG8_STAGE(PG8_SB(1, 1), cB + hstep + kstep, voffB);
        PG8_WAIT_V(6); PG8_BAR;
    } else {
        PG8_STAGE(PG8_SB(0, 0), cB, voffB); PG8_STAGE(PG8_SA(0, 0), cA, voffA); PG8_STAGE(PG8_SB(0, 1), cB + hstep, voffB); PG8_STAGE(PG8_SA(0, 1), cA + hstep, voffA);
        if (wr == 1) PG8_BAR;
        PG8_WAIT_V(4); PG8_BAR;
        PG8_STAGE(PG8_SB(1, 0), cB + kstep, voffB); PG8_STAGE(PG8_SA(1, 0), cA + kstep, voffA); PG8_STAGE(PG8_SB(1, 1), cB + hstep + kstep, voffB);
        PG8_WAIT_V(6); PG8_BAR;
    }
    for (;;) {
        const bool has_next = S.next(ui + 1, nxt);
        const char* nA = has_next ? (const char*)g.A + (size_t)nxt.pm * tstep : cA; const char* nB = has_next ? (const char*)g.Bt + (size_t)nxt.pn * tstep : cB;
        for (int t = 0; t < nt; t += 2) {
            const bool last = (t == nt - 2);
            const char* a1 = cA + (size_t)(t + 1) * kstep;
            const char* a2 = last ? nA : cA + (size_t)(t + 2) * kstep; const char* b2 = last ? nB : cB + (size_t)(t + 2) * kstep;
            const char* a3 = a2 + kstep; const char* b3 = b2 + kstep;
            if (last && has_next) S.a_ready(nxt);
            if constexpr (SP2) {
            PG8_LDB(B0, 0, 0); PG8_LDB(B1, 0, 1); PG8_SCHED; PG8_LDA(At, 0, 0); PG8_STAGE(PG8_SA(1, 1), a1 + hstep, voffA);
            PG8_WAIT_V(8); PG8_WAIT_L(0); PG8_BAR; PG8_MMA(0, 0, At, B0); PG8_MMA(0, 1, At, B1); PG8_BAR; PG8_SCHED;
            PG8_LDA(At, 0, 1); PG8_STAGE(PG8_SB(0, 0), b2, voffB); PG8_STAGE(PG8_SB(0, 1), b2 + hstep, voffB); PG8_STAGE(PG8_SA(0, 0), a2, voffA);
            PG8_WAIT_V(8); PG8_WAIT_L(0); PG8_BAR; PG8_MMA(1, 0, At, B0); PG8_MMA(1, 1, At, B1); PG8_BAR; PG8_SCHED;
            PG8_LDB(B0, 1, 0); PG8_LDB(B1, 1, 1); PG8_SCHED; PG8_LDA(At, 1, 0); PG8_STAGE(PG8_SA(0, 1), a2 + hstep, voffA);
            PG8_WAIT_V(8); PG8_WAIT_L(0); PG8_BAR; PG8_MMA(0, 0, At, B0); PG8_MMA(0, 1, At, B1); PG8_BAR; PG8_SCHED;
            PG8_LDA(At, 1, 1); PG8_STAGE(PG8_SB(1, 0), b3, voffB); PG8_STAGE(PG8_SB(1, 1), b3 + hstep, voffB); PG8_STAGE(PG8_SA(1, 0), a3, voffA);
            PG8_WAIT_V(8); PG8_WAIT_L(0); PG8_BAR; PG8_MMA(1, 0, At, B0); PG8_MMA(1, 1, At, B1); PG8_BAR; PG8_SCHED;
            } else {
            PG8_LDB(B0, 0, 0); PG8_SCHED; PG8_LDA(At, 0, 0); PG8_STAGE(PG8_SA(1, 1), a1 + hstep, voffA);
            PG8_WAIT_L(8); PG8_BAR; PG8_WAIT_L(0); PG8_MMA(0, 0, At, B0); PG8_BAR; PG8_SCHED;
            PG8_LDB(B1, 0, 1); PG8_STAGE(PG8_SB(0, 0), b2, voffB);
            PG8_BAR; PG8_WAIT_L(0); PG8_MMA(0, 1, At, B1); PG8_BAR;
            PG8_LDA(At, 0, 1); PG8_STAGE(PG8_SA(0, 0), a2, voffA);
            PG8_BAR; PG8_WAIT_L(0); PG8_MMA(1, 0, At, B0); PG8_BAR; PG8_SCHED;
            PG8_STAGE(PG8_SB(0, 1), b2 + hstep, voffB);
            PG8_WAIT_V(6); PG8_BAR; PG8_MMA(1, 1, At, B1); PG8_BAR;
            PG8_LDB(B0, 1, 0); PG8_SCHED; PG8_LDA(At, 1, 0); PG8_STAGE(PG8_SA(0, 1), a2 + hstep, voffA);
            PG8_WAIT_L(8); PG8_BAR; PG8_WAIT_L(0); PG8_MMA(0, 0, At, B0); PG8_BAR; PG8_SCHED;
            PG8_LDB(B1, 1, 1); PG8_STAGE(PG8_SB(1, 0), b3, voffB);
            PG8_BAR; PG8_WAIT_L(0); PG8_MMA(0, 1, At, B1); PG8_BAR;
            PG8_LDA(At, 1, 1); PG8_STAGE(PG8_SA(1, 0), a3, voffA);
            PG8_BAR; PG8_WAIT_L(0); PG8_MMA(1, 0, At, B0); PG8_BAR; PG8_SCHED;
            PG8_STAGE(PG8_SB(1, 1), b3 + hstep, voffB);
            PG8_WAIT_V(6); PG8_BAR; PG8_MMA(1, 1, At, B1); PG8_BAR;
            }
        }
        if constexpr (ALIGN_EPI) { if (wr == 0) PG8_BAR; }
        asm volatile("s_nop 15\n\ts_nop 15" ::: "memory");
        if constexpr (!Epi::AFTER_DRAIN) { E(acc, cur, wr, wc, fr, fq); S.done(cur); }
        if (!has_next) break;
#pragma unroll
        for (int a = 0; a < 2; ++a)
#pragma unroll
            for (int b = 0; b < 2; ++b)
#pragma unroll
                for (int m = 0; m < 4; ++m)
#pragma unroll
                    for (int n = 0; n < 2; ++n) acc[a][b][m][n] = (f32x4){0.f, 0.f, 0.f, 0.f};
        cur = nxt; cA = nA; cB = nB; ++ui;
        if constexpr (ALIGN_EPI) { if (wr == 1) PG8_BAR; }
    }
    PG8_WAIT_V(0);
    if constexpr (!ALIGN_EPI) { if (wr == 0) PG8_BAR; }
    PG8_BAR;
    if constexpr (Epi::AFTER_DRAIN) { E.fused(acc, cur, wr, wc, fr, fq, lds, wid, lane); S.done(cur); }
#undef PG8_SA
#undef PG8_SB
#undef PG8_STAGE
#undef PG8_LDA
#undef PG8_LDB
#undef PG8_MMA
#undef PG8_WAIT_V
#undef PG8_WAIT_L
#undef PG8_BAR
#undef PG8_SCHED
}

template <class Epi, class Sched>
__device__ __forceinline__ void gemm_phase_gather_f8(PG8_LAS unsigned char* lds, const Gemm g, const Sched& S, const Epi& E) {
    constexpr bool ALIGN_EPI = true, SP2 = true;
    const int tid = threadIdx.x, wid = __builtin_amdgcn_readfirstlane(tid >> 6), lane = tid & 63, wr = wid >> 2, wc = wid & 3, fr = lane & 15, fq = lane >> 4;
    const int K = g.K, nt = K / BK;
    unsigned voffA[2], voffB[2];
#pragma unroll
    for (int i = 0; i < 2; ++i) { int R, C; stage_rc(tid * 16 + i * 8192, R, C); const int Rb = Epi::PERM ? ((R & ~31) + perm32(R & 31)) : R;
        voffA[i] = (unsigned)(R * K + C) * 2u; voffB[i] = (unsigned)(Rb * K + C) * 2u; }
    const size_t kstep = (size_t)(BK * 2);
    const size_t hstep = (size_t)HALF * K * 2;
    const size_t tstep = 2 * hstep;
    const unsigned ldsw = (unsigned)wid * 1024u;
    const int aoff = lds_byte(wr * 64 + fr, fq * 8), boff = lds_byte(wc * 32 + fr, fq * 8);
#define PG8_SA(b, h) (((b) * 2 + (h)) * HTB)
#define PG8_SB(b, h) ((4 + (b) * 2 + (h)) * HTB)
#define PG8_STAGE(bufoff, gbase, voff) do { _Pragma("unroll") for (int _i = 0; _i < 2; ++_i) \
        __builtin_amdgcn_global_load_lds((const unsigned*)((const char*)(gbase) + (voff)[_i]), (PG8_LAS unsigned*)(lds + (bufoff) + ldsw + _i * 8192), 16, 0, 0); } while (0)
#define PG8_LDA(dst, b, h) do { _Pragma("unroll") for (int m = 0; m < 4; ++m) { const v4i_t lo_ = *(const PG8_LAS v4i_t*)(lds + PG8_SA(b, h) + aoff + m * 2048), hi_ = *(const PG8_LAS v4i_t*)(lds + PG8_SA(b, h) + aoff + m * 2048 + 1024); dst[m] = __builtin_shufflevector(lo_, hi_, 0, 1, 2, 3, 4, 5, 6, 7); } } while (0)
#define PG8_LDB(dst, b, h) do { _Pragma("unroll") for (int n = 0; n < 2; ++n) { const v4i_t lo_ = *(const PG8_LAS v4i_t*)(lds + PG8_SB(b, h) + boff + n * 2048), hi_ = *(const PG8_LAS v4i_t*)(lds + PG8_SB(b, h) + boff + n * 2048 + 1024); dst[n] = __builtin_shufflevector(lo_, hi_, 0, 1, 2, 3, 4, 5, 6, 7); } } while (0)
#define PG8_MMA(ai, bj, At, Bt) do { __builtin_amdgcn_s_setprio(1); _Pragma("unroll") for (int m = 0; m < 4; ++m) _Pragma("unroll") for (int n = 0; n < 2; ++n) \
        asm volatile("v_mfma_scale_f32_16x16x128_f8f6f4 %0, %1, %2, %0, %3, %3 op_sel_hi:[0,0,0]" : "+v"(acc[ai][bj][m][n]) : "v"(Bt[n]), "v"(At[m]), "v"(scl_)); __builtin_amdgcn_s_setprio(0); } while (0)
#define PG8_WAIT_V(n) asm volatile("s_waitcnt vmcnt(" #n ")" ::: "memory")
#define PG8_WAIT_L(n) asm volatile("s_waitcnt lgkmcnt(" #n ")" ::: "memory")
#define PG8_BAR __builtin_amdgcn_s_barrier()
#define PG8_SCHED __builtin_amdgcn_sched_barrier(0)
    Unit cur, nxt; int ui = 0;
    if (!S.next(0, cur)) return;
    int rA[2]; unsigned cAo[2];
#pragma unroll
    for (int i = 0; i < 2; ++i) { int R, C; stage_rc(tid * 16 + i * 8192, R, C); rA[i] = R; cAo[i] = (unsigned)C * 2u; }
    unsigned cO[2][2], o2[2][2]; int nR[2][2];
#define PG8_ROWS(dst, u) do { _Pragma("unroll") for (int h_ = 0; h_ < 2; ++h_) _Pragma("unroll") for (int i_ = 0; i_ < 2; ++i_) \
        dst[h_][i_] = (unsigned)S.arow(u, h_ * HALF + rA[i_]) * (unsigned)(K * 2) + cAo[i_]; } while (0)
    PG8_ROWS(cO, cur);
    f32x4 acc[2][2][4][2];
#pragma unroll
    for (int a = 0; a < 2; ++a)
#pragma unroll
        for (int b = 0; b < 2; ++b)
#pragma unroll
            for (int m = 0; m < 4; ++m)
#pragma unroll
                for (int n = 0; n < 2; ++n) acc[a][b][m][n] = (f32x4){0.f, 0.f, 0.f, 0.f};
    const int scl_ = 0x7f7f7f7f;
    v8i_t At[4], B0[2], B1[2];
    const char* const Ab = (const char*)g.A; const char* cB = (const char*)g.Bt + (size_t)cur.pn * tstep;
    S.a_ready(cur);
    if constexpr (SP2) {
        PG8_STAGE(PG8_SB(0, 0), cB, voffB); PG8_STAGE(PG8_SB(0, 1), cB + hstep, voffB); PG8_STAGE(PG8_SA(0, 0), Ab, cO[0]); PG8_STAGE(PG8_SA(0, 1), Ab, cO[1]);
        if (wr == 1) PG8_BAR;
        PG8_WAIT_V(2); PG8_BAR;
        PG8_STAGE(PG8_SB(1, 0), cB + kstep, voffB); PG8_STAGE(PG8_SA(1, 0), Ab + kstep, cO[0]); PG8_STAGE(PG8_SB(1, 1), cB + hstep + kstep, voffB);
        PG8_WAIT_V(6); PG8_BAR;
    }
    for (;;) {
        const bool has_next = S.next(ui + 1, nxt);
        const char* nB = has_next ? (const char*)g.Bt + (size_t)nxt.pn * tstep : cB;
#pragma unroll
        for (int h_ = 0; h_ < 2; ++h_)
#pragma unroll
            for (int i_ = 0; i_ < 2; ++i_) nR[h_][i_] = has_next ? S.arow(nxt, h_ * HALF + rA[i_]) : 0;
        for (int t = 0; t < nt; t += 2) {
            const bool last = (t == nt - 2);
            const char* a1 = Ab + (size_t)(t + 1) * kstep;
            const char* a2 = last ? Ab : Ab + (size_t)(t + 2) * kstep; const char* b2 = last ? nB : cB + (size_t)(t + 2) * kstep;
#pragma unroll
            for (int h_ = 0; h_ < 2; ++h_)
#pragma unroll
                for (int i_ = 0; i_ < 2; ++i_) o2[h_][i_] = cO[h_][i_];
            if (last && has_next) {
#pragma unroll
                for (int h_ = 0; h_ < 2; ++h_)
#pragma unroll
                    for (int i_ = 0; i_ < 2; ++i_) { int v_ = nR[h_][i_]; asm volatile("" : "+v"(v_)); o2[h_][i_] = (unsigned)v_ * (unsigned)(K * 2) + cAo[i_]; } }
            const char* a3 = a2 + kstep; const char* b3 = b2 + kstep;
            if (last && has_next) S.a_ready(nxt);
            if constexpr (SP2) {
            PG8_LDB(B0, 0, 0); PG8_LDB(B1, 0, 1); PG8_SCHED; PG8_LDA(At, 0, 0); PG8_STAGE(PG8_SA(1, 1), a1, cO[1]);
            PG8_WAIT_V(8); PG8_WAIT_L(0); PG8_BAR; PG8_MMA(0, 0, At, B0); PG8_MMA(0, 1, At, B1); PG8_BAR; PG8_SCHED;
            PG8_LDA(At, 0, 1); PG8_STAGE(PG8_SB(0, 0), b2, voffB); PG8_STAGE(PG8_SB(0, 1), b2 + hstep, voffB); PG8_STAGE(PG8_SA(0, 0), a2, o2[0]);
            PG8_WAIT_V(8); PG8_WAIT_L(0); PG8_BAR; PG8_MMA(1, 0, At, B0); PG8_MMA(1, 1, At, B1); PG8_BAR; PG8_SCHED;
            PG8_LDB(B0, 1, 0); PG8_LDB(B1, 1, 1); PG8_SCHED; PG8_LDA(At, 1, 0); PG8_STAGE(PG8_SA(0, 1), a2, o2[1]);
            PG8_WAIT_V(8); PG8_WAIT_L(0); PG8_BAR; PG8_MMA(0, 0, At, B0); PG8_MMA(0, 1, At, B1); PG8_BAR; PG8_SCHED;
            PG8_LDA(At, 1, 1); PG8_STAGE(PG8_SB(1, 0), b3, voffB); PG8_STAGE(PG8_SB(1, 1), b3 + hstep, voffB); PG8_STAGE(PG8_SA(1, 0), a3, o2[0]);
            PG8_WAIT_V(8); PG8_WAIT_L(0); PG8_BAR; PG8_MMA(1, 0, At, B0); PG8_MMA(1, 1, At, B1); PG8_BAR; PG8_SCHED;
            }
        }
        if constexpr (ALIGN_EPI) { if (wr == 0) PG8_BAR; }
        asm volatile("s_nop 15\n\ts_nop 15" ::: "memory");
        if constexpr (!Epi::AFTER_DRAIN) { E(acc, cur, wr, wc, fr, fq); S.done(cur); }
        if (!has_next) break;
#pragma unroll
        for (int a = 0; a < 2; ++a)
#pragma unroll
            for (int b = 0; b < 2; ++b)
#pragma unroll
                for (int m = 0; m < 4; ++m)
#pragma unroll
                    for (int n = 0; n < 2; ++n) acc[a][b][m][n] = (f32x4){0.f, 0.f, 0.f, 0.f};
        cur = nxt; cB = nB; ++ui;
#pragma unroll
        for (int h_ = 0; h_ < 2; ++h_)
#pragma unroll
            for (int i_ = 0; i_ < 2; ++i_) cO[h_][i_] = o2[h_][i_];
        if constexpr (ALIGN_EPI) { if (wr == 1) PG8_BAR; }
    }
    PG8_WAIT_V(0);
    if constexpr (!ALIGN_EPI) { if (wr == 0) PG8_BAR; }
    PG8_BAR;
    if constexpr (Epi::AFTER_DRAIN) { E.fused(acc, cur, wr, wc, fr, fq, lds, wid, lane); S.done(cur); }
#undef PG8_ROWS
#undef PG8_SA
#undef PG8_SB
#undef PG8_STAGE
#undef PG8_LDA
#undef PG8_LDB
#undef PG8_MMA
#undef PG8_WAIT_V
#undef PG8_WAIT_L
#undef PG8_BAR
#undef PG8_SCHED
}
}

struct EpiP { bf16_t* P; int n0; __device__ __forceinline__ void operator()(int r, int cl, float a, float) const { P[(size_t)r * NPROJ + n0 + cl] = (bf16_t)f2bf(a); } };
__device__ __forceinline__ void phase_gemm1_naive(const Params& p, const Ctx& c) {
    const bf16_t* H = (const bf16_t*)(p.ws + WS_H); const bf16_t* W = (const bf16_t*)(p.ws + WS_WINT); bf16_t* P = (bf16_t*)(p.ws + WS_P);
    constexpr int NT_N = NPROJ / 64, NT_M = M / 128;
    for (int it = c.bid; it < NT_M * NT_N; it += c.G) {
        const int mt = it / NT_N, nt = it % NT_N;
        ngemm_tile<false>(ARowPlain{H, 1024}, W + (size_t)nt * 64 * 1024, nullptr, 1024, mt * 128, EpiP{P, nt * 64}, (LAS float*)c.lds, c.tid);
    }
}

typedef short bf16x8c __attribute__((ext_vector_type(8)));
typedef float f32x16c __attribute__((ext_vector_type(16)));
__device__ __forceinline__ void phase_conv(const Params& p, const Ctx& c) {
    unsigned char* ws = p.ws;
    const bf16_t* P = (const bf16_t*)(ws + WS_P);
    const int tid = c.tid;
    LAS bf16_t* raw = (LAS bf16_t*)c.lds;
    LAS bf16_t* outb = (LAS bf16_t*)(c.lds + 132 * 256 * 2);
    for (int it = c.bid; it < 2 * 64 * 6; it += c.G) {
        const int part = it % 6, bc = it / 6, b = bc / 64, ch_ = bc % 64, t0 = ch_ * 128;
        __syncthreads();
        {
            u32x4 rv[9];
#pragma unroll
            for (int i = 0; i < 9; ++i) { const int idx = tid + 512 * i, r = idx >> 5, c8 = idx & 31, tok = t0 - 2 + r;
                rv[i] = (u32x4){0u, 0u, 0u, 0u};
                if (idx < 132 * 32 && tok >= 0 && tok < S) rv[i] = *(const u32x4*)(P + (size_t)(b * S + tok) * NPROJ + PXBC + part * 256 + c8 * 8); }
#pragma unroll
            for (int i = 0; i < 9; ++i) { const int idx = tid + 512 * i, r = idx >> 5, c8 = idx & 31;
                if (idx < 132 * 32) *(LAS u32x4*)(raw + r * 256 + c8 * 8) = rv[i]; }
        }
        __syncthreads();
        {
            const int ch = tid & 255, hf = tid >> 8, cg_ = part * 256 + ch;
            const float* cw = p.in[3]; const float cb = p.in[4][cg_];
            const float w0 = cw[0 * 1536 + cg_], w1 = cw[1 * 1536 + cg_], w2 = cw[2 * 1536 + cg_], w3 = cw[3 * 1536 + cg_], w4 = cw[4 * 1536 + cg_];
            const LAS bf16_t* rp = raw + (hf * 64) * 256 + ch;
            float r0 = bf2f(rp[0 * 256]), r1 = bf2f(rp[1 * 256]), r2 = bf2f(rp[2 * 256]), r3 = bf2f(rp[3 * 256]);
            unsigned ov[32];
#pragma unroll
            for (int i = 0; i < 64; ++i) {
                const float r4 = bf2f(rp[(i + 4) * 256]);
                float a = cb; a = fmaf(w0, r0, a); a = fmaf(w1, r1, a); a = fmaf(w2, r2, a); a = fmaf(w3, r3, a); a = fmaf(w4, r4, a);
                const unsigned hv = f2bf(a * sigmoidf_(a));
                if (i & 1) ov[i >> 1] |= hv << 16; else ov[i >> 1] = hv;
                r0 = r1; r1 = r2; r2 = r3; r3 = r4;
            }
            if (part <= 4) {
                bf16_t* dst = (part < 4 ? (bf16_t*)(ws + WS_XT) + ((size_t)(b * 64 + ch_) * 16 + part * 4) * 64 * 128
                                        : (bf16_t*)(ws + WS_BMT) + (size_t)(b * 64 + ch_) * 2 * 128 * 128) + (size_t)ch * 128 + hf * 64;
#pragma unroll
                for (int q = 0; q < 8; ++q) *(u32x4*)(dst + q * 8) = (u32x4){ov[4 * q], ov[4 * q + 1], ov[4 * q + 2], ov[4 * q + 3]};
            }
            if (part >= 4) {
#pragma unroll
                for (int i = 0; i < 64; ++i) outb[(hf * 64 + i) * 256 + ch] = (bf16_t)((i & 1) ? (ov[i >> 1] >> 16) : (ov[i >> 1] & 0xffffu));
            }
        }
        if (part >= 4) {
            __syncthreads();
            bf16_t* dst = (bf16_t*)(ws + (part == 4 ? WS_BMR : WS_CMR)) + (size_t)(b * S + t0) * 256;
#pragma unroll
            for (int q = 0; q < 8; ++q) { const int idx = tid + 512 * q, l = idx >> 5, c8 = idx & 31;
                *(u32x4*)(dst + (size_t)l * 256 + c8 * 8) = *(const LAS u32x4*)(outb + l * 256 + c8 * 8); }
        }
    }
    {
        float* DT = (float*)(ws + WS_DT); float* ACS = (float*)(ws + WS_ACS); float* CDEC = (float*)(ws + WS_CDEC);
        const bf16_t* H = (const bf16_t*)(ws + WS_H); const bf16_t* Wdt = (const bf16_t*)(ws + WS_WINT) + (size_t)PDT * 1024;
        constexpr int WS_ = 1032;
        LAS bf16_t* wl = (LAS bf16_t*)c.lds; LAS float* dtr = (LAS float*)(c.lds + 32 * WS_ * 2);
        const int lane = c.lane, r = lane & 31, hh = lane >> 5;
        bool staged = false;
        for (int it = c.bid; it < 128; it += c.G) {
            const int b = it / 64, ch_ = it % 64, t0 = ch_ * 128;
            __syncthreads();
            if (!staged) { staged = true;
#pragma unroll
                for (int i = 0; i < 8; ++i) { const int idx = tid + 512 * i, row = idx >> 7, c8 = idx & 127; *(LAS u32x4*)(wl + row * WS_ + c8 * 8) = *(const u32x4*)(Wdt + (size_t)row * 1024 + c8 * 8); }
                __syncthreads(); }
            {
                const int rb = c.wave & 3, kh = c.wave >> 2;
                const bf16_t* hrow = H + ((size_t)b * S + t0 + rb * 32 + r) * 1024 + kh * 512 + 8 * hh;
                f32x16c acc = {};
#pragma unroll
                for (int k8 = 0; k8 < 4; ++k8) { bf16x8c a[8];
#pragma unroll
                    for (int ks = 0; ks < 8; ++ks) a[ks] = *(const bf16x8c*)(hrow + (k8 * 8 + ks) * 16);
#pragma unroll
                    for (int ks = 0; ks < 8; ++ks) acc = __builtin_amdgcn_mfma_f32_32x32x16_bf16(a[ks], *(const LAS bf16x8c*)(wl + r * WS_ + kh * 512 + (k8 * 8 + ks) * 16 + 8 * hh), acc, 0, 0, 0); }
#pragma unroll
                for (int i = 0; i < 16; ++i) { const int l = rb * 32 + (i & 3) + 8 * (i >> 2) + 4 * hh; dtr[(kh * 128 + l) * 33 + r] = acc[i]; }
            }
            __syncthreads();
#pragma unroll
            for (int qi = 0; qi < 4; ++qi) {
                const int q = c.wave * 4 + qi, dir = q >> 4, h = q & 15;
                const float bias = dir ? p.in[6][h] : p.in[5][h], nA = -expf(dir ? p.in[8][h] : p.in[7][h]);
                const int l0 = dir ? 127 - lane : lane, l1 = dir ? 63 - lane : lane + 64;
                const size_t tok0 = (size_t)b * S + t0 + l0, tok1 = (size_t)b * S + t0 + l1;
                const float x0 = dtr[l0 * 33 + q] + dtr[(128 + l0) * 33 + q] + bias, x1 = dtr[l1 * 33 + q] + dtr[(128 + l1) * 33 + q] + bias;
                const float d0 = fmaxf(x0, 0.f) + log1pf(expf(-fabsf(x0))), d1 = fmaxf(x1, 0.f) + log1pf(expf(-fabsf(x1)));
                float a0 = d0 * nA, a1 = d1 * nA;
#pragma unroll
                for (int o = 1; o < 64; o <<= 1) { const float t0_ = __shfl_up(a0, o), t1_ = __shfl_up(a1, o); if (lane >= o) { a0 += t0_; a1 += t1_; } }
                const float tot0 = __shfl(a0, 63); a1 += tot0;
                DT[((size_t)dir * M + tok0) * 16 + h] = d0; DT[((size_t)dir * M + tok1) * 16 + h] = d1;
                ACS[((size_t)dir * M + tok0) * 16 + h] = a0; ACS[((size_t)dir * M + tok1) * 16 + h] = a1;
                if (lane == 63) CDEC[((dir * 2 + b) * 64 + ch_) * 16 + h] = expf(a1);
            }
        }
        __syncthreads();
    }
    {
        const int gw = c.bid * 8 + c.wave, NGW = c.G * 8, lane = c.lane;
        const float* rc = (const float*)(ws + WS_ROPE); const float* rs = rc + 4096;
        const int sub = lane >> 4, j = lane & 15, axis = j >> 3, i0 = 8 * (j & 3); const bool second = (j & 4) != 0;
        const f32x4 gq0 = *(const f32x4*)(p.in[11] + 8 * j), gq1 = *(const f32x4*)(p.in[11] + 8 * j + 4), gk0 = *(const f32x4*)(p.in[12] + 8 * j), gk1 = *(const f32x4*)(p.in[12] + 8 * j + 4);
        unsigned char* QN = ws + WS_QN; unsigned char* KN = ws + WS_KN;
        for (int base0 = gw; base0 < M * 10 / 4; base0 += 4 * NGW) {
            u32x4 vq[4]; int tokq[4], hhq[4];
#pragma unroll
            for (int u = 0; u < 4; ++u) { const int base = base0 + u * NGW, it = base * 4 + sub; tokq[u] = it / 10; hhq[u] = it % 10;
                vq[u] = (u32x4){0u, 0u, 0u, 0u};
                if (base < M * 10 / 4) vq[u] = *(const u32x4*)(P + (size_t)tokq[u] * NPROJ + (hhq[u] < 8 ? PQ + hhq[u] * 128 : PK + (hhq[u] - 8) * 128) + 8 * j); }
#pragma unroll
            for (int u = 0; u < 4; ++u) {
                const int base = base0 + u * NGW, tok = tokq[u], hh = hhq[u];
                unsigned char* dst = (hh < 8 ? QN + (size_t)tok * 1024 + hh * 128 : KN + (size_t)tok * 256 + (hh - 8) * 128) + 8 * j;
                const u32x4 v = vq[u];
                float y[8] = {bflo(v.x), bfhi(v.x), bflo(v.y), bfhi(v.y), bflo(v.z), bfhi(v.z), bflo(v.w), bfhi(v.w)};
                float ss = 0.f;
#pragma unroll
                for (int i = 0; i < 8; ++i) ss = fmaf(y[i], y[i], ss);
                ss += __shfl_xor(ss, 1); ss += __shfl_xor(ss, 2); ss += __shfl_xor(ss, 4); ss += __shfl_xor(ss, 8);
                const float rstd = rsqrtf(ss * (1.f / 128.f) + EPS);
                const f32x4 g0 = hh < 8 ? gq0 : gk0, g1 = hh < 8 ? gq1 : gk1;
#pragma unroll
                for (int i = 0; i < 4; ++i) { y[i] *= rstd * g0[i]; y[4 + i] *= rstd * g1[i]; }
                const int s = tok & (S - 1), pos = axis ? (s & 63) : (s >> 6);
                const f32x4 c0 = *(const f32x4*)(rc + pos * 32 + i0), c1 = *(const f32x4*)(rc + pos * 32 + i0 + 4), s0 = *(const f32x4*)(rs + pos * 32 + i0), s1 = *(const f32x4*)(rs + pos * 32 + i0 + 4);
                float o[8];
#pragma unroll
                for (int i = 0; i < 8; ++i) { const float other = __shfl_xor(y[i], 4); const float cs = i < 4 ? c0[i] : c1[i - 4], sn = i < 4 ? s0[i] : s1[i - 4];
                    o[i] = second ? fmaf(other, sn, y[i] * cs) : fmaf(-other, sn, y[i] * cs); }
                u32x2 w; w.x = pack4_fp8(o[0], o[1], o[2], o[3]); w.y = pack4_fp8(o[4], o[5], o[6], o[7]);
                if (base < M * 10 / 4) *(u32x2*)dst = w;
            }
        }
    }
    {
        unsigned char* VT8 = ws + WS_VB; LAS unsigned char* vt = c.lds;
        for (int it = c.bid; it < 256; it += c.G) {
            const int b = it >> 7, jt = it & 127;
            __syncthreads();
            u32x4 vv[4];
#pragma unroll
            for (int q = 0; q < 4; ++q) { const int idx = tid + 512 * q, key = idx >> 5, c8 = idx & 31; vv[q] = *(const u32x4*)(P + ((size_t)b * S + jt * 64 + key) * NPROJ + PV + c8 * 8); }
#pragma unroll
            for (int q = 0; q < 4; ++q) { const int idx = tid + 512 * q, key = idx >> 5, c8 = idx & 31, d0 = c8 * 8;
                const int off = 32 * ((key >> 2) & 1) + 16 * (key >> 5) + (key & 3) + 4 * ((key & 31) >> 3);
                const unsigned w0 = pack4_fp8(bflo(vv[q].x), bfhi(vv[q].x), bflo(vv[q].y), bfhi(vv[q].y)), w1 = pack4_fp8(bflo(vv[q].z), bfhi(vv[q].z), bflo(vv[q].w), bfhi(vv[q].w));
                LAS unsigned char* dp = vt + d0 * 64 + off;
                dp[0 * 64] = (unsigned char)(w0); dp[1 * 64] = (unsigned char)(w0 >> 8); dp[2 * 64] = (unsigned char)(w0 >> 16); dp[3 * 64] = (unsigned char)(w0 >> 24);
                dp[4 * 64] = (unsigned char)(w1); dp[5 * 64] = (unsigned char)(w1 >> 8); dp[6 * 64] = (unsigned char)(w1 >> 16); dp[7 * 64] = (unsigned char)(w1 >> 24); }
            __syncthreads();
#pragma unroll
            for (int q = 0; q < 2; ++q) { const int idx = tid + 512 * q, kvh = idx >> 9, rem = idx & 511;
                *(u32x4*)(VT8 + ((size_t)(b * 2 + kvh) * 128 + jt) * 8192 + rem * 16) = *(const LAS u32x4*)(vt + kvh * 8192 + rem * 16); }
        }
        __syncthreads();
    }
}

__device__ __forceinline__ void phase_ssd_naive(const Params& p, const Ctx& c) {
    unsigned char* ws = p.ws;
    const bf16_t* P = (const bf16_t*)(ws + WS_P); const bf16_t* XT = (const bf16_t*)(ws + WS_XT);
    const bf16_t* BMR = (const bf16_t*)(ws + WS_BMR); const bf16_t* CMR = (const bf16_t*)(ws + WS_CMR);
    const float* DT = (const float*)(ws + WS_DT); float* YACC = (float*)(ws + WS_ST); bf16_t* YZ = (bf16_t*)(ws + WS_YZ);
    const int pp = c.tid >> 3, nq = c.tid & 7;
    for (int item = c.bid; item < 32; item += c.G) {
        const int b = item >> 4, h = item & 15, g = h >> 3;
        const float dsk = p.in[9][h];
        for (int dir = 0; dir < 2; ++dir) {
            const float A = -expf(dir ? p.in[8][h] : p.in[7][h]);
            float st[16];
#pragma unroll
            for (int i = 0; i < 16; ++i) st[i] = 0.f;
            int t = dir ? S - 1 : 0;
            size_t tok = (size_t)b * S + t;
            u32x4 nb0 = *(const u32x4*)(BMR + tok * 256 + g * 128 + nq * 16), nb1 = *(const u32x4*)(BMR + tok * 256 + g * 128 + nq * 16 + 8);
            u32x4 nc0 = *(const u32x4*)(CMR + tok * 256 + g * 128 + nq * 16), nc1 = *(const u32x4*)(CMR + tok * 256 + g * 128 + nq * 16 + 8);
            float nx = bf2f(XT[((((size_t)b * 64 + (t >> 7)) * 16 + h) * 64 + pp) * 128 + (t & 127)]);
            float ndt = DT[((size_t)dir * M + tok) * 16 + h];
            for (int step = 0; step < S; ++step) {
                const u32x4 b0 = nb0, b1 = nb1, c0 = nc0, c1 = nc1; const float x = nx, dt = ndt; const size_t tokc = tok;
                if (step + 1 < S) {
                    t = dir ? S - 2 - step : step + 1; tok = (size_t)b * S + t;
                    nb0 = *(const u32x4*)(BMR + tok * 256 + g * 128 + nq * 16); nb1 = *(const u32x4*)(BMR + tok * 256 + g * 128 + nq * 16 + 8);
                    nc0 = *(const u32x4*)(CMR + tok * 256 + g * 128 + nq * 16); nc1 = *(const u32x4*)(CMR + tok * 256 + g * 128 + nq * 16 + 8);
                    nx = bf2f(XT[((((size_t)b * 64 + (t >> 7)) * 16 + h) * 64 + pp) * 128 + (t & 127)]);
                    ndt = DT[((size_t)dir * M + tok) * 16 + h];
                }
                const float dec = __expf(dt * A), xdt = x * dt;
                float part = 0.f;
#define SSD_STEP(i, BW, CW, LOHI) { st[i] = fmaf(st[i], dec, LOHI(BW) * xdt); part = fmaf(LOHI(CW), st[i], part); }
                SSD_STEP(0, b0.x, c0.x, bflo) SSD_STEP(1, b0.x, c0.x, bfhi) SSD_STEP(2, b0.y, c0.y, bflo) SSD_STEP(3, b0.y, c0.y, bfhi)
                SSD_STEP(4, b0.z, c0.z, bflo) SSD_STEP(5, b0.z, c0.z, bfhi) SSD_STEP(6, b0.w, c0.w, bflo) SSD_STEP(7, b0.w, c0.w, bfhi)
                SSD_STEP(8, b1.x, c1.x, bflo) SSD_STEP(9, b1.x, c1.x, bfhi) SSD_STEP(10, b1.y, c1.y, bflo) SSD_STEP(11, b1.y, c1.y, bfhi)
                SSD_STEP(12, b1.z, c1.z, bflo) SSD_STEP(13, b1.z, c1.z, bfhi) SSD_STEP(14, b1.w, c1.w, bflo) SSD_STEP(15, b1.w, c1.w, bfhi)
#undef SSD_STEP
                part += __shfl_xor(part, 1); part += __shfl_xor(part, 2); part += __shfl_xor(part, 4);
                if (nq == 0) {
                    const size_t o = tokc * 1024 + h * 64 + pp;
                    if (dir == 0) YACC[o] = part + x * dsk;
                    else { const float y = YACC[o] + part; const float z = bf2f(P[tokc * NPROJ + PZ + h * 64 + pp]); YZ[o] = (bf16_t)f2bf(y * z * sigmoidf_(z)); }
                }
            }
        }
    }
}


typedef short bf16x8 __attribute__((ext_vector_type(8)));
typedef float f32x16 __attribute__((ext_vector_type(16)));
constexpr int TS = 136;
__device__ __forceinline__ bf16x8 ldfrag(const LAS bf16_t* tile, int row, int k0) { return *(const LAS bf16x8*)(tile + row * TS + k0); }
template <int ROWS> __device__ __forceinline__ void load_tile128(LAS bf16_t* dst, const bf16_t* src, int ld, int tid) {
    constexpr int N = ROWS * 16 / 512;
    u32x4 v[N];
#pragma unroll
    for (int i = 0; i < N; ++i) { const int idx = tid + 512 * i; v[i] = *(const u32x4*)(src + (size_t)(idx >> 4) * ld + (idx & 15) * 8); }
#pragma unroll
    for (int i = 0; i < N; ++i) { const int idx = tid + 512 * i; *(LAS u32x4*)(dst + (idx >> 4) * TS + (idx & 15) * 8) = v[i]; }
}
__device__ __forceinline__ void phase_ssd_states(const Params& p, const Ctx& c) {
    unsigned char* ws = p.ws;
    const bf16_t* XT = (const bf16_t*)(ws + WS_XT); const bf16_t* BMT = (const bf16_t*)(ws + WS_BMT);
    const float* DT = (const float*)(ws + WS_DT); const float* ACS = (const float*)(ws + WS_ACS); bf16_t* ST = (bf16_t*)(ws + WS_PREV);
    LAS bf16_t* BTs = (LAS bf16_t*)c.lds; LAS bf16_t* XTf = BTs + 128 * TS; LAS bf16_t* XTb = XTf + 64 * TS; LAS float* wd = (LAS float*)(XTb + 64 * TS);
    const int tid = c.tid, lane = c.lane, r = lane & 31, hh = lane >> 5;
    for (int unit = c.bid; unit < 256; unit += c.G) {
        const int b = unit >> 7, ch = (unit >> 1) & 63, g = unit & 1;
        __syncthreads();
        load_tile128<128>(BTs, BMT + ((size_t)(b * 64 + ch) * 2 + g) * 128 * 128, 128, tid);
        u32x4 xv0, xv1; float pacs = 0.f, pdt = 0.f, paend = 0.f;
        const int wd_d = (tid >> 7) & 1, wd_l = tid & 127; const size_t wd_t0 = (size_t)wd_d * M + (size_t)b * S + ch * 128;
#define S1_PREFETCH(H) do { const bf16_t* xt_ = XT + ((size_t)(b * 64 + ch) * 16 + (H)) * 64 * 128; \
            xv0 = *(const u32x4*)(xt_ + (tid >> 4) * 128 + (tid & 15) * 8); xv1 = *(const u32x4*)(xt_ + ((tid + 512) >> 4) * 128 + (tid & 15) * 8); \
            if (tid < 256) { pacs = ACS[(wd_t0 + wd_l) * 16 + (H)]; pdt = DT[(wd_t0 + wd_l) * 16 + (H)]; paend = ACS[(wd_t0 + (wd_d ? 0 : 127)) * 16 + (H)]; } } while (0)
        S1_PREFETCH(g * 8);
#pragma unroll 1
        for (int h8 = 0; h8 < 8; ++h8) {
            const int h = g * 8 + h8;
            __syncthreads();
            if (tid < 256) wd[wd_d * 128 + wd_l] = pdt * __expf(paend - pacs);
            __syncthreads();
            {
                const u32x4 vv[2] = {xv0, xv1};
#pragma unroll
                for (int i = 0; i < 2; ++i) { const int idx = tid + 512 * i, pr = idx >> 4, l0 = (idx & 15) * 8; const u32x4 v = vv[i];
                    const float x[8] = {bflo(v.x), bfhi(v.x), bflo(v.y), bfhi(v.y), bflo(v.z), bfhi(v.z), bflo(v.w), bfhi(v.w)};
                    const f32x4 wf0 = *(const LAS f32x4*)(wd + l0), wf1 = *(const LAS f32x4*)(wd + l0 + 4), wb0 = *(const LAS f32x4*)(wd + 128 + l0), wb1 = *(const LAS f32x4*)(wd + 128 + l0 + 4);
                    u32x4 of, ob;
                    of.x = pk2(x[0] * wf0[0], x[1] * wf0[1]); of.y = pk2(x[2] * wf0[2], x[3] * wf0[3]); of.z = pk2(x[4] * wf1[0], x[5] * wf1[1]); of.w = pk2(x[6] * wf1[2], x[7] * wf1[3]);
                    ob.x = pk2(x[0] * wb0[0], x[1] * wb0[1]); ob.y = pk2(x[2] * wb0[2], x[3] * wb0[3]); ob.z = pk2(x[4] * wb1[0], x[5] * wb1[1]); ob.w = pk2(x[6] * wb1[2], x[7] * wb1[3]);
                    *(LAS u32x4*)(XTf + pr * TS + l0) = of; *(LAS u32x4*)(XTb + pr * TS + l0) = ob; }
            }
            if (h8 < 7) S1_PREFETCH(h + 1);
            __syncthreads();
            { const int d = c.wave >> 2, nb = c.wave & 3; const LAS bf16_t* XTd = d ? XTb : XTf;
              bf16_t* st = ST + ((((size_t)(d * 2 + b) * 64 + ch) * 16 + h) * 64) * 128;
#pragma unroll
              for (int pb = 0; pb < 2; ++pb) { f32x16 acc = {};
#pragma unroll
                for (int ks = 0; ks < 8; ++ks) acc = __builtin_amdgcn_mfma_f32_32x32x16_bf16(ldfrag(XTd, pb * 32 + r, ks * 16 + 8 * hh), ldfrag(BTs, nb * 32 + r, ks * 16 + 8 * hh), acc, 0, 0, 0);
#pragma unroll
                for (int i = 0; i < 16; ++i) { const int pp = pb * 32 + (i & 3) + 8 * (i >> 2) + 4 * hh; st[(size_t)pp * 128 + nb * 32 + r] = (bf16_t)f2bf(acc[i]); } } }
        }
#undef S1_PREFETCH
    }
}
__device__ __forceinline__ void phase_ssd_scan(const Params& p, const Ctx& c) {
    unsigned char* ws = p.ws;
    const float* CDEC = (const float*)(ws + WS_CDEC); bf16_t* PREV = (bf16_t*)(ws + WS_PREV);
    for (int idx = c.bid * 512 + c.tid; idx < 131072; idx += c.G * 512) {
        const int n4 = idx & 31, pp = (idx >> 5) & 63, h = (idx >> 11) & 15, b = (idx >> 15) & 1, d = idx >> 16;
        f32x4 run = {0.f, 0.f, 0.f, 0.f};
        const size_t obase = ((size_t)(d * 2 + b) * 64 * 16 + h) * 64 * 128 + (size_t)pp * 128 + n4 * 4;
        const float* cd = CDEC + (d * 2 + b) * 64 * 16 + h;
#pragma unroll 1
        for (int s0 = 0; s0 < 64; s0 += 16) {
            u32x2 sv[16]; float dec[16];
#pragma unroll
            for (int i = 0; i < 16; ++i) { const int ch = d ? 63 - (s0 + i) : s0 + i; sv[i] = *(const u32x2*)(PREV + obase + (size_t)ch * (16 * 64 * 128)); dec[i] = cd[ch * 16]; }
#pragma unroll
            for (int i = 0; i < 16; ++i) { const int ch = d ? 63 - (s0 + i) : s0 + i;
                u32x2 w; w.x = pk2(run.x, run.y); w.y = pk2(run.z, run.w); *(u32x2*)(PREV + obase + (size_t)ch * (16 * 64 * 128)) = w;
                run.x = fmaf(run.x, dec[i], bflo(sv[i].x)); run.y = fmaf(run.y, dec[i], bfhi(sv[i].x)); run.z = fmaf(run.z, dec[i], bflo(sv[i].y)); run.w = fmaf(run.w, dec[i], bfhi(sv[i].y)); }
        }
    }
}
__device__ __forceinline__ void phase_ssd_out(const Params& p, const Ctx& c) {
    unsigned char* ws = p.ws;
    const bf16_t* P = (const bf16_t*)(ws + WS_P); const bf16_t* XT = (const bf16_t*)(ws + WS_XT);
    const bf16_t* BMR = (const bf16_t*)(ws + WS_BMR); const bf16_t* CMR = (const bf16_t*)(ws + WS_CMR); const bf16_t* PREV = (const bf16_t*)(ws + WS_PREV);
    const float* DT = (const float*)(ws + WS_DT); const float* ACS = (const float*)(ws + WS_ACS); bf16_t* YZ = (bf16_t*)(ws + WS_YZ);
    LAS bf16_t* Cs = (LAS bf16_t*)c.lds; LAS bf16_t* Ms = Cs + 128 * TS; LAS bf16_t* XTs = Ms + 128 * TS; LAS bf16_t* PF = XTs + 64 * TS; LAS bf16_t* PB = PF + 64 * TS;
    LAS float* vec = (LAS float*)(PB + 64 * TS);
    constexpr int ZS = 72; LAS bf16_t* Zs = (LAS bf16_t*)(vec + 512); LAS float* dskl = (LAS float*)(Zs + 128 * ZS);
    const int tid = c.tid, lane = c.lane, r = lane & 31, hh = lane >> 5, wave = c.wave;
    for (int unit = c.bid; unit < 256; unit += c.G) {
        const int b = unit >> 7, ch = (unit >> 1) & 63, g = unit & 1;
        const size_t tok0 = (size_t)b * S + ch * 128;
        __syncthreads();
        load_tile128<128>(Cs, CMR + tok0 * 256 + g * 128, 256, tid);
        load_tile128<128>(Ms, BMR + tok0 * 256 + g * 128, 256, tid);
        u32x4 px0, px1, pf0, pf1, pb0, pb1, pz0, pz1; float pvec;
        const int t_r0 = tid >> 4, t_r1 = (tid + 512) >> 4, t_c = (tid & 15) * 8;
#define S3_PREFETCH(H) do { const bf16_t* xt_ = XT + ((size_t)(b * 64 + ch) * 16 + (H)) * 64 * 128; \
            const bf16_t* f_ = PREV + ((((size_t)(0 * 2 + b) * 64 + ch) * 16 + (H)) * 64) * 128; const bf16_t* b_ = PREV + ((((size_t)(1 * 2 + b) * 64 + ch) * 16 + (H)) * 64) * 128; \
            px0 = *(const u32x4*)(xt_ + t_r0 * 128 + t_c); px1 = *(const u32x4*)(xt_ + t_r1 * 128 + t_c); pf0 = *(const u32x4*)(f_ + t_r0 * 128 + t_c); pf1 = *(const u32x4*)(f_ + t_r1 * 128 + t_c); \
            pb0 = *(const u32x4*)(b_ + t_r0 * 128 + t_c); pb1 = *(const u32x4*)(b_ + t_r1 * 128 + t_c); \
            pz0 = *(const u32x4*)(P + (tok0 + (tid >> 3)) * NPROJ + PZ + (H) * 64 + (tid & 7) * 8); pz1 = *(const u32x4*)(P + (tok0 + 64 + (tid >> 3)) * NPROJ + PZ + (H) * 64 + (tid & 7) * 8); \
            { const int v_ = tid >> 7, l_ = tid & 127; const size_t o_ = ((size_t)(v_ & 1) * M + tok0 + l_) * 16 + (H); pvec = (v_ < 2) ? ACS[o_] : DT[o_]; } } while (0)
        S3_PREFETCH(g * 8);
        if (tid < 8) dskl[tid] = p.in[9][g * 8 + tid];
        __syncthreads();
        const int lb = wave & 3, sb0 = 2 * (wave >> 2);
        f32x16 G0 = {}, G1 = {};
#pragma unroll
        for (int ks = 0; ks < 8; ++ks) { const bf16x8 a = ldfrag(Cs, lb * 32 + r, ks * 16 + 8 * hh);
            G0 = __builtin_amdgcn_mfma_f32_32x32x16_bf16(a, ldfrag(Ms, sb0 * 32 + r, ks * 16 + 8 * hh), G0, 0, 0, 0);
            G1 = __builtin_amdgcn_mfma_f32_32x32x16_bf16(a, ldfrag(Ms, (sb0 + 1) * 32 + r, ks * 16 + 8 * hh), G1, 0, 0, 0); }
#pragma unroll 1
        for (int h8 = 0; h8 < 8; ++h8) {
            const int h = g * 8 + h8;
            __syncthreads();
            vec[tid] = pvec;
            *(LAS u32x4*)(XTs + t_r0 * TS + t_c) = px0; *(LAS u32x4*)(XTs + t_r1 * TS + t_c) = px1;
            *(LAS u32x4*)(PF + t_r0 * TS + t_c) = pf0; *(LAS u32x4*)(PF + t_r1 * TS + t_c) = pf1;
            *(LAS u32x4*)(PB + t_r0 * TS + t_c) = pb0; *(LAS u32x4*)(PB + t_r1 * TS + t_c) = pb1;
            *(LAS u32x4*)(Zs + (tid >> 3) * ZS + (tid & 7) * 8) = pz0; *(LAS u32x4*)(Zs + (64 + (tid >> 3)) * ZS + (tid & 7) * 8) = pz1;
            if (h8 < 7) S3_PREFETCH(h + 1);
            const int pbY = wave >> 2;
            __syncthreads();
#pragma unroll
            for (int t2 = 0; t2 < 2; ++t2) { const f32x16& Gt = t2 ? G1 : G0; const int sb = sb0 + t2, s = sb * 32 + r;
                const float afs = vec[s], abs_ = vec[128 + s], dfs = vec[256 + s], dbs = vec[384 + s];
                if (sb < lb) {
#pragma unroll
                    for (int i = 0; i < 16; ++i) { const int l = lb * 32 + (i & 3) + 8 * (i >> 2) + 4 * hh;
                        Ms[l * TS + s] = (bf16_t)f2bf(Gt[i] * __expf(vec[l] - afs) * dfs); }
                } else if (sb > lb) {
#pragma unroll
                    for (int i = 0; i < 16; ++i) { const int l = lb * 32 + (i & 3) + 8 * (i >> 2) + 4 * hh;
                        Ms[l * TS + s] = (bf16_t)f2bf(Gt[i] * __expf(vec[128 + l] - abs_) * dbs); }
                } else {
                    const float dsk = dskl[h8];
#pragma unroll
                    for (int i = 0; i < 16; ++i) { const int l = lb * 32 + (i & 3) + 8 * (i >> 2) + 4 * hh;
                        const float ef = __expf(fminf(vec[l] - afs, 0.f)) * dfs, eb = __expf(fminf(vec[128 + l] - abs_, 0.f)) * dbs;
                        const float tf = (s <= l) ? ef : 0.f, tb = (s >= l) ? eb : 0.f;
                        Ms[l * TS + s] = (bf16_t)f2bf(Gt[i] * (tf + tb) + (s == l ? dsk : 0.f)); }
                } }
            __syncthreads();
            { f32x16 Yd = {}, Yf = {}, Yb = {};
#pragma unroll
              for (int ks = 0; ks < 8; ++ks) { const int k0 = ks * 16 + 8 * hh;
                  Yd = __builtin_amdgcn_mfma_f32_32x32x16_bf16(ldfrag(Ms, lb * 32 + r, k0), ldfrag(XTs, pbY * 32 + r, k0), Yd, 0, 0, 0);
                  const bf16x8 a = ldfrag(Cs, lb * 32 + r, k0);
                  Yf = __builtin_amdgcn_mfma_f32_32x32x16_bf16(a, ldfrag(PF, pbY * 32 + r, k0), Yf, 0, 0, 0);
                  Yb = __builtin_amdgcn_mfma_f32_32x32x16_bf16(a, ldfrag(PB, pbY * 32 + r, k0), Yb, 0, 0, 0);
                  if (ks & 1) __builtin_amdgcn_sched_barrier(0); }
#pragma unroll
              for (int i = 0; i < 16; ++i) { const int l = lb * 32 + (i & 3) + 8 * (i >> 2) + 4 * hh;
                  const float y = Yd[i] + __expf(vec[l]) * Yf[i] + __expf(vec[128 + l]) * Yb[i];
                  const float z = bf2f(Zs[l * ZS + pbY * 32 + r]);
                  Zs[l * ZS + pbY * 32 + r] = (bf16_t)f2bf(y * z * sigmoidf_(z)); } }
            __syncthreads();
            *(u32x4*)(YZ + (tok0 + (tid >> 3)) * 1024 + h * 64 + (tid & 7) * 8) = *(const LAS u32x4*)(Zs + (tid >> 3) * ZS + (tid & 7) * 8);
            *(u32x4*)(YZ + (tok0 + 64 + (tid >> 3)) * 1024 + h * 64 + (tid & 7) * 8) = *(const LAS u32x4*)(Zs + (64 + (tid >> 3)) * ZS + (tid & 7) * 8);
        }
#undef S3_PREFETCH
    }
}

__device__ __forceinline__ void phase_rstd(const Params& p, const Ctx& c) {
    const bf16_t* YZ = (const bf16_t*)(p.ws + WS_YZ); float* RSTD = (float*)(p.ws + WS_RSTD);
    const int gw = c.bid * 8 + c.wave, NGW = c.G * 8;
    for (int m0 = gw * 4; m0 < M; m0 += NGW * 4) {
        u32x4 v[4][2];
#pragma unroll
        for (int q = 0; q < 4; ++q) { const u32x4* r = (const u32x4*)(YZ + (size_t)(m0 + q) * 1024) + c.lane; v[q][0] = r[0]; v[q][1] = r[64]; }
#pragma unroll
        for (int q = 0; q < 4; ++q) { float s = 0.f;
#pragma unroll
            for (int j = 0; j < 2; ++j) { const u32x4 w = v[q][j];
                s += bflo(w.x) * bflo(w.x) + bfhi(w.x) * bfhi(w.x) + bflo(w.y) * bflo(w.y) + bfhi(w.y) * bfhi(w.y) + bflo(w.z) * bflo(w.z) + bfhi(w.z) * bfhi(w.z) + bflo(w.w) * bflo(w.w) + bfhi(w.w) * bfhi(w.w); }
            s = wave_sum(s);
            if (c.lane == 0) RSTD[m0 + q] = rsqrtf(s * (1.f / 1024.f) + EPS); }
    }
}

__device__ __forceinline__ void phase_attn_naive(const Params& p, const Ctx& c) {
    unsigned char* ws = p.ws;
    const bf16_t* QN = (const bf16_t*)(ws + WS_QN); const bf16_t* KN = (const bf16_t*)(ws + WS_KN); const bf16_t* VB = (const bf16_t*)(ws + WS_VB);
    bf16_t* AO = (bf16_t*)(ws + WS_AO);
    LAS bf16_t* Ks = (LAS bf16_t*)c.lds; LAS bf16_t* Vs = Ks + 64 * 128;
    const int tid = c.tid, row = tid >> 2, dq = tid & 3;
    constexpr float C = 0.088388347648318440f * 1.4426950408889634f;
    for (int item = c.bid; item < 1024; item += c.G) {
        const int b = item >> 9, h = (item >> 6) & 7, qb = item & 63, kvh = h >> 2;
        const size_t tokq = (size_t)b * S + qb * 128 + row;
        float q[32], o[32];
#pragma unroll
        for (int i = 0; i < 4; ++i) { const u32x4 v = *(const u32x4*)(QN + tokq * 1024 + h * 128 + dq * 32 + i * 8);
            q[i * 8 + 0] = bflo(v.x) * C; q[i * 8 + 1] = bfhi(v.x) * C; q[i * 8 + 2] = bflo(v.y) * C; q[i * 8 + 3] = bfhi(v.y) * C;
            q[i * 8 + 4] = bflo(v.z) * C; q[i * 8 + 5] = bfhi(v.z) * C; q[i * 8 + 6] = bflo(v.w) * C; q[i * 8 + 7] = bfhi(v.w) * C; }
#pragma unroll
        for (int i = 0; i < 32; ++i) o[i] = 0.f;
        float mrun = -1e30f, lrun = 0.f;
        for (int kt = 0; kt < S / 64; ++kt) {
            __syncthreads();
            {
                const int key = tid >> 3, ch = tid & 7;
                const size_t tk = ((size_t)b * S + kt * 64 + key) * 256 + kvh * 128 + ch * 16;
                *(LAS u32x4*)(Ks + key * 128 + ch * 16) = *(const u32x4*)(KN + tk); *(LAS u32x4*)(Ks + key * 128 + ch * 16 + 8) = *(const u32x4*)(KN + tk + 8);
                *(LAS u32x4*)(Vs + key * 128 + ch * 16) = *(const u32x4*)(VB + tk); *(LAS u32x4*)(Vs + key * 128 + ch * 16 + 8) = *(const u32x4*)(VB + tk + 8);
            }
            __syncthreads();
            for (int j = 0; j < 64; ++j) {
                float s = 0.f;
#pragma unroll
                for (int i = 0; i < 4; ++i) { const u32x4 v = *(const LAS u32x4*)(Ks + j * 128 + dq * 32 + i * 8);
                    s = fmaf(q[i * 8 + 0], bflo(v.x), s); s = fmaf(q[i * 8 + 1], bfhi(v.x), s); s = fmaf(q[i * 8 + 2], bflo(v.y), s); s = fmaf(q[i * 8 + 3], bfhi(v.y), s);
                    s = fmaf(q[i * 8 + 4], bflo(v.z), s); s = fmaf(q[i * 8 + 5], bfhi(v.z), s); s = fmaf(q[i * 8 + 6], bflo(v.w), s); s = fmaf(q[i * 8 + 7], bfhi(v.w), s); }
                s += __shfl_xor(s, 1); s += __shfl_xor(s, 2);
                const float mn = fmaxf(mrun, s), al = __builtin_amdgcn_exp2f(mrun - mn), pe = __builtin_amdgcn_exp2f(s - mn);
                mrun = mn; lrun = lrun * al + pe;
#pragma unroll
                for (int i = 0; i < 4; ++i) { const u32x4 v = *(const LAS u32x4*)(Vs + j * 128 + dq * 32 + i * 8);
                    o[i * 8 + 0] = fmaf(pe, bflo(v.x), o[i * 8 + 0] * al); o[i * 8 + 1] = fmaf(pe, bfhi(v.x), o[i * 8 + 1] * al);
                    o[i * 8 + 2] = fmaf(pe, bflo(v.y), o[i * 8 + 2] * al); o[i * 8 + 3] = fmaf(pe, bfhi(v.y), o[i * 8 + 3] * al);
                    o[i * 8 + 4] = fmaf(pe, bflo(v.z), o[i * 8 + 4] * al); o[i * 8 + 5] = fmaf(pe, bfhi(v.z), o[i * 8 + 5] * al);
                    o[i * 8 + 6] = fmaf(pe, bflo(v.w), o[i * 8 + 6] * al); o[i * 8 + 7] = fmaf(pe, bfhi(v.w), o[i * 8 + 7] * al); }
            }
        }
        const float rl = 1.f / lrun;
#pragma unroll
        for (int i = 0; i < 4; ++i) { u32x4 w;
            w.x = pk2(o[i * 8 + 0] * rl, o[i * 8 + 1] * rl); w.y = pk2(o[i * 8 + 2] * rl, o[i * 8 + 3] * rl); w.z = pk2(o[i * 8 + 4] * rl, o[i * 8 + 5] * rl); w.w = pk2(o[i * 8 + 6] * rl, o[i * 8 + 7] * rl);
            *(u32x4*)(AO + tokq * 1024 + h * 128 + dq * 32 + i * 8) = w; }
    }
}

namespace attn {
typedef unsigned short bf16;
constexpr int   D = 128, NW = 8, QBLK = 32, KVBLK = 64;
constexpr float SCALE = 0.088388347648318440f;
constexpr float THR = 8.f;
constexpr int SDEPTH = 2;
constexpr int LDQ = 1024, LDK = 256, LDO = 1024;
constexpr size_t SHM_V = KVBLK * D * 2, SHM_K = KVBLK * D * 2, SHM_ATTN = 2 * SHM_V + 2 * SHM_K + NW * 64 * 4;
using bf16x8 = __attribute__((ext_vector_type(8))) short;
using s16x4  = __attribute__((ext_vector_type(4))) short;
using f32x16 = __attribute__((ext_vector_type(16))) float;
using f32x8  = __attribute__((ext_vector_type(8))) float;
using u32x4  = __attribute__((ext_vector_type(4))) unsigned;
#define KSWZ(row, colB) ((row) * 256 + ((colB) ^ (((row) & 7) << 4)))
#define SBAR() __builtin_amdgcn_sched_barrier(0)
__device__ __forceinline__ int crow(int r, int hi) { return (r & 3) + 8 * (r >> 2) + 4 * hi; }
__device__ __forceinline__ unsigned cvtpk(float lo, float hi) {
  unsigned r; asm volatile("v_cvt_pk_bf16_f32 %0, %1, %2" : "=v"(r) : "v"(lo), "v"(hi)); return r;
}
template <typename TIn> struct Stage;
template <> struct Stage<bf16>  { using T = bf16x8;
  __device__ static __forceinline__ T ld8(const bf16* p) { return *reinterpret_cast<const bf16x8*>(p); }
  __device__ static __forceinline__ bf16x8 tobf(T x) { return x; } };
template <> struct Stage<float> { using T = f32x8;
  __device__ static __forceinline__ T ld8(const float* p) { return *reinterpret_cast<const f32x8*>(p); }
  __device__ static __forceinline__ bf16x8 tobf(T x) {
    u32x4 w = {cvtpk(x[0], x[1]), cvtpk(x[2], x[3]), cvtpk(x[4], x[5]), cvtpk(x[6], x[7])}; return *reinterpret_cast<bf16x8*>(&w); } };

__device__ __forceinline__ void partialSM(f32x16& p0, f32x16& p1, float& m_reg, float& mn, float& alpha) {
  constexpr float C = SCALE * 1.4426950408889634f;
  float pmax = p0[0]; for (int r = 1; r < 16; ++r) pmax = fmaxf(pmax, p0[r]); for (int r = 0; r < 16; ++r) pmax = fmaxf(pmax, p1[r]);
  { auto rr = __builtin_amdgcn_permlane32_swap(__float_as_uint(pmax), __float_as_uint(pmax), false, false);
    pmax = fmaxf(__uint_as_float(rr[0]), __uint_as_float(rr[1])); }
  if (__builtin_expect(__all(pmax - m_reg <= THR / SCALE), 1)) { mn = m_reg; alpha = 1.f; }
  else { mn = fmaxf(m_reg, pmax); alpha = __builtin_amdgcn_exp2f((m_reg - mn) * C); m_reg = mn; }
  float mnC = -mn * C;
  for (int r = 0; r < 16; ++r) p0[r] = fmaf(p0[r], C, mnC); for (int r = 0; r < 16; ++r) p1[r] = fmaf(p1[r], C, mnC);
  for (int r = 0; r < 16; ++r) p0[r] = __builtin_amdgcn_exp2f(p0[r]);
}
__device__ __forceinline__ void finishSM(f32x16& p0, f32x16& p1, float alpha, float& l_reg, bf16x8& pa0, bf16x8& pa1, bf16x8& pa2, bf16x8& pa3) {
  for (int r = 0; r < 16; ++r) p1[r] = __builtin_amdgcn_exp2f(p1[r]);
  float ps = 0; for (int r = 0; r < 16; ++r) ps += p0[r]; for (int r = 0; r < 16; ++r) ps += p1[r];
  { auto rr = __builtin_amdgcn_permlane32_swap(__float_as_uint(ps), __float_as_uint(ps), false, false);
    ps = __uint_as_float(rr[0]) + __uint_as_float(rr[1]); }
  l_reg = l_reg * alpha + ps;
#define PK4(P, BASE, OUT) do { unsigned a0 = cvtpk(P[BASE + 0], P[BASE + 1]), a1 = cvtpk(P[BASE + 2], P[BASE + 3]);   \
    unsigned b0 = cvtpk(P[BASE + 4], P[BASE + 5]), b1 = cvtpk(P[BASE + 6], P[BASE + 7]);                              \
    auto r0 = __builtin_amdgcn_permlane32_swap(a0, b0, false, false); auto r1 = __builtin_amdgcn_permlane32_swap(a1, b1, false, false); \
    u32x4 w = {r0[0], r1[0], r0[1], r1[1]}; OUT = *reinterpret_cast<bf16x8*>(&w); } while (0)
  PK4(p0, 0, pa0); PK4(p0, 8, pa1); PK4(p1, 0, pa2); PK4(p1, 8, pa3);
#undef PK4
}
__device__ __forceinline__ void qkt(f32x16& p0, f32x16& p1, const bf16* Ks, const bf16x8* qr, int r32, int hi) {
  p0 = f32x16{}; p1 = f32x16{};
  for (int d0 = 0; d0 < 8; ++d0) { int cb = (d0 * 16 + hi * 8) * 2;
    bf16x8 b0 = *reinterpret_cast<const bf16x8*>((const char*)Ks + KSWZ(r32, cb));
    bf16x8 b1 = *reinterpret_cast<const bf16x8*>((const char*)Ks + KSWZ(32 + r32, cb));
    p0 = __builtin_amdgcn_mfma_f32_32x32x16_bf16(b0, qr[d0], p0, 0, 0, 0);
    p1 = __builtin_amdgcn_mfma_f32_32x32x16_bf16(b1, qr[d0], p1, 0, 0, 0); }
}
__device__ __forceinline__ int v_st(int k, int c) { const int kk = (k & ~0xC) | ((k & 4) << 1) | ((k & 8) >> 1); return ((kk >> 3) * 4 + (c >> 5)) * 512 + ((kk & 7) * 32 + (c & 31)) * 2; }
__device__ __forceinline__ int v_rd_base(int lane) { return ((lane & 3) << 3) | (((lane >> 2) & 3) << 6) | (((lane >> 4) & 1) << 5) | (((lane >> 5) & 1) << 8); }
constexpr int v_rd_off(int d0, int ks, int half) { return d0 * 512 + ks * 4096 + half * 2048; }
template <int OFF> __device__ __forceinline__ s16x4 tr_read(int vb) {
  s16x4 r; asm volatile("ds_read_b64_tr_b16 %0, %1 offset:%2" : "=&v"(r) : "v"(vb), "i"(OFF) : "memory"); return r;
}
template <int D0> __device__ __forceinline__ void pv_one(f32x16& od, int vb, bf16x8 pa0, bf16x8 pa1, bf16x8 pa2, bf16x8 pa3) {
  const s16x4 l0 = tr_read<v_rd_off(D0, 0, 0)>(vb), h0 = tr_read<v_rd_off(D0, 0, 1)>(vb), l1 = tr_read<v_rd_off(D0, 1, 0)>(vb), h1 = tr_read<v_rd_off(D0, 1, 1)>(vb);
  const s16x4 l2 = tr_read<v_rd_off(D0, 2, 0)>(vb), h2 = tr_read<v_rd_off(D0, 2, 1)>(vb), l3 = tr_read<v_rd_off(D0, 3, 0)>(vb), h3 = tr_read<v_rd_off(D0, 3, 1)>(vb);
  asm volatile("s_waitcnt lgkmcnt(0)" ::: "memory"); SBAR();
#define PK(L, H) (bf16x8){L[0], L[1], L[2], L[3], H[0], H[1], H[2], H[3]}
  od = __builtin_amdgcn_mfma_f32_32x32x16_bf16(pa0, PK(l0, h0), od, 0, 0, 0);
  od = __builtin_amdgcn_mfma_f32_32x32x16_bf16(pa1, PK(l1, h1), od, 0, 0, 0);
  od = __builtin_amdgcn_mfma_f32_32x32x16_bf16(pa2, PK(l2, h2), od, 0, 0, 0);
  od = __builtin_amdgcn_mfma_f32_32x32x16_bf16(pa3, PK(l3, h3), od, 0, 0, 0);
#undef PK
}
__device__ __forceinline__ void pv_d0(f32x16* o, int vb, bf16x8 pa0, bf16x8 pa1, bf16x8 pa2, bf16x8 pa3) {
  pv_one<0>(o[0], vb, pa0, pa1, pa2, pa3); pv_one<1>(o[1], vb, pa0, pa1, pa2, pa3); pv_one<2>(o[2], vb, pa0, pa1, pa2, pa3); pv_one<3>(o[3], vb, pa0, pa1, pa2, pa3);
}

template <typename TQ>
__device__ __forceinline__ void attn_dense_body(const TQ* __restrict__ Qb, const bf16* __restrict__ Kh, const bf16* __restrict__ Vh,
                                                bf16* __restrict__ Ob, int seq, char* lds) {
  using St = Stage<bf16>; using SQ = Stage<TQ>;
  const int tid = threadIdx.x, wid = tid >> 6, lane = tid & 63, r32 = lane & 31, hi = lane >> 5;
  bf16* V_lds = (bf16*)lds; bf16* K_lds = (bf16*)(lds + 2 * SHM_V);
  float* ws = (float*)(lds + 2 * SHM_V + 2 * SHM_K) + wid * 64; float* li_l = ws; float* al_l = ws + 32;
  float m_reg = -1e30f, l_reg = 0; f32x16 o[4] = {}; bf16x8 qr[8];
  const TQ* Qw = Qb + (long)(wid * QBLK + r32) * LDQ + hi * 8;
#pragma unroll
  for (int d0 = 0; d0 < 8; ++d0) qr[d0] = SQ::tobf(SQ::ld8(Qw + d0 * 16));
  const int sr = tid >> 4, sc = (tid & 15) * 8, vst0 = v_st(sr, sc), vst1 = v_st(32 + sr, sc);
  const int vb0 = (int)(uintptr_t)V_lds + v_rd_base(lane);
  struct { typename St::T vs0, vs1, ks0, ks1; } sr_[SDEPTH];
#define SLOAD(i, k0) do { sr_[i].vs0 = St::ld8(&Vh[(long)((k0) + sr) * LDK + sc]); sr_[i].vs1 = St::ld8(&Vh[(long)((k0) + 32 + sr) * LDK + sc]); \
    sr_[i].ks0 = St::ld8(&Kh[(long)((k0) + sr) * LDK + sc]); sr_[i].ks1 = St::ld8(&Kh[(long)((k0) + 32 + sr) * LDK + sc]); } while (0)
#define SWRITE(b, i) do { *(bf16x8*)((char*)V_lds + (b) * SHM_V + vst0) = St::tobf(sr_[i].vs0);          \
    *(bf16x8*)((char*)V_lds + (b) * SHM_V + vst1) = St::tobf(sr_[i].vs1); int kc = sc * 2;               \
    *(bf16x8*)((char*)K_lds + (b) * SHM_K + KSWZ(sr, kc)) = St::tobf(sr_[i].ks0);                       \
    *(bf16x8*)((char*)K_lds + (b) * SHM_K + KSWZ(32 + sr, kc)) = St::tobf(sr_[i].ks1); } while (0)
#define SWAIT() do { if constexpr (SDEPTH == 2) asm volatile("s_waitcnt vmcnt(4)" ::: "memory"); else asm volatile("s_waitcnt vmcnt(0)" ::: "memory"); } while (0)
#define RESC(a) do { if (__any((a) < 1.f)) { if (hi == 0) al_l[r32] = (a); asm volatile("s_waitcnt lgkmcnt(0)" ::: "memory"); \
    for (int d = 0; d < 4; ++d) for (int r = 0; r < 16; ++r) o[d][r] *= al_l[crow(r, hi)]; } } while (0)
  f32x16 pA0, pA1, pB0, pB1; float mnA, mnB, alA, alB; bf16x8 pa0, pa1, pa2, pa3; const int NT = seq / KVBLK;
  constexpr int SE = 0, SO = SDEPTH - 1;
  SLOAD(SE, 0); asm volatile("s_waitcnt vmcnt(0)" ::: "memory"); SWRITE(0, SE); __syncthreads();
  qkt(pA0, pA1, K_lds, qr, r32, hi); partialSM(pA0, pA1, m_reg, mnA, alA);
  SLOAD(SO, KVBLK); if constexpr (SDEPTH == 2) { if (2 < NT) SLOAD(SE, 2 * KVBLK); }
  SWAIT(); SWRITE(1, SO); __syncthreads();
  for (int j = 1; j + 1 < NT; j += 2) {
    SBAR(); qkt(pB0, pB1, (bf16*)((char*)K_lds + SHM_K), qr, r32, hi);
    finishSM(pA0, pA1, alA, l_reg, pa0, pa1, pa2, pa3); SBAR();
    SLOAD(SO, (j + SDEPTH) * KVBLK); SBAR();
    pv_d0(o, vb0, pa0, pa1, pa2, pa3); partialSM(pB0, pB1, m_reg, mnB, alB);
    __syncthreads(); SWAIT(); SWRITE(0, SE);
    RESC(alB); __syncthreads();
    SBAR(); qkt(pA0, pA1, K_lds, qr, r32, hi);
    finishSM(pB0, pB1, alB, l_reg, pa0, pa1, pa2, pa3); SBAR();
    if (SDEPTH == 1 || j + 3 < NT) SLOAD(SE, (j + 1 + SDEPTH) * KVBLK); SBAR();
    pv_d0(o, vb0 + (int)SHM_V, pa0, pa1, pa2, pa3); partialSM(pA0, pA1, m_reg, mnA, alA);
    __syncthreads(); SWAIT(); SWRITE(1, SO);
    RESC(alA); __syncthreads();
  }
  SBAR(); qkt(pB0, pB1, (bf16*)((char*)K_lds + SHM_K), qr, r32, hi);
  finishSM(pA0, pA1, alA, l_reg, pa0, pa1, pa2, pa3); SBAR();
  pv_d0(o, vb0, pa0, pa1, pa2, pa3); partialSM(pB0, pB1, m_reg, mnB, alB);
  __syncthreads(); RESC(alB);
  finishSM(pB0, pB1, alB, l_reg, pa0, pa1, pa2, pa3); SBAR();
  pv_d0(o, vb0 + (int)SHM_V, pa0, pa1, pa2, pa3);
  if (hi == 0) li_l[r32] = l_reg; asm volatile("s_waitcnt lgkmcnt(0)" ::: "memory");
  float rli[16];
#pragma unroll
  for (int r = 0; r < 16; ++r) rli[r] = __builtin_amdgcn_rcpf(li_l[crow(r, hi)]);
  bf16* Ow = Ob + (long)(wid * QBLK) * LDO;
#pragma unroll
  for (int r = 0; r < 16; ++r) { int orow = crow(r, hi);
    for (int d0 = 0; d0 < 4; ++d0) Ow[(long)orow * LDO + d0 * 32 + r32] = (bf16)f2bf(o[d0][r] * rli[r]); }
#undef SLOAD
#undef SWRITE
#undef SWAIT
#undef RESC
}
}


namespace attn8 {
typedef int v8i __attribute__((ext_vector_type(8)));
typedef float f32x16 __attribute__((ext_vector_type(16)));
typedef unsigned u32x4_ __attribute__((ext_vector_type(4)));
constexpr int QBLK = 32, KVBLK = 64;
constexpr float SCALE = 0.088388347648318440f;
constexpr float THR = 0.69f;
constexpr size_t SHM_K = 64 * 128, SHM_V = 128 * 64, SHM_ATTN = 2 * SHM_K + 2 * SHM_V + 8 * 64 * 4;
__device__ __forceinline__ int crow(int r, int hi) { return (r & 3) + 8 * (r >> 2) + 4 * hi; }
__device__ __forceinline__ int kswz(int row, int colB) { return row * 128 + (colB ^ ((row & 7) << 4)); }
__device__ __forceinline__ int vswz(int d, int slot) { return d * 64 + ((slot ^ ((d >> 2) & 3)) << 4); }
__device__ __forceinline__ v8i cat8(const u32x4_& lo, const u32x4_& hi) { v8i r; r[0] = (int)lo.x; r[1] = (int)lo.y; r[2] = (int)lo.z; r[3] = (int)lo.w; r[4] = (int)hi.x; r[5] = (int)hi.y; r[6] = (int)hi.z; r[7] = (int)hi.w; return r; }
template <bool LAST> __device__ __forceinline__ void mfma8(f32x16& acc, const v8i& a, const v8i& b, int scl) {
    if (LAST) asm volatile("v_mfma_scale_f32_32x32x64_f8f6f4 %0, %1, %2, %0, %3, %3 op_sel_hi:[0,0,0]\n\ts_nop 15\n\ts_nop 15" : "+v"(acc) : "v"(a), "v"(b), "v"(scl));
    else asm volatile("v_mfma_scale_f32_32x32x64_f8f6f4 %0, %1, %2, %0, %3, %3 op_sel_hi:[0,0,0]" : "+v"(acc) : "v"(a), "v"(b), "v"(scl));
}
__device__ __forceinline__ void partialSM(f32x16& p0, f32x16& p1, float& m_reg, float& mn, float& alpha) {
    constexpr float C = SCALE * 1.4426950408889634f;
    float pmax = p0[0];
#pragma unroll
    for (int r = 1; r < 16; ++r) pmax = fmaxf(pmax, p0[r]);
#pragma unroll
    for (int r = 0; r < 16; ++r) pmax = fmaxf(pmax, p1[r]);
    { auto rr = __builtin_amdgcn_permlane32_swap(__float_as_uint(pmax), __float_as_uint(pmax), false, false); pmax = fmaxf(__uint_as_float(rr[0]), __uint_as_float(rr[1])); }
    if (__builtin_expect(__all(pmax - m_reg <= THR / SCALE), 1)) { mn = m_reg; alpha = 1.f; }
    else { mn = fmaxf(m_reg, pmax); alpha = __builtin_amdgcn_exp2f((m_reg - mn) * C); m_reg = mn; }
    const float mnC = 7.f - mn * C;
#pragma unroll
    for (int r = 0; r < 16; ++r) p0[r] = fmaf(p0[r], C, mnC);
#pragma unroll
    for (int r = 0; r < 16; ++r) p1[r] = fmaf(p1[r], C, mnC);
#pragma unroll
    for (int r = 0; r < 16; ++r) p0[r] = __builtin_amdgcn_exp2f(p0[r]);
}
__device__ __forceinline__ void finishSM(f32x16& p0, f32x16& p1, float alpha, float& l_reg, v8i& pa) {
#pragma unroll
    for (int r = 0; r < 16; ++r) p1[r] = __builtin_amdgcn_exp2f(p1[r]);
    float ps = 0;
#pragma unroll
    for (int r = 0; r < 16; ++r) ps += p0[r];
#pragma unroll
    for (int r = 0; r < 16; ++r) ps += p1[r];
    { auto rr = __builtin_amdgcn_permlane32_swap(__float_as_uint(ps), __float_as_uint(ps), false, false); ps = __uint_as_float(rr[0]) + __uint_as_float(rr[1]); }
    l_reg = l_reg * alpha + ps;
#pragma unroll
    for (int w = 0; w < 4; ++w) { pa[w] = (int)pack4_fp8(p0[4 * w], p0[4 * w + 1], p0[4 * w + 2], p0[4 * w + 3]); pa[4 + w] = (int)pack4_fp8(p1[4 * w], p1[4 * w + 1], p1[4 * w + 2], p1[4 * w + 3]); }
}
__device__ __forceinline__ void qkt(f32x16& p0, f32x16& p1, const char* Ks, const v8i* qf, int r32, int hi, int scl) {
    p0 = f32x16{}; p1 = f32x16{};
#pragma unroll
    for (int s = 0; s < 2; ++s) { const int cb = 64 * s + 32 * hi;
        const v8i a0 = cat8(*(const u32x4_*)(Ks + kswz(r32, cb)), *(const u32x4_*)(Ks + kswz(r32, cb + 16)));
        const v8i a1 = cat8(*(const u32x4_*)(Ks + kswz(32 + r32, cb)), *(const u32x4_*)(Ks + kswz(32 + r32, cb + 16)));
        if (s == 0) { mfma8<false>(p0, a0, qf[s], scl); mfma8<false>(p1, a1, qf[s], scl); }
        else { mfma8<false>(p0, a0, qf[s], scl); mfma8<true>(p1, a1, qf[s], scl); } }
}
__device__ __forceinline__ void pv(f32x16* o, const char* Vs, const v8i& pa, int r32, int hi, int scl) {
#pragma unroll
    for (int d0 = 0; d0 < 4; ++d0) { const int d = d0 * 32 + r32;
        const v8i b = cat8(*(const u32x4_*)(Vs + vswz(d, 2 * hi)), *(const u32x4_*)(Vs + vswz(d, 2 * hi + 1)));
        if (d0 == 3) mfma8<true>(o[d0], pa, b, scl); else mfma8<false>(o[d0], pa, b, scl); }
}
__device__ __forceinline__ void body(const unsigned char* __restrict__ Qb, const unsigned char* __restrict__ Kh, const unsigned char* __restrict__ Vt, unsigned short* __restrict__ Ob, int seq, char* lds) {
    const int tid = threadIdx.x, wid = tid >> 6, lane = tid & 63, r32 = lane & 31, hi = lane >> 5;
    const int scl = 0x7f7f7f7f;
    char* K_lds = lds; char* V_lds = lds + 2 * SHM_K;
    float* ws = (float*)(lds + 2 * SHM_K + 2 * SHM_V) + wid * 64; float* li_l = ws; float* al_l = ws + 32;
    float m_reg = -1e30f, l_reg = 0; f32x16 o[4] = {}; v8i qf[2];
    { const unsigned char* Qw = Qb + (long)(wid * QBLK + r32) * 1024 + 32 * hi;
#pragma unroll
      for (int s = 0; s < 2; ++s) qf[s] = cat8(*(const u32x4_*)(Qw + 64 * s), *(const u32x4_*)(Qw + 64 * s + 16)); }
    const int kr = tid >> 3, kc = (tid & 7) * 16, kdst = kswz(kr, kc);
    const int vd = tid >> 2, vsl = tid & 3, vdst = vswz(vd, vsl);
    struct { u32x4_ k, v; } sr_[2];
#define SLOAD(i, t) do { sr_[i].k = *(const u32x4_*)(Kh + (long)((t) * KVBLK + kr) * 256 + kc); sr_[i].v = *(const u32x4_*)(Vt + (long)(t) * 8192 + vd * 64 + vsl * 16); } while (0)
#define SWRITE(b, i) do { *(u32x4_*)(K_lds + (b) * SHM_K + kdst) = sr_[i].k; *(u32x4_*)(V_lds + (b) * SHM_V + vdst) = sr_[i].v; } while (0)
#define SWAIT() asm volatile("s_waitcnt vmcnt(2)" ::: "memory")
#define RESC(a) do { if (__any((a) < 1.f)) { if (hi == 0) al_l[r32] = (a); asm volatile("s_waitcnt lgkmcnt(0)" ::: "memory"); \
    _Pragma("unroll") for (int d = 0; d < 4; ++d) _Pragma("unroll") for (int r = 0; r < 16; ++r) o[d][r] *= al_l[crow(r, hi)]; } } while (0)
#define SBAR_() __builtin_amdgcn_sched_barrier(0)
    f32x16 pA0, pA1, pB0, pB1; float mnA, mnB, alA, alB; v8i pa; const int NT = seq / KVBLK;
    SLOAD(0, 0); asm volatile("s_waitcnt vmcnt(0)" ::: "memory"); SWRITE(0, 0); __syncthreads();
    qkt(pA0, pA1, K_lds, qf, r32, hi, scl); partialSM(pA0, pA1, m_reg, mnA, alA);
    SLOAD(1, 1); if (2 < NT) SLOAD(0, 2);
    SWAIT(); SWRITE(1, 1); __syncthreads();
    for (int j = 1; j + 1 < NT; j += 2) {
        SBAR_(); qkt(pB0, pB1, K_lds + SHM_K, qf, r32, hi, scl);
        finishSM(pA0, pA1, alA, l_reg, pa); SBAR_();
        SLOAD(1, j + 2); SBAR_();
        pv(o, V_lds, pa, r32, hi, scl); partialSM(pB0, pB1, m_reg, mnB, alB);
        __syncthreads(); SWAIT(); SWRITE(0, 0);
        RESC(alB); __syncthreads();
        SBAR_(); qkt(pA0, pA1, K_lds, qf, r32, hi, scl);
        finishSM(pB0, pB1, alB, l_reg, pa); SBAR_();
        if (j + 3 < NT) SLOAD(0, j + 3); SBAR_();
        pv(o, V_lds + SHM_V, pa, r32, hi, scl); partialSM(pA0, pA1, m_reg, mnA, alA);
        __syncthreads(); SWAIT(); SWRITE(1, 1);
        RESC(alA); __syncthreads();
    }
    SBAR_(); qkt(pB0, pB1, K_lds + SHM_K, qf, r32, hi, scl);
    finishSM(pA0, pA1, alA, l_reg, pa); SBAR_();
    pv(o, V_lds, pa, r32, hi, scl); partialSM(pB0, pB1, m_reg, mnB, alB);
    __syncthreads(); RESC(alB);
    finishSM(pB0, pB1, alB, l_reg, pa); SBAR_();
    pv(o, V_lds + SHM_V, pa, r32, hi, scl);
    if (hi == 0) li_l[r32] = l_reg; asm volatile("s_waitcnt lgkmcnt(0)" ::: "memory");
    float rli[16];
#pragma unroll
    for (int r = 0; r < 16; ++r) rli[r] = __builtin_amdgcn_rcpf(li_l[crow(r, hi)]);
    unsigned short* Ow = Ob + (long)(wid * QBLK) * 1024;
#pragma unroll
    for (int r = 0; r < 16; ++r) { const int orow = crow(r, hi);
#pragma unroll
        for (int d0 = 0; d0 < 4; ++d0) Ow[(long)orow * 1024 + d0 * 32 + r32] = (unsigned short)f2bf(o[d0][r] * rli[r]); }
#undef SLOAD
#undef SWRITE
#undef SWAIT
#undef RESC
#undef SBAR_
}
}
__device__ __forceinline__ void phase_attn(const Params& p, const Ctx& c, char* lds_generic) {
    unsigned char* ws = p.ws;
    const unsigned char* Q8 = ws + WS_QN; const unsigned char* K8 = ws + WS_KN; const unsigned char* VT8 = ws + WS_VB; bf16_t* AO = (bf16_t*)(ws + WS_AO);
    for (int item = c.bid; item < 512; item += c.G) {
        const int b = item >> 8, h = (item >> 5) & 7, qb = item & 31, kvh = h >> 2;
        const size_t qrow = (size_t)b * S + qb * 256;
        attn8::body(Q8 + qrow * 1024 + h * 128, K8 + (size_t)b * S * 256 + kvh * 128, VT8 + (size_t)(b * 2 + kvh) * 128 * 8192, AO + qrow * 1024 + h * 128, S, lds_generic);
        __syncthreads();
    }
}

struct EpiT1 { bf16_t* T1; const bf16_t* P; const float* RSTD; int n0;
    __device__ __forceinline__ void operator()(int r, int cl, float a, float) const { const int col = n0 + cl;
        T1[(size_t)r * 1024 + col] = (bf16_t)f2bf(a * RSTD[r] * sigmoidf_(bf2f(P[(size_t)r * NPROJ + PG + col]))); } };
struct EpiT2 { bf16_t* MG; const bf16_t* T1; const bf16_t* P; int n0;
    __device__ __forceinline__ void operator()(int r, int cl, float a, float) const { const int col = n0 + cl;
        MG[(size_t)r * 1024 + col] = (bf16_t)f2bf(bf2f(T1[(size_t)r * 1024 + col]) + a * sigmoidf_(bf2f(P[(size_t)r * NPROJ + PG + 1024 + col]))); } };
struct EpiT3 { float* X1; const float* x; int n0;
    __device__ __forceinline__ void operator()(int r, int cl, float a, float) const { const size_t o = (size_t)r * 1024 + n0 + cl; X1[o] = x[o] + a; } };
template <int WHICH> __device__ __forceinline__ void phase_tail_naive(const Params& p, const Ctx& c) {
    unsigned char* ws = p.ws;
    for (int it = c.bid; it < (M / 128) * 16; it += c.G) {
        const int mt = it >> 4, nt = it & 15;
        if (WHICH == 0) ngemm_tile<false>(ARowPlain{(const bf16_t*)(ws + WS_YZ), 1024}, (const bf16_t*)(ws + WS_WST) + (size_t)nt * 64 * 1024, nullptr, 1024, mt * 128,
                                          EpiT1{(bf16_t*)(ws + WS_T1), (const bf16_t*)(ws + WS_P), (const float*)(ws + WS_RSTD), nt * 64}, (LAS float*)c.lds, c.tid);
        if (WHICH == 1) ngemm_tile<false>(ARowPlain{(const bf16_t*)(ws + WS_AO), 1024}, (const bf16_t*)(ws + WS_WAT) + (size_t)nt * 64 * 1024, nullptr, 1024, mt * 128,
                                          EpiT2{(bf16_t*)(ws + WS_MG), (const bf16_t*)(ws + WS_T1), (const bf16_t*)(ws + WS_P), nt * 64}, (LAS float*)c.lds, c.tid);
        if (WHICH == 2) ngemm_tile<false>(ARowPlain{(const bf16_t*)(ws + WS_MG), 1024}, (const bf16_t*)(ws + WS_WOT) + (size_t)nt * 64 * 1024, nullptr, 1024, mt * 128,
                                          EpiT3{(float*)(ws + WS_X1), p.in[0], nt * 64}, (LAS float*)c.lds, c.tid);
    }
}

__device__ __forceinline__ void phase_router(const Params& p, const Ctx& c) {
    unsigned char* ws = p.ws;
    LAS float* wT = (LAS float*)c.lds;
    LAS int* tokE = (LAS int*)(c.lds + LDS_CTL + 512);
    LAS float* tokW = (LAS float*)(c.lds + LDS_CTL + 512 + 1024);
    LAS int* lcnt = (LAS int*)(c.lds + LDS_CTL + 512 + 2048);
    LAS int* lbase = lcnt + 32;
    LAS int* lrank = lbase + 32;
    const float* X1 = (const float*)(ws + WS_X1); unsigned char* H2 = ws + WS_H2;
    int* CNT = (int*)(ws + WS_CTL); int* TOKES = (int*)(ws + WS_TOKES); float* TOKW = (float*)(ws + WS_TOKW); int* LIST = (int*)(ws + WS_LIST);
    const int tid = c.tid, lane = c.lane;
    __syncthreads();
    { const f32x4* src = (const f32x4*)(ws + WS_WRT); for (int idx = tid; idx < 8192; idx += 512) ((LAS f32x4*)wT)[idx] = src[idx]; }
    __syncthreads();
    f32x4 gv[4];
#pragma unroll
    for (int j = 0; j < 4; ++j) gv[j] = ((const f32x4*)p.in[16])[lane + 64 * j];
    const float bias_e = p.in[18][(lane >> 1) & 31];
    for (int blk = c.bid; blk < M / 64; blk += c.G) {
        if (tid < 32) lcnt[tid] = 0;
        for (int pr = 0; pr < 4; ++pr) {
            const int tl = c.wave * 8 + pr * 2;
            const size_t tokA = (size_t)blk * 64 + tl;
            f32x4 hA[4], hB[4];
            {
                const f32x4* xa = (const f32x4*)(X1 + tokA * 1024) + lane; const f32x4* xb = xa + 256;
                float sa = 0.f, sb = 0.f;
#pragma unroll
                for (int j = 0; j < 4; ++j) { hA[j] = xa[64 * j]; hB[j] = xb[64 * j];
                    sa += (hA[j].x * hA[j].x + hA[j].y * hA[j].y) + (hA[j].z * hA[j].z + hA[j].w * hA[j].w);
                    sb += (hB[j].x * hB[j].x + hB[j].y * hB[j].y) + (hB[j].z * hB[j].z + hB[j].w * hB[j].w); }
                const float ra = rsqrtf(wave_sum(sa) * (1.f / 1024.f) + EPS), rb = rsqrtf(wave_sum(sb) * (1.f / 1024.f) + EPS);
                unsigned* oa = (unsigned*)(H2 + tokA * 1024) + lane; unsigned* ob = oa + 256;
#pragma unroll
                for (int j = 0; j < 4; ++j) { hA[j] = hA[j] * ra * gv[j]; hB[j] = hB[j] * rb * gv[j];
                    oa[64 * j] = pack4_fp8(8.f * hA[j].x, 8.f * hA[j].y, 8.f * hA[j].z, 8.f * hA[j].w);
                    ob[64 * j] = pack4_fp8(8.f * hB[j].x, 8.f * hB[j].y, 8.f * hB[j].z, 8.f * hB[j].w); }
            }
            float accA[32], accB[32];
#pragma unroll
            for (int e = 0; e < 32; ++e) {
                float a = 0.f, b = 0.f;
#pragma unroll
                for (int j = 0; j < 4; ++j) { const f32x4 w = *(const LAS f32x4*)&wT[e * 1024 + 256 * j + 4 * lane];
                    a = fmaf(hA[j].x, w.x, a); a = fmaf(hA[j].y, w.y, a); a = fmaf(hA[j].z, w.z, a); a = fmaf(hA[j].w, w.w, a);
                    b = fmaf(hB[j].x, w.x, b); b = fmaf(hB[j].y, w.y, b); b = fmaf(hB[j].z, w.z, b); b = fmaf(hB[j].w, w.w, b); }
                accA[e] = a; accB[e] = b;
                if (e & 1) __builtin_amdgcn_sched_barrier(0);
            }
#define RSTEP(N, BIT) _Pragma("unroll") for (int i = 0; i < N; ++i) { const bool up = (lane & BIT) != 0; \
                const float ka = up ? accA[N + i] : accA[i], sa_ = up ? accA[i] : accA[N + i]; accA[i] = ka + __shfl_xor(sa_, BIT); \
                const float kb = up ? accB[N + i] : accB[i], sb_ = up ? accB[i] : accB[N + i]; accB[i] = kb + __shfl_xor(sb_, BIT); }
            RSTEP(16, 32) RSTEP(8, 16) RSTEP(4, 8) RSTEP(2, 4) RSTEP(1, 2)
#undef RSTEP
            const float la = accA[0] + __shfl_xor(accA[0], 1) + bias_e, lb = accB[0] + __shfl_xor(accB[0], 1) + bias_e;
            const int my_e = (lane >> 1) & 31;
#pragma unroll
            for (int t2 = 0; t2 < 2; ++t2) {
                float val = t2 ? lb : la;
                int se[4]; float sv[4];
#pragma unroll
                for (int k = 0; k < 4; ++k) {
                    const float mx = wave_max(val);
                    const int sel = wave_min_i(val == mx ? my_e : 64);
                    se[k] = sel; sv[k] = mx;
                    if (my_e == sel) val = -INFINITY;
                }
                const float e1 = __expf(sv[1] - sv[0]), e2 = __expf(sv[2] - sv[0]), e3 = __expf(sv[3] - sv[0]);
                const float inv = 1.f / (1.f + e1 + e2 + e3);
                if (lane == 0) {
                    const int t = tl + t2;
                    tokE[t * 4 + 0] = se[0]; tokE[t * 4 + 1] = se[1]; tokE[t * 4 + 2] = se[2]; tokE[t * 4 + 3] = se[3];
                    tokW[t * 4 + 0] = inv; tokW[t * 4 + 1] = e1 * inv; tokW[t * 4 + 2] = e2 * inv; tokW[t * 4 + 3] = e3 * inv;
                }
            }
        }
        __syncthreads();
        if (tid < 256) lrank[tid] = atomicAdd((int*)&lcnt[tokE[tid]], 1);
        __syncthreads();
        if (tid < 32) lbase[tid] = lcnt[tid] ? atomicAdd(&CNT[tid], lcnt[tid]) : 0;
        __syncthreads();
        if (tid < 256) {
            const int e = tokE[tid], slot = lbase[e] + lrank[tid], tok = blk * 64 + (tid >> 2);
            LIST[e * 16384 + slot] = tok; TOKES[tok * 4 + (tid & 3)] = (e << 16) | slot; TOKW[tok * 4 + (tid & 3)] = tokW[tid];
        }
        __syncthreads();
    }
}

__device__ __forceinline__ void load_offs(const Params& p, const Ctx& c, LAS int*& offs, LAS int*& cnt) {
    offs = (LAS int*)(c.lds + LDS_CTL); cnt = offs + 40;
    __syncthreads();
    if (c.tid == 0) {
        const int* CNT = (const int*)(p.ws + WS_CTL); int run = 0;
        for (int e = 0; e < 32; ++e) { const int n = __hip_atomic_load(CNT + e, __ATOMIC_RELAXED, __HIP_MEMORY_SCOPE_AGENT); cnt[e] = n; offs[e] = run; run += (n + 255) & ~255; }
        offs[32] = run;
    }
    __syncthreads();
}
__device__ __forceinline__ int find_expert(const LAS int* offs, int row) { int e = 0; while (e < 31 && row >= offs[e + 1]) ++e; return e; }

__device__ __forceinline__ void phase_gather(const Params& p, const Ctx& c) {
    LAS int* offs; LAS int* cnt; load_offs(p, c, offs, cnt);
    const bf16_t* H2 = (const bf16_t*)(p.ws + WS_H2); bf16_t* XB = (bf16_t*)(p.ws + WS_XB); const int* LIST = (const int*)(p.ws + WS_LIST);
    const int gw = c.bid * 8 + c.wave, NGW = c.G * 8, total = offs[32];
    for (int row0 = gw * 4; row0 < total; row0 += NGW * 4) {
        const int e = find_expert(offs, row0), slot0 = row0 - offs[e], n = cnt[e];
        int tok[4];
#pragma unroll
        for (int q = 0; q < 4; ++q) tok[q] = (slot0 + q < n) ? LIST[e * 16384 + slot0 + q] : -1;
        u32x4 v[4][2];
#pragma unroll
        for (int q = 0; q < 4; ++q) { v[q][0] = (u32x4){0u, 0u, 0u, 0u}; v[q][1] = v[q][0];
            if (tok[q] >= 0) { const u32x4* s = (const u32x4*)(H2 + (size_t)tok[q] * 1024); v[q][0] = s[c.lane]; v[q][1] = s[c.lane + 64]; } }
#pragma unroll
        for (int q = 0; q < 4; ++q) { u32x4* d = (u32x4*)(XB + (size_t)(row0 + q) * 1024); d[c.lane] = v[q][0]; d[c.lane + 64] = v[q][1]; }
    }
}

struct EpiAct { bf16_t* ACT; const float* b1; int j0;
    __device__ __forceinline__ void operator()(int r, int cl, float g, float u) const { const int j = j0 + cl;
        g = fminf(g + b1[j], 7.f); u = fminf(fmaxf(u + b1[1024 + j], -7.f), 7.f);
        ACT[(size_t)r * 1024 + j] = (bf16_t)f2bf(g * sigmoidf_(1.702f * g) * (u + 1.f)); } };
struct EpiY { bf16_t* YB; const float* b2; int n0;
    __device__ __forceinline__ void operator()(int r, int cl, float a, float) const { const int col = n0 + cl; YB[(size_t)r * 1024 + col] = (bf16_t)f2bf(a + b2[col]); } };
template <int WHICH> __device__ __forceinline__ void phase_moe_naive(const Params& p, const Ctx& c) {
    LAS int* offs; LAS int* cnt; load_offs(p, c, offs, cnt);
    unsigned char* ws = p.ws;
    const int nrt = offs[32] / 128;
    for (int it = c.bid; it < nrt * 16; it += c.G) {
        const int rt = it >> 4, ct = it & 15, row0 = rt * 128, e = find_expert(offs, row0);
        if (WHICH == 0) {
            const int j0 = ct * 64, nt = j0 >> 7, jj = j0 & 127;
            const bf16_t* Wg = (const bf16_t*)(ws + WS_W1T) + ((size_t)e * 2048 + nt * 256 + jj) * 1024;
            ngemm_tile<true>(ARowPlain{(const bf16_t*)(ws + WS_XB), 1024}, Wg, Wg + (size_t)128 * 1024, 1024, row0,
                             EpiAct{(bf16_t*)(ws + WS_ACT), p.in[20] + (size_t)e * 2048, j0}, (LAS float*)c.lds, c.tid);
        } else {
            const bf16_t* W = (const bf16_t*)(ws + WS_W2T) + ((size_t)e * 1024 + ct * 64) * 1024;
            ngemm_tile<false>(ARowPlain{(const bf16_t*)(ws + WS_ACT), 1024}, W, nullptr, 1024, row0,
                              EpiY{(bf16_t*)(ws + WS_YB), p.in[22] + (size_t)e * 1024, ct * 64}, (LAS float*)c.lds, c.tid);
        }
    }
}


__device__ __forceinline__ void phase_gemm1(const Params& p, const Ctx& c) {
    pg8::Gemm g{(const bf16_t*)(p.ws + WS_H), (const bf16_t*)(p.ws + WS_WINT), M, PDT, 1024};
    pg8::StaticOrder S; S.init(M, PDT, c.G, c.bid);
    pg8::EpiStore E{(bf16_t*)(p.ws + WS_P), NPROJ};
    pg8::gemm_phase<pg8::EpiStore, pg8::StaticOrder, true, true>(c.lds, g, S, E);
}
__device__ __forceinline__ void phase_tail12(const Params& p, const Ctx& c) {
    unsigned char* ws = p.ws;
    pg8::TailOrder S; S.so.init(M, 1024, c.G, c.bid);
    pg8::Gemm g{(const bf16_t*)(ws + WS_YZ), (const bf16_t*)(ws + WS_WST), 2 * M, 2048, 1024};
    pg8::EpiT12 E{(bf16_t*)(ws + WS_T1), (bf16_t*)(ws + WS_MG), (const bf16_t*)(ws + WS_P) + PG, NPROJ, (const float*)(ws + WS_RSTD)};
    pg8::gemm_phase<pg8::EpiT12, pg8::TailOrder, true, true>(c.lds, g, S, E);
}
__device__ __forceinline__ void phase_tail3(const Params& p, const Ctx& c) {
    unsigned char* ws = p.ws;
    pg8::StaticOrder S; S.init(M, 1024, c.G, c.bid);
    pg8::Gemm g{(const bf16_t*)(ws + WS_MG), (const bf16_t*)(ws + WS_WOT), M, 1024, 1024};
    pg8::EpiT3b E{(float*)(ws + WS_X1), p.in[0]};
    pg8::gemm_phase<pg8::EpiT3b, pg8::StaticOrder, true, true>(c.lds, g, S, E);
}
__device__ __forceinline__ void phase_moe1(const Params& p, const Ctx& c) {
    LAS int* offs; LAS int* cnt; load_offs(p, c, offs, cnt);
    unsigned char* ws = p.ws;
    pg8::Gemm g{(const bf16_t*)(ws + WS_H2), (const bf16_t*)(ws + WS_W1T), M, 32 * 2048, 512};
    pg8::MoeGatherOrder S{offs, cnt, (const int*)(ws + WS_LIST), 8, c.G, c.bid, offs[32] / 256};
    pg8::EpiAct8 E{(unsigned char*)(ws + WS_ACT), p.in[20]};
    pg8::gemm_phase_gather_f8<pg8::EpiAct8, pg8::MoeGatherOrder>(c.lds, g, S, E);
}
__device__ __forceinline__ void phase_moe2(const Params& p, const Ctx& c) {
    LAS int* offs; LAS int* cnt; load_offs(p, c, offs, cnt);
    unsigned char* ws = p.ws;
    pg8::Gemm g{(const bf16_t*)(ws + WS_ACT), (const bf16_t*)(ws + WS_W2T), ROWS_MAX, 32 * 1024, 512};
    pg8::MoeOrder S{offs, 4, c.G, c.bid, offs[32] / 256};
    pg8::EpiY8 E{(bf16_t*)(ws + WS_YB), p.in[22]};
    pg8::gemm_phase_f8<pg8::EpiY8, pg8::MoeOrder, true, true>(c.lds, g, S, E);
}

__device__ __forceinline__ void phase_combine(const Params& p, const Ctx& c) {
    LAS int* offs; LAS int* cnt; load_offs(p, c, offs, cnt);
    unsigned char* ws = p.ws;
    const float* X1 = (const float*)(ws + WS_X1); const bf16_t* YB = (const bf16_t*)(ws + WS_YB);
    const int* TOKES = (const int*)(ws + WS_TOKES); const float* TOKW = (const float*)(ws + WS_TOKW);
    const int gw = c.bid * 8 + c.wave, NGW = c.G * 8, lane = c.lane;
    f32x4 gv[4];
#pragma unroll
    for (int j = 0; j < 4; ++j) gv[j] = ((const f32x4*)p.in[23])[lane + 64 * j];
    for (int m0 = gw * 2; m0 < M; m0 += NGW * 2) {
        int es[2][4]; float wq[2][4];
#pragma unroll
        for (int t = 0; t < 2; ++t)
#pragma unroll
            for (int k = 0; k < 4; ++k) { es[t][k] = TOKES[(m0 + t) * 4 + k]; wq[t][k] = TOKW[(m0 + t) * 4 + k]; }
        f32x4 v[2][4]; u32x2 y[2][4][4];
#pragma unroll
        for (int t = 0; t < 2; ++t) { const f32x4* xr = (const f32x4*)(X1 + (size_t)(m0 + t) * 1024) + lane;
#pragma unroll
            for (int j = 0; j < 4; ++j) v[t][j] = xr[64 * j];
#pragma unroll
            for (int k = 0; k < 4; ++k) { const int row = offs[es[t][k] >> 16] + (es[t][k] & 0xffff); const u32x2* yr = (const u32x2*)(YB + (size_t)row * 1024) + lane;
#pragma unroll
                for (int j = 0; j < 4; ++j) y[t][k][j] = yr[64 * j]; } }
#pragma unroll
        for (int t = 0; t < 2; ++t) {
#pragma unroll
            for (int k = 0; k < 4; ++k) { const float w = wq[t][k];
#pragma unroll
                for (int j = 0; j < 4; ++j) { const u32x2 yy = y[t][k][j];
                    v[t][j].x = fmaf(w, bflo(yy.x), v[t][j].x); v[t][j].y = fmaf(w, bfhi(yy.x), v[t][j].y); v[t][j].z = fmaf(w, bflo(yy.y), v[t][j].z); v[t][j].w = fmaf(w, bfhi(yy.y), v[t][j].w); } }
            float s = 0.f;
#pragma unroll
            for (int j = 0; j < 4; ++j) s += (v[t][j].x * v[t][j].x + v[t][j].y * v[t][j].y) + (v[t][j].z * v[t][j].z + v[t][j].w * v[t][j].w);
            const float rstd = rsqrtf(wave_sum(s) * (1.f / 1024.f) + EPS);
            f32x4* o = (f32x4*)(p.out + (size_t)(m0 + t) * 1024) + lane;
#pragma unroll
            for (int j = 0; j < 4; ++j) o[64 * j] = v[t][j] * rstd * gv[j];
        }
    }
}

#define XB_TMO      128
#define XB_XCNT(j)  (256  + 64 * (j))
#define XB_XSUB(j)  (1280 + 64 * (j))
#define XB_XGEN(j)  (2304 + 64 * (j))
#define XB_TOP      3328
#define XB_TOPGEN   3392
#define XCD_BAR_WORDS 3456
#define XB_SPIN_CAP (1u << 18)

__device__ __forceinline__ unsigned xb_ld(unsigned* p)              { return __hip_atomic_load(p, __ATOMIC_RELAXED, __HIP_MEMORY_SCOPE_AGENT); }
__device__ __forceinline__ unsigned xb_add(unsigned* p, unsigned v) { return __hip_atomic_fetch_add(p, v, __ATOMIC_RELAXED, __HIP_MEMORY_SCOPE_AGENT); }
__device__ __forceinline__ unsigned xb_xcc_id() { return (unsigned)__builtin_amdgcn_s_getreg((3 << 11) | 20) & 0xFu; }
#define XB_SPIN(cond, bar) do { unsigned _sp = 0; while (cond) { __builtin_amdgcn_s_sleep(1); \
    if ((++_sp & 255u) == 0u) { if (xb_ld(&(bar)[XB_TMO])) break; if (_sp > XB_SPIN_CAP) { atomicAdd(&(bar)[XB_TMO], 1u); break; } } } } while (0)

struct XcdBarrier {
    unsigned* bar; unsigned x;
    volatile LAS unsigned* st;
};

__device__ __forceinline__ XcdBarrier xcd_barrier_post(unsigned* bar, volatile LAS unsigned* st) {
    XcdBarrier b; b.bar = bar; b.x = xb_xcc_id(); b.st = st;
    if (threadIdx.x == 0) (void)xb_add(&bar[XB_XCNT(b.x)], 1u);
    return b;
}
__device__ __forceinline__ void xcd_barrier_complete(unsigned* bar, unsigned x, unsigned& nloc, unsigned& nx) {
    const unsigned G = gridDim.x * gridDim.y * gridDim.z;
    unsigned sum, cnt, mine, sp = 0u;
    for (;;) {
        sum = 0u; cnt = 0u; mine = 0u;
#pragma unroll
        for (unsigned j = 0; j < 16; ++j) { const unsigned c = xb_ld(&bar[XB_XCNT(j)]); sum += c; cnt += (c > 0u) ? 1u : 0u; mine = (j == x) ? c : mine; }
        if (sum == G) break;
        __builtin_amdgcn_s_sleep(1);
        if ((++sp & 255u) == 0u) { if (xb_ld(&bar[XB_TMO])) break; if (sp > XB_SPIN_CAP) { atomicAdd(&bar[XB_TMO], 1u); break; } }
    }
    nloc = mine > 0u ? mine : 1u; nx = cnt > 0u ? cnt : 1u;
}

__device__ __forceinline__ void xcd_barrier(const XcdBarrier& b) {
    asm volatile("s_waitcnt vmcnt(0)" ::: "memory");
    __syncthreads();
    if (threadIdx.x == 0) {
        unsigned* bar = b.bar;
        __builtin_amdgcn_s_waitcnt(0);
        unsigned nloc = b.st[0], nx = b.st[1];
        if (nloc == 0u) { xcd_barrier_complete(bar, b.x, nloc, nx); b.st[0] = nloc; b.st[1] = nx; }
        const unsigned old = xb_add(&bar[XB_XSUB(b.x)], 1u);
        const unsigned gen = old / nloc;
        if (old + 1u == (gen + 1u) * nloc) {
            __builtin_amdgcn_fence(__ATOMIC_RELEASE, "agent");
            asm volatile("s_waitcnt vmcnt(0)" ::: "memory");
            const unsigned og = xb_add(&bar[XB_TOP], 1u);
            const unsigned tg = og / nx;
            if (og + 1u == (tg + 1u) * nx) xb_add(&bar[XB_TOPGEN], 1u);
            else XB_SPIN(xb_ld(&bar[XB_TOPGEN]) == tg, bar);
            __builtin_amdgcn_fence(__ATOMIC_ACQUIRE, "agent");
            xb_add(&bar[XB_XGEN(b.x)], 1u);
            asm volatile("s_waitcnt vmcnt(0)" ::: "memory");
        } else {
            XB_SPIN(xb_ld(&bar[XB_XGEN(b.x)]) == gen, bar);
            __builtin_amdgcn_fence(__ATOMIC_ACQUIRE, "agent");
            asm volatile("s_waitcnt vmcnt(0)" ::: "memory");
        }
    }
    __syncthreads();
}

constexpr int NPHASE = 13;
__global__ void __launch_bounds__(512) mega(Params p) {
    extern __shared__ __attribute__((aligned(16))) unsigned char lds_raw[];
    Ctx c; c.tid = threadIdx.x; c.lane = c.tid & 63; c.wave = __builtin_amdgcn_readfirstlane(c.tid >> 6); c.bid = blockIdx.x; c.G = gridDim.x;
    c.lds = (LAS unsigned char*)lds_raw;
    cg::grid_group grid = cg::this_grid();
    if (c.tid < 2) ((volatile LAS unsigned*)(c.lds + LDS_BARST))[c.tid] = 0u;
    __syncthreads();
#define SEAM(k) do { if ((k) == 0) { grid.sync(); (void)xcd_barrier_post((unsigned*)(p.ws + WS_BAR), (volatile LAS unsigned*)(c.lds + LDS_BARST)); } \
        else { XcdBarrier b_; b_.bar = (unsigned*)(p.ws + WS_BAR); b_.x = xb_xcc_id(); b_.st = (volatile LAS unsigned*)(c.lds + LDS_BARST); xcd_barrier(b_); } } while (0)
#define RUN(k, call) if (p.ph_lo <= (k) && (k) < p.ph_hi) { call; if ((k) + 1 < p.ph_hi) SEAM(k); }
    RUN(0, phase_prep(p, c))
    RUN(1, phase_gemm1(p, c))
    RUN(2, phase_conv(p, c))
    RUN(3, phase_ssd_states(p, c))
    RUN(4, phase_ssd_scan(p, c))
    RUN(5, phase_ssd_out(p, c))
    RUN(6, phase_rstd(p, c); phase_attn(p, c, (char*)lds_raw))
    RUN(7, phase_tail12(p, c))
    RUN(8, phase_tail3(p, c))
    RUN(9, phase_router(p, c))
    RUN(10, phase_moe1(p, c))
    RUN(11, phase_moe2(p, c))
    RUN(12, phase_combine(p, c))
#undef RUN
}

extern "C" void kernel_launch(void* const* d_in, const int* in_sizes, int n_in, void* d_out, int out_size, void* d_ws, size_t ws_size, hipStream_t stream) {
    static int ok = 0; static int grid_blocks = 0;
    if (ok == 0) {
        if (n_in != 24 || out_size != M * D || ws_size < WS_END) { fprintf(stderr, "kernel_launch: unexpected shapes: n_in %d out %d ws %zu (need %zu)\n", n_in, out_size, ws_size, (size_t)WS_END); ok = -1; return; }
        if (hipFuncSetAttribute((const void*)mega, hipFuncAttributeMaxDynamicSharedMemorySize, LDS_BYTES) != hipSuccess) { fprintf(stderr, "kernel_launch: hipFuncSetAttribute failed\n"); ok = -1; return; }
        int dev = 0, cus = 0, per_cu = 0;
        hipGetDevice(&dev);
        hipDeviceGetAttribute(&cus, hipDeviceAttributeMultiprocessorCount, dev);
        hipOccupancyMaxActiveBlocksPerMultiprocessor(&per_cu, (const void*)mega, 512, LDS_BYTES);
        if (per_cu < 1 || cus < 1) { fprintf(stderr, "kernel_launch: occupancy query gave %d blocks/CU on %d CUs\n", per_cu, cus); ok = -1; return; }
        grid_blocks = cus;
        ok = 1;
    }
    if (ok < 0) return;
    Params p{};
    for (int i = 0; i < 24; ++i) p.in[i] = (const float*)d_in[i];
    p.out = (float*)d_out; p.ws = (unsigned char*)d_ws;
    p.ph_lo = 0; p.ph_hi = NPHASE;
    void* args[] = {&p};
    hipError_t e = hipLaunchCooperativeKernel((const void*)mega, dim3(grid_blocks), dim3(512), args, LDS_BYTES, stream);
    if (e != hipSuccess) fprintf(stderr, "kernel_launch: cooperative launch failed: %s (grid %d)\n", hipGetErrorString(e), grid_blocks);
}
```

```cpp
#include <hip/hip_runtime.h>
#include <hip/hip_cooperative_groups.h>
#include <cstdio>
#include <cstdint>

namespace cg = cooperative_groups;
#define LAS __attribute__((address_space(3)))
typedef unsigned short bf16_t;
typedef unsigned u32x4 __attribute__((ext_vector_type(4)));
typedef unsigned u32x2 __attribute__((ext_vector_type(2)));
typedef float f32x4 __attribute__((ext_vector_type(4)));

constexpr int NB = 2, S = 8192, D = 1024, M = NB * S;
constexpr int NPROJ = 6400;
constexpr int PZ = 0, PXBC = 1024, PQ = 2560, PK = 3584, PV = 3840, PG = 4096, PDT = 6144;
constexpr int ROWS_MAX = 65536 + 32 * 256;
constexpr float EPS = 1e-6f;

constexpr size_t al256(size_t x) { return (x + 255) / 256 * 256; }
constexpr size_t WS_CTL = 0;
constexpr size_t WS_BAR = 4096;
constexpr size_t WS_ROPE = 4096 + 16384;
constexpr size_t WS_WRT = WS_ROPE + 32768;
constexpr size_t WS_WINT = WS_WRT + 131072;
constexpr size_t WS_WST = WS_WINT + (size_t)NPROJ * 1024 * 2;
constexpr size_t WS_WAT = WS_WST + 2097152;
constexpr size_t WS_WOT = WS_WAT + 2097152;
constexpr size_t WS_W1T = WS_WOT + 2097152;
constexpr size_t WS_W2T = WS_W1T + (size_t)32 * 2048 * 1024 * 2;
constexpr size_t WS_X1 = WS_W2T + (size_t)32 * 1024 * 1024 * 2;
constexpr size_t WS_H2 = WS_X1 + (size_t)M * 1024 * 4;
constexpr size_t WS_TOKES = WS_H2 + (size_t)M * 1024 * 2;
constexpr size_t WS_TOKW = WS_TOKES + (size_t)M * 16;
constexpr size_t WS_LIST = WS_TOKW + (size_t)M * 16;
constexpr size_t WS_R = WS_LIST + (size_t)32 * 16384 * 4;
constexpr size_t WS_H = WS_R;
constexpr size_t WS_P = WS_H + (size_t)M * 1024 * 2;
constexpr size_t WS_XT = WS_P + (size_t)M * NPROJ * 2;
constexpr size_t WS_BMR = WS_XT + (size_t)M * 1024 * 2;
constexpr size_t WS_BMT = WS_BMR + (size_t)M * 256 * 2;
constexpr size_t WS_CMR = WS_BMT + (size_t)M * 256 * 2;
constexpr size_t WS_DT = WS_CMR + (size_t)M * 256 * 2;
constexpr size_t WS_ACS = WS_DT + (size_t)2 * M * 16 * 4;
constexpr size_t WS_CDEC = WS_ACS + (size_t)2 * M * 16 * 4;
constexpr size_t WS_ST = WS_CDEC + 16384;
constexpr size_t WS_PREV = WS_ST + (size_t)2 * 2 * 64 * 16 * 8192 * 4;
constexpr size_t WS_YZ = WS_PREV + (size_t)2 * 2 * 64 * 16 * 8192 * 2;
constexpr size_t WS_AO = WS_YZ + (size_t)M * 1024 * 2;
constexpr size_t WS_RSTD = WS_AO + (size_t)M * 1024 * 2;
constexpr size_t WS_QN = WS_RSTD + (size_t)M * 4;
constexpr size_t WS_KN = WS_QN + (size_t)M * 1024 * 2;
constexpr size_t WS_VB = WS_KN + (size_t)M * 256 * 2;
constexpr size_t WS_T1 = WS_VB + (size_t)M * 256 * 2;
constexpr size_t WS_MG = WS_T1 + (size_t)M * 1024 * 2;
constexpr size_t WS_END = WS_MG + (size_t)M * 1024 * 2;
constexpr size_t WS_XB = WS_R;
constexpr size_t WS_ACT = WS_XB + (size_t)ROWS_MAX * 1024 * 2;
constexpr size_t WS_YB = WS_XB;
static_assert(WS_ACT + (size_t)ROWS_MAX * 1024 * 2 <= WS_END, "moe overlay");
static_assert(WS_END <= (size_t)1073741824, "workspace");
static_assert(WS_WAT == WS_WST + 2097152 && WS_AO == WS_YZ + (size_t)M * 2048, "concatenated operands of the merged branch GEMMs");

constexpr int LDS_BYTES = 147712;
constexpr int LDS_BARST = 147456;
constexpr int LDS_CTL = 143360;

struct Params {
    const float* in[24];
    float* out;
    unsigned char* ws;
    int ph_lo, ph_hi;
};

__device__ __forceinline__ float bf2f(bf16_t v) { return __uint_as_float((unsigned)v << 16); }
__device__ __forceinline__ float bflo(unsigned w) { return __uint_as_float(w << 16); }
__device__ __forceinline__ float bfhi(unsigned w) { return __uint_as_float(w & 0xffff0000u); }
__device__ __forceinline__ unsigned f2bf(float f) { unsigned u = __float_as_uint(f); return (u + 0x7fffu + ((u >> 16) & 1u)) >> 16; }
__device__ __forceinline__ unsigned pk2(float lo, float hi) { return f2bf(lo) | (f2bf(hi) << 16); }
__device__ __forceinline__ float wave_sum(float v) {
#pragma unroll
    for (int o = 1; o < 64; o <<= 1) v += __shfl_xor(v, o);
    return v;
}
__device__ __forceinline__ float wave_max(float v) {
#pragma unroll
    for (int o = 1; o < 64; o <<= 1) v = fmaxf(v, __shfl_xor(v, o));
    return v;
}
__device__ __forceinline__ int wave_min_i(int v) {
#pragma unroll
    for (int o = 1; o < 64; o <<= 1) { int t = __shfl_xor(v, o); v = t < v ? t : v; }
    return v;
}
__device__ __forceinline__ float sigmoidf_(float x) { return 1.f / (1.f + __expf(-x)); }
__device__ __forceinline__ unsigned pack4_fp8(float a, float b, float c, float d) { unsigned w = __builtin_amdgcn_cvt_pk_fp8_f32(a, b, 0u, false); return __builtin_amdgcn_cvt_pk_fp8_f32(c, d, w, true); }
#define LDS_WAIT() asm volatile("s_waitcnt lgkmcnt(0)" ::: "memory")

struct Ctx { int tid, lane, wave, bid, G; LAS unsigned char* lds; };

struct TItem { const float* W; bf16_t* WT; const float* kscale; int N, k0, n0, orow0; };
__device__ __forceinline__ void transpose_load(const TItem& t, f32x4 (&v)[8], int lane) {
    const int nq = lane & 7, kg = lane >> 3;
    const float* s = t.W + (size_t)(t.k0 + 8 * kg) * t.N + t.n0 + 4 * nq;
#pragma unroll
    for (int i = 0; i < 8; ++i) v[i] = *(const f32x4*)(s + (size_t)i * t.N);
}
__device__ __forceinline__ void transpose_store(const TItem& t, f32x4 (&v)[8], int lane) {
    const int nq = lane & 7, kg = lane >> 3;
    if (t.kscale) {
#pragma unroll
        for (int i = 0; i < 8; ++i) v[i] = v[i] * t.kscale[t.k0 + 8 * kg + i];
    }
    bf16_t* d = t.WT + (size_t)(t.orow0 + 4 * nq) * 1024 + t.k0 + 8 * kg;
#pragma unroll
    for (int j = 0; j < 4; ++j) { u32x4 o; o.x = pk2(v[0][j], v[1][j]); o.y = pk2(v[2][j], v[3][j]); o.z = pk2(v[4][j], v[5][j]); o.w = pk2(v[6][j], v[7][j]);
        *(u32x4*)(d + (size_t)j * 1024) = o; }
}
constexpr int PREP_I_IN = 16 * 193, PREP_I_SQ = 512, PREP_NITEMS = PREP_I_IN + 3 * PREP_I_SQ;
__device__ __forceinline__ TItem prep_item(const Params& p, int r) {
    unsigned char* ws = p.ws; TItem t; t.kscale = nullptr;
    if (r < PREP_I_IN) { const int kb = r / 193, nb = r % 193, n0 = nb * 32;
        t.W = p.in[2]; t.WT = (bf16_t*)(ws + WS_WINT); t.N = 6176; t.k0 = kb * 64; t.n0 = n0; t.orow0 = n0 < 2560 ? n0 : (n0 < 2592 ? PDT + (n0 - 2560) : n0 - 32); return t; }
    r -= PREP_I_IN;
    { const int which = r / PREP_I_SQ, q = r % PREP_I_SQ;
        t.W = which == 0 ? p.in[13] : (which == 1 ? p.in[14] : p.in[15]); t.WT = (bf16_t*)(ws + (which == 0 ? WS_WST : (which == 1 ? WS_WAT : WS_WOT)));
        t.kscale = which == 0 ? p.in[10] : nullptr; t.N = 1024; t.k0 = (q / 32) * 64; t.n0 = (q % 32) * 32; t.orow0 = t.n0; return t; }
}
constexpr int PREP8_TILES = 32 * 64 + 32 * 32;
struct T8 { const float* W; unsigned char* WT; int N, k0, n0; bool w1; };
__device__ __forceinline__ T8 prep8_tile(const Params& p, int t) {
    T8 r;
    if (t < 2048) { const int e = t >> 6; r.W = p.in[19] + (size_t)e * 1024 * 2048; r.WT = p.ws + WS_W1T + (size_t)e * 2048 * 1024; r.N = 2048; r.k0 = ((t >> 3) & 7) * 128; r.n0 = (t & 7) * 256; r.w1 = true; }
    else { t -= 2048; const int e = t >> 5; r.W = p.in[21] + (size_t)e * 1024 * 1024; r.WT = p.ws + WS_W2T + (size_t)e * 1024 * 1024; r.N = 1024; r.k0 = ((t >> 2) & 7) * 128; r.n0 = (t & 3) * 256; r.w1 = false; }
    return r;
}
__device__ __forceinline__ void prep8_load(const T8& t, f32x4 (&v)[16], int wave, int lane) {
    const float* s = t.W + (size_t)(t.k0 + 16 * wave) * t.N + t.n0 + 4 * lane;
#pragma unroll
    for (int i = 0; i < 16; ++i) v[i] = *(const f32x4*)(s + (size_t)i * t.N);
}
__device__ __forceinline__ void phase_prep8(const Params& p, const Ctx& c) {
    f32x4 v[16];
    int t = c.bid;
    if (t < PREP8_TILES) { const T8 t0 = prep8_tile(p, t); prep8_load(t0, v, c.wave, c.lane); }
    for (int i = 0; t < PREP8_TILES; ++i, t += c.G) {
        const T8 cur = prep8_tile(p, t);
        LAS unsigned char* img = c.lds + (i & 1) * 32768;
#pragma unroll
        for (int j = 0; j < 4; ++j) { u32x4 o;
            o.x = pack4_fp8(64.f * v[0][j], 64.f * v[1][j], 64.f * v[2][j], 64.f * v[3][j]); o.y = pack4_fp8(64.f * v[4][j], 64.f * v[5][j], 64.f * v[6][j], 64.f * v[7][j]);
            o.z = pack4_fp8(64.f * v[8][j], 64.f * v[9][j], 64.f * v[10][j], 64.f * v[11][j]); o.w = pack4_fp8(64.f * v[12][j], 64.f * v[13][j], 64.f * v[14][j], 64.f * v[15][j]);
            *(LAS u32x4*)(img + (4 * c.lane + j) * 128 + 16 * c.wave) = o; }
        if (t + c.G < PREP8_TILES) { const T8 nx = prep8_tile(p, t + c.G); prep8_load(nx, v, c.wave, c.lane); }
        __syncthreads();
#pragma unroll
        for (int q = 0; q < 4; ++q) { const int idx = c.tid + 512 * q, nl = idx >> 3, cw = idx & 7, n = cur.n0 + nl;
            const int orow = cur.w1 ? (((n & 1023) >> 7) * 256 + (n >> 10) * 128 + (n & 127)) : n;
            *(u32x4*)(cur.WT + (size_t)orow * 1024 + cur.k0 + 16 * cw) = *(const LAS u32x4*)(img + nl * 128 + 16 * cw); }
    }
    __syncthreads();
}

__device__ __forceinline__ void phase_prep(const Params& p, const Ctx& c) {
    unsigned char* ws = p.ws;
    const int gw = c.bid * 8 + c.wave, NGW = c.G * 8;
    for (int it = gw; it < PREP_NITEMS; it += 2 * NGW) {
        const TItem ta = prep_item(p, it); f32x4 va[8], vb[8];
        transpose_load(ta, va, c.lane);
        const bool two = it + NGW < PREP_NITEMS;
        const TItem tb = prep_item(p, two ? it + NGW : it);
        if (two) transpose_load(tb, vb, c.lane);
        transpose_store(ta, va, c.lane);
        if (two) transpose_store(tb, vb, c.lane);
    }
    phase_prep8(p, c);
    for (int r = 6176 + gw; r < NPROJ; r += NGW) {
        u32x4* o = (u32x4*)((bf16_t*)(ws + WS_WINT) + (size_t)r * 1024);
        o[c.lane] = (u32x4){0u, 0u, 0u, 0u}; o[c.lane + 64] = (u32x4){0u, 0u, 0u, 0u};
    }
    {
        const float* x = p.in[0]; const float* g = p.in[1]; bf16_t* H = (bf16_t*)(ws + WS_H);
        f32x4 gv[4];
#pragma unroll
        for (int j = 0; j < 4; ++j) gv[j] = ((const f32x4*)g)[c.lane + 64 * j];
        for (int m = gw; m < M; m += NGW) {
            const f32x4* xr = (const f32x4*)(x + (size_t)m * D) + c.lane;
            f32x4 v[4]; float s = 0.f;
#pragma unroll
            for (int j = 0; j < 4; ++j) { v[j] = xr[64 * j]; s += (v[j].x * v[j].x + v[j].y * v[j].y) + (v[j].z * v[j].z + v[j].w * v[j].w); }
            const float rstd = rsqrtf(wave_sum(s) * (1.f / D) + EPS);
            u32x2* o = (u32x2*)(H + (size_t)m * D) + c.lane;
#pragma unroll
            for (int j = 0; j < 4; ++j) { u32x2 w; w.x = pk2(v[j].x * rstd * gv[j].x, v[j].y * rstd * gv[j].y); w.y = pk2(v[j].z * rstd * gv[j].z, v[j].w * rstd * gv[j].w); o[64 * j] = w; }
        }
    }
    {
        float* rc = (float*)(ws + WS_ROPE); float* rs = rc + 4096;
        for (int idx = c.bid * 512 + c.tid; idx < 4096; idx += c.G * 512) {
            const int pos = idx >> 5, i = idx & 31;
            const float inv = exp2f(-(float)i * (13.287712379549449f / 32.f));
            float rev = (float)pos * inv * 0.15915494309189535f; rev -= floorf(rev);
            rc[idx] = __builtin_amdgcn_cosf(rev); rs[idx] = __builtin_amdgcn_sinf(rev);
        }
        float* wrt = (float*)(ws + WS_WRT); const float* wr = p.in[17];
        for (int idx = c.bid * 512 + c.tid; idx < 32768; idx += c.G * 512) { const int k = idx >> 5, e = idx & 31; wrt[e * 1024 + k] = wr[idx]; }
        if (c.bid == 0 && c.tid < 64) ((int*)(ws + WS_CTL))[c.tid] = 0;
    }
}

template <bool DUAL, class ARow, class Epi>
__device__ __forceinline__ void ngemm_tile(const ARow& arow, const bf16_t* Bt, const bf16_t* Bt2, int K, int m0, const Epi& epi, LAS float* lds, int tid) {
    LAS float* As = lds;
    LAS float* Bs = lds + 32 * 132;
    LAS float* Bs2 = Bs + 32 * 68;
    float acc[4][4], acc2[4][4];
#pragma unroll
    for (int i = 0; i < 4; ++i)
#pragma unroll
        for (int j = 0; j < 4; ++j) { acc[i][j] = 0.f; acc2[i][j] = 0.f; }
    const int tm = tid & 31, tn = tid >> 5;
    const int sr = tid >> 2, kq = (tid & 3) * 8;
    const bf16_t* ap = arow(m0 + sr) + kq;
    const bf16_t* bp = Bt + (size_t)(sr & 63) * K + kq;
    const bf16_t* bp2 = DUAL ? Bt2 + (size_t)(sr & 63) * K + kq : nullptr;
    for (int k0 = 0; k0 < K; k0 += 32) {
        {
            const u32x4 v = *(const u32x4*)(ap + k0);
            As[(kq + 0) * 132 + sr] = bflo(v.x); As[(kq + 1) * 132 + sr] = bfhi(v.x); As[(kq + 2) * 132 + sr] = bflo(v.y); As[(kq + 3) * 132 + sr] = bfhi(v.y);
            As[(kq + 4) * 132 + sr] = bflo(v.z); As[(kq + 5) * 132 + sr] = bfhi(v.z); As[(kq + 6) * 132 + sr] = bflo(v.w); As[(kq + 7) * 132 + sr] = bfhi(v.w);
        }
        if (tid < 256) {
            const u32x4 v = *(const u32x4*)(bp + k0);
            Bs[(kq + 0) * 68 + sr] = bflo(v.x); Bs[(kq + 1) * 68 + sr] = bfhi(v.x); Bs[(kq + 2) * 68 + sr] = bflo(v.y); Bs[(kq + 3) * 68 + sr] = bfhi(v.y);
            Bs[(kq + 4) * 68 + sr] = bflo(v.z); Bs[(kq + 5) * 68 + sr] = bfhi(v.z); Bs[(kq + 6) * 68 + sr] = bflo(v.w); Bs[(kq + 7) * 68 + sr] = bfhi(v.w);
        } else if (DUAL) {
            const int r2 = sr & 63;
            const u32x4 v = *(const u32x4*)(bp2 + k0);
            Bs2[(kq + 0) * 68 + r2] = bflo(v.x); Bs2[(kq + 1) * 68 + r2] = bfhi(v.x); Bs2[(kq + 2) * 68 + r2] = bflo(v.y); Bs2[(kq + 3) * 68 + r2] = bfhi(v.y);
            Bs2[(kq + 4) * 68 + r2] = bflo(v.z); Bs2[(kq + 5) * 68 + r2] = bfhi(v.z); Bs2[(kq + 6) * 68 + r2] = bflo(v.w); Bs2[(kq + 7) * 68 + r2] = bfhi(v.w);
        }
        __syncthreads();
#pragma unroll 8
        for (int k = 0; k < 32; ++k) {
            const f32x4 a = *(const LAS f32x4*)&As[k * 132 + tm * 4];
            const f32x4 b = *(const LAS f32x4*)&Bs[k * 68 + tn * 4];
#pragma unroll
            for (int i = 0; i < 4; ++i)
#pragma unroll
                for (int j = 0; j < 4; ++j) acc[i][j] = fmaf(a[i], b[j], acc[i][j]);
            if (DUAL) {
                const f32x4 b2 = *(const LAS f32x4*)&Bs2[k * 68 + tn * 4];
#pragma unroll
                for (int i = 0; i < 4; ++i)
#pragma unroll
                    for (int j = 0; j < 4; ++j) acc2[i][j] = fmaf(a[i], b2[j], acc2[i][j]);
            }
        }
        __syncthreads();
    }
#pragma unroll
    for (int i = 0; i < 4; ++i)
#pragma unroll
        for (int j = 0; j < 4; ++j) epi(m0 + tm * 4 + i, tn * 4 + j, acc[i][j], acc2[i][j]);
}
struct ARowPlain { const bf16_t* A; int lda; __device__ __forceinline__ const bf16_t* operator()(int m) const { return A + (size_t)m * lda; } };

namespace pg8 {
#define PG8_LAS __attribute__((address_space(3)))
typedef unsigned short bf16_t;
typedef short bf16x8 __attribute__((ext_vector_type(8)));
typedef float f32x4 __attribute__((ext_vector_type(4)));
typedef unsigned u32x4 __attribute__((ext_vector_type(4)));
constexpr int BM = 256, BK = 64, HALF = 128, HTB = HALF * BK * 2  , STAGE_BYTES = 8 * HTB, NXCD = 8, WGM = 8;

__host__ __device__ __forceinline__ int lds_byte(int r, int c) { const int st = (r >> 4) * 2 + (c >> 5), rr = r & 15, cc = c & 31, ob = rr * 64 + cc * 2; return st * 1024 + (ob ^ (((ob >> 9) & 1) << 5)); }
__host__ __device__ __forceinline__ void stage_rc(int b, int& R, int& C) { const int st = b / 1024, sb = b % 1024, swz = sb ^ (((sb >> 9) & 1) << 5); R = (st >> 1) * 16 + swz / 64; C = (st & 1) * 32 + (swz % 64) / 2; }
__host__ __device__ __forceinline__ int perm32(int rho) { const int n = rho >> 4, i = rho & 15; return 8 * (i >> 2) + 4 * n + (i & 3); }

struct Unit { int pm, pn; };
struct Gemm { const bf16_t* A; const bf16_t* Bt; int M, N, K; };

struct StaticOrder {
    int nM, nN, nwg, G, c;
    __host__ __device__ void init(int M, int N, int G_, int c_) { nM = M / BM; nN = N / BM; nwg = nM * nN; G = G_; c = c_; }
    __host__ __device__ bool next(int i, Unit& u) const {
        const long L = (long)i * G + c; if (L >= nwg) return false;
        int wgid = (int)L; { const int q = nwg / NXCD, r = nwg % NXCD, xcd = wgid % NXCD, off = wgid / NXCD; wgid = (xcd < r ? xcd * (q + 1) : r * (q + 1) + (xcd - r) * q) + off; }
        const int nig = WGM * nN, gid = wgid / nig, fm = gid * WGM, gsz = (nM - fm) < WGM ? (nM - fm) : WGM;
        u.pm = fm + ((wgid % nig) % gsz); u.pn = (wgid % nig) / gsz; return true;
    }
    __device__ __forceinline__ void a_ready(const Unit&) const {}
    __device__ __forceinline__ void done(const Unit&) const {}
};


__device__ __forceinline__ unsigned cvt_pk_bf16(float lo, float hi) { unsigned r; asm volatile("v_cvt_pk_bf16_f32 %0, %1, %2" : "=v"(r) : "v"(lo), "v"(hi)); return r; }
__device__ __forceinline__ float sig_(float x) { return __builtin_amdgcn_rcpf(1.f + __builtin_amdgcn_exp2f(-1.4426950408889634f * x)); }
__device__ __forceinline__ u32x4 pack8(const f32x4& v0, const f32x4& v1) { u32x4 w; w.x = cvt_pk_bf16(v0[0], v0[1]); w.y = cvt_pk_bf16(v0[2], v0[3]); w.z = cvt_pk_bf16(v1[0], v1[1]); w.w = cvt_pk_bf16(v1[2], v1[3]); return w; }
__device__ __forceinline__ void unpack8(const u32x4& w, f32x4& v0, f32x4& v1) {
    v0[0] = __uint_as_float(w.x << 16); v0[1] = __uint_as_float(w.x & 0xffff0000u); v0[2] = __uint_as_float(w.y << 16); v0[3] = __uint_as_float(w.y & 0xffff0000u);
    v1[0] = __uint_as_float(w.z << 16); v1[1] = __uint_as_float(w.z & 0xffff0000u); v1[2] = __uint_as_float(w.w << 16); v1[3] = __uint_as_float(w.w & 0xffff0000u); }
struct EpiStore {
    static constexpr bool PERM = true, AFTER_DRAIN = false;
    bf16_t* O; int ldc;
    __device__ __forceinline__ void operator()(const f32x4 (&acc)[2][2][4][2], const Unit& u, int wr, int wc, int fr, int fq) const {
        const int row0 = u.pm * BM + wr * 64 + fr, col0 = u.pn * BM + wc * 32 + 8 * fq;
#pragma unroll
        for (int ai = 0; ai < 2; ++ai)
#pragma unroll
            for (int m = 0; m < 4; ++m) { bf16_t* rowp = O + (size_t)(row0 + ai * HALF + m * 16) * ldc + col0;
#pragma unroll
                for (int bj = 0; bj < 2; ++bj) *(u32x4*)(rowp + bj * HALF) = pack8(acc[ai][bj][m][0], acc[ai][bj][m][1]); }
    }
};
struct EpiT1 {
    static constexpr bool PERM = true, AFTER_DRAIN = false;
    bf16_t* T1; const bf16_t* G; int ldg; const float* RSTD;
    __device__ __forceinline__ void operator()(const f32x4 (&acc)[2][2][4][2], const Unit& u, int wr, int wc, int fr, int fq) const {
        const int row0 = u.pm * BM + wr * 64 + fr, col0 = u.pn * BM + wc * 32 + 8 * fq;
#pragma unroll
        for (int ai = 0; ai < 2; ++ai)
#pragma unroll
            for (int m = 0; m < 4; ++m) { const int row = row0 + ai * HALF + m * 16; const float rs = RSTD[row];
#pragma unroll
                for (int bj = 0; bj < 2; ++bj) { const int col = col0 + bj * HALF;
                    f32x4 g0, g1; unpack8(*(const u32x4*)(G + (size_t)row * ldg + col), g0, g1);
                    f32x4 v0 = acc[ai][bj][m][0] * rs, v1 = acc[ai][bj][m][1] * rs;
#pragma unroll
                    for (int i = 0; i < 4; ++i) { v0[i] *= sig_(g0[i]); v1[i] *= sig_(g1[i]); }
                    *(u32x4*)(T1 + (size_t)row * 1024 + col) = pack8(v0, v1); } }
    }
};
struct EpiT2 {
    static constexpr bool PERM = true, AFTER_DRAIN = false;
    bf16_t* MG; const bf16_t* T1; const bf16_t* G; int ldg;
    __device__ __forceinline__ void operator()(const f32x4 (&acc)[2][2][4][2], const Unit& u, int wr, int wc, int fr, int fq) const {
        const int row0 = u.pm * BM + wr * 64 + fr, col0 = u.pn * BM + wc * 32 + 8 * fq;
#pragma unroll
        for (int ai = 0; ai < 2; ++ai)
#pragma unroll
            for (int m = 0; m < 4; ++m) { const int row = row0 + ai * HALF + m * 16;
#pragma unroll
                for (int bj = 0; bj < 2; ++bj) { const int col = col0 + bj * HALF;
                    f32x4 g0, g1, t0, t1; unpack8(*(const u32x4*)(G + (size_t)row * ldg + col), g0, g1); unpack8(*(const u32x4*)(T1 + (size_t)row * 1024 + col), t0, t1);
                    f32x4 v0 = acc[ai][bj][m][0], v1 = acc[ai][bj][m][1];
#pragma unroll
                    for (int i = 0; i < 4; ++i) { v0[i] = fmaf(v0[i], sig_(g0[i]), t0[i]); v1[i] = fmaf(v1[i], sig_(g1[i]), t1[i]); }
                    *(u32x4*)(MG + (size_t)row * 1024 + col) = pack8(v0, v1); } }
    }
};
struct EpiT3 {
    static constexpr bool PERM = true, AFTER_DRAIN = false;
    float* X1; const float* x;
    __device__ __forceinline__ void operator()(const f32x4 (&acc)[2][2][4][2], const Unit& u, int wr, int wc, int fr, int fq) const {
        const int row0 = u.pm * BM + wr * 64 + fr, col0 = u.pn * BM + wc * 32 + 8 * fq;
#pragma unroll
        for (int ai = 0; ai < 2; ++ai)
#pragma unroll
            for (int m = 0; m < 4; ++m) { const size_t ro = (size_t)(row0 + ai * HALF + m * 16) * 1024 + col0;
#pragma unroll
                for (int bj = 0; bj < 2; ++bj) { const size_t o = ro + bj * HALF;
                    *(f32x4*)(X1 + o) = *(const f32x4*)(x + o) + acc[ai][bj][m][0]; *(f32x4*)(X1 + o + 4) = *(const f32x4*)(x + o + 4) + acc[ai][bj][m][1]; } }
    }
};
struct EpiAct {
    static constexpr bool PERM = true, AFTER_DRAIN = false;
    bf16_t* ACT; const float* b1;
    __device__ __forceinline__ void operator()(const f32x4 (&acc)[2][2][4][2], const Unit& u, int wr, int wc, int fr, int fq) const {
        const int e = u.pn >> 3, nt = u.pn & 7;
        const int row0 = u.pm * BM + wr * 64 + fr, col0 = nt * 128 + wc * 32 + 8 * fq;
        const float* bg = b1 + (size_t)e * 2048 + col0;
        const f32x4 bg0 = *(const f32x4*)bg, bg1 = *(const f32x4*)(bg + 4), bu0 = *(const f32x4*)(bg + 1024), bu1 = *(const f32x4*)(bg + 1028);
#pragma unroll
        for (int ai = 0; ai < 2; ++ai)
#pragma unroll
            for (int m = 0; m < 4; ++m) { const int row = row0 + ai * HALF + m * 16;
                f32x4 g0 = acc[ai][0][m][0] + bg0, g1 = acc[ai][0][m][1] + bg1, u0 = acc[ai][1][m][0] + bu0, u1 = acc[ai][1][m][1] + bu1;
#pragma unroll
                for (int i = 0; i < 4; ++i) {
                    const float ga = fminf(g0[i], 7.f), gb = fminf(g1[i], 7.f), ua = fminf(fmaxf(u0[i], -7.f), 7.f), ub = fminf(fmaxf(u1[i], -7.f), 7.f);
                    g0[i] = ga * sig_(1.702f * ga) * (ua + 1.f); g1[i] = gb * sig_(1.702f * gb) * (ub + 1.f); }
                *(u32x4*)(ACT + (size_t)row * 1024 + col0) = pack8(g0, g1); }
    }
};
struct EpiY {
    static constexpr bool PERM = true, AFTER_DRAIN = false;
    bf16_t* YB; const float* b2;
    __device__ __forceinline__ void operator()(const f32x4 (&acc)[2][2][4][2], const Unit& u, int wr, int wc, int fr, int fq) const {
        const int e = u.pn >> 2, nt = u.pn & 3;
        const int row0 = u.pm * BM + wr * 64 + fr, col0 = nt * BM + wc * 32 + 8 * fq;
        f32x4 bv[2][2];
#pragma unroll
        for (int bj = 0; bj < 2; ++bj) { bv[bj][0] = *(const f32x4*)(b2 + (size_t)e * 1024 + col0 + bj * HALF); bv[bj][1] = *(const f32x4*)(b2 + (size_t)e * 1024 + col0 + bj * HALF + 4); }
#pragma unroll
        for (int ai = 0; ai < 2; ++ai)
#pragma unroll
            for (int m = 0; m < 4; ++m) { bf16_t* rowp = YB + (size_t)(row0 + ai * HALF + m * 16) * 1024 + col0;
#pragma unroll
                for (int bj = 0; bj < 2; ++bj) *(u32x4*)(rowp + bj * HALF) = pack8(acc[ai][bj][m][0] + bv[bj][0], acc[ai][bj][m][1] + bv[bj][1]); }
    }
};

struct EpiAct8 {
    static constexpr bool PERM = true, AFTER_DRAIN = false;
    unsigned char* ACT; const float* b1;
    __device__ __forceinline__ void operator()(const f32x4 (&acc)[2][2][4][2], const Unit& u, int wr, int wc, int fr, int fq) const {
        const int e = u.pn >> 3, nt = u.pn & 7;
        const int row0 = u.pm * BM + wr * 64 + fr, col0 = nt * 128 + wc * 32 + 8 * fq;
        const float* bg = b1 + (size_t)e * 2048 + col0;
        const f32x4 bg0 = *(const f32x4*)bg, bg1 = *(const f32x4*)(bg + 4), bu0 = *(const f32x4*)(bg + 1024), bu1 = *(const f32x4*)(bg + 1028);
        constexpr float SC = 1.f / 512.f;
#pragma unroll
        for (int ai = 0; ai < 2; ++ai)
#pragma unroll
            for (int m = 0; m < 4; ++m) { const int row = row0 + ai * HALF + m * 16;
                f32x4 g0 = acc[ai][0][m][0] * SC + bg0, g1 = acc[ai][0][m][1] * SC + bg1, u0 = acc[ai][1][m][0] * SC + bu0, u1 = acc[ai][1][m][1] * SC + bu1;
#pragma unroll
                for (int i = 0; i < 4; ++i) {
                    const float ga = fminf(g0[i], 7.f), gb = fminf(g1[i], 7.f), ua = fminf(fmaxf(u0[i], -7.f), 7.f), ub = fminf(fmaxf(u1[i], -7.f), 7.f);
                    g0[i] = 4.f * ga * sig_(1.702f * ga) * (ua + 1.f); g1[i] = 4.f * gb * sig_(1.702f * gb) * (ub + 1.f); }
                u32x2 w; w.x = pack4_fp8(g0[0], g0[1], g0[2], g0[3]); w.y = pack4_fp8(g1[0], g1[1], g1[2], g1[3]);
                *(u32x2*)(ACT + (size_t)row * 1024 + col0) = w; }
    }
};
struct EpiY8 {
    static constexpr bool PERM = true, AFTER_DRAIN = false;
    bf16_t* YB; const float* b2;
    __device__ __forceinline__ void operator()(const f32x4 (&acc)[2][2][4][2], const Unit& u, int wr, int wc, int fr, int fq) const {
        const int e = u.pn >> 2, nt = u.pn & 3;
        const int row0 = u.pm * BM + wr * 64 + fr, col0 = nt * BM + wc * 32 + 8 * fq;
        constexpr float SC = 1.f / 256.f;
        f32x4 bv[2][2];
#pragma unroll
        for (int bj = 0; bj < 2; ++bj) { bv[bj][0] = *(const f32x4*)(b2 + (size_t)e * 1024 + col0 + bj * HALF); bv[bj][1] = *(const f32x4*)(b2 + (size_t)e * 1024 + col0 + bj * HALF + 4); }
#pragma unroll
        for (int ai = 0; ai < 2; ++ai)
#pragma unroll
            for (int m = 0; m < 4; ++m) { bf16_t* rowp = YB + (size_t)(row0 + ai * HALF + m * 16) * 1024 + col0;
#pragma unroll
                for (int bj = 0; bj < 2; ++bj) *(u32x4*)(rowp + bj * HALF) = pack8(acc[ai][bj][m][0] * SC + bv[bj][0], acc[ai][bj][m][1] * SC + bv[bj][1]); }
    }
};
template <int NN> struct MoeOrder {
    const PG8_LAS int* texp; int G, c, ntile;
    __device__ __forceinline__ bool next(int i, Unit& u) const {
        const int L = i * G + c; if (L >= ntile * NN) return false;
        const int t = L / NN, pnl = L % NN;
        u.pm = t; u.pn = texp[t] * NN + pnl; return true;
    }
    __device__ __forceinline__ void a_ready(const Unit&) const {}
    __device__ __forceinline__ void done(const Unit&) const {}
};
template <class Epi, class Sched, bool ALIGN_EPI = false, bool SP2 = false>
__device__ __forceinline__ void gemm_phase(PG8_LAS unsigned char* lds, const Gemm g, const Sched& S, const Epi& E) {
    const int tid = threadIdx.x, wid = __builtin_amdgcn_readfirstlane(tid >> 6), lane = tid & 63, wr = wid >> 2, wc = wid & 3, fr = lane & 15, fq = lane >> 4;
    const int K = g.K, nt = K / BK;
    unsigned voffA[2], voffB[2];
#pragma unroll
    for (int i = 0; i < 2; ++i) { int R, C; stage_rc(tid * 16 + i * 8192, R, C); const int Rb = Epi::PERM ? ((R & ~31) + perm32(R & 31)) : R;
        voffA[i] = (unsigned)(R * K + C) * 2u; voffB[i] = (unsigned)(Rb * K + C) * 2u; }
    const size_t kstep = (size_t)(BK * 2);
    const size_t hstep = (size_t)HALF * K * 2;
    const size_t tstep = 2 * hstep;
    const unsigned ldsw = (unsigned)wid * 1024u;
    const int aoff = lds_byte(wr * 64 + fr, fq * 8), boff = lds_byte(wc * 32 + fr, fq * 8);
#define PG8_SA(b, h) (((b) * 2 + (h)) * HTB)
#define PG8_SB(b, h) ((4 + (b) * 2 + (h)) * HTB)
#define PG8_STAGE(bufoff, gbase, voff) do { _Pragma("unroll") for (int _i = 0; _i < 2; ++_i) \
        __builtin_amdgcn_global_load_lds((const unsigned*)((const char*)(gbase) + (voff)[_i]), (PG8_LAS unsigned*)(lds + (bufoff) + ldsw + _i * 8192), 16, 0, 0); } while (0)
#define PG8_LDA(dst, b, h) do { _Pragma("unroll") for (int m = 0; m < 4; ++m) _Pragma("unroll") for (int k = 0; k < 2; ++k) dst[m][k] = *(const PG8_LAS bf16x8*)(lds + PG8_SA(b, h) + aoff + m * 2048 + k * 1024); } while (0)
#define PG8_LDB(dst, b, h) do { _Pragma("unroll") for (int n = 0; n < 2; ++n) _Pragma("unroll") for (int k = 0; k < 2; ++k) dst[n][k] = *(const PG8_LAS bf16x8*)(lds + PG8_SB(b, h) + boff + n * 2048 + k * 1024); } while (0)
#define PG8_MMA(ai, bj, At, Bt) do { __builtin_amdgcn_s_setprio(1); _Pragma("unroll") for (int m = 0; m < 4; ++m) _Pragma("unroll") for (int n = 0; n < 2; ++n) _Pragma("unroll") for (int k = 0; k < 2; ++k) \
        acc[ai][bj][m][n] = __builtin_amdgcn_mfma_f32_16x16x32_bf16(Bt[n][k], At[m][k], acc[ai][bj][m][n], 0, 0, 0); __builtin_amdgcn_s_setprio(0); } while (0)
#define PG8_WAIT_V(n) asm volatile("s_waitcnt vmcnt(" #n ")" ::: "memory")
#define PG8_WAIT_L(n) asm volatile("s_waitcnt lgkmcnt(" #n ")" ::: "memory")
#define PG8_BAR __builtin_amdgcn_s_barrier()
#define PG8_SCHED __builtin_amdgcn_sched_barrier(0)
    Unit cur, nxt; int ui = 0;
    if (!S.next(0, cur)) return;
    f32x4 acc[2][2][4][2];
#pragma unroll
    for (int a = 0; a < 2; ++a)
#pragma unroll
        for (int b = 0; b < 2; ++b)
#pragma unroll
            for (int m = 0; m < 4; ++m)
#pragma unroll
                for (int n = 0; n < 2; ++n) acc[a][b][m][n] = (f32x4){0.f, 0.f, 0.f, 0.f};
    bf16x8 At[4][2], B0[2][2], B1[2][2];
    const char* cA = (const char*)g.A + (size_t)cur.pm * tstep; const char* cB = (const char*)g.Bt + (size_t)cur.pn * tstep;
    S.a_ready(cur);
    if constexpr (SP2) {
        PG8_STAGE(PG8_SB(0, 0), cB, voffB); PG8_STAGE(PG8_SB(0, 1), cB + hstep, voffB); PG8_STAGE(PG8_SA(0, 0), cA, voffA); PG8_STAGE(PG8_SA(0, 1), cA + hstep, voffA);
        if (wr == 1) PG8_BAR;
        PG8_WAIT_V(2); PG8_BAR;
        PG8_STAGE(PG8_SB(1, 0), cB + kstep, voffB); PG8_STAGE(PG8_SA(1, 0), cA + kstep, voffA); PG8_STAGE(PG8_SB(1, 1), cB + hstep + kstep, voffB);
        PG8_WAIT_V(6); PG8_BAR;
    } else {
        PG8_STAGE(PG8_SB(0, 0), cB, voffB); PG8_STAGE(PG8_SA(0, 0), cA, voffA); PG8_STAGE(PG8_SB(0, 1), cB + hstep, voffB); PG8_STAGE(PG8_SA(0, 1), cA + hstep, voffA);
        if (wr == 1) PG8_BAR;
        PG8_WAIT_V(4); PG8_BAR;
        PG8_STAGE(PG8_SB(1, 0), cB + kstep, voffB); PG8_STAGE(PG8_SA(1, 0), cA + kstep, voffA); PG8_STAGE(PG8_SB(1, 1), cB + hstep + kstep, voffB);
        PG8_WAIT_V(6); PG8_BAR;
    }
    for (;;) {
        const bool has_next = S.next(ui + 1, nxt);
        const char* nA = has_next ? (const char*)g.A + (size_t)nxt.pm * tstep : cA; const char* nB = has_next ? (const char*)g.Bt + (size_t)nxt.pn * tstep : cB;
        for (int t = 0; t < nt; t += 2) {
            const bool last = (t == nt - 2);
            const char* a1 = cA + (size_t)(t + 1) * kstep;
            const char* a2 = last ? nA : cA + (size_t)(t + 2) * kstep; const char* b2 = last ? nB : cB + (size_t)(t + 2) * kstep;
            const char* a3 = a2 + kstep; const char* b3 = b2 + kstep;
            if (last && has_next) S.a_ready(nxt);
            if constexpr (SP2) {
            PG8_LDB(B0, 0, 0); PG8_LDB(B1, 0, 1); PG8_SCHED; PG8_LDA(At, 0, 0); PG8_STAGE(PG8_SA(1, 1), a1 + hstep, voffA);
            PG8_WAIT_V(8); PG8_WAIT_L(0); PG8_BAR; PG8_MMA(0, 0, At, B0); PG8_MMA(0, 1, At, B1); PG8_BAR; PG8_SCHED;
            PG8_LDA(At, 0, 1); PG8_STAGE(PG8_SB(0, 0), b2, voffB); PG8_STAGE(PG8_SB(0, 1), b2 + hstep, voffB); PG8_STAGE(PG8_SA(0, 0), a2, voffA);
            PG8_WAIT_V(8); PG8_WAIT_L(0); PG8_BAR; PG8_MMA(1, 0, At, B0); PG8_MMA(1, 1, At, B1); PG8_BAR; PG8_SCHED;
            PG8_LDB(B0, 1, 0); PG8_LDB(B1, 1, 1); PG8_SCHED; PG8_LDA(At, 1, 0); PG8_STAGE(PG8_SA(0, 1), a2 + hstep, voffA);
            PG8_WAIT_V(8); PG8_WAIT_L(0); PG8_BAR; PG8_MMA(0, 0, At, B0); PG8_MMA(0, 1, At, B1); PG8_BAR; PG8_SCHED;
            PG8_LDA(At, 1, 1); PG8_STAGE(PG8_SB(1, 0), b3, voffB); PG8_STAGE(PG8_SB(1, 1), b3 + hstep, voffB); PG8_STAGE(PG8_SA(1, 0), a3, voffA);
            PG8_WAIT_V(8); PG8_WAIT_L(0); PG8_BAR; PG8_MMA(1, 0, At, B0); PG8_MMA(1, 1, At, B1); PG8_BAR; PG8_SCHED;
            } else {
            PG8_LDB(B0, 0, 0); PG8_SCHED; PG8_LDA(At, 0, 0); PG8_STAGE(PG8_SA(1, 1), a1 + hstep, voffA);
            PG8_WAIT_L(8); PG8_BAR; PG8_WAIT_L(0); PG8_MMA(0, 0, At, B0); PG8_BAR; PG8_SCHED;
            PG8_LDB(B1, 0, 1); PG8_STAGE(PG8_SB(0, 0), b2, voffB);
            PG8_BAR; PG8_WAIT_L(0); PG8_MMA(0, 1, At, B1); PG8_BAR;
            PG8_LDA(At, 0, 1); PG8_STAGE(PG8_SA(0, 0), a2, voffA);
            PG8_BAR; PG8_WAIT_L(0); PG8_MMA(1, 0, At, B0); PG8_BAR; PG8_SCHED;
            PG8_STAGE(PG8_SB(0, 1), b2 + hstep, voffB);
            PG8_WAIT_V(6); PG8_BAR; PG8_MMA(1, 1, At, B1); PG8_BAR;
            PG8_LDB(B0, 1, 0); PG8_SCHED; PG8_LDA(At, 1, 0); PG8_STAGE(PG8_SA(0, 1), a2 + hstep, voffA);
            PG8_WAIT_L(8); PG8_BAR; PG8_WAIT_L(0); PG8_MMA(0, 0, At, B0); PG8_BAR; PG8_SCHED;
            PG8_LDB(B1, 1, 1); PG8_STAGE(PG8_SB(1, 0), b3, voffB);
            PG8_BAR; PG8_WAIT_L(0); PG8_MMA(0, 1, At, B1); PG8_BAR;
            PG8_LDA(At, 1, 1); PG8_STAGE(PG8_SA(1, 0), a3, voffA);
            PG8_BAR; PG8_WAIT_L(0); PG8_MMA(1, 0, At, B0); PG8_BAR; PG8_SCHED;
            PG8_STAGE(PG8_SB(1, 1), b3 + hstep, voffB);
            PG8_WAIT_V(6); PG8_BAR; PG8_MMA(1, 1, At, B1); PG8_BAR;
            }
        }
        if constexpr (ALIGN_EPI) { if (wr == 0) PG8_BAR; }
        if constexpr (!Epi::AFTER_DRAIN) { E(acc, cur, wr, wc, fr, fq); S.done(cur); }
        if (!has_next) break;
#pragma unroll
        for (int a = 0; a < 2; ++a)
#pragma unroll
            for (int b = 0; b < 2; ++b)
#pragma unroll
                for (int m = 0; m < 4; ++m)
#pragma unroll
                    for (int n = 0; n < 2; ++n) acc[a][b][m][n] = (f32x4){0.f, 0.f, 0.f, 0.f};
        cur = nxt; cA = nA; cB = nB; ++ui;
        if constexpr (ALIGN_EPI) { if (wr == 1) PG8_BAR; }
    }
    PG8_WAIT_V(0);
    if constexpr (!ALIGN_EPI) { if (wr == 0) PG8_BAR; }
    PG8_BAR;
    if constexpr (Epi::AFTER_DRAIN) { E.fused(acc, cur, wr, wc, fr, fq, lds, wid, lane); S.done(cur); }
#undef PG8_SA
#undef PG8_SB
#undef PG8_STAGE
#undef PG8_LDA
#undef PG8_LDB
#undef PG8_MMA
#undef PG8_WAIT_V
#undef PG8_WAIT_L
#undef PG8_BAR
#undef PG8_SCHED
}

struct MoeGatherOrder {
    const PG8_LAS int* offs; const PG8_LAS int* cnt; const PG8_LAS int* texp; const int* LIST; int G, c, ntile;
    __device__ __forceinline__ bool next(int i, Unit& u) const {
        const int L = i * G + c; if (L >= ntile * 8) return false;
        const int t = L >> 3, pnl = L & 7;
        u.pm = t; u.pn = texp[t] * 8 + pnl; return true;
    }
    __device__ __forceinline__ int arow(const Unit& u, int r) const { const int e = u.pn >> 3, slot = u.pm * 256 + r - offs[e]; return slot < cnt[e] ? LIST[e * 16384 + slot] : 0; }
    __device__ __forceinline__ void a_ready(const Unit&) const {}
    __device__ __forceinline__ void done(const Unit&) const {}
};
struct TailOrder {
    StaticOrder so;
    __device__ __forceinline__ bool next(int i, Unit& u) const { Unit b; if (!so.next(i >> 1, b)) return false; u.pm = b.pm + 64 * (i & 1); u.pn = b.pn + 4 * (i & 1); return true; }
    __device__ __forceinline__ void a_ready(const Unit&) const {}
    __device__ __forceinline__ void done(const Unit&) const {}
};
struct EpiT12 {
    static constexpr bool PERM = true, AFTER_DRAIN = false;
    bf16_t* T1; bf16_t* MG; const bf16_t* G; int ldg; const float* RSTD;
    __device__ __forceinline__ void operator()(const f32x4 (&acc)[2][2][4][2], const Unit& u, int wr, int wc, int fr, int fq) const {
        const bool second = u.pm >= 64;
        const int row0 = (u.pm & 63) * BM + wr * 64 + fr, col0 = (u.pn & 3) * BM + wc * 32 + 8 * fq;
        const bf16_t* Gp = G + (second ? 1024 : 0);
#pragma unroll
        for (int ai = 0; ai < 2; ++ai) {
            u32x4 gv[4][2], tv[4][2]; float rs[4];
#pragma unroll
            for (int m = 0; m < 4; ++m) { const int row = row0 + ai * HALF + m * 16; rs[m] = second ? 1.f : RSTD[row];
#pragma unroll
                for (int bj = 0; bj < 2; ++bj) { gv[m][bj] = *(const u32x4*)(Gp + (size_t)row * ldg + col0 + bj * HALF);
                    tv[m][bj] = second ? *(const u32x4*)(T1 + (size_t)row * 1024 + col0 + bj * HALF) : (u32x4){0u, 0u, 0u, 0u}; } }
#pragma unroll
            for (int m = 0; m < 4; ++m) { const int row = row0 + ai * HALF + m * 16;
#pragma unroll
                for (int bj = 0; bj < 2; ++bj) { f32x4 g0, g1, t0, t1; unpack8(gv[m][bj], g0, g1); unpack8(tv[m][bj], t0, t1);
                    f32x4 v0 = acc[ai][bj][m][0] * rs[m], v1 = acc[ai][bj][m][1] * rs[m];
#pragma unroll
                    for (int i = 0; i < 4; ++i) { v0[i] = fmaf(v0[i], sig_(g0[i]), t0[i]); v1[i] = fmaf(v1[i], sig_(g1[i]), t1[i]); }
                    *(u32x4*)((second ? MG : T1) + (size_t)row * 1024 + col0 + bj * HALF) = pack8(v0, v1); } }
        }
    }
};
struct EpiT3b {
    static constexpr bool PERM = true, AFTER_DRAIN = false;
    float* X1; const float* x;
    __device__ __forceinline__ void operator()(const f32x4 (&acc)[2][2][4][2], const Unit& u, int wr, int wc, int fr, int fq) const {
        const int row0 = u.pm * BM + wr * 64 + fr, col0 = u.pn * BM + wc * 32 + 8 * fq;
#pragma unroll
        for (int ai = 0; ai < 2; ++ai) {
            f32x4 xv[4][2][2];
#pragma unroll
            for (int m = 0; m < 4; ++m)
#pragma unroll
                for (int bj = 0; bj < 2; ++bj) { const size_t o = (size_t)(row0 + ai * HALF + m * 16) * 1024 + col0 + bj * HALF; xv[m][bj][0] = *(const f32x4*)(x + o); xv[m][bj][1] = *(const f32x4*)(x + o + 4); }
#pragma unroll
            for (int m = 0; m < 4; ++m)
#pragma unroll
                for (int bj = 0; bj < 2; ++bj) { const size_t o = (size_t)(row0 + ai * HALF + m * 16) * 1024 + col0 + bj * HALF;
                    *(f32x4*)(X1 + o) = xv[m][bj][0] + acc[ai][bj][m][0]; *(f32x4*)(X1 + o + 4) = xv[m][bj][1] + acc[ai][bj][m][1]; }
        }
    }
};
template <class Epi, class Sched>
__device__ __forceinline__ void gemm_phase_gather(PG8_LAS unsigned char* lds, const Gemm g, const Sched& S, const Epi& E) {
    constexpr bool ALIGN_EPI = true, SP2 = true;
    const int tid = threadIdx.x, wid = __builtin_amdgcn_readfirstlane(tid >> 6), lane = tid & 63, wr = wid >> 2, wc = wid & 3, fr = lane & 15, fq = lane >> 4;
    const int K = g.K, nt = K / BK;
    unsigned voffA[2], voffB[2];
#pragma unroll
    for (int i = 0; i < 2; ++i) { int R, C; stage_rc(tid * 16 + i * 8192, R, C); const int Rb = Epi::PERM ? ((R & ~31) + perm32(R & 31)) : R;
        voffA[i] = (unsigned)(R * K + C) * 2u; voffB[i] = (unsigned)(Rb * K + C) * 2u; }
    const size_t kstep = (size_t)(BK * 2);
    const size_t hstep = (size_t)HALF * K * 2;
    const size_t tstep = 2 * hstep;
    const unsigned ldsw = (unsigned)wid * 1024u;
    const int aoff = lds_byte(wr * 64 + fr, fq * 8), boff = lds_byte(wc * 32 + fr, fq * 8);
#define PG8_SA(b, h) (((b) * 2 + (h)) * HTB)
#define PG8_SB(b, h) ((4 + (b) * 2 + (h)) * HTB)
#define PG8_STAGE(bufoff, gbase, voff) do { _Pragma("unroll") for (int _i = 0; _i < 2; ++_i) \
        __builtin_amdgcn_global_load_lds((const unsigned*)((const char*)(gbase) + (voff)[_i]), (PG8_LAS unsigned*)(lds + (bufoff) + ldsw + _i * 8192), 16, 0, 0); } while (0)
#define PG8_LDA(dst, b, h) do { _Pragma("unroll") for (int m = 0; m < 4; ++m) _Pragma("unroll") for (int k = 0; k < 2; ++k) dst[m][k] = *(const PG8_LAS bf16x8*)(lds + PG8_SA(b, h) + aoff + m * 2048 + k * 1024); } while (0)
#define PG8_LDB(dst, b, h) do { _Pragma("unroll") for (int n = 0; n < 2; ++n) _Pragma("unroll") for (int k = 0; k < 2; ++k) dst[n][k] = *(const PG8_LAS bf16x8*)(lds + PG8_SB(b, h) + boff + n * 2048 + k * 1024); } while (0)
#define PG8_MMA(ai, bj, At, Bt) do { __builtin_amdgcn_s_setprio(1); _Pragma("unroll") for (int m = 0; m < 4; ++m) _Pragma("unroll") for (int n = 0; n < 2; ++n) _Pragma("unroll") for (int k = 0; k < 2; ++k) \
        acc[ai][bj][m][n] = __builtin_amdgcn_mfma_f32_16x16x32_bf16(Bt[n][k], At[m][k], acc[ai][bj][m][n], 0, 0, 0); __builtin_amdgcn_s_setprio(0); } while (0)
#define PG8_WAIT_V(n) asm volatile("s_waitcnt vmcnt(" #n ")" ::: "memory")
#define PG8_WAIT_L(n) asm volatile("s_waitcnt lgkmcnt(" #n ")" ::: "memory")
#define PG8_BAR __builtin_amdgcn_s_barrier()
#define PG8_SCHED __builtin_amdgcn_sched_barrier(0)
    Unit cur, nxt; int ui = 0;
    if (!S.next(0, cur)) return;
    int rA[2]; unsigned cAo[2];
#pragma unroll
    for (int i = 0; i < 2; ++i) { int R, C; stage_rc(tid * 16 + i * 8192, R, C); rA[i] = R; cAo[i] = (unsigned)C * 2u; }
    unsigned cO[2][2], o2[2][2]; int nR[2][2];
#define PG8_ROWS(dst, u) do { _Pragma("unroll") for (int h_ = 0; h_ < 2; ++h_) _Pragma("unroll") for (int i_ = 0; i_ < 2; ++i_) \
        dst[h_][i_] = (unsigned)S.arow(u, h_ * HALF + rA[i_]) * (unsigned)(K * 2) + cAo[i_]; } while (0)
    PG8_ROWS(cO, cur);
    f32x4 acc[2][2][4][2];
#pragma unroll
    for (int a = 0; a < 2; ++a)
#pragma unroll
        for (int b = 0; b < 2; ++b)
#pragma unroll
            for (int m = 0; m < 4; ++m)
#pragma unroll
                for (int n = 0; n < 2; ++n) acc[a][b][m][n] = (f32x4){0.f, 0.f, 0.f, 0.f};
    bf16x8 At[4][2], B0[2][2], B1[2][2];
    const char* const Ab = (const char*)g.A; const char* cB = (const char*)g.Bt + (size_t)cur.pn * tstep;
    S.a_ready(cur);
    if constexpr (SP2) {
        PG8_STAGE(PG8_SB(0, 0), cB, voffB); PG8_STAGE(PG8_SB(0, 1), cB + hstep, voffB); PG8_STAGE(PG8_SA(0, 0), Ab, cO[0]); PG8_STAGE(PG8_SA(0, 1), Ab, cO[1]);
        if (wr == 1) PG8_BAR;
        PG8_WAIT_V(2); PG8_BAR;
        PG8_STAGE(PG8_SB(1, 0), cB + kstep, voffB); PG8_STAGE(PG8_SA(1, 0), Ab + kstep, cO[0]); PG8_STAGE(PG8_SB(1, 1), cB + hstep + kstep, voffB);
        PG8_WAIT_V(6); PG8_BAR;
    }
    for (;;) {
        const bool has_next = S.next(ui + 1, nxt);
        const char* nB = has_next ? (const char*)g.Bt + (size_t)nxt.pn * tstep : cB;
#pragma unroll
        for (int h_ = 0; h_ < 2; ++h_)
#pragma unroll
            for (int i_ = 0; i_ < 2; ++i_) nR[h_][i_] = has_next ? S.arow(nxt, h_ * HALF + rA[i_]) : 0;
        for (int t = 0; t < nt; t += 2) {
            const bool last = (t == nt - 2);
            const char* a1 = Ab + (size_t)(t + 1) * kstep;
            const char* a2 = last ? Ab : Ab + (size_t)(t + 2) * kstep; const char* b2 = last ? nB : cB + (size_t)(t + 2) * kstep;
#pragma unroll
            for (int h_ = 0; h_ < 2; ++h_)
#pragma unroll
                for (int i_ = 0; i_ < 2; ++i_) o2[h_][i_] = cO[h_][i_];
            if (last && has_next) {
#pragma unroll
                for (int h_ = 0; h_ < 2; ++h_)
#pragma unroll
                    for (int i_ = 0; i_ < 2; ++i_) { int v_ = nR[h_][i_]; asm volatile("" : "+v"(v_)); o2[h_][i_] = (unsigned)v_ * (unsigned)(K * 2) + cAo[i_]; } }
            const char* a3 = a2 + kstep; const char* b3 = b2 + kstep;
            if (last && has_next) S.a_ready(nxt);
            if constexpr (SP2) {
            PG8_LDB(B0, 0, 0); PG8_LDB(B1, 0, 1); PG8_SCHED; PG8_LDA(At, 0, 0); PG8_STAGE(PG8_SA(1, 1), a1, cO[1]);
            PG8_WAIT_V(8); PG8_WAIT_L(0); PG8_BAR; PG8_MMA(0, 0, At, B0); PG8_MMA(0, 1, At, B1); PG8_BAR; PG8_SCHED;
            PG8_LDA(At, 0, 1); PG8_STAGE(PG8_SB(0, 0), b2, voffB); PG8_STAGE(PG8_SB(0, 1), b2 + hstep, voffB); PG8_STAGE(PG8_SA(0, 0), a2, o2[0]);
            PG8_WAIT_V(8); PG8_WAIT_L(0); PG8_BAR; PG8_MMA(1, 0, At, B0); PG8_MMA(1, 1, At, B1); PG8_BAR; PG8_SCHED;
            PG8_LDB(B0, 1, 0); PG8_LDB(B1, 1, 1); PG8_SCHED; PG8_LDA(At, 1, 0); PG8_STAGE(PG8_SA(0, 1), a2, o2[1]);
            PG8_WAIT_V(8); PG8_WAIT_L(0); PG8_BAR; PG8_MMA(0, 0, At, B0); PG8_MMA(0, 1, At, B1); PG8_BAR; PG8_SCHED;
            PG8_LDA(At, 1, 1); PG8_STAGE(PG8_SB(1, 0), b3, voffB); PG8_STAGE(PG8_SB(1, 1), b3 + hstep, voffB); PG8_STAGE(PG8_SA(1, 0), a3, o2[0]);
            PG8_WAIT_V(8); PG8_WAIT_L(0); PG8_BAR; PG8_MMA(1, 0, At, B0); PG8_MMA(1, 1, At, B1); PG8_BAR; PG8_SCHED;
            }
        }
        if constexpr (ALIGN_EPI) { if (wr == 0) PG8_BAR; }
        if constexpr (!Epi::AFTER_DRAIN) { E(acc, cur, wr, wc, fr, fq); S.done(cur); }
        if (!has_next) break;
#pragma unroll
        for (int a = 0; a < 2; ++a)
#pragma unroll
            for (int b = 0; b < 2; ++b)
#pragma unroll
                for (int m = 0; m < 4; ++m)
#pragma unroll
                    for (int n = 0; n < 2; ++n) acc[a][b][m][n] = (f32x4){0.f, 0.f, 0.f, 0.f};
        cur = nxt; cB = nB; ++ui;
#pragma unroll
        for (int h_ = 0; h_ < 2; ++h_)
#pragma unroll
            for (int i_ = 0; i_ < 2; ++i_) cO[h_][i_] = o2[h_][i_];
        if constexpr (ALIGN_EPI) { if (wr == 1) PG8_BAR; }
    }
    PG8_WAIT_V(0);
    if constexpr (!ALIGN_EPI) { if (wr == 0) PG8_BAR; }
    PG8_BAR;
    if constexpr (Epi::AFTER_DRAIN) { E.fused(acc, cur, wr, wc, fr, fq, lds, wid, lane); S.done(cur); }
#undef PG8_ROWS
#undef PG8_SA
#undef PG8_SB
#undef PG8_STAGE
#undef PG8_LDA
#undef PG8_LDB
#undef PG8_MMA
#undef PG8_WAIT_V
#undef PG8_WAIT_L
#undef PG8_BAR
#undef PG8_SCHED
}
typedef int v4i_t __attribute__((ext_vector_type(4)));
typedef int v8i_t __attribute__((ext_vector_type(8)));
template <class Epi, class Sched, bool ALIGN_EPI = false, bool SP2 = false>
__device__ __forceinline__ void gemm_phase_f8(PG8_LAS unsigned char* lds, const Gemm g, const Sched& S, const Epi& E) {
    const int tid = threadIdx.x, wid = __builtin_amdgcn_readfirstlane(tid >> 6), lane = tid & 63, wr = wid >> 2, wc = wid & 3, fr = lane & 15, fq = lane >> 4;
    const int K = g.K, nt = K / BK;
    unsigned voffA[2], voffB[2];
#pragma unroll
    for (int i = 0; i < 2; ++i) { int R, C; stage_rc(tid * 16 + i * 8192, R, C); const int Rb = Epi::PERM ? ((R & ~31) + perm32(R & 31)) : R;
        voffA[i] = (unsigned)(R * K + C) * 2u; voffB[i] = (unsigned)(Rb * K + C) * 2u; }
    const size_t kstep = (size_t)(BK * 2);
    const size_t hstep = (size_t)HALF * K * 2;
    const size_t tstep = 2 * hstep;
    const unsigned ldsw = (unsigned)wid * 1024u;
    const int aoff = lds_byte(wr * 64 + fr, fq * 8), boff = lds_byte(wc * 32 + fr, fq * 8);
#define PG8_SA(b, h) (((b) * 2 + (h)) * HTB)
#define PG8_SB(b, h) ((4 + (b) * 2 + (h)) * HTB)
#define PG8_STAGE(bufoff, gbase, voff) do { _Pragma("unroll") for (int _i = 0; _i < 2; ++_i) \
        __builtin_amdgcn_global_load_lds((const unsigned*)((const char*)(gbase) + (voff)[_i]), (PG8_LAS unsigned*)(lds + (bufoff) + ldsw + _i * 8192), 16, 0, 0); } while (0)
#define PG8_LDA(dst, b, h) do { _Pragma("unroll") for (int m = 0; m < 4; ++m) { const v4i_t lo_ = *(const PG8_LAS v4i_t*)(lds + PG8_SA(b, h) + aoff + m * 2048), hi_ = *(const PG8_LAS v4i_t*)(lds + PG8_SA(b, h) + aoff + m * 2048 + 1024); dst[m] = __builtin_shufflevector(lo_, hi_, 0, 1, 2, 3, 4, 5, 6, 7); } } while (0)
#define PG8_LDB(dst, b, h) do { _Pragma("unroll") for (int n = 0; n < 2; ++n) { const v4i_t lo_ = *(const PG8_LAS v4i_t*)(lds + PG8_SB(b, h) + boff + n * 2048), hi_ = *(const PG8_LAS v4i_t*)(lds + PG8_SB(b, h) + boff + n * 2048 + 1024); dst[n] = __builtin_shufflevector(lo_, hi_, 0, 1, 2, 3, 4, 5, 6, 7); } } while (0)
#define PG8_MMA(ai, bj, At, Bt) do { __builtin_amdgcn_s_setprio(1); _Pragma("unroll") for (int m = 0; m < 4; ++m) _Pragma("unroll") for (int n = 0; n < 2; ++n) \
        asm volatile("v_mfma_scale_f32_16x16x128_f8f6f4 %0, %1, %2, %0, %3, %3 op_sel_hi:[0,0,0]" : "+v"(acc[ai][bj][m][n]) : "v"(Bt[n]), "v"(At[m]), "v"(scl_)); __builtin_amdgcn_s_setprio(0); } while (0)
#define PG8_WAIT_V(n) asm volatile("s_waitcnt vmcnt(" #n ")" ::: "memory")
#define PG8_WAIT_L(n) asm volatile("s_waitcnt lgkmcnt(" #n ")" ::: "memory")
#define PG8_BAR __builtin_amdgcn_s_barrier()
#define PG8_SCHED __builtin_amdgcn_sched_barrier(0)
    Unit cur, nxt; int ui = 0;
    if (!S.next(0, cur)) return;
    f32x4 acc[2][2][4][2];
#pragma unroll
    for (int a = 0; a < 2; ++a)
#pragma unroll
        for (int b = 0; b < 2; ++b)
#pragma unroll
            for (int m = 0; m < 4; ++m)
#pragma unroll
                for (int n = 0; n < 2; ++n) acc[a][b][m][n] = (f32x4){0.f, 0.f, 0.f, 0.f};
    const int scl_ = 0x7f7f7f7f;
    v8i_t At[4], B0[2], B1[2];
    const char* cA = (const char*)g.A + (size_t)cur.pm * tstep; const char* cB = (const char*)g.Bt + (size_t)cur.pn * tstep;
    S.a_ready(cur);
    if constexpr (SP2) {
        PG8_STAGE(PG8_SB(0, 0), cB, voffB); PG8_STAGE(PG8_SB(0, 1), cB + hstep, voffB); PG8_STAGE(PG8_SA(0, 0), cA, voffA); PG8_STAGE(PG8_SA(0, 1), cA + hstep, voffA);
        if (wr == 1) PG8_BAR;
        PG8_WAIT_V(2); PG8_BAR;
        PG8_STAGE(PG8_SB(1, 0), cB + kstep, voffB); PG8_STAGE(PG8_SA(1, 0), cA + kstep, voffA); PG8_STAGE(PG8_SB(1, 1), cB + hstep + kstep, voffB);
        PG8_WAIT_V(6); PG8_BAR;
    } else {
        PG8_STAGE(PG8_SB(0, 0), cB, voffB); PG8_STAGE(PG8_SA(0, 0), cA, voffA); PG8_STAGE(PG8_SB(0, 1), cB + hstep, voffB); PG8_STAGE(PG8_SA(0, 1), cA + hstep, voffA);
        if (wr == 1) PG8_BAR;
        PG8_WAIT_V(4); PG8_BAR;
        PG8_STAGE(PG8_SB(1, 0), cB + kstep, voffB); PG8_STAGE(PG8_SA(1, 0), cA + kstep, voffA); PG8_STAGE(PG8_SB(1, 1), cB + hstep + kstep, voffB);
        PG8_WAIT_V(6); PG8_BAR;
    }
    for (;;) {
        const bool has_next = S.next(ui + 1, nxt);
        const char* nA = has_next ? (const char*)g.A + (size_t)nxt.pm * tstep : cA; const char* nB = has_next ? (const char*)g.Bt + (size_t)nxt.pn * tstep : cB;
        for (int t = 0; t < nt; t += 2) {
            const bool last = (t == nt - 2);
            const char* a1 = cA + (size_t)(t + 1) * kstep;
            const char* a2 = last ? nA : cA + (size_t)(t + 2) * kstep; const char* b2 = last ? nB : cB + (size_t)(t + 2) * kstep;
            const char* a3 = a2 + kstep; const char* b3 = b2 + kstep;
            if (last && has_next) S.a_ready(nxt);
            if constexpr (SP2) {
            PG8_LDB(B0, 0, 0); PG8_LDB(B1, 0, 1); PG8_SCHED; PG8_LDA(At, 0, 0); PG8_STAGE(PG8_SA(1, 1), a1 + hstep, voffA);
            PG8_WAIT_V(8); PG8_WAIT_L(0); PG8_BAR; PG8_MMA(0, 0, At, B0); PG8_MMA(0, 1, At, B1); PG8_BAR; PG8_SCHED;
            PG8_LDA(At, 0, 1); PG8_STAGE(PG8_SB(0, 0), b2, voffB); PG8_STAGE(PG8_SB(0, 1), b2 + hstep, voffB); PG8_STAGE(PG8_SA(0, 0), a2, voffA);
            PG8_WAIT_V(8); PG8_WAIT_L(0); PG8_BAR; PG8_MMA(1, 0, At, B0); PG8_MMA(1, 1, At, B1); PG8_BAR; PG8_SCHED;
            PG8_LDB(B0, 1, 0); PG8_LDB(B1, 1, 1); PG8_SCHED; PG8_LDA(At, 1, 0); PG8_STAGE(PG8_SA(0, 1), a2 + hstep, voffA);
            PG8_WAIT_V(8); PG8_WAIT_L(0); PG8_BAR; PG8_MMA(0, 0, At, B0); PG8_MMA(0, 1, At, B1); PG8_BAR; PG8_SCHED;
            PG8_LDA(At, 1, 1); PG8_STAGE(PG8_SB(1, 0), b3, voffB); PG8_STAGE(PG8_SB(1, 1), b3 + hstep, voffB); PG8_STAGE(PG8_SA(1, 0), a3, voffA);
            PG8_WAIT_V(8); PG8_WAIT_L(0); PG8_BAR; PG8_MMA(1, 0, At, B0); PG8_MMA(1, 1, At, B1); PG8_BAR; PG8_SCHED;
            } else {
            PG8_LDB(B0, 0, 0); PG8_SCHED; PG8_LDA(At, 0, 0); PG8_STAGE(PG8_SA(1, 1), a1 + hstep, voffA);
            PG8_WAIT_L(8); PG8_BAR; PG8_WAIT_L(0); PG8_MMA(0, 0, At, B0); PG8_BAR; PG8_SCHED;
            PG8_LDB(B1, 0, 1); PG8_STAGE(PG8_SB(0, 0), b2, voffB);
            PG8_BAR; PG8_WAIT_L(0); PG8_MMA(0, 1, At, B1); PG8_BAR;
            PG8_LDA(At, 0, 1); PG8_STAGE(PG8_SA(0, 0), a2, voffA);
            PG8_BAR; PG8_WAIT_L(0); PG8_MMA(1, 0, At, B0); PG8_BAR; PG8_SCHED;
            PG8_STAGE(PG8_SB(0, 1), b2 + hstep, voffB);
            PG8_WAIT_V(6); PG8_BAR; PG8_MMA(1, 1, At, B1); PG8_BAR;
            PG8_LDB(B0, 1, 0); PG8_SCHED; PG8_LDA(At, 1, 0); PG8_STAGE(PG8_SA(0, 1), a2 + hstep, voffA);
            PG8_WAIT_L(8); PG8_BAR; PG8_WAIT_L(0); PG8_MMA(0, 0, At, B0); PG8_BAR; PG8_SCHED;
            PG8_LDB(B1, 1, 1); PG8_STAGE(PG8_SB(1, 0), b3, voffB);
            PG8_BAR; PG8_WAIT_L(0); PG8_MMA(0, 1, At, B1); PG8_BAR;
            PG8_LDA(At, 1, 1); PG8_STAGE(PG8_SA(1, 0), a3, voffA);
            PG8_BAR; PG8_WAIT_L(0); PG8_MMA(1, 0, At, B0); PG8_BAR; PG8_SCHED;
            PG8_STAGE(PG8_SB(1, 1), b3 + hstep, voffB);
            PG8_WAIT_V(6); PG8_BAR; PG8_MMA(1, 1, At, B1); PG8_BAR;
            }
        }
        if constexpr (ALIGN_EPI) { if (wr == 0) PG8_BAR; }
        asm volatile("s_nop 15\n\ts_nop 15" ::: "memory");
        if constexpr (!Epi::AFTER_DRAIN) { E(acc, cur, wr, wc, fr, fq); S.done(cur); }
        if (!has_next) break;
#pragma unroll
        for (int a = 0; a < 2; ++a)
#pragma unroll
            for (int b = 0; b < 2; ++b)
#pragma unroll
                for (int m = 0; m < 4; ++m)
#pragma unroll
                    for (int n = 0; n < 2; ++n) acc[a][b][m][n] = (f32x4){0.f, 0.f, 0.f, 0.f};
        cur = nxt; cA = nA; cB = nB; ++ui;
        if constexpr (ALIGN_EPI) { if (wr == 1) PG8_BAR; }
    }
    PG8_WAIT_V(0);
    if constexpr (!ALIGN_EPI) { if (wr == 0) PG8_BAR; }
    PG8_BAR;
    if constexpr (Epi::AFTER_DRAIN) { E.fused(acc, cur, wr, wc, fr, fq, lds, wid, lane); S.done(cur); }
#undef PG8_SA
#undef PG8_SB
#undef PG8_STAGE
#undef PG8_LDA
#undef PG8_LDB
#undef PG8_MMA
#undef PG8_WAIT_V
#undef PG8_WAIT_L
#undef PG8_BAR
#undef PG8_SCHED
}

template <class Epi, class Sched>
__device__ __forceinline__ void gemm_phase_gather_f8(PG8_LAS unsigned char* lds, const Gemm g, const Sched& S, const Epi& E) {
    constexpr bool ALIGN_EPI = true, SP2 = true;
    const int tid = threadIdx.x, wid = __builtin_amdgcn_readfirstlane(tid >> 6), lane = tid & 63, wr = wid >> 2, wc = wid & 3, fr = lane & 15, fq = lane >> 4;
    const int K = g.K, nt = K / BK;
    unsigned voffA[2], voffB[2];
#pragma unroll
    for (int i = 0; i < 2; ++i) { int R, C; stage_rc(tid * 16 + i * 8192, R, C); const int Rb = Epi::PERM ? ((R & ~31) + perm32(R & 31)) : R;
        voffA[i] = (unsigned)(R * K + C) * 2u; voffB[i] = (unsigned)(Rb * K + C) * 2u; }
    const size_t kstep = (size_t)(BK * 2);
    const size_t hstep = (size_t)HALF * K * 2;
    const size_t tstep = 2 * hstep;
    const unsigned ldsw = (unsigned)wid * 1024u;
    const int aoff = lds_byte(wr * 64 + fr, fq * 8), boff = lds_byte(wc * 32 + fr, fq * 8);
#define PG8_SA(b, h) (((b) * 2 + (h)) * HTB)
#define PG8_SB(b, h) ((4 + (b) * 2 + (h)) * HTB)
#define PG8_STAGE(bufoff, gbase, voff) do { _Pragma("unroll") for (int _i = 0; _i < 2; ++_i) \
        __builtin_amdgcn_global_load_lds((const unsigned*)((const char*)(gbase) + (voff)[_i]), (PG8_LAS unsigned*)(lds + (bufoff) + ldsw + _i * 8192), 16, 0, 0); } while (0)
#define PG8_LDA(dst, b, h) do { _Pragma("unroll") for (int m = 0; m < 4; ++m) { const v4i_t lo_ = *(const PG8_LAS v4i_t*)(lds + PG8_SA(b, h) + aoff + m * 2048), hi_ = *(const PG8_LAS v4i_t*)(lds + PG8_SA(b, h) + aoff + m * 2048 + 1024); dst[m] = __builtin_shufflevector(lo_, hi_, 0, 1, 2, 3, 4, 5, 6, 7); } } while (0)
#define PG8_LDB(dst, b, h) do { _Pragma("unroll") for (int n = 0; n < 2; ++n) { const v4i_t lo_ = *(const PG8_LAS v4i_t*)(lds + PG8_SB(b, h) + boff + n * 2048), hi_ = *(const PG8_LAS v4i_t*)(lds + PG8_SB(b, h) + boff + n * 2048 + 1024); dst[n] = __builtin_shufflevector(lo_, hi_, 0, 1, 2, 3, 4, 5, 6, 7); } } while (0)
#define PG8_MMA(ai, bj, At, Bt) do { __builtin_amdgcn_s_setprio(1); _Pragma("unroll") for (int m = 0; m < 4; ++m) _Pragma("unroll") for (int n = 0; n < 2; ++n) \
        asm volatile("v_mfma_scale_f32_16x16x128_f8f6f4 %0, %1, %2, %0, %3, %3 op_sel_hi:[0,0,0]" : "+v"(acc[ai][bj][m][n]) : "v"(Bt[n]), "v"(At[m]), "v"(scl_)); __builtin_amdgcn_s_setprio(0); } while (0)
#define PG8_WAIT_V(n) asm volatile("s_waitcnt vmcnt(" #n ")" ::: "memory")
#define PG8_WAIT_L(n) asm volatile("s_waitcnt lgkmcnt(" #n ")" ::: "memory")
#define PG8_BAR __builtin_amdgcn_s_barrier()
#define PG8_SCHED __builtin_amdgcn_sched_barrier(0)
    Unit cur, nxt; int ui = 0;
    if (!S.next(0, cur)) return;
    int rA[2]; unsigned cAo[2];
#pragma unroll
    for (int i = 0; i < 2; ++i) { int R, C; stage_rc(tid * 16 + i * 8192, R, C); rA[i] = R; cAo[i] = (unsigned)C * 2u; }
    unsigned cO[2][2], o2[2][2]; int nR[2][2];
#define PG8_ROWS(dst, u) do { _Pragma("unroll") for (int h_ = 0; h_ < 2; ++h_) _Pragma("unroll") for (int i_ = 0; i_ < 2; ++i_) \
        dst[h_][i_] = (unsigned)S.arow(u, h_ * HALF + rA[i_]) * (unsigned)(K * 2) + cAo[i_]; } while (0)
    PG8_ROWS(cO, cur);
    f32x4 acc[2][2][4][2];
#pragma unroll
    for (int a = 0; a < 2; ++a)
#pragma unroll
        for (int b = 0; b < 2; ++b)
#pragma unroll
            for (int m = 0; m < 4; ++m)
#pragma unroll
                for (int n = 0; n < 2; ++n) acc[a][b][m][n] = (f32x4){0.f, 0.f, 0.f, 0.f};
    const int scl_ = 0x7f7f7f7f;
    v8i_t At[4], B0[2], B1[2];
    const char* const Ab = (const char*)g.A; const char* cB = (const char*)g.Bt + (size_t)cur.pn * tstep;
    S.a_ready(cur);
    if constexpr (SP2) {
        PG8_STAGE(PG8_SB(0, 0), cB, voffB); PG8_STAGE(PG8_SB(0, 1), cB + hstep, voffB); PG8_STAGE(PG8_SA(0, 0), Ab, cO[0]); PG8_STAGE(PG8_SA(0, 1), Ab, cO[1]);
        if (wr == 1) PG8_BAR;
        PG8_WAIT_V(2); PG8_BAR;
        PG8_STAGE(PG8_SB(1, 0), cB + kstep, voffB); PG8_STAGE(PG8_SA(1, 0), Ab + kstep, cO[0]); PG8_STAGE(PG8_SB(1, 1), cB + hstep + kstep, voffB);
        PG8_WAIT_V(6); PG8_BAR;
    }
    for (;;) {
        const bool has_next = S.next(ui + 1, nxt);
        const char* nB = has_next ? (const char*)g.Bt + (size_t)nxt.pn * tstep : cB;
#pragma unroll
        for (int h_ = 0; h_ < 2; ++h_)
#pragma unroll
            for (int i_ = 0; i_ < 2; ++i_) nR[h_][i_] = has_next ? S.arow(nxt, h_ * HALF + rA[i_]) : 0;
        for (int t = 0; t < nt; t += 2) {
            const bool last = (t == nt - 2);
            const char* a1 = Ab + (size_t)(t + 1) * kstep;
            const char* a2 = last ? Ab : Ab + (size_t)(t + 2) * kstep; const char* b2 = last ? nB : cB + (size_t)(t + 2) * kstep;
#pragma unroll
            for (int h_ = 0; h_ < 2; ++h_)
#pragma unroll
                for (int i_ = 0; i_ < 2; ++i_) o2[h_][i_] = cO[h_][i_];
            if (last && has_next) {
#pragma unroll
                for (int h_ = 0; h_ < 2; ++h_)
#pragma unroll
                    for (int i_ = 0; i_ < 2; ++i_) { int v_ = nR[h_][i_]; asm volatile("" : "+v"(v_)); o2[h_][i_] = (unsigned)v_ * (unsigned)(K * 2) + cAo[i_]; } }
            const char* a3 = a2 + kstep; const char* b3 = b2 + kstep;
            if (last && has_next) S.a_ready(nxt);
            if constexpr (SP2) {
            PG8_LDB(B0, 0, 0); PG8_LDB(B1, 0, 1); PG8_SCHED; PG8_LDA(At, 0, 0); PG8_STAGE(PG8_SA(1, 1), a1, cO[1]);
            PG8_WAIT_V(8); PG8_WAIT_L(0); PG8_BAR; PG8_MMA(0, 0, At, B0); PG8_MMA(0, 1, At, B1); PG8_BAR; PG8_SCHED;
            PG8_LDA(At, 0, 1); PG8_STAGE(PG8_SB(0, 0), b2, voffB); PG8_STAGE(PG8_SB(0, 1), b2 + hstep, voffB); PG8_STAGE(PG8_SA(0, 0), a2, o2[0]);
            PG8_WAIT_V(8); PG8_WAIT_L(0); PG8_BAR; PG8_MMA(1, 0, At, B0); PG8_MMA(1, 1, At, B1); PG8_BAR; PG8_SCHED;
            PG8_LDB(B0, 1, 0); PG8_LDB(B1, 1, 1); PG8_SCHED; PG8_LDA(At, 1, 0); PG8_STAGE(PG8_SA(0, 1), a2, o2[1]);
            PG8_WAIT_V(8); PG8_WAIT_L(0); PG8_BAR; PG8_MMA(0, 0, At, B0); PG8_MMA(0, 1, At, B1); PG8_BAR; PG8_SCHED;
            PG8_LDA(At, 1, 1); PG8_STAGE(PG8_SB(1, 0), b3, voffB); PG8_STAGE(PG8_SB(1, 1), b3 + hstep, voffB); PG8_STAGE(PG8_SA(1, 0), a3, o2[0]);
            PG8_WAIT_V(8); PG8_WAIT_L(0); PG8_BAR; PG8_MMA(1, 0, At, B0); PG8_MMA(1, 1, At, B1); PG8_BAR; PG8_SCHED;
            }
        }
        if constexpr (ALIGN_EPI) { if (wr == 0) PG8_BAR; }
        asm volatile("s_nop 15\n\ts_nop 15" ::: "memory");
        if constexpr (!Epi::AFTER_DRAIN) { E(acc, cur, wr, wc, fr, fq); S.done(cur); }
        if (!has_next) break;
#pragma unroll
        for (int a = 0; a < 2; ++a)
#pragma unroll
            for (int b = 0; b < 2; ++b)
#pragma unroll
                for (int m = 0; m < 4; ++m)
#pragma unroll
                    for (int n = 0; n < 2; ++n) acc[a][b][m][n] = (f32x4){0.f, 0.f, 0.f, 0.f};
        cur = nxt; cB = nB; ++ui;
#pragma unroll
        for (int h_ = 0; h_ < 2; ++h_)
#pragma unroll
            for (int i_ = 0; i_ < 2; ++i_) cO[h_][i_] = o2[h_][i_];
        if constexpr (ALIGN_EPI) { if (wr == 1) PG8_BAR; }
    }
    PG8_WAIT_V(0);
    if constexpr (!ALIGN_EPI) { if (wr == 0) PG8_BAR; }
    PG8_BAR;
    if constexpr (Epi::AFTER_DRAIN) { E.fused(acc, cur, wr, wc, fr, fq, lds, wid, lane); S.done(cur); }
#undef PG8_ROWS
#undef PG8_SA
#undef PG8_SB
#undef PG8_STAGE
#undef PG8_LDA
#undef PG8_LDB
#undef PG8_MMA
#undef PG8_WAIT_V
#undef PG8_WAIT_L
#undef PG8_BAR
#undef PG8_SCHED
}
}

struct EpiP { bf16_t* P; int n0; __device__ __forceinline__ void operator()(int r, int cl, float a, float) const { P[(size_t)r * NPROJ + n0 + cl] = (bf16_t)f2bf(a); } };
__device__ __forceinline__ void phase_gemm1_naive(const Params& p, const Ctx& c) {
    const bf16_t* H = (const bf16_t*)(p.ws + WS_H); const bf16_t* W = (const bf16_t*)(p.ws + WS_WINT); bf16_t* P = (bf16_t*)(p.ws + WS_P);
    constexpr int NT_N = NPROJ / 64, NT_M = M / 128;
    for (int it = c.bid; it < NT_M * NT_N; it += c.G) {
        const int mt = it / NT_N, nt = it % NT_N;
        ngemm_tile<false>(ARowPlain{H, 1024}, W + (size_t)nt * 64 * 1024, nullptr, 1024, mt * 128, EpiP{P, nt * 64}, (LAS float*)c.lds, c.tid);
    }
}

typedef short bf16x8c __attribute__((ext_vector_type(8)));
typedef float f32x16c __attribute__((ext_vector_type(16)));
__device__ __forceinline__ void phase_conv(const Params& p, const Ctx& c) {
    unsigned char* ws = p.ws;
    const bf16_t* P = (const bf16_t*)(ws + WS_P);
    const int tid = c.tid;
    LAS bf16_t* raw = (LAS bf16_t*)c.lds;
    LAS bf16_t* outb = (LAS bf16_t*)(c.lds + 132 * 256 * 2);
    for (int it = c.bid; it < 2 * 64 * 6; it += c.G) {
        const int part = it % 6, bc = it / 6, b = bc / 64, ch_ = bc % 64, t0 = ch_ * 128;
        __syncthreads();
        {
            u32x4 rv[9];
#pragma unroll
            for (int i = 0; i < 9; ++i) { const int idx = tid + 512 * i, r = idx >> 5, c8 = idx & 31, tok = t0 - 2 + r;
                rv[i] = (u32x4){0u, 0u, 0u, 0u};
                if (idx < 132 * 32 && tok >= 0 && tok < S) rv[i] = *(const u32x4*)(P + (size_t)(b * S + tok) * NPROJ + PXBC + part * 256 + c8 * 8); }
#pragma unroll
            for (int i = 0; i < 9; ++i) { const int idx = tid + 512 * i, r = idx >> 5, c8 = idx & 31;
                if (idx < 132 * 32) *(LAS u32x4*)(raw + r * 256 + c8 * 8) = rv[i]; }
        }
        __syncthreads();
        {
            const int ch = tid & 255, hf = tid >> 8, cg_ = part * 256 + ch;
            const float* cw = p.in[3]; const float cb = p.in[4][cg_];
            const float w0 = cw[0 * 1536 + cg_], w1 = cw[1 * 1536 + cg_], w2 = cw[2 * 1536 + cg_], w3 = cw[3 * 1536 + cg_], w4 = cw[4 * 1536 + cg_];
            const LAS bf16_t* rp = raw + (hf * 64) * 256 + ch;
            float r0 = bf2f(rp[0 * 256]), r1 = bf2f(rp[1 * 256]), r2 = bf2f(rp[2 * 256]), r3 = bf2f(rp[3 * 256]);
            unsigned ov[32];
#pragma unroll
            for (int i = 0; i < 64; ++i) {
                const float r4 = bf2f(rp[(i + 4) * 256]);
                float a = cb; a = fmaf(w0, r0, a); a = fmaf(w1, r1, a); a = fmaf(w2, r2, a); a = fmaf(w3, r3, a); a = fmaf(w4, r4, a);
                const unsigned hv = f2bf(a * sigmoidf_(a));
                if (i & 1) ov[i >> 1] |= hv << 16; else ov[i >> 1] = hv;
                r0 = r1; r1 = r2; r2 = r3; r3 = r4;
            }
            if (part <= 4) {
                bf16_t* dst = (part < 4 ? (bf16_t*)(ws + WS_XT) + ((size_t)(b * 64 + ch_) * 16 + part * 4) * 64 * 128
                                        : (bf16_t*)(ws + WS_BMT) + (size_t)(b * 64 + ch_) * 2 * 128 * 128) + (size_t)ch * 128 + hf * 64;
#pragma unroll
                for (int q = 0; q < 8; ++q) *(u32x4*)(dst + q * 8) = (u32x4){ov[4 * q], ov[4 * q + 1], ov[4 * q + 2], ov[4 * q + 3]};
            }
            if (part >= 4) {
#pragma unroll
                for (int i = 0; i < 64; ++i) outb[(hf * 64 + i) * 256 + ch] = (bf16_t)((i & 1) ? (ov[i >> 1] >> 16) : (ov[i >> 1] & 0xffffu));
            }
        }
        if (part >= 4) {
            __syncthreads();
            bf16_t* dst = (bf16_t*)(ws + (part == 4 ? WS_BMR : WS_CMR)) + (size_t)(b * S + t0) * 256;
#pragma unroll
            for (int q = 0; q < 8; ++q) { const int idx = tid + 512 * q, l = idx >> 5, c8 = idx & 31;
                *(u32x4*)(dst + (size_t)l * 256 + c8 * 8) = *(const LAS u32x4*)(outb + l * 256 + c8 * 8); }
        }
    }
    {
        float* DT = (float*)(ws + WS_DT); float* ACS = (float*)(ws + WS_ACS); float* CDEC = (float*)(ws + WS_CDEC);
        const bf16_t* H = (const bf16_t*)(ws + WS_H); const bf16_t* Wdt = (const bf16_t*)(ws + WS_WINT) + (size_t)PDT * 1024;
        constexpr int WS_ = 1032;
        LAS bf16_t* wl = (LAS bf16_t*)c.lds; LAS float* dtr = (LAS float*)(c.lds + 32 * WS_ * 2);
        const int lane = c.lane, r = lane & 31, hh = lane >> 5;
        bool staged = false;
        for (int it = c.bid; it < 128; it += c.G) {
            const int b = it / 64, ch_ = it % 64, t0 = ch_ * 128;
            __syncthreads();
            if (!staged) { staged = true;
#pragma unroll
                for (int i = 0; i < 8; ++i) { const int idx = tid + 512 * i, row = idx >> 7, c8 = idx & 127; *(LAS u32x4*)(wl + row * WS_ + c8 * 8) = *(const u32x4*)(Wdt + (size_t)row * 1024 + c8 * 8); }
                __syncthreads(); }
            {
                const int rb = c.wave & 3, kh = c.wave >> 2;
                const bf16_t* hrow = H + ((size_t)b * S + t0 + rb * 32 + r) * 1024 + kh * 512 + 8 * hh;
                f32x16c acc = {};
#pragma unroll
                for (int k8 = 0; k8 < 4; ++k8) { bf16x8c a[8];
#pragma unroll
                    for (int ks = 0; ks < 8; ++ks) a[ks] = *(const bf16x8c*)(hrow + (k8 * 8 + ks) * 16);
#pragma unroll
                    for (int ks = 0; ks < 8; ++ks) acc = __builtin_amdgcn_mfma_f32_32x32x16_bf16(a[ks], *(const LAS bf16x8c*)(wl + r * WS_ + kh * 512 + (k8 * 8 + ks) * 16 + 8 * hh), acc, 0, 0, 0); }
#pragma unroll
                for (int i = 0; i < 16; ++i) { const int l = rb * 32 + (i & 3) + 8 * (i >> 2) + 4 * hh; dtr[(kh * 128 + l) * 33 + r] = acc[i]; }
            }
            __syncthreads();
#pragma unroll
            for (int qi = 0; qi < 4; ++qi) {
                const int q = c.wave * 4 + qi, dir = q >> 4, h = q & 15;
                const float bias = dir ? p.in[6][h] : p.in[5][h], nA = -expf(dir ? p.in[8][h] : p.in[7][h]);
                const int l0 = dir ? 127 - lane : lane, l1 = dir ? 63 - lane : lane + 64;
                const size_t tok0 = (size_t)b * S + t0 + l0, tok1 = (size_t)b * S + t0 + l1;
                const float x0 = dtr[l0 * 33 + q] + dtr[(128 + l0) * 33 + q] + bias, x1 = dtr[l1 * 33 + q] + dtr[(128 + l1) * 33 + q] + bias;
                const float d0 = fmaxf(x0, 0.f) + log1pf(expf(-fabsf(x0))), d1 = fmaxf(x1, 0.f) + log1pf(expf(-fabsf(x1)));
                float a0 = d0 * nA, a1 = d1 * nA;
#pragma unroll
                for (int o = 1; o < 64; o <<= 1) { const float t0_ = __shfl_up(a0, o), t1_ = __shfl_up(a1, o); if (lane >= o) { a0 += t0_; a1 += t1_; } }
                const float tot0 = __shfl(a0, 63); a1 += tot0;
                DT[((size_t)dir * M + tok0) * 16 + h] = d0; DT[((size_t)dir * M + tok1) * 16 + h] = d1;
                ACS[((size_t)dir * M + tok0) * 16 + h] = a0; ACS[((size_t)dir * M + tok1) * 16 + h] = a1;
                if (lane == 63) CDEC[((dir * 2 + b) * 64 + ch_) * 16 + h] = expf(a1);
            }
        }
        __syncthreads();
    }
    {
        const int gw = c.bid * 8 + c.wave, NGW = c.G * 8, lane = c.lane;
        const float* rc = (const float*)(ws + WS_ROPE); const float* rs = rc + 4096;
        const int sub = lane >> 4, j = lane & 15, axis = j >> 3, i0 = 8 * (j & 3); const bool second = (j & 4) != 0;
        const f32x4 gq0 = *(const f32x4*)(p.in[11] + 8 * j), gq1 = *(const f32x4*)(p.in[11] + 8 * j + 4), gk0 = *(const f32x4*)(p.in[12] + 8 * j), gk1 = *(const f32x4*)(p.in[12] + 8 * j + 4);
        unsigned char* QN = ws + WS_QN; unsigned char* KN = ws + WS_KN;
        for (int base0 = gw; base0 < M * 10 / 4; base0 += 4 * NGW) {
            u32x4 vq[4]; int tokq[4], hhq[4];
#pragma unroll
            for (int u = 0; u < 4; ++u) { const int base = base0 + u * NGW, it = base * 4 + sub; tokq[u] = it / 10; hhq[u] = it % 10;
                vq[u] = (u32x4){0u, 0u, 0u, 0u};
                if (base < M * 10 / 4) vq[u] = *(const u32x4*)(P + (size_t)tokq[u] * NPROJ + (hhq[u] < 8 ? PQ + hhq[u] * 128 : PK + (hhq[u] - 8) * 128) + 8 * j); }
#pragma unroll
            for (int u = 0; u < 4; ++u) {
                const int base = base0 + u * NGW, tok = tokq[u], hh = hhq[u];
                unsigned char* dst = (hh < 8 ? QN + (size_t)tok * 1024 + hh * 128 : KN + (size_t)tok * 256 + (hh - 8) * 128) + 8 * j;
                const u32x4 v = vq[u];
                float y[8] = {bflo(v.x), bfhi(v.x), bflo(v.y), bfhi(v.y), bflo(v.z), bfhi(v.z), bflo(v.w), bfhi(v.w)};
                float ss = 0.f;
#pragma unroll
                for (int i = 0; i < 8; ++i) ss = fmaf(y[i], y[i], ss);
                ss += __shfl_xor(ss, 1); ss += __shfl_xor(ss, 2); ss += __shfl_xor(ss, 4); ss += __shfl_xor(ss, 8);
                const float rstd = rsqrtf(ss * (1.f / 128.f) + EPS);
                const f32x4 g0 = hh < 8 ? gq0 : gk0, g1 = hh < 8 ? gq1 : gk1;
#pragma unroll
                for (int i = 0; i < 4; ++i) { y[i] *= rstd * g0[i]; y[4 + i] *= rstd * g1[i]; }
                const int s = tok & (S - 1), pos = axis ? (s & 63) : (s >> 6);
                const f32x4 c0 = *(const f32x4*)(rc + pos * 32 + i0), c1 = *(const f32x4*)(rc + pos * 32 + i0 + 4), s0 = *(const f32x4*)(rs + pos * 32 + i0), s1 = *(const f32x4*)(rs + pos * 32 + i0 + 4);
                float o[8];
#pragma unroll
                for (int i = 0; i < 8; ++i) { const float other = __shfl_xor(y[i], 4); const float cs = i < 4 ? c0[i] : c1[i - 4], sn = i < 4 ? s0[i] : s1[i - 4];
                    o[i] = second ? fmaf(other, sn, y[i] * cs) : fmaf(-other, sn, y[i] * cs); }
                u32x2 w; w.x = pack4_fp8(o[0], o[1], o[2], o[3]); w.y = pack4_fp8(o[4], o[5], o[6], o[7]);
                if (base < M * 10 / 4) *(u32x2*)dst = w;
            }
        }
    }
    {
        unsigned char* VT8 = ws + WS_VB; LAS unsigned char* vt = c.lds;
        for (int it = c.bid; it < 256; it += c.G) {
            const int b = it >> 7, jt = it & 127;
            __syncthreads();
            u32x4 vv[4];
#pragma unroll
            for (int q = 0; q < 4; ++q) { const int idx = tid + 512 * q, key = idx >> 5, c8 = idx & 31; vv[q] = *(const u32x4*)(P + ((size_t)b * S + jt * 64 + key) * NPROJ + PV + c8 * 8); }
#pragma unroll
            for (int q = 0; q < 4; ++q) { const int idx = tid + 512 * q, key = idx >> 5, c8 = idx & 31, d0 = c8 * 8;
                const int off = 32 * ((key >> 2) & 1) + 16 * (key >> 5) + (key & 3) + 4 * ((key & 31) >> 3);
                const unsigned w0 = pack4_fp8(bflo(vv[q].x), bfhi(vv[q].x), bflo(vv[q].y), bfhi(vv[q].y)), w1 = pack4_fp8(bflo(vv[q].z), bfhi(vv[q].z), bflo(vv[q].w), bfhi(vv[q].w));
                LAS unsigned char* dp = vt + d0 * 64 + off;
                dp[0 * 64] = (unsigned char)(w0); dp[1 * 64] = (unsigned char)(w0 >> 8); dp[2 * 64] = (unsigned char)(w0 >> 16); dp[3 * 64] = (unsigned char)(w0 >> 24);
                dp[4 * 64] = (unsigned char)(w1); dp[5 * 64] = (unsigned char)(w1 >> 8); dp[6 * 64] = (unsigned char)(w1 >> 16); dp[7 * 64] = (unsigned char)(w1 >> 24); }
            __syncthreads();
#pragma unroll
            for (int q = 0; q < 2; ++q) { const int idx = tid + 512 * q, kvh = idx >> 9, rem = idx & 511;
                *(u32x4*)(VT8 + ((size_t)(b * 2 + kvh) * 128 + jt) * 8192 + rem * 16) = *(const LAS u32x4*)(vt + kvh * 8192 + rem * 16); }
        }
        __syncthreads();
    }
}

__device__ __forceinline__ void phase_ssd_naive(const Params& p, const Ctx& c) {
    unsigned char* ws = p.ws;
    const bf16_t* P = (const bf16_t*)(ws + WS_P); const bf16_t* XT = (const bf16_t*)(ws + WS_XT);
    const bf16_t* BMR = (const bf16_t*)(ws + WS_BMR); const bf16_t* CMR = (const bf16_t*)(ws + WS_CMR);
    const float* DT = (const float*)(ws + WS_DT); float* YACC = (float*)(ws + WS_ST); bf16_t* YZ = (bf16_t*)(ws + WS_YZ);
    const int pp = c.tid >> 3, nq = c.tid & 7;
    for (int item = c.bid; item < 32; item += c.G) {
        const int b = item >> 4, h = item & 15, g = h >> 3;
        const float dsk = p.in[9][h];
        for (int dir = 0; dir < 2; ++dir) {
            const float A = -expf(dir ? p.in[8][h] : p.in[7][h]);
            float st[16];
#pragma unroll
            for (int i = 0; i < 16; ++i) st[i] = 0.f;
            int t = dir ? S - 1 : 0;
            size_t tok = (size_t)b * S + t;
            u32x4 nb0 = *(const u32x4*)(BMR + tok * 256 + g * 128 + nq * 16), nb1 = *(const u32x4*)(BMR + tok * 256 + g * 128 + nq * 16 + 8);
            u32x4 nc0 = *(const u32x4*)(CMR + tok * 256 + g * 128 + nq * 16), nc1 = *(const u32x4*)(CMR + tok * 256 + g * 128 + nq * 16 + 8);
            float nx = bf2f(XT[((((size_t)b * 64 + (t >> 7)) * 16 + h) * 64 + pp) * 128 + (t & 127)]);
            float ndt = DT[((size_t)dir * M + tok) * 16 + h];
            for (int step = 0; step < S; ++step) {
                const u32x4 b0 = nb0, b1 = nb1, c0 = nc0, c1 = nc1; const float x = nx, dt = ndt; const size_t tokc = tok;
                if (step + 1 < S) {
                    t = dir ? S - 2 - step : step + 1; tok = (size_t)b * S + t;
                    nb0 = *(const u32x4*)(BMR + tok * 256 + g * 128 + nq * 16); nb1 = *(const u32x4*)(BMR + tok * 256 + g * 128 + nq * 16 + 8);
                    nc0 = *(const u32x4*)(CMR + tok * 256 + g * 128 + nq * 16); nc1 = *(const u32x4*)(CMR + tok * 256 + g * 128 + nq * 16 + 8);
                    nx = bf2f(XT[((((size_t)b * 64 + (t >> 7)) * 16 + h) * 64 + pp) * 128 + (t & 127)]);
                    ndt = DT[((size_t)dir * M + tok) * 16 + h];
                }
                const float dec = __expf(dt * A), xdt = x * dt;
                float part = 0.f;
#define SSD_STEP(i, BW, CW, LOHI) { st[i] = fmaf(st[i], dec, LOHI(BW) * xdt); part = fmaf(LOHI(CW), st[i], part); }
                SSD_STEP(0, b0.x, c0.x, bflo) SSD_STEP(1, b0.x, c0.x, bfhi) SSD_STEP(2, b0.y, c0.y, bflo) SSD_STEP(3, b0.y, c0.y, bfhi)
                SSD_STEP(4, b0.z, c0.z, bflo) SSD_STEP(5, b0.z, c0.z, bfhi) SSD_STEP(6, b0.w, c0.w, bflo) SSD_STEP(7, b0.w, c0.w, bfhi)
                SSD_STEP(8, b1.x, c1.x, bflo) SSD_STEP(9, b1.x, c1.x, bfhi) SSD_STEP(10, b1.y, c1.y, bflo) SSD_STEP(11, b1.y, c1.y, bfhi)
                SSD_STEP(12, b1.z, c1.z, bflo) SSD_STEP(13, b1.z, c1.z, bfhi) SSD_STEP(14, b1.w, c1.w, bflo) SSD_STEP(15, b1.w, c1.w, bfhi)
#undef SSD_STEP
                part += __shfl_xor(part, 1); part += __shfl_xor(part, 2); part += __shfl_xor(part, 4);
                if (nq == 0) {
                    const size_t o = tokc * 1024 + h * 64 + pp;
                    if (dir == 0) YACC[o] = part + x * dsk;
                    else { const float y = YACC[o] + part; const float z = bf2f(P[tokc * NPROJ + PZ + h * 64 + pp]); YZ[o] = (bf16_t)f2bf(y * z * sigmoidf_(z)); }
                }
            }
        }
    }
}


typedef short bf16x8 __attribute__((ext_vector_type(8)));
typedef float f32x16 __attribute__((ext_vector_type(16)));
constexpr int TS = 136;
__device__ __forceinline__ bf16x8 ldfrag(const LAS bf16_t* tile, int row, int k0) { return *(const LAS bf16x8*)(tile + row * TS + k0); }
template <int ROWS> __device__ __forceinline__ void load_tile128(LAS bf16_t* dst, const bf16_t* src, int ld, int tid) {
    constexpr int N = ROWS * 16 / 512;
    u32x4 v[N];
#pragma unroll
    for (int i = 0; i < N; ++i) { const int idx = tid + 512 * i; v[i] = *(const u32x4*)(src + (size_t)(idx >> 4) * ld + (idx & 15) * 8); }
#pragma unroll
    for (int i = 0; i < N; ++i) { const int idx = tid + 512 * i; *(LAS u32x4*)(dst + (idx >> 4) * TS + (idx & 15) * 8) = v[i]; }
}
__device__ __forceinline__ void phase_ssd_states(const Params& p, const Ctx& c) {
    unsigned char* ws = p.ws;
    const bf16_t* XT = (const bf16_t*)(ws + WS_XT); const bf16_t* BMT = (const bf16_t*)(ws + WS_BMT);
    const float* DT = (const float*)(ws + WS_DT); const float* ACS = (const float*)(ws + WS_ACS); bf16_t* ST = (bf16_t*)(ws + WS_PREV);
    LAS bf16_t* BTs = (LAS bf16_t*)c.lds; LAS bf16_t* XTf = BTs + 128 * TS; LAS bf16_t* XTb = XTf + 64 * TS; LAS float* wd = (LAS float*)(XTb + 64 * TS);
    const int tid = c.tid, lane = c.lane, r = lane & 31, hh = lane >> 5;
    for (int unit = c.bid; unit < 256; unit += c.G) {
        const int b = unit >> 7, ch = (unit >> 1) & 63, g = unit & 1;
        __syncthreads();
        load_tile128<128>(BTs, BMT + ((size_t)(b * 64 + ch) * 2 + g) * 128 * 128, 128, tid);
        u32x4 xv0, xv1; float pacs = 0.f, pdt = 0.f, paend = 0.f;
        const int wd_d = (tid >> 7) & 1, wd_l = tid & 127; const size_t wd_t0 = (size_t)wd_d * M + (size_t)b * S + ch * 128;
#define S1_PREFETCH(H) do { const bf16_t* xt_ = XT + ((size_t)(b * 64 + ch) * 16 + (H)) * 64 * 128; \
            xv0 = *(const u32x4*)(xt_ + (tid >> 4) * 128 + (tid & 15) * 8); xv1 = *(const u32x4*)(xt_ + ((tid + 512) >> 4) * 128 + (tid & 15) * 8); \
            if (tid < 256) { pacs = ACS[(wd_t0 + wd_l) * 16 + (H)]; pdt = DT[(wd_t0 + wd_l) * 16 + (H)]; paend = ACS[(wd_t0 + (wd_d ? 0 : 127)) * 16 + (H)]; } } while (0)
        S1_PREFETCH(g * 8);
#pragma unroll 1
        for (int h8 = 0; h8 < 8; ++h8) {
            const int h = g * 8 + h8;
            __syncthreads();
            if (tid < 256) wd[wd_d * 128 + wd_l] = pdt * __expf(paend - pacs);
            __syncthreads();
            {
                const u32x4 vv[2] = {xv0, xv1};
#pragma unroll
                for (int i = 0; i < 2; ++i) { const int idx = tid + 512 * i, pr = idx >> 4, l0 = (idx & 15) * 8; const u32x4 v = vv[i];
                    const float x[8] = {bflo(v.x), bfhi(v.x), bflo(v.y), bfhi(v.y), bflo(v.z), bfhi(v.z), bflo(v.w), bfhi(v.w)};
                    const f32x4 wf0 = *(const LAS f32x4*)(wd + l0), wf1 = *(const LAS f32x4*)(wd + l0 + 4), wb0 = *(const LAS f32x4*)(wd + 128 + l0), wb1 = *(const LAS f32x4*)(wd + 128 + l0 + 4);
                    u32x4 of, ob;
                    of.x = pk2(x[0] * wf0[0], x[1] * wf0[1]); of.y = pk2(x[2] * wf0[2], x[3] * wf0[3]); of.z = pk2(x[4] * wf1[0], x[5] * wf1[1]); of.w = pk2(x[6] * wf1[2], x[7] * wf1[3]);
                    ob.x = pk2(x[0] * wb0[0], x[1] * wb0[1]); ob.y = pk2(x[2] * wb0[2], x[3] * wb0[3]); ob.z = pk2(x[4] * wb1[0], x[5] * wb1[1]); ob.w = pk2(x[6] * wb1[2], x[7] * wb1[3]);
                    *(LAS u32x4*)(XTf + pr * TS + l0) = of; *(LAS u32x4*)(XTb + pr * TS + l0) = ob; }
            }
            if (h8 < 7) S1_PREFETCH(h + 1);
            __syncthreads();
            { const int d = c.wave >> 2, nb = c.wave & 3; const LAS bf16_t* XTd = d ? XTb : XTf;
              bf16_t* st = ST + ((((size_t)(d * 2 + b) * 64 + ch) * 16 + h) * 64) * 128;
#pragma unroll
              for (int pb = 0; pb < 2; ++pb) { f32x16 acc = {};
#pragma unroll
                for (int ks = 0; ks < 8; ++ks) acc = __builtin_amdgcn_mfma_f32_32x32x16_bf16(ldfrag(XTd, pb * 32 + r, ks * 16 + 8 * hh), ldfrag(BTs, nb * 32 + r, ks * 16 + 8 * hh), acc, 0, 0, 0);
#pragma unroll
                for (int i = 0; i < 16; ++i) { const int pp = pb * 32 + (i & 3) + 8 * (i >> 2) + 4 * hh; st[(size_t)pp * 128 + nb * 32 + r] = (bf16_t)f2bf(acc[i]); } } }
        }
#undef S1_PREFETCH
    }
}
__device__ __forceinline__ void phase_ssd_scan(const Params& p, const Ctx& c) {
    unsigned char* ws = p.ws;
    const float* CDEC = (const float*)(ws + WS_CDEC); bf16_t* PREV = (bf16_t*)(ws + WS_PREV);
    for (int idx = c.bid * 512 + c.tid; idx < 131072; idx += c.G * 512) {
        const int n4 = idx & 31, pp = (idx >> 5) & 63, h = (idx >> 11) & 15, b = (idx >> 15) & 1, d = idx >> 16;
        f32x4 run = {0.f, 0.f, 0.f, 0.f};
        const size_t obase = ((size_t)(d * 2 + b) * 64 * 16 + h) * 64 * 128 + (size_t)pp * 128 + n4 * 4;
        const float* cd = CDEC + (d * 2 + b) * 64 * 16 + h;
#pragma unroll 1
        for (int s0 = 0; s0 < 64; s0 += 16) {
            u32x2 sv[16]; float dec[16];
#pragma unroll
            for (int i = 0; i < 16; ++i) { const int ch = d ? 63 - (s0 + i) : s0 + i; sv[i] = *(const u32x2*)(PREV + obase + (size_t)ch * (16 * 64 * 128)); dec[i] = cd[ch * 16]; }
#pragma unroll
            for (int i = 0; i < 16; ++i) { const int ch = d ? 63 - (s0 + i) : s0 + i;
                u32x2 w; w.x = pk2(run.x, run.y); w.y = pk2(run.z, run.w); *(u32x2*)(PREV + obase + (size_t)ch * (16 * 64 * 128)) = w;
                run.x = fmaf(run.x, dec[i], bflo(sv[i].x)); run.y = fmaf(run.y, dec[i], bfhi(sv[i].x)); run.z = fmaf(run.z, dec[i], bflo(sv[i].y)); run.w = fmaf(run.w, dec[i], bfhi(sv[i].y)); }
        }
    }
}
__device__ __forceinline__ void phase_ssd_out(const Params& p, const Ctx& c) {
    unsigned char* ws = p.ws;
    const bf16_t* P = (const bf16_t*)(ws + WS_P); const bf16_t* XT = (const bf16_t*)(ws + WS_XT);
    const bf16_t* BMR = (const bf16_t*)(ws + WS_BMR); const bf16_t* CMR = (const bf16_t*)(ws + WS_CMR); const bf16_t* PREV = (const bf16_t*)(ws + WS_PREV);
    const float* DT = (const float*)(ws + WS_DT); const float* ACS = (const float*)(ws + WS_ACS); bf16_t* YZ = (bf16_t*)(ws + WS_YZ);
    LAS bf16_t* Cs = (LAS bf16_t*)c.lds; LAS bf16_t* Ms = Cs + 128 * TS; LAS bf16_t* XTs = Ms + 128 * TS; LAS bf16_t* PF = XTs + 64 * TS; LAS bf16_t* PB = PF + 64 * TS;
    LAS float* vec = (LAS float*)(PB + 64 * TS);
    constexpr int ZS = 72; LAS bf16_t* Zs = (LAS bf16_t*)(vec + 512); LAS float* dskl = (LAS float*)(Zs + 128 * ZS);
    const int tid = c.tid, lane = c.lane, r = lane & 31, hh = lane >> 5, wave = c.wave;
    for (int unit = c.bid; unit < 256; unit += c.G) {
        const int b = unit >> 7, ch = (unit >> 1) & 63, g = unit & 1;
        const size_t tok0 = (size_t)b * S + ch * 128;
        __syncthreads();
        load_tile128<128>(Cs, CMR + tok0 * 256 + g * 128, 256, tid);
        load_tile128<128>(Ms, BMR + tok0 * 256 + g * 128, 256, tid);
        u32x4 px0, px1, pf0, pf1, pb0, pb1, pz0, pz1; float pvec;
        const int t_r0 = tid >> 4, t_r1 = (tid + 512) >> 4, t_c = (tid & 15) * 8;
#define S3_PREFETCH(H) do { const bf16_t* xt_ = XT + ((size_t)(b * 64 + ch) * 16 + (H)) * 64 * 128; \
            const bf16_t* f_ = PREV + ((((size_t)(0 * 2 + b) * 64 + ch) * 16 + (H)) * 64) * 128; const bf16_t* b_ = PREV + ((((size_t)(1 * 2 + b) * 64 + ch) * 16 + (H)) * 64) * 128; \
            px0 = *(const u32x4*)(xt_ + t_r0 * 128 + t_c); px1 = *(const u32x4*)(xt_ + t_r1 * 128 + t_c); pf0 = *(const u32x4*)(f_ + t_r0 * 128 + t_c); pf1 = *(const u32x4*)(f_ + t_r1 * 128 + t_c); \
            pb0 = *(const u32x4*)(b_ + t_r0 * 128 + t_c); pb1 = *(const u32x4*)(b_ + t_r1 * 128 + t_c); \
            pz0 = *(const u32x4*)(P + (tok0 + (tid >> 3)) * NPROJ + PZ + (H) * 64 + (tid & 7) * 8); pz1 = *(const u32x4*)(P + (tok0 + 64 + (tid >> 3)) * NPROJ + PZ + (H) * 64 + (tid & 7) * 8); \
            { const int v_ = tid >> 7, l_ = tid & 127; const size_t o_ = ((size_t)(v_ & 1) * M + tok0 + l_) * 16 + (H); pvec = (v_ < 2) ? ACS[o_] : DT[o_]; } } while (0)
        S3_PREFETCH(g * 8);
        if (tid < 8) dskl[tid] = p.in[9][g * 8 + tid];
        __syncthreads();
        const int lb = wave & 3, sb0 = 2 * (wave >> 2);
        f32x16 G0 = {}, G1 = {};
#pragma unroll
        for (int ks = 0; ks < 8; ++ks) { const bf16x8 a = ldfrag(Cs, lb * 32 + r, ks * 16 + 8 * hh);
            G0 = __builtin_amdgcn_mfma_f32_32x32x16_bf16(a, ldfrag(Ms, sb0 * 32 + r, ks * 16 + 8 * hh), G0, 0, 0, 0);
            G1 = __builtin_amdgcn_mfma_f32_32x32x16_bf16(a, ldfrag(Ms, (sb0 + 1) * 32 + r, ks * 16 + 8 * hh), G1, 0, 0, 0); }
#pragma unroll 1
        for (int h8 = 0; h8 < 8; ++h8) {
            const int h = g * 8 + h8;
            __syncthreads();
            vec[tid] = pvec;
            *(LAS u32x4*)(XTs + t_r0 * TS + t_c) = px0; *(LAS u32x4*)(XTs + t_r1 * TS + t_c) = px1;
            *(LAS u32x4*)(PF + t_r0 * TS + t_c) = pf0; *(LAS u32x4*)(PF + t_r1 * TS + t_c) = pf1;
            *(LAS u32x4*)(PB + t_r0 * TS + t_c) = pb0; *(LAS u32x4*)(PB + t_r1 * TS + t_c) = pb1;
            *(LAS u32x4*)(Zs + (tid >> 3) * ZS + (tid & 7) * 8) = pz0; *(LAS u32x4*)(Zs + (64 + (tid >> 3)) * ZS + (tid & 7) * 8) = pz1;
            if (h8 < 7) S3_PREFETCH(h + 1);
            const int pbY = wave >> 2;
            __syncthreads();
#pragma unroll
            for (int t2 = 0; t2 < 2; ++t2) { const f32x16& Gt = t2 ? G1 : G0; const int sb = sb0 + t2, s = sb * 32 + r;
                const float afs = vec[s], abs_ = vec[128 + s], dfs = vec[256 + s], dbs = vec[384 + s];
                if (sb < lb) {
#pragma unroll
                    for (int i = 0; i < 16; ++i) { const int l = lb * 32 + (i & 3) + 8 * (i >> 2) + 4 * hh;
                        Ms[l * TS + s] = (bf16_t)f2bf(Gt[i] * __expf(vec[l] - afs) * dfs); }
                } else if (sb > lb) {
#pragma unroll
                    for (int i = 0; i < 16; ++i) { const int l = lb * 32 + (i & 3) + 8 * (i >> 2) + 4 * hh;
                        Ms[l * TS + s] = (bf16_t)f2bf(Gt[i] * __expf(vec[128 + l] - abs_) * dbs); }
                } else {
                    const float dsk = dskl[h8];
#pragma unroll
                    for (int i = 0; i < 16; ++i) { const int l = lb * 32 + (i & 3) + 8 * (i >> 2) + 4 * hh;
                        const float ef = __expf(fminf(vec[l] - afs, 0.f)) * dfs, eb = __expf(fminf(vec[128 + l] - abs_, 0.f)) * dbs;
                        const float tf = (s <= l) ? ef : 0.f, tb = (s >= l) ? eb : 0.f;
                        Ms[l * TS + s] = (bf16_t)f2bf(Gt[i] * (tf + tb) + (s == l ? dsk : 0.f)); }
                } }
            __syncthreads();
            { f32x16 Yd = {}, Yf = {}, Yb = {};
#pragma unroll
              for (int ks = 0; ks < 8; ++ks) { const int k0 = ks * 16 + 8 * hh;
                  Yd = __builtin_amdgcn_mfma_f32_32x32x16_bf16(ldfrag(Ms, lb * 32 + r, k0), ldfrag(XTs, pbY * 32 + r, k0), Yd, 0, 0, 0);
                  const bf16x8 a = ldfrag(Cs, lb * 32 + r, k0);
                  Yf = __builtin_amdgcn_mfma_f32_32x32x16_bf16(a, ldfrag(PF, pbY * 32 + r, k0), Yf, 0, 0, 0);
                  Yb = __builtin_amdgcn_mfma_f32_32x32x16_bf16(a, ldfrag(PB, pbY * 32 + r, k0), Yb, 0, 0, 0);
                  if (ks & 1) __builtin_amdgcn_sched_barrier(0); }
#pragma unroll
              for (int i = 0; i < 16; ++i) { const int l = lb * 32 + (i & 3) + 8 * (i >> 2) + 4 * hh;
                  const float y = Yd[i] + __expf(vec[l]) * Yf[i] + __expf(vec[128 + l]) * Yb[i];
                  const float z = bf2f(Zs[l * ZS + pbY * 32 + r]);
                  Zs[l * ZS + pbY * 32 + r] = (bf16_t)f2bf(y * z * sigmoidf_(z)); } }
            __syncthreads();
            *(u32x4*)(YZ + (tok0 + (tid >> 3)) * 1024 + h * 64 + (tid & 7) * 8) = *(const LAS u32x4*)(Zs + (tid >> 3) * ZS + (tid & 7) * 8);
            *(u32x4*)(YZ + (tok0 + 64 + (tid >> 3)) * 1024 + h * 64 + (tid & 7) * 8) = *(const LAS u32x4*)(Zs + (64 + (tid >> 3)) * ZS + (tid & 7) * 8);
        }
#undef S3_PREFETCH
    }
}

__device__ __forceinline__ void phase_rstd(const Params& p, const Ctx& c) {
    const bf16_t* YZ = (const bf16_t*)(p.ws + WS_YZ); float* RSTD = (float*)(p.ws + WS_RSTD);
    const int gw = c.bid * 8 + c.wave, NGW = c.G * 8;
    for (int m0 = gw * 4; m0 < M; m0 += NGW * 4) {
        u32x4 v[4][2];
#pragma unroll
        for (int q = 0; q < 4; ++q) { const u32x4* r = (const u32x4*)(YZ + (size_t)(m0 + q) * 1024) + c.lane; v[q][0] = r[0]; v[q][1] = r[64]; }
#pragma unroll
        for (int q = 0; q < 4; ++q) { float s = 0.f;
#pragma unroll
            for (int j = 0; j < 2; ++j) { const u32x4 w = v[q][j];
                s += bflo(w.x) * bflo(w.x) + bfhi(w.x) * bfhi(w.x) + bflo(w.y) * bflo(w.y) + bfhi(w.y) * bfhi(w.y) + bflo(w.z) * bflo(w.z) + bfhi(w.z) * bfhi(w.z) + bflo(w.w) * bflo(w.w) + bfhi(w.w) * bfhi(w.w); }
            s = wave_sum(s);
            if (c.lane == 0) RSTD[m0 + q] = rsqrtf(s * (1.f / 1024.f) + EPS); }
    }
}

__device__ __forceinline__ void phase_attn_naive(const Params& p, const Ctx& c) {
    unsigned char* ws = p.ws;
    const bf16_t* QN = (const bf16_t*)(ws + WS_QN); const bf16_t* KN = (const bf16_t*)(ws + WS_KN); const bf16_t* VB = (const bf16_t*)(ws + WS_VB);
    bf16_t* AO = (bf16_t*)(ws + WS_AO);
    LAS bf16_t* Ks = (LAS bf16_t*)c.lds; LAS bf16_t* Vs = Ks + 64 * 128;
    const int tid = c.tid, row = tid >> 2, dq = tid & 3;
    constexpr float C = 0.088388347648318440f * 1.4426950408889634f;
    for (int item = c.bid; item < 1024; item += c.G) {
        const int b = item >> 9, h = (item >> 6) & 7, qb = item & 63, kvh = h >> 2;
        const size_t tokq = (size_t)b * S + qb * 128 + row;
        float q[32], o[32];
#pragma unroll
        for (int i = 0; i < 4; ++i) { const u32x4 v = *(const u32x4*)(QN + tokq * 1024 + h * 128 + dq * 32 + i * 8);
            q[i * 8 + 0] = bflo(v.x) * C; q[i * 8 + 1] = bfhi(v.x) * C; q[i * 8 + 2] = bflo(v.y) * C; q[i * 8 + 3] = bfhi(v.y) * C;
            q[i * 8 + 4] = bflo(v.z) * C; q[i * 8 + 5] = bfhi(v.z) * C; q[i * 8 + 6] = bflo(v.w) * C; q[i * 8 + 7] = bfhi(v.w) * C; }
#pragma unroll
        for (int i = 0; i < 32; ++i) o[i] = 0.f;
        float mrun = -1e30f, lrun = 0.f;
        for (int kt = 0; kt < S / 64; ++kt) {
            __syncthreads();
            {
                const int key = tid >> 3, ch = tid & 7;
                const size_t tk = ((size_t)b * S + kt * 64 + key) * 256 + kvh * 128 + ch * 16;
                *(LAS u32x4*)(Ks + key * 128 + ch * 16) = *(const u32x4*)(KN + tk); *(LAS u32x4*)(Ks + key * 128 + ch * 16 + 8) = *(const u32x4*)(KN + tk + 8);
                *(LAS u32x4*)(Vs + key * 128 + ch * 16) = *(const u32x4*)(VB + tk); *(LAS u32x4*)(Vs + key * 128 + ch * 16 + 8) = *(const u32x4*)(VB + tk + 8);
            }
            __syncthreads();
            for (int j = 0; j < 64; ++j) {
                float s = 0.f;
#pragma unroll
                for (int i = 0; i < 4; ++i) { const u32x4 v = *(const LAS u32x4*)(Ks + j * 128 + dq * 32 + i * 8);
                    s = fmaf(q[i * 8 + 0], bflo(v.x), s); s = fmaf(q[i * 8 + 1], bfhi(v.x), s); s = fmaf(q[i * 8 + 2], bflo(v.y), s); s = fmaf(q[i * 8 + 3], bfhi(v.y), s);
                    s = fmaf(q[i * 8 + 4], bflo(v.z), s); s = fmaf(q[i * 8 + 5], bfhi(v.z), s); s = fmaf(q[i * 8 + 6], bflo(v.w), s); s = fmaf(q[i * 8 + 7], bfhi(v.w), s); }
                s += __shfl_xor(s, 1); s += __shfl_xor(s, 2);
                const float mn = fmaxf(mrun, s), al = __builtin_amdgcn_exp2f(mrun - mn), pe = __builtin_amdgcn_exp2f(s - mn);
                mrun = mn; lrun = lrun * al + pe;
#pragma unroll
                for (int i = 0; i < 4; ++i) { const u32x4 v = *(const LAS u32x4*)(Vs + j * 128 + dq * 32 + i * 8);
                    o[i * 8 + 0] = fmaf(pe, bflo(v.x), o[i * 8 + 0] * al); o[i * 8 + 1] = fmaf(pe, bfhi(v.x), o[i * 8 + 1] * al);
                    o[i * 8 + 2] = fmaf(pe, bflo(v.y), o[i * 8 + 2] * al); o[i * 8 + 3] = fmaf(pe, bfhi(v.y), o[i * 8 + 3] * al);
                    o[i * 8 + 4] = fmaf(pe, bflo(v.z), o[i * 8 + 4] * al); o[i * 8 + 5] = fmaf(pe, bfhi(v.z), o[i * 8 + 5] * al);
                    o[i * 8 + 6] = fmaf(pe, bflo(v.w), o[i * 8 + 6] * al); o[i * 8 + 7] = fmaf(pe, bfhi(v.w), o[i * 8 + 7] * al); }
            }
        }
        const float rl = 1.f / lrun;
#pragma unroll
        for (int i = 0; i < 4; ++i) { u32x4 w;
            w.x = pk2(o[i * 8 + 0] * rl, o[i * 8 + 1] * rl); w.y = pk2(o[i * 8 + 2] * rl, o[i * 8 + 3] * rl); w.z = pk2(o[i * 8 + 4] * rl, o[i * 8 + 5] * rl); w.w = pk2(o[i * 8 + 6] * rl, o[i * 8 + 7] * rl);
            *(u32x4*)(AO + tokq * 1024 + h * 128 + dq * 32 + i * 8) = w; }
    }
}

namespace attn {
typedef unsigned short bf16;
constexpr int   D = 128, NW = 8, QBLK = 32, KVBLK = 64;
constexpr float SCALE = 0.088388347648318440f;
constexpr float THR = 8.f;
constexpr int SDEPTH = 2;
constexpr int LDQ = 1024, LDK = 256, LDO = 1024;
constexpr size_t SHM_V = KVBLK * D * 2, SHM_K = KVBLK * D * 2, SHM_ATTN = 2 * SHM_V + 2 * SHM_K + NW * 64 * 4;
using bf16x8 = __attribute__((ext_vector_type(8))) short;
using s16x4  = __attribute__((ext_vector_type(4))) short;
using f32x16 = __attribute__((ext_vector_type(16))) float;
using f32x8  = __attribute__((ext_vector_type(8))) float;
using u32x4  = __attribute__((ext_vector_type(4))) unsigned;
#define KSWZ(row, colB) ((row) * 256 + ((colB) ^ (((row) & 7) << 4)))
#define SBAR() __builtin_amdgcn_sched_barrier(0)
__device__ __forceinline__ int crow(int r, int hi) { return (r & 3) + 8 * (r >> 2) + 4 * hi; }
__device__ __forceinline__ unsigned cvtpk(float lo, float hi) {
  unsigned r; asm volatile("v_cvt_pk_bf16_f32 %0, %1, %2" : "=v"(r) : "v"(lo), "v"(hi)); return r;
}
template <typename TIn> struct Stage;
template <> struct Stage<bf16>  { using T = bf16x8;
  __device__ static __forceinline__ T ld8(const bf16* p) { return *reinterpret_cast<const bf16x8*>(p); }
  __device__ static __forceinline__ bf16x8 tobf(T x) { return x; } };
template <> struct Stage<float> { using T = f32x8;
  __device__ static __forceinline__ T ld8(const float* p) { return *reinterpret_cast<const f32x8*>(p); }
  __device__ static __forceinline__ bf16x8 tobf(T x) {
    u32x4 w = {cvtpk(x[0], x[1]), cvtpk(x[2], x[3]), cvtpk(x[4], x[5]), cvtpk(x[6], x[7])}; return *reinterpret_cast<bf16x8*>(&w); } };

__device__ __forceinline__ void partialSM(f32x16& p0, f32x16& p1, float& m_reg, float& mn, float& alpha) {
  constexpr float C = SCALE * 1.4426950408889634f;
  float pmax = p0[0]; for (int r = 1; r < 16; ++r) pmax = fmaxf(pmax, p0[r]); for (int r = 0; r < 16; ++r) pmax = fmaxf(pmax, p1[r]);
  { auto rr = __builtin_amdgcn_permlane32_swap(__float_as_uint(pmax), __float_as_uint(pmax), false, false);
    pmax = fmaxf(__uint_as_float(rr[0]), __uint_as_float(rr[1])); }
  if (__builtin_expect(__all(pmax - m_reg <= THR / SCALE), 1)) { mn = m_reg; alpha = 1.f; }
  else { mn = fmaxf(m_reg, pmax); alpha = __builtin_amdgcn_exp2f((m_reg - mn) * C); m_reg = mn; }
  float mnC = -mn * C;
  for (int r = 0; r < 16; ++r) p0[r] = fmaf(p0[r], C, mnC); for (int r = 0; r < 16; ++r) p1[r] = fmaf(p1[r], C, mnC);
  for (int r = 0; r < 16; ++r) p0[r] = __builtin_amdgcn_exp2f(p0[r]);
}
__device__ __forceinline__ void finishSM(f32x16& p0, f32x16& p1, float alpha, float& l_reg, bf16x8& pa0, bf16x8& pa1, bf16x8& pa2, bf16x8& pa3) {
  for (int r = 0; r < 16; ++r) p1[r] = __builtin_amdgcn_exp2f(p1[r]);
  float ps = 0; for (int r = 0; r < 16; ++r) ps += p0[r]; for (int r = 0; r < 16; ++r) ps += p1[r];
  { auto rr = __builtin_amdgcn_permlane32_swap(__float_as_uint(ps), __float_as_uint(ps), false, false);
    ps = __uint_as_float(rr[0]) + __uint_as_float(rr[1]); }
  l_reg = l_reg * alpha + ps;
#define PK4(P, BASE, OUT) do { unsigned a0 = cvtpk(P[BASE + 0], P[BASE + 1]), a1 = cvtpk(P[BASE + 2], P[BASE + 3]);   \
    unsigned b0 = cvtpk(P[BASE + 4], P[BASE + 5]), b1 = cvtpk(P[BASE + 6], P[BASE + 7]);                              \
    auto r0 = __builtin_amdgcn_permlane32_swap(a0, b0, false, false); auto r1 = __builtin_amdgcn_permlane32_swap(a1, b1, false, false); \
    u32x4 w = {r0[0], r1[0], r0[1], r1[1]}; OUT = *reinterpret_cast<bf16x8*>(&w); } while (0)
  PK4(p0, 0, pa0); PK4(p0, 8, pa1); PK4(p1, 0, pa2); PK4(p1, 8, pa3);
#undef PK4
}
__device__ __forceinline__ void qkt(f32x16& p0, f32x16& p1, const bf16* Ks, const bf16x8* qr, int r32, int hi) {
  p0 = f32x16{}; p1 = f32x16{};
  for (int d0 = 0; d0 < 8; ++d0) { int cb = (d0 * 16 + hi * 8) * 2;
    bf16x8 b0 = *reinterpret_cast<const bf16x8*>((const char*)Ks + KSWZ(r32, cb));
    bf16x8 b1 = *reinterpret_cast<const bf16x8*>((const char*)Ks + KSWZ(32 + r32, cb));
    p0 = __builtin_amdgcn_mfma_f32_32x32x16_bf16(b0, qr[d0], p0, 0, 0, 0);
    p1 = __builtin_amdgcn_mfma_f32_32x32x16_bf16(b1, qr[d0], p1, 0, 0, 0); }
}
__device__ __forceinline__ int v_st(int k, int c) { const int kk = (k & ~0xC) | ((k & 4) << 1) | ((k & 8) >> 1); return ((kk >> 3) * 4 + (c >> 5)) * 512 + ((kk & 7) * 32 + (c & 31)) * 2; }
__device__ __forceinline__ int v_rd_base(int lane) { return ((lane & 3) << 3) | (((lane >> 2) & 3) << 6) | (((lane >> 4) & 1) << 5) | (((lane >> 5) & 1) << 8); }
constexpr int v_rd_off(int d0, int ks, int half) { return d0 * 512 + ks * 4096 + half * 2048; }
template <int OFF> __device__ __forceinline__ s16x4 tr_read(int vb) {
  s16x4 r; asm volatile("ds_read_b64_tr_b16 %0, %1 offset:%2" : "=&v"(r) : "v"(vb), "i"(OFF) : "memory"); return r;
}
template <int D0> __device__ __forceinline__ void pv_one(f32x16& od, int vb, bf16x8 pa0, bf16x8 pa1, bf16x8 pa2, bf16x8 pa3) {
  const s16x4 l0 = tr_read<v_rd_off(D0, 0, 0)>(vb), h0 = tr_read<v_rd_off(D0, 0, 1)>(vb), l1 = tr_read<v_rd_off(D0, 1, 0)>(vb), h1 = tr_read<v_rd_off(D0, 1, 1)>(vb);
  const s16x4 l2 = tr_read<v_rd_off(D0, 2, 0)>(vb), h2 = tr_read<v_rd_off(D0, 2, 1)>(vb), l3 = tr_read<v_rd_off(D0, 3, 0)>(vb), h3 = tr_read<v_rd_off(D0, 3, 1)>(vb);
  asm volatile("s_waitcnt lgkmcnt(0)" ::: "memory"); SBAR();
#define PK(L, H) (bf16x8){L[0], L[1], L[2], L[3], H[0], H[1], H[2], H[3]}
  od = __builtin_amdgcn_mfma_f32_32x32x16_bf16(pa0, PK(l0, h0), od, 0, 0, 0);
  od = __builtin_amdgcn_mfma_f32_32x32x16_bf16(pa1, PK(l1, h1), od, 0, 0, 0);
  od = __builtin_amdgcn_mfma_f32_32x32x16_bf16(pa2, PK(l2, h2), od, 0, 0, 0);
  od = __builtin_amdgcn_mfma_f32_32x32x16_bf16(pa3, PK(l3, h3), od, 0, 0, 0);
#undef PK
}
__device__ __forceinline__ void pv_d0(f32x16* o, int vb, bf16x8 pa0, bf16x8 pa1, bf16x8 pa2, bf16x8 pa3) {
  pv_one<0>(o[0], vb, pa0, pa1, pa2, pa3); pv_one<1>(o[1], vb, pa0, pa1, pa2, pa3); pv_one<2>(o[2], vb, pa0, pa1, pa2, pa3); pv_one<3>(o[3], vb, pa0, pa1, pa2, pa3);
}

template <typename TQ>
__device__ __forceinline__ void attn_dense_body(const TQ* __restrict__ Qb, const bf16* __restrict__ Kh, const bf16* __restrict__ Vh,
                                                bf16* __restrict__ Ob, int seq, char* lds) {
  using St = Stage<bf16>; using SQ = Stage<TQ>;
  const int tid = threadIdx.x, wid = tid >> 6, lane = tid & 63, r32 = lane & 31, hi = lane >> 5;
  bf16* V_lds = (bf16*)lds; bf16* K_lds = (bf16*)(lds + 2 * SHM_V);
  float* ws = (float*)(lds + 2 * SHM_V + 2 * SHM_K) + wid * 64; float* li_l = ws; float* al_l = ws + 32;
  float m_reg = -1e30f, l_reg = 0; f32x16 o[4] = {}; bf16x8 qr[8];
  const TQ* Qw = Qb + (long)(wid * QBLK + r32) * LDQ + hi * 8;
#pragma unroll
  for (int d0 = 0; d0 < 8; ++d0) qr[d0] = SQ::tobf(SQ::ld8(Qw + d0 * 16));
  const int sr = tid >> 4, sc = (tid & 15) * 8, vst0 = v_st(sr, sc), vst1 = v_st(32 + sr, sc);
  const int vb0 = (int)(uintptr_t)V_lds + v_rd_base(lane);
  struct { typename St::T vs0, vs1, ks0, ks1; } sr_[SDEPTH];
#define SLOAD(i, k0) do { sr_[i].vs0 = St::ld8(&Vh[(long)((k0) + sr) * LDK + sc]); sr_[i].vs1 = St::ld8(&Vh[(long)((k0) + 32 + sr) * LDK + sc]); \
    sr_[i].ks0 = St::ld8(&Kh[(long)((k0) + sr) * LDK + sc]); sr_[i].ks1 = St::ld8(&Kh[(long)((k0) + 32 + sr) * LDK + sc]); } while (0)
#define SWRITE(b, i) do { *(bf16x8*)((char*)V_lds + (b) * SHM_V + vst0) = St::tobf(sr_[i].vs0);          \
    *(bf16x8*)((char*)V_lds + (b) * SHM_V + vst1) = St::tobf(sr_[i].vs1); int kc = sc * 2;               \
    *(bf16x8*)((char*)K_lds + (b) * SHM_K + KSWZ(sr, kc)) = St::tobf(sr_[i].ks0);                       \
    *(bf16x8*)((char*)K_lds + (b) * SHM_K + KSWZ(32 + sr, kc)) = St::tobf(sr_[i].ks1); } while (0)
#define SWAIT() do { if constexpr (SDEPTH == 2) asm volatile("s_waitcnt vmcnt(4)" ::: "memory"); else asm volatile("s_waitcnt vmcnt(0)" ::: "memory"); } while (0)
#define RESC(a) do { if (__any((a) < 1.f)) { if (hi == 0) al_l[r32] = (a); asm volatile("s_waitcnt lgkmcnt(0)" ::: "memory"); \
    for (int d = 0; d < 4; ++d) for (int r = 0; r < 16; ++r) o[d][r] *= al_l[crow(r, hi)]; } } while (0)
  f32x16 pA0, pA1, pB0, pB1; float mnA, mnB, alA, alB; bf16x8 pa0, pa1, pa2, pa3; const int NT = seq / KVBLK;
  constexpr int SE = 0, SO = SDEPTH - 1;
  SLOAD(SE, 0); asm volatile("s_waitcnt vmcnt(0)" ::: "memory"); SWRITE(0, SE); __syncthreads();
  qkt(pA0, pA1, K_lds, qr, r32, hi); partialSM(pA0, pA1, m_reg, mnA, alA);
  SLOAD(SO, KVBLK); if constexpr (SDEPTH == 2) { if (2 < NT) SLOAD(SE, 2 * KVBLK); }
  SWAIT(); SWRITE(1, SO); __syncthreads();
  for (int j = 1; j + 1 < NT; j += 2) {
    SBAR(); qkt(pB0, pB1, (bf16*)((char*)K_lds + SHM_K), qr, r32, hi);
    finishSM(pA0, pA1, alA, l_reg, pa0, pa1, pa2, pa3); SBAR();
    SLOAD(SO, (j + SDEPTH) * KVBLK); SBAR();
    pv_d0(o, vb0, pa0, pa1, pa2, pa3); partialSM(pB0, pB1, m_reg, mnB, alB);
    __syncthreads(); SWAIT(); SWRITE(0, SE);
    RESC(alB); __syncthreads();
    SBAR(); qkt(pA0, pA1, K_lds, qr, r32, hi);
    finishSM(pB0, pB1, alB, l_reg, pa0, pa1, pa2, pa3); SBAR();
    if (SDEPTH == 1 || j + 3 < NT) SLOAD(SE, (j + 1 + SDEPTH) * KVBLK); SBAR();
    pv_d0(o, vb0 + (int)SHM_V, pa0, pa1, pa2, pa3); partialSM(pA0, pA1, m_reg, mnA, alA);
    __syncthreads(); SWAIT(); SWRITE(1, SO);
    RESC(alA); __syncthreads();
  }
  SBAR(); qkt(pB0, pB1, (bf16*)((char*)K_lds + SHM_K), qr, r32, hi);
  finishSM(pA0, pA1, alA, l_reg, pa0, pa1, pa2, pa3); SBAR();
  pv_d0(o, vb0, pa0, pa1, pa2, pa3); partialSM(pB0, pB1, m_reg, mnB, alB);
  __syncthreads(); RESC(alB);
  finishSM(pB0, pB1, alB, l_reg, pa0, pa1, pa2, pa3); SBAR();
  pv_d0(o, vb0 + (int)SHM_V, pa0, pa1, pa2, pa3);
  if (hi == 0) li_l[r32] = l_reg; asm volatile("s_waitcnt lgkmcnt(0)" ::: "memory");
  float rli[16];
#pragma unroll
  for (int r = 0; r < 16; ++r) rli[r] = __builtin_amdgcn_rcpf(li_l[crow(r, hi)]);
  bf16* Ow = Ob + (long)(wid * QBLK) * LDO;
#pragma unroll
  for (int r = 0; r < 16; ++r) { int orow = crow(r, hi);
    for (int d0 = 0; d0 < 4; ++d0) Ow[(long)orow * LDO + d0 * 32 + r32] = (bf16)f2bf(o[d0][r] * rli[r]); }
#undef SLOAD
#undef SWRITE
#undef SWAIT
#undef RESC
}
}


namespace attn8 {
typedef int v8i __attribute__((ext_vector_type(8)));
typedef float f32x16 __attribute__((ext_vector_type(16)));
typedef unsigned u32x4_ __attribute__((ext_vector_type(4)));
constexpr int QBLK = 32, KVBLK = 64;
constexpr float SCALE = 0.088388347648318440f;
constexpr float THR = 0.69f;
constexpr size_t SHM_K = 64 * 128, SHM_V = 128 * 64, SHM_ATTN = 2 * SHM_K + 2 * SHM_V + 8 * 64 * 4;
__device__ __forceinline__ int crow(int r, int hi) { return (r & 3) + 8 * (r >> 2) + 4 * hi; }
__device__ __forceinline__ int kswz(int row, int colB) { return row * 128 + (colB ^ ((row & 7) << 4)); }
__device__ __forceinline__ int vswz(int d, int slot) { return d * 64 + ((slot ^ ((d >> 2) & 3)) << 4); }
__device__ __forceinline__ v8i cat8(const u32x4_& lo, const u32x4_& hi) { v8i r; r[0] = (int)lo.x; r[1] = (int)lo.y; r[2] = (int)lo.z; r[3] = (int)lo.w; r[4] = (int)hi.x; r[5] = (int)hi.y; r[6] = (int)hi.z; r[7] = (int)hi.w; return r; }
template <bool LAST> __device__ __forceinline__ void mfma8(f32x16& acc, const v8i& a, const v8i& b, int scl) {
    if (LAST) asm volatile("v_mfma_scale_f32_32x32x64_f8f6f4 %0, %1, %2, %0, %3, %3 op_sel_hi:[0,0,0]\n\ts_nop 15\n\ts_nop 15" : "+v"(acc) : "v"(a), "v"(b), "v"(scl));
    else asm volatile("v_mfma_scale_f32_32x32x64_f8f6f4 %0, %1, %2, %0, %3, %3 op_sel_hi:[0,0,0]" : "+v"(acc) : "v"(a), "v"(b), "v"(scl));
}
__device__ __forceinline__ void partialSM(f32x16& p0, f32x16& p1, float& m_reg, float& mn, float& alpha) {
    constexpr float C = SCALE * 1.4426950408889634f;
    float pmax = p0[0];
#pragma unroll
    for (int r = 1; r < 16; ++r) pmax = fmaxf(pmax, p0[r]);
#pragma unroll
    for (int r = 0; r < 16; ++r) pmax = fmaxf(pmax, p1[r]);
    { auto rr = __builtin_amdgcn_permlane32_swap(__float_as_uint(pmax), __float_as_uint(pmax), false, false); pmax = fmaxf(__uint_as_float(rr[0]), __uint_as_float(rr[1])); }
    if (__builtin_expect(__all(pmax - m_reg <= THR / SCALE), 1)) { mn = m_reg; alpha = 1.f; }
    else { mn = fmaxf(m_reg, pmax); alpha = __builtin_amdgcn_exp2f((m_reg - mn) * C); m_reg = mn; }
    const float mnC = 7.f - mn * C;
#pragma unroll
    for (int r = 0; r < 16; ++r) p0[r] = fmaf(p0[r], C, mnC);
#pragma unroll
    for (int r = 0; r < 16; ++r) p1[r] = fmaf(p1[r], C, mnC);
#pragma unroll
    for (int r = 0; r < 16; ++r) p0[r] = __builtin_amdgcn_exp2f(p0[r]);
}
__device__ __forceinline__ void finishSM(f32x16& p0, f32x16& p1, float alpha, float& l_reg, v8i& pa) {
#pragma unroll
    for (int r = 0; r < 16; ++r) p1[r] = __builtin_amdgcn_exp2f(p1[r]);
    float ps = 0;
#pragma unroll
    for (int r = 0; r < 16; ++r) ps += p0[r];
#pragma unroll
    for (int r = 0; r < 16; ++r) ps += p1[r];
    { auto rr = __builtin_amdgcn_permlane32_swap(__float_as_uint(ps), __float_as_uint(ps), false, false); ps = __uint_as_float(rr[0]) + __uint_as_float(rr[1]); }
    l_reg = l_reg * alpha + ps;
#pragma unroll
    for (int w = 0; w < 4; ++w) { pa[w] = (int)pack4_fp8(p0[4 * w], p0[4 * w + 1], p0[4 * w + 2], p0[4 * w + 3]); pa[4 + w] = (int)pack4_fp8(p1[4 * w], p1[4 * w + 1], p1[4 * w + 2], p1[4 * w + 3]); }
}
__device__ __forceinline__ void qkt(f32x16& p0, f32x16& p1, const char* Ks, const v8i* qf, int r32, int hi, int scl) {
    p0 = f32x16{}; p1 = f32x16{};
#pragma unroll
    for (int s = 0; s < 2; ++s) { const int cb = 64 * s + 32 * hi;
        const v8i a0 = cat8(*(const u32x4_*)(Ks + kswz(r32, cb)), *(const u32x4_*)(Ks + kswz(r32, cb + 16)));
        const v8i a1 = cat8(*(const u32x4_*)(Ks + kswz(32 + r32, cb)), *(const u32x4_*)(Ks + kswz(32 + r32, cb + 16)));
        if (s == 0) { mfma8<false>(p0, a0, qf[s], scl); mfma8<false>(p1, a1, qf[s], scl); }
        else { mfma8<false>(p0, a0, qf[s], scl); mfma8<true>(p1, a1, qf[s], scl); } }
}
__device__ __forceinline__ void pv(f32x16* o, const char* Vs, const v8i& pa, int r32, int hi, int scl) {
#pragma unroll
    for (int d0 = 0; d0 < 4; ++d0) { const int d = d0 * 32 + r32;
        const v8i b = cat8(*(const u32x4_*)(Vs + vswz(d, 2 * hi)), *(const u32x4_*)(Vs + vswz(d, 2 * hi + 1)));
        if (d0 == 3) mfma8<true>(o[d0], pa, b, scl); else mfma8<false>(o[d0], pa, b, scl); }
}
__device__ __forceinline__ void body(const unsigned char* __restrict__ Qb, const unsigned char* __restrict__ Kh, const unsigned char* __restrict__ Vt, unsigned short* __restrict__ Ob, int seq, char* lds) {
    const int tid = threadIdx.x, wid = tid >> 6, lane = tid & 63, r32 = lane & 31, hi = lane >> 5;
    const int scl = 0x7f7f7f7f;
    char* K_lds = lds; char* V_lds = lds + 2 * SHM_K;
    float* ws = (float*)(lds + 2 * SHM_K + 2 * SHM_V) + wid * 64; float* li_l = ws; float* al_l = ws + 32;
    float m_reg = -1e30f, l_reg = 0; f32x16 o[4] = {}; v8i qf[2];
    { const unsigned char* Qw = Qb + (long)(wid * QBLK + r32) * 1024 + 32 * hi;
#pragma unroll
      for (int s = 0; s < 2; ++s) qf[s] = cat8(*(const u32x4_*)(Qw + 64 * s), *(const u32x4_*)(Qw + 64 * s + 16)); }
    const int kr = tid >> 3, kc = (tid & 7) * 16, kdst = kswz(kr, kc);
    const int vd = tid >> 2, vsl = tid & 3, vdst = vswz(vd, vsl);
    struct { u32x4_ k, v; } sr_[2];
#define SLOAD(i, t) do { sr_[i].k = *(const u32x4_*)(Kh + (long)((t) * KVBLK + kr) * 256 + kc); sr_[i].v = *(const u32x4_*)(Vt + (long)(t) * 8192 + vd * 64 + vsl * 16); } while (0)
#define SWRITE(b, i) do { *(u32x4_*)(K_lds + (b) * SHM_K + kdst) = sr_[i].k; *(u32x4_*)(V_lds + (b) * SHM_V + vdst) = sr_[i].v; } while (0)
#define SWAIT() asm volatile("s_waitcnt vmcnt(2)" ::: "memory")
#define RESC(a) do { if (__any((a) < 1.f)) { if (hi == 0) al_l[r32] = (a); asm volatile("s_waitcnt lgkmcnt(0)" ::: "memory"); \
    _Pragma("unroll") for (int d = 0; d < 4; ++d) _Pragma("unroll") for (int r = 0; r < 16; ++r) o[d][r] *= al_l[crow(r, hi)]; } } while (0)
#define SBAR_() __builtin_amdgcn_sched_barrier(0)
    f32x16 pA0, pA1, pB0, pB1; float mnA, mnB, alA, alB; v8i pa; const int NT = seq / KVBLK;
    SLOAD(0, 0); asm volatile("s_waitcnt vmcnt(0)" ::: "memory"); SWRITE(0, 0); __syncthreads();
    qkt(pA0, pA1, K_lds, qf, r32, hi, scl); partialSM(pA0, pA1, m_reg, mnA, alA);
    SLOAD(1, 1); if (2 < NT) SLOAD(0, 2);
    SWAIT(); SWRITE(1, 1); __syncthreads();
    for (int j = 1; j + 1 < NT; j += 2) {
        SBAR_(); qkt(pB0, pB1, K_lds + SHM_K, qf, r32, hi, scl);
        finishSM(pA0, pA1, alA, l_reg, pa); SBAR_();
        SLOAD(1, j + 2); SBAR_();
        pv(o, V_lds, pa, r32, hi, scl); partialSM(pB0, pB1, m_reg, mnB, alB);
        __syncthreads(); SWAIT(); SWRITE(0, 0);
        RESC(alB); __syncthreads();
        SBAR_(); qkt(pA0, pA1, K_lds, qf, r32, hi, scl);
        finishSM(pB0, pB1, alB, l_reg, pa); SBAR_();
        if (j + 3 < NT) SLOAD(0, j + 3); SBAR_();
        pv(o, V_lds + SHM_V, pa, r32, hi, scl); partialSM(pA0, pA1, m_reg, mnA, alA);
        __syncthreads(); SWAIT(); SWRITE(1, 1);
        RESC(alA); __syncthreads();
    }
    SBAR_(); qkt(pB0, pB1, K_lds + SHM_K, qf, r32, hi, scl);
    finishSM(pA0, pA1, alA, l_reg, pa); SBAR_();
    pv(o, V_lds, pa, r32, hi, scl); partialSM(pB0, pB1, m_reg, mnB, alB);
    __syncthreads(); RESC(alB);
    finishSM(pB0, pB1, alB, l_reg, pa); SBAR_();
    pv(o, V_lds + SHM_V, pa, r32, hi, scl);
    if (hi == 0) li_l[r32] = l_reg; asm volatile("s_waitcnt lgkmcnt(0)" ::: "memory");
    float rli[16];
#pragma unroll
    for (int r = 0; r < 16; ++r) rli[r] = __builtin_amdgcn_rcpf(li_l[crow(r, hi)]);
    unsigned short* Ow = Ob + (long)(wid * QBLK) * 1024;
#pragma unroll
    for (int r = 0; r < 16; ++r) { const int orow = crow(r, hi);
#pragma unroll
        for (int d0 = 0; d0 < 4; ++d0) Ow[(long)orow * 1024 + d0 * 32 + r32] = (unsigned short)f2bf(o[d0][r] * rli[r]); }
#undef SLOAD
#undef SWRITE
#undef SWAIT
#undef RESC
#undef SBAR_
}
}
__device__ __forceinline__ void phase_attn(const Params& p, const Ctx& c, char* lds_generic) {
    unsigned char* ws = p.ws;
    const unsigned char* Q8 = ws + WS_QN; const unsigned char* K8 = ws + WS_KN; const unsigned char* VT8 = ws + WS_VB; bf16_t* AO = (bf16_t*)(ws + WS_AO);
    for (int item = c.bid; item < 512; item += c.G) {
        const int b = item >> 8, h = (item >> 5) & 7, qb = item & 31, kvh = h >> 2;
        const size_t qrow = (size_t)b * S + qb * 256;
        attn8::body(Q8 + qrow * 1024 + h * 128, K8 + (size_t)b * S * 256 + kvh * 128, VT8 + (size_t)(b * 2 + kvh) * 128 * 8192, AO + qrow * 1024 + h * 128, S, lds_generic);
        __syncthreads();
    }
}

struct EpiT1 { bf16_t* T1; const bf16_t* P; const float* RSTD; int n0;
    __device__ __forceinline__ void operator()(int r, int cl, float a, float) const { const int col = n0 + cl;
        T1[(size_t)r * 1024 + col] = (bf16_t)f2bf(a * RSTD[r] * sigmoidf_(bf2f(P[(size_t)r * NPROJ + PG + col]))); } };
struct EpiT2 { bf16_t* MG; const bf16_t* T1; const bf16_t* P; int n0;
    __device__ __forceinline__ void operator()(int r, int cl, float a, float) const { const int col = n0 + cl;
        MG[(size_t)r * 1024 + col] = (bf16_t)f2bf(bf2f(T1[(size_t)r * 1024 + col]) + a * sigmoidf_(bf2f(P[(size_t)r * NPROJ + PG + 1024 + col]))); } };
struct EpiT3 { float* X1; const float* x; int n0;
    __device__ __forceinline__ void operator()(int r, int cl, float a, float) const { const size_t o = (size_t)r * 1024 + n0 + cl; X1[o] = x[o] + a; } };
template <int WHICH> __device__ __forceinline__ void phase_tail_naive(const Params& p, const Ctx& c) {
    unsigned char* ws = p.ws;
    for (int it = c.bid; it < (M / 128) * 16; it += c.G) {
        const int mt = it >> 4, nt = it & 15;
        if (WHICH == 0) ngemm_tile<false>(ARowPlain{(const bf16_t*)(ws + WS_YZ), 1024}, (const bf16_t*)(ws + WS_WST) + (size_t)nt * 64 * 1024, nullptr, 1024, mt * 128,
                                          EpiT1{(bf16_t*)(ws + WS_T1), (const bf16_t*)(ws + WS_P), (const float*)(ws + WS_RSTD), nt * 64}, (LAS float*)c.lds, c.tid);
        if (WHICH == 1) ngemm_tile<false>(ARowPlain{(const bf16_t*)(ws + WS_AO), 1024}, (const bf16_t*)(ws + WS_WAT) + (size_t)nt * 64 * 1024, nullptr, 1024, mt * 128,
                                          EpiT2{(bf16_t*)(ws + WS_MG), (const bf16_t*)(ws + WS_T1), (const bf16_t*)(ws + WS_P), nt * 64}, (LAS float*)c.lds, c.tid);
        if (WHICH == 2) ngemm_tile<false>(ARowPlain{(const bf16_t*)(ws + WS_MG), 1024}, (const bf16_t*)(ws + WS_WOT) + (size_t)nt * 64 * 1024, nullptr, 1024, mt * 128,
                                          EpiT3{(float*)(ws + WS_X1), p.in[0], nt * 64}, (LAS float*)c.lds, c.tid);
    }
}

__device__ __forceinline__ void phase_router(const Params& p, const Ctx& c) {
    unsigned char* ws = p.ws;
    LAS float* wT = (LAS float*)c.lds;
    LAS int* tokE = (LAS int*)(c.lds + LDS_CTL + 512);
    LAS float* tokW = (LAS float*)(c.lds + LDS_CTL + 512 + 1024);
    LAS int* lcnt = (LAS int*)(c.lds + LDS_CTL + 512 + 2048);
    LAS int* lbase = lcnt + 32;
    LAS int* lrank = lbase + 32;
    const float* X1 = (const float*)(ws + WS_X1); unsigned char* H2 = ws + WS_H2;
    int* CNT = (int*)(ws + WS_CTL); int* TOKES = (int*)(ws + WS_TOKES); float* TOKW = (float*)(ws + WS_TOKW); int* LIST = (int*)(ws + WS_LIST);
    const int tid = c.tid, lane = c.lane;
    __syncthreads();
    { const f32x4* src = (const f32x4*)(ws + WS_WRT);
      f32x4 wv[16];
#pragma unroll
      for (int i = 0; i < 16; ++i) wv[i] = src[tid + 512 * i];
#pragma unroll
      for (int i = 0; i < 16; ++i) ((LAS f32x4*)wT)[tid + 512 * i] = wv[i]; }
    __syncthreads();
    f32x4 gv[4];
#pragma unroll
    for (int j = 0; j < 4; ++j) gv[j] = ((const f32x4*)p.in[16])[lane + 64 * j];
    const float bias_e = p.in[18][(lane >> 1) & 31];
    for (int blk = c.bid; blk < M / 64; blk += c.G) {
        if (tid < 32) lcnt[tid] = 0;
        for (int pr = 0; pr < 4; ++pr) {
            const int tl = c.wave * 8 + pr * 2;
            const size_t tokA = (size_t)blk * 64 + tl;
            f32x4 hA[4], hB[4];
            {
                const f32x4* xa = (const f32x4*)(X1 + tokA * 1024) + lane; const f32x4* xb = xa + 256;
                float sa = 0.f, sb = 0.f;
#pragma unroll
                for (int j = 0; j < 4; ++j) { hA[j] = xa[64 * j]; hB[j] = xb[64 * j];
                    sa += (hA[j].x * hA[j].x + hA[j].y * hA[j].y) + (hA[j].z * hA[j].z + hA[j].w * hA[j].w);
                    sb += (hB[j].x * hB[j].x + hB[j].y * hB[j].y) + (hB[j].z * hB[j].z + hB[j].w * hB[j].w); }
                const float ra = rsqrtf(wave_sum(sa) * (1.f / 1024.f) + EPS), rb = rsqrtf(wave_sum(sb) * (1.f / 1024.f) + EPS);
                unsigned* oa = (unsigned*)(H2 + tokA * 1024) + lane; unsigned* ob = oa + 256;
#pragma unroll
                for (int j = 0; j < 4; ++j) { hA[j] = hA[j] * ra * gv[j]; hB[j] = hB[j] * rb * gv[j];
                    oa[64 * j] = pack4_fp8(8.f * hA[j].x, 8.f * hA[j].y, 8.f * hA[j].z, 8.f * hA[j].w);
                    ob[64 * j] = pack4_fp8(8.f * hB[j].x, 8.f * hB[j].y, 8.f * hB[j].z, 8.f * hB[j].w); }
            }
            float accA[32], accB[32];
#pragma unroll
            for (int e = 0; e < 32; ++e) {
                float a = 0.f, b = 0.f;
#pragma unroll
                for (int j = 0; j < 4; ++j) { const f32x4 w = *(const LAS f32x4*)&wT[e * 1024 + 256 * j + 4 * lane];
                    a = fmaf(hA[j].x, w.x, a); a = fmaf(hA[j].y, w.y, a); a = fmaf(hA[j].z, w.z, a); a = fmaf(hA[j].w, w.w, a);
                    b = fmaf(hB[j].x, w.x, b); b = fmaf(hB[j].y, w.y, b); b = fmaf(hB[j].z, w.z, b); b = fmaf(hB[j].w, w.w, b); }
                accA[e] = a; accB[e] = b;
                if (e & 1) __builtin_amdgcn_sched_barrier(0);
            }
#define RSTEP(N, BIT) _Pragma("unroll") for (int i = 0; i < N; ++i) { const bool up = (lane & BIT) != 0; \
                const float ka = up ? accA[N + i] : accA[i], sa_ = up ? accA[i] : accA[N + i]; accA[i] = ka + __shfl_xor(sa_, BIT); \
                const float kb = up ? accB[N + i] : accB[i], sb_ = up ? accB[i] : accB[N + i]; accB[i] = kb + __shfl_xor(sb_, BIT); }
            RSTEP(16, 32) RSTEP(8, 16) RSTEP(4, 8) RSTEP(2, 4) RSTEP(1, 2)
#undef RSTEP
            const float la = accA[0] + __shfl_xor(accA[0], 1) + bias_e, lb = accB[0] + __shfl_xor(accB[0], 1) + bias_e;
            const int my_e = (lane >> 1) & 31;
#pragma unroll
            for (int t2 = 0; t2 < 2; ++t2) {
                float val = t2 ? lb : la;
                int se[4]; float sv[4];
#pragma unroll
                for (int k = 0; k < 4; ++k) {
                    const float mx = wave_max(val);
                    const int sel = wave_min_i(val == mx ? my_e : 64);
                    se[k] = sel & 31; sv[k] = mx;
                    if (my_e == sel) val = -INFINITY;
                }
                const float e1 = __expf(sv[1] - sv[0]), e2 = __expf(sv[2] - sv[0]), e3 = __expf(sv[3] - sv[0]);
                const float inv = 1.f / (1.f + e1 + e2 + e3);
                if (lane == 0) {
                    const int t = tl + t2;
                    tokE[t * 4 + 0] = se[0]; tokE[t * 4 + 1] = se[1]; tokE[t * 4 + 2] = se[2]; tokE[t * 4 + 3] = se[3];
                    tokW[t * 4 + 0] = inv; tokW[t * 4 + 1] = e1 * inv; tokW[t * 4 + 2] = e2 * inv; tokW[t * 4 + 3] = e3 * inv;
                }
            }
        }
        __syncthreads();
        if (tid < 256) lrank[tid] = atomicAdd((int*)&lcnt[tokE[tid]], 1);
        __syncthreads();
        if (tid < 32) lbase[tid] = lcnt[tid] ? atomicAdd(&CNT[tid], lcnt[tid]) : 0;
        __syncthreads();
        if (tid < 256) {
            const int e = tokE[tid], slot = lbase[e] + lrank[tid], tok = blk * 64 + (tid >> 2);
            LIST[e * 16384 + slot] = tok; TOKES[tok * 4 + (tid & 3)] = (e << 16) | slot; TOKW[tok * 4 + (tid & 3)] = tokW[tid];
        }
        __syncthreads();
    }
}

__device__ __forceinline__ void load_offs(const Params& p, const Ctx& c, LAS int*& offs, LAS int*& cnt) {
    offs = (LAS int*)(c.lds + LDS_CTL); cnt = offs + 40;
    __syncthreads();
    if (c.tid == 0) {
        const int* CNT = (const int*)(p.ws + WS_CTL); int run = 0;
        for (int e = 0; e < 32; ++e) { const int n = __hip_atomic_load(CNT + e, __ATOMIC_RELAXED, __HIP_MEMORY_SCOPE_AGENT); cnt[e] = n; offs[e] = run; run += (n + 255) & ~255; }
        offs[32] = run;
    }
    __syncthreads();
    if (c.tid < 320) { int e = 0; while (e < 31 && c.tid * 256 >= offs[e + 1]) ++e; offs[80 + c.tid] = e; }
    __syncthreads();
}
__device__ __forceinline__ int find_expert(const LAS int* offs, int row) { int e = 0; while (e < 31 && row >= offs[e + 1]) ++e; return e; }

__device__ __forceinline__ void phase_gather(const Params& p, const Ctx& c) {
    LAS int* offs; LAS int* cnt; load_offs(p, c, offs, cnt);
    const bf16_t* H2 = (const bf16_t*)(p.ws + WS_H2); bf16_t* XB = (bf16_t*)(p.ws + WS_XB); const int* LIST = (const int*)(p.ws + WS_LIST);
    const int gw = c.bid * 8 + c.wave, NGW = c.G * 8, total = offs[32];
    for (int row0 = gw * 4; row0 < total; row0 += NGW * 4) {
        const int e = find_expert(offs, row0), slot0 = row0 - offs[e], n = cnt[e];
        int tok[4];
#pragma unroll
        for (int q = 0; q < 4; ++q) tok[q] = (slot0 + q < n) ? LIST[e * 16384 + slot0 + q] : -1;
        u32x4 v[4][2];
#pragma unroll
        for (int q = 0; q < 4; ++q) { v[q][0] = (u32x4){0u, 0u, 0u, 0u}; v[q][1] = v[q][0];
            if (tok[q] >= 0) { const u32x4* s = (const u32x4*)(H2 + (size_t)tok[q] * 1024); v[q][0] = s[c.lane]; v[q][1] = s[c.lane + 64]; } }
#pragma unroll
        for (int q = 0; q < 4; ++q) { u32x4* d = (u32x4*)(XB + (size_t)(row0 + q) * 1024); d[c.lane] = v[q][0]; d[c.lane + 64] = v[q][1]; }
    }
}

struct EpiAct { bf16_t* ACT; const float* b1; int j0;
    __device__ __forceinline__ void operator()(int r, int cl, float g, float u) const { const int j = j0 + cl;
        g = fminf(g + b1[j], 7.f); u = fminf(fmaxf(u + b1[1024 + j], -7.f), 7.f);
        ACT[(size_t)r * 1024 + j] = (bf16_t)f2bf(g * sigmoidf_(1.702f * g) * (u + 1.f)); } };
struct EpiY { bf16_t* YB; const float* b2; int n0;
    __device__ __forceinline__ void operator()(int r, int cl, float a, float) const { const int col = n0 + cl; YB[(size_t)r * 1024 + col] = (bf16_t)f2bf(a + b2[col]); } };
template <int WHICH> __device__ __forceinline__ void phase_moe_naive(const Params& p, const Ctx& c) {
    LAS int* offs; LAS int* cnt; load_offs(p, c, offs, cnt);
    unsigned char* ws = p.ws;
    const int nrt = offs[32] / 128;
    for (int it = c.bid; it < nrt * 16; it += c.G) {
        const int rt = it >> 4, ct = it & 15, row0 = rt * 128, e = find_expert(offs, row0);
        if (WHICH == 0) {
            const int j0 = ct * 64, nt = j0 >> 7, jj = j0 & 127;
            const bf16_t* Wg = (const bf16_t*)(ws + WS_W1T) + ((size_t)e * 2048 + nt * 256 + jj) * 1024;
            ngemm_tile<true>(ARowPlain{(const bf16_t*)(ws + WS_XB), 1024}, Wg, Wg + (size_t)128 * 1024, 1024, row0,
                             EpiAct{(bf16_t*)(ws + WS_ACT), p.in[20] + (size_t)e * 2048, j0}, (LAS float*)c.lds, c.tid);
        } else {
            const bf16_t* W = (const bf16_t*)(ws + WS_W2T) + ((size_t)e * 1024 + ct * 64) * 1024;
            ngemm_tile<false>(ARowPlain{(const bf16_t*)(ws + WS_ACT), 1024}, W, nullptr, 1024, row0,
                              EpiY{(bf16_t*)(ws + WS_YB), p.in[22] + (size_t)e * 1024, ct * 64}, (LAS float*)c.lds, c.tid);
        }
    }
}


__device__ __forceinline__ void phase_gemm1(const Params& p, const Ctx& c) {
    pg8::Gemm g{(const bf16_t*)(p.ws + WS_H), (const bf16_t*)(p.ws + WS_WINT), M, PDT, 1024};
    pg8::StaticOrder S; S.init(M, PDT, c.G, c.bid);
    pg8::EpiStore E{(bf16_t*)(p.ws + WS_P), NPROJ};
    pg8::gemm_phase<pg8::EpiStore, pg8::StaticOrder, true, true>(c.lds, g, S, E);
}
__device__ __forceinline__ void phase_tail12(const Params& p, const Ctx& c) {
    unsigned char* ws = p.ws;
    pg8::TailOrder S; S.so.init(M, 1024, c.G, c.bid);
    pg8::Gemm g{(const bf16_t*)(ws + WS_YZ), (const bf16_t*)(ws + WS_WST), 2 * M, 2048, 1024};
    pg8::EpiT12 E{(bf16_t*)(ws + WS_T1), (bf16_t*)(ws + WS_MG), (const bf16_t*)(ws + WS_P) + PG, NPROJ, (const float*)(ws + WS_RSTD)};
    pg8::gemm_phase<pg8::EpiT12, pg8::TailOrder, true, true>(c.lds, g, S, E);
}
__device__ __forceinline__ void phase_tail3(const Params& p, const Ctx& c) {
    unsigned char* ws = p.ws;
    pg8::StaticOrder S; S.init(M, 1024, c.G, c.bid);
    pg8::Gemm g{(const bf16_t*)(ws + WS_MG), (const bf16_t*)(ws + WS_WOT), M, 1024, 1024};
    pg8::EpiT3b E{(float*)(ws + WS_X1), p.in[0]};
    pg8::gemm_phase<pg8::EpiT3b, pg8::StaticOrder, true, true>(c.lds, g, S, E);
}
__device__ __forceinline__ void phase_moe1(const Params& p, const Ctx& c) {
    LAS int* offs; LAS int* cnt; load_offs(p, c, offs, cnt);
    unsigned char* ws = p.ws;
    pg8::Gemm g{(const bf16_t*)(ws + WS_H2), (const bf16_t*)(ws + WS_W1T), M, 32 * 2048, 512};
    pg8::MoeGatherOrder S{offs, cnt, offs + 80, (const int*)(ws + WS_LIST), c.G, c.bid, offs[32] / 256};
    pg8::EpiAct8 E{(unsigned char*)(ws + WS_ACT), p.in[20]};
    pg8::gemm_phase_gather_f8<pg8::EpiAct8, pg8::MoeGatherOrder>(c.lds, g, S, E);
}
__device__ __forceinline__ void phase_moe2(const Params& p, const Ctx& c) {
    LAS int* offs; LAS int* cnt; load_offs(p, c, offs, cnt);
    unsigned char* ws = p.ws;
    pg8::Gemm g{(const bf16_t*)(ws + WS_ACT), (const bf16_t*)(ws + WS_W2T), ROWS_MAX, 32 * 1024, 512};
    pg8::MoeOrder<4> S{offs + 80, c.G, c.bid, offs[32] / 256};
    pg8::EpiY8 E{(bf16_t*)(ws + WS_YB), p.in[22]};
    pg8::gemm_phase_f8<pg8::EpiY8, pg8::MoeOrder<4>, true, true>(c.lds, g, S, E);
}

__device__ __forceinline__ void phase_combine(const Params& p, const Ctx& c) {
    LAS int* offs; LAS int* cnt; load_offs(p, c, offs, cnt);
    unsigned char* ws = p.ws;
    const float* X1 = (const float*)(ws + WS_X1); const bf16_t* YB = (const bf16_t*)(ws + WS_YB);
    const int* TOKES = (const int*)(ws + WS_TOKES); const float* TOKW = (const float*)(ws + WS_TOKW);
    const int gw = c.bid * 8 + c.wave, NGW = c.G * 8, lane = c.lane;
    f32x4 gv[4];
#pragma unroll
    for (int j = 0; j < 4; ++j) gv[j] = ((const f32x4*)p.in[23])[lane + 64 * j];
    for (int m0 = gw * 2; m0 < M; m0 += NGW * 2) {
        int es[2][4]; float wq[2][4];
#pragma unroll
        for (int t = 0; t < 2; ++t)
#pragma unroll
            for (int k = 0; k < 4; ++k) { es[t][k] = TOKES[(m0 + t) * 4 + k]; wq[t][k] = TOKW[(m0 + t) * 4 + k]; }
        f32x4 v[2][4]; u32x2 y[2][4][4];
#pragma unroll
        for (int t = 0; t < 2; ++t) { const f32x4* xr = (const f32x4*)(X1 + (size_t)(m0 + t) * 1024) + lane;
#pragma unroll
            for (int j = 0; j < 4; ++j) v[t][j] = xr[64 * j];
#pragma unroll
            for (int k = 0; k < 4; ++k) { const int row = offs[es[t][k] >> 16] + (es[t][k] & 0xffff); const u32x2* yr = (const u32x2*)(YB + (size_t)row * 1024) + lane;
#pragma unroll
                for (int j = 0; j < 4; ++j) y[t][k][j] = yr[64 * j]; } }
#pragma unroll
        for (int t = 0; t < 2; ++t) {
#pragma unroll
            for (int k = 0; k < 4; ++k) { const float w = wq[t][k];
#pragma unroll
                for (int j = 0; j < 4; ++j) { const u32x2 yy = y[t][k][j];
                    v[t][j].x = fmaf(w, bflo(yy.x), v[t][j].x); v[t][j].y = fmaf(w, bfhi(yy.x), v[t][j].y); v[t][j].z = fmaf(w, bflo(yy.y), v[t][j].z); v[t][j].w = fmaf(w, bfhi(yy.y), v[t][j].w); } }
            float s = 0.f;
#pragma unroll
            for (int j = 0; j < 4; ++j) s += (v[t][j].x * v[t][j].x + v[t][j].y * v[t][j].y) + (v[t][j].z * v[t][j].z + v[t][j].w * v[t][j].w);
            const float rstd = rsqrtf(wave_sum(s) * (1.f / 1024.f) + EPS);
            f32x4* o = (f32x4*)(p.out + (size_t)(m0 + t) * 1024) + lane;
#pragma unroll
            for (int j = 0; j < 4; ++j) o[64 * j] = v[t][j] * rstd * gv[j];
        }
    }
}

#define XB_TMO      128
#define XB_XCNT(j)  (256  + 64 * (j))
#define XB_XSUB(j)  (1280 + 64 * (j))
#define XB_XGEN(j)  (2304 + 64 * (j))
#define XB_TOP      3328
#define XB_TOPGEN   3392
#define XCD_BAR_WORDS 3456
#define XB_SPIN_CAP (1u << 18)

__device__ __forceinline__ unsigned xb_ld(unsigned* p)              { return __hip_atomic_load(p, __ATOMIC_RELAXED, __HIP_MEMORY_SCOPE_AGENT); }
__device__ __forceinline__ unsigned xb_add(unsigned* p, unsigned v) { return __hip_atomic_fetch_add(p, v, __ATOMIC_RELAXED, __HIP_MEMORY_SCOPE_AGENT); }
__device__ __forceinline__ unsigned xb_xcc_id() { return (unsigned)__builtin_amdgcn_s_getreg((3 << 11) | 20) & 0xFu; }
#define XB_SPIN(cond, bar) do { unsigned _sp = 0; while (cond) { __builtin_amdgcn_s_sleep(1); \
    if ((++_sp & 255u) == 0u) { if (xb_ld(&(bar)[XB_TMO])) break; if (_sp > XB_SPIN_CAP) { atomicAdd(&(bar)[XB_TMO], 1u); break; } } } } while (0)

struct XcdBarrier {
    unsigned* bar; unsigned x;
    volatile LAS unsigned* st;
};

__device__ __forceinline__ XcdBarrier xcd_barrier_post(unsigned* bar, volatile LAS unsigned* st) {
    XcdBarrier b; b.bar = bar; b.x = xb_xcc_id(); b.st = st;
    if (threadIdx.x == 0) (void)xb_add(&bar[XB_XCNT(b.x)], 1u);
    return b;
}
__device__ __forceinline__ void xcd_barrier_complete(unsigned* bar, unsigned x, unsigned& nloc, unsigned& nx) {
    const unsigned G = gridDim.x * gridDim.y * gridDim.z;
    unsigned sum, cnt, mine, sp = 0u;
    for (;;) {
        sum = 0u; cnt = 0u; mine = 0u;
#pragma unroll
        for (unsigned j = 0; j < 16; ++j) { const unsigned c = xb_ld(&bar[XB_XCNT(j)]); sum += c; cnt += (c > 0u) ? 1u : 0u; mine = (j == x) ? c : mine; }
        if (sum == G) break;
        __builtin_amdgcn_s_sleep(1);
        if ((++sp & 255u) == 0u) { if (xb_ld(&bar[XB_TMO])) break; if (sp > XB_SPIN_CAP) { atomicAdd(&bar[XB_TMO], 1u); break; } }
    }
    nloc = mine > 0u ? mine : 1u; nx = cnt > 0u ? cnt : 1u;
}

__device__ __forceinline__ void xcd_barrier(const XcdBarrier& b) {
    asm volatile("s_waitcnt vmcnt(0)" ::: "memory");
    __syncthreads();
    if (threadIdx.x == 0) {
        unsigned* bar = b.bar;
        __builtin_amdgcn_s_waitcnt(0);
        unsigned nloc = b.st[0], nx = b.st[1];
        if (nloc == 0u) { xcd_barrier_complete(bar, b.x, nloc, nx); b.st[0] = nloc; b.st[1] = nx; }
        const unsigned old = xb_add(&bar[XB_XSUB(b.x)], 1u);
        const unsigned gen = old / nloc;
        if (old + 1u == (gen + 1u) * nloc) {
            __builtin_amdgcn_fence(__ATOMIC_RELEASE, "agent");
            asm volatile("s_waitcnt vmcnt(0)" ::: "memory");
            const unsigned og = xb_add(&bar[XB_TOP], 1u);
            const unsigned tg = og / nx;
            if (og + 1u == (tg + 1u) * nx) xb_add(&bar[XB_TOPGEN], 1u);
            else XB_SPIN(xb_ld(&bar[XB_TOPGEN]) == tg, bar);
            __builtin_amdgcn_fence(__ATOMIC_ACQUIRE, "agent");
            xb_add(&bar[XB_XGEN(b.x)], 1u);
            asm volatile("s_waitcnt vmcnt(0)" ::: "memory");
        } else {
            XB_SPIN(xb_ld(&bar[XB_XGEN(b.x)]) == gen, bar);
            __builtin_amdgcn_fence(__ATOMIC_ACQUIRE, "agent");
            asm volatile("s_waitcnt vmcnt(0)" ::: "memory");
        }
    }
    __syncthreads();
}

constexpr int NPHASE = 13;
__global__ void __launch_bounds__(512) mega(Params p) {
    extern __shared__ __attribute__((aligned(16))) unsigned char lds_raw[];
    Ctx c; c.tid = threadIdx.x; c.lane = c.tid & 63; c.wave = __builtin_amdgcn_readfirstlane(c.tid >> 6); c.bid = blockIdx.x; c.G = gridDim.x;
    c.lds = (LAS unsigned char*)lds_raw;
    cg::grid_group grid = cg::this_grid();
    if (c.tid < 2) ((volatile LAS unsigned*)(c.lds + LDS_BARST))[c.tid] = 0u;
    __syncthreads();
#define SEAM(k) do { XcdBarrier b_; b_.bar = (unsigned*)(p.ws + WS_BAR); b_.x = xb_xcc_id(); b_.st = (volatile LAS unsigned*)(c.lds + LDS_BARST); xcd_barrier(b_); } while (0)
    if (p.ph_lo < 0) grid.sync();
    (void)xcd_barrier_post((unsigned*)(p.ws + WS_BAR), (volatile LAS unsigned*)(c.lds + LDS_BARST));
#define RUN(k, call) if (p.ph_lo <= (k) && (k) < p.ph_hi) { call; if ((k) + 1 < p.ph_hi) SEAM(k); }
    RUN(0, phase_prep(p, c))
    RUN(1, phase_gemm1(p, c))
    RUN(2, phase_conv(p, c))
    RUN(3, phase_ssd_states(p, c))
    RUN(4, phase_ssd_scan(p, c))
    RUN(5, phase_ssd_out(p, c))
    RUN(6, phase_rstd(p, c); phase_attn(p, c, (char*)lds_raw))
    RUN(7, phase_tail12(p, c))
    RUN(8, phase_tail3(p, c))
    RUN(9, phase_router(p, c))
    RUN(10, phase_moe1(p, c))
    RUN(11, phase_moe2(p, c))
    RUN(12, phase_combine(p, c))
#undef RUN
}

extern "C" void kernel_launch(void* const* d_in, const int* in_sizes, int n_in, void* d_out, int out_size, void* d_ws, size_t ws_size, hipStream_t stream) {
    static int ok = 0; static int grid_blocks = 0;
    if (ok == 0) {
        if (n_in != 24 || out_size != M * D || ws_size < WS_END) { fprintf(stderr, "kernel_launch: unexpected shapes: n_in %d out %d ws %zu (need %zu)\n", n_in, out_size, ws_size, (size_t)WS_END); ok = -1; return; }
        if (hipFuncSetAttribute((const void*)mega, hipFuncAttributeMaxDynamicSharedMemorySize, LDS_BYTES) != hipSuccess) { fprintf(stderr, "kernel_launch: hipFuncSetAttribute failed\n"); ok = -1; return; }
        int dev = 0, cus = 0, per_cu = 0;
        hipGetDevice(&dev);
        hipDeviceGetAttribute(&cus, hipDeviceAttributeMultiprocessorCount, dev);
        hipOccupancyMaxActiveBlocksPerMultiprocessor(&per_cu, (const void*)mega, 512, LDS_BYTES);
        if (per_cu < 1 || cus < 1) { fprintf(stderr, "kernel_launch: occupancy query gave %d blocks/CU on %d CUs\n", per_cu, cus); ok = -1; return; }
        grid_blocks = cus;
        ok = 1;
    }
    if (ok < 0) return;
    Params p{};
    for (int i = 0; i < 24; ++i) p.in[i] = (const float*)d_in[i];
    p.out = (float*)d_out; p.ws = (unsigned char*)d_ws;
    p.ph_lo = 0; p.ph_hi = NPHASE;
    if (hipMemsetAsync((char*)d_ws + WS_BAR, 0, 16384, stream) != hipSuccess) { fprintf(stderr, "kernel_launch: hipMemsetAsync of the barrier words failed\n"); return; }
    void* args[] = {&p};
    hipError_t e = hipLaunchCooperativeKernel((const void*)mega, dim3(grid_blocks), dim3(512), args, LDS_BYTES, stream);
    if (e != hipSuccess) fprintf(stderr, "kernel_launch: cooperative launch failed: %s (grid %d)\n", hipGetErrorString(e), grid_blocks);
}
```

```cpp
#include <hip/hip_runtime.h>
#include <hip/hip_cooperative_groups.h>
#include <cstdio>
#include <cstdint>

namespace cg = cooperative_groups;
#define LAS __attribute__((address_space(3)))
typedef unsigned short bf16_t;
typedef unsigned u32x4 __attribute__((ext_vector_type(4)));
typedef unsigned u32x2 __attribute__((ext_vector_type(2)));
typedef float f32x4 __attribute__((ext_vector_type(4)));

constexpr int NB = 2, S = 8192, D = 1024, M = NB * S;
constexpr int NPROJ = 6400;
constexpr int PZ = 0, PXBC = 1024, PQ = 2560, PK = 3584, PV = 3840, PG = 4096, PDT = 6144;
constexpr int ROWS_MAX = 65536 + 32 * 256;
constexpr float EPS = 1e-6f;

constexpr size_t al256(size_t x) { return (x + 255) / 256 * 256; }
constexpr size_t WS_CTL = 0;
constexpr size_t WS_BAR = 4096;
constexpr size_t WS_ROPE = 4096 + 16384;
constexpr size_t WS_WRT = WS_ROPE + 32768;
constexpr size_t WS_WINT = WS_WRT + 131072;
constexpr size_t WS_WST = WS_WINT + (size_t)NPROJ * 1024 * 2;
constexpr size_t WS_WAT = WS_WST + 2097152;
constexpr size_t WS_WOT = WS_WAT + 2097152;
constexpr size_t WS_W1T = WS_WOT + 2097152;
constexpr size_t WS_W2T = WS_W1T + (size_t)32 * 2048 * 1024 * 2;
constexpr size_t WS_X1 = WS_W2T + (size_t)32 * 1024 * 1024 * 2;
constexpr size_t WS_H2 = WS_X1 + (size_t)M * 1024 * 4;
constexpr size_t WS_TOKES = WS_H2 + (size_t)M * 1024 * 2;
constexpr size_t WS_TOKW = WS_TOKES + (size_t)M * 16;
constexpr size_t WS_LIST = WS_TOKW + (size_t)M * 16;
constexpr size_t WS_R = WS_LIST + (size_t)32 * 16384 * 4;
constexpr size_t WS_H = WS_R;
constexpr size_t WS_P = WS_H + (size_t)M * 1024 * 2;
constexpr size_t WS_XT = WS_P + (size_t)M * NPROJ * 2;
constexpr size_t WS_BMR = WS_XT + (size_t)M * 1024 * 2;
constexpr size_t WS_BMT = WS_BMR + (size_t)M * 256 * 2;
constexpr size_t WS_CMR = WS_BMT + (size_t)M * 256 * 2;
constexpr size_t WS_DT = WS_CMR + (size_t)M * 256 * 2;
constexpr size_t WS_ACS = WS_DT + (size_t)2 * M * 16 * 4;
constexpr size_t WS_CDEC = WS_ACS + (size_t)2 * M * 16 * 4;
constexpr size_t WS_ST = WS_CDEC + 16384;
constexpr size_t WS_PREV = WS_ST + (size_t)2 * 2 * 64 * 16 * 8192 * 4;
constexpr size_t WS_YZ = WS_PREV + (size_t)2 * 2 * 64 * 16 * 8192 * 2;
constexpr size_t WS_AO = WS_YZ + (size_t)M * 1024 * 2;
constexpr size_t WS_RSTD = WS_AO + (size_t)M * 1024 * 2;
constexpr size_t WS_QN = WS_RSTD + (size_t)M * 4;
constexpr size_t WS_KN = WS_QN + (size_t)M * 1024 * 2;
constexpr size_t WS_VB = WS_KN + (size_t)M * 256 * 2;
constexpr size_t WS_T1 = WS_VB + (size_t)M * 256 * 2;
constexpr size_t WS_MG = WS_T1 + (size_t)M * 1024 * 2;
constexpr size_t WS_END = WS_MG + (size_t)M * 1024 * 2;
constexpr size_t WS_XB = WS_R;
constexpr size_t WS_ACT = WS_XB + (size_t)ROWS_MAX * 1024 * 2;
constexpr size_t WS_YB = WS_XB;
static_assert(WS_ACT + (size_t)ROWS_MAX * 1024 * 2 <= WS_END, "moe overlay");
static_assert(WS_END <= (size_t)1073741824, "workspace");
static_assert(WS_WAT == WS_WST + 2097152 && WS_AO == WS_YZ + (size_t)M * 2048, "concatenated operands of the merged branch GEMMs");

constexpr int LDS_BYTES = 147712;
constexpr int LDS_BARST = 147456;
constexpr int LDS_CTL = 143360;

struct Params {
    const float* in[24];
    float* out;
    unsigned char* ws;
    int ph_lo, ph_hi;
};

__device__ __forceinline__ float bf2f(bf16_t v) { return __uint_as_float((unsigned)v << 16); }
__device__ __forceinline__ float bflo(unsigned w) { return __uint_as_float(w << 16); }
__device__ __forceinline__ float bfhi(unsigned w) { return __uint_as_float(w & 0xffff0000u); }
__device__ __forceinline__ unsigned f2bf(float f) { unsigned u = __float_as_uint(f); return (u + 0x7fffu + ((u >> 16) & 1u)) >> 16; }
__device__ __forceinline__ unsigned pk2(float lo, float hi) { return f2bf(lo) | (f2bf(hi) << 16); }
__device__ __forceinline__ float wave_sum(float v) {
#pragma unroll
    for (int o = 1; o < 64; o <<= 1) v += __shfl_xor(v, o);
    return v;
}
__device__ __forceinline__ float wave_max(float v) {
#pragma unroll
    for (int o = 1; o < 64; o <<= 1) v = fmaxf(v, __shfl_xor(v, o));
    return v;
}
__device__ __forceinline__ int wave_min_i(int v) {
#pragma unroll
    for (int o = 1; o < 64; o <<= 1) { int t = __shfl_xor(v, o); v = t < v ? t : v; }
    return v;
}
__device__ __forceinline__ float sigmoidf_(float x) { return 1.f / (1.f + __expf(-x)); }
__device__ __forceinline__ unsigned pack4_fp8(float a, float b, float c, float d) { unsigned w = __builtin_amdgcn_cvt_pk_fp8_f32(a, b, 0u, false); return __builtin_amdgcn_cvt_pk_fp8_f32(c, d, w, true); }
#define LDS_WAIT() asm volatile("s_waitcnt lgkmcnt(0)" ::: "memory")

struct Ctx { int tid, lane, wave, bid, G; LAS unsigned char* lds; };

struct TItem { const float* W; bf16_t* WT; const float* kscale; int N, k0, n0, orow0; };
__device__ __forceinline__ void transpose_load(const TItem& t, f32x4 (&v)[8], int lane) {
    const int nq = lane & 7, kg = lane >> 3;
    const float* s = t.W + (size_t)(t.k0 + 8 * kg) * t.N + t.n0 + 4 * nq;
#pragma unroll
    for (int i = 0; i < 8; ++i) v[i] = *(const f32x4*)(s + (size_t)i * t.N);
}
__device__ __forceinline__ void transpose_store(const TItem& t, f32x4 (&v)[8], int lane) {
    const int nq = lane & 7, kg = lane >> 3;
    if (t.kscale) {
#pragma unroll
        for (int i = 0; i < 8; ++i) v[i] = v[i] * t.kscale[t.k0 + 8 * kg + i];
    }
    bf16_t* d = t.WT + (size_t)(t.orow0 + 4 * nq) * 1024 + t.k0 + 8 * kg;
#pragma unroll
    for (int j = 0; j < 4; ++j) { u32x4 o; o.x = pk2(v[0][j], v[1][j]); o.y = pk2(v[2][j], v[3][j]); o.z = pk2(v[4][j], v[5][j]); o.w = pk2(v[6][j], v[7][j]);
        *(u32x4*)(d + (size_t)j * 1024) = o; }
}
constexpr int PREP_I_IN = 16 * 193, PREP_I_SQ = 512, PREP_NITEMS = PREP_I_IN + 3 * PREP_I_SQ;
__device__ __forceinline__ TItem prep_item(const Params& p, int r) {
    unsigned char* ws = p.ws; TItem t; t.kscale = nullptr;
    if (r < PREP_I_IN) { const int kb = r / 193, nb = r % 193, n0 = nb * 32;
        t.W = p.in[2]; t.WT = (bf16_t*)(ws + WS_WINT); t.N = 6176; t.k0 = kb * 64; t.n0 = n0; t.orow0 = n0 < 2560 ? n0 : (n0 < 2592 ? PDT + (n0 - 2560) : n0 - 32); return t; }
    r -= PREP_I_IN;
    { const int which = r / PREP_I_SQ, q = r % PREP_I_SQ;
        t.W = which == 0 ? p.in[13] : (which == 1 ? p.in[14] : p.in[15]); t.WT = (bf16_t*)(ws + (which == 0 ? WS_WST : (which == 1 ? WS_WAT : WS_WOT)));
        t.kscale = which == 0 ? p.in[10] : nullptr; t.N = 1024; t.k0 = (q / 32) * 64; t.n0 = (q % 32) * 32; t.orow0 = t.n0; return t; }
}
constexpr int PREP8_TILES = 32 * 64 + 32 * 32;
struct T8 { const float* W; unsigned char* WT; int N, k0, n0; bool w1; };
__device__ __forceinline__ T8 prep8_tile(const Params& p, int t) {
    T8 r;
    if (t < 2048) { const int e = t >> 6; r.W = p.in[19] + (size_t)e * 1024 * 2048; r.WT = p.ws + WS_W1T + (size_t)e * 2048 * 1024; r.N = 2048; r.k0 = ((t >> 3) & 7) * 128; r.n0 = (t & 7) * 256; r.w1 = true; }
    else { t -= 2048; const int e = t >> 5; r.W = p.in[21] + (size_t)e * 1024 * 1024; r.WT = p.ws + WS_W2T + (size_t)e * 1024 * 1024; r.N = 1024; r.k0 = ((t >> 2) & 7) * 128; r.n0 = (t & 3) * 256; r.w1 = false; }
    return r;
}
__device__ __forceinline__ void prep8_load(const T8& t, f32x4 (&v)[16], int wave, int lane) {
    const float* s = t.W + (size_t)(t.k0 + 16 * wave) * t.N + t.n0 + 4 * lane;
#pragma unroll
    for (int i = 0; i < 16; ++i) v[i] = *(const f32x4*)(s + (size_t)i * t.N);
}
__device__ __forceinline__ void phase_prep8(const Params& p, const Ctx& c) {
    f32x4 v[16];
    int t = c.bid;
    if (t < PREP8_TILES) { const T8 t0 = prep8_tile(p, t); prep8_load(t0, v, c.wave, c.lane); }
    for (int i = 0; t < PREP8_TILES; ++i, t += c.G) {
        const T8 cur = prep8_tile(p, t);
        LAS unsigned char* img = c.lds + (i & 1) * 32768;
#pragma unroll
        for (int j = 0; j < 4; ++j) { u32x4 o;
            o.x = pack4_fp8(64.f * v[0][j], 64.f * v[1][j], 64.f * v[2][j], 64.f * v[3][j]); o.y = pack4_fp8(64.f * v[4][j], 64.f * v[5][j], 64.f * v[6][j], 64.f * v[7][j]);
            o.z = pack4_fp8(64.f * v[8][j], 64.f * v[9][j], 64.f * v[10][j], 64.f * v[11][j]); o.w = pack4_fp8(64.f * v[12][j], 64.f * v[13][j], 64.f * v[14][j], 64.f * v[15][j]);
            *(LAS u32x4*)(img + (4 * c.lane + j) * 128 + 16 * c.wave) = o; }
        if (t + c.G < PREP8_TILES) { const T8 nx = prep8_tile(p, t + c.G); prep8_load(nx, v, c.wave, c.lane); }
        __syncthreads();
#pragma unroll
        for (int q = 0; q < 4; ++q) { const int idx = c.tid + 512 * q, nl = idx >> 3, cw = idx & 7, n = cur.n0 + nl;
            const int orow = cur.w1 ? (((n & 1023) >> 7) * 256 + (n >> 10) * 128 + (n & 127)) : n;
            *(u32x4*)(cur.WT + (size_t)orow * 1024 + cur.k0 + 16 * cw) = *(const LAS u32x4*)(img + nl * 128 + 16 * cw); }
    }
    __syncthreads();
}

__device__ __forceinline__ void phase_prep(const Params& p, const Ctx& c) {
    unsigned char* ws = p.ws;
    const int gw = c.bid * 8 + c.wave, NGW = c.G * 8;
    for (int it = gw; it < PREP_NITEMS; it += 2 * NGW) {
        const TItem ta = prep_item(p, it); f32x4 va[8], vb[8];
        transpose_load(ta, va, c.lane);
        const bool two = it + NGW < PREP_NITEMS;
        const TItem tb = prep_item(p, two ? it + NGW : it);
        if (two) transpose_load(tb, vb, c.lane);
        transpose_store(ta, va, c.lane);
        if (two) transpose_store(tb, vb, c.lane);
    }
    phase_prep8(p, c);
    for (int r = 6176 + gw; r < NPROJ; r += NGW) {
        u32x4* o = (u32x4*)((bf16_t*)(ws + WS_WINT) + (size_t)r * 1024);
        o[c.lane] = (u32x4){0u, 0u, 0u, 0u}; o[c.lane + 64] = (u32x4){0u, 0u, 0u, 0u};
    }
    {
        const float* x = p.in[0]; const float* g = p.in[1]; bf16_t* H = (bf16_t*)(ws + WS_H);
        f32x4 gv[4];
#pragma unroll
        for (int j = 0; j < 4; ++j) gv[j] = ((const f32x4*)g)[c.lane + 64 * j];
        for (int m = gw; m < M; m += NGW) {
            const f32x4* xr = (const f32x4*)(x + (size_t)m * D) + c.lane;
            f32x4 v[4]; float s = 0.f;
#pragma unroll
            for (int j = 0; j < 4; ++j) { v[j] = xr[64 * j]; s += (v[j].x * v[j].x + v[j].y * v[j].y) + (v[j].z * v[j].z + v[j].w * v[j].w); }
            const float rstd = rsqrtf(wave_sum(s) * (1.f / D) + EPS);
            u32x2* o = (u32x2*)(H + (size_t)m * D) + c.lane;
#pragma unroll
            for (int j = 0; j < 4; ++j) { u32x2 w; w.x = pk2(v[j].x * rstd * gv[j].x, v[j].y * rstd * gv[j].y); w.y = pk2(v[j].z * rstd * gv[j].z, v[j].w * rstd * gv[j].w); o[64 * j] = w; }
        }
    }
    {
        float* rc = (float*)(ws + WS_ROPE); float* rs = rc + 4096;
        for (int idx = c.bid * 512 + c.tid; idx < 4096; idx += c.G * 512) {
            const int pos = idx >> 5, i = idx & 31;
            const float inv = exp2f(-(float)i * (13.287712379549449f / 32.f));
            float rev = (float)pos * inv * 0.15915494309189535f; rev -= floorf(rev);
            rc[idx] = __builtin_amdgcn_cosf(rev); rs[idx] = __builtin_amdgcn_sinf(rev);
        }
        float* wrt = (float*)(ws + WS_WRT); const float* wr = p.in[17];
        for (int idx = c.bid * 512 + c.tid; idx < 32768; idx += c.G * 512) { const int k = idx >> 5, e = idx & 31; wrt[e * 1024 + k] = wr[idx]; }
        if (c.bid == 0 && c.tid < 64) ((int*)(ws + WS_CTL))[c.tid] = 0;
    }
}

template <bool DUAL, class ARow, class Epi>
__device__ __forceinline__ void ngemm_tile(const ARow& arow, const bf16_t* Bt, const bf16_t* Bt2, int K, int m0, const Epi& epi, LAS float* lds, int tid) {
    LAS float* As = lds;
    LAS float* Bs = lds + 32 * 132;
    LAS float* Bs2 = Bs + 32 * 68;
    float acc[4][4], acc2[4][4];
#pragma unroll
    for (int i = 0; i < 4; ++i)
#pragma unroll
        for (int j = 0; j < 4; ++j) { acc[i][j] = 0.f; acc2[i][j] = 0.f; }
    const int tm = tid & 31, tn = tid >> 5;
    const int sr = tid >> 2, kq = (tid & 3) * 8;
    const bf16_t* ap = arow(m0 + sr) + kq;
    const bf16_t* bp = Bt + (size_t)(sr & 63) * K + kq;
    const bf16_t* bp2 = DUAL ? Bt2 + (size_t)(sr & 63) * K + kq : nullptr;
    for (int k0 = 0; k0 < K; k0 += 32) {
        {
            const u32x4 v = *(const u32x4*)(ap + k0);
            As[(kq + 0) * 132 + sr] = bflo(v.x); As[(kq + 1) * 132 + sr] = bfhi(v.x); As[(kq + 2) * 132 + sr] = bflo(v.y); As[(kq + 3) * 132 + sr] = bfhi(v.y);
            As[(kq + 4) * 132 + sr] = bflo(v.z); As[(kq + 5) * 132 + sr] = bfhi(v.z); As[(kq + 6) * 132 + sr] = bflo(v.w); As[(kq + 7) * 132 + sr] = bfhi(v.w);
        }
        if (tid < 256) {
            const u32x4 v = *(const u32x4*)(bp + k0);
            Bs[(kq + 0) * 68 + sr] = bflo(v.x); Bs[(kq + 1) * 68 + sr] = bfhi(v.x); Bs[(kq + 2) * 68 + sr] = bflo(v.y); Bs[(kq + 3) * 68 + sr] = bfhi(v.y);
            Bs[(kq + 4) * 68 + sr] = bflo(v.z); Bs[(kq + 5) * 68 + sr] = bfhi(v.z); Bs[(kq + 6) * 68 + sr] = bflo(v.w); Bs[(kq + 7) * 68 + sr] = bfhi(v.w);
        } else if (DUAL) {
            const int r2 = sr & 63;
            const u32x4 v = *(const u32x4*)(bp2 + k0);
            Bs2[(kq + 0) * 68 + r2] = bflo(v.x); Bs2[(kq + 1) * 68 + r2] = bfhi(v.x); Bs2[(kq + 2) * 68 + r2] = bflo(v.y); Bs2[(kq + 3) * 68 + r2] = bfhi(v.y);
            Bs2[(kq + 4) * 68 + r2] = bflo(v.z); Bs2[(kq + 5) * 68 + r2] = bfhi(v.z); Bs2[(kq + 6) * 68 + r2] = bflo(v.w); Bs2[(kq + 7) * 68 + r2] = bfhi(v.w);
        }
        __syncthreads();
#pragma unroll 8
        for (int k = 0; k < 32; ++k) {
            const f32x4 a = *(const LAS f32x4*)&As[k * 132 + tm * 4];
            const f32x4 b = *(const LAS f32x4*)&Bs[k * 68 + tn * 4];
#pragma unroll
            for (int i = 0; i < 4; ++i)
#pragma unroll
                for (int j = 0; j < 4; ++j) acc[i][j] = fmaf(a[i], b[j], acc[i][j]);
            if (DUAL) {
                const f32x4 b2 = *(const LAS f32x4*)&Bs2[k * 68 + tn * 4];
#pragma unroll
                for (int i = 0; i < 4; ++i)
#pragma unroll
                    for (int j = 0; j < 4; ++j) acc2[i][j] = fmaf(a[i], b2[j], acc2[i][j]);
            }
        }
        __syncthreads();
    }
#pragma unroll
    for (int i = 0; i < 4; ++i)
#pragma unroll
        for (int j = 0; j < 4; ++j) epi(m0 + tm * 4 + i, tn * 4 + j, acc[i][j], acc2[i][j]);
}
struct ARowPlain { const bf16_t* A; int lda; __device__ __forceinline__ const bf16_t* operator()(int m) const { return A + (size_t)m * lda; } };

namespace pg8 {
#define PG8_LAS __attribute__((address_space(3)))
typedef unsigned short bf16_t;
typedef short bf16x8 __attribute__((ext_vector_type(8)));
typedef float f32x4 __attribute__((ext_vector_type(4)));
typedef unsigned u32x4 __attribute__((ext_vector_type(4)));
constexpr int BM = 256, BK = 64, HALF = 128, HTB = HALF * BK * 2  , STAGE_BYTES = 8 * HTB, NXCD = 8, WGM = 8;

__host__ __device__ __forceinline__ int lds_byte(int r, int c) { const int st = (r >> 4) * 2 + (c >> 5), rr = r & 15, cc = c & 31, ob = rr * 64 + cc * 2; return st * 1024 + (ob ^ (((ob >> 9) & 1) << 5)); }
__host__ __device__ __forceinline__ void stage_rc(int b, int& R, int& C) { const int st = b / 1024, sb = b % 1024, swz = sb ^ (((sb >> 9) & 1) << 5); R = (st >> 1) * 16 + swz / 64; C = (st & 1) * 32 + (swz % 64) / 2; }
__host__ __device__ __forceinline__ int perm32(int rho) { const int n = rho >> 4, i = rho & 15; return 8 * (i >> 2) + 4 * n + (i & 3); }

struct Unit { int pm, pn; };
struct Gemm { const bf16_t* A; const bf16_t* Bt; int M, N, K; };

struct StaticOrder {
    int nM, nN, nwg, G, c;
    __host__ __device__ void init(int M, int N, int G_, int c_) { nM = M / BM; nN = N / BM; nwg = nM * nN; G = G_; c = c_; }
    __host__ __device__ bool next(int i, Unit& u) const {
        const long L = (long)i * G + c; if (L >= nwg) return false;
        int wgid = (int)L; { const int q = nwg / NXCD, r = nwg % NXCD, xcd = wgid % NXCD, off = wgid / NXCD; wgid = (xcd < r ? xcd * (q + 1) : r * (q + 1) + (xcd - r) * q) + off; }
        const int nig = WGM * nN, gid = wgid / nig, fm = gid * WGM, gsz = (nM - fm) < WGM ? (nM - fm) : WGM;
        u.pm = fm + ((wgid % nig) % gsz); u.pn = (wgid % nig) / gsz; return true;
    }
    __device__ __forceinline__ void a_ready(const Unit&) const {}
    __device__ __forceinline__ void done(const Unit&) const {}
};


__device__ __forceinline__ unsigned cvt_pk_bf16(float lo, float hi) { unsigned r; asm volatile("v_cvt_pk_bf16_f32 %0, %1, %2" : "=v"(r) : "v"(lo), "v"(hi)); return r; }
__device__ __forceinline__ float sig_(float x) { return __builtin_amdgcn_rcpf(1.f + __builtin_amdgcn_exp2f(-1.4426950408889634f * x)); }
__device__ __forceinline__ u32x4 pack8(const f32x4& v0, const f32x4& v1) { u32x4 w; w.x = cvt_pk_bf16(v0[0], v0[1]); w.y = cvt_pk_bf16(v0[2], v0[3]); w.z = cvt_pk_bf16(v1[0], v1[1]); w.w = cvt_pk_bf16(v1[2], v1[3]); return w; }
__device__ __forceinline__ void unpack8(const u32x4& w, f32x4& v0, f32x4& v1) {
    v0[0] = __uint_as_float(w.x << 16); v0[1] = __uint_as_float(w.x & 0xffff0000u); v0[2] = __uint_as_float(w.y << 16); v0[3] = __uint_as_float(w.y & 0xffff0000u);
    v1[0] = __uint_as_float(w.z << 16); v1[1] = __uint_as_float(w.z & 0xffff0000u); v1[2] = __uint_as_float(w.w << 16); v1[3] = __uint_as_float(w.w & 0xffff0000u); }
struct EpiStore {
    static constexpr bool PERM = true, AFTER_DRAIN = false;
    bf16_t* O; int ldc;
    __device__ __forceinline__ void operator()(const f32x4 (&acc)[2][2][4][2], const Unit& u, int wr, int wc, int fr, int fq) const {
        const int row0 = u.pm * BM + wr * 64 + fr, col0 = u.pn * BM + wc * 32 + 8 * fq;
#pragma unroll
        for (int ai = 0; ai < 2; ++ai)
#pragma unroll
            for (int m = 0; m < 4; ++m) { bf16_t* rowp = O + (size_t)(row0 + ai * HALF + m * 16) * ldc + col0;
#pragma unroll
                for (int bj = 0; bj < 2; ++bj) *(u32x4*)(rowp + bj * HALF) = pack8(acc[ai][bj][m][0], acc[ai][bj][m][1]); }
    }
};
struct EpiT1 {
    static constexpr bool PERM = true, AFTER_DRAIN = false;
    bf16_t* T1; const bf16_t* G; int ldg; const float* RSTD;
    __device__ __forceinline__ void operator()(const f32x4 (&acc)[2][2][4][2], const Unit& u, int wr, int wc, int fr, int fq) const {
        const int row0 = u.pm * BM + wr * 64 + fr, col0 = u.pn * BM + wc * 32 + 8 * fq;
#pragma unroll
        for (int ai = 0; ai < 2; ++ai)
#pragma unroll
            for (int m = 0; m < 4; ++m) { const int row = row0 + ai * HALF + m * 16; const float rs = RSTD[row];
#pragma unroll
                for (int bj = 0; bj < 2; ++bj) { const int col = col0 + bj * HALF;
                    f32x4 g0, g1; unpack8(*(const u32x4*)(G + (size_t)row * ldg + col), g0, g1);
                    f32x4 v0 = acc[ai][bj][m][0] * rs, v1 = acc[ai][bj][m][1] * rs;
#pragma unroll
                    for (int i = 0; i < 4; ++i) { v0[i] *= sig_(g0[i]); v1[i] *= sig_(g1[i]); }
                    *(u32x4*)(T1 + (size_t)row * 1024 + col) = pack8(v0, v1); } }
    }
};
struct EpiT2 {
    static constexpr bool PERM = true, AFTER_DRAIN = false;
    bf16_t* MG; const bf16_t* T1; const bf16_t* G; int ldg;
    __device__ __forceinline__ void operator()(const f32x4 (&acc)[2][2][4][2], const Unit& u, int wr, int wc, int fr, int fq) const {
        const int row0 = u.pm * BM + wr * 64 + fr, col0 = u.pn * BM + wc * 32 + 8 * fq;
#pragma unroll
        for (int ai = 0; ai < 2; ++ai)
#pragma unroll
            for (int m = 0; m < 4; ++m) { const int row = row0 + ai * HALF + m * 16;
#pragma unroll
                for (int bj = 0; bj < 2; ++bj) { const int col = col0 + bj * HALF;
                    f32x4 g0, g1, t0, t1; unpack8(*(const u32x4*)(G + (size_t)row * ldg + col), g0, g1); unpack8(*(const u32x4*)(T1 + (size_t)row * 1024 + col), t0, t1);
                    f32x4 v0 = acc[ai][bj][m][0], v1 = acc[ai][bj][m][1];
#pragma unroll
                    for (int i = 0; i < 4; ++i) { v0[i] = fmaf(v0[i], sig_(g0[i]), t0[i]); v1[i] = fmaf(v1[i], sig_(g1[i]), t1[i]); }
                    *(u32x4*)(MG + (size_t)row * 1024 + col) = pack8(v0, v1); } }
    }
};
struct EpiT3 {
    static constexpr bool PERM = true, AFTER_DRAIN = false;
    float* X1; const float* x;
    __device__ __forceinline__ void operator()(const f32x4 (&acc)[2][2][4][2], const Unit& u, int wr, int wc, int fr, int fq) const {
        const int row0 = u.pm * BM + wr * 64 + fr, col0 = u.pn * BM + wc * 32 + 8 * fq;
#pragma unroll
        for (int ai = 0; ai < 2; ++ai)
#pragma unroll
            for (int m = 0; m < 4; ++m) { const size_t ro = (size_t)(row0 + ai * HALF + m * 16) * 1024 + col0;
#pragma unroll
                for (int bj = 0; bj < 2; ++bj) { const size_t o = ro + bj * HALF;
                    *(f32x4*)(X1 + o) = *(const f32x4*)(x + o) + acc[ai][bj][m][0]; *(f32x4*)(X1 + o + 4) = *(const f32x4*)(x + o + 4) + acc[ai][bj][m][1]; } }
    }
};
struct EpiAct {
    static constexpr bool PERM = true, AFTER_DRAIN = false;
    bf16_t* ACT; const float* b1;
    __device__ __forceinline__ void operator()(const f32x4 (&acc)[2][2][4][2], const Unit& u, int wr, int wc, int fr, int fq) const {
        const int e = u.pn >> 3, nt = u.pn & 7;
        const int row0 = u.pm * BM + wr * 64 + fr, col0 = nt * 128 + wc * 32 + 8 * fq;
        const float* bg = b1 + (size_t)e * 2048 + col0;
        const f32x4 bg0 = *(const f32x4*)bg, bg1 = *(const f32x4*)(bg + 4), bu0 = *(const f32x4*)(bg + 1024), bu1 = *(const f32x4*)(bg + 1028);
#pragma unroll
        for (int ai = 0; ai < 2; ++ai)
#pragma unroll
            for (int m = 0; m < 4; ++m) { const int row = row0 + ai * HALF + m * 16;
                f32x4 g0 = acc[ai][0][m][0] + bg0, g1 = acc[ai][0][m][1] + bg1, u0 = acc[ai][1][m][0] + bu0, u1 = acc[ai][1][m][1] + bu1;
#pragma unroll
                for (int i = 0; i < 4; ++i) {
                    const float ga = fminf(g0[i], 7.f), gb = fminf(g1[i], 7.f), ua = fminf(fmaxf(u0[i], -7.f), 7.f), ub = fminf(fmaxf(u1[i], -7.f), 7.f);
                    g0[i] = ga * sig_(1.702f * ga) * (ua + 1.f); g1[i] = gb * sig_(1.702f * gb) * (ub + 1.f); }
                *(u32x4*)(ACT + (size_t)row * 1024 + col0) = pack8(g0, g1); }
    }
};
struct EpiY {
    static constexpr bool PERM = true, AFTER_DRAIN = false;
    bf16_t* YB; const float* b2;
    __device__ __forceinline__ void operator()(const f32x4 (&acc)[2][2][4][2], const Unit& u, int wr, int wc, int fr, int fq) const {
        const int e = u.pn >> 2, nt = u.pn & 3;
        const int row0 = u.pm * BM + wr * 64 + fr, col0 = nt * BM + wc * 32 + 8 * fq;
        f32x4 bv[2][2];
#pragma unroll
        for (int bj = 0; bj < 2; ++bj) { bv[bj][0] = *(const f32x4*)(b2 + (size_t)e * 1024 + col0 + bj * HALF); bv[bj][1] = *(const f32x4*)(b2 + (size_t)e * 1024 + col0 + bj * HALF + 4); }
#pragma unroll
        for (int ai = 0; ai < 2; ++ai)
#pragma unroll
            for (int m = 0; m < 4; ++m) { bf16_t* rowp = YB + (size_t)(row0 + ai * HALF + m * 16) * 1024 + col0;
#pragma unroll
                for (int bj = 0; bj < 2; ++bj) *(u32x4*)(rowp + bj * HALF) = pack8(acc[ai][bj][m][0] + bv[bj][0], acc[ai][bj][m][1] + bv[bj][1]); }
    }
};

struct EpiAct8 {
    static constexpr bool PERM = true, AFTER_DRAIN = false;
    unsigned char* ACT; const float* b1;
    __device__ __forceinline__ void operator()(const f32x4 (&acc)[2][2][4][2], const Unit& u, int wr, int wc, int fr, int fq) const {
        const int e = u.pn >> 3, nt = u.pn & 7;
        const int row0 = u.pm * BM + wr * 64 + fr, col0 = nt * 128 + wc * 32 + 8 * fq;
        const float* bg = b1 + (size_t)e * 2048 + col0;
        const f32x4 bg0 = *(const f32x4*)bg, bg1 = *(const f32x4*)(bg + 4), bu0 = *(const f32x4*)(bg + 1024), bu1 = *(const f32x4*)(bg + 1028);
        constexpr float SC = 1.f / 512.f;
#pragma unroll
        for (int ai = 0; ai < 2; ++ai)
#pragma unroll
            for (int m = 0; m < 4; ++m) { const int row = row0 + ai * HALF + m * 16;
                f32x4 g0 = acc[ai][0][m][0] * SC + bg0, g1 = acc[ai][0][m][1] * SC + bg1, u0 = acc[ai][1][m][0] * SC + bu0, u1 = acc[ai][1][m][1] * SC + bu1;
#pragma unroll
                for (int i = 0; i < 4; ++i) {
                    const float ga = fminf(g0[i], 7.f), gb = fminf(g1[i], 7.f), ua = fminf(fmaxf(u0[i], -7.f), 7.f), ub = fminf(fmaxf(u1[i], -7.f), 7.f);
                    g0[i] = 4.f * ga * sig_(1.702f * ga) * (ua + 1.f); g1[i] = 4.f * gb * sig_(1.702f * gb) * (ub + 1.f); }
                u32x2 w; w.x = pack4_fp8(g0[0], g0[1], g0[2], g0[3]); w.y = pack4_fp8(g1[0], g1[1], g1[2], g1[3]);
                *(u32x2*)(ACT + (size_t)row * 1024 + col0) = w; }
    }
};
struct EpiY8 {
    static constexpr bool PERM = true, AFTER_DRAIN = false;
    bf16_t* YB; const float* b2;
    __device__ __forceinline__ void operator()(const f32x4 (&acc)[2][2][4][2], const Unit& u, int wr, int wc, int fr, int fq) const {
        const int e = u.pn >> 2, nt = u.pn & 3;
        const int row0 = u.pm * BM + wr * 64 + fr, col0 = nt * BM + wc * 32 + 8 * fq;
        constexpr float SC = 1.f / 256.f;
        f32x4 bv[2][2];
#pragma unroll
        for (int bj = 0; bj < 2; ++bj) { bv[bj][0] = *(const f32x4*)(b2 + (size_t)e * 1024 + col0 + bj * HALF); bv[bj][1] = *(const f32x4*)(b2 + (size_t)e * 1024 + col0 + bj * HALF + 4); }
#pragma unroll
        for (int ai = 0; ai < 2; ++ai)
#pragma unroll
            for (int m = 0; m < 4; ++m) { bf16_t* rowp = YB + (size_t)(row0 + ai * HALF + m * 16) * 1024 + col0;
#pragma unroll
                for (int bj = 0; bj < 2; ++bj) *(u32x4*)(rowp + bj * HALF) = pack8(acc[ai][bj][m][0] * SC + bv[bj][0], acc[ai][bj][m][1] * SC + bv[bj][1]); }
    }
};
template <int NN> struct MoeOrder {
    const PG8_LAS int* texp; int G, c, ntile;
    __device__ __forceinline__ bool next(int i, Unit& u) const {
        const int L = i * G + c; if (L >= ntile * NN) return false;
        const int t = L / NN, pnl = L % NN;
        u.pm = t; u.pn = texp[t] * NN + pnl; return true;
    }
    __device__ __forceinline__ void a_ready(const Unit&) const {}
    __device__ __forceinline__ void done(const Unit&) const {}
};
template <class Epi, class Sched, bool ALIGN_EPI = false, bool SP2 = false>
__device__ __forceinline__ void gemm_phase(PG8_LAS unsigned char* lds, const Gemm g, const Sched& S, const Epi& E) {
    const int tid = threadIdx.x, wid = __builtin_amdgcn_readfirstlane(tid >> 6), lane = tid & 63, wr = wid >> 2, wc = wid & 3, fr = lane & 15, fq = lane >> 4;
    const int K = g.K, nt = K / BK;
    unsigned voffA[2], voffB[2];
#pragma unroll
    for (int i = 0; i < 2; ++i) { int R, C; stage_rc(tid * 16 + i * 8192, R, C); const int Rb = Epi::PERM ? ((R & ~31) + perm32(R & 31)) : R;
        voffA[i] = (unsigned)(R * K + C) * 2u; voffB[i] = (unsigned)(Rb * K + C) * 2u; }
    const size_t kstep = (size_t)(BK * 2);
    const size_t hstep = (size_t)HALF * K * 2;
    const size_t tstep = 2 * hstep;
    const unsigned ldsw = (unsigned)wid * 1024u;
    const int aoff = lds_byte(wr * 64 + fr, fq * 8), boff = lds_byte(wc * 32 + fr, fq * 8);
#define PG8_SA(b, h) (((b) * 2 + (h)) * HTB)
#define PG8_SB(b, h) ((4 + (b) * 2 + (h)) * HTB)
#define PG8_STAGE(bufoff, gbase, voff) do { _Pragma("unroll") for (int _i = 0; _i < 2; ++_i) \
        __builtin_amdgcn_global_load_lds((const unsigned*)((const char*)(gbase) + (voff)[_i]), (PG8_LAS unsigned*)(lds + (bufoff) + ldsw + _i * 8192), 16, 0, 0); } while (0)
#define PG8_LDA(dst, b, h) do { _Pragma("unroll") for (int m = 0; m < 4; ++m) _Pragma("unroll") for (int k = 0; k < 2; ++k) dst[m][k] = *(const PG8_LAS bf16x8*)(lds + PG8_SA(b, h) + aoff + m * 2048 + k * 1024); } while (0)
#define PG8_LDB(dst, b, h) do { _Pragma("unroll") for (int n = 0; n < 2; ++n) _Pragma("unroll") for (int k = 0; k < 2; ++k) dst[n][k] = *(const PG8_LAS bf16x8*)(lds + PG8_SB(b, h) + boff + n * 2048 + k * 1024); } while (0)
#define PG8_MMA(ai, bj, At, Bt) do { __builtin_amdgcn_s_setprio(1); _Pragma("unroll") for (int m = 0; m < 4; ++m) _Pragma("unroll") for (int n = 0; n < 2; ++n) _Pragma("unroll") for (int k = 0; k < 2; ++k) \
        acc[ai][bj][m][n] = __builtin_amdgcn_mfma_f32_16x16x32_bf16(Bt[n][k], At[m][k], acc[ai][bj][m][n], 0, 0, 0); __builtin_amdgcn_s_setprio(0); } while (0)
#define PG8_WAIT_V(n) asm volatile("s_waitcnt vmcnt(" #n ")" ::: "memory")
#define PG8_WAIT_L(n) asm volatile("s_waitcnt lgkmcnt(" #n ")" ::: "memory")
#define PG8_BAR __builtin_amdgcn_s_barrier()
#define PG8_SCHED __builtin_amdgcn_sched_barrier(0)
    Unit cur, nxt; int ui = 0;
    if (!S.next(0, cur)) return;
    f32x4 acc[2][2][4][2];
#pragma unroll
    for (int a = 0; a < 2; ++a)
#pragma unroll
        for (int b = 0; b < 2; ++b)
#pragma unroll
            for (int m = 0; m < 4; ++m)
#pragma unroll
                for (int n = 0; n < 2; ++n) acc[a][b][m][n] = (f32x4){0.f, 0.f, 0.f, 0.f};
    bf16x8 At[4][2], B0[2][2], B1[2][2];
    const char* cA = (const char*)g.A + (size_t)cur.pm * tstep; const char* cB = (const char*)g.Bt + (size_t)cur.pn * tstep;
    S.a_ready(cur);
    if constexpr (SP2) {
        PG8_STAGE(PG8_SB(0, 0), cB, voffB); PG8_STAGE(PG8_SB(0, 1), cB + hstep, voffB); PG8_STAGE(PG8_SA(0, 0), cA, voffA); PG8_STAGE(PG8_SA(0, 1), cA + hstep, voffA);
        if (wr == 1) PG8_BAR;
        PG8_WAIT_V(2); PG8_BAR;
        PG8_STAGE(PG8_SB(1, 0), cB + kstep, voffB); PG8_STAGE(PG8_SA(1, 0), cA + kstep, voffA); PG8_STAGE(PG8_SB(1, 1), cB + hstep + kstep, voffB);
        PG8_WAIT_V(6); PG8_BAR;
    } else {
        PG8_STAGE(PG8_SB(0, 0), cB, voffB); PG8_STAGE(PG8_SA(0, 0), cA, voffA); PG8_STAGE(PG8_SB(0, 1), cB + hstep, voffB); PG8_STAGE(PG8_SA(0, 1), cA + hstep, voffA);
        if (wr == 1) PG8_BAR;
        PG8_WAIT_V(4); PG8_BAR;
        PG8_STAGE(PG8_SB(1, 0), cB + kstep, voffB); PG8_STAGE(PG8_SA(1, 0), cA + kstep, voffA); PG8_STAGE(PG8_SB(1, 1), cB + hstep + kstep, voffB);
        PG8_WAIT_V(6); PG8_BAR;
    }
    for (;;) {
        const bool has_next = S.next(ui + 1, nxt);
        const char* nA = has_next ? (const char*)g.A + (size_t)nxt.pm * tstep : cA; const char* nB = has_next ? (const char*)g.Bt + (size_t)nxt.pn * tstep : cB;
        for (int t = 0; t < nt; t += 2) {
            const bool last = (t == nt - 2);
            const char* a1 = cA + (size_t)(t + 1) * kstep;
            const char* a2 = last ? nA : cA + (size_t)(t + 2) * kstep; const char* b2 = last ? nB : cB + (size_t)(t + 2) * kstep;
            const char* a3 = a2 + kstep; const char* b3 = b2 + kstep;
            if (last && has_next) S.a_ready(nxt);
            if constexpr (SP2) {
            PG8_LDB(B0, 0, 0); PG8_LDB(B1, 0, 1); PG8_SCHED; PG8_LDA(At, 0, 0); PG8_STAGE(PG8_SA(1, 1), a1 + hstep, voffA);
            PG8_WAIT_V(8); PG8_WAIT_L(0); PG8_BAR; PG8_MMA(0, 0, At, B0); PG8_MMA(0, 1, At, B1); PG8_BAR; PG8_SCHED;
            PG8_LDA(At, 0, 1); PG8_STAGE(PG8_SB(0, 0), b2, voffB); PG8_STAGE(PG8_SB(0, 1), b2 + hstep, voffB); PG8_STAGE(PG8_SA(0, 0), a2, voffA);
            PG8_WAIT_V(8); PG8_WAIT_L(0); PG8_BAR; PG8_MMA(1, 0, At, B0); PG8_MMA(1, 1, At, B1); PG8_BAR; PG8_SCHED;
            PG8_LDB(B0, 1, 0); PG8_LDB(B1, 1, 1); PG8_SCHED; PG8_LDA(At, 1, 0); PG8_STAGE(PG8_SA(0, 1), a2 + hstep, voffA);
            PG8_WAIT_V(8); PG8_WAIT_L(0); PG8_BAR; PG8_MMA(0, 0, At, B0); PG8_MMA(0, 1, At, B1); PG8_BAR; PG8_SCHED;
            PG8_LDA(At, 1, 1); PG8_STAGE(PG8_SB(1, 0), b3, voffB); PG8_STAGE(PG8_SB(1, 1), b3 + hstep, voffB); PG8_STAGE(PG8_SA(1, 0), a3, voffA);
            PG8_WAIT_V(8); PG8_WAIT_L(0); PG8_BAR; PG8_MMA(1, 0, At, B0); PG8_MMA(1, 1, At, B1); PG8_BAR; PG8_SCHED;
            } else {
            PG8_LDB(B0, 0, 0); PG8_SCHED; PG8_LDA(At, 0, 0); PG8_STAGE(PG8_SA(1, 1), a1 + hstep, voffA);
            PG8_WAIT_L(8); PG8_BAR; PG8_WAIT_L(0); PG8_MMA(0, 0, At, B0); PG8_BAR; PG8_SCHED;
            PG8_LDB(B1, 0, 1); PG8_STAGE(PG8_SB(0, 0), b2, voffB);
            PG8_BAR; PG8_WAIT_L(0); PG8_MMA(0, 1, At, B1); PG8_BAR;
            PG8_LDA(At, 0, 1); PG8_STAGE(PG8_SA(0, 0), a2, voffA);
            PG8_BAR; PG8_WAIT_L(0); PG8_MMA(1, 0, At, B0); PG8_BAR; PG8_SCHED;
            PG8_STAGE(PG8_SB(0, 1), b2 + hstep, voffB);
            PG8_WAIT_V(6); PG8_BAR; PG8_MMA(1, 1, At, B1); PG8_BAR;
            PG8_LDB(B0, 1, 0); PG8_SCHED; PG8_LDA(At, 1, 0); PG8_STAGE(PG8_SA(0, 1), a2 + hstep, voffA);
            PG8_WAIT_L(8); PG8_BAR; PG8_WAIT_L(0); PG8_MMA(0, 0, At, B0); PG8_BAR; PG8_SCHED;
            PG8_LDB(B1, 1, 1); PG8_STAGE(PG8_SB(1, 0), b3, voffB);
            PG8_BAR; PG8_WAIT_L(0); PG8_MMA(0, 1, At, B1); PG8_BAR;
            PG8_LDA(At, 1, 1); PG8_STAGE(PG8_SA(1, 0), a3, voffA);
            PG8_BAR; PG8_WAIT_L(0); PG8_MMA(1, 0, At, B0); PG8_BAR; PG8_SCHED;
            PG8_STAGE(PG8_SB(1, 1), b3 + hstep, voffB);
            PG8_WAIT_V(6); PG8_BAR; PG8_MMA(1, 1, At, B1); PG8_BAR;
            }
        }
        if constexpr (ALIGN_EPI) { if (wr == 0) PG8_BAR; }
        if constexpr (!Epi::AFTER_DRAIN) { E(acc, cur, wr, wc, fr, fq); S.done(cur); }
        if (!has_next) break;
#pragma unroll
        for (int a = 0; a < 2; ++a)
#pragma unroll
            for (int b = 0; b < 2; ++b)
#pragma unroll
                for (int m = 0; m < 4; ++m)
#pragma unroll
                    for (int n = 0; n < 2; ++n) acc[a][b][m][n] = (f32x4){0.f, 0.f, 0.f, 0.f};
        cur = nxt; cA = nA; cB = nB; ++ui;
        if constexpr (ALIGN_EPI) { if (wr == 1) PG8_BAR; }
    }
    PG8_WAIT_V(0);
    if constexpr (!ALIGN_EPI) { if (wr == 0) PG8_BAR; }
    PG8_BAR;
    if constexpr (Epi::AFTER_DRAIN) { E.fused(acc, cur, wr, wc, fr, fq, lds, wid, lane); S.done(cur); }
#undef PG8_SA
#undef PG8_SB
#undef PG8_STAGE
#undef PG8_LDA
#undef PG8_LDB
#undef PG8_MMA
#undef PG8_WAIT_V
#undef PG8_WAIT_L
#undef PG8_BAR
#undef PG8_SCHED
}

struct MoeGatherOrder {
    const PG8_LAS int* offs; const PG8_LAS int* cnt; const PG8_LAS int* texp; const int* LIST; int G, c, ntile;
    __device__ __forceinline__ bool next(int i, Unit& u) const {
        const int L = i * G + c; if (L >= ntile * 8) return false;
        const int t = L >> 3, pnl = L & 7;
        u.pm = t; u.pn = texp[t] * 8 + pnl; return true;
    }
    __device__ __forceinline__ int arow(const Unit& u, int r) const { const int e = u.pn >> 3, slot = u.pm * 256 + r - offs[e]; return slot < cnt[e] ? LIST[e * 16384 + slot] : 0; }
    __device__ __forceinline__ void a_ready(const Unit&) const {}
    __device__ __forceinline__ void done(const Unit&) const {}
};
struct TailOrder {
    StaticOrder so;
    __device__ __forceinline__ bool next(int i, Unit& u) const { Unit b; if (!so.next(i >> 1, b)) return false; u.pm = b.pm + 64 * (i & 1); u.pn = b.pn + 4 * (i & 1); return true; }
    __device__ __forceinline__ void a_ready(const Unit&) const {}
    __device__ __forceinline__ void done(const Unit&) const {}
};
struct EpiT12 {
    static constexpr bool PERM = true, AFTER_DRAIN = false;
    bf16_t* T1; bf16_t* MG; const bf16_t* G; int ldg; const float* RSTD;
    __device__ __forceinline__ void operator()(const f32x4 (&acc)[2][2][4][2], const Unit& u, int wr, int wc, int fr, int fq) const {
        const bool second = u.pm >= 64;
        const int row0 = (u.pm & 63) * BM + wr * 64 + fr, col0 = (u.pn & 3) * BM + wc * 32 + 8 * fq;
        const bf16_t* Gp = G + (second ? 1024 : 0);
#pragma unroll
        for (int ai = 0; ai < 2; ++ai) {
            u32x4 gv[4][2], tv[4][2]; float rs[4];
#pragma unroll
            for (int m = 0; m < 4; ++m) { const int row = row0 + ai * HALF + m * 16; rs[m] = second ? 1.f : RSTD[row];
#pragma unroll
                for (int bj = 0; bj < 2; ++bj) { gv[m][bj] = *(const u32x4*)(Gp + (size_t)row * ldg + col0 + bj * HALF);
                    tv[m][bj] = second ? *(const u32x4*)(T1 + (size_t)row * 1024 + col0 + bj * HALF) : (u32x4){0u, 0u, 0u, 0u}; } }
#pragma unroll
            for (int m = 0; m < 4; ++m) { const int row = row0 + ai * HALF + m * 16;
#pragma unroll
                for (int bj = 0; bj < 2; ++bj) { f32x4 g0, g1, t0, t1; unpack8(gv[m][bj], g0, g1); unpack8(tv[m][bj], t0, t1);
                    f32x4 v0 = acc[ai][bj][m][0] * rs[m], v1 = acc[ai][bj][m][1] * rs[m];
#pragma unroll
                    for (int i = 0; i < 4; ++i) { v0[i] = fmaf(v0[i], sig_(g0[i]), t0[i]); v1[i] = fmaf(v1[i], sig_(g1[i]), t1[i]); }
                    *(u32x4*)((second ? MG : T1) + (size_t)row * 1024 + col0 + bj * HALF) = pack8(v0, v1); } }
        }
    }
};
struct EpiT3b {
    static constexpr bool PERM = true, AFTER_DRAIN = false;
    bf16_t* X1; const float* x;
    __device__ __forceinline__ void operator()(const f32x4 (&acc)[2][2][4][2], const Unit& u, int wr, int wc, int fr, int fq) const {
        const int row0 = u.pm * BM + wr * 64 + fr, col0 = u.pn * BM + wc * 32 + 8 * fq;
#pragma unroll
        for (int ai = 0; ai < 2; ++ai) {
            f32x4 xv[4][2][2];
#pragma unroll
            for (int m = 0; m < 4; ++m)
#pragma unroll
                for (int bj = 0; bj < 2; ++bj) { const size_t o = (size_t)(row0 + ai * HALF + m * 16) * 1024 + col0 + bj * HALF; xv[m][bj][0] = *(const f32x4*)(x + o); xv[m][bj][1] = *(const f32x4*)(x + o + 4); }
#pragma unroll
            for (int m = 0; m < 4; ++m)
#pragma unroll
                for (int bj = 0; bj < 2; ++bj) { const size_t o = (size_t)(row0 + ai * HALF + m * 16) * 1024 + col0 + bj * HALF;
                    *(u32x4*)(X1 + o) = pack8(xv[m][bj][0] + acc[ai][bj][m][0], xv[m][bj][1] + acc[ai][bj][m][1]); }
        }
    }
};
template <class Epi, class Sched>
__device__ __forceinline__ void gemm_phase_gather(PG8_LAS unsigned char* lds, const Gemm g, const Sched& S, const Epi& E) {
    constexpr bool ALIGN_EPI = true, SP2 = true;
    const int tid = threadIdx.x, wid = __builtin_amdgcn_readfirstlane(tid >> 6), lane = tid & 63, wr = wid >> 2, wc = wid & 3, fr = lane & 15, fq = lane >> 4;
    const int K = g.K, nt = K / BK;
    unsigned voffA[2], voffB[2];
#pragma unroll
    for (int i = 0; i < 2; ++i) { int R, C; stage_rc(tid * 16 + i * 8192, R, C); const int Rb = Epi::PERM ? ((R & ~31) + perm32(R & 31)) : R;
        voffA[i] = (unsigned)(R * K + C) * 2u; voffB[i] = (unsigned)(Rb * K + C) * 2u; }
    const size_t kstep = (size_t)(BK * 2);
    const size_t hstep = (size_t)HALF * K * 2;
    const size_t tstep = 2 * hstep;
    const unsigned ldsw = (unsigned)wid * 1024u;
    const int aoff = lds_byte(wr * 64 + fr, fq * 8), boff = lds_byte(wc * 32 + fr, fq * 8);
#define PG8_SA(b, h) (((b) * 2 + (h)) * HTB)
#define PG8_SB(b, h) ((4 + (b) * 2 + (h)) * HTB)
#define PG8_STAGE(bufoff, gbase, voff) do { _Pragma("unroll") for (int _i = 0; _i < 2; ++_i) \
        __builtin_amdgcn_global_load_lds((const unsigned*)((const char*)(gbase) + (voff)[_i]), (PG8_LAS unsigned*)(lds + (bufoff) + ldsw + _i * 8192), 16, 0, 0); } while (0)
#define PG8_LDA(dst, b, h) do { _Pragma("unroll") for (int m = 0; m < 4; ++m) _Pragma("unroll") for (int k = 0; k < 2; ++k) dst[m][k] = *(const PG8_LAS bf16x8*)(lds + PG8_SA(b, h) + aoff + m * 2048 + k * 1024); } while (0)
#define PG8_LDB(dst, b, h) do { _Pragma("unroll") for (int n = 0; n < 2; ++n) _Pragma("unroll") for (int k = 0; k < 2; ++k) dst[n][k] = *(const PG8_LAS bf16x8*)(lds + PG8_SB(b, h) + boff + n * 2048 + k * 1024); } while (0)
#define PG8_MMA(ai, bj, At, Bt) do { __builtin_amdgcn_s_setprio(1); _Pragma("unroll") for (int m = 0; m < 4; ++m) _Pragma("unroll") for (int n = 0; n < 2; ++n) _Pragma("unroll") for (int k = 0; k < 2; ++k) \
        acc[ai][bj][m][n] = __builtin_amdgcn_mfma_f32_16x16x32_bf16(Bt[n][k], At[m][k], acc[ai][bj][m][n], 0, 0, 0); __builtin_amdgcn_s_setprio(0); } while (0)
#define PG8_WAIT_V(n) asm volatile("s_waitcnt vmcnt(" #n ")" ::: "memory")
#define PG8_WAIT_L(n) asm volatile("s_waitcnt lgkmcnt(" #n ")" ::: "memory")
#define PG8_BAR __builtin_amdgcn_s_barrier()
#define PG8_SCHED __builtin_amdgcn_sched_barrier(0)
    Unit cur, nxt; int ui = 0;
    if (!S.next(0, cur)) return;
    int rA[2]; unsigned cAo[2];
#pragma unroll
    for (int i = 0; i < 2; ++i) { int R, C; stage_rc(tid * 16 + i * 8192, R, C); rA[i] = R; cAo[i] = (unsigned)C * 2u; }
    unsigned cO[2][2], o2[2][2]; int nR[2][2];
#define PG8_ROWS(dst, u) do { _Pragma("unroll") for (int h_ = 0; h_ < 2; ++h_) _Pragma("unroll") for (int i_ = 0; i_ < 2; ++i_) \
        dst[h_][i_] = (unsigned)S.arow(u, h_ * HALF + rA[i_]) * (unsigned)(K * 2) + cAo[i_]; } while (0)
    PG8_ROWS(cO, cur);
    f32x4 acc[2][2][4][2];
#pragma unroll
    for (int a = 0; a < 2; ++a)
#pragma unroll
        for (int b = 0; b < 2; ++b)
#pragma unroll
            for (int m = 0; m < 4; ++m)
#pragma unroll
                for (int n = 0; n < 2; ++n) acc[a][b][m][n] = (f32x4){0.f, 0.f, 0.f, 0.f};
    bf16x8 At[4][2], B0[2][2], B1[2][2];
    const char* const Ab = (const char*)g.A; const char* cB = (const char*)g.Bt + (size_t)cur.pn * tstep;
    S.a_ready(cur);
    if constexpr (SP2) {
        PG8_STAGE(PG8_SB(0, 0), cB, voffB); PG8_STAGE(PG8_SB(0, 1), cB + hstep, voffB); PG8_STAGE(PG8_SA(0, 0), Ab, cO[0]); PG8_STAGE(PG8_SA(0, 1), Ab, cO[1]);
        if (wr == 1) PG8_BAR;
        PG8_WAIT_V(2); PG8_BAR;
        PG8_STAGE(PG8_SB(1, 0), cB + kstep, voffB); PG8_STAGE(PG8_SA(1, 0), Ab + kstep, cO[0]); PG8_STAGE(PG8_SB(1, 1), cB + hstep + kstep, voffB);
        PG8_WAIT_V(6); PG8_BAR;
    }
    for (;;) {
        const bool has_next = S.next(ui + 1, nxt);
        const char* nB = has_next ? (const char*)g.Bt + (size_t)nxt.pn * tstep : cB;
#pragma unroll
        for (int h_ = 0; h_ < 2; ++h_)
#pragma unroll
            for (int i_ = 0; i_ < 2; ++i_) nR[h_][i_] = has_next ? S.arow(nxt, h_ * HALF + rA[i_]) : 0;
        for (int t = 0; t < nt; t += 2) {
            const bool last = (t == nt - 2);
            const char* a1 = Ab + (size_t)(t + 1) * kstep;
            const char* a2 = last ? Ab : Ab + (size_t)(t + 2) * kstep; const char* b2 = last ? nB : cB + (size_t)(t + 2) * kstep;
#pragma unroll
            for (int h_ = 0; h_ < 2; ++h_)
#pragma unroll
                for (int i_ = 0; i_ < 2; ++i_) o2[h_][i_] = cO[h_][i_];
            if (last && has_next) {
#pragma unroll
                for (int h_ = 0; h_ < 2; ++h_)
#pragma unroll
                    for (int i_ = 0; i_ < 2; ++i_) { int v_ = nR[h_][i_]; asm volatile("" : "+v"(v_)); o2[h_][i_] = (unsigned)v_ * (unsigned)(K * 2) + cAo[i_]; } }
            const char* a3 = a2 + kstep; const char* b3 = b2 + kstep;
            if (last && has_next) S.a_ready(nxt);
            if constexpr (SP2) {
            PG8_LDB(B0, 0, 0); PG8_LDB(B1, 0, 1); PG8_SCHED; PG8_LDA(At, 0, 0); PG8_STAGE(PG8_SA(1, 1), a1, cO[1]);
            PG8_WAIT_V(8); PG8_WAIT_L(0); PG8_BAR; PG8_MMA(0, 0, At, B0); PG8_MMA(0, 1, At, B1); PG8_BAR; PG8_SCHED;
            PG8_LDA(At, 0, 1); PG8_STAGE(PG8_SB(0, 0), b2, voffB); PG8_STAGE(PG8_SB(0, 1), b2 + hstep, voffB); PG8_STAGE(PG8_SA(0, 0), a2, o2[0]);
            PG8_WAIT_V(8); PG8_WAIT_L(0); PG8_BAR; PG8_MMA(1, 0, At, B0); PG8_MMA(1, 1, At, B1); PG8_BAR; PG8_SCHED;
            PG8_LDB(B0, 1, 0); PG8_LDB(B1, 1, 1); PG8_SCHED; PG8_LDA(At, 1, 0); PG8_STAGE(PG8_SA(0, 1), a2, o2[1]);
            PG8_WAIT_V(8); PG8_WAIT_L(0); PG8_BAR; PG8_MMA(0, 0, At, B0); PG8_MMA(0, 1, At, B1); PG8_BAR; PG8_SCHED;
            PG8_LDA(At, 1, 1); PG8_STAGE(PG8_SB(1, 0), b3, voffB); PG8_STAGE(PG8_SB(1, 1), b3 + hstep, voffB); PG8_STAGE(PG8_SA(1, 0), a3, o2[0]);
            PG8_WAIT_V(8); PG8_WAIT_L(0); PG8_BAR; PG8_MMA(1, 0, At, B0); PG8_MMA(1, 1, At, B1); PG8_BAR; PG8_SCHED;
            }
        }
        if constexpr (ALIGN_EPI) { if (wr == 0) PG8_BAR; }
        if constexpr (!Epi::AFTER_DRAIN) { E(acc, cur, wr, wc, fr, fq); S.done(cur); }
        if (!has_next) break;
#pragma unroll
        for (int a = 0; a < 2; ++a)
#pragma unroll
            for (int b = 0; b < 2; ++b)
#pragma unroll
                for (int m = 0; m < 4; ++m)
#pragma unroll
                    for (int n = 0; n < 2; ++n) acc[a][b][m][n] = (f32x4){0.f, 0.f, 0.f, 0.f};
        cur = nxt; cB = nB; ++ui;
#pragma unroll
        for (int h_ = 0; h_ < 2; ++h_)
#pragma unroll
            for (int i_ = 0; i_ < 2; ++i_) cO[h_][i_] = o2[h_][i_];
        if constexpr (ALIGN_EPI) { if (wr == 1) PG8_BAR; }
    }
    PG8_WAIT_V(0);
    if constexpr (!ALIGN_EPI) { if (wr == 0) PG8_BAR; }
    PG8_BAR;
    if constexpr (Epi::AFTER_DRAIN) { E.fused(acc, cur, wr, wc, fr, fq, lds, wid, lane); S.done(cur); }
#undef PG8_ROWS
#undef PG8_SA
#undef PG8_SB
#undef PG8_STAGE
#undef PG8_LDA
#undef PG8_LDB
#undef PG8_MMA
#undef PG8_WAIT_V
#undef PG8_WAIT_L
#undef PG8_BAR
#undef PG8_SCHED
}
typedef int v4i_t __attribute__((ext_vector_type(4)));
typedef int v8i_t __attribute__((ext_vector_type(8)));
template <class Epi, class Sched, bool ALIGN_EPI = false, bool SP2 = false>
__device__ __forceinline__ void gemm_phase_f8(PG8_LAS unsigned char* lds, const Gemm g, const Sched& S, const Epi& E) {
    const int tid = threadIdx.x, wid = __builtin_amdgcn_readfirstlane(tid >> 6), lane = tid & 63, wr = wid >> 2, wc = wid & 3, fr = lane & 15, fq = lane >> 4;
    const int K = g.K, nt = K / BK;
    unsigned voffA[2], voffB[2];
#pragma unroll
    for (int i = 0; i < 2; ++i) { int R, C; stage_rc(tid * 16 + i * 8192, R, C); const int Rb = Epi::PERM ? ((R & ~31) + perm32(R & 31)) : R;
        voffA[i] = (unsigned)(R * K + C) * 2u; voffB[i] = (unsigned)(Rb * K + C) * 2u; }
    const size_t kstep = (size_t)(BK * 2);
    const size_t hstep = (size_t)HALF * K * 2;
    const size_t tstep = 2 * hstep;
    const unsigned ldsw = (unsigned)wid * 1024u;
    const int aoff = lds_byte(wr * 64 + fr, fq * 8), boff = lds_byte(wc * 32 + fr, fq * 8);
#define PG8_SA(b, h) (((b) * 2 + (h)) * HTB)
#define PG8_SB(b, h) ((4 + (b) * 2 + (h)) * HTB)
#define PG8_STAGE(bufoff, gbase, voff) do { _Pragma("unroll") for (int _i = 0; _i < 2; ++_i) \
        __builtin_amdgcn_global_load_lds((const unsigned*)((const char*)(gbase) + (voff)[_i]), (PG8_LAS unsigned*)(lds + (bufoff) + ldsw + _i * 8192), 16, 0, 0); } while (0)
#define PG8_LDA(dst, b, h) do { _Pragma("unroll") for (int m = 0; m < 4; ++m) { const v4i_t lo_ = *(const PG8_LAS v4i_t*)(lds + PG8_SA(b, h) + aoff + m * 2048), hi_ = *(const PG8_LAS v4i_t*)(lds + PG8_SA(b, h) + aoff + m * 2048 + 1024); dst[m] = __builtin_shufflevector(lo_, hi_, 0, 1, 2, 3, 4, 5, 6, 7); } } while (0)
#define PG8_LDB(dst, b, h) do { _Pragma("unroll") for (int n = 0; n < 2; ++n) { const v4i_t lo_ = *(const PG8_LAS v4i_t*)(lds + PG8_SB(b, h) + boff + n * 2048), hi_ = *(const PG8_LAS v4i_t*)(lds + PG8_SB(b, h) + boff + n * 2048 + 1024); dst[n] = __builtin_shufflevector(lo_, hi_, 0, 1, 2, 3, 4, 5, 6, 7); } } while (0)
#define PG8_MMA(ai, bj, At, Bt) do { __builtin_amdgcn_s_setprio(1); _Pragma("unroll") for (int m = 0; m < 4; ++m) _Pragma("unroll") for (int n = 0; n < 2; ++n) \
        asm volatile("v_mfma_scale_f32_16x16x128_f8f6f4 %0, %1, %2, %0, %3, %3 op_sel_hi:[0,0,0]" : "+v"(acc[ai][bj][m][n]) : "v"(Bt[n]), "v"(At[m]), "v"(scl_)); __builtin_amdgcn_s_setprio(0); } while (0)
#define PG8_WAIT_V(n) asm volatile("s_waitcnt vmcnt(" #n ")" ::: "memory")
#define PG8_WAIT_L(n) asm volatile("s_waitcnt lgkmcnt(" #n ")" ::: "memory")
#define PG8_BAR __builtin_amdgcn_s_barrier()
#define PG8_SCHED __builtin_amdgcn_sched_barrier(0)
    Unit cur, nxt; int ui = 0;
    if (!S.next(0, cur)) return;
    f32x4 acc[2][2][4][2];
#pragma unroll
    for (int a = 0; a < 2; ++a)
#pragma unroll
        for (int b = 0; b < 2; ++b)
#pragma unroll
            for (int m = 0; m < 4; ++m)
#pragma unroll
                for (int n = 0; n < 2; ++n) acc[a][b][m][n] = (f32x4){0.f, 0.f, 0.f, 0.f};
    const int scl_ = 0x7f7f7f7f;
    v8i_t At[4], B0[2], B1[2];
    const char* cA = (const char*)g.A + (size_t)cur.pm * tstep; const char* cB = (const char*)g.Bt + (size_t)cur.pn * tstep;
    S.a_ready(cur);
    if constexpr (SP2) {
        PG8_STAGE(PG8_SB(0, 0), cB, voffB); PG8_STAGE(PG8_SB(0, 1), cB + hstep, voffB); PG8_STAGE(PG8_SA(0, 0), cA, voffA); PG8_STAGE(PG8_SA(0, 1), cA + hstep, voffA);
        if (wr == 1) PG8_BAR;
        PG8_WAIT_V(2); PG8_BAR;
        PG8_STAGE(PG8_SB(1, 0), cB + kstep, voffB); PG8_STAGE(PG8_SA(1, 0), cA + kstep, voffA); PG8_STAGE(PG8_SB(1, 1), cB + hstep + kstep, voffB);
        PG8_WAIT_V(6); PG8_BAR;
    } else {
        PG8_STAGE(PG8_SB(0, 0), cB, voffB); PG8_STAGE(PG8_SA(0, 0), cA, voffA); PG8_STAGE(PG8_SB(0, 1), cB + hstep, voffB); PG8_STAGE(PG8_SA(0, 1), cA + hstep, voffA);
        if (wr == 1) PG8_BAR;
        PG8_WAIT_V(4); PG8_BAR;
        PG8_STAGE(PG8_SB(1, 0), cB + kstep, voffB); PG8_STAGE(PG8_SA(1, 0), cA + kstep, voffA); PG8_STAGE(PG8_SB(1, 1), cB + hstep + kstep, voffB);
        PG8_WAIT_V(6); PG8_BAR;
    }
    for (;;) {
        const bool has_next = S.next(ui + 1, nxt);
        const char* nA = has_next ? (const char*)g.A + (size_t)nxt.pm * tstep : cA; const char* nB = has_next ? (const char*)g.Bt + (size_t)nxt.pn * tstep : cB;
        for (int t = 0; t < nt; t += 2) {
            const bool last = (t == nt - 2);
            const char* a1 = cA + (size_t)(t + 1) * kstep;
            const char* a2 = last ? nA : cA + (size_t)(t + 2) * kstep; const char* b2 = last ? nB : cB + (size_t)(t + 2) * kstep;
            const char* a3 = a2 + kstep; const char* b3 = b2 + kstep;
            if (last && has_next) S.a_ready(nxt);
            if constexpr (SP2) {
            PG8_LDB(B0, 0, 0); PG8_LDB(B1, 0, 1); PG8_SCHED; PG8_LDA(At, 0, 0); PG8_STAGE(PG8_SA(1, 1), a1 + hstep, voffA);
            PG8_WAIT_V(8); PG8_WAIT_L(0); PG8_BAR; PG8_MMA(0, 0, At, B0); PG8_MMA(0, 1, At, B1); PG8_BAR; PG8_SCHED;
            PG8_LDA(At, 0, 1); PG8_STAGE(PG8_SB(0, 0), b2, voffB); PG8_STAGE(PG8_SB(0, 1), b2 + hstep, voffB); PG8_STAGE(PG8_SA(0, 0), a2, voffA);
            PG8_WAIT_V(8); PG8_WAIT_L(0); PG8_BAR; PG8_MMA(1, 0, At, B0); PG8_MMA(1, 1, At, B1); PG8_BAR; PG8_SCHED;
            PG8_LDB(B0, 1, 0); PG8_LDB(B1, 1, 1); PG8_SCHED; PG8_LDA(At, 1, 0); PG8_STAGE(PG8_SA(0, 1), a2 + hstep, voffA);
            PG8_WAIT_V(8); PG8_WAIT_L(0); PG8_BAR; PG8_MMA(0, 0, At, B0); PG8_MMA(0, 1, At, B1); PG8_BAR; PG8_SCHED;
            PG8_LDA(At, 1, 1); PG8_STAGE(PG8_SB(1, 0), b3, voffB); PG8_STAGE(PG8_SB(1, 1), b3 + hstep, voffB); PG8_STAGE(PG8_SA(1, 0), a3, voffA);
            PG8_WAIT_V(8); PG8_WAIT_L(0); PG8_BAR; PG8_MMA(1, 0, At, B0); PG8_MMA(1, 1, At, B1); PG8_BAR; PG8_SCHED;
            } else {
            PG8_LDB(B0, 0, 0); PG8_SCHED; PG8_LDA(At, 0, 0); PG8_STAGE(PG8_SA(1, 1), a1 + hstep, voffA);
            PG8_WAIT_L(8); PG8_BAR; PG8_WAIT_L(0); PG8_MMA(0, 0, At, B0); PG8_BAR; PG8_SCHED;
            PG8_LDB(B1, 0, 1); PG8_STAGE(PG8_SB(0, 0), b2, voffB);
            PG8_BAR; PG8_WAIT_L(0); PG8_MMA(0, 1, At, B1); PG8_BAR;
            PG8_LDA(At, 0, 1); PG8_STAGE(PG8_SA(0, 0), a2, voffA);
            PG8_BAR; PG8_WAIT_L(0); PG8_MMA(1, 0, At, B0); PG8_BAR; PG8_SCHED;
            PG8_STAGE(PG8_SB(0, 1), b2 + hstep, voffB);
            PG8_WAIT_V(6); PG8_BAR; PG8_MMA(1, 1, At, B1); PG8_BAR;
            PG8_LDB(B0, 1, 0); PG8_SCHED; PG8_LDA(At, 1, 0); PG8_STAGE(PG8_SA(0, 1), a2 + hstep, voffA);
            PG8_WAIT_L(8); PG8_BAR; PG8_WAIT_L(0); PG8_MMA(0, 0, At, B0); PG8_BAR; PG8_SCHED;
            PG8_LDB(B1, 1, 1); PG8_STAGE(PG8_SB(1, 0), b3, voffB);
            PG8_BAR; PG8_WAIT_L(0); PG8_MMA(0, 1, At, B1); PG8_BAR;
            PG8_LDA(At, 1, 1); PG8_STAGE(PG8_SA(1, 0), a3, voffA);
            PG8_BAR; PG8_WAIT_L(0); PG8_MMA(1, 0, At, B0); PG8_BAR; PG8_SCHED;
            PG8_STAGE(PG8_SB(1, 1), b3 + hstep, voffB);
            PG8_WAIT_V(6); PG8_BAR; PG8_MMA(1, 1, At, B1); PG8_BAR;
            }
        }
        if constexpr (ALIGN_EPI) { if (wr == 0) PG8_BAR; }
        asm volatile("s_nop 15\n\ts_nop 15" ::: "memory");
        if constexpr (!Epi::AFTER_DRAIN) { E(acc, cur, wr, wc, fr, fq); S.done(cur); }
        if (!has_next) break;
#pragma unroll
        for (int a = 0; a < 2; ++a)
#pragma unroll
            for (int b = 0; b < 2; ++b)
#pragma unroll
                for (int m = 0; m < 4; ++m)
#pragma unroll
                    for (int n = 0; n < 2; ++n) acc[a][b][m][n] = (f32x4){0.f, 0.f, 0.f, 0.f};
        cur = nxt; cA = nA; cB = nB; ++ui;
        if constexpr (ALIGN_EPI) { if (wr == 1) PG8_BAR; }
    }
    PG8_WAIT_V(0);
    if constexpr (!ALIGN_EPI) { if (wr == 0) PG8_BAR; }
    PG8_BAR;
    if constexpr (Epi::AFTER_DRAIN) { E.fused(acc, cur, wr, wc, fr, fq, lds, wid, lane); S.done(cur); }
#undef PG8_SA
#undef PG8_SB
#undef PG8_STAGE
#undef PG8_LDA
#undef PG8_LDB
#undef PG8_MMA
#undef PG8_WAIT_V
#undef PG8_WAIT_L
#undef PG8_BAR
#undef PG8_SCHED
}

template <class Epi, class Sched>
__device__ __forceinline__ void gemm_phase_gather_f8(PG8_LAS unsigned char* lds, const Gemm g, const Sched& S, const Epi& E) {
    constexpr bool ALIGN_EPI = true, SP2 = true;
    const int tid = threadIdx.x, wid = __builtin_amdgcn_readfirstlane(tid >> 6), lane = tid & 63, wr = wid >> 2, wc = wid & 3, fr = lane & 15, fq = lane >> 4;
    const int K = g.K, nt = K / BK;
    unsigned voffA[2], voffB[2];
#pragma unroll
    for (int i = 0; i < 2; ++i) { int R, C; stage_rc(tid * 16 + i * 8192, R, C); const int Rb = Epi::PERM ? ((R & ~31) + perm32(R & 31)) : R;
        voffA[i] = (unsigned)(R * K + C) * 2u; voffB[i] = (unsigned)(Rb * K + C) * 2u; }
    const size_t kstep = (size_t)(BK * 2);
    const size_t hstep = (size_t)HALF * K * 2;
    const size_t tstep = 2 * hstep;
    const unsigned ldsw = (unsigned)wid * 1024u;
    const int aoff = lds_byte(wr * 64 + fr, fq * 8), boff = lds_byte(wc * 32 + fr, fq * 8);
#define PG8_SA(b, h) (((b) * 2 + (h)) * HTB)
#define PG8_SB(b, h) ((4 + (b) * 2 + (h)) * HTB)
#define PG8_STAGE(bufoff, gbase, voff) do { _Pragma("unroll") for (int _i = 0; _i < 2; ++_i) \
        __builtin_amdgcn_global_load_lds((const unsigned*)((const char*)(gbase) + (voff)[_i]), (PG8_LAS unsigned*)(lds + (bufoff) + ldsw + _i * 8192), 16, 0, 0); } while (0)
#define PG8_LDA(dst, b, h) do { _Pragma("unroll") for (int m = 0; m < 4; ++m) { const v4i_t lo_ = *(const PG8_LAS v4i_t*)(lds + PG8_SA(b, h) + aoff + m * 2048), hi_ = *(const PG8_LAS v4i_t*)(lds + PG8_SA(b, h) + aoff + m * 2048 + 1024); dst[m] = __builtin_shufflevector(lo_, hi_, 0, 1, 2, 3, 4, 5, 6, 7); } } while (0)
#define PG8_LDB(dst, b, h) do { _Pragma("unroll") for (int n = 0; n < 2; ++n) { const v4i_t lo_ = *(const PG8_LAS v4i_t*)(lds + PG8_SB(b, h) + boff + n * 2048), hi_ = *(const PG8_LAS v4i_t*)(lds + PG8_SB(b, h) + boff + n * 2048 + 1024); dst[n] = __builtin_shufflevector(lo_, hi_, 0, 1, 2, 3, 4, 5, 6, 7); } } while (0)
#define PG8_MMA(ai, bj, At, Bt) do { __builtin_amdgcn_s_setprio(1); _Pragma("unroll") for (int m = 0; m < 4; ++m) _Pragma("unroll") for (int n = 0; n < 2; ++n) \
        asm volatile("v_mfma_scale_f32_16x16x128_f8f6f4 %0, %1, %2, %0, %3, %3 op_sel_hi:[0,0,0]" : "+v"(acc[ai][bj][m][n]) : "v"(Bt[n]), "v"(At[m]), "v"(scl_)); __builtin_amdgcn_s_setprio(0); } while (0)
#define PG8_WAIT_V(n) asm volatile("s_waitcnt vmcnt(" #n ")" ::: "memory")
#define PG8_WAIT_L(n) asm volatile("s_waitcnt lgkmcnt(" #n ")" ::: "memory")
#define PG8_BAR __builtin_amdgcn_s_barrier()
#define PG8_SCHED __builtin_amdgcn_sched_barrier(0)
    Unit cur, nxt; int ui = 0;
    if (!S.next(0, cur)) return;
    int rA[2]; unsigned cAo[2];
#pragma unroll
    for (int i = 0; i < 2; ++i) { int R, C; stage_rc(tid * 16 + i * 8192, R, C); rA[i] = R; cAo[i] = (unsigned)C * 2u; }
    unsigned cO[2][2], o2[2][2]; int nR[2][2];
#define PG8_ROWS(dst, u) do { _Pragma("unroll") for (int h_ = 0; h_ < 2; ++h_) _Pragma("unroll") for (int i_ = 0; i_ < 2; ++i_) \
        dst[h_][i_] = (unsigned)S.arow(u, h_ * HALF + rA[i_]) * (unsigned)(K * 2) + cAo[i_]; } while (0)
    PG8_ROWS(cO, cur);
    f32x4 acc[2][2][4][2];
#pragma unroll
    for (int a = 0; a < 2; ++a)
#pragma unroll
        for (int b = 0; b < 2; ++b)
#pragma unroll
            for (int m = 0; m < 4; ++m)
#pragma unroll
                for (int n = 0; n < 2; ++n) acc[a][b][m][n] = (f32x4){0.f, 0.f, 0.f, 0.f};
    const int scl_ = 0x7f7f7f7f;
    v8i_t At[4], B0[2], B1[2];
    const char* const Ab = (const char*)g.A; const char* cB = (const char*)g.Bt + (size_t)cur.pn * tstep;
    S.a_ready(cur);
    if constexpr (SP2) {
        PG8_STAGE(PG8_SB(0, 0), cB, voffB); PG8_STAGE(PG8_SB(0, 1), cB + hstep, voffB); PG8_STAGE(PG8_SA(0, 0), Ab, cO[0]); PG8_STAGE(PG8_SA(0, 1), Ab, cO[1]);
        if (wr == 1) PG8_BAR;
        PG8_WAIT_V(2); PG8_BAR;
        PG8_STAGE(PG8_SB(1, 0), cB + kstep, voffB); PG8_STAGE(PG8_SA(1, 0), Ab + kstep, cO[0]); PG8_STAGE(PG8_SB(1, 1), cB + hstep + kstep, voffB);
        PG8_WAIT_V(6); PG8_BAR;
    }
    for (;;) {
        const bool has_next = S.next(ui + 1, nxt);
        const char* nB = has_next ? (const char*)g.Bt + (size_t)nxt.pn * tstep : cB;
#pragma unroll
        for (int h_ = 0; h_ < 2; ++h_)
#pragma unroll
            for (int i_ = 0; i_ < 2; ++i_) nR[h_][i_] = has_next ? S.arow(nxt, h_ * HALF + rA[i_]) : 0;
        for (int t = 0; t < nt; t += 2) {
            const bool last = (t == nt - 2);
            const char* a1 = Ab + (size_t)(t + 1) * kstep;
            const char* a2 = last ? Ab : Ab + (size_t)(t + 2) * kstep; const char* b2 = last ? nB : cB + (size_t)(t + 2) * kstep;
#pragma unroll
            for (int h_ = 0; h_ < 2; ++h_)
#pragma unroll
                for (int i_ = 0; i_ < 2; ++i_) o2[h_][i_] = cO[h_][i_];
            if (last && has_next) {
#pragma unroll
                for (int h_ = 0; h_ < 2; ++h_)
#pragma unroll
                    for (int i_ = 0; i_ < 2; ++i_) { int v_ = nR[h_][i_]; asm volatile("" : "+v"(v_)); o2[h_][i_] = (unsigned)v_ * (unsigned)(K * 2) + cAo[i_]; } }
            const char* a3 = a2 + kstep; const char* b3 = b2 + kstep;
            if (last && has_next) S.a_ready(nxt);
            if constexpr (SP2) {
            PG8_LDB(B0, 0, 0); PG8_LDB(B1, 0, 1); PG8_SCHED; PG8_LDA(At, 0, 0); PG8_STAGE(PG8_SA(1, 1), a1, cO[1]);
            PG8_WAIT_V(8); PG8_WAIT_L(0); PG8_BAR; PG8_MMA(0, 0, At, B0); PG8_MMA(0, 1, At, B1); PG8_BAR; PG8_SCHED;
            PG8_LDA(At, 0, 1); PG8_STAGE(PG8_SB(0, 0), b2, voffB); PG8_STAGE(PG8_SB(0, 1), b2 + hstep, voffB); PG8_STAGE(PG8_SA(0, 0), a2, o2[0]);
            PG8_WAIT_V(8); PG8_WAIT_L(0); PG8_BAR; PG8_MMA(1, 0, At, B0); PG8_MMA(1, 1, At, B1); PG8_BAR; PG8_SCHED;
            PG8_LDB(B0, 1, 0); PG8_LDB(B1, 1, 1); PG8_SCHED; PG8_LDA(At, 1, 0); PG8_STAGE(PG8_SA(0, 1), a2, o2[1]);
            PG8_WAIT_V(8); PG8_WAIT_L(0); PG8_BAR; PG8_MMA(0, 0, At, B0); PG8_MMA(0, 1, At, B1); PG8_BAR; PG8_SCHED;
            PG8_LDA(At, 1, 1); PG8_STAGE(PG8_SB(1, 0), b3, voffB); PG8_STAGE(PG8_SB(1, 1), b3 + hstep, voffB); PG8_STAGE(PG8_SA(1, 0), a3, o2[0]);
            PG8_WAIT_V(8); PG8_WAIT_L(0); PG8_BAR; PG8_MMA(1, 0, At, B0); PG8_MMA(1, 1, At, B1); PG8_BAR; PG8_SCHED;
            }
        }
        if constexpr (ALIGN_EPI) { if (wr == 0) PG8_BAR; }
        asm volatile("s_nop 15\n\ts_nop 15" ::: "memory");
        if constexpr (!Epi::AFTER_DRAIN) { E(acc, cur, wr, wc, fr, fq); S.done(cur); }
        if (!has_next) break;
#pragma unroll
        for (int a = 0; a < 2; ++a)
#pragma unroll
            for (int b = 0; b < 2; ++b)
#pragma unroll
                for (int m = 0; m < 4; ++m)
#pragma unroll
                    for (int n = 0; n < 2; ++n) acc[a][b][m][n] = (f32x4){0.f, 0.f, 0.f, 0.f};
        cur = nxt; cB = nB; ++ui;
#pragma unroll
        for (int h_ = 0; h_ < 2; ++h_)
#pragma unroll
            for (int i_ = 0; i_ < 2; ++i_) cO[h_][i_] = o2[h_][i_];
        if constexpr (ALIGN_EPI) { if (wr == 1) PG8_BAR; }
    }
    PG8_WAIT_V(0);
    if constexpr (!ALIGN_EPI) { if (wr == 0) PG8_BAR; }
    PG8_BAR;
    if constexpr (Epi::AFTER_DRAIN) { E.fused(acc, cur, wr, wc, fr, fq, lds, wid, lane); S.done(cur); }
#undef PG8_ROWS
#undef PG8_SA
#undef PG8_SB
#undef PG8_STAGE
#undef PG8_LDA
#undef PG8_LDB
#undef PG8_MMA
#undef PG8_WAIT_V
#undef PG8_WAIT_L
#undef PG8_BAR
#undef PG8_SCHED
}
}

struct EpiP { bf16_t* P; int n0; __device__ __forceinline__ void operator()(int r, int cl, float a, float) const { P[(size_t)r * NPROJ + n0 + cl] = (bf16_t)f2bf(a); } };
__device__ __forceinline__ void phase_gemm1_naive(const Params& p, const Ctx& c) {
    const bf16_t* H = (const bf16_t*)(p.ws + WS_H); const bf16_t* W = (const bf16_t*)(p.ws + WS_WINT); bf16_t* P = (bf16_t*)(p.ws + WS_P);
    constexpr int NT_N = NPROJ / 64, NT_M = M / 128;
    for (int it = c.bid; it < NT_M * NT_N; it += c.G) {
        const int mt = it / NT_N, nt = it % NT_N;
        ngemm_tile<false>(ARowPlain{H, 1024}, W + (size_t)nt * 64 * 1024, nullptr, 1024, mt * 128, EpiP{P, nt * 64}, (LAS float*)c.lds, c.tid);
    }
}

typedef short bf16x8c __attribute__((ext_vector_type(8)));
typedef float f32x16c __attribute__((ext_vector_type(16)));
__device__ __forceinline__ void phase_conv(const Params& p, const Ctx& c) {
    unsigned char* ws = p.ws;
    const bf16_t* P = (const bf16_t*)(ws + WS_P);
    const int tid = c.tid;
    LAS bf16_t* raw = (LAS bf16_t*)c.lds;
    LAS bf16_t* outb = (LAS bf16_t*)(c.lds + 132 * 256 * 2);
    for (int it = c.bid; it < 2 * 64 * 6; it += c.G) {
        const int part = it % 6, bc = it / 6, b = bc / 64, ch_ = bc % 64, t0 = ch_ * 128;
        __syncthreads();
        {
            u32x4 rv[9];
#pragma unroll
            for (int i = 0; i < 9; ++i) { const int idx = tid + 512 * i, r = idx >> 5, c8 = idx & 31, tok = t0 - 2 + r;
                rv[i] = (u32x4){0u, 0u, 0u, 0u};
                if (idx < 132 * 32 && tok >= 0 && tok < S) rv[i] = *(const u32x4*)(P + (size_t)(b * S + tok) * NPROJ + PXBC + part * 256 + c8 * 8); }
#pragma unroll
            for (int i = 0; i < 9; ++i) { const int idx = tid + 512 * i, r = idx >> 5, c8 = idx & 31;
                if (idx < 132 * 32) *(LAS u32x4*)(raw + r * 256 + c8 * 8) = rv[i]; }
        }
        __syncthreads();
        {
            const int ch = tid & 255, hf = tid >> 8, cg_ = part * 256 + ch;
            const float* cw = p.in[3]; const float cb = p.in[4][cg_];
            const float w0 = cw[0 * 1536 + cg_], w1 = cw[1 * 1536 + cg_], w2 = cw[2 * 1536 + cg_], w3 = cw[3 * 1536 + cg_], w4 = cw[4 * 1536 + cg_];
            const LAS bf16_t* rp = raw + (hf * 64) * 256 + ch;
            float r0 = bf2f(rp[0 * 256]), r1 = bf2f(rp[1 * 256]), r2 = bf2f(rp[2 * 256]), r3 = bf2f(rp[3 * 256]);
            unsigned ov[32];
#pragma unroll
            for (int i = 0; i < 64; ++i) {
                const float r4 = bf2f(rp[(i + 4) * 256]);
                float a = cb; a = fmaf(w0, r0, a); a = fmaf(w1, r1, a); a = fmaf(w2, r2, a); a = fmaf(w3, r3, a); a = fmaf(w4, r4, a);
                const unsigned hv = f2bf(a * sigmoidf_(a));
                if (i & 1) ov[i >> 1] |= hv << 16; else ov[i >> 1] = hv;
                r0 = r1; r1 = r2; r2 = r3; r3 = r4;
            }
            if (part <= 4) {
                bf16_t* dst = (part < 4 ? (bf16_t*)(ws + WS_XT) + ((size_t)(b * 64 + ch_) * 16 + part * 4) * 64 * 128
                                        : (bf16_t*)(ws + WS_BMT) + (size_t)(b * 64 + ch_) * 2 * 128 * 128) + (size_t)ch * 128 + hf * 64;
#pragma unroll
                for (int q = 0; q < 8; ++q) *(u32x4*)(dst + q * 8) = (u32x4){ov[4 * q], ov[4 * q + 1], ov[4 * q + 2], ov[4 * q + 3]};
            }
            if (part >= 4) {
#pragma unroll
                for (int i = 0; i < 64; ++i) outb[(hf * 64 + i) * 256 + ch] = (bf16_t)((i & 1) ? (ov[i >> 1] >> 16) : (ov[i >> 1] & 0xffffu));
            }
        }
        if (part >= 4) {
            __syncthreads();
            bf16_t* dst = (bf16_t*)(ws + (part == 4 ? WS_BMR : WS_CMR)) + (size_t)(b * S + t0) * 256;
#pragma unroll
            for (int q = 0; q < 8; ++q) { const int idx = tid + 512 * q, l = idx >> 5, c8 = idx & 31;
                *(u32x4*)(dst + (size_t)l * 256 + c8 * 8) = *(const LAS u32x4*)(outb + l * 256 + c8 * 8); }
        }
    }
    {
        float* DT = (float*)(ws + WS_DT); float* ACS = (float*)(ws + WS_ACS); float* CDEC = (float*)(ws + WS_CDEC);
        const bf16_t* H = (const bf16_t*)(ws + WS_H); const bf16_t* Wdt = (const bf16_t*)(ws + WS_WINT) + (size_t)PDT * 1024;
        constexpr int WS_ = 1032;
        LAS bf16_t* wl = (LAS bf16_t*)c.lds; LAS float* dtr = (LAS float*)(c.lds + 32 * WS_ * 2);
        const int lane = c.lane, r = lane & 31, hh = lane >> 5;
        bool staged = false;
        for (int it = c.bid; it < 128; it += c.G) {
            const int b = it / 64, ch_ = it % 64, t0 = ch_ * 128;
            __syncthreads();
            if (!staged) { staged = true;
#pragma unroll
                for (int i = 0; i < 8; ++i) { const int idx = tid + 512 * i, row = idx >> 7, c8 = idx & 127; *(LAS u32x4*)(wl + row * WS_ + c8 * 8) = *(const u32x4*)(Wdt + (size_t)row * 1024 + c8 * 8); }
                __syncthreads(); }
            {
                const int rb = c.wave & 3, kh = c.wave >> 2;
                const bf16_t* hrow = H + ((size_t)b * S + t0 + rb * 32 + r) * 1024 + kh * 512 + 8 * hh;
                f32x16c acc = {};
#pragma unroll
                for (int k8 = 0; k8 < 4; ++k8) { bf16x8c a[8];
#pragma unroll
                    for (int ks = 0; ks < 8; ++ks) a[ks] = *(const bf16x8c*)(hrow + (k8 * 8 + ks) * 16);
#pragma unroll
                    for (int ks = 0; ks < 8; ++ks) acc = __builtin_amdgcn_mfma_f32_32x32x16_bf16(a[ks], *(const LAS bf16x8c*)(wl + r * WS_ + kh * 512 + (k8 * 8 + ks) * 16 + 8 * hh), acc, 0, 0, 0); }
#pragma unroll
                for (int i = 0; i < 16; ++i) { const int l = rb * 32 + (i & 3) + 8 * (i >> 2) + 4 * hh; dtr[(kh * 128 + l) * 33 + r] = acc[i]; }
            }
            __syncthreads();
#pragma unroll
            for (int qi = 0; qi < 4; ++qi) {
                const int q = c.wave * 4 + qi, dir = q >> 4, h = q & 15;
                const float bias = dir ? p.in[6][h] : p.in[5][h], nA = -expf(dir ? p.in[8][h] : p.in[7][h]);
                const int l0 = dir ? 127 - lane : lane, l1 = dir ? 63 - lane : lane + 64;
                const size_t tok0 = (size_t)b * S + t0 + l0, tok1 = (size_t)b * S + t0 + l1;
                const float x0 = dtr[l0 * 33 + q] + dtr[(128 + l0) * 33 + q] + bias, x1 = dtr[l1 * 33 + q] + dtr[(128 + l1) * 33 + q] + bias;
                const float d0 = fmaxf(x0, 0.f) + log1pf(expf(-fabsf(x0))), d1 = fmaxf(x1, 0.f) + log1pf(expf(-fabsf(x1)));
                float a0 = d0 * nA, a1 = d1 * nA;
#pragma unroll
                for (int o = 1; o < 64; o <<= 1) { const float t0_ = __shfl_up(a0, o), t1_ = __shfl_up(a1, o); if (lane >= o) { a0 += t0_; a1 += t1_; } }
                const float tot0 = __shfl(a0, 63); a1 += tot0;
                DT[((size_t)dir * M + tok0) * 16 + h] = d0; DT[((size_t)dir * M + tok1) * 16 + h] = d1;
                ACS[((size_t)dir * M + tok0) * 16 + h] = a0; ACS[((size_t)dir * M + tok1) * 16 + h] = a1;
                if (lane == 63) CDEC[((dir * 2 + b) * 64 + ch_) * 16 + h] = expf(a1);
            }
        }
        __syncthreads();
    }
    {
        const int gw = c.bid * 8 + c.wave, NGW = c.G * 8, lane = c.lane;
        const float* rc = (const float*)(ws + WS_ROPE); const float* rs = rc + 4096;
        const int sub = lane >> 4, j = lane & 15, axis = j >> 3, i0 = 8 * (j & 3); const bool second = (j & 4) != 0;
        const f32x4 gq0 = *(const f32x4*)(p.in[11] + 8 * j), gq1 = *(const f32x4*)(p.in[11] + 8 * j + 4), gk0 = *(const f32x4*)(p.in[12] + 8 * j), gk1 = *(const f32x4*)(p.in[12] + 8 * j + 4);
        unsigned char* QN = ws + WS_QN; unsigned char* KN = ws + WS_KN;
        for (int base0 = gw; base0 < M * 10 / 4; base0 += 4 * NGW) {
            u32x4 vq[4]; int tokq[4], hhq[4];
#pragma unroll
            for (int u = 0; u < 4; ++u) { const int base = base0 + u * NGW, it = base * 4 + sub; tokq[u] = it / 10; hhq[u] = it % 10;
                vq[u] = (u32x4){0u, 0u, 0u, 0u};
                if (base < M * 10 / 4) vq[u] = *(const u32x4*)(P + (size_t)tokq[u] * NPROJ + (hhq[u] < 8 ? PQ + hhq[u] * 128 : PK + (hhq[u] - 8) * 128) + 8 * j); }
#pragma unroll
            for (int u = 0; u < 4; ++u) {
                const int base = base0 + u * NGW, tok = tokq[u], hh = hhq[u];
                unsigned char* dst = (hh < 8 ? QN + (size_t)tok * 1024 + hh * 128 : KN + (size_t)tok * 256 + (hh - 8) * 128) + 8 * j;
                const u32x4 v = vq[u];
                float y[8] = {bflo(v.x), bfhi(v.x), bflo(v.y), bfhi(v.y), bflo(v.z), bfhi(v.z), bflo(v.w), bfhi(v.w)};
                float ss = 0.f;
#pragma unroll
                for (int i = 0; i < 8; ++i) ss = fmaf(y[i], y[i], ss);
                ss += __shfl_xor(ss, 1); ss += __shfl_xor(ss, 2); ss += __shfl_xor(ss, 4); ss += __shfl_xor(ss, 8);
                const float rstd = rsqrtf(ss * (1.f / 128.f) + EPS);
                const f32x4 g0 = hh < 8 ? gq0 : gk0, g1 = hh < 8 ? gq1 : gk1;
#pragma unroll
                for (int i = 0; i < 4; ++i) { y[i] *= rstd * g0[i]; y[4 + i] *= rstd * g1[i]; }
                const int s = tok & (S - 1), pos = axis ? (s & 63) : (s >> 6);
                const f32x4 c0 = *(const f32x4*)(rc + pos * 32 + i0), c1 = *(const f32x4*)(rc + pos * 32 + i0 + 4), s0 = *(const f32x4*)(rs + pos * 32 + i0), s1 = *(const f32x4*)(rs + pos * 32 + i0 + 4);
                float o[8];
#pragma unroll
                for (int i = 0; i < 8; ++i) { const float other = __shfl_xor(y[i], 4); const float cs = i < 4 ? c0[i] : c1[i - 4], sn = i < 4 ? s0[i] : s1[i - 4];
                    o[i] = second ? fmaf(other, sn, y[i] * cs) : fmaf(-other, sn, y[i] * cs); }
                u32x2 w; w.x = pack4_fp8(o[0], o[1], o[2], o[3]); w.y = pack4_fp8(o[4], o[5], o[6], o[7]);
                if (base < M * 10 / 4) *(u32x2*)dst = w;
            }
        }
    }
    {
        unsigned char* VT8 = ws + WS_VB; LAS unsigned char* vt = c.lds;
        for (int it = c.bid; it < 256; it += c.G) {
            const int b = it >> 7, jt = it & 127;
            __syncthreads();
            u32x4 vv[4];
#pragma unroll
            for (int q = 0; q < 4; ++q) { const int idx = tid + 512 * q, key = idx >> 5, c8 = idx & 31; vv[q] = *(const u32x4*)(P + ((size_t)b * S + jt * 64 + key) * NPROJ + PV + c8 * 8); }
#pragma unroll
            for (int q = 0; q < 4; ++q) { const int idx = tid + 512 * q, key = idx >> 5, c8 = idx & 31, d0 = c8 * 8;
                const int off = 32 * ((key >> 2) & 1) + 16 * (key >> 5) + (key & 3) + 4 * ((key & 31) >> 3);
                const unsigned w0 = pack4_fp8(bflo(vv[q].x), bfhi(vv[q].x), bflo(vv[q].y), bfhi(vv[q].y)), w1 = pack4_fp8(bflo(vv[q].z), bfhi(vv[q].z), bflo(vv[q].w), bfhi(vv[q].w));
                LAS unsigned char* dp = vt + d0 * 64 + off;
                dp[0 * 64] = (unsigned char)(w0); dp[1 * 64] = (unsigned char)(w0 >> 8); dp[2 * 64] = (unsigned char)(w0 >> 16); dp[3 * 64] = (unsigned char)(w0 >> 24);
                dp[4 * 64] = (unsigned char)(w1); dp[5 * 64] = (unsigned char)(w1 >> 8); dp[6 * 64] = (unsigned char)(w1 >> 16); dp[7 * 64] = (unsigned char)(w1 >> 24); }
            __syncthreads();
#pragma unroll
            for (int q = 0; q < 2; ++q) { const int idx = tid + 512 * q, kvh = idx >> 9, rem = idx & 511;
                *(u32x4*)(VT8 + ((size_t)(b * 2 + kvh) * 128 + jt) * 8192 + rem * 16) = *(const LAS u32x4*)(vt + kvh * 8192 + rem * 16); }
        }
        __syncthreads();
    }
}

__device__ __forceinline__ void phase_ssd_naive(const Params& p, const Ctx& c) {
    unsigned char* ws = p.ws;
    const bf16_t* P = (const bf16_t*)(ws + WS_P); const bf16_t* XT = (const bf16_t*)(ws + WS_XT);
    const bf16_t* BMR = (const bf16_t*)(ws + WS_BMR); const bf16_t* CMR = (const bf16_t*)(ws + WS_CMR);
    const float* DT = (const float*)(ws + WS_DT); float* YACC = (float*)(ws + WS_ST); bf16_t* YZ = (bf16_t*)(ws + WS_YZ);
    const int pp = c.tid >> 3, nq = c.tid & 7;
    for (int item = c.bid; item < 32; item += c.G) {
        const int b = item >> 4, h = item & 15, g = h >> 3;
        const float dsk = p.in[9][h];
        for (int dir = 0; dir < 2; ++dir) {
            const float A = -expf(dir ? p.in[8][h] : p.in[7][h]);
            float st[16];
#pragma unroll
            for (int i = 0; i < 16; ++i) st[i] = 0.f;
            int t = dir ? S - 1 : 0;
            size_t tok = (size_t)b * S + t;
            u32x4 nb0 = *(const u32x4*)(BMR + tok * 256 + g * 128 + nq * 16), nb1 = *(const u32x4*)(BMR + tok * 256 + g * 128 + nq * 16 + 8);
            u32x4 nc0 = *(const u32x4*)(CMR + tok * 256 + g * 128 + nq * 16), nc1 = *(const u32x4*)(CMR + tok * 256 + g * 128 + nq * 16 + 8);
            float nx = bf2f(XT[((((size_t)b * 64 + (t >> 7)) * 16 + h) * 64 + pp) * 128 + (t & 127)]);
            float ndt = DT[((size_t)dir * M + tok) * 16 + h];
            for (int step = 0; step < S; ++step) {
                const u32x4 b0 = nb0, b1 = nb1, c0 = nc0, c1 = nc1; const float x = nx, dt = ndt; const size_t tokc = tok;
                if (step + 1 < S) {
                    t = dir ? S - 2 - step : step + 1; tok = (size_t)b * S + t;
                    nb0 = *(const u32x4*)(BMR + tok * 256 + g * 128 + nq * 16); nb1 = *(const u32x4*)(BMR + tok * 256 + g * 128 + nq * 16 + 8);
                    nc0 = *(const u32x4*)(CMR + tok * 256 + g * 128 + nq * 16); nc1 = *(const u32x4*)(CMR + tok * 256 + g * 128 + nq * 16 + 8);
                    nx = bf2f(XT[((((size_t)b * 64 + (t >> 7)) * 16 + h) * 64 + pp) * 128 + (t & 127)]);
                    ndt = DT[((size_t)dir * M + tok) * 16 + h];
                }
                const float dec = __expf(dt * A), xdt = x * dt;
                float part = 0.f;
#define SSD_STEP(i, BW, CW, LOHI) { st[i] = fmaf(st[i], dec, LOHI(BW) * xdt); part = fmaf(LOHI(CW), st[i], part); }
                SSD_STEP(0, b0.x, c0.x, bflo) SSD_STEP(1, b0.x, c0.x, bfhi) SSD_STEP(2, b0.y, c0.y, bflo) SSD_STEP(3, b0.y, c0.y, bfhi)
                SSD_STEP(4, b0.z, c0.z, bflo) SSD_STEP(5, b0.z, c0.z, bfhi) SSD_STEP(6, b0.w, c0.w, bflo) SSD_STEP(7, b0.w, c0.w, bfhi)
                SSD_STEP(8, b1.x, c1.x, bflo) SSD_STEP(9, b1.x, c1.x, bfhi) SSD_STEP(10, b1.y, c1.y, bflo) SSD_STEP(11, b1.y, c1.y, bfhi)
                SSD_STEP(12, b1.z, c1.z, bflo) SSD_STEP(13, b1.z, c1.z, bfhi) SSD_STEP(14, b1.w, c1.w, bflo) SSD_STEP(15, b1.w, c1.w, bfhi)
#undef SSD_STEP
                part += __shfl_xor(part, 1); part += __shfl_xor(part, 2); part += __shfl_xor(part, 4);
                if (nq == 0) {
                    const size_t o = tokc * 1024 + h * 64 + pp;
                    if (dir == 0) YACC[o] = part + x * dsk;
                    else { const float y = YACC[o] + part; const float z = bf2f(P[tokc * NPROJ + PZ + h * 64 + pp]); YZ[o] = (bf16_t)f2bf(y * z * sigmoidf_(z)); }
                }
            }
        }
    }
}


typedef short bf16x8 __attribute__((ext_vector_type(8)));
typedef float f32x16 __attribute__((ext_vector_type(16)));
constexpr int TS = 136;
__device__ __forceinline__ bf16x8 ldfrag(const LAS bf16_t* tile, int row, int k0) { return *(const LAS bf16x8*)(tile + row * TS + k0); }
template <int ROWS> __device__ __forceinline__ void load_tile128(LAS bf16_t* dst, const bf16_t* src, int ld, int tid) {
    constexpr int N = ROWS * 16 / 512;
    u32x4 v[N];
#pragma unroll
    for (int i = 0; i < N; ++i) { const int idx = tid + 512 * i; v[i] = *(const u32x4*)(src + (size_t)(idx >> 4) * ld + (idx & 15) * 8); }
#pragma unroll
    for (int i = 0; i < N; ++i) { const int idx = tid + 512 * i; *(LAS u32x4*)(dst + (idx >> 4) * TS + (idx & 15) * 8) = v[i]; }
}
__device__ __forceinline__ void phase_ssd_states(const Params& p, const Ctx& c) {
    unsigned char* ws = p.ws;
    const bf16_t* XT = (const bf16_t*)(ws + WS_XT); const bf16_t* BMT = (const bf16_t*)(ws + WS_BMT);
    const float* DT = (const float*)(ws + WS_DT); const float* ACS = (const float*)(ws + WS_ACS); bf16_t* ST = (bf16_t*)(ws + WS_PREV);
    LAS bf16_t* BTs = (LAS bf16_t*)c.lds; LAS bf16_t* XTf = BTs + 128 * TS; LAS bf16_t* XTb = XTf + 64 * TS; LAS float* wd = (LAS float*)(XTb + 64 * TS);
    const int tid = c.tid, lane = c.lane, r = lane & 31, hh = lane >> 5;
    for (int unit = c.bid; unit < 256; unit += c.G) {
        const int b = unit >> 7, ch = (unit >> 1) & 63, g = unit & 1;
        __syncthreads();
        load_tile128<128>(BTs, BMT + ((size_t)(b * 64 + ch) * 2 + g) * 128 * 128, 128, tid);
        u32x4 xv0, xv1; float pacs = 0.f, pdt = 0.f, paend = 0.f;
        const int wd_d = (tid >> 7) & 1, wd_l = tid & 127; const size_t wd_t0 = (size_t)wd_d * M + (size_t)b * S + ch * 128;
#define S1_PREFETCH(H) do { const bf16_t* xt_ = XT + ((size_t)(b * 64 + ch) * 16 + (H)) * 64 * 128; \
            xv0 = *(const u32x4*)(xt_ + (tid >> 4) * 128 + (tid & 15) * 8); xv1 = *(const u32x4*)(xt_ + ((tid + 512) >> 4) * 128 + (tid & 15) * 8); \
            if (tid < 256) { pacs = ACS[(wd_t0 + wd_l) * 16 + (H)]; pdt = DT[(wd_t0 + wd_l) * 16 + (H)]; paend = ACS[(wd_t0 + (wd_d ? 0 : 127)) * 16 + (H)]; } } while (0)
        S1_PREFETCH(g * 8);
#pragma unroll 1
        for (int h8 = 0; h8 < 8; ++h8) {
            const int h = g * 8 + h8;
            __syncthreads();
            if (tid < 256) wd[wd_d * 128 + wd_l] = pdt * __expf(paend - pacs);
            __syncthreads();
            {
                const u32x4 vv[2] = {xv0, xv1};
#pragma unroll
                for (int i = 0; i < 2; ++i) { const int idx = tid + 512 * i, pr = idx >> 4, l0 = (idx & 15) * 8; const u32x4 v = vv[i];
                    const float x[8] = {bflo(v.x), bfhi(v.x), bflo(v.y), bfhi(v.y), bflo(v.z), bfhi(v.z), bflo(v.w), bfhi(v.w)};
                    const f32x4 wf0 = *(const LAS f32x4*)(wd + l0), wf1 = *(const LAS f32x4*)(wd + l0 + 4), wb0 = *(const LAS f32x4*)(wd + 128 + l0), wb1 = *(const LAS f32x4*)(wd + 128 + l0 + 4);
                    u32x4 of, ob;
                    of.x = pk2(x[0] * wf0[0], x[1] * wf0[1]); of.y = pk2(x[2] * wf0[2], x[3] * wf0[3]); of.z = pk2(x[4] * wf1[0], x[5] * wf1[1]); of.w = pk2(x[6] * wf1[2], x[7] * wf1[3]);
                    ob.x = pk2(x[0] * wb0[0], x[1] * wb0[1]); ob.y = pk2(x[2] * wb0[2], x[3] * wb0[3]); ob.z = pk2(x[4] * wb1[0], x[5] * wb1[1]); ob.w = pk2(x[6] * wb1[2], x[7] * wb1[3]);
                    *(LAS u32x4*)(XTf + pr * TS + l0) = of; *(LAS u32x4*)(XTb + pr * TS + l0) = ob; }
            }
            if (h8 < 7) S1_PREFETCH(h + 1);
            __syncthreads();
            { const int d = c.wave >> 2, nb = c.wave & 3; const LAS bf16_t* XTd = d ? XTb : XTf;
              bf16_t* st = ST + ((((size_t)(d * 2 + b) * 64 + ch) * 16 + h) * 64) * 128;
#pragma unroll
              for (int pb = 0; pb < 2; ++pb) { f32x16 acc = {};
#pragma unroll
                for (int ks = 0; ks < 8; ++ks) acc = __builtin_amdgcn_mfma_f32_32x32x16_bf16(ldfrag(XTd, pb * 32 + r, ks * 16 + 8 * hh), ldfrag(BTs, nb * 32 + r, ks * 16 + 8 * hh), acc, 0, 0, 0);
#pragma unroll
                for (int i = 0; i < 16; ++i) { const int pp = pb * 32 + (i & 3) + 8 * (i >> 2) + 4 * hh; st[(size_t)pp * 128 + nb * 32 + r] = (bf16_t)f2bf(acc[i]); } } }
        }
#undef S1_PREFETCH
    }
}
__device__ __forceinline__ void phase_ssd_scan(const Params& p, const Ctx& c) {
    unsigned char* ws = p.ws;
    const float* CDEC = (const float*)(ws + WS_CDEC); bf16_t* PREV = (bf16_t*)(ws + WS_PREV);
    for (int idx = c.bid * 512 + c.tid; idx < 131072; idx += c.G * 512) {
        const int n4 = idx & 31, pp = (idx >> 5) & 63, h = (idx >> 11) & 15, b = (idx >> 15) & 1, d = idx >> 16;
        f32x4 run = {0.f, 0.f, 0.f, 0.f};
        const size_t obase = ((size_t)(d * 2 + b) * 64 * 16 + h) * 64 * 128 + (size_t)pp * 128 + n4 * 4;
        const float* cd = CDEC + (d * 2 + b) * 64 * 16 + h;
#pragma unroll 1
        for (int s0 = 0; s0 < 64; s0 += 16) {
            u32x2 sv[16]; float dec[16];
#pragma unroll
            for (int i = 0; i < 16; ++i) { const int ch = d ? 63 - (s0 + i) : s0 + i; sv[i] = *(const u32x2*)(PREV + obase + (size_t)ch * (16 * 64 * 128)); dec[i] = cd[ch * 16]; }
#pragma unroll
            for (int i = 0; i < 16; ++i) { const int ch = d ? 63 - (s0 + i) : s0 + i;
                u32x2 w; w.x = pk2(run.x, run.y); w.y = pk2(run.z, run.w); *(u32x2*)(PREV + obase + (size_t)ch * (16 * 64 * 128)) = w;
                run.x = fmaf(run.x, dec[i], bflo(sv[i].x)); run.y = fmaf(run.y, dec[i], bfhi(sv[i].x)); run.z = fmaf(run.z, dec[i], bflo(sv[i].y)); run.w = fmaf(run.w, dec[i], bfhi(sv[i].y)); }
        }
    }
}
__device__ __forceinline__ void phase_ssd_out(const Params& p, const Ctx& c) {
    unsigned char* ws = p.ws;
    const bf16_t* P = (const bf16_t*)(ws + WS_P); const bf16_t* XT = (const bf16_t*)(ws + WS_XT);
    const bf16_t* BMR = (const bf16_t*)(ws + WS_BMR); const bf16_t* CMR = (const bf16_t*)(ws + WS_CMR); const bf16_t* PREV = (const bf16_t*)(ws + WS_PREV);
    const float* DT = (const float*)(ws + WS_DT); const float* ACS = (const float*)(ws + WS_ACS); bf16_t* YZ = (bf16_t*)(ws + WS_YZ);
    LAS bf16_t* Cs = (LAS bf16_t*)c.lds; LAS bf16_t* Ms = Cs + 128 * TS; LAS bf16_t* XTs = Ms + 128 * TS; LAS bf16_t* PF = XTs + 64 * TS; LAS bf16_t* PB = PF + 64 * TS;
    LAS float* vec = (LAS float*)(PB + 64 * TS);
    constexpr int ZS = 72; LAS bf16_t* Zs = (LAS bf16_t*)(vec + 512); LAS float* dskl = (LAS float*)(Zs + 128 * ZS);
    const int tid = c.tid, lane = c.lane, r = lane & 31, hh = lane >> 5, wave = c.wave;
    for (int unit = c.bid; unit < 256; unit += c.G) {
        const int b = unit >> 7, ch = (unit >> 1) & 63, g = unit & 1;
        const size_t tok0 = (size_t)b * S + ch * 128;
        __syncthreads();
        load_tile128<128>(Cs, CMR + tok0 * 256 + g * 128, 256, tid);
        load_tile128<128>(Ms, BMR + tok0 * 256 + g * 128, 256, tid);
        u32x4 px0, px1, pf0, pf1, pb0, pb1, pz0, pz1; float pvec;
        const int t_r0 = tid >> 4, t_r1 = (tid + 512) >> 4, t_c = (tid & 15) * 8;
#define S3_PREFETCH(H) do { const bf16_t* xt_ = XT + ((size_t)(b * 64 + ch) * 16 + (H)) * 64 * 128; \
            const bf16_t* f_ = PREV + ((((size_t)(0 * 2 + b) * 64 + ch) * 16 + (H)) * 64) * 128; const bf16_t* b_ = PREV + ((((size_t)(1 * 2 + b) * 64 + ch) * 16 + (H)) * 64) * 128; \
            px0 = *(const u32x4*)(xt_ + t_r0 * 128 + t_c); px1 = *(const u32x4*)(xt_ + t_r1 * 128 + t_c); pf0 = *(const u32x4*)(f_ + t_r0 * 128 + t_c); pf1 = *(const u32x4*)(f_ + t_r1 * 128 + t_c); \
            pb0 = *(const u32x4*)(b_ + t_r0 * 128 + t_c); pb1 = *(const u32x4*)(b_ + t_r1 * 128 + t_c); \
            pz0 = *(const u32x4*)(P + (tok0 + (tid >> 3)) * NPROJ + PZ + (H) * 64 + (tid & 7) * 8); pz1 = *(const u32x4*)(P + (tok0 + 64 + (tid >> 3)) * NPROJ + PZ + (H) * 64 + (tid & 7) * 8); \
            { const int v_ = tid >> 7, l_ = tid & 127; const size_t o_ = ((size_t)(v_ & 1) * M + tok0 + l_) * 16 + (H); pvec = (v_ < 2) ? ACS[o_] : DT[o_]; } } while (0)
        S3_PREFETCH(g * 8);
        if (tid < 8) dskl[tid] = p.in[9][g * 8 + tid];
        __syncthreads();
        const int lb = wave & 3, sb0 = 2 * (wave >> 2);
        f32x16 G0 = {}, G1 = {};
#pragma unroll
        for (int ks = 0; ks < 8; ++ks) { const bf16x8 a = ldfrag(Cs, lb * 32 + r, ks * 16 + 8 * hh);
            G0 = __builtin_amdgcn_mfma_f32_32x32x16_bf16(a, ldfrag(Ms, sb0 * 32 + r, ks * 16 + 8 * hh), G0, 0, 0, 0);
            G1 = __builtin_amdgcn_mfma_f32_32x32x16_bf16(a, ldfrag(Ms, (sb0 + 1) * 32 + r, ks * 16 + 8 * hh), G1, 0, 0, 0); }
#pragma unroll 1
        for (int h8 = 0; h8 < 8; ++h8) {
            const int h = g * 8 + h8;
            __syncthreads();
            vec[tid] = pvec;
            *(LAS u32x4*)(XTs + t_r0 * TS + t_c) = px0; *(LAS u32x4*)(XTs + t_r1 * TS + t_c) = px1;
            *(LAS u32x4*)(PF + t_r0 * TS + t_c) = pf0; *(LAS u32x4*)(PF + t_r1 * TS + t_c) = pf1;
            *(LAS u32x4*)(PB + t_r0 * TS + t_c) = pb0; *(LAS u32x4*)(PB + t_r1 * TS + t_c) = pb1;
            *(LAS u32x4*)(Zs + (tid >> 3) * ZS + (tid & 7) * 8) = pz0; *(LAS u32x4*)(Zs + (64 + (tid >> 3)) * ZS + (tid & 7) * 8) = pz1;
            if (h8 < 7) S3_PREFETCH(h + 1);
            const int pbY = wave >> 2;
            __syncthreads();
#pragma unroll
            for (int t2 = 0; t2 < 2; ++t2) { const f32x16& Gt = t2 ? G1 : G0; const int sb = sb0 + t2, s = sb * 32 + r;
                const float afs = vec[s], abs_ = vec[128 + s], dfs = vec[256 + s], dbs = vec[384 + s];
                if (sb < lb) {
#pragma unroll
                    for (int i = 0; i < 16; ++i) { const int l = lb * 32 + (i & 3) + 8 * (i >> 2) + 4 * hh;
                        Ms[l * TS + s] = (bf16_t)f2bf(Gt[i] * __expf(vec[l] - afs) * dfs); }
                } else if (sb > lb) {
#pragma unroll
                    for (int i = 0; i < 16; ++i) { const int l = lb * 32 + (i & 3) + 8 * (i >> 2) + 4 * hh;
                        Ms[l * TS + s] = (bf16_t)f2bf(Gt[i] * __expf(vec[128 + l] - abs_) * dbs); }
                } else {
                    const float dsk = dskl[h8];
#pragma unroll
                    for (int i = 0; i < 16; ++i) { const int l = lb * 32 + (i & 3) + 8 * (i >> 2) + 4 * hh;
                        const float ef = __expf(fminf(vec[l] - afs, 0.f)) * dfs, eb = __expf(fminf(vec[128 + l] - abs_, 0.f)) * dbs;
                        const float tf = (s <= l) ? ef : 0.f, tb = (s >= l) ? eb : 0.f;
                        Ms[l * TS + s] = (bf16_t)f2bf(Gt[i] * (tf + tb) + (s == l ? dsk : 0.f)); }
                } }
            __syncthreads();
            { f32x16 Yd = {}, Yf = {}, Yb = {};
#pragma unroll
              for (int ks = 0; ks < 8; ++ks) { const int k0 = ks * 16 + 8 * hh;
                  Yd = __builtin_amdgcn_mfma_f32_32x32x16_bf16(ldfrag(Ms, lb * 32 + r, k0), ldfrag(XTs, pbY * 32 + r, k0), Yd, 0, 0, 0);
                  const bf16x8 a = ldfrag(Cs, lb * 32 + r, k0);
                  Yf = __builtin_amdgcn_mfma_f32_32x32x16_bf16(a, ldfrag(PF, pbY * 32 + r, k0), Yf, 0, 0, 0);
                  Yb = __builtin_amdgcn_mfma_f32_32x32x16_bf16(a, ldfrag(PB, pbY * 32 + r, k0), Yb, 0, 0, 0);
                  if (ks & 1) __builtin_amdgcn_sched_barrier(0); }
#pragma unroll
              for (int i = 0; i < 16; ++i) { const int l = lb * 32 + (i & 3) + 8 * (i >> 2) + 4 * hh;
                  const float y = Yd[i] + __expf(vec[l]) * Yf[i] + __expf(vec[128 + l]) * Yb[i];
                  const float z = bf2f(Zs[l * ZS + pbY * 32 + r]);
                  Zs[l * ZS + pbY * 32 + r] = (bf16_t)f2bf(y * z * sigmoidf_(z)); } }
            __syncthreads();
            *(u32x4*)(YZ + (tok0 + (tid >> 3)) * 1024 + h * 64 + (tid & 7) * 8) = *(const LAS u32x4*)(Zs + (tid >> 3) * ZS + (tid & 7) * 8);
            *(u32x4*)(YZ + (tok0 + 64 + (tid >> 3)) * 1024 + h * 64 + (tid & 7) * 8) = *(const LAS u32x4*)(Zs + (64 + (tid >> 3)) * ZS + (tid & 7) * 8);
        }
#undef S3_PREFETCH
    }
}

__device__ __forceinline__ void phase_rstd(const Params& p, const Ctx& c) {
    const bf16_t* YZ = (const bf16_t*)(p.ws + WS_YZ); float* RSTD = (float*)(p.ws + WS_RSTD);
    const int gw = c.bid * 8 + c.wave, NGW = c.G * 8;
    for (int m0 = gw * 4; m0 < M; m0 += NGW * 4) {
        u32x4 v[4][2];
#pragma unroll
        for (int q = 0; q < 4; ++q) { const u32x4* r = (const u32x4*)(YZ + (size_t)(m0 + q) * 1024) + c.lane; v[q][0] = r[0]; v[q][1] = r[64]; }
#pragma unroll
        for (int q = 0; q < 4; ++q) { float s = 0.f;
#pragma unroll
            for (int j = 0; j < 2; ++j) { const u32x4 w = v[q][j];
                s += bflo(w.x) * bflo(w.x) + bfhi(w.x) * bfhi(w.x) + bflo(w.y) * bflo(w.y) + bfhi(w.y) * bfhi(w.y) + bflo(w.z) * bflo(w.z) + bfhi(w.z) * bfhi(w.z) + bflo(w.w) * bflo(w.w) + bfhi(w.w) * bfhi(w.w); }
            s = wave_sum(s);
            if (c.lane == 0) RSTD[m0 + q] = rsqrtf(s * (1.f / 1024.f) + EPS); }
    }
}

__device__ __forceinline__ void phase_attn_naive(const Params& p, const Ctx& c) {
    unsigned char* ws = p.ws;
    const bf16_t* QN = (const bf16_t*)(ws + WS_QN); const bf16_t* KN = (const bf16_t*)(ws + WS_KN); const bf16_t* VB = (const bf16_t*)(ws + WS_VB);
    bf16_t* AO = (bf16_t*)(ws + WS_AO);
    LAS bf16_t* Ks = (LAS bf16_t*)c.lds; LAS bf16_t* Vs = Ks + 64 * 128;
    const int tid = c.tid, row = tid >> 2, dq = tid & 3;
    constexpr float C = 0.088388347648318440f * 1.4426950408889634f;
    for (int item = c.bid; item < 1024; item += c.G) {
        const int b = item >> 9, h = (item >> 6) & 7, qb = item & 63, kvh = h >> 2;
        const size_t tokq = (size_t)b * S + qb * 128 + row;
        float q[32], o[32];
#pragma unroll
        for (int i = 0; i < 4; ++i) { const u32x4 v = *(const u32x4*)(QN + tokq * 1024 + h * 128 + dq * 32 + i * 8);
            q[i * 8 + 0] = bflo(v.x) * C; q[i * 8 + 1] = bfhi(v.x) * C; q[i * 8 + 2] = bflo(v.y) * C; q[i * 8 + 3] = bfhi(v.y) * C;
            q[i * 8 + 4] = bflo(v.z) * C; q[i * 8 + 5] = bfhi(v.z) * C; q[i * 8 + 6] = bflo(v.w) * C; q[i * 8 + 7] = bfhi(v.w) * C; }
#pragma unroll
        for (int i = 0; i < 32; ++i) o[i] = 0.f;
        float mrun = -1e30f, lrun = 0.f;
        for (int kt = 0; kt < S / 64; ++kt) {
            __syncthreads();
            {
                const int key = tid >> 3, ch = tid & 7;
                const size_t tk = ((size_t)b * S + kt * 64 + key) * 256 + kvh * 128 + ch * 16;
                *(LAS u32x4*)(Ks + key * 128 + ch * 16) = *(const u32x4*)(KN + tk); *(LAS u32x4*)(Ks + key * 128 + ch * 16 + 8) = *(const u32x4*)(KN + tk + 8);
                *(LAS u32x4*)(Vs + key * 128 + ch * 16) = *(const u32x4*)(VB + tk); *(LAS u32x4*)(Vs + key * 128 + ch * 16 + 8) = *(const u32x4*)(VB + tk + 8);
            }
            __syncthreads();
            for (int j = 0; j < 64; ++j) {
                float s = 0.f;
#pragma unroll
                for (int i = 0; i < 4; ++i) { const u32x4 v = *(const LAS u32x4*)(Ks + j * 128 + dq * 32 + i * 8);
                    s = fmaf(q[i * 8 + 0], bflo(v.x), s); s = fmaf(q[i * 8 + 1], bfhi(v.x), s); s = fmaf(q[i * 8 + 2], bflo(v.y), s); s = fmaf(q[i * 8 + 3], bfhi(v.y), s);
                    s = fmaf(q[i * 8 + 4], bflo(v.z), s); s = fmaf(q[i * 8 + 5], bfhi(v.z), s); s = fmaf(q[i * 8 + 6], bflo(v.w), s); s = fmaf(q[i * 8 + 7], bfhi(v.w), s); }
                s += __shfl_xor(s, 1); s += __shfl_xor(s, 2);
                const float mn = fmaxf(mrun, s), al = __builtin_amdgcn_exp2f(mrun - mn), pe = __builtin_amdgcn_exp2f(s - mn);
                mrun = mn; lrun = lrun * al + pe;
#pragma unroll
                for (int i = 0; i < 4; ++i) { const u32x4 v = *(const LAS u32x4*)(Vs + j * 128 + dq * 32 + i * 8);
                    o[i * 8 + 0] = fmaf(pe, bflo(v.x), o[i * 8 + 0] * al); o[i * 8 + 1] = fmaf(pe, bfhi(v.x), o[i * 8 + 1] * al);
                    o[i * 8 + 2] = fmaf(pe, bflo(v.y), o[i * 8 + 2] * al); o[i * 8 + 3] = fmaf(pe, bfhi(v.y), o[i * 8 + 3] * al);
                    o[i * 8 + 4] = fmaf(pe, bflo(v.z), o[i * 8 + 4] * al); o[i * 8 + 5] = fmaf(pe, bfhi(v.z), o[i * 8 + 5] * al);
                    o[i * 8 + 6] = fmaf(pe, bflo(v.w), o[i * 8 + 6] * al); o[i * 8 + 7] = fmaf(pe, bfhi(v.w), o[i * 8 + 7] * al); }
            }
        }
        const float rl = 1.f / lrun;
#pragma unroll
        for (int i = 0; i < 4; ++i) { u32x4 w;
            w.x = pk2(o[i * 8 + 0] * rl, o[i * 8 + 1] * rl); w.y = pk2(o[i * 8 + 2] * rl, o[i * 8 + 3] * rl); w.z = pk2(o[i * 8 + 4] * rl, o[i * 8 + 5] * rl); w.w = pk2(o[i * 8 + 6] * rl, o[i * 8 + 7] * rl);
            *(u32x4*)(AO + tokq * 1024 + h * 128 + dq * 32 + i * 8) = w; }
    }
}

namespace attn {
typedef unsigned short bf16;
constexpr int   D = 128, NW = 8, QBLK = 32, KVBLK = 64;
constexpr float SCALE = 0.088388347648318440f;
constexpr float THR = 8.f;
constexpr int SDEPTH = 2;
constexpr int LDQ = 1024, LDK = 256, LDO = 1024;
constexpr size_t SHM_V = KVBLK * D * 2, SHM_K = KVBLK * D * 2, SHM_ATTN = 2 * SHM_V + 2 * SHM_K + NW * 64 * 4;
using bf16x8 = __attribute__((ext_vector_type(8))) short;
using s16x4  = __attribute__((ext_vector_type(4))) short;
using f32x16 = __attribute__((ext_vector_type(16))) float;
using f32x8  = __attribute__((ext_vector_type(8))) float;
using u32x4  = __attribute__((ext_vector_type(4))) unsigned;
#define KSWZ(row, colB) ((row) * 256 + ((colB) ^ (((row) & 7) << 4)))
#define SBAR() __builtin_amdgcn_sched_barrier(0)
__device__ __forceinline__ int crow(int r, int hi) { return (r & 3) + 8 * (r >> 2) + 4 * hi; }
__device__ __forceinline__ unsigned cvtpk(float lo, float hi) {
  unsigned r; asm volatile("v_cvt_pk_bf16_f32 %0, %1, %2" : "=v"(r) : "v"(lo), "v"(hi)); return r;
}
template <typename TIn> struct Stage;
template <> struct Stage<bf16>  { using T = bf16x8;
  __device__ static __forceinline__ T ld8(const bf16* p) { return *reinterpret_cast<const bf16x8*>(p); }
  __device__ static __forceinline__ bf16x8 tobf(T x) { return x; } };
template <> struct Stage<float> { using T = f32x8;
  __device__ static __forceinline__ T ld8(const float* p) { return *reinterpret_cast<const f32x8*>(p); }
  __device__ static __forceinline__ bf16x8 tobf(T x) {
    u32x4 w = {cvtpk(x[0], x[1]), cvtpk(x[2], x[3]), cvtpk(x[4], x[5]), cvtpk(x[6], x[7])}; return *reinterpret_cast<bf16x8*>(&w); } };

__device__ __forceinline__ void partialSM(f32x16& p0, f32x16& p1, float& m_reg, float& mn, float& alpha) {
  constexpr float C = SCALE * 1.4426950408889634f;
  float pmax = p0[0]; for (int r = 1; r < 16; ++r) pmax = fmaxf(pmax, p0[r]); for (int r = 0; r < 16; ++r) pmax = fmaxf(pmax, p1[r]);
  { auto rr = __builtin_amdgcn_permlane32_swap(__float_as_uint(pmax), __float_as_uint(pmax), false, false);
    pmax = fmaxf(__uint_as_float(rr[0]), __uint_as_float(rr[1])); }
  if (__builtin_expect(__all(pmax - m_reg <= THR / SCALE), 1)) { mn = m_reg; alpha = 1.f; }
  else { mn = fmaxf(m_reg, pmax); alpha = __builtin_amdgcn_exp2f((m_reg - mn) * C); m_reg = mn; }
  float mnC = -mn * C;
  for (int r = 0; r < 16; ++r) p0[r] = fmaf(p0[r], C, mnC); for (int r = 0; r < 16; ++r) p1[r] = fmaf(p1[r], C, mnC);
  for (int r = 0; r < 16; ++r) p0[r] = __builtin_amdgcn_exp2f(p0[r]);
}
__device__ __forceinline__ void finishSM(f32x16& p0, f32x16& p1, float alpha, float& l_reg, bf16x8& pa0, bf16x8& pa1, bf16x8& pa2, bf16x8& pa3) {
  for (int r = 0; r < 16; ++r) p1[r] = __builtin_amdgcn_exp2f(p1[r]);
  float ps = 0; for (int r = 0; r < 16; ++r) ps += p0[r]; for (int r = 0; r < 16; ++r) ps += p1[r];
  { auto rr = __builtin_amdgcn_permlane32_swap(__float_as_uint(ps), __float_as_uint(ps), false, false);
    ps = __uint_as_float(rr[0]) + __uint_as_float(rr[1]); }
  l_reg = l_reg * alpha + ps;
#define PK4(P, BASE, OUT) do { unsigned a0 = cvtpk(P[BASE + 0], P[BASE + 1]), a1 = cvtpk(P[BASE + 2], P[BASE + 3]);   \
    unsigned b0 = cvtpk(P[BASE + 4], P[BASE + 5]), b1 = cvtpk(P[BASE + 6], P[BASE + 7]);                              \
    auto r0 = __builtin_amdgcn_permlane32_swap(a0, b0, false, false); auto r1 = __builtin_amdgcn_permlane32_swap(a1, b1, false, false); \
    u32x4 w = {r0[0], r1[0], r0[1], r1[1]}; OUT = *reinterpret_cast<bf16x8*>(&w); } while (0)
  PK4(p0, 0, pa0); PK4(p0, 8, pa1); PK4(p1, 0, pa2); PK4(p1, 8, pa3);
#undef PK4
}
__device__ __forceinline__ void qkt(f32x16& p0, f32x16& p1, const bf16* Ks, const bf16x8* qr, int r32, int hi) {
  p0 = f32x16{}; p1 = f32x16{};
  for (int d0 = 0; d0 < 8; ++d0) { int cb = (d0 * 16 + hi * 8) * 2;
    bf16x8 b0 = *reinterpret_cast<const bf16x8*>((const char*)Ks + KSWZ(r32, cb));
    bf16x8 b1 = *reinterpret_cast<const bf16x8*>((const char*)Ks + KSWZ(32 + r32, cb));
    p0 = __builtin_amdgcn_mfma_f32_32x32x16_bf16(b0, qr[d0], p0, 0, 0, 0);
    p1 = __builtin_amdgcn_mfma_f32_32x32x16_bf16(b1, qr[d0], p1, 0, 0, 0); }
}
__device__ __forceinline__ int v_st(int k, int c) { const int kk = (k & ~0xC) | ((k & 4) << 1) | ((k & 8) >> 1); return ((kk >> 3) * 4 + (c >> 5)) * 512 + ((kk & 7) * 32 + (c & 31)) * 2; }
__device__ __forceinline__ int v_rd_base(int lane) { return ((lane & 3) << 3) | (((lane >> 2) & 3) << 6) | (((lane >> 4) & 1) << 5) | (((lane >> 5) & 1) << 8); }
constexpr int v_rd_off(int d0, int ks, int half) { return d0 * 512 + ks * 4096 + half * 2048; }
template <int OFF> __device__ __forceinline__ s16x4 tr_read(int vb) {
  s16x4 r; asm volatile("ds_read_b64_tr_b16 %0, %1 offset:%2" : "=&v"(r) : "v"(vb), "i"(OFF) : "memory"); return r;
}
template <int D0> __device__ __forceinline__ void pv_one(f32x16& od, int vb, bf16x8 pa0, bf16x8 pa1, bf16x8 pa2, bf16x8 pa3) {
  const s16x4 l0 = tr_read<v_rd_off(D0, 0, 0)>(vb), h0 = tr_read<v_rd_off(D0, 0, 1)>(vb), l1 = tr_read<v_rd_off(D0, 1, 0)>(vb), h1 = tr_read<v_rd_off(D0, 1, 1)>(vb);
  const s16x4 l2 = tr_read<v_rd_off(D0, 2, 0)>(vb), h2 = tr_read<v_rd_off(D0, 2, 1)>(vb), l3 = tr_read<v_rd_off(D0, 3, 0)>(vb), h3 = tr_read<v_rd_off(D0, 3, 1)>(vb);
  asm volatile("s_waitcnt lgkmcnt(0)" ::: "memory"); SBAR();
#define PK(L, H) (bf16x8){L[0], L[1], L[2], L[3], H[0], H[1], H[2], H[3]}
  od = __builtin_amdgcn_mfma_f32_32x32x16_bf16(pa0, PK(l0, h0), od, 0, 0, 0);
  od = __builtin_amdgcn_mfma_f32_32x32x16_bf16(pa1, PK(l1, h1), od, 0, 0, 0);
  od = __builtin_amdgcn_mfma_f32_32x32x16_bf16(pa2, PK(l2, h2), od, 0, 0, 0);
  od = __builtin_amdgcn_mfma_f32_32x32x16_bf16(pa3, PK(l3, h3), od, 0, 0, 0);
#undef PK
}
__device__ __forceinline__ void pv_d0(f32x16* o, int vb, bf16x8 pa0, bf16x8 pa1, bf16x8 pa2, bf16x8 pa3) {
  pv_one<0>(o[0], vb, pa0, pa1, pa2, pa3); pv_one<1>(o[1], vb, pa0, pa1, pa2, pa3); pv_one<2>(o[2], vb, pa0, pa1, pa2, pa3); pv_one<3>(o[3], vb, pa0, pa1, pa2, pa3);
}

template <typename TQ>
__device__ __forceinline__ void attn_dense_body(const TQ* __restrict__ Qb, const bf16* __restrict__ Kh, const bf16* __restrict__ Vh,
                                                bf16* __restrict__ Ob, int seq, char* lds) {
  using St = Stage<bf16>; using SQ = Stage<TQ>;
  const int tid = threadIdx.x, wid = tid >> 6, lane = tid & 63, r32 = lane & 31, hi = lane >> 5;
  bf16* V_lds = (bf16*)lds; bf16* K_lds = (bf16*)(lds + 2 * SHM_V);
  float* ws = (float*)(lds + 2 * SHM_V + 2 * SHM_K) + wid * 64; float* li_l = ws; float* al_l = ws + 32;
  float m_reg = -1e30f, l_reg = 0; f32x16 o[4] = {}; bf16x8 qr[8];
  const TQ* Qw = Qb + (long)(wid * QBLK + r32) * LDQ + hi * 8;
#pragma unroll
  for (int d0 = 0; d0 < 8; ++d0) qr[d0] = SQ::tobf(SQ::ld8(Qw + d0 * 16));
  const int sr = tid >> 4, sc = (tid & 15) * 8, vst0 = v_st(sr, sc), vst1 = v_st(32 + sr, sc);
  const int vb0 = (int)(uintptr_t)V_lds + v_rd_base(lane);
  struct { typename St::T vs0, vs1, ks0, ks1; } sr_[SDEPTH];
#define SLOAD(i, k0) do { sr_[i].vs0 = St::ld8(&Vh[(long)((k0) + sr) * LDK + sc]); sr_[i].vs1 = St::ld8(&Vh[(long)((k0) + 32 + sr) * LDK + sc]); \
    sr_[i].ks0 = St::ld8(&Kh[(long)((k0) + sr) * LDK + sc]); sr_[i].ks1 = St::ld8(&Kh[(long)((k0) + 32 + sr) * LDK + sc]); } while (0)
#define SWRITE(b, i) do { *(bf16x8*)((char*)V_lds + (b) * SHM_V + vst0) = St::tobf(sr_[i].vs0);          \
    *(bf16x8*)((char*)V_lds + (b) * SHM_V + vst1) = St::tobf(sr_[i].vs1); int kc = sc * 2;               \
    *(bf16x8*)((char*)K_lds + (b) * SHM_K + KSWZ(sr, kc)) = St::tobf(sr_[i].ks0);                       \
    *(bf16x8*)((char*)K_lds + (b) * SHM_K + KSWZ(32 + sr, kc)) = St::tobf(sr_[i].ks1); } while (0)
#define SWAIT() do { if constexpr (SDEPTH == 2) asm volatile("s_waitcnt vmcnt(4)" ::: "memory"); else asm volatile("s_waitcnt vmcnt(0)" ::: "memory"); } while (0)
#define RESC(a) do { if (__any((a) < 1.f)) { if (hi == 0) al_l[r32] = (a); asm volatile("s_waitcnt lgkmcnt(0)" ::: "memory"); \
    for (int d = 0; d < 4; ++d) for (int r = 0; r < 16; ++r) o[d][r] *= al_l[crow(r, hi)]; } } while (0)
  f32x16 pA0, pA1, pB0, pB1; float mnA, mnB, alA, alB; bf16x8 pa0, pa1, pa2, pa3; const int NT = seq / KVBLK;
  constexpr int SE = 0, SO = SDEPTH - 1;
  SLOAD(SE, 0); asm volatile("s_waitcnt vmcnt(0)" ::: "memory"); SWRITE(0, SE); __syncthreads();
  qkt(pA0, pA1, K_lds, qr, r32, hi); partialSM(pA0, pA1, m_reg, mnA, alA);
  SLOAD(SO, KVBLK); if constexpr (SDEPTH == 2) { if (2 < NT) SLOAD(SE, 2 * KVBLK); }
  SWAIT(); SWRITE(1, SO); __syncthreads();
  for (int j = 1; j + 1 < NT; j += 2) {
    SBAR(); qkt(pB0, pB1, (bf16*)((char*)K_lds + SHM_K), qr, r32, hi);
    finishSM(pA0, pA1, alA, l_reg, pa0, pa1, pa2, pa3); SBAR();
    SLOAD(SO, (j + SDEPTH) * KVBLK); SBAR();
    pv_d0(o, vb0, pa0, pa1, pa2, pa3); partialSM(pB0, pB1, m_reg, mnB, alB);
    __syncthreads(); SWAIT(); SWRITE(0, SE);
    RESC(alB); __syncthreads();
    SBAR(); qkt(pA0, pA1, K_lds, qr, r32, hi);
    finishSM(pB0, pB1, alB, l_reg, pa0, pa1, pa2, pa3); SBAR();
    if (SDEPTH == 1 || j + 3 < NT) SLOAD(SE, (j + 1 + SDEPTH) * KVBLK); SBAR();
    pv_d0(o, vb0 + (int)SHM_V, pa0, pa1, pa2, pa3); partialSM(pA0, pA1, m_reg, mnA, alA);
    __syncthreads(); SWAIT(); SWRITE(1, SO);
    RESC(alA); __syncthreads();
  }
  SBAR(); qkt(pB0, pB1, (bf16*)((char*)K_lds + SHM_K), qr, r32, hi);
  finishSM(pA0, pA1, alA, l_reg, pa0, pa1, pa2, pa3); SBAR();
  pv_d0(o, vb0, pa0, pa1, pa2, pa3); partialSM(pB0, pB1, m_reg, mnB, alB);
  __syncthreads(); RESC(alB);
  finishSM(pB0, pB1, alB, l_reg, pa0, pa1, pa2, pa3); SBAR();
  pv_d0(o, vb0 + (int)SHM_V, pa0, pa1, pa2, pa3);
  if (hi == 0) li_l[r32] = l_reg; asm volatile("s_waitcnt lgkmcnt(0)" ::: "memory");
  float rli[16];
#pragma unroll
  for (int r = 0; r < 16; ++r) rli[r] = __builtin_amdgcn_rcpf(li_l[crow(r, hi)]);
  bf16* Ow = Ob + (long)(wid * QBLK) * LDO;
#pragma unroll
  for (int r = 0; r < 16; ++r) { int orow = crow(r, hi);
    for (int d0 = 0; d0 < 4; ++d0) Ow[(long)orow * LDO + d0 * 32 + r32] = (bf16)f2bf(o[d0][r] * rli[r]); }
#undef SLOAD
#undef SWRITE
#undef SWAIT
#undef RESC
}
}


namespace attn8 {
typedef int v8i __attribute__((ext_vector_type(8)));
typedef float f32x16 __attribute__((ext_vector_type(16)));
typedef unsigned u32x4_ __attribute__((ext_vector_type(4)));
constexpr int QBLK = 32, KVBLK = 64;
constexpr float SCALE = 0.088388347648318440f;
constexpr float THR = 0.69f;
constexpr size_t SHM_K = 64 * 128, SHM_V = 128 * 64, SHM_ATTN = 2 * SHM_K + 2 * SHM_V + 8 * 64 * 4;
__device__ __forceinline__ int crow(int r, int hi) { return (r & 3) + 8 * (r >> 2) + 4 * hi; }
__device__ __forceinline__ int kswz(int row, int colB) { return row * 128 + (colB ^ (((row >> 1) & 7) << 4)); }
__device__ __forceinline__ int vswz(int d, int slot) { return d * 64 + ((slot ^ ((d >> 2) & 3)) << 4); }
__device__ __forceinline__ v8i cat8(const u32x4_& lo, const u32x4_& hi) { v8i r; r[0] = (int)lo.x; r[1] = (int)lo.y; r[2] = (int)lo.z; r[3] = (int)lo.w; r[4] = (int)hi.x; r[5] = (int)hi.y; r[6] = (int)hi.z; r[7] = (int)hi.w; return r; }
template <bool LAST> __device__ __forceinline__ void mfma8(f32x16& acc, const v8i& a, const v8i& b, int scl) {
    acc = __builtin_amdgcn_mfma_scale_f32_32x32x64_f8f6f4(a, b, acc, 0, 0, 0, scl, 0, scl);
}
__device__ __forceinline__ void partialSM(f32x16& p0, f32x16& p1, float& m_reg, float& mn, float& alpha) {
    constexpr float C = SCALE * 1.4426950408889634f;
    float pmax = p0[0];
#pragma unroll
    for (int r = 1; r < 16; ++r) pmax = fmaxf(pmax, p0[r]);
#pragma unroll
    for (int r = 0; r < 16; ++r) pmax = fmaxf(pmax, p1[r]);
    { auto rr = __builtin_amdgcn_permlane32_swap(__float_as_uint(pmax), __float_as_uint(pmax), false, false); pmax = fmaxf(__uint_as_float(rr[0]), __uint_as_float(rr[1])); }
    if (__builtin_expect(__all(pmax - m_reg <= THR / SCALE), 1)) { mn = m_reg; alpha = 1.f; }
    else { mn = fmaxf(m_reg, pmax); alpha = __builtin_amdgcn_exp2f((m_reg - mn) * C); m_reg = mn; }
    const float mnC = 7.f - mn * C;
#pragma unroll
    for (int r = 0; r < 16; ++r) p0[r] = fmaf(p0[r], C, mnC);
#pragma unroll
    for (int r = 0; r < 16; ++r) p1[r] = fmaf(p1[r], C, mnC);
#pragma unroll
    for (int r = 0; r < 16; ++r) p0[r] = __builtin_amdgcn_exp2f(p0[r]);
}
__device__ __forceinline__ void finishSM(f32x16& p0, f32x16& p1, float alpha, float& l_reg, v8i& pa) {
#pragma unroll
    for (int r = 0; r < 16; ++r) p1[r] = __builtin_amdgcn_exp2f(p1[r]);
    float ps = 0;
#pragma unroll
    for (int r = 0; r < 16; ++r) ps += p0[r];
#pragma unroll
    for (int r = 0; r < 16; ++r) ps += p1[r];
    { auto rr = __builtin_amdgcn_permlane32_swap(__float_as_uint(ps), __float_as_uint(ps), false, false); ps = __uint_as_float(rr[0]) + __uint_as_float(rr[1]); }
    l_reg = l_reg * alpha + ps;
#pragma unroll
    for (int w = 0; w < 4; ++w) { pa[w] = (int)pack4_fp8(p0[4 * w], p0[4 * w + 1], p0[4 * w + 2], p0[4 * w + 3]); pa[4 + w] = (int)pack4_fp8(p1[4 * w], p1[4 * w + 1], p1[4 * w + 2], p1[4 * w + 3]); }
}
__device__ __forceinline__ void qkt(f32x16& p0, f32x16& p1, const char* Ks, const v8i* qf, int r32, int hi, int scl) {
    p0 = f32x16{}; p1 = f32x16{};
#pragma unroll
    for (int s = 0; s < 2; ++s) { const int cb = 64 * s + 32 * hi;
        const v8i a0 = cat8(*(const u32x4_*)(Ks + kswz(r32, cb)), *(const u32x4_*)(Ks + kswz(r32, cb + 16)));
        const v8i a1 = cat8(*(const u32x4_*)(Ks + kswz(32 + r32, cb)), *(const u32x4_*)(Ks + kswz(32 + r32, cb + 16)));
        if (s == 0) { mfma8<false>(p0, a0, qf[s], scl); mfma8<false>(p1, a1, qf[s], scl); }
        else { mfma8<false>(p0, a0, qf[s], scl); mfma8<true>(p1, a1, qf[s], scl); } }
}
__device__ __forceinline__ void pv(f32x16* o, const char* Vs, const v8i& pa, int r32, int hi, int scl) {
#pragma unroll
    for (int d0 = 0; d0 < 4; ++d0) { const int d = d0 * 32 + r32;
        const v8i b = cat8(*(const u32x4_*)(Vs + vswz(d, 2 * hi)), *(const u32x4_*)(Vs + vswz(d, 2 * hi + 1)));
        if (d0 == 3) mfma8<true>(o[d0], pa, b, scl); else mfma8<false>(o[d0], pa, b, scl); }
}
__device__ __forceinline__ void body(const unsigned char* __restrict__ Qb, const unsigned char* __restrict__ Kh, const unsigned char* __restrict__ Vt, unsigned short* __restrict__ Ob, int seq, char* lds) {
    const int tid = threadIdx.x, wid = tid >> 6, lane = tid & 63, r32 = lane & 31, hi = lane >> 5;
    const int scl = 0x7f7f7f7f;
    char* K_lds = lds; char* V_lds = lds + 2 * SHM_K;
    float* ws = (float*)(lds + 2 * SHM_K + 2 * SHM_V) + wid * 64; float* li_l = ws; float* al_l = ws + 32;
    float m_reg = -1e30f, l_reg = 0; f32x16 o[4] = {}; v8i qf[2];
    { const unsigned char* Qw = Qb + (long)(wid * QBLK + r32) * 1024 + 32 * hi;
#pragma unroll
      for (int s = 0; s < 2; ++s) qf[s] = cat8(*(const u32x4_*)(Qw + 64 * s), *(const u32x4_*)(Qw + 64 * s + 16)); }
    const int kr = tid >> 3, kc = (tid & 7) * 16, kdst = kswz(kr, kc);
    const int vd = tid >> 2, vsl = tid & 3, vdst = vswz(vd, vsl);
    struct { u32x4_ k, v; } sr_[2];
#define SLOAD(i, t) do { sr_[i].k = *(const u32x4_*)(Kh + (long)((t) * KVBLK + kr) * 256 + kc); sr_[i].v = *(const u32x4_*)(Vt + (long)(t) * 8192 + vd * 64 + vsl * 16); } while (0)
#define SWRITE(b, i) do { *(u32x4_*)(K_lds + (b) * SHM_K + kdst) = sr_[i].k; *(u32x4_*)(V_lds + (b) * SHM_V + vdst) = sr_[i].v; } while (0)
#define SWAIT() asm volatile("s_waitcnt vmcnt(2)" ::: "memory")
#define RESC(a) do { if (__any((a) < 1.f)) { if (hi == 0) al_l[r32] = (a); asm volatile("s_waitcnt lgkmcnt(0)" ::: "memory"); \
    _Pragma("unroll") for (int d = 0; d < 4; ++d) _Pragma("unroll") for (int r = 0; r < 16; ++r) o[d][r] *= al_l[crow(r, hi)]; } } while (0)
#define SBAR_() __builtin_amdgcn_sched_barrier(0)
    f32x16 pA0, pA1, pB0, pB1; float mnA, mnB, alA, alB; v8i pa; const int NT = seq / KVBLK;
    SLOAD(0, 0); asm volatile("s_waitcnt vmcnt(0)" ::: "memory"); SWRITE(0, 0); __syncthreads();
    qkt(pA0, pA1, K_lds, qf, r32, hi, scl); partialSM(pA0, pA1, m_reg, mnA, alA);
    SLOAD(1, 1); if (2 < NT) SLOAD(0, 2);
    SWAIT(); SWRITE(1, 1); __syncthreads();
    for (int j = 1; j + 1 < NT; j += 2) {
        SBAR_(); qkt(pB0, pB1, K_lds + SHM_K, qf, r32, hi, scl);
        finishSM(pA0, pA1, alA, l_reg, pa); SBAR_();
        SLOAD(1, j + 2); SBAR_();
        pv(o, V_lds, pa, r32, hi, scl); partialSM(pB0, pB1, m_reg, mnB, alB);
        __syncthreads(); SWAIT(); SWRITE(0, 0);
        RESC(alB); __syncthreads();
        SBAR_(); qkt(pA0, pA1, K_lds, qf, r32, hi, scl);
        finishSM(pB0, pB1, alB, l_reg, pa); SBAR_();
        if (j + 3 < NT) SLOAD(0, j + 3); SBAR_();
        pv(o, V_lds + SHM_V, pa, r32, hi, scl); partialSM(pA0, pA1, m_reg, mnA, alA);
        __syncthreads(); SWAIT(); SWRITE(1, 1);
        RESC(alA); __syncthreads();
    }
    SBAR_(); qkt(pB0, pB1, K_lds + SHM_K, qf, r32, hi, scl);
    finishSM(pA0, pA1, alA, l_reg, pa); SBAR_();
    pv(o, V_lds, pa, r32, hi, scl); partialSM(pB0, pB1, m_reg, mnB, alB);
    __syncthreads(); RESC(alB);
    finishSM(pB0, pB1, alB, l_reg, pa); SBAR_();
    pv(o, V_lds + SHM_V, pa, r32, hi, scl);
    if (hi == 0) li_l[r32] = l_reg; asm volatile("s_waitcnt lgkmcnt(0)" ::: "memory");
    float rli[16];
#pragma unroll
    for (int r = 0; r < 16; ++r) rli[r] = __builtin_amdgcn_rcpf(li_l[crow(r, hi)]);
    unsigned short* Ow = Ob + (long)(wid * QBLK) * 1024;
#pragma unroll
    for (int r = 0; r < 16; ++r) { const int orow = crow(r, hi);
#pragma unroll
        for (int d0 = 0; d0 < 4; ++d0) Ow[(long)orow * 1024 + d0 * 32 + r32] = (unsigned short)f2bf(o[d0][r] * rli[r]); }
#undef SLOAD
#undef SWRITE
#undef SWAIT
#undef RESC
#undef SBAR_
}
}
__device__ __forceinline__ void phase_attn(const Params& p, const Ctx& c, char* lds_generic) {
    unsigned char* ws = p.ws;
    const unsigned char* Q8 = ws + WS_QN; const unsigned char* K8 = ws + WS_KN; const unsigned char* VT8 = ws + WS_VB; bf16_t* AO = (bf16_t*)(ws + WS_AO);
    for (int item = c.bid; item < 512; item += c.G) {
        const int b = item >> 8, h = (item >> 5) & 7, qb = item & 31, kvh = h >> 2;
        const size_t qrow = (size_t)b * S + qb * 256;
        attn8::body(Q8 + qrow * 1024 + h * 128, K8 + (size_t)b * S * 256 + kvh * 128, VT8 + (size_t)(b * 2 + kvh) * 128 * 8192, AO + qrow * 1024 + h * 128, S, lds_generic);
        __syncthreads();
    }
}

struct EpiT1 { bf16_t* T1; const bf16_t* P; const float* RSTD; int n0;
    __device__ __forceinline__ void operator()(int r, int cl, float a, float) const { const int col = n0 + cl;
        T1[(size_t)r * 1024 + col] = (bf16_t)f2bf(a * RSTD[r] * sigmoidf_(bf2f(P[(size_t)r * NPROJ + PG + col]))); } };
struct EpiT2 { bf16_t* MG; const bf16_t* T1; const bf16_t* P; int n0;
    __device__ __forceinline__ void operator()(int r, int cl, float a, float) const { const int col = n0 + cl;
        MG[(size_t)r * 1024 + col] = (bf16_t)f2bf(bf2f(T1[(size_t)r * 1024 + col]) + a * sigmoidf_(bf2f(P[(size_t)r * NPROJ + PG + 1024 + col]))); } };
struct EpiT3 { float* X1; const float* x; int n0;
    __device__ __forceinline__ void operator()(int r, int cl, float a, float) const { const size_t o = (size_t)r * 1024 + n0 + cl; X1[o] = x[o] + a; } };
template <int WHICH> __device__ __forceinline__ void phase_tail_naive(const Params& p, const Ctx& c) {
    unsigned char* ws = p.ws;
    for (int it = c.bid; it < (M / 128) * 16; it += c.G) {
        const int mt = it >> 4, nt = it & 15;
        if (WHICH == 0) ngemm_tile<false>(ARowPlain{(const bf16_t*)(ws + WS_YZ), 1024}, (const bf16_t*)(ws + WS_WST) + (size_t)nt * 64 * 1024, nullptr, 1024, mt * 128,
                                          EpiT1{(bf16_t*)(ws + WS_T1), (const bf16_t*)(ws + WS_P), (const float*)(ws + WS_RSTD), nt * 64}, (LAS float*)c.lds, c.tid);
        if (WHICH == 1) ngemm_tile<false>(ARowPlain{(const bf16_t*)(ws + WS_AO), 1024}, (const bf16_t*)(ws + WS_WAT) + (size_t)nt * 64 * 1024, nullptr, 1024, mt * 128,
                                          EpiT2{(bf16_t*)(ws + WS_MG), (const bf16_t*)(ws + WS_T1), (const bf16_t*)(ws + WS_P), nt * 64}, (LAS float*)c.lds, c.tid);
        if (WHICH == 2) ngemm_tile<false>(ARowPlain{(const bf16_t*)(ws + WS_MG), 1024}, (const bf16_t*)(ws + WS_WOT) + (size_t)nt * 64 * 1024, nullptr, 1024, mt * 128,
                                          EpiT3{(float*)(ws + WS_X1), p.in[0], nt * 64}, (LAS float*)c.lds, c.tid);
    }
}

__device__ __forceinline__ void phase_router(const Params& p, const Ctx& c) {
    unsigned char* ws = p.ws;
    LAS float* wT = (LAS float*)c.lds;
    LAS int* tokE = (LAS int*)(c.lds + LDS_CTL + 512);
    LAS float* tokW = (LAS float*)(c.lds + LDS_CTL + 512 + 1024);
    LAS int* lcnt = (LAS int*)(c.lds + LDS_CTL + 512 + 2048);
    LAS int* lbase = lcnt + 32;
    LAS int* lrank = lbase + 32;
    const bf16_t* X1 = (const bf16_t*)(ws + WS_X1); unsigned char* H2 = ws + WS_H2;
    int* CNT = (int*)(ws + WS_CTL); int* TOKES = (int*)(ws + WS_TOKES); float* TOKW = (float*)(ws + WS_TOKW); int* LIST = (int*)(ws + WS_LIST);
    const int tid = c.tid, lane = c.lane;
    __syncthreads();
    { const f32x4* src = (const f32x4*)(ws + WS_WRT);
      f32x4 wv[16];
#pragma unroll
      for (int i = 0; i < 16; ++i) wv[i] = src[tid + 512 * i];
#pragma unroll
      for (int i = 0; i < 16; ++i) ((LAS f32x4*)wT)[tid + 512 * i] = wv[i]; }
    __syncthreads();
    f32x4 gv[4];
#pragma unroll
    for (int j = 0; j < 4; ++j) gv[j] = *(const f32x4*)(p.in[16] + (j >> 1) * 512 + 8 * lane + (j & 1) * 4);
    const float bias_e = p.in[18][(lane >> 1) & 31];
    for (int blk = c.bid; blk < M / 64; blk += c.G) {
        if (tid < 32) lcnt[tid] = 0;
        for (int pr = 0; pr < 4; ++pr) {
            const int tl = c.wave * 8 + pr * 2;
            const size_t tokA = (size_t)blk * 64 + tl;
            f32x4 hA[4], hB[4];
            {
                const u32x4* xa = (const u32x4*)(X1 + tokA * 1024) + lane; const u32x4* xb = xa + 128;
                float sa = 0.f, sb = 0.f;
                { const u32x4 a0 = xa[0], a1 = xa[64], b0 = xb[0], b1 = xb[64];
                  hA[0] = (f32x4){bflo(a0.x), bfhi(a0.x), bflo(a0.y), bfhi(a0.y)}; hA[1] = (f32x4){bflo(a0.z), bfhi(a0.z), bflo(a0.w), bfhi(a0.w)};
                  hA[2] = (f32x4){bflo(a1.x), bfhi(a1.x), bflo(a1.y), bfhi(a1.y)}; hA[3] = (f32x4){bflo(a1.z), bfhi(a1.z), bflo(a1.w), bfhi(a1.w)};
                  hB[0] = (f32x4){bflo(b0.x), bfhi(b0.x), bflo(b0.y), bfhi(b0.y)}; hB[1] = (f32x4){bflo(b0.z), bfhi(b0.z), bflo(b0.w), bfhi(b0.w)};
                  hB[2] = (f32x4){bflo(b1.x), bfhi(b1.x), bflo(b1.y), bfhi(b1.y)}; hB[3] = (f32x4){bflo(b1.z), bfhi(b1.z), bflo(b1.w), bfhi(b1.w)}; }
#pragma unroll
                for (int j = 0; j < 4; ++j) {
                    sa += (hA[j].x * hA[j].x + hA[j].y * hA[j].y) + (hA[j].z * hA[j].z + hA[j].w * hA[j].w);
                    sb += (hB[j].x * hB[j].x + hB[j].y * hB[j].y) + (hB[j].z * hB[j].z + hB[j].w * hB[j].w); }
                const float ra = rsqrtf(wave_sum(sa) * (1.f / 1024.f) + EPS), rb = rsqrtf(wave_sum(sb) * (1.f / 1024.f) + EPS);
#pragma unroll
                for (int j = 0; j < 4; ++j) { hA[j] = hA[j] * ra * gv[j]; hB[j] = hB[j] * rb * gv[j]; }
                u32x2* oa = (u32x2*)(H2 + tokA * 1024) + lane; u32x2* ob = oa + 128;
#pragma unroll
                for (int j2 = 0; j2 < 2; ++j2) { u32x2 w;
                    w.x = pack4_fp8(8.f * hA[2 * j2].x, 8.f * hA[2 * j2].y, 8.f * hA[2 * j2].z, 8.f * hA[2 * j2].w); w.y = pack4_fp8(8.f * hA[2 * j2 + 1].x, 8.f * hA[2 * j2 + 1].y, 8.f * hA[2 * j2 + 1].z, 8.f * hA[2 * j2 + 1].w); oa[64 * j2] = w;
                    w.x = pack4_fp8(8.f * hB[2 * j2].x, 8.f * hB[2 * j2].y, 8.f * hB[2 * j2].z, 8.f * hB[2 * j2].w); w.y = pack4_fp8(8.f * hB[2 * j2 + 1].x, 8.f * hB[2 * j2 + 1].y, 8.f * hB[2 * j2 + 1].z, 8.f * hB[2 * j2 + 1].w); ob[64 * j2] = w; }
            }
            float accA[32], accB[32];
#pragma unroll
            for (int e = 0; e < 32; ++e) {
                float a = 0.f, b = 0.f;
#pragma unroll
                for (int j = 0; j < 4; ++j) { const f32x4 w = *(const LAS f32x4*)&wT[e * 1024 + (j >> 1) * 512 + 8 * lane + (j & 1) * 4];
                    a = fmaf(hA[j].x, w.x, a); a = fmaf(hA[j].y, w.y, a); a = fmaf(hA[j].z, w.z, a); a = fmaf(hA[j].w, w.w, a);
                    b = fmaf(hB[j].x, w.x, b); b = fmaf(hB[j].y, w.y, b); b = fmaf(hB[j].z, w.z, b); b = fmaf(hB[j].w, w.w, b); }
                accA[e] = a; accB[e] = b;
                if (e & 1) __builtin_amdgcn_sched_barrier(0);
            }
#define RSTEP(N, BIT) _Pragma("unroll") for (int i = 0; i < N; ++i) { const bool up = (lane & BIT) != 0; \
                const float ka = up ? accA[N + i] : accA[i], sa_ = up ? accA[i] : accA[N + i]; accA[i] = ka + __shfl_xor(sa_, BIT); \
                const float kb = up ? accB[N + i] : accB[i], sb_ = up ? accB[i] : accB[N + i]; accB[i] = kb + __shfl_xor(sb_, BIT); }
            RSTEP(16, 32) RSTEP(8, 16) RSTEP(4, 8) RSTEP(2, 4) RSTEP(1, 2)
#undef RSTEP
            const float la = accA[0] + __shfl_xor(accA[0], 1) + bias_e, lb = accB[0] + __shfl_xor(accB[0], 1) + bias_e;
            const int my_e = (lane >> 1) & 31;
#pragma unroll
            for (int t2 = 0; t2 < 2; ++t2) {
                float val = t2 ? lb : la;
                int se[4]; float sv[4];
#pragma unroll
                for (int k = 0; k < 4; ++k) {
                    const float mx = wave_max(val);
                    const int sel = wave_min_i(val == mx ? my_e : 64);
                    se[k] = sel & 31; sv[k] = mx;
                    if (my_e == sel) val = -INFINITY;
                }
                const float e1 = __expf(sv[1] - sv[0]), e2 = __expf(sv[2] - sv[0]), e3 = __expf(sv[3] - sv[0]);
                const float inv = 1.f / (1.f + e1 + e2 + e3);
                if (lane == 0) {
                    const int t = tl + t2;
                    tokE[t * 4 + 0] = se[0]; tokE[t * 4 + 1] = se[1]; tokE[t * 4 + 2] = se[2]; tokE[t * 4 + 3] = se[3];
                    tokW[t * 4 + 0] = inv; tokW[t * 4 + 1] = e1 * inv; tokW[t * 4 + 2] = e2 * inv; tokW[t * 4 + 3] = e3 * inv;
                }
            }
        }
        __syncthreads();
        if (tid < 256) lrank[tid] = atomicAdd((int*)&lcnt[tokE[tid]], 1);
        __syncthreads();
        if (tid < 32) lbase[tid] = lcnt[tid] ? atomicAdd(&CNT[tid], lcnt[tid]) : 0;
        __syncthreads();
        if (tid < 256) {
            const int e = tokE[tid], slot = lbase[e] + lrank[tid], tok = blk * 64 + (tid >> 2);
            LIST[e * 16384 + slot] = tok; TOKES[tok * 4 + (tid & 3)] = (e << 16) | slot; TOKW[tok * 4 + (tid & 3)] = tokW[tid];
        }
        __syncthreads();
    }
}

__device__ __forceinline__ void load_offs(const Params& p, const Ctx& c, LAS int*& offs, LAS int*& cnt) {
    offs = (LAS int*)(c.lds + LDS_CTL); cnt = offs + 40;
    __syncthreads();
    if (c.tid == 0) {
        const int* CNT = (const int*)(p.ws + WS_CTL); int run = 0;
        for (int e = 0; e < 32; ++e) { const int n = __hip_atomic_load(CNT + e, __ATOMIC_RELAXED, __HIP_MEMORY_SCOPE_AGENT); cnt[e] = n; offs[e] = run; run += (n + 255) & ~255; }
        offs[32] = run;
    }
    __syncthreads();
    if (c.tid < 320) { int e = 0; while (e < 31 && c.tid * 256 >= offs[e + 1]) ++e; offs[80 + c.tid] = e; }
    __syncthreads();
}
__device__ __forceinline__ int find_expert(const LAS int* offs, int row) { int e = 0; while (e < 31 && row >= offs[e + 1]) ++e; return e; }

__device__ __forceinline__ void phase_gather(const Params& p, const Ctx& c) {
    LAS int* offs; LAS int* cnt; load_offs(p, c, offs, cnt);
    const bf16_t* H2 = (const bf16_t*)(p.ws + WS_H2); bf16_t* XB = (bf16_t*)(p.ws + WS_XB); const int* LIST = (const int*)(p.ws + WS_LIST);
    const int gw = c.bid * 8 + c.wave, NGW = c.G * 8, total = offs[32];
    for (int row0 = gw * 4; row0 < total; row0 += NGW * 4) {
        const int e = find_expert(offs, row0), slot0 = row0 - offs[e], n = cnt[e];
        int tok[4];
#pragma unroll
        for (int q = 0; q < 4; ++q) tok[q] = (slot0 + q < n) ? LIST[e * 16384 + slot0 + q] : -1;
        u32x4 v[4][2];
#pragma unroll
        for (int q = 0; q < 4; ++q) { v[q][0] = (u32x4){0u, 0u, 0u, 0u}; v[q][1] = v[q][0];
            if (tok[q] >= 0) { const u32x4* s = (const u32x4*)(H2 + (size_t)tok[q] * 1024); v[q][0] = s[c.lane]; v[q][1] = s[c.lane + 64]; } }
#pragma unroll
        for (int q = 0; q < 4; ++q) { u32x4* d = (u32x4*)(XB + (size_t)(row0 + q) * 1024); d[c.lane] = v[q][0]; d[c.lane + 64] = v[q][1]; }
    }
}

struct EpiAct { bf16_t* ACT; const float* b1; int j0;
    __device__ __forceinline__ void operator()(int r, int cl, float g, float u) const { const int j = j0 + cl;
        g = fminf(g + b1[j], 7.f); u = fminf(fmaxf(u + b1[1024 + j], -7.f), 7.f);
        ACT[(size_t)r * 1024 + j] = (bf16_t)f2bf(g * sigmoidf_(1.702f * g) * (u + 1.f)); } };
struct EpiY { bf16_t* YB; const float* b2; int n0;
    __device__ __forceinline__ void operator()(int r, int cl, float a, float) const { const int col = n0 + cl; YB[(size_t)r * 1024 + col] = (bf16_t)f2bf(a + b2[col]); } };
template <int WHICH> __device__ __forceinline__ void phase_moe_naive(const Params& p, const Ctx& c) {
    LAS int* offs; LAS int* cnt; load_offs(p, c, offs, cnt);
    unsigned char* ws = p.ws;
    const int nrt = offs[32] / 128;
    for (int it = c.bid; it < nrt * 16; it += c.G) {
        const int rt = it >> 4, ct = it & 15, row0 = rt * 128, e = find_expert(offs, row0);
        if (WHICH == 0) {
            const int j0 = ct * 64, nt = j0 >> 7, jj = j0 & 127;
            const bf16_t* Wg = (const bf16_t*)(ws + WS_W1T) + ((size_t)e * 2048 + nt * 256 + jj) * 1024;
            ngemm_tile<true>(ARowPlain{(const bf16_t*)(ws + WS_XB), 1024}, Wg, Wg + (size_t)128 * 1024, 1024, row0,
                             EpiAct{(bf16_t*)(ws + WS_ACT), p.in[20] + (size_t)e * 2048, j0}, (LAS float*)c.lds, c.tid);
        } else {
            const bf16_t* W = (const bf16_t*)(ws + WS_W2T) + ((size_t)e * 1024 + ct * 64) * 1024;
            ngemm_tile<false>(ARowPlain{(const bf16_t*)(ws + WS_ACT), 1024}, W, nullptr, 1024, row0,
                              EpiY{(bf16_t*)(ws + WS_YB), p.in[22] + (size_t)e * 1024, ct * 64}, (LAS float*)c.lds, c.tid);
        }
    }
}


__device__ __forceinline__ void phase_gemm1(const Params& p, const Ctx& c) {
    pg8::Gemm g{(const bf16_t*)(p.ws + WS_H), (const bf16_t*)(p.ws + WS_WINT), M, PDT, 1024};
    pg8::StaticOrder S; S.init(M, PDT, c.G, c.bid);
    pg8::EpiStore E{(bf16_t*)(p.ws + WS_P), NPROJ};
    pg8::gemm_phase<pg8::EpiStore, pg8::StaticOrder, true, true>(c.lds, g, S, E);
}
__device__ __forceinline__ void phase_tail12(const Params& p, const Ctx& c) {
    unsigned char* ws = p.ws;
    pg8::TailOrder S; S.so.init(M, 1024, c.G, c.bid);
    pg8::Gemm g{(const bf16_t*)(ws + WS_YZ), (const bf16_t*)(ws + WS_WST), 2 * M, 2048, 1024};
    pg8::EpiT12 E{(bf16_t*)(ws + WS_T1), (bf16_t*)(ws + WS_MG), (const bf16_t*)(ws + WS_P) + PG, NPROJ, (const float*)(ws + WS_RSTD)};
    pg8::gemm_phase<pg8::EpiT12, pg8::TailOrder, true, true>(c.lds, g, S, E);
}
__device__ __forceinline__ void phase_tail3(const Params& p, const Ctx& c) {
    unsigned char* ws = p.ws;
    pg8::StaticOrder S; S.init(M, 1024, c.G, c.bid);
    pg8::Gemm g{(const bf16_t*)(ws + WS_MG), (const bf16_t*)(ws + WS_WOT), M, 1024, 1024};
    pg8::EpiT3b E{(bf16_t*)(ws + WS_X1), p.in[0]};
    pg8::gemm_phase<pg8::EpiT3b, pg8::StaticOrder, true, true>(c.lds, g, S, E);
}
__device__ __forceinline__ void phase_moe1(const Params& p, const Ctx& c) {
    LAS int* offs; LAS int* cnt; load_offs(p, c, offs, cnt);
    unsigned char* ws = p.ws;
    pg8::Gemm g{(const bf16_t*)(ws + WS_H2), (const bf16_t*)(ws + WS_W1T), M, 32 * 2048, 512};
    pg8::MoeGatherOrder S{offs, cnt, offs + 80, (const int*)(ws + WS_LIST), c.G, c.bid, offs[32] / 256};
    pg8::EpiAct8 E{(unsigned char*)(ws + WS_ACT), p.in[20]};
    pg8::gemm_phase_gather_f8<pg8::EpiAct8, pg8::MoeGatherOrder>(c.lds, g, S, E);
}
__device__ __forceinline__ void phase_moe2(const Params& p, const Ctx& c) {
    LAS int* offs; LAS int* cnt; load_offs(p, c, offs, cnt);
    unsigned char* ws = p.ws;
    pg8::Gemm g{(const bf16_t*)(ws + WS_ACT), (const bf16_t*)(ws + WS_W2T), ROWS_MAX, 32 * 1024, 512};
    pg8::MoeOrder<4> S{offs + 80, c.G, c.bid, offs[32] / 256};
    pg8::EpiY8 E{(bf16_t*)(ws + WS_YB), p.in[22]};
    pg8::gemm_phase_f8<pg8::EpiY8, pg8::MoeOrder<4>, true, true>(c.lds, g, S, E);
}

__device__ __forceinline__ void phase_combine(const Params& p, const Ctx& c) {
    LAS int* offs; LAS int* cnt; load_offs(p, c, offs, cnt);
    unsigned char* ws = p.ws;
    const bf16_t* X1 = (const bf16_t*)(ws + WS_X1); const bf16_t* YB = (const bf16_t*)(ws + WS_YB);
    const int* TOKES = (const int*)(ws + WS_TOKES); const float* TOKW = (const float*)(ws + WS_TOKW);
    const int gw = c.bid * 8 + c.wave, NGW = c.G * 8, lane = c.lane;
    f32x4 gv[4];
#pragma unroll
    for (int j = 0; j < 4; ++j) gv[j] = ((const f32x4*)p.in[23])[lane + 64 * j];
    for (int m0 = gw * 2; m0 < M; m0 += NGW * 2) {
        int es[2][4]; float wq[2][4];
#pragma unroll
        for (int t = 0; t < 2; ++t)
#pragma unroll
            for (int k = 0; k < 4; ++k) { es[t][k] = TOKES[(m0 + t) * 4 + k]; wq[t][k] = TOKW[(m0 + t) * 4 + k]; }
        f32x4 v[2][4]; u32x2 y[2][4][4];
#pragma unroll
        for (int t = 0; t < 2; ++t) { const u32x2* xr = (const u32x2*)(X1 + (size_t)(m0 + t) * 1024) + lane;
#pragma unroll
            for (int j = 0; j < 4; ++j) { const u32x2 xx = xr[64 * j]; v[t][j] = (f32x4){bflo(xx.x), bfhi(xx.x), bflo(xx.y), bfhi(xx.y)}; }
#pragma unroll
            for (int k = 0; k < 4; ++k) { const int row = offs[es[t][k] >> 16] + (es[t][k] & 0xffff); const u32x2* yr = (const u32x2*)(YB + (size_t)row * 1024) + lane;
#pragma unroll
                for (int j = 0; j < 4; ++j) y[t][k][j] = yr[64 * j]; } }
#pragma unroll
        for (int t = 0; t < 2; ++t) {
#pragma unroll
            for (int k = 0; k < 4; ++k) { const float w = wq[t][k];
#pragma unroll
                for (int j = 0; j < 4; ++j) { const u32x2 yy = y[t][k][j];
                    v[t][j].x = fmaf(w, bflo(yy.x), v[t][j].x); v[t][j].y = fmaf(w, bfhi(yy.x), v[t][j].y); v[t][j].z = fmaf(w, bflo(yy.y), v[t][j].z); v[t][j].w = fmaf(w, bfhi(yy.y), v[t][j].w); } }
            float s = 0.f;
#pragma unroll
            for (int j = 0; j < 4; ++j) s += (v[t][j].x * v[t][j].x + v[t][j].y * v[t][j].y) + (v[t][j].z * v[t][j].z + v[t][j].w * v[t][j].w);
            const float rstd = rsqrtf(wave_sum(s) * (1.f / 1024.f) + EPS);
            f32x4* o = (f32x4*)(p.out + (size_t)(m0 + t) * 1024) + lane;
#pragma unroll
            for (int j = 0; j < 4; ++j) o[64 * j] = v[t][j] * rstd * gv[j];
        }
    }
}

#define XB_TMO      128
#define XB_XCNT(j)  (256  + 64 * (j))
#define XB_XSUB(j)  (1280 + 64 * (j))
#define XB_XGEN(j)  (2304 + 64 * (j))
#define XB_TOP      3328
#define XB_TOPGEN   3392
#define XCD_BAR_WORDS 3456
#define XB_SPIN_CAP (1u << 18)

__device__ __forceinline__ unsigned xb_ld(unsigned* p)              { return __hip_atomic_load(p, __ATOMIC_RELAXED, __HIP_MEMORY_SCOPE_AGENT); }
__device__ __forceinline__ unsigned xb_add(unsigned* p, unsigned v) { return __hip_atomic_fetch_add(p, v, __ATOMIC_RELAXED, __HIP_MEMORY_SCOPE_AGENT); }
__device__ __forceinline__ unsigned xb_xcc_id() { return (unsigned)__builtin_amdgcn_s_getreg((3 << 11) | 20) & 0xFu; }
#define XB_SPIN(cond, bar) do { unsigned _sp = 0; while (cond) { __builtin_amdgcn_s_sleep(1); \
    if ((++_sp & 255u) == 0u) { if (xb_ld(&(bar)[XB_TMO])) break; if (_sp > XB_SPIN_CAP) { atomicAdd(&(bar)[XB_TMO], 1u); break; } } } } while (0)

struct XcdBarrier {
    unsigned* bar; unsigned x;
    volatile LAS unsigned* st;
};

__device__ __forceinline__ XcdBarrier xcd_barrier_post(unsigned* bar, volatile LAS unsigned* st) {
    XcdBarrier b; b.bar = bar; b.x = xb_xcc_id(); b.st = st;
    if (threadIdx.x == 0) (void)xb_add(&bar[XB_XCNT(b.x)], 1u);
    return b;
}
__device__ __forceinline__ void xcd_barrier_complete(unsigned* bar, unsigned x, unsigned& nloc, unsigned& nx) {
    const unsigned G = gridDim.x * gridDim.y * gridDim.z;
    unsigned sum, cnt, mine, sp = 0u;
    for (;;) {
        sum = 0u; cnt = 0u; mine = 0u;
#pragma unroll
        for (unsigned j = 0; j < 16; ++j) { const unsigned c = xb_ld(&bar[XB_XCNT(j)]); sum += c; cnt += (c > 0u) ? 1u : 0u; mine = (j == x) ? c : mine; }
        if (sum == G) break;
        __builtin_amdgcn_s_sleep(1);
        if ((++sp & 255u) == 0u) { if (xb_ld(&bar[XB_TMO])) break; if (sp > XB_SPIN_CAP) { atomicAdd(&bar[XB_TMO], 1u); break; } }
    }
    nloc = mine > 0u ? mine : 1u; nx = cnt > 0u ? cnt : 1u;
}

__device__ __forceinline__ void xcd_barrier(const XcdBarrier& b) {
    asm volatile("s_waitcnt vmcnt(0)" ::: "memory");
    __syncthreads();
    if (threadIdx.x == 0) {
        unsigned* bar = b.bar;
        __builtin_amdgcn_s_waitcnt(0);
        unsigned nloc = b.st[0], nx = b.st[1];
        if (nloc == 0u) { xcd_barrier_complete(bar, b.x, nloc, nx); b.st[0] = nloc; b.st[1] = nx; }
        const unsigned old = xb_add(&bar[XB_XSUB(b.x)], 1u);
        const unsigned gen = old / nloc;
        if (old + 1u == (gen + 1u) * nloc) {
            __builtin_amdgcn_fence(__ATOMIC_RELEASE, "agent");
            asm volatile("s_waitcnt vmcnt(0)" ::: "memory");
            const unsigned og = xb_add(&bar[XB_TOP], 1u);
            const unsigned tg = og / nx;
            if (og + 1u == (tg + 1u) * nx) xb_add(&bar[XB_TOPGEN], 1u);
            else XB_SPIN(xb_ld(&bar[XB_TOPGEN]) == tg, bar);
            __builtin_amdgcn_fence(__ATOMIC_ACQUIRE, "agent");
            xb_add(&bar[XB_XGEN(b.x)], 1u);
            asm volatile("s_waitcnt vmcnt(0)" ::: "memory");
        } else {
            XB_SPIN(xb_ld(&bar[XB_XGEN(b.x)]) == gen, bar);
            __builtin_amdgcn_fence(__ATOMIC_ACQUIRE, "agent");
            asm volatile("s_waitcnt vmcnt(0)" ::: "memory");
        }
    }
    __syncthreads();
}

constexpr int NPHASE = 13;
__global__ void __launch_bounds__(512) mega(Params p) {
    extern __shared__ __attribute__((aligned(16))) unsigned char lds_raw[];
    Ctx c; c.tid = threadIdx.x; c.lane = c.tid & 63; c.wave = __builtin_amdgcn_readfirstlane(c.tid >> 6); c.bid = blockIdx.x; c.G = gridDim.x;
    c.lds = (LAS unsigned char*)lds_raw;
    cg::grid_group grid = cg::this_grid();
    if (c.tid < 2) ((volatile LAS unsigned*)(c.lds + LDS_BARST))[c.tid] = 0u;
    __syncthreads();
#define SEAM(k) do { XcdBarrier b_; b_.bar = (unsigned*)(p.ws + WS_BAR); b_.x = xb_xcc_id(); b_.st = (volatile LAS unsigned*)(c.lds + LDS_BARST); xcd_barrier(b_); } while (0)
    if (p.ph_lo < 0) grid.sync();
    (void)xcd_barrier_post((unsigned*)(p.ws + WS_BAR), (volatile LAS unsigned*)(c.lds + LDS_BARST));
#define RUN(k, call) if (p.ph_lo <= (k) && (k) < p.ph_hi) { call; if ((k) + 1 < p.ph_hi) SEAM(k); }
    RUN(0, phase_prep(p, c))
    RUN(1, phase_gemm1(p, c))
    RUN(2, phase_conv(p, c))
    RUN(3, phase_ssd_states(p, c))
    RUN(4, phase_ssd_scan(p, c))
    RUN(5, phase_ssd_out(p, c))
    RUN(6, phase_rstd(p, c); phase_attn(p, c, (char*)lds_raw))
    RUN(7, phase_tail12(p, c))
    RUN(8, phase_tail3(p, c))
    RUN(9, phase_router(p, c))
    RUN(10, phase_moe1(p, c))
    RUN(11, phase_moe2(p, c))
    RUN(12, phase_combine(p, c))
#undef RUN
}

extern "C" void kernel_launch(void* const* d_in, const int* in_sizes, int n_in, void* d_out, int out_size, void* d_ws, size_t ws_size, hipStream_t stream) {
    static int ok = 0; static int grid_blocks = 0;
    if (ok == 0) {
        if (n_in != 24 || out_size != M * D || ws_size < WS_END) { fprintf(stderr, "kernel_launch: unexpected shapes: n_in %d out %d ws %zu (need %zu)\n", n_in, out_size, ws_size, (size_t)WS_END); ok = -1; return; }
        if (hipFuncSetAttribute((const void*)mega, hipFuncAttributeMaxDynamicSharedMemorySize, LDS_BYTES) != hipSuccess) { fprintf(stderr, "kernel_launch: hipFuncSetAttribute failed\n"); ok = -1; return; }
        int dev = 0, cus = 0, per_cu = 0;
        hipGetDevice(&dev);
        hipDeviceGetAttribute(&cus, hipDeviceAttributeMultiprocessorCount, dev);
        hipOccupancyMaxActiveBlocksPerMultiprocessor(&per_cu, (const void*)mega, 512, LDS_BYTES);
        if (per_cu < 1 || cus < 1) { fprintf(stderr, "kernel_launch: occupancy query gave %d blocks/CU on %d CUs\n", per_cu, cus); ok = -1; return; }
        grid_blocks = cus;
        ok = 1;
    }
    if (ok < 0) return;
    Params p{};
    for (int i = 0; i < 24; ++i) p.in[i] = (const float*)d_in[i];
    p.out = (float*)d_out; p.ws = (unsigned char*)d_ws;
    p.ph_lo = 0; p.ph_hi = NPHASE;
    if (hipMemsetAsync((char*)d_ws + WS_BAR, 0, 16384, stream) != hipSuccess) { fprintf(stderr, "kernel_launch: hipMemsetAsync of the barrier words failed\n"); return; }
    void* args[] = {&p};
    hipError_t e = hipLaunchCooperativeKernel((const void*)mega, dim3(grid_blocks), dim3(512), args, LDS_BYTES, stream);
    if (e != hipSuccess) fprintf(stderr, "kernel_launch: cooperative launch failed: %s (grid %d)\n", hipGetErrorString(e), grid_blocks);
}
```

```cpp
#include <hip/hip_runtime.h>
#include <hip/hip_cooperative_groups.h>
#include <cstdio>
#include <cstdint>

namespace cg = cooperative_groups;
#define LAS __attribute__((address_space(3)))
typedef unsigned short bf16_t;
typedef unsigned u32x4 __attribute__((ext_vector_type(4)));
typedef unsigned u32x2 __attribute__((ext_vector_type(2)));
typedef float f32x4 __attribute__((ext_vector_type(4)));

constexpr int NB = 2, S = 8192, D = 1024, M = NB * S;
constexpr int NPROJ = 6400;
constexpr int PZ = 0, PXBC = 1024, PQ = 2560, PK = 3584, PV = 3840, PG = 4096, PDT = 6144;
constexpr int ROWS_MAX = 65536 + 32 * 256;
constexpr float EPS = 1e-6f;

constexpr size_t al256(size_t x) { return (x + 255) / 256 * 256; }
constexpr size_t WS_CTL = 0;
constexpr size_t WS_BAR = 4096;
constexpr size_t WS_ROPE = 4096 + 16384;
constexpr size_t WS_WRT = WS_ROPE + 32768;
constexpr size_t WS_WINT = WS_WRT + 131072;
constexpr size_t WS_WST = WS_WINT + (size_t)NPROJ * 1024 * 2;
constexpr size_t WS_WAT = WS_WST + 2097152;
constexpr size_t WS_WOT = WS_WAT + 2097152;
constexpr size_t WS_W1T = WS_WOT + 2097152;
constexpr size_t WS_W2T = WS_W1T + (size_t)32 * 2048 * 1024 * 2;
constexpr size_t WS_X1 = WS_W2T + (size_t)32 * 1024 * 1024 * 2;
constexpr size_t WS_H2 = WS_X1 + (size_t)M * 1024 * 4;
constexpr size_t WS_TOKES = WS_H2 + (size_t)M * 1024 * 2;
constexpr size_t WS_TOKW = WS_TOKES + (size_t)M * 16;
constexpr size_t WS_LIST = WS_TOKW + (size_t)M * 16;
constexpr size_t WS_R = WS_LIST + (size_t)32 * 16384 * 4;
constexpr size_t WS_H = WS_R;
constexpr size_t WS_P = WS_H + (size_t)M * 1024 * 2;
constexpr size_t WS_XT = WS_P + (size_t)M * NPROJ * 2;
constexpr size_t WS_BMR = WS_XT + (size_t)M * 1024 * 2;
constexpr size_t WS_BMT = WS_BMR + (size_t)M * 256 * 2;
constexpr size_t WS_CMR = WS_BMT + (size_t)M * 256 * 2;
constexpr size_t WS_DT = WS_CMR + (size_t)M * 256 * 2;
constexpr size_t WS_ACS = WS_DT + (size_t)2 * M * 16 * 4;
constexpr size_t WS_CDEC = WS_ACS + (size_t)2 * M * 16 * 4;
constexpr size_t WS_ST = WS_CDEC + 16384;
constexpr size_t WS_PREV = WS_ST + (size_t)2 * 2 * 64 * 16 * 8192 * 4;
constexpr size_t WS_YZ = WS_PREV + (size_t)2 * 2 * 64 * 16 * 8192 * 2;
constexpr size_t WS_AO = WS_YZ + (size_t)M * 1024 * 2;
constexpr size_t WS_RSTD = WS_AO + (size_t)M * 1024 * 2;
constexpr size_t WS_QN = WS_RSTD + (size_t)M * 4;
constexpr size_t WS_KN = WS_QN + (size_t)M * 1024 * 2;
constexpr size_t WS_VB = WS_KN + (size_t)M * 256 * 2;
constexpr size_t WS_T1 = WS_VB + (size_t)M * 256 * 2;
constexpr size_t WS_MG = WS_T1 + (size_t)M * 1024 * 2;
constexpr size_t WS_END = WS_MG + (size_t)M * 1024 * 2;
constexpr size_t WS_XB = WS_R;
constexpr size_t WS_ACT = WS_XB + (size_t)ROWS_MAX * 1024 * 2;
constexpr size_t WS_YB = WS_XB;
static_assert(WS_ACT + (size_t)ROWS_MAX * 1024 * 2 <= WS_END, "moe overlay");
static_assert(WS_END <= (size_t)1073741824, "workspace");
static_assert(WS_WAT == WS_WST + 2097152 && WS_AO == WS_YZ + (size_t)M * 2048, "concatenated operands of the merged branch GEMMs");

constexpr int LDS_BYTES = 147712;
constexpr int LDS_BARST = 147456;
constexpr int LDS_CTL = 143360;

struct Params {
    const float* in[24];
    float* out;
    unsigned char* ws;
    int ph_lo, ph_hi;
};

__device__ __forceinline__ float bf2f(bf16_t v) { return __uint_as_float((unsigned)v << 16); }
__device__ __forceinline__ float bflo(unsigned w) { return __uint_as_float(w << 16); }
__device__ __forceinline__ float bfhi(unsigned w) { return __uint_as_float(w & 0xffff0000u); }
__device__ __forceinline__ unsigned f2bf(float f) { unsigned u = __float_as_uint(f); return (u + 0x7fffu + ((u >> 16) & 1u)) >> 16; }
__device__ __forceinline__ unsigned pk2(float lo, float hi) { return f2bf(lo) | (f2bf(hi) << 16); }
__device__ __forceinline__ float wave_sum(float v) {
#pragma unroll
    for (int o = 1; o < 64; o <<= 1) v += __shfl_xor(v, o);
    return v;
}
__device__ __forceinline__ float wave_max(float v) {
#pragma unroll
    for (int o = 1; o < 64; o <<= 1) v = fmaxf(v, __shfl_xor(v, o));
    return v;
}
__device__ __forceinline__ int wave_min_i(int v) {
#pragma unroll
    for (int o = 1; o < 64; o <<= 1) { int t = __shfl_xor(v, o); v = t < v ? t : v; }
    return v;
}
__device__ __forceinline__ float sigmoidf_(float x) { return 1.f / (1.f + __expf(-x)); }
__device__ __forceinline__ unsigned pack4_fp8(float a, float b, float c, float d) { unsigned w = __builtin_amdgcn_cvt_pk_fp8_f32(a, b, 0u, false); return __builtin_amdgcn_cvt_pk_fp8_f32(c, d, w, true); }
#define LDS_WAIT() asm volatile("s_waitcnt lgkmcnt(0)" ::: "memory")

struct Ctx { int tid, lane, wave, bid, G; LAS unsigned char* lds; };

struct TItem { const float* W; bf16_t* WT; const float* kscale; int N, k0, n0, orow0; };
__device__ __forceinline__ void transpose_load(const TItem& t, f32x4 (&v)[8], int lane) {
    const int nq = lane & 7, kg = lane >> 3;
    const float* s = t.W + (size_t)(t.k0 + 8 * kg) * t.N + t.n0 + 4 * nq;
#pragma unroll
    for (int i = 0; i < 8; ++i) v[i] = *(const f32x4*)(s + (size_t)i * t.N);
}
__device__ __forceinline__ void transpose_store(const TItem& t, f32x4 (&v)[8], int lane) {
    const int nq = lane & 7, kg = lane >> 3;
    if (t.kscale) {
#pragma unroll
        for (int i = 0; i < 8; ++i) v[i] = v[i] * t.kscale[t.k0 + 8 * kg + i];
    }
    bf16_t* d = t.WT + (size_t)(t.orow0 + 4 * nq) * 1024 + t.k0 + 8 * kg;
#pragma unroll
    for (int j = 0; j < 4; ++j) { u32x4 o; o.x = pk2(v[0][j], v[1][j]); o.y = pk2(v[2][j], v[3][j]); o.z = pk2(v[4][j], v[5][j]); o.w = pk2(v[6][j], v[7][j]);
        *(u32x4*)(d + (size_t)j * 1024) = o; }
}
constexpr int PREP_I_IN = 16 * 193, PREP_I_SQ = 512, PREP_NITEMS = PREP_I_IN + 3 * PREP_I_SQ;
__device__ __forceinline__ TItem prep_item(const Params& p, int r) {
    unsigned char* ws = p.ws; TItem t; t.kscale = nullptr;
    if (r < PREP_I_IN) { const int kb = r / 193, nb = r % 193, n0 = nb * 32;
        t.W = p.in[2]; t.WT = (bf16_t*)(ws + WS_WINT); t.N = 6176; t.k0 = kb * 64; t.n0 = n0; t.orow0 = n0 < 2560 ? n0 : (n0 < 2592 ? PDT + (n0 - 2560) : n0 - 32); return t; }
    r -= PREP_I_IN;
    { const int which = r / PREP_I_SQ, q = r % PREP_I_SQ;
        t.W = which == 0 ? p.in[13] : (which == 1 ? p.in[14] : p.in[15]); t.WT = (bf16_t*)(ws + (which == 0 ? WS_WST : (which == 1 ? WS_WAT : WS_WOT)));
        t.kscale = which == 0 ? p.in[10] : nullptr; t.N = 1024; t.k0 = (q / 32) * 64; t.n0 = (q % 32) * 32; t.orow0 = t.n0; return t; }
}
constexpr int PREP8_TILES = 32 * 64 + 32 * 32;
struct T8 { const float* W; unsigned char* WT; int N, k0, n0; bool w1; };
__device__ __forceinline__ T8 prep8_tile(const Params& p, int t) {
    T8 r;
    if (t < 2048) { const int e = t >> 6; r.W = p.in[19] + (size_t)e * 1024 * 2048; r.WT = p.ws + WS_W1T + (size_t)e * 2048 * 1024; r.N = 2048; r.k0 = ((t >> 3) & 7) * 128; r.n0 = (t & 7) * 256; r.w1 = true; }
    else { t -= 2048; const int e = t >> 5; r.W = p.in[21] + (size_t)e * 1024 * 1024; r.WT = p.ws + WS_W2T + (size_t)e * 1024 * 1024; r.N = 1024; r.k0 = ((t >> 2) & 7) * 128; r.n0 = (t & 3) * 256; r.w1 = false; }
    return r;
}
__device__ __forceinline__ void prep8_load(const T8& t, f32x4 (&v)[16], int wave, int lane) {
    const float* s = t.W + (size_t)(t.k0 + 16 * wave) * t.N + t.n0 + 4 * lane;
#pragma unroll
    for (int i = 0; i < 16; ++i) v[i] = *(const f32x4*)(s + (size_t)i * t.N);
}
__device__ __forceinline__ void phase_prep8(const Params& p, const Ctx& c) {
    f32x4 v[16];
    int t = c.bid;
    if (t < PREP8_TILES) { const T8 t0 = prep8_tile(p, t); prep8_load(t0, v, c.wave, c.lane); }
    for (int i = 0; t < PREP8_TILES; ++i, t += c.G) {
        const T8 cur = prep8_tile(p, t);
        LAS unsigned char* img = c.lds + (i & 1) * 32768;
#pragma unroll
        for (int j = 0; j < 4; ++j) { u32x4 o;
            o.x = pack4_fp8(64.f * v[0][j], 64.f * v[1][j], 64.f * v[2][j], 64.f * v[3][j]); o.y = pack4_fp8(64.f * v[4][j], 64.f * v[5][j], 64.f * v[6][j], 64.f * v[7][j]);
            o.z = pack4_fp8(64.f * v[8][j], 64.f * v[9][j], 64.f * v[10][j], 64.f * v[11][j]); o.w = pack4_fp8(64.f * v[12][j], 64.f * v[13][j], 64.f * v[14][j], 64.f * v[15][j]);
            *(LAS u32x4*)(img + (4 * c.lane + j) * 128 + 16 * c.wave) = o; }
        if (t + c.G < PREP8_TILES) { const T8 nx = prep8_tile(p, t + c.G); prep8_load(nx, v, c.wave, c.lane); }
        __syncthreads();
#pragma unroll
        for (int q = 0; q < 4; ++q) { const int idx = c.tid + 512 * q, nl = idx >> 3, cw = idx & 7, n = cur.n0 + nl;
            const int orow = cur.w1 ? (((n & 1023) >> 7) * 256 + (n >> 10) * 128 + (n & 127)) : n;
            *(u32x4*)(cur.WT + (size_t)orow * 1024 + cur.k0 + 16 * cw) = *(const LAS u32x4*)(img + nl * 128 + 16 * cw); }
    }
    __syncthreads();
}

__device__ __forceinline__ void phase_prep(const Params& p, const Ctx& c) {
    unsigned char* ws = p.ws;
    const int gw = c.bid * 8 + c.wave, NGW = c.G * 8;
    for (int it = gw; it < PREP_NITEMS; it += 2 * NGW) {
        const TItem ta = prep_item(p, it); f32x4 va[8], vb[8];
        transpose_load(ta, va, c.lane);
        const bool two = it + NGW < PREP_NITEMS;
        const TItem tb = prep_item(p, two ? it + NGW : it);
        if (two) transpose_load(tb, vb, c.lane);
        transpose_store(ta, va, c.lane);
        if (two) transpose_store(tb, vb, c.lane);
    }
    phase_prep8(p, c);
    for (int r = 6176 + gw; r < NPROJ; r += NGW) {
        u32x4* o = (u32x4*)((bf16_t*)(ws + WS_WINT) + (size_t)r * 1024);
        o[c.lane] = (u32x4){0u, 0u, 0u, 0u}; o[c.lane + 64] = (u32x4){0u, 0u, 0u, 0u};
    }
    {
        const float* x = p.in[0]; const float* g = p.in[1]; bf16_t* H = (bf16_t*)(ws + WS_H);
        f32x4 gv[4];
#pragma unroll
        for (int j = 0; j < 4; ++j) gv[j] = ((const f32x4*)g)[c.lane + 64 * j];
        for (int m = gw; m < M; m += NGW) {
            const f32x4* xr = (const f32x4*)(x + (size_t)m * D) + c.lane;
            f32x4 v[4]; float s = 0.f;
#pragma unroll
            for (int j = 0; j < 4; ++j) { v[j] = xr[64 * j]; s += (v[j].x * v[j].x + v[j].y * v[j].y) + (v[j].z * v[j].z + v[j].w * v[j].w); }
            const float rstd = rsqrtf(wave_sum(s) * (1.f / D) + EPS);
            u32x2* o = (u32x2*)(H + (size_t)m * D) + c.lane;
#pragma unroll
            for (int j = 0; j < 4; ++j) { u32x2 w; w.x = pk2(v[j].x * rstd * gv[j].x, v[j].y * rstd * gv[j].y); w.y = pk2(v[j].z * rstd * gv[j].z, v[j].w * rstd * gv[j].w); o[64 * j] = w; }
        }
    }
    {
        float* rc = (float*)(ws + WS_ROPE); float* rs = rc + 4096;
        for (int idx = c.bid * 512 + c.tid; idx < 4096; idx += c.G * 512) {
            const int pos = idx >> 5, i = idx & 31;
            const float inv = exp2f(-(float)i * (13.287712379549449f / 32.f));
            float rev = (float)pos * inv * 0.15915494309189535f; rev -= floorf(rev);
            rc[idx] = __builtin_amdgcn_cosf(rev); rs[idx] = __builtin_amdgcn_sinf(rev);
        }
        float* wrt = (float*)(ws + WS_WRT); const float* wr = p.in[17];
        for (int idx = c.bid * 512 + c.tid; idx < 32768; idx += c.G * 512) { const int k = idx >> 5, e = idx & 31; wrt[e * 1024 + k] = wr[idx]; }
        if (c.bid == 0 && c.tid < 64) ((int*)(ws + WS_CTL))[c.tid] = 0;
    }
}

namespace pg8 {
#define PG8_LAS __attribute__((address_space(3)))
typedef unsigned short bf16_t;
typedef short bf16x8 __attribute__((ext_vector_type(8)));
typedef float f32x4 __attribute__((ext_vector_type(4)));
typedef unsigned u32x4 __attribute__((ext_vector_type(4)));
constexpr int BM = 256, BK = 64, HALF = 128, HTB = HALF * BK * 2  , STAGE_BYTES = 8 * HTB, NXCD = 8, WGM = 8;

__host__ __device__ __forceinline__ int lds_byte(int r, int c) { const int st = (r >> 4) * 2 + (c >> 5), rr = r & 15, cc = c & 31, ob = rr * 64 + cc * 2; return st * 1024 + (ob ^ (((ob >> 9) & 1) << 5)); }
__host__ __device__ __forceinline__ void stage_rc(int b, int& R, int& C) { const int st = b / 1024, sb = b % 1024, swz = sb ^ (((sb >> 9) & 1) << 5); R = (st >> 1) * 16 + swz / 64; C = (st & 1) * 32 + (swz % 64) / 2; }
__host__ __device__ __forceinline__ int perm32(int rho) { const int n = rho >> 4, i = rho & 15; return 8 * (i >> 2) + 4 * n + (i & 3); }

struct Unit { int pm, pn; };
struct Gemm { const bf16_t* A; const bf16_t* Bt; int M, N, K; };

struct StaticOrder {
    int nM, nN, nwg, G, c;
    __host__ __device__ void init(int M, int N, int G_, int c_) { nM = M / BM; nN = N / BM; nwg = nM * nN; G = G_; c = c_; }
    __host__ __device__ bool next(int i, Unit& u) const {
        const long L = (long)i * G + c; if (L >= nwg) return false;
        int wgid = (int)L; { const int q = nwg / NXCD, r = nwg % NXCD, xcd = wgid % NXCD, off = wgid / NXCD; wgid = (xcd < r ? xcd * (q + 1) : r * (q + 1) + (xcd - r) * q) + off; }
        const int nig = WGM * nN, gid = wgid / nig, fm = gid * WGM, gsz = (nM - fm) < WGM ? (nM - fm) : WGM;
        u.pm = fm + ((wgid % nig) % gsz); u.pn = (wgid % nig) / gsz; return true;
    }
    __device__ __forceinline__ void a_ready(const Unit&) const {}
    __device__ __forceinline__ void done(const Unit&) const {}
};


__device__ __forceinline__ unsigned cvt_pk_bf16(float lo, float hi) { unsigned r; asm volatile("v_cvt_pk_bf16_f32 %0, %1, %2" : "=v"(r) : "v"(lo), "v"(hi)); return r; }
__device__ __forceinline__ float sig_(float x) { return __builtin_amdgcn_rcpf(1.f + __builtin_amdgcn_exp2f(-1.4426950408889634f * x)); }
__device__ __forceinline__ u32x4 pack8(const f32x4& v0, const f32x4& v1) { u32x4 w; w.x = cvt_pk_bf16(v0[0], v0[1]); w.y = cvt_pk_bf16(v0[2], v0[3]); w.z = cvt_pk_bf16(v1[0], v1[1]); w.w = cvt_pk_bf16(v1[2], v1[3]); return w; }
__device__ __forceinline__ void unpack8(const u32x4& w, f32x4& v0, f32x4& v1) {
    v0[0] = __uint_as_float(w.x << 16); v0[1] = __uint_as_float(w.x & 0xffff0000u); v0[2] = __uint_as_float(w.y << 16); v0[3] = __uint_as_float(w.y & 0xffff0000u);
    v1[0] = __uint_as_float(w.z << 16); v1[1] = __uint_as_float(w.z & 0xffff0000u); v1[2] = __uint_as_float(w.w << 16); v1[3] = __uint_as_float(w.w & 0xffff0000u); }
struct EpiStore {
    static constexpr bool PERM = true, AFTER_DRAIN = false;
    bf16_t* O; int ldc;
    __device__ __forceinline__ void operator()(const f32x4 (&acc)[2][2][4][2], const Unit& u, int wr, int wc, int fr, int fq) const {
        const int row0 = u.pm * BM + wr * 64 + fr, col0 = u.pn * BM + wc * 32 + 8 * fq;
#pragma unroll
        for (int ai = 0; ai < 2; ++ai)
#pragma unroll
            for (int m = 0; m < 4; ++m) { bf16_t* rowp = O + (size_t)(row0 + ai * HALF + m * 16) * ldc + col0;
#pragma unroll
                for (int bj = 0; bj < 2; ++bj) *(u32x4*)(rowp + bj * HALF) = pack8(acc[ai][bj][m][0], acc[ai][bj][m][1]); }
    }
};
struct EpiAct8 {
    static constexpr bool PERM = true, AFTER_DRAIN = false;
    unsigned char* ACT; const float* b1;
    __device__ __forceinline__ void operator()(const f32x4 (&acc)[2][2][4][2], const Unit& u, int wr, int wc, int fr, int fq) const {
        const int e = u.pn >> 3, nt = u.pn & 7;
        const int row0 = u.pm * BM + wr * 64 + fr, col0 = nt * 128 + wc * 32 + 8 * fq;
        const float* bg = b1 + (size_t)e * 2048 + col0;
        const f32x4 bg0 = *(const f32x4*)bg, bg1 = *(const f32x4*)(bg + 4), bu0 = *(const f32x4*)(bg + 1024), bu1 = *(const f32x4*)(bg + 1028);
        constexpr float SC = 1.f / 512.f;
#pragma unroll
        for (int ai = 0; ai < 2; ++ai)
#pragma unroll
            for (int m = 0; m < 4; ++m) { const int row = row0 + ai * HALF + m * 16;
                f32x4 g0 = acc[ai][0][m][0] * SC + bg0, g1 = acc[ai][0][m][1] * SC + bg1, u0 = acc[ai][1][m][0] * SC + bu0, u1 = acc[ai][1][m][1] * SC + bu1;
#pragma unroll
                for (int i = 0; i < 4; ++i) {
                    const float ga = fminf(g0[i], 7.f), gb = fminf(g1[i], 7.f), ua = fminf(fmaxf(u0[i], -7.f), 7.f), ub = fminf(fmaxf(u1[i], -7.f), 7.f);
                    g0[i] = 4.f * ga * sig_(1.702f * ga) * (ua + 1.f); g1[i] = 4.f * gb * sig_(1.702f * gb) * (ub + 1.f); }
                u32x2 w; w.x = pack4_fp8(g0[0], g0[1], g0[2], g0[3]); w.y = pack4_fp8(g1[0], g1[1], g1[2], g1[3]);
                *(u32x2*)(ACT + (size_t)row * 1024 + col0) = w; }
    }
};
struct EpiY8 {
    static constexpr bool PERM = true, AFTER_DRAIN = false;
    bf16_t* YB; const float* b2;
    __device__ __forceinline__ void operator()(const f32x4 (&acc)[2][2][4][2], const Unit& u, int wr, int wc, int fr, int fq) const {
        const int e = u.pn >> 2, nt = u.pn & 3;
        const int row0 = u.pm * BM + wr * 64 + fr, col0 = nt * BM + wc * 32 + 8 * fq;
        constexpr float SC = 1.f / 256.f;
        f32x4 bv[2][2];
#pragma unroll
        for (int bj = 0; bj < 2; ++bj) { bv[bj][0] = *(const f32x4*)(b2 + (size_t)e * 1024 + col0 + bj * HALF); bv[bj][1] = *(const f32x4*)(b2 + (size_t)e * 1024 + col0 + bj * HALF + 4); }
#pragma unroll
        for (int ai = 0; ai < 2; ++ai)
#pragma unroll
            for (int m = 0; m < 4; ++m) { bf16_t* rowp = YB + (size_t)(row0 + ai * HALF + m * 16) * 1024 + col0;
#pragma unroll
                for (int bj = 0; bj < 2; ++bj) *(u32x4*)(rowp + bj * HALF) = pack8(acc[ai][bj][m][0] * SC + bv[bj][0], acc[ai][bj][m][1] * SC + bv[bj][1]); }
    }
};
template <int NN> struct MoeOrder {
    const PG8_LAS int* texp; int G, c, ntile;
    __device__ __forceinline__ bool next(int i, Unit& u) const {
        const int L = i * G + c; if (L >= ntile * NN) return false;
        const int t = L / NN, pnl = L % NN;
        u.pm = t; u.pn = texp[t] * NN + pnl; return true;
    }
    __device__ __forceinline__ void a_ready(const Unit&) const {}
    __device__ __forceinline__ void done(const Unit&) const {}
};
template <class Epi, class Sched, bool ALIGN_EPI = false, bool SP2 = false>
__device__ __forceinline__ void gemm_phase(PG8_LAS unsigned char* lds, const Gemm g, const Sched& S, const Epi& E) {
    const int tid = threadIdx.x, wid = __builtin_amdgcn_readfirstlane(tid >> 6), lane = tid & 63, wr = wid >> 2, wc = wid & 3, fr = lane & 15, fq = lane >> 4;
    const int K = g.K, nt = K / BK;
    unsigned voffA[2], voffB[2];
#pragma unroll
    for (int i = 0; i < 2; ++i) { int R, C; stage_rc(tid * 16 + i * 8192, R, C); const int Rb = Epi::PERM ? ((R & ~31) + perm32(R & 31)) : R;
        voffA[i] = (unsigned)(R * K + C) * 2u; voffB[i] = (unsigned)(Rb * K + C) * 2u; }
    const size_t kstep = (size_t)(BK * 2);
    const size_t hstep = (size_t)HALF * K * 2;
    const size_t tstep = 2 * hstep;
    const unsigned ldsw = (unsigned)wid * 1024u;
    const int aoff = lds_byte(wr * 64 + fr, fq * 8), boff = lds_byte(wc * 32 + fr, fq * 8);
#define PG8_SA(b, h) (((b) * 2 + (h)) * HTB)
#define PG8_SB(b, h) ((4 + (b) * 2 + (h)) * HTB)
#define PG8_STAGE(bufoff, gbase, voff) do { _Pragma("unroll") for (int _i = 0; _i < 2; ++_i) \
        __builtin_amdgcn_global_load_lds((const unsigned*)((const char*)(gbase) + (voff)[_i]), (PG8_LAS unsigned*)(lds + (bufoff) + ldsw + _i * 8192), 16, 0, 0); } while (0)
#define PG8_LDA(dst, b, h) do { _Pragma("unroll") for (int m = 0; m < 4; ++m) _Pragma("unroll") for (int k = 0; k < 2; ++k) dst[m][k] = *(const PG8_LAS bf16x8*)(lds + PG8_SA(b, h) + aoff + m * 2048 + k * 1024); } while (0)
#define PG8_LDB(dst, b, h) do { _Pragma("unroll") for (int n = 0; n < 2; ++n) _Pragma("unroll") for (int k = 0; k < 2; ++k) dst[n][k] = *(const PG8_LAS bf16x8*)(lds + PG8_SB(b, h) + boff + n * 2048 + k * 1024); } while (0)
#define PG8_MMA(ai, bj, At, Bt) do { __builtin_amdgcn_s_setprio(1); _Pragma("unroll") for (int m = 0; m < 4; ++m) _Pragma("unroll") for (int n = 0; n < 2; ++n) _Pragma("unroll") for (int k = 0; k < 2; ++k) \
        acc[ai][bj][m][n] = __builtin_amdgcn_mfma_f32_16x16x32_bf16(Bt[n][k], At[m][k], acc[ai][bj][m][n], 0, 0, 0); __builtin_amdgcn_s_setprio(0); } while (0)
#define PG8_WAIT_V(n) asm volatile("s_waitcnt vmcnt(" #n ")" ::: "memory")
#define PG8_WAIT_L(n) asm volatile("s_waitcnt lgkmcnt(" #n ")" ::: "memory")
#define PG8_BAR __builtin_amdgcn_s_barrier()
#define PG8_SCHED __builtin_amdgcn_sched_barrier(0)
    Unit cur, nxt; int ui = 0;
    if (!S.next(0, cur)) return;
    f32x4 acc[2][2][4][2];
#pragma unroll
    for (int a = 0; a < 2; ++a)
#pragma unroll
        for (int b = 0; b < 2; ++b)
#pragma unroll
            for (int m = 0; m < 4; ++m)
#pragma unroll
                for (int n = 0; n < 2; ++n) acc[a][b][m][n] = (f32x4){0.f, 0.f, 0.f, 0.f};
    bf16x8 At[4][2], B0[2][2], B1[2][2];
    const char* cA = (const char*)g.A + (size_t)cur.pm * tstep; const char* cB = (const char*)g.Bt + (size_t)cur.pn * tstep;
    S.a_ready(cur);
    if constexpr (SP2) {
        PG8_STAGE(PG8_SB(0, 0), cB, voffB); PG8_STAGE(PG8_SB(0, 1), cB + hstep, voffB); PG8_STAGE(PG8_SA(0, 0), cA, voffA); PG8_STAGE(PG8_SA(0, 1), cA + hstep, voffA);
        if (wr == 1) PG8_BAR;
        PG8_WAIT_V(2); PG8_BAR;
        PG8_STAGE(PG8_SB(1, 0), cB + kstep, voffB); PG8_STAGE(PG8_SA(1, 0), cA + kstep, voffA); PG8_STAGE(PG8_SB(1, 1), cB + hstep + kstep, voffB);
        PG8_WAIT_V(6); PG8_BAR;
    } else {
        PG8_STAGE(PG8_SB(0, 0), cB, voffB); PG8_STAGE(PG8_SA(0, 0), cA, voffA); PG8_STAGE(PG8_SB(0, 1), cB + hstep, voffB); PG8_STAGE(PG8_SA(0, 1), cA + hstep, voffA);
        if (wr == 1) PG8_BAR;
        PG8_WAIT_V(4); PG8_BAR;
        PG8_STAGE(PG8_SB(1, 0), cB + kstep, voffB); PG8_STAGE(PG8_SA(1, 0), cA + kstep, voffA); PG8_STAGE(PG8_SB(1, 1), cB + hstep + kstep, voffB);
        PG8_WAIT_V(6); PG8_BAR;
    }
    for (;;) {
        const bool has_next = S.next(ui + 1, nxt);
        const char* nA = has_next ? (const char*)g.A + (size_t)nxt.pm * tstep : cA; const char* nB = has_next ? (const char*)g.Bt + (size_t)nxt.pn * tstep : cB;
        for (int t = 0; t < nt; t += 2) {
            const bool last = (t == nt - 2);
            const char* a1 = cA + (size_t)(t + 1) * kstep;
            const char* a2 = last ? nA : cA + (size_t)(t + 2) * kstep; const char* b2 = last ? nB : cB + (size_t)(t + 2) * kstep;
            const char* a3 = a2 + kstep; const char* b3 = b2 + kstep;
            if (last && has_next) S.a_ready(nxt);
            if constexpr (SP2) {
            PG8_LDB(B0, 0, 0); PG8_LDB(B1, 0, 1); PG8_SCHED; PG8_LDA(At, 0, 0); PG8_STAGE(PG8_SA(1, 1), a1 + hstep, voffA);
            PG8_WAIT_V(8); PG8_WAIT_L(0); PG8_BAR; PG8_MMA(0, 0, At, B0); PG8_MMA(0, 1, At, B1); PG8_BAR; PG8_SCHED;
            PG8_LDA(At, 0, 1); PG8_STAGE(PG8_SB(0, 0), b2, voffB); PG8_STAGE(PG8_SB(0, 1), b2 + hstep, voffB); PG8_STAGE(PG8_SA(0, 0), a2, voffA);
            PG8_WAIT_V(8); PG8_WAIT_L(0); PG8_BAR; PG8_MMA(1, 0, At, B0); PG8_MMA(1, 1, At, B1); PG8_BAR; PG8_SCHED;
            PG8_LDB(B0, 1, 0); PG8_LDB(B1, 1, 1); PG8_SCHED; PG8_LDA(At, 1, 0); PG8_STAGE(PG8_SA(0, 1), a2 + hstep, voffA);
            PG8_WAIT_V(8); PG8_WAIT_L(0); PG8_BAR; PG8_MMA(0, 0, At, B0); PG8_MMA(0, 1, At, B1); PG8_BAR; PG8_SCHED;
            PG8_LDA(At, 1, 1); PG8_STAGE(PG8_SB(1, 0), b3, voffB); PG8_STAGE(PG8_SB(1, 1), b3 + hstep, voffB); PG8_STAGE(PG8_SA(1, 0), a3, voffA);
            PG8_WAIT_V(8); PG8_WAIT_L(0); PG8_BAR; PG8_MMA(1, 0, At, B0); PG8_MMA(1, 1, At, B1); PG8_BAR; PG8_SCHED;
            } else {
            PG8_LDB(B0, 0, 0); PG8_SCHED; PG8_LDA(At, 0, 0); PG8_STAGE(PG8_SA(1, 1), a1 + hstep, voffA);
            PG8_WAIT_L(8); PG8_BAR; PG8_WAIT_L(0); PG8_MMA(0, 0, At, B0); PG8_BAR; PG8_SCHED;
            PG8_LDB(B1, 0, 1); PG8_STAGE(PG8_SB(0, 0), b2, voffB);
            PG8_BAR; PG8_WAIT_L(0); PG8_MMA(0, 1, At, B1); PG8_BAR;
            PG8_LDA(At, 0, 1); PG8_STAGE(PG8_SA(0, 0), a2, voffA);
            PG8_BAR; PG8_WAIT_L(0); PG8_MMA(1, 0, At, B0); PG8_BAR; PG8_SCHED;
            PG8_STAGE(PG8_SB(0, 1), b2 + hstep, voffB);
            PG8_WAIT_V(6); PG8_BAR; PG8_MMA(1, 1, At, B1); PG8_BAR;
            PG8_LDB(B0, 1, 0); PG8_SCHED; PG8_LDA(At, 1, 0); PG8_STAGE(PG8_SA(0, 1), a2 + hstep, voffA);
            PG8_WAIT_L(8); PG8_BAR; PG8_WAIT_L(0); PG8_MMA(0, 0, At, B0); PG8_BAR; PG8_SCHED;
            PG8_LDB(B1, 1, 1); PG8_STAGE(PG8_SB(1, 0), b3, voffB);
            PG8_BAR; PG8_WAIT_L(0); PG8_MMA(0, 1, At, B1); PG8_BAR;
            PG8_LDA(At, 1, 1); PG8_STAGE(PG8_SA(1, 0), a3, voffA);
            PG8_BAR; PG8_WAIT_L(0); PG8_MMA(1, 0, At, B0); PG8_BAR; PG8_SCHED;
            PG8_STAGE(PG8_SB(1, 1), b3 + hstep, voffB);
            PG8_WAIT_V(6); PG8_BAR; PG8_MMA(1, 1, At, B1); PG8_BAR;
            }
        }
        if constexpr (ALIGN_EPI) { if (wr == 0) PG8_BAR; }
        if constexpr (!Epi::AFTER_DRAIN) { E(acc, cur, wr, wc, fr, fq); S.done(cur); }
        if (!has_next) break;
#pragma unroll
        for (int a = 0; a < 2; ++a)
#pragma unroll
            for (int b = 0; b < 2; ++b)
#pragma unroll
                for (int m = 0; m < 4; ++m)
#pragma unroll
                    for (int n = 0; n < 2; ++n) acc[a][b][m][n] = (f32x4){0.f, 0.f, 0.f, 0.f};
        cur = nxt; cA = nA; cB = nB; ++ui;
        if constexpr (ALIGN_EPI) { if (wr == 1) PG8_BAR; }
    }
    PG8_WAIT_V(0);
    if constexpr (!ALIGN_EPI) { if (wr == 0) PG8_BAR; }
    PG8_BAR;
    if constexpr (Epi::AFTER_DRAIN) { E.fused(acc, cur, wr, wc, fr, fq, lds, wid, lane); S.done(cur); }
#undef PG8_SA
#undef PG8_SB
#undef PG8_STAGE
#undef PG8_LDA
#undef PG8_LDB
#undef PG8_MMA
#undef PG8_WAIT_V
#undef PG8_WAIT_L
#undef PG8_BAR
#undef PG8_SCHED
}

struct MoeGatherOrder {
    const PG8_LAS int* offs; const PG8_LAS int* cnt; const PG8_LAS int* texp; const int* LIST; int G, c, ntile;
    __device__ __forceinline__ bool next(int i, Unit& u) const {
        const int L = i * G + c; if (L >= ntile * 8) return false;
        const int t = L >> 3, pnl = L & 7;
        u.pm = t; u.pn = texp[t] * 8 + pnl; return true;
    }
    __device__ __forceinline__ int arow(const Unit& u, int r) const { const int e = u.pn >> 3, slot = u.pm * 256 + r - offs[e]; return slot < cnt[e] ? LIST[e * 16384 + slot] : 0; }
    __device__ __forceinline__ void a_ready(const Unit&) const {}
    __device__ __forceinline__ void done(const Unit&) const {}
};
struct TailOrder {
    StaticOrder so;
    __device__ __forceinline__ bool next(int i, Unit& u) const { Unit b; if (!so.next(i >> 1, b)) return false; u.pm = b.pm + 64 * (i & 1); u.pn = b.pn + 4 * (i & 1); return true; }
    __device__ __forceinline__ void a_ready(const Unit&) const {}
    __device__ __forceinline__ void done(const Unit&) const {}
};
struct EpiT12 {
    static constexpr bool PERM = true, AFTER_DRAIN = false;
    bf16_t* T1; bf16_t* MG; const bf16_t* G; int ldg; const float* RSTD;
    __device__ __forceinline__ void operator()(const f32x4 (&acc)[2][2][4][2], const Unit& u, int wr, int wc, int fr, int fq) const {
        const bool second = u.pm >= 64;
        const int row0 = (u.pm & 63) * BM + wr * 64 + fr, col0 = (u.pn & 3) * BM + wc * 32 + 8 * fq;
        const bf16_t* Gp = G + (second ? 1024 : 0);
#pragma unroll
        for (int ai = 0; ai < 2; ++ai) {
            u32x4 gv[4][2], tv[4][2]; float rs[4];
#pragma unroll
            for (int m = 0; m < 4; ++m) { const int row = row0 + ai * HALF + m * 16; rs[m] = second ? 1.f : RSTD[row];
#pragma unroll
                for (int bj = 0; bj < 2; ++bj) { gv[m][bj] = *(const u32x4*)(Gp + (size_t)row * ldg + col0 + bj * HALF);
                    tv[m][bj] = second ? *(const u32x4*)(T1 + (size_t)row * 1024 + col0 + bj * HALF) : (u32x4){0u, 0u, 0u, 0u}; } }
#pragma unroll
            for (int m = 0; m < 4; ++m) { const int row = row0 + ai * HALF + m * 16;
#pragma unroll
                for (int bj = 0; bj < 2; ++bj) { f32x4 g0, g1, t0, t1; unpack8(gv[m][bj], g0, g1); unpack8(tv[m][bj], t0, t1);
                    f32x4 v0 = acc[ai][bj][m][0] * rs[m], v1 = acc[ai][bj][m][1] * rs[m];
#pragma unroll
                    for (int i = 0; i < 4; ++i) { v0[i] = fmaf(v0[i], sig_(g0[i]), t0[i]); v1[i] = fmaf(v1[i], sig_(g1[i]), t1[i]); }
                    *(u32x4*)((second ? MG : T1) + (size_t)row * 1024 + col0 + bj * HALF) = pack8(v0, v1); } }
        }
    }
};
struct EpiT3b {
    static constexpr bool PERM = true, AFTER_DRAIN = false;
    bf16_t* X1; const float* x;
    __device__ __forceinline__ void operator()(const f32x4 (&acc)[2][2][4][2], const Unit& u, int wr, int wc, int fr, int fq) const {
        const int row0 = u.pm * BM + wr * 64 + fr, col0 = u.pn * BM + wc * 32 + 8 * fq;
#pragma unroll
        for (int ai = 0; ai < 2; ++ai) {
            f32x4 xv[4][2][2];
#pragma unroll
            for (int m = 0; m < 4; ++m)
#pragma unroll
                for (int bj = 0; bj < 2; ++bj) { const size_t o = (size_t)(row0 + ai * HALF + m * 16) * 1024 + col0 + bj * HALF; xv[m][bj][0] = *(const f32x4*)(x + o); xv[m][bj][1] = *(const f32x4*)(x + o + 4); }
#pragma unroll
            for (int m = 0; m < 4; ++m)
#pragma unroll
                for (int bj = 0; bj < 2; ++bj) { const size_t o = (size_t)(row0 + ai * HALF + m * 16) * 1024 + col0 + bj * HALF;
                    *(u32x4*)(X1 + o) = pack8(xv[m][bj][0] + acc[ai][bj][m][0], xv[m][bj][1] + acc[ai][bj][m][1]); }
        }
    }
};
typedef int v4i_t __attribute__((ext_vector_type(4)));
typedef int v8i_t __attribute__((ext_vector_type(8)));
template <class Epi, class Sched, bool ALIGN_EPI = false, bool SP2 = false>
__device__ __forceinline__ void gemm_phase_f8(PG8_LAS unsigned char* lds, const Gemm g, const Sched& S, const Epi& E) {
    const int tid = threadIdx.x, wid = __builtin_amdgcn_readfirstlane(tid >> 6), lane = tid & 63, wr = wid >> 2, wc = wid & 3, fr = lane & 15, fq = lane >> 4;
    const int K = g.K, nt = K / BK;
    unsigned voffA[2], voffB[2];
#pragma unroll
    for (int i = 0; i < 2; ++i) { int R, C; stage_rc(tid * 16 + i * 8192, R, C); const int Rb = Epi::PERM ? ((R & ~31) + perm32(R & 31)) : R;
        voffA[i] = (unsigned)(R * K + C) * 2u; voffB[i] = (unsigned)(Rb * K + C) * 2u; }
    const size_t kstep = (size_t)(BK * 2);
    const size_t hstep = (size_t)HALF * K * 2;
    const size_t tstep = 2 * hstep;
    const unsigned ldsw = (unsigned)wid * 1024u;
    const int aoff = lds_byte(wr * 64 + fr, fq * 8), boff = lds_byte(wc * 32 + fr, fq * 8);
#define PG8_SA(b, h) (((b) * 2 + (h)) * HTB)
#define PG8_SB(b, h) ((4 + (b) * 2 + (h)) * HTB)
#define PG8_STAGE(bufoff, gbase, voff) do { _Pragma("unroll") for (int _i = 0; _i < 2; ++_i) \
        __builtin_amdgcn_global_load_lds((const unsigned*)((const char*)(gbase) + (voff)[_i]), (PG8_LAS unsigned*)(lds + (bufoff) + ldsw + _i * 8192), 16, 0, 0); } while (0)
#define PG8_LDA(dst, b, h) do { _Pragma("unroll") for (int m = 0; m < 4; ++m) { const v4i_t lo_ = *(const PG8_LAS v4i_t*)(lds + PG8_SA(b, h) + aoff + m * 2048), hi_ = *(const PG8_LAS v4i_t*)(lds + PG8_SA(b, h) + aoff + m * 2048 + 1024); dst[m] = __builtin_shufflevector(lo_, hi_, 0, 1, 2, 3, 4, 5, 6, 7); } } while (0)
#define PG8_LDB(dst, b, h) do { _Pragma("unroll") for (int n = 0; n < 2; ++n) { const v4i_t lo_ = *(const PG8_LAS v4i_t*)(lds + PG8_SB(b, h) + boff + n * 2048), hi_ = *(const PG8_LAS v4i_t*)(lds + PG8_SB(b, h) + boff + n * 2048 + 1024); dst[n] = __builtin_shufflevector(lo_, hi_, 0, 1, 2, 3, 4, 5, 6, 7); } } while (0)
#define PG8_MMA(ai, bj, At, Bt) do { __builtin_amdgcn_s_setprio(1); _Pragma("unroll") for (int m = 0; m < 4; ++m) _Pragma("unroll") for (int n = 0; n < 2; ++n) \
        asm volatile("v_mfma_scale_f32_16x16x128_f8f6f4 %0, %1, %2, %0, %3, %3 op_sel_hi:[0,0,0]" : "+v"(acc[ai][bj][m][n]) : "v"(Bt[n]), "v"(At[m]), "v"(scl_)); __builtin_amdgcn_s_setprio(0); } while (0)
#define PG8_WAIT_V(n) asm volatile("s_waitcnt vmcnt(" #n ")" ::: "memory")
#define PG8_WAIT_L(n) asm volatile("s_waitcnt lgkmcnt(" #n ")" ::: "memory")
#define PG8_BAR __builtin_amdgcn_s_barrier()
#define PG8_SCHED __builtin_amdgcn_sched_barrier(0)
    Unit cur, nxt; int ui = 0;
    if (!S.next(0, cur)) return;
    f32x4 acc[2][2][4][2];
#pragma unroll
    for (int a = 0; a < 2; ++a)
#pragma unroll
        for (int b = 0; b < 2; ++b)
#pragma unroll
            for (int m = 0; m < 4; ++m)
#pragma unroll
                for (int n = 0; n < 2; ++n) acc[a][b][m][n] = (f32x4){0.f, 0.f, 0.f, 0.f};
    const int scl_ = 0x7f7f7f7f;
    v8i_t At[4], B0[2], B1[2];
    const char* cA = (const char*)g.A + (size_t)cur.pm * tstep; const char* cB = (const char*)g.Bt + (size_t)cur.pn * tstep;
    S.a_ready(cur);
    if constexpr (SP2) {
        PG8_STAGE(PG8_SB(0, 0), cB, voffB); PG8_STAGE(PG8_SB(0, 1), cB + hstep, voffB); PG8_STAGE(PG8_SA(0, 0), cA, voffA); PG8_STAGE(PG8_SA(0, 1), cA + hstep, voffA);
        if (wr == 1) PG8_BAR;
        PG8_WAIT_V(2); PG8_BAR;
        PG8_STAGE(PG8_SB(1, 0), cB + kstep, voffB); PG8_STAGE(PG8_SA(1, 0), cA + kstep, voffA); PG8_STAGE(PG8_SB(1, 1), cB + hstep + kstep, voffB);
        PG8_WAIT_V(6); PG8_BAR;
    } else {
        PG8_STAGE(PG8_SB(0, 0), cB, voffB); PG8_STAGE(PG8_SA(0, 0), cA, voffA); PG8_STAGE(PG8_SB(0, 1), cB + hstep, voffB); PG8_STAGE(PG8_SA(0, 1), cA + hstep, voffA);
        if (wr == 1) PG8_BAR;
        PG8_WAIT_V(4); PG8_BAR;
        PG8_STAGE(PG8_SB(1, 0), cB + kstep, voffB); PG8_STAGE(PG8_SA(1, 0), cA + kstep, voffA); PG8_STAGE(PG8_SB(1, 1), cB + hstep + kstep, voffB);
        PG8_WAIT_V(6); PG8_BAR;
    }
    for (;;) {
        const bool has_next = S.next(ui + 1, nxt);
        const char* nA = has_next ? (const char*)g.A + (size_t)nxt.pm * tstep : cA; const char* nB = has_next ? (const char*)g.Bt + (size_t)nxt.pn * tstep : cB;
        for (int t = 0; t < nt; t += 2) {
            const bool last = (t == nt - 2);
            const char* a1 = cA + (size_t)(t + 1) * kstep;
            const char* a2 = last ? nA : cA + (size_t)(t + 2) * kstep; const char* b2 = last ? nB : cB + (size_t)(t + 2) * kstep;
            const char* a3 = a2 + kstep; const char* b3 = b2 + kstep;
            if (last && has_next) S.a_ready(nxt);
            if constexpr (SP2) {
            PG8_LDB(B0, 0, 0); PG8_LDB(B1, 0, 1); PG8_SCHED; PG8_LDA(At, 0, 0); PG8_STAGE(PG8_SA(1, 1), a1 + hstep, voffA);
            PG8_WAIT_V(8); PG8_WAIT_L(0); PG8_BAR; PG8_MMA(0, 0, At, B0); PG8_MMA(0, 1, At, B1); PG8_BAR; PG8_SCHED;
            PG8_LDA(At, 0, 1); PG8_STAGE(PG8_SB(0, 0), b2, voffB); PG8_STAGE(PG8_SB(0, 1), b2 + hstep, voffB); PG8_STAGE(PG8_SA(0, 0), a2, voffA);
            PG8_WAIT_V(8); PG8_WAIT_L(0); PG8_BAR; PG8_MMA(1, 0, At, B0); PG8_MMA(1, 1, At, B1); PG8_BAR; PG8_SCHED;
            PG8_LDB(B0, 1, 0); PG8_LDB(B1, 1, 1); PG8_SCHED; PG8_LDA(At, 1, 0); PG8_STAGE(PG8_SA(0, 1), a2 + hstep, voffA);
            PG8_WAIT_V(8); PG8_WAIT_L(0); PG8_BAR; PG8_MMA(0, 0, At, B0); PG8_MMA(0, 1, At, B1); PG8_BAR; PG8_SCHED;
            PG8_LDA(At, 1, 1); PG8_STAGE(PG8_SB(1, 0), b3, voffB); PG8_STAGE(PG8_SB(1, 1), b3 + hstep, voffB); PG8_STAGE(PG8_SA(1, 0), a3, voffA);
            PG8_WAIT_V(8); PG8_WAIT_L(0); PG8_BAR; PG8_MMA(1, 0, At, B0); PG8_MMA(1, 1, At, B1); PG8_BAR; PG8_SCHED;
            } else {
            PG8_LDB(B0, 0, 0); PG8_SCHED; PG8_LDA(At, 0, 0); PG8_STAGE(PG8_SA(1, 1), a1 + hstep, voffA);
            PG8_WAIT_L(8); PG8_BAR; PG8_WAIT_L(0); PG8_MMA(0, 0, At, B0); PG8_BAR; PG8_SCHED;
            PG8_LDB(B1, 0, 1); PG8_STAGE(PG8_SB(0, 0), b2, voffB);
            PG8_BAR; PG8_WAIT_L(0); PG8_MMA(0, 1, At, B1); PG8_BAR;
            PG8_LDA(At, 0, 1); PG8_STAGE(PG8_SA(0, 0), a2, voffA);
            PG8_BAR; PG8_WAIT_L(0); PG8_MMA(1, 0, At, B0); PG8_BAR; PG8_SCHED;
            PG8_STAGE(PG8_SB(0, 1), b2 + hstep, voffB);
            PG8_WAIT_V(6); PG8_BAR; PG8_MMA(1, 1, At, B1); PG8_BAR;
            PG8_LDB(B0, 1, 0); PG8_SCHED; PG8_LDA(At, 1, 0); PG8_STAGE(PG8_SA(0, 1), a2 + hstep, voffA);
            PG8_WAIT_L(8); PG8_BAR; PG8_WAIT_L(0); PG8_MMA(0, 0, At, B0); PG8_BAR; PG8_SCHED;
            PG8_LDB(B1, 1, 1); PG8_STAGE(PG8_SB(1, 0), b3, voffB);
            PG8_BAR; PG8_WAIT_L(0); PG8_MMA(0, 1, At, B1); PG8_BAR;
            PG8_LDA(At, 1, 1); PG8_STAGE(PG8_SA(1, 0), a3, voffA);
            PG8_BAR; PG8_WAIT_L(0); PG8_MMA(1, 0, At, B0); PG8_BAR; PG8_SCHED;
            PG8_STAGE(PG8_SB(1, 1), b3 + hstep, voffB);
            PG8_WAIT_V(6); PG8_BAR; PG8_MMA(1, 1, At, B1); PG8_BAR;
            }
        }
        if constexpr (ALIGN_EPI) { if (wr == 0) PG8_BAR; }
        asm volatile("s_nop 15\n\ts_nop 15" ::: "memory");
        if constexpr (!Epi::AFTER_DRAIN) { E(acc, cur, wr, wc, fr, fq); S.done(cur); }
        if (!has_next) break;
#pragma unroll
        for (int a = 0; a < 2; ++a)
#pragma unroll
            for (int b = 0; b < 2; ++b)
#pragma unroll
                for (int m = 0; m < 4; ++m)
#pragma unroll
                    for (int n = 0; n < 2; ++n) acc[a][b][m][n] = (f32x4){0.f, 0.f, 0.f, 0.f};
        cur = nxt; cA = nA; cB = nB; ++ui;
        if constexpr (ALIGN_EPI) { if (wr == 1) PG8_BAR; }
    }
    PG8_WAIT_V(0);
    if constexpr (!ALIGN_EPI) { if (wr == 0) PG8_BAR; }
    PG8_BAR;
    if constexpr (Epi::AFTER_DRAIN) { E.fused(acc, cur, wr, wc, fr, fq, lds, wid, lane); S.done(cur); }
#undef PG8_SA
#undef PG8_SB
#undef PG8_STAGE
#undef PG8_LDA
#undef PG8_LDB
#undef PG8_MMA
#undef PG8_WAIT_V
#undef PG8_WAIT_L
#undef PG8_BAR
#undef PG8_SCHED
}

template <class Epi, class Sched>
__device__ __forceinline__ void gemm_phase_gather_f8(PG8_LAS unsigned char* lds, const Gemm g, const Sched& S, const Epi& E) {
    constexpr bool ALIGN_EPI = true, SP2 = true;
    const int tid = threadIdx.x, wid = __builtin_amdgcn_readfirstlane(tid >> 6), lane = tid & 63, wr = wid >> 2, wc = wid & 3, fr = lane & 15, fq = lane >> 4;
    const int K = g.K, nt = K / BK;
    unsigned voffA[2], voffB[2];
#pragma unroll
    for (int i = 0; i < 2; ++i) { int R, C; stage_rc(tid * 16 + i * 8192, R, C); const int Rb = Epi::PERM ? ((R & ~31) + perm32(R & 31)) : R;
        voffA[i] = (unsigned)(R * K + C) * 2u; voffB[i] = (unsigned)(Rb * K + C) * 2u; }
    const size_t kstep = (size_t)(BK * 2);
    const size_t hstep = (size_t)HALF * K * 2;
    const size_t tstep = 2 * hstep;
    const unsigned ldsw = (unsigned)wid * 1024u;
    const int aoff = lds_byte(wr * 64 + fr, fq * 8), boff = lds_byte(wc * 32 + fr, fq * 8);
#define PG8_SA(b, h) (((b) * 2 + (h)) * HTB)
#define PG8_SB(b, h) ((4 + (b) * 2 + (h)) * HTB)
#define PG8_STAGE(bufoff, gbase, voff) do { _Pragma("unroll") for (int _i = 0; _i < 2; ++_i) \
        __builtin_amdgcn_global_load_lds((const unsigned*)((const char*)(gbase) + (voff)[_i]), (PG8_LAS unsigned*)(lds + (bufoff) + ldsw + _i * 8192), 16, 0, 0); } while (0)
#define PG8_LDA(dst, b, h) do { _Pragma("unroll") for (int m = 0; m < 4; ++m) { const v4i_t lo_ = *(const PG8_LAS v4i_t*)(lds + PG8_SA(b, h) + aoff + m * 2048), hi_ = *(const PG8_LAS v4i_t*)(lds + PG8_SA(b, h) + aoff + m * 2048 + 1024); dst[m] = __builtin_shufflevector(lo_, hi_, 0, 1, 2, 3, 4, 5, 6, 7); } } while (0)
#define PG8_LDB(dst, b, h) do { _Pragma("unroll") for (int n = 0; n < 2; ++n) { const v4i_t lo_ = *(const PG8_LAS v4i_t*)(lds + PG8_SB(b, h) + boff + n * 2048), hi_ = *(const PG8_LAS v4i_t*)(lds + PG8_SB(b, h) + boff + n * 2048 + 1024); dst[n] = __builtin_shufflevector(lo_, hi_, 0, 1, 2, 3, 4, 5, 6, 7); } } while (0)
#define PG8_MMA(ai, bj, At, Bt) do { __builtin_amdgcn_s_setprio(1); _Pragma("unroll") for (int m = 0; m < 4; ++m) _Pragma("unroll") for (int n = 0; n < 2; ++n) \
        asm volatile("v_mfma_scale_f32_16x16x128_f8f6f4 %0, %1, %2, %0, %3, %3 op_sel_hi:[0,0,0]" : "+v"(acc[ai][bj][m][n]) : "v"(Bt[n]), "v"(At[m]), "v"(scl_)); __builtin_amdgcn_s_setprio(0); } while (0)
#define PG8_WAIT_V(n) asm volatile("s_waitcnt vmcnt(" #n ")" ::: "memory")
#define PG8_WAIT_L(n) asm volatile("s_waitcnt lgkmcnt(" #n ")" ::: "memory")
#define PG8_BAR __builtin_amdgcn_s_barrier()
#define PG8_SCHED __builtin_amdgcn_sched_barrier(0)
    Unit cur, nxt; int ui = 0;
    if (!S.next(0, cur)) return;
    int rA[2]; unsigned cAo[2];
#pragma unroll
    for (int i = 0; i < 2; ++i) { int R, C; stage_rc(tid * 16 + i * 8192, R, C); rA[i] = R; cAo[i] = (unsigned)C * 2u; }
    unsigned cO[2][2], o2[2][2]; int nR[2][2];
#define PG8_ROWS(dst, u) do { _Pragma("unroll") for (int h_ = 0; h_ < 2; ++h_) _Pragma("unroll") for (int i_ = 0; i_ < 2; ++i_) \
        dst[h_][i_] = (unsigned)S.arow(u, h_ * HALF + rA[i_]) * (unsigned)(K * 2) + cAo[i_]; } while (0)
    PG8_ROWS(cO, cur);
    f32x4 acc[2][2][4][2];
#pragma unroll
    for (int a = 0; a < 2; ++a)
#pragma unroll
        for (int b = 0; b < 2; ++b)
#pragma unroll
            for (int m = 0; m < 4; ++m)
#pragma unroll
                for (int n = 0; n < 2; ++n) acc[a][b][m][n] = (f32x4){0.f, 0.f, 0.f, 0.f};
    const int scl_ = 0x7f7f7f7f;
    v8i_t At[4], B0[2], B1[2];
    const char* const Ab = (const char*)g.A; const char* cB = (const char*)g.Bt + (size_t)cur.pn * tstep;
    S.a_ready(cur);
    if constexpr (SP2) {
        PG8_STAGE(PG8_SB(0, 0), cB, voffB); PG8_STAGE(PG8_SB(0, 1), cB + hstep, voffB); PG8_STAGE(PG8_SA(0, 0), Ab, cO[0]); PG8_STAGE(PG8_SA(0, 1), Ab, cO[1]);
        if (wr == 1) PG8_BAR;
        PG8_WAIT_V(2); PG8_BAR;
        PG8_STAGE(PG8_SB(1, 0), cB + kstep, voffB); PG8_STAGE(PG8_SA(1, 0), Ab + kstep, cO[0]); PG8_STAGE(PG8_SB(1, 1), cB + hstep + kstep, voffB);
        PG8_WAIT_V(6); PG8_BAR;
    }
    for (;;) {
        const bool has_next = S.next(ui + 1, nxt);
        const char* nB = has_next ? (const char*)g.Bt + (size_t)nxt.pn * tstep : cB;
#pragma unroll
        for (int h_ = 0; h_ < 2; ++h_)
#pragma unroll
            for (int i_ = 0; i_ < 2; ++i_) nR[h_][i_] = has_next ? S.arow(nxt, h_ * HALF + rA[i_]) : 0;
        for (int t = 0; t < nt; t += 2) {
            const bool last = (t == nt - 2);
            const char* a1 = Ab + (size_t)(t + 1) * kstep;
            const char* a2 = last ? Ab : Ab + (size_t)(t + 2) * kstep; const char* b2 = last ? nB : cB + (size_t)(t + 2) * kstep;
#pragma unroll
            for (int h_ = 0; h_ < 2; ++h_)
#pragma unroll
                for (int i_ = 0; i_ < 2; ++i_) o2[h_][i_] = cO[h_][i_];
            if (last && has_next) {
#pragma unroll
                for (int h_ = 0; h_ < 2; ++h_)
#pragma unroll
                    for (int i_ = 0; i_ < 2; ++i_) { int v_ = nR[h_][i_]; asm volatile("" : "+v"(v_)); o2[h_][i_] = (unsigned)v_ * (unsigned)(K * 2) + cAo[i_]; } }
            const char* a3 = a2 + kstep; const char* b3 = b2 + kstep;
            if (last && has_next) S.a_ready(nxt);
            if constexpr (SP2) {
            PG8_LDB(B0, 0, 0); PG8_LDB(B1, 0, 1); PG8_SCHED; PG8_LDA(At, 0, 0); PG8_STAGE(PG8_SA(1, 1), a1, cO[1]);
            PG8_WAIT_V(8); PG8_WAIT_L(0); PG8_BAR; PG8_MMA(0, 0, At, B0); PG8_MMA(0, 1, At, B1); PG8_BAR; PG8_SCHED;
            PG8_LDA(At, 0, 1); PG8_STAGE(PG8_SB(0, 0), b2, voffB); PG8_STAGE(PG8_SB(0, 1), b2 + hstep, voffB); PG8_STAGE(PG8_SA(0, 0), a2, o2[0]);
            PG8_WAIT_V(8); PG8_WAIT_L(0); PG8_BAR; PG8_MMA(1, 0, At, B0); PG8_MMA(1, 1, At, B1); PG8_BAR; PG8_SCHED;
            PG8_LDB(B0, 1, 0); PG8_LDB(B1, 1, 1); PG8_SCHED; PG8_LDA(At, 1, 0); PG8_STAGE(PG8_SA(0, 1), a2, o2[1]);
            PG8_WAIT_V(8); PG8_WAIT_L(0); PG8_BAR; PG8_MMA(0, 0, At, B0); PG8_MMA(0, 1, At, B1); PG8_BAR; PG8_SCHED;
            PG8_LDA(At, 1, 1); PG8_STAGE(PG8_SB(1, 0), b3, voffB); PG8_STAGE(PG8_SB(1, 1), b3 + hstep, voffB); PG8_STAGE(PG8_SA(1, 0), a3, o2[0]);
            PG8_WAIT_V(8); PG8_WAIT_L(0); PG8_BAR; PG8_MMA(1, 0, At, B0); PG8_MMA(1, 1, At, B1); PG8_BAR; PG8_SCHED;
            }
        }
        if constexpr (ALIGN_EPI) { if (wr == 0) PG8_BAR; }
        asm volatile("s_nop 15\n\ts_nop 15" ::: "memory");
        if constexpr (!Epi::AFTER_DRAIN) { E(acc, cur, wr, wc, fr, fq); S.done(cur); }
        if (!has_next) break;
#pragma unroll
        for (int a = 0; a < 2; ++a)
#pragma unroll
            for (int b = 0; b < 2; ++b)
#pragma unroll
                for (int m = 0; m < 4; ++m)
#pragma unroll
                    for (int n = 0; n < 2; ++n) acc[a][b][m][n] = (f32x4){0.f, 0.f, 0.f, 0.f};
        cur = nxt; cB = nB; ++ui;
#pragma unroll
        for (int h_ = 0; h_ < 2; ++h_)
#pragma unroll
            for (int i_ = 0; i_ < 2; ++i_) cO[h_][i_] = o2[h_][i_];
        if constexpr (ALIGN_EPI) { if (wr == 1) PG8_BAR; }
    }
    PG8_WAIT_V(0);
    if constexpr (!ALIGN_EPI) { if (wr == 0) PG8_BAR; }
    PG8_BAR;
    if constexpr (Epi::AFTER_DRAIN) { E.fused(acc, cur, wr, wc, fr, fq, lds, wid, lane); S.done(cur); }
#undef PG8_ROWS
#undef PG8_SA
#undef PG8_SB
#undef PG8_STAGE
#undef PG8_LDA
#undef PG8_LDB
#undef PG8_MMA
#undef PG8_WAIT_V
#undef PG8_WAIT_L
#undef PG8_BAR
#undef PG8_SCHED
}
}

typedef short bf16x8c __attribute__((ext_vector_type(8)));
typedef float f32x16c __attribute__((ext_vector_type(16)));
__device__ __forceinline__ void phase_conv(const Params& p, const Ctx& c) {
    unsigned char* ws = p.ws;
    const bf16_t* P = (const bf16_t*)(ws + WS_P);
    const int tid = c.tid;
    LAS bf16_t* raw = (LAS bf16_t*)c.lds;
    LAS bf16_t* outb = (LAS bf16_t*)(c.lds + 132 * 256 * 2);
    for (int it = c.bid; it < 2 * 64 * 6; it += c.G) {
        const int part = it % 6, bc = it / 6, b = bc / 64, ch_ = bc % 64, t0 = ch_ * 128;
        __syncthreads();
        {
            u32x4 rv[9];
#pragma unroll
            for (int i = 0; i < 9; ++i) { const int idx = tid + 512 * i, r = idx >> 5, c8 = idx & 31, tok = t0 - 2 + r;
                rv[i] = (u32x4){0u, 0u, 0u, 0u};
                if (idx < 132 * 32 && tok >= 0 && tok < S) rv[i] = *(const u32x4*)(P + (size_t)(b * S + tok) * NPROJ + PXBC + part * 256 + c8 * 8); }
#pragma unroll
            for (int i = 0; i < 9; ++i) { const int idx = tid + 512 * i, r = idx >> 5, c8 = idx & 31;
                if (idx < 132 * 32) *(LAS u32x4*)(raw + r * 256 + c8 * 8) = rv[i]; }
        }
        __syncthreads();
        {
            const int ch = tid & 255, hf = tid >> 8, cg_ = part * 256 + ch;
            const float* cw = p.in[3]; const float cb = p.in[4][cg_];
            const float w0 = cw[0 * 1536 + cg_], w1 = cw[1 * 1536 + cg_], w2 = cw[2 * 1536 + cg_], w3 = cw[3 * 1536 + cg_], w4 = cw[4 * 1536 + cg_];
            const LAS bf16_t* rp = raw + (hf * 64) * 256 + ch;
            float r0 = bf2f(rp[0 * 256]), r1 = bf2f(rp[1 * 256]), r2 = bf2f(rp[2 * 256]), r3 = bf2f(rp[3 * 256]);
            unsigned ov[32];
#pragma unroll
            for (int i = 0; i < 64; ++i) {
                const float r4 = bf2f(rp[(i + 4) * 256]);
                float a = cb; a = fmaf(w0, r0, a); a = fmaf(w1, r1, a); a = fmaf(w2, r2, a); a = fmaf(w3, r3, a); a = fmaf(w4, r4, a);
                const unsigned hv = f2bf(a * sigmoidf_(a));
                if (i & 1) ov[i >> 1] |= hv << 16; else ov[i >> 1] = hv;
                r0 = r1; r1 = r2; r2 = r3; r3 = r4;
            }
            if (part <= 4) {
                bf16_t* dst = (part < 4 ? (bf16_t*)(ws + WS_XT) + ((size_t)(b * 64 + ch_) * 16 + part * 4) * 64 * 128
                                        : (bf16_t*)(ws + WS_BMT) + (size_t)(b * 64 + ch_) * 2 * 128 * 128) + (size_t)ch * 128 + hf * 64;
#pragma unroll
                for (int q = 0; q < 8; ++q) *(u32x4*)(dst + q * 8) = (u32x4){ov[4 * q], ov[4 * q + 1], ov[4 * q + 2], ov[4 * q + 3]};
            }
            if (part >= 4) {
#pragma unroll
                for (int i = 0; i < 64; ++i) outb[(hf * 64 + i) * 256 + ch] = (bf16_t)((i & 1) ? (ov[i >> 1] >> 16) : (ov[i >> 1] & 0xffffu));
            }
        }
        if (part >= 4) {
            __syncthreads();
            bf16_t* dst = (bf16_t*)(ws + (part == 4 ? WS_BMR : WS_CMR)) + (size_t)(b * S + t0) * 256;
#pragma unroll
            for (int q = 0; q < 8; ++q) { const int idx = tid + 512 * q, l = idx >> 5, c8 = idx & 31;
                *(u32x4*)(dst + (size_t)l * 256 + c8 * 8) = *(const LAS u32x4*)(outb + l * 256 + c8 * 8); }
        }
    }
    {
        float* DT = (float*)(ws + WS_DT); float* ACS = (float*)(ws + WS_ACS); float* CDEC = (float*)(ws + WS_CDEC);
        const bf16_t* H = (const bf16_t*)(ws + WS_H); const bf16_t* Wdt = (const bf16_t*)(ws + WS_WINT) + (size_t)PDT * 1024;
        constexpr int WS_ = 1032;
        LAS bf16_t* wl = (LAS bf16_t*)c.lds; LAS float* dtr = (LAS float*)(c.lds + 32 * WS_ * 2);
        const int lane = c.lane, r = lane & 31, hh = lane >> 5;
        bool staged = false;
        for (int it = c.bid; it < 128; it += c.G) {
            const int b = it / 64, ch_ = it % 64, t0 = ch_ * 128;
            __syncthreads();
            if (!staged) { staged = true;
#pragma unroll
                for (int i = 0; i < 8; ++i) { const int idx = tid + 512 * i, row = idx >> 7, c8 = idx & 127; *(LAS u32x4*)(wl + row * WS_ + c8 * 8) = *(const u32x4*)(Wdt + (size_t)row * 1024 + c8 * 8); }
                __syncthreads(); }
            {
                const int rb = c.wave & 3, kh = c.wave >> 2;
                const bf16_t* hrow = H + ((size_t)b * S + t0 + rb * 32 + r) * 1024 + kh * 512 + 8 * hh;
                f32x16c acc = {};
#pragma unroll
                for (int k8 = 0; k8 < 4; ++k8) { bf16x8c a[8];
#pragma unroll
                    for (int ks = 0; ks < 8; ++ks) a[ks] = *(const bf16x8c*)(hrow + (k8 * 8 + ks) * 16);
#pragma unroll
                    for (int ks = 0; ks < 8; ++ks) acc = __builtin_amdgcn_mfma_f32_32x32x16_bf16(a[ks], *(const LAS bf16x8c*)(wl + r * WS_ + kh * 512 + (k8 * 8 + ks) * 16 + 8 * hh), acc, 0, 0, 0); }
#pragma unroll
                for (int i = 0; i < 16; ++i) { const int l = rb * 32 + (i & 3) + 8 * (i >> 2) + 4 * hh; dtr[(kh * 128 + l) * 33 + r] = acc[i]; }
            }
            __syncthreads();
#pragma unroll
            for (int qi = 0; qi < 4; ++qi) {
                const int q = c.wave * 4 + qi, dir = q >> 4, h = q & 15;
                const float bias = dir ? p.in[6][h] : p.in[5][h], nA = -expf(dir ? p.in[8][h] : p.in[7][h]);
                const int l0 = dir ? 127 - lane : lane, l1 = dir ? 63 - lane : lane + 64;
                const size_t tok0 = (size_t)b * S + t0 + l0, tok1 = (size_t)b * S + t0 + l1;
                const float x0 = dtr[l0 * 33 + q] + dtr[(128 + l0) * 33 + q] + bias, x1 = dtr[l1 * 33 + q] + dtr[(128 + l1) * 33 + q] + bias;
                const float d0 = fmaxf(x0, 0.f) + log1pf(expf(-fabsf(x0))), d1 = fmaxf(x1, 0.f) + log1pf(expf(-fabsf(x1)));
                float a0 = d0 * nA, a1 = d1 * nA;
#pragma unroll
                for (int o = 1; o < 64; o <<= 1) { const float t0_ = __shfl_up(a0, o), t1_ = __shfl_up(a1, o); if (lane >= o) { a0 += t0_; a1 += t1_; } }
                const float tot0 = __shfl(a0, 63); a1 += tot0;
                DT[((size_t)dir * M + tok0) * 16 + h] = d0; DT[((size_t)dir * M + tok1) * 16 + h] = d1;
                ACS[((size_t)dir * M + tok0) * 16 + h] = a0; ACS[((size_t)dir * M + tok1) * 16 + h] = a1;
                if (lane == 63) CDEC[((dir * 2 + b) * 64 + ch_) * 16 + h] = expf(a1);
            }
        }
        __syncthreads();
    }
    {
        const int gw = c.bid * 8 + c.wave, NGW = c.G * 8, lane = c.lane;
        const float* rc = (const float*)(ws + WS_ROPE); const float* rs = rc + 4096;
        const int sub = lane >> 4, j = lane & 15, axis = j >> 3, i0 = 8 * (j & 3); const bool second = (j & 4) != 0;
        const f32x4 gq0 = *(const f32x4*)(p.in[11] + 8 * j), gq1 = *(const f32x4*)(p.in[11] + 8 * j + 4), gk0 = *(const f32x4*)(p.in[12] + 8 * j), gk1 = *(const f32x4*)(p.in[12] + 8 * j + 4);
        unsigned char* QN = ws + WS_QN; unsigned char* KN = ws + WS_KN;
        for (int base0 = gw; base0 < M * 10 / 4; base0 += 4 * NGW) {
            u32x4 vq[4]; int tokq[4], hhq[4];
#pragma unroll
            for (int u = 0; u < 4; ++u) { const int base = base0 + u * NGW, it = base * 4 + sub; tokq[u] = it / 10; hhq[u] = it % 10;
                vq[u] = (u32x4){0u, 0u, 0u, 0u};
                if (base < M * 10 / 4) vq[u] = *(const u32x4*)(P + (size_t)tokq[u] * NPROJ + (hhq[u] < 8 ? PQ + hhq[u] * 128 : PK + (hhq[u] - 8) * 128) + 8 * j); }
#pragma unroll
            for (int u = 0; u < 4; ++u) {
                const int base = base0 + u * NGW, tok = tokq[u], hh = hhq[u];
                unsigned char* dst = (hh < 8 ? QN + (size_t)tok * 1024 + hh * 128 : KN + (size_t)tok * 256 + (hh - 8) * 128) + 8 * j;
                const u32x4 v = vq[u];
                float y[8] = {bflo(v.x), bfhi(v.x), bflo(v.y), bfhi(v.y), bflo(v.z), bfhi(v.z), bflo(v.w), bfhi(v.w)};
                float ss = 0.f;
#pragma unroll
                for (int i = 0; i < 8; ++i) ss = fmaf(y[i], y[i], ss);
                ss += __shfl_xor(ss, 1); ss += __shfl_xor(ss, 2); ss += __shfl_xor(ss, 4); ss += __shfl_xor(ss, 8);
                const float rstd = rsqrtf(ss * (1.f / 128.f) + EPS);
                const f32x4 g0 = hh < 8 ? gq0 : gk0, g1 = hh < 8 ? gq1 : gk1;
#pragma unroll
                for (int i = 0; i < 4; ++i) { y[i] *= rstd * g0[i]; y[4 + i] *= rstd * g1[i]; }
                const int s = tok & (S - 1), pos = axis ? (s & 63) : (s >> 6);
                const f32x4 c0 = *(const f32x4*)(rc + pos * 32 + i0), c1 = *(const f32x4*)(rc + pos * 32 + i0 + 4), s0 = *(const f32x4*)(rs + pos * 32 + i0), s1 = *(const f32x4*)(rs + pos * 32 + i0 + 4);
                float o[8];
#pragma unroll
                for (int i = 0; i < 8; ++i) { const float other = __shfl_xor(y[i], 4); const float cs = i < 4 ? c0[i] : c1[i - 4], sn = i < 4 ? s0[i] : s1[i - 4];
                    o[i] = second ? fmaf(other, sn, y[i] * cs) : fmaf(-other, sn, y[i] * cs); }
                u32x2 w; w.x = pack4_fp8(o[0], o[1], o[2], o[3]); w.y = pack4_fp8(o[4], o[5], o[6], o[7]);
                if (base < M * 10 / 4) *(u32x2*)dst = w;
            }
        }
    }
    {
        unsigned char* VT8 = ws + WS_VB; LAS unsigned char* vt = c.lds;
        for (int it = c.bid; it < 256; it += c.G) {
            const int b = it >> 7, jt = it & 127;
            __syncthreads();
            u32x4 vv[4];
#pragma unroll
            for (int q = 0; q < 4; ++q) { const int idx = tid + 512 * q, key = idx >> 5, c8 = idx & 31; vv[q] = *(const u32x4*)(P + ((size_t)b * S + jt * 64 + key) * NPROJ + PV + c8 * 8); }
#pragma unroll
            for (int q = 0; q < 4; ++q) { const int idx = tid + 512 * q, key = idx >> 5, c8 = idx & 31, d0 = c8 * 8;
                const int off = 32 * ((key >> 2) & 1) + 16 * (key >> 5) + (key & 3) + 4 * ((key & 31) >> 3);
                const unsigned w0 = pack4_fp8(bflo(vv[q].x), bfhi(vv[q].x), bflo(vv[q].y), bfhi(vv[q].y)), w1 = pack4_fp8(bflo(vv[q].z), bfhi(vv[q].z), bflo(vv[q].w), bfhi(vv[q].w));
                LAS unsigned char* dp = vt + d0 * 64 + off;
                dp[0 * 64] = (unsigned char)(w0); dp[1 * 64] = (unsigned char)(w0 >> 8); dp[2 * 64] = (unsigned char)(w0 >> 16); dp[3 * 64] = (unsigned char)(w0 >> 24);
                dp[4 * 64] = (unsigned char)(w1); dp[5 * 64] = (unsigned char)(w1 >> 8); dp[6 * 64] = (unsigned char)(w1 >> 16); dp[7 * 64] = (unsigned char)(w1 >> 24); }
            __syncthreads();
#pragma unroll
            for (int q = 0; q < 2; ++q) { const int idx = tid + 512 * q, kvh = idx >> 9, rem = idx & 511;
                *(u32x4*)(VT8 + ((size_t)(b * 2 + kvh) * 128 + jt) * 8192 + rem * 16) = *(const LAS u32x4*)(vt + kvh * 8192 + rem * 16); }
        }
        __syncthreads();
    }
}

typedef short bf16x8 __attribute__((ext_vector_type(8)));
typedef float f32x16 __attribute__((ext_vector_type(16)));
constexpr int TS = 136;
__device__ __forceinline__ bf16x8 ldfrag(const LAS bf16_t* tile, int row, int k0) { return *(const LAS bf16x8*)(tile + row * TS + k0); }
template <int ROWS> __device__ __forceinline__ void load_tile128(LAS bf16_t* dst, const bf16_t* src, int ld, int tid) {
    constexpr int N = ROWS * 16 / 512;
    u32x4 v[N];
#pragma unroll
    for (int i = 0; i < N; ++i) { const int idx = tid + 512 * i; v[i] = *(const u32x4*)(src + (size_t)(idx >> 4) * ld + (idx & 15) * 8); }
#pragma unroll
    for (int i = 0; i < N; ++i) { const int idx = tid + 512 * i; *(LAS u32x4*)(dst + (idx >> 4) * TS + (idx & 15) * 8) = v[i]; }
}
__device__ __forceinline__ void phase_ssd_states(const Params& p, const Ctx& c) {
    unsigned char* ws = p.ws;
    const bf16_t* XT = (const bf16_t*)(ws + WS_XT); const bf16_t* BMT = (const bf16_t*)(ws + WS_BMT);
    const float* DT = (const float*)(ws + WS_DT); const float* ACS = (const float*)(ws + WS_ACS); bf16_t* ST = (bf16_t*)(ws + WS_PREV);
    LAS bf16_t* BTs = (LAS bf16_t*)c.lds; LAS bf16_t* XTf = BTs + 128 * TS; LAS bf16_t* XTb = XTf + 64 * TS; LAS float* wd = (LAS float*)(XTb + 64 * TS);
    const int tid = c.tid, lane = c.lane, r = lane & 31, hh = lane >> 5;
    for (int unit = c.bid; unit < 256; unit += c.G) {
        const int b = unit >> 7, ch = (unit >> 1) & 63, g = unit & 1;
        __syncthreads();
        load_tile128<128>(BTs, BMT + ((size_t)(b * 64 + ch) * 2 + g) * 128 * 128, 128, tid);
        u32x4 xv0, xv1; float pacs = 0.f, pdt = 0.f, paend = 0.f;
        const int wd_d = (tid >> 7) & 1, wd_l = tid & 127; const size_t wd_t0 = (size_t)wd_d * M + (size_t)b * S + ch * 128;
#define S1_PREFETCH(H) do { const bf16_t* xt_ = XT + ((size_t)(b * 64 + ch) * 16 + (H)) * 64 * 128; \
            xv0 = *(const u32x4*)(xt_ + (tid >> 4) * 128 + (tid & 15) * 8); xv1 = *(const u32x4*)(xt_ + ((tid + 512) >> 4) * 128 + (tid & 15) * 8); \
            if (tid < 256) { pacs = ACS[(wd_t0 + wd_l) * 16 + (H)]; pdt = DT[(wd_t0 + wd_l) * 16 + (H)]; paend = ACS[(wd_t0 + (wd_d ? 0 : 127)) * 16 + (H)]; } } while (0)
        S1_PREFETCH(g * 8);
#pragma unroll 1
        for (int h8 = 0; h8 < 8; ++h8) {
            const int h = g * 8 + h8;
            __syncthreads();
            if (tid < 256) wd[wd_d * 128 + wd_l] = pdt * __expf(paend - pacs);
            __syncthreads();
            {
                const u32x4 vv[2] = {xv0, xv1};
#pragma unroll
                for (int i = 0; i < 2; ++i) { const int idx = tid + 512 * i, pr = idx >> 4, l0 = (idx & 15) * 8; const u32x4 v = vv[i];
                    const float x[8] = {bflo(v.x), bfhi(v.x), bflo(v.y), bfhi(v.y), bflo(v.z), bfhi(v.z), bflo(v.w), bfhi(v.w)};
                    const f32x4 wf0 = *(const LAS f32x4*)(wd + l0), wf1 = *(const LAS f32x4*)(wd + l0 + 4), wb0 = *(const LAS f32x4*)(wd + 128 + l0), wb1 = *(const LAS f32x4*)(wd + 128 + l0 + 4);
                    u32x4 of, ob;
                    of.x = pk2(x[0] * wf0[0], x[1] * wf0[1]); of.y = pk2(x[2] * wf0[2], x[3] * wf0[3]); of.z = pk2(x[4] * wf1[0], x[5] * wf1[1]); of.w = pk2(x[6] * wf1[2], x[7] * wf1[3]);
                    ob.x = pk2(x[0] * wb0[0], x[1] * wb0[1]); ob.y = pk2(x[2] * wb0[2], x[3] * wb0[3]); ob.z = pk2(x[4] * wb1[0], x[5] * wb1[1]); ob.w = pk2(x[6] * wb1[2], x[7] * wb1[3]);
                    *(LAS u32x4*)(XTf + pr * TS + l0) = of; *(LAS u32x4*)(XTb + pr * TS + l0) = ob; }
            }
            if (h8 < 7) S1_PREFETCH(h + 1);
            __syncthreads();
            { const int d = c.wave >> 2, nb = c.wave & 3; const LAS bf16_t* XTd = d ? XTb : XTf;
              bf16_t* st = ST + ((((size_t)(d * 2 + b) * 64 + ch) * 16 + h) * 64) * 128;
#pragma unroll
              for (int pb = 0; pb < 2; ++pb) { f32x16 acc = {};
#pragma unroll
                for (int ks = 0; ks < 8; ++ks) acc = __builtin_amdgcn_mfma_f32_32x32x16_bf16(ldfrag(XTd, pb * 32 + r, ks * 16 + 8 * hh), ldfrag(BTs, nb * 32 + r, ks * 16 + 8 * hh), acc, 0, 0, 0);
#pragma unroll
                for (int i = 0; i < 16; ++i) { const int pp = pb * 32 + (i & 3) + 8 * (i >> 2) + 4 * hh; st[(size_t)pp * 128 + nb * 32 + r] = (bf16_t)f2bf(acc[i]); } } }
        }
#undef S1_PREFETCH
    }
}
__device__ __forceinline__ void phase_ssd_scan(const Params& p, const Ctx& c) {
    unsigned char* ws = p.ws;
    const float* CDEC = (const float*)(ws + WS_CDEC); bf16_t* PREV = (bf16_t*)(ws + WS_PREV);
    for (int idx = c.bid * 512 + c.tid; idx < 131072; idx += c.G * 512) {
        const int n4 = idx & 31, pp = (idx >> 5) & 63, h = (idx >> 11) & 15, b = (idx >> 15) & 1, d = idx >> 16;
        f32x4 run = {0.f, 0.f, 0.f, 0.f};
        const size_t obase = ((size_t)(d * 2 + b) * 64 * 16 + h) * 64 * 128 + (size_t)pp * 128 + n4 * 4;
        const float* cd = CDEC + (d * 2 + b) * 64 * 16 + h;
#pragma unroll 1
        for (int s0 = 0; s0 < 64; s0 += 16) {
            u32x2 sv[16]; float dec[16];
#pragma unroll
            for (int i = 0; i < 16; ++i) { const int ch = d ? 63 - (s0 + i) : s0 + i; sv[i] = *(const u32x2*)(PREV + obase + (size_t)ch * (16 * 64 * 128)); dec[i] = cd[ch * 16]; }
#pragma unroll
            for (int i = 0; i < 16; ++i) { const int ch = d ? 63 - (s0 + i) : s0 + i;
                u32x2 w; w.x = pk2(run.x, run.y); w.y = pk2(run.z, run.w); *(u32x2*)(PREV + obase + (size_t)ch * (16 * 64 * 128)) = w;
                run.x = fmaf(run.x, dec[i], bflo(sv[i].x)); run.y = fmaf(run.y, dec[i], bfhi(sv[i].x)); run.z = fmaf(run.z, dec[i], bflo(sv[i].y)); run.w = fmaf(run.w, dec[i], bfhi(sv[i].y)); }
        }
    }
}
__device__ __forceinline__ void phase_ssd_out(const Params& p, const Ctx& c) {
    unsigned char* ws = p.ws;
    const bf16_t* P = (const bf16_t*)(ws + WS_P); const bf16_t* XT = (const bf16_t*)(ws + WS_XT);
    const bf16_t* BMR = (const bf16_t*)(ws + WS_BMR); const bf16_t* CMR = (const bf16_t*)(ws + WS_CMR); const bf16_t* PREV = (const bf16_t*)(ws + WS_PREV);
    const float* DT = (const float*)(ws + WS_DT); const float* ACS = (const float*)(ws + WS_ACS); bf16_t* YZ = (bf16_t*)(ws + WS_YZ);
    LAS bf16_t* Cs = (LAS bf16_t*)c.lds; LAS bf16_t* Ms = Cs + 128 * TS; LAS bf16_t* XTs = Ms + 128 * TS; LAS bf16_t* PF = XTs + 64 * TS; LAS bf16_t* PB = PF + 64 * TS;
    LAS float* vec = (LAS float*)(PB + 64 * TS);
    constexpr int ZS = 72; LAS bf16_t* Zs = (LAS bf16_t*)(vec + 512); LAS float* dskl = (LAS float*)(Zs + 128 * ZS);
    const int tid = c.tid, lane = c.lane, r = lane & 31, hh = lane >> 5, wave = c.wave;
    for (int unit = c.bid; unit < 256; unit += c.G) {
        const int b = unit >> 7, ch = (unit >> 1) & 63, g = unit & 1;
        const size_t tok0 = (size_t)b * S + ch * 128;
        __syncthreads();
        load_tile128<128>(Cs, CMR + tok0 * 256 + g * 128, 256, tid);
        load_tile128<128>(Ms, BMR + tok0 * 256 + g * 128, 256, tid);
        u32x4 px0, px1, pf0, pf1, pb0, pb1, pz0, pz1; float pvec;
        const int t_r0 = tid >> 4, t_r1 = (tid + 512) >> 4, t_c = (tid & 15) * 8;
#define S3_PREFETCH(H) do { const bf16_t* xt_ = XT + ((size_t)(b * 64 + ch) * 16 + (H)) * 64 * 128; \
            const bf16_t* f_ = PREV + ((((size_t)(0 * 2 + b) * 64 + ch) * 16 + (H)) * 64) * 128; const bf16_t* b_ = PREV + ((((size_t)(1 * 2 + b) * 64 + ch) * 16 + (H)) * 64) * 128; \
            px0 = *(const u32x4*)(xt_ + t_r0 * 128 + t_c); px1 = *(const u32x4*)(xt_ + t_r1 * 128 + t_c); pf0 = *(const u32x4*)(f_ + t_r0 * 128 + t_c); pf1 = *(const u32x4*)(f_ + t_r1 * 128 + t_c); \
            pb0 = *(const u32x4*)(b_ + t_r0 * 128 + t_c); pb1 = *(const u32x4*)(b_ + t_r1 * 128 + t_c); \
            pz0 = *(const u32x4*)(P + (tok0 + (tid >> 3)) * NPROJ + PZ + (H) * 64 + (tid & 7) * 8); pz1 = *(const u32x4*)(P + (tok0 + 64 + (tid >> 3)) * NPROJ + PZ + (H) * 64 + (tid & 7) * 8); \
            { const int v_ = tid >> 7, l_ = tid & 127; const size_t o_ = ((size_t)(v_ & 1) * M + tok0 + l_) * 16 + (H); pvec = (v_ < 2) ? ACS[o_] : DT[o_]; } } while (0)
        S3_PREFETCH(g * 8);
        if (tid < 8) dskl[tid] = p.in[9][g * 8 + tid];
        __syncthreads();
        const int lb = wave & 3, sb0 = 2 * (wave >> 2);
        f32x16 G0 = {}, G1 = {};
#pragma unroll
        for (int ks = 0; ks < 8; ++ks) { const bf16x8 a = ldfrag(Cs, lb * 32 + r, ks * 16 + 8 * hh);
            G0 = __builtin_amdgcn_mfma_f32_32x32x16_bf16(a, ldfrag(Ms, sb0 * 32 + r, ks * 16 + 8 * hh), G0, 0, 0, 0);
            G1 = __builtin_amdgcn_mfma_f32_32x32x16_bf16(a, ldfrag(Ms, (sb0 + 1) * 32 + r, ks * 16 + 8 * hh), G1, 0, 0, 0); }
#pragma unroll 1
        for (int h8 = 0; h8 < 8; ++h8) {
            const int h = g * 8 + h8;
            __syncthreads();
            vec[tid] = pvec;
            *(LAS u32x4*)(XTs + t_r0 * TS + t_c) = px0; *(LAS u32x4*)(XTs + t_r1 * TS + t_c) = px1;
            *(LAS u32x4*)(PF + t_r0 * TS + t_c) = pf0; *(LAS u32x4*)(PF + t_r1 * TS + t_c) = pf1;
            *(LAS u32x4*)(PB + t_r0 * TS + t_c) = pb0; *(LAS u32x4*)(PB + t_r1 * TS + t_c) = pb1;
            *(LAS u32x4*)(Zs + (tid >> 3) * ZS + (tid & 7) * 8) = pz0; *(LAS u32x4*)(Zs + (64 + (tid >> 3)) * ZS + (tid & 7) * 8) = pz1;
            if (h8 < 7) S3_PREFETCH(h + 1);
            const int pbY = wave >> 2;
            __syncthreads();
#pragma unroll
            for (int t2 = 0; t2 < 2; ++t2) { const f32x16& Gt = t2 ? G1 : G0; const int sb = sb0 + t2, s = sb * 32 + r;
                const float afs = vec[s], abs_ = vec[128 + s], dfs = vec[256 + s], dbs = vec[384 + s];
                if (sb < lb) {
#pragma unroll
                    for (int i = 0; i < 16; ++i) { const int l = lb * 32 + (i & 3) + 8 * (i >> 2) + 4 * hh;
                        Ms[l * TS + s] = (bf16_t)f2bf(Gt[i] * __expf(vec[l] - afs) * dfs); }
                } else if (sb > lb) {
#pragma unroll
                    for (int i = 0; i < 16; ++i) { const int l = lb * 32 + (i & 3) + 8 * (i >> 2) + 4 * hh;
                        Ms[l * TS + s] = (bf16_t)f2bf(Gt[i] * __expf(vec[128 + l] - abs_) * dbs); }
                } else {
                    const float dsk = dskl[h8];
#pragma unroll
                    for (int i = 0; i < 16; ++i) { const int l = lb * 32 + (i & 3) + 8 * (i >> 2) + 4 * hh;
                        const float ef = __expf(fminf(vec[l] - afs, 0.f)) * dfs, eb = __expf(fminf(vec[128 + l] - abs_, 0.f)) * dbs;
                        const float tf = (s <= l) ? ef : 0.f, tb = (s >= l) ? eb : 0.f;
                        Ms[l * TS + s] = (bf16_t)f2bf(Gt[i] * (tf + tb) + (s == l ? dsk : 0.f)); }
                } }
            __syncthreads();
            { f32x16 Yd = {}, Yf = {}, Yb = {};
#pragma unroll
              for (int ks = 0; ks < 8; ++ks) { const int k0 = ks * 16 + 8 * hh;
                  Yd = __builtin_amdgcn_mfma_f32_32x32x16_bf16(ldfrag(Ms, lb * 32 + r, k0), ldfrag(XTs, pbY * 32 + r, k0), Yd, 0, 0, 0);
                  const bf16x8 a = ldfrag(Cs, lb * 32 + r, k0);
                  Yf = __builtin_amdgcn_mfma_f32_32x32x16_bf16(a, ldfrag(PF, pbY * 32 + r, k0), Yf, 0, 0, 0);
                  Yb = __builtin_amdgcn_mfma_f32_32x32x16_bf16(a, ldfrag(PB, pbY * 32 + r, k0), Yb, 0, 0, 0);
                  if (ks & 1) __builtin_amdgcn_sched_barrier(0); }
#pragma unroll
              for (int i = 0; i < 16; ++i) { const int l = lb * 32 + (i & 3) + 8 * (i >> 2) + 4 * hh;
                  const float y = Yd[i] + __expf(vec[l]) * Yf[i] + __expf(vec[128 + l]) * Yb[i];
                  const float z = bf2f(Zs[l * ZS + pbY * 32 + r]);
                  Zs[l * ZS + pbY * 32 + r] = (bf16_t)f2bf(y * z * sigmoidf_(z)); } }
            __syncthreads();
            *(u32x4*)(YZ + (tok0 + (tid >> 3)) * 1024 + h * 64 + (tid & 7) * 8) = *(const LAS u32x4*)(Zs + (tid >> 3) * ZS + (tid & 7) * 8);
            *(u32x4*)(YZ + (tok0 + 64 + (tid >> 3)) * 1024 + h * 64 + (tid & 7) * 8) = *(const LAS u32x4*)(Zs + (64 + (tid >> 3)) * ZS + (tid & 7) * 8);
        }
#undef S3_PREFETCH
    }
}

__device__ __forceinline__ void phase_rstd(const Params& p, const Ctx& c) {
    const bf16_t* YZ = (const bf16_t*)(p.ws + WS_YZ); float* RSTD = (float*)(p.ws + WS_RSTD);
    const int gw = c.bid * 8 + c.wave, NGW = c.G * 8;
    for (int m0 = gw * 4; m0 < M; m0 += NGW * 4) {
        u32x4 v[4][2];
#pragma unroll
        for (int q = 0; q < 4; ++q) { const u32x4* r = (const u32x4*)(YZ + (size_t)(m0 + q) * 1024) + c.lane; v[q][0] = r[0]; v[q][1] = r[64]; }
#pragma unroll
        for (int q = 0; q < 4; ++q) { float s = 0.f;
#pragma unroll
            for (int j = 0; j < 2; ++j) { const u32x4 w = v[q][j];
                s += bflo(w.x) * bflo(w.x) + bfhi(w.x) * bfhi(w.x) + bflo(w.y) * bflo(w.y) + bfhi(w.y) * bfhi(w.y) + bflo(w.z) * bflo(w.z) + bfhi(w.z) * bfhi(w.z) + bflo(w.w) * bflo(w.w) + bfhi(w.w) * bfhi(w.w); }
            s = wave_sum(s);
            if (c.lane == 0) RSTD[m0 + q] = rsqrtf(s * (1.f / 1024.f) + EPS); }
    }
}

namespace attn8 {
typedef int v8i __attribute__((ext_vector_type(8)));
typedef float f32x16 __attribute__((ext_vector_type(16)));
typedef unsigned u32x4_ __attribute__((ext_vector_type(4)));
constexpr int QBLK = 32, KVBLK = 64;
constexpr float SCALE = 0.088388347648318440f;
constexpr float THR = 0.69f;
constexpr size_t SHM_K = 64 * 128, SHM_V = 128 * 64, SHM_ATTN = 2 * SHM_K + 2 * SHM_V + 8 * 64 * 4;
__device__ __forceinline__ int crow(int r, int hi) { return (r & 3) + 8 * (r >> 2) + 4 * hi; }
__device__ __forceinline__ int kswz(int row, int colB) { return row * 128 + (colB ^ (((row >> 1) & 7) << 4)); }
__device__ __forceinline__ int vswz(int d, int slot) { return d * 64 + ((slot ^ ((d >> 2) & 3)) << 4); }
__device__ __forceinline__ v8i cat8(const u32x4_& lo, const u32x4_& hi) { v8i r; r[0] = (int)lo.x; r[1] = (int)lo.y; r[2] = (int)lo.z; r[3] = (int)lo.w; r[4] = (int)hi.x; r[5] = (int)hi.y; r[6] = (int)hi.z; r[7] = (int)hi.w; return r; }
template <bool LAST> __device__ __forceinline__ void mfma8(f32x16& acc, const v8i& a, const v8i& b, int scl) {
    acc = __builtin_amdgcn_mfma_scale_f32_32x32x64_f8f6f4(a, b, acc, 0, 0, 0, scl, 0, scl);
}
__device__ __forceinline__ void partialSM(f32x16& p0, f32x16& p1, float& m_reg, float& mn, float& alpha) {
    constexpr float C = SCALE * 1.4426950408889634f;
    float pmax = p0[0];
#pragma unroll
    for (int r = 1; r < 16; ++r) pmax = fmaxf(pmax, p0[r]);
#pragma unroll
    for (int r = 0; r < 16; ++r) pmax = fmaxf(pmax, p1[r]);
    { auto rr = __builtin_amdgcn_permlane32_swap(__float_as_uint(pmax), __float_as_uint(pmax), false, false); pmax = fmaxf(__uint_as_float(rr[0]), __uint_as_float(rr[1])); }
    if (__builtin_expect(__all(pmax - m_reg <= THR / SCALE), 1)) { mn = m_reg; alpha = 1.f; }
    else { mn = fmaxf(m_reg, pmax); alpha = __builtin_amdgcn_exp2f((m_reg - mn) * C); m_reg = mn; }
    const float mnC = 7.f - mn * C;
#pragma unroll
    for (int r = 0; r < 16; ++r) p0[r] = fmaf(p0[r], C, mnC);
#pragma unroll
    for (int r = 0; r < 16; ++r) p1[r] = fmaf(p1[r], C, mnC);
#pragma unroll
    for (int r = 0; r < 16; ++r) p0[r] = __builtin_amdgcn_exp2f(p0[r]);
}
__device__ __forceinline__ void finishSM(f32x16& p0, f32x16& p1, float alpha, float& l_reg, v8i& pa) {
#pragma unroll
    for (int r = 0; r < 16; ++r) p1[r] = __builtin_amdgcn_exp2f(p1[r]);
    float ps = 0;
#pragma unroll
    for (int r = 0; r < 16; ++r) ps += p0[r];
#pragma unroll
    for (int r = 0; r < 16; ++r) ps += p1[r];
    { auto rr = __builtin_amdgcn_permlane32_swap(__float_as_uint(ps), __float_as_uint(ps), false, false); ps = __uint_as_float(rr[0]) + __uint_as_float(rr[1]); }
    l_reg = l_reg * alpha + ps;
#pragma unroll
    for (int w = 0; w < 4; ++w) { pa[w] = (int)pack4_fp8(p0[4 * w], p0[4 * w + 1], p0[4 * w + 2], p0[4 * w + 3]); pa[4 + w] = (int)pack4_fp8(p1[4 * w], p1[4 * w + 1], p1[4 * w + 2], p1[4 * w + 3]); }
}
__device__ __forceinline__ void qkt(f32x16& p0, f32x16& p1, const char* Ks, const v8i* qf, int r32, int hi, int scl) {
    p0 = f32x16{}; p1 = f32x16{};
#pragma unroll
    for (int s = 0; s < 2; ++s) { const int cb = 64 * s + 32 * hi;
        const v8i a0 = cat8(*(const u32x4_*)(Ks + kswz(r32, cb)), *(const u32x4_*)(Ks + kswz(r32, cb + 16)));
        const v8i a1 = cat8(*(const u32x4_*)(Ks + kswz(32 + r32, cb)), *(const u32x4_*)(Ks + kswz(32 + r32, cb + 16)));
        if (s == 0) { mfma8<false>(p0, a0, qf[s], scl); mfma8<false>(p1, a1, qf[s], scl); }
        else { mfma8<false>(p0, a0, qf[s], scl); mfma8<true>(p1, a1, qf[s], scl); } }
}
__device__ __forceinline__ void pv(f32x16* o, const char* Vs, const v8i& pa, int r32, int hi, int scl) {
#pragma unroll
    for (int d0 = 0; d0 < 4; ++d0) { const int d = d0 * 32 + r32;
        const v8i b = cat8(*(const u32x4_*)(Vs + vswz(d, 2 * hi)), *(const u32x4_*)(Vs + vswz(d, 2 * hi + 1)));
        if (d0 == 3) mfma8<true>(o[d0], pa, b, scl); else mfma8<false>(o[d0], pa, b, scl); }
}
__device__ __forceinline__ void body(const unsigned char* __restrict__ Qb, const unsigned char* __restrict__ Kh, const unsigned char* __restrict__ Vt, unsigned short* __restrict__ Ob, int seq, char* lds) {
    const int tid = threadIdx.x, wid = tid >> 6, lane = tid & 63, r32 = lane & 31, hi = lane >> 5;
    const int scl = 0x7f7f7f7f;
    float* ws = (float*)(lds + 65536) + wid * 64; float* li_l = ws; float* al_l = ws + 32;
    float m_reg = -1e30f, l_reg = 0; f32x16 o[4] = {}; v8i qf[2];
    { const unsigned char* Qw = Qb + (long)(wid * QBLK + r32) * 1024 + 32 * hi;
#pragma unroll
      for (int s = 0; s < 2; ++s) qf[s] = cat8(*(const u32x4_*)(Qw + 64 * s), *(const u32x4_*)(Qw + 64 * s + 16)); }
    const int kr = tid >> 3, kc = (tid & 7) * 16, kdst = kswz(kr, kc);
    const int vd = tid >> 2, vsl = tid & 3, vdst = vswz(vd, vsl);
    struct { u32x4_ k, v; } sr_[2];
#define SLOAD(i, t) do { sr_[i].k = *(const u32x4_*)(Kh + (long)((t) * KVBLK + kr) * 256 + kc); sr_[i].v = *(const u32x4_*)(Vt + (long)(t) * 8192 + vd * 64 + vsl * 16); } while (0)
#define SWRITE(t, i) do { char* s_ = lds + ((t) & 3) * 16384; *(u32x4_*)(s_ + kdst) = sr_[i].k; *(u32x4_*)(s_ + 8192 + vdst) = sr_[i].v; } while (0)
#define KS(t) (lds + ((t) & 3) * 16384)
#define VS(t) (lds + ((t) & 3) * 16384 + 8192)
#define SWAIT() asm volatile("s_waitcnt vmcnt(2)" ::: "memory")
#define RESC(a) do { if (__any((a) < 1.f)) { if (hi == 0) al_l[r32] = (a); asm volatile("s_waitcnt lgkmcnt(0)" ::: "memory"); \
    _Pragma("unroll") for (int d = 0; d < 4; ++d) _Pragma("unroll") for (int r = 0; r < 16; ++r) o[d][r] *= al_l[crow(r, hi)]; } } while (0)
#define SBAR_() __builtin_amdgcn_sched_barrier(0)
    f32x16 pA0, pA1, pB0, pB1; float mnA, mnB, alA, alB; v8i pa; const int NT = seq / KVBLK;
    SLOAD(0, 0); asm volatile("s_waitcnt vmcnt(0)" ::: "memory"); SWRITE(0, 0); __syncthreads();
    qkt(pA0, pA1, KS(0), qf, r32, hi, scl); partialSM(pA0, pA1, m_reg, mnA, alA);
    SLOAD(1, 1); if (2 < NT) SLOAD(0, 2);
    SWAIT(); SWRITE(1, 1); __syncthreads();
    for (int j = 1; j + 1 < NT; j += 2) {
        SBAR_(); qkt(pB0, pB1, KS(j), qf, r32, hi, scl);
        finishSM(pA0, pA1, alA, l_reg, pa); SBAR_();
        SLOAD(1, j + 2); SBAR_();
        pv(o, VS(j - 1), pa, r32, hi, scl); partialSM(pB0, pB1, m_reg, mnB, alB);
        SWAIT(); SWRITE(j + 1, 0);
        RESC(alB); __syncthreads();
        SBAR_(); qkt(pA0, pA1, KS(j + 1), qf, r32, hi, scl);
        finishSM(pB0, pB1, alB, l_reg, pa); SBAR_();
        if (j + 3 < NT) SLOAD(0, j + 3); SBAR_();
        pv(o, VS(j), pa, r32, hi, scl); partialSM(pA0, pA1, m_reg, mnA, alA);
        SWAIT(); SWRITE(j + 2, 1);
        RESC(alA); __syncthreads();
    }
    SBAR_(); qkt(pB0, pB1, KS(NT - 1), qf, r32, hi, scl);
    finishSM(pA0, pA1, alA, l_reg, pa); SBAR_();
    pv(o, VS(NT - 2), pa, r32, hi, scl); partialSM(pB0, pB1, m_reg, mnB, alB);
    __syncthreads(); RESC(alB);
    finishSM(pB0, pB1, alB, l_reg, pa); SBAR_();
    pv(o, VS(NT - 1), pa, r32, hi, scl);
    if (hi == 0) li_l[r32] = l_reg; asm volatile("s_waitcnt lgkmcnt(0)" ::: "memory");
    float rli[16];
#pragma unroll
    for (int r = 0; r < 16; ++r) rli[r] = __builtin_amdgcn_rcpf(li_l[crow(r, hi)]);
    unsigned short* Ow = Ob + (long)(wid * QBLK) * 1024;
#pragma unroll
    for (int r = 0; r < 16; ++r) { const int orow = crow(r, hi);
#pragma unroll
        for (int d0 = 0; d0 < 4; ++d0) Ow[(long)orow * 1024 + d0 * 32 + r32] = (unsigned short)f2bf(o[d0][r] * rli[r]); }
#undef KS
#undef VS
#undef SLOAD
#undef SWRITE
#undef SWAIT
#undef RESC
#undef SBAR_
}
}
__device__ __forceinline__ void phase_attn(const Params& p, const Ctx& c, char* lds_generic) {
    unsigned char* ws = p.ws;
    const unsigned char* Q8 = ws + WS_QN; const unsigned char* K8 = ws + WS_KN; const unsigned char* VT8 = ws + WS_VB; bf16_t* AO = (bf16_t*)(ws + WS_AO);
    for (int item = c.bid; item < 512; item += c.G) {
        const int b = item >> 8, h = (item >> 5) & 7, qb = item & 31, kvh = h >> 2;
        const size_t qrow = (size_t)b * S + qb * 256;
        attn8::body(Q8 + qrow * 1024 + h * 128, K8 + (size_t)b * S * 256 + kvh * 128, VT8 + (size_t)(b * 2 + kvh) * 128 * 8192, AO + qrow * 1024 + h * 128, S, lds_generic);
        __syncthreads();
    }
}

__device__ __forceinline__ void phase_router(const Params& p, const Ctx& c) {
    unsigned char* ws = p.ws;
    LAS float* wT = (LAS float*)c.lds;
    LAS int* tokE = (LAS int*)(c.lds + LDS_CTL + 512);
    LAS float* tokW = (LAS float*)(c.lds + LDS_CTL + 512 + 1024);
    LAS int* lcnt = (LAS int*)(c.lds + LDS_CTL + 512 + 2048);
    LAS int* lbase = lcnt + 32;
    LAS int* lrank = lbase + 32;
    const bf16_t* X1 = (const bf16_t*)(ws + WS_X1); unsigned char* H2 = ws + WS_H2;
    int* CNT = (int*)(ws + WS_CTL); int* TOKES = (int*)(ws + WS_TOKES); float* TOKW = (float*)(ws + WS_TOKW); int* LIST = (int*)(ws + WS_LIST);
    const int tid = c.tid, lane = c.lane;
    __syncthreads();
    { const f32x4* src = (const f32x4*)(ws + WS_WRT);
      f32x4 wv[16];
#pragma unroll
      for (int i = 0; i < 16; ++i) wv[i] = src[tid + 512 * i];
#pragma unroll
      for (int i = 0; i < 16; ++i) ((LAS f32x4*)wT)[tid + 512 * i] = wv[i]; }
    __syncthreads();
    f32x4 gv[4];
#pragma unroll
    for (int j = 0; j < 4; ++j) gv[j] = *(const f32x4*)(p.in[16] + (j >> 1) * 512 + 8 * lane + (j & 1) * 4);
    const float bias_e = p.in[18][(lane >> 1) & 31];
    for (int blk = c.bid; blk < M / 64; blk += c.G) {
        if (tid < 32) lcnt[tid] = 0;
        for (int pr = 0; pr < 4; ++pr) {
            const int tl = c.wave * 8 + pr * 2;
            const size_t tokA = (size_t)blk * 64 + tl;
            f32x4 hA[4], hB[4];
            {
                const u32x4* xa = (const u32x4*)(X1 + tokA * 1024) + lane; const u32x4* xb = xa + 128;
                float sa = 0.f, sb = 0.f;
                { const u32x4 a0 = xa[0], a1 = xa[64], b0 = xb[0], b1 = xb[64];
                  hA[0] = (f32x4){bflo(a0.x), bfhi(a0.x), bflo(a0.y), bfhi(a0.y)}; hA[1] = (f32x4){bflo(a0.z), bfhi(a0.z), bflo(a0.w), bfhi(a0.w)};
                  hA[2] = (f32x4){bflo(a1.x), bfhi(a1.x), bflo(a1.y), bfhi(a1.y)}; hA[3] = (f32x4){bflo(a1.z), bfhi(a1.z), bflo(a1.w), bfhi(a1.w)};
                  hB[0] = (f32x4){bflo(b0.x), bfhi(b0.x), bflo(b0.y), bfhi(b0.y)}; hB[1] = (f32x4){bflo(b0.z), bfhi(b0.z), bflo(b0.w), bfhi(b0.w)};
                  hB[2] = (f32x4){bflo(b1.x), bfhi(b1.x), bflo(b1.y), bfhi(b1.y)}; hB[3] = (f32x4){bflo(b1.z), bfhi(b1.z), bflo(b1.w), bfhi(b1.w)}; }
#pragma unroll
                for (int j = 0; j < 4; ++j) {
                    sa += (hA[j].x * hA[j].x + hA[j].y * hA[j].y) + (hA[j].z * hA[j].z + hA[j].w * hA[j].w);
                    sb += (hB[j].x * hB[j].x + hB[j].y * hB[j].y) + (hB[j].z * hB[j].z + hB[j].w * hB[j].w); }
                const float ra = rsqrtf(wave_sum(sa) * (1.f / 1024.f) + EPS), rb = rsqrtf(wave_sum(sb) * (1.f / 1024.f) + EPS);
#pragma unroll
                for (int j = 0; j < 4; ++j) { hA[j] = hA[j] * ra * gv[j]; hB[j] = hB[j] * rb * gv[j]; }
                u32x2* oa = (u32x2*)(H2 + tokA * 1024) + lane; u32x2* ob = oa + 128;
#pragma unroll
                for (int j2 = 0; j2 < 2; ++j2) { u32x2 w;
                    w.x = pack4_fp8(8.f * hA[2 * j2].x, 8.f * hA[2 * j2].y, 8.f * hA[2 * j2].z, 8.f * hA[2 * j2].w); w.y = pack4_fp8(8.f * hA[2 * j2 + 1].x, 8.f * hA[2 * j2 + 1].y, 8.f * hA[2 * j2 + 1].z, 8.f * hA[2 * j2 + 1].w); oa[64 * j2] = w;
                    w.x = pack4_fp8(8.f * hB[2 * j2].x, 8.f * hB[2 * j2].y, 8.f * hB[2 * j2].z, 8.f * hB[2 * j2].w); w.y = pack4_fp8(8.f * hB[2 * j2 + 1].x, 8.f * hB[2 * j2 + 1].y, 8.f * hB[2 * j2 + 1].z, 8.f * hB[2 * j2 + 1].w); ob[64 * j2] = w; }
            }
            float accA[32], accB[32];
#pragma unroll
            for (int e = 0; e < 32; ++e) {
                float a = 0.f, b = 0.f;
#pragma unroll
                for (int j = 0; j < 4; ++j) { const f32x4 w = *(const LAS f32x4*)&wT[e * 1024 + (j >> 1) * 512 + 8 * lane + (j & 1) * 4];
                    a = fmaf(hA[j].x, w.x, a); a = fmaf(hA[j].y, w.y, a); a = fmaf(hA[j].z, w.z, a); a = fmaf(hA[j].w, w.w, a);
                    b = fmaf(hB[j].x, w.x, b); b = fmaf(hB[j].y, w.y, b); b = fmaf(hB[j].z, w.z, b); b = fmaf(hB[j].w, w.w, b); }
                accA[e] = a; accB[e] = b;
                if (e & 1) __builtin_amdgcn_sched_barrier(0);
            }
#define RSTEP(N, BIT) _Pragma("unroll") for (int i = 0; i < N; ++i) { const bool up = (lane & BIT) != 0; \
                const float ka = up ? accA[N + i] : accA[i], sa_ = up ? accA[i] : accA[N + i]; accA[i] = ka + __shfl_xor(sa_, BIT); \
                const float kb = up ? accB[N + i] : accB[i], sb_ = up ? accB[i] : accB[N + i]; accB[i] = kb + __shfl_xor(sb_, BIT); }
            RSTEP(16, 32) RSTEP(8, 16) RSTEP(4, 8) RSTEP(2, 4) RSTEP(1, 2)
#undef RSTEP
            const float la = accA[0] + __shfl_xor(accA[0], 1) + bias_e, lb = accB[0] + __shfl_xor(accB[0], 1) + bias_e;
            const int my_e = (lane >> 1) & 31;
#pragma unroll
            for (int t2 = 0; t2 < 2; ++t2) {
                float val = t2 ? lb : la;
                int se[4]; float sv[4];
#pragma unroll
                for (int k = 0; k < 4; ++k) {
                    const float mx = wave_max(val);
                    const int sel = wave_min_i(val == mx ? my_e : 64);
                    se[k] = sel & 31; sv[k] = mx;
                    if (my_e == sel) val = -INFINITY;
                }
                const float e1 = __expf(sv[1] - sv[0]), e2 = __expf(sv[2] - sv[0]), e3 = __expf(sv[3] - sv[0]);
                const float inv = 1.f / (1.f + e1 + e2 + e3);
                if (lane == 0) {
                    const int t = tl + t2;
                    tokE[t * 4 + 0] = se[0]; tokE[t * 4 + 1] = se[1]; tokE[t * 4 + 2] = se[2]; tokE[t * 4 + 3] = se[3];
                    tokW[t * 4 + 0] = inv; tokW[t * 4 + 1] = e1 * inv; tokW[t * 4 + 2] = e2 * inv; tokW[t * 4 + 3] = e3 * inv;
                }
            }
        }
        __syncthreads();
        if (tid < 256) lrank[tid] = atomicAdd((int*)&lcnt[tokE[tid]], 1);
        __syncthreads();
        if (tid < 32) lbase[tid] = lcnt[tid] ? atomicAdd(&CNT[tid], lcnt[tid]) : 0;
        __syncthreads();
        if (tid < 256) {
            const int e = tokE[tid], slot = lbase[e] + lrank[tid], tok = blk * 64 + (tid >> 2);
            LIST[e * 16384 + slot] = tok; TOKES[tok * 4 + (tid & 3)] = (e << 16) | slot; TOKW[tok * 4 + (tid & 3)] = tokW[tid];
        }
        __syncthreads();
    }
}

__device__ __forceinline__ void load_offs(const Params& p, const Ctx& c, LAS int*& offs, LAS int*& cnt) {
    offs = (LAS int*)(c.lds + LDS_CTL); cnt = offs + 40;
    __syncthreads();
    if (c.tid == 0) {
        const int* CNT = (const int*)(p.ws + WS_CTL); int run = 0;
        for (int e = 0; e < 32; ++e) { const int n = __hip_atomic_load(CNT + e, __ATOMIC_RELAXED, __HIP_MEMORY_SCOPE_AGENT); cnt[e] = n; offs[e] = run; run += (n + 255) & ~255; }
        offs[32] = run;
    }
    __syncthreads();
    if (c.tid < 320) { int e = 0; while (e < 31 && c.tid * 256 >= offs[e + 1]) ++e; offs[80 + c.tid] = e; }
    __syncthreads();
}
__device__ __forceinline__ void phase_gemm1(const Params& p, const Ctx& c) {
    pg8::Gemm g{(const bf16_t*)(p.ws + WS_H), (const bf16_t*)(p.ws + WS_WINT), M, PDT, 1024};
    pg8::StaticOrder S; S.init(M, PDT, c.G, c.bid);
    pg8::EpiStore E{(bf16_t*)(p.ws + WS_P), NPROJ};
    pg8::gemm_phase<pg8::EpiStore, pg8::StaticOrder, true, true>(c.lds, g, S, E);
}
__device__ __forceinline__ void phase_tail12(const Params& p, const Ctx& c) {
    unsigned char* ws = p.ws;
    pg8::TailOrder S; S.so.init(M, 1024, c.G, c.bid);
    pg8::Gemm g{(const bf16_t*)(ws + WS_YZ), (const bf16_t*)(ws + WS_WST), 2 * M, 2048, 1024};
    pg8::EpiT12 E{(bf16_t*)(ws + WS_T1), (bf16_t*)(ws + WS_MG), (const bf16_t*)(ws + WS_P) + PG, NPROJ, (const float*)(ws + WS_RSTD)};
    pg8::gemm_phase<pg8::EpiT12, pg8::TailOrder, true, true>(c.lds, g, S, E);
}
__device__ __forceinline__ void phase_tail3(const Params& p, const Ctx& c) {
    unsigned char* ws = p.ws;
    pg8::StaticOrder S; S.init(M, 1024, c.G, c.bid);
    pg8::Gemm g{(const bf16_t*)(ws + WS_MG), (const bf16_t*)(ws + WS_WOT), M, 1024, 1024};
    pg8::EpiT3b E{(bf16_t*)(ws + WS_X1), p.in[0]};
    pg8::gemm_phase<pg8::EpiT3b, pg8::StaticOrder, true, true>(c.lds, g, S, E);
}
__device__ __forceinline__ void phase_moe1(const Params& p, const Ctx& c) {
    LAS int* offs; LAS int* cnt; load_offs(p, c, offs, cnt);
    unsigned char* ws = p.ws;
    pg8::Gemm g{(const bf16_t*)(ws + WS_H2), (const bf16_t*)(ws + WS_W1T), M, 32 * 2048, 512};
    pg8::MoeGatherOrder S{offs, cnt, offs + 80, (const int*)(ws + WS_LIST), c.G, c.bid, offs[32] / 256};
    pg8::EpiAct8 E{(unsigned char*)(ws + WS_ACT), p.in[20]};
    pg8::gemm_phase_gather_f8<pg8::EpiAct8, pg8::MoeGatherOrder>(c.lds, g, S, E);
}
__device__ __forceinline__ void phase_moe2(const Params& p, const Ctx& c) {
    LAS int* offs; LAS int* cnt; load_offs(p, c, offs, cnt);
    unsigned char* ws = p.ws;
    pg8::Gemm g{(const bf16_t*)(ws + WS_ACT), (const bf16_t*)(ws + WS_W2T), ROWS_MAX, 32 * 1024, 512};
    pg8::MoeOrder<4> S{offs + 80, c.G, c.bid, offs[32] / 256};
    pg8::EpiY8 E{(bf16_t*)(ws + WS_YB), p.in[22]};
    pg8::gemm_phase_f8<pg8::EpiY8, pg8::MoeOrder<4>, true, true>(c.lds, g, S, E);
}

__device__ __forceinline__ void phase_combine(const Params& p, const Ctx& c) {
    LAS int* offs; LAS int* cnt; load_offs(p, c, offs, cnt);
    unsigned char* ws = p.ws;
    const bf16_t* X1 = (const bf16_t*)(ws + WS_X1); const bf16_t* YB = (const bf16_t*)(ws + WS_YB);
    const int* TOKES = (const int*)(ws + WS_TOKES); const float* TOKW = (const float*)(ws + WS_TOKW);
    const int gw = c.bid * 8 + c.wave, NGW = c.G * 8, lane = c.lane;
    f32x4 gv[4];
#pragma unroll
    for (int j = 0; j < 4; ++j) gv[j] = ((const f32x4*)p.in[23])[lane + 64 * j];
    for (int m0 = gw * 2; m0 < M; m0 += NGW * 2) {
        int es[2][4]; float wq[2][4];
#pragma unroll
        for (int t = 0; t < 2; ++t)
#pragma unroll
            for (int k = 0; k < 4; ++k) { es[t][k] = TOKES[(m0 + t) * 4 + k]; wq[t][k] = TOKW[(m0 + t) * 4 + k]; }
        f32x4 v[2][4]; u32x2 y[2][4][4];
#pragma unroll
        for (int t = 0; t < 2; ++t) { const u32x2* xr = (const u32x2*)(X1 + (size_t)(m0 + t) * 1024) + lane;
#pragma unroll
            for (int j = 0; j < 4; ++j) { const u32x2 xx = xr[64 * j]; v[t][j] = (f32x4){bflo(xx.x), bfhi(xx.x), bflo(xx.y), bfhi(xx.y)}; }
#pragma unroll
            for (int k = 0; k < 4; ++k) { const int row = offs[es[t][k] >> 16] + (es[t][k] & 0xffff); const u32x2* yr = (const u32x2*)(YB + (size_t)row * 1024) + lane;
#pragma unroll
                for (int j = 0; j < 4; ++j) y[t][k][j] = yr[64 * j]; } }
#pragma unroll
        for (int t = 0; t < 2; ++t) {
#pragma unroll
            for (int k = 0; k < 4; ++k) { const float w = wq[t][k];
#pragma unroll
                for (int j = 0; j < 4; ++j) { const u32x2 yy = y[t][k][j];
                    v[t][j].x = fmaf(w, bflo(yy.x), v[t][j].x); v[t][j].y = fmaf(w, bfhi(yy.x), v[t][j].y); v[t][j].z = fmaf(w, bflo(yy.y), v[t][j].z); v[t][j].w = fmaf(w, bfhi(yy.y), v[t][j].w); } }
            float s = 0.f;
#pragma unroll
            for (int j = 0; j < 4; ++j) s += (v[t][j].x * v[t][j].x + v[t][j].y * v[t][j].y) + (v[t][j].z * v[t][j].z + v[t][j].w * v[t][j].w);
            const float rstd = rsqrtf(wave_sum(s) * (1.f / 1024.f) + EPS);
            f32x4* o = (f32x4*)(p.out + (size_t)(m0 + t) * 1024) + lane;
#pragma unroll
            for (int j = 0; j < 4; ++j) o[64 * j] = v[t][j] * rstd * gv[j];
        }
    }
}

#define XB_TMO      128
#define XB_XCNT(j)  (256  + 64 * (j))
#define XB_XSUB(j)  (1280 + 64 * (j))
#define XB_XGEN(j)  (2304 + 64 * (j))
#define XB_TOP      3328
#define XB_TOPGEN   3392
#define XCD_BAR_WORDS 3456
#define XB_SPIN_CAP (1u << 18)

__device__ __forceinline__ unsigned xb_ld(unsigned* p)              { return __hip_atomic_load(p, __ATOMIC_RELAXED, __HIP_MEMORY_SCOPE_AGENT); }
__device__ __forceinline__ unsigned xb_add(unsigned* p, unsigned v) { return __hip_atomic_fetch_add(p, v, __ATOMIC_RELAXED, __HIP_MEMORY_SCOPE_AGENT); }
__device__ __forceinline__ unsigned xb_xcc_id() { return (unsigned)__builtin_amdgcn_s_getreg((3 << 11) | 20) & 0xFu; }
#define XB_SPIN(cond, bar) do { unsigned _sp = 0; while (cond) { __builtin_amdgcn_s_sleep(1); \
    if ((++_sp & 255u) == 0u) { if (xb_ld(&(bar)[XB_TMO])) break; if (_sp > XB_SPIN_CAP) { atomicAdd(&(bar)[XB_TMO], 1u); break; } } } } while (0)

struct XcdBarrier {
    unsigned* bar; unsigned x;
    volatile LAS unsigned* st;
};

__device__ __forceinline__ XcdBarrier xcd_barrier_post(unsigned* bar, volatile LAS unsigned* st) {
    XcdBarrier b; b.bar = bar; b.x = xb_xcc_id(); b.st = st;
    if (threadIdx.x == 0) (void)xb_add(&bar[XB_XCNT(b.x)], 1u);
    return b;
}
__device__ __forceinline__ void xcd_barrier_complete(unsigned* bar, unsigned x, unsigned& nloc, unsigned& nx) {
    const unsigned G = gridDim.x * gridDim.y * gridDim.z;
    unsigned sum, cnt, mine, sp = 0u;
    for (;;) {
        sum = 0u; cnt = 0u; mine = 0u;
#pragma unroll
        for (unsigned j = 0; j < 16; ++j) { const unsigned c = xb_ld(&bar[XB_XCNT(j)]); sum += c; cnt += (c > 0u) ? 1u : 0u; mine = (j == x) ? c : mine; }
        if (sum == G) break;
        __builtin_amdgcn_s_sleep(1);
        if ((++sp & 255u) == 0u) { if (xb_ld(&bar[XB_TMO])) break; if (sp > XB_SPIN_CAP) { atomicAdd(&bar[XB_TMO], 1u); break; } }
    }
    nloc = mine > 0u ? mine : 1u; nx = cnt > 0u ? cnt : 1u;
}

__device__ __forceinline__ void xcd_barrier(const XcdBarrier& b) {
    asm volatile("s_waitcnt vmcnt(0)" ::: "memory");
    __syncthreads();
    if (threadIdx.x == 0) {
        unsigned* bar = b.bar;
        __builtin_amdgcn_s_waitcnt(0);
        unsigned nloc = b.st[0], nx = b.st[1];
        if (nloc == 0u) { xcd_barrier_complete(bar, b.x, nloc, nx); b.st[0] = nloc; b.st[1] = nx; }
        const unsigned old = xb_add(&bar[XB_XSUB(b.x)], 1u);
        const unsigned gen = old / nloc;
        if (old + 1u == (gen + 1u) * nloc) {
            __builtin_amdgcn_fence(__ATOMIC_RELEASE, "agent");
            asm volatile("s_waitcnt vmcnt(0)" ::: "memory");
            const unsigned og = xb_add(&bar[XB_TOP], 1u);
            const unsigned tg = og / nx;
            if (og + 1u == (tg + 1u) * nx) xb_add(&bar[XB_TOPGEN], 1u);
            else XB_SPIN(xb_ld(&bar[XB_TOPGEN]) == tg, bar);
            __builtin_amdgcn_fence(__ATOMIC_ACQUIRE, "agent");
            xb_add(&bar[XB_XGEN(b.x)], 1u);
            asm volatile("s_waitcnt vmcnt(0)" ::: "memory");
        } else {
            XB_SPIN(xb_ld(&bar[XB_XGEN(b.x)]) == gen, bar);
            __builtin_amdgcn_fence(__ATOMIC_ACQUIRE, "agent");
            asm volatile("s_waitcnt vmcnt(0)" ::: "memory");
        }
    }
    __syncthreads();
}

constexpr int NPHASE = 13;
__global__ void __launch_bounds__(512) mega(Params p) {
    extern __shared__ __attribute__((aligned(16))) unsigned char lds_raw[];
    Ctx c; c.tid = threadIdx.x; c.lane = c.tid & 63; c.wave = __builtin_amdgcn_readfirstlane(c.tid >> 6); c.bid = blockIdx.x; c.G = gridDim.x;
    c.lds = (LAS unsigned char*)lds_raw;
    cg::grid_group grid = cg::this_grid();
    if (c.tid < 2) ((volatile LAS unsigned*)(c.lds + LDS_BARST))[c.tid] = 0u;
    __syncthreads();
#define SEAM(k) do { XcdBarrier b_; b_.bar = (unsigned*)(p.ws + WS_BAR); b_.x = xb_xcc_id(); b_.st = (volatile LAS unsigned*)(c.lds + LDS_BARST); xcd_barrier(b_); } while (0)
    if (p.ph_lo < 0) grid.sync();
    (void)xcd_barrier_post((unsigned*)(p.ws + WS_BAR), (volatile LAS unsigned*)(c.lds + LDS_BARST));
#define RUN(k, call) if (p.ph_lo <= (k) && (k) < p.ph_hi) { call; if ((k) + 1 < p.ph_hi) SEAM(k); }
    RUN(0, phase_prep(p, c))
    RUN(1, phase_gemm1(p, c))
    RUN(2, phase_conv(p, c))
    RUN(3, phase_ssd_states(p, c))
    RUN(4, phase_ssd_scan(p, c))
    RUN(5, phase_ssd_out(p, c))
    RUN(6, phase_rstd(p, c); phase_attn(p, c, (char*)lds_raw))
    RUN(7, phase_tail12(p, c))
    RUN(8, phase_tail3(p, c))
    RUN(9, phase_router(p, c))
    RUN(10, phase_moe1(p, c))
    RUN(11, phase_moe2(p, c))
    RUN(12, phase_combine(p, c))
#undef RUN
}

extern "C" void kernel_launch(void* const* d_in, const int* in_sizes, int n_in, void* d_out, int out_size, void* d_ws, size_t ws_size, hipStream_t stream) {
    static int ok = 0; static int grid_blocks = 0;
    if (ok == 0) {
        if (n_in != 24 || out_size != M * D || ws_size < WS_END) { fprintf(stderr, "kernel_launch: unexpected shapes: n_in %d out %d ws %zu (need %zu)\n", n_in, out_size, ws_size, (size_t)WS_END); ok = -1; return; }
        if (hipFuncSetAttribute((const void*)mega, hipFuncAttributeMaxDynamicSharedMemorySize, LDS_BYTES) != hipSuccess) { fprintf(stderr, "kernel_launch: hipFuncSetAttribute failed\n"); ok = -1; return; }
        int dev = 0, cus = 0, per_cu = 0;
        hipGetDevice(&dev);
        hipDeviceGetAttribute(&cus, hipDeviceAttributeMultiprocessorCount, dev);
        hipOccupancyMaxActiveBlocksPerMultiprocessor(&per_cu, (const void*)mega, 512, LDS_BYTES);
        if (per_cu < 1 || cus < 1) { fprintf(stderr, "kernel_launch: occupancy query gave %d blocks/CU on %d CUs\n", per_cu, cus); ok = -1; return; }
        grid_blocks = cus;
        ok = 1;
    }
    if (ok < 0) return;
    Params p{};
    for (int i = 0; i < 24; ++i) p.in[i] = (const float*)d_in[i];
    p.out = (float*)d_out; p.ws = (unsigned char*)d_ws;
    p.ph_lo = 0; p.ph_hi = NPHASE;
    if (hipMemsetAsync((char*)d_ws + WS_BAR, 0, 16384, stream) != hipSuccess) { fprintf(stderr, "kernel_launch: hipMemsetAsync of the barrier words failed\n"); return; }
    void* args[] = {&p};
    hipError_t e = hipLaunchCooperativeKernel((const void*)mega, dim3(grid_blocks), dim3(512), args, LDS_BYTES, stream);
    if (e != hipSuccess) fprintf(stderr, "kernel_launch: cooperative launch failed: %s (grid %d)\n", hipGetErrorString(e), grid_blocks);
}
```

```cpp
#include <hip/hip_runtime.h>
#include <hip/hip_cooperative_groups.h>
#include <cstdio>
#include <cstdint>

namespace cg = cooperative_groups;
#define LAS __attribute__((address_space(3)))
typedef unsigned short bf16_t;
typedef unsigned u32x4 __attribute__((ext_vector_type(4)));
typedef unsigned u32x2 __attribute__((ext_vector_type(2)));
typedef float f32x4 __attribute__((ext_vector_type(4)));

constexpr int NB = 2, S = 8192, D = 1024, M = NB * S;
constexpr int NPROJ = 6400;
constexpr int PZ = 0, PXBC = 1024, PQ = 2560, PK = 3584, PV = 3840, PG = 4096, PDT = 6144;
constexpr int ROWS_MAX = 65536 + 32 * 256;
constexpr float EPS = 1e-6f;

constexpr size_t al256(size_t x) { return (x + 255) / 256 * 256; }
constexpr size_t WS_CTL = 0;
constexpr size_t WS_BAR = 4096;
constexpr size_t WS_ROPE = 4096 + 16384;
constexpr size_t WS_WRT = WS_ROPE + 32768;
constexpr size_t WS_WINT = WS_WRT + 131072;
constexpr size_t WS_WST = WS_WINT + (size_t)NPROJ * 1024 * 2;
constexpr size_t WS_WAT = WS_WST + 2097152;
constexpr size_t WS_WOT = WS_WAT + 2097152;
constexpr size_t WS_W1T = WS_WOT + 2097152;
constexpr size_t WS_W2T = WS_W1T + (size_t)32 * 2048 * 1024 * 2;
constexpr size_t WS_X1 = WS_W2T + (size_t)32 * 1024 * 1024 * 2;
constexpr size_t WS_H2 = WS_X1 + (size_t)M * 1024 * 4;
constexpr size_t WS_TOKES = WS_H2 + (size_t)M * 1024 * 2;
constexpr size_t WS_TOKW = WS_TOKES + (size_t)M * 16;
constexpr size_t WS_LIST = WS_TOKW + (size_t)M * 16;
constexpr size_t WS_R = WS_LIST + (size_t)32 * 16384 * 4;
constexpr size_t WS_H = WS_R;
constexpr size_t WS_P = WS_H + (size_t)M * 1024 * 2;
constexpr size_t WS_XT = WS_P + (size_t)M * NPROJ * 2;
constexpr size_t WS_BMR = WS_XT + (size_t)M * 1024 * 2;
constexpr size_t WS_BMT = WS_BMR + (size_t)M * 256 * 2;
constexpr size_t WS_CMR = WS_BMT + (size_t)M * 256 * 2;
constexpr size_t WS_DT = WS_CMR + (size_t)M * 256 * 2;
constexpr size_t WS_ACS = WS_DT + (size_t)2 * M * 16 * 4;
constexpr size_t WS_CDEC = WS_ACS + (size_t)2 * M * 16 * 4;
constexpr size_t WS_ST = WS_CDEC + 16384;
constexpr size_t WS_PREV = WS_ST + (size_t)2 * 2 * 64 * 16 * 8192 * 4;
constexpr size_t WS_YZ = WS_PREV + (size_t)2 * 2 * 64 * 16 * 8192 * 2;
constexpr size_t WS_AO = WS_YZ + (size_t)M * 1024 * 2;
constexpr size_t WS_RSTD = WS_AO + (size_t)M * 1024 * 2;
constexpr size_t WS_QN = WS_RSTD + (size_t)M * 4;
constexpr size_t WS_KN = WS_QN + (size_t)M * 1024 * 2;
constexpr size_t WS_VB = WS_KN + (size_t)M * 256 * 2;
constexpr size_t WS_T1 = WS_VB + (size_t)M * 256 * 2;
constexpr size_t WS_MG = WS_T1 + (size_t)M * 1024 * 2;
constexpr size_t WS_END = WS_MG + (size_t)M * 1024 * 2;
constexpr size_t WS_XB = WS_R;
constexpr size_t WS_ACT = WS_XB + (size_t)ROWS_MAX * 1024 * 2;
constexpr size_t WS_YB = WS_XB;
static_assert(WS_ACT + (size_t)ROWS_MAX * 1024 * 2 <= WS_END, "moe overlay");
static_assert(WS_END <= (size_t)1073741824, "workspace");
static_assert(WS_WAT == WS_WST + 2097152 && WS_AO == WS_YZ + (size_t)M * 2048, "concatenated operands of the merged branch GEMMs");

constexpr int LDS_BYTES = 147712;
constexpr int LDS_BARST = 147456;
constexpr int LDS_CTL = 143360;

struct Params {
    const float* in[24];
    float* out;
    unsigned char* ws;
    int ph_lo, ph_hi;
};

__device__ __forceinline__ float bf2f(bf16_t v) { return __uint_as_float((unsigned)v << 16); }
__device__ __forceinline__ float bflo(unsigned w) { return __uint_as_float(w << 16); }
__device__ __forceinline__ float bfhi(unsigned w) { return __uint_as_float(w & 0xffff0000u); }
__device__ __forceinline__ unsigned f2bf(float f) { unsigned u = __float_as_uint(f); return (u + 0x7fffu + ((u >> 16) & 1u)) >> 16; }
__device__ __forceinline__ unsigned pk2(float lo, float hi) { return f2bf(lo) | (f2bf(hi) << 16); }
__device__ __forceinline__ float wave_sum(float v) {
#pragma unroll
    for (int o = 1; o < 64; o <<= 1) v += __shfl_xor(v, o);
    return v;
}
__device__ __forceinline__ float wave_max(float v) {
#pragma unroll
    for (int o = 1; o < 64; o <<= 1) v = fmaxf(v, __shfl_xor(v, o));
    return v;
}
__device__ __forceinline__ int wave_min_i(int v) {
#pragma unroll
    for (int o = 1; o < 64; o <<= 1) { int t = __shfl_xor(v, o); v = t < v ? t : v; }
    return v;
}
__device__ __forceinline__ float sigmoidf_(float x) { return 1.f / (1.f + __expf(-x)); }
__device__ __forceinline__ unsigned pack4_fp8(float a, float b, float c, float d) { unsigned w = __builtin_amdgcn_cvt_pk_fp8_f32(a, b, 0u, false); return __builtin_amdgcn_cvt_pk_fp8_f32(c, d, w, true); }
#define LDS_WAIT() asm volatile("s_waitcnt lgkmcnt(0)" ::: "memory")

struct Ctx { int tid, lane, wave, bid, G; LAS unsigned char* lds; };

struct TItem { const float* W; bf16_t* WT; const float* kscale; int N, k0, n0, orow0; };
__device__ __forceinline__ void transpose_load(const TItem& t, f32x4 (&v)[8], int lane) {
    const int nq = lane & 7, kg = lane >> 3;
    const float* s = t.W + (size_t)(t.k0 + 8 * kg) * t.N + t.n0 + 4 * nq;
#pragma unroll
    for (int i = 0; i < 8; ++i) v[i] = __builtin_nontemporal_load((const f32x4*)(s + (size_t)i * t.N));
}
__device__ __forceinline__ void transpose_store(const TItem& t, f32x4 (&v)[8], int lane) {
    const int nq = lane & 7, kg = lane >> 3;
    if (t.kscale) {
#pragma unroll
        for (int i = 0; i < 8; ++i) v[i] = v[i] * t.kscale[t.k0 + 8 * kg + i];
    }
    bf16_t* d = t.WT + (size_t)(t.orow0 + 4 * nq) * 1024 + t.k0 + 8 * kg;
#pragma unroll
    for (int j = 0; j < 4; ++j) { u32x4 o; o.x = pk2(v[0][j], v[1][j]); o.y = pk2(v[2][j], v[3][j]); o.z = pk2(v[4][j], v[5][j]); o.w = pk2(v[6][j], v[7][j]);
        *(u32x4*)(d + (size_t)j * 1024) = o; }
}
constexpr int PREP_I_IN = 16 * 193, PREP_I_SQ = 512, PREP_NITEMS = PREP_I_IN + 3 * PREP_I_SQ;
__device__ __forceinline__ TItem prep_item(const Params& p, int r) {
    unsigned char* ws = p.ws; TItem t; t.kscale = nullptr;
    if (r < PREP_I_IN) { const int kb = r / 193, nb = r % 193, n0 = nb * 32;
        t.W = p.in[2]; t.WT = (bf16_t*)(ws + WS_WINT); t.N = 6176; t.k0 = kb * 64; t.n0 = n0; t.orow0 = n0 < 2560 ? n0 : (n0 < 2592 ? PDT + (n0 - 2560) : n0 - 32); return t; }
    r -= PREP_I_IN;
    { const int which = r / PREP_I_SQ, q = r % PREP_I_SQ;
        t.W = which == 0 ? p.in[13] : (which == 1 ? p.in[14] : p.in[15]); t.WT = (bf16_t*)(ws + (which == 0 ? WS_WST : (which == 1 ? WS_WAT : WS_WOT)));
        t.kscale = which == 0 ? p.in[10] : nullptr; t.N = 1024; t.k0 = (q / 32) * 64; t.n0 = (q % 32) * 32; t.orow0 = t.n0; return t; }
}
constexpr int PREP8_TILES = 32 * 64 + 32 * 32;
struct T8 { const float* W; unsigned char* WT; int N, k0, n0; bool w1; };
__device__ __forceinline__ T8 prep8_tile(const Params& p, int t) {
    T8 r;
    if (t < 2048) { const int e = t >> 6; r.W = p.in[19] + (size_t)e * 1024 * 2048; r.WT = p.ws + WS_W1T + (size_t)e * 2048 * 1024; r.N = 2048; r.k0 = ((t >> 3) & 7) * 128; r.n0 = (t & 7) * 256; r.w1 = true; }
    else { t -= 2048; const int e = t >> 5; r.W = p.in[21] + (size_t)e * 1024 * 1024; r.WT = p.ws + WS_W2T + (size_t)e * 1024 * 1024; r.N = 1024; r.k0 = ((t >> 2) & 7) * 128; r.n0 = (t & 3) * 256; r.w1 = false; }
    return r;
}
__device__ __forceinline__ void prep8_load(const T8& t, f32x4 (&v)[16], int wave, int lane) {
    const float* s = t.W + (size_t)(t.k0 + 16 * wave) * t.N + t.n0 + 4 * lane;
#pragma unroll
    for (int i = 0; i < 16; ++i) v[i] = __builtin_nontemporal_load((const f32x4*)(s + (size_t)i * t.N));
}
__device__ __forceinline__ void phase_prep8(const Params& p, const Ctx& c) {
    f32x4 v[16];
    int t = c.bid;
    if (t < PREP8_TILES) { const T8 t0 = prep8_tile(p, t); prep8_load(t0, v, c.wave, c.lane); }
    for (int i = 0; t < PREP8_TILES; ++i, t += c.G) {
        const T8 cur = prep8_tile(p, t);
        LAS unsigned char* img = c.lds + (i & 1) * 32768;
#pragma unroll
        for (int j = 0; j < 4; ++j) { u32x4 o;
            o.x = pack4_fp8(64.f * v[0][j], 64.f * v[1][j], 64.f * v[2][j], 64.f * v[3][j]); o.y = pack4_fp8(64.f * v[4][j], 64.f * v[5][j], 64.f * v[6][j], 64.f * v[7][j]);
            o.z = pack4_fp8(64.f * v[8][j], 64.f * v[9][j], 64.f * v[10][j], 64.f * v[11][j]); o.w = pack4_fp8(64.f * v[12][j], 64.f * v[13][j], 64.f * v[14][j], 64.f * v[15][j]);
            *(LAS u32x4*)(img + (4 * c.lane + j) * 128 + 16 * c.wave) = o; }
        if (t + c.G < PREP8_TILES) { const T8 nx = prep8_tile(p, t + c.G); prep8_load(nx, v, c.wave, c.lane); }
        __syncthreads();
#pragma unroll
        for (int q = 0; q < 4; ++q) { const int idx = c.tid + 512 * q, nl = idx >> 3, cw = idx & 7, n = cur.n0 + nl;
            const int orow = cur.w1 ? (((n & 1023) >> 7) * 256 + (n >> 10) * 128 + (n & 127)) : n;
            *(u32x4*)(cur.WT + (size_t)orow * 1024 + cur.k0 + 16 * cw) = *(const LAS u32x4*)(img + nl * 128 + 16 * cw); }
    }
    __syncthreads();
}

__device__ __forceinline__ void phase_prep(const Params& p, const Ctx& c) {
    unsigned char* ws = p.ws;
    const int gw = c.bid * 8 + c.wave, NGW = c.G * 8;
    for (int it = gw; it < PREP_NITEMS; it += 2 * NGW) {
        const TItem ta = prep_item(p, it); f32x4 va[8], vb[8];
        transpose_load(ta, va, c.lane);
        const bool two = it + NGW < PREP_NITEMS;
        const TItem tb = prep_item(p, two ? it + NGW : it);
        if (two) transpose_load(tb, vb, c.lane);
        transpose_store(ta, va, c.lane);
        if (two) transpose_store(tb, vb, c.lane);
    }
    phase_prep8(p, c);
    for (int r = 6176 + gw; r < NPROJ; r += NGW) {
        u32x4* o = (u32x4*)((bf16_t*)(ws + WS_WINT) + (size_t)r * 1024);
        o[c.lane] = (u32x4){0u, 0u, 0u, 0u}; o[c.lane + 64] = (u32x4){0u, 0u, 0u, 0u};
    }
    {
        const float* x = p.in[0]; const float* g = p.in[1]; bf16_t* H = (bf16_t*)(ws + WS_H);
        f32x4 gv[4];
#pragma unroll
        for (int j = 0; j < 4; ++j) gv[j] = ((const f32x4*)g)[c.lane + 64 * j];
        for (int m = gw; m < M; m += NGW) {
            const f32x4* xr = (const f32x4*)(x + (size_t)m * D) + c.lane;
            f32x4 v[4]; float s = 0.f;
#pragma unroll
            for (int j = 0; j < 4; ++j) { v[j] = __builtin_nontemporal_load(xr + 64 * j); s += (v[j].x * v[j].x + v[j].y * v[j].y) + (v[j].z * v[j].z + v[j].w * v[j].w); }
            const float rstd = rsqrtf(wave_sum(s) * (1.f / D) + EPS);
            u32x2* o = (u32x2*)(H + (size_t)m * D) + c.lane;
#pragma unroll
            for (int j = 0; j < 4; ++j) { u32x2 w; w.x = pk2(v[j].x * rstd * gv[j].x, v[j].y * rstd * gv[j].y); w.y = pk2(v[j].z * rstd * gv[j].z, v[j].w * rstd * gv[j].w); o[64 * j] = w; }
        }
    }
    {
        float* rc = (float*)(ws + WS_ROPE); float* rs = rc + 4096;
        for (int idx = c.bid * 512 + c.tid; idx < 4096; idx += c.G * 512) {
            const int pos = idx >> 5, i = idx & 31;
            const float inv = exp2f(-(float)i * (13.287712379549449f / 32.f));
            float rev = (float)pos * inv * 0.15915494309189535f; rev -= floorf(rev);
            rc[idx] = __builtin_amdgcn_cosf(rev); rs[idx] = __builtin_amdgcn_sinf(rev);
        }
        float* wrt = (float*)(ws + WS_WRT); const float* wr = p.in[17];
        for (int idx = c.bid * 512 + c.tid; idx < 32768; idx += c.G * 512) { const int k = idx >> 5, e = idx & 31; wrt[e * 1024 + k] = wr[idx]; }
        if (c.bid == 0 && c.tid < 64) ((int*)(ws + WS_CTL))[c.tid] = 0;
    }
}

namespace pg8 {
#define PG8_LAS __attribute__((address_space(3)))
typedef unsigned short bf16_t;
typedef short bf16x8 __attribute__((ext_vector_type(8)));
typedef float f32x4 __attribute__((ext_vector_type(4)));
typedef unsigned u32x4 __attribute__((ext_vector_type(4)));
constexpr int BM = 256, BK = 64, HALF = 128, HTB = HALF * BK * 2  , STAGE_BYTES = 8 * HTB, NXCD = 8, WGM = 8;

__host__ __device__ __forceinline__ int lds_byte(int r, int c) { const int st = (r >> 4) * 2 + (c >> 5), rr = r & 15, cc = c & 31, ob = rr * 64 + cc * 2; return st * 1024 + (ob ^ (((ob >> 9) & 1) << 5)); }
__host__ __device__ __forceinline__ void stage_rc(int b, int& R, int& C) { const int st = b / 1024, sb = b % 1024, swz = sb ^ (((sb >> 9) & 1) << 5); R = (st >> 1) * 16 + swz / 64; C = (st & 1) * 32 + (swz % 64) / 2; }
__host__ __device__ __forceinline__ int perm32(int rho) { const int n = rho >> 4, i = rho & 15; return 8 * (i >> 2) + 4 * n + (i & 3); }

struct Unit { int pm, pn; };
struct Gemm { const bf16_t* A; const bf16_t* Bt; int M, N, K; };

struct StaticOrder {
    int nM, nN, nwg, G, c;
    __host__ __device__ void init(int M, int N, int G_, int c_) { nM = M / BM; nN = N / BM; nwg = nM * nN; G = G_; c = c_; }
    __host__ __device__ bool next(int i, Unit& u) const {
        const long L = (long)i * G + c; if (L >= nwg) return false;
        int wgid = (int)L; { const int q = nwg / NXCD, r = nwg % NXCD, xcd = wgid % NXCD, off = wgid / NXCD; wgid = (xcd < r ? xcd * (q + 1) : r * (q + 1) + (xcd - r) * q) + off; }
        const int nig = WGM * nN, gid = wgid / nig, fm = gid * WGM, gsz = (nM - fm) < WGM ? (nM - fm) : WGM;
        u.pm = fm + ((wgid % nig) % gsz); u.pn = (wgid % nig) / gsz; return true;
    }
    __device__ __forceinline__ void a_ready(const Unit&) const {}
    __device__ __forceinline__ void done(const Unit&) const {}
};


__device__ __forceinline__ unsigned cvt_pk_bf16(float lo, float hi) { unsigned r; asm volatile("v_cvt_pk_bf16_f32 %0, %1, %2" : "=v"(r) : "v"(lo), "v"(hi)); return r; }
__device__ __forceinline__ float sig_(float x) { return __builtin_amdgcn_rcpf(1.f + __builtin_amdgcn_exp2f(-1.4426950408889634f * x)); }
__device__ __forceinline__ u32x4 pack8(const f32x4& v0, const f32x4& v1) { u32x4 w; w.x = cvt_pk_bf16(v0[0], v0[1]); w.y = cvt_pk_bf16(v0[2], v0[3]); w.z = cvt_pk_bf16(v1[0], v1[1]); w.w = cvt_pk_bf16(v1[2], v1[3]); return w; }
__device__ __forceinline__ void unpack8(const u32x4& w, f32x4& v0, f32x4& v1) {
    v0[0] = __uint_as_float(w.x << 16); v0[1] = __uint_as_float(w.x & 0xffff0000u); v0[2] = __uint_as_float(w.y << 16); v0[3] = __uint_as_float(w.y & 0xffff0000u);
    v1[0] = __uint_as_float(w.z << 16); v1[1] = __uint_as_float(w.z & 0xffff0000u); v1[2] = __uint_as_float(w.w << 16); v1[3] = __uint_as_float(w.w & 0xffff0000u); }
struct EpiStore {
    static constexpr bool PERM = true, AFTER_DRAIN = false;
    bf16_t* O; int ldc;
    __device__ __forceinline__ void operator()(const f32x4 (&acc)[2][2][4][2], const Unit& u, int wr, int wc, int fr, int fq) const {
        const int row0 = u.pm * BM + wr * 64 + fr, col0 = u.pn * BM + wc * 32 + 8 * fq;
#pragma unroll
        for (int ai = 0; ai < 2; ++ai)
#pragma unroll
            for (int m = 0; m < 4; ++m) { bf16_t* rowp = O + (size_t)(row0 + ai * HALF + m * 16) * ldc + col0;
#pragma unroll
                for (int bj = 0; bj < 2; ++bj) *(u32x4*)(rowp + bj * HALF) = pack8(acc[ai][bj][m][0], acc[ai][bj][m][1]); }
    }
};
struct EpiAct8 {
    static constexpr bool PERM = true, AFTER_DRAIN = false;
    unsigned char* ACT; const float* b1;
    __device__ __forceinline__ void operator()(const f32x4 (&acc)[2][2][4][2], const Unit& u, int wr, int wc, int fr, int fq) const {
        const int e = u.pn >> 3, nt = u.pn & 7;
        const int row0 = u.pm * BM + wr * 64 + fr, col0 = nt * 128 + wc * 32 + 8 * fq;
        const float* bg = b1 + (size_t)e * 2048 + col0;
        const f32x4 bg0 = *(const f32x4*)bg, bg1 = *(const f32x4*)(bg + 4), bu0 = *(const f32x4*)(bg + 1024), bu1 = *(const f32x4*)(bg + 1028);
        constexpr float SC = 1.f / 512.f;
#pragma unroll
        for (int ai = 0; ai < 2; ++ai)
#pragma unroll
            for (int m = 0; m < 4; ++m) { const int row = row0 + ai * HALF + m * 16;
                f32x4 g0 = acc[ai][0][m][0] * SC + bg0, g1 = acc[ai][0][m][1] * SC + bg1, u0 = acc[ai][1][m][0] * SC + bu0, u1 = acc[ai][1][m][1] * SC + bu1;
#pragma unroll
                for (int i = 0; i < 4; ++i) {
                    const float ga = fminf(g0[i], 7.f), gb = fminf(g1[i], 7.f), ua = fminf(fmaxf(u0[i], -7.f), 7.f), ub = fminf(fmaxf(u1[i], -7.f), 7.f);
                    g0[i] = 4.f * ga * sig_(1.702f * ga) * (ua + 1.f); g1[i] = 4.f * gb * sig_(1.702f * gb) * (ub + 1.f); }
                u32x2 w; w.x = pack4_fp8(g0[0], g0[1], g0[2], g0[3]); w.y = pack4_fp8(g1[0], g1[1], g1[2], g1[3]);
                *(u32x2*)(ACT + (size_t)row * 1024 + col0) = w; }
    }
};
struct EpiY8 {
    static constexpr bool PERM = true, AFTER_DRAIN = false;
    bf16_t* YB; const float* b2;
    __device__ __forceinline__ void operator()(const f32x4 (&acc)[2][2][4][2], const Unit& u, int wr, int wc, int fr, int fq) const {
        const int e = u.pn >> 2, nt = u.pn & 3;
        const int row0 = u.pm * BM + wr * 64 + fr, col0 = nt * BM + wc * 32 + 8 * fq;
        constexpr float SC = 1.f / 256.f;
        f32x4 bv[2][2];
#pragma unroll
        for (int bj = 0; bj < 2; ++bj) { bv[bj][0] = *(const f32x4*)(b2 + (size_t)e * 1024 + col0 + bj * HALF); bv[bj][1] = *(const f32x4*)(b2 + (size_t)e * 1024 + col0 + bj * HALF + 4); }
#pragma unroll
        for (int ai = 0; ai < 2; ++ai)
#pragma unroll
            for (int m = 0; m < 4; ++m) { bf16_t* rowp = YB + (size_t)(row0 + ai * HALF + m * 16) * 1024 + col0;
#pragma unroll
                for (int bj = 0; bj < 2; ++bj) *(u32x4*)(rowp + bj * HALF) = pack8(acc[ai][bj][m][0] * SC + bv[bj][0], acc[ai][bj][m][1] * SC + bv[bj][1]); }
    }
};
template <int NN> struct MoeOrder {
    const PG8_LAS int* texp; int G, c, ntile;
    __device__ __forceinline__ bool next(int i, Unit& u) const {
        const int L = i * G + c; if (L >= ntile * NN) return false;
        const int t = L / NN, pnl = L % NN;
        u.pm = t; u.pn = texp[t] * NN + pnl; return true;
    }
    __device__ __forceinline__ void a_ready(const Unit&) const {}
    __device__ __forceinline__ void done(const Unit&) const {}
};
template <class Epi, class Sched, bool ALIGN_EPI = false, bool SP2 = false>
__device__ __forceinline__ void gemm_phase(PG8_LAS unsigned char* lds, const Gemm g, const Sched& S, const Epi& E) {
    const int tid = threadIdx.x, wid = __builtin_amdgcn_readfirstlane(tid >> 6), lane = tid & 63, wr = wid >> 2, wc = wid & 3, fr = lane & 15, fq = lane >> 4;
    const int K = g.K, nt = K / BK;
    unsigned voffA[2], voffB[2];
#pragma unroll
    for (int i = 0; i < 2; ++i) { int R, C; stage_rc(tid * 16 + i * 8192, R, C); const int Rb = Epi::PERM ? ((R & ~31) + perm32(R & 31)) : R;
        voffA[i] = (unsigned)(R * K + C) * 2u; voffB[i] = (unsigned)(Rb * K + C) * 2u; }
    const size_t kstep = (size_t)(BK * 2);
    const size_t hstep = (size_t)HALF * K * 2;
    const size_t tstep = 2 * hstep;
    const unsigned ldsw = (unsigned)wid * 1024u;
    const int aoff = lds_byte(wr * 64 + fr, fq * 8), boff = lds_byte(wc * 32 + fr, fq * 8);
#define PG8_SA(b, h) (((b) * 2 + (h)) * HTB)
#define PG8_SB(b, h) ((4 + (b) * 2 + (h)) * HTB)
#define PG8_STAGE(bufoff, gbase, voff) do { _Pragma("unroll") for (int _i = 0; _i < 2; ++_i) \
        __builtin_amdgcn_global_load_lds((const unsigned*)((const char*)(gbase) + (voff)[_i]), (PG8_LAS unsigned*)(lds + (bufoff) + ldsw + _i * 8192), 16, 0, 0); } while (0)
#define PG8_LDA(dst, b, h) do { _Pragma("unroll") for (int m = 0; m < 4; ++m) _Pragma("unroll") for (int k = 0; k < 2; ++k) dst[m][k] = *(const PG8_LAS bf16x8*)(lds + PG8_SA(b, h) + aoff + m * 2048 + k * 1024); } while (0)
#define PG8_LDB(dst, b, h) do { _Pragma("unroll") for (int n = 0; n < 2; ++n) _Pragma("unroll") for (int k = 0; k < 2; ++k) dst[n][k] = *(const PG8_LAS bf16x8*)(lds + PG8_SB(b, h) + boff + n * 2048 + k * 1024); } while (0)
#define PG8_MMA(ai, bj, At, Bt) do { __builtin_amdgcn_s_setprio(1); _Pragma("unroll") for (int m = 0; m < 4; ++m) _Pragma("unroll") for (int n = 0; n < 2; ++n) _Pragma("unroll") for (int k = 0; k < 2; ++k) \
        acc[ai][bj][m][n] = __builtin_amdgcn_mfma_f32_16x16x32_bf16(Bt[n][k], At[m][k], acc[ai][bj][m][n], 0, 0, 0); __builtin_amdgcn_s_setprio(0); } while (0)
#define PG8_WAIT_V(n) asm volatile("s_waitcnt vmcnt(" #n ")" ::: "memory")
#define PG8_WAIT_L(n) asm volatile("s_waitcnt lgkmcnt(" #n ")" ::: "memory")
#define PG8_BAR __builtin_amdgcn_s_barrier()
#define PG8_SCHED __builtin_amdgcn_sched_barrier(0)
    Unit cur, nxt; int ui = 0;
    if (!S.next(0, cur)) return;
    f32x4 acc[2][2][4][2];
#pragma unroll
    for (int a = 0; a < 2; ++a)
#pragma unroll
        for (int b = 0; b < 2; ++b)
#pragma unroll
            for (int m = 0; m < 4; ++m)
#pragma unroll
                for (int n = 0; n < 2; ++n) acc[a][b][m][n] = (f32x4){0.f, 0.f, 0.f, 0.f};
    bf16x8 At[4][2], B0[2][2], B1[2][2];
    const char* cA = (const char*)g.A + (size_t)cur.pm * tstep; const char* cB = (const char*)g.Bt + (size_t)cur.pn * tstep;
    S.a_ready(cur);
    if constexpr (SP2) {
        PG8_STAGE(PG8_SB(0, 0), cB, voffB); PG8_STAGE(PG8_SB(0, 1), cB + hstep, voffB); PG8_STAGE(PG8_SA(0, 0), cA, voffA); PG8_STAGE(PG8_SA(0, 1), cA + hstep, voffA);
        if (wr == 1) PG8_BAR;
        PG8_WAIT_V(2); PG8_BAR;
        PG8_STAGE(PG8_SB(1, 0), cB + kstep, voffB); PG8_STAGE(PG8_SA(1, 0), cA + kstep, voffA); PG8_STAGE(PG8_SB(1, 1), cB + hstep + kstep, voffB);
        PG8_WAIT_V(6); PG8_BAR;
    } else {
        PG8_STAGE(PG8_SB(0, 0), cB, voffB); PG8_STAGE(PG8_SA(0, 0), cA, voffA); PG8_STAGE(PG8_SB(0, 1), cB + hstep, voffB); PG8_STAGE(PG8_SA(0, 1), cA + hstep, voffA);
        if (wr == 1) PG8_BAR;
        PG8_WAIT_V(4); PG8_BAR;
        PG8_STAGE(PG8_SB(1, 0), cB + kstep, voffB); PG8_STAGE(PG8_SA(1, 0), cA + kstep, voffA); PG8_STAGE(PG8_SB(1, 1), cB + hstep + kstep, voffB);
        PG8_WAIT_V(6); PG8_BAR;
    }
    for (;;) {
        const bool has_next = S.next(ui + 1, nxt);
        const char* nA = has_next ? (const char*)g.A + (size_t)nxt.pm * tstep : cA; const char* nB = has_next ? (const char*)g.Bt + (size_t)nxt.pn * tstep : cB;
        for (int t = 0; t < nt; t += 2) {
            const bool last = (t == nt - 2);
            const char* a1 = cA + (size_t)(t + 1) * kstep;
            const char* a2 = last ? nA : cA + (size_t)(t + 2) * kstep; const char* b2 = last ? nB : cB + (size_t)(t + 2) * kstep;
            const char* a3 = a2 + kstep; const char* b3 = b2 + kstep;
            if (last && has_next) S.a_ready(nxt);
            if constexpr (SP2) {
            PG8_LDB(B0, 0, 0); PG8_LDB(B1, 0, 1); PG8_SCHED; PG8_LDA(At, 0, 0); PG8_STAGE(PG8_SA(1, 1), a1 + hstep, voffA);
            PG8_WAIT_V(8); PG8_WAIT_L(0); PG8_BAR; PG8_MMA(0, 0, At, B0); PG8_MMA(0, 1, At, B1); PG8_BAR; PG8_SCHED;
            PG8_LDA(At, 0, 1); PG8_STAGE(PG8_SB(0, 0), b2, voffB); PG8_STAGE(PG8_SB(0, 1), b2 + hstep, voffB); PG8_STAGE(PG8_SA(0, 0), a2, voffA);
            PG8_WAIT_V(8); PG8_WAIT_L(0); PG8_BAR; PG8_MMA(1, 0, At, B0); PG8_MMA(1, 1, At, B1); PG8_BAR; PG8_SCHED;
            PG8_LDB(B0, 1, 0); PG8_LDB(B1, 1, 1); PG8_SCHED; PG8_LDA(At, 1, 0); PG8_STAGE(PG8_SA(0, 1), a2 + hstep, voffA);
            PG8_WAIT_V(8); PG8_WAIT_L(0); PG8_BAR; PG8_MMA(0, 0, At, B0); PG8_MMA(0, 1, At, B1); PG8_BAR; PG8_SCHED;
            PG8_LDA(At, 1, 1); PG8_STAGE(PG8_SB(1, 0), b3, voffB); PG8_STAGE(PG8_SB(1, 1), b3 + hstep, voffB); PG8_STAGE(PG8_SA(1, 0), a3, voffA);
            PG8_WAIT_V(8); PG8_WAIT_L(0); PG8_BAR; PG8_MMA(1, 0, At, B0); PG8_MMA(1, 1, At, B1); PG8_BAR; PG8_SCHED;
            } else {
            PG8_LDB(B0, 0, 0); PG8_SCHED; PG8_LDA(At, 0, 0); PG8_STAGE(PG8_SA(1, 1), a1 + hstep, voffA);
            PG8_WAIT_L(8); PG8_BAR; PG8_WAIT_L(0); PG8_MMA(0, 0, At, B0); PG8_BAR; PG8_SCHED;
            PG8_LDB(B1, 0, 1); PG8_STAGE(PG8_SB(0, 0), b2, voffB);
            PG8_BAR; PG8_WAIT_L(0); PG8_MMA(0, 1, At, B1); PG8_BAR;
            PG8_LDA(At, 0, 1); PG8_STAGE(PG8_SA(0, 0), a2, voffA);
            PG8_BAR; PG8_WAIT_L(0); PG8_MMA(1, 0, At, B0); PG8_BAR; PG8_SCHED;
            PG8_STAGE(PG8_SB(0, 1), b2 + hstep, voffB);
            PG8_WAIT_V(6); PG8_BAR; PG8_MMA(1, 1, At, B1); PG8_BAR;
            PG8_LDB(B0, 1, 0); PG8_SCHED; PG8_LDA(At, 1, 0); PG8_STAGE(PG8_SA(0, 1), a2 + hstep, voffA);
            PG8_WAIT_L(8); PG8_BAR; PG8_WAIT_L(0); PG8_MMA(0, 0, At, B0); PG8_BAR; PG8_SCHED;
            PG8_LDB(B1, 1, 1); PG8_STAGE(PG8_SB(1, 0), b3, voffB);
            PG8_BAR; PG8_WAIT_L(0); PG8_MMA(0, 1, At, B1); PG8_BAR;
            PG8_LDA(At, 1, 1); PG8_STAGE(PG8_SA(1, 0), a3, voffA);
            PG8_BAR; PG8_WAIT_L(0); PG8_MMA(1, 0, At, B0); PG8_BAR; PG8_SCHED;
            PG8_STAGE(PG8_SB(1, 1), b3 + hstep, voffB);
            PG8_WAIT_V(6); PG8_BAR; PG8_MMA(1, 1, At, B1); PG8_BAR;
            }
        }
        if constexpr (ALIGN_EPI) { if (wr == 0) PG8_BAR; }
        if constexpr (!Epi::AFTER_DRAIN) { E(acc, cur, wr, wc, fr, fq); S.done(cur); }
        if (!has_next) break;
#pragma unroll
        for (int a = 0; a < 2; ++a)
#pragma unroll
            for (int b = 0; b < 2; ++b)
#pragma unroll
                for (int m = 0; m < 4; ++m)
#pragma unroll
                    for (int n = 0; n < 2; ++n) acc[a][b][m][n] = (f32x4){0.f, 0.f, 0.f, 0.f};
        cur = nxt; cA = nA; cB = nB; ++ui;
        if constexpr (ALIGN_EPI) { if (wr == 1) PG8_BAR; }
    }
    PG8_WAIT_V(0);
    if constexpr (!ALIGN_EPI) { if (wr == 0) PG8_BAR; }
    PG8_BAR;
    if constexpr (Epi::AFTER_DRAIN) { E.fused(acc, cur, wr, wc, fr, fq, lds, wid, lane); S.done(cur); }
#undef PG8_SA
#undef PG8_SB
#undef PG8_STAGE
#undef PG8_LDA
#undef PG8_LDB
#undef PG8_MMA
#undef PG8_WAIT_V
#undef PG8_WAIT_L
#undef PG8_BAR
#undef PG8_SCHED
}

struct MoeGatherOrder {
    const PG8_LAS int* offs; const PG8_LAS int* cnt; const PG8_LAS int* texp; const int* LIST; int G, c, ntile;
    __device__ __forceinline__ bool next(int i, Unit& u) const {
        const int L = i * G + c; if (L >= ntile * 8) return false;
        const int t = L >> 3, pnl = L & 7;
        u.pm = t; u.pn = texp[t] * 8 + pnl; return true;
    }
    __device__ __forceinline__ int arow(const Unit& u, int r) const { const int e = u.pn >> 3, slot = u.pm * 256 + r - offs[e]; return slot < cnt[e] ? LIST[e * 16384 + slot] : 0; }
    __device__ __forceinline__ void a_ready(const Unit&) const {}
    __device__ __forceinline__ void done(const Unit&) const {}
};
struct TailOrder {
    StaticOrder so;
    __device__ __forceinline__ bool next(int i, Unit& u) const { Unit b; if (!so.next(i >> 1, b)) return false; u.pm = b.pm + 64 * (i & 1); u.pn = b.pn + 4 * (i & 1); return true; }
    __device__ __forceinline__ void a_ready(const Unit&) const {}
    __device__ __forceinline__ void done(const Unit&) const {}
};
struct EpiT12 {
    static constexpr bool PERM = true, AFTER_DRAIN = false;
    bf16_t* T1; bf16_t* MG; const bf16_t* G; int ldg; const float* RSTD;
    __device__ __forceinline__ void operator()(const f32x4 (&acc)[2][2][4][2], const Unit& u, int wr, int wc, int fr, int fq) const {
        const bool second = u.pm >= 64;
        const int row0 = (u.pm & 63) * BM + wr * 64 + fr, col0 = (u.pn & 3) * BM + wc * 32 + 8 * fq;
        const bf16_t* Gp = G + (second ? 1024 : 0);
#pragma unroll
        for (int ai = 0; ai < 2; ++ai) {
            u32x4 gv[4][2], tv[4][2]; float rs[4];
#pragma unroll
            for (int m = 0; m < 4; ++m) { const int row = row0 + ai * HALF + m * 16; rs[m] = second ? 1.f : RSTD[row];
#pragma unroll
                for (int bj = 0; bj < 2; ++bj) { gv[m][bj] = *(const u32x4*)(Gp + (size_t)row * ldg + col0 + bj * HALF);
                    tv[m][bj] = second ? *(const u32x4*)(T1 + (size_t)row * 1024 + col0 + bj * HALF) : (u32x4){0u, 0u, 0u, 0u}; } }
#pragma unroll
            for (int m = 0; m < 4; ++m) { const int row = row0 + ai * HALF + m * 16;
#pragma unroll
                for (int bj = 0; bj < 2; ++bj) { f32x4 g0, g1, t0, t1; unpack8(gv[m][bj], g0, g1); unpack8(tv[m][bj], t0, t1);
                    f32x4 v0 = acc[ai][bj][m][0] * rs[m], v1 = acc[ai][bj][m][1] * rs[m];
#pragma unroll
                    for (int i = 0; i < 4; ++i) { v0[i] = fmaf(v0[i], sig_(g0[i]), t0[i]); v1[i] = fmaf(v1[i], sig_(g1[i]), t1[i]); }
                    *(u32x4*)((second ? MG : T1) + (size_t)row * 1024 + col0 + bj * HALF) = pack8(v0, v1); } }
        }
    }
};
struct EpiT3b {
    static constexpr bool PERM = true, AFTER_DRAIN = false;
    bf16_t* X1; const float* x;
    __device__ __forceinline__ void operator()(const f32x4 (&acc)[2][2][4][2], const Unit& u, int wr, int wc, int fr, int fq) const {
        const int row0 = u.pm * BM + wr * 64 + fr, col0 = u.pn * BM + wc * 32 + 8 * fq;
#pragma unroll
        for (int ai = 0; ai < 2; ++ai) {
            f32x4 xv[4][2][2];
#pragma unroll
            for (int m = 0; m < 4; ++m)
#pragma unroll
                for (int bj = 0; bj < 2; ++bj) { const size_t o = (size_t)(row0 + ai * HALF + m * 16) * 1024 + col0 + bj * HALF; xv[m][bj][0] = *(const f32x4*)(x + o); xv[m][bj][1] = *(const f32x4*)(x + o + 4); }
#pragma unroll
            for (int m = 0; m < 4; ++m)
#pragma unroll
                for (int bj = 0; bj < 2; ++bj) { const size_t o = (size_t)(row0 + ai * HALF + m * 16) * 1024 + col0 + bj * HALF;
                    *(u32x4*)(X1 + o) = pack8(xv[m][bj][0] + acc[ai][bj][m][0], xv[m][bj][1] + acc[ai][bj][m][1]); }
        }
    }
};
typedef int v4i_t __attribute__((ext_vector_type(4)));
typedef int v8i_t __attribute__((ext_vector_type(8)));
template <class Epi, class Sched, bool ALIGN_EPI = false, bool SP2 = false>
__device__ __forceinline__ void gemm_phase_f8(PG8_LAS unsigned char* lds, const Gemm g, const Sched& S, const Epi& E) {
    const int tid = threadIdx.x, wid = __builtin_amdgcn_readfirstlane(tid >> 6), lane = tid & 63, wr = wid >> 2, wc = wid & 3, fr = lane & 15, fq = lane >> 4;
    const int K = g.K, nt = K / BK;
    unsigned voffA[2], voffB[2];
#pragma unroll
    for (int i = 0; i < 2; ++i) { int R, C; stage_rc(tid * 16 + i * 8192, R, C); const int Rb = Epi::PERM ? ((R & ~31) + perm32(R & 31)) : R;
        voffA[i] = (unsigned)(R * K + C) * 2u; voffB[i] = (unsigned)(Rb * K + C) * 2u; }
    const size_t kstep = (size_t)(BK * 2);
    const size_t hstep = (size_t)HALF * K * 2;
    const size_t tstep = 2 * hstep;
    const unsigned ldsw = (unsigned)wid * 1024u;
    const int aoff = lds_byte(wr * 64 + fr, fq * 8), boff = lds_byte(wc * 32 + fr, fq * 8);
#define PG8_SA(b, h) (((b) * 2 + (h)) * HTB)
#define PG8_SB(b, h) ((4 + (b) * 2 + (h)) * HTB)
#define PG8_STAGE(bufoff, gbase, voff) do { _Pragma("unroll") for (int _i = 0; _i < 2; ++_i) \
        __builtin_amdgcn_global_load_lds((const unsigned*)((const char*)(gbase) + (voff)[_i]), (PG8_LAS unsigned*)(lds + (bufoff) + ldsw + _i * 8192), 16, 0, 0); } while (0)
#define PG8_LDA(dst, b, h) do { _Pragma("unroll") for (int m = 0; m < 4; ++m) { const v4i_t lo_ = *(const PG8_LAS v4i_t*)(lds + PG8_SA(b, h) + aoff + m * 2048), hi_ = *(const PG8_LAS v4i_t*)(lds + PG8_SA(b, h) + aoff + m * 2048 + 1024); dst[m] = __builtin_shufflevector(lo_, hi_, 0, 1, 2, 3, 4, 5, 6, 7); } } while (0)
#define PG8_LDB(dst, b, h) do { _Pragma("unroll") for (int n = 0; n < 2; ++n) { const v4i_t lo_ = *(const PG8_LAS v4i_t*)(lds + PG8_SB(b, h) + boff + n * 2048), hi_ = *(const PG8_LAS v4i_t*)(lds + PG8_SB(b, h) + boff + n * 2048 + 1024); dst[n] = __builtin_shufflevector(lo_, hi_, 0, 1, 2, 3, 4, 5, 6, 7); } } while (0)
#define PG8_MMA(ai, bj, At, Bt) do { __builtin_amdgcn_s_setprio(1); _Pragma("unroll") for (int m = 0; m < 4; ++m) _Pragma("unroll") for (int n = 0; n < 2; ++n) \
        asm volatile("v_mfma_scale_f32_16x16x128_f8f6f4 %0, %1, %2, %0, %3, %3 op_sel_hi:[0,0,0]" : "+v"(acc[ai][bj][m][n]) : "v"(Bt[n]), "v"(At[m]), "v"(scl_)); __builtin_amdgcn_s_setprio(0); } while (0)
#define PG8_WAIT_V(n) asm volatile("s_waitcnt vmcnt(" #n ")" ::: "memory")
#define PG8_WAIT_L(n) asm volatile("s_waitcnt lgkmcnt(" #n ")" ::: "memory")
#define PG8_BAR __builtin_amdgcn_s_barrier()
#define PG8_SCHED __builtin_amdgcn_sched_barrier(0)
    Unit cur, nxt; int ui = 0;
    if (!S.next(0, cur)) return;
    f32x4 acc[2][2][4][2];
#pragma unroll
    for (int a = 0; a < 2; ++a)
#pragma unroll
        for (int b = 0; b < 2; ++b)
#pragma unroll
            for (int m = 0; m < 4; ++m)
#pragma unroll
                for (int n = 0; n < 2; ++n) acc[a][b][m][n] = (f32x4){0.f, 0.f, 0.f, 0.f};
    const int scl_ = 0x7f7f7f7f;
    v8i_t At[4], B0[2], B1[2];
    const char* cA = (const char*)g.A + (size_t)cur.pm * tstep; const char* cB = (const char*)g.Bt + (size_t)cur.pn * tstep;
    S.a_ready(cur);
    if constexpr (SP2) {
        PG8_STAGE(PG8_SB(0, 0), cB, voffB); PG8_STAGE(PG8_SB(0, 1), cB + hstep, voffB); PG8_STAGE(PG8_SA(0, 0), cA, voffA); PG8_STAGE(PG8_SA(0, 1), cA + hstep, voffA);
        if (wr == 1) PG8_BAR;
        PG8_WAIT_V(2); PG8_BAR;
        PG8_STAGE(PG8_SB(1, 0), cB + kstep, voffB); PG8_STAGE(PG8_SA(1, 0), cA + kstep, voffA); PG8_STAGE(PG8_SB(1, 1), cB + hstep + kstep, voffB);
        PG8_WAIT_V(6); PG8_BAR;
    } else {
        PG8_STAGE(PG8_SB(0, 0), cB, voffB); PG8_STAGE(PG8_SA(0, 0), cA, voffA); PG8_STAGE(PG8_SB(0, 1), cB + hstep, voffB); PG8_STAGE(PG8_SA(0, 1), cA + hstep, voffA);
        if (wr == 1) PG8_BAR;
        PG8_WAIT_V(4); PG8_BAR;
        PG8_STAGE(PG8_SB(1, 0), cB + kstep, voffB); PG8_STAGE(PG8_SA(1, 0), cA + kstep, voffA); PG8_STAGE(PG8_SB(1, 1), cB + hstep + kstep, voffB);
        PG8_WAIT_V(6); PG8_BAR;
    }
    for (;;) {
        const bool has_next = S.next(ui + 1, nxt);
        const char* nA = has_next ? (const char*)g.A + (size_t)nxt.pm * tstep : cA; const char* nB = has_next ? (const char*)g.Bt + (size_t)nxt.pn * tstep : cB;
        for (int t = 0; t < nt; t += 2) {
            const bool last = (t == nt - 2);
            const char* a1 = cA + (size_t)(t + 1) * kstep;
            const char* a2 = last ? nA : cA + (size_t)(t + 2) * kstep; const char* b2 = last ? nB : cB + (size_t)(t + 2) * kstep;
            const char* a3 = a2 + kstep; const char* b3 = b2 + kstep;
            if (last && has_next) S.a_ready(nxt);
            if constexpr (SP2) {
            PG8_LDB(B0, 0, 0); PG8_LDB(B1, 0, 1); PG8_SCHED; PG8_LDA(At, 0, 0); PG8_STAGE(PG8_SA(1, 1), a1 + hstep, voffA);
            PG8_WAIT_V(8); PG8_WAIT_L(0); PG8_BAR; PG8_MMA(0, 0, At, B0); PG8_MMA(0, 1, At, B1); PG8_BAR; PG8_SCHED;
            PG8_LDA(At, 0, 1); PG8_STAGE(PG8_SB(0, 0), b2, voffB); PG8_STAGE(PG8_SB(0, 1), b2 + hstep, voffB); PG8_STAGE(PG8_SA(0, 0), a2, voffA);
            PG8_WAIT_V(8); PG8_WAIT_L(0); PG8_BAR; PG8_MMA(1, 0, At, B0); PG8_MMA(1, 1, At, B1); PG8_BAR; PG8_SCHED;
            PG8_LDB(B0, 1, 0); PG8_LDB(B1, 1, 1); PG8_SCHED; PG8_LDA(At, 1, 0); PG8_STAGE(PG8_SA(0, 1), a2 + hstep, voffA);
            PG8_WAIT_V(8); PG8_WAIT_L(0); PG8_BAR; PG8_MMA(0, 0, At, B0); PG8_MMA(0, 1, At, B1); PG8_BAR; PG8_SCHED;
            PG8_LDA(At, 1, 1); PG8_STAGE(PG8_SB(1, 0), b3, voffB); PG8_STAGE(PG8_SB(1, 1), b3 + hstep, voffB); PG8_STAGE(PG8_SA(1, 0), a3, voffA);
            PG8_WAIT_V(8); PG8_WAIT_L(0); PG8_BAR; PG8_MMA(1, 0, At, B0); PG8_MMA(1, 1, At, B1); PG8_BAR; PG8_SCHED;
            } else {
            PG8_LDB(B0, 0, 0); PG8_SCHED; PG8_LDA(At, 0, 0); PG8_STAGE(PG8_SA(1, 1), a1 + hstep, voffA);
            PG8_WAIT_L(8); PG8_BAR; PG8_WAIT_L(0); PG8_MMA(0, 0, At, B0); PG8_BAR; PG8_SCHED;
            PG8_LDB(B1, 0, 1); PG8_STAGE(PG8_SB(0, 0), b2, voffB);
            PG8_BAR; PG8_WAIT_L(0); PG8_MMA(0, 1, At, B1); PG8_BAR;
            PG8_LDA(At, 0, 1); PG8_STAGE(PG8_SA(0, 0), a2, voffA);
            PG8_BAR; PG8_WAIT_L(0); PG8_MMA(1, 0, At, B0); PG8_BAR; PG8_SCHED;
            PG8_STAGE(PG8_SB(0, 1), b2 + hstep, voffB);
            PG8_WAIT_V(6); PG8_BAR; PG8_MMA(1, 1, At, B1); PG8_BAR;
            PG8_LDB(B0, 1, 0); PG8_SCHED; PG8_LDA(At, 1, 0); PG8_STAGE(PG8_SA(0, 1), a2 + hstep, voffA);
            PG8_WAIT_L(8); PG8_BAR; PG8_WAIT_L(0); PG8_MMA(0, 0, At, B0); PG8_BAR; PG8_SCHED;
            PG8_LDB(B1, 1, 1); PG8_STAGE(PG8_SB(1, 0), b3, voffB);
            PG8_BAR; PG8_WAIT_L(0); PG8_MMA(0, 1, At, B1); PG8_BAR;
            PG8_LDA(At, 1, 1); PG8_STAGE(PG8_SA(1, 0), a3, voffA);
            PG8_BAR; PG8_WAIT_L(0); PG8_MMA(1, 0, At, B0); PG8_BAR; PG8_SCHED;
            PG8_STAGE(PG8_SB(1, 1), b3 + hstep, voffB);
            PG8_WAIT_V(6); PG8_BAR; PG8_MMA(1, 1, At, B1); PG8_BAR;
            }
        }
        if constexpr (ALIGN_EPI) { if (wr == 0) PG8_BAR; }
        asm volatile("s_nop 15\n\ts_nop 15" ::: "memory");
        if constexpr (!Epi::AFTER_DRAIN) { E(acc, cur, wr, wc, fr, fq); S.done(cur); }
        if (!has_next) break;
#pragma unroll
        for (int a = 0; a < 2; ++a)
#pragma unroll
            for (int b = 0; b < 2; ++b)
#pragma unroll
                for (int m = 0; m < 4; ++m)
#pragma unroll
                    for (int n = 0; n < 2; ++n) acc[a][b][m][n] = (f32x4){0.f, 0.f, 0.f, 0.f};
        cur = nxt; cA = nA; cB = nB; ++ui;
        if constexpr (ALIGN_EPI) { if (wr == 1) PG8_BAR; }
    }
    PG8_WAIT_V(0);
    if constexpr (!ALIGN_EPI) { if (wr == 0) PG8_BAR; }
    PG8_BAR;
    if constexpr (Epi::AFTER_DRAIN) { E.fused(acc, cur, wr, wc, fr, fq, lds, wid, lane); S.done(cur); }
#undef PG8_SA
#undef PG8_SB
#undef PG8_STAGE
#undef PG8_LDA
#undef PG8_LDB
#undef PG8_MMA
#undef PG8_WAIT_V
#undef PG8_WAIT_L
#undef PG8_BAR
#undef PG8_SCHED
}

template <class Epi, class Sched>
__device__ __forceinline__ void gemm_phase_gather_f8(PG8_LAS unsigned char* lds, const Gemm g, const Sched& S, const Epi& E) {
    constexpr bool ALIGN_EPI = true, SP2 = true;
    const int tid = threadIdx.x, wid = __builtin_amdgcn_readfirstlane(tid >> 6), lane = tid & 63, wr = wid >> 2, wc = wid & 3, fr = lane & 15, fq = lane >> 4;
    const int K = g.K, nt = K / BK;
    unsigned voffA[2], voffB[2];
#pragma unroll
    for (int i = 0; i < 2; ++i) { int R, C; stage_rc(tid * 16 + i * 8192, R, C); const int Rb = Epi::PERM ? ((R & ~31) + perm32(R & 31)) : R;
        voffA[i] = (unsigned)(R * K + C) * 2u; voffB[i] = (unsigned)(Rb * K + C) * 2u; }
    const size_t kstep = (size_t)(BK * 2);
    const size_t hstep = (size_t)HALF * K * 2;
    const size_t tstep = 2 * hstep;
    const unsigned ldsw = (unsigned)wid * 1024u;
    const int aoff = lds_byte(wr * 64 + fr, fq * 8), boff = lds_byte(wc * 32 + fr, fq * 8);
#define PG8_SA(b, h) (((b) * 2 + (h)) * HTB)
#define PG8_SB(b, h) ((4 + (b) * 2 + (h)) * HTB)
#define PG8_STAGE(bufoff, gbase, voff) do { _Pragma("unroll") for (int _i = 0; _i < 2; ++_i) \
        __builtin_amdgcn_global_load_lds((const unsigned*)((const char*)(gbase) + (voff)[_i]), (PG8_LAS unsigned*)(lds + (bufoff) + ldsw + _i * 8192), 16, 0, 0); } while (0)
#define PG8_LDA(dst, b, h) do { _Pragma("unroll") for (int m = 0; m < 4; ++m) { const v4i_t lo_ = *(const PG8_LAS v4i_t*)(lds + PG8_SA(b, h) + aoff + m * 2048), hi_ = *(const PG8_LAS v4i_t*)(lds + PG8_SA(b, h) + aoff + m * 2048 + 1024); dst[m] = __builtin_shufflevector(lo_, hi_, 0, 1, 2, 3, 4, 5, 6, 7); } } while (0)
#define PG8_LDB(dst, b, h) do { _Pragma("unroll") for (int n = 0; n < 2; ++n) { const v4i_t lo_ = *(const PG8_LAS v4i_t*)(lds + PG8_SB(b, h) + boff + n * 2048), hi_ = *(const PG8_LAS v4i_t*)(lds + PG8_SB(b, h) + boff + n * 2048 + 1024); dst[n] = __builtin_shufflevector(lo_, hi_, 0, 1, 2, 3, 4, 5, 6, 7); } } while (0)
#define PG8_MMA(ai, bj, At, Bt) do { __builtin_amdgcn_s_setprio(1); _Pragma("unroll") for (int m = 0; m < 4; ++m) _Pragma("unroll") for (int n = 0; n < 2; ++n) \
        asm volatile("v_mfma_scale_f32_16x16x128_f8f6f4 %0, %1, %2, %0, %3, %3 op_sel_hi:[0,0,0]" : "+v"(acc[ai][bj][m][n]) : "v"(Bt[n]), "v"(At[m]), "v"(scl_)); __builtin_amdgcn_s_setprio(0); } while (0)
#define PG8_WAIT_V(n) asm volatile("s_waitcnt vmcnt(" #n ")" ::: "memory")
#define PG8_WAIT_L(n) asm volatile("s_waitcnt lgkmcnt(" #n ")" ::: "memory")
#define PG8_BAR __builtin_amdgcn_s_barrier()
#define PG8_SCHED __builtin_amdgcn_sched_barrier(0)
    Unit cur, nxt; int ui = 0;
    if (!S.next(0, cur)) return;
    int rA[2]; unsigned cAo[2];
#pragma unroll
    for (int i = 0; i < 2; ++i) { int R, C; stage_rc(tid * 16 + i * 8192, R, C); rA[i] = R; cAo[i] = (unsigned)C * 2u; }
    unsigned cO[2][2], o2[2][2]; int nR[2][2];
#define PG8_ROWS(dst, u) do { _Pragma("unroll") for (int h_ = 0; h_ < 2; ++h_) _Pragma("unroll") for (int i_ = 0; i_ < 2; ++i_) \
        dst[h_][i_] = (unsigned)S.arow(u, h_ * HALF + rA[i_]) * (unsigned)(K * 2) + cAo[i_]; } while (0)
    PG8_ROWS(cO, cur);
    f32x4 acc[2][2][4][2];
#pragma unroll
    for (int a = 0; a < 2; ++a)
#pragma unroll
        for (int b = 0; b < 2; ++b)
#pragma unroll
            for (int m = 0; m < 4; ++m)
#pragma unroll
                for (int n = 0; n < 2; ++n) acc[a][b][m][n] = (f32x4){0.f, 0.f, 0.f, 0.f};
    const int scl_ = 0x7f7f7f7f;
    v8i_t At[4], B0[2], B1[2];
    const char* const Ab = (const char*)g.A; const char* cB = (const char*)g.Bt + (size_t)cur.pn * tstep;
    S.a_ready(cur);
    if constexpr (SP2) {
        PG8_STAGE(PG8_SB(0, 0), cB, voffB); PG8_STAGE(PG8_SB(0, 1), cB + hstep, voffB); PG8_STAGE(PG8_SA(0, 0), Ab, cO[0]); PG8_STAGE(PG8_SA(0, 1), Ab, cO[1]);
        if (wr == 1) PG8_BAR;
        PG8_WAIT_V(2); PG8_BAR;
        PG8_STAGE(PG8_SB(1, 0), cB + kstep, voffB); PG8_STAGE(PG8_SA(1, 0), Ab + kstep, cO[0]); PG8_STAGE(PG8_SB(1, 1), cB + hstep + kstep, voffB);
        PG8_WAIT_V(6); PG8_BAR;
    }
    for (;;) {
        const bool has_next = S.next(ui + 1, nxt);
        const char* nB = has_next ? (const char*)g.Bt + (size_t)nxt.pn * tstep : cB;
#pragma unroll
        for (int h_ = 0; h_ < 2; ++h_)
#pragma unroll
            for (int i_ = 0; i_ < 2; ++i_) nR[h_][i_] = has_next ? S.arow(nxt, h_ * HALF + rA[i_]) : 0;
        for (int t = 0; t < nt; t += 2) {
            const bool last = (t == nt - 2);
            const char* a1 = Ab + (size_t)(t + 1) * kstep;
            const char* a2 = last ? Ab : Ab + (size_t)(t + 2) * kstep; const char* b2 = last ? nB : cB + (size_t)(t + 2) * kstep;
#pragma unroll
            for (int h_ = 0; h_ < 2; ++h_)
#pragma unroll
                for (int i_ = 0; i_ < 2; ++i_) o2[h_][i_] = cO[h_][i_];
            if (last && has_next) {
#pragma unroll
                for (int h_ = 0; h_ < 2; ++h_)
#pragma unroll
                    for (int i_ = 0; i_ < 2; ++i_) { int v_ = nR[h_][i_]; asm volatile("" : "+v"(v_)); o2[h_][i_] = (unsigned)v_ * (unsigned)(K * 2) + cAo[i_]; } }
            const char* a3 = a2 + kstep; const char* b3 = b2 + kstep;
            if (last && has_next) S.a_ready(nxt);
            if constexpr (SP2) {
            PG8_LDB(B0, 0, 0); PG8_LDB(B1, 0, 1); PG8_SCHED; PG8_LDA(At, 0, 0); PG8_STAGE(PG8_SA(1, 1), a1, cO[1]);
            PG8_WAIT_V(8); PG8_WAIT_L(0); PG8_BAR; PG8_MMA(0, 0, At, B0); PG8_MMA(0, 1, At, B1); PG8_BAR; PG8_SCHED;
            PG8_LDA(At, 0, 1); PG8_STAGE(PG8_SB(0, 0), b2, voffB); PG8_STAGE(PG8_SB(0, 1), b2 + hstep, voffB); PG8_STAGE(PG8_SA(0, 0), a2, o2[0]);
            PG8_WAIT_V(8); PG8_WAIT_L(0); PG8_BAR; PG8_MMA(1, 0, At, B0); PG8_MMA(1, 1, At, B1); PG8_BAR; PG8_SCHED;
            PG8_LDB(B0, 1, 0); PG8_LDB(B1, 1, 1); PG8_SCHED; PG8_LDA(At, 1, 0); PG8_STAGE(PG8_SA(0, 1), a2, o2[1]);
            PG8_WAIT_V(8); PG8_WAIT_L(0); PG8_BAR; PG8_MMA(0, 0, At, B0); PG8_MMA(0, 1, At, B1); PG8_BAR; PG8_SCHED;
            PG8_LDA(At, 1, 1); PG8_STAGE(PG8_SB(1, 0), b3, voffB); PG8_STAGE(PG8_SB(1, 1), b3 + hstep, voffB); PG8_STAGE(PG8_SA(1, 0), a3, o2[0]);
            PG8_WAIT_V(8); PG8_WAIT_L(0); PG8_BAR; PG8_MMA(1, 0, At, B0); PG8_MMA(1, 1, At, B1); PG8_BAR; PG8_SCHED;
            }
        }
        if constexpr (ALIGN_EPI) { if (wr == 0) PG8_BAR; }
        asm volatile("s_nop 15\n\ts_nop 15" ::: "memory");
        if constexpr (!Epi::AFTER_DRAIN) { E(acc, cur, wr, wc, fr, fq); S.done(cur); }
        if (!has_next) break;
#pragma unroll
        for (int a = 0; a < 2; ++a)
#pragma unroll
            for (int b = 0; b < 2; ++b)
#pragma unroll
                for (int m = 0; m < 4; ++m)
#pragma unroll
                    for (int n = 0; n < 2; ++n) acc[a][b][m][n] = (f32x4){0.f, 0.f, 0.f, 0.f};
        cur = nxt; cB = nB; ++ui;
#pragma unroll
        for (int h_ = 0; h_ < 2; ++h_)
#pragma unroll
            for (int i_ = 0; i_ < 2; ++i_) cO[h_][i_] = o2[h_][i_];
        if constexpr (ALIGN_EPI) { if (wr == 1) PG8_BAR; }
    }
    PG8_WAIT_V(0);
    if constexpr (!ALIGN_EPI) { if (wr == 0) PG8_BAR; }
    PG8_BAR;
    if constexpr (Epi::AFTER_DRAIN) { E.fused(acc, cur, wr, wc, fr, fq, lds, wid, lane); S.done(cur); }
#undef PG8_ROWS
#undef PG8_SA
#undef PG8_SB
#undef PG8_STAGE
#undef PG8_LDA
#undef PG8_LDB
#undef PG8_MMA
#undef PG8_WAIT_V
#undef PG8_WAIT_L
#undef PG8_BAR
#undef PG8_SCHED
}
}

typedef short bf16x8c __attribute__((ext_vector_type(8)));
typedef float f32x16c __attribute__((ext_vector_type(16)));
__device__ __forceinline__ void phase_conv(const Params& p, const Ctx& c) {
    unsigned char* ws = p.ws;
    const bf16_t* P = (const bf16_t*)(ws + WS_P);
    const int tid = c.tid;
    LAS bf16_t* raw = (LAS bf16_t*)c.lds;
    LAS bf16_t* outb = (LAS bf16_t*)(c.lds + 132 * 256 * 2);
    for (int it = c.bid; it < 2 * 64 * 6; it += c.G) {
        const int part = it % 6, bc = it / 6, b = bc / 64, ch_ = bc % 64, t0 = ch_ * 128;
        __syncthreads();
        {
            u32x4 rv[9];
#pragma unroll
            for (int i = 0; i < 9; ++i) { const int idx = tid + 512 * i, r = idx >> 5, c8 = idx & 31, tok = t0 - 2 + r;
                rv[i] = (u32x4){0u, 0u, 0u, 0u};
                if (idx < 132 * 32 && tok >= 0 && tok < S) rv[i] = *(const u32x4*)(P + (size_t)(b * S + tok) * NPROJ + PXBC + part * 256 + c8 * 8); }
#pragma unroll
            for (int i = 0; i < 9; ++i) { const int idx = tid + 512 * i, r = idx >> 5, c8 = idx & 31;
                if (idx < 132 * 32) *(LAS u32x4*)(raw + r * 256 + c8 * 8) = rv[i]; }
        }
        __syncthreads();
        {
            const int ch = tid & 255, hf = tid >> 8, cg_ = part * 256 + ch;
            const float* cw = p.in[3]; const float cb = p.in[4][cg_];
            const float w0 = cw[0 * 1536 + cg_], w1 = cw[1 * 1536 + cg_], w2 = cw[2 * 1536 + cg_], w3 = cw[3 * 1536 + cg_], w4 = cw[4 * 1536 + cg_];
            const LAS bf16_t* rp = raw + (hf * 64) * 256 + ch;
            float r0 = bf2f(rp[0 * 256]), r1 = bf2f(rp[1 * 256]), r2 = bf2f(rp[2 * 256]), r3 = bf2f(rp[3 * 256]);
            unsigned ov[32];
#pragma unroll
            for (int i = 0; i < 64; ++i) {
                const float r4 = bf2f(rp[(i + 4) * 256]);
                float a = cb; a = fmaf(w0, r0, a); a = fmaf(w1, r1, a); a = fmaf(w2, r2, a); a = fmaf(w3, r3, a); a = fmaf(w4, r4, a);
                const unsigned hv = f2bf(a * sigmoidf_(a));
                if (i & 1) ov[i >> 1] |= hv << 16; else ov[i >> 1] = hv;
                r0 = r1; r1 = r2; r2 = r3; r3 = r4;
            }
            if (part <= 4) {
                bf16_t* dst = (part < 4 ? (bf16_t*)(ws + WS_XT) + ((size_t)(b * 64 + ch_) * 16 + part * 4) * 64 * 128
                                        : (bf16_t*)(ws + WS_BMT) + (size_t)(b * 64 + ch_) * 2 * 128 * 128) + (size_t)ch * 128 + hf * 64;
#pragma unroll
                for (int q = 0; q < 8; ++q) *(u32x4*)(dst + q * 8) = (u32x4){ov[4 * q], ov[4 * q + 1], ov[4 * q + 2], ov[4 * q + 3]};
            }
            if (part >= 4) {
#pragma unroll
                for (int i = 0; i < 64; ++i) outb[(hf * 64 + i) * 256 + ch] = (bf16_t)((i & 1) ? (ov[i >> 1] >> 16) : (ov[i >> 1] & 0xffffu));
            }
        }
        if (part >= 4) {
            __syncthreads();
            bf16_t* dst = (bf16_t*)(ws + (part == 4 ? WS_BMR : WS_CMR)) + (size_t)(b * S + t0) * 256;
#pragma unroll
            for (int q = 0; q < 8; ++q) { const int idx = tid + 512 * q, l = idx >> 5, c8 = idx & 31;
                *(u32x4*)(dst + (size_t)l * 256 + c8 * 8) = *(const LAS u32x4*)(outb + l * 256 + c8 * 8); }
        }
    }
    {
        float* DT = (float*)(ws + WS_DT); float* ACS = (float*)(ws + WS_ACS); float* CDEC = (float*)(ws + WS_CDEC);
        const bf16_t* H = (const bf16_t*)(ws + WS_H); const bf16_t* Wdt = (const bf16_t*)(ws + WS_WINT) + (size_t)PDT * 1024;
        constexpr int WS_ = 1032;
        LAS bf16_t* wl = (LAS bf16_t*)c.lds; LAS float* dtr = (LAS float*)(c.lds + 32 * WS_ * 2);
        const int lane = c.lane, r = lane & 31, hh = lane >> 5;
        bool staged = false;
        for (int it = c.bid; it < 128; it += c.G) {
            const int b = it / 64, ch_ = it % 64, t0 = ch_ * 128;
            __syncthreads();
            if (!staged) { staged = true;
#pragma unroll
                for (int i = 0; i < 8; ++i) { const int idx = tid + 512 * i, row = idx >> 7, c8 = idx & 127; *(LAS u32x4*)(wl + row * WS_ + c8 * 8) = *(const u32x4*)(Wdt + (size_t)row * 1024 + c8 * 8); }
                __syncthreads(); }
            {
                const int rb = c.wave & 3, kh = c.wave >> 2;
                const bf16_t* hrow = H + ((size_t)b * S + t0 + rb * 32 + r) * 1024 + kh * 512 + 8 * hh;
                f32x16c acc = {};
#pragma unroll
                for (int k8 = 0; k8 < 4; ++k8) { bf16x8c a[8];
#pragma unroll
                    for (int ks = 0; ks < 8; ++ks) a[ks] = *(const bf16x8c*)(hrow + (k8 * 8 + ks) * 16);
#pragma unroll
                    for (int ks = 0; ks < 8; ++ks) acc = __builtin_amdgcn_mfma_f32_32x32x16_bf16(a[ks], *(const LAS bf16x8c*)(wl + r * WS_ + kh * 512 + (k8 * 8 + ks) * 16 + 8 * hh), acc, 0, 0, 0); }
#pragma unroll
                for (int i = 0; i < 16; ++i) { const int l = rb * 32 + (i & 3) + 8 * (i >> 2) + 4 * hh; dtr[(kh * 128 + l) * 33 + r] = acc[i]; }
            }
            __syncthreads();
#pragma unroll
            for (int qi = 0; qi < 4; ++qi) {
                const int q = c.wave * 4 + qi, dir = q >> 4, h = q & 15;
                const float bias = dir ? p.in[6][h] : p.in[5][h], nA = -expf(dir ? p.in[8][h] : p.in[7][h]);
                const int l0 = dir ? 127 - lane : lane, l1 = dir ? 63 - lane : lane + 64;
                const size_t tok0 = (size_t)b * S + t0 + l0, tok1 = (size_t)b * S + t0 + l1;
                const float x0 = dtr[l0 * 33 + q] + dtr[(128 + l0) * 33 + q] + bias, x1 = dtr[l1 * 33 + q] + dtr[(128 + l1) * 33 + q] + bias;
                const float d0 = fmaxf(x0, 0.f) + log1pf(expf(-fabsf(x0))), d1 = fmaxf(x1, 0.f) + log1pf(expf(-fabsf(x1)));
                float a0 = d0 * nA, a1 = d1 * nA;
#pragma unroll
                for (int o = 1; o < 64; o <<= 1) { const float t0_ = __shfl_up(a0, o), t1_ = __shfl_up(a1, o); if (lane >= o) { a0 += t0_; a1 += t1_; } }
                const float tot0 = __shfl(a0, 63); a1 += tot0;
                DT[((size_t)dir * M + tok0) * 16 + h] = d0; DT[((size_t)dir * M + tok1) * 16 + h] = d1;
                ACS[((size_t)dir * M + tok0) * 16 + h] = a0; ACS[((size_t)dir * M + tok1) * 16 + h] = a1;
                if (lane == 63) CDEC[((dir * 2 + b) * 64 + ch_) * 16 + h] = expf(a1);
            }
        }
        __syncthreads();
    }
    {
        const int gw = c.bid * 8 + c.wave, NGW = c.G * 8, lane = c.lane;
        const float* rc = (const float*)(ws + WS_ROPE); const float* rs = rc + 4096;
        const int sub = lane >> 4, j = lane & 15, axis = j >> 3, i0 = 8 * (j & 3); const bool second = (j & 4) != 0;
        const f32x4 gq0 = *(const f32x4*)(p.in[11] + 8 * j), gq1 = *(const f32x4*)(p.in[11] + 8 * j + 4), gk0 = *(const f32x4*)(p.in[12] + 8 * j), gk1 = *(const f32x4*)(p.in[12] + 8 * j + 4);
        unsigned char* QN = ws + WS_QN; unsigned char* KN = ws + WS_KN;
        for (int base0 = gw; base0 < M * 10 / 4; base0 += 4 * NGW) {
            u32x4 vq[4]; int tokq[4], hhq[4];
#pragma unroll
            for (int u = 0; u < 4; ++u) { const int base = base0 + u * NGW, it = base * 4 + sub; tokq[u] = it / 10; hhq[u] = it % 10;
                vq[u] = (u32x4){0u, 0u, 0u, 0u};
                if (base < M * 10 / 4) vq[u] = *(const u32x4*)(P + (size_t)tokq[u] * NPROJ + (hhq[u] < 8 ? PQ + hhq[u] * 128 : PK + (hhq[u] - 8) * 128) + 8 * j); }
#pragma unroll
            for (int u = 0; u < 4; ++u) {
                const int base = base0 + u * NGW, tok = tokq[u], hh = hhq[u];
                unsigned char* dst = (hh < 8 ? QN + (size_t)tok * 1024 + hh * 128 : KN + (size_t)tok * 256 + (hh - 8) * 128) + 8 * j;
                const u32x4 v = vq[u];
                float y[8] = {bflo(v.x), bfhi(v.x), bflo(v.y), bfhi(v.y), bflo(v.z), bfhi(v.z), bflo(v.w), bfhi(v.w)};
                float ss = 0.f;
#pragma unroll
                for (int i = 0; i < 8; ++i) ss = fmaf(y[i], y[i], ss);
                ss += __shfl_xor(ss, 1); ss += __shfl_xor(ss, 2); ss += __shfl_xor(ss, 4); ss += __shfl_xor(ss, 8);
                const float rstd = rsqrtf(ss * (1.f / 128.f) + EPS);
                const f32x4 g0 = hh < 8 ? gq0 : gk0, g1 = hh < 8 ? gq1 : gk1;
#pragma unroll
                for (int i = 0; i < 4; ++i) { y[i] *= rstd * g0[i]; y[4 + i] *= rstd * g1[i]; }
                const int s = tok & (S - 1), pos = axis ? (s & 63) : (s >> 6);
                const f32x4 c0 = *(const f32x4*)(rc + pos * 32 + i0), c1 = *(const f32x4*)(rc + pos * 32 + i0 + 4), s0 = *(const f32x4*)(rs + pos * 32 + i0), s1 = *(const f32x4*)(rs + pos * 32 + i0 + 4);
                float o[8];
#pragma unroll
                for (int i = 0; i < 8; ++i) { const float other = __shfl_xor(y[i], 4); const float cs = i < 4 ? c0[i] : c1[i - 4], sn = i < 4 ? s0[i] : s1[i - 4];
                    o[i] = second ? fmaf(other, sn, y[i] * cs) : fmaf(-other, sn, y[i] * cs); }
                u32x2 w; w.x = pack4_fp8(o[0], o[1], o[2], o[3]); w.y = pack4_fp8(o[4], o[5], o[6], o[7]);
                if (base < M * 10 / 4) *(u32x2*)dst = w;
            }
        }
    }
    {
        unsigned char* VT8 = ws + WS_VB; LAS unsigned char* vt = c.lds;
        for (int it = c.bid; it < 256; it += c.G) {
            const int b = it >> 7, jt = it & 127;
            __syncthreads();
            u32x4 vv[4];
#pragma unroll
            for (int q = 0; q < 4; ++q) { const int idx = tid + 512 * q, key = idx >> 5, c8 = idx & 31; vv[q] = *(const u32x4*)(P + ((size_t)b * S + jt * 64 + key) * NPROJ + PV + c8 * 8); }
#pragma unroll
            for (int q = 0; q < 4; ++q) { const int idx = tid + 512 * q, key = idx >> 5, c8 = idx & 31, d0 = c8 * 8;
                const int off = 32 * ((key >> 2) & 1) + 16 * (key >> 5) + (key & 3) + 4 * ((key & 31) >> 3);
                const unsigned w0 = pack4_fp8(bflo(vv[q].x), bfhi(vv[q].x), bflo(vv[q].y), bfhi(vv[q].y)), w1 = pack4_fp8(bflo(vv[q].z), bfhi(vv[q].z), bflo(vv[q].w), bfhi(vv[q].w));
                LAS unsigned char* dp = vt + d0 * 64 + off;
                dp[0 * 64] = (unsigned char)(w0); dp[1 * 64] = (unsigned char)(w0 >> 8); dp[2 * 64] = (unsigned char)(w0 >> 16); dp[3 * 64] = (unsigned char)(w0 >> 24);
                dp[4 * 64] = (unsigned char)(w1); dp[5 * 64] = (unsigned char)(w1 >> 8); dp[6 * 64] = (unsigned char)(w1 >> 16); dp[7 * 64] = (unsigned char)(w1 >> 24); }
            __syncthreads();
#pragma unroll
            for (int q = 0; q < 2; ++q) { const int idx = tid + 512 * q, kvh = idx >> 9, rem = idx & 511;
                *(u32x4*)(VT8 + ((size_t)(b * 2 + kvh) * 128 + jt) * 8192 + rem * 16) = *(const LAS u32x4*)(vt + kvh * 8192 + rem * 16); }
        }
        __syncthreads();
    }
}

typedef short bf16x8 __attribute__((ext_vector_type(8)));
typedef float f32x16 __attribute__((ext_vector_type(16)));
constexpr int TS = 136;
__device__ __forceinline__ bf16x8 ldfrag(const LAS bf16_t* tile, int row, int k0) { return *(const LAS bf16x8*)(tile + row * TS + k0); }
template <int ROWS> __device__ __forceinline__ void load_tile128(LAS bf16_t* dst, const bf16_t* src, int ld, int tid) {
    constexpr int N = ROWS * 16 / 512;
    u32x4 v[N];
#pragma unroll
    for (int i = 0; i < N; ++i) { const int idx = tid + 512 * i; v[i] = *(const u32x4*)(src + (size_t)(idx >> 4) * ld + (idx & 15) * 8); }
#pragma unroll
    for (int i = 0; i < N; ++i) { const int idx = tid + 512 * i; *(LAS u32x4*)(dst + (idx >> 4) * TS + (idx & 15) * 8) = v[i]; }
}
__device__ __forceinline__ void phase_ssd_states(const Params& p, const Ctx& c) {
    unsigned char* ws = p.ws;
    const bf16_t* XT = (const bf16_t*)(ws + WS_XT); const bf16_t* BMT = (const bf16_t*)(ws + WS_BMT);
    const float* DT = (const float*)(ws + WS_DT); const float* ACS = (const float*)(ws + WS_ACS); bf16_t* ST = (bf16_t*)(ws + WS_PREV);
    LAS bf16_t* BTs = (LAS bf16_t*)c.lds; LAS bf16_t* XTf = BTs + 128 * TS; LAS bf16_t* XTb = XTf + 64 * TS; LAS float* wd = (LAS float*)(XTb + 64 * TS);
    const int tid = c.tid, lane = c.lane, r = lane & 31, hh = lane >> 5;
    for (int unit = c.bid; unit < 256; unit += c.G) {
        const int b = unit >> 7, ch = (unit >> 1) & 63, g = unit & 1;
        __syncthreads();
        load_tile128<128>(BTs, BMT + ((size_t)(b * 64 + ch) * 2 + g) * 128 * 128, 128, tid);
        u32x4 xv0, xv1; float pacs = 0.f, pdt = 0.f, paend = 0.f;
        const int wd_d = (tid >> 7) & 1, wd_l = tid & 127; const size_t wd_t0 = (size_t)wd_d * M + (size_t)b * S + ch * 128;
#define S1_PREFETCH(H) do { const bf16_t* xt_ = XT + ((size_t)(b * 64 + ch) * 16 + (H)) * 64 * 128; \
            xv0 = *(const u32x4*)(xt_ + (tid >> 4) * 128 + (tid & 15) * 8); xv1 = *(const u32x4*)(xt_ + ((tid + 512) >> 4) * 128 + (tid & 15) * 8); \
            if (tid < 256) { pacs = ACS[(wd_t0 + wd_l) * 16 + (H)]; pdt = DT[(wd_t0 + wd_l) * 16 + (H)]; paend = ACS[(wd_t0 + (wd_d ? 0 : 127)) * 16 + (H)]; } } while (0)
        S1_PREFETCH(g * 8);
#pragma unroll 1
        for (int h8 = 0; h8 < 8; ++h8) {
            const int h = g * 8 + h8;
            __syncthreads();
            if (tid < 256) wd[wd_d * 128 + wd_l] = pdt * __expf(paend - pacs);
            __syncthreads();
            {
                const u32x4 vv[2] = {xv0, xv1};
#pragma unroll
                for (int i = 0; i < 2; ++i) { const int idx = tid + 512 * i, pr = idx >> 4, l0 = (idx & 15) * 8; const u32x4 v = vv[i];
                    const float x[8] = {bflo(v.x), bfhi(v.x), bflo(v.y), bfhi(v.y), bflo(v.z), bfhi(v.z), bflo(v.w), bfhi(v.w)};
                    const f32x4 wf0 = *(const LAS f32x4*)(wd + l0), wf1 = *(const LAS f32x4*)(wd + l0 + 4), wb0 = *(const LAS f32x4*)(wd + 128 + l0), wb1 = *(const LAS f32x4*)(wd + 128 + l0 + 4);
                    u32x4 of, ob;
                    of.x = pk2(x[0] * wf0[0], x[1] * wf0[1]); of.y = pk2(x[2] * wf0[2], x[3] * wf0[3]); of.z = pk2(x[4] * wf1[0], x[5] * wf1[1]); of.w = pk2(x[6] * wf1[2], x[7] * wf1[3]);
                    ob.x = pk2(x[0] * wb0[0], x[1] * wb0[1]); ob.y = pk2(x[2] * wb0[2], x[3] * wb0[3]); ob.z = pk2(x[4] * wb1[0], x[5] * wb1[1]); ob.w = pk2(x[6] * wb1[2], x[7] * wb1[3]);
                    *(LAS u32x4*)(XTf + pr * TS + l0) = of; *(LAS u32x4*)(XTb + pr * TS + l0) = ob; }
            }
            if (h8 < 7) S1_PREFETCH(h + 1);
            __syncthreads();
            { const int d = c.wave >> 2, nb = c.wave & 3; const LAS bf16_t* XTd = d ? XTb : XTf;
              bf16_t* st = ST + ((((size_t)(d * 2 + b) * 64 + ch) * 16 + h) * 64) * 128;
#pragma unroll
              for (int pb = 0; pb < 2; ++pb) { f32x16 acc = {};
#pragma unroll
                for (int ks = 0; ks < 8; ++ks) acc = __builtin_amdgcn_mfma_f32_32x32x16_bf16(ldfrag(XTd, pb * 32 + r, ks * 16 + 8 * hh), ldfrag(BTs, nb * 32 + r, ks * 16 + 8 * hh), acc, 0, 0, 0);
#pragma unroll
                for (int i = 0; i < 16; ++i) { const int pp = pb * 32 + (i & 3) + 8 * (i >> 2) + 4 * hh; st[(size_t)pp * 128 + nb * 32 + r] = (bf16_t)f2bf(acc[i]); } } }
        }
#undef S1_PREFETCH
    }
}
__device__ __forceinline__ void phase_ssd_scan(const Params& p, const Ctx& c) {
    unsigned char* ws = p.ws;
    const float* CDEC = (const float*)(ws + WS_CDEC); bf16_t* PREV = (bf16_t*)(ws + WS_PREV);
    for (int idx = c.bid * 512 + c.tid; idx < 131072; idx += c.G * 512) {
        const int n4 = idx & 31, pp = (idx >> 5) & 63, h = (idx >> 11) & 15, b = (idx >> 15) & 1, d = idx >> 16;
        f32x4 run = {0.f, 0.f, 0.f, 0.f};
        const size_t obase = ((size_t)(d * 2 + b) * 64 * 16 + h) * 64 * 128 + (size_t)pp * 128 + n4 * 4;
        const float* cd = CDEC + (d * 2 + b) * 64 * 16 + h;
#pragma unroll 1
        for (int s0 = 0; s0 < 64; s0 += 16) {
            u32x2 sv[16]; float dec[16];
#pragma unroll
            for (int i = 0; i < 16; ++i) { const int ch = d ? 63 - (s0 + i) : s0 + i; sv[i] = *(const u32x2*)(PREV + obase + (size_t)ch * (16 * 64 * 128)); dec[i] = cd[ch * 16]; }
#pragma unroll
            for (int i = 0; i < 16; ++i) { const int ch = d ? 63 - (s0 + i) : s0 + i;
                u32x2 w; w.x = pk2(run.x, run.y); w.y = pk2(run.z, run.w); *(u32x2*)(PREV + obase + (size_t)ch * (16 * 64 * 128)) = w;
                run.x = fmaf(run.x, dec[i], bflo(sv[i].x)); run.y = fmaf(run.y, dec[i], bfhi(sv[i].x)); run.z = fmaf(run.z, dec[i], bflo(sv[i].y)); run.w = fmaf(run.w, dec[i], bfhi(sv[i].y)); }
        }
    }
}
__device__ __forceinline__ void phase_ssd_out(const Params& p, const Ctx& c) {
    unsigned char* ws = p.ws;
    const bf16_t* P = (const bf16_t*)(ws + WS_P); const bf16_t* XT = (const bf16_t*)(ws + WS_XT);
    const bf16_t* BMR = (const bf16_t*)(ws + WS_BMR); const bf16_t* CMR = (const bf16_t*)(ws + WS_CMR); const bf16_t* PREV = (const bf16_t*)(ws + WS_PREV);
    const float* DT = (const float*)(ws + WS_DT); const float* ACS = (const float*)(ws + WS_ACS); bf16_t* YZ = (bf16_t*)(ws + WS_YZ);
    LAS bf16_t* Cs = (LAS bf16_t*)c.lds; LAS bf16_t* Ms = Cs + 128 * TS; LAS bf16_t* XTs = Ms + 128 * TS; LAS bf16_t* PF = XTs + 64 * TS; LAS bf16_t* PB = PF + 64 * TS;
    LAS float* vec = (LAS float*)(PB + 64 * TS);
    constexpr int ZS = 72; LAS bf16_t* Zs = (LAS bf16_t*)(vec + 512); LAS float* dskl = (LAS float*)(Zs + 128 * ZS);
    const int tid = c.tid, lane = c.lane, r = lane & 31, hh = lane >> 5, wave = c.wave;
    for (int unit = c.bid; unit < 256; unit += c.G) {
        const int b = unit >> 7, ch = (unit >> 1) & 63, g = unit & 1;
        const size_t tok0 = (size_t)b * S + ch * 128;
        __syncthreads();
        load_tile128<128>(Cs, CMR + tok0 * 256 + g * 128, 256, tid);
        load_tile128<128>(Ms, BMR + tok0 * 256 + g * 128, 256, tid);
        u32x4 px0, px1, pf0, pf1, pb0, pb1, pz0, pz1; float pvec;
        const int t_r0 = tid >> 4, t_r1 = (tid + 512) >> 4, t_c = (tid & 15) * 8;
#define S3_PREFETCH(H) do { const bf16_t* xt_ = XT + ((size_t)(b * 64 + ch) * 16 + (H)) * 64 * 128; \
            const bf16_t* f_ = PREV + ((((size_t)(0 * 2 + b) * 64 + ch) * 16 + (H)) * 64) * 128; const bf16_t* b_ = PREV + ((((size_t)(1 * 2 + b) * 64 + ch) * 16 + (H)) * 64) * 128; \
            px0 = *(const u32x4*)(xt_ + t_r0 * 128 + t_c); px1 = *(const u32x4*)(xt_ + t_r1 * 128 + t_c); pf0 = *(const u32x4*)(f_ + t_r0 * 128 + t_c); pf1 = *(const u32x4*)(f_ + t_r1 * 128 + t_c); \
            pb0 = *(const u32x4*)(b_ + t_r0 * 128 + t_c); pb1 = *(const u32x4*)(b_ + t_r1 * 128 + t_c); \
            pz0 = *(const u32x4*)(P + (tok0 + (tid >> 3)) * NPROJ + PZ + (H) * 64 + (tid & 7) * 8); pz1 = *(const u32x4*)(P + (tok0 + 64 + (tid >> 3)) * NPROJ + PZ + (H) * 64 + (tid & 7) * 8); \
            { const int v_ = tid >> 7, l_ = tid & 127; const size_t o_ = ((size_t)(v_ & 1) * M + tok0 + l_) * 16 + (H); pvec = (v_ < 2) ? ACS[o_] : DT[o_]; } } while (0)
        S3_PREFETCH(g * 8);
        if (tid < 8) dskl[tid] = p.in[9][g * 8 + tid];
        __syncthreads();
        const int lb = wave & 3, sb0 = 2 * (wave >> 2);
        f32x16 G0 = {}, G1 = {};
#pragma unroll
        for (int ks = 0; ks < 8; ++ks) { const bf16x8 a = ldfrag(Cs, lb * 32 + r, ks * 16 + 8 * hh);
            G0 = __builtin_amdgcn_mfma_f32_32x32x16_bf16(a, ldfrag(Ms, sb0 * 32 + r, ks * 16 + 8 * hh), G0, 0, 0, 0);
            G1 = __builtin_amdgcn_mfma_f32_32x32x16_bf16(a, ldfrag(Ms, (sb0 + 1) * 32 + r, ks * 16 + 8 * hh), G1, 0, 0, 0); }
#pragma unroll 1
        for (int h8 = 0; h8 < 8; ++h8) {
            const int h = g * 8 + h8;
            __syncthreads();
            vec[tid] = pvec;
            *(LAS u32x4*)(XTs + t_r0 * TS + t_c) = px0; *(LAS u32x4*)(XTs + t_r1 * TS + t_c) = px1;
            *(LAS u32x4*)(PF + t_r0 * TS + t_c) = pf0; *(LAS u32x4*)(PF + t_r1 * TS + t_c) = pf1;
            *(LAS u32x4*)(PB + t_r0 * TS + t_c) = pb0; *(LAS u32x4*)(PB + t_r1 * TS + t_c) = pb1;
            *(LAS u32x4*)(Zs + (tid >> 3) * ZS + (tid & 7) * 8) = pz0; *(LAS u32x4*)(Zs + (64 + (tid >> 3)) * ZS + (tid & 7) * 8) = pz1;
            if (h8 < 7) S3_PREFETCH(h + 1);
            const int pbY = wave >> 2;
            __syncthreads();
#pragma unroll
            for (int t2 = 0; t2 < 2; ++t2) { const f32x16& Gt = t2 ? G1 : G0; const int sb = sb0 + t2, s = sb * 32 + r;
                const float afs = vec[s], abs_ = vec[128 + s], dfs = vec[256 + s], dbs = vec[384 + s];
                if (sb < lb) {
#pragma unroll
                    for (int i = 0; i < 16; ++i) { const int l = lb * 32 + (i & 3) + 8 * (i >> 2) + 4 * hh;
                        Ms[l * TS + s] = (bf16_t)f2bf(Gt[i] * __expf(vec[l] - afs) * dfs); }
                } else if (sb > lb) {
#pragma unroll
                    for (int i = 0; i < 16; ++i) { const int l = lb * 32 + (i & 3) + 8 * (i >> 2) + 4 * hh;
                        Ms[l * TS + s] = (bf16_t)f2bf(Gt[i] * __expf(vec[128 + l] - abs_) * dbs); }
                } else {
                    const float dsk = dskl[h8];
#pragma unroll
                    for (int i = 0; i < 16; ++i) { const int l = lb * 32 + (i & 3) + 8 * (i >> 2) + 4 * hh;
                        const float ef = __expf(fminf(vec[l] - afs, 0.f)) * dfs, eb = __expf(fminf(vec[128 + l] - abs_, 0.f)) * dbs;
                        const float tf = (s <= l) ? ef : 0.f, tb = (s >= l) ? eb : 0.f;
                        Ms[l * TS + s] = (bf16_t)f2bf(Gt[i] * (tf + tb) + (s == l ? dsk : 0.f)); }
                } }
            __syncthreads();
            { f32x16 Yd = {}, Yf = {}, Yb = {};
#pragma unroll
              for (int ks = 0; ks < 8; ++ks) { const int k0 = ks * 16 + 8 * hh;
                  Yd = __builtin_amdgcn_mfma_f32_32x32x16_bf16(ldfrag(Ms, lb * 32 + r, k0), ldfrag(XTs, pbY * 32 + r, k0), Yd, 0, 0, 0);
                  const bf16x8 a = ldfrag(Cs, lb * 32 + r, k0);
                  Yf = __builtin_amdgcn_mfma_f32_32x32x16_bf16(a, ldfrag(PF, pbY * 32 + r, k0), Yf, 0, 0, 0);
                  Yb = __builtin_amdgcn_mfma_f32_32x32x16_bf16(a, ldfrag(PB, pbY * 32 + r, k0), Yb, 0, 0, 0);
                  if (ks & 1) __builtin_amdgcn_sched_barrier(0); }
#pragma unroll
              for (int i = 0; i < 16; ++i) { const int l = lb * 32 + (i & 3) + 8 * (i >> 2) + 4 * hh;
                  const float y = Yd[i] + __expf(vec[l]) * Yf[i] + __expf(vec[128 + l]) * Yb[i];
                  const float z = bf2f(Zs[l * ZS + pbY * 32 + r]);
                  Zs[l * ZS + pbY * 32 + r] = (bf16_t)f2bf(y * z * sigmoidf_(z)); } }
            __syncthreads();
            *(u32x4*)(YZ + (tok0 + (tid >> 3)) * 1024 + h * 64 + (tid & 7) * 8) = *(const LAS u32x4*)(Zs + (tid >> 3) * ZS + (tid & 7) * 8);
            *(u32x4*)(YZ + (tok0 + 64 + (tid >> 3)) * 1024 + h * 64 + (tid & 7) * 8) = *(const LAS u32x4*)(Zs + (64 + (tid >> 3)) * ZS + (tid & 7) * 8);
        }
#undef S3_PREFETCH
    }
}

__device__ __forceinline__ void phase_rstd(const Params& p, const Ctx& c) {
    const bf16_t* YZ = (const bf16_t*)(p.ws + WS_YZ); float* RSTD = (float*)(p.ws + WS_RSTD);
    const int gw = c.bid * 8 + c.wave, NGW = c.G * 8;
    for (int m0 = gw * 4; m0 < M; m0 += NGW * 4) {
        u32x4 v[4][2];
#pragma unroll
        for (int q = 0; q < 4; ++q) { const u32x4* r = (const u32x4*)(YZ + (size_t)(m0 + q) * 1024) + c.lane; v[q][0] = r[0]; v[q][1] = r[64]; }
#pragma unroll
        for (int q = 0; q < 4; ++q) { float s = 0.f;
#pragma unroll
            for (int j = 0; j < 2; ++j) { const u32x4 w = v[q][j];
                s += bflo(w.x) * bflo(w.x) + bfhi(w.x) * bfhi(w.x) + bflo(w.y) * bflo(w.y) + bfhi(w.y) * bfhi(w.y) + bflo(w.z) * bflo(w.z) + bfhi(w.z) * bfhi(w.z) + bflo(w.w) * bflo(w.w) + bfhi(w.w) * bfhi(w.w); }
            s = wave_sum(s);
            if (c.lane == 0) RSTD[m0 + q] = rsqrtf(s * (1.f / 1024.f) + EPS); }
    }
}

namespace attn8 {
typedef int v8i __attribute__((ext_vector_type(8)));
typedef float f32x16 __attribute__((ext_vector_type(16)));
typedef unsigned u32x4_ __attribute__((ext_vector_type(4)));
constexpr int QBLK = 32, KVBLK = 64;
constexpr float SCALE = 0.088388347648318440f;
constexpr float THR = 0.69f;
constexpr size_t SHM_K = 64 * 128, SHM_V = 128 * 64, SHM_ATTN = 2 * SHM_K + 2 * SHM_V + 8 * 64 * 4;
__device__ __forceinline__ int crow(int r, int hi) { return (r & 3) + 8 * (r >> 2) + 4 * hi; }
__device__ __forceinline__ int kswz(int row, int colB) { return row * 128 + (colB ^ (((row >> 1) & 7) << 4)); }
__device__ __forceinline__ int vswz(int d, int slot) { return d * 64 + ((slot ^ ((d >> 2) & 3)) << 4); }
__device__ __forceinline__ v8i cat8(const u32x4_& lo, const u32x4_& hi) { v8i r; r[0] = (int)lo.x; r[1] = (int)lo.y; r[2] = (int)lo.z; r[3] = (int)lo.w; r[4] = (int)hi.x; r[5] = (int)hi.y; r[6] = (int)hi.z; r[7] = (int)hi.w; return r; }
template <bool LAST> __device__ __forceinline__ void mfma8(f32x16& acc, const v8i& a, const v8i& b, int scl) {
    acc = __builtin_amdgcn_mfma_scale_f32_32x32x64_f8f6f4(a, b, acc, 0, 0, 0, scl, 0, scl);
}
__device__ __forceinline__ void partialSM(f32x16& p0, f32x16& p1, float& m_reg, float& mn, float& alpha) {
    constexpr float C = SCALE * 1.4426950408889634f;
    float pmax = p0[0];
#pragma unroll
    for (int r = 1; r < 16; ++r) pmax = fmaxf(pmax, p0[r]);
#pragma unroll
    for (int r = 0; r < 16; ++r) pmax = fmaxf(pmax, p1[r]);
    { auto rr = __builtin_amdgcn_permlane32_swap(__float_as_uint(pmax), __float_as_uint(pmax), false, false); pmax = fmaxf(__uint_as_float(rr[0]), __uint_as_float(rr[1])); }
    if (__builtin_expect(__all(pmax - m_reg <= THR / SCALE), 1)) { mn = m_reg; alpha = 1.f; }
    else { mn = fmaxf(m_reg, pmax); alpha = __builtin_amdgcn_exp2f((m_reg - mn) * C); m_reg = mn; }
    const float mnC = 7.f - mn * C;
#pragma unroll
    for (int r = 0; r < 16; ++r) p0[r] = fmaf(p0[r], C, mnC);
#pragma unroll
    for (int r = 0; r < 16; ++r) p1[r] = fmaf(p1[r], C, mnC);
#pragma unroll
    for (int r = 0; r < 16; ++r) p0[r] = __builtin_amdgcn_exp2f(p0[r]);
}
__device__ __forceinline__ void finishSM(f32x16& p0, f32x16& p1, float alpha, float& l_reg, v8i& pa) {
#pragma unroll
    for (int r = 0; r < 16; ++r) p1[r] = __builtin_amdgcn_exp2f(p1[r]);
    float ps = 0;
#pragma unroll
    for (int r = 0; r < 16; ++r) ps += p0[r];
#pragma unroll
    for (int r = 0; r < 16; ++r) ps += p1[r];
    { auto rr = __builtin_amdgcn_permlane32_swap(__float_as_uint(ps), __float_as_uint(ps), false, false); ps = __uint_as_float(rr[0]) + __uint_as_float(rr[1]); }
    l_reg = l_reg * alpha + ps;
#pragma unroll
    for (int w = 0; w < 4; ++w) { pa[w] = (int)pack4_fp8(p0[4 * w], p0[4 * w + 1], p0[4 * w + 2], p0[4 * w + 3]); pa[4 + w] = (int)pack4_fp8(p1[4 * w], p1[4 * w + 1], p1[4 * w + 2], p1[4 * w + 3]); }
}
__device__ __forceinline__ void qkt(f32x16& p0, f32x16& p1, const char* Ks, const v8i* qf, int r32, int hi, int scl) {
    p0 = f32x16{}; p1 = f32x16{};
#pragma unroll
    for (int s = 0; s < 2; ++s) { const int cb = 64 * s + 32 * hi;
        const v8i a0 = cat8(*(const u32x4_*)(Ks + kswz(r32, cb)), *(const u32x4_*)(Ks + kswz(r32, cb + 16)));
        const v8i a1 = cat8(*(const u32x4_*)(Ks + kswz(32 + r32, cb)), *(const u32x4_*)(Ks + kswz(32 + r32, cb + 16)));
        if (s == 0) { mfma8<false>(p0, a0, qf[s], scl); mfma8<false>(p1, a1, qf[s], scl); }
        else { mfma8<false>(p0, a0, qf[s], scl); mfma8<true>(p1, a1, qf[s], scl); } }
}
__device__ __forceinline__ void pv(f32x16* o, const char* Vs, const v8i& pa, int r32, int hi, int scl) {
#pragma unroll
    for (int d0 = 0; d0 < 4; ++d0) { const int d = d0 * 32 + r32;
        const v8i b = cat8(*(const u32x4_*)(Vs + vswz(d, 2 * hi)), *(const u32x4_*)(Vs + vswz(d, 2 * hi + 1)));
        if (d0 == 3) mfma8<true>(o[d0], pa, b, scl); else mfma8<false>(o[d0], pa, b, scl); }
}
__device__ __forceinline__ void body(const unsigned char* __restrict__ Qb, const unsigned char* __restrict__ Kh, const unsigned char* __restrict__ Vt, unsigned short* __restrict__ Ob, int seq, char* lds) {
    const int tid = threadIdx.x, wid = tid >> 6, lane = tid & 63, r32 = lane & 31, hi = lane >> 5;
    const int scl = 0x7f7f7f7f;
    float* ws = (float*)(lds + 65536) + wid * 64; float* li_l = ws; float* al_l = ws + 32;
    float m_reg = -1e30f, l_reg = 0; f32x16 o[4] = {}; v8i qf[2];
    { const unsigned char* Qw = Qb + (long)(wid * QBLK + r32) * 1024 + 32 * hi;
#pragma unroll
      for (int s = 0; s < 2; ++s) qf[s] = cat8(*(const u32x4_*)(Qw + 64 * s), *(const u32x4_*)(Qw + 64 * s + 16)); }
    const int kr = tid >> 3, kc = (tid & 7) * 16, kdst = kswz(kr, kc);
    const int vd = tid >> 2, vsl = tid & 3, vdst = vswz(vd, vsl);
    struct { u32x4_ k, v; } sr_[2];
#define SLOAD(i, t) do { sr_[i].k = *(const u32x4_*)(Kh + (long)((t) * KVBLK + kr) * 256 + kc); sr_[i].v = *(const u32x4_*)(Vt + (long)(t) * 8192 + vd * 64 + vsl * 16); } while (0)
#define SWRITE(t, i) do { char* s_ = lds + ((t) & 3) * 16384; *(u32x4_*)(s_ + kdst) = sr_[i].k; *(u32x4_*)(s_ + 8192 + vdst) = sr_[i].v; } while (0)
#define KS(t) (lds + ((t) & 3) * 16384)
#define VS(t) (lds + ((t) & 3) * 16384 + 8192)
#define SWAIT() asm volatile("s_waitcnt vmcnt(2)" ::: "memory")
#define RESC(a) do { if (__any((a) < 1.f)) { if (hi == 0) al_l[r32] = (a); asm volatile("s_waitcnt lgkmcnt(0)" ::: "memory"); \
    _Pragma("unroll") for (int d = 0; d < 4; ++d) _Pragma("unroll") for (int r = 0; r < 16; ++r) o[d][r] *= al_l[crow(r, hi)]; } } while (0)
#define SBAR_() __builtin_amdgcn_sched_barrier(0)
    f32x16 pA0, pA1, pB0, pB1; float mnA, mnB, alA, alB; v8i pa; const int NT = seq / KVBLK;
    SLOAD(0, 0); asm volatile("s_waitcnt vmcnt(0)" ::: "memory"); SWRITE(0, 0); __syncthreads();
    qkt(pA0, pA1, KS(0), qf, r32, hi, scl); partialSM(pA0, pA1, m_reg, mnA, alA);
    SLOAD(1, 1); if (2 < NT) SLOAD(0, 2);
    SWAIT(); SWRITE(1, 1); __syncthreads();
    for (int j = 1; j + 1 < NT; j += 2) {
        SBAR_(); qkt(pB0, pB1, KS(j), qf, r32, hi, scl);
        finishSM(pA0, pA1, alA, l_reg, pa); SBAR_();
        SLOAD(1, j + 2); SBAR_();
        pv(o, VS(j - 1), pa, r32, hi, scl); partialSM(pB0, pB1, m_reg, mnB, alB);
        SWAIT(); SWRITE(j + 1, 0);
        RESC(alB); __syncthreads();
        SBAR_(); qkt(pA0, pA1, KS(j + 1), qf, r32, hi, scl);
        finishSM(pB0, pB1, alB, l_reg, pa); SBAR_();
        if (j + 3 < NT) SLOAD(0, j + 3); SBAR_();
        pv(o, VS(j), pa, r32, hi, scl); partialSM(pA0, pA1, m_reg, mnA, alA);
        SWAIT(); SWRITE(j + 2, 1);
        RESC(alA); __syncthreads();
    }
    SBAR_(); qkt(pB0, pB1, KS(NT - 1), qf, r32, hi, scl);
    finishSM(pA0, pA1, alA, l_reg, pa); SBAR_();
    pv(o, VS(NT - 2), pa, r32, hi, scl); partialSM(pB0, pB1, m_reg, mnB, alB);
    __syncthreads(); RESC(alB);
    finishSM(pB0, pB1, alB, l_reg, pa); SBAR_();
    pv(o, VS(NT - 1), pa, r32, hi, scl);
    if (hi == 0) li_l[r32] = l_reg; asm volatile("s_waitcnt lgkmcnt(0)" ::: "memory");
    float rli[16];
#pragma unroll
    for (int r = 0; r < 16; ++r) rli[r] = __builtin_amdgcn_rcpf(li_l[crow(r, hi)]);
    unsigned short* Ow = Ob + (long)(wid * QBLK) * 1024;
#pragma unroll
    for (int r = 0; r < 16; ++r) { const int orow = crow(r, hi);
#pragma unroll
        for (int d0 = 0; d0 < 4; ++d0) Ow[(long)orow * 1024 + d0 * 32 + r32] = (unsigned short)f2bf(o[d0][r] * rli[r]); }
#undef KS
#undef VS
#undef SLOAD
#undef SWRITE
#undef SWAIT
#undef RESC
#undef SBAR_
}
}
__device__ __forceinline__ void phase_attn(const Params& p, const Ctx& c, char* lds_generic) {
    unsigned char* ws = p.ws;
    const unsigned char* Q8 = ws + WS_QN; const unsigned char* K8 = ws + WS_KN; const unsigned char* VT8 = ws + WS_VB; bf16_t* AO = (bf16_t*)(ws + WS_AO);
    for (int item = c.bid; item < 512; item += c.G) {
        const int b = item >> 8, h = (item >> 5) & 7, qb = item & 31, kvh = h >> 2;
        const size_t qrow = (size_t)b * S + qb * 256;
        attn8::body(Q8 + qrow * 1024 + h * 128, K8 + (size_t)b * S * 256 + kvh * 128, VT8 + (size_t)(b * 2 + kvh) * 128 * 8192, AO + qrow * 1024 + h * 128, S, lds_generic);
        __syncthreads();
    }
}

__device__ __forceinline__ void phase_router(const Params& p, const Ctx& c) {
    unsigned char* ws = p.ws;
    LAS float* wT = (LAS float*)c.lds;
    LAS int* tokE = (LAS int*)(c.lds + LDS_CTL + 512);
    LAS float* tokW = (LAS float*)(c.lds + LDS_CTL + 512 + 1024);
    LAS int* lcnt = (LAS int*)(c.lds + LDS_CTL + 512 + 2048);
    LAS int* lbase = lcnt + 32;
    LAS int* lrank = lbase + 32;
    const bf16_t* X1 = (const bf16_t*)(ws + WS_X1); unsigned char* H2 = ws + WS_H2;
    int* CNT = (int*)(ws + WS_CTL); int* TOKES = (int*)(ws + WS_TOKES); float* TOKW = (float*)(ws + WS_TOKW); int* LIST = (int*)(ws + WS_LIST);
    const int tid = c.tid, lane = c.lane;
    __syncthreads();
    { const f32x4* src = (const f32x4*)(ws + WS_WRT);
      f32x4 wv[16];
#pragma unroll
      for (int i = 0; i < 16; ++i) wv[i] = src[tid + 512 * i];
#pragma unroll
      for (int i = 0; i < 16; ++i) ((LAS f32x4*)wT)[tid + 512 * i] = wv[i]; }
    __syncthreads();
    f32x4 gv[4];
#pragma unroll
    for (int j = 0; j < 4; ++j) gv[j] = *(const f32x4*)(p.in[16] + (j >> 1) * 512 + 8 * lane + (j & 1) * 4);
    const float bias_e = p.in[18][(lane >> 1) & 31];
    for (int blk = c.bid; blk < M / 64; blk += c.G) {
        if (tid < 32) lcnt[tid] = 0;
        for (int pr = 0; pr < 4; ++pr) {
            const int tl = c.wave * 8 + pr * 2;
            const size_t tokA = (size_t)blk * 64 + tl;
            f32x4 hA[4], hB[4];
            {
                const u32x4* xa = (const u32x4*)(X1 + tokA * 1024) + lane; const u32x4* xb = xa + 128;
                float sa = 0.f, sb = 0.f;
                { const u32x4 a0 = xa[0], a1 = xa[64], b0 = xb[0], b1 = xb[64];
                  hA[0] = (f32x4){bflo(a0.x), bfhi(a0.x), bflo(a0.y), bfhi(a0.y)}; hA[1] = (f32x4){bflo(a0.z), bfhi(a0.z), bflo(a0.w), bfhi(a0.w)};
                  hA[2] = (f32x4){bflo(a1.x), bfhi(a1.x), bflo(a1.y), bfhi(a1.y)}; hA[3] = (f32x4){bflo(a1.z), bfhi(a1.z), bflo(a1.w), bfhi(a1.w)};
                  hB[0] = (f32x4){bflo(b0.x), bfhi(b0.x), bflo(b0.y), bfhi(b0.y)}; hB[1] = (f32x4){bflo(b0.z), bfhi(b0.z), bflo(b0.w), bfhi(b0.w)};
                  hB[2] = (f32x4){bflo(b1.x), bfhi(b1.x), bflo(b1.y), bfhi(b1.y)}; hB[3] = (f32x4){bflo(b1.z), bfhi(b1.z), bflo(b1.w), bfhi(b1.w)}; }
#pragma unroll
                for (int j = 0; j < 4; ++j) {
                    sa += (hA[j].x * hA[j].x + hA[j].y * hA[j].y) + (hA[j].z * hA[j].z + hA[j].w * hA[j].w);
                    sb += (hB[j].x * hB[j].x + hB[j].y * hB[j].y) + (hB[j].z * hB[j].z + hB[j].w * hB[j].w); }
                const float ra = rsqrtf(wave_sum(sa) * (1.f / 1024.f) + EPS), rb = rsqrtf(wave_sum(sb) * (1.f / 1024.f) + EPS);
#pragma unroll
                for (int j = 0; j < 4; ++j) { hA[j] = hA[j] * ra * gv[j]; hB[j] = hB[j] * rb * gv[j]; }
                u32x2* oa = (u32x2*)(H2 + tokA * 1024) + lane; u32x2* ob = oa + 128;
#pragma unroll
                for (int j2 = 0; j2 < 2; ++j2) { u32x2 w;
                    w.x = pack4_fp8(8.f * hA[2 * j2].x, 8.f * hA[2 * j2].y, 8.f * hA[2 * j2].z, 8.f * hA[2 * j2].w); w.y = pack4_fp8(8.f * hA[2 * j2 + 1].x, 8.f * hA[2 * j2 + 1].y, 8.f * hA[2 * j2 + 1].z, 8.f * hA[2 * j2 + 1].w); oa[64 * j2] = w;
                    w.x = pack4_fp8(8.f * hB[2 * j2].x, 8.f * hB[2 * j2].y, 8.f * hB[2 * j2].z, 8.f * hB[2 * j2].w); w.y = pack4_fp8(8.f * hB[2 * j2 + 1].x, 8.f * hB[2 * j2 + 1].y, 8.f * hB[2 * j2 + 1].z, 8.f * hB[2 * j2 + 1].w); ob[64 * j2] = w; }
            }
            float accA[32], accB[32];
#pragma unroll
            for (int e = 0; e < 32; ++e) {
                float a = 0.f, b = 0.f;
#pragma unroll
                for (int j = 0; j < 4; ++j) { const f32x4 w = *(const LAS f32x4*)&wT[e * 1024 + (j >> 1) * 512 + 8 * lane + (j & 1) * 4];
                    a = fmaf(hA[j].x, w.x, a); a = fmaf(hA[j].y, w.y, a); a = fmaf(hA[j].z, w.z, a); a = fmaf(hA[j].w, w.w, a);
                    b = fmaf(hB[j].x, w.x, b); b = fmaf(hB[j].y, w.y, b); b = fmaf(hB[j].z, w.z, b); b = fmaf(hB[j].w, w.w, b); }
                accA[e] = a; accB[e] = b;
                if (e & 1) __builtin_amdgcn_sched_barrier(0);
            }
#define RSTEP(N, BIT) _Pragma("unroll") for (int i = 0; i < N; ++i) { const bool up = (lane & BIT) != 0; \
                const float ka = up ? accA[N + i] : accA[i], sa_ = up ? accA[i] : accA[N + i]; accA[i] = ka + __shfl_xor(sa_, BIT); \
                const float kb = up ? accB[N + i] : accB[i], sb_ = up ? accB[i] : accB[N + i]; accB[i] = kb + __shfl_xor(sb_, BIT); }
            RSTEP(16, 32) RSTEP(8, 16) RSTEP(4, 8) RSTEP(2, 4) RSTEP(1, 2)
#undef RSTEP
            const float la = accA[0] + __shfl_xor(accA[0], 1) + bias_e, lb = accB[0] + __shfl_xor(accB[0], 1) + bias_e;
            const int my_e = (lane >> 1) & 31;
#pragma unroll
            for (int t2 = 0; t2 < 2; ++t2) {
                float val = t2 ? lb : la;
                int se[4]; float sv[4];
#pragma unroll
                for (int k = 0; k < 4; ++k) {
                    const float mx = wave_max(val);
                    const int sel = wave_min_i(val == mx ? my_e : 64);
                    se[k] = sel & 31; sv[k] = mx;
                    if (my_e == sel) val = -INFINITY;
                }
                const float e1 = __expf(sv[1] - sv[0]), e2 = __expf(sv[2] - sv[0]), e3 = __expf(sv[3] - sv[0]);
                const float inv = 1.f / (1.f + e1 + e2 + e3);
                if (lane == 0) {
                    const int t = tl + t2;
                    tokE[t * 4 + 0] = se[0]; tokE[t * 4 + 1] = se[1]; tokE[t * 4 + 2] = se[2]; tokE[t * 4 + 3] = se[3];
                    tokW[t * 4 + 0] = inv; tokW[t * 4 + 1] = e1 * inv; tokW[t * 4 + 2] = e2 * inv; tokW[t * 4 + 3] = e3 * inv;
                }
            }
        }
        __syncthreads();
        if (tid < 256) lrank[tid] = atomicAdd((int*)&lcnt[tokE[tid]], 1);
        __syncthreads();
        if (tid < 32) lbase[tid] = lcnt[tid] ? atomicAdd(&CNT[tid], lcnt[tid]) : 0;
        __syncthreads();
        if (tid < 256) {
            const int e = tokE[tid], slot = lbase[e] + lrank[tid], tok = blk * 64 + (tid >> 2);
            LIST[e * 16384 + slot] = tok; TOKES[tok * 4 + (tid & 3)] = (e << 16) | slot; TOKW[tok * 4 + (tid & 3)] = tokW[tid];
        }
        __syncthreads();
    }
}

__device__ __forceinline__ void load_offs(const Params& p, const Ctx& c, LAS int*& offs, LAS int*& cnt) {
    offs = (LAS int*)(c.lds + LDS_CTL); cnt = offs + 40;
    __syncthreads();
    if (c.tid == 0) {
        const int* CNT = (const int*)(p.ws + WS_CTL); int run = 0;
        for (int e = 0; e < 32; ++e) { const int n = __hip_atomic_load(CNT + e, __ATOMIC_RELAXED, __HIP_MEMORY_SCOPE_AGENT); cnt[e] = n; offs[e] = run; run += (n + 255) & ~255; }
        offs[32] = run;
    }
    __syncthreads();
    if (c.tid < 320) { int e = 0; while (e < 31 && c.tid * 256 >= offs[e + 1]) ++e; offs[80 + c.tid] = e; }
    __syncthreads();
}
__device__ __forceinline__ void phase_gemm1(const Params& p, const Ctx& c) {
    pg8::Gemm g{(const bf16_t*)(p.ws + WS_H), (const bf16_t*)(p.ws + WS_WINT), M, PDT, 1024};
    pg8::StaticOrder S; S.init(M, PDT, c.G, c.bid);
    pg8::EpiStore E{(bf16_t*)(p.ws + WS_P), NPROJ};
    pg8::gemm_phase<pg8::EpiStore, pg8::StaticOrder, true, true>(c.lds, g, S, E);
}
__device__ __forceinline__ void phase_tail12(const Params& p, const Ctx& c) {
    unsigned char* ws = p.ws;
    pg8::TailOrder S; S.so.init(M, 1024, c.G, c.bid);
    pg8::Gemm g{(const bf16_t*)(ws + WS_YZ), (const bf16_t*)(ws + WS_WST), 2 * M, 2048, 1024};
    pg8::EpiT12 E{(bf16_t*)(ws + WS_T1), (bf16_t*)(ws + WS_MG), (const bf16_t*)(ws + WS_P) + PG, NPROJ, (const float*)(ws + WS_RSTD)};
    pg8::gemm_phase<pg8::EpiT12, pg8::TailOrder, true, true>(c.lds, g, S, E);
}
__device__ __forceinline__ void phase_tail3(const Params& p, const Ctx& c) {
    unsigned char* ws = p.ws;
    pg8::StaticOrder S; S.init(M, 1024, c.G, c.bid);
    pg8::Gemm g{(const bf16_t*)(ws + WS_MG), (const bf16_t*)(ws + WS_WOT), M, 1024, 1024};
    pg8::EpiT3b E{(bf16_t*)(ws + WS_X1), p.in[0]};
    pg8::gemm_phase<pg8::EpiT3b, pg8::StaticOrder, true, true>(c.lds, g, S, E);
}
__device__ __forceinline__ void phase_moe1(const Params& p, const Ctx& c) {
    LAS int* offs; LAS int* cnt; load_offs(p, c, offs, cnt);
    unsigned char* ws = p.ws;
    pg8::Gemm g{(const bf16_t*)(ws + WS_H2), (const bf16_t*)(ws + WS_W1T), M, 32 * 2048, 512};
    pg8::MoeGatherOrder S{offs, cnt, offs + 80, (const int*)(ws + WS_LIST), c.G, c.bid, offs[32] / 256};
    pg8::EpiAct8 E{(unsigned char*)(ws + WS_ACT), p.in[20]};
    pg8::gemm_phase_gather_f8<pg8::EpiAct8, pg8::MoeGatherOrder>(c.lds, g, S, E);
}
__device__ __forceinline__ void phase_moe2(const Params& p, const Ctx& c) {
    LAS int* offs; LAS int* cnt; load_offs(p, c, offs, cnt);
    unsigned char* ws = p.ws;
    pg8::Gemm g{(const bf16_t*)(ws + WS_ACT), (const bf16_t*)(ws + WS_W2T), ROWS_MAX, 32 * 1024, 512};
    pg8::MoeOrder<4> S{offs + 80, c.G, c.bid, offs[32] / 256};
    pg8::EpiY8 E{(bf16_t*)(ws + WS_YB), p.in[22]};
    pg8::gemm_phase_f8<pg8::EpiY8, pg8::MoeOrder<4>, true, true>(c.lds, g, S, E);
}

__device__ __forceinline__ void phase_combine(const Params& p, const Ctx& c) {
    LAS int* offs; LAS int* cnt; load_offs(p, c, offs, cnt);
    unsigned char* ws = p.ws;
    const bf16_t* X1 = (const bf16_t*)(ws + WS_X1); const bf16_t* YB = (const bf16_t*)(ws + WS_YB);
    const int* TOKES = (const int*)(ws + WS_TOKES); const float* TOKW = (const float*)(ws + WS_TOKW);
    const int gw = c.bid * 8 + c.wave, NGW = c.G * 8, lane = c.lane;
    f32x4 gv[4];
#pragma unroll
    for (int j = 0; j < 4; ++j) gv[j] = ((const f32x4*)p.in[23])[lane + 64 * j];
    for (int m0 = gw * 2; m0 < M; m0 += NGW * 2) {
        int es[2][4]; float wq[2][4];
#pragma unroll
        for (int t = 0; t < 2; ++t)
#pragma unroll
            for (int k = 0; k < 4; ++k) { es[t][k] = TOKES[(m0 + t) * 4 + k]; wq[t][k] = TOKW[(m0 + t) * 4 + k]; }
        f32x4 v[2][4]; u32x2 y[2][4][4];
#pragma unroll
        for (int t = 0; t < 2; ++t) { const u32x2* xr = (const u32x2*)(X1 + (size_t)(m0 + t) * 1024) + lane;
#pragma unroll
            for (int j = 0; j < 4; ++j) { const u32x2 xx = xr[64 * j]; v[t][j] = (f32x4){bflo(xx.x), bfhi(xx.x), bflo(xx.y), bfhi(xx.y)}; }
#pragma unroll
            for (int k = 0; k < 4; ++k) { const int row = offs[es[t][k] >> 16] + (es[t][k] & 0xffff); const u32x2* yr = (const u32x2*)(YB + (size_t)row * 1024) + lane;
#pragma unroll
                for (int j = 0; j < 4; ++j) y[t][k][j] = yr[64 * j]; } }
#pragma unroll
        for (int t = 0; t < 2; ++t) {
#pragma unroll
            for (int k = 0; k < 4; ++k) { const float w = wq[t][k];
#pragma unroll
                for (int j = 0; j < 4; ++j) { const u32x2 yy = y[t][k][j];
                    v[t][j].x = fmaf(w, bflo(yy.x), v[t][j].x); v[t][j].y = fmaf(w, bfhi(yy.x), v[t][j].y); v[t][j].z = fmaf(w, bflo(yy.y), v[t][j].z); v[t][j].w = fmaf(w, bfhi(yy.y), v[t][j].w); } }
            float s = 0.f;
#pragma unroll
            for (int j = 0; j < 4; ++j) s += (v[t][j].x * v[t][j].x + v[t][j].y * v[t][j].y) + (v[t][j].z * v[t][j].z + v[t][j].w * v[t][j].w);
            const float rstd = rsqrtf(wave_sum(s) * (1.f / 1024.f) + EPS);
            f32x4* o = (f32x4*)(p.out + (size_t)(m0 + t) * 1024) + lane;
#pragma unroll
            for (int j = 0; j < 4; ++j) o[64 * j] = v[t][j] * rstd * gv[j];
        }
    }
}

#define XB_TMO      128
#define XB_XCNT(j)  (256  + 64 * (j))
#define XB_XSUB(j)  (1280 + 64 * (j))
#define XB_XGEN(j)  (2304 + 64 * (j))
#define XB_TOP      3328
#define XB_TOPGEN   3392
#define XCD_BAR_WORDS 3456
#define XB_SPIN_CAP (1u << 18)

__device__ __forceinline__ unsigned xb_ld(unsigned* p)              { return __hip_atomic_load(p, __ATOMIC_RELAXED, __HIP_MEMORY_SCOPE_AGENT); }
__device__ __forceinline__ unsigned xb_add(unsigned* p, unsigned v) { return __hip_atomic_fetch_add(p, v, __ATOMIC_RELAXED, __HIP_MEMORY_SCOPE_AGENT); }
__device__ __forceinline__ unsigned xb_xcc_id() { return (unsigned)__builtin_amdgcn_s_getreg((3 << 11) | 20) & 0xFu; }
#define XB_SPIN(cond, bar) do { unsigned _sp = 0; while (cond) { __builtin_amdgcn_s_sleep(1); \
    if ((++_sp & 255u) == 0u) { if (xb_ld(&(bar)[XB_TMO])) break; if (_sp > XB_SPIN_CAP) { atomicAdd(&(bar)[XB_TMO], 1u); break; } } } } while (0)

struct XcdBarrier {
    unsigned* bar; unsigned x;
    volatile LAS unsigned* st;
};

__device__ __forceinline__ XcdBarrier xcd_barrier_post(unsigned* bar, volatile LAS unsigned* st) {
    XcdBarrier b; b.bar = bar; b.x = xb_xcc_id(); b.st = st;
    if (threadIdx.x == 0) (void)xb_add(&bar[XB_XCNT(b.x)], 1u);
    return b;
}
__device__ __forceinline__ void xcd_barrier_complete(unsigned* bar, unsigned x, unsigned& nloc, unsigned& nx) {
    const unsigned G = gridDim.x * gridDim.y * gridDim.z;
    unsigned sum, cnt, mine, sp = 0u;
    for (;;) {
        sum = 0u; cnt = 0u; mine = 0u;
#pragma unroll
        for (unsigned j = 0; j < 16; ++j) { const unsigned c = xb_ld(&bar[XB_XCNT(j)]); sum += c; cnt += (c > 0u) ? 1u : 0u; mine = (j == x) ? c : mine; }
        if (sum == G) break;
        __builtin_amdgcn_s_sleep(1);
        if ((++sp & 255u) == 0u) { if (xb_ld(&bar[XB_TMO])) break; if (sp > XB_SPIN_CAP) { atomicAdd(&bar[XB_TMO], 1u); break; } }
    }
    nloc = mine > 0u ? mine : 1u; nx = cnt > 0u ? cnt : 1u;
}

__device__ __forceinline__ void xcd_barrier(const XcdBarrier& b) {
    asm volatile("s_waitcnt vmcnt(0)" ::: "memory");
    __syncthreads();
    if (threadIdx.x == 0) {
        unsigned* bar = b.bar;
        __builtin_amdgcn_s_waitcnt(0);
        unsigned nloc = b.st[0], nx = b.st[1];
        if (nloc == 0u) { xcd_barrier_complete(bar, b.x, nloc, nx); b.st[0] = nloc; b.st[1] = nx; }
        const unsigned old = xb_add(&bar[XB_XSUB(b.x)], 1u);
        const unsigned gen = old / nloc;
        if (old + 1u == (gen + 1u) * nloc) {
            __builtin_amdgcn_fence(__ATOMIC_RELEASE, "agent");
            asm volatile("s_waitcnt vmcnt(0)" ::: "memory");
            const unsigned og = xb_add(&bar[XB_TOP], 1u);
            const unsigned tg = og / nx;
            if (og + 1u == (tg + 1u) * nx) xb_add(&bar[XB_TOPGEN], 1u);
            else XB_SPIN(xb_ld(&bar[XB_TOPGEN]) == tg, bar);
            __builtin_amdgcn_fence(__ATOMIC_ACQUIRE, "agent");
            xb_add(&bar[XB_XGEN(b.x)], 1u);
            asm volatile("s_waitcnt vmcnt(0)" ::: "memory");
        } else {
            XB_SPIN(xb_ld(&bar[XB_XGEN(b.x)]) == gen, bar);
            __builtin_amdgcn_fence(__ATOMIC_ACQUIRE, "agent");
            asm volatile("s_waitcnt vmcnt(0)" ::: "memory");
        }
    }
    __syncthreads();
}

constexpr int NPHASE = 13;
__global__ void __launch_bounds__(512) mega(Params p) {
    extern __shared__ __attribute__((aligned(16))) unsigned char lds_raw[];
    Ctx c; c.tid = threadIdx.x; c.lane = c.tid & 63; c.wave = __builtin_amdgcn_readfirstlane(c.tid >> 6); c.bid = blockIdx.x; c.G = gridDim.x;
    c.lds = (LAS unsigned char*)lds_raw;
    cg::grid_group grid = cg::this_grid();
    if (c.tid < 2) ((volatile LAS unsigned*)(c.lds + LDS_BARST))[c.tid] = 0u;
    __syncthreads();
#define SEAM(k) do { XcdBarrier b_; b_.bar = (unsigned*)(p.ws + WS_BAR); b_.x = xb_xcc_id(); b_.st = (volatile LAS unsigned*)(c.lds + LDS_BARST); xcd_barrier(b_); } while (0)
    if (p.ph_lo < 0) grid.sync();
    (void)xcd_barrier_post((unsigned*)(p.ws + WS_BAR), (volatile LAS unsigned*)(c.lds + LDS_BARST));
#define RUN(k, call) if (p.ph_lo <= (k) && (k) < p.ph_hi) { call; if ((k) + 1 < p.ph_hi) SEAM(k); }
    RUN(0, phase_prep(p, c))
    RUN(1, phase_gemm1(p, c))
    RUN(2, phase_conv(p, c))
    RUN(3, phase_ssd_states(p, c))
    RUN(4, phase_ssd_scan(p, c))
    RUN(5, phase_ssd_out(p, c))
    RUN(6, phase_rstd(p, c); phase_attn(p, c, (char*)lds_raw))
    RUN(7, phase_tail12(p, c))
    RUN(8, phase_tail3(p, c))
    RUN(9, phase_router(p, c))
    RUN(10, phase_moe1(p, c))
    RUN(11, phase_moe2(p, c))
    RUN(12, phase_combine(p, c))
#undef RUN
}

extern "C" void kernel_launch(void* const* d_in, const int* in_sizes, int n_in, void* d_out, int out_size, void* d_ws, size_t ws_size, hipStream_t stream) {
    static int ok = 0; static int grid_blocks = 0;
    if (ok == 0) {
        if (n_in != 24 || out_size != M * D || ws_size < WS_END) { fprintf(stderr, "kernel_launch: unexpected shapes: n_in %d out %d ws %zu (need %zu)\n", n_in, out_size, ws_size, (size_t)WS_END); ok = -1; return; }
        if (hipFuncSetAttribute((const void*)mega, hipFuncAttributeMaxDynamicSharedMemorySize, LDS_BYTES) != hipSuccess) { fprintf(stderr, "kernel_launch: hipFuncSetAttribute failed\n"); ok = -1; return; }
        int dev = 0, cus = 0, per_cu = 0;
        hipGetDevice(&dev);
        hipDeviceGetAttribute(&cus, hipDeviceAttributeMultiprocessorCount, dev);
        hipOccupancyMaxActiveBlocksPerMultiprocessor(&per_cu, (const void*)mega, 512, LDS_BYTES);
        if (per_cu < 1 || cus < 1) { fprintf(stderr, "kernel_launch: occupancy query gave %d blocks/CU on %d CUs\n", per_cu, cus); ok = -1; return; }
        grid_blocks = cus;
        ok = 1;
    }
    if (ok < 0) return;
    Params p{};
    for (int i = 0; i < 24; ++i) p.in[i] = (const float*)d_in[i];
    p.out = (float*)d_out; p.ws = (unsigned char*)d_ws;
    p.ph_lo = 0; p.ph_hi = NPHASE;
    if (hipMemsetAsync((char*)d_ws + WS_BAR, 0, 16384, stream) != hipSuccess) { fprintf(stderr, "kernel_launch: hipMemsetAsync of the barrier words failed\n"); return; }
    void* args[] = {&p};
    hipError_t e = hipLaunchCooperativeKernel((const void*)mega, dim3(grid_blocks), dim3(512), args, LDS_BYTES, stream);
    if (e != hipSuccess) fprintf(stderr, "kernel_launch: cooperative launch failed: %s (grid %d)\n", hipGetErrorString(e), grid_blocks);
}
```

```cpp
#include <hip/hip_runtime.h>
#include <hip/hip_cooperative_groups.h>
#include <cstdio>
#include <cstdint>

namespace cg = cooperative_groups;
#define LAS __attribute__((address_space(3)))
typedef unsigned short bf16_t;
typedef unsigned u32x4 __attribute__((ext_vector_type(4)));
typedef unsigned u32x2 __attribute__((ext_vector_type(2)));
typedef float f32x4 __attribute__((ext_vector_type(4)));

constexpr int NB = 2, S = 8192, D = 1024, M = NB * S;
constexpr int NPROJ = 6400;
constexpr int PZ = 0, PXBC = 1024, PQ = 2560, PK = 3584, PV = 3840, PG = 4096, PDT = 6144;
constexpr int ROWS_MAX = 65536 + 32 * 256;
constexpr float EPS = 1e-6f;

constexpr size_t al256(size_t x) { return (x + 255) / 256 * 256; }
constexpr size_t WS_CTL = 0;
constexpr size_t WS_BAR = 4096;
constexpr size_t WS_ROPE = 4096 + 16384;
constexpr size_t WS_WRT = WS_ROPE + 32768;
constexpr size_t WS_WINT = WS_WRT + 131072;
constexpr size_t WS_WST = WS_WINT + (size_t)NPROJ * 1024 * 2;
constexpr size_t WS_WAT = WS_WST + 2097152;
constexpr size_t WS_WOT = WS_WAT + 2097152;
constexpr size_t WS_W1T = WS_WOT + 2097152;
constexpr size_t WS_W2T = WS_W1T + (size_t)32 * 2048 * 1024 * 2;
constexpr size_t WS_X1 = WS_W2T + (size_t)32 * 1024 * 1024 * 2;
constexpr size_t WS_H2 = WS_X1 + (size_t)M * 1024 * 4;
constexpr size_t WS_TOKES = WS_H2 + (size_t)M * 1024 * 2;
constexpr size_t WS_TOKW = WS_TOKES + (size_t)M * 16;
constexpr size_t WS_LIST = WS_TOKW + (size_t)M * 16;
constexpr size_t WS_R = WS_LIST + (size_t)32 * 16384 * 4;
constexpr size_t WS_H = WS_R;
constexpr size_t WS_P = WS_H + (size_t)M * 1024 * 2;
constexpr size_t WS_XT = WS_P + (size_t)M * NPROJ * 2;
constexpr size_t WS_BMR = WS_XT + (size_t)M * 1024 * 2;
constexpr size_t WS_BMT = WS_BMR + (size_t)M * 256 * 2;
constexpr size_t WS_CMR = WS_BMT + (size_t)M * 256 * 2;
constexpr size_t WS_DT = WS_CMR + (size_t)M * 256 * 2;
constexpr size_t WS_ACS = WS_DT + (size_t)2 * M * 16 * 4;
constexpr size_t WS_CDEC = WS_ACS + (size_t)2 * M * 16 * 4;
constexpr size_t WS_ST = WS_CDEC + 16384;
constexpr size_t WS_H8 = WS_ST, WS_WIN8 = WS_ST + (size_t)M * 1024;
constexpr size_t WS_PREV = WS_ST + (size_t)2 * 2 * 64 * 16 * 8192 * 4;
constexpr size_t WS_YZ = WS_PREV + (size_t)2 * 2 * 64 * 16 * 8192 * 2;
constexpr size_t WS_AO = WS_YZ + (size_t)M * 1024 * 2;
constexpr size_t WS_RSTD = WS_AO + (size_t)M * 1024 * 2;
constexpr size_t WS_QN = WS_RSTD + (size_t)M * 4;
constexpr size_t WS_KN = WS_QN + (size_t)M * 1024 * 2;
constexpr size_t WS_VB = WS_KN + (size_t)M * 256 * 2;
constexpr size_t WS_T1 = WS_VB + (size_t)M * 256 * 2;
constexpr size_t WS_MG = WS_T1 + (size_t)M * 1024 * 2;
constexpr size_t WS_END = WS_MG + (size_t)M * 1024 * 2;
constexpr size_t WS_XB = WS_R;
constexpr size_t WS_ACT = WS_XB + (size_t)ROWS_MAX * 1024 * 2;
constexpr size_t WS_YB = WS_XB;
static_assert(WS_ACT + (size_t)ROWS_MAX * 1024 * 2 <= WS_END, "moe overlay");
static_assert(WS_END <= (size_t)1073741824, "workspace");
static_assert(WS_WAT == WS_WST + 2097152 && WS_AO == WS_YZ + (size_t)M * 2048, "concatenated operands of the merged branch GEMMs");

constexpr int LDS_BYTES = 147712;
constexpr int LDS_BARST = 147456;
constexpr int LDS_CTL = 143360;

struct Params {
    const float* in[24];
    float* out;
    unsigned char* ws;
    int ph_lo, ph_hi;
};

__device__ __forceinline__ float bf2f(bf16_t v) { return __uint_as_float((unsigned)v << 16); }
__device__ __forceinline__ float bflo(unsigned w) { return __uint_as_float(w << 16); }
__device__ __forceinline__ float bfhi(unsigned w) { return __uint_as_float(w & 0xffff0000u); }
__device__ __forceinline__ unsigned f2bf(float f) { unsigned u = __float_as_uint(f); return (u + 0x7fffu + ((u >> 16) & 1u)) >> 16; }
__device__ __forceinline__ unsigned pk2(float lo, float hi) { return f2bf(lo) | (f2bf(hi) << 16); }
__device__ __forceinline__ float wave_sum(float v) {
#pragma unroll
    for (int o = 1; o < 64; o <<= 1) v += __shfl_xor(v, o);
    return v;
}
__device__ __forceinline__ float wave_max(float v) {
#pragma unroll
    for (int o = 1; o < 64; o <<= 1) v = fmaxf(v, __shfl_xor(v, o));
    return v;
}
__device__ __forceinline__ int wave_min_i(int v) {
#pragma unroll
    for (int o = 1; o < 64; o <<= 1) { int t = __shfl_xor(v, o); v = t < v ? t : v; }
    return v;
}
__device__ __forceinline__ float sigmoidf_(float x) { return 1.f / (1.f + __expf(-x)); }
__device__ __forceinline__ unsigned pack4_fp8(float a, float b, float c, float d) { unsigned w = __builtin_amdgcn_cvt_pk_fp8_f32(a, b, 0u, false); return __builtin_amdgcn_cvt_pk_fp8_f32(c, d, w, true); }
#define LDS_WAIT() asm volatile("s_waitcnt lgkmcnt(0)" ::: "memory")

struct Ctx { int tid, lane, wave, bid, G; LAS unsigned char* lds; };

struct TItem { const float* W; bf16_t* WT; const float* kscale; int N, k0, n0, orow0; unsigned char* WT8; };
__device__ __forceinline__ void transpose_load(const TItem& t, f32x4 (&v)[8], int lane) {
    const int nq = lane & 7, kg = lane >> 3;
    const float* s = t.W + (size_t)(t.k0 + 8 * kg) * t.N + t.n0 + 4 * nq;
#pragma unroll
    for (int i = 0; i < 8; ++i) v[i] = __builtin_nontemporal_load((const f32x4*)(s + (size_t)i * t.N));
}
__device__ __forceinline__ void transpose_store(const TItem& t, f32x4 (&v)[8], int lane) {
    const int nq = lane & 7, kg = lane >> 3;
    if (t.kscale) {
#pragma unroll
        for (int i = 0; i < 8; ++i) v[i] = v[i] * t.kscale[t.k0 + 8 * kg + i];
    }
    if (t.WT8) {
        unsigned char* d8 = t.WT8 + (size_t)(t.orow0 + 4 * nq) * 1024 + t.k0 + 8 * kg;
#pragma unroll
        for (int j = 0; j < 4; ++j) { u32x2 o; o.x = pack4_fp8(64.f * v[0][j], 64.f * v[1][j], 64.f * v[2][j], 64.f * v[3][j]); o.y = pack4_fp8(64.f * v[4][j], 64.f * v[5][j], 64.f * v[6][j], 64.f * v[7][j]);
            *(u32x2*)(d8 + (size_t)j * 1024) = o; }
        return;
    }
    bf16_t* d = t.WT + (size_t)(t.orow0 + 4 * nq) * 1024 + t.k0 + 8 * kg;
#pragma unroll
    for (int j = 0; j < 4; ++j) { u32x4 o; o.x = pk2(v[0][j], v[1][j]); o.y = pk2(v[2][j], v[3][j]); o.z = pk2(v[4][j], v[5][j]); o.w = pk2(v[6][j], v[7][j]);
        *(u32x4*)(d + (size_t)j * 1024) = o; }
}
constexpr int PREP_I_IN = 16 * 193, PREP_I_SQ = 512, PREP_NITEMS = PREP_I_IN + 3 * PREP_I_SQ;
__device__ __forceinline__ TItem prep_item(const Params& p, int r) {
    unsigned char* ws = p.ws; TItem t; t.kscale = nullptr; t.WT8 = nullptr;
    if (r < PREP_I_IN) { const int kb = r / 193, nb = r % 193, n0 = nb * 32;
        t.W = p.in[2]; t.WT = (bf16_t*)(ws + WS_WINT); t.N = 6176; t.k0 = kb * 64; t.n0 = n0; t.orow0 = n0 < 2560 ? n0 : (n0 < 2592 ? PDT + (n0 - 2560) : n0 - 32);
        if (n0 >= 2592) { t.WT8 = ws + WS_WIN8; t.orow0 -= PQ; }
        return t; }
    r -= PREP_I_IN;
    { const int which = r / PREP_I_SQ, q = r % PREP_I_SQ;
        t.W = which == 0 ? p.in[13] : (which == 1 ? p.in[14] : p.in[15]); t.WT = (bf16_t*)(ws + (which == 0 ? WS_WST : (which == 1 ? WS_WAT : WS_WOT)));
        t.kscale = which == 0 ? p.in[10] : nullptr; t.N = 1024; t.k0 = (q / 32) * 64; t.n0 = (q % 32) * 32; t.orow0 = t.n0; return t; }
}
constexpr int PREP8_TILES = 32 * 64 + 32 * 32;
struct T8 { const float* W; unsigned char* WT; int N, k0, n0; bool w1; };
__device__ __forceinline__ T8 prep8_tile(const Params& p, int t) {
    T8 r;
    if (t < 2048) { const int e = t >> 6; r.W = p.in[19] + (size_t)e * 1024 * 2048; r.WT = p.ws + WS_W1T + (size_t)e * 2048 * 1024; r.N = 2048; r.k0 = ((t >> 3) & 7) * 128; r.n0 = (t & 7) * 256; r.w1 = true; }
    else { t -= 2048; const int e = t >> 5; r.W = p.in[21] + (size_t)e * 1024 * 1024; r.WT = p.ws + WS_W2T + (size_t)e * 1024 * 1024; r.N = 1024; r.k0 = ((t >> 2) & 7) * 128; r.n0 = (t & 3) * 256; r.w1 = false; }
    return r;
}
__device__ __forceinline__ void prep8_load(const T8& t, f32x4 (&v)[16], int wave, int lane) {
    const float* s = t.W + (size_t)(t.k0 + 16 * wave) * t.N + t.n0 + 4 * lane;
#pragma unroll
    for (int i = 0; i < 16; ++i) v[i] = __builtin_nontemporal_load((const f32x4*)(s + (size_t)i * t.N));
}
__device__ __forceinline__ void phase_prep8(const Params& p, const Ctx& c) {
    f32x4 v[16];
    int t = c.bid;
    if (t < PREP8_TILES) { const T8 t0 = prep8_tile(p, t); prep8_load(t0, v, c.wave, c.lane); }
    for (int i = 0; t < PREP8_TILES; ++i, t += c.G) {
        const T8 cur = prep8_tile(p, t);
        LAS unsigned char* img = c.lds + (i & 1) * 32768;
#pragma unroll
        for (int j = 0; j < 4; ++j) { u32x4 o;
            o.x = pack4_fp8(64.f * v[0][j], 64.f * v[1][j], 64.f * v[2][j], 64.f * v[3][j]); o.y = pack4_fp8(64.f * v[4][j], 64.f * v[5][j], 64.f * v[6][j], 64.f * v[7][j]);
            o.z = pack4_fp8(64.f * v[8][j], 64.f * v[9][j], 64.f * v[10][j], 64.f * v[11][j]); o.w = pack4_fp8(64.f * v[12][j], 64.f * v[13][j], 64.f * v[14][j], 64.f * v[15][j]);
            *(LAS u32x4*)(img + (4 * c.lane + j) * 128 + 16 * c.wave) = o; }
        if (t + c.G < PREP8_TILES) { const T8 nx = prep8_tile(p, t + c.G); prep8_load(nx, v, c.wave, c.lane); }
        __syncthreads();
#pragma unroll
        for (int q = 0; q < 4; ++q) { const int idx = c.tid + 512 * q, nl = idx >> 3, cw = idx & 7, n = cur.n0 + nl;
            const int orow = cur.w1 ? (((n & 1023) >> 7) * 256 + (n >> 10) * 128 + (n & 127)) : n;
            __builtin_nontemporal_store(*(const LAS u32x4*)(img + nl * 128 + 16 * cw), (u32x4*)(cur.WT + (size_t)orow * 1024 + cur.k0 + 16 * cw)); }
    }
    __syncthreads();
}

__device__ __forceinline__ void phase_prep(const Params& p, const Ctx& c) {
    unsigned char* ws = p.ws;
    const int gw = c.bid * 8 + c.wave, NGW = c.G * 8;
    for (int it = gw; it < PREP_NITEMS; it += 2 * NGW) {
        const TItem ta = prep_item(p, it); f32x4 va[8], vb[8];
        transpose_load(ta, va, c.lane);
        const bool two = it + NGW < PREP_NITEMS;
        const TItem tb = prep_item(p, two ? it + NGW : it);
        if (two) transpose_load(tb, vb, c.lane);
        transpose_store(ta, va, c.lane);
        if (two) transpose_store(tb, vb, c.lane);
    }
    phase_prep8(p, c);
    for (int r = 6176 + gw; r < NPROJ; r += NGW) {
        u32x4* o = (u32x4*)((bf16_t*)(ws + WS_WINT) + (size_t)r * 1024);
        o[c.lane] = (u32x4){0u, 0u, 0u, 0u}; o[c.lane + 64] = (u32x4){0u, 0u, 0u, 0u};
    }
    {
        const float* x = p.in[0]; const float* g = p.in[1]; bf16_t* H = (bf16_t*)(ws + WS_H);
        f32x4 gv[4];
#pragma unroll
        for (int j = 0; j < 4; ++j) gv[j] = ((const f32x4*)g)[c.lane + 64 * j];
        for (int m = gw; m < M; m += NGW) {
            const f32x4* xr = (const f32x4*)(x + (size_t)m * D) + c.lane;
            f32x4 v[4]; float s = 0.f;
#pragma unroll
            for (int j = 0; j < 4; ++j) { v[j] = __builtin_nontemporal_load(xr + 64 * j); s += (v[j].x * v[j].x + v[j].y * v[j].y) + (v[j].z * v[j].z + v[j].w * v[j].w); }
            const float rstd = rsqrtf(wave_sum(s) * (1.f / D) + EPS);
            u32x2* o = (u32x2*)(H + (size_t)m * D) + c.lane; unsigned* o8 = (unsigned*)(ws + WS_H8 + (size_t)m * D) + c.lane;
#pragma unroll
            for (int j = 0; j < 4; ++j) { const f32x4 hn = v[j] * rstd * gv[j]; u32x2 w; w.x = pk2(hn.x, hn.y); w.y = pk2(hn.z, hn.w); o[64 * j] = w;
                o8[64 * j] = pack4_fp8(8.f * hn.x, 8.f * hn.y, 8.f * hn.z, 8.f * hn.w); }
        }
    }
    {
        float* rc = (float*)(ws + WS_ROPE); float* rs = rc + 4096;
        for (int idx = c.bid * 512 + c.tid; idx < 4096; idx += c.G * 512) {
            const int pos = idx >> 5, i = idx & 31;
            const float inv = exp2f(-(float)i * (13.287712379549449f / 32.f));
            float rev = (float)pos * inv * 0.15915494309189535f; rev -= floorf(rev);
            rc[idx] = __builtin_amdgcn_cosf(rev); rs[idx] = __builtin_amdgcn_sinf(rev);
        }
        float* wrt = (float*)(ws + WS_WRT); const float* wr = p.in[17];
        for (int idx = c.bid * 512 + c.tid; idx < 32768; idx += c.G * 512) { const int k = idx >> 5, e = idx & 31; wrt[e * 1024 + k] = wr[idx]; }
        if (c.bid == 0 && c.tid < 64) ((int*)(ws + WS_CTL))[c.tid] = 0;
    }
}

namespace pg8 {
#define PG8_LAS __attribute__((address_space(3)))
typedef unsigned short bf16_t;
typedef short bf16x8 __attribute__((ext_vector_type(8)));
typedef float f32x4 __attribute__((ext_vector_type(4)));
typedef unsigned u32x4 __attribute__((ext_vector_type(4)));
constexpr int BM = 256, BK = 64, HALF = 128, HTB = HALF * BK * 2  , STAGE_BYTES = 8 * HTB, NXCD = 8, WGM = 8;

__host__ __device__ __forceinline__ int lds_byte(int r, int c) { const int st = (r >> 4) * 2 + (c >> 5), rr = r & 15, cc = c & 31, ob = rr * 64 + cc * 2; return st * 1024 + (ob ^ (((ob >> 9) & 1) << 5)); }
__host__ __device__ __forceinline__ void stage_rc(int b, int& R, int& C) { const int st = b / 1024, sb = b % 1024, swz = sb ^ (((sb >> 9) & 1) << 5); R = (st >> 1) * 16 + swz / 64; C = (st & 1) * 32 + (swz % 64) / 2; }
__host__ __device__ __forceinline__ int perm32(int rho) { const int n = rho >> 4, i = rho & 15; return 8 * (i >> 2) + 4 * n + (i & 3); }

struct Unit { int pm, pn; };
struct Gemm { const bf16_t* A; const bf16_t* Bt; int M, N, K; };

struct StaticOrder {
    int nM, nN, nwg, G, c;
    __host__ __device__ void init(int M, int N, int G_, int c_) { nM = M / BM; nN = N / BM; nwg = nM * nN; G = G_; c = c_; }
    __host__ __device__ bool next(int i, Unit& u) const {
        const long L = (long)i * G + c; if (L >= nwg) return false;
        int wgid = (int)L; { const int q = nwg / NXCD, r = nwg % NXCD, xcd = wgid % NXCD, off = wgid / NXCD; wgid = (xcd < r ? xcd * (q + 1) : r * (q + 1) + (xcd - r) * q) + off; }
        const int nig = WGM * nN, gid = wgid / nig, fm = gid * WGM, gsz = (nM - fm) < WGM ? (nM - fm) : WGM;
        u.pm = fm + ((wgid % nig) % gsz); u.pn = (wgid % nig) / gsz; return true;
    }
    __device__ __forceinline__ void a_ready(const Unit&) const {}
    __device__ __forceinline__ void done(const Unit&) const {}
};


__device__ __forceinline__ unsigned cvt_pk_bf16(float lo, float hi) { unsigned r; asm volatile("v_cvt_pk_bf16_f32 %0, %1, %2" : "=v"(r) : "v"(lo), "v"(hi)); return r; }
__device__ __forceinline__ float sig_(float x) { return __builtin_amdgcn_rcpf(1.f + __builtin_amdgcn_exp2f(-1.4426950408889634f * x)); }
__device__ __forceinline__ u32x4 pack8(const f32x4& v0, const f32x4& v1) { u32x4 w; w.x = cvt_pk_bf16(v0[0], v0[1]); w.y = cvt_pk_bf16(v0[2], v0[3]); w.z = cvt_pk_bf16(v1[0], v1[1]); w.w = cvt_pk_bf16(v1[2], v1[3]); return w; }
__device__ __forceinline__ void unpack8(const u32x4& w, f32x4& v0, f32x4& v1) {
    v0[0] = __uint_as_float(w.x << 16); v0[1] = __uint_as_float(w.x & 0xffff0000u); v0[2] = __uint_as_float(w.y << 16); v0[3] = __uint_as_float(w.y & 0xffff0000u);
    v1[0] = __uint_as_float(w.z << 16); v1[1] = __uint_as_float(w.z & 0xffff0000u); v1[2] = __uint_as_float(w.w << 16); v1[3] = __uint_as_float(w.w & 0xffff0000u); }
struct EpiStore {
    static constexpr bool PERM = true, AFTER_DRAIN = false;
    bf16_t* O; int ldc;
    __device__ __forceinline__ void operator()(const f32x4 (&acc)[2][2][4][2], const Unit& u, int wr, int wc, int fr, int fq) const {
        const int row0 = u.pm * BM + wr * 64 + fr, col0 = u.pn * BM + wc * 32 + 8 * fq;
#pragma unroll
        for (int ai = 0; ai < 2; ++ai)
#pragma unroll
            for (int m = 0; m < 4; ++m) { bf16_t* rowp = O + (size_t)(row0 + ai * HALF + m * 16) * ldc + col0;
#pragma unroll
                for (int bj = 0; bj < 2; ++bj) *(u32x4*)(rowp + bj * HALF) = pack8(acc[ai][bj][m][0], acc[ai][bj][m][1]); }
    }
};
struct EpiStore8 {
    static constexpr bool PERM = true, AFTER_DRAIN = false;
    bf16_t* O; int ldc; float sc;
    __device__ __forceinline__ void operator()(const f32x4 (&acc)[2][2][4][2], const Unit& u, int wr, int wc, int fr, int fq) const {
        const int row0 = u.pm * BM + wr * 64 + fr, col0 = u.pn * BM + wc * 32 + 8 * fq;
#pragma unroll
        for (int ai = 0; ai < 2; ++ai)
#pragma unroll
            for (int m = 0; m < 4; ++m) { bf16_t* rowp = O + (size_t)(row0 + ai * HALF + m * 16) * ldc + col0;
#pragma unroll
                for (int bj = 0; bj < 2; ++bj) *(u32x4*)(rowp + bj * HALF) = pack8(acc[ai][bj][m][0] * sc, acc[ai][bj][m][1] * sc); }
    }
};
struct EpiAct8 {
    static constexpr bool PERM = true, AFTER_DRAIN = false;
    unsigned char* ACT; const float* b1;
    __device__ __forceinline__ void operator()(const f32x4 (&acc)[2][2][4][2], const Unit& u, int wr, int wc, int fr, int fq) const {
        const int e = u.pn >> 3, nt = u.pn & 7;
        const int row0 = u.pm * BM + wr * 64 + fr, col0 = nt * 128 + wc * 32 + 8 * fq;
        const float* bg = b1 + (size_t)e * 2048 + col0;
        const f32x4 bg0 = *(const f32x4*)bg, bg1 = *(const f32x4*)(bg + 4), bu0 = *(const f32x4*)(bg + 1024), bu1 = *(const f32x4*)(bg + 1028);
        constexpr float SC = 1.f / 512.f;
#pragma unroll
        for (int ai = 0; ai < 2; ++ai)
#pragma unroll
            for (int m = 0; m < 4; ++m) { const int row = row0 + ai * HALF + m * 16;
                f32x4 g0 = acc[ai][0][m][0] * SC + bg0, g1 = acc[ai][0][m][1] * SC + bg1, u0 = acc[ai][1][m][0] * SC + bu0, u1 = acc[ai][1][m][1] * SC + bu1;
#pragma unroll
                for (int i = 0; i < 4; ++i) {
                    const float ga = fminf(g0[i], 7.f), gb = fminf(g1[i], 7.f), ua = fminf(fmaxf(u0[i], -7.f), 7.f), ub = fminf(fmaxf(u1[i], -7.f), 7.f);
                    g0[i] = 4.f * ga * sig_(1.702f * ga) * (ua + 1.f); g1[i] = 4.f * gb * sig_(1.702f * gb) * (ub + 1.f); }
                u32x2 w; w.x = pack4_fp8(g0[0], g0[1], g0[2], g0[3]); w.y = pack4_fp8(g1[0], g1[1], g1[2], g1[3]);
                *(u32x2*)(ACT + (size_t)row * 1024 + col0) = w; }
    }
};
struct EpiY8 {
    static constexpr bool PERM = true, AFTER_DRAIN = false;
    bf16_t* YB; const float* b2;
    __device__ __forceinline__ void operator()(const f32x4 (&acc)[2][2][4][2], const Unit& u, int wr, int wc, int fr, int fq) const {
        const int e = u.pn >> 2, nt = u.pn & 3;
        const int row0 = u.pm * BM + wr * 64 + fr, col0 = nt * BM + wc * 32 + 8 * fq;
        constexpr float SC = 1.f / 256.f;
        f32x4 bv[2][2];
#pragma unroll
        for (int bj = 0; bj < 2; ++bj) { bv[bj][0] = *(const f32x4*)(b2 + (size_t)e * 1024 + col0 + bj * HALF); bv[bj][1] = *(const f32x4*)(b2 + (size_t)e * 1024 + col0 + bj * HALF + 4); }
#pragma unroll
        for (int ai = 0; ai < 2; ++ai)
#pragma unroll
            for (int m = 0; m < 4; ++m) { bf16_t* rowp = YB + (size_t)(row0 + ai * HALF + m * 16) * 1024 + col0;
#pragma unroll
                for (int bj = 0; bj < 2; ++bj) *(u32x4*)(rowp + bj * HALF) = pack8(acc[ai][bj][m][0] * SC + bv[bj][0], acc[ai][bj][m][1] * SC + bv[bj][1]); }
    }
};
template <int NN> struct MoeOrder {
    const PG8_LAS int* texp; int G, c, ntile;
    __device__ __forceinline__ bool next(int i, Unit& u) const {
        const int L = i * G + c; if (L >= ntile * NN) return false;
        const int t = L / NN, pnl = L % NN;
        u.pm = t; u.pn = texp[t] * NN + pnl; return true;
    }
    __device__ __forceinline__ void a_ready(const Unit&) const {}
    __device__ __forceinline__ void done(const Unit&) const {}
};
template <class Epi, class Sched, bool ALIGN_EPI = false, bool SP2 = false>
__device__ __forceinline__ void gemm_phase(PG8_LAS unsigned char* lds, const Gemm g, const Sched& S, const Epi& E) {
    const int tid = threadIdx.x, wid = __builtin_amdgcn_readfirstlane(tid >> 6), lane = tid & 63, wr = wid >> 2, wc = wid & 3, fr = lane & 15, fq = lane >> 4;
    const int K = g.K, nt = K / BK;
    unsigned voffA[2], voffB[2];
#pragma unroll
    for (int i = 0; i < 2; ++i) { int R, C; stage_rc(tid * 16 + i * 8192, R, C); const int Rb = Epi::PERM ? ((R & ~31) + perm32(R & 31)) : R;
        voffA[i] = (unsigned)(R * K + C) * 2u; voffB[i] = (unsigned)(Rb * K + C) * 2u; }
    const size_t kstep = (size_t)(BK * 2);
    const size_t hstep = (size_t)HALF * K * 2;
    const size_t tstep = 2 * hstep;
    const unsigned ldsw = (unsigned)wid * 1024u;
    const int aoff = lds_byte(wr * 64 + fr, fq * 8), boff = lds_byte(wc * 32 + fr, fq * 8);
#define PG8_SA(b, h) (((b) * 2 + (h)) * HTB)
#define PG8_SB(b, h) ((4 + (b) * 2 + (h)) * HTB)
#define PG8_STAGE(bufoff, gbase, voff) do { _Pragma("unroll") for (int _i = 0; _i < 2; ++_i) \
        __builtin_amdgcn_global_load_lds((const unsigned*)((const char*)(gbase) + (voff)[_i]), (PG8_LAS unsigned*)(lds + (bufoff) + ldsw + _i * 8192), 16, 0, 0); } while (0)
#define PG8_LDA(dst, b, h) do { _Pragma("unroll") for (int m = 0; m < 4; ++m) _Pragma("unroll") for (int k = 0; k < 2; ++k) dst[m][k] = *(const PG8_LAS bf16x8*)(lds + PG8_SA(b, h) + aoff + m * 2048 + k * 1024); } while (0)
#define PG8_LDB(dst, b, h) do { _Pragma("unroll") for (int n = 0; n < 2; ++n) _Pragma("unroll") for (int k = 0; k < 2; ++k) dst[n][k] = *(const PG8_LAS bf16x8*)(lds + PG8_SB(b, h) + boff + n * 2048 + k * 1024); } while (0)
#define PG8_MMA(ai, bj, At, Bt) do { __builtin_amdgcn_s_setprio(1); _Pragma("unroll") for (int m = 0; m < 4; ++m) _Pragma("unroll") for (int n = 0; n < 2; ++n) _Pragma("unroll") for (int k = 0; k < 2; ++k) \
        acc[ai][bj][m][n] = __builtin_amdgcn_mfma_f32_16x16x32_bf16(Bt[n][k], At[m][k], acc[ai][bj][m][n], 0, 0, 0); __builtin_amdgcn_s_setprio(0); } while (0)
#define PG8_WAIT_V(n) asm volatile("s_waitcnt vmcnt(" #n ")" ::: "memory")
#define PG8_WAIT_L(n) asm volatile("s_waitcnt lgkmcnt(" #n ")" ::: "memory")
#define PG8_BAR __builtin_amdgcn_s_barrier()
#define PG8_SCHED __builtin_amdgcn_sched_barrier(0)
    Unit cur, nxt; int ui = 0;
    if (!S.next(0, cur)) return;
    f32x4 acc[2][2][4][2];
#pragma unroll
    for (int a = 0; a < 2; ++a)
#pragma unroll
        for (int b = 0; b < 2; ++b)
#pragma unroll
            for (int m = 0; m < 4; ++m)
#pragma unroll
                for (int n = 0; n < 2; ++n) acc[a][b][m][n] = (f32x4){0.f, 0.f, 0.f, 0.f};
    bf16x8 At[4][2], B0[2][2], B1[2][2];
    const char* cA = (const char*)g.A + (size_t)cur.pm * tstep; const char* cB = (const char*)g.Bt + (size_t)cur.pn * tstep;
    S.a_ready(cur);
    if constexpr (SP2) {
        PG8_STAGE(PG8_SB(0, 0), cB, voffB); PG8_STAGE(PG8_SB(0, 1), cB + hstep, voffB); PG8_STAGE(PG8_SA(0, 0), cA, voffA); PG8_STAGE(PG8_SA(0, 1), cA + hstep, voffA);
        if (wr == 1) PG8_BAR;
        PG8_WAIT_V(2); PG8_BAR;
        PG8_STAGE(PG8_SB(1, 0), cB + kstep, voffB); PG8_STAGE(PG8_SA(1, 0), cA + kstep, voffA); PG8_STAGE(PG8_SB(1, 1), cB + hstep + kstep, voffB);
        PG8_WAIT_V(6); PG8_BAR;
    } else {
        PG8_STAGE(PG8_SB(0, 0), cB, voffB); PG8_STAGE(PG8_SA(0, 0), cA, voffA); PG8_STAGE(PG8_SB(0, 1), cB + hstep, voffB); PG8_STAGE(PG8_SA(0, 1), cA + hstep, voffA);
        if (wr == 1) PG8_BAR;
        PG8_WAIT_V(4); PG8_BAR;
        PG8_STAGE(PG8_SB(1, 0), cB + kstep, voffB); PG8_STAGE(PG8_SA(1, 0), cA + kstep, voffA); PG8_STAGE(PG8_SB(1, 1), cB + hstep + kstep, voffB);
        PG8_WAIT_V(6); PG8_BAR;
    }
    for (;;) {
        const bool has_next = S.next(ui + 1, nxt);
        const char* nA = has_next ? (const char*)g.A + (size_t)nxt.pm * tstep : cA; const char* nB = has_next ? (const char*)g.Bt + (size_t)nxt.pn * tstep : cB;
        for (int t = 0; t < nt; t += 2) {
            const bool last = (t == nt - 2);
            const char* a1 = cA + (size_t)(t + 1) * kstep;
            const char* a2 = last ? nA : cA + (size_t)(t + 2) * kstep; const char* b2 = last ? nB : cB + (size_t)(t + 2) * kstep;
            const char* a3 = a2 + kstep; const char* b3 = b2 + kstep;
            if (last && has_next) S.a_ready(nxt);
            if constexpr (SP2) {
            PG8_LDB(B0, 0, 0); PG8_LDB(B1, 0, 1); PG8_SCHED; PG8_LDA(At, 0, 0); PG8_STAGE(PG8_SA(1, 1), a1 + hstep, voffA);
            PG8_WAIT_V(8); PG8_WAIT_L(0); PG8_BAR; PG8_MMA(0, 0, At, B0); PG8_MMA(0, 1, At, B1); PG8_BAR; PG8_SCHED;
            PG8_LDA(At, 0, 1); PG8_STAGE(PG8_SB(0, 0), b2, voffB); PG8_STAGE(PG8_SB(0, 1), b2 + hstep, voffB); PG8_STAGE(PG8_SA(0, 0), a2, voffA);
            PG8_WAIT_V(8); PG8_WAIT_L(0); PG8_BAR; PG8_MMA(1, 0, At, B0); PG8_MMA(1, 1, At, B1); PG8_BAR; PG8_SCHED;
            PG8_LDB(B0, 1, 0); PG8_LDB(B1, 1, 1); PG8_SCHED; PG8_LDA(At, 1, 0); PG8_STAGE(PG8_SA(0, 1), a2 + hstep, voffA);
            PG8_WAIT_V(8); PG8_WAIT_L(0); PG8_BAR; PG8_MMA(0, 0, At, B0); PG8_MMA(0, 1, At, B1); PG8_BAR; PG8_SCHED;
            PG8_LDA(At, 1, 1); PG8_STAGE(PG8_SB(1, 0), b3, voffB); PG8_STAGE(PG8_SB(1, 1), b3 + hstep, voffB); PG8_STAGE(PG8_SA(1, 0), a3, voffA);
            PG8_WAIT_V(8); PG8_WAIT_L(0); PG8_BAR; PG8_MMA(1, 0, At, B0); PG8_MMA(1, 1, At, B1); PG8_BAR; PG8_SCHED;
            } else {
            PG8_LDB(B0, 0, 0); PG8_SCHED; PG8_LDA(At, 0, 0); PG8_STAGE(PG8_SA(1, 1), a1 + hstep, voffA);
            PG8_WAIT_L(8); PG8_BAR; PG8_WAIT_L(0); PG8_MMA(0, 0, At, B0); PG8_BAR; PG8_SCHED;
            PG8_LDB(B1, 0, 1); PG8_STAGE(PG8_SB(0, 0), b2, voffB);
            PG8_BAR; PG8_WAIT_L(0); PG8_MMA(0, 1, At, B1); PG8_BAR;
            PG8_LDA(At, 0, 1); PG8_STAGE(PG8_SA(0, 0), a2, voffA);
            PG8_BAR; PG8_WAIT_L(0); PG8_MMA(1, 0, At, B0); PG8_BAR; PG8_SCHED;
            PG8_STAGE(PG8_SB(0, 1), b2 + hstep, voffB);
            PG8_WAIT_V(6); PG8_BAR; PG8_MMA(1, 1, At, B1); PG8_BAR;
            PG8_LDB(B0, 1, 0); PG8_SCHED; PG8_LDA(At, 1, 0); PG8_STAGE(PG8_SA(0, 1), a2 + hstep, voffA);
            PG8_WAIT_L(8); PG8_BAR; PG8_WAIT_L(0); PG8_MMA(0, 0, At, B0); PG8_BAR; PG8_SCHED;
            PG8_LDB(B1, 1, 1); PG8_STAGE(PG8_SB(1, 0), b3, voffB);
            PG8_BAR; PG8_WAIT_L(0); PG8_MMA(0, 1, At, B1); PG8_BAR;
            PG8_LDA(At, 1, 1); PG8_STAGE(PG8_SA(1, 0), a3, voffA);
            PG8_BAR; PG8_WAIT_L(0); PG8_MMA(1, 0, At, B0); PG8_BAR; PG8_SCHED;
            PG8_STAGE(PG8_SB(1, 1), b3 + hstep, voffB);
            PG8_WAIT_V(6); PG8_BAR; PG8_MMA(1, 1, At, B1); PG8_BAR;
            }
        }
        if constexpr (ALIGN_EPI) { if (wr == 0) PG8_BAR; }
        if constexpr (!Epi::AFTER_DRAIN) { E(acc, cur, wr, wc, fr, fq); S.done(cur); }
        if (!has_next) break;
#pragma unroll
        for (int a = 0; a < 2; ++a)
#pragma unroll
            for (int b = 0; b < 2; ++b)
#pragma unroll
                for (int m = 0; m < 4; ++m)
#pragma unroll
                    for (int n = 0; n < 2; ++n) acc[a][b][m][n] = (f32x4){0.f, 0.f, 0.f, 0.f};
        cur = nxt; cA = nA; cB = nB; ++ui;
        if constexpr (ALIGN_EPI) { if (wr == 1) PG8_BAR; }
    }
    PG8_WAIT_V(0);
    if constexpr (!ALIGN_EPI) { if (wr == 0) PG8_BAR; }
    PG8_BAR;
    if constexpr (Epi::AFTER_DRAIN) { E.fused(acc, cur, wr, wc, fr, fq, lds, wid, lane); S.done(cur); }
#undef PG8_SA
#undef PG8_SB
#undef PG8_STAGE
#undef PG8_LDA
#undef PG8_LDB
#undef PG8_MMA
#undef PG8_WAIT_V
#undef PG8_WAIT_L
#undef PG8_BAR
#undef PG8_SCHED
}

struct MoeGatherOrder {
    const PG8_LAS int* offs; const PG8_LAS int* cnt; const PG8_LAS int* texp; const int* LIST; int G, c, ntile;
    __device__ __forceinline__ bool next(int i, Unit& u) const {
        const int L = i * G + c; if (L >= ntile * 8) return false;
        const int t = L >> 3, pnl = L & 7;
        u.pm = t; u.pn = texp[t] * 8 + pnl; return true;
    }
    __device__ __forceinline__ int arow(const Unit& u, int r) const { const int e = u.pn >> 3, slot = u.pm * 256 + r - offs[e]; return slot < cnt[e] ? LIST[e * 16384 + slot] : 0; }
    __device__ __forceinline__ void a_ready(const Unit&) const {}
    __device__ __forceinline__ void done(const Unit&) const {}
};
struct TailOrder {
    StaticOrder so;
    __device__ __forceinline__ bool next(int i, Unit& u) const { Unit b; if (!so.next(i >> 1, b)) return false; u.pm = b.pm + 64 * (i & 1); u.pn = b.pn + 4 * (i & 1); return true; }
    __device__ __forceinline__ void a_ready(const Unit&) const {}
    __device__ __forceinline__ void done(const Unit&) const {}
};
struct EpiT12 {
    static constexpr bool PERM = true, AFTER_DRAIN = false;
    bf16_t* T1; bf16_t* MG; const bf16_t* G; int ldg; const float* RSTD;
    __device__ __forceinline__ void operator()(const f32x4 (&acc)[2][2][4][2], const Unit& u, int wr, int wc, int fr, int fq) const {
        const bool second = u.pm >= 64;
        const int row0 = (u.pm & 63) * BM + wr * 64 + fr, col0 = (u.pn & 3) * BM + wc * 32 + 8 * fq;
        const bf16_t* Gp = G + (second ? 1024 : 0);
#pragma unroll
        for (int ai = 0; ai < 2; ++ai) {
            u32x4 gv[4][2], tv[4][2]; float rs[4];
#pragma unroll
            for (int m = 0; m < 4; ++m) { const int row = row0 + ai * HALF + m * 16; rs[m] = second ? 1.f : RSTD[row];
#pragma unroll
                for (int bj = 0; bj < 2; ++bj) { gv[m][bj] = *(const u32x4*)(Gp + (size_t)row * ldg + col0 + bj * HALF);
                    tv[m][bj] = second ? *(const u32x4*)(T1 + (size_t)row * 1024 + col0 + bj * HALF) : (u32x4){0u, 0u, 0u, 0u}; } }
#pragma unroll
            for (int m = 0; m < 4; ++m) { const int row = row0 + ai * HALF + m * 16;
#pragma unroll
                for (int bj = 0; bj < 2; ++bj) { f32x4 g0, g1, t0, t1; unpack8(gv[m][bj], g0, g1); unpack8(tv[m][bj], t0, t1);
                    f32x4 v0 = acc[ai][bj][m][0] * rs[m], v1 = acc[ai][bj][m][1] * rs[m];
#pragma unroll
                    for (int i = 0; i < 4; ++i) { v0[i] = fmaf(v0[i], sig_(g0[i]), t0[i]); v1[i] = fmaf(v1[i], sig_(g1[i]), t1[i]); }
                    *(u32x4*)((second ? MG : T1) + (size_t)row * 1024 + col0 + bj * HALF) = pack8(v0, v1); } }
        }
    }
};
struct EpiT3b {
    static constexpr bool PERM = true, AFTER_DRAIN = false;
    bf16_t* X1; const float* x;
    __device__ __forceinline__ void operator()(const f32x4 (&acc)[2][2][4][2], const Unit& u, int wr, int wc, int fr, int fq) const {
        const int row0 = u.pm * BM + wr * 64 + fr, col0 = u.pn * BM + wc * 32 + 8 * fq;
#pragma unroll
        for (int ai = 0; ai < 2; ++ai) {
            f32x4 xv[4][2][2];
#pragma unroll
            for (int m = 0; m < 4; ++m)
#pragma unroll
                for (int bj = 0; bj < 2; ++bj) { const size_t o = (size_t)(row0 + ai * HALF + m * 16) * 1024 + col0 + bj * HALF; xv[m][bj][0] = *(const f32x4*)(x + o); xv[m][bj][1] = *(const f32x4*)(x + o + 4); }
#pragma unroll
            for (int m = 0; m < 4; ++m)
#pragma unroll
                for (int bj = 0; bj < 2; ++bj) { const size_t o = (size_t)(row0 + ai * HALF + m * 16) * 1024 + col0 + bj * HALF;
                    *(u32x4*)(X1 + o) = pack8(xv[m][bj][0] + acc[ai][bj][m][0], xv[m][bj][1] + acc[ai][bj][m][1]); }
        }
    }
};
typedef int v4i_t __attribute__((ext_vector_type(4)));
typedef int v8i_t __attribute__((ext_vector_type(8)));
template <class Epi, class Sched, bool ALIGN_EPI = false, bool SP2 = false>
__device__ __forceinline__ void gemm_phase_f8(PG8_LAS unsigned char* lds, const Gemm g, const Sched& S, const Epi& E) {
    const int tid = threadIdx.x, wid = __builtin_amdgcn_readfirstlane(tid >> 6), lane = tid & 63, wr = wid >> 2, wc = wid & 3, fr = lane & 15, fq = lane >> 4;
    const int K = g.K, nt = K / BK;
    unsigned voffA[2], voffB[2];
#pragma unroll
    for (int i = 0; i < 2; ++i) { int R, C; stage_rc(tid * 16 + i * 8192, R, C); const int Rb = Epi::PERM ? ((R & ~31) + perm32(R & 31)) : R;
        voffA[i] = (unsigned)(R * K + C) * 2u; voffB[i] = (unsigned)(Rb * K + C) * 2u; }
    const size_t kstep = (size_t)(BK * 2);
    const size_t hstep = (size_t)HALF * K * 2;
    const size_t tstep = 2 * hstep;
    const unsigned ldsw = (unsigned)wid * 1024u;
    const int aoff = lds_byte(wr * 64 + fr, fq * 8), boff = lds_byte(wc * 32 + fr, fq * 8);
#define PG8_SA(b, h) (((b) * 2 + (h)) * HTB)
#define PG8_SB(b, h) ((4 + (b) * 2 + (h)) * HTB)
#define PG8_STAGE(bufoff, gbase, voff) do { _Pragma("unroll") for (int _i = 0; _i < 2; ++_i) \
        __builtin_amdgcn_global_load_lds((const unsigned*)((const char*)(gbase) + (voff)[_i]), (PG8_LAS unsigned*)(lds + (bufoff) + ldsw + _i * 8192), 16, 0, 0); } while (0)
#define PG8_LDA(dst, b, h) do { _Pragma("unroll") for (int m = 0; m < 4; ++m) { const v4i_t lo_ = *(const PG8_LAS v4i_t*)(lds + PG8_SA(b, h) + aoff + m * 2048), hi_ = *(const PG8_LAS v4i_t*)(lds + PG8_SA(b, h) + aoff + m * 2048 + 1024); dst[m] = __builtin_shufflevector(lo_, hi_, 0, 1, 2, 3, 4, 5, 6, 7); } } while (0)
#define PG8_LDB(dst, b, h) do { _Pragma("unroll") for (int n = 0; n < 2; ++n) { const v4i_t lo_ = *(const PG8_LAS v4i_t*)(lds + PG8_SB(b, h) + boff + n * 2048), hi_ = *(const PG8_LAS v4i_t*)(lds + PG8_SB(b, h) + boff + n * 2048 + 1024); dst[n] = __builtin_shufflevector(lo_, hi_, 0, 1, 2, 3, 4, 5, 6, 7); } } while (0)
#define PG8_MMA(ai, bj, At, Bt) do { __builtin_amdgcn_s_setprio(1); _Pragma("unroll") for (int m = 0; m < 4; ++m) _Pragma("unroll") for (int n = 0; n < 2; ++n) \
        asm volatile("v_mfma_scale_f32_16x16x128_f8f6f4 %0, %1, %2, %0, %3, %3 op_sel_hi:[0,0,0]" : "+v"(acc[ai][bj][m][n]) : "v"(Bt[n]), "v"(At[m]), "v"(scl_)); __builtin_amdgcn_s_setprio(0); } while (0)
#define PG8_WAIT_V(n) asm volatile("s_waitcnt vmcnt(" #n ")" ::: "memory")
#define PG8_WAIT_L(n) asm volatile("s_waitcnt lgkmcnt(" #n ")" ::: "memory")
#define PG8_BAR __builtin_amdgcn_s_barrier()
#define PG8_SCHED __builtin_amdgcn_sched_barrier(0)
    Unit cur, nxt; int ui = 0;
    if (!S.next(0, cur)) return;
    f32x4 acc[2][2][4][2];
#pragma unroll
    for (int a = 0; a < 2; ++a)
#pragma unroll
        for (int b = 0; b < 2; ++b)
#pragma unroll
            for (int m = 0; m < 4; ++m)
#pragma unroll
                for (int n = 0; n < 2; ++n) acc[a][b][m][n] = (f32x4){0.f, 0.f, 0.f, 0.f};
    const int scl_ = 0x7f7f7f7f;
    v8i_t At[4], B0[2], B1[2];
    const char* cA = (const char*)g.A + (size_t)cur.pm * tstep; const char* cB = (const char*)g.Bt + (size_t)cur.pn * tstep;
    S.a_ready(cur);
    if constexpr (SP2) {
        PG8_STAGE(PG8_SB(0, 0), cB, voffB); PG8_STAGE(PG8_SB(0, 1), cB + hstep, voffB); PG8_STAGE(PG8_SA(0, 0), cA, voffA); PG8_STAGE(PG8_SA(0, 1), cA + hstep, voffA);
        if (wr == 1) PG8_BAR;
        PG8_WAIT_V(2); PG8_BAR;
        PG8_STAGE(PG8_SB(1, 0), cB + kstep, voffB); PG8_STAGE(PG8_SA(1, 0), cA + kstep, voffA); PG8_STAGE(PG8_SB(1, 1), cB + hstep + kstep, voffB);
        PG8_WAIT_V(6); PG8_BAR;
    } else {
        PG8_STAGE(PG8_SB(0, 0), cB, voffB); PG8_STAGE(PG8_SA(0, 0), cA, voffA); PG8_STAGE(PG8_SB(0, 1), cB + hstep, voffB); PG8_STAGE(PG8_SA(0, 1), cA + hstep, voffA);
        if (wr == 1) PG8_BAR;
        PG8_WAIT_V(4); PG8_BAR;
        PG8_STAGE(PG8_SB(1, 0), cB + kstep, voffB); PG8_STAGE(PG8_SA(1, 0), cA + kstep, voffA); PG8_STAGE(PG8_SB(1, 1), cB + hstep + kstep, voffB);
        PG8_WAIT_V(6); PG8_BAR;
    }
    for (;;) {
        const bool has_next = S.next(ui + 1, nxt);
        const char* nA = has_next ? (const char*)g.A + (size_t)nxt.pm * tstep : cA; const char* nB = has_next ? (const char*)g.Bt + (size_t)nxt.pn * tstep : cB;
        for (int t = 0; t < nt; t += 2) {
            const bool last = (t == nt - 2);
            const char* a1 = cA + (size_t)(t + 1) * kstep;
            const char* a2 = last ? nA : cA + (size_t)(t + 2) * kstep; const char* b2 = last ? nB : cB + (size_t)(t + 2) * kstep;
            const char* a3 = a2 + kstep; const char* b3 = b2 + kstep;
            if (last && has_next) S.a_ready(nxt);
            if constexpr (SP2) {
            PG8_LDB(B0, 0, 0); PG8_LDB(B1, 0, 1); PG8_SCHED; PG8_LDA(At, 0, 0); PG8_STAGE(PG8_SA(1, 1), a1 + hstep, voffA);
            PG8_WAIT_V(8); PG8_WAIT_L(0); PG8_BAR; PG8_MMA(0, 0, At, B0); PG8_MMA(0, 1, At, B1); PG8_BAR; PG8_SCHED;
            PG8_LDA(At, 0, 1); PG8_STAGE(PG8_SB(0, 0), b2, voffB); PG8_STAGE(PG8_SB(0, 1), b2 + hstep, voffB); PG8_STAGE(PG8_SA(0, 0), a2, voffA);
            PG8_WAIT_V(8); PG8_WAIT_L(0); PG8_BAR; PG8_MMA(1, 0, At, B0); PG8_MMA(1, 1, At, B1); PG8_BAR; PG8_SCHED;
            PG8_LDB(B0, 1, 0); PG8_LDB(B1, 1, 1); PG8_SCHED; PG8_LDA(At, 1, 0); PG8_STAGE(PG8_SA(0, 1), a2 + hstep, voffA);
            PG8_WAIT_V(8); PG8_WAIT_L(0); PG8_BAR; PG8_MMA(0, 0, At, B0); PG8_MMA(0, 1, At, B1); PG8_BAR; PG8_SCHED;
            PG8_LDA(At, 1, 1); PG8_STAGE(PG8_SB(1, 0), b3, voffB); PG8_STAGE(PG8_SB(1, 1), b3 + hstep, voffB); PG8_STAGE(PG8_SA(1, 0), a3, voffA);
            PG8_WAIT_V(8); PG8_WAIT_L(0); PG8_BAR; PG8_MMA(1, 0, At, B0); PG8_MMA(1, 1, At, B1); PG8_BAR; PG8_SCHED;
            } else {
            PG8_LDB(B0, 0, 0); PG8_SCHED; PG8_LDA(At, 0, 0); PG8_STAGE(PG8_SA(1, 1), a1 + hstep, voffA);
            PG8_WAIT_L(8); PG8_BAR; PG8_WAIT_L(0); PG8_MMA(0, 0, At, B0); PG8_BAR; PG8_SCHED;
            PG8_LDB(B1, 0, 1); PG8_STAGE(PG8_SB(0, 0), b2, voffB);
            PG8_BAR; PG8_WAIT_L(0); PG8_MMA(0, 1, At, B1); PG8_BAR;
            PG8_LDA(At, 0, 1); PG8_STAGE(PG8_SA(0, 0), a2, voffA);
            PG8_BAR; PG8_WAIT_L(0); PG8_MMA(1, 0, At, B0); PG8_BAR; PG8_SCHED;
            PG8_STAGE(PG8_SB(0, 1), b2 + hstep, voffB);
            PG8_WAIT_V(6); PG8_BAR; PG8_MMA(1, 1, At, B1); PG8_BAR;
            PG8_LDB(B0, 1, 0); PG8_SCHED; PG8_LDA(At, 1, 0); PG8_STAGE(PG8_SA(0, 1), a2 + hstep, voffA);
            PG8_WAIT_L(8); PG8_BAR; PG8_WAIT_L(0); PG8_MMA(0, 0, At, B0); PG8_BAR; PG8_SCHED;
            PG8_LDB(B1, 1, 1); PG8_STAGE(PG8_SB(1, 0), b3, voffB);
            PG8_BAR; PG8_WAIT_L(0); PG8_MMA(0, 1, At, B1); PG8_BAR;
            PG8_LDA(At, 1, 1); PG8_STAGE(PG8_SA(1, 0), a3, voffA);
            PG8_BAR; PG8_WAIT_L(0); PG8_MMA(1, 0, At, B0); PG8_BAR; PG8_SCHED;
            PG8_STAGE(PG8_SB(1, 1), b3 + hstep, voffB);
            PG8_WAIT_V(6); PG8_BAR; PG8_MMA(1, 1, At, B1); PG8_BAR;
            }
        }
        if constexpr (ALIGN_EPI) { if (wr == 0) PG8_BAR; }
        asm volatile("s_nop 15\n\ts_nop 15" ::: "memory");
        if constexpr (!Epi::AFTER_DRAIN) { E(acc, cur, wr, wc, fr, fq); S.done(cur); }
        if (!has_next) break;
#pragma unroll
        for (int a = 0; a < 2; ++a)
#pragma unroll
            for (int b = 0; b < 2; ++b)
#pragma unroll
                for (int m = 0; m < 4; ++m)
#pragma unroll
                    for (int n = 0; n < 2; ++n) acc[a][b][m][n] = (f32x4){0.f, 0.f, 0.f, 0.f};
        cur = nxt; cA = nA; cB = nB; ++ui;
        if constexpr (ALIGN_EPI) { if (wr == 1) PG8_BAR; }
    }
    PG8_WAIT_V(0);
    if constexpr (!ALIGN_EPI) { if (wr == 0) PG8_BAR; }
    PG8_BAR;
    if constexpr (Epi::AFTER_DRAIN) { E.fused(acc, cur, wr, wc, fr, fq, lds, wid, lane); S.done(cur); }
#undef PG8_SA
#undef PG8_SB
#undef PG8_STAGE
#undef PG8_LDA
#undef PG8_LDB
#undef PG8_MMA
#undef PG8_WAIT_V
#undef PG8_WAIT_L
#undef PG8_BAR
#undef PG8_SCHED
}

template <class Epi, class Sched>
__device__ __forceinline__ void gemm_phase_gather_f8(PG8_LAS unsigned char* lds, const Gemm g, const Sched& S, const Epi& E) {
    constexpr bool ALIGN_EPI = true, SP2 = true;
    const int tid = threadIdx.x, wid = __builtin_amdgcn_readfirstlane(tid >> 6), lane = tid & 63, wr = wid >> 2, wc = wid & 3, fr = lane & 15, fq = lane >> 4;
    const int K = g.K, nt = K / BK;
    unsigned voffA[2], voffB[2];
#pragma unroll
    for (int i = 0; i < 2; ++i) { int R, C; stage_rc(tid * 16 + i * 8192, R, C); const int Rb = Epi::PERM ? ((R & ~31) + perm32(R & 31)) : R;
        voffA[i] = (unsigned)(R * K + C) * 2u; voffB[i] = (unsigned)(Rb * K + C) * 2u; }
    const size_t kstep = (size_t)(BK * 2);
    const size_t hstep = (size_t)HALF * K * 2;
    const size_t tstep = 2 * hstep;
    const unsigned ldsw = (unsigned)wid * 1024u;
    const int aoff = lds_byte(wr * 64 + fr, fq * 8), boff = lds_byte(wc * 32 + fr, fq * 8);
#define PG8_SA(b, h) (((b) * 2 + (h)) * HTB)
#define PG8_SB(b, h) ((4 + (b) * 2 + (h)) * HTB)
#define PG8_STAGE(bufoff, gbase, voff) do { _Pragma("unroll") for (int _i = 0; _i < 2; ++_i) \
        __builtin_amdgcn_global_load_lds((const unsigned*)((const char*)(gbase) + (voff)[_i]), (PG8_LAS unsigned*)(lds + (bufoff) + ldsw + _i * 8192), 16, 0, 0); } while (0)
#define PG8_LDA(dst, b, h) do { _Pragma("unroll") for (int m = 0; m < 4; ++m) { const v4i_t lo_ = *(const PG8_LAS v4i_t*)(lds + PG8_SA(b, h) + aoff + m * 2048), hi_ = *(const PG8_LAS v4i_t*)(lds + PG8_SA(b, h) + aoff + m * 2048 + 1024); dst[m] = __builtin_shufflevector(lo_, hi_, 0, 1, 2, 3, 4, 5, 6, 7); } } while (0)
#define PG8_LDB(dst, b, h) do { _Pragma("unroll") for (int n = 0; n < 2; ++n) { const v4i_t lo_ = *(const PG8_LAS v4i_t*)(lds + PG8_SB(b, h) + boff + n * 2048), hi_ = *(const PG8_LAS v4i_t*)(lds + PG8_SB(b, h) + boff + n * 2048 + 1024); dst[n] = __builtin_shufflevector(lo_, hi_, 0, 1, 2, 3, 4, 5, 6, 7); } } while (0)
#define PG8_MMA(ai, bj, At, Bt) do { __builtin_amdgcn_s_setprio(1); _Pragma("unroll") for (int m = 0; m < 4; ++m) _Pragma("unroll") for (int n = 0; n < 2; ++n) \
        asm volatile("v_mfma_scale_f32_16x16x128_f8f6f4 %0, %1, %2, %0, %3, %3 op_sel_hi:[0,0,0]" : "+v"(acc[ai][bj][m][n]) : "v"(Bt[n]), "v"(At[m]), "v"(scl_)); __builtin_amdgcn_s_setprio(0); } while (0)
#define PG8_WAIT_V(n) asm volatile("s_waitcnt vmcnt(" #n ")" ::: "memory")
#define PG8_WAIT_L(n) asm volatile("s_waitcnt lgkmcnt(" #n ")" ::: "memory")
#define PG8_BAR __builtin_amdgcn_s_barrier()
#define PG8_SCHED __builtin_amdgcn_sched_barrier(0)
    Unit cur, nxt; int ui = 0;
    if (!S.next(0, cur)) return;
    int rA[2]; unsigned cAo[2];
#pragma unroll
    for (int i = 0; i < 2; ++i) { int R, C; stage_rc(tid * 16 + i * 8192, R, C); rA[i] = R; cAo[i] = (unsigned)C * 2u; }
    unsigned cO[2][2], o2[2][2]; int nR[2][2];
#define PG8_ROWS(dst, u) do { _Pragma("unroll") for (int h_ = 0; h_ < 2; ++h_) _Pragma("unroll") for (int i_ = 0; i_ < 2; ++i_) \
        dst[h_][i_] = (unsigned)S.arow(u, h_ * HALF + rA[i_]) * (unsigned)(K * 2) + cAo[i_]; } while (0)
    PG8_ROWS(cO, cur);
    f32x4 acc[2][2][4][2];
#pragma unroll
    for (int a = 0; a < 2; ++a)
#pragma unroll
        for (int b = 0; b < 2; ++b)
#pragma unroll
            for (int m = 0; m < 4; ++m)
#pragma unroll
                for (int n = 0; n < 2; ++n) acc[a][b][m][n] = (f32x4){0.f, 0.f, 0.f, 0.f};
    const int scl_ = 0x7f7f7f7f;
    v8i_t At[4], B0[2], B1[2];
    const char* const Ab = (const char*)g.A; const char* cB = (const char*)g.Bt + (size_t)cur.pn * tstep;
    S.a_ready(cur);
    if constexpr (SP2) {
        PG8_STAGE(PG8_SB(0, 0), cB, voffB); PG8_STAGE(PG8_SB(0, 1), cB + hstep, voffB); PG8_STAGE(PG8_SA(0, 0), Ab, cO[0]); PG8_STAGE(PG8_SA(0, 1), Ab, cO[1]);
        if (wr == 1) PG8_BAR;
        PG8_WAIT_V(2); PG8_BAR;
        PG8_STAGE(PG8_SB(1, 0), cB + kstep, voffB); PG8_STAGE(PG8_SA(1, 0), Ab + kstep, cO[0]); PG8_STAGE(PG8_SB(1, 1), cB + hstep + kstep, voffB);
        PG8_WAIT_V(6); PG8_BAR;
    }
    for (;;) {
        const bool has_next = S.next(ui + 1, nxt);
        const char* nB = has_next ? (const char*)g.Bt + (size_t)nxt.pn * tstep : cB;
#pragma unroll
        for (int h_ = 0; h_ < 2; ++h_)
#pragma unroll
            for (int i_ = 0; i_ < 2; ++i_) nR[h_][i_] = has_next ? S.arow(nxt, h_ * HALF + rA[i_]) : 0;
        for (int t = 0; t < nt; t += 2) {
            const bool last = (t == nt - 2);
            const char* a1 = Ab + (size_t)(t + 1) * kstep;
            const char* a2 = last ? Ab : Ab + (size_t)(t + 2) * kstep; const char* b2 = last ? nB : cB + (size_t)(t + 2) * kstep;
#pragma unroll
            for (int h_ = 0; h_ < 2; ++h_)
#pragma unroll
                for (int i_ = 0; i_ < 2; ++i_) o2[h_][i_] = cO[h_][i_];
            if (last && has_next) {
#pragma unroll
                for (int h_ = 0; h_ < 2; ++h_)
#pragma unroll
                    for (int i_ = 0; i_ < 2; ++i_) { int v_ = nR[h_][i_]; asm volatile("" : "+v"(v_)); o2[h_][i_] = (unsigned)v_ * (unsigned)(K * 2) + cAo[i_]; } }
            const char* a3 = a2 + kstep; const char* b3 = b2 + kstep;
            if (last && has_next) S.a_ready(nxt);
            if constexpr (SP2) {
            PG8_LDB(B0, 0, 0); PG8_LDB(B1, 0, 1); PG8_SCHED; PG8_LDA(At, 0, 0); PG8_STAGE(PG8_SA(1, 1), a1, cO[1]);
            PG8_WAIT_V(8); PG8_WAIT_L(0); PG8_BAR; PG8_MMA(0, 0, At, B0); PG8_MMA(0, 1, At, B1); PG8_BAR; PG8_SCHED;
            PG8_LDA(At, 0, 1); PG8_STAGE(PG8_SB(0, 0), b2, voffB); PG8_STAGE(PG8_SB(0, 1), b2 + hstep, voffB); PG8_STAGE(PG8_SA(0, 0), a2, o2[0]);
            PG8_WAIT_V(8); PG8_WAIT_L(0); PG8_BAR; PG8_MMA(1, 0, At, B0); PG8_MMA(1, 1, At, B1); PG8_BAR; PG8_SCHED;
            PG8_LDB(B0, 1, 0); PG8_LDB(B1, 1, 1); PG8_SCHED; PG8_LDA(At, 1, 0); PG8_STAGE(PG8_SA(0, 1), a2, o2[1]);
            PG8_WAIT_V(8); PG8_WAIT_L(0); PG8_BAR; PG8_MMA(0, 0, At, B0); PG8_MMA(0, 1, At, B1); PG8_BAR; PG8_SCHED;
            PG8_LDA(At, 1, 1); PG8_STAGE(PG8_SB(1, 0), b3, voffB); PG8_STAGE(PG8_SB(1, 1), b3 + hstep, voffB); PG8_STAGE(PG8_SA(1, 0), a3, o2[0]);
            PG8_WAIT_V(8); PG8_WAIT_L(0); PG8_BAR; PG8_MMA(1, 0, At, B0); PG8_MMA(1, 1, At, B1); PG8_BAR; PG8_SCHED;
            }
        }
        if constexpr (ALIGN_EPI) { if (wr == 0) PG8_BAR; }
        asm volatile("s_nop 15\n\ts_nop 15" ::: "memory");
        if constexpr (!Epi::AFTER_DRAIN) { E(acc, cur, wr, wc, fr, fq); S.done(cur); }
        if (!has_next) break;
#pragma unroll
        for (int a = 0; a < 2; ++a)
#pragma unroll
            for (int b = 0; b < 2; ++b)
#pragma unroll
                for (int m = 0; m < 4; ++m)
#pragma unroll
                    for (int n = 0; n < 2; ++n) acc[a][b][m][n] = (f32x4){0.f, 0.f, 0.f, 0.f};
        cur = nxt; cB = nB; ++ui;
#pragma unroll
        for (int h_ = 0; h_ < 2; ++h_)
#pragma unroll
            for (int i_ = 0; i_ < 2; ++i_) cO[h_][i_] = o2[h_][i_];
        if constexpr (ALIGN_EPI) { if (wr == 1) PG8_BAR; }
    }
    PG8_WAIT_V(0);
    if constexpr (!ALIGN_EPI) { if (wr == 0) PG8_BAR; }
    PG8_BAR;
    if constexpr (Epi::AFTER_DRAIN) { E.fused(acc, cur, wr, wc, fr, fq, lds, wid, lane); S.done(cur); }
#undef PG8_ROWS
#undef PG8_SA
#undef PG8_SB
#undef PG8_STAGE
#undef PG8_LDA
#undef PG8_LDB
#undef PG8_MMA
#undef PG8_WAIT_V
#undef PG8_WAIT_L
#undef PG8_BAR
#undef PG8_SCHED
}
}

typedef short bf16x8c __attribute__((ext_vector_type(8)));
typedef float f32x16c __attribute__((ext_vector_type(16)));
__device__ __forceinline__ void phase_conv(const Params& p, const Ctx& c) {
    unsigned char* ws = p.ws;
    const bf16_t* P = (const bf16_t*)(ws + WS_P);
    const int tid = c.tid;
    LAS bf16_t* raw = (LAS bf16_t*)c.lds;
    LAS bf16_t* outb = (LAS bf16_t*)(c.lds + 132 * 256 * 2);
    for (int it = c.bid; it < 2 * 64 * 6; it += c.G) {
        const int part = it % 6, bc = it / 6, b = bc / 64, ch_ = bc % 64, t0 = ch_ * 128;
        __syncthreads();
        {
            u32x4 rv[9];
#pragma unroll
            for (int i = 0; i < 9; ++i) { const int idx = tid + 512 * i, r = idx >> 5, c8 = idx & 31, tok = t0 - 2 + r;
                rv[i] = (u32x4){0u, 0u, 0u, 0u};
                if (idx < 132 * 32 && tok >= 0 && tok < S) rv[i] = __builtin_nontemporal_load((const u32x4*)(P + (size_t)(b * S + tok) * NPROJ + PXBC + part * 256 + c8 * 8)); }
#pragma unroll
            for (int i = 0; i < 9; ++i) { const int idx = tid + 512 * i, r = idx >> 5, c8 = idx & 31;
                if (idx < 132 * 32) *(LAS u32x4*)(raw + r * 256 + c8 * 8) = rv[i]; }
        }
        __syncthreads();
        {
            const int ch = tid & 255, hf = tid >> 8, cg_ = part * 256 + ch;
            const float* cw = p.in[3]; const float cb = p.in[4][cg_];
            const float w0 = cw[0 * 1536 + cg_], w1 = cw[1 * 1536 + cg_], w2 = cw[2 * 1536 + cg_], w3 = cw[3 * 1536 + cg_], w4 = cw[4 * 1536 + cg_];
            const LAS bf16_t* rp = raw + (hf * 64) * 256 + ch;
            float r0 = bf2f(rp[0 * 256]), r1 = bf2f(rp[1 * 256]), r2 = bf2f(rp[2 * 256]), r3 = bf2f(rp[3 * 256]);
            unsigned ov[32];
#pragma unroll
            for (int i = 0; i < 64; ++i) {
                const float r4 = bf2f(rp[(i + 4) * 256]);
                float a = cb; a = fmaf(w0, r0, a); a = fmaf(w1, r1, a); a = fmaf(w2, r2, a); a = fmaf(w3, r3, a); a = fmaf(w4, r4, a);
                const unsigned hv = f2bf(a * sigmoidf_(a));
                if (i & 1) ov[i >> 1] |= hv << 16; else ov[i >> 1] = hv;
                r0 = r1; r1 = r2; r2 = r3; r3 = r4;
            }
            if (part <= 4) {
                bf16_t* dst = (part < 4 ? (bf16_t*)(ws + WS_XT) + ((size_t)(b * 64 + ch_) * 16 + part * 4) * 64 * 128
                                        : (bf16_t*)(ws + WS_BMT) + (size_t)(b * 64 + ch_) * 2 * 128 * 128) + (size_t)ch * 128 + hf * 64;
#pragma unroll
                for (int q = 0; q < 8; ++q) *(u32x4*)(dst + q * 8) = (u32x4){ov[4 * q], ov[4 * q + 1], ov[4 * q + 2], ov[4 * q + 3]};
            }
            if (part >= 4) {
#pragma unroll
                for (int i = 0; i < 64; ++i) outb[(hf * 64 + i) * 256 + ch] = (bf16_t)((i & 1) ? (ov[i >> 1] >> 16) : (ov[i >> 1] & 0xffffu));
            }
        }
        if (part >= 4) {
            __syncthreads();
            bf16_t* dst = (bf16_t*)(ws + (part == 4 ? WS_BMR : WS_CMR)) + (size_t)(b * S + t0) * 256;
#pragma unroll
            for (int q = 0; q < 8; ++q) { const int idx = tid + 512 * q, l = idx >> 5, c8 = idx & 31;
                *(u32x4*)(dst + (size_t)l * 256 + c8 * 8) = *(const LAS u32x4*)(outb + l * 256 + c8 * 8); }
        }
    }
    {
        float* DT = (float*)(ws + WS_DT); float* ACS = (float*)(ws + WS_ACS); float* CDEC = (float*)(ws + WS_CDEC);
        const bf16_t* H = (const bf16_t*)(ws + WS_H); const bf16_t* Wdt = (const bf16_t*)(ws + WS_WINT) + (size_t)PDT * 1024;
        constexpr int WS_ = 1032;
        LAS bf16_t* wl = (LAS bf16_t*)c.lds; LAS float* dtr = (LAS float*)(c.lds + 32 * WS_ * 2);
        const int lane = c.lane, r = lane & 31, hh = lane >> 5;
        bool staged = false;
        for (int it = c.bid; it < 128; it += c.G) {
            const int b = it / 64, ch_ = it % 64, t0 = ch_ * 128;
            __syncthreads();
            if (!staged) { staged = true;
#pragma unroll
                for (int i = 0; i < 8; ++i) { const int idx = tid + 512 * i, row = idx >> 7, c8 = idx & 127; *(LAS u32x4*)(wl + row * WS_ + c8 * 8) = *(const u32x4*)(Wdt + (size_t)row * 1024 + c8 * 8); }
                __syncthreads(); }
            {
                const int rb = c.wave & 3, kh = c.wave >> 2;
                const bf16_t* hrow = H + ((size_t)b * S + t0 + rb * 32 + r) * 1024 + kh * 512 + 8 * hh;
                f32x16c acc = {};
#pragma unroll
                for (int k8 = 0; k8 < 4; ++k8) { bf16x8c a[8];
#pragma unroll
                    for (int ks = 0; ks < 8; ++ks) a[ks] = *(const bf16x8c*)(hrow + (k8 * 8 + ks) * 16);
#pragma unroll
                    for (int ks = 0; ks < 8; ++ks) acc = __builtin_amdgcn_mfma_f32_32x32x16_bf16(a[ks], *(const LAS bf16x8c*)(wl + r * WS_ + kh * 512 + (k8 * 8 + ks) * 16 + 8 * hh), acc, 0, 0, 0); }
#pragma unroll
                for (int i = 0; i < 16; ++i) { const int l = rb * 32 + (i & 3) + 8 * (i >> 2) + 4 * hh; dtr[(kh * 128 + l) * 33 + r] = acc[i]; }
            }
            __syncthreads();
#pragma unroll
            for (int qi = 0; qi < 4; ++qi) {
                const int q = c.wave * 4 + qi, dir = q >> 4, h = q & 15;
                const float bias = dir ? p.in[6][h] : p.in[5][h], nA = -expf(dir ? p.in[8][h] : p.in[7][h]);
                const int l0 = dir ? 127 - lane : lane, l1 = dir ? 63 - lane : lane + 64;
                const size_t tok0 = (size_t)b * S + t0 + l0, tok1 = (size_t)b * S + t0 + l1;
                const float x0 = dtr[l0 * 33 + q] + dtr[(128 + l0) * 33 + q] + bias, x1 = dtr[l1 * 33 + q] + dtr[(128 + l1) * 33 + q] + bias;
                const float d0 = fmaxf(x0, 0.f) + log1pf(expf(-fabsf(x0))), d1 = fmaxf(x1, 0.f) + log1pf(expf(-fabsf(x1)));
                float a0 = d0 * nA, a1 = d1 * nA;
#pragma unroll
                for (int o = 1; o < 64; o <<= 1) { const float t0_ = __shfl_up(a0, o), t1_ = __shfl_up(a1, o); if (lane >= o) { a0 += t0_; a1 += t1_; } }
                const float tot0 = __shfl(a0, 63); a1 += tot0;
                DT[((size_t)dir * M + tok0) * 16 + h] = d0; DT[((size_t)dir * M + tok1) * 16 + h] = d1;
                ACS[((size_t)dir * M + tok0) * 16 + h] = a0; ACS[((size_t)dir * M + tok1) * 16 + h] = a1;
                if (lane == 63) CDEC[((dir * 2 + b) * 64 + ch_) * 16 + h] = expf(a1);
            }
        }
        __syncthreads();
    }
    {
        const int gw = c.bid * 8 + c.wave, NGW = c.G * 8, lane = c.lane;
        const float* rc = (const float*)(ws + WS_ROPE); const float* rs = rc + 4096;
        const int sub = lane >> 4, j = lane & 15, axis = j >> 3, i0 = 8 * (j & 3); const bool second = (j & 4) != 0;
        const f32x4 gq0 = *(const f32x4*)(p.in[11] + 8 * j), gq1 = *(const f32x4*)(p.in[11] + 8 * j + 4), gk0 = *(const f32x4*)(p.in[12] + 8 * j), gk1 = *(const f32x4*)(p.in[12] + 8 * j + 4);
        unsigned char* QN = ws + WS_QN; unsigned char* KN = ws + WS_KN;
        for (int base0 = gw; base0 < M * 10 / 4; base0 += 4 * NGW) {
            u32x4 vq[4]; int tokq[4], hhq[4];
#pragma unroll
            for (int u = 0; u < 4; ++u) { const int base = base0 + u * NGW, it = base * 4 + sub; tokq[u] = it / 10; hhq[u] = it % 10;
                vq[u] = (u32x4){0u, 0u, 0u, 0u};
                if (base < M * 10 / 4) vq[u] = __builtin_nontemporal_load((const u32x4*)(P + (size_t)tokq[u] * NPROJ + (hhq[u] < 8 ? PQ + hhq[u] * 128 : PK + (hhq[u] - 8) * 128) + 8 * j)); }
#pragma unroll
            for (int u = 0; u < 4; ++u) {
                const int base = base0 + u * NGW, tok = tokq[u], hh = hhq[u];
                unsigned char* dst = (hh < 8 ? QN + (size_t)tok * 1024 + hh * 128 : KN + (size_t)tok * 256 + (hh - 8) * 128) + 8 * j;
                const u32x4 v = vq[u];
                float y[8] = {bflo(v.x), bfhi(v.x), bflo(v.y), bfhi(v.y), bflo(v.z), bfhi(v.z), bflo(v.w), bfhi(v.w)};
                float ss = 0.f;
#pragma unroll
                for (int i = 0; i < 8; ++i) ss = fmaf(y[i], y[i], ss);
                ss += __shfl_xor(ss, 1); ss += __shfl_xor(ss, 2); ss += __shfl_xor(ss, 4); ss += __shfl_xor(ss, 8);
                const float rstd = rsqrtf(ss * (1.f / 128.f) + EPS);
                const f32x4 g0 = hh < 8 ? gq0 : gk0, g1 = hh < 8 ? gq1 : gk1;
#pragma unroll
                for (int i = 0; i < 4; ++i) { y[i] *= rstd * g0[i]; y[4 + i] *= rstd * g1[i]; }
                const int s = tok & (S - 1), pos = axis ? (s & 63) : (s >> 6);
                const f32x4 c0 = *(const f32x4*)(rc + pos * 32 + i0), c1 = *(const f32x4*)(rc + pos * 32 + i0 + 4), s0 = *(const f32x4*)(rs + pos * 32 + i0), s1 = *(const f32x4*)(rs + pos * 32 + i0 + 4);
                float o[8];
#pragma unroll
                for (int i = 0; i < 8; ++i) { const float other = __shfl_xor(y[i], 4); const float cs = i < 4 ? c0[i] : c1[i - 4], sn = i < 4 ? s0[i] : s1[i - 4];
                    o[i] = second ? fmaf(other, sn, y[i] * cs) : fmaf(-other, sn, y[i] * cs); }
                u32x2 w; w.x = pack4_fp8(o[0], o[1], o[2], o[3]); w.y = pack4_fp8(o[4], o[5], o[6], o[7]);
                if (base < M * 10 / 4) *(u32x2*)dst = w;
            }
        }
    }
    {
        unsigned char* VT8 = ws + WS_VB; LAS unsigned char* vt = c.lds;
        for (int it = c.bid; it < 256; it += c.G) {
            const int b = it >> 7, jt = it & 127;
            __syncthreads();
            u32x4 vv[4];
#pragma unroll
            for (int q = 0; q < 4; ++q) { const int idx = tid + 512 * q, key = idx >> 5, c8 = idx & 31; vv[q] = __builtin_nontemporal_load((const u32x4*)(P + ((size_t)b * S + jt * 64 + key) * NPROJ + PV + c8 * 8)); }
#pragma unroll
            for (int q = 0; q < 4; ++q) { const int idx = tid + 512 * q, key = idx >> 5, c8 = idx & 31, d0 = c8 * 8;
                const int off = 32 * ((key >> 2) & 1) + 16 * (key >> 5) + (key & 3) + 4 * ((key & 31) >> 3);
                const unsigned w0 = pack4_fp8(bflo(vv[q].x), bfhi(vv[q].x), bflo(vv[q].y), bfhi(vv[q].y)), w1 = pack4_fp8(bflo(vv[q].z), bfhi(vv[q].z), bflo(vv[q].w), bfhi(vv[q].w));
                LAS unsigned char* dp = vt + d0 * 64 + off;
                dp[0 * 64] = (unsigned char)(w0); dp[1 * 64] = (unsigned char)(w0 >> 8); dp[2 * 64] = (unsigned char)(w0 >> 16); dp[3 * 64] = (unsigned char)(w0 >> 24);
                dp[4 * 64] = (unsigned char)(w1); dp[5 * 64] = (unsigned char)(w1 >> 8); dp[6 * 64] = (unsigned char)(w1 >> 16); dp[7 * 64] = (unsigned char)(w1 >> 24); }
            __syncthreads();
#pragma unroll
            for (int q = 0; q < 2; ++q) { const int idx = tid + 512 * q, kvh = idx >> 9, rem = idx & 511;
                *(u32x4*)(VT8 + ((size_t)(b * 2 + kvh) * 128 + jt) * 8192 + rem * 16) = *(const LAS u32x4*)(vt + kvh * 8192 + rem * 16); }
        }
        __syncthreads();
    }
}

typedef short bf16x8 __attribute__((ext_vector_type(8)));
typedef float f32x16 __attribute__((ext_vector_type(16)));
constexpr int TS = 136;
__device__ __forceinline__ bf16x8 ldfrag(const LAS bf16_t* tile, int row, int k0) { return *(const LAS bf16x8*)(tile + row * TS + k0); }
template <int ROWS> __device__ __forceinline__ void load_tile128(LAS bf16_t* dst, const bf16_t* src, int ld, int tid) {
    constexpr int N = ROWS * 16 / 512;
    u32x4 v[N];
#pragma unroll
    for (int i = 0; i < N; ++i) { const int idx = tid + 512 * i; v[i] = *(const u32x4*)(src + (size_t)(idx >> 4) * ld + (idx & 15) * 8); }
#pragma unroll
    for (int i = 0; i < N; ++i) { const int idx = tid + 512 * i; *(LAS u32x4*)(dst + (idx >> 4) * TS + (idx & 15) * 8) = v[i]; }
}
__device__ __forceinline__ void phase_ssd_states(const Params& p, const Ctx& c) {
    unsigned char* ws = p.ws;
    const bf16_t* XT = (const bf16_t*)(ws + WS_XT); const bf16_t* BMT = (const bf16_t*)(ws + WS_BMT);
    const float* DT = (const float*)(ws + WS_DT); const float* ACS = (const float*)(ws + WS_ACS); bf16_t* ST = (bf16_t*)(ws + WS_PREV);
    LAS bf16_t* BTs = (LAS bf16_t*)c.lds; LAS bf16_t* XTf = BTs + 128 * TS; LAS bf16_t* XTb = XTf + 64 * TS; LAS float* wd = (LAS float*)(XTb + 64 * TS);
    const int tid = c.tid, lane = c.lane, r = lane & 31, hh = lane >> 5;
    for (int unit = c.bid; unit < 256; unit += c.G) {
        const int b = unit >> 7, ch = (unit >> 1) & 63, g = unit & 1;
        __syncthreads();
        load_tile128<128>(BTs, BMT + ((size_t)(b * 64 + ch) * 2 + g) * 128 * 128, 128, tid);
        u32x4 xv0, xv1; float pacs = 0.f, pdt = 0.f, paend = 0.f;
        const int wd_d = (tid >> 7) & 1, wd_l = tid & 127; const size_t wd_t0 = (size_t)wd_d * M + (size_t)b * S + ch * 128;
#define S1_PREFETCH(H) do { const bf16_t* xt_ = XT + ((size_t)(b * 64 + ch) * 16 + (H)) * 64 * 128; \
            xv0 = *(const u32x4*)(xt_ + (tid >> 4) * 128 + (tid & 15) * 8); xv1 = *(const u32x4*)(xt_ + ((tid + 512) >> 4) * 128 + (tid & 15) * 8); \
            if (tid < 256) { pacs = ACS[(wd_t0 + wd_l) * 16 + (H)]; pdt = DT[(wd_t0 + wd_l) * 16 + (H)]; paend = ACS[(wd_t0 + (wd_d ? 0 : 127)) * 16 + (H)]; } } while (0)
        S1_PREFETCH(g * 8);
#pragma unroll 1
        for (int h8 = 0; h8 < 8; ++h8) {
            const int h = g * 8 + h8;
            __syncthreads();
            if (tid < 256) wd[wd_d * 128 + wd_l] = pdt * __expf(paend - pacs);
            __syncthreads();
            {
                const u32x4 vv[2] = {xv0, xv1};
#pragma unroll
                for (int i = 0; i < 2; ++i) { const int idx = tid + 512 * i, pr = idx >> 4, l0 = (idx & 15) * 8; const u32x4 v = vv[i];
                    const float x[8] = {bflo(v.x), bfhi(v.x), bflo(v.y), bfhi(v.y), bflo(v.z), bfhi(v.z), bflo(v.w), bfhi(v.w)};
                    const f32x4 wf0 = *(const LAS f32x4*)(wd + l0), wf1 = *(const LAS f32x4*)(wd + l0 + 4), wb0 = *(const LAS f32x4*)(wd + 128 + l0), wb1 = *(const LAS f32x4*)(wd + 128 + l0 + 4);
                    u32x4 of, ob;
                    of.x = pk2(x[0] * wf0[0], x[1] * wf0[1]); of.y = pk2(x[2] * wf0[2], x[3] * wf0[3]); of.z = pk2(x[4] * wf1[0], x[5] * wf1[1]); of.w = pk2(x[6] * wf1[2], x[7] * wf1[3]);
                    ob.x = pk2(x[0] * wb0[0], x[1] * wb0[1]); ob.y = pk2(x[2] * wb0[2], x[3] * wb0[3]); ob.z = pk2(x[4] * wb1[0], x[5] * wb1[1]); ob.w = pk2(x[6] * wb1[2], x[7] * wb1[3]);
                    *(LAS u32x4*)(XTf + pr * TS + l0) = of; *(LAS u32x4*)(XTb + pr * TS + l0) = ob; }
            }
            if (h8 < 7) S1_PREFETCH(h + 1);
            __syncthreads();
            { const int d = c.wave >> 2, nb = c.wave & 3; const LAS bf16_t* XTd = d ? XTb : XTf;
              bf16_t* st = ST + ((((size_t)(d * 2 + b) * 64 + ch) * 16 + h) * 64) * 128;
#pragma unroll
              for (int pb = 0; pb < 2; ++pb) { f32x16 acc = {};
#pragma unroll
                for (int ks = 0; ks < 8; ++ks) acc = __builtin_amdgcn_mfma_f32_32x32x16_bf16(ldfrag(XTd, pb * 32 + r, ks * 16 + 8 * hh), ldfrag(BTs, nb * 32 + r, ks * 16 + 8 * hh), acc, 0, 0, 0);
#pragma unroll
                for (int i = 0; i < 16; ++i) { const int pp = pb * 32 + (i & 3) + 8 * (i >> 2) + 4 * hh; st[(size_t)pp * 128 + nb * 32 + r] = (bf16_t)f2bf(acc[i]); } } }
        }
#undef S1_PREFETCH
    }
}
__device__ __forceinline__ void phase_ssd_scan(const Params& p, const Ctx& c) {
    unsigned char* ws = p.ws;
    const float* CDEC = (const float*)(ws + WS_CDEC); bf16_t* PREV = (bf16_t*)(ws + WS_PREV);
    for (int idx = c.bid * 512 + c.tid; idx < 131072; idx += c.G * 512) {
        const int n4 = idx & 31, pp = (idx >> 5) & 63, h = (idx >> 11) & 15, b = (idx >> 15) & 1, d = idx >> 16;
        f32x4 run = {0.f, 0.f, 0.f, 0.f};
        const size_t obase = ((size_t)(d * 2 + b) * 64 * 16 + h) * 64 * 128 + (size_t)pp * 128 + n4 * 4;
        const float* cd = CDEC + (d * 2 + b) * 64 * 16 + h;
#pragma unroll 1
        for (int s0 = 0; s0 < 64; s0 += 16) {
            u32x2 sv[16]; float dec[16];
#pragma unroll
            for (int i = 0; i < 16; ++i) { const int ch = d ? 63 - (s0 + i) : s0 + i; sv[i] = __builtin_nontemporal_load((const u32x2*)(PREV + obase + (size_t)ch * (16 * 64 * 128))); dec[i] = cd[ch * 16]; }
#pragma unroll
            for (int i = 0; i < 16; ++i) { const int ch = d ? 63 - (s0 + i) : s0 + i;
                u32x2 w; w.x = pk2(run.x, run.y); w.y = pk2(run.z, run.w); *(u32x2*)(PREV + obase + (size_t)ch * (16 * 64 * 128)) = w;
                run.x = fmaf(run.x, dec[i], bflo(sv[i].x)); run.y = fmaf(run.y, dec[i], bfhi(sv[i].x)); run.z = fmaf(run.z, dec[i], bflo(sv[i].y)); run.w = fmaf(run.w, dec[i], bfhi(sv[i].y)); }
        }
    }
}
__device__ __forceinline__ void phase_ssd_out(const Params& p, const Ctx& c) {
    unsigned char* ws = p.ws;
    const bf16_t* P = (const bf16_t*)(ws + WS_P); const bf16_t* XT = (const bf16_t*)(ws + WS_XT);
    const bf16_t* BMR = (const bf16_t*)(ws + WS_BMR); const bf16_t* CMR = (const bf16_t*)(ws + WS_CMR); const bf16_t* PREV = (const bf16_t*)(ws + WS_PREV);
    const float* DT = (const float*)(ws + WS_DT); const float* ACS = (const float*)(ws + WS_ACS); bf16_t* YZ = (bf16_t*)(ws + WS_YZ);
    LAS bf16_t* Cs = (LAS bf16_t*)c.lds; LAS bf16_t* Ms = Cs + 128 * TS; LAS bf16_t* XTs = Ms + 128 * TS; LAS bf16_t* PF = XTs + 64 * TS; LAS bf16_t* PB = PF + 64 * TS;
    LAS float* vec = (LAS float*)(PB + 64 * TS);
    constexpr int ZS = 72; LAS bf16_t* Zs = (LAS bf16_t*)(vec + 512); LAS float* dskl = (LAS float*)(Zs + 128 * ZS);
    const int tid = c.tid, lane = c.lane, r = lane & 31, hh = lane >> 5, wave = c.wave;
    for (int unit = c.bid; unit < 256; unit += c.G) {
        const int b = unit >> 7, ch = (unit >> 1) & 63, g = unit & 1;
        const size_t tok0 = (size_t)b * S + ch * 128;
        __syncthreads();
        load_tile128<128>(Cs, CMR + tok0 * 256 + g * 128, 256, tid);
        load_tile128<128>(Ms, BMR + tok0 * 256 + g * 128, 256, tid);
        u32x4 px0, px1, pf0, pf1, pb0, pb1, pz0, pz1; float pvec;
        const int t_r0 = tid >> 4, t_r1 = (tid + 512) >> 4, t_c = (tid & 15) * 8;
#define S3_PREFETCH(H) do { const bf16_t* xt_ = XT + ((size_t)(b * 64 + ch) * 16 + (H)) * 64 * 128; \
            const bf16_t* f_ = PREV + ((((size_t)(0 * 2 + b) * 64 + ch) * 16 + (H)) * 64) * 128; const bf16_t* b_ = PREV + ((((size_t)(1 * 2 + b) * 64 + ch) * 16 + (H)) * 64) * 128; \
            px0 = __builtin_nontemporal_load((const u32x4*)(xt_ + t_r0 * 128 + t_c)); px1 = __builtin_nontemporal_load((const u32x4*)(xt_ + t_r1 * 128 + t_c)); pf0 = __builtin_nontemporal_load((const u32x4*)(f_ + t_r0 * 128 + t_c)); pf1 = __builtin_nontemporal_load((const u32x4*)(f_ + t_r1 * 128 + t_c)); \
            pb0 = __builtin_nontemporal_load((const u32x4*)(b_ + t_r0 * 128 + t_c)); pb1 = __builtin_nontemporal_load((const u32x4*)(b_ + t_r1 * 128 + t_c)); \
            pz0 = __builtin_nontemporal_load((const u32x4*)(P + (tok0 + (tid >> 3)) * NPROJ + PZ + (H) * 64 + (tid & 7) * 8)); pz1 = __builtin_nontemporal_load((const u32x4*)(P + (tok0 + 64 + (tid >> 3)) * NPROJ + PZ + (H) * 64 + (tid & 7) * 8)); \
            { const int v_ = tid >> 7, l_ = tid & 127; const size_t o_ = ((size_t)(v_ & 1) * M + tok0 + l_) * 16 + (H); pvec = (v_ < 2) ? ACS[o_] : DT[o_]; } } while (0)
        S3_PREFETCH(g * 8);
        if (tid < 8) dskl[tid] = p.in[9][g * 8 + tid];
        __syncthreads();
        const int lb = wave & 3, sb0 = 2 * (wave >> 2);
        f32x16 G0 = {}, G1 = {};
#pragma unroll
        for (int ks = 0; ks < 8; ++ks) { const bf16x8 a = ldfrag(Cs, lb * 32 + r, ks * 16 + 8 * hh);
            G0 = __builtin_amdgcn_mfma_f32_32x32x16_bf16(a, ldfrag(Ms, sb0 * 32 + r, ks * 16 + 8 * hh), G0, 0, 0, 0);
            G1 = __builtin_amdgcn_mfma_f32_32x32x16_bf16(a, ldfrag(Ms, (sb0 + 1) * 32 + r, ks * 16 + 8 * hh), G1, 0, 0, 0); }
#pragma unroll 1
        for (int h8 = 0; h8 < 8; ++h8) {
            const int h = g * 8 + h8;
            __syncthreads();
            vec[tid] = pvec;
            *(LAS u32x4*)(XTs + t_r0 * TS + t_c) = px0; *(LAS u32x4*)(XTs + t_r1 * TS + t_c) = px1;
            *(LAS u32x4*)(PF + t_r0 * TS + t_c) = pf0; *(LAS u32x4*)(PF + t_r1 * TS + t_c) = pf1;
            *(LAS u32x4*)(PB + t_r0 * TS + t_c) = pb0; *(LAS u32x4*)(PB + t_r1 * TS + t_c) = pb1;
            *(LAS u32x4*)(Zs + (tid >> 3) * ZS + (tid & 7) * 8) = pz0; *(LAS u32x4*)(Zs + (64 + (tid >> 3)) * ZS + (tid & 7) * 8) = pz1;
            if (h8 < 7) S3_PREFETCH(h + 1);
            const int pbY = wave >> 2;
            __syncthreads();
#pragma unroll
            for (int t2 = 0; t2 < 2; ++t2) { const f32x16& Gt = t2 ? G1 : G0; const int sb = sb0 + t2, s = sb * 32 + r;
                const float afs = vec[s], abs_ = vec[128 + s], dfs = vec[256 + s], dbs = vec[384 + s];
                if (sb < lb) {
#pragma unroll
                    for (int i = 0; i < 16; ++i) { const int l = lb * 32 + (i & 3) + 8 * (i >> 2) + 4 * hh;
                        Ms[l * TS + s] = (bf16_t)f2bf(Gt[i] * __expf(vec[l] - afs) * dfs); }
                } else if (sb > lb) {
#pragma unroll
                    for (int i = 0; i < 16; ++i) { const int l = lb * 32 + (i & 3) + 8 * (i >> 2) + 4 * hh;
                        Ms[l * TS + s] = (bf16_t)f2bf(Gt[i] * __expf(vec[128 + l] - abs_) * dbs); }
                } else {
                    const float dsk = dskl[h8];
#pragma unroll
                    for (int i = 0; i < 16; ++i) { const int l = lb * 32 + (i & 3) + 8 * (i >> 2) + 4 * hh;
                        const float ef = __expf(fminf(vec[l] - afs, 0.f)) * dfs, eb = __expf(fminf(vec[128 + l] - abs_, 0.f)) * dbs;
                        const float tf = (s <= l) ? ef : 0.f, tb = (s >= l) ? eb : 0.f;
                        Ms[l * TS + s] = (bf16_t)f2bf(Gt[i] * (tf + tb) + (s == l ? dsk : 0.f)); }
                } }
            __syncthreads();
            { f32x16 Yd = {}, Yf = {}, Yb = {};
#pragma unroll
              for (int ks = 0; ks < 8; ++ks) { const int k0 = ks * 16 + 8 * hh;
                  Yd = __builtin_amdgcn_mfma_f32_32x32x16_bf16(ldfrag(Ms, lb * 32 + r, k0), ldfrag(XTs, pbY * 32 + r, k0), Yd, 0, 0, 0);
                  const bf16x8 a = ldfrag(Cs, lb * 32 + r, k0);
                  Yf = __builtin_amdgcn_mfma_f32_32x32x16_bf16(a, ldfrag(PF, pbY * 32 + r, k0), Yf, 0, 0, 0);
                  Yb = __builtin_amdgcn_mfma_f32_32x32x16_bf16(a, ldfrag(PB, pbY * 32 + r, k0), Yb, 0, 0, 0);
                  if (ks & 1) __builtin_amdgcn_sched_barrier(0); }
#pragma unroll
              for (int i = 0; i < 16; ++i) { const int l = lb * 32 + (i & 3) + 8 * (i >> 2) + 4 * hh;
                  const float y = Yd[i] + __expf(vec[l]) * Yf[i] + __expf(vec[128 + l]) * Yb[i];
                  const float z = bf2f(Zs[l * ZS + pbY * 32 + r]);
                  Zs[l * ZS + pbY * 32 + r] = (bf16_t)f2bf(y * z * sigmoidf_(z)); } }
            __syncthreads();
            *(u32x4*)(YZ + (tok0 + (tid >> 3)) * 1024 + h * 64 + (tid & 7) * 8) = *(const LAS u32x4*)(Zs + (tid >> 3) * ZS + (tid & 7) * 8);
            *(u32x4*)(YZ + (tok0 + 64 + (tid >> 3)) * 1024 + h * 64 + (tid & 7) * 8) = *(const LAS u32x4*)(Zs + (64 + (tid >> 3)) * ZS + (tid & 7) * 8);
        }
#undef S3_PREFETCH
    }
}

__device__ __forceinline__ void phase_rstd(const Params& p, const Ctx& c) {
    const bf16_t* YZ = (const bf16_t*)(p.ws + WS_YZ); float* RSTD = (float*)(p.ws + WS_RSTD);
    const int gw = c.bid * 8 + c.wave, NGW = c.G * 8;
    for (int m0 = gw * 4; m0 < M; m0 += NGW * 4) {
        u32x4 v[4][2];
#pragma unroll
        for (int q = 0; q < 4; ++q) { const u32x4* r = (const u32x4*)(YZ + (size_t)(m0 + q) * 1024) + c.lane; v[q][0] = r[0]; v[q][1] = r[64]; }
#pragma unroll
        for (int q = 0; q < 4; ++q) { float s = 0.f;
#pragma unroll
            for (int j = 0; j < 2; ++j) { const u32x4 w = v[q][j];
                s += bflo(w.x) * bflo(w.x) + bfhi(w.x) * bfhi(w.x) + bflo(w.y) * bflo(w.y) + bfhi(w.y) * bfhi(w.y) + bflo(w.z) * bflo(w.z) + bfhi(w.z) * bfhi(w.z) + bflo(w.w) * bflo(w.w) + bfhi(w.w) * bfhi(w.w); }
            s = wave_sum(s);
            if (c.lane == 0) RSTD[m0 + q] = rsqrtf(s * (1.f / 1024.f) + EPS); }
    }
}

namespace attn8 {
typedef int v8i __attribute__((ext_vector_type(8)));
typedef float f32x16 __attribute__((ext_vector_type(16)));
typedef unsigned u32x4_ __attribute__((ext_vector_type(4)));
constexpr int QBLK = 32, KVBLK = 64;
constexpr float SCALE = 0.088388347648318440f;
constexpr float THR = 0.69f;
constexpr size_t SHM_K = 64 * 128, SHM_V = 128 * 64, SHM_ATTN = 2 * SHM_K + 2 * SHM_V + 8 * 64 * 4;
__device__ __forceinline__ int crow(int r, int hi) { return (r & 3) + 8 * (r >> 2) + 4 * hi; }
__device__ __forceinline__ int kswz(int row, int colB) { return row * 128 + (colB ^ (((row >> 1) & 7) << 4)); }
__device__ __forceinline__ int vswz(int d, int slot) { return d * 64 + ((slot ^ ((d >> 2) & 3)) << 4); }
__device__ __forceinline__ v8i cat8(const u32x4_& lo, const u32x4_& hi) { v8i r; r[0] = (int)lo.x; r[1] = (int)lo.y; r[2] = (int)lo.z; r[3] = (int)lo.w; r[4] = (int)hi.x; r[5] = (int)hi.y; r[6] = (int)hi.z; r[7] = (int)hi.w; return r; }
template <bool LAST> __device__ __forceinline__ void mfma8(f32x16& acc, const v8i& a, const v8i& b, int scl) {
    acc = __builtin_amdgcn_mfma_scale_f32_32x32x64_f8f6f4(a, b, acc, 0, 0, 0, scl, 0, scl);
}
__device__ __forceinline__ void partialSM(f32x16& p0, f32x16& p1, float& m_reg, float& mn, float& alpha) {
    constexpr float C = SCALE * 1.4426950408889634f;
    float pmax = p0[0];
#pragma unroll
    for (int r = 1; r < 16; ++r) pmax = fmaxf(pmax, p0[r]);
#pragma unroll
    for (int r = 0; r < 16; ++r) pmax = fmaxf(pmax, p1[r]);
    { auto rr = __builtin_amdgcn_permlane32_swap(__float_as_uint(pmax), __float_as_uint(pmax), false, false); pmax = fmaxf(__uint_as_float(rr[0]), __uint_as_float(rr[1])); }
    if (__builtin_expect(__all(pmax - m_reg <= THR / SCALE), 1)) { mn = m_reg; alpha = 1.f; }
    else { mn = fmaxf(m_reg, pmax); alpha = __builtin_amdgcn_exp2f((m_reg - mn) * C); m_reg = mn; }
    const float mnC = 7.f - mn * C;
#pragma unroll
    for (int r = 0; r < 16; ++r) p0[r] = fmaf(p0[r], C, mnC);
#pragma unroll
    for (int r = 0; r < 16; ++r) p1[r] = fmaf(p1[r], C, mnC);
#pragma unroll
    for (int r = 0; r < 16; ++r) p0[r] = __builtin_amdgcn_exp2f(p0[r]);
}
__device__ __forceinline__ void finishSM(f32x16& p0, f32x16& p1, float alpha, float& l_reg, v8i& pa) {
#pragma unroll
    for (int r = 0; r < 16; ++r) p1[r] = __builtin_amdgcn_exp2f(p1[r]);
    float ps = 0;
#pragma unroll
    for (int r = 0; r < 16; ++r) ps += p0[r];
#pragma unroll
    for (int r = 0; r < 16; ++r) ps += p1[r];
    { auto rr = __builtin_amdgcn_permlane32_swap(__float_as_uint(ps), __float_as_uint(ps), false, false); ps = __uint_as_float(rr[0]) + __uint_as_float(rr[1]); }
    l_reg = l_reg * alpha + ps;
#pragma unroll
    for (int w = 0; w < 4; ++w) { pa[w] = (int)pack4_fp8(p0[4 * w], p0[4 * w + 1], p0[4 * w + 2], p0[4 * w + 3]); pa[4 + w] = (int)pack4_fp8(p1[4 * w], p1[4 * w + 1], p1[4 * w + 2], p1[4 * w + 3]); }
}
__device__ __forceinline__ void qkt(f32x16& p0, f32x16& p1, const char* Ks, const v8i* qf, int r32, int hi, int scl) {
    p0 = f32x16{}; p1 = f32x16{};
#pragma unroll
    for (int s = 0; s < 2; ++s) { const int cb = 64 * s + 32 * hi;
        const v8i a0 = cat8(*(const u32x4_*)(Ks + kswz(r32, cb)), *(const u32x4_*)(Ks + kswz(r32, cb + 16)));
        const v8i a1 = cat8(*(const u32x4_*)(Ks + kswz(32 + r32, cb)), *(const u32x4_*)(Ks + kswz(32 + r32, cb + 16)));
        if (s == 0) { mfma8<false>(p0, a0, qf[s], scl); mfma8<false>(p1, a1, qf[s], scl); }
        else { mfma8<false>(p0, a0, qf[s], scl); mfma8<true>(p1, a1, qf[s], scl); } }
}
__device__ __forceinline__ void pv(f32x16* o, const char* Vs, const v8i& pa, int r32, int hi, int scl) {
#pragma unroll
    for (int d0 = 0; d0 < 4; ++d0) { const int d = d0 * 32 + r32;
        const v8i b = cat8(*(const u32x4_*)(Vs + vswz(d, 2 * hi)), *(const u32x4_*)(Vs + vswz(d, 2 * hi + 1)));
        if (d0 == 3) mfma8<true>(o[d0], pa, b, scl); else mfma8<false>(o[d0], pa, b, scl); }
}
__device__ __forceinline__ void body(const unsigned char* __restrict__ Qb, const unsigned char* __restrict__ Kh, const unsigned char* __restrict__ Vt, unsigned short* __restrict__ Ob, int seq, char* lds) {
    const int tid = threadIdx.x, wid = tid >> 6, lane = tid & 63, r32 = lane & 31, hi = lane >> 5;
    const int scl = 0x7f7f7f7f;
    float* ws = (float*)(lds + 65536) + wid * 64; float* li_l = ws; float* al_l = ws + 32;
    float m_reg = -1e30f, l_reg = 0; f32x16 o[4] = {}; v8i qf[2];
    { const unsigned char* Qw = Qb + (long)(wid * QBLK + r32) * 1024 + 32 * hi;
#pragma unroll
      for (int s = 0; s < 2; ++s) qf[s] = cat8(*(const u32x4_*)(Qw + 64 * s), *(const u32x4_*)(Qw + 64 * s + 16)); }
    const int kr = tid >> 3, kc = (tid & 7) * 16, kdst = kswz(kr, kc);
    const int vd = tid >> 2, vsl = tid & 3, vdst = vswz(vd, vsl);
    struct { u32x4_ k, v; } sr_[2];
#define SLOAD(i, t) do { sr_[i].k = *(const u32x4_*)(Kh + (long)((t) * KVBLK + kr) * 256 + kc); sr_[i].v = *(const u32x4_*)(Vt + (long)(t) * 8192 + vd * 64 + vsl * 16); } while (0)
#define SWRITE(t, i) do { char* s_ = lds + ((t) & 3) * 16384; *(u32x4_*)(s_ + kdst) = sr_[i].k; *(u32x4_*)(s_ + 8192 + vdst) = sr_[i].v; } while (0)
#define KS(t) (lds + ((t) & 3) * 16384)
#define VS(t) (lds + ((t) & 3) * 16384 + 8192)
#define SWAIT() asm volatile("s_waitcnt vmcnt(2)" ::: "memory")
#define RESC(a) do { if (__any((a) < 1.f)) { if (hi == 0) al_l[r32] = (a); asm volatile("s_waitcnt lgkmcnt(0)" ::: "memory"); \
    _Pragma("unroll") for (int d = 0; d < 4; ++d) _Pragma("unroll") for (int r = 0; r < 16; ++r) o[d][r] *= al_l[crow(r, hi)]; } } while (0)
#define SBAR_() __builtin_amdgcn_sched_barrier(0)
    f32x16 pA0, pA1, pB0, pB1; float mnA, mnB, alA, alB; v8i pa; const int NT = seq / KVBLK;
    SLOAD(0, 0); asm volatile("s_waitcnt vmcnt(0)" ::: "memory"); SWRITE(0, 0); __syncthreads();
    qkt(pA0, pA1, KS(0), qf, r32, hi, scl); partialSM(pA0, pA1, m_reg, mnA, alA);
    SLOAD(1, 1); if (2 < NT) SLOAD(0, 2);
    SWAIT(); SWRITE(1, 1); __syncthreads();
    for (int j = 1; j + 1 < NT; j += 2) {
        SBAR_(); qkt(pB0, pB1, KS(j), qf, r32, hi, scl);
        finishSM(pA0, pA1, alA, l_reg, pa); SBAR_();
        SLOAD(1, j + 2); SBAR_();
        pv(o, VS(j - 1), pa, r32, hi, scl); partialSM(pB0, pB1, m_reg, mnB, alB);
        SWAIT(); SWRITE(j + 1, 0);
        RESC(alB); __syncthreads();
        SBAR_(); qkt(pA0, pA1, KS(j + 1), qf, r32, hi, scl);
        finishSM(pB0, pB1, alB, l_reg, pa); SBAR_();
        if (j + 3 < NT) SLOAD(0, j + 3); SBAR_();
        pv(o, VS(j), pa, r32, hi, scl); partialSM(pA0, pA1, m_reg, mnA, alA);
        SWAIT(); SWRITE(j + 2, 1);
        RESC(alA); __syncthreads();
    }
    SBAR_(); qkt(pB0, pB1, KS(NT - 1), qf, r32, hi, scl);
    finishSM(pA0, pA1, alA, l_reg, pa); SBAR_();
    pv(o, VS(NT - 2), pa, r32, hi, scl); partialSM(pB0, pB1, m_reg, mnB, alB);
    __syncthreads(); RESC(alB);
    finishSM(pB0, pB1, alB, l_reg, pa); SBAR_();
    pv(o, VS(NT - 1), pa, r32, hi, scl);
    if (hi == 0) li_l[r32] = l_reg; asm volatile("s_waitcnt lgkmcnt(0)" ::: "memory");
    float rli[16];
#pragma unroll
    for (int r = 0; r < 16; ++r) rli[r] = __builtin_amdgcn_rcpf(li_l[crow(r, hi)]);
    unsigned short* Ow = Ob + (long)(wid * QBLK) * 1024;
#pragma unroll
    for (int r = 0; r < 16; ++r) { const int orow = crow(r, hi);
#pragma unroll
        for (int d0 = 0; d0 < 4; ++d0) Ow[(long)orow * 1024 + d0 * 32 + r32] = (unsigned short)f2bf(o[d0][r] * rli[r]); }
#undef KS
#undef VS
#undef SLOAD
#undef SWRITE
#undef SWAIT
#undef RESC
#undef SBAR_
}
}
__device__ __forceinline__ void phase_attn(const Params& p, const Ctx& c, char* lds_generic) {
    unsigned char* ws = p.ws;
    const unsigned char* Q8 = ws + WS_QN; const unsigned char* K8 = ws + WS_KN; const unsigned char* VT8 = ws + WS_VB; bf16_t* AO = (bf16_t*)(ws + WS_AO);
    for (int item = c.bid; item < 512; item += c.G) {
        const int b = item >> 8, h = (item >> 5) & 7, qb = item & 31, kvh = h >> 2;
        const size_t qrow = (size_t)b * S + qb * 256;
        attn8::body(Q8 + qrow * 1024 + h * 128, K8 + (size_t)b * S * 256 + kvh * 128, VT8 + (size_t)(b * 2 + kvh) * 128 * 8192, AO + qrow * 1024 + h * 128, S, lds_generic);
        __syncthreads();
    }
}

__device__ __forceinline__ void phase_router(const Params& p, const Ctx& c) {
    unsigned char* ws = p.ws;
    LAS float* wT = (LAS float*)c.lds;
    LAS int* tokE = (LAS int*)(c.lds + LDS_CTL + 512);
    LAS float* tokW = (LAS float*)(c.lds + LDS_CTL + 512 + 1024);
    LAS int* lcnt = (LAS int*)(c.lds + LDS_CTL + 512 + 2048);
    LAS int* lbase = lcnt + 32;
    LAS int* lrank = lbase + 32;
    const bf16_t* X1 = (const bf16_t*)(ws + WS_X1); unsigned char* H2 = ws + WS_H2;
    int* CNT = (int*)(ws + WS_CTL); int* TOKES = (int*)(ws + WS_TOKES); float* TOKW = (float*)(ws + WS_TOKW); int* LIST = (int*)(ws + WS_LIST);
    const int tid = c.tid, lane = c.lane;
    __syncthreads();
    { const f32x4* src = (const f32x4*)(ws + WS_WRT);
      f32x4 wv[16];
#pragma unroll
      for (int i = 0; i < 16; ++i) wv[i] = src[tid + 512 * i];
#pragma unroll
      for (int i = 0; i < 16; ++i) ((LAS f32x4*)wT)[tid + 512 * i] = wv[i]; }
    __syncthreads();
    f32x4 gv[4];
#pragma unroll
    for (int j = 0; j < 4; ++j) gv[j] = *(const f32x4*)(p.in[16] + (j >> 1) * 512 + 8 * lane + (j & 1) * 4);
    const float bias_e = p.in[18][(lane >> 1) & 31];
    for (int blk = c.bid; blk < M / 64; blk += c.G) {
        if (tid < 32) lcnt[tid] = 0;
        for (int pr = 0; pr < 4; ++pr) {
            const int tl = c.wave * 8 + pr * 2;
            const size_t tokA = (size_t)blk * 64 + tl;
            f32x4 hA[4], hB[4];
            {
                const u32x4* xa = (const u32x4*)(X1 + tokA * 1024) + lane; const u32x4* xb = xa + 128;
                float sa = 0.f, sb = 0.f;
                { const u32x4 a0 = xa[0], a1 = xa[64], b0 = xb[0], b1 = xb[64];
                  hA[0] = (f32x4){bflo(a0.x), bfhi(a0.x), bflo(a0.y), bfhi(a0.y)}; hA[1] = (f32x4){bflo(a0.z), bfhi(a0.z), bflo(a0.w), bfhi(a0.w)};
                  hA[2] = (f32x4){bflo(a1.x), bfhi(a1.x), bflo(a1.y), bfhi(a1.y)}; hA[3] = (f32x4){bflo(a1.z), bfhi(a1.z), bflo(a1.w), bfhi(a1.w)};
                  hB[0] = (f32x4){bflo(b0.x), bfhi(b0.x), bflo(b0.y), bfhi(b0.y)}; hB[1] = (f32x4){bflo(b0.z), bfhi(b0.z), bflo(b0.w), bfhi(b0.w)};
                  hB[2] = (f32x4){bflo(b1.x), bfhi(b1.x), bflo(b1.y), bfhi(b1.y)}; hB[3] = (f32x4){bflo(b1.z), bfhi(b1.z), bflo(b1.w), bfhi(b1.w)}; }
#pragma unroll
                for (int j = 0; j < 4; ++j) {
                    sa += (hA[j].x * hA[j].x + hA[j].y * hA[j].y) + (hA[j].z * hA[j].z + hA[j].w * hA[j].w);
                    sb += (hB[j].x * hB[j].x + hB[j].y * hB[j].y) + (hB[j].z * hB[j].z + hB[j].w * hB[j].w); }
                const float ra = rsqrtf(wave_sum(sa) * (1.f / 1024.f) + EPS), rb = rsqrtf(wave_sum(sb) * (1.f / 1024.f) + EPS);
#pragma unroll
                for (int j = 0; j < 4; ++j) { hA[j] = hA[j] * ra * gv[j]; hB[j] = hB[j] * rb * gv[j]; }
                u32x2* oa = (u32x2*)(H2 + tokA * 1024) + lane; u32x2* ob = oa + 128;
#pragma unroll
                for (int j2 = 0; j2 < 2; ++j2) { u32x2 w;
                    w.x = pack4_fp8(8.f * hA[2 * j2].x, 8.f * hA[2 * j2].y, 8.f * hA[2 * j2].z, 8.f * hA[2 * j2].w); w.y = pack4_fp8(8.f * hA[2 * j2 + 1].x, 8.f * hA[2 * j2 + 1].y, 8.f * hA[2 * j2 + 1].z, 8.f * hA[2 * j2 + 1].w); oa[64 * j2] = w;
                    w.x = pack4_fp8(8.f * hB[2 * j2].x, 8.f * hB[2 * j2].y, 8.f * hB[2 * j2].z, 8.f * hB[2 * j2].w); w.y = pack4_fp8(8.f * hB[2 * j2 + 1].x, 8.f * hB[2 * j2 + 1].y, 8.f * hB[2 * j2 + 1].z, 8.f * hB[2 * j2 + 1].w); ob[64 * j2] = w; }
            }
            float accA[32], accB[32];
#pragma unroll
            for (int e = 0; e < 32; ++e) {
                float a = 0.f, b = 0.f;
#pragma unroll
                for (int j = 0; j < 4; ++j) { const f32x4 w = *(const LAS f32x4*)&wT[e * 1024 + (j >> 1) * 512 + 8 * lane + (j & 1) * 4];
                    a = fmaf(hA[j].x, w.x, a); a = fmaf(hA[j].y, w.y, a); a = fmaf(hA[j].z, w.z, a); a = fmaf(hA[j].w, w.w, a);
                    b = fmaf(hB[j].x, w.x, b); b = fmaf(hB[j].y, w.y, b); b = fmaf(hB[j].z, w.z, b); b = fmaf(hB[j].w, w.w, b); }
                accA[e] = a; accB[e] = b;
                if (e & 1) __builtin_amdgcn_sched_barrier(0);
            }
#define RSTEP(N, BIT) _Pragma("unroll") for (int i = 0; i < N; ++i) { const bool up = (lane & BIT) != 0; \
                const float ka = up ? accA[N + i] : accA[i], sa_ = up ? accA[i] : accA[N + i]; accA[i] = ka + __shfl_xor(sa_, BIT); \
                const float kb = up ? accB[N + i] : accB[i], sb_ = up ? accB[i] : accB[N + i]; accB[i] = kb + __shfl_xor(sb_, BIT); }
            RSTEP(16, 32) RSTEP(8, 16) RSTEP(4, 8) RSTEP(2, 4) RSTEP(1, 2)
#undef RSTEP
            const float la = accA[0] + __shfl_xor(accA[0], 1) + bias_e, lb = accB[0] + __shfl_xor(accB[0], 1) + bias_e;
            const int my_e = (lane >> 1) & 31;
#pragma unroll
            for (int t2 = 0; t2 < 2; ++t2) {
                float val = t2 ? lb : la;
                int se[4]; float sv[4];
#pragma unroll
                for (int k = 0; k < 4; ++k) {
                    const float mx = wave_max(val);
                    const int sel = wave_min_i(val == mx ? my_e : 64);
                    se[k] = sel & 31; sv[k] = mx;
                    if (my_e == sel) val = -INFINITY;
                }
                const float e1 = __expf(sv[1] - sv[0]), e2 = __expf(sv[2] - sv[0]), e3 = __expf(sv[3] - sv[0]);
                const float inv = 1.f / (1.f + e1 + e2 + e3);
                if (lane == 0) {
                    const int t = tl + t2;
                    tokE[t * 4 + 0] = se[0]; tokE[t * 4 + 1] = se[1]; tokE[t * 4 + 2] = se[2]; tokE[t * 4 + 3] = se[3];
                    tokW[t * 4 + 0] = inv; tokW[t * 4 + 1] = e1 * inv; tokW[t * 4 + 2] = e2 * inv; tokW[t * 4 + 3] = e3 * inv;
                }
            }
        }
        __syncthreads();
        if (tid < 256) lrank[tid] = atomicAdd((int*)&lcnt[tokE[tid]], 1);
        __syncthreads();
        if (tid < 32) lbase[tid] = lcnt[tid] ? atomicAdd(&CNT[tid], lcnt[tid]) : 0;
        __syncthreads();
        if (tid < 256) {
            const int e = tokE[tid], slot = lbase[e] + lrank[tid], tok = blk * 64 + (tid >> 2);
            LIST[e * 16384 + slot] = tok; TOKES[tok * 4 + (tid & 3)] = (e << 16) | slot; TOKW[tok * 4 + (tid & 3)] = tokW[tid];
        }
        __syncthreads();
    }
}

__device__ __forceinline__ void load_offs(const Params& p, const Ctx& c, LAS int*& offs, LAS int*& cnt) {
    offs = (LAS int*)(c.lds + LDS_CTL); cnt = offs + 40;
    __syncthreads();
    if (c.tid == 0) {
        const int* CNT = (const int*)(p.ws + WS_CTL); int run = 0;
        for (int e = 0; e < 32; ++e) { const int n = __hip_atomic_load(CNT + e, __ATOMIC_RELAXED, __HIP_MEMORY_SCOPE_AGENT); cnt[e] = n; offs[e] = run; run += (n + 255) & ~255; }
        offs[32] = run;
    }
    __syncthreads();
    if (c.tid < 320) { int e = 0; while (e < 31 && c.tid * 256 >= offs[e + 1]) ++e; offs[80 + c.tid] = e; }
    __syncthreads();
}
__device__ __forceinline__ void phase_gemm1(const Params& p, const Ctx& c) {
    { pg8::Gemm g{(const bf16_t*)(p.ws + WS_H), (const bf16_t*)(p.ws + WS_WINT), M, PQ, 1024};
      pg8::StaticOrder S; S.init(M, PQ, c.G, c.bid);
      pg8::EpiStore E{(bf16_t*)(p.ws + WS_P), NPROJ};
      pg8::gemm_phase<pg8::EpiStore, pg8::StaticOrder, true, true>(c.lds, g, S, E); }
    { pg8::Gemm g{(const bf16_t*)(p.ws + WS_H8), (const bf16_t*)(p.ws + WS_WIN8), M, PDT - PQ, 512};
      pg8::StaticOrder S; S.init(M, PDT - PQ, c.G, c.G - 1 - c.bid);
      pg8::EpiStore8 E{(bf16_t*)(p.ws + WS_P) + PQ, NPROJ, 1.f / 512.f};
      pg8::gemm_phase_f8<pg8::EpiStore8, pg8::StaticOrder, true, true>(c.lds, g, S, E); }
}
__device__ __forceinline__ void phase_tail12(const Params& p, const Ctx& c) {
    unsigned char* ws = p.ws;
    pg8::TailOrder S; S.so.init(M, 1024, c.G, c.bid);
    pg8::Gemm g{(const bf16_t*)(ws + WS_YZ), (const bf16_t*)(ws + WS_WST), 2 * M, 2048, 1024};
    pg8::EpiT12 E{(bf16_t*)(ws + WS_T1), (bf16_t*)(ws + WS_MG), (const bf16_t*)(ws + WS_P) + PG, NPROJ, (const float*)(ws + WS_RSTD)};
    pg8::gemm_phase<pg8::EpiT12, pg8::TailOrder, true, true>(c.lds, g, S, E);
}
__device__ __forceinline__ void phase_tail3(const Params& p, const Ctx& c) {
    unsigned char* ws = p.ws;
    pg8::StaticOrder S; S.init(M, 1024, c.G, c.bid);
    pg8::Gemm g{(const bf16_t*)(ws + WS_MG), (const bf16_t*)(ws + WS_WOT), M, 1024, 1024};
    pg8::EpiT3b E{(bf16_t*)(ws + WS_X1), p.in[0]};
    pg8::gemm_phase<pg8::EpiT3b, pg8::StaticOrder, true, true>(c.lds, g, S, E);
}
__device__ __forceinline__ void phase_moe1(const Params& p, const Ctx& c) {
    LAS int* offs; LAS int* cnt; load_offs(p, c, offs, cnt);
    unsigned char* ws = p.ws;
    pg8::Gemm g{(const bf16_t*)(ws + WS_H2), (const bf16_t*)(ws + WS_W1T), M, 32 * 2048, 512};
    pg8::MoeGatherOrder S{offs, cnt, offs + 80, (const int*)(ws + WS_LIST), c.G, c.bid, offs[32] / 256};
    pg8::EpiAct8 E{(unsigned char*)(ws + WS_ACT), p.in[20]};
    pg8::gemm_phase_gather_f8<pg8::EpiAct8, pg8::MoeGatherOrder>(c.lds, g, S, E);
}
__device__ __forceinline__ void phase_moe2(const Params& p, const Ctx& c) {
    LAS int* offs; LAS int* cnt; load_offs(p, c, offs, cnt);
    unsigned char* ws = p.ws;
    pg8::Gemm g{(const bf16_t*)(ws + WS_ACT), (const bf16_t*)(ws + WS_W2T), ROWS_MAX, 32 * 1024, 512};
    pg8::MoeOrder<4> S{offs + 80, c.G, c.bid, offs[32] / 256};
    pg8::EpiY8 E{(bf16_t*)(ws + WS_YB), p.in[22]};
    pg8::gemm_phase_f8<pg8::EpiY8, pg8::MoeOrder<4>, true, true>(c.lds, g, S, E);
}

__device__ __forceinline__ void phase_combine(const Params& p, const Ctx& c) {
    LAS int* offs; LAS int* cnt; load_offs(p, c, offs, cnt);
    unsigned char* ws = p.ws;
    const bf16_t* X1 = (const bf16_t*)(ws + WS_X1); const bf16_t* YB = (const bf16_t*)(ws + WS_YB);
    const int* TOKES = (const int*)(ws + WS_TOKES); const float* TOKW = (const float*)(ws + WS_TOKW);
    const int gw = c.bid * 8 + c.wave, NGW = c.G * 8, lane = c.lane;
    f32x4 gv[4];
#pragma unroll
    for (int j = 0; j < 4; ++j) gv[j] = ((const f32x4*)p.in[23])[lane + 64 * j];
    for (int m0 = gw * 2; m0 < M; m0 += NGW * 2) {
        int es[2][4]; float wq[2][4];
#pragma unroll
        for (int t = 0; t < 2; ++t)
#pragma unroll
            for (int k = 0; k < 4; ++k) { es[t][k] = TOKES[(m0 + t) * 4 + k]; wq[t][k] = TOKW[(m0 + t) * 4 + k]; }
        f32x4 v[2][4]; u32x2 y[2][4][4];
#pragma unroll
        for (int t = 0; t < 2; ++t) { const u32x2* xr = (const u32x2*)(X1 + (size_t)(m0 + t) * 1024) + lane;
#pragma unroll
            for (int j = 0; j < 4; ++j) { const u32x2 xx = xr[64 * j]; v[t][j] = (f32x4){bflo(xx.x), bfhi(xx.x), bflo(xx.y), bfhi(xx.y)}; }
#pragma unroll
            for (int k = 0; k < 4; ++k) { const int row = offs[es[t][k] >> 16] + (es[t][k] & 0xffff); const u32x2* yr = (const u32x2*)(YB + (size_t)row * 1024) + lane;
#pragma unroll
                for (int j = 0; j < 4; ++j) y[t][k][j] = yr[64 * j]; } }
#pragma unroll
        for (int t = 0; t < 2; ++t) {
#pragma unroll
            for (int k = 0; k < 4; ++k) { const float w = wq[t][k];
#pragma unroll
                for (int j = 0; j < 4; ++j) { const u32x2 yy = y[t][k][j];
                    v[t][j].x = fmaf(w, bflo(yy.x), v[t][j].x); v[t][j].y = fmaf(w, bfhi(yy.x), v[t][j].y); v[t][j].z = fmaf(w, bflo(yy.y), v[t][j].z); v[t][j].w = fmaf(w, bfhi(yy.y), v[t][j].w); } }
            float s = 0.f;
#pragma unroll
            for (int j = 0; j < 4; ++j) s += (v[t][j].x * v[t][j].x + v[t][j].y * v[t][j].y) + (v[t][j].z * v[t][j].z + v[t][j].w * v[t][j].w);
            const float rstd = rsqrtf(wave_sum(s) * (1.f / 1024.f) + EPS);
            f32x4* o = (f32x4*)(p.out + (size_t)(m0 + t) * 1024) + lane;
#pragma unroll
            for (int j = 0; j < 4; ++j) o[64 * j] = v[t][j] * rstd * gv[j];
        }
    }
}

#define XB_TMO      128
#define XB_XCNT(j)  (256  + 64 * (j))
#define XB_XSUB(j)  (1280 + 64 * (j))
#define XB_XGEN(j)  (2304 + 64 * (j))
#define XB_TOP      3328
#define XB_TOPGEN   3392
#define XCD_BAR_WORDS 3456
#define XB_SPIN_CAP (1u << 18)

__device__ __forceinline__ unsigned xb_ld(unsigned* p)              { return __hip_atomic_load(p, __ATOMIC_RELAXED, __HIP_MEMORY_SCOPE_AGENT); }
__device__ __forceinline__ unsigned xb_add(unsigned* p, unsigned v) { return __hip_atomic_fetch_add(p, v, __ATOMIC_RELAXED, __HIP_MEMORY_SCOPE_AGENT); }
__device__ __forceinline__ unsigned xb_xcc_id() { return (unsigned)__builtin_amdgcn_s_getreg((3 << 11) | 20) & 0xFu; }
#define XB_SPIN(cond, bar) do { unsigned _sp = 0; while (cond) { __builtin_amdgcn_s_sleep(1); \
    if ((++_sp & 255u) == 0u) { if (xb_ld(&(bar)[XB_TMO])) break; if (_sp > XB_SPIN_CAP) { atomicAdd(&(bar)[XB_TMO], 1u); break; } } } } while (0)

struct XcdBarrier {
    unsigned* bar; unsigned x;
    volatile LAS unsigned* st;
};

__device__ __forceinline__ XcdBarrier xcd_barrier_post(unsigned* bar, volatile LAS unsigned* st) {
    XcdBarrier b; b.bar = bar; b.x = xb_xcc_id(); b.st = st;
    if (threadIdx.x == 0) (void)xb_add(&bar[XB_XCNT(b.x)], 1u);
    return b;
}
__device__ __forceinline__ void xcd_barrier_complete(unsigned* bar, unsigned x, unsigned& nloc, unsigned& nx) {
    const unsigned G = gridDim.x * gridDim.y * gridDim.z;
    unsigned sum, cnt, mine, sp = 0u;
    for (;;) {
        sum = 0u; cnt = 0u; mine = 0u;
#pragma unroll
        for (unsigned j = 0; j < 16; ++j) { const unsigned c = xb_ld(&bar[XB_XCNT(j)]); sum += c; cnt += (c > 0u) ? 1u : 0u; mine = (j == x) ? c : mine; }
        if (sum == G) break;
        __builtin_amdgcn_s_sleep(1);
        if ((++sp & 255u) == 0u) { if (xb_ld(&bar[XB_TMO])) break; if (sp > XB_SPIN_CAP) { atomicAdd(&bar[XB_TMO], 1u); break; } }
    }
    nloc = mine > 0u ? mine : 1u; nx = cnt > 0u ? cnt : 1u;
}

__device__ __forceinline__ void xcd_barrier(const XcdBarrier& b) {
    asm volatile("s_waitcnt vmcnt(0)" ::: "memory");
    __syncthreads();
    if (threadIdx.x == 0) {
        unsigned* bar = b.bar;
        __builtin_amdgcn_s_waitcnt(0);
        unsigned nloc = b.st[0], nx = b.st[1];
        if (nloc == 0u) { xcd_barrier_complete(bar, b.x, nloc, nx); b.st[0] = nloc; b.st[1] = nx; }
        const unsigned old = xb_add(&bar[XB_XSUB(b.x)], 1u);
        const unsigned gen = old / nloc;
        if (old + 1u == (gen + 1u) * nloc) {
            __builtin_amdgcn_fence(__ATOMIC_RELEASE, "agent");
            asm volatile("s_waitcnt vmcnt(0)" ::: "memory");
            const unsigned og = xb_add(&bar[XB_TOP], 1u);
            const unsigned tg = og / nx;
            if (og + 1u == (tg + 1u) * nx) xb_add(&bar[XB_TOPGEN], 1u);
            else XB_SPIN(xb_ld(&bar[XB_TOPGEN]) == tg, bar);
            __builtin_amdgcn_fence(__ATOMIC_ACQUIRE, "agent");
            xb_add(&bar[XB_XGEN(b.x)], 1u);
            asm volatile("s_waitcnt vmcnt(0)" ::: "memory");
        } else {
            XB_SPIN(xb_ld(&bar[XB_XGEN(b.x)]) == gen, bar);
            __builtin_amdgcn_fence(__ATOMIC_ACQUIRE, "agent");
            asm volatile("s_waitcnt vmcnt(0)" ::: "memory");
        }
    }
    __syncthreads();
}

constexpr int NPHASE = 13;
__global__ void __launch_bounds__(512) mega(Params p) {
    extern __shared__ __attribute__((aligned(16))) unsigned char lds_raw[];
    Ctx c; c.tid = threadIdx.x; c.lane = c.tid & 63; c.wave = __builtin_amdgcn_readfirstlane(c.tid >> 6); c.bid = blockIdx.x; c.G = gridDim.x;
    c.lds = (LAS unsigned char*)lds_raw;
    cg::grid_group grid = cg::this_grid();
    if (c.tid < 2) ((volatile LAS unsigned*)(c.lds + LDS_BARST))[c.tid] = 0u;
    __syncthreads();
#define SEAM(k) do { XcdBarrier b_; b_.bar = (unsigned*)(p.ws + WS_BAR); b_.x = xb_xcc_id(); b_.st = (volatile LAS unsigned*)(c.lds + LDS_BARST); xcd_barrier(b_); } while (0)
    if (p.ph_lo < 0) grid.sync();
    (void)xcd_barrier_post((unsigned*)(p.ws + WS_BAR), (volatile LAS unsigned*)(c.lds + LDS_BARST));
#define RUN(k, call) if (p.ph_lo <= (k) && (k) < p.ph_hi) { call; if ((k) + 1 < p.ph_hi) SEAM(k); }
    RUN(0, phase_prep(p, c))
    RUN(1, phase_gemm1(p, c))
    RUN(2, phase_conv(p, c))
    RUN(3, phase_ssd_states(p, c))
    RUN(4, phase_ssd_scan(p, c))
    RUN(5, phase_ssd_out(p, c))
    RUN(6, phase_rstd(p, c); phase_attn(p, c, (char*)lds_raw))
    RUN(7, phase_tail12(p, c))
    RUN(8, phase_tail3(p, c))
    RUN(9, phase_router(p, c))
    RUN(10, phase_moe1(p, c))
    RUN(11, phase_moe2(p, c))
    RUN(12, phase_combine(p, c))
#undef RUN
}

extern "C" void kernel_launch(void* const* d_in, const int* in_sizes, int n_in, void* d_out, int out_size, void* d_ws, size_t ws_size, hipStream_t stream) {
    static int ok = 0; static int grid_blocks = 0;
    if (ok == 0) {
        if (n_in != 24 || out_size != M * D || ws_size < WS_END) { fprintf(stderr, "kernel_launch: unexpected shapes: n_in %d out %d ws %zu (need %zu)\n", n_in, out_size, ws_size, (size_t)WS_END); ok = -1; return; }
        if (hipFuncSetAttribute((const void*)mega, hipFuncAttributeMaxDynamicSharedMemorySize, LDS_BYTES) != hipSuccess) { fprintf(stderr, "kernel_launch: hipFuncSetAttribute failed\n"); ok = -1; return; }
        int dev = 0, cus = 0, per_cu = 0;
        hipGetDevice(&dev);
        hipDeviceGetAttribute(&cus, hipDeviceAttributeMultiprocessorCount, dev);
        hipOccupancyMaxActiveBlocksPerMultiprocessor(&per_cu, (const void*)mega, 512, LDS_BYTES);
        if (per_cu < 1 || cus < 1) { fprintf(stderr, "kernel_launch: occupancy query gave %d blocks/CU on %d CUs\n", per_cu, cus); ok = -1; return; }
        grid_blocks = cus;
        ok = 1;
    }
    if (ok < 0) return;
    Params p{};
    for (int i = 0; i < 24; ++i) p.in[i] = (const float*)d_in[i];
    p.out = (float*)d_out; p.ws = (unsigned char*)d_ws;
    p.ph_lo = 0; p.ph_hi = NPHASE;
    if (hipMemsetAsync((char*)d_ws + WS_BAR, 0, 16384, stream) != hipSuccess) { fprintf(stderr, "kernel_launch: hipMemsetAsync of the barrier words failed\n"); return; }
    void* args[] = {&p};
    hipError_t e = hipLaunchCooperativeKernel((const void*)mega, dim3(grid_blocks), dim3(512), args, LDS_BYTES, stream);
    if (e != hipSuccess) fprintf(stderr, "kernel_launch: cooperative launch failed: %s (grid %d)\n", hipGetErrorString(e), grid_blocks);
}
```

```cpp
#include <hip/hip_runtime.h>
#include <hip/hip_cooperative_groups.h>
#include <cstdio>
#include <cstdint>

namespace cg = cooperative_groups;
#define LAS __attribute__((address_space(3)))
typedef unsigned short bf16_t;
typedef unsigned u32x4 __attribute__((ext_vector_type(4)));
typedef unsigned u32x2 __attribute__((ext_vector_type(2)));
typedef float f32x4 __attribute__((ext_vector_type(4)));

constexpr int NB = 2, S = 8192, D = 1024, M = NB * S;
constexpr int NPROJ = 6400;
constexpr int PZ = 0, PXBC = 1024, PQ = 2560, PK = 3584, PV = 3840, PG = 4096, PDT = 6144;
constexpr int ROWS_MAX = 65536 + 32 * 256;
constexpr float EPS = 1e-6f;

constexpr size_t al256(size_t x) { return (x + 255) / 256 * 256; }
constexpr size_t WS_CTL = 0;
constexpr size_t WS_BAR = 4096;
constexpr size_t WS_ROPE = 4096 + 16384;
constexpr size_t WS_WRT = WS_ROPE + 32768;
constexpr size_t WS_WINT = WS_WRT + 131072;
constexpr size_t WS_WST = WS_WINT + (size_t)NPROJ * 1024 * 2;
constexpr size_t WS_WAT = WS_WST + 2097152;
constexpr size_t WS_WOT = WS_WAT + 2097152;
constexpr size_t WS_W1T = WS_WOT + 2097152;
constexpr size_t WS_W2T = WS_W1T + (size_t)32 * 2048 * 1024 * 2;
constexpr size_t WS_X1 = WS_W2T + (size_t)32 * 1024 * 1024 * 2;
constexpr size_t WS_H2 = WS_X1 + (size_t)M * 1024 * 4;
constexpr size_t WS_TOKES = WS_H2 + (size_t)M * 1024 * 2;
constexpr size_t WS_TOKW = WS_TOKES + (size_t)M * 16;
constexpr size_t WS_LIST = WS_TOKW + (size_t)M * 16;
constexpr size_t WS_R = WS_LIST + (size_t)32 * 16384 * 4;
constexpr size_t WS_H = WS_R;
constexpr size_t WS_P = WS_H + (size_t)M * 1024 * 2;
constexpr size_t WS_XT = WS_P + (size_t)M * NPROJ * 2;
constexpr size_t WS_BMR = WS_XT + (size_t)M * 1024 * 2;
constexpr size_t WS_BMT = WS_BMR + (size_t)M * 256 * 2;
constexpr size_t WS_CMR = WS_BMT + (size_t)M * 256 * 2;
constexpr size_t WS_DT = WS_CMR + (size_t)M * 256 * 2;
constexpr size_t WS_ACS = WS_DT + (size_t)2 * M * 16 * 4;
constexpr size_t WS_CDEC = WS_ACS + (size_t)2 * M * 16 * 4;
constexpr size_t WS_ST = WS_CDEC + 16384;
constexpr size_t WS_H8 = WS_ST, WS_WIN8 = WS_ST + (size_t)M * 1024;
constexpr size_t WS_PREV = WS_ST + (size_t)2 * 2 * 64 * 16 * 8192 * 4;
constexpr size_t WS_YZ = WS_PREV + (size_t)2 * 2 * 64 * 16 * 8192 * 2;
constexpr size_t WS_AO = WS_YZ + (size_t)M * 1024 * 2;
constexpr size_t WS_RSTD = WS_AO + (size_t)M * 1024 * 2;
constexpr size_t WS_QN = WS_RSTD + (size_t)M * 4;
constexpr size_t WS_KN = WS_QN + (size_t)M * 1024 * 2;
constexpr size_t WS_VB = WS_KN + (size_t)M * 256 * 2;
constexpr size_t WS_T1 = WS_VB + (size_t)M * 256 * 2;
constexpr size_t WS_MG = WS_T1 + (size_t)M * 1024 * 2;
constexpr size_t WS_END = WS_MG + (size_t)M * 1024 * 2;
constexpr size_t WS_XB = WS_R;
constexpr size_t WS_ACT = WS_XB + (size_t)ROWS_MAX * 1024 * 2;
constexpr size_t WS_YB = WS_XB;
static_assert(WS_ACT + (size_t)ROWS_MAX * 1024 * 2 <= WS_END, "moe overlay");
static_assert(WS_END <= (size_t)1073741824, "workspace");
static_assert(WS_WAT == WS_WST + 2097152 && WS_AO == WS_YZ + (size_t)M * 2048, "concatenated operands of the merged branch GEMMs");

constexpr int LDS_BYTES = 147712;
constexpr int LDS_BARST = 147456;
constexpr int LDS_CTL = 143360;

struct Params {
    const float* in[24];
    float* out;
    unsigned char* ws;
    int ph_lo, ph_hi;
};

__device__ __forceinline__ float bf2f(bf16_t v) { return __uint_as_float((unsigned)v << 16); }
__device__ __forceinline__ float bflo(unsigned w) { return __uint_as_float(w << 16); }
__device__ __forceinline__ float bfhi(unsigned w) { return __uint_as_float(w & 0xffff0000u); }
__device__ __forceinline__ unsigned f2bf(float f) { unsigned u = __float_as_uint(f); return (u + 0x7fffu + ((u >> 16) & 1u)) >> 16; }
__device__ __forceinline__ unsigned pk2(float lo, float hi) { return f2bf(lo) | (f2bf(hi) << 16); }
__device__ __forceinline__ float wave_sum(float v) {
#pragma unroll
    for (int o = 1; o < 64; o <<= 1) v += __shfl_xor(v, o);
    return v;
}
__device__ __forceinline__ float wave_max(float v) {
#pragma unroll
    for (int o = 1; o < 64; o <<= 1) v = fmaxf(v, __shfl_xor(v, o));
    return v;
}
__device__ __forceinline__ int wave_min_i(int v) {
#pragma unroll
    for (int o = 1; o < 64; o <<= 1) { int t = __shfl_xor(v, o); v = t < v ? t : v; }
    return v;
}
__device__ __forceinline__ float sigmoidf_(float x) { return 1.f / (1.f + __expf(-x)); }
__device__ __forceinline__ unsigned pack4_fp8(float a, float b, float c, float d) { unsigned w = __builtin_amdgcn_cvt_pk_fp8_f32(a, b, 0u, false); return __builtin_amdgcn_cvt_pk_fp8_f32(c, d, w, true); }
#define LDS_WAIT() asm volatile("s_waitcnt lgkmcnt(0)" ::: "memory")

struct Ctx { int tid, lane, wave, bid, G; LAS unsigned char* lds; };

struct TItem { const float* W; bf16_t* WT; const float* kscale; int N, k0, n0, orow0; unsigned char* WT8; };
__device__ __forceinline__ void transpose_load(const TItem& t, f32x4 (&v)[8], int lane) {
    const int nq = lane & 7, kg = lane >> 3;
    const float* s = t.W + (size_t)(t.k0 + 8 * kg) * t.N + t.n0 + 4 * nq;
#pragma unroll
    for (int i = 0; i < 8; ++i) v[i] = __builtin_nontemporal_load((const f32x4*)(s + (size_t)i * t.N));
}
__device__ __forceinline__ void transpose_store(const TItem& t, f32x4 (&v)[8], int lane) {
    const int nq = lane & 7, kg = lane >> 3;
    if (t.kscale) {
#pragma unroll
        for (int i = 0; i < 8; ++i) v[i] = v[i] * t.kscale[t.k0 + 8 * kg + i];
    }
    if (t.WT8) {
        unsigned char* d8 = t.WT8 + (size_t)(t.orow0 + 4 * nq) * 1024 + t.k0 + 8 * kg;
#pragma unroll
        for (int j = 0; j < 4; ++j) { u32x2 o; o.x = pack4_fp8(64.f * v[0][j], 64.f * v[1][j], 64.f * v[2][j], 64.f * v[3][j]); o.y = pack4_fp8(64.f * v[4][j], 64.f * v[5][j], 64.f * v[6][j], 64.f * v[7][j]);
            *(u32x2*)(d8 + (size_t)j * 1024) = o; }
        return;
    }
    bf16_t* d = t.WT + (size_t)(t.orow0 + 4 * nq) * 1024 + t.k0 + 8 * kg;
#pragma unroll
    for (int j = 0; j < 4; ++j) { u32x4 o; o.x = pk2(v[0][j], v[1][j]); o.y = pk2(v[2][j], v[3][j]); o.z = pk2(v[4][j], v[5][j]); o.w = pk2(v[6][j], v[7][j]);
        *(u32x4*)(d + (size_t)j * 1024) = o; }
}
constexpr int PREP_I_IN = 16 * 193, PREP_I_SQ = 512, PREP_NITEMS = PREP_I_IN + 3 * PREP_I_SQ;
__device__ __forceinline__ TItem prep_item(const Params& p, int r) {
    unsigned char* ws = p.ws; TItem t; t.kscale = nullptr; t.WT8 = nullptr;
    if (r < PREP_I_IN) { const int kb = r / 193, nb = r % 193, n0 = nb * 32;
        t.W = p.in[2]; t.WT = (bf16_t*)(ws + WS_WINT); t.N = 6176; t.k0 = kb * 64; t.n0 = n0; t.orow0 = n0 < 2560 ? n0 : (n0 < 2592 ? PDT + (n0 - 2560) : n0 - 32);
        if (n0 >= 2592) { t.WT8 = ws + WS_WIN8; t.orow0 -= PQ; }
        return t; }
    r -= PREP_I_IN;
    { const int which = r / PREP_I_SQ, q = r % PREP_I_SQ;
        t.W = which == 0 ? p.in[13] : (which == 1 ? p.in[14] : p.in[15]); t.WT = (bf16_t*)(ws + (which == 0 ? WS_WST : (which == 1 ? WS_WAT : WS_WOT)));
        t.kscale = which == 0 ? p.in[10] : nullptr; t.N = 1024; t.k0 = (q / 32) * 64; t.n0 = (q % 32) * 32; t.orow0 = t.n0; return t; }
}
constexpr int PREP8_TILES = 32 * 64 + 32 * 32;
struct T8 { const float* W; unsigned char* WT; int N, k0, n0; bool w1; };
__device__ __forceinline__ T8 prep8_tile(const Params& p, int t) {
    T8 r;
    if (t < 2048) { const int e = t >> 6; r.W = p.in[19] + (size_t)e * 1024 * 2048; r.WT = p.ws + WS_W1T + (size_t)e * 2048 * 1024; r.N = 2048; r.k0 = ((t >> 3) & 7) * 128; r.n0 = (t & 7) * 256; r.w1 = true; }
    else { t -= 2048; const int e = t >> 5; r.W = p.in[21] + (size_t)e * 1024 * 1024; r.WT = p.ws + WS_W2T + (size_t)e * 1024 * 1024; r.N = 1024; r.k0 = ((t >> 2) & 7) * 128; r.n0 = (t & 3) * 256; r.w1 = false; }
    return r;
}
__device__ __forceinline__ void prep8_load(const T8& t, f32x4 (&v)[16], int wave, int lane) {
    const float* s = t.W + (size_t)(t.k0 + 16 * wave) * t.N + t.n0 + 4 * lane;
#pragma unroll
    for (int i = 0; i < 16; ++i) v[i] = __builtin_nontemporal_load((const f32x4*)(s + (size_t)i * t.N));
}
__device__ __forceinline__ void phase_prep8(const Params& p, const Ctx& c) {
    f32x4 v[16];
    int t = c.bid;
    if (t < PREP8_TILES) { const T8 t0 = prep8_tile(p, t); prep8_load(t0, v, c.wave, c.lane); }
    for (int i = 0; t < PREP8_TILES; ++i, t += c.G) {
        const T8 cur = prep8_tile(p, t);
        LAS unsigned char* img = c.lds + (i & 1) * 32768;
#pragma unroll
        for (int j = 0; j < 4; ++j) { u32x4 o;
            o.x = pack4_fp8(64.f * v[0][j], 64.f * v[1][j], 64.f * v[2][j], 64.f * v[3][j]); o.y = pack4_fp8(64.f * v[4][j], 64.f * v[5][j], 64.f * v[6][j], 64.f * v[7][j]);
            o.z = pack4_fp8(64.f * v[8][j], 64.f * v[9][j], 64.f * v[10][j], 64.f * v[11][j]); o.w = pack4_fp8(64.f * v[12][j], 64.f * v[13][j], 64.f * v[14][j], 64.f * v[15][j]);
            *(LAS u32x4*)(img + (4 * c.lane + j) * 128 + 16 * c.wave) = o; }
        if (t + c.G < PREP8_TILES) { const T8 nx = prep8_tile(p, t + c.G); prep8_load(nx, v, c.wave, c.lane); }
        __syncthreads();
#pragma unroll
        for (int q = 0; q < 4; ++q) { const int idx = c.tid + 512 * q, nl = idx >> 3, cw = idx & 7, n = cur.n0 + nl;
            const int orow = cur.w1 ? (((n & 1023) >> 7) * 256 + (n >> 10) * 128 + (n & 127)) : n;
            __builtin_nontemporal_store(*(const LAS u32x4*)(img + nl * 128 + 16 * cw), (u32x4*)(cur.WT + (size_t)orow * 1024 + cur.k0 + 16 * cw)); }
    }
    __syncthreads();
}

__device__ __forceinline__ void phase_prep(const Params& p, const Ctx& c) {
    unsigned char* ws = p.ws;
    const int gw = c.bid * 8 + c.wave, NGW = c.G * 8;
    for (int it = gw; it < PREP_NITEMS; it += 2 * NGW) {
        const TItem ta = prep_item(p, it); f32x4 va[8], vb[8];
        transpose_load(ta, va, c.lane);
        const bool two = it + NGW < PREP_NITEMS;
        const TItem tb = prep_item(p, two ? it + NGW : it);
        if (two) transpose_load(tb, vb, c.lane);
        transpose_store(ta, va, c.lane);
        if (two) transpose_store(tb, vb, c.lane);
    }
    phase_prep8(p, c);
    for (int r = 6176 + gw; r < NPROJ; r += NGW) {
        u32x4* o = (u32x4*)((bf16_t*)(ws + WS_WINT) + (size_t)r * 1024);
        o[c.lane] = (u32x4){0u, 0u, 0u, 0u}; o[c.lane + 64] = (u32x4){0u, 0u, 0u, 0u};
    }
    {
        const float* x = p.in[0]; const float* g = p.in[1]; bf16_t* H = (bf16_t*)(ws + WS_H);
        f32x4 gv[4];
#pragma unroll
        for (int j = 0; j < 4; ++j) gv[j] = ((const f32x4*)g)[c.lane + 64 * j];
        for (int m = gw; m < M; m += NGW) {
            const f32x4* xr = (const f32x4*)(x + (size_t)m * D) + c.lane;
            f32x4 v[4]; float s = 0.f;
#pragma unroll
            for (int j = 0; j < 4; ++j) { v[j] = __builtin_nontemporal_load(xr + 64 * j); s += (v[j].x * v[j].x + v[j].y * v[j].y) + (v[j].z * v[j].z + v[j].w * v[j].w); }
            const float rstd = rsqrtf(wave_sum(s) * (1.f / D) + EPS);
            u32x2* o = (u32x2*)(H + (size_t)m * D) + c.lane; unsigned* o8 = (unsigned*)(ws + WS_H8 + (size_t)m * D) + c.lane;
#pragma unroll
            for (int j = 0; j < 4; ++j) { const f32x4 hn = v[j] * rstd * gv[j]; u32x2 w; w.x = pk2(hn.x, hn.y); w.y = pk2(hn.z, hn.w); o[64 * j] = w;
                o8[64 * j] = pack4_fp8(8.f * hn.x, 8.f * hn.y, 8.f * hn.z, 8.f * hn.w); }
        }
    }
    {
        float* rc = (float*)(ws + WS_ROPE); float* rs = rc + 4096;
        for (int idx = c.bid * 512 + c.tid; idx < 4096; idx += c.G * 512) {
            const int pos = idx >> 5, i = idx & 31;
            const float inv = exp2f(-(float)i * (13.287712379549449f / 32.f));
            float rev = (float)pos * inv * 0.15915494309189535f; rev -= floorf(rev);
            rc[idx] = __builtin_amdgcn_cosf(rev); rs[idx] = __builtin_amdgcn_sinf(rev);
        }
        bf16_t* wh = (bf16_t*)(ws + WS_WRT); bf16_t* wl = wh + 32768; const float* wr = p.in[17]; const float* gf = p.in[16];
        for (int idx = c.bid * 512 + c.tid; idx < 32768; idx += c.G * 512) { const int k = idx >> 5, e = idx & 31; const float v = gf[k] * wr[idx];
            const unsigned hi = f2bf(v); const float rem = v - __uint_as_float(hi << 16); wh[e * 1024 + k] = (bf16_t)hi; wl[e * 1024 + k] = (bf16_t)f2bf(rem); }
        if (c.bid == 0 && c.tid < 64) ((int*)(ws + WS_CTL))[c.tid] = 0;
    }
}

namespace pg8 {
#define PG8_LAS __attribute__((address_space(3)))
typedef unsigned short bf16_t;
typedef short bf16x8 __attribute__((ext_vector_type(8)));
typedef float f32x4 __attribute__((ext_vector_type(4)));
typedef unsigned u32x4 __attribute__((ext_vector_type(4)));
constexpr int BM = 256, BK = 64, HALF = 128, HTB = HALF * BK * 2  , STAGE_BYTES = 8 * HTB, NXCD = 8, WGM = 8;

__host__ __device__ __forceinline__ int lds_byte(int r, int c) { const int st = (r >> 4) * 2 + (c >> 5), rr = r & 15, cc = c & 31, ob = rr * 64 + cc * 2; return st * 1024 + (ob ^ (((ob >> 9) & 1) << 5)); }
__host__ __device__ __forceinline__ void stage_rc(int b, int& R, int& C) { const int st = b / 1024, sb = b % 1024, swz = sb ^ (((sb >> 9) & 1) << 5); R = (st >> 1) * 16 + swz / 64; C = (st & 1) * 32 + (swz % 64) / 2; }
__host__ __device__ __forceinline__ int perm32(int rho) { const int n = rho >> 4, i = rho & 15; return 8 * (i >> 2) + 4 * n + (i & 3); }

struct Unit { int pm, pn; };
struct Gemm { const bf16_t* A; const bf16_t* Bt; int M, N, K; };

struct StaticOrder {
    int nM, nN, nwg, G, c;
    __host__ __device__ void init(int M, int N, int G_, int c_) { nM = M / BM; nN = N / BM; nwg = nM * nN; G = G_; c = c_; }
    __host__ __device__ bool next(int i, Unit& u) const {
        const long L = (long)i * G + c; if (L >= nwg) return false;
        int wgid = (int)L; { const int q = nwg / NXCD, r = nwg % NXCD, xcd = wgid % NXCD, off = wgid / NXCD; wgid = (xcd < r ? xcd * (q + 1) : r * (q + 1) + (xcd - r) * q) + off; }
        const int nig = WGM * nN, gid = wgid / nig, fm = gid * WGM, gsz = (nM - fm) < WGM ? (nM - fm) : WGM;
        u.pm = fm + ((wgid % nig) % gsz); u.pn = (wgid % nig) / gsz; return true;
    }
    __device__ __forceinline__ void a_ready(const Unit&) const {}
    __device__ __forceinline__ void done(const Unit&) const {}
};


__device__ __forceinline__ unsigned cvt_pk_bf16(float lo, float hi) { unsigned r; asm volatile("v_cvt_pk_bf16_f32 %0, %1, %2" : "=v"(r) : "v"(lo), "v"(hi)); return r; }
__device__ __forceinline__ float sig_(float x) { return __builtin_amdgcn_rcpf(1.f + __builtin_amdgcn_exp2f(-1.4426950408889634f * x)); }
__device__ __forceinline__ u32x4 pack8(const f32x4& v0, const f32x4& v1) { u32x4 w; w.x = cvt_pk_bf16(v0[0], v0[1]); w.y = cvt_pk_bf16(v0[2], v0[3]); w.z = cvt_pk_bf16(v1[0], v1[1]); w.w = cvt_pk_bf16(v1[2], v1[3]); return w; }
__device__ __forceinline__ void unpack8(const u32x4& w, f32x4& v0, f32x4& v1) {
    v0[0] = __uint_as_float(w.x << 16); v0[1] = __uint_as_float(w.x & 0xffff0000u); v0[2] = __uint_as_float(w.y << 16); v0[3] = __uint_as_float(w.y & 0xffff0000u);
    v1[0] = __uint_as_float(w.z << 16); v1[1] = __uint_as_float(w.z & 0xffff0000u); v1[2] = __uint_as_float(w.w << 16); v1[3] = __uint_as_float(w.w & 0xffff0000u); }
struct EpiStore {
    static constexpr bool PERM = true, AFTER_DRAIN = false;
    bf16_t* O; int ldc;
    __device__ __forceinline__ void operator()(const f32x4 (&acc)[2][2][4][2], const Unit& u, int wr, int wc, int fr, int fq) const {
        const int row0 = u.pm * BM + wr * 64 + fr, col0 = u.pn * BM + wc * 32 + 8 * fq;
#pragma unroll
        for (int ai = 0; ai < 2; ++ai)
#pragma unroll
            for (int m = 0; m < 4; ++m) { bf16_t* rowp = O + (size_t)(row0 + ai * HALF + m * 16) * ldc + col0;
#pragma unroll
                for (int bj = 0; bj < 2; ++bj) *(u32x4*)(rowp + bj * HALF) = pack8(acc[ai][bj][m][0], acc[ai][bj][m][1]); }
    }
};
struct EpiStore8 {
    static constexpr bool PERM = true, AFTER_DRAIN = false;
    bf16_t* O; int ldc; float sc;
    __device__ __forceinline__ void operator()(const f32x4 (&acc)[2][2][4][2], const Unit& u, int wr, int wc, int fr, int fq) const {
        const int row0 = u.pm * BM + wr * 64 + fr, col0 = u.pn * BM + wc * 32 + 8 * fq;
#pragma unroll
        for (int ai = 0; ai < 2; ++ai)
#pragma unroll
            for (int m = 0; m < 4; ++m) { bf16_t* rowp = O + (size_t)(row0 + ai * HALF + m * 16) * ldc + col0;
#pragma unroll
                for (int bj = 0; bj < 2; ++bj) *(u32x4*)(rowp + bj * HALF) = pack8(acc[ai][bj][m][0] * sc, acc[ai][bj][m][1] * sc); }
    }
};
struct EpiAct8 {
    static constexpr bool PERM = true, AFTER_DRAIN = false;
    unsigned char* ACT; const float* b1;
    __device__ __forceinline__ void operator()(const f32x4 (&acc)[2][2][4][2], const Unit& u, int wr, int wc, int fr, int fq) const {
        const int e = u.pn >> 3, nt = u.pn & 7;
        const int row0 = u.pm * BM + wr * 64 + fr, col0 = nt * 128 + wc * 32 + 8 * fq;
        const float* bg = b1 + (size_t)e * 2048 + col0;
        const f32x4 bg0 = *(const f32x4*)bg, bg1 = *(const f32x4*)(bg + 4), bu0 = *(const f32x4*)(bg + 1024), bu1 = *(const f32x4*)(bg + 1028);
        constexpr float SC = 1.f / 512.f;
#pragma unroll
        for (int ai = 0; ai < 2; ++ai)
#pragma unroll
            for (int m = 0; m < 4; ++m) { const int row = row0 + ai * HALF + m * 16;
                f32x4 g0 = acc[ai][0][m][0] * SC + bg0, g1 = acc[ai][0][m][1] * SC + bg1, u0 = acc[ai][1][m][0] * SC + bu0, u1 = acc[ai][1][m][1] * SC + bu1;
#pragma unroll
                for (int i = 0; i < 4; ++i) {
                    const float ga = fminf(g0[i], 7.f), gb = fminf(g1[i], 7.f), ua = fminf(fmaxf(u0[i], -7.f), 7.f), ub = fminf(fmaxf(u1[i], -7.f), 7.f);
                    g0[i] = 4.f * ga * sig_(1.702f * ga) * (ua + 1.f); g1[i] = 4.f * gb * sig_(1.702f * gb) * (ub + 1.f); }
                u32x2 w; w.x = pack4_fp8(g0[0], g0[1], g0[2], g0[3]); w.y = pack4_fp8(g1[0], g1[1], g1[2], g1[3]);
                *(u32x2*)(ACT + (size_t)row * 1024 + col0) = w; }
    }
};
struct EpiY8 {
    static constexpr bool PERM = true, AFTER_DRAIN = false;
    bf16_t* YB; const float* b2;
    __device__ __forceinline__ void operator()(const f32x4 (&acc)[2][2][4][2], const Unit& u, int wr, int wc, int fr, int fq) const {
        const int e = u.pn >> 2, nt = u.pn & 3;
        const int row0 = u.pm * BM + wr * 64 + fr, col0 = nt * BM + wc * 32 + 8 * fq;
        constexpr float SC = 1.f / 256.f;
        f32x4 bv[2][2];
#pragma unroll
        for (int bj = 0; bj < 2; ++bj) { bv[bj][0] = *(const f32x4*)(b2 + (size_t)e * 1024 + col0 + bj * HALF); bv[bj][1] = *(const f32x4*)(b2 + (size_t)e * 1024 + col0 + bj * HALF + 4); }
#pragma unroll
        for (int ai = 0; ai < 2; ++ai)
#pragma unroll
            for (int m = 0; m < 4; ++m) { bf16_t* rowp = YB + (size_t)(row0 + ai * HALF + m * 16) * 1024 + col0;
#pragma unroll
                for (int bj = 0; bj < 2; ++bj) *(u32x4*)(rowp + bj * HALF) = pack8(acc[ai][bj][m][0] * SC + bv[bj][0], acc[ai][bj][m][1] * SC + bv[bj][1]); }
    }
};
template <int NN> struct MoeOrder {
    const PG8_LAS int* texp; int G, c, ntile;
    __device__ __forceinline__ bool next(int i, Unit& u) const {
        const int L = i * G + c; if (L >= ntile * NN) return false;
        const int t = L / NN, pnl = L % NN;
        u.pm = t; u.pn = texp[t] * NN + pnl; return true;
    }
    __device__ __forceinline__ void a_ready(const Unit&) const {}
    __device__ __forceinline__ void done(const Unit&) const {}
};
template <class Epi, class Sched, bool ALIGN_EPI = false, bool SP2 = false>
__device__ __forceinline__ void gemm_phase(PG8_LAS unsigned char* lds, const Gemm g, const Sched& S, const Epi& E) {
    const int tid = threadIdx.x, wid = __builtin_amdgcn_readfirstlane(tid >> 6), lane = tid & 63, wr = wid >> 2, wc = wid & 3, fr = lane & 15, fq = lane >> 4;
    const int K = g.K, nt = K / BK;
    unsigned voffA[2], voffB[2];
#pragma unroll
    for (int i = 0; i < 2; ++i) { int R, C; stage_rc(tid * 16 + i * 8192, R, C); const int Rb = Epi::PERM ? ((R & ~31) + perm32(R & 31)) : R;
        voffA[i] = (unsigned)(R * K + C) * 2u; voffB[i] = (unsigned)(Rb * K + C) * 2u; }
    const size_t kstep = (size_t)(BK * 2);
    const size_t hstep = (size_t)HALF * K * 2;
    const size_t tstep = 2 * hstep;
    const unsigned ldsw = (unsigned)wid * 1024u;
    const int aoff = lds_byte(wr * 64 + fr, fq * 8), boff = lds_byte(wc * 32 + fr, fq * 8);
#define PG8_SA(b, h) (((b) * 2 + (h)) * HTB)
#define PG8_SB(b, h) ((4 + (b) * 2 + (h)) * HTB)
#define PG8_STAGE(bufoff, gbase, voff) do { _Pragma("unroll") for (int _i = 0; _i < 2; ++_i) \
        __builtin_amdgcn_global_load_lds((const unsigned*)((const char*)(gbase) + (voff)[_i]), (PG8_LAS unsigned*)(lds + (bufoff) + ldsw + _i * 8192), 16, 0, 0); } while (0)
#define PG8_LDA(dst, b, h) do { _Pragma("unroll") for (int m = 0; m < 4; ++m) _Pragma("unroll") for (int k = 0; k < 2; ++k) dst[m][k] = *(const PG8_LAS bf16x8*)(lds + PG8_SA(b, h) + aoff + m * 2048 + k * 1024); } while (0)
#define PG8_LDB(dst, b, h) do { _Pragma("unroll") for (int n = 0; n < 2; ++n) _Pragma("unroll") for (int k = 0; k < 2; ++k) dst[n][k] = *(const PG8_LAS bf16x8*)(lds + PG8_SB(b, h) + boff + n * 2048 + k * 1024); } while (0)
#define PG8_MMA(ai, bj, At, Bt) do { __builtin_amdgcn_s_setprio(1); _Pragma("unroll") for (int m = 0; m < 4; ++m) _Pragma("unroll") for (int n = 0; n < 2; ++n) _Pragma("unroll") for (int k = 0; k < 2; ++k) \
        acc[ai][bj][m][n] = __builtin_amdgcn_mfma_f32_16x16x32_bf16(Bt[n][k], At[m][k], acc[ai][bj][m][n], 0, 0, 0); __builtin_amdgcn_s_setprio(0); } while (0)
#define PG8_WAIT_V(n) asm volatile("s_waitcnt vmcnt(" #n ")" ::: "memory")
#define PG8_WAIT_L(n) asm volatile("s_waitcnt lgkmcnt(" #n ")" ::: "memory")
#define PG8_BAR __builtin_amdgcn_s_barrier()
#define PG8_SCHED __builtin_amdgcn_sched_barrier(0)
    Unit cur, nxt; int ui = 0;
    if (!S.next(0, cur)) return;
    f32x4 acc[2][2][4][2];
#pragma unroll
    for (int a = 0; a < 2; ++a)
#pragma unroll
        for (int b = 0; b < 2; ++b)
#pragma unroll
            for (int m = 0; m < 4; ++m)
#pragma unroll
                for (int n = 0; n < 2; ++n) acc[a][b][m][n] = (f32x4){0.f, 0.f, 0.f, 0.f};
    bf16x8 At[4][2], B0[2][2], B1[2][2];
    const char* cA = (const char*)g.A + (size_t)cur.pm * tstep; const char* cB = (const char*)g.Bt + (size_t)cur.pn * tstep;
    S.a_ready(cur);
    if constexpr (SP2) {
        PG8_STAGE(PG8_SB(0, 0), cB, voffB); PG8_STAGE(PG8_SB(0, 1), cB + hstep, voffB); PG8_STAGE(PG8_SA(0, 0), cA, voffA); PG8_STAGE(PG8_SA(0, 1), cA + hstep, voffA);
        if (wr == 1) PG8_BAR;
        PG8_WAIT_V(2); PG8_BAR;
        PG8_STAGE(PG8_SB(1, 0), cB + kstep, voffB); PG8_STAGE(PG8_SA(1, 0), cA + kstep, voffA); PG8_STAGE(PG8_SB(1, 1), cB + hstep + kstep, voffB);
        PG8_WAIT_V(6); PG8_BAR;
    } else {
        PG8_STAGE(PG8_SB(0, 0), cB, voffB); PG8_STAGE(PG8_SA(0, 0), cA, voffA); PG8_STAGE(PG8_SB(0, 1), cB + hstep, voffB); PG8_STAGE(PG8_SA(0, 1), cA + hstep, voffA);
        if (wr == 1) PG8_BAR;
        PG8_WAIT_V(4); PG8_BAR;
        PG8_STAGE(PG8_SB(1, 0), cB + kstep, voffB); PG8_STAGE(PG8_SA(1, 0), cA + kstep, voffA); PG8_STAGE(PG8_SB(1, 1), cB + hstep + kstep, voffB);
        PG8_WAIT_V(6); PG8_BAR;
    }
    for (;;) {
        const bool has_next = S.next(ui + 1, nxt);
        const char* nA = has_next ? (const char*)g.A + (size_t)nxt.pm * tstep : cA; const char* nB = has_next ? (const char*)g.Bt + (size_t)nxt.pn * tstep : cB;
        for (int t = 0; t < nt; t += 2) {
            const bool last = (t == nt - 2);
            const char* a1 = cA + (size_t)(t + 1) * kstep;
            const char* a2 = last ? nA : cA + (size_t)(t + 2) * kstep; const char* b2 = last ? nB : cB + (size_t)(t + 2) * kstep;
            const char* a3 = a2 + kstep; const char* b3 = b2 + kstep;
            if (last && has_next) S.a_ready(nxt);
            if constexpr (SP2) {
            PG8_LDB(B0, 0, 0); PG8_LDB(B1, 0, 1); PG8_SCHED; PG8_LDA(At, 0, 0); PG8_STAGE(PG8_SA(1, 1), a1 + hstep, voffA);
            PG8_WAIT_V(8); PG8_WAIT_L(0); PG8_BAR; PG8_MMA(0, 0, At, B0); PG8_MMA(0, 1, At, B1); PG8_BAR; PG8_SCHED;
            PG8_LDA(At, 0, 1); PG8_STAGE(PG8_SB(0, 0), b2, voffB); PG8_STAGE(PG8_SB(0, 1), b2 + hstep, voffB); PG8_STAGE(PG8_SA(0, 0), a2, voffA);
            PG8_WAIT_V(8); PG8_WAIT_L(0); PG8_BAR; PG8_MMA(1, 0, At, B0); PG8_MMA(1, 1, At, B1); PG8_BAR; PG8_SCHED;
            PG8_LDB(B0, 1, 0); PG8_LDB(B1, 1, 1); PG8_SCHED; PG8_LDA(At, 1, 0); PG8_STAGE(PG8_SA(0, 1), a2 + hstep, voffA);
            PG8_WAIT_V(8); PG8_WAIT_L(0); PG8_BAR; PG8_MMA(0, 0, At, B0); PG8_MMA(0, 1, At, B1); PG8_BAR; PG8_SCHED;
            PG8_LDA(At, 1, 1); PG8_STAGE(PG8_SB(1, 0), b3, voffB); PG8_STAGE(PG8_SB(1, 1), b3 + hstep, voffB); PG8_STAGE(PG8_SA(1, 0), a3, voffA);
            PG8_WAIT_V(8); PG8_WAIT_L(0); PG8_BAR; PG8_MMA(1, 0, At, B0); PG8_MMA(1, 1, At, B1); PG8_BAR; PG8_SCHED;
            } else {
            PG8_LDB(B0, 0, 0); PG8_SCHED; PG8_LDA(At, 0, 0); PG8_STAGE(PG8_SA(1, 1), a1 + hstep, voffA);
            PG8_WAIT_L(8); PG8_BAR; PG8_WAIT_L(0); PG8_MMA(0, 0, At, B0); PG8_BAR; PG8_SCHED;
            PG8_LDB(B1, 0, 1); PG8_STAGE(PG8_SB(0, 0), b2, voffB);
            PG8_BAR; PG8_WAIT_L(0); PG8_MMA(0, 1, At, B1); PG8_BAR;
            PG8_LDA(At, 0, 1); PG8_STAGE(PG8_SA(0, 0), a2, voffA);
            PG8_BAR; PG8_WAIT_L(0); PG8_MMA(1, 0, At, B0); PG8_BAR; PG8_SCHED;
            PG8_STAGE(PG8_SB(0, 1), b2 + hstep, voffB);
            PG8_WAIT_V(6); PG8_BAR; PG8_MMA(1, 1, At, B1); PG8_BAR;
            PG8_LDB(B0, 1, 0); PG8_SCHED; PG8_LDA(At, 1, 0); PG8_STAGE(PG8_SA(0, 1), a2 + hstep, voffA);
            PG8_WAIT_L(8); PG8_BAR; PG8_WAIT_L(0); PG8_MMA(0, 0, At, B0); PG8_BAR; PG8_SCHED;
            PG8_LDB(B1, 1, 1); PG8_STAGE(PG8_SB(1, 0), b3, voffB);
            PG8_BAR; PG8_WAIT_L(0); PG8_MMA(0, 1, At, B1); PG8_BAR;
            PG8_LDA(At, 1, 1); PG8_STAGE(PG8_SA(1, 0), a3, voffA);
            PG8_BAR; PG8_WAIT_L(0); PG8_MMA(1, 0, At, B0); PG8_BAR; PG8_SCHED;
            PG8_STAGE(PG8_SB(1, 1), b3 + hstep, voffB);
            PG8_WAIT_V(6); PG8_BAR; PG8_MMA(1, 1, At, B1); PG8_BAR;
            }
        }
        if constexpr (ALIGN_EPI) { if (wr == 0) PG8_BAR; }
        if constexpr (!Epi::AFTER_DRAIN) { E(acc, cur, wr, wc, fr, fq); S.done(cur); }
        if (!has_next) break;
#pragma unroll
        for (int a = 0; a < 2; ++a)
#pragma unroll
            for (int b = 0; b < 2; ++b)
#pragma unroll
                for (int m = 0; m < 4; ++m)
#pragma unroll
                    for (int n = 0; n < 2; ++n) acc[a][b][m][n] = (f32x4){0.f, 0.f, 0.f, 0.f};
        cur = nxt; cA = nA; cB = nB; ++ui;
        if constexpr (ALIGN_EPI) { if (wr == 1) PG8_BAR; }
    }
    PG8_WAIT_V(0);
    if constexpr (!ALIGN_EPI) { if (wr == 0) PG8_BAR; }
    PG8_BAR;
    if constexpr (Epi::AFTER_DRAIN) { E.fused(acc, cur, wr, wc, fr, fq, lds, wid, lane); S.done(cur); }
#undef PG8_SA
#undef PG8_SB
#undef PG8_STAGE
#undef PG8_LDA
#undef PG8_LDB
#undef PG8_MMA
#undef PG8_WAIT_V
#undef PG8_WAIT_L
#undef PG8_BAR
#undef PG8_SCHED
}

struct MoeGatherOrder {
    const PG8_LAS int* offs; const PG8_LAS int* cnt; const PG8_LAS int* texp; const int* LIST; int G, c, ntile;
    __device__ __forceinline__ bool next(int i, Unit& u) const {
        const int L = i * G + c; if (L >= ntile * 8) return false;
        const int t = L >> 3, pnl = L & 7;
        u.pm = t; u.pn = texp[t] * 8 + pnl; return true;
    }
    __device__ __forceinline__ int arow(const Unit& u, int r) const { const int e = u.pn >> 3, slot = u.pm * 256 + r - offs[e]; return slot < cnt[e] ? LIST[e * 16384 + slot] : 0; }
    __device__ __forceinline__ void a_ready(const Unit&) const {}
    __device__ __forceinline__ void done(const Unit&) const {}
};
struct TailOrder {
    StaticOrder so;
    __device__ __forceinline__ bool next(int i, Unit& u) const { Unit b; if (!so.next(i >> 1, b)) return false; u.pm = b.pm + 64 * (i & 1); u.pn = b.pn + 4 * (i & 1); return true; }
    __device__ __forceinline__ void a_ready(const Unit&) const {}
    __device__ __forceinline__ void done(const Unit&) const {}
};
struct EpiT12 {
    static constexpr bool PERM = true, AFTER_DRAIN = false;
    bf16_t* T1; bf16_t* MG; const bf16_t* G; int ldg; const float* RSTD;
    __device__ __forceinline__ void operator()(const f32x4 (&acc)[2][2][4][2], const Unit& u, int wr, int wc, int fr, int fq) const {
        const bool second = u.pm >= 64;
        const int row0 = (u.pm & 63) * BM + wr * 64 + fr, col0 = (u.pn & 3) * BM + wc * 32 + 8 * fq;
        const bf16_t* Gp = G + (second ? 1024 : 0);
#pragma unroll
        for (int ai = 0; ai < 2; ++ai) {
            u32x4 gv[4][2], tv[4][2]; float rs[4];
#pragma unroll
            for (int m = 0; m < 4; ++m) { const int row = row0 + ai * HALF + m * 16; rs[m] = second ? 1.f : RSTD[row];
#pragma unroll
                for (int bj = 0; bj < 2; ++bj) { gv[m][bj] = *(const u32x4*)(Gp + (size_t)row * ldg + col0 + bj * HALF);
                    tv[m][bj] = second ? *(const u32x4*)(T1 + (size_t)row * 1024 + col0 + bj * HALF) : (u32x4){0u, 0u, 0u, 0u}; } }
#pragma unroll
            for (int m = 0; m < 4; ++m) { const int row = row0 + ai * HALF + m * 16;
#pragma unroll
                for (int bj = 0; bj < 2; ++bj) { f32x4 g0, g1, t0, t1; unpack8(gv[m][bj], g0, g1); unpack8(tv[m][bj], t0, t1);
                    f32x4 v0 = acc[ai][bj][m][0] * rs[m], v1 = acc[ai][bj][m][1] * rs[m];
#pragma unroll
                    for (int i = 0; i < 4; ++i) { v0[i] = fmaf(v0[i], sig_(g0[i]), t0[i]); v1[i] = fmaf(v1[i], sig_(g1[i]), t1[i]); }
                    *(u32x4*)((second ? MG : T1) + (size_t)row * 1024 + col0 + bj * HALF) = pack8(v0, v1); } }
        }
    }
};
struct EpiT3b {
    static constexpr bool PERM = true, AFTER_DRAIN = false;
    bf16_t* X1; const float* x;
    __device__ __forceinline__ void operator()(const f32x4 (&acc)[2][2][4][2], const Unit& u, int wr, int wc, int fr, int fq) const {
        const int row0 = u.pm * BM + wr * 64 + fr, col0 = u.pn * BM + wc * 32 + 8 * fq;
#pragma unroll
        for (int ai = 0; ai < 2; ++ai) {
            f32x4 xv[4][2][2];
#pragma unroll
            for (int m = 0; m < 4; ++m)
#pragma unroll
                for (int bj = 0; bj < 2; ++bj) { const size_t o = (size_t)(row0 + ai * HALF + m * 16) * 1024 + col0 + bj * HALF; xv[m][bj][0] = *(const f32x4*)(x + o); xv[m][bj][1] = *(const f32x4*)(x + o + 4); }
#pragma unroll
            for (int m = 0; m < 4; ++m)
#pragma unroll
                for (int bj = 0; bj < 2; ++bj) { const size_t o = (size_t)(row0 + ai * HALF + m * 16) * 1024 + col0 + bj * HALF;
                    *(u32x4*)(X1 + o) = pack8(xv[m][bj][0] + acc[ai][bj][m][0], xv[m][bj][1] + acc[ai][bj][m][1]); }
        }
    }
};
typedef int v4i_t __attribute__((ext_vector_type(4)));
typedef int v8i_t __attribute__((ext_vector_type(8)));
template <class Epi, class Sched, bool ALIGN_EPI = false, bool SP2 = false>
__device__ __forceinline__ void gemm_phase_f8(PG8_LAS unsigned char* lds, const Gemm g, const Sched& S, const Epi& E) {
    const int tid = threadIdx.x, wid = __builtin_amdgcn_readfirstlane(tid >> 6), lane = tid & 63, wr = wid >> 2, wc = wid & 3, fr = lane & 15, fq = lane >> 4;
    const int K = g.K, nt = K / BK;
    unsigned voffA[2], voffB[2];
#pragma unroll
    for (int i = 0; i < 2; ++i) { int R, C; stage_rc(tid * 16 + i * 8192, R, C); const int Rb = Epi::PERM ? ((R & ~31) + perm32(R & 31)) : R;
        voffA[i] = (unsigned)(R * K + C) * 2u; voffB[i] = (unsigned)(Rb * K + C) * 2u; }
    const size_t kstep = (size_t)(BK * 2);
    const size_t hstep = (size_t)HALF * K * 2;
    const size_t tstep = 2 * hstep;
    const unsigned ldsw = (unsigned)wid * 1024u;
    const int aoff = lds_byte(wr * 64 + fr, fq * 8), boff = lds_byte(wc * 32 + fr, fq * 8);
#define PG8_SA(b, h) (((b) * 2 + (h)) * HTB)
#define PG8_SB(b, h) ((4 + (b) * 2 + (h)) * HTB)
#define PG8_STAGE(bufoff, gbase, voff) do { _Pragma("unroll") for (int _i = 0; _i < 2; ++_i) \
        __builtin_amdgcn_global_load_lds((const unsigned*)((const char*)(gbase) + (voff)[_i]), (PG8_LAS unsigned*)(lds + (bufoff) + ldsw + _i * 8192), 16, 0, 0); } while (0)
#define PG8_LDA(dst, b, h) do { _Pragma("unroll") for (int m = 0; m < 4; ++m) { const v4i_t lo_ = *(const PG8_LAS v4i_t*)(lds + PG8_SA(b, h) + aoff + m * 2048), hi_ = *(const PG8_LAS v4i_t*)(lds + PG8_SA(b, h) + aoff + m * 2048 + 1024); dst[m] = __builtin_shufflevector(lo_, hi_, 0, 1, 2, 3, 4, 5, 6, 7); } } while (0)
#define PG8_LDB(dst, b, h) do { _Pragma("unroll") for (int n = 0; n < 2; ++n) { const v4i_t lo_ = *(const PG8_LAS v4i_t*)(lds + PG8_SB(b, h) + boff + n * 2048), hi_ = *(const PG8_LAS v4i_t*)(lds + PG8_SB(b, h) + boff + n * 2048 + 1024); dst[n] = __builtin_shufflevector(lo_, hi_, 0, 1, 2, 3, 4, 5, 6, 7); } } while (0)
#define PG8_MMA(ai, bj, At, Bt) do { __builtin_amdgcn_s_setprio(1); _Pragma("unroll") for (int m = 0; m < 4; ++m) _Pragma("unroll") for (int n = 0; n < 2; ++n) \
        asm volatile("v_mfma_scale_f32_16x16x128_f8f6f4 %0, %1, %2, %0, %3, %3 op_sel_hi:[0,0,0]" : "+v"(acc[ai][bj][m][n]) : "v"(Bt[n]), "v"(At[m]), "v"(scl_)); __builtin_amdgcn_s_setprio(0); } while (0)
#define PG8_WAIT_V(n) asm volatile("s_waitcnt vmcnt(" #n ")" ::: "memory")
#define PG8_WAIT_L(n) asm volatile("s_waitcnt lgkmcnt(" #n ")" ::: "memory")
#define PG8_BAR __builtin_amdgcn_s_barrier()
#define PG8_SCHED __builtin_amdgcn_sched_barrier(0)
    Unit cur, nxt; int ui = 0;
    if (!S.next(0, cur)) return;
    f32x4 acc[2][2][4][2];
#pragma unroll
    for (int a = 0; a < 2; ++a)
#pragma unroll
        for (int b = 0; b < 2; ++b)
#pragma unroll
            for (int m = 0; m < 4; ++m)
#pragma unroll
                for (int n = 0; n < 2; ++n) acc[a][b][m][n] = (f32x4){0.f, 0.f, 0.f, 0.f};
    const int scl_ = 0x7f7f7f7f;
    v8i_t At[4], B0[2], B1[2];
    const char* cA = (const char*)g.A + (size_t)cur.pm * tstep; const char* cB = (const char*)g.Bt + (size_t)cur.pn * tstep;
    S.a_ready(cur);
    if constexpr (SP2) {
        PG8_STAGE(PG8_SB(0, 0), cB, voffB); PG8_STAGE(PG8_SB(0, 1), cB + hstep, voffB); PG8_STAGE(PG8_SA(0, 0), cA, voffA); PG8_STAGE(PG8_SA(0, 1), cA + hstep, voffA);
        if (wr == 1) PG8_BAR;
        PG8_WAIT_V(2); PG8_BAR;
        PG8_STAGE(PG8_SB(1, 0), cB + kstep, voffB); PG8_STAGE(PG8_SA(1, 0), cA + kstep, voffA); PG8_STAGE(PG8_SB(1, 1), cB + hstep + kstep, voffB);
        PG8_WAIT_V(6); PG8_BAR;
    } else {
        PG8_STAGE(PG8_SB(0, 0), cB, voffB); PG8_STAGE(PG8_SA(0, 0), cA, voffA); PG8_STAGE(PG8_SB(0, 1), cB + hstep, voffB); PG8_STAGE(PG8_SA(0, 1), cA + hstep, voffA);
        if (wr == 1) PG8_BAR;
        PG8_WAIT_V(4); PG8_BAR;
        PG8_STAGE(PG8_SB(1, 0), cB + kstep, voffB); PG8_STAGE(PG8_SA(1, 0), cA + kstep, voffA); PG8_STAGE(PG8_SB(1, 1), cB + hstep + kstep, voffB);
        PG8_WAIT_V(6); PG8_BAR;
    }
    for (;;) {
        const bool has_next = S.next(ui + 1, nxt);
        const char* nA = has_next ? (const char*)g.A + (size_t)nxt.pm * tstep : cA; const char* nB = has_next ? (const char*)g.Bt + (size_t)nxt.pn * tstep : cB;
        for (int t = 0; t < nt; t += 2) {
            const bool last = (t == nt - 2);
            const char* a1 = cA + (size_t)(t + 1) * kstep;
            const char* a2 = last ? nA : cA + (size_t)(t + 2) * kstep; const char* b2 = last ? nB : cB + (size_t)(t + 2) * kstep;
            const char* a3 = a2 + kstep; const char* b3 = b2 + kstep;
            if (last && has_next) S.a_ready(nxt);
            if constexpr (SP2) {
            PG8_LDB(B0, 0, 0); PG8_LDB(B1, 0, 1); PG8_SCHED; PG8_LDA(At, 0, 0); PG8_STAGE(PG8_SA(1, 1), a1 + hstep, voffA);
            PG8_WAIT_V(8); PG8_WAIT_L(0); PG8_BAR; PG8_MMA(0, 0, At, B0); PG8_MMA(0, 1, At, B1); PG8_BAR; PG8_SCHED;
            PG8_LDA(At, 0, 1); PG8_STAGE(PG8_SB(0, 0), b2, voffB); PG8_STAGE(PG8_SB(0, 1), b2 + hstep, voffB); PG8_STAGE(PG8_SA(0, 0), a2, voffA);
            PG8_WAIT_V(8); PG8_WAIT_L(0); PG8_BAR; PG8_MMA(1, 0, At, B0); PG8_MMA(1, 1, At, B1); PG8_BAR; PG8_SCHED;
            PG8_LDB(B0, 1, 0); PG8_LDB(B1, 1, 1); PG8_SCHED; PG8_LDA(At, 1, 0); PG8_STAGE(PG8_SA(0, 1), a2 + hstep, voffA);
            PG8_WAIT_V(8); PG8_WAIT_L(0); PG8_BAR; PG8_MMA(0, 0, At, B0); PG8_MMA(0, 1, At, B1); PG8_BAR; PG8_SCHED;
            PG8_LDA(At, 1, 1); PG8_STAGE(PG8_SB(1, 0), b3, voffB); PG8_STAGE(PG8_SB(1, 1), b3 + hstep, voffB); PG8_STAGE(PG8_SA(1, 0), a3, voffA);
            PG8_WAIT_V(8); PG8_WAIT_L(0); PG8_BAR; PG8_MMA(1, 0, At, B0); PG8_MMA(1, 1, At, B1); PG8_BAR; PG8_SCHED;
            } else {
            PG8_LDB(B0, 0, 0); PG8_SCHED; PG8_LDA(At, 0, 0); PG8_STAGE(PG8_SA(1, 1), a1 + hstep, voffA);
            PG8_WAIT_L(8); PG8_BAR; PG8_WAIT_L(0); PG8_MMA(0, 0, At, B0); PG8_BAR; PG8_SCHED;
            PG8_LDB(B1, 0, 1); PG8_STAGE(PG8_SB(0, 0), b2, voffB);
            PG8_BAR; PG8_WAIT_L(0); PG8_MMA(0, 1, At, B1); PG8_BAR;
            PG8_LDA(At, 0, 1); PG8_STAGE(PG8_SA(0, 0), a2, voffA);
            PG8_BAR; PG8_WAIT_L(0); PG8_MMA(1, 0, At, B0); PG8_BAR; PG8_SCHED;
            PG8_STAGE(PG8_SB(0, 1), b2 + hstep, voffB);
            PG8_WAIT_V(6); PG8_BAR; PG8_MMA(1, 1, At, B1); PG8_BAR;
            PG8_LDB(B0, 1, 0); PG8_SCHED; PG8_LDA(At, 1, 0); PG8_STAGE(PG8_SA(0, 1), a2 + hstep, voffA);
            PG8_WAIT_L(8); PG8_BAR; PG8_WAIT_L(0); PG8_MMA(0, 0, At, B0); PG8_BAR; PG8_SCHED;
            PG8_LDB(B1, 1, 1); PG8_STAGE(PG8_SB(1, 0), b3, voffB);
            PG8_BAR; PG8_WAIT_L(0); PG8_MMA(0, 1, At, B1); PG8_BAR;
            PG8_LDA(At, 1, 1); PG8_STAGE(PG8_SA(1, 0), a3, voffA);
            PG8_BAR; PG8_WAIT_L(0); PG8_MMA(1, 0, At, B0); PG8_BAR; PG8_SCHED;
            PG8_STAGE(PG8_SB(1, 1), b3 + hstep, voffB);
            PG8_WAIT_V(6); PG8_BAR; PG8_MMA(1, 1, At, B1); PG8_BAR;
            }
        }
        if constexpr (ALIGN_EPI) { if (wr == 0) PG8_BAR; }
        asm volatile("s_nop 15\n\ts_nop 15" ::: "memory");
        if constexpr (!Epi::AFTER_DRAIN) { E(acc, cur, wr, wc, fr, fq); S.done(cur); }
        if (!has_next) break;
#pragma unroll
        for (int a = 0; a < 2; ++a)
#pragma unroll
            for (int b = 0; b < 2; ++b)
#pragma unroll
                for (int m = 0; m < 4; ++m)
#pragma unroll
                    for (int n = 0; n < 2; ++n) acc[a][b][m][n] = (f32x4){0.f, 0.f, 0.f, 0.f};
        cur = nxt; cA = nA; cB = nB; ++ui;
        if constexpr (ALIGN_EPI) { if (wr == 1) PG8_BAR; }
    }
    PG8_WAIT_V(0);
    if constexpr (!ALIGN_EPI) { if (wr == 0) PG8_BAR; }
    PG8_BAR;
    if constexpr (Epi::AFTER_DRAIN) { E.fused(acc, cur, wr, wc, fr, fq, lds, wid, lane); S.done(cur); }
#undef PG8_SA
#undef PG8_SB
#undef PG8_STAGE
#undef PG8_LDA
#undef PG8_LDB
#undef PG8_MMA
#undef PG8_WAIT_V
#undef PG8_WAIT_L
#undef PG8_BAR
#undef PG8_SCHED
}

template <class Epi, class Sched>
__device__ __forceinline__ void gemm_phase_gather_f8(PG8_LAS unsigned char* lds, const Gemm g, const Sched& S, const Epi& E) {
    constexpr bool ALIGN_EPI = true, SP2 = true;
    const int tid = threadIdx.x, wid = __builtin_amdgcn_readfirstlane(tid >> 6), lane = tid & 63, wr = wid >> 2, wc = wid & 3, fr = lane & 15, fq = lane >> 4;
    const int K = g.K, nt = K / BK;
    unsigned voffA[2], voffB[2];
#pragma unroll
    for (int i = 0; i < 2; ++i) { int R, C; stage_rc(tid * 16 + i * 8192, R, C); const int Rb = Epi::PERM ? ((R & ~31) + perm32(R & 31)) : R;
        voffA[i] = (unsigned)(R * K + C) * 2u; voffB[i] = (unsigned)(Rb * K + C) * 2u; }
    const size_t kstep = (size_t)(BK * 2);
    const size_t hstep = (size_t)HALF * K * 2;
    const size_t tstep = 2 * hstep;
    const unsigned ldsw = (unsigned)wid * 1024u;
    const int aoff = lds_byte(wr * 64 + fr, fq * 8), boff = lds_byte(wc * 32 + fr, fq * 8);
#define PG8_SA(b, h) (((b) * 2 + (h)) * HTB)
#define PG8_SB(b, h) ((4 + (b) * 2 + (h)) * HTB)
#define PG8_STAGE(bufoff, gbase, voff) do { _Pragma("unroll") for (int _i = 0; _i < 2; ++_i) \
        __builtin_amdgcn_global_load_lds((const unsigned*)((const char*)(gbase) + (voff)[_i]), (PG8_LAS unsigned*)(lds + (bufoff) + ldsw + _i * 8192), 16, 0, 0); } while (0)
#define PG8_LDA(dst, b, h) do { _Pragma("unroll") for (int m = 0; m < 4; ++m) { const v4i_t lo_ = *(const PG8_LAS v4i_t*)(lds + PG8_SA(b, h) + aoff + m * 2048), hi_ = *(const PG8_LAS v4i_t*)(lds + PG8_SA(b, h) + aoff + m * 2048 + 1024); dst[m] = __builtin_shufflevector(lo_, hi_, 0, 1, 2, 3, 4, 5, 6, 7); } } while (0)
#define PG8_LDB(dst, b, h) do { _Pragma("unroll") for (int n = 0; n < 2; ++n) { const v4i_t lo_ = *(const PG8_LAS v4i_t*)(lds + PG8_SB(b, h) + boff + n * 2048), hi_ = *(const PG8_LAS v4i_t*)(lds + PG8_SB(b, h) + boff + n * 2048 + 1024); dst[n] = __builtin_shufflevector(lo_, hi_, 0, 1, 2, 3, 4, 5, 6, 7); } } while (0)
#define PG8_MMA(ai, bj, At, Bt) do { __builtin_amdgcn_s_setprio(1); _Pragma("unroll") for (int m = 0; m < 4; ++m) _Pragma("unroll") for (int n = 0; n < 2; ++n) \
        asm volatile("v_mfma_scale_f32_16x16x128_f8f6f4 %0, %1, %2, %0, %3, %3 op_sel_hi:[0,0,0]" : "+v"(acc[ai][bj][m][n]) : "v"(Bt[n]), "v"(At[m]), "v"(scl_)); __builtin_amdgcn_s_setprio(0); } while (0)
#define PG8_WAIT_V(n) asm volatile("s_waitcnt vmcnt(" #n ")" ::: "memory")
#define PG8_WAIT_L(n) asm volatile("s_waitcnt lgkmcnt(" #n ")" ::: "memory")
#define PG8_BAR __builtin_amdgcn_s_barrier()
#define PG8_SCHED __builtin_amdgcn_sched_barrier(0)
    Unit cur, nxt; int ui = 0;
    if (!S.next(0, cur)) return;
    int rA[2]; unsigned cAo[2];
#pragma unroll
    for (int i = 0; i < 2; ++i) { int R, C; stage_rc(tid * 16 + i * 8192, R, C); rA[i] = R; cAo[i] = (unsigned)C * 2u; }
    unsigned cO[2][2], o2[2][2]; int nR[2][2];
#define PG8_ROWS(dst, u) do { _Pragma("unroll") for (int h_ = 0; h_ < 2; ++h_) _Pragma("unroll") for (int i_ = 0; i_ < 2; ++i_) \
        dst[h_][i_] = (unsigned)S.arow(u, h_ * HALF + rA[i_]) * (unsigned)(K * 2) + cAo[i_]; } while (0)
    PG8_ROWS(cO, cur);
    f32x4 acc[2][2][4][2];
#pragma unroll
    for (int a = 0; a < 2; ++a)
#pragma unroll
        for (int b = 0; b < 2; ++b)
#pragma unroll
            for (int m = 0; m < 4; ++m)
#pragma unroll
                for (int n = 0; n < 2; ++n) acc[a][b][m][n] = (f32x4){0.f, 0.f, 0.f, 0.f};
    const int scl_ = 0x7f7f7f7f;
    v8i_t At[4], B0[2], B1[2];
    const char* const Ab = (const char*)g.A; const char* cB = (const char*)g.Bt + (size_t)cur.pn * tstep;
    S.a_ready(cur);
    if constexpr (SP2) {
        PG8_STAGE(PG8_SB(0, 0), cB, voffB); PG8_STAGE(PG8_SB(0, 1), cB + hstep, voffB); PG8_STAGE(PG8_SA(0, 0), Ab, cO[0]); PG8_STAGE(PG8_SA(0, 1), Ab, cO[1]);
        if (wr == 1) PG8_BAR;
        PG8_WAIT_V(2); PG8_BAR;
        PG8_STAGE(PG8_SB(1, 0), cB + kstep, voffB); PG8_STAGE(PG8_SA(1, 0), Ab + kstep, cO[0]); PG8_STAGE(PG8_SB(1, 1), cB + hstep + kstep, voffB);
        PG8_WAIT_V(6); PG8_BAR;
    }
    for (;;) {
        const bool has_next = S.next(ui + 1, nxt);
        const char* nB = has_next ? (const char*)g.Bt + (size_t)nxt.pn * tstep : cB;
#pragma unroll
        for (int h_ = 0; h_ < 2; ++h_)
#pragma unroll
            for (int i_ = 0; i_ < 2; ++i_) nR[h_][i_] = has_next ? S.arow(nxt, h_ * HALF + rA[i_]) : 0;
        for (int t = 0; t < nt; t += 2) {
            const bool last = (t == nt - 2);
            const char* a1 = Ab + (size_t)(t + 1) * kstep;
            const char* a2 = last ? Ab : Ab + (size_t)(t + 2) * kstep; const char* b2 = last ? nB : cB + (size_t)(t + 2) * kstep;
#pragma unroll
            for (int h_ = 0; h_ < 2; ++h_)
#pragma unroll
                for (int i_ = 0; i_ < 2; ++i_) o2[h_][i_] = cO[h_][i_];
            if (last && has_next) {
#pragma unroll
                for (int h_ = 0; h_ < 2; ++h_)
#pragma unroll
                    for (int i_ = 0; i_ < 2; ++i_) { int v_ = nR[h_][i_]; asm volatile("" : "+v"(v_)); o2[h_][i_] = (unsigned)v_ * (unsigned)(K * 2) + cAo[i_]; } }
            const char* a3 = a2 + kstep; const char* b3 = b2 + kstep;
            if (last && has_next) S.a_ready(nxt);
            if constexpr (SP2) {
            PG8_LDB(B0, 0, 0); PG8_LDB(B1, 0, 1); PG8_SCHED; PG8_LDA(At, 0, 0); PG8_STAGE(PG8_SA(1, 1), a1, cO[1]);
            PG8_WAIT_V(8); PG8_WAIT_L(0); PG8_BAR; PG8_MMA(0, 0, At, B0); PG8_MMA(0, 1, At, B1); PG8_BAR; PG8_SCHED;
            PG8_LDA(At, 0, 1); PG8_STAGE(PG8_SB(0, 0), b2, voffB); PG8_STAGE(PG8_SB(0, 1), b2 + hstep, voffB); PG8_STAGE(PG8_SA(0, 0), a2, o2[0]);
            PG8_WAIT_V(8); PG8_WAIT_L(0); PG8_BAR; PG8_MMA(1, 0, At, B0); PG8_MMA(1, 1, At, B1); PG8_BAR; PG8_SCHED;
            PG8_LDB(B0, 1, 0); PG8_LDB(B1, 1, 1); PG8_SCHED; PG8_LDA(At, 1, 0); PG8_STAGE(PG8_SA(0, 1), a2, o2[1]);
            PG8_WAIT_V(8); PG8_WAIT_L(0); PG8_BAR; PG8_MMA(0, 0, At, B0); PG8_MMA(0, 1, At, B1); PG8_BAR; PG8_SCHED;
            PG8_LDA(At, 1, 1); PG8_STAGE(PG8_SB(1, 0), b3, voffB); PG8_STAGE(PG8_SB(1, 1), b3 + hstep, voffB); PG8_STAGE(PG8_SA(1, 0), a3, o2[0]);
            PG8_WAIT_V(8); PG8_WAIT_L(0); PG8_BAR; PG8_MMA(1, 0, At, B0); PG8_MMA(1, 1, At, B1); PG8_BAR; PG8_SCHED;
            }
        }
        if constexpr (ALIGN_EPI) { if (wr == 0) PG8_BAR; }
        asm volatile("s_nop 15\n\ts_nop 15" ::: "memory");
        if constexpr (!Epi::AFTER_DRAIN) { E(acc, cur, wr, wc, fr, fq); S.done(cur); }
        if (!has_next) break;
#pragma unroll
        for (int a = 0; a < 2; ++a)
#pragma unroll
            for (int b = 0; b < 2; ++b)
#pragma unroll
                for (int m = 0; m < 4; ++m)
#pragma unroll
                    for (int n = 0; n < 2; ++n) acc[a][b][m][n] = (f32x4){0.f, 0.f, 0.f, 0.f};
        cur = nxt; cB = nB; ++ui;
#pragma unroll
        for (int h_ = 0; h_ < 2; ++h_)
#pragma unroll
            for (int i_ = 0; i_ < 2; ++i_) cO[h_][i_] = o2[h_][i_];
        if constexpr (ALIGN_EPI) { if (wr == 1) PG8_BAR; }
    }
    PG8_WAIT_V(0);
    if constexpr (!ALIGN_EPI) { if (wr == 0) PG8_BAR; }
    PG8_BAR;
    if constexpr (Epi::AFTER_DRAIN) { E.fused(acc, cur, wr, wc, fr, fq, lds, wid, lane); S.done(cur); }
#undef PG8_ROWS
#undef PG8_SA
#undef PG8_SB
#undef PG8_STAGE
#undef PG8_LDA
#undef PG8_LDB
#undef PG8_MMA
#undef PG8_WAIT_V
#undef PG8_WAIT_L
#undef PG8_BAR
#undef PG8_SCHED
}
}

typedef short bf16x8c __attribute__((ext_vector_type(8)));
typedef float f32x16c __attribute__((ext_vector_type(16)));
__device__ __forceinline__ void phase_conv(const Params& p, const Ctx& c) {
    unsigned char* ws = p.ws;
    const bf16_t* P = (const bf16_t*)(ws + WS_P);
    const int tid = c.tid;
    LAS bf16_t* raw = (LAS bf16_t*)c.lds;
    LAS bf16_t* outb = (LAS bf16_t*)(c.lds + 132 * 256 * 2);
    for (int it = c.bid; it < 2 * 64 * 6; it += c.G) {
        const int part = it % 6, bc = it / 6, b = bc / 64, ch_ = bc % 64, t0 = ch_ * 128;
        __syncthreads();
        {
            u32x4 rv[9];
#pragma unroll
            for (int i = 0; i < 9; ++i) { const int idx = tid + 512 * i, r = idx >> 5, c8 = idx & 31, tok = t0 - 2 + r;
                rv[i] = (u32x4){0u, 0u, 0u, 0u};
                if (idx < 132 * 32 && tok >= 0 && tok < S) rv[i] = __builtin_nontemporal_load((const u32x4*)(P + (size_t)(b * S + tok) * NPROJ + PXBC + part * 256 + c8 * 8)); }
#pragma unroll
            for (int i = 0; i < 9; ++i) { const int idx = tid + 512 * i, r = idx >> 5, c8 = idx & 31;
                if (idx < 132 * 32) *(LAS u32x4*)(raw + r * 256 + c8 * 8) = rv[i]; }
        }
        __syncthreads();
        {
            const int ch = tid & 255, hf = tid >> 8, cg_ = part * 256 + ch;
            const float* cw = p.in[3]; const float cb = p.in[4][cg_];
            const float w0 = cw[0 * 1536 + cg_], w1 = cw[1 * 1536 + cg_], w2 = cw[2 * 1536 + cg_], w3 = cw[3 * 1536 + cg_], w4 = cw[4 * 1536 + cg_];
            const LAS bf16_t* rp = raw + (hf * 64) * 256 + ch;
            float r0 = bf2f(rp[0 * 256]), r1 = bf2f(rp[1 * 256]), r2 = bf2f(rp[2 * 256]), r3 = bf2f(rp[3 * 256]);
            unsigned ov[32];
#pragma unroll
            for (int i = 0; i < 64; ++i) {
                const float r4 = bf2f(rp[(i + 4) * 256]);
                float a = cb; a = fmaf(w0, r0, a); a = fmaf(w1, r1, a); a = fmaf(w2, r2, a); a = fmaf(w3, r3, a); a = fmaf(w4, r4, a);
                const unsigned hv = f2bf(a * sigmoidf_(a));
                if (i & 1) ov[i >> 1] |= hv << 16; else ov[i >> 1] = hv;
                r0 = r1; r1 = r2; r2 = r3; r3 = r4;
            }
            if (part <= 4) {
                bf16_t* dst = (part < 4 ? (bf16_t*)(ws + WS_XT) + ((size_t)(b * 64 + ch_) * 16 + part * 4) * 64 * 128
                                        : (bf16_t*)(ws + WS_BMT) + (size_t)(b * 64 + ch_) * 2 * 128 * 128) + (size_t)ch * 128 + hf * 64;
#pragma unroll
                for (int q = 0; q < 8; ++q) *(u32x4*)(dst + q * 8) = (u32x4){ov[4 * q], ov[4 * q + 1], ov[4 * q + 2], ov[4 * q + 3]};
            }
            if (part >= 4) {
#pragma unroll
                for (int i = 0; i < 64; ++i) outb[(hf * 64 + i) * 256 + ch] = (bf16_t)((i & 1) ? (ov[i >> 1] >> 16) : (ov[i >> 1] & 0xffffu));
            }
        }
        if (part >= 4) {
            __syncthreads();
            bf16_t* dst = (bf16_t*)(ws + (part == 4 ? WS_BMR : WS_CMR)) + (size_t)(b * S + t0) * 256;
#pragma unroll
            for (int q = 0; q < 8; ++q) { const int idx = tid + 512 * q, l = idx >> 5, c8 = idx & 31;
                *(u32x4*)(dst + (size_t)l * 256 + c8 * 8) = *(const LAS u32x4*)(outb + l * 256 + c8 * 8); }
        }
    }
    {
        float* DT = (float*)(ws + WS_DT); float* ACS = (float*)(ws + WS_ACS); float* CDEC = (float*)(ws + WS_CDEC);
        const bf16_t* H = (const bf16_t*)(ws + WS_H); const bf16_t* Wdt = (const bf16_t*)(ws + WS_WINT) + (size_t)PDT * 1024;
        constexpr int WS_ = 1032;
        LAS bf16_t* wl = (LAS bf16_t*)c.lds; LAS float* dtr = (LAS float*)(c.lds + 32 * WS_ * 2);
        const int lane = c.lane, r = lane & 31, hh = lane >> 5;
        bool staged = false;
        for (int it = c.bid; it < 128; it += c.G) {
            const int b = it / 64, ch_ = it % 64, t0 = ch_ * 128;
            __syncthreads();
            if (!staged) { staged = true;
#pragma unroll
                for (int i = 0; i < 8; ++i) { const int idx = tid + 512 * i, row = idx >> 7, c8 = idx & 127; *(LAS u32x4*)(wl + row * WS_ + c8 * 8) = *(const u32x4*)(Wdt + (size_t)row * 1024 + c8 * 8); }
                __syncthreads(); }
            {
                const int rb = c.wave & 3, kh = c.wave >> 2;
                const bf16_t* hrow = H + ((size_t)b * S + t0 + rb * 32 + r) * 1024 + kh * 512 + 8 * hh;
                f32x16c acc = {};
#pragma unroll
                for (int k8 = 0; k8 < 4; ++k8) { bf16x8c a[8];
#pragma unroll
                    for (int ks = 0; ks < 8; ++ks) a[ks] = *(const bf16x8c*)(hrow + (k8 * 8 + ks) * 16);
#pragma unroll
                    for (int ks = 0; ks < 8; ++ks) acc = __builtin_amdgcn_mfma_f32_32x32x16_bf16(a[ks], *(const LAS bf16x8c*)(wl + r * WS_ + kh * 512 + (k8 * 8 + ks) * 16 + 8 * hh), acc, 0, 0, 0); }
#pragma unroll
                for (int i = 0; i < 16; ++i) { const int l = rb * 32 + (i & 3) + 8 * (i >> 2) + 4 * hh; dtr[(kh * 128 + l) * 33 + r] = acc[i]; }
            }
            __syncthreads();
#pragma unroll
            for (int qi = 0; qi < 4; ++qi) {
                const int q = c.wave * 4 + qi, dir = q >> 4, h = q & 15;
                const float bias = dir ? p.in[6][h] : p.in[5][h], nA = -expf(dir ? p.in[8][h] : p.in[7][h]);
                const int l0 = dir ? 127 - lane : lane, l1 = dir ? 63 - lane : lane + 64;
                const size_t tok0 = (size_t)b * S + t0 + l0, tok1 = (size_t)b * S + t0 + l1;
                const float x0 = dtr[l0 * 33 + q] + dtr[(128 + l0) * 33 + q] + bias, x1 = dtr[l1 * 33 + q] + dtr[(128 + l1) * 33 + q] + bias;
                const float d0 = fmaxf(x0, 0.f) + log1pf(expf(-fabsf(x0))), d1 = fmaxf(x1, 0.f) + log1pf(expf(-fabsf(x1)));
                float a0 = d0 * nA, a1 = d1 * nA;
#pragma unroll
                for (int o = 1; o < 64; o <<= 1) { const float t0_ = __shfl_up(a0, o), t1_ = __shfl_up(a1, o); if (lane >= o) { a0 += t0_; a1 += t1_; } }
                const float tot0 = __shfl(a0, 63); a1 += tot0;
                DT[((size_t)dir * M + tok0) * 16 + h] = d0; DT[((size_t)dir * M + tok1) * 16 + h] = d1;
                ACS[((size_t)dir * M + tok0) * 16 + h] = a0; ACS[((size_t)dir * M + tok1) * 16 + h] = a1;
                if (lane == 63) CDEC[((dir * 2 + b) * 64 + ch_) * 16 + h] = expf(a1);
            }
        }
        __syncthreads();
    }
    {
        const int gw = c.bid * 8 + c.wave, NGW = c.G * 8, lane = c.lane;
        const float* rc = (const float*)(ws + WS_ROPE); const float* rs = rc + 4096;
        const int sub = lane >> 4, j = lane & 15, axis = j >> 3, i0 = 8 * (j & 3); const bool second = (j & 4) != 0;
        const f32x4 gq0 = *(const f32x4*)(p.in[11] + 8 * j), gq1 = *(const f32x4*)(p.in[11] + 8 * j + 4), gk0 = *(const f32x4*)(p.in[12] + 8 * j), gk1 = *(const f32x4*)(p.in[12] + 8 * j + 4);
        unsigned char* QN = ws + WS_QN; unsigned char* KN = ws + WS_KN;
        for (int base0 = gw; base0 < M * 10 / 4; base0 += 4 * NGW) {
            u32x4 vq[4]; int tokq[4], hhq[4];
#pragma unroll
            for (int u = 0; u < 4; ++u) { const int base = base0 + u * NGW, it = base * 4 + sub; tokq[u] = it / 10; hhq[u] = it % 10;
                vq[u] = (u32x4){0u, 0u, 0u, 0u};
                if (base < M * 10 / 4) vq[u] = __builtin_nontemporal_load((const u32x4*)(P + (size_t)tokq[u] * NPROJ + (hhq[u] < 8 ? PQ + hhq[u] * 128 : PK + (hhq[u] - 8) * 128) + 8 * j)); }
#pragma unroll
            for (int u = 0; u < 4; ++u) {
                const int base = base0 + u * NGW, tok = tokq[u], hh = hhq[u];
                unsigned char* dst = (hh < 8 ? QN + (size_t)tok * 1024 + hh * 128 : KN + (size_t)tok * 256 + (hh - 8) * 128) + 8 * j;
                const u32x4 v = vq[u];
                float y[8] = {bflo(v.x), bfhi(v.x), bflo(v.y), bfhi(v.y), bflo(v.z), bfhi(v.z), bflo(v.w), bfhi(v.w)};
                float ss = 0.f;
#pragma unroll
                for (int i = 0; i < 8; ++i) ss = fmaf(y[i], y[i], ss);
                ss += __shfl_xor(ss, 1); ss += __shfl_xor(ss, 2); ss += __shfl_xor(ss, 4); ss += __shfl_xor(ss, 8);
                const float rstd = rsqrtf(ss * (1.f / 128.f) + EPS);
                const f32x4 g0 = hh < 8 ? gq0 : gk0, g1 = hh < 8 ? gq1 : gk1;
#pragma unroll
                for (int i = 0; i < 4; ++i) { y[i] *= rstd * g0[i]; y[4 + i] *= rstd * g1[i]; }
                const int s = tok & (S - 1), pos = axis ? (s & 63) : (s >> 6);
                const f32x4 c0 = *(const f32x4*)(rc + pos * 32 + i0), c1 = *(const f32x4*)(rc + pos * 32 + i0 + 4), s0 = *(const f32x4*)(rs + pos * 32 + i0), s1 = *(const f32x4*)(rs + pos * 32 + i0 + 4);
                float o[8];
#pragma unroll
                for (int i = 0; i < 8; ++i) { const float other = __shfl_xor(y[i], 4); const float cs = i < 4 ? c0[i] : c1[i - 4], sn = i < 4 ? s0[i] : s1[i - 4];
                    o[i] = second ? fmaf(other, sn, y[i] * cs) : fmaf(-other, sn, y[i] * cs); }
                u32x2 w; w.x = pack4_fp8(o[0], o[1], o[2], o[3]); w.y = pack4_fp8(o[4], o[5], o[6], o[7]);
                if (base < M * 10 / 4) *(u32x2*)dst = w;
            }
        }
    }
    {
        unsigned char* VT8 = ws + WS_VB; LAS unsigned char* vt = c.lds;
        for (int it = c.bid; it < 256; it += c.G) {
            const int b = it >> 7, jt = it & 127;
            __syncthreads();
            u32x4 vv[4];
#pragma unroll
            for (int q = 0; q < 4; ++q) { const int idx = tid + 512 * q, key = idx >> 5, c8 = idx & 31; vv[q] = __builtin_nontemporal_load((const u32x4*)(P + ((size_t)b * S + jt * 64 + key) * NPROJ + PV + c8 * 8)); }
#pragma unroll
            for (int q = 0; q < 4; ++q) { const int idx = tid + 512 * q, key = idx >> 5, c8 = idx & 31, d0 = c8 * 8;
                const int off = 32 * ((key >> 2) & 1) + 16 * (key >> 5) + (key & 3) + 4 * ((key & 31) >> 3);
                const unsigned w0 = pack4_fp8(bflo(vv[q].x), bfhi(vv[q].x), bflo(vv[q].y), bfhi(vv[q].y)), w1 = pack4_fp8(bflo(vv[q].z), bfhi(vv[q].z), bflo(vv[q].w), bfhi(vv[q].w));
                LAS unsigned char* dp = vt + d0 * 64 + off;
                dp[0 * 64] = (unsigned char)(w0); dp[1 * 64] = (unsigned char)(w0 >> 8); dp[2 * 64] = (unsigned char)(w0 >> 16); dp[3 * 64] = (unsigned char)(w0 >> 24);
                dp[4 * 64] = (unsigned char)(w1); dp[5 * 64] = (unsigned char)(w1 >> 8); dp[6 * 64] = (unsigned char)(w1 >> 16); dp[7 * 64] = (unsigned char)(w1 >> 24); }
            __syncthreads();
#pragma unroll
            for (int q = 0; q < 2; ++q) { const int idx = tid + 512 * q, kvh = idx >> 9, rem = idx & 511;
                *(u32x4*)(VT8 + ((size_t)(b * 2 + kvh) * 128 + jt) * 8192 + rem * 16) = *(const LAS u32x4*)(vt + kvh * 8192 + rem * 16); }
        }
        __syncthreads();
    }
}

typedef short bf16x8 __attribute__((ext_vector_type(8)));
typedef float f32x16 __attribute__((ext_vector_type(16)));
constexpr int TS = 136;
__device__ __forceinline__ bf16x8 ldfrag(const LAS bf16_t* tile, int row, int k0) { return *(const LAS bf16x8*)(tile + row * TS + k0); }
template <int ROWS> __device__ __forceinline__ void load_tile128(LAS bf16_t* dst, const bf16_t* src, int ld, int tid) {
    constexpr int N = ROWS * 16 / 512;
    u32x4 v[N];
#pragma unroll
    for (int i = 0; i < N; ++i) { const int idx = tid + 512 * i; v[i] = *(const u32x4*)(src + (size_t)(idx >> 4) * ld + (idx & 15) * 8); }
#pragma unroll
    for (int i = 0; i < N; ++i) { const int idx = tid + 512 * i; *(LAS u32x4*)(dst + (idx >> 4) * TS + (idx & 15) * 8) = v[i]; }
}
__device__ __forceinline__ void phase_ssd_states(const Params& p, const Ctx& c) {
    unsigned char* ws = p.ws;
    const bf16_t* XT = (const bf16_t*)(ws + WS_XT); const bf16_t* BMT = (const bf16_t*)(ws + WS_BMT);
    const float* DT = (const float*)(ws + WS_DT); const float* ACS = (const float*)(ws + WS_ACS); bf16_t* ST = (bf16_t*)(ws + WS_PREV);
    LAS bf16_t* BTs = (LAS bf16_t*)c.lds; LAS bf16_t* XTf = BTs + 128 * TS; LAS bf16_t* XTb = XTf + 64 * TS; LAS float* wd = (LAS float*)(XTb + 64 * TS);
    const int tid = c.tid, lane = c.lane, r = lane & 31, hh = lane >> 5;
    for (int unit = c.bid; unit < 256; unit += c.G) {
        const int b = unit >> 7, ch = (unit >> 1) & 63, g = unit & 1;
        __syncthreads();
        load_tile128<128>(BTs, BMT + ((size_t)(b * 64 + ch) * 2 + g) * 128 * 128, 128, tid);
        u32x4 xv0, xv1; float pacs = 0.f, pdt = 0.f, paend = 0.f;
        const int wd_d = (tid >> 7) & 1, wd_l = tid & 127; const size_t wd_t0 = (size_t)wd_d * M + (size_t)b * S + ch * 128;
#define S1_PREFETCH(H) do { const bf16_t* xt_ = XT + ((size_t)(b * 64 + ch) * 16 + (H)) * 64 * 128; \
            xv0 = *(const u32x4*)(xt_ + (tid >> 4) * 128 + (tid & 15) * 8); xv1 = *(const u32x4*)(xt_ + ((tid + 512) >> 4) * 128 + (tid & 15) * 8); \
            if (tid < 256) { pacs = ACS[(wd_t0 + wd_l) * 16 + (H)]; pdt = DT[(wd_t0 + wd_l) * 16 + (H)]; paend = ACS[(wd_t0 + (wd_d ? 0 : 127)) * 16 + (H)]; } } while (0)
        S1_PREFETCH(g * 8);
#pragma unroll 1
        for (int h8 = 0; h8 < 8; ++h8) {
            const int h = g * 8 + h8;
            __syncthreads();
            if (tid < 256) wd[wd_d * 128 + wd_l] = pdt * __expf(paend - pacs);
            __syncthreads();
            {
                const u32x4 vv[2] = {xv0, xv1};
#pragma unroll
                for (int i = 0; i < 2; ++i) { const int idx = tid + 512 * i, pr = idx >> 4, l0 = (idx & 15) * 8; const u32x4 v = vv[i];
                    const float x[8] = {bflo(v.x), bfhi(v.x), bflo(v.y), bfhi(v.y), bflo(v.z), bfhi(v.z), bflo(v.w), bfhi(v.w)};
                    const f32x4 wf0 = *(const LAS f32x4*)(wd + l0), wf1 = *(const LAS f32x4*)(wd + l0 + 4), wb0 = *(const LAS f32x4*)(wd + 128 + l0), wb1 = *(const LAS f32x4*)(wd + 128 + l0 + 4);
                    u32x4 of, ob;
                    of.x = pk2(x[0] * wf0[0], x[1] * wf0[1]); of.y = pk2(x[2] * wf0[2], x[3] * wf0[3]); of.z = pk2(x[4] * wf1[0], x[5] * wf1[1]); of.w = pk2(x[6] * wf1[2], x[7] * wf1[3]);
                    ob.x = pk2(x[0] * wb0[0], x[1] * wb0[1]); ob.y = pk2(x[2] * wb0[2], x[3] * wb0[3]); ob.z = pk2(x[4] * wb1[0], x[5] * wb1[1]); ob.w = pk2(x[6] * wb1[2], x[7] * wb1[3]);
                    *(LAS u32x4*)(XTf + pr * TS + l0) = of; *(LAS u32x4*)(XTb + pr * TS + l0) = ob; }
            }
            if (h8 < 7) S1_PREFETCH(h + 1);
            __syncthreads();
            { const int d = c.wave >> 2, nb = c.wave & 3; const LAS bf16_t* XTd = d ? XTb : XTf;
              bf16_t* st = ST + ((((size_t)(d * 2 + b) * 64 + ch) * 16 + h) * 64) * 128;
#pragma unroll
              for (int pb = 0; pb < 2; ++pb) { f32x16 acc = {};
#pragma unroll
                for (int ks = 0; ks < 8; ++ks) acc = __builtin_amdgcn_mfma_f32_32x32x16_bf16(ldfrag(XTd, pb * 32 + r, ks * 16 + 8 * hh), ldfrag(BTs, nb * 32 + r, ks * 16 + 8 * hh), acc, 0, 0, 0);
#pragma unroll
                for (int i = 0; i < 16; ++i) { const int pp = pb * 32 + (i & 3) + 8 * (i >> 2) + 4 * hh; st[(size_t)pp * 128 + nb * 32 + r] = (bf16_t)f2bf(acc[i]); } } }
        }
#undef S1_PREFETCH
    }
}
__device__ __forceinline__ void phase_ssd_scan(const Params& p, const Ctx& c) {
    unsigned char* ws = p.ws;
    const float* CDEC = (const float*)(ws + WS_CDEC); bf16_t* PREV = (bf16_t*)(ws + WS_PREV);
    for (int idx = c.bid * 512 + c.tid; idx < 131072; idx += c.G * 512) {
        const int n4 = idx & 31, pp = (idx >> 5) & 63, h = (idx >> 11) & 15, b = (idx >> 15) & 1, d = idx >> 16;
        f32x4 run = {0.f, 0.f, 0.f, 0.f};
        const size_t obase = ((size_t)(d * 2 + b) * 64 * 16 + h) * 64 * 128 + (size_t)pp * 128 + n4 * 4;
        const float* cd = CDEC + (d * 2 + b) * 64 * 16 + h;
#pragma unroll 1
        for (int s0 = 0; s0 < 64; s0 += 16) {
            u32x2 sv[16]; float dec[16];
#pragma unroll
            for (int i = 0; i < 16; ++i) { const int ch = d ? 63 - (s0 + i) : s0 + i; sv[i] = __builtin_nontemporal_load((const u32x2*)(PREV + obase + (size_t)ch * (16 * 64 * 128))); dec[i] = cd[ch * 16]; }
#pragma unroll
            for (int i = 0; i < 16; ++i) { const int ch = d ? 63 - (s0 + i) : s0 + i;
                u32x2 w; w.x = pk2(run.x, run.y); w.y = pk2(run.z, run.w); *(u32x2*)(PREV + obase + (size_t)ch * (16 * 64 * 128)) = w;
                run.x = fmaf(run.x, dec[i], bflo(sv[i].x)); run.y = fmaf(run.y, dec[i], bfhi(sv[i].x)); run.z = fmaf(run.z, dec[i], bflo(sv[i].y)); run.w = fmaf(run.w, dec[i], bfhi(sv[i].y)); }
        }
    }
}
__device__ __forceinline__ void phase_ssd_out(const Params& p, const Ctx& c) {
    unsigned char* ws = p.ws;
    const bf16_t* P = (const bf16_t*)(ws + WS_P); const bf16_t* XT = (const bf16_t*)(ws + WS_XT);
    const bf16_t* BMR = (const bf16_t*)(ws + WS_BMR); const bf16_t* CMR = (const bf16_t*)(ws + WS_CMR); const bf16_t* PREV = (const bf16_t*)(ws + WS_PREV);
    const float* DT = (const float*)(ws + WS_DT); const float* ACS = (const float*)(ws + WS_ACS); bf16_t* YZ = (bf16_t*)(ws + WS_YZ);
    LAS bf16_t* Cs = (LAS bf16_t*)c.lds; LAS bf16_t* Ms = Cs + 128 * TS; LAS bf16_t* XTs = Ms + 128 * TS; LAS bf16_t* PF = XTs + 64 * TS; LAS bf16_t* PB = PF + 64 * TS;
    LAS float* vec = (LAS float*)(PB + 64 * TS);
    constexpr int ZS = 72; LAS bf16_t* Zs = (LAS bf16_t*)(vec + 512); LAS float* dskl = (LAS float*)(Zs + 128 * ZS);
    const int tid = c.tid, lane = c.lane, r = lane & 31, hh = lane >> 5, wave = c.wave;
    for (int unit = c.bid; unit < 256; unit += c.G) {
        const int b = unit >> 7, ch = (unit >> 1) & 63, g = unit & 1;
        const size_t tok0 = (size_t)b * S + ch * 128;
        __syncthreads();
        load_tile128<128>(Cs, CMR + tok0 * 256 + g * 128, 256, tid);
        load_tile128<128>(Ms, BMR + tok0 * 256 + g * 128, 256, tid);
        u32x4 px0, px1, pf0, pf1, pb0, pb1, pz0, pz1; float pvec;
        const int t_r0 = tid >> 4, t_r1 = (tid + 512) >> 4, t_c = (tid & 15) * 8;
#define S3_PREFETCH(H) do { const bf16_t* xt_ = XT + ((size_t)(b * 64 + ch) * 16 + (H)) * 64 * 128; \
            const bf16_t* f_ = PREV + ((((size_t)(0 * 2 + b) * 64 + ch) * 16 + (H)) * 64) * 128; const bf16_t* b_ = PREV + ((((size_t)(1 * 2 + b) * 64 + ch) * 16 + (H)) * 64) * 128; \
            px0 = __builtin_nontemporal_load((const u32x4*)(xt_ + t_r0 * 128 + t_c)); px1 = __builtin_nontemporal_load((const u32x4*)(xt_ + t_r1 * 128 + t_c)); pf0 = __builtin_nontemporal_load((const u32x4*)(f_ + t_r0 * 128 + t_c)); pf1 = __builtin_nontemporal_load((const u32x4*)(f_ + t_r1 * 128 + t_c)); \
            pb0 = __builtin_nontemporal_load((const u32x4*)(b_ + t_r0 * 128 + t_c)); pb1 = __builtin_nontemporal_load((const u32x4*)(b_ + t_r1 * 128 + t_c)); \
            pz0 = __builtin_nontemporal_load((const u32x4*)(P + (tok0 + (tid >> 3)) * NPROJ + PZ + (H) * 64 + (tid & 7) * 8)); pz1 = __builtin_nontemporal_load((const u32x4*)(P + (tok0 + 64 + (tid >> 3)) * NPROJ + PZ + (H) * 64 + (tid & 7) * 8)); \
            { const int v_ = tid >> 7, l_ = tid & 127; const size_t o_ = ((size_t)(v_ & 1) * M + tok0 + l_) * 16 + (H); pvec = (v_ < 2) ? ACS[o_] : DT[o_]; } } while (0)
        S3_PREFETCH(g * 8);
        if (tid < 8) dskl[tid] = p.in[9][g * 8 + tid];
        __syncthreads();
        const int lb = wave & 3, sb0 = 2 * (wave >> 2);
        f32x16 G0 = {}, G1 = {};
#pragma unroll
        for (int ks = 0; ks < 8; ++ks) { const bf16x8 a = ldfrag(Cs, lb * 32 + r, ks * 16 + 8 * hh);
            G0 = __builtin_amdgcn_mfma_f32_32x32x16_bf16(a, ldfrag(Ms, sb0 * 32 + r, ks * 16 + 8 * hh), G0, 0, 0, 0);
            G1 = __builtin_amdgcn_mfma_f32_32x32x16_bf16(a, ldfrag(Ms, (sb0 + 1) * 32 + r, ks * 16 + 8 * hh), G1, 0, 0, 0); }
#pragma unroll 1
        for (int h8 = 0; h8 < 8; ++h8) {
            const int h = g * 8 + h8;
            __syncthreads();
            vec[tid] = pvec;
            *(LAS u32x4*)(XTs + t_r0 * TS + t_c) = px0; *(LAS u32x4*)(XTs + t_r1 * TS + t_c) = px1;
            *(LAS u32x4*)(PF + t_r0 * TS + t_c) = pf0; *(LAS u32x4*)(PF + t_r1 * TS + t_c) = pf1;
            *(LAS u32x4*)(PB + t_r0 * TS + t_c) = pb0; *(LAS u32x4*)(PB + t_r1 * TS + t_c) = pb1;
            *(LAS u32x4*)(Zs + (tid >> 3) * ZS + (tid & 7) * 8) = pz0; *(LAS u32x4*)(Zs + (64 + (tid >> 3)) * ZS + (tid & 7) * 8) = pz1;
            if (h8 < 7) S3_PREFETCH(h + 1);
            const int pbY = wave >> 2;
            __syncthreads();
#pragma unroll
            for (int t2 = 0; t2 < 2; ++t2) { const f32x16& Gt = t2 ? G1 : G0; const int sb = sb0 + t2, s = sb * 32 + r;
                const float afs = vec[s], abs_ = vec[128 + s], dfs = vec[256 + s], dbs = vec[384 + s];
                if (sb < lb) {
#pragma unroll
                    for (int i = 0; i < 16; ++i) { const int l = lb * 32 + (i & 3) + 8 * (i >> 2) + 4 * hh;
                        Ms[l * TS + s] = (bf16_t)f2bf(Gt[i] * __expf(vec[l] - afs) * dfs); }
                } else if (sb > lb) {
#pragma unroll
                    for (int i = 0; i < 16; ++i) { const int l = lb * 32 + (i & 3) + 8 * (i >> 2) + 4 * hh;
                        Ms[l * TS + s] = (bf16_t)f2bf(Gt[i] * __expf(vec[128 + l] - abs_) * dbs); }
                } else {
                    const float dsk = dskl[h8];
#pragma unroll
                    for (int i = 0; i < 16; ++i) { const int l = lb * 32 + (i & 3) + 8 * (i >> 2) + 4 * hh;
                        const float ef = __expf(fminf(vec[l] - afs, 0.f)) * dfs, eb = __expf(fminf(vec[128 + l] - abs_, 0.f)) * dbs;
                        const float tf = (s <= l) ? ef : 0.f, tb = (s >= l) ? eb : 0.f;
                        Ms[l * TS + s] = (bf16_t)f2bf(Gt[i] * (tf + tb) + (s == l ? dsk : 0.f)); }
                } }
            __syncthreads();
            { f32x16 Yd = {}, Yf = {}, Yb = {};
#pragma unroll
              for (int ks = 0; ks < 8; ++ks) { const int k0 = ks * 16 + 8 * hh;
                  Yd = __builtin_amdgcn_mfma_f32_32x32x16_bf16(ldfrag(Ms, lb * 32 + r, k0), ldfrag(XTs, pbY * 32 + r, k0), Yd, 0, 0, 0);
                  const bf16x8 a = ldfrag(Cs, lb * 32 + r, k0);
                  Yf = __builtin_amdgcn_mfma_f32_32x32x16_bf16(a, ldfrag(PF, pbY * 32 + r, k0), Yf, 0, 0, 0);
                  Yb = __builtin_amdgcn_mfma_f32_32x32x16_bf16(a, ldfrag(PB, pbY * 32 + r, k0), Yb, 0, 0, 0);
                  if (ks & 1) __builtin_amdgcn_sched_barrier(0); }
#pragma unroll
              for (int i = 0; i < 16; ++i) { const int l = lb * 32 + (i & 3) + 8 * (i >> 2) + 4 * hh;
                  const float y = Yd[i] + __expf(vec[l]) * Yf[i] + __expf(vec[128 + l]) * Yb[i];
                  const float z = bf2f(Zs[l * ZS + pbY * 32 + r]);
                  Zs[l * ZS + pbY * 32 + r] = (bf16_t)f2bf(y * z * sigmoidf_(z)); } }
            __syncthreads();
            *(u32x4*)(YZ + (tok0 + (tid >> 3)) * 1024 + h * 64 + (tid & 7) * 8) = *(const LAS u32x4*)(Zs + (tid >> 3) * ZS + (tid & 7) * 8);
            *(u32x4*)(YZ + (tok0 + 64 + (tid >> 3)) * 1024 + h * 64 + (tid & 7) * 8) = *(const LAS u32x4*)(Zs + (64 + (tid >> 3)) * ZS + (tid & 7) * 8);
        }
#undef S3_PREFETCH
    }
}

__device__ __forceinline__ void phase_rstd(const Params& p, const Ctx& c) {
    const bf16_t* YZ = (const bf16_t*)(p.ws + WS_YZ); float* RSTD = (float*)(p.ws + WS_RSTD);
    const int gw = c.bid * 8 + c.wave, NGW = c.G * 8;
    for (int m0 = gw * 4; m0 < M; m0 += NGW * 4) {
        u32x4 v[4][2];
#pragma unroll
        for (int q = 0; q < 4; ++q) { const u32x4* r = (const u32x4*)(YZ + (size_t)(m0 + q) * 1024) + c.lane; v[q][0] = r[0]; v[q][1] = r[64]; }
#pragma unroll
        for (int q = 0; q < 4; ++q) { float s = 0.f;
#pragma unroll
            for (int j = 0; j < 2; ++j) { const u32x4 w = v[q][j];
                s += bflo(w.x) * bflo(w.x) + bfhi(w.x) * bfhi(w.x) + bflo(w.y) * bflo(w.y) + bfhi(w.y) * bfhi(w.y) + bflo(w.z) * bflo(w.z) + bfhi(w.z) * bfhi(w.z) + bflo(w.w) * bflo(w.w) + bfhi(w.w) * bfhi(w.w); }
            s = wave_sum(s);
            if (c.lane == 0) RSTD[m0 + q] = rsqrtf(s * (1.f / 1024.f) + EPS); }
    }
}

namespace attn8 {
typedef int v8i __attribute__((ext_vector_type(8)));
typedef float f32x16 __attribute__((ext_vector_type(16)));
typedef unsigned u32x4_ __attribute__((ext_vector_type(4)));
constexpr int QBLK = 32, KVBLK = 64;
constexpr float SCALE = 0.088388347648318440f;
constexpr float THR = 0.69f;
constexpr size_t SHM_K = 64 * 128, SHM_V = 128 * 64, SHM_ATTN = 2 * SHM_K + 2 * SHM_V + 8 * 64 * 4;
__device__ __forceinline__ int crow(int r, int hi) { return (r & 3) + 8 * (r >> 2) + 4 * hi; }
__device__ __forceinline__ int kswz(int row, int colB) { return row * 128 + (colB ^ (((row >> 1) & 7) << 4)); }
__device__ __forceinline__ int vswz(int d, int slot) { return d * 64 + ((slot ^ ((d >> 2) & 3)) << 4); }
__device__ __forceinline__ v8i cat8(const u32x4_& lo, const u32x4_& hi) { v8i r; r[0] = (int)lo.x; r[1] = (int)lo.y; r[2] = (int)lo.z; r[3] = (int)lo.w; r[4] = (int)hi.x; r[5] = (int)hi.y; r[6] = (int)hi.z; r[7] = (int)hi.w; return r; }
template <bool LAST> __device__ __forceinline__ void mfma8(f32x16& acc, const v8i& a, const v8i& b, int scl) {
    acc = __builtin_amdgcn_mfma_scale_f32_32x32x64_f8f6f4(a, b, acc, 0, 0, 0, scl, 0, scl);
}
__device__ __forceinline__ void partialSM(f32x16& p0, f32x16& p1, float& m_reg, float& mn, float& alpha) {
    constexpr float C = SCALE * 1.4426950408889634f;
    float pmax = p0[0];
#pragma unroll
    for (int r = 1; r < 16; ++r) pmax = fmaxf(pmax, p0[r]);
#pragma unroll
    for (int r = 0; r < 16; ++r) pmax = fmaxf(pmax, p1[r]);
    { auto rr = __builtin_amdgcn_permlane32_swap(__float_as_uint(pmax), __float_as_uint(pmax), false, false); pmax = fmaxf(__uint_as_float(rr[0]), __uint_as_float(rr[1])); }
    if (__builtin_expect(__all(pmax - m_reg <= THR / SCALE), 1)) { mn = m_reg; alpha = 1.f; }
    else { mn = fmaxf(m_reg, pmax); alpha = __builtin_amdgcn_exp2f((m_reg - mn) * C); m_reg = mn; }
    const float mnC = 7.f - mn * C;
#pragma unroll
    for (int r = 0; r < 16; ++r) p0[r] = fmaf(p0[r], C, mnC);
#pragma unroll
    for (int r = 0; r < 16; ++r) p1[r] = fmaf(p1[r], C, mnC);
#pragma unroll
    for (int r = 0; r < 16; ++r) p0[r] = __builtin_amdgcn_exp2f(p0[r]);
}
__device__ __forceinline__ void finishSM(f32x16& p0, f32x16& p1, float alpha, float& l_reg, v8i& pa) {
#pragma unroll
    for (int r = 0; r < 16; ++r) p1[r] = __builtin_amdgcn_exp2f(p1[r]);
    float ps = 0;
#pragma unroll
    for (int r = 0; r < 16; ++r) ps += p0[r];
#pragma unroll
    for (int r = 0; r < 16; ++r) ps += p1[r];
    { auto rr = __builtin_amdgcn_permlane32_swap(__float_as_uint(ps), __float_as_uint(ps), false, false); ps = __uint_as_float(rr[0]) + __uint_as_float(rr[1]); }
    l_reg = l_reg * alpha + ps;
#pragma unroll
    for (int w = 0; w < 4; ++w) { pa[w] = (int)pack4_fp8(p0[4 * w], p0[4 * w + 1], p0[4 * w + 2], p0[4 * w + 3]); pa[4 + w] = (int)pack4_fp8(p1[4 * w], p1[4 * w + 1], p1[4 * w + 2], p1[4 * w + 3]); }
}
__device__ __forceinline__ void qkt(f32x16& p0, f32x16& p1, const char* Ks, const v8i* qf, int r32, int hi, int scl) {
    p0 = f32x16{}; p1 = f32x16{};
#pragma unroll
    for (int s = 0; s < 2; ++s) { const int cb = 64 * s + 32 * hi;
        const v8i a0 = cat8(*(const u32x4_*)(Ks + kswz(r32, cb)), *(const u32x4_*)(Ks + kswz(r32, cb + 16)));
        const v8i a1 = cat8(*(const u32x4_*)(Ks + kswz(32 + r32, cb)), *(const u32x4_*)(Ks + kswz(32 + r32, cb + 16)));
        if (s == 0) { mfma8<false>(p0, a0, qf[s], scl); mfma8<false>(p1, a1, qf[s], scl); }
        else { mfma8<false>(p0, a0, qf[s], scl); mfma8<true>(p1, a1, qf[s], scl); } }
}
__device__ __forceinline__ void pv(f32x16* o, const char* Vs, const v8i& pa, int r32, int hi, int scl) {
#pragma unroll
    for (int d0 = 0; d0 < 4; ++d0) { const int d = d0 * 32 + r32;
        const v8i b = cat8(*(const u32x4_*)(Vs + vswz(d, 2 * hi)), *(const u32x4_*)(Vs + vswz(d, 2 * hi + 1)));
        if (d0 == 3) mfma8<true>(o[d0], pa, b, scl); else mfma8<false>(o[d0], pa, b, scl); }
}
__device__ __forceinline__ void body(const unsigned char* __restrict__ Qb, const unsigned char* __restrict__ Kh, const unsigned char* __restrict__ Vt, unsigned short* __restrict__ Ob, int seq, char* lds) {
    const int tid = threadIdx.x, wid = tid >> 6, lane = tid & 63, r32 = lane & 31, hi = lane >> 5;
    const int scl = 0x7f7f7f7f;
    float* ws = (float*)(lds + 65536) + wid * 64; float* li_l = ws; float* al_l = ws + 32;
    float m_reg = -1e30f, l_reg = 0; f32x16 o[4] = {}; v8i qf[2];
    { const unsigned char* Qw = Qb + (long)(wid * QBLK + r32) * 1024 + 32 * hi;
#pragma unroll
      for (int s = 0; s < 2; ++s) qf[s] = cat8(*(const u32x4_*)(Qw + 64 * s), *(const u32x4_*)(Qw + 64 * s + 16)); }
    const int kr = tid >> 3, kc = (tid & 7) * 16, kdst = kswz(kr, kc);
    const int vd = tid >> 2, vsl = tid & 3, vdst = vswz(vd, vsl);
    struct { u32x4_ k, v; } sr_[2];
#define SLOAD(i, t) do { sr_[i].k = *(const u32x4_*)(Kh + (long)((t) * KVBLK + kr) * 256 + kc); sr_[i].v = *(const u32x4_*)(Vt + (long)(t) * 8192 + vd * 64 + vsl * 16); } while (0)
#define SWRITE(t, i) do { char* s_ = lds + ((t) & 3) * 16384; *(u32x4_*)(s_ + kdst) = sr_[i].k; *(u32x4_*)(s_ + 8192 + vdst) = sr_[i].v; } while (0)
#define KS(t) (lds + ((t) & 3) * 16384)
#define VS(t) (lds + ((t) & 3) * 16384 + 8192)
#define SWAIT() asm volatile("s_waitcnt vmcnt(2)" ::: "memory")
#define RESC(a) do { if (__any((a) < 1.f)) { if (hi == 0) al_l[r32] = (a); asm volatile("s_waitcnt lgkmcnt(0)" ::: "memory"); \
    _Pragma("unroll") for (int d = 0; d < 4; ++d) _Pragma("unroll") for (int r = 0; r < 16; ++r) o[d][r] *= al_l[crow(r, hi)]; } } while (0)
#define SBAR_() __builtin_amdgcn_sched_barrier(0)
    f32x16 pA0, pA1, pB0, pB1; float mnA, mnB, alA, alB; v8i pa; const int NT = seq / KVBLK;
    SLOAD(0, 0); asm volatile("s_waitcnt vmcnt(0)" ::: "memory"); SWRITE(0, 0); __syncthreads();
    qkt(pA0, pA1, KS(0), qf, r32, hi, scl); partialSM(pA0, pA1, m_reg, mnA, alA);
    SLOAD(1, 1); if (2 < NT) SLOAD(0, 2);
    SWAIT(); SWRITE(1, 1); __syncthreads();
    for (int j = 1; j + 1 < NT; j += 2) {
        SBAR_(); qkt(pB0, pB1, KS(j), qf, r32, hi, scl);
        finishSM(pA0, pA1, alA, l_reg, pa); SBAR_();
        SLOAD(1, j + 2); SBAR_();
        pv(o, VS(j - 1), pa, r32, hi, scl); partialSM(pB0, pB1, m_reg, mnB, alB);
        SWAIT(); SWRITE(j + 1, 0);
        RESC(alB); __syncthreads();
        SBAR_(); qkt(pA0, pA1, KS(j + 1), qf, r32, hi, scl);
        finishSM(pB0, pB1, alB, l_reg, pa); SBAR_();
        if (j + 3 < NT) SLOAD(0, j + 3); SBAR_();
        pv(o, VS(j), pa, r32, hi, scl); partialSM(pA0, pA1, m_reg, mnA, alA);
        SWAIT(); SWRITE(j + 2, 1);
        RESC(alA); __syncthreads();
    }
    SBAR_(); qkt(pB0, pB1, KS(NT - 1), qf, r32, hi, scl);
    finishSM(pA0, pA1, alA, l_reg, pa); SBAR_();
    pv(o, VS(NT - 2), pa, r32, hi, scl); partialSM(pB0, pB1, m_reg, mnB, alB);
    __syncthreads(); RESC(alB);
    finishSM(pB0, pB1, alB, l_reg, pa); SBAR_();
    pv(o, VS(NT - 1), pa, r32, hi, scl);
    if (hi == 0) li_l[r32] = l_reg; asm volatile("s_waitcnt lgkmcnt(0)" ::: "memory");
    float rli[16];
#pragma unroll
    for (int r = 0; r < 16; ++r) rli[r] = __builtin_amdgcn_rcpf(li_l[crow(r, hi)]);
    unsigned short* Ow = Ob + (long)(wid * QBLK) * 1024;
#pragma unroll
    for (int r = 0; r < 16; ++r) { const int orow = crow(r, hi);
#pragma unroll
        for (int d0 = 0; d0 < 4; ++d0) Ow[(long)orow * 1024 + d0 * 32 + r32] = (unsigned short)f2bf(o[d0][r] * rli[r]); }
#undef KS
#undef VS
#undef SLOAD
#undef SWRITE
#undef SWAIT
#undef RESC
#undef SBAR_
}
}
__device__ __forceinline__ void phase_attn(const Params& p, const Ctx& c, char* lds_generic) {
    unsigned char* ws = p.ws;
    const unsigned char* Q8 = ws + WS_QN; const unsigned char* K8 = ws + WS_KN; const unsigned char* VT8 = ws + WS_VB; bf16_t* AO = (bf16_t*)(ws + WS_AO);
    for (int item = c.bid; item < 512; item += c.G) {
        const int b = item >> 8, h = (item >> 5) & 7, qb = item & 31, kvh = h >> 2;
        const size_t qrow = (size_t)b * S + qb * 256;
        attn8::body(Q8 + qrow * 1024 + h * 128, K8 + (size_t)b * S * 256 + kvh * 128, VT8 + (size_t)(b * 2 + kvh) * 128 * 8192, AO + qrow * 1024 + h * 128, S, lds_generic);
        __syncthreads();
    }
}

typedef short bf16x8r __attribute__((ext_vector_type(8)));
typedef float f32x16r __attribute__((ext_vector_type(16)));
__device__ __forceinline__ void phase_router(const Params& p, const Ctx& c) {
    unsigned char* ws = p.ws;
    constexpr int XS = 1032;
    LAS bf16_t* xs = (LAS bf16_t*)c.lds;
    LAS float* part = (LAS float*)(c.lds + 66048);
    LAS float* ssq = (LAS float*)(c.lds + 66048 + 33792);
    LAS float* lgt = ssq + 32;
    LAS int* tokE = (LAS int*)(c.lds + LDS_CTL + 512);
    LAS float* tokW = (LAS float*)(c.lds + LDS_CTL + 512 + 1024);
    LAS int* lcnt = (LAS int*)(c.lds + LDS_CTL + 512 + 2048);
    LAS int* lbase = lcnt + 32;
    LAS int* lrank = lbase + 32;
    const bf16_t* X1 = (const bf16_t*)(ws + WS_X1); unsigned char* H2 = ws + WS_H2;
    const bf16_t* WH = (const bf16_t*)(ws + WS_WRT); const bf16_t* WL = WH + 32768;
    int* CNT = (int*)(ws + WS_CTL); int* TOKES = (int*)(ws + WS_TOKES); float* TOKW = (float*)(ws + WS_TOKW); int* LIST = (int*)(ws + WS_LIST);
    const int tid = c.tid, lane = c.lane, r = lane & 31, hh = lane >> 5, wave = c.wave;
    bf16x8r bh[8], bl[8];
#pragma unroll
    for (int ks = 0; ks < 8; ++ks) { const int k0 = 128 * wave + 16 * ks + 8 * hh; bh[ks] = *(const bf16x8r*)(WH + r * 1024 + k0); bl[ks] = *(const bf16x8r*)(WL + r * 1024 + k0); }
    const float bias_e = p.in[18][lane & 31];
    for (int blk = c.bid; blk < M / 64; blk += c.G) {
        __syncthreads();
        if (tid < 32) lcnt[tid] = 0;
        for (int grp = 0; grp < 2; ++grp) {
            const size_t tok0 = (size_t)blk * 64 + grp * 32;
            __syncthreads();
            if (tid < 32) ssq[tid] = 0.f;
            u32x4 xv[8];
#pragma unroll
            for (int q = 0; q < 8; ++q) { const int idx = tid + 512 * q; xv[q] = *(const u32x4*)(X1 + (tok0 + (idx >> 7)) * 1024 + (idx & 127) * 8); }
            __syncthreads();
#pragma unroll
            for (int q = 0; q < 8; ++q) { const int idx = tid + 512 * q; *(LAS u32x4*)(xs + (idx >> 7) * XS + (idx & 127) * 8) = xv[q];
                const u32x4 v = xv[q]; float s = bflo(v.x) * bflo(v.x) + bfhi(v.x) * bfhi(v.x) + bflo(v.y) * bflo(v.y) + bfhi(v.y) * bfhi(v.y) + bflo(v.z) * bflo(v.z) + bfhi(v.z) * bfhi(v.z) + bflo(v.w) * bflo(v.w) + bfhi(v.w) * bfhi(v.w);
                s = wave_sum(s); if (lane == 0) atomicAdd((float*)&ssq[idx >> 7], s); }
            __syncthreads();
            { f32x16r acc = {};
#pragma unroll
              for (int ks = 0; ks < 8; ++ks) { const bf16x8r a = *(const LAS bf16x8r*)(xs + r * XS + 128 * wave + 16 * ks + 8 * hh);
                  acc = __builtin_amdgcn_mfma_f32_32x32x16_bf16(a, bh[ks], acc, 0, 0, 0); acc = __builtin_amdgcn_mfma_f32_32x32x16_bf16(a, bl[ks], acc, 0, 0, 0); }
#pragma unroll
              for (int i = 0; i < 16; ++i) part[(wave * 32 + (i & 3) + 8 * (i >> 2) + 4 * hh) * 33 + r] = acc[i]; }
            __syncthreads();
#pragma unroll
            for (int q = 0; q < 2; ++q) { const int idx = tid + 512 * q, tk = idx >> 5, e = idx & 31; float s = 0.f;
#pragma unroll
                for (int w = 0; w < 8; ++w) s += part[(w * 32 + tk) * 33 + e];
                lgt[tk * 33 + e] = s * rsqrtf(ssq[tk] * (1.f / 1024.f) + EPS) + p.in[18][e]; }
#pragma unroll
            for (int q = 0; q < 8; ++q) { const int idx = tid + 512 * q, row = idx >> 7, c8 = idx & 127; const u32x4 v = xv[q];
                const float rs = 8.f * rsqrtf(ssq[row] * (1.f / 1024.f) + EPS);
                const f32x4 g0 = *(const f32x4*)(p.in[16] + c8 * 8), g1 = *(const f32x4*)(p.in[16] + c8 * 8 + 4);
                u32x2 w; w.x = pack4_fp8(bflo(v.x) * rs * g0[0], bfhi(v.x) * rs * g0[1], bflo(v.y) * rs * g0[2], bfhi(v.y) * rs * g0[3]);
                w.y = pack4_fp8(bflo(v.z) * rs * g1[0], bfhi(v.z) * rs * g1[1], bflo(v.w) * rs * g1[2], bfhi(v.w) * rs * g1[3]);
                *(u32x2*)(H2 + (tok0 + row) * 1024 + c8 * 8) = w; }
            __syncthreads();
#pragma unroll
            for (int t4 = 0; t4 < 4; ++t4) { const int tk = wave * 4 + t4;
                float val = lane < 32 ? lgt[tk * 33 + lane] : -INFINITY; const int my_e = lane < 32 ? lane : 64;
                int se[4]; float sv[4];
#pragma unroll
                for (int k = 0; k < 4; ++k) {
                    const float mx = wave_max(val);
                    const int sel = wave_min_i(val == mx ? my_e : 64);
                    se[k] = sel & 31; sv[k] = mx;
                    if (my_e == sel) val = -INFINITY;
                }
                const float e1 = __expf(sv[1] - sv[0]), e2 = __expf(sv[2] - sv[0]), e3 = __expf(sv[3] - sv[0]);
                const float inv = 1.f / (1.f + e1 + e2 + e3);
                if (lane == 0) { const int t = grp * 32 + tk;
                    tokE[t * 4 + 0] = se[0]; tokE[t * 4 + 1] = se[1]; tokE[t * 4 + 2] = se[2]; tokE[t * 4 + 3] = se[3];
                    tokW[t * 4 + 0] = inv; tokW[t * 4 + 1] = e1 * inv; tokW[t * 4 + 2] = e2 * inv; tokW[t * 4 + 3] = e3 * inv; } }
        }
        (void)bias_e;
        __syncthreads();
        if (tid < 256) lrank[tid] = atomicAdd((int*)&lcnt[tokE[tid]], 1);
        __syncthreads();
        if (tid < 32) lbase[tid] = lcnt[tid] ? atomicAdd(&CNT[tid], lcnt[tid]) : 0;
        __syncthreads();
        if (tid < 256) {
            const int e = tokE[tid], slot = lbase[e] + lrank[tid], tok = blk * 64 + (tid >> 2);
            LIST[e * 16384 + slot] = tok; TOKES[tok * 4 + (tid & 3)] = (e << 16) | slot; TOKW[tok * 4 + (tid & 3)] = tokW[tid];
        }
    }
    __syncthreads();
}

__device__ __forceinline__ void load_offs(const Params& p, const Ctx& c, LAS int*& offs, LAS int*& cnt) {
    offs = (LAS int*)(c.lds + LDS_CTL); cnt = offs + 40;
    __syncthreads();
    if (c.tid == 0) {
        const int* CNT = (const int*)(p.ws + WS_CTL); int run = 0;
        for (int e = 0; e < 32; ++e) { const int n = __hip_atomic_load(CNT + e, __ATOMIC_RELAXED, __HIP_MEMORY_SCOPE_AGENT); cnt[e] = n; offs[e] = run; run += (n + 255) & ~255; }
        offs[32] = run;
    }
    __syncthreads();
    if (c.tid < 320) { int e = 0; while (e < 31 && c.tid * 256 >= offs[e + 1]) ++e; offs[80 + c.tid] = e; }
    __syncthreads();
}
__device__ __forceinline__ void phase_gemm1(const Params& p, const Ctx& c) {
    { pg8::Gemm g{(const bf16_t*)(p.ws + WS_H), (const bf16_t*)(p.ws + WS_WINT), M, PQ, 1024};
      pg8::StaticOrder S; S.init(M, PQ, c.G, c.bid);
      pg8::EpiStore E{(bf16_t*)(p.ws + WS_P), NPROJ};
      pg8::gemm_phase<pg8::EpiStore, pg8::StaticOrder, true, true>(c.lds, g, S, E); }
    { pg8::Gemm g{(const bf16_t*)(p.ws + WS_H8), (const bf16_t*)(p.ws + WS_WIN8), M, PDT - PQ, 512};
      pg8::StaticOrder S; S.init(M, PDT - PQ, c.G, c.G - 1 - c.bid);
      pg8::EpiStore8 E{(bf16_t*)(p.ws + WS_P) + PQ, NPROJ, 1.f / 512.f};
      pg8::gemm_phase_f8<pg8::EpiStore8, pg8::StaticOrder, true, true>(c.lds, g, S, E); }
}
__device__ __forceinline__ void phase_tail12(const Params& p, const Ctx& c) {
    unsigned char* ws = p.ws;
    pg8::TailOrder S; S.so.init(M, 1024, c.G, c.bid);
    pg8::Gemm g{(const bf16_t*)(ws + WS_YZ), (const bf16_t*)(ws + WS_WST), 2 * M, 2048, 1024};
    pg8::EpiT12 E{(bf16_t*)(ws + WS_T1), (bf16_t*)(ws + WS_MG), (const bf16_t*)(ws + WS_P) + PG, NPROJ, (const float*)(ws + WS_RSTD)};
    pg8::gemm_phase<pg8::EpiT12, pg8::TailOrder, true, true>(c.lds, g, S, E);
}
__device__ __forceinline__ void phase_tail3(const Params& p, const Ctx& c) {
    unsigned char* ws = p.ws;
    pg8::StaticOrder S; S.init(M, 1024, c.G, c.bid);
    pg8::Gemm g{(const bf16_t*)(ws + WS_MG), (const bf16_t*)(ws + WS_WOT), M, 1024, 1024};
    pg8::EpiT3b E{(bf16_t*)(ws + WS_X1), p.in[0]};
    pg8::gemm_phase<pg8::EpiT3b, pg8::StaticOrder, true, true>(c.lds, g, S, E);
}
__device__ __forceinline__ void phase_moe1(const Params& p, const Ctx& c) {
    LAS int* offs; LAS int* cnt; load_offs(p, c, offs, cnt);
    unsigned char* ws = p.ws;
    pg8::Gemm g{(const bf16_t*)(ws + WS_H2), (const bf16_t*)(ws + WS_W1T), M, 32 * 2048, 512};
    pg8::MoeGatherOrder S{offs, cnt, offs + 80, (const int*)(ws + WS_LIST), c.G, c.bid, offs[32] / 256};
    pg8::EpiAct8 E{(unsigned char*)(ws + WS_ACT), p.in[20]};
    pg8::gemm_phase_gather_f8<pg8::EpiAct8, pg8::MoeGatherOrder>(c.lds, g, S, E);
}
__device__ __forceinline__ void phase_moe2(const Params& p, const Ctx& c) {
    LAS int* offs; LAS int* cnt; load_offs(p, c, offs, cnt);
    unsigned char* ws = p.ws;
    pg8::Gemm g{(const bf16_t*)(ws + WS_ACT), (const bf16_t*)(ws + WS_W2T), ROWS_MAX, 32 * 1024, 512};
    pg8::MoeOrder<4> S{offs + 80, c.G, c.bid, offs[32] / 256};
    pg8::EpiY8 E{(bf16_t*)(ws + WS_YB), p.in[22]};
    pg8::gemm_phase_f8<pg8::EpiY8, pg8::MoeOrder<4>, true, true>(c.lds, g, S, E);
}

__device__ __forceinline__ void phase_combine(const Params& p, const Ctx& c) {
    LAS int* offs; LAS int* cnt; load_offs(p, c, offs, cnt);
    unsigned char* ws = p.ws;
    const bf16_t* X1 = (const bf16_t*)(ws + WS_X1); const bf16_t* YB = (const bf16_t*)(ws + WS_YB);
    const int* TOKES = (const int*)(ws + WS_TOKES); const float* TOKW = (const float*)(ws + WS_TOKW);
    const int gw = c.bid * 8 + c.wave, NGW = c.G * 8, lane = c.lane;
    f32x4 gv[4];
#pragma unroll
    for (int j = 0; j < 4; ++j) gv[j] = ((const f32x4*)p.in[23])[lane + 64 * j];
    for (int m0 = gw * 2; m0 < M; m0 += NGW * 2) {
        int es[2][4]; float wq[2][4];
#pragma unroll
        for (int t = 0; t < 2; ++t)
#pragma unroll
            for (int k = 0; k < 4; ++k) { es[t][k] = TOKES[(m0 + t) * 4 + k]; wq[t][k] = TOKW[(m0 + t) * 4 + k]; }
        f32x4 v[2][4]; u32x2 y[2][4][4];
#pragma unroll
        for (int t = 0; t < 2; ++t) { const u32x2* xr = (const u32x2*)(X1 + (size_t)(m0 + t) * 1024) + lane;
#pragma unroll
            for (int j = 0; j < 4; ++j) { const u32x2 xx = xr[64 * j]; v[t][j] = (f32x4){bflo(xx.x), bfhi(xx.x), bflo(xx.y), bfhi(xx.y)}; }
#pragma unroll
            for (int k = 0; k < 4; ++k) { const int row = offs[es[t][k] >> 16] + (es[t][k] & 0xffff); const u32x2* yr = (const u32x2*)(YB + (size_t)row * 1024) + lane;
#pragma unroll
                for (int j = 0; j < 4; ++j) y[t][k][j] = yr[64 * j]; } }
#pragma unroll
        for (int t = 0; t < 2; ++t) {
#pragma unroll
            for (int k = 0; k < 4; ++k) { const float w = wq[t][k];
#pragma unroll
                for (int j = 0; j < 4; ++j) { const u32x2 yy = y[t][k][j];
                    v[t][j].x = fmaf(w, bflo(yy.x), v[t][j].x); v[t][j].y = fmaf(w, bfhi(yy.x), v[t][j].y); v[t][j].z = fmaf(w, bflo(yy.y), v[t][j].z); v[t][j].w = fmaf(w, bfhi(yy.y), v[t][j].w); } }
            float s = 0.f;
#pragma unroll
            for (int j = 0; j < 4; ++j) s += (v[t][j].x * v[t][j].x + v[t][j].y * v[t][j].y) + (v[t][j].z * v[t][j].z + v[t][j].w * v[t][j].w);
            const float rstd = rsqrtf(wave_sum(s) * (1.f / 1024.f) + EPS);
            f32x4* o = (f32x4*)(p.out + (size_t)(m0 + t) * 1024) + lane;
#pragma unroll
            for (int j = 0; j < 4; ++j) o[64 * j] = v[t][j] * rstd * gv[j];
        }
    }
}

#define XB_TMO      128
#define XB_XCNT(j)  (256  + 64 * (j))
#define XB_XSUB(j)  (1280 + 64 * (j))
#define XB_XGEN(j)  (2304 + 64 * (j))
#define XB_TOP      3328
#define XB_TOPGEN   3392
#define XCD_BAR_WORDS 3456
#define XB_SPIN_CAP (1u << 18)

__device__ __forceinline__ unsigned xb_ld(unsigned* p)              { return __hip_atomic_load(p, __ATOMIC_RELAXED, __HIP_MEMORY_SCOPE_AGENT); }
__device__ __forceinline__ unsigned xb_add(unsigned* p, unsigned v) { return __hip_atomic_fetch_add(p, v, __ATOMIC_RELAXED, __HIP_MEMORY_SCOPE_AGENT); }
__device__ __forceinline__ unsigned xb_xcc_id() { return (unsigned)__builtin_amdgcn_s_getreg((3 << 11) | 20) & 0xFu; }
#define XB_SPIN(cond, bar) do { unsigned _sp = 0; while (cond) { __builtin_amdgcn_s_sleep(1); \
    if ((++_sp & 255u) == 0u) { if (xb_ld(&(bar)[XB_TMO])) break; if (_sp > XB_SPIN_CAP) { atomicAdd(&(bar)[XB_TMO], 1u); break; } } } } while (0)

struct XcdBarrier {
    unsigned* bar; unsigned x;
    volatile LAS unsigned* st;
};

__device__ __forceinline__ XcdBarrier xcd_barrier_post(unsigned* bar, volatile LAS unsigned* st) {
    XcdBarrier b; b.bar = bar; b.x = xb_xcc_id(); b.st = st;
    if (threadIdx.x == 0) (void)xb_add(&bar[XB_XCNT(b.x)], 1u);
    return b;
}
__device__ __forceinline__ void xcd_barrier_complete(unsigned* bar, unsigned x, unsigned& nloc, unsigned& nx) {
    const unsigned G = gridDim.x * gridDim.y * gridDim.z;
    unsigned sum, cnt, mine, sp = 0u;
    for (;;) {
        sum = 0u; cnt = 0u; mine = 0u;
#pragma unroll
        for (unsigned j = 0; j < 16; ++j) { const unsigned c = xb_ld(&bar[XB_XCNT(j)]); sum += c; cnt += (c > 0u) ? 1u : 0u; mine = (j == x) ? c : mine; }
        if (sum == G) break;
        __builtin_amdgcn_s_sleep(1);
        if ((++sp & 255u) == 0u) { if (xb_ld(&bar[XB_TMO])) break; if (sp > XB_SPIN_CAP) { atomicAdd(&bar[XB_TMO], 1u); break; } }
    }
    nloc = mine > 0u ? mine : 1u; nx = cnt > 0u ? cnt : 1u;
}

__device__ __forceinline__ void xcd_barrier(const XcdBarrier& b) {
    asm volatile("s_waitcnt vmcnt(0)" ::: "memory");
    __syncthreads();
    if (threadIdx.x == 0) {
        unsigned* bar = b.bar;
        __builtin_amdgcn_s_waitcnt(0);
        unsigned nloc = b.st[0], nx = b.st[1];
        if (nloc == 0u) { xcd_barrier_complete(bar, b.x, nloc, nx); b.st[0] = nloc; b.st[1] = nx; }
        const unsigned old = xb_add(&bar[XB_XSUB(b.x)], 1u);
        const unsigned gen = old / nloc;
        if (old + 1u == (gen + 1u) * nloc) {
            __builtin_amdgcn_fence(__ATOMIC_RELEASE, "agent");
            asm volatile("s_waitcnt vmcnt(0)" ::: "memory");
            const unsigned og = xb_add(&bar[XB_TOP], 1u);
            const unsigned tg = og / nx;
            if (og + 1u == (tg + 1u) * nx) xb_add(&bar[XB_TOPGEN], 1u);
            else XB_SPIN(xb_ld(&bar[XB_TOPGEN]) == tg, bar);
            __builtin_amdgcn_fence(__ATOMIC_ACQUIRE, "agent");
            xb_add(&bar[XB_XGEN(b.x)], 1u);
            asm volatile("s_waitcnt vmcnt(0)" ::: "memory");
        } else {
            XB_SPIN(xb_ld(&bar[XB_XGEN(b.x)]) == gen, bar);
            __builtin_amdgcn_fence(__ATOMIC_ACQUIRE, "agent");
            asm volatile("s_waitcnt vmcnt(0)" ::: "memory");
        }
    }
    __syncthreads();
}

constexpr int NPHASE = 13;
__global__ void __launch_bounds__(512) mega(Params p) {
    extern __shared__ __attribute__((aligned(16))) unsigned char lds_raw[];
    Ctx c; c.tid = threadIdx.x; c.lane = c.tid & 63; c.wave = __builtin_amdgcn_readfirstlane(c.tid >> 6); c.bid = blockIdx.x; c.G = gridDim.x;
    c.lds = (LAS unsigned char*)lds_raw;
    cg::grid_group grid = cg::this_grid();
    if (c.tid < 2) ((volatile LAS unsigned*)(c.lds + LDS_BARST))[c.tid] = 0u;
    __syncthreads();
#define SEAM(k) do { XcdBarrier b_; b_.bar = (unsigned*)(p.ws + WS_BAR); b_.x = xb_xcc_id(); b_.st = (volatile LAS unsigned*)(c.lds + LDS_BARST); xcd_barrier(b_); } while (0)
    if (p.ph_lo < 0) grid.sync();
    (void)xcd_barrier_post((unsigned*)(p.ws + WS_BAR), (volatile LAS unsigned*)(c.lds + LDS_BARST));
#define RUN(k, call) if (p.ph_lo <= (k) && (k) < p.ph_hi) { call; if ((k) + 1 < p.ph_hi) SEAM(k); }
    RUN(0, phase_prep(p, c))
    RUN(1, phase_gemm1(p, c))
    RUN(2, phase_conv(p, c))
    RUN(3, phase_ssd_states(p, c))
    RUN(4, phase_ssd_scan(p, c))
    RUN(5, phase_ssd_out(p, c))
    RUN(6, phase_rstd(p, c); phase_attn(p, c, (char*)lds_raw))
    RUN(7, phase_tail12(p, c))
    RUN(8, phase_tail3(p, c))
    RUN(9, phase_router(p, c))
    RUN(10, phase_moe1(p, c))
    RUN(11, phase_moe2(p, c))
    RUN(12, phase_combine(p, c))
#undef RUN
}

extern "C" void kernel_launch(void* const* d_in, const int* in_sizes, int n_in, void* d_out, int out_size, void* d_ws, size_t ws_size, hipStream_t stream) {
    static int ok = 0; static int grid_blocks = 0;
    if (ok == 0) {
        if (n_in != 24 || out_size != M * D || ws_size < WS_END) { fprintf(stderr, "kernel_launch: unexpected shapes: n_in %d out %d ws %zu (need %zu)\n", n_in, out_size, ws_size, (size_t)WS_END); ok = -1; return; }
        if (hipFuncSetAttribute((const void*)mega, hipFuncAttributeMaxDynamicSharedMemorySize, LDS_BYTES) != hipSuccess) { fprintf(stderr, "kernel_launch: hipFuncSetAttribute failed\n"); ok = -1; return; }
        int dev = 0, cus = 0, per_cu = 0;
        hipGetDevice(&dev);
        hipDeviceGetAttribute(&cus, hipDeviceAttributeMultiprocessorCount, dev);
        hipOccupancyMaxActiveBlocksPerMultiprocessor(&per_cu, (const void*)mega, 512, LDS_BYTES);
        if (per_cu < 1 || cus < 1) { fprintf(stderr, "kernel_launch: occupancy query gave %d blocks/CU on %d CUs\n", per_cu, cus); ok = -1; return; }
        grid_blocks = cus;
        ok = 1;
    }
    if (ok < 0) return;
    Params p{};
    for (int i = 0; i < 24; ++i) p.in[i] = (const float*)d_in[i];
    p.out = (float*)d_out; p.ws = (unsigned char*)d_ws;
    p.ph_lo = 0; p.ph_hi = NPHASE;
    if (hipMemsetAsync((char*)d_ws + WS_BAR, 0, 16384, stream) != hipSuccess) { fprintf(stderr, "kernel_launch: hipMemsetAsync of the barrier words failed\n"); return; }
    void* args[] = {&p};
    hipError_t e = hipLaunchCooperativeKernel((const void*)mega, dim3(grid_blocks), dim3(512), args, LDS_BYTES, stream);
    if (e != hipSuccess) fprintf(stderr, "kernel_launch: cooperative launch failed: %s (grid %d)\n", hipGetErrorString(e), grid_blocks);
}
```

```cpp
#include <hip/hip_runtime.h>
#include <hip/hip_cooperative_groups.h>
#include <cstdio>
#include <cstdint>

namespace cg = cooperative_groups;
#define LAS __attribute__((address_space(3)))
typedef unsigned short bf16_t;
typedef unsigned u32x4 __attribute__((ext_vector_type(4)));
typedef unsigned u32x2 __attribute__((ext_vector_type(2)));
typedef float f32x4 __attribute__((ext_vector_type(4)));

constexpr int NB = 2, S = 8192, D = 1024, M = NB * S;
constexpr int NPROJ = 6400;
constexpr int PZ = 0, PXBC = 1024, PQ = 2560, PK = 3584, PV = 3840, PG = 4096, PDT = 6144;
constexpr int ROWS_MAX = 65536 + 32 * 256;
constexpr float EPS = 1e-6f;

constexpr size_t al256(size_t x) { return (x + 255) / 256 * 256; }
constexpr size_t WS_CTL = 0;
constexpr size_t WS_BAR = 4096;
constexpr size_t WS_ROPE = 4096 + 16384;
constexpr size_t WS_WRT = WS_ROPE + 32768;
constexpr size_t WS_WINT = WS_WRT + 131072;
constexpr size_t WS_WST = WS_WINT + (size_t)NPROJ * 1024 * 2;
constexpr size_t WS_WAT = WS_WST + 2097152;
constexpr size_t WS_WOT = WS_WAT + 2097152;
constexpr size_t WS_W1T = WS_WOT + 2097152;
constexpr size_t WS_W2T = WS_W1T + (size_t)32 * 2048 * 1024 * 2;
constexpr size_t WS_X1 = WS_W2T + (size_t)32 * 1024 * 1024 * 2;
constexpr size_t WS_H2 = WS_X1 + (size_t)M * 1024 * 4;
constexpr size_t WS_TOKES = WS_H2 + (size_t)M * 1024 * 2;
constexpr size_t WS_TOKW = WS_TOKES + (size_t)M * 16;
constexpr size_t WS_LIST = WS_TOKW + (size_t)M * 16;
constexpr size_t WS_R = WS_LIST + (size_t)32 * 16384 * 4;
constexpr size_t WS_H = WS_R;
constexpr size_t WS_P = WS_H + (size_t)M * 1024 * 2;
constexpr size_t WS_XT = WS_P + (size_t)M * NPROJ * 2;
constexpr size_t WS_BMR = WS_XT + (size_t)M * 1024 * 2;
constexpr size_t WS_BMT = WS_BMR + (size_t)M * 256 * 2;
constexpr size_t WS_CMR = WS_BMT + (size_t)M * 256 * 2;
constexpr size_t WS_DT = WS_CMR + (size_t)M * 256 * 2;
constexpr size_t WS_ACS = WS_DT + (size_t)2 * M * 16 * 4;
constexpr size_t WS_CDEC = WS_ACS + (size_t)2 * M * 16 * 4;
constexpr size_t WS_ST = WS_CDEC + 16384;
constexpr size_t WS_H8 = WS_ST, WS_WIN8 = WS_ST + (size_t)M * 1024;
constexpr size_t WS_G8 = WS_ST + (size_t)64 * 1048576;
static_assert(WS_WIN8 + (size_t)3584 * 1024 <= WS_G8 && WS_G8 + (size_t)M * 2048 <= WS_ST + (size_t)128 * 1048576, "gate bytes inside the old state region");
constexpr size_t WS_PREV = WS_ST + (size_t)2 * 2 * 64 * 16 * 8192 * 4;
constexpr size_t WS_YZ = WS_PREV + (size_t)2 * 2 * 64 * 16 * 8192 * 2;
constexpr size_t WS_AO = WS_YZ + (size_t)M * 1024 * 2;
constexpr size_t WS_RSTD = WS_AO + (size_t)M * 1024 * 2;
constexpr size_t WS_QN = WS_RSTD + (size_t)M * 8;
constexpr size_t WS_KN = WS_QN + (size_t)M * 1024 * 2;
constexpr size_t WS_VB = WS_KN + (size_t)M * 256 * 2;
constexpr size_t WS_T1 = WS_VB + (size_t)M * 256 * 2;
constexpr size_t WS_MG = WS_T1 + (size_t)M * 1024 * 2;
constexpr size_t WS_END = WS_MG + (size_t)M * 1024 * 2;
constexpr size_t WS_XB = WS_R;
constexpr size_t WS_ACT = WS_XB + (size_t)ROWS_MAX * 1024 * 2;
constexpr size_t WS_YB = WS_XB;
static_assert(WS_ACT + (size_t)ROWS_MAX * 1024 * 2 <= WS_END, "moe overlay");
static_assert(WS_END <= (size_t)1073741824, "workspace");

constexpr int LDS_BYTES = 147712;
constexpr int LDS_BARST = 147456;
constexpr int LDS_CTL = 143360;

struct Params {
    const float* in[24];
    float* out;
    unsigned char* ws;
    int ph_lo, ph_hi;
};

__device__ __forceinline__ float bf2f(bf16_t v) { return __uint_as_float((unsigned)v << 16); }
__device__ __forceinline__ float bflo(unsigned w) { return __uint_as_float(w << 16); }
__device__ __forceinline__ float bfhi(unsigned w) { return __uint_as_float(w & 0xffff0000u); }
typedef __bf16 bf16x2_hw __attribute__((ext_vector_type(2)));
typedef float f32x2_hw __attribute__((ext_vector_type(2)));
__device__ __forceinline__ unsigned f2bf(float f) { const __bf16 h = (__bf16)f; return (unsigned)__builtin_bit_cast(unsigned short, h); }
__device__ __forceinline__ unsigned pk2(float lo, float hi) { const bf16x2_hw r = __builtin_convertvector((f32x2_hw){lo, hi}, bf16x2_hw); return __builtin_bit_cast(unsigned, r); }
#define DPPF_(v, ctrl, rmask) __builtin_bit_cast(float, __builtin_amdgcn_update_dpp(0, __builtin_bit_cast(int, (v)), (ctrl), (rmask), 0xf, false))
__device__ __forceinline__ float wave_sum(float v) {
    v += DPPF_(v, 0xB1, 0xf);
    v += DPPF_(v, 0x4E, 0xf);
    v += DPPF_(v, 0x141, 0xf);
    v += DPPF_(v, 0x140, 0xf);
    v += DPPF_(v, 0x142, 0xa);
    v += DPPF_(v, 0x143, 0xc);
    return __builtin_bit_cast(float, __builtin_amdgcn_readlane(__builtin_bit_cast(int, v), 63));
}
__device__ __forceinline__ float wave_max(float v) {
#pragma unroll
    for (int o = 1; o < 64; o <<= 1) v = fmaxf(v, __shfl_xor(v, o));
    return v;
}
__device__ __forceinline__ int wave_min_i(int v) {
#pragma unroll
    for (int o = 1; o < 64; o <<= 1) { int t = __shfl_xor(v, o); v = t < v ? t : v; }
    return v;
}
__device__ __forceinline__ float sigmoidf_(float x) { return __builtin_amdgcn_rcpf(1.f + __expf(-x)); }
__device__ __forceinline__ unsigned pack4_fp8(float a, float b, float c, float d) { unsigned w = __builtin_amdgcn_cvt_pk_fp8_f32(a, b, 0u, false); return __builtin_amdgcn_cvt_pk_fp8_f32(c, d, w, true); }
#define LDS_WAIT() asm volatile("s_waitcnt lgkmcnt(0)" ::: "memory")

struct Ctx { int tid, lane, wave, bid, G; LAS unsigned char* lds; };

struct TItem { const float* W; bf16_t* WT; const float* kscale; int N, k0, n0, orow0; unsigned char* WT8; };
__device__ __forceinline__ void transpose_load(const TItem& t, f32x4 (&v)[8], int lane) {
    const int nq = lane & 7, kg = lane >> 3;
    const float* s = t.W + (size_t)(t.k0 + 8 * kg) * t.N + t.n0 + 4 * nq;
#pragma unroll
    for (int i = 0; i < 8; ++i) v[i] = __builtin_nontemporal_load((const f32x4*)(s + (size_t)i * t.N));
}
__device__ __forceinline__ void transpose_store(const TItem& t, f32x4 (&v)[8], int lane) {
    const int nq = lane & 7, kg = lane >> 3;
    if (t.kscale) {
#pragma unroll
        for (int i = 0; i < 8; ++i) v[i] = v[i] * t.kscale[t.k0 + 8 * kg + i];
    }
    if (t.WT8) {
        unsigned char* d8 = t.WT8 + (size_t)(t.orow0 + 4 * nq) * 1024 + t.k0 + 8 * kg;
#pragma unroll
        for (int j = 0; j < 4; ++j) { u32x2 o; o.x = pack4_fp8(64.f * v[0][j], 64.f * v[1][j], 64.f * v[2][j], 64.f * v[3][j]); o.y = pack4_fp8(64.f * v[4][j], 64.f * v[5][j], 64.f * v[6][j], 64.f * v[7][j]);
            *(u32x2*)(d8 + (size_t)j * 1024) = o; }
        return;
    }
    bf16_t* d = t.WT + (size_t)(t.orow0 + 4 * nq) * 1024 + t.k0 + 8 * kg;
#pragma unroll
    for (int j = 0; j < 4; ++j) { u32x4 o; o.x = pk2(v[0][j], v[1][j]); o.y = pk2(v[2][j], v[3][j]); o.z = pk2(v[4][j], v[5][j]); o.w = pk2(v[6][j], v[7][j]);
        *(u32x4*)(d + (size_t)j * 1024) = o; }
}
constexpr int PREP_I_IN = 16 * 193, PREP_I_SQ = 512, PREP_NITEMS = PREP_I_IN + 3 * PREP_I_SQ;
__device__ __forceinline__ TItem prep_item(const Params& p, int r) {
    unsigned char* ws = p.ws; TItem t; t.kscale = nullptr; t.WT8 = nullptr;
    if (r < PREP_I_IN) { const int kb = r / 193, nb = r % 193, n0 = nb * 32;
        t.W = p.in[2]; t.WT = (bf16_t*)(ws + WS_WINT); t.N = 6176; t.k0 = kb * 64; t.n0 = n0; t.orow0 = n0 < 2560 ? n0 : (n0 < 2592 ? PDT + (n0 - 2560) : n0 - 32);
        if (n0 >= 2592) { t.WT8 = ws + WS_WIN8; t.orow0 -= PQ; }
        return t; }
    r -= PREP_I_IN;
    { const int which = r / PREP_I_SQ, q = r % PREP_I_SQ;
        t.W = which == 0 ? p.in[13] : (which == 1 ? p.in[14] : p.in[15]); t.WT = (bf16_t*)(ws + (which == 0 ? WS_WST : (which == 1 ? WS_WAT : WS_WOT)));
        t.kscale = which == 0 ? p.in[10] : nullptr; t.N = 1024; t.k0 = (q / 32) * 64; t.n0 = (q % 32) * 32; t.orow0 = t.n0;
        if (which == 1) t.WT8 = ws + WS_WAT;
        return t; }
}
constexpr int PREP8_TILES = 32 * 64 + 32 * 32;
struct T8 { const float* W; unsigned char* WT; int N, k0, n0; bool w1; };
__device__ __forceinline__ T8 prep8_tile(const Params& p, int t) {
    T8 r;
    if (t < 2048) { const int e = t >> 6; r.W = p.in[19] + (size_t)e * 1024 * 2048; r.WT = p.ws + WS_W1T + (size_t)e * 2048 * 1024; r.N = 2048; r.k0 = ((t >> 3) & 7) * 128; r.n0 = (t & 7) * 256; r.w1 = true; }
    else { t -= 2048; const int e = t >> 5; r.W = p.in[21] + (size_t)e * 1024 * 1024; r.WT = p.ws + WS_W2T + (size_t)e * 1024 * 1024; r.N = 1024; r.k0 = ((t >> 2) & 7) * 128; r.n0 = (t & 3) * 256; r.w1 = false; }
    return r;
}
__device__ __forceinline__ void prep8_load(const T8& t, f32x4 (&v)[16], int wave, int lane) {
    const float* s = t.W + (size_t)(t.k0 + 16 * wave) * t.N + t.n0 + 4 * lane;
#pragma unroll
    for (int i = 0; i < 16; ++i) v[i] = __builtin_nontemporal_load((const f32x4*)(s + (size_t)i * t.N));
}
__device__ __forceinline__ void prep8_cvt(const f32x4 (&v)[16], LAS unsigned char* img, int wave, int lane) {
#pragma unroll
    for (int j = 0; j < 4; ++j) { u32x4 o;
        o.x = pack4_fp8(64.f * v[0][j], 64.f * v[1][j], 64.f * v[2][j], 64.f * v[3][j]); o.y = pack4_fp8(64.f * v[4][j], 64.f * v[5][j], 64.f * v[6][j], 64.f * v[7][j]);
        o.z = pack4_fp8(64.f * v[8][j], 64.f * v[9][j], 64.f * v[10][j], 64.f * v[11][j]); o.w = pack4_fp8(64.f * v[12][j], 64.f * v[13][j], 64.f * v[14][j], 64.f * v[15][j]);
        *(LAS u32x4*)(img + (4 * lane + j) * 128 + 16 * wave) = o; }
}
__device__ __forceinline__ void prep8_out(const T8& cur, const LAS unsigned char* img, int tid) {
#pragma unroll
    for (int q = 0; q < 4; ++q) { const int idx = tid + 512 * q, nl = idx >> 3, cw = idx & 7, n = cur.n0 + nl;
        const int orow = cur.w1 ? (((n & 1023) >> 7) * 256 + (n >> 10) * 128 + (n & 127)) : n;
        __builtin_nontemporal_store(*(const LAS u32x4*)(img + nl * 128 + 16 * cw), (u32x4*)(cur.WT + (size_t)orow * 1024 + cur.k0 + 16 * cw)); }
}
__device__ __forceinline__ void phase_prep8q(const Params& p, const Ctx& c) {
    int* Q = (int*)(p.ws + WS_CTL) + 48;
    LAS int* tk = (LAS int*)(c.lds + LDS_CTL + 64);
    LAS unsigned char* img0 = c.lds; LAS unsigned char* img1 = c.lds + 32768;
    f32x4 va[16], vb[16];
    __syncthreads();
    if (c.tid == 0) { tk[2] = atomicAdd(Q, 2); tk[3] = atomicAdd(Q, 2); }
    __syncthreads();
    int cur = tk[2], nxt = tk[3];
    if (cur < PREP8_TILES) { prep8_load(prep8_tile(p, cur), va, c.wave, c.lane); prep8_load(prep8_tile(p, cur + 1), vb, c.wave, c.lane); }
    for (int it = 0; cur < PREP8_TILES; ++it) {
        int nn = 0; if (c.tid == 0) nn = atomicAdd(Q, 2);
        const T8 ta = prep8_tile(p, cur), tb = prep8_tile(p, cur + 1);
        prep8_cvt(va, img0, c.wave, c.lane);
        if (nxt < PREP8_TILES) prep8_load(prep8_tile(p, nxt), va, c.wave, c.lane);
        if (c.tid == 0) tk[it & 1] = nn;
        __syncthreads();
        prep8_out(ta, img0, c.tid);
        prep8_cvt(vb, img1, c.wave, c.lane);
        if (nxt < PREP8_TILES) prep8_load(prep8_tile(p, nxt + 1), vb, c.wave, c.lane);
        __syncthreads();
        prep8_out(tb, img1, c.tid);
        cur = nxt; nxt = tk[it & 1];
    }
    __syncthreads();
}

__device__ __forceinline__ void phase_prep(const Params& p, const Ctx& c) {
    unsigned char* ws = p.ws;
    const int gw = c.bid * 8 + c.wave, NGW = c.G * 8;
    for (int it = gw; it < PREP_NITEMS; it += 2 * NGW) {
        const TItem ta = prep_item(p, it); f32x4 va[8], vb[8];
        transpose_load(ta, va, c.lane);
        const bool two = it + NGW < PREP_NITEMS;
        const TItem tb = prep_item(p, two ? it + NGW : it);
        if (two) transpose_load(tb, vb, c.lane);
        transpose_store(ta, va, c.lane);
        if (two) transpose_store(tb, vb, c.lane);
    }
    for (int r = 6176 + gw; r < NPROJ; r += NGW) {
        u32x4* o = (u32x4*)((bf16_t*)(ws + WS_WINT) + (size_t)r * 1024);
        o[c.lane] = (u32x4){0u, 0u, 0u, 0u}; o[c.lane + 64] = (u32x4){0u, 0u, 0u, 0u};
    }
    {
        const float* x = p.in[0]; const float* g = p.in[1]; bf16_t* H = (bf16_t*)(ws + WS_H);
        f32x4 gv[4];
#pragma unroll
        for (int j = 0; j < 4; ++j) gv[j] = ((const f32x4*)g)[c.lane + 64 * j];
        for (int m = gw; m < M; m += NGW) {
            const f32x4* xr = (const f32x4*)(x + (size_t)m * D) + c.lane;
            f32x4 v[4]; float s = 0.f;
#pragma unroll
            for (int j = 0; j < 4; ++j) { v[j] = __builtin_nontemporal_load(xr + 64 * j); s += (v[j].x * v[j].x + v[j].y * v[j].y) + (v[j].z * v[j].z + v[j].w * v[j].w); }
            const float rstd = rsqrtf(wave_sum(s) * (1.f / D) + EPS);
            u32x2* o = (u32x2*)(H + (size_t)m * D) + c.lane; unsigned* o8 = (unsigned*)(ws + WS_H8 + (size_t)m * D) + c.lane;
#pragma unroll
            for (int j = 0; j < 4; ++j) { const f32x4 hn = v[j] * rstd * gv[j]; u32x2 w; w.x = pk2(hn.x, hn.y); w.y = pk2(hn.z, hn.w); o[64 * j] = w;
                o8[64 * j] = pack4_fp8(8.f * hn.x, 8.f * hn.y, 8.f * hn.z, 8.f * hn.w); }
        }
    }
    {
        float* rc = (float*)(ws + WS_ROPE); float* rs = rc + 4096;
        for (int idx = c.bid * 512 + c.tid; idx < 4096; idx += c.G * 512) {
            const int pos = idx >> 5, i = idx & 31;
            const float inv = exp2f(-(float)i * (13.287712379549449f / 32.f));
            float rev = (float)pos * inv * 0.15915494309189535f; rev -= floorf(rev);
            rc[idx] = __builtin_amdgcn_cosf(rev); rs[idx] = __builtin_amdgcn_sinf(rev);
        }
        bf16_t* wh = (bf16_t*)(ws + WS_WRT); bf16_t* wl = wh + 32768; const float* wr = p.in[17]; const float* gf = p.in[16];
        for (int idx = c.bid * 512 + c.tid; idx < 32768; idx += c.G * 512) { const int k = idx >> 5, e = idx & 31; const float v = gf[k] * wr[idx];
            const unsigned hi = f2bf(v); const float rem = v - __uint_as_float(hi << 16); wh[e * 1024 + k] = (bf16_t)hi; wl[e * 1024 + k] = (bf16_t)f2bf(rem); }
        if (c.bid == 0 && c.tid < 64) ((int*)(ws + WS_CTL))[c.tid] = 0;
    }
}

namespace pg8 {
#define PG8_LAS __attribute__((address_space(3)))
typedef unsigned short bf16_t;
typedef short bf16x8 __attribute__((ext_vector_type(8)));
typedef float f32x4 __attribute__((ext_vector_type(4)));
typedef unsigned u32x4 __attribute__((ext_vector_type(4)));
constexpr int BM = 256, BK = 64, HALF = 128, HTB = HALF * BK * 2  , STAGE_BYTES = 8 * HTB, NXCD = 8, WGM = 8;

__host__ __device__ __forceinline__ int lds_byte(int r, int c) { const int st = (r >> 4) * 2 + (c >> 5), rr = r & 15, cc = c & 31, ob = rr * 64 + cc * 2; return st * 1024 + (ob ^ (((ob >> 9) & 1) << 5)); }
__host__ __device__ __forceinline__ void stage_rc(int b, int& R, int& C) { const int st = b / 1024, sb = b % 1024, swz = sb ^ (((sb >> 9) & 1) << 5); R = (st >> 1) * 16 + swz / 64; C = (st & 1) * 32 + (swz % 64) / 2; }
__host__ __device__ __forceinline__ int perm32(int rho) { const int n = rho >> 4, i = rho & 15; return 8 * (i >> 2) + 4 * n + (i & 3); }

struct Unit { int pm, pn; };
struct Gemm { const bf16_t* A; const bf16_t* Bt; int M, N, K; };

struct StaticOrder {
    int nM, nN, nwg, G, c;
    __host__ __device__ void init(int M, int N, int G_, int c_) { nM = M / BM; nN = N / BM; nwg = nM * nN; G = G_; c = c_; }
    __host__ __device__ bool next(int i, Unit& u) const {
        const long L = (long)i * G + c; if (L >= nwg) return false;
        int wgid = (int)L; { const int q = nwg / NXCD, r = nwg % NXCD, xcd = wgid % NXCD, off = wgid / NXCD; wgid = (xcd < r ? xcd * (q + 1) : r * (q + 1) + (xcd - r) * q) + off; }
        const int nig = WGM * nN, gid = wgid / nig, fm = gid * WGM, gsz = (nM - fm) < WGM ? (nM - fm) : WGM;
        u.pm = fm + ((wgid % nig) % gsz); u.pn = (wgid % nig) / gsz; return true;
    }
    __device__ __forceinline__ void a_ready(const Unit&) const {}
    __device__ __forceinline__ void done(const Unit&) const {}
};


__device__ __forceinline__ unsigned cvt_pk_bf16(float lo, float hi) { unsigned r; asm volatile("v_cvt_pk_bf16_f32 %0, %1, %2" : "=v"(r) : "v"(lo), "v"(hi)); return r; }
__device__ __forceinline__ float sig_(float x) { return __builtin_amdgcn_rcpf(1.f + __builtin_amdgcn_exp2f(-1.4426950408889634f * x)); }
__device__ __forceinline__ u32x4 pack8(const f32x4& v0, const f32x4& v1) { u32x4 w; w.x = cvt_pk_bf16(v0[0], v0[1]); w.y = cvt_pk_bf16(v0[2], v0[3]); w.z = cvt_pk_bf16(v1[0], v1[1]); w.w = cvt_pk_bf16(v1[2], v1[3]); return w; }
__device__ __forceinline__ void unpack8(const u32x4& w, f32x4& v0, f32x4& v1) {
    v0[0] = __uint_as_float(w.x << 16); v0[1] = __uint_as_float(w.x & 0xffff0000u); v0[2] = __uint_as_float(w.y << 16); v0[3] = __uint_as_float(w.y & 0xffff0000u);
    v1[0] = __uint_as_float(w.z << 16); v1[1] = __uint_as_float(w.z & 0xffff0000u); v1[2] = __uint_as_float(w.w << 16); v1[3] = __uint_as_float(w.w & 0xffff0000u); }
struct EpiStore {
    static constexpr bool PERM = true, AFTER_DRAIN = false;
    bf16_t* O; int ldc;
    __device__ __forceinline__ void operator()(const f32x4 (&acc)[2][2][4][2], const Unit& u, int wr, int wc, int fr, int fq) const {
        const int row0 = u.pm * BM + wr * 64 + fr, col0 = u.pn * BM + wc * 32 + 8 * fq;
#pragma unroll
        for (int ai = 0; ai < 2; ++ai)
#pragma unroll
            for (int m = 0; m < 4; ++m) { bf16_t* rowp = O + (size_t)(row0 + ai * HALF + m * 16) * ldc + col0;
#pragma unroll
                for (int bj = 0; bj < 2; ++bj) *(u32x4*)(rowp + bj * HALF) = pack8(acc[ai][bj][m][0], acc[ai][bj][m][1]); }
    }
};
struct EpiStore8 {
    static constexpr bool PERM = true, AFTER_DRAIN = false;
    bf16_t* O; int ldc; float sc;
    __device__ __forceinline__ void operator()(const f32x4 (&acc)[2][2][4][2], const Unit& u, int wr, int wc, int fr, int fq) const {
        const int row0 = u.pm * BM + wr * 64 + fr, col0 = u.pn * BM + wc * 32 + 8 * fq;
#pragma unroll
        for (int ai = 0; ai < 2; ++ai)
#pragma unroll
            for (int m = 0; m < 4; ++m) { bf16_t* rowp = O + (size_t)(row0 + ai * HALF + m * 16) * ldc + col0;
#pragma unroll
                for (int bj = 0; bj < 2; ++bj) *(u32x4*)(rowp + bj * HALF) = pack8(acc[ai][bj][m][0] * sc, acc[ai][bj][m][1] * sc); }
    }
};
struct EpiStore8G {
    static constexpr bool PERM = true, AFTER_DRAIN = false;
    bf16_t* O; int ldc; float sc; unsigned char* G8;
    __device__ __forceinline__ void operator()(const f32x4 (&acc)[2][2][4][2], const Unit& u, int wr, int wc, int fr, int fq) const {
        const int row0 = u.pm * BM + wr * 64 + fr, col0 = u.pn * BM + wc * 32 + 8 * fq;
        if (u.pn >= 6) {
            const float ksc = -1.4426950408889634f * sc;
#pragma unroll
            for (int ai = 0; ai < 2; ++ai)
#pragma unroll
                for (int m = 0; m < 4; ++m) { unsigned char* rowp = G8 + (size_t)(row0 + ai * HALF + m * 16) * 2048 + (col0 - 6 * BM);
#pragma unroll
                    for (int bj = 0; bj < 2; ++bj) { u32x2 w = {0u, 0u};
#pragma unroll
                        for (int i = 0; i < 4; ++i) {
                            const float s0 = __builtin_rintf(255.f * __builtin_amdgcn_rcpf(1.f + __builtin_amdgcn_exp2f(acc[ai][bj][m][0][i] * ksc))), s1 = __builtin_rintf(255.f * __builtin_amdgcn_rcpf(1.f + __builtin_amdgcn_exp2f(acc[ai][bj][m][1][i] * ksc)));
                            w.x = __builtin_amdgcn_cvt_pk_u8_f32(s0, i, w.x); w.y = __builtin_amdgcn_cvt_pk_u8_f32(s1, i, w.y); }
                        *(u32x2*)(rowp + bj * HALF) = w; } }
            return;
        }
#pragma unroll
        for (int ai = 0; ai < 2; ++ai)
#pragma unroll
            for (int m = 0; m < 4; ++m) { bf16_t* rowp = O + (size_t)(row0 + ai * HALF + m * 16) * ldc + col0;
#pragma unroll
                for (int bj = 0; bj < 2; ++bj) *(u32x4*)(rowp + bj * HALF) = pack8(acc[ai][bj][m][0] * sc, acc[ai][bj][m][1] * sc); }
    }
};
struct EpiAct8 {
    static constexpr bool PERM = true, AFTER_DRAIN = false;
    unsigned char* ACT; const float* b1;
    typedef float f2 __attribute__((ext_vector_type(2)));
    __device__ __forceinline__ static f2 act2(f2 g, f2 u) {
        g.x = fminf(g.x, 7.f); g.y = fminf(g.y, 7.f); u.x = __builtin_amdgcn_fmed3f(u.x, -7.f, 7.f); u.y = __builtin_amdgcn_fmed3f(u.y, -7.f, 7.f);
        f2 e = g * (f2){-1.702f * 1.4426950408889634f, -1.702f * 1.4426950408889634f};
        e.x = __builtin_amdgcn_exp2f(e.x); e.y = __builtin_amdgcn_exp2f(e.y); e = e + (f2){1.f, 1.f};
        e.x = __builtin_amdgcn_rcpf(e.x); e.y = __builtin_amdgcn_rcpf(e.y);
        const f2 u4 = __builtin_elementwise_fma(u, (f2){4.f, 4.f}, (f2){4.f, 4.f});
        return (g * e) * u4;
    }
    __device__ __forceinline__ void operator()(const f32x4 (&acc)[2][2][4][2], const Unit& u, int wr, int wc, int fr, int fq) const {
        const int e = u.pn >> 3, nt = u.pn & 7;
        const int row0 = u.pm * BM + wr * 64 + fr, col0 = nt * 128 + wc * 32 + 8 * fq;
        const float* bg = b1 + (size_t)e * 2048 + col0;
        const f32x4 bg0 = *(const f32x4*)bg, bg1 = *(const f32x4*)(bg + 4), bu0 = *(const f32x4*)(bg + 1024), bu1 = *(const f32x4*)(bg + 1028);
        const f2 SC2 = {1.f / 512.f, 1.f / 512.f};
#pragma unroll
        for (int ai = 0; ai < 2; ++ai)
#pragma unroll
            for (int m = 0; m < 4; ++m) { const int row = row0 + ai * HALF + m * 16;
                const f32x4 ag0 = acc[ai][0][m][0], ag1 = acc[ai][0][m][1], au0 = acc[ai][1][m][0], au1 = acc[ai][1][m][1];
                const f2 r0 = act2(__builtin_elementwise_fma((f2){ag0[0], ag0[1]}, SC2, (f2){bg0[0], bg0[1]}), __builtin_elementwise_fma((f2){au0[0], au0[1]}, SC2, (f2){bu0[0], bu0[1]}));
                const f2 r1 = act2(__builtin_elementwise_fma((f2){ag0[2], ag0[3]}, SC2, (f2){bg0[2], bg0[3]}), __builtin_elementwise_fma((f2){au0[2], au0[3]}, SC2, (f2){bu0[2], bu0[3]}));
                const f2 r2 = act2(__builtin_elementwise_fma((f2){ag1[0], ag1[1]}, SC2, (f2){bg1[0], bg1[1]}), __builtin_elementwise_fma((f2){au1[0], au1[1]}, SC2, (f2){bu1[0], bu1[1]}));
                const f2 r3 = act2(__builtin_elementwise_fma((f2){ag1[2], ag1[3]}, SC2, (f2){bg1[2], bg1[3]}), __builtin_elementwise_fma((f2){au1[2], au1[3]}, SC2, (f2){bu1[2], bu1[3]}));
                u32x2 w; w.x = pack4_fp8(r0.x, r0.y, r1.x, r1.y); w.y = pack4_fp8(r2.x, r2.y, r3.x, r3.y);
                *(u32x2*)(ACT + (size_t)row * 1024 + col0) = w; }
    }
};
struct EpiY8 {
    static constexpr bool PERM = true, AFTER_DRAIN = false;
    bf16_t* YB; const float* b2;
    __device__ __forceinline__ void operator()(const f32x4 (&acc)[2][2][4][2], const Unit& u, int wr, int wc, int fr, int fq) const {
        const int e = u.pn >> 2, nt = u.pn & 3;
        const int row0 = u.pm * BM + wr * 64 + fr, col0 = nt * BM + wc * 32 + 8 * fq;
        constexpr float SC = 1.f / 256.f;
        f32x4 bv[2][2];
#pragma unroll
        for (int bj = 0; bj < 2; ++bj) { bv[bj][0] = *(const f32x4*)(b2 + (size_t)e * 1024 + col0 + bj * HALF); bv[bj][1] = *(const f32x4*)(b2 + (size_t)e * 1024 + col0 + bj * HALF + 4); }
#pragma unroll
        for (int ai = 0; ai < 2; ++ai)
#pragma unroll
            for (int m = 0; m < 4; ++m) { bf16_t* rowp = YB + (size_t)(row0 + ai * HALF + m * 16) * 1024 + col0;
#pragma unroll
                for (int bj = 0; bj < 2; ++bj) *(u32x4*)(rowp + bj * HALF) = pack8(acc[ai][bj][m][0] * SC + bv[bj][0], acc[ai][bj][m][1] * SC + bv[bj][1]); }
    }
};
template <int NN> struct MoeOrder {
    const PG8_LAS int* texp; int G, c, ntile;
    __device__ __forceinline__ bool next(int i, Unit& u) const {
        const int L = i * G + c; if (L >= ntile * NN) return false;
        const int t = L / NN, pnl = L % NN;
        u.pm = t; u.pn = texp[t] * NN + pnl; return true;
    }
    __device__ __forceinline__ void a_ready(const Unit&) const {}
    __device__ __forceinline__ void done(const Unit&) const {}
};
template <class Epi, class Sched, bool ALIGN_EPI = false, bool SP2 = false>
__device__ __forceinline__ void gemm_phase(PG8_LAS unsigned char* lds, const Gemm g, const Sched& S, const Epi& E) {
    const int tid = threadIdx.x, wid = __builtin_amdgcn_readfirstlane(tid >> 6), lane = tid & 63, wr = wid >> 2, wc = wid & 3, fr = lane & 15, fq = lane >> 4;
    const int K = g.K, nt = K / BK;
    unsigned voffA[2], voffB[2];
#pragma unroll
    for (int i = 0; i < 2; ++i) { int R, C; stage_rc(tid * 16 + i * 8192, R, C); const int Rb = Epi::PERM ? ((R & ~31) + perm32(R & 31)) : R;
        voffA[i] = (unsigned)(R * K + C) * 2u; voffB[i] = (unsigned)(Rb * K + C) * 2u; }
    const size_t kstep = (size_t)(BK * 2);
    const size_t hstep = (size_t)HALF * K * 2;
    const size_t tstep = 2 * hstep;
    const unsigned ldsw = (unsigned)wid * 1024u;
    const int aoff = lds_byte(wr * 64 + fr, fq * 8), boff = lds_byte(wc * 32 + fr, fq * 8);
#define PG8_SA(b, h) (((b) * 2 + (h)) * HTB)
#define PG8_SB(b, h) ((4 + (b) * 2 + (h)) * HTB)
#define PG8_STAGE(bufoff, gbase, voff) do { _Pragma("unroll") for (int _i = 0; _i < 2; ++_i) \
        __builtin_amdgcn_global_load_lds((const unsigned*)((const char*)(gbase) + (voff)[_i]), (PG8_LAS unsigned*)(lds + (bufoff) + ldsw + _i * 8192), 16, 0, 0); } while (0)
#define PG8_LDA(dst, b, h) do { _Pragma("unroll") for (int m = 0; m < 4; ++m) _Pragma("unroll") for (int k = 0; k < 2; ++k) dst[m][k] = *(const PG8_LAS bf16x8*)(lds + PG8_SA(b, h) + aoff + m * 2048 + k * 1024); } while (0)
#define PG8_LDB(dst, b, h) do { _Pragma("unroll") for (int n = 0; n < 2; ++n) _Pragma("unroll") for (int k = 0; k < 2; ++k) dst[n][k] = *(const PG8_LAS bf16x8*)(lds + PG8_SB(b, h) + boff + n * 2048 + k * 1024); } while (0)
#define PG8_MMA(ai, bj, At, Bt) do { __builtin_amdgcn_s_setprio(1); _Pragma("unroll") for (int m = 0; m < 4; ++m) _Pragma("unroll") for (int n = 0; n < 2; ++n) _Pragma("unroll") for (int k = 0; k < 2; ++k) \
        acc[ai][bj][m][n] = __builtin_amdgcn_mfma_f32_16x16x32_bf16(Bt[n][k], At[m][k], acc[ai][bj][m][n], 0, 0, 0); __builtin_amdgcn_s_setprio(0); } while (0)
#define PG8_WAIT_V(n) asm volatile("s_waitcnt vmcnt(" #n ")" ::: "memory")
#define PG8_WAIT_L(n) asm volatile("s_waitcnt lgkmcnt(" #n ")" ::: "memory")
#define PG8_BAR __builtin_amdgcn_s_barrier()
#define PG8_SCHED __builtin_amdgcn_sched_barrier(0)
    Unit cur, nxt; int ui = 0;
    if (!S.next(0, cur)) return;
    f32x4 acc[2][2][4][2];
#pragma unroll
    for (int a = 0; a < 2; ++a)
#pragma unroll
        for (int b = 0; b < 2; ++b)
#pragma unroll
            for (int m = 0; m < 4; ++m)
#pragma unroll
                for (int n = 0; n < 2; ++n) acc[a][b][m][n] = (f32x4){0.f, 0.f, 0.f, 0.f};
    bf16x8 At[4][2], B0[2][2], B1[2][2];
    const char* cA = (const char*)g.A + (size_t)cur.pm * tstep; const char* cB = (const char*)g.Bt + (size_t)cur.pn * tstep;
    S.a_ready(cur);
    if constexpr (SP2) {
        PG8_STAGE(PG8_SB(0, 0), cB, voffB); PG8_STAGE(PG8_SB(0, 1), cB + hstep, voffB); PG8_STAGE(PG8_SA(0, 0), cA, voffA); PG8_STAGE(PG8_SA(0, 1), cA + hstep, voffA);
        if (wr == 1) PG8_BAR;
        PG8_WAIT_V(2); PG8_BAR;
        PG8_STAGE(PG8_SB(1, 0), cB + kstep, voffB); PG8_STAGE(PG8_SA(1, 0), cA + kstep, voffA); PG8_STAGE(PG8_SB(1, 1), cB + hstep + kstep, voffB);
        PG8_WAIT_V(6); PG8_BAR;
    } else {
        PG8_STAGE(PG8_SB(0, 0), cB, voffB); PG8_STAGE(PG8_SA(0, 0), cA, voffA); PG8_STAGE(PG8_SB(0, 1), cB + hstep, voffB); PG8_STAGE(PG8_SA(0, 1), cA + hstep, voffA);
        if (wr == 1) PG8_BAR;
        PG8_WAIT_V(4); PG8_BAR;
        PG8_STAGE(PG8_SB(1, 0), cB + kstep, voffB); PG8_STAGE(PG8_SA(1, 0), cA + kstep, voffA); PG8_STAGE(PG8_SB(1, 1), cB + hstep + kstep, voffB);
        PG8_WAIT_V(6); PG8_BAR;
    }
    for (;;) {
        const bool has_next = S.next(ui + 1, nxt);
        const char* nA = has_next ? (const char*)g.A + (size_t)nxt.pm * tstep : cA; const char* nB = has_next ? (const char*)g.Bt + (size_t)nxt.pn * tstep : cB;
        for (int t = 0; t < nt; t += 2) {
            const bool last = (t == nt - 2);
            const char* a1 = cA + (size_t)(t + 1) * kstep;
            const char* a2 = last ? nA : cA + (size_t)(t + 2) * kstep; const char* b2 = last ? nB : cB + (size_t)(t + 2) * kstep;
            const char* a3 = a2 + kstep; const char* b3 = b2 + kstep;
            if (last && has_next) S.a_ready(nxt);
            if constexpr (SP2) {
            PG8_LDB(B0, 0, 0); PG8_LDB(B1, 0, 1); PG8_SCHED; PG8_LDA(At, 0, 0); PG8_STAGE(PG8_SA(1, 1), a1 + hstep, voffA);
            PG8_WAIT_V(8); PG8_WAIT_L(0); PG8_BAR; PG8_MMA(0, 0, At, B0); PG8_MMA(0, 1, At, B1); PG8_BAR; PG8_SCHED;
            PG8_LDA(At, 0, 1); PG8_STAGE(PG8_SB(0, 0), b2, voffB); PG8_STAGE(PG8_SB(0, 1), b2 + hstep, voffB); PG8_STAGE(PG8_SA(0, 0), a2, voffA);
            PG8_WAIT_V(8); PG8_WAIT_L(0); PG8_BAR; PG8_MMA(1, 0, At, B0); PG8_MMA(1, 1, At, B1); PG8_BAR; PG8_SCHED;
            PG8_LDB(B0, 1, 0); PG8_LDB(B1, 1, 1); PG8_SCHED; PG8_LDA(At, 1, 0); PG8_STAGE(PG8_SA(0, 1), a2 + hstep, voffA);
            PG8_WAIT_V(8); PG8_WAIT_L(0); PG8_BAR; PG8_MMA(0, 0, At, B0); PG8_MMA(0, 1, At, B1); PG8_BAR; PG8_SCHED;
            PG8_LDA(At, 1, 1); PG8_STAGE(PG8_SB(1, 0), b3, voffB); PG8_STAGE(PG8_SB(1, 1), b3 + hstep, voffB); PG8_STAGE(PG8_SA(1, 0), a3, voffA);
            PG8_WAIT_V(8); PG8_WAIT_L(0); PG8_BAR; PG8_MMA(1, 0, At, B0); PG8_MMA(1, 1, At, B1); PG8_BAR; PG8_SCHED;
            } else {
            PG8_LDB(B0, 0, 0); PG8_SCHED; PG8_LDA(At, 0, 0); PG8_STAGE(PG8_SA(1, 1), a1 + hstep, voffA);
            PG8_WAIT_L(8); PG8_BAR; PG8_WAIT_L(0); PG8_MMA(0, 0, At, B0); PG8_BAR; PG8_SCHED;
            PG8_LDB(B1, 0, 1); PG8_STAGE(PG8_SB(0, 0), b2, voffB);
            PG8_BAR; PG8_WAIT_L(0); PG8_MMA(0, 1, At, B1); PG8_BAR;
            PG8_LDA(At, 0, 1); PG8_STAGE(PG8_SA(0, 0), a2, voffA);
            PG8_BAR; PG8_WAIT_L(0); PG8_MMA(1, 0, At, B0); PG8_BAR; PG8_SCHED;
            PG8_STAGE(PG8_SB(0, 1), b2 + hstep, voffB);
            PG8_WAIT_V(6); PG8_BAR; PG8_MMA(1, 1, At, B1); PG8_BAR;
            PG8_LDB(B0, 1, 0); PG8_SCHED; PG8_LDA(At, 1, 0); PG8_STAGE(PG8_SA(0, 1), a2 + hstep, voffA);
            PG8_WAIT_L(8); PG8_BAR; PG8_WAIT_L(0); PG8_MMA(0, 0, At, B0); PG8_BAR; PG8_SCHED;
            PG8_LDB(B1, 1, 1); PG8_STAGE(PG8_SB(1, 0), b3, voffB);
            PG8_BAR; PG8_WAIT_L(0); PG8_MMA(0, 1, At, B1); PG8_BAR;
            PG8_LDA(At, 1, 1); PG8_STAGE(PG8_SA(1, 0), a3, voffA);
            PG8_BAR; PG8_WAIT_L(0); PG8_MMA(1, 0, At, B0); PG8_BAR; PG8_SCHED;
            PG8_STAGE(PG8_SB(1, 1), b3 + hstep, voffB);
            PG8_WAIT_V(6); PG8_BAR; PG8_MMA(1, 1, At, B1); PG8_BAR;
            }
        }
        if constexpr (ALIGN_EPI) { if (wr == 0) PG8_BAR; }
        if constexpr (!Epi::AFTER_DRAIN) { E(acc, cur, wr, wc, fr, fq); S.done(cur); }
        if (!has_next) break;
#pragma unroll
        for (int a = 0; a < 2; ++a)
#pragma unroll
            for (int b = 0; b < 2; ++b)
#pragma unroll
                for (int m = 0; m < 4; ++m)
#pragma unroll
                    for (int n = 0; n < 2; ++n) acc[a][b][m][n] = (f32x4){0.f, 0.f, 0.f, 0.f};
        cur = nxt; cA = nA; cB = nB; ++ui;
        if constexpr (ALIGN_EPI) { if (wr == 1) PG8_BAR; }
    }
    PG8_WAIT_V(0);
    if constexpr (!ALIGN_EPI) { if (wr == 0) PG8_BAR; }
    PG8_BAR;
    if constexpr (Epi::AFTER_DRAIN) { E.fused(acc, cur, wr, wc, fr, fq, lds, wid, lane); S.done(cur); }
#undef PG8_SA
#undef PG8_SB
#undef PG8_STAGE
#undef PG8_LDA
#undef PG8_LDB
#undef PG8_MMA
#undef PG8_WAIT_V
#undef PG8_WAIT_L
#undef PG8_BAR
#undef PG8_SCHED
}

struct MoeGatherOrder {
    const PG8_LAS int* offs; const PG8_LAS int* cnt; const PG8_LAS int* texp; const int* LIST; int G, c, ntile;
    __device__ __forceinline__ bool next(int i, Unit& u) const {
        const int L = i * G + c; if (L >= ntile * 8) return false;
        const int t = L >> 3, pnl = L & 7;
        u.pm = t; u.pn = texp[t] * 8 + pnl; return true;
    }
    __device__ __forceinline__ int arow(const Unit& u, int r) const { const int e = u.pn >> 3, slot = u.pm * 256 + r - offs[e]; return slot < cnt[e] ? LIST[e * 16384 + slot] : 0; }
    __device__ __forceinline__ void a_ready(const Unit&) const {}
    __device__ __forceinline__ void done(const Unit&) const {}
};
struct TailOrder {
    StaticOrder so;
    __device__ __forceinline__ bool next(int i, Unit& u) const { Unit b; if (!so.next(i >> 1, b)) return false; u.pm = b.pm + 64 * (i & 1); u.pn = b.pn + 4 * (i & 1); return true; }
    __device__ __forceinline__ void a_ready(const Unit&) const {}
    __device__ __forceinline__ void done(const Unit&) const {}
};
typedef float f2 __attribute__((ext_vector_type(2)));
typedef float f32x2_ss __attribute__((ext_vector_type(2)));
struct EpiT12 {
    static constexpr bool PERM = true, AFTER_DRAIN = false;
    bf16_t* T1; bf16_t* MG; const unsigned char* G8; const float* RSTD; bool second_;
    __device__ __forceinline__ void operator()(const f32x4 (&acc)[2][2][4][2], const Unit& u, int wr, int wc, int fr, int fq) const {
        const bool second = second_;
        const int row0 = (u.pm & 63) * BM + wr * 64 + fr, col0 = (u.pn & 3) * BM + wc * 32 + 8 * fq;
        const unsigned char* Gp = G8 + (second ? 1024 : 0);
#pragma unroll
        for (int ai = 0; ai < 2; ++ai) {
            u32x2 gv[4][2]; u32x4 tv[4][2]; float rs[4];
#pragma unroll
            for (int m = 0; m < 4; ++m) { const int row = row0 + ai * HALF + m * 16; rs[m] = 1.f / (255.f * 4096.f); if (!second) { const f32x2_ss q_ = *(const f32x2_ss*)(RSTD + 2 * (size_t)row); rs[m] = (1.f / 255.f) * rsqrtf((q_.x + q_.y) * (1.f / 1024.f) + EPS); }
#pragma unroll
                for (int bj = 0; bj < 2; ++bj) { gv[m][bj] = *(const u32x2*)(Gp + (size_t)row * 2048 + col0 + bj * HALF);
                    tv[m][bj] = second ? *(const u32x4*)(T1 + (size_t)row * 1024 + col0 + bj * HALF) : (u32x4){0u, 0u, 0u, 0u}; } }
#pragma unroll
            for (int m = 0; m < 4; ++m) { const int row = row0 + ai * HALF + m * 16;
#pragma unroll
                for (int bj = 0; bj < 2; ++bj) { f32x4 t0, t1; unpack8(tv[m][bj], t0, t1);
                    const unsigned ga = gv[m][bj].x, gb = gv[m][bj].y;
                    const f32x4 g0 = {(float)((ga >> 0) & 0xffu), (float)((ga >> 8) & 0xffu), (float)((ga >> 16) & 0xffu), (float)((ga >> 24) & 0xffu)};
                    const f32x4 g1 = {(float)((gb >> 0) & 0xffu), (float)((gb >> 8) & 0xffu), (float)((gb >> 16) & 0xffu), (float)((gb >> 24) & 0xffu)};
                    f32x4 v0 = acc[ai][bj][m][0] * rs[m], v1 = acc[ai][bj][m][1] * rs[m];
#pragma unroll
                    for (int i = 0; i < 4; ++i) { v0[i] = fmaf(v0[i], g0[i], t0[i]); v1[i] = fmaf(v1[i], g1[i], t1[i]); }
                    *(u32x4*)((second ? MG : T1) + (size_t)row * 1024 + col0 + bj * HALF) = pack8(v0, v1); } }
        }
    }
};
struct EpiT3b {
    static constexpr bool PERM = true, AFTER_DRAIN = false;
    bf16_t* X1; const float* x;
    __device__ __forceinline__ void operator()(const f32x4 (&acc)[2][2][4][2], const Unit& u, int wr, int wc, int fr, int fq) const {
        const int row0 = u.pm * BM + wr * 64 + fr, col0 = u.pn * BM + wc * 32 + 8 * fq;
#pragma unroll
        for (int ai = 0; ai < 2; ++ai) {
            f32x4 xv[4][2][2];
#pragma unroll
            for (int m = 0; m < 4; ++m)
#pragma unroll
                for (int bj = 0; bj < 2; ++bj) { const size_t o = (size_t)(row0 + ai * HALF + m * 16) * 1024 + col0 + bj * HALF; xv[m][bj][0] = *(const f32x4*)(x + o); xv[m][bj][1] = *(const f32x4*)(x + o + 4); }
#pragma unroll
            for (int m = 0; m < 4; ++m)
#pragma unroll
                for (int bj = 0; bj < 2; ++bj) { const size_t o = (size_t)(row0 + ai * HALF + m * 16) * 1024 + col0 + bj * HALF;
                    *(u32x4*)(X1 + o) = pack8(xv[m][bj][0] + acc[ai][bj][m][0], xv[m][bj][1] + acc[ai][bj][m][1]); }
        }
    }
};
typedef int v4i_t __attribute__((ext_vector_type(4)));
typedef int v8i_t __attribute__((ext_vector_type(8)));
template <class Epi, class Sched, bool ALIGN_EPI = false, bool SP2 = false>
__device__ __forceinline__ void gemm_phase_f8(PG8_LAS unsigned char* lds, const Gemm g, const Sched& S, const Epi& E) {
    const int tid = threadIdx.x, wid = __builtin_amdgcn_readfirstlane(tid >> 6), lane = tid & 63, wr = wid >> 2, wc = wid & 3, fr = lane & 15, fq = lane >> 4;
    const int K = g.K, nt = K / BK;
    unsigned voffA[2], voffB[2];
#pragma unroll
    for (int i = 0; i < 2; ++i) { int R, C; stage_rc(tid * 16 + i * 8192, R, C); const int Rb = Epi::PERM ? ((R & ~31) + perm32(R & 31)) : R;
        voffA[i] = (unsigned)(R * K + C) * 2u; voffB[i] = (unsigned)(Rb * K + C) * 2u; }
    const size_t kstep = (size_t)(BK * 2);
    const size_t hstep = (size_t)HALF * K * 2;
    const size_t tstep = 2 * hstep;
    const unsigned ldsw = (unsigned)wid * 1024u;
    const int aoff = lds_byte(wr * 64 + fr, fq * 8), boff = lds_byte(wc * 32 + fr, fq * 8);
#define PG8_SA(b, h) (((b) * 2 + (h)) * HTB)
#define PG8_SB(b, h) ((4 + (b) * 2 + (h)) * HTB)
#define PG8_STAGE(bufoff, gbase, voff) do { _Pragma("unroll") for (int _i = 0; _i < 2; ++_i) \
        __builtin_amdgcn_global_load_lds((const unsigned*)((const char*)(gbase) + (voff)[_i]), (PG8_LAS unsigned*)(lds + (bufoff) + ldsw + _i * 8192), 16, 0, 0); } while (0)
#define PG8_LDA(dst, b, h) do { _Pragma("unroll") for (int m = 0; m < 4; ++m) { const v4i_t lo_ = *(const PG8_LAS v4i_t*)(lds + PG8_SA(b, h) + aoff + m * 2048), hi_ = *(const PG8_LAS v4i_t*)(lds + PG8_SA(b, h) + aoff + m * 2048 + 1024); dst[m] = __builtin_shufflevector(lo_, hi_, 0, 1, 2, 3, 4, 5, 6, 7); } } while (0)
#define PG8_LDB(dst, b, h) do { _Pragma("unroll") for (int n = 0; n < 2; ++n) { const v4i_t lo_ = *(const PG8_LAS v4i_t*)(lds + PG8_SB(b, h) + boff + n * 2048), hi_ = *(const PG8_LAS v4i_t*)(lds + PG8_SB(b, h) + boff + n * 2048 + 1024); dst[n] = __builtin_shufflevector(lo_, hi_, 0, 1, 2, 3, 4, 5, 6, 7); } } while (0)
#define PG8_MMA(ai, bj, At, Bt) do { __builtin_amdgcn_s_setprio(1); _Pragma("unroll") for (int m = 0; m < 4; ++m) _Pragma("unroll") for (int n = 0; n < 2; ++n) \
        asm volatile("v_mfma_scale_f32_16x16x128_f8f6f4 %0, %1, %2, %0, %3, %3 op_sel_hi:[0,0,0]" : "+v"(acc[ai][bj][m][n]) : "v"(Bt[n]), "v"(At[m]), "v"(scl_)); __builtin_amdgcn_s_setprio(0); } while (0)
#define PG8_WAIT_V(n) asm volatile("s_waitcnt vmcnt(" #n ")" ::: "memory")
#define PG8_WAIT_L(n) asm volatile("s_waitcnt lgkmcnt(" #n ")" ::: "memory")
#define PG8_BAR __builtin_amdgcn_s_barrier()
#define PG8_SCHED __builtin_amdgcn_sched_barrier(0)
    Unit cur, nxt; int ui = 0;
    if (!S.next(0, cur)) return;
    f32x4 acc[2][2][4][2];
#pragma unroll
    for (int a = 0; a < 2; ++a)
#pragma unroll
        for (int b = 0; b < 2; ++b)
#pragma unroll
            for (int m = 0; m < 4; ++m)
#pragma unroll
                for (int n = 0; n < 2; ++n) acc[a][b][m][n] = (f32x4){0.f, 0.f, 0.f, 0.f};
    const int scl_ = 0x7f7f7f7f;
    v8i_t At[4], B0[2], B1[2];
    const char* cA = (const char*)g.A + (size_t)cur.pm * tstep; const char* cB = (const char*)g.Bt + (size_t)cur.pn * tstep;
    S.a_ready(cur);
    if constexpr (SP2) {
        PG8_STAGE(PG8_SB(0, 0), cB, voffB); PG8_STAGE(PG8_SB(0, 1), cB + hstep, voffB); PG8_STAGE(PG8_SA(0, 0), cA, voffA); PG8_STAGE(PG8_SA(0, 1), cA + hstep, voffA);
        if (wr == 1) PG8_BAR;
        PG8_WAIT_V(2); PG8_BAR;
        PG8_STAGE(PG8_SB(1, 0), cB + kstep, voffB); PG8_STAGE(PG8_SA(1, 0), cA + kstep, voffA); PG8_STAGE(PG8_SB(1, 1), cB + hstep + kstep, voffB);
        PG8_WAIT_V(6); PG8_BAR;
    } else {
        PG8_STAGE(PG8_SB(0, 0), cB, voffB); PG8_STAGE(PG8_SA(0, 0), cA, voffA); PG8_STAGE(PG8_SB(0, 1), cB + hstep, voffB); PG8_STAGE(PG8_SA(0, 1), cA + hstep, voffA);
        if (wr == 1) PG8_BAR;
        PG8_WAIT_V(4); PG8_BAR;
        PG8_STAGE(PG8_SB(1, 0), cB + kstep, voffB); PG8_STAGE(PG8_SA(1, 0), cA + kstep, voffA); PG8_STAGE(PG8_SB(1, 1), cB + hstep + kstep, voffB);
        PG8_WAIT_V(6); PG8_BAR;
    }
    for (;;) {
        const bool has_next = S.next(ui + 1, nxt);
        const char* nA = has_next ? (const char*)g.A + (size_t)nxt.pm * tstep : cA; const char* nB = has_next ? (const char*)g.Bt + (size_t)nxt.pn * tstep : cB;
        for (int t = 0; t < nt; t += 2) {
            const bool last = (t == nt - 2);
            const char* a1 = cA + (size_t)(t + 1) * kstep;
            const char* a2 = last ? nA : cA + (size_t)(t + 2) * kstep; const char* b2 = last ? nB : cB + (size_t)(t + 2) * kstep;
            const char* a3 = a2 + kstep; const char* b3 = b2 + kstep;
            if (last && has_next) S.a_ready(nxt);
            if constexpr (SP2) {
            PG8_LDB(B0, 0, 0); PG8_LDB(B1, 0, 1); PG8_SCHED; PG8_LDA(At, 0, 0); PG8_STAGE(PG8_SA(1, 1), a1 + hstep, voffA);
            PG8_WAIT_V(8); PG8_WAIT_L(0); PG8_BAR; PG8_MMA(0, 0, At, B0); PG8_MMA(0, 1, At, B1); PG8_BAR; PG8_SCHED;
            PG8_LDA(At, 0, 1); PG8_STAGE(PG8_SB(0, 0), b2, voffB); PG8_STAGE(PG8_SB(0, 1), b2 + hstep, voffB); PG8_STAGE(PG8_SA(0, 0), a2, voffA);
            PG8_WAIT_V(8); PG8_WAIT_L(0); PG8_BAR; PG8_MMA(1, 0, At, B0); PG8_MMA(1, 1, At, B1); PG8_BAR; PG8_SCHED;
            PG8_LDB(B0, 1, 0); PG8_LDB(B1, 1, 1); PG8_SCHED; PG8_LDA(At, 1, 0); PG8_STAGE(PG8_SA(0, 1), a2 + hstep, voffA);
            PG8_WAIT_V(8); PG8_WAIT_L(0); PG8_BAR; PG8_MMA(0, 0, At, B0); PG8_MMA(0, 1, At, B1); PG8_BAR; PG8_SCHED;
            PG8_LDA(At, 1, 1); PG8_STAGE(PG8_SB(1, 0), b3, voffB); PG8_STAGE(PG8_SB(1, 1), b3 + hstep, voffB); PG8_STAGE(PG8_SA(1, 0), a3, voffA);
            PG8_WAIT_V(8); PG8_WAIT_L(0); PG8_BAR; PG8_MMA(1, 0, At, B0); PG8_MMA(1, 1, At, B1); PG8_BAR; PG8_SCHED;
            } else {
            PG8_LDB(B0, 0, 0); PG8_SCHED; PG8_LDA(At, 0, 0); PG8_STAGE(PG8_SA(1, 1), a1 + hstep, voffA);
            PG8_WAIT_L(8); PG8_BAR; PG8_WAIT_L(0); PG8_MMA(0, 0, At, B0); PG8_BAR; PG8_SCHED;
            PG8_LDB(B1, 0, 1); PG8_STAGE(PG8_SB(0, 0), b2, voffB);
            PG8_BAR; PG8_WAIT_L(0); PG8_MMA(0, 1, At, B1); PG8_BAR;
            PG8_LDA(At, 0, 1); PG8_STAGE(PG8_SA(0, 0), a2, voffA);
            PG8_BAR; PG8_WAIT_L(0); PG8_MMA(1, 0, At, B0); PG8_BAR; PG8_SCHED;
            PG8_STAGE(PG8_SB(0, 1), b2 + hstep, voffB);
            PG8_WAIT_V(6); PG8_BAR; PG8_MMA(1, 1, At, B1); PG8_BAR;
            PG8_LDB(B0, 1, 0); PG8_SCHED; PG8_LDA(At, 1, 0); PG8_STAGE(PG8_SA(0, 1), a2 + hstep, voffA);
            PG8_WAIT_L(8); PG8_BAR; PG8_WAIT_L(0); PG8_MMA(0, 0, At, B0); PG8_BAR; PG8_SCHED;
            PG8_LDB(B1, 1, 1); PG8_STAGE(PG8_SB(1, 0), b3, voffB);
            PG8_BAR; PG8_WAIT_L(0); PG8_MMA(0, 1, At, B1); PG8_BAR;
            PG8_LDA(At, 1, 1); PG8_STAGE(PG8_SA(1, 0), a3, voffA);
            PG8_BAR; PG8_WAIT_L(0); PG8_MMA(1, 0, At, B0); PG8_BAR; PG8_SCHED;
            PG8_STAGE(PG8_SB(1, 1), b3 + hstep, voffB);
            PG8_WAIT_V(6); PG8_BAR; PG8_MMA(1, 1, At, B1); PG8_BAR;
            }
        }
        if constexpr (ALIGN_EPI) { if (wr == 0) PG8_BAR; }
        asm volatile("s_nop 15\n\ts_nop 15" ::: "memory");
        if constexpr (!Epi::AFTER_DRAIN) { E(acc, cur, wr, wc, fr, fq); S.done(cur); }
        if (!has_next) break;
#pragma unroll
        for (int a = 0; a < 2; ++a)
#pragma unroll
            for (int b = 0; b < 2; ++b)
#pragma unroll
                for (int m = 0; m < 4; ++m)
#pragma unroll
                    for (int n = 0; n < 2; ++n) acc[a][b][m][n] = (f32x4){0.f, 0.f, 0.f, 0.f};
        cur = nxt; cA = nA; cB = nB; ++ui;
        if constexpr (ALIGN_EPI) { if (wr == 1) PG8_BAR; }
    }
    PG8_WAIT_V(0);
    if constexpr (!ALIGN_EPI) { if (wr == 0) PG8_BAR; }
    PG8_BAR;
    if constexpr (Epi::AFTER_DRAIN) { E.fused(acc, cur, wr, wc, fr, fq, lds, wid, lane); S.done(cur); }
#undef PG8_SA
#undef PG8_SB
#undef PG8_STAGE
#undef PG8_LDA
#undef PG8_LDB
#undef PG8_MMA
#undef PG8_WAIT_V
#undef PG8_WAIT_L
#undef PG8_BAR
#undef PG8_SCHED
}

template <class Epi, class Sched>
__device__ __forceinline__ void gemm_phase_gather_f8(PG8_LAS unsigned char* lds, const Gemm g, const Sched& S, const Epi& E) {
    constexpr bool ALIGN_EPI = true, SP2 = true;
    const int tid = threadIdx.x, wid = __builtin_amdgcn_readfirstlane(tid >> 6), lane = tid & 63, wr = wid >> 2, wc = wid & 3, fr = lane & 15, fq = lane >> 4;
    const int K = g.K, nt = K / BK;
    unsigned voffA[2], voffB[2];
#pragma unroll
    for (int i = 0; i < 2; ++i) { int R, C; stage_rc(tid * 16 + i * 8192, R, C); const int Rb = Epi::PERM ? ((R & ~31) + perm32(R & 31)) : R;
        voffA[i] = (unsigned)(R * K + C) * 2u; voffB[i] = (unsigned)(Rb * K + C) * 2u; }
    const size_t kstep = (size_t)(BK * 2);
    const size_t hstep = (size_t)HALF * K * 2;
    const size_t tstep = 2 * hstep;
    const unsigned ldsw = (unsigned)wid * 1024u;
    const int aoff = lds_byte(wr * 64 + fr, fq * 8), boff = lds_byte(wc * 32 + fr, fq * 8);
#define PG8_SA(b, h) (((b) * 2 + (h)) * HTB)
#define PG8_SB(b, h) ((4 + (b) * 2 + (h)) * HTB)
#define PG8_STAGE(bufoff, gbase, voff) do { _Pragma("unroll") for (int _i = 0; _i < 2; ++_i) \
        __builtin_amdgcn_global_load_lds((const unsigned*)((const char*)(gbase) + (voff)[_i]), (PG8_LAS unsigned*)(lds + (bufoff) + ldsw + _i * 8192), 16, 0, 0); } while (0)
#define PG8_LDA(dst, b, h) do { _Pragma("unroll") for (int m = 0; m < 4; ++m) { const v4i_t lo_ = *(const PG8_LAS v4i_t*)(lds + PG8_SA(b, h) + aoff + m * 2048), hi_ = *(const PG8_LAS v4i_t*)(lds + PG8_SA(b, h) + aoff + m * 2048 + 1024); dst[m] = __builtin_shufflevector(lo_, hi_, 0, 1, 2, 3, 4, 5, 6, 7); } } while (0)
#define PG8_LDB(dst, b, h) do { _Pragma("unroll") for (int n = 0; n < 2; ++n) { const v4i_t lo_ = *(const PG8_LAS v4i_t*)(lds + PG8_SB(b, h) + boff + n * 2048), hi_ = *(const PG8_LAS v4i_t*)(lds + PG8_SB(b, h) + boff + n * 2048 + 1024); dst[n] = __builtin_shufflevector(lo_, hi_, 0, 1, 2, 3, 4, 5, 6, 7); } } while (0)
#define PG8_MMA(ai, bj, At, Bt) do { __builtin_amdgcn_s_setprio(1); _Pragma("unroll") for (int m = 0; m < 4; ++m) _Pragma("unroll") for (int n = 0; n < 2; ++n) \
        asm volatile("v_mfma_scale_f32_16x16x128_f8f6f4 %0, %1, %2, %0, %3, %3 op_sel_hi:[0,0,0]" : "+v"(acc[ai][bj][m][n]) : "v"(Bt[n]), "v"(At[m]), "v"(scl_)); __builtin_amdgcn_s_setprio(0); } while (0)
#define PG8_WAIT_V(n) asm volatile("s_waitcnt vmcnt(" #n ")" ::: "memory")
#define PG8_WAIT_L(n) asm volatile("s_waitcnt lgkmcnt(" #n ")" ::: "memory")
#define PG8_BAR __builtin_amdgcn_s_barrier()
#define PG8_SCHED __builtin_amdgcn_sched_barrier(0)
    Unit cur, nxt; int ui = 0;
    if (!S.next(0, cur)) return;
    int rA[2]; unsigned cAo[2];
#pragma unroll
    for (int i = 0; i < 2; ++i) { int R, C; stage_rc(tid * 16 + i * 8192, R, C); rA[i] = R; cAo[i] = (unsigned)C * 2u; }
    unsigned cO[2][2], o2[2][2]; int nR[2][2];
#define PG8_ROWS(dst, u) do { _Pragma("unroll") for (int h_ = 0; h_ < 2; ++h_) _Pragma("unroll") for (int i_ = 0; i_ < 2; ++i_) \
        dst[h_][i_] = (unsigned)S.arow(u, h_ * HALF + rA[i_]) * (unsigned)(K * 2) + cAo[i_]; } while (0)
    PG8_ROWS(cO, cur);
    f32x4 acc[2][2][4][2];
#pragma unroll
    for (int a = 0; a < 2; ++a)
#pragma unroll
        for (int b = 0; b < 2; ++b)
#pragma unroll
            for (int m = 0; m < 4; ++m)
#pragma unroll
                for (int n = 0; n < 2; ++n) acc[a][b][m][n] = (f32x4){0.f, 0.f, 0.f, 0.f};
    const int scl_ = 0x7f7f7f7f;
    v8i_t At[4], B0[2], B1[2];
    const char* const Ab = (const char*)g.A; const char* cB = (const char*)g.Bt + (size_t)cur.pn * tstep;
    S.a_ready(cur);
    if constexpr (SP2) {
        PG8_STAGE(PG8_SB(0, 0), cB, voffB); PG8_STAGE(PG8_SB(0, 1), cB + hstep, voffB); PG8_STAGE(PG8_SA(0, 0), Ab, cO[0]); PG8_STAGE(PG8_SA(0, 1), Ab, cO[1]);
        if (wr == 1) PG8_BAR;
        PG8_WAIT_V(2); PG8_BAR;
        PG8_STAGE(PG8_SB(1, 0), cB + kstep, voffB); PG8_STAGE(PG8_SA(1, 0), Ab + kstep, cO[0]); PG8_STAGE(PG8_SB(1, 1), cB + hstep + kstep, voffB);
        PG8_WAIT_V(6); PG8_BAR;
    }
    for (;;) {
        const bool has_next = S.next(ui + 1, nxt);
        const char* nB = has_next ? (const char*)g.Bt + (size_t)nxt.pn * tstep : cB;
#pragma unroll
        for (int h_ = 0; h_ < 2; ++h_)
#pragma unroll
            for (int i_ = 0; i_ < 2; ++i_) nR[h_][i_] = has_next ? S.arow(nxt, h_ * HALF + rA[i_]) : 0;
        for (int t = 0; t < nt; t += 2) {
            const bool last = (t == nt - 2);
            const char* a1 = Ab + (size_t)(t + 1) * kstep;
            const char* a2 = last ? Ab : Ab + (size_t)(t + 2) * kstep; const char* b2 = last ? nB : cB + (size_t)(t + 2) * kstep;
#pragma unroll
            for (int h_ = 0; h_ < 2; ++h_)
#pragma unroll
                for (int i_ = 0; i_ < 2; ++i_) o2[h_][i_] = cO[h_][i_];
            if (last && has_next) {
#pragma unroll
                for (int h_ = 0; h_ < 2; ++h_)
#pragma unroll
                    for (int i_ = 0; i_ < 2; ++i_) { int v_ = nR[h_][i_]; asm volatile("" : "+v"(v_)); o2[h_][i_] = (unsigned)v_ * (unsigned)(K * 2) + cAo[i_]; } }
            const char* a3 = a2 + kstep; const char* b3 = b2 + kstep;
            if (last && has_next) S.a_ready(nxt);
            if constexpr (SP2) {
            PG8_LDB(B0, 0, 0); PG8_LDB(B1, 0, 1); PG8_SCHED; PG8_LDA(At, 0, 0); PG8_STAGE(PG8_SA(1, 1), a1, cO[1]);
            PG8_WAIT_V(8); PG8_WAIT_L(0); PG8_BAR; PG8_MMA(0, 0, At, B0); PG8_MMA(0, 1, At, B1); PG8_BAR; PG8_SCHED;
            PG8_LDA(At, 0, 1); PG8_STAGE(PG8_SB(0, 0), b2, voffB); PG8_STAGE(PG8_SB(0, 1), b2 + hstep, voffB); PG8_STAGE(PG8_SA(0, 0), a2, o2[0]);
            PG8_WAIT_V(8); PG8_WAIT_L(0); PG8_BAR; PG8_MMA(1, 0, At, B0); PG8_MMA(1, 1, At, B1); PG8_BAR; PG8_SCHED;
            PG8_LDB(B0, 1, 0); PG8_LDB(B1, 1, 1); PG8_SCHED; PG8_LDA(At, 1, 0); PG8_STAGE(PG8_SA(0, 1), a2, o2[1]);
            PG8_WAIT_V(8); PG8_WAIT_L(0); PG8_BAR; PG8_MMA(0, 0, At, B0); PG8_MMA(0, 1, At, B1); PG8_BAR; PG8_SCHED;
            PG8_LDA(At, 1, 1); PG8_STAGE(PG8_SB(1, 0), b3, voffB); PG8_STAGE(PG8_SB(1, 1), b3 + hstep, voffB); PG8_STAGE(PG8_SA(1, 0), a3, o2[0]);
            PG8_WAIT_V(8); PG8_WAIT_L(0); PG8_BAR; PG8_MMA(1, 0, At, B0); PG8_MMA(1, 1, At, B1); PG8_BAR; PG8_SCHED;
            }
        }
        if constexpr (ALIGN_EPI) { if (wr == 0) PG8_BAR; }
        asm volatile("s_nop 15\n\ts_nop 15" ::: "memory");
        if constexpr (!Epi::AFTER_DRAIN) { E(acc, cur, wr, wc, fr, fq); S.done(cur); }
        if (!has_next) break;
#pragma unroll
        for (int a = 0; a < 2; ++a)
#pragma unroll
            for (int b = 0; b < 2; ++b)
#pragma unroll
                for (int m = 0; m < 4; ++m)
#pragma unroll
                    for (int n = 0; n < 2; ++n) acc[a][b][m][n] = (f32x4){0.f, 0.f, 0.f, 0.f};
        cur = nxt; cB = nB; ++ui;
#pragma unroll
        for (int h_ = 0; h_ < 2; ++h_)
#pragma unroll
            for (int i_ = 0; i_ < 2; ++i_) cO[h_][i_] = o2[h_][i_];
        if constexpr (ALIGN_EPI) { if (wr == 1) PG8_BAR; }
    }
    PG8_WAIT_V(0);
    if constexpr (!ALIGN_EPI) { if (wr == 0) PG8_BAR; }
    PG8_BAR;
    if constexpr (Epi::AFTER_DRAIN) { E.fused(acc, cur, wr, wc, fr, fq, lds, wid, lane); S.done(cur); }
#undef PG8_ROWS
#undef PG8_SA
#undef PG8_SB
#undef PG8_STAGE
#undef PG8_LDA
#undef PG8_LDB
#undef PG8_MMA
#undef PG8_WAIT_V
#undef PG8_WAIT_L
#undef PG8_BAR
#undef PG8_SCHED
}
}

typedef short bf16x8c __attribute__((ext_vector_type(8)));
typedef float f32x16c __attribute__((ext_vector_type(16)));
__device__ __forceinline__ void phase_dt(const Params& p, const Ctx& c, int first, int step) {
    unsigned char* ws = p.ws; const int tid = c.tid;
    {
        float* DT = (float*)(ws + WS_DT); float* ACS = (float*)(ws + WS_ACS); float* CDEC = (float*)(ws + WS_CDEC);
        const bf16_t* H = (const bf16_t*)(ws + WS_H); const bf16_t* Wdt = (const bf16_t*)(ws + WS_WINT) + (size_t)PDT * 1024;
        constexpr int WS_ = 1032;
        LAS bf16_t* wl = (LAS bf16_t*)c.lds; LAS float* dtr = (LAS float*)(c.lds + 32 * WS_ * 2);
        const int lane = c.lane, r = lane & 31, hh = lane >> 5;
        bool staged = false;
        for (int it = first; it < 128; it += step) {
            const int b = it / 64, ch_ = it % 64, t0 = ch_ * 128;
            __syncthreads();
            if (!staged) { staged = true;
#pragma unroll
                for (int i = 0; i < 8; ++i) { const int idx = tid + 512 * i, row = idx >> 7, c8 = idx & 127; *(LAS u32x4*)(wl + row * WS_ + c8 * 8) = *(const u32x4*)(Wdt + (size_t)row * 1024 + c8 * 8); }
                __syncthreads(); }
            {
                const int rb = c.wave & 3, kh = c.wave >> 2;
                const bf16_t* hrow = H + ((size_t)b * S + t0 + rb * 32 + r) * 1024 + kh * 512 + 8 * hh;
                f32x16c acc = {};
#pragma unroll
                for (int k8 = 0; k8 < 4; ++k8) { bf16x8c a[8];
#pragma unroll
                    for (int ks = 0; ks < 8; ++ks) a[ks] = *(const bf16x8c*)(hrow + (k8 * 8 + ks) * 16);
#pragma unroll
                    for (int ks = 0; ks < 8; ++ks) acc = __builtin_amdgcn_mfma_f32_32x32x16_bf16(a[ks], *(const LAS bf16x8c*)(wl + r * WS_ + kh * 512 + (k8 * 8 + ks) * 16 + 8 * hh), acc, 0, 0, 0); }
#pragma unroll
                for (int i = 0; i < 16; ++i) { const int l = rb * 32 + (i & 3) + 8 * (i >> 2) + 4 * hh; dtr[(kh * 128 + l) * 33 + r] = acc[i]; }
            }
            __syncthreads();
#pragma unroll
            for (int qi = 0; qi < 4; ++qi) {
                const int q = c.wave * 4 + qi, dir = q >> 4, h = q & 15;
                const float bias = dir ? p.in[6][h] : p.in[5][h], nA = -expf(dir ? p.in[8][h] : p.in[7][h]);
                const int l0 = dir ? 127 - lane : lane, l1 = dir ? 63 - lane : lane + 64;
                const size_t tok0 = (size_t)b * S + t0 + l0, tok1 = (size_t)b * S + t0 + l1;
                const float x0 = dtr[l0 * 33 + q] + dtr[(128 + l0) * 33 + q] + bias, x1 = dtr[l1 * 33 + q] + dtr[(128 + l1) * 33 + q] + bias;
                const float d0 = fmaxf(x0, 0.f) + log1pf(expf(-fabsf(x0))), d1 = fmaxf(x1, 0.f) + log1pf(expf(-fabsf(x1)));
                float a0 = d0 * nA, a1 = d1 * nA;
#pragma unroll
                for (int o = 1; o < 64; o <<= 1) { const float t0_ = __shfl_up(a0, o), t1_ = __shfl_up(a1, o); if (lane >= o) { a0 += t0_; a1 += t1_; } }
                const float tot0 = __shfl(a0, 63); a1 += tot0;
                DT[((size_t)dir * M + tok0) * 16 + h] = d0; DT[((size_t)dir * M + tok1) * 16 + h] = d1;
                ACS[((size_t)dir * M + tok0) * 16 + h] = a0; ACS[((size_t)dir * M + tok1) * 16 + h] = a1;
                if (lane == 63) CDEC[((dir * 2 + b) * 64 + ch_) * 16 + h] = expf(a1);
            }
        }
        __syncthreads();
    }
}
__device__ __forceinline__ void phase_conv(const Params& p, const Ctx& c) {
    unsigned char* ws = p.ws;
    const bf16_t* P = (const bf16_t*)(ws + WS_P);
    const int tid = c.tid;
    LAS bf16_t* raw = (LAS bf16_t*)c.lds;
    LAS bf16_t* outb = (LAS bf16_t*)(c.lds + 132 * 256 * 2);
    for (int it = c.bid; it < 2 * 64 * 6; it += c.G) {
        const int part = it % 6, bc = it / 6, b = bc / 64, ch_ = bc % 64, t0 = ch_ * 128;
        __syncthreads();
        {
            u32x4 rv[9];
#pragma unroll
            for (int i = 0; i < 9; ++i) { const int idx = tid + 512 * i, r = idx >> 5, c8 = idx & 31, tok = t0 - 2 + r;
                rv[i] = (u32x4){0u, 0u, 0u, 0u};
                if (idx < 132 * 32 && tok >= 0 && tok < S) rv[i] = __builtin_nontemporal_load((const u32x4*)(P + (size_t)(b * S + tok) * NPROJ + PXBC + part * 256 + c8 * 8)); }
#pragma unroll
            for (int i = 0; i < 9; ++i) { const int idx = tid + 512 * i, r = idx >> 5, c8 = idx & 31;
                if (idx < 132 * 32) *(LAS u32x4*)(raw + r * 256 + c8 * 8) = rv[i]; }
        }
        __syncthreads();
        {
            const int ch = tid & 255, hf = tid >> 8, cg_ = part * 256 + ch;
            const float* cw = p.in[3]; const float cb = p.in[4][cg_];
            const float w0 = cw[0 * 1536 + cg_], w1 = cw[1 * 1536 + cg_], w2 = cw[2 * 1536 + cg_], w3 = cw[3 * 1536 + cg_], w4 = cw[4 * 1536 + cg_];
            const LAS bf16_t* rp = raw + (hf * 64) * 256 + ch;
            float r0 = bf2f(rp[0 * 256]), r1 = bf2f(rp[1 * 256]), r2 = bf2f(rp[2 * 256]), r3 = bf2f(rp[3 * 256]);
            unsigned ov[32];
#pragma unroll
            for (int i = 0; i < 64; ++i) {
                const float r4 = bf2f(rp[(i + 4) * 256]);
                float a = cb; a = fmaf(w0, r0, a); a = fmaf(w1, r1, a); a = fmaf(w2, r2, a); a = fmaf(w3, r3, a); a = fmaf(w4, r4, a);
                const unsigned hv = f2bf(a * sigmoidf_(a));
                if (i & 1) ov[i >> 1] |= hv << 16; else ov[i >> 1] = hv;
                r0 = r1; r1 = r2; r2 = r3; r3 = r4;
            }
            if (part <= 4) {
                bf16_t* dst = (part < 4 ? (bf16_t*)(ws + WS_XT) + ((size_t)(b * 64 + ch_) * 16 + part * 4) * 64 * 128
                                        : (bf16_t*)(ws + WS_BMT) + (size_t)(b * 64 + ch_) * 2 * 128 * 128) + (size_t)ch * 128 + hf * 64;
#pragma unroll
                for (int q = 0; q < 8; ++q) *(u32x4*)(dst + q * 8) = (u32x4){ov[4 * q], ov[4 * q + 1], ov[4 * q + 2], ov[4 * q + 3]};
            }
            if (part >= 4) {
#pragma unroll
                for (int i = 0; i < 64; ++i) outb[(hf * 64 + i) * 256 + ch] = (bf16_t)((i & 1) ? (ov[i >> 1] >> 16) : (ov[i >> 1] & 0xffffu));
            }
        }
        if (part >= 4) {
            __syncthreads();
            bf16_t* dst = (bf16_t*)(ws + (part == 4 ? WS_BMR : WS_CMR)) + (size_t)(b * S + t0) * 256;
#pragma unroll
            for (int q = 0; q < 8; ++q) { const int idx = tid + 512 * q, l = idx >> 5, c8 = idx & 31;
                *(u32x4*)(dst + (size_t)l * 256 + c8 * 8) = *(const LAS u32x4*)(outb + l * 256 + c8 * 8); }
        }
    }
    {
        const int gw = c.bid * 8 + c.wave, NGW = c.G * 8, lane = c.lane;
        const float* rc = (const float*)(ws + WS_ROPE); const float* rs = rc + 4096;
        const int sub = lane >> 4, j = lane & 15, axis = j >> 3, i0 = 8 * (j & 3); const bool second = (j & 4) != 0;
        const f32x4 gq0 = *(const f32x4*)(p.in[11] + 8 * j), gq1 = *(const f32x4*)(p.in[11] + 8 * j + 4), gk0 = *(const f32x4*)(p.in[12] + 8 * j), gk1 = *(const f32x4*)(p.in[12] + 8 * j + 4);
        unsigned char* QN = ws + WS_QN; unsigned char* KN = ws + WS_KN;
        for (int base0 = gw; base0 < M * 10 / 4; base0 += 4 * NGW) {
            u32x4 vq[4]; int tokq[4], hhq[4];
#pragma unroll
            for (int u = 0; u < 4; ++u) { const int base = base0 + u * NGW, it = base * 4 + sub; tokq[u] = it / 10; hhq[u] = it % 10;
                vq[u] = (u32x4){0u, 0u, 0u, 0u};
                if (base < M * 10 / 4) vq[u] = __builtin_nontemporal_load((const u32x4*)(P + (size_t)tokq[u] * NPROJ + (hhq[u] < 8 ? PQ + hhq[u] * 128 : PK + (hhq[u] - 8) * 128) + 8 * j)); }
#pragma unroll
            for (int u = 0; u < 4; ++u) {
                const int base = base0 + u * NGW, tok = tokq[u], hh = hhq[u];
                unsigned char* dst = (hh < 8 ? QN + (size_t)tok * 1024 + hh * 128 : KN + (size_t)tok * 256 + (hh - 8) * 128) + 8 * j;
                const u32x4 v = vq[u];
                float y[8] = {bflo(v.x), bfhi(v.x), bflo(v.y), bfhi(v.y), bflo(v.z), bfhi(v.z), bflo(v.w), bfhi(v.w)};
                float ss = 0.f;
#pragma unroll
                for (int i = 0; i < 8; ++i) ss = fmaf(y[i], y[i], ss);
                ss += DPPF_(ss, 0xB1, 0xf); ss += DPPF_(ss, 0x4E, 0xf); ss += DPPF_(ss, 0x141, 0xf); ss += DPPF_(ss, 0x140, 0xf);
                const float rstd = rsqrtf(ss * (1.f / 128.f) + EPS);
                const f32x4 g0 = hh < 8 ? gq0 : gk0, g1 = hh < 8 ? gq1 : gk1;
#pragma unroll
                for (int i = 0; i < 4; ++i) { y[i] *= rstd * g0[i]; y[4 + i] *= rstd * g1[i]; }
                const int s = tok & (S - 1), pos = axis ? (s & 63) : (s >> 6);
                const f32x4 c0 = *(const f32x4*)(rc + pos * 32 + i0), c1 = *(const f32x4*)(rc + pos * 32 + i0 + 4), s0 = *(const f32x4*)(rs + pos * 32 + i0), s1 = *(const f32x4*)(rs + pos * 32 + i0 + 4);
                float o[8];
#pragma unroll
                for (int i = 0; i < 8; ++i) { const float up_ = DPPF_(y[i], 0x104, 0xf), dn_ = DPPF_(y[i], 0x114, 0xf); const float other = second ? dn_ : up_;     const float cs = i < 4 ? c0[i] : c1[i - 4], sn = i < 4 ? s0[i] : s1[i - 4];
                    o[i] = second ? fmaf(other, sn, y[i] * cs) : fmaf(-other, sn, y[i] * cs); }
                u32x2 w; w.x = pack4_fp8(o[0], o[1], o[2], o[3]); w.y = pack4_fp8(o[4], o[5], o[6], o[7]);
                if (base < M * 10 / 4) *(u32x2*)dst = w;
            }
        }
    }
    {
        unsigned char* VT8 = ws + WS_VB; LAS unsigned char* vt = c.lds;
        const bool vsplit = false;
        for (int it = vsplit ? (c.bid >= 128 ? c.bid - 128 : 256) : c.bid; it < 256; it += vsplit ? 128 : c.G) {
            const int b = it >> 7, jt = it & 127;
            __syncthreads();
            u32x4 vv[4];
#pragma unroll
            for (int q = 0; q < 4; ++q) { const int idx = tid + 512 * q, key = idx >> 5, c8 = idx & 31; vv[q] = __builtin_nontemporal_load((const u32x4*)(P + ((size_t)b * S + jt * 64 + key) * NPROJ + PV + c8 * 8)); }
#pragma unroll
            for (int q = 0; q < 4; ++q) { const int idx = tid + 512 * q, key = idx >> 5, c8 = idx & 31, d0 = c8 * 8;
                const int off = 32 * ((key >> 2) & 1) + 16 * (key >> 5) + (key & 3) + 4 * ((key & 31) >> 3);
                const unsigned w0 = pack4_fp8(bflo(vv[q].x), bfhi(vv[q].x), bflo(vv[q].y), bfhi(vv[q].y)), w1 = pack4_fp8(bflo(vv[q].z), bfhi(vv[q].z), bflo(vv[q].w), bfhi(vv[q].w));
                LAS unsigned char* dp = vt + d0 * 64 + off;
                dp[0 * 64] = (unsigned char)(w0); dp[1 * 64] = (unsigned char)(w0 >> 8); dp[2 * 64] = (unsigned char)(w0 >> 16); dp[3 * 64] = (unsigned char)(w0 >> 24);
                dp[4 * 64] = (unsigned char)(w1); dp[5 * 64] = (unsigned char)(w1 >> 8); dp[6 * 64] = (unsigned char)(w1 >> 16); dp[7 * 64] = (unsigned char)(w1 >> 24); }
            __syncthreads();
#pragma unroll
            for (int q = 0; q < 2; ++q) { const int idx = tid + 512 * q, kvh = idx >> 9, rem = idx & 511;
                *(u32x4*)(VT8 + ((size_t)(b * 2 + kvh) * 128 + jt) * 8192 + rem * 16) = *(const LAS u32x4*)(vt + kvh * 8192 + rem * 16); }
        }
        __syncthreads();
    }
}

typedef short bf16x8 __attribute__((ext_vector_type(8)));
typedef float f32x16 __attribute__((ext_vector_type(16)));
constexpr int TS = 136;
__device__ __forceinline__ bf16x8 ldfrag(const LAS bf16_t* tile, int row, int k0) { return *(const LAS bf16x8*)(tile + row * TS + k0); }
template <int ROWS> __device__ __forceinline__ void load_tile128(LAS bf16_t* dst, const bf16_t* src, int ld, int tid) {
    constexpr int N = ROWS * 16 / 512;
    u32x4 v[N];
#pragma unroll
    for (int i = 0; i < N; ++i) { const int idx = tid + 512 * i; v[i] = *(const u32x4*)(src + (size_t)(idx >> 4) * ld + (idx & 15) * 8); }
#pragma unroll
    for (int i = 0; i < N; ++i) { const int idx = tid + 512 * i; *(LAS u32x4*)(dst + (idx >> 4) * TS + (idx & 15) * 8) = v[i]; }
}
__device__ __forceinline__ void phase_ssd_states(const Params& p, const Ctx& c) {
    unsigned char* ws = p.ws;
    const bf16_t* XT = (const bf16_t*)(ws + WS_XT); const bf16_t* BMT = (const bf16_t*)(ws + WS_BMT);
    const float* DT = (const float*)(ws + WS_DT); const float* ACS = (const float*)(ws + WS_ACS); bf16_t* ST = (bf16_t*)(ws + WS_PREV);
    LAS bf16_t* BTs = (LAS bf16_t*)c.lds; LAS bf16_t* XTf = BTs + 128 * TS; LAS bf16_t* XTb = XTf + 64 * TS; LAS float* wd = (LAS float*)(XTb + 64 * TS);
    const int tid = c.tid, lane = c.lane, r = lane & 31, hh = lane >> 5;
    for (int unit = c.bid; unit < 256; unit += c.G) {
        const int b = unit >> 7, ch = (unit >> 1) & 63, g = unit & 1;
        __syncthreads();
        load_tile128<128>(BTs, BMT + ((size_t)(b * 64 + ch) * 2 + g) * 128 * 128, 128, tid);
        u32x4 xv0, xv1; float pacs = 0.f, pdt = 0.f, paend = 0.f;
        const int wd_d = (tid >> 7) & 1, wd_l = tid & 127; const size_t wd_t0 = (size_t)wd_d * M + (size_t)b * S + ch * 128;
#define S1_PREFETCH(H) do { const bf16_t* xt_ = XT + ((size_t)(b * 64 + ch) * 16 + (H)) * 64 * 128; \
            xv0 = *(const u32x4*)(xt_ + (tid >> 4) * 128 + (tid & 15) * 8); xv1 = *(const u32x4*)(xt_ + ((tid + 512) >> 4) * 128 + (tid & 15) * 8); \
            if (tid < 256) { pacs = ACS[(wd_t0 + wd_l) * 16 + (H)]; pdt = DT[(wd_t0 + wd_l) * 16 + (H)]; paend = ACS[(wd_t0 + (wd_d ? 0 : 127)) * 16 + (H)]; } } while (0)
        S1_PREFETCH(g * 8);
#pragma unroll 1
        for (int h8 = 0; h8 < 8; ++h8) {
            const int h = g * 8 + h8;
            __syncthreads();
            if (tid < 256) wd[wd_d * 128 + wd_l] = pdt * __expf(paend - pacs);
            __syncthreads();
            {
                const u32x4 vv[2] = {xv0, xv1};
#pragma unroll
                for (int i = 0; i < 2; ++i) { const int idx = tid + 512 * i, pr = idx >> 4, l0 = (idx & 15) * 8; const u32x4 v = vv[i];
                    const float x[8] = {bflo(v.x), bfhi(v.x), bflo(v.y), bfhi(v.y), bflo(v.z), bfhi(v.z), bflo(v.w), bfhi(v.w)};
                    const f32x4 wf0 = *(const LAS f32x4*)(wd + l0), wf1 = *(const LAS f32x4*)(wd + l0 + 4), wb0 = *(const LAS f32x4*)(wd + 128 + l0), wb1 = *(const LAS f32x4*)(wd + 128 + l0 + 4);
                    u32x4 of, ob;
                    of.x = pk2(x[0] * wf0[0], x[1] * wf0[1]); of.y = pk2(x[2] * wf0[2], x[3] * wf0[3]); of.z = pk2(x[4] * wf1[0], x[5] * wf1[1]); of.w = pk2(x[6] * wf1[2], x[7] * wf1[3]);
                    ob.x = pk2(x[0] * wb0[0], x[1] * wb0[1]); ob.y = pk2(x[2] * wb0[2], x[3] * wb0[3]); ob.z = pk2(x[4] * wb1[0], x[5] * wb1[1]); ob.w = pk2(x[6] * wb1[2], x[7] * wb1[3]);
                    *(LAS u32x4*)(XTf + pr * TS + l0) = of; *(LAS u32x4*)(XTb + pr * TS + l0) = ob; }
            }
            if (h8 < 7) S1_PREFETCH(h + 1);
            __syncthreads();
            { const int d = c.wave >> 2, nb = c.wave & 3; const LAS bf16_t* XTd = d ? XTb : XTf;
              bf16_t* st = ST + ((((size_t)(d * 2 + b) * 64 + ch) * 16 + h) * 64) * 128;
#pragma unroll
              for (int pb = 0; pb < 2; ++pb) { f32x16 acc = {};
#pragma unroll
                for (int ks = 0; ks < 8; ++ks) acc = __builtin_amdgcn_mfma_f32_32x32x16_bf16(ldfrag(XTd, pb * 32 + r, ks * 16 + 8 * hh), ldfrag(BTs, nb * 32 + r, ks * 16 + 8 * hh), acc, 0, 0, 0);
#pragma unroll
                for (int i = 0; i < 16; ++i) { const int pp = pb * 32 + (i & 3) + 8 * (i >> 2) + 4 * hh; st[(size_t)pp * 128 + nb * 32 + r] = (bf16_t)f2bf(acc[i]); } } }
        }
#undef S1_PREFETCH
    }
}
__device__ __forceinline__ void phase_ssd_scan(const Params& p, const Ctx& c) {
    unsigned char* ws = p.ws;
    const float* CDEC = (const float*)(ws + WS_CDEC); bf16_t* PREV = (bf16_t*)(ws + WS_PREV);
    for (int idx = c.bid * 512 + c.tid; idx < 131072; idx += c.G * 512) {
        const int n4 = idx & 31, pp = (idx >> 5) & 63, h = (idx >> 11) & 15, b = (idx >> 15) & 1, d = idx >> 16;
        f32x4 run = {0.f, 0.f, 0.f, 0.f};
        const size_t obase = ((size_t)(d * 2 + b) * 64 * 16 + h) * 64 * 128 + (size_t)pp * 128 + n4 * 4;
        const float* cd = CDEC + (d * 2 + b) * 64 * 16 + h;
#pragma unroll 1
        for (int s0 = 0; s0 < 64; s0 += 16) {
            u32x2 sv[16]; float dec[16];
#pragma unroll
            for (int i = 0; i < 16; ++i) { const int ch = d ? 63 - (s0 + i) : s0 + i; sv[i] = __builtin_nontemporal_load((const u32x2*)(PREV + obase + (size_t)ch * (16 * 64 * 128))); dec[i] = cd[ch * 16]; }
#pragma unroll
            for (int i = 0; i < 16; ++i) { const int ch = d ? 63 - (s0 + i) : s0 + i;
                u32x2 w; w.x = pk2(run.x, run.y); w.y = pk2(run.z, run.w); *(u32x2*)(PREV + obase + (size_t)ch * (16 * 64 * 128)) = w;
                run.x = fmaf(run.x, dec[i], bflo(sv[i].x)); run.y = fmaf(run.y, dec[i], bfhi(sv[i].x)); run.z = fmaf(run.z, dec[i], bflo(sv[i].y)); run.w = fmaf(run.w, dec[i], bfhi(sv[i].y)); }
        }
    }
}
__device__ __forceinline__ void phase_ssd_out(const Params& p, const Ctx& c) {
    unsigned char* ws = p.ws;
    const bf16_t* P = (const bf16_t*)(ws + WS_P); const bf16_t* XT = (const bf16_t*)(ws + WS_XT);
    const bf16_t* BMR = (const bf16_t*)(ws + WS_BMR); const bf16_t* CMR = (const bf16_t*)(ws + WS_CMR); const bf16_t* PREV = (const bf16_t*)(ws + WS_PREV);
    const float* DT = (const float*)(ws + WS_DT); const float* ACS = (const float*)(ws + WS_ACS); bf16_t* YZ = (bf16_t*)(ws + WS_YZ);
    LAS bf16_t* Cs = (LAS bf16_t*)c.lds; LAS bf16_t* Ms = Cs + 128 * TS; LAS bf16_t* XTs = Ms + 128 * TS; LAS bf16_t* PF = XTs + 64 * TS; LAS bf16_t* PB = PF + 64 * TS;
    LAS float* vec = (LAS float*)(PB + 64 * TS);
    constexpr int ZS = 72; LAS bf16_t* Zs = (LAS bf16_t*)(vec + 512); LAS float* dskl = (LAS float*)(Zs + 128 * ZS);
    const int tid = c.tid, lane = c.lane, r = lane & 31, hh = lane >> 5, wave = c.wave;
    for (int unit = c.bid; unit < 256; unit += c.G) {
        const int b = unit >> 7, ch = (unit >> 1) & 63, g = unit & 1;
        const size_t tok0 = (size_t)b * S + ch * 128;
        __syncthreads();
        load_tile128<128>(Cs, CMR + tok0 * 256 + g * 128, 256, tid);
        load_tile128<128>(Ms, BMR + tok0 * 256 + g * 128, 256, tid);
        u32x4 px0, px1, pf0, pf1, pb0, pb1, pz0, pz1; float pvec;
        const int t_r0 = tid >> 4, t_r1 = (tid + 512) >> 4, t_c = (tid & 15) * 8;
        const __amdgpu_buffer_rsrc_t rX_ = __builtin_amdgcn_make_buffer_rsrc((void*)XT, 0, 0x7fffffff, 0x00020000), rP_ = __builtin_amdgcn_make_buffer_rsrc((void*)PREV, 0, 0x7fffffff, 0x00020000),
                                     rZ_ = __builtin_amdgcn_make_buffer_rsrc((void*)P, 0, 0x7fffffff, 0x00020000);
        const int lo0_ = (t_r0 * 128 + t_c) * 2, lo1_ = (t_r1 * 128 + t_c) * 2, zo_ = (int)(((tok0 + (tid >> 3)) * NPROJ + PZ + (tid & 7) * 8) * 2);
#define S3_LD_(r, o) __builtin_bit_cast(u32x4, __builtin_amdgcn_raw_buffer_load_b128((r), (o), 0, 2))
#define S3_PREFETCH(H) do { const int xo_ = (((b * 64 + ch) * 16 + (H)) * 64 * 128) * 2, fo_ = (((((0 * 2 + b) * 64 + ch) * 16 + (H)) * 64) * 128) * 2, bo_ = (((((1 * 2 + b) * 64 + ch) * 16 + (H)) * 64) * 128) * 2; \
            px0 = S3_LD_(rX_, xo_ + lo0_); px1 = S3_LD_(rX_, xo_ + lo1_); pf0 = S3_LD_(rP_, fo_ + lo0_); pf1 = S3_LD_(rP_, fo_ + lo1_); pb0 = S3_LD_(rP_, bo_ + lo0_); pb1 = S3_LD_(rP_, bo_ + lo1_); \
            pz0 = S3_LD_(rZ_, zo_ + (H) * 128); pz1 = S3_LD_(rZ_, zo_ + 64 * NPROJ * 2 + (H) * 128); \
            { const int v_ = tid >> 7, l_ = tid & 127; const size_t o_ = ((size_t)(v_ & 1) * M + tok0 + l_) * 16 + (H); pvec = (v_ < 2) ? ACS[o_] : DT[o_]; } } while (0)
        S3_PREFETCH(g * 8);
        if (tid < 8) dskl[tid] = p.in[9][g * 8 + tid];
        __syncthreads();
        const int lb = wave & 3, sb0 = 2 * (wave >> 2);
        f32x16 G0 = {}, G1 = {};
#pragma unroll
        for (int ks = 0; ks < 8; ++ks) { const bf16x8 a = ldfrag(Cs, lb * 32 + r, ks * 16 + 8 * hh);
            G0 = __builtin_amdgcn_mfma_f32_32x32x16_bf16(a, ldfrag(Ms, sb0 * 32 + r, ks * 16 + 8 * hh), G0, 0, 0, 0);
            G1 = __builtin_amdgcn_mfma_f32_32x32x16_bf16(a, ldfrag(Ms, (sb0 + 1) * 32 + r, ks * 16 + 8 * hh), G1, 0, 0, 0); }
        float ssq0 = 0.f, ssq1 = 0.f;
#pragma unroll 1
        for (int h8 = 0; h8 < 8; ++h8) {
            const int h = g * 8 + h8;
            __syncthreads();
            vec[tid] = pvec;
            *(LAS u32x4*)(XTs + t_r0 * TS + t_c) = px0; *(LAS u32x4*)(XTs + t_r1 * TS + t_c) = px1;
            *(LAS u32x4*)(PF + t_r0 * TS + t_c) = pf0; *(LAS u32x4*)(PF + t_r1 * TS + t_c) = pf1;
            *(LAS u32x4*)(PB + t_r0 * TS + t_c) = pb0; *(LAS u32x4*)(PB + t_r1 * TS + t_c) = pb1;
            *(LAS u32x4*)(Zs + (tid >> 3) * ZS + (tid & 7) * 8) = pz0; *(LAS u32x4*)(Zs + (64 + (tid >> 3)) * ZS + (tid & 7) * 8) = pz1;
            if (h8 < 7) S3_PREFETCH(h + 1);
            const int pbY = wave >> 2;
            __syncthreads();
#pragma unroll
            for (int t2 = 0; t2 < 2; ++t2) { const f32x16& Gt = t2 ? G1 : G0; const int sb = sb0 + t2, s = sb * 32 + r;
                const float afs = vec[s], abs_ = vec[128 + s], dfs = vec[256 + s], dbs = vec[384 + s];
                if (sb < lb) {
#pragma unroll
                    for (int i = 0; i < 16; ++i) { const int l = lb * 32 + (i & 3) + 8 * (i >> 2) + 4 * hh;
                        Ms[l * TS + s] = (bf16_t)f2bf(Gt[i] * __expf(vec[l] - afs) * dfs); }
                } else if (sb > lb) {
#pragma unroll
                    for (int i = 0; i < 16; ++i) { const int l = lb * 32 + (i & 3) + 8 * (i >> 2) + 4 * hh;
                        Ms[l * TS + s] = (bf16_t)f2bf(Gt[i] * __expf(vec[128 + l] - abs_) * dbs); }
                } else {
                    const float dsk = dskl[h8];
                    int sq = s; asm volatile("" : "+v"(sq));
#pragma unroll
                    for (int i = 0; i < 16; ++i) { const int l = lb * 32 + (i & 3) + 8 * (i >> 2) + 4 * hh;
                        const float ef = __expf(fminf(vec[l] - afs, 0.f)) * dfs, eb = __expf(fminf(vec[128 + l] - abs_, 0.f)) * dbs;
                        const float tf = (sq <= l) ? ef : 0.f, tb = (sq >= l) ? eb : 0.f;
                        Ms[l * TS + s] = (bf16_t)f2bf(Gt[i] * (tf + tb) + (sq == l ? dsk : 0.f)); }
                } }
            __syncthreads();
            { f32x16 Yd = {}, Yf = {}, Yb = {};
              bf16x8 fm = ldfrag(Ms, lb * 32 + r, 8 * hh), fx = ldfrag(XTs, pbY * 32 + r, 8 * hh), fc = ldfrag(Cs, lb * 32 + r, 8 * hh), ff = ldfrag(PF, pbY * 32 + r, 8 * hh), fb = ldfrag(PB, pbY * 32 + r, 8 * hh);
#pragma unroll
              for (int ks = 0; ks < 8; ++ks) { const int k1 = (ks < 7 ? ks + 1 : 7) * 16 + 8 * hh;
                  const bf16x8 nm = ldfrag(Ms, lb * 32 + r, k1), nx = ldfrag(XTs, pbY * 32 + r, k1), nc = ldfrag(Cs, lb * 32 + r, k1), nf = ldfrag(PF, pbY * 32 + r, k1), nb = ldfrag(PB, pbY * 32 + r, k1);
                  __builtin_amdgcn_sched_barrier(0);
                  Yd = __builtin_amdgcn_mfma_f32_32x32x16_bf16(fm, fx, Yd, 0, 0, 0);
                  Yf = __builtin_amdgcn_mfma_f32_32x32x16_bf16(fc, ff, Yf, 0, 0, 0);
                  Yb = __builtin_amdgcn_mfma_f32_32x32x16_bf16(fc, fb, Yb, 0, 0, 0);
                  __builtin_amdgcn_sched_barrier(0);
                  fm = nm; fx = nx; fc = nc; ff = nf; fb = nb; }
#pragma unroll
              for (int i = 0; i < 16; ++i) { const int l = lb * 32 + (i & 3) + 8 * (i >> 2) + 4 * hh;
                  const float y = Yd[i] + __expf(vec[l]) * Yf[i] + __expf(vec[128 + l]) * Yb[i];
                  const float z = bf2f(Zs[l * ZS + pbY * 32 + r]);
                  Zs[l * ZS + pbY * 32 + r] = (bf16_t)f2bf(y * z * sigmoidf_(z)); } }
            __syncthreads();
            { const u32x4 y0 = *(const LAS u32x4*)(Zs + (tid >> 3) * ZS + (tid & 7) * 8), y1 = *(const LAS u32x4*)(Zs + (64 + (tid >> 3)) * ZS + (tid & 7) * 8);
              *(u32x4*)(YZ + (tok0 + (tid >> 3)) * 1024 + h * 64 + (tid & 7) * 8) = y0;
              *(u32x4*)(YZ + (tok0 + 64 + (tid >> 3)) * 1024 + h * 64 + (tid & 7) * 8) = y1;
              ssq0 += (bflo(y0.x) * bflo(y0.x) + bfhi(y0.x) * bfhi(y0.x)) + (bflo(y0.y) * bflo(y0.y) + bfhi(y0.y) * bfhi(y0.y)) + (bflo(y0.z) * bflo(y0.z) + bfhi(y0.z) * bfhi(y0.z)) + (bflo(y0.w) * bflo(y0.w) + bfhi(y0.w) * bfhi(y0.w));
              ssq1 += (bflo(y1.x) * bflo(y1.x) + bfhi(y1.x) * bfhi(y1.x)) + (bflo(y1.y) * bflo(y1.y) + bfhi(y1.y) * bfhi(y1.y)) + (bflo(y1.z) * bflo(y1.z) + bfhi(y1.z) * bfhi(y1.z)) + (bflo(y1.w) * bflo(y1.w) + bfhi(y1.w) * bfhi(y1.w)); }
        }
        ssq0 += __shfl_xor(ssq0, 1); ssq1 += __shfl_xor(ssq1, 1); ssq0 += __shfl_xor(ssq0, 2); ssq1 += __shfl_xor(ssq1, 2); ssq0 += __shfl_xor(ssq0, 4); ssq1 += __shfl_xor(ssq1, 4);
        if ((tid & 7) == 0) { float* SSQ = (float*)(ws + WS_RSTD); SSQ[(tok0 + (tid >> 3)) * 2 + g] = ssq0; SSQ[(tok0 + 64 + (tid >> 3)) * 2 + g] = ssq1; }
#undef S3_PREFETCH
#undef S3_LD_
    }
}


namespace attn8 {
typedef int v8i __attribute__((ext_vector_type(8)));
typedef float f32x16 __attribute__((ext_vector_type(16)));
typedef unsigned u32x4_ __attribute__((ext_vector_type(4)));
constexpr int QBLK = 32, KVBLK = 64;
constexpr float SCALE = 0.088388347648318440f;
constexpr float THR = 2.55f;
constexpr float PBASE = 5.f;
constexpr size_t SHM_K = 64 * 128, SHM_V = 128 * 64, SHM_ATTN = 2 * SHM_K + 2 * SHM_V + 8 * 64 * 4;
__device__ __forceinline__ int crow(int r, int hi) { return (r & 3) + 8 * (r >> 2) + 4 * hi; }
__device__ __forceinline__ int kswz(int row, int colB) { return row * 128 + (colB ^ (((row >> 1) & 7) << 4)); }
__device__ __forceinline__ int vswz(int d, int slot) { return d * 64 + ((slot ^ ((d >> 2) & 3)) << 4); }
__device__ __forceinline__ v8i cat8(const u32x4_& lo, const u32x4_& hi) { v8i r; r[0] = (int)lo.x; r[1] = (int)lo.y; r[2] = (int)lo.z; r[3] = (int)lo.w; r[4] = (int)hi.x; r[5] = (int)hi.y; r[6] = (int)hi.z; r[7] = (int)hi.w; return r; }
template <bool LAST> __device__ __forceinline__ void mfma8(f32x16& acc, const v8i& a, const v8i& b, int scl) {
    acc = __builtin_amdgcn_mfma_scale_f32_32x32x64_f8f6f4(a, b, acc, 0, 0, 0, scl, 0, scl);
}
typedef float f32x2_ __attribute__((ext_vector_type(2)));
__device__ __forceinline__ float max3_(float a, float b, float c) { return fmaxf(fmaxf(a, b), c); }
__device__ __forceinline__ unsigned pack4t_(float a, float b, float c, float d, unsigned old) { const unsigned w = __builtin_amdgcn_cvt_pk_fp8_f32(a, b, old, false); return __builtin_amdgcn_cvt_pk_fp8_f32(c, d, w, true); }
__device__ __forceinline__ unsigned pack4s_(float a, float b, float c, float d) { unsigned w = __builtin_amdgcn_cvt_pk_fp8_f32(a, b, __float_as_uint(a), false); return __builtin_amdgcn_cvt_pk_fp8_f32(c, d, w, true); }
__device__ __forceinline__ void partialSM(f32x16& p0, f32x16& p1, float& m_reg, float& mn, float& alpha) {
    constexpr float C = SCALE * 1.4426950408889634f;
    float pmax = max3_(p0[0], p0[1], p0[2]);
#pragma unroll
    for (int r = 3; r < 15; r += 2) pmax = max3_(pmax, p0[r], p0[r + 1]);
    pmax = max3_(pmax, p0[15], p1[0]);
#pragma unroll
    for (int r = 1; r < 15; r += 2) pmax = max3_(pmax, p1[r], p1[r + 1]);
    pmax = max3_(pmax, p1[15], p1[15]);
    { auto rr = __builtin_amdgcn_permlane32_swap(__float_as_uint(pmax), __float_as_uint(pmax), false, false); pmax = max3_(__uint_as_float(rr[0]), __uint_as_float(rr[1]), __uint_as_float(rr[1])); }
    if (__builtin_expect(__all(pmax - m_reg <= THR / SCALE), 1)) { mn = m_reg; alpha = 1.f; }
    else { mn = fmaxf(m_reg, pmax); alpha = __builtin_amdgcn_exp2f((m_reg - mn) * C); m_reg = mn; }
    const float mnC = PBASE - mn * C;
    const f32x2_ C2 = {C, C}, M2 = {mnC, mnC};
#pragma unroll
    for (int r = 0; r < 16; r += 2) { f32x2_ t = {p0[r], p0[r + 1]}; t = __builtin_elementwise_fma(t, C2, M2); p0[r] = t.x; p0[r + 1] = t.y; }
#pragma unroll
    for (int r = 0; r < 16; r += 2) { f32x2_ t = {p1[r], p1[r + 1]}; t = __builtin_elementwise_fma(t, C2, M2); p1[r] = t.x; p1[r + 1] = t.y; }
#pragma unroll
    for (int r = 0; r < 16; ++r) p0[r] = __builtin_amdgcn_exp2f(p0[r]);
}
__device__ __forceinline__ void finishSM(f32x16& p0, f32x16& p1, float alpha, float& l_reg, v8i& pa) {
#pragma unroll
    for (int r = 0; r < 16; ++r) p1[r] = __builtin_amdgcn_exp2f(p1[r]);
    f32x2_ s0 = {p0[0], p0[1]}, s1 = {p1[0], p1[1]};
#pragma unroll
    for (int r = 2; r < 16; r += 2) { s0 += (f32x2_){p0[r], p0[r + 1]}; s1 += (f32x2_){p1[r], p1[r + 1]}; }
    s0 += s1; float ps = s0.x + s0.y;
    { auto rr = __builtin_amdgcn_permlane32_swap(__float_as_uint(ps), __float_as_uint(ps), false, false); ps = __uint_as_float(rr[0]) + __uint_as_float(rr[1]); }
    l_reg = l_reg * alpha + ps;
#pragma unroll
    for (int w = 0; w < 4; ++w) { pa[w] = (int)pack4s_(p0[4 * w], p0[4 * w + 1], p0[4 * w + 2], p0[4 * w + 3]); pa[4 + w] = (int)pack4s_(p1[4 * w], p1[4 * w + 1], p1[4 * w + 2], p1[4 * w + 3]); }
}
__device__ __forceinline__ void qkt(f32x16& p0, f32x16& p1, const char* Ks, const v8i* qf, int r32, int hi, int scl) {
    p0 = f32x16{}; p1 = f32x16{};
#pragma unroll
    for (int s = 0; s < 2; ++s) { const int cb = 64 * s + 32 * hi;
        const v8i a0 = cat8(*(const u32x4_*)(Ks + kswz(r32, cb)), *(const u32x4_*)(Ks + kswz(r32, cb + 16)));
        const v8i a1 = cat8(*(const u32x4_*)(Ks + kswz(32 + r32, cb)), *(const u32x4_*)(Ks + kswz(32 + r32, cb + 16)));
        if (s == 0) { mfma8<false>(p0, a0, qf[s], scl); mfma8<false>(p1, a1, qf[s], scl); }
        else { mfma8<false>(p0, a0, qf[s], scl); mfma8<true>(p1, a1, qf[s], scl); } }
}
__device__ __forceinline__ void pv(f32x16* o, const char* Vs, const v8i& pa, int r32, int hi, int scl) {
#pragma unroll
    for (int d0 = 0; d0 < 4; ++d0) { const int d = d0 * 32 + r32;
        const v8i b = cat8(*(const u32x4_*)(Vs + vswz(d, 2 * hi)), *(const u32x4_*)(Vs + vswz(d, 2 * hi + 1)));
        if (d0 == 3) mfma8<true>(o[d0], pa, b, scl); else mfma8<false>(o[d0], pa, b, scl); }
}
#define SB_() __builtin_amdgcn_sched_barrier(0)
#define LDF_(p) (*(const u32x4_*)(p))
__device__ __forceinline__ void stepA(f32x16& q0, f32x16& q1, f32x16& p0, f32x16& p1, float alpha, float& l_reg, v8i& pa, v8i* ka, v8i* vb, const char* Kn, const char* Vs, const v8i* qf, int r32, int hi, int scl) {
    ka[2] = cat8(LDF_(Kn + kswz(r32, 64 + 32 * hi)), LDF_(Kn + kswz(r32, 64 + 32 * hi + 16))); ka[3] = cat8(LDF_(Kn + kswz(32 + r32, 64 + 32 * hi)), LDF_(Kn + kswz(32 + r32, 64 + 32 * hi + 16)));
    SB_();
#pragma unroll
    for (int r = 0; r < 8; ++r) p1[r] = __builtin_amdgcn_exp2f(p1[r]);
    SB_();
    q0 = __builtin_amdgcn_mfma_scale_f32_32x32x64_f8f6f4(ka[0], qf[0], f32x16{}, 0, 0, 0, scl, 0, scl);
#pragma unroll
    for (int r = 8; r < 16; ++r) p1[r] = __builtin_amdgcn_exp2f(p1[r]);
    SB_();
    q1 = __builtin_amdgcn_mfma_scale_f32_32x32x64_f8f6f4(ka[1], qf[0], f32x16{}, 0, 0, 0, scl, 0, scl);
#pragma unroll
    for (int d0 = 0; d0 < 2; ++d0) vb[d0] = cat8(LDF_(Vs + vswz(d0 * 32 + r32, 2 * hi)), LDF_(Vs + vswz(d0 * 32 + r32, 2 * hi + 1)));
    float s0 = p0[0] + p0[1], s1 = p0[2] + p0[3], s2 = p1[0] + p1[1], s3 = p1[2] + p1[3];
#pragma unroll
    for (int r = 4; r < 16; r += 4) { s0 += p0[r]; s1 += p0[r + 1]; s2 += p1[r]; s3 += p1[r + 1]; s0 += p0[r + 2]; s1 += p0[r + 3]; s2 += p1[r + 2]; s3 += p1[r + 3]; }
    float ps = (s0 + s1) + (s2 + s3);
    { auto rr = __builtin_amdgcn_permlane32_swap(__float_as_uint(ps), __float_as_uint(ps), false, false); ps = __uint_as_float(rr[0]) + __uint_as_float(rr[1]); }
    l_reg = l_reg * alpha + ps;
    SB_();
    q0 = __builtin_amdgcn_mfma_scale_f32_32x32x64_f8f6f4(ka[2], qf[1], q0, 0, 0, 0, scl, 0, scl);
#pragma unroll
    for (int w = 0; w < 4; ++w) { unsigned u0, u1; asm("" : "=v"(u0)); asm("" : "=v"(u1));
        pa[w] = (int)pack4t_(p0[4 * w], p0[4 * w + 1], p0[4 * w + 2], p0[4 * w + 3], u0); pa[4 + w] = (int)pack4t_(p1[4 * w], p1[4 * w + 1], p1[4 * w + 2], p1[4 * w + 3], u1); }
    SB_();
    q1 = __builtin_amdgcn_mfma_scale_f32_32x32x64_f8f6f4(ka[3], qf[1], q1, 0, 0, 0, scl, 0, scl);
    SB_();
}
__device__ __forceinline__ void stepB(f32x16* o, v8i* vb, v8i* ka, const char* Kn, const char* Vs, const v8i& pa, f32x16& q0, f32x16& q1, float& m_reg, float& alpha, int r32, int hi, int scl) {
    constexpr float C = SCALE * 1.4426950408889634f;
#pragma unroll
    for (int d0 = 2; d0 < 4; ++d0) vb[d0] = cat8(LDF_(Vs + vswz(d0 * 32 + r32, 2 * hi)), LDF_(Vs + vswz(d0 * 32 + r32, 2 * hi + 1)));
    SB_();
    o[0] = __builtin_amdgcn_mfma_scale_f32_32x32x64_f8f6f4(pa, vb[0], o[0], 0, 0, 0, scl, 0, scl);
    float pmax = -INFINITY;
#pragma unroll
    for (int r = 0; r < 16; r += 2) pmax = max3_(pmax, q0[r], q0[r + 1]);
#pragma unroll
    for (int r = 0; r < 16; r += 2) pmax = max3_(pmax, q1[r], q1[r + 1]);
    SB_();
    o[1] = __builtin_amdgcn_mfma_scale_f32_32x32x64_f8f6f4(pa, vb[1], o[1], 0, 0, 0, scl, 0, scl);
    ka[0] = cat8(LDF_(Kn + kswz(r32, 32 * hi)), LDF_(Kn + kswz(r32, 32 * hi + 16))); ka[1] = cat8(LDF_(Kn + kswz(32 + r32, 32 * hi)), LDF_(Kn + kswz(32 + r32, 32 * hi + 16)));
    { auto rr = __builtin_amdgcn_permlane32_swap(__float_as_uint(pmax), __float_as_uint(pmax), false, false); pmax = max3_(-INFINITY, __uint_as_float(rr[0]), __uint_as_float(rr[1])); }
    float mn;
    { const bool keep = __all(pmax - m_reg <= THR / SCALE);
      mn = keep ? m_reg : fmaxf(m_reg, pmax); alpha = __builtin_amdgcn_exp2f((m_reg - mn) * C); m_reg = mn; }
    const float mnC = PBASE - mn * C;
#pragma unroll
    for (int r = 0; r < 16; ++r) q0[r] = fmaf(q0[r], C, mnC);
    SB_();
    o[2] = __builtin_amdgcn_mfma_scale_f32_32x32x64_f8f6f4(pa, vb[2], o[2], 0, 0, 0, scl, 0, scl);
#pragma unroll
    for (int r = 0; r < 16; ++r) q1[r] = fmaf(q1[r], C, mnC);
#pragma unroll
    for (int r = 0; r < 6; ++r) q0[r] = __builtin_amdgcn_exp2f(q0[r]);
    SB_();
    o[3] = __builtin_amdgcn_mfma_scale_f32_32x32x64_f8f6f4(pa, vb[3], o[3], 0, 0, 0, scl, 0, scl);
#pragma unroll
    for (int r = 6; r < 16; ++r) q0[r] = __builtin_amdgcn_exp2f(q0[r]);
    asm volatile("" : "+v"(q0), "+v"(q1));
    SB_();
}
__device__ __forceinline__ void body(const unsigned char* __restrict__ Qb, const unsigned char* __restrict__ Kh, const unsigned char* __restrict__ Vt, unsigned char* __restrict__ Ob, int seq, char* lds) {
    const int tid = threadIdx.x, wid = tid >> 6, lane = tid & 63, r32 = lane & 31, hi = lane >> 5;
    const int scl = 0x7f7f7f7f;
    float* ws = (float*)(lds + 65536) + wid * 64; float* li_l = ws; float* al_l = ws + 32;
    float m_reg = -1e30f, l_reg = 0; f32x16 o[4] = {}; v8i qf[2];
    { int tq = threadIdx.x; asm volatile("" : "+v"(tq));
      const unsigned qoff = (unsigned)((tq >> 6) * QBLK + (tq & 31)) * 1024u + 32u * (unsigned)((tq >> 5) & 1);
      const __amdgpu_buffer_rsrc_t rQ_ = __builtin_amdgcn_make_buffer_rsrc((void*)Qb, 0, 0x7fffffff, 0x00020000);
#pragma unroll
      for (int s = 0; s < 2; ++s) qf[s] = cat8(__builtin_bit_cast(u32x4_, __builtin_amdgcn_raw_buffer_load_b128(rQ_, (int)qoff + 64 * s, 0, 0)), __builtin_bit_cast(u32x4_, __builtin_amdgcn_raw_buffer_load_b128(rQ_, (int)qoff + 64 * s + 16, 0, 0))); }
    const int kr = tid >> 3, kc = (tid & 7) * 16, kdst = kswz(kr, kc);
    const int vd = tid >> 2, vsl = tid & 3, vdst = vswz(vd, vsl);
    struct { u32x4_ k, v; } sr_[2];
    const __amdgpu_buffer_rsrc_t rK_ = __builtin_amdgcn_make_buffer_rsrc((void*)Kh, 0, 0x7fffffff, 0x00020000), rV_ = __builtin_amdgcn_make_buffer_rsrc((void*)Vt, 0, 0x7fffffff, 0x00020000);
    const int kb0_ = kr * 256 + kc, vb0_ = vd * 64 + vsl * 16;
#define BLD_(r, off) __builtin_bit_cast(u32x4_, __builtin_amdgcn_raw_buffer_load_b128((r), (off), 0, 0))
#define SLOAD(i, t) do { sr_[i].k = BLD_(rK_, kb0_ + (t) * 16384); sr_[i].v = BLD_(rV_, vb0_ + (t) * 8192); } while (0)
#define SWRITE(t, i) do { char* s_ = lds + ((t) & 3) * 16384; *(u32x4_*)(s_ + kdst) = sr_[i].k; *(u32x4_*)(s_ + 8192 + vdst) = sr_[i].v; } while (0)
#define KS(t) (lds + ((t) & 3) * 16384)
#define VS(t) (lds + ((t) & 3) * 16384 + 8192)
#define SWAIT() asm volatile("s_waitcnt vmcnt(2)" ::: "memory")
#define RESC(a) do { if (__any((a) < 1.f)) { if (hi == 0) al_l[r32] = (a); asm volatile("s_waitcnt lgkmcnt(0)" ::: "memory"); \
    _Pragma("unroll") for (int d = 0; d < 4; ++d) _Pragma("unroll") for (int r = 0; r < 16; ++r) o[d][r] *= al_l[crow(r, hi)]; } } while (0)
#define SBAR_() __builtin_amdgcn_sched_barrier(0)
    f32x16 pA0, pA1, pB0, pB1; float mnA, mnB, alA, alB; v8i pa; const int NT = seq / KVBLK;
    v8i ka[4], vb[4];
    SLOAD(0, 0); SLOAD(1, 1); asm volatile("s_waitcnt vmcnt(0)" ::: "memory"); SWRITE(0, 0); SWRITE(1, 1); __syncthreads();
    qkt(pA0, pA1, KS(0), qf, r32, hi, scl); partialSM(pA0, pA1, m_reg, mnA, alA);
    SLOAD(0, 2); SLOAD(1, 3 < NT ? 3 : NT - 1);
    SWAIT(); SWRITE(2, 0);
    { const char* Kn = KS(1);
      ka[0] = cat8(LDF_(Kn + kswz(r32, 32 * hi)), LDF_(Kn + kswz(r32, 32 * hi + 16))); ka[1] = cat8(LDF_(Kn + kswz(32 + r32, 32 * hi)), LDF_(Kn + kswz(32 + r32, 32 * hi + 16))); }
    __syncthreads();
    int koff_ = kb0_ + 4 * 16384, voff_ = vb0_ + 4 * 8192;
#define KSC(s) (lds + (s) * 16384)
#define VSC(s) (lds + (s) * 16384 + 8192)
#define SWRITEC(s, i) do { char* s_ = lds + (s) * 16384; *(u32x4_*)(s_ + kdst) = sr_[i].k; *(u32x4_*)(s_ + 8192 + vdst) = sr_[i].v; } while (0)
#define SLOADP(i) do { sr_[i].k = BLD_(rK_, koff_); sr_[i].v = BLD_(rV_, voff_); koff_ += 16384; voff_ += 8192; } while (0)
#define PAIR_(A, PA_, PB_) \
        SBAR_(); __builtin_amdgcn_s_setprio(PA_); stepA(pB0, pB1, pA0, pA1, alA, l_reg, pa, ka, vb, KSC(A), VSC(((A) + 3) & 3), qf, r32, hi, scl); \
        SLOADP(0); __builtin_amdgcn_s_setprio(PB_); SBAR_(); \
        stepB(o, vb, ka, KSC(((A) + 1) & 3), VSC(((A) + 3) & 3), pa, pB0, pB1, m_reg, alB, r32, hi, scl); \
        SWAIT(); SWRITEC(((A) + 2) & 3, 1); \
        RESC(alB); __syncthreads(); \
        SBAR_(); __builtin_amdgcn_s_setprio(PA_); stepA(pA0, pA1, pB0, pB1, alB, l_reg, pa, ka, vb, KSC(((A) + 1) & 3), VSC(A), qf, r32, hi, scl); \
        SLOADP(1); __builtin_amdgcn_s_setprio(PB_); SBAR_(); \
        stepB(o, vb, ka, KSC(((A) + 2) & 3), VSC(A), pa, pA0, pA1, m_reg, alA, r32, hi, scl); \
        SWAIT(); SWRITEC(((A) + 3) & 3, 0); \
        RESC(alA); __syncthreads();
    if (wid < 4) {
        for (int j = 1; j + 4 < NT; j += 4) { PAIR_(1, 0, 0) PAIR_(3, 0, 0) }
        PAIR_(1, 0, 0)
    } else {
        for (int j = 1; j + 4 < NT; j += 4) { PAIR_(1, 1, 0) PAIR_(3, 1, 0) }
        PAIR_(1, 1, 0)
    }
#undef PAIR_
#undef SLOADP
#undef SWRITEC
#undef KSC
#undef VSC
    asm volatile("s_waitcnt vmcnt(0)" ::: "memory");
    SBAR_(); qkt(pB0, pB1, KS(NT - 1), qf, r32, hi, scl);
    finishSM(pA0, pA1, alA, l_reg, pa); SBAR_();
    pv(o, VS(NT - 2), pa, r32, hi, scl); partialSM(pB0, pB1, m_reg, mnB, alB);
    __syncthreads(); RESC(alB);
    finishSM(pB0, pB1, alB, l_reg, pa); SBAR_();
    pv(o, VS(NT - 1), pa, r32, hi, scl);
    if (hi == 0) li_l[r32] = l_reg; asm volatile("s_waitcnt lgkmcnt(0)" ::: "memory");
    float rli[16];
#pragma unroll
    for (int r = 0; r < 16; ++r) rli[r] = __builtin_amdgcn_rcpf(li_l[crow(r, hi)]);
    { int te = threadIdx.x; asm volatile("" : "+v"(te));
      const int hi_e = (te >> 5) & 1; unsigned char* Ow = Ob + (long)((te >> 6) * QBLK) * 1024 + (te & 31);
#pragma unroll
      for (int r = 0; r < 16; ++r) { const int orow = crow(r, hi_e); const float sc_ = 64.f * rli[r];
        const unsigned w_ = pack4_fp8(o[0][r] * sc_, o[1][r] * sc_, o[2][r] * sc_, o[3][r] * sc_);
#pragma unroll
        for (int d0 = 0; d0 < 4; ++d0) Ow[(long)orow * 1024 + d0 * 32] = (unsigned char)(w_ >> (8 * d0)); } }
#undef KS
#undef VS
#undef SLOAD
#undef SWRITE
#undef SWAIT
#undef BLD_
#undef RESC
#undef SBAR_
}
}
__device__ __forceinline__ void phase_attn(const Params& p, const Ctx& c, char* lds_generic) {
    unsigned char* ws = p.ws;
    const unsigned char* Q8 = ws + WS_QN; const unsigned char* K8 = ws + WS_KN; const unsigned char* VT8 = ws + WS_VB; unsigned char* AO = ws + WS_AO;
    for (int item = c.bid; item < 512; item += c.G) {
        const int b = item >> 8, h = (item >> 5) & 7, qb = item & 31, kvh = h >> 2;
        const size_t qrow = (size_t)b * S + qb * 256;
        attn8::body(Q8 + qrow * 1024 + h * 128, K8 + (size_t)b * S * 256 + kvh * 128, VT8 + (size_t)(b * 2 + kvh) * 128 * 8192, AO + qrow * 1024 + h * 128, S, lds_generic);
        __syncthreads();
    }
}

typedef short bf16x8r __attribute__((ext_vector_type(8)));
typedef float f32x16r __attribute__((ext_vector_type(16)));
__device__ __forceinline__ void phase_router(const Params& p, const Ctx& c) {
    unsigned char* ws = p.ws;
    constexpr int XS = 1032;
    LAS bf16_t* xs = (LAS bf16_t*)c.lds;
    LAS float* part = (LAS float*)(c.lds + 66048);
    LAS float* ssq = (LAS float*)(c.lds + 66048 + 33792);
    LAS float* lgt = ssq + 32;
    LAS int* tokE = (LAS int*)(c.lds + LDS_CTL + 512);
    LAS float* tokW = (LAS float*)(c.lds + LDS_CTL + 512 + 1024);
    LAS int* lcnt = (LAS int*)(c.lds + LDS_CTL + 512 + 2048);
    LAS int* lbase = lcnt + 32;
    LAS int* lrank = lbase + 32;
    const bf16_t* X1 = (const bf16_t*)(ws + WS_X1); unsigned char* H2 = ws + WS_H2;
    const bf16_t* WH = (const bf16_t*)(ws + WS_WRT); const bf16_t* WL = WH + 32768;
    int* CNT = (int*)(ws + WS_CTL); int* TOKES = (int*)(ws + WS_TOKES); float* TOKW = (float*)(ws + WS_TOKW); int* LIST = (int*)(ws + WS_LIST);
    const int tid = c.tid, lane = c.lane, r = lane & 31, hh = lane >> 5, wave = c.wave;
    bf16x8r bh[8], bl[8];
#pragma unroll
    for (int ks = 0; ks < 8; ++ks) { const int k0 = 128 * wave + 16 * ks + 8 * hh; bh[ks] = *(const bf16x8r*)(WH + r * 1024 + k0); bl[ks] = *(const bf16x8r*)(WL + r * 1024 + k0); }
    const float bias_e = p.in[18][lane & 31];
    for (int blk = c.bid; blk < M / 64; blk += c.G) {
        __syncthreads();
        if (tid < 32) lcnt[tid] = 0;
        for (int grp = 0; grp < 2; ++grp) {
            const size_t tok0 = (size_t)blk * 64 + grp * 32;
            __syncthreads();
            if (tid < 32) ssq[tid] = 0.f;
            u32x4 xv[8];
#pragma unroll
            for (int q = 0; q < 8; ++q) { const int idx = tid + 512 * q; xv[q] = *(const u32x4*)(X1 + (tok0 + (idx >> 7)) * 1024 + (idx & 127) * 8); }
            __syncthreads();
#pragma unroll
            for (int q = 0; q < 8; ++q) { const int idx = tid + 512 * q; *(LAS u32x4*)(xs + (idx >> 7) * XS + (idx & 127) * 8) = xv[q];
                const u32x4 v = xv[q]; float s = bflo(v.x) * bflo(v.x) + bfhi(v.x) * bfhi(v.x) + bflo(v.y) * bflo(v.y) + bfhi(v.y) * bfhi(v.y) + bflo(v.z) * bflo(v.z) + bfhi(v.z) * bfhi(v.z) + bflo(v.w) * bflo(v.w) + bfhi(v.w) * bfhi(v.w);
                s = wave_sum(s); if (lane == 0) atomicAdd((float*)&ssq[idx >> 7], s); }
            __syncthreads();
            { f32x16r acc = {};
#pragma unroll
              for (int ks = 0; ks < 8; ++ks) { const bf16x8r a = *(const LAS bf16x8r*)(xs + r * XS + 128 * wave + 16 * ks + 8 * hh);
                  acc = __builtin_amdgcn_mfma_f32_32x32x16_bf16(a, bh[ks], acc, 0, 0, 0); acc = __builtin_amdgcn_mfma_f32_32x32x16_bf16(a, bl[ks], acc, 0, 0, 0); }
#pragma unroll
              for (int i = 0; i < 16; ++i) part[(wave * 32 + (i & 3) + 8 * (i >> 2) + 4 * hh) * 33 + r] = acc[i]; }
            __syncthreads();
#pragma unroll
            for (int q = 0; q < 2; ++q) { const int idx = tid + 512 * q, tk = idx >> 5, e = idx & 31; float s = 0.f;
#pragma unroll
                for (int w = 0; w < 8; ++w) s += part[(w * 32 + tk) * 33 + e];
                lgt[tk * 33 + e] = s * rsqrtf(ssq[tk] * (1.f / 1024.f) + EPS) + p.in[18][e]; }
#pragma unroll
            for (int q = 0; q < 8; ++q) { const int idx = tid + 512 * q, row = idx >> 7, c8 = idx & 127; const u32x4 v = xv[q];
                const float rs = 8.f * rsqrtf(ssq[row] * (1.f / 1024.f) + EPS);
                const f32x4 g0 = *(const f32x4*)(p.in[16] + c8 * 8), g1 = *(const f32x4*)(p.in[16] + c8 * 8 + 4);
                u32x2 w; w.x = pack4_fp8(bflo(v.x) * rs * g0[0], bfhi(v.x) * rs * g0[1], bflo(v.y) * rs * g0[2], bfhi(v.y) * rs * g0[3]);
                w.y = pack4_fp8(bflo(v.z) * rs * g1[0], bfhi(v.z) * rs * g1[1], bflo(v.w) * rs * g1[2], bfhi(v.w) * rs * g1[3]);
                *(u32x2*)(H2 + (tok0 + row) * 1024 + c8 * 8) = w; }
            __syncthreads();
            if (tid < 32) {
                float v0 = -INFINITY, v1 = -INFINITY, v2 = -INFINITY, v3 = -INFINITY; int i0 = 0, i1 = 0, i2 = 0, i3 = 0;
#pragma unroll
                for (int e = 0; e < 32; ++e) { const float x = lgt[tid * 33 + e];
                    bool cc = x > v3; v3 = cc ? x : v3; i3 = cc ? e : i3;
                    cc = v3 > v2; { const float tv = cc ? v3 : v2; const int ti = cc ? i3 : i2; v3 = cc ? v2 : v3; i3 = cc ? i2 : i3; v2 = tv; i2 = ti; }
                    cc = v2 > v1; { const float tv = cc ? v2 : v1; const int ti = cc ? i2 : i1; v2 = cc ? v1 : v2; i2 = cc ? i1 : i2; v1 = tv; i1 = ti; }
                    cc = v1 > v0; { const float tv = cc ? v1 : v0; const int ti = cc ? i1 : i0; v1 = cc ? v0 : v1; i1 = cc ? i0 : i1; v0 = tv; i0 = ti; } }
                const float e1 = __expf(v1 - v0), e2 = __expf(v2 - v0), e3 = __expf(v3 - v0);
                const float inv = 1.f / (1.f + e1 + e2 + e3);
                const int t = grp * 32 + tid;
                tokE[t * 4 + 0] = i0; tokE[t * 4 + 1] = i1; tokE[t * 4 + 2] = i2; tokE[t * 4 + 3] = i3;
                tokW[t * 4 + 0] = inv; tokW[t * 4 + 1] = e1 * inv; tokW[t * 4 + 2] = e2 * inv; tokW[t * 4 + 3] = e3 * inv; }
        }
        (void)bias_e;
        __syncthreads();
        if (tid < 256) lrank[tid] = atomicAdd((int*)&lcnt[tokE[tid]], 1);
        __syncthreads();
        if (tid < 32) lbase[tid] = lcnt[tid] ? atomicAdd(&CNT[tid], lcnt[tid]) : 0;
        __syncthreads();
        if (tid < 256) {
            const int e = tokE[tid], slot = lbase[e] + lrank[tid], tok = blk * 64 + (tid >> 2);
            LIST[e * 16384 + slot] = tok; TOKES[tok * 4 + (tid & 3)] = (e << 16) | slot; TOKW[tok * 4 + (tid & 3)] = tokW[tid];
        }
    }
    __syncthreads();
}

__device__ __forceinline__ void load_offs(const Params& p, const Ctx& c, LAS int*& offs, LAS int*& cnt, bool build = true) {
    offs = (LAS int*)(c.lds + LDS_CTL); cnt = offs + 40;
    if (!build) return;
    __syncthreads();
    if (c.tid < 32) { const int n = __hip_atomic_load((const int*)(p.ws + WS_CTL) + c.tid, __ATOMIC_RELAXED, __HIP_MEMORY_SCOPE_AGENT); cnt[c.tid] = n; offs[c.tid] = (n + 255) & ~255; }
    __syncthreads();
    if (c.tid == 0) { int run = 0; for (int e = 0; e < 32; ++e) { const int sz = offs[e]; offs[e] = run; run += sz; } offs[32] = run; }
    __syncthreads();
    if (c.tid < 320) { int e = 0; while (e < 31 && c.tid * 256 >= offs[e + 1]) ++e; offs[80 + c.tid] = e; }
    __syncthreads();
}
__device__ __forceinline__ void phase_gemm1(const Params& p, const Ctx& c) {
    const int grp = c.bid >> 3, xcd = c.bid & 7; const bool spec = c.G == 256, streamer = spec && (grp & 3) == 0;
    const int GG = spec ? 192 : c.G, cc = spec ? 8 * (grp - (grp >> 2) - 1) + xcd : c.bid;
    if (!streamer) {
    { pg8::Gemm g{(const bf16_t*)(p.ws + WS_H), (const bf16_t*)(p.ws + WS_WINT), M, PQ, 1024};
      pg8::StaticOrder S; S.init(M, PQ, GG, cc);
      pg8::EpiStore E{(bf16_t*)(p.ws + WS_P), NPROJ};
      pg8::gemm_phase<pg8::EpiStore, pg8::StaticOrder, true, true>(c.lds, g, S, E); }
    { pg8::Gemm g{(const bf16_t*)(p.ws + WS_H8), (const bf16_t*)(p.ws + WS_WIN8), M, PDT - PQ, 512};
      pg8::StaticOrder S; S.init(M, PDT - PQ, GG, GG - 1 - cc);
      pg8::EpiStore8G E{(bf16_t*)(p.ws + WS_P) + PQ, NPROJ, 1.f / 512.f, p.ws + WS_G8};
      pg8::gemm_phase_f8<pg8::EpiStore8G, pg8::StaticOrder, true, true>(c.lds, g, S, E); }
      asm volatile("s_waitcnt vmcnt(0) lgkmcnt(0)" ::: "memory");
      __syncthreads();
      if (spec) { if (cc >= 64) phase_dt(p, c, cc - 64, 128); } else phase_dt(p, c, c.bid, c.G);
    }
    phase_prep8q(p, c);
}
__device__ __forceinline__ void phase_tail12(const Params& p, const Ctx& c) {
    unsigned char* ws = p.ws;
    pg8::StaticOrder S; S.init(M, 1024, c.G, c.bid);
    { pg8::Gemm g{(const bf16_t*)(ws + WS_YZ), (const bf16_t*)(ws + WS_WST), M, 1024, 1024};
      pg8::EpiT12 E{(bf16_t*)(ws + WS_T1), (bf16_t*)(ws + WS_MG), ws + WS_G8, (const float*)(ws + WS_RSTD), false};
      pg8::gemm_phase<pg8::EpiT12, pg8::StaticOrder, true, true>(c.lds, g, S, E); }
    { pg8::Gemm g{(const bf16_t*)(ws + WS_AO), (const bf16_t*)(ws + WS_WAT), M, 1024, 512};
      pg8::EpiT12 E{(bf16_t*)(ws + WS_T1), (bf16_t*)(ws + WS_MG), ws + WS_G8, (const float*)(ws + WS_RSTD), true};
      pg8::gemm_phase_f8<pg8::EpiT12, pg8::StaticOrder, true, true>(c.lds, g, S, E); }
}
__device__ __forceinline__ void phase_tail3(const Params& p, const Ctx& c) {
    unsigned char* ws = p.ws;
    pg8::StaticOrder S; S.init(M, 1024, c.G, c.bid);
    pg8::Gemm g{(const bf16_t*)(ws + WS_MG), (const bf16_t*)(ws + WS_WOT), M, 1024, 1024};
    pg8::EpiT3b E{(bf16_t*)(ws + WS_X1), p.in[0]};
    pg8::gemm_phase<pg8::EpiT3b, pg8::StaticOrder, true, true>(c.lds, g, S, E);
}
__device__ __forceinline__ void phase_moe1(const Params& p, const Ctx& c) {
    LAS int* offs; LAS int* cnt; load_offs(p, c, offs, cnt);
    unsigned char* ws = p.ws;
    pg8::Gemm g{(const bf16_t*)(ws + WS_H2), (const bf16_t*)(ws + WS_W1T), M, 32 * 2048, 512};
    pg8::MoeGatherOrder S{offs, cnt, offs + 80, (const int*)(ws + WS_LIST), c.G, c.bid, offs[32] / 256};
    pg8::EpiAct8 E{(unsigned char*)(ws + WS_ACT), p.in[20]};
    pg8::gemm_phase_gather_f8<pg8::EpiAct8, pg8::MoeGatherOrder>(c.lds, g, S, E);
}
__device__ __forceinline__ void phase_moe2(const Params& p, const Ctx& c) {
    LAS int* offs; LAS int* cnt; load_offs(p, c, offs, cnt, false);
    unsigned char* ws = p.ws;
    pg8::Gemm g{(const bf16_t*)(ws + WS_ACT), (const bf16_t*)(ws + WS_W2T), ROWS_MAX, 32 * 1024, 512};
    pg8::MoeOrder<4> S{offs + 80, c.G, c.bid, offs[32] / 256};
    pg8::EpiY8 E{(bf16_t*)(ws + WS_YB), p.in[22]};
    pg8::gemm_phase_f8<pg8::EpiY8, pg8::MoeOrder<4>, true, true>(c.lds, g, S, E);
}

__device__ __forceinline__ void phase_combine(const Params& p, const Ctx& c) {
    LAS int* offs; LAS int* cnt; load_offs(p, c, offs, cnt, false);
    unsigned char* ws = p.ws;
    const bf16_t* X1 = (const bf16_t*)(ws + WS_X1); const bf16_t* YB = (const bf16_t*)(ws + WS_YB);
    const int* TOKES = (const int*)(ws + WS_TOKES); const float* TOKW = (const float*)(ws + WS_TOKW);
    const int gw = c.bid * 8 + c.wave, NGW = c.G * 8, lane = c.lane;
    f32x4 gv[4];
#pragma unroll
    for (int j = 0; j < 4; ++j) gv[j] = ((const f32x4*)p.in[23])[lane + 64 * j];
    for (int m0 = gw * 2; m0 < M; m0 += NGW * 2) {
        int es[2][4]; float wq[2][4];
#pragma unroll
        for (int t = 0; t < 2; ++t)
#pragma unroll
            for (int k = 0; k < 4; ++k) { es[t][k] = TOKES[(m0 + t) * 4 + k]; wq[t][k] = TOKW[(m0 + t) * 4 + k]; }
        f32x4 v[2][4]; u32x2 y[2][4][4];
#pragma unroll
        for (int t = 0; t < 2; ++t) { const u32x2* xr = (const u32x2*)(X1 + (size_t)(m0 + t) * 1024) + lane;
#pragma unroll
            for (int j = 0; j < 4; ++j) { const u32x2 xx = xr[64 * j]; v[t][j] = (f32x4){bflo(xx.x), bfhi(xx.x), bflo(xx.y), bfhi(xx.y)}; }
#pragma unroll
            for (int k = 0; k < 4; ++k) { const int row = offs[es[t][k] >> 16] + (es[t][k] & 0xffff); const u32x2* yr = (const u32x2*)(YB + (size_t)row * 1024) + lane;
#pragma unroll
                for (int j = 0; j < 4; ++j) y[t][k][j] = yr[64 * j]; } }
#pragma unroll
        for (int t = 0; t < 2; ++t) {
#pragma unroll
            for (int k = 0; k < 4; ++k) { const float w = wq[t][k];
#pragma unroll
                for (int j = 0; j < 4; ++j) { const u32x2 yy = y[t][k][j];
                    v[t][j].x = fmaf(w, bflo(yy.x), v[t][j].x); v[t][j].y = fmaf(w, bfhi(yy.x), v[t][j].y); v[t][j].z = fmaf(w, bflo(yy.y), v[t][j].z); v[t][j].w = fmaf(w, bfhi(yy.y), v[t][j].w); } }
            float s = 0.f;
#pragma unroll
            for (int j = 0; j < 4; ++j) s += (v[t][j].x * v[t][j].x + v[t][j].y * v[t][j].y) + (v[t][j].z * v[t][j].z + v[t][j].w * v[t][j].w);
            const float rstd = rsqrtf(wave_sum(s) * (1.f / 1024.f) + EPS);
            f32x4* o = (f32x4*)(p.out + (size_t)(m0 + t) * 1024) + lane;
#pragma unroll
            for (int j = 0; j < 4; ++j) o[64 * j] = v[t][j] * rstd * gv[j];
        }
    }
}

#define XB_TMO      128
#define XB_XCNT(j)  (256  + 64 * (j))
#define XB_XSUB(j)  (1280 + 64 * (j))
#define XB_XGEN(j)  (2304 + 64 * (j))
#define XB_TOP      3328
#define XB_TOPGEN   3392
#define XCD_BAR_WORDS 3456
#define XB_SPIN_CAP (1u << 18)

__device__ __forceinline__ unsigned xb_ld(unsigned* p)              { return __hip_atomic_load(p, __ATOMIC_RELAXED, __HIP_MEMORY_SCOPE_AGENT); }
__device__ __forceinline__ unsigned xb_add(unsigned* p, unsigned v) { return __hip_atomic_fetch_add(p, v, __ATOMIC_RELAXED, __HIP_MEMORY_SCOPE_AGENT); }
__device__ __forceinline__ unsigned xb_xcc_id() { return (unsigned)__builtin_amdgcn_s_getreg((3 << 11) | 20) & 0xFu; }
#define XB_SPIN(cond, bar) do { unsigned _sp = 0; while (cond) { __builtin_amdgcn_s_sleep(1); \
    if ((++_sp & 255u) == 0u) { if (xb_ld(&(bar)[XB_TMO])) break; if (_sp > XB_SPIN_CAP) { atomicAdd(&(bar)[XB_TMO], 1u); break; } } } } while (0)

struct XcdBarrier {
    unsigned* bar; unsigned x;
    volatile LAS unsigned* st;
};

__device__ __forceinline__ XcdBarrier xcd_barrier_post(unsigned* bar, volatile LAS unsigned* st) {
    XcdBarrier b; b.bar = bar; b.x = xb_xcc_id(); b.st = st;
    if (threadIdx.x == 0) (void)xb_add(&bar[XB_XCNT(b.x)], 1u);
    return b;
}
__device__ __forceinline__ void xcd_barrier_complete(unsigned* bar, unsigned x, unsigned& nloc, unsigned& nx) {
    const unsigned G = gridDim.x * gridDim.y * gridDim.z;
    unsigned sum, cnt, mine, sp = 0u;
    for (;;) {
        sum = 0u; cnt = 0u; mine = 0u;
#pragma unroll
        for (unsigned j = 0; j < 16; ++j) { const unsigned c = xb_ld(&bar[XB_XCNT(j)]); sum += c; cnt += (c > 0u) ? 1u : 0u; mine = (j == x) ? c : mine; }
        if (sum == G) break;
        __builtin_amdgcn_s_sleep(1);
        if ((++sp & 255u) == 0u) { if (xb_ld(&bar[XB_TMO])) break; if (sp > XB_SPIN_CAP) { atomicAdd(&bar[XB_TMO], 1u); break; } }
    }
    nloc = mine > 0u ? mine : 1u; nx = cnt > 0u ? cnt : 1u;
}

__device__ __forceinline__ void xcd_barrier(const XcdBarrier& b) {
    asm volatile("s_waitcnt vmcnt(0)" ::: "memory");
    __syncthreads();
    if (threadIdx.x == 0) {
        unsigned* bar = b.bar;
        __builtin_amdgcn_s_waitcnt(0);
        unsigned nloc = b.st[0], nx = b.st[1];
        if (nloc == 0u) { xcd_barrier_complete(bar, b.x, nloc, nx); b.st[0] = nloc; b.st[1] = nx; }
        const unsigned old = xb_add(&bar[XB_XSUB(b.x)], 1u);
        const unsigned gen = old / nloc;
        if (old + 1u == (gen + 1u) * nloc) {
            __builtin_amdgcn_fence(__ATOMIC_RELEASE, "agent");
            asm volatile("s_waitcnt vmcnt(0)" ::: "memory");
            const unsigned og = xb_add(&bar[XB_TOP], 1u);
            const unsigned tg = og / nx;
            if (og + 1u == (tg + 1u) * nx) xb_add(&bar[XB_TOPGEN], 1u);
            else XB_SPIN(xb_ld(&bar[XB_TOPGEN]) == tg, bar);
            __builtin_amdgcn_fence(__ATOMIC_ACQUIRE, "agent");
            xb_add(&bar[XB_XGEN(b.x)], 1u);
            asm volatile("s_waitcnt vmcnt(0)" ::: "memory");
        } else {
            XB_SPIN(xb_ld(&bar[XB_XGEN(b.x)]) == gen, bar);
            __builtin_amdgcn_fence(__ATOMIC_ACQUIRE, "agent");
            asm volatile("s_waitcnt vmcnt(0)" ::: "memory");
        }
    }
    __syncthreads();
}

constexpr int NPHASE = 12;
__global__ void __launch_bounds__(512) mega(Params p) {
    extern __shared__ __attribute__((aligned(16))) unsigned char lds_raw[];
    Ctx c; c.tid = threadIdx.x; c.lane = c.tid & 63; c.wave = __builtin_amdgcn_readfirstlane(c.tid >> 6); c.bid = blockIdx.x; c.G = gridDim.x;
    c.lds = (LAS unsigned char*)lds_raw;
    cg::grid_group grid = cg::this_grid();
    if (c.tid < 2) ((volatile LAS unsigned*)(c.lds + LDS_BARST))[c.tid] = 0u;
    __syncthreads();
#define SEAM(k) do { XcdBarrier b_; b_.bar = (unsigned*)(p.ws + WS_BAR); b_.x = xb_xcc_id(); b_.st = (volatile LAS unsigned*)(c.lds + LDS_BARST); xcd_barrier(b_); } while (0)
    if (p.ph_lo < 0) grid.sync();
    (void)xcd_barrier_post((unsigned*)(p.ws + WS_BAR), (volatile LAS unsigned*)(c.lds + LDS_BARST));
#define RUN(k, call) if (p.ph_lo <= (k) && (k) < p.ph_hi) { call; if ((k) + 1 < p.ph_hi) SEAM(k); }
    RUN(0, phase_prep(p, c))
    RUN(1, phase_gemm1(p, c))
    RUN(2, phase_conv(p, c))
    RUN(3, phase_ssd_states(p, c))
    RUN(4, phase_ssd_scan(p, c))
    RUN(5, phase_ssd_out(p, c); __syncthreads(); phase_attn(p, c, (char*)lds_raw))
    RUN(6, phase_tail12(p, c))
    RUN(7, phase_tail3(p, c))
    RUN(8, phase_router(p, c))
    RUN(9, phase_moe1(p, c))
    RUN(10, phase_moe2(p, c))
    RUN(11, phase_combine(p, c))
#undef RUN
}

extern "C" void kernel_launch(void* const* d_in, const int* in_sizes, int n_in, void* d_out, int out_size, void* d_ws, size_t ws_size, hipStream_t stream) {
    static int ok = 0; static int grid_blocks = 0;
    if (ok == 0) {
        if (n_in != 24 || out_size != M * D || ws_size < WS_END) { fprintf(stderr, "kernel_launch: unexpected shapes: n_in %d out %d ws %zu (need %zu)\n", n_in, out_size, ws_size, (size_t)WS_END); ok = -1; return; }
        if (hipFuncSetAttribute((const void*)mega, hipFuncAttributeMaxDynamicSharedMemorySize, LDS_BYTES) != hipSuccess) { fprintf(stderr, "kernel_launch: hipFuncSetAttribute failed\n"); ok = -1; return; }
        int dev = 0, cus = 0, per_cu = 0;
        hipGetDevice(&dev);
        hipDeviceGetAttribute(&cus, hipDeviceAttributeMultiprocessorCount, dev);
        hipOccupancyMaxActiveBlocksPerMultiprocessor(&per_cu, (const void*)mega, 512, LDS_BYTES);
        if (per_cu < 1 || cus < 1) { fprintf(stderr, "kernel_launch: occupancy query gave %d blocks/CU on %d CUs\n", per_cu, cus); ok = -1; return; }
        grid_blocks = cus;
        ok = 1;
    }
    if (ok < 0) return;
    Params p{};
    for (int i = 0; i < 24; ++i) p.in[i] = (const float*)d_in[i];
    p.out = (float*)d_out; p.ws = (unsigned char*)d_ws;
    p.ph_lo = 0; p.ph_hi = NPHASE;
    if (hipMemsetAsync((char*)d_ws + WS_BAR, 0, 16384, stream) != hipSuccess) { fprintf(stderr, "kernel_launch: hipMemsetAsync of the barrier words failed\n"); return; }
    void* args[] = {&p};
    hipError_t e = hipLaunchCooperativeKernel((const void*)mega, dim3(grid_blocks), dim3(512), args, LDS_BYTES, stream);
    if (e != hipSuccess) fprintf(stderr, "kernel_launch: cooperative launch failed: %s (grid %d)\n", hipGetErrorString(e), grid_blocks);
}
```
